# Optimizing an MI355X kernel written in HIP

```python
import jax, jax.numpy as jnp
from jax import lax
import numpy as np

D_MODEL = 1024
BATCH = 2
SEQ = 8192
DEPTH = 2

N_A = DEPTH // 2
N_B = DEPTH - N_A
N_DENSE = (DEPTH + 1) // 2
N_MOE = DEPTH // 2

HEAD_DIM = 128
N_HEADS_A = D_MODEL // HEAD_DIM
N_KV_HEADS_A = 2
GROUP_A = N_HEADS_A // N_KV_HEADS_A
N_IDX_HEADS = 8
IDX_DIM = 64
MAX_TOPK = 256
N_HEADS_B = D_MODEL // HEAD_DIM

ROPE_THETA = 500000.0
ROT_FRAC = 4
Q_BLOCK = 128
NORM_EPS = 1e-6

D_FF = 2816
N_EXPERTS = 8
TOP_K_EXPERTS = 2

A_Q = N_HEADS_A * HEAD_DIM
A_K = N_KV_HEADS_A * HEAD_DIM
A_V = N_KV_HEADS_A * HEAD_DIM
A_QI = N_IDX_HEADS * IDX_DIM
A_KI = IDX_DIM
A_WI = N_IDX_HEADS
A_IN = A_Q + A_K + A_V + A_QI + A_KI + A_WI
A_SPLITS = (A_Q, A_Q + A_K, A_Q + A_K + A_V, A_Q + A_K + A_V + A_QI, A_Q + A_K + A_V + A_QI + A_KI)
KV_B = 2 * N_HEADS_B * HEAD_DIM

kernel_name = "yoco_dsa_stickbreaking_moe_block"


def rms_norm(x, w):
    xf = x.astype(jnp.float32)
    y = xf * lax.rsqrt(jnp.mean(xf * xf, axis=-1, keepdims=True) + NORM_EPS)
    return (y * w.astype(jnp.float32)).astype(x.dtype)


def partial_rope(x, pos):
    d = x.shape[-1]
    r = d // ROT_FRAC
    half = r // 2
    inv = ROPE_THETA ** (-jnp.arange(half, dtype=jnp.float32) * 2.0 / r)
    ang = pos.astype(jnp.float32)[:, None] * inv[None, :]
    shape = (1, pos.shape[0]) + (1,) * (x.ndim - 3) + (half,)
    cos = jnp.cos(ang).reshape(shape).astype(x.dtype)
    sin = jnp.sin(ang).reshape(shape).astype(x.dtype)
    x1, x2, rest = x[..., :half], x[..., half:r], x[..., r:]
    return jnp.concatenate([x1 * cos - x2 * sin, x2 * cos + x1 * sin, rest], axis=-1)


def swiglu(u, w_gate_up, w_down):
    g, up = jnp.split(u @ w_gate_up, 2, axis=-1)
    return (jax.nn.silu(g) * up) @ w_down


def dsa_attention(h, norm_w, w_in, q_norm_w, k_norm_w, w_out):
    B, S, _ = h.shape
    topk = min(MAX_TOPK, S // 4)
    pos = jnp.arange(S)
    u = rms_norm(h, norm_w)
    q, k, v, qi, ki, wi = jnp.split(u @ w_in, A_SPLITS, axis=-1)
    q = q.reshape(B, S, N_KV_HEADS_A, GROUP_A, HEAD_DIM)
    k = k.reshape(B, S, N_KV_HEADS_A, HEAD_DIM)
    v = v.reshape(B, S, N_KV_HEADS_A, HEAD_DIM)
    q = partial_rope(rms_norm(q, q_norm_w), pos)
    k = partial_rope(rms_norm(k, k_norm_w), pos)
    qi = partial_rope(qi.reshape(B, S, N_IDX_HEADS, IDX_DIM), pos)
    ki = partial_rope(ki[:, :, None, :], pos)[:, :, 0, :]
    wi = wi * (N_IDX_HEADS ** -0.5)
    s_idx = jnp.arange(S)
    scale = HEAD_DIM ** -0.5
    gather = jax.vmap(lambda kb, ib: kb[ib])

    def block(i):
        start = i * Q_BLOCK
        t = start + jnp.arange(Q_BLOCK)
        qb = lax.dynamic_slice_in_dim(q, start, Q_BLOCK, axis=1)
        qib = lax.dynamic_slice_in_dim(qi, start, Q_BLOCK, axis=1)
        wib = lax.dynamic_slice_in_dim(wi, start, Q_BLOCK, axis=1)
        causal = s_idx[None, :] <= t[:, None]
        rel = jax.nn.relu(jnp.einsum('bqhd,bsd->bqhs', qib, ki).astype(jnp.float32) * (IDX_DIM ** -0.5))
        score = jnp.einsum('bqhs,bqh->bqs', rel, wib.astype(jnp.float32))
        score = jnp.where(causal[None], score, -jnp.inf)
        _, sel = lax.top_k(score, topk)
        sel_valid = sel <= t[None, :, None]
        k_sel = gather(k, sel)
        v_sel = gather(v, sel)
        logits = jnp.einsum('bqhgd,bqkhd->bqhgk', qb, k_sel).astype(jnp.float32) * scale
        logits = jnp.where(sel_valid[:, :, None, None, :], logits, -jnp.inf)
        p = jax.nn.softmax(logits, axis=-1).astype(v.dtype)
        o = jnp.einsum('bqhgk,bqkhd->bqhgd', p, v_sel)
        return o.reshape(B, Q_BLOCK, A_Q)

    o = lax.map(block, jnp.arange(S // Q_BLOCK))
    o = jnp.transpose(o, (1, 0, 2, 3)).reshape(B, S, A_Q)
    return o @ w_out


def stick_breaking_attention(h, norm_w, w_q, w_out, k_sb, v_sb):
    B, S, _ = h.shape
    u = rms_norm(h, norm_w)
    q = (u @ w_q).reshape(B, S, N_HEADS_B, HEAD_DIM)
    s_idx = jnp.arange(S)
    scale = HEAD_DIM ** -0.5

    def block(i):
        start = i * Q_BLOCK
        t = start + jnp.arange(Q_BLOCK)
        qb = lax.dynamic_slice_in_dim(q, start, Q_BLOCK, axis=1)
        strict = (s_idx[None, :] < t[:, None])[None, None]
        z = jnp.einsum('bqhd,bshd->bhqs', qb, k_sb).astype(jnp.float32) * scale
        log_beta = jax.nn.log_sigmoid(z)
        log_keep = jnp.where(strict, jax.nn.log_sigmoid(-z), 0.0)
        after = lax.cumsum(log_keep, axis=3, reverse=True) - log_keep
        a = jnp.where(strict, jnp.exp(log_beta + after), 0.0)
        o = jnp.einsum('bhqs,bshd->bqhd', a.astype(v_sb.dtype), v_sb)
        return o.reshape(B, Q_BLOCK, N_HEADS_B * HEAD_DIM)

    o = lax.map(block, jnp.arange(S // Q_BLOCK))
    o = jnp.transpose(o, (1, 0, 2, 3)).reshape(B, S, N_HEADS_B * HEAD_DIM)
    return o @ w_out


def moe_ffn(u, router_w, w_gate_up, w_down):
    B, S, D = u.shape
    tok = u.reshape(B * S, D)
    logits = (tok @ router_w).astype(jnp.float32)
    top_vals, top_idx = lax.top_k(logits, TOP_K_EXPERTS)
    gates = jax.nn.softmax(top_vals, axis=-1)
    dense_gates = jnp.sum(jax.nn.one_hot(top_idx, N_EXPERTS, dtype=jnp.float32) * gates[..., None], axis=1)
    y = jnp.zeros_like(tok)
    for e in range(N_EXPERTS):
        y = y + dense_gates[:, e:e + 1].astype(tok.dtype) * swiglu(tok, w_gate_up[e], w_down[e])
    return y.reshape(B, S, D)


def setup_inputs(seed: int = 0) -> dict:
    key = jax.random.key(seed)
    ks = iter(jax.random.split(key, 32))

    def w(shape, fan_in):
        return jax.random.normal(next(ks), shape, jnp.float32) * (fan_in ** -0.5)

    def gain(shape):
        return 1.0 + 0.02 * jax.random.normal(next(ks), shape, jnp.float32)

    return {
        "x": jax.random.normal(next(ks), (BATCH, SEQ, D_MODEL), jnp.float32),
        "a_norm_w": gain((N_A, D_MODEL)),
        "a_w_in": w((N_A, D_MODEL, A_IN), D_MODEL),
        "a_q_norm_w": gain((N_A, HEAD_DIM)),
        "a_k_norm_w": gain((N_A, HEAD_DIM)),
        "a_w_out": w((N_A, A_Q, D_MODEL), A_Q),
        "kv_norm_w": gain((D_MODEL,)),
        "kv_w": w((D_MODEL, KV_B), D_MODEL),
        "b_norm_w": gain((N_B, D_MODEL)),
        "b_w_q": w((N_B, D_MODEL, N_HEADS_B * HEAD_DIM), D_MODEL),
        "b_w_out": w((N_B, N_HEADS_B * HEAD_DIM, D_MODEL), N_HEADS_B * HEAD_DIM),
        "ffn_norm_w": gain((DEPTH, D_MODEL)),
        "dense_w_gate_up": w((N_DENSE, D_MODEL, 2 * D_FF), D_MODEL),
        "dense_w_down": w((N_DENSE, D_FF, D_MODEL), D_FF),
        "moe_router_w": w((N_MOE, D_MODEL, N_EXPERTS), D_MODEL),
        "moe_w_gate_up": w((N_MOE, N_EXPERTS, D_MODEL, 2 * D_FF), D_MODEL),
        "moe_w_down": w((N_MOE, N_EXPERTS, D_FF, D_MODEL), D_FF),
    }


def reference(x, a_norm_w, a_w_in, a_q_norm_w, a_k_norm_w, a_w_out, kv_norm_w, kv_w,
              b_norm_w, b_w_q, b_w_out, ffn_norm_w, dense_w_gate_up, dense_w_down,
              moe_router_w, moe_w_gate_up, moe_w_down):
    B, S, _ = x.shape
    h = x
    k_sb = v_sb = None
    for l in range(DEPTH):
        if l < N_A:
            h = h + dsa_attention(h, a_norm_w[l], a_w_in[l], a_q_norm_w[l], a_k_norm_w[l], a_w_out[l])
        else:
            j = l - N_A
            h = h + stick_breaking_attention(h, b_norm_w[j], b_w_q[j], b_w_out[j], k_sb, v_sb)
        u = rms_norm(h, ffn_norm_w[l])
        if l % 2 == 0:
            h = h + swiglu(u, dense_w_gate_up[l // 2], dense_w_down[l // 2])
        else:
            m = l // 2
            h = h + moe_ffn(u, moe_router_w[m], moe_w_gate_up[m], moe_w_down[m])
        if l == N_A - 1:
            kv = rms_norm(h, kv_norm_w) @ kv_w
            k_sb, v_sb = jnp.split(kv, 2, axis=-1)
            k_sb = k_sb.reshape(B, S, N_HEADS_B, HEAD_DIM)
            v_sb = v_sb.reshape(B, S, N_HEADS_B, HEAD_DIM)
    return h
```

```cpp
#include <hip/hip_runtime.h>
#include <cstdio>
#include <cstdint>
namespace pg8 {
#define PG8_LAS __attribute__((address_space(3)))
typedef unsigned short bf16_t;
typedef short bf16x8 __attribute__((ext_vector_type(8)));
typedef float f32x4 __attribute__((ext_vector_type(4)));
typedef unsigned u32x4 __attribute__((ext_vector_type(4)));
constexpr int BM = 256, BK = 64, HALF = 128, HTB = HALF * BK * 2  , STAGE_BYTES = 8 * HTB, NXCD = 8, WGM = 8;

__host__ __device__ __forceinline__ int lds_byte(int r, int c) { const int st = (r >> 4) * 2 + (c >> 5), rr = r & 15, cc = c & 31, ob = rr * 64 + cc * 2; return st * 1024 + (ob ^ (((ob >> 9) & 1) << 5)); }
__host__ __device__ __forceinline__ void stage_rc(int b, int& R, int& C) { const int st = b / 1024, sb = b % 1024, swz = sb ^ (((sb >> 9) & 1) << 5); R = (st >> 1) * 16 + swz / 64; C = (st & 1) * 32 + (swz % 64) / 2; }
__host__ __device__ __forceinline__ int perm32(int rho) { const int n = rho >> 4, i = rho & 15; return 8 * (i >> 2) + 4 * n + (i & 3); }

struct Unit { int pm, pn; };
struct Gemm { const bf16_t* A; const bf16_t* Bt; int M, N, K; };

struct StaticOrder {
    int nM, nN, nwg, G, c;
    __host__ __device__ void init(int M, int N, int G_, int c_) { nM = M / BM; nN = N / BM; nwg = nM * nN; G = G_; c = c_; }
    __host__ __device__ bool next(int i, Unit& u) const {
        const long L = (long)i * G + c; if (L >= nwg) return false;
        int wgid = (int)L; { const int q = nwg / NXCD, r = nwg % NXCD, xcd = wgid % NXCD, off = wgid / NXCD; wgid = (xcd < r ? xcd * (q + 1) : r * (q + 1) + (xcd - r) * q) + off; }
        const int nig = WGM * nN, gid = wgid / nig, fm = gid * WGM, gsz = (nM - fm) < WGM ? (nM - fm) : WGM;
        u.pm = fm + ((wgid % nig) % gsz); u.pn = (wgid % nig) / gsz; return true;
    }
    __device__ __forceinline__ void a_ready(const Unit&) const {}
    __device__ __forceinline__ void done(const Unit&) const {}
};

__device__ __forceinline__ unsigned cvt_pk_bf16(float lo, float hi) { unsigned r; asm volatile("v_cvt_pk_bf16_f32 %0, %1, %2" : "=v"(r) : "v"(lo), "v"(hi)); return r; }
typedef unsigned u32x2 __attribute__((ext_vector_type(2)));
constexpr float RMS_EPS = 1e-6f;
__device__ __forceinline__ float rstd16(const float* p) {
    const f32x4 a = *(const f32x4*)p, b = *(const f32x4*)(p + 4), c = *(const f32x4*)(p + 8), d = *(const f32x4*)(p + 12);
    const float s = (((a[0] + a[1]) + (a[2] + a[3])) + ((b[0] + b[1]) + (b[2] + b[3]))) + (((c[0] + c[1]) + (c[2] + c[3])) + ((d[0] + d[1]) + (d[2] + d[3])));
    return 1.0f / sqrtf(s * (1.0f / 1024.0f) + RMS_EPS);
}
struct EpiScaleBf16 {
    static constexpr bool PERM = true, AFTER_DRAIN = false;
    bf16_t* O; int ldc; const float* ss;
    __device__ __forceinline__ void operator()(const f32x4 (&acc)[2][2][4][2], const Unit& u, int wr, int wc, int fr, int fq) const {
        const int row0 = u.pm * BM + wr * 64 + fr, col0 = u.pn * BM + wc * 32 + 8 * fq;
#pragma unroll
        for (int ai = 0; ai < 2; ++ai)
#pragma unroll
            for (int m = 0; m < 4; ++m) { const int row = row0 + ai * HALF + m * 16; const float rs = rstd16(ss + (size_t)row * 16); bf16_t* rowp = O + (size_t)row * ldc + col0;
#pragma unroll
                for (int bj = 0; bj < 2; ++bj) { const f32x4 v0 = acc[ai][bj][m][0] * rs, v1 = acc[ai][bj][m][1] * rs;
                    u32x4 w; w.x = cvt_pk_bf16(v0[0], v0[1]); w.y = cvt_pk_bf16(v0[2], v0[3]); w.z = cvt_pk_bf16(v1[0], v1[1]); w.w = cvt_pk_bf16(v1[2], v1[3]);
                    *(u32x4*)(rowp + bj * HALF) = w; } }
    }
};
struct EpiResid {
    static constexpr bool PERM = false, AFTER_DRAIN = false;
    const float* base; float* H; bf16_t* XB; float* ssp;
    __device__ __forceinline__ void operator()(const f32x4 (&acc)[2][2][4][2], const Unit& u, int wr, int wc, int fr, int fq) const {
        const int row0 = u.pm * BM + wr * 64 + fr, col0 = u.pn * BM + wc * 32 + 4 * fq;
#pragma unroll
        for (int ai = 0; ai < 2; ++ai)
#pragma unroll
            for (int m = 0; m < 4; ++m) { const int row = row0 + ai * HALF + m * 16; float q = 0.f;
#pragma unroll
                for (int bj = 0; bj < 2; ++bj)
#pragma unroll
                    for (int n = 0; n < 2; ++n) { const size_t off = (size_t)row * 1024 + col0 + bj * HALF + n * 16;
                        const f32x4 v = *(const f32x4*)(base + off) + acc[ai][bj][m][n]; *(f32x4*)(H + off) = v;
                        q += (v[0] * v[0] + v[1] * v[1]) + (v[2] * v[2] + v[3] * v[3]);
                        u32x2 w; w.x = cvt_pk_bf16(v[0], v[1]); w.y = cvt_pk_bf16(v[2], v[3]); *(u32x2*)(XB + off) = w; }
                q += __shfl_xor(q, 16); q += __shfl_xor(q, 32);
                if (fq == 0) ssp[(size_t)row * 16 + u.pn * 4 + wc] = q; }
    }
};
__device__ __forceinline__ float silu_mul(float g, float u) { return g * __builtin_amdgcn_rcpf(1.0f + __builtin_amdgcn_exp2f(g * -1.4426950408889634f)) * u; }
template <bool MOE> struct EpiSwiGLU {
    static constexpr bool PERM = true, AFTER_DRAIN = false;
    bf16_t* O; int ldc; const float* ss;
    __device__ __forceinline__ void operator()(const f32x4 (&acc)[2][2][4][2], const Unit& u, int wr, int wc, int fr, int fq) const {
        const int row0 = u.pm * BM + wr * 64 + fr; const int pnl = MOE ? (u.pn % 22) : u.pn; const int col0 = pnl * HALF + wc * 32 + 8 * fq;
#pragma unroll
        for (int ai = 0; ai < 2; ++ai)
#pragma unroll
            for (int m = 0; m < 4; ++m) { const int row = row0 + ai * HALF + m * 16; const float rs = MOE ? ss[row] : rstd16(ss + (size_t)row * 16);
                const f32x4 g0 = acc[ai][0][m][0] * rs, g1 = acc[ai][0][m][1] * rs, u0 = acc[ai][1][m][0] * rs, u1 = acc[ai][1][m][1] * rs;
                u32x4 w; w.x = cvt_pk_bf16(silu_mul(g0[0], u0[0]), silu_mul(g0[1], u0[1])); w.y = cvt_pk_bf16(silu_mul(g0[2], u0[2]), silu_mul(g0[3], u0[3]));
                w.z = cvt_pk_bf16(silu_mul(g1[0], u1[0]), silu_mul(g1[1], u1[1])); w.w = cvt_pk_bf16(silu_mul(g1[2], u1[2]), silu_mul(g1[3], u1[3]));
                *(u32x4*)(O + (size_t)row * ldc + col0) = w; }
    }
};
struct EpiGateBf16 {
    static constexpr bool PERM = true, AFTER_DRAIN = false;
    bf16_t* Y; const float* gate;
    __device__ __forceinline__ void operator()(const f32x4 (&acc)[2][2][4][2], const Unit& u, int wr, int wc, int fr, int fq) const {
        const int row0 = u.pm * BM + wr * 64 + fr, col0 = (u.pn & 3) * BM + wc * 32 + 8 * fq;
#pragma unroll
        for (int ai = 0; ai < 2; ++ai)
#pragma unroll
            for (int m = 0; m < 4; ++m) { const int row = row0 + ai * HALF + m * 16; const float gt = gate[row]; bf16_t* rowp = Y + (size_t)row * 1024 + col0;
#pragma unroll
                for (int bj = 0; bj < 2; ++bj) { const f32x4 v0 = acc[ai][bj][m][0] * gt, v1 = acc[ai][bj][m][1] * gt;
                    u32x4 w; w.x = cvt_pk_bf16(v0[0], v0[1]); w.y = cvt_pk_bf16(v0[2], v0[3]); w.z = cvt_pk_bf16(v1[0], v1[1]); w.w = cvt_pk_bf16(v1[2], v1[3]);
                    *(u32x4*)(rowp + bj * HALF) = w; } }
    }
};
struct MoeOrder {
    int tb[9]; int npn, G, c;
    __device__ __forceinline__ bool next(int i, Unit& u) const {
        const int L = i * G + c; if (L >= tb[8] * npn) return false;
        const int t = L / npn, j = L - t * npn; int e = 0;
#pragma unroll
        for (int k = 1; k < 8; ++k) e += (t >= tb[k]) ? 1 : 0;
        u.pm = t; u.pn = e * npn + j; return true;
    }
    __device__ __forceinline__ void a_ready(const Unit&) const {}
    __device__ __forceinline__ void done(const Unit&) const {}
};

template <class Epi, class Sched, bool ALIGN_EPI = false, bool SP2 = false>
__device__ __forceinline__ void gemm_phase(PG8_LAS unsigned char* lds, const Gemm g, const Sched& S, const Epi& E) {
    const int tid = threadIdx.x, wid = __builtin_amdgcn_readfirstlane(tid >> 6), lane = tid & 63, wr = wid >> 2, wc = wid & 3, fr = lane & 15, fq = lane >> 4;
    const int K = g.K, nt = K / BK;
    unsigned voffA[2], voffB[2];
#pragma unroll
    for (int i = 0; i < 2; ++i) { int R, C; stage_rc(tid * 16 + i * 8192, R, C); const int Rb = Epi::PERM ? ((R & ~31) + perm32(R & 31)) : R;
        voffA[i] = (unsigned)(R * K + C) * 2u; voffB[i] = (unsigned)(Rb * K + C) * 2u; }
    const size_t kstep = (size_t)(BK * 2);
    const size_t hstep = (size_t)HALF * K * 2;
    const size_t tstep = 2 * hstep;
    const unsigned ldsw = (unsigned)wid * 1024u;
    const int aoff = lds_byte(wr * 64 + fr, fq * 8), boff = lds_byte(wc * 32 + fr, fq * 8);
#define PG8_SA(b, h) (((b) * 2 + (h)) * HTB)
#define PG8_SB(b, h) ((4 + (b) * 2 + (h)) * HTB)
#define PG8_STAGE(bufoff, gbase, voff) do { _Pragma("unroll") for (int _i = 0; _i < 2; ++_i) \
        __builtin_amdgcn_global_load_lds((const unsigned*)((const char*)(gbase) + (voff)[_i]), (PG8_LAS unsigned*)(lds + (bufoff) + ldsw + _i * 8192), 16, 0, 0); } while (0)
#define PG8_LDA(dst, b, h) do { _Pragma("unroll") for (int m = 0; m < 4; ++m) _Pragma("unroll") for (int k = 0; k < 2; ++k) dst[m][k] = *(const PG8_LAS bf16x8*)(lds + PG8_SA(b, h) + aoff + m * 2048 + k * 1024); } while (0)
#define PG8_LDB(dst, b, h) do { _Pragma("unroll") for (int n = 0; n < 2; ++n) _Pragma("unroll") for (int k = 0; k < 2; ++k) dst[n][k] = *(const PG8_LAS bf16x8*)(lds + PG8_SB(b, h) + boff + n * 2048 + k * 1024); } while (0)
#define PG8_MMA(ai, bj, At, Bt) do { __builtin_amdgcn_s_setprio(1); _Pragma("unroll") for (int m = 0; m < 4; ++m) _Pragma("unroll") for (int n = 0; n < 2; ++n) _Pragma("unroll") for (int k = 0; k < 2; ++k) \
        acc[ai][bj][m][n] = __builtin_amdgcn_mfma_f32_16x16x32_bf16(Bt[n][k], At[m][k], acc[ai][bj][m][n], 0, 0, 0); __builtin_amdgcn_s_setprio(0); } while (0)
#define PG8_WAIT_V(n) asm volatile("s_waitcnt vmcnt(" #n ")" ::: "memory")
#define PG8_WAIT_L(n) asm volatile("s_waitcnt lgkmcnt(" #n ")" ::: "memory")
#define PG8_BAR __builtin_amdgcn_s_barrier()
#define PG8_SCHED __builtin_amdgcn_sched_barrier(0)
    Unit cur, nxt; int ui = 0;
    if (!S.next(0, cur)) return;
    f32x4 acc[2][2][4][2];
#pragma unroll
    for (int a = 0; a < 2; ++a)
#pragma unroll
        for (int b = 0; b < 2; ++b)
#pragma unroll
            for (int m = 0; m < 4; ++m)
#pragma unroll
                for (int n = 0; n < 2; ++n) acc[a][b][m][n] = (f32x4){0.f, 0.f, 0.f, 0.f};
    bf16x8 At[4][2], B0[2][2], B1[2][2];
    const char* cA = (const char*)g.A + (size_t)cur.pm * tstep; const char* cB = (const char*)g.Bt + (size_t)cur.pn * tstep;
    S.a_ready(cur);
    if constexpr (SP2) {
        PG8_STAGE(PG8_SB(0, 0), cB, voffB); PG8_STAGE(PG8_SB(0, 1), cB + hstep, voffB); PG8_STAGE(PG8_SA(0, 0), cA, voffA); PG8_STAGE(PG8_SA(0, 1), cA + hstep, voffA);
        if (wr == 1) PG8_BAR;
        PG8_WAIT_V(2); PG8_BAR;
        PG8_STAGE(PG8_SB(1, 0), cB + kstep, voffB); PG8_STAGE(PG8_SA(1, 0), cA + kstep, voffA); PG8_STAGE(PG8_SB(1, 1), cB + hstep + kstep, voffB);
        PG8_WAIT_V(6); PG8_BAR;
    } else {
        PG8_STAGE(PG8_SB(0, 0), cB, voffB); PG8_STAGE(PG8_SA(0, 0), cA, voffA); PG8_STAGE(PG8_SB(0, 1), cB + hstep, voffB); PG8_STAGE(PG8_SA(0, 1), cA + hstep, voffA);
        if (wr == 1) PG8_BAR;
        PG8_WAIT_V(4); PG8_BAR;
        PG8_STAGE(PG8_SB(1, 0), cB + kstep, voffB); PG8_STAGE(PG8_SA(1, 0), cA + kstep, voffA); PG8_STAGE(PG8_SB(1, 1), cB + hstep + kstep, voffB);
        PG8_WAIT_V(6); PG8_BAR;
    }
    for (;;) {
        const bool has_next = S.next(ui + 1, nxt);
        const char* nA = has_next ? (const char*)g.A + (size_t)nxt.pm * tstep : cA; const char* nB = has_next ? (const char*)g.Bt + (size_t)nxt.pn * tstep : cB;
        for (int t = 0; t < nt; t += 2) {
            const bool last = (t == nt - 2);
            const char* a1 = cA + (size_t)(t + 1) * kstep;
            const char* a2 = last ? nA : cA + (size_t)(t + 2) * kstep; const char* b2 = last ? nB : cB + (size_t)(t + 2) * kstep;
            const char* a3 = a2 + kstep; const char* b3 = b2 + kstep;
            if (last && has_next) S.a_ready(nxt);
            if constexpr (SP2) {
            PG8_LDB(B0, 0, 0); PG8_LDB(B1, 0, 1); PG8_SCHED; PG8_LDA(At, 0, 0); PG8_STAGE(PG8_SA(1, 1), a1 + hstep, voffA);
            PG8_WAIT_V(8); PG8_WAIT_L(0); PG8_BAR; PG8_MMA(0, 0, At, B0); PG8_MMA(0, 1, At, B1); PG8_BAR; PG8_SCHED;
            PG8_LDA(At, 0, 1); PG8_STAGE(PG8_SB(0, 0), b2, voffB); PG8_STAGE(PG8_SB(0, 1), b2 + hstep, voffB); PG8_STAGE(PG8_SA(0, 0), a2, voffA);
            PG8_WAIT_V(8); PG8_WAIT_L(0); PG8_BAR; PG8_MMA(1, 0, At, B0); PG8_MMA(1, 1, At, B1); PG8_BAR; PG8_SCHED;
            PG8_LDB(B0, 1, 0); PG8_LDB(B1, 1, 1); PG8_SCHED; PG8_LDA(At, 1, 0); PG8_STAGE(PG8_SA(0, 1), a2 + hstep, voffA);
            PG8_WAIT_V(8); PG8_WAIT_L(0); PG8_BAR; PG8_MMA(0, 0, At, B0); PG8_MMA(0, 1, At, B1); PG8_BAR; PG8_SCHED;
            PG8_LDA(At, 1, 1); PG8_STAGE(PG8_SB(1, 0), b3, voffB); PG8_STAGE(PG8_SB(1, 1), b3 + hstep, voffB); PG8_STAGE(PG8_SA(1, 0), a3, voffA);
            PG8_WAIT_V(8); PG8_WAIT_L(0); PG8_BAR; PG8_MMA(1, 0, At, B0); PG8_MMA(1, 1, At, B1); PG8_BAR; PG8_SCHED;
            } else {
            PG8_LDB(B0, 0, 0); PG8_SCHED; PG8_LDA(At, 0, 0); PG8_STAGE(PG8_SA(1, 1), a1 + hstep, voffA);
            PG8_WAIT_L(8); PG8_BAR; PG8_WAIT_L(0); PG8_MMA(0, 0, At, B0); PG8_BAR; PG8_SCHED;
            PG8_LDB(B1, 0, 1); PG8_STAGE(PG8_SB(0, 0), b2, voffB);
            PG8_BAR; PG8_WAIT_L(0); PG8_MMA(0, 1, At, B1); PG8_BAR;
            PG8_LDA(At, 0, 1); PG8_STAGE(PG8_SA(0, 0), a2, voffA);
            PG8_BAR; PG8_WAIT_L(0); PG8_MMA(1, 0, At, B0); PG8_BAR; PG8_SCHED;
            PG8_STAGE(PG8_SB(0, 1), b2 + hstep, voffB);
            PG8_WAIT_V(6); PG8_BAR; PG8_MMA(1, 1, At, B1); PG8_BAR;
            PG8_LDB(B0, 1, 0); PG8_SCHED; PG8_LDA(At, 1, 0); PG8_STAGE(PG8_SA(0, 1), a2 + hstep, voffA);
            PG8_WAIT_L(8); PG8_BAR; PG8_WAIT_L(0); PG8_MMA(0, 0, At, B0); PG8_BAR; PG8_SCHED;
            PG8_LDB(B1, 1, 1); PG8_STAGE(PG8_SB(1, 0), b3, voffB);
            PG8_BAR; PG8_WAIT_L(0); PG8_MMA(0, 1, At, B1); PG8_BAR;
            PG8_LDA(At, 1, 1); PG8_STAGE(PG8_SA(1, 0), a3, voffA);
            PG8_BAR; PG8_WAIT_L(0); PG8_MMA(1, 0, At, B0); PG8_BAR; PG8_SCHED;
            PG8_STAGE(PG8_SB(1, 1), b3 + hstep, voffB);
            PG8_WAIT_V(6); PG8_BAR; PG8_MMA(1, 1, At, B1); PG8_BAR;
            }
        }
        if constexpr (ALIGN_EPI) { if (wr == 0) PG8_BAR; }
        if constexpr (!Epi::AFTER_DRAIN) { E(acc, cur, wr, wc, fr, fq); S.done(cur); }
        if (!has_next) break;
#pragma unroll
        for (int a = 0; a < 2; ++a)
#pragma unroll
            for (int b = 0; b < 2; ++b)
#pragma unroll
                for (int m = 0; m < 4; ++m)
#pragma unroll
                    for (int n = 0; n < 2; ++n) acc[a][b][m][n] = (f32x4){0.f, 0.f, 0.f, 0.f};
        cur = nxt; cA = nA; cB = nB; ++ui;
        if constexpr (ALIGN_EPI) { if (wr == 1) PG8_BAR; }
    }
    PG8_WAIT_V(0);
    if constexpr (!ALIGN_EPI) { if (wr == 0) PG8_BAR; }
    PG8_BAR;
    if constexpr (Epi::AFTER_DRAIN) { E.fused(acc, cur, wr, wc, fr, fq, lds, wid, lane); S.done(cur); }
#undef PG8_SA
#undef PG8_SB
#undef PG8_STAGE
#undef PG8_LDA
#undef PG8_LDB
#undef PG8_MMA
#undef PG8_WAIT_V
#undef PG8_WAIT_L
#undef PG8_BAR
#undef PG8_SCHED
}
}

constexpr int NWAVES = 8;
constexpr int BATCH = 2, SEQ = 8192, D = 1024, M = BATCH * SEQ;
constexpr int HD = 128, NH = 8, NKV = 2, NIH = 8, IDX = 64, TOPK = 256;
constexpr int A_IN = 2120, FF = 2816, NE = 8;
constexpr int MAXSLOT = 34816;
constexpr float QSCALE = 0.12751743082459868f;
constexpr float SBSCALE = 0.08838834764831845f;
constexpr float WISCALE = 0.04419417382415922f;
constexpr size_t MiB = 1u << 20;
constexpr size_t WS_CTL = 0, CTL_ZERO_BYTES = 1 * MiB;
constexpr size_t WS_WIN = 2 * MiB, WS_WTAIL = 6 * MiB, WS_WOA = 7 * MiB, WS_WGU = 9 * MiB, WS_WD = 20 * MiB, WS_WKVQ = 26 * MiB, WS_WOB = 32 * MiB, WS_WGUM = 34 * MiB, WS_WDM = 122 * MiB;
constexpr size_t WS_H = 166 * MiB, WS_XB = 230 * MiB, WS_SS0 = 262 * MiB, WS_SS1 = 263 * MiB, WS_SS2 = 264 * MiB, WS_SS3 = 265 * MiB;
constexpr size_t WS_T = 266 * MiB;
constexpr size_t WS_PROJ = WS_T, WS_QF = 330 * MiB, WS_KVF = 362 * MiB, WS_QIF = 378 * MiB, WS_KIF = 394 * MiB, WS_WIF = 396 * MiB, WS_SEL = 397 * MiB, WS_AO = 413 * MiB;
constexpr size_t WS_HF = WS_T, WS_KVQ = WS_T;
constexpr size_t WS_XPERM = WS_T, WS_HM = 334 * MiB, WS_Y = 521 * MiB;
constexpr size_t WS_RT = 590 * MiB;
constexpr size_t WS_RSTDS = 591 * MiB, WS_GATES = 591 * MiB + 512 * 1024, WS_END = 592 * MiB;
constexpr int CW_CNT = 64;
constexpr int CW_BAR = 4096;
constexpr int RING_BYTES = 131072, LDSCTL_OFF = RING_BYTES, MISC_OFF = LDSCTL_OFF + 320, LDS_BYTES = 147456;

#define GAS __attribute__((address_space(1)))
#define LAS __attribute__((address_space(3)))
typedef unsigned short bf16;
typedef unsigned v4u __attribute__((ext_vector_type(4)));
typedef unsigned v2u __attribute__((ext_vector_type(2)));
typedef float f32x4 __attribute__((ext_vector_type(4)));
typedef short bf16x8 __attribute__((ext_vector_type(8)));
typedef GAS unsigned gu32;
#define RLX_AGENT __ATOMIC_RELAXED, __HIP_MEMORY_SCOPE_AGENT
#define LDS_WAIT() asm volatile("s_waitcnt lgkmcnt(0)" ::: "memory")
#define VM_WAIT() asm volatile("s_waitcnt vmcnt(0)" ::: "memory")
__device__ __forceinline__ unsigned f2bf(float f) { unsigned u = __builtin_bit_cast(unsigned, f); return (u + 0x7fffu + ((u >> 16) & 1u)) >> 16; }
__device__ __forceinline__ unsigned pk2(float lo, float hi) { return f2bf(lo) | (f2bf(hi) << 16); }
__device__ __forceinline__ float bflo(unsigned w) { return __uint_as_float(w << 16); }
__device__ __forceinline__ float bfhi(unsigned w) { return __uint_as_float(w & 0xffff0000u); }
__device__ __forceinline__ float wave_sum(float v) {
#pragma unroll
    for (int o = 1; o < 64; o <<= 1) v += __shfl_xor(v, o);
    return v;
}
__device__ __forceinline__ float wave_max(float v) {
#pragma unroll
    for (int o = 1; o < 64; o <<= 1) v = fmaxf(v, __shfl_xor(v, o));
    return v;
}
__device__ __forceinline__ void sincos_acc(float a, float& c, float& s) {
    const double x = (double)a; const double n = __builtin_rint(x * 0.63661977236758134308);
    const double r = __builtin_fma(-n, 6.123233995736766035869e-17, __builtin_fma(-n, 1.57079632679489655800, x)); const double r2 = r * r;
    double sn = 1.0 - r2 * (1.0 / 156.0); sn = 1.0 - r2 * (1.0 / 110.0) * sn; sn = 1.0 - r2 * (1.0 / 72.0) * sn; sn = 1.0 - r2 * (1.0 / 42.0) * sn; sn = 1.0 - r2 * (1.0 / 20.0) * sn; sn = 1.0 - r2 * (1.0 / 6.0) * sn; sn *= r;
    double cs = 1.0 - r2 * (1.0 / 182.0); cs = 1.0 - r2 * (1.0 / 132.0) * cs; cs = 1.0 - r2 * (1.0 / 90.0) * cs; cs = 1.0 - r2 * (1.0 / 56.0) * cs; cs = 1.0 - r2 * (1.0 / 30.0) * cs; cs = 1.0 - r2 * (1.0 / 12.0) * cs; cs = 1.0 - r2 * 0.5 * cs;
    const int q = ((int)n) & 3;
    const double cq = (q == 0) ? cs : (q == 1) ? -sn : (q == 2) ? -cs : sn;
    const double sq = (q == 0) ? sn : (q == 1) ? cs : (q == 2) ? -sn : -cs;
    c = (float)cq; s = (float)sq;
}
__device__ const float INV_Q[16] = {1.000000000e+00f, 4.403665960e-01f, 1.939227432e-01f, 8.539710194e-02f, 3.760603070e-02f, 1.656043902e-02f, 7.292664610e-03f, 3.211445874e-03f,
                                    1.414213562e-03f, 6.227723788e-04f, 2.742481884e-04f, 1.207697351e-04f, 5.318296098e-05f, 2.341999971e-05f, 1.031338616e-05f, 4.541670478e-06f};
__device__ const float INV_I[8] = {1.000000000e+00f, 1.939227432e-01f, 3.760603070e-02f, 7.292664610e-03f, 1.414213562e-03f, 2.742481884e-04f, 5.318296098e-05f, 1.031338616e-05f};

#define XB_TMO      128
#define XB_XCNT(j)  (256  + 64 * (j))
#define XB_XSUB(j)  (1280 + 64 * (j))
#define XB_XGEN(j)  (2304 + 64 * (j))
#define XB_TOP      3328
#define XB_TOPGEN   3392
#define XCD_BAR_WORDS 3456
#define XB_SPIN_CAP (1u << 18)

__device__ __forceinline__ unsigned xb_ld(unsigned* p)              { return __hip_atomic_load(p, __ATOMIC_RELAXED, __HIP_MEMORY_SCOPE_AGENT); }
__device__ __forceinline__ unsigned xb_add(unsigned* p, unsigned v) { return __hip_atomic_fetch_add(p, v, __ATOMIC_RELAXED, __HIP_MEMORY_SCOPE_AGENT); }
__device__ __forceinline__ unsigned xb_xcc_id() { return (unsigned)__builtin_amdgcn_s_getreg((3 << 11) | 20) & 0xFu; }
#define XB_SPIN(cond, bar) do { unsigned _sp = 0; while (cond) { __builtin_amdgcn_s_sleep(1); \
    if ((++_sp & 255u) == 0u) { if (xb_ld(&(bar)[XB_TMO])) break; if (_sp > XB_SPIN_CAP) { atomicAdd(&(bar)[XB_TMO], 1u); break; } } } } while (0)

struct XcdBarrier {
    unsigned* bar; unsigned x;
    volatile LAS unsigned* st;
};

__device__ __forceinline__ XcdBarrier xcd_barrier_post(unsigned* bar, volatile LAS unsigned* st) {
    XcdBarrier b; b.bar = bar; b.x = xb_xcc_id(); b.st = st;
    if (threadIdx.x == 0) (void)xb_add(&bar[XB_XCNT(b.x)], 1u);
    return b;
}
__device__ __forceinline__ void xcd_barrier_complete(unsigned* bar, unsigned x, unsigned& nloc, unsigned& nx) {
    const unsigned G = gridDim.x * gridDim.y * gridDim.z;
    unsigned sum, cnt, mine, sp = 0u;
    for (;;) {
        sum = 0u; cnt = 0u; mine = 0u;
#pragma unroll
        for (unsigned j = 0; j < 16; ++j) { const unsigned c = xb_ld(&bar[XB_XCNT(j)]); sum += c; cnt += (c > 0u) ? 1u : 0u; mine = (j == x) ? c : mine; }
        if (sum == G) break;
        __builtin_amdgcn_s_sleep(1);
        if ((++sp & 255u) == 0u) { if (xb_ld(&bar[XB_TMO])) break; if (sp > XB_SPIN_CAP) { atomicAdd(&bar[XB_TMO], 1u); break; } }
    }
    nloc = mine > 0u ? mine : 1u; nx = cnt > 0u ? cnt : 1u;
}

__device__ __forceinline__ void xcd_barrier(const XcdBarrier& b) {
    asm volatile("s_waitcnt vmcnt(0)" ::: "memory");
    __syncthreads();
    if (threadIdx.x == 0) {
        unsigned* bar = b.bar;
        __builtin_amdgcn_s_waitcnt(0);
        unsigned nloc = b.st[0], nx = b.st[1];
        if (nloc == 0u) { xcd_barrier_complete(bar, b.x, nloc, nx); b.st[0] = nloc; b.st[1] = nx; }
        const unsigned old = xb_add(&bar[XB_XSUB(b.x)], 1u);
        const unsigned gen = old / nloc;
        if (old + 1u == (gen + 1u) * nloc) {
            __builtin_amdgcn_fence(__ATOMIC_RELEASE, "agent");
            asm volatile("s_waitcnt vmcnt(0)" ::: "memory");
            const unsigned og = xb_add(&bar[XB_TOP], 1u);
            const unsigned tg = og / nx;
            if (og + 1u == (tg + 1u) * nx) xb_add(&bar[XB_TOPGEN], 1u);
            else XB_SPIN(xb_ld(&bar[XB_TOPGEN]) == tg, bar);
            __builtin_amdgcn_fence(__ATOMIC_ACQUIRE, "agent");
            xb_add(&bar[XB_XGEN(b.x)], 1u);
            asm volatile("s_waitcnt vmcnt(0)" ::: "memory");
        } else {
            XB_SPIN(xb_ld(&bar[XB_XGEN(b.x)]) == gen, bar);
            __builtin_amdgcn_fence(__ATOMIC_ACQUIRE, "agent");
            asm volatile("s_waitcnt vmcnt(0)" ::: "memory");
        }
    }
    __syncthreads();
}

struct Frame {
    LAS unsigned char* lds;
    volatile LAS unsigned* MISC;
    gu32* ctl;
    int tid, lane, wave, G, bid;
    const float* in[17];
    float* out; unsigned char* ws;
};
enum { IN_X = 0, IN_ANORM, IN_AWIN, IN_AQN, IN_AKN, IN_AWOUT, IN_KVNORM, IN_KVW, IN_BNORM, IN_BWQ, IN_BWOUT, IN_FFNNORM, IN_DGU, IN_DDN, IN_ROUTER, IN_MGU, IN_MDN };

__device__ __forceinline__ void tr_item(const float* W, size_t ldw, int K, int k0, int csrc0, int cend, bf16* WT, int drow0, const float* gain, float scale, LAS float* scr, int lane) {
#pragma unroll 8
    for (int i = 0; i < 32; ++i) { const int kk = 2 * i + (lane >> 5); const int c = csrc0 + (lane & 31);
        const float v = (c < cend) ? W[(size_t)(k0 + kk) * ldw + c] : 0.f; const float g = gain ? gain[k0 + kk] * scale : scale; scr[kk * 33 + (lane & 31)] = v * g; }
    LDS_WAIT(); asm volatile("" ::: "memory");
    const int c8 = lane & 7;
#pragma unroll
    for (int j = 0; j < 4; ++j) { const int n = (lane >> 3) + 8 * j; const LAS float* s = scr + (8 * c8) * 33 + n;
        v4u o; o.x = pk2(s[0 * 33], s[1 * 33]); o.y = pk2(s[2 * 33], s[3 * 33]); o.z = pk2(s[4 * 33], s[5 * 33]); o.w = pk2(s[6 * 33], s[7 * 33]);
        *(GAS v4u*)(WT + (size_t)(drow0 + n) * K + k0 + 8 * c8) = o; }
    LDS_WAIT(); asm volatile("" ::: "memory");
}
__device__ __forceinline__ int gu_row(int c0) { return (c0 < FF) ? ((c0 >> 7) * 256 + (c0 & 127)) : (((c0 - FF) >> 7) * 256 + 128 + ((c0 - FF) & 127)); }
__device__ __forceinline__ void p0_prologue(Frame& F) {
    LAS float* scr = (LAS float*)(F.lds + F.wave * 16384);
    const int gw = F.wave * F.G + F.bid, NGW = F.G * NWAVES;
    unsigned char* ws = F.ws;
    constexpr int I_WIN = 16 * 64, I_TAIL = 16 * 3, I_SQ = 16 * 32, I_GU = 16 * 176, I_DN = 44 * 32, I_KV = 16 * 64;
    constexpr int NITEMS = I_WIN + I_TAIL + I_SQ + I_GU + I_DN + I_KV + I_SQ + I_SQ + NE * I_GU + NE * I_DN;
    for (int it = gw; it < NITEMS; it += NGW) {
        int r = it;
        if (r < I_WIN) { const int kb = r / 64, nb = r % 64; tr_item(F.in[IN_AWIN], A_IN, D, 64 * kb, 32 * nb, A_IN, (bf16*)(ws + WS_WIN), 32 * nb, F.in[IN_ANORM], 1.f, scr, F.lane); continue; } r -= I_WIN;
        if (r < I_TAIL) { const int kb = r / 3, nb = r % 3; tr_item(F.in[IN_AWIN], A_IN, D, 64 * kb, 2048 + 32 * nb, A_IN, (bf16*)(ws + WS_WTAIL), 32 * nb, F.in[IN_ANORM], 1.f, scr, F.lane); continue; } r -= I_TAIL;
        if (r < I_SQ) { const int kb = r / 32, nb = r % 32; tr_item(F.in[IN_AWOUT], D, D, 64 * kb, 32 * nb, D, (bf16*)(ws + WS_WOA), 32 * nb, nullptr, 1.f, scr, F.lane); continue; } r -= I_SQ;
        if (r < I_GU) { const int kb = r / 176, nb = r % 176; tr_item(F.in[IN_DGU], 2 * FF, D, 64 * kb, 32 * nb, 2 * FF, (bf16*)(ws + WS_WGU), gu_row(32 * nb), F.in[IN_FFNNORM], 1.f, scr, F.lane); continue; } r -= I_GU;
        if (r < I_DN) { const int kb = r / 32, nb = r % 32; tr_item(F.in[IN_DDN], D, FF, 64 * kb, 32 * nb, D, (bf16*)(ws + WS_WD), 32 * nb, nullptr, 1.f, scr, F.lane); continue; } r -= I_DN;
        if (r < I_KV) { const int kb = r / 64, nb = r % 64; tr_item(F.in[IN_KVW], 2 * D, D, 64 * kb, 32 * nb, 2 * D, (bf16*)(ws + WS_WKVQ), 32 * nb, F.in[IN_KVNORM], 1.f, scr, F.lane); continue; } r -= I_KV;
        if (r < I_SQ) { const int kb = r / 32, nb = r % 32; tr_item(F.in[IN_BWQ], D, D, 64 * kb, 32 * nb, D, (bf16*)(ws + WS_WKVQ), 2048 + 32 * nb, F.in[IN_BNORM], SBSCALE, scr, F.lane); continue; } r -= I_SQ;
        if (r < I_SQ) { const int kb = r / 32, nb = r % 32; tr_item(F.in[IN_BWOUT], D, D, 64 * kb, 32 * nb, D, (bf16*)(ws + WS_WOB), 32 * nb, nullptr, 1.f, scr, F.lane); continue; } r -= I_SQ;
        if (r < NE * I_GU) { const int e = r / I_GU, rr = r % I_GU, kb = rr / 176, nb = rr % 176;
            tr_item(F.in[IN_MGU] + (size_t)e * D * 2 * FF, 2 * FF, D, 64 * kb, 32 * nb, 2 * FF, (bf16*)(ws + WS_WGUM), e * 2 * FF + gu_row(32 * nb), F.in[IN_FFNNORM] + D, 1.f, scr, F.lane); continue; } r -= NE * I_GU;
        { const int e = r / I_DN, rr = r % I_DN, kb = rr / 32, nb = rr % 32;
            tr_item(F.in[IN_MDN] + (size_t)e * FF * D, D, FF, 64 * kb, 32 * nb, D, (bf16*)(ws + WS_WDM), e * D + 32 * nb, nullptr, 1.f, scr, F.lane); }
    }
    const float* x = F.in[IN_X]; bf16* XB = (bf16*)(ws + WS_XB); float* SS0 = (float*)(ws + WS_SS0);
    for (int m = gw; m < M; m += NGW) {
        const GAS f32x4* xr = (const GAS f32x4*)(x + (size_t)m * D) + F.lane; f32x4 v[4]; float s = 0.f;
#pragma unroll
        for (int j = 0; j < 4; ++j) { v[j] = xr[64 * j]; s += (v[j].x * v[j].x + v[j].y * v[j].y) + (v[j].z * v[j].z + v[j].w * v[j].w); }
        s = wave_sum(s);
        GAS unsigned long long* o8 = (GAS unsigned long long*)(XB + (size_t)m * D) + F.lane;
#pragma unroll
        for (int j = 0; j < 4; ++j) o8[64 * j] = (unsigned long long)pk2(v[j].x, v[j].y) | ((unsigned long long)pk2(v[j].z, v[j].w) << 32);
        if (F.lane < 16) SS0[(size_t)m * 16 + F.lane] = (F.lane == 0) ? s : 0.f;
    }
}

__device__ __forceinline__ void rope8(float (&y)[8], bool isx1, bool isx2, int i0, int pshift, float pos, const float* inv) {
#pragma unroll
    for (int e = 0; e < 8; ++e) {
        const float other = __shfl_xor(y[e], pshift);
        if (isx1 || isx2) { float c, s; sincos_acc(pos * inv[i0 + e], c, s); y[e] = isx1 ? (y[e] * c - other * s) : (y[e] * c + other * s); }
    }
}
__device__ __forceinline__ void unpack8(const v4u w, float (&y)[8]) { y[0] = bflo(w.x); y[1] = bfhi(w.x); y[2] = bflo(w.y); y[3] = bfhi(w.y); y[4] = bflo(w.z); y[5] = bfhi(w.z); y[6] = bflo(w.w); y[7] = bfhi(w.w); }
__device__ __forceinline__ v4u pack8(const float (&y)[8]) { v4u o; o.x = pk2(y[0], y[1]); o.y = pk2(y[2], y[3]); o.z = pk2(y[4], y[5]); o.w = pk2(y[6], y[7]); return o; }
__device__ __forceinline__ void p2_post(Frame& F) {
    unsigned char* ws = F.ws; const int lane = F.lane;
    const bf16* PROJ = (const bf16*)(ws + WS_PROJ); const bf16* XB = (const bf16*)(ws + WS_XB); const bf16* WT = (const bf16*)(ws + WS_WTAIL); const float* SS0 = (const float*)(ws + WS_SS0);
    bf16* QF = (bf16*)(ws + WS_QF); bf16* KVF = (bf16*)(ws + WS_KVF); bf16* QIF = (bf16*)(ws + WS_QIF); bf16* KIF = (bf16*)(ws + WS_KIF); float* WIF = (float*)(ws + WS_WIF);
    const float* qnw = F.in[IN_AQN]; const float* knw = F.in[IN_AKN];
    const int gw = F.wave * F.G + F.bid, NGW = F.G * NWAVES;
    for (int task = gw; task < M / 16; task += NGW) {
        const int row0 = task * 16;
        f32x4 acc[5];
#pragma unroll
        for (int c = 0; c < 5; ++c) acc[c] = (f32x4){0.f, 0.f, 0.f, 0.f};
        const bf16* ap = XB + (size_t)(row0 + (lane & 15)) * D + 8 * (lane >> 4);
        const bf16* bp = WT + (size_t)(lane & 15) * D + 8 * (lane >> 4);
#pragma unroll 4
        for (int j = 0; j < 32; ++j) {
            const bf16x8 a = *(const bf16x8*)(ap + 32 * j);
#pragma unroll
            for (int c = 0; c < 5; ++c) { const bf16x8 b = *(const bf16x8*)(bp + (size_t)(16 * c) * D + 32 * j); acc[c] = __builtin_amdgcn_mfma_f32_16x16x32_bf16(a, b, acc[c], 0, 0, 0); }
        }
#pragma unroll
        for (int reg = 0; reg < 4; ++reg) {
            const int row = row0 + 4 * (lane >> 4) + reg; const float rs = pg8::rstd16(SS0 + (size_t)row * 16); const float pos = (float)(row & (SEQ - 1));
            const int d = lane & 15;
            float v0 = acc[0][reg] * rs; const float other = __shfl_xor(v0, 8);
            { float c, s; sincos_acc(pos * INV_I[d & 7], c, s); v0 = (d < 8) ? (v0 * c - other * s) : (v0 * c + other * s); }
            KIF[(size_t)row * IDX + d] = (bf16)f2bf(v0);
#pragma unroll
            for (int c = 1; c < 4; ++c) KIF[(size_t)row * IDX + 16 * c + d] = (bf16)f2bf(acc[c][reg] * rs);
            if (d < 8) WIF[(size_t)row * 8 + d] = acc[4][reg] * rs * WISCALE;
        }
        for (int r = 0; r < 16; ++r) {
            const int row = row0 + r, b = row >> 13, t = row & (SEQ - 1); const float pos = (float)t;
            const bf16* pr = PROJ + (size_t)row * 2048 + 8 * lane;
            v4u w[4];
#pragma unroll
            for (int j = 0; j < 4; ++j) w[j] = *(const v4u*)(pr + 512 * j);
#pragma unroll
            for (int j = 0; j < 2; ++j) {
                float y[8]; unpack8(w[j], y); float ss = 0.f;
#pragma unroll
                for (int e = 0; e < 8; ++e) ss += y[e] * y[e];
                ss += __shfl_xor(ss, 1); ss += __shfl_xor(ss, 2); ss += __shfl_xor(ss, 4); ss += __shfl_xor(ss, 8);
                const float rs = 1.0f / sqrtf(ss * (1.0f / 128.0f) + 1e-6f); const int c8 = (lane & 15) * 8;
#pragma unroll
                for (int e = 0; e < 8; ++e) y[e] = y[e] * rs * qnw[c8 + e];
                rope8(y, c8 < 16, c8 >= 16 && c8 < 32, c8 & 15, 2, pos, INV_Q);
#pragma unroll
                for (int e = 0; e < 8; ++e) y[e] *= QSCALE;
                *(v4u*)(QF + (size_t)row * D + 512 * j + 8 * lane) = pack8(y);
            }
            {
                float y[8]; unpack8(w[2], y); float ss = 0.f;
#pragma unroll
                for (int e = 0; e < 8; ++e) ss += y[e] * y[e];
                ss += __shfl_xor(ss, 1); ss += __shfl_xor(ss, 2); ss += __shfl_xor(ss, 4); ss += __shfl_xor(ss, 8);
                const bool isk = lane < 32; const float rs = 1.0f / sqrtf(ss * (1.0f / 128.0f) + 1e-6f); const int c8 = (lane & 15) * 8;
                if (isk) {
#pragma unroll
                    for (int e = 0; e < 8; ++e) y[e] = y[e] * rs * knw[c8 + e];
                }
                rope8(y, isk && c8 < 16, isk && c8 >= 16 && c8 < 32, c8 & 15, 2, pos, INV_Q);
                const int kvh = (lane >> 4) & 1;
                *(v4u*)(KVF + ((size_t)(b * NKV + kvh) * SEQ + t) * 256 + (isk ? 0 : 128) + c8) = pack8(y);
            }
            {
                float y[8]; unpack8(w[3], y); const int c8 = (lane & 7) * 8;
                rope8(y, c8 == 0, c8 == 8, 0, 1, pos, INV_I);
                *(v4u*)(QIF + (size_t)row * 512 + 8 * lane) = pack8(y);
            }
        }
    }
}

__device__ __forceinline__ unsigned f2key(float f) { const unsigned u = __float_as_uint(f); return (u & 0x80000000u) ? ~u : (u | 0x80000000u); }
__device__ __forceinline__ void p3_index_naive(Frame& F) {
    unsigned char* ws = F.ws; const int tid = F.tid, lane = F.lane, wave = F.wave;
    const bf16* QIF = (const bf16*)(ws + WS_QIF); const bf16* KIF = (const bf16*)(ws + WS_KIF); const float* WIF = (const float*)(ws + WS_WIF); int* SEL = (int*)(ws + WS_SEL);
    LAS unsigned* keys = (LAS unsigned*)F.lds;
    LAS float* qis = (LAS float*)(F.lds + 32768);
    LAS float* wl = (LAS float*)(F.lds + 32768 + 2048);
    LAS unsigned* hist = (LAS unsigned*)(F.lds + 36864);
    LAS unsigned* ctl = (LAS unsigned*)(F.lds + 36864 + 1024);
    LAS unsigned* wcnt = (LAS unsigned*)(F.lds + 36864 + 1024 + 64);
    for (int qi = F.bid; qi < M; qi += F.G) {
        const int row = qi, b = row >> 13, t = row & (SEQ - 1), n = t + 1;
        int* sel = SEL + (size_t)row * TOPK;
        if (n <= TOPK) { if (tid < TOPK) sel[tid] = tid < n ? tid : 0; continue; }
        qis[tid] = __uint_as_float((unsigned)QIF[(size_t)row * 512 + tid] << 16);
        if (tid < 8) wl[tid] = WIF[(size_t)row * 8 + tid];
        __syncthreads();
        for (int s = tid; s < n; s += 512) {
            const v4u* kp = (const v4u*)(KIF + ((size_t)(b << 13) + s) * IDX);
            float kf[64];
#pragma unroll
            for (int j = 0; j < 8; ++j) { const v4u w = kp[j]; kf[8 * j] = bflo(w.x); kf[8 * j + 1] = bfhi(w.x); kf[8 * j + 2] = bflo(w.y); kf[8 * j + 3] = bfhi(w.y); kf[8 * j + 4] = bflo(w.z); kf[8 * j + 5] = bfhi(w.z); kf[8 * j + 6] = bflo(w.w); kf[8 * j + 7] = bfhi(w.w); }
            float sc = 0.f;
#pragma unroll
            for (int h = 0; h < 8; ++h) { float d = 0.f; asm volatile("" ::: "memory");
#pragma unroll
                for (int dd = 0; dd < 64; ++dd) d += qis[h * 64 + dd] * kf[dd];
                sc += wl[h] * fmaxf(d, 0.f); }
            keys[s] = f2key(sc + 0.0f);
        }
        __syncthreads();
        unsigned prefix = 0u, mask = 0u, need = TOPK;
        for (int pass = 0; pass < 4; ++pass) {
            const int shift = 24 - 8 * pass;
            if (tid < 256) hist[tid] = 0u;
            __syncthreads();
            for (int s = tid; s < n; s += 512) { const unsigned k = keys[s]; if ((k & mask) == prefix) __hip_atomic_fetch_add(&hist[(k >> shift) & 255u], 1u, __ATOMIC_RELAXED, __HIP_MEMORY_SCOPE_WORKGROUP); }
            __syncthreads();
            if (tid < 64) {
                const unsigned h0 = hist[4 * lane], h1 = hist[4 * lane + 1], h2 = hist[4 * lane + 2], h3 = hist[4 * lane + 3]; const unsigned tot = h0 + h1 + h2 + h3;
                unsigned incl = tot;
#pragma unroll
                for (int o = 1; o < 64; o <<= 1) { const unsigned v = __shfl_down(incl, o); if (lane + o < 64) incl += v; }
                const unsigned above = incl - tot;
                if (above < need && need <= above + tot) {
                    unsigned a = above; unsigned bin;
                    if (a + h3 >= need) bin = 3; else { a += h3; if (a + h2 >= need) bin = 2; else { a += h2; if (a + h1 >= need) bin = 1; else { a += h1; bin = 0; } } }
                    ctl[0] = 4 * lane + bin; ctl[1] = need - a;
                }
            }
            __syncthreads();
            prefix |= ctl[0] << shift; mask |= 255u << shift; need = ctl[1];
            __syncthreads();
        }
        const unsigned thr = prefix, n_gt = TOPK - need;
        unsigned base_gt = 0u, base_eq = 0u;
        for (int s0 = 0; s0 < n; s0 += 512) {
            const int s = s0 + tid; const unsigned k = s < n ? keys[s] : 0u; const bool gt = (s < n) && (k > thr); const bool eq = (s < n) && (k == thr);
            const unsigned long long bg = __ballot(gt), be = __ballot(eq); const unsigned long long lt = (1ull << lane) - 1ull;
            const unsigned rg = __popcll(bg & lt), re = __popcll(be & lt);
            if (lane == 0) { wcnt[wave] = __popcll(bg); wcnt[8 + wave] = __popcll(be); }
            __syncthreads();
            unsigned og = base_gt, oe = base_eq, tg = 0u, te = 0u;
#pragma unroll
            for (int w = 0; w < 8; ++w) { const unsigned cg = wcnt[w], ce = wcnt[8 + w]; if (w < wave) { og += cg; oe += ce; } tg += cg; te += ce; }
            if (gt) sel[og + rg] = s;
            if (eq && oe + re < need) sel[n_gt + oe + re] = s;
            base_gt += tg; base_eq += te;
            __syncthreads();
        }
    }
}

__device__ __forceinline__ void p4_dsa_naive(Frame& F) {
    unsigned char* ws = F.ws; const int lane = F.lane;
    const bf16* QF = (const bf16*)(ws + WS_QF); const bf16* KVF = (const bf16*)(ws + WS_KVF); const int* SEL = (const int*)(ws + WS_SEL); bf16* AO = (bf16*)(ws + WS_AO);
    LAS f32x4* sc = (LAS f32x4*)(F.lds + F.wave * 4096);
    const int gw = F.wave * F.G + F.bid, NGW = F.G * NWAVES;
    for (int p = gw; p < 2 * M; p += NGW) {
        const int row = p >> 1, kvh = p & 1, b = row >> 13, t = row & (SEQ - 1); const int cnt = (t + 1 < TOPK) ? (t + 1) : TOPK;
        const int* sel = SEL + (size_t)row * TOPK;
        int myidx[4];
#pragma unroll
        for (int j = 0; j < 4; ++j) myidx[j] = sel[lane + 64 * j];
        float qa[4], qb[4];
#pragma unroll
        for (int g = 0; g < 4; ++g) { const unsigned w = *(const unsigned*)(QF + (size_t)row * D + (kvh * 4 + g) * HD + 2 * lane); qa[g] = bflo(w); qb[g] = bfhi(w); }
        const bf16* kvb = KVF + (size_t)(b * NKV + kvh) * SEQ * 256 + 2 * lane;
#pragma unroll
        for (int j = 0; j < 4; ++j) {
            const int lim = cnt - 64 * j < 64 ? cnt - 64 * j : 64;
            for (int i = 0; i < lim; ++i) {
                const int key = __builtin_amdgcn_readlane(myidx[j], i);
                const unsigned w = *(const unsigned*)(kvb + (size_t)key * 256); const float k0 = bflo(w), k1 = bfhi(w);
                f32x4 d;
                d[0] = wave_sum(qa[0] * k0 + qb[0] * k1); d[1] = wave_sum(qa[1] * k0 + qb[1] * k1); d[2] = wave_sum(qa[2] * k0 + qb[2] * k1); d[3] = wave_sum(qa[3] * k0 + qb[3] * k1);
                if (lane == 0) sc[64 * j + i] = d;
            }
        }
        float mx[4] = {-INFINITY, -INFINITY, -INFINITY, -INFINITY};
#pragma unroll
        for (int j = 0; j < 4; ++j) { const int pp = lane + 64 * j; if (pp < cnt) { const f32x4 v = sc[pp];
#pragma unroll
            for (int g = 0; g < 4; ++g) mx[g] = fmaxf(mx[g], v[g]); } }
#pragma unroll
        for (int g = 0; g < 4; ++g) mx[g] = wave_max(mx[g]);
        float sm[4] = {0.f, 0.f, 0.f, 0.f};
#pragma unroll
        for (int j = 0; j < 4; ++j) { const int pp = lane + 64 * j; if (pp < cnt) { f32x4 v = sc[pp];
#pragma unroll
            for (int g = 0; g < 4; ++g) { v[g] = __builtin_amdgcn_exp2f(v[g] - mx[g]); sm[g] += v[g]; }
            sc[pp] = v; } }
#pragma unroll
        for (int g = 0; g < 4; ++g) sm[g] = 1.0f / wave_sum(sm[g]);
        float oa[4] = {0.f, 0.f, 0.f, 0.f}, ob[4] = {0.f, 0.f, 0.f, 0.f};
#pragma unroll
        for (int j = 0; j < 4; ++j) {
            const int lim = cnt - 64 * j < 64 ? cnt - 64 * j : 64;
            for (int i = 0; i < lim; ++i) {
                const int key = __builtin_amdgcn_readlane(myidx[j], i);
                const unsigned w = *(const unsigned*)(kvb + (size_t)key * 256 + 128); const float v0 = bflo(w), v1 = bfhi(w);
                const f32x4 pr = sc[64 * j + i];
#pragma unroll
                for (int g = 0; g < 4; ++g) { oa[g] += pr[g] * v0; ob[g] += pr[g] * v1; }
            }
        }
#pragma unroll
        for (int g = 0; g < 4; ++g) *(unsigned*)(AO + (size_t)row * D + (kvh * 4 + g) * HD + 2 * lane) = pk2(oa[g] * sm[g], ob[g] * sm[g]);
    }
}

#ifndef SB_EXIT
#define SB_EXIT 0
#endif
__device__ __forceinline__ void p9_sb_naive(Frame& F) {
    unsigned char* ws = F.ws; const int lane = F.lane;
    const bf16* KVQ = (const bf16*)(ws + WS_KVQ); bf16* AO = (bf16*)(ws + WS_AO);
    const int gw = F.wave * F.G + F.bid, NGW = F.G * NWAVES;
    for (int p = gw; p < NH * M; p += NGW) {
        const int row = p >> 3, h = p & 7, b = row >> 13, t = row & (SEQ - 1);
        const unsigned qw = *(const unsigned*)(KVQ + (size_t)row * 3072 + 2048 + h * HD + 2 * lane); const float qa = bflo(qw), qb = bfhi(qw);
        const bf16* kb = KVQ + (size_t)(b << 13) * 3072 + h * HD + 2 * lane;
        float C = 0.f, oa = 0.f, ob = 0.f;
#pragma unroll 4
        for (int s = t - 1; s >= 0; --s) {
            const unsigned kw = *(const unsigned*)(kb + (size_t)s * 3072); const unsigned vw = *(const unsigned*)(kb + (size_t)s * 3072 + 1024);
            const float z = wave_sum(qa * bflo(kw) + qb * bfhi(kw));
            const float sp = fmaxf(z, 0.f) + __logf(1.0f + __expf(-fabsf(z)));
            const float a = __expf((z - sp) + C);
            oa += a * bflo(vw); ob += a * bfhi(vw);
            C -= sp;
#if SB_EXIT
            if (C < -44.0f) break;
#endif
        }
        *(unsigned*)(AO + (size_t)row * D + h * HD + 2 * lane) = pk2(oa, ob);
    }
}

__device__ __forceinline__ void p11_router(Frame& F) {
    unsigned char* ws = F.ws; const int tid = F.tid, lane = F.lane, wave = F.wave;
    const float* H = (const float*)(ws + WS_H); const float* gn = F.in[IN_FFNNORM] + D; const float* Wr = F.in[IN_ROUTER];
    int* TOPE = (int*)(ws + WS_RT); int* POS = (int*)(ws + WS_RT + 128 * 1024); float* GATE = (float*)(ws + WS_RT + 256 * 1024); float* RSTD3 = (float*)(ws + WS_RT + 384 * 1024);
    LAS unsigned* lcnt = (LAS unsigned*)F.lds;
    LAS unsigned* gb = (LAS unsigned*)(F.lds + 64);
    LAS int* ltok = (LAS int*)(F.lds + 128);
    LAS float* lgt = (LAS float*)(F.lds + 128 + 1024);
    for (int chunk = F.bid; chunk < M / 64; chunk += F.G) {
        if (tid < 8) lcnt[tid] = 0u;
        __syncthreads();
        for (int r = 0; r < 8; ++r) {
            const int row = chunk * 64 + wave * 8 + r;
            const GAS f32x4* xr = (const GAS f32x4*)(H + (size_t)row * D) + lane; f32x4 v[4]; float ss = 0.f;
#pragma unroll
            for (int j = 0; j < 4; ++j) { v[j] = xr[64 * j]; ss += (v[j].x * v[j].x + v[j].y * v[j].y) + (v[j].z * v[j].z + v[j].w * v[j].w); }
            ss = wave_sum(ss); const float rs = 1.0f / sqrtf(ss * (1.0f / 1024.0f) + 1e-6f);
            float lg[8] = {0.f, 0.f, 0.f, 0.f, 0.f, 0.f, 0.f, 0.f};
#pragma unroll
            for (int j = 0; j < 4; ++j)
#pragma unroll
                for (int i = 0; i < 4; ++i) { const int k = 256 * j + 4 * lane + i; const float xv = v[j][i] * gn[k]; const f32x4 w0 = *(const f32x4*)(Wr + (size_t)k * 8), w1 = *(const f32x4*)(Wr + (size_t)k * 8 + 4);
                    lg[0] += xv * w0[0]; lg[1] += xv * w0[1]; lg[2] += xv * w0[2]; lg[3] += xv * w0[3]; lg[4] += xv * w1[0]; lg[5] += xv * w1[1]; lg[6] += xv * w1[2]; lg[7] += xv * w1[3]; }
#pragma unroll
            for (int e = 0; e < 8; ++e) lg[e] = wave_sum(lg[e]) * rs;
            int i1 = 0; float l1 = lg[0];
#pragma unroll
            for (int e = 1; e < 8; ++e) if (lg[e] > l1) { l1 = lg[e]; i1 = e; }
            int i2 = -1; float l2 = -INFINITY;
#pragma unroll
            for (int e = 0; e < 8; ++e) if (e != i1 && lg[e] > l2) { l2 = lg[e]; i2 = e; }
            const float g1 = 1.0f / (1.0f + __expf(l2 - l1)), g2 = 1.0f - g1;
            if (lane == 0) {
                const unsigned p1 = __hip_atomic_fetch_add(&lcnt[i1], 1u, __ATOMIC_RELAXED, __HIP_MEMORY_SCOPE_WORKGROUP), p2 = __hip_atomic_fetch_add(&lcnt[i2], 1u, __ATOMIC_RELAXED, __HIP_MEMORY_SCOPE_WORKGROUP);
                const int ti = wave * 8 + r; ltok[ti * 4 + 0] = i1; ltok[ti * 4 + 1] = i2; ltok[ti * 4 + 2] = (int)p1; ltok[ti * 4 + 3] = (int)p2;
                lgt[ti * 4 + 0] = g1; lgt[ti * 4 + 1] = g2; lgt[ti * 4 + 2] = rs;
            }
        }
        __syncthreads();
        if (tid < 8) gb[tid] = __hip_atomic_fetch_add(F.ctl + CW_CNT + tid, lcnt[tid], RLX_AGENT);
        __syncthreads();
        if (tid < 64) { const int row = chunk * 64 + tid; const int e1 = ltok[tid * 4], e2 = ltok[tid * 4 + 1];
            TOPE[row * 2] = e1; TOPE[row * 2 + 1] = e2; POS[row * 2] = (int)gb[e1] + ltok[tid * 4 + 2]; POS[row * 2 + 1] = (int)gb[e2] + ltok[tid * 4 + 3];
            GATE[row * 2] = lgt[tid * 4]; GATE[row * 2 + 1] = lgt[tid * 4 + 1]; RSTD3[row] = lgt[tid * 4 + 2]; }
        __syncthreads();
    }
}
__device__ __forceinline__ void moe_bases(Frame& F, int (&tb)[9]) {
    int acc = 0;
#pragma unroll
    for (int e = 0; e < 8; ++e) { tb[e] = acc; const unsigned c = __hip_atomic_load(F.ctl + CW_CNT + e, RLX_AGENT); acc += (int)((c + 255u) >> 8); }
    tb[8] = acc;
}
__device__ __forceinline__ void p12_permute(Frame& F) {
    unsigned char* ws = F.ws; const int lane = F.lane;
    const int* TOPE = (const int*)(ws + WS_RT); const int* POS = (const int*)(ws + WS_RT + 128 * 1024); const float* GATE = (const float*)(ws + WS_RT + 256 * 1024); const float* RSTD3 = (const float*)(ws + WS_RT + 384 * 1024);
    int* SLOT = (int*)(ws + WS_RT + 512 * 1024); float* RSTDS = (float*)(ws + WS_RSTDS); float* GATES = (float*)(ws + WS_GATES);
    const bf16* XB = (const bf16*)(ws + WS_XB); bf16* XP = (bf16*)(ws + WS_XPERM);
    int tb[9]; moe_bases(F, tb);
    const int gw = F.wave * F.G + F.bid, NGW = F.G * NWAVES;
    for (int i = gw; i < 2 * M; i += NGW) {
        const int row = i >> 1; const int e = TOPE[i]; int base = 0;
#pragma unroll
        for (int k = 0; k < 8; ++k) base = (e == k) ? tb[k] : base;
        const int slot = base * 256 + POS[i];
        const v4u* src = (const v4u*)(XB + (size_t)row * D) + lane; v4u* dst = (v4u*)(XP + (size_t)slot * D) + lane;
        const v4u a = src[0], c = src[64]; dst[0] = a; dst[64] = c;
        if (lane == 0) { SLOT[i] = slot; RSTDS[slot] = RSTD3[row]; GATES[slot] = GATE[i]; }
    }
}
__device__ __forceinline__ void p15_combine(Frame& F) {
    unsigned char* ws = F.ws; const int lane = F.lane;
    const float* H = (const float*)(ws + WS_H); const bf16* Y = (const bf16*)(ws + WS_Y); const int* SLOT = (const int*)(ws + WS_RT + 512 * 1024);
    const int gw = F.wave * F.G + F.bid, NGW = F.G * NWAVES;
    for (int row = gw; row < M; row += NGW) {
        const int s1 = SLOT[row * 2], s2 = SLOT[row * 2 + 1];
        const GAS f32x4* hr = (const GAS f32x4*)(H + (size_t)row * D) + lane; GAS f32x4* orow = (GAS f32x4*)(F.out + (size_t)row * D) + lane;
        const GAS v2u* y1 = (const GAS v2u*)(Y + (size_t)s1 * D) + lane; const GAS v2u* y2 = (const GAS v2u*)(Y + (size_t)s2 * D) + lane;
#pragma unroll
        for (int j = 0; j < 4; ++j) { const f32x4 h = hr[64 * j]; const v2u a = y1[64 * j], c = y2[64 * j]; f32x4 o;
            o.x = h.x + (bflo(a.x) + bflo(c.x)); o.y = h.y + (bfhi(a.x) + bfhi(c.x)); o.z = h.z + (bflo(a.y) + bflo(c.y)); o.w = h.w + (bfhi(a.y) + bfhi(c.y)); orow[64 * j] = o; }
    }
}

constexpr int N_PHASES = 16;
#ifndef MK_ONE_LAUNCH
#define MK_ONE_LAUNCH 0
#endif
struct Args { const float* in[17]; float* out; unsigned char* ws; int ph_lo, ph_hi; };
__global__ void __launch_bounds__(NWAVES * 64, 2) yoco_fwd(Args args) {
    extern __shared__ __attribute__((aligned(16))) unsigned char lds[];
    Frame F;
    F.lds = (LAS unsigned char*)lds; F.MISC = (volatile LAS unsigned*)(F.lds + MISC_OFF);
    F.tid = threadIdx.x; F.lane = F.tid & 63; F.wave = __builtin_amdgcn_readfirstlane(F.tid >> 6); F.G = gridDim.x; F.bid = blockIdx.x;
    F.ws = args.ws; F.ctl = (gu32*)(args.ws + WS_CTL); F.out = args.out;
#pragma unroll
    for (int i = 0; i < 17; ++i) F.in[i] = args.in[i];
    for (int u = F.tid; u < (LDS_BYTES - LDSCTL_OFF) / 4; u += NWAVES * 64) ((LAS unsigned*)(F.lds + LDSCTL_OFF))[u] = 0u;
    __syncthreads();
    unsigned char* ws = args.ws;
    XcdBarrier bar; bar.bar = (unsigned*)(F.ctl + CW_BAR); bar.x = 0; bar.st = nullptr;
    if (MK_ONE_LAUNCH) bar = xcd_barrier_post((unsigned*)(F.ctl + CW_BAR), F.MISC + 8);
    const int lo = args.ph_lo, hi = args.ph_hi;
#define IN(k) (lo <= (k) && (k) < hi)
#define SEAM(k) do { if (MK_ONE_LAUNCH && IN((k) + 1)) xcd_barrier(bar); } while (0)
    bf16* XB = (bf16*)(ws + WS_XB); float* H = (float*)(ws + WS_H); bf16* AO = (bf16*)(ws + WS_AO);

    if (IN(0)) { p0_prologue(F); SEAM(0); }
    if (IN(1)) {
        pg8::Gemm g{XB, (const bf16*)(ws + WS_WIN), M, 2048, D}; pg8::StaticOrder S; S.init(M, 2048, F.G, F.bid);
        pg8::EpiScaleBf16 E{(bf16*)(ws + WS_PROJ), 2048, (const float*)(ws + WS_SS0)};
        pg8::gemm_phase<pg8::EpiScaleBf16, pg8::StaticOrder, true, true>(F.lds, g, S, E); SEAM(1); }
    if (IN(2)) { p2_post(F); SEAM(2); }
    if (IN(3)) { p3_index_naive(F); SEAM(3); }
    if (IN(4)) { p4_dsa_naive(F); SEAM(4); }
    if (IN(5)) {
        pg8::Gemm g{AO, (const bf16*)(ws + WS_WOA), M, D, D}; pg8::StaticOrder S; S.init(M, D, F.G, F.bid);
        pg8::EpiResid E{F.in[IN_X], H, XB, (float*)(ws + WS_SS1)};
        pg8::gemm_phase<pg8::EpiResid, pg8::StaticOrder, true, true>(F.lds, g, S, E); SEAM(5); }
    if (IN(6)) {
        pg8::Gemm g{XB, (const bf16*)(ws + WS_WGU), M, 2 * FF, D}; pg8::StaticOrder S; S.init(M, 2 * FF, F.G, F.bid);
        pg8::EpiSwiGLU<false> E{(bf16*)(ws + WS_HF), FF, (const float*)(ws + WS_SS1)};
        pg8::gemm_phase<pg8::EpiSwiGLU<false>, pg8::StaticOrder, true, true>(F.lds, g, S, E); SEAM(6); }
    if (IN(7)) {
        pg8::Gemm g{(const bf16*)(ws + WS_HF), (const bf16*)(ws + WS_WD), M, D, FF}; pg8::StaticOrder S; S.init(M, D, F.G, F.bid);
        pg8::EpiResid E{H, H, XB, (float*)(ws + WS_SS2)};
        pg8::gemm_phase<pg8::EpiResid, pg8::StaticOrder, true, true>(F.lds, g, S, E); SEAM(7); }
    if (IN(8)) {
        pg8::Gemm g{XB, (const bf16*)(ws + WS_WKVQ), M, 3072, D}; pg8::StaticOrder S; S.init(M, 3072, F.G, F.bid);
        pg8::EpiScaleBf16 E{(bf16*)(ws + WS_KVQ), 3072, (const float*)(ws + WS_SS2)};
        pg8::gemm_phase<pg8::EpiScaleBf16, pg8::StaticOrder, true, true>(F.lds, g, S, E); SEAM(8); }
    if (IN(9)) { p9_sb_naive(F); SEAM(9); }
    if (IN(10)) {
        pg8::Gemm g{AO, (const bf16*)(ws + WS_WOB), M, D, D}; pg8::StaticOrder S; S.init(M, D, F.G, F.bid);
        pg8::EpiResid E{H, H, XB, (float*)(ws + WS_SS3)};
        pg8::gemm_phase<pg8::EpiResid, pg8::StaticOrder, true, true>(F.lds, g, S, E); SEAM(10); }
    if (IN(11)) { p11_router(F); SEAM(11); }
    if (IN(12)) { p12_permute(F); SEAM(12); }
    if (IN(13)) {
        pg8::MoeOrder S; moe_bases(F, S.tb); S.npn = 22; S.G = F.G; S.c = F.bid;
        pg8::Gemm g{(const bf16*)(ws + WS_XPERM), (const bf16*)(ws + WS_WGUM), MAXSLOT, NE * 2 * FF, D};
        pg8::EpiSwiGLU<true> E{(bf16*)(ws + WS_HM), FF, (const float*)(ws + WS_RSTDS)};
        pg8::gemm_phase<pg8::EpiSwiGLU<true>, pg8::MoeOrder, true, true>(F.lds, g, S, E); SEAM(13); }
    if (IN(14)) {
        pg8::MoeOrder S; moe_bases(F, S.tb); S.npn = 4; S.G = F.G; S.c = F.bid;
        pg8::Gemm g{(const bf16*)(ws + WS_HM), (const bf16*)(ws + WS_WDM), MAXSLOT, NE * D, FF};
        pg8::EpiGateBf16 E{(bf16*)(ws + WS_Y), (const float*)(ws + WS_GATES)};
        pg8::gemm_phase<pg8::EpiGateBf16, pg8::MoeOrder, true, true>(F.lds, g, S, E); SEAM(14); }
    if (IN(15)) { p15_combine(F); }
#undef IN
#undef SEAM
}

extern "C" void kernel_launch(void* const* d_in, const int* in_sizes, int n_in, void* d_out, int out_size, void* d_ws, size_t ws_size, hipStream_t stream) {
    static int grid = 0;
    if (grid == 0) {
        if (n_in != 17 || out_size != M * D || ws_size < WS_END) { fprintf(stderr, "kernel_launch: unexpected problem (n_in %d, out %d, ws %zu < %zu)\n", n_in, out_size, ws_size, (size_t)WS_END); grid = -1; return; }
        int dev = 0, cus = 0, per_cu = 0;
        if (hipGetDevice(&dev) != hipSuccess || hipDeviceGetAttribute(&cus, hipDeviceAttributeMultiprocessorCount, dev) != hipSuccess) { grid = -1; return; }
        if (hipFuncSetAttribute((const void*)yoco_fwd, hipFuncAttributeMaxDynamicSharedMemorySize, LDS_BYTES) != hipSuccess) { fprintf(stderr, "kernel_launch: hipFuncSetAttribute failed\n"); grid = -1; return; }
        if (hipOccupancyMaxActiveBlocksPerMultiprocessor(&per_cu, (const void*)yoco_fwd, NWAVES * 64, LDS_BYTES) != hipSuccess || per_cu < 1) fprintf(stderr, "kernel_launch: occupancy query says %d\n", per_cu);
        (void)hipGetLastError();
        grid = cus;
    }
    if (grid < 0) return;
    if (hipMemsetAsync((char*)d_ws + WS_CTL, 0, CTL_ZERO_BYTES, stream) != hipSuccess) return;
    Args a{};
    for (int i = 0; i < 17; ++i) a.in[i] = (const float*)d_in[i];
    a.out = (float*)d_out; a.ws = (unsigned char*)d_ws;
#if MK_ONE_LAUNCH
    a.ph_lo = 0; a.ph_hi = N_PHASES;
    hipLaunchKernelGGL(yoco_fwd, dim3(grid), dim3(NWAVES * 64), LDS_BYTES, stream, a);
#else
    for (int p = 0; p < N_PHASES; ++p) { a.ph_lo = p; a.ph_hi = p + 1; hipLaunchKernelGGL(yoco_fwd, dim3(grid), dim3(NWAVES * 64), LDS_BYTES, stream, a); }
#endif
}
```

```cpp
#include <hip/hip_runtime.h>
#include <cstdio>
#include <cstdint>
namespace pg8 {
#define PG8_LAS __attribute__((address_space(3)))
typedef unsigned short bf16_t;
typedef short bf16x8 __attribute__((ext_vector_type(8)));
typedef float f32x4 __attribute__((ext_vector_type(4)));
typedef unsigned u32x4 __attribute__((ext_vector_type(4)));
constexpr int BM = 256, BK = 64, HALF = 128, HTB = HALF * BK * 2  , STAGE_BYTES = 8 * HTB, NXCD = 8, WGM = 8;

__host__ __device__ __forceinline__ int lds_byte(int r, int c) { const int st = (r >> 4) * 2 + (c >> 5), rr = r & 15, cc = c & 31, ob = rr * 64 + cc * 2; return st * 1024 + (ob ^ (((ob >> 9) & 1) << 5)); }
__host__ __device__ __forceinline__ void stage_rc(int b, int& R, int& C) { const int st = b / 1024, sb = b % 1024, swz = sb ^ (((sb >> 9) & 1) << 5); R = (st >> 1) * 16 + swz / 64; C = (st & 1) * 32 + (swz % 64) / 2; }
__host__ __device__ __forceinline__ int perm32(int rho) { const int n = rho >> 4, i = rho & 15; return 8 * (i >> 2) + 4 * n + (i & 3); }

struct Unit { int pm, pn; };
struct Gemm { const bf16_t* A; const bf16_t* Bt; int M, N, K; };

struct StaticOrder {
    int nM, nN, nwg, G, c;
    __host__ __device__ void init(int M, int N, int G_, int c_) { nM = M / BM; nN = N / BM; nwg = nM * nN; G = G_; c = c_; }
    __host__ __device__ bool next(int i, Unit& u) const {
        const long L = (long)i * G + c; if (L >= nwg) return false;
        int wgid = (int)L; { const int q = nwg / NXCD, r = nwg % NXCD, xcd = wgid % NXCD, off = wgid / NXCD; wgid = (xcd < r ? xcd * (q + 1) : r * (q + 1) + (xcd - r) * q) + off; }
        const int nig = WGM * nN, gid = wgid / nig, fm = gid * WGM, gsz = (nM - fm) < WGM ? (nM - fm) : WGM;
        u.pm = fm + ((wgid % nig) % gsz); u.pn = (wgid % nig) / gsz; return true;
    }
    __device__ __forceinline__ void a_ready(const Unit&) const {}
    __device__ __forceinline__ void done(const Unit&) const {}
};

__device__ __forceinline__ unsigned cvt_pk_bf16(float lo, float hi) { unsigned r; asm volatile("v_cvt_pk_bf16_f32 %0, %1, %2" : "=v"(r) : "v"(lo), "v"(hi)); return r; }
typedef unsigned u32x2 __attribute__((ext_vector_type(2)));
constexpr float RMS_EPS = 1e-6f;
__device__ __forceinline__ float rstd16(const float* p) {
    const f32x4 a = *(const f32x4*)p, b = *(const f32x4*)(p + 4), c = *(const f32x4*)(p + 8), d = *(const f32x4*)(p + 12);
    const float s = (((a[0] + a[1]) + (a[2] + a[3])) + ((b[0] + b[1]) + (b[2] + b[3]))) + (((c[0] + c[1]) + (c[2] + c[3])) + ((d[0] + d[1]) + (d[2] + d[3])));
    return 1.0f / sqrtf(s * (1.0f / 1024.0f) + RMS_EPS);
}
struct EpiScaleBf16 {
    static constexpr bool PERM = true, AFTER_DRAIN = false;
    bf16_t* O; int ldc; const float* ss;
    __device__ __forceinline__ void operator()(const f32x4 (&acc)[2][2][4][2], const Unit& u, int wr, int wc, int fr, int fq) const {
        const int row0 = u.pm * BM + wr * 64 + fr, col0 = u.pn * BM + wc * 32 + 8 * fq;
#pragma unroll
        for (int ai = 0; ai < 2; ++ai)
#pragma unroll
            for (int m = 0; m < 4; ++m) { const int row = row0 + ai * HALF + m * 16; const float rs = rstd16(ss + (size_t)row * 16); bf16_t* rowp = O + (size_t)row * ldc + col0;
#pragma unroll
                for (int bj = 0; bj < 2; ++bj) { const f32x4 v0 = acc[ai][bj][m][0] * rs, v1 = acc[ai][bj][m][1] * rs;
                    u32x4 w; w.x = cvt_pk_bf16(v0[0], v0[1]); w.y = cvt_pk_bf16(v0[2], v0[3]); w.z = cvt_pk_bf16(v1[0], v1[1]); w.w = cvt_pk_bf16(v1[2], v1[3]);
                    *(u32x4*)(rowp + bj * HALF) = w; } }
    }
};
struct EpiScaleColBf16 {
    static constexpr bool PERM = true, AFTER_DRAIN = false;
    bf16_t* O; int ldc; const float* ss;
    __device__ __forceinline__ void operator()(const f32x4 (&acc)[2][2][4][2], const Unit& u, int wr, int wc, int fr, int fq) const {
        const int row0 = u.pm * BM + wr * 64 + fr, col0 = u.pn * BM + wc * 32 + 8 * fq;
        f32x4 rs[2][2];
#pragma unroll
        for (int bj = 0; bj < 2; ++bj)
#pragma unroll
            for (int n = 0; n < 2; ++n)
#pragma unroll
                for (int e = 0; e < 4; ++e) rs[bj][n][e] = rstd16(ss + (size_t)(col0 + bj * HALF + 4 * n + e) * 16);
#pragma unroll
        for (int ai = 0; ai < 2; ++ai)
#pragma unroll
            for (int m = 0; m < 4; ++m) { const int row = row0 + ai * HALF + m * 16; bf16_t* rowp = O + (size_t)row * ldc + col0;
#pragma unroll
                for (int bj = 0; bj < 2; ++bj) { const f32x4 v0 = acc[ai][bj][m][0] * rs[bj][0], v1 = acc[ai][bj][m][1] * rs[bj][1];
                    u32x4 w; w.x = cvt_pk_bf16(v0[0], v0[1]); w.y = cvt_pk_bf16(v0[2], v0[3]); w.z = cvt_pk_bf16(v1[0], v1[1]); w.w = cvt_pk_bf16(v1[2], v1[3]);
                    *(u32x4*)(rowp + bj * HALF) = w; } }
    }
};
struct EpiResid {
    static constexpr bool PERM = false, AFTER_DRAIN = false;
    const float* base; float* H; bf16_t* XB; float* ssp;
    __device__ __forceinline__ void operator()(const f32x4 (&acc)[2][2][4][2], const Unit& u, int wr, int wc, int fr, int fq) const {
        const int row0 = u.pm * BM + wr * 64 + fr, col0 = u.pn * BM + wc * 32 + 4 * fq;
#pragma unroll
        for (int ai = 0; ai < 2; ++ai)
#pragma unroll
            for (int m = 0; m < 4; ++m) { const int row = row0 + ai * HALF + m * 16; float q = 0.f;
#pragma unroll
                for (int bj = 0; bj < 2; ++bj)
#pragma unroll
                    for (int n = 0; n < 2; ++n) { const size_t off = (size_t)row * 1024 + col0 + bj * HALF + n * 16;
                        const f32x4 v = *(const f32x4*)(base + off) + acc[ai][bj][m][n]; *(f32x4*)(H + off) = v;
                        q += (v[0] * v[0] + v[1] * v[1]) + (v[2] * v[2] + v[3] * v[3]);
                        u32x2 w; w.x = cvt_pk_bf16(v[0], v[1]); w.y = cvt_pk_bf16(v[2], v[3]); *(u32x2*)(XB + off) = w; }
                q += __shfl_xor(q, 16); q += __shfl_xor(q, 32);
                if (fq == 0) ssp[(size_t)row * 16 + u.pn * 4 + wc] = q; }
    }
};
__device__ __forceinline__ float silu_mul(float g, float u) { return g * __builtin_amdgcn_rcpf(1.0f + __builtin_amdgcn_exp2f(g * -1.4426950408889634f)) * u; }
template <bool MOE> struct EpiSwiGLU {
    static constexpr bool PERM = true, AFTER_DRAIN = false;
    bf16_t* O; int ldc; const float* ss;
    __device__ __forceinline__ void operator()(const f32x4 (&acc)[2][2][4][2], const Unit& u, int wr, int wc, int fr, int fq) const {
        const int row0 = u.pm * BM + wr * 64 + fr; const int pnl = MOE ? (u.pn % 22) : u.pn; const int col0 = pnl * HALF + wc * 32 + 8 * fq;
#pragma unroll
        for (int ai = 0; ai < 2; ++ai)
#pragma unroll
            for (int m = 0; m < 4; ++m) { const int row = row0 + ai * HALF + m * 16; const float rs = MOE ? ss[row] : rstd16(ss + (size_t)row * 16);
                const f32x4 g0 = acc[ai][0][m][0] * rs, g1 = acc[ai][0][m][1] * rs, u0 = acc[ai][1][m][0] * rs, u1 = acc[ai][1][m][1] * rs;
                u32x4 w; w.x = cvt_pk_bf16(silu_mul(g0[0], u0[0]), silu_mul(g0[1], u0[1])); w.y = cvt_pk_bf16(silu_mul(g0[2], u0[2]), silu_mul(g0[3], u0[3]));
                w.z = cvt_pk_bf16(silu_mul(g1[0], u1[0]), silu_mul(g1[1], u1[1])); w.w = cvt_pk_bf16(silu_mul(g1[2], u1[2]), silu_mul(g1[3], u1[3]));
                *(u32x4*)(O + (size_t)row * ldc + col0) = w; }
    }
};
struct EpiGateBf16 {
    static constexpr bool PERM = true, AFTER_DRAIN = false;
    bf16_t* Y; const float* gate;
    __device__ __forceinline__ void operator()(const f32x4 (&acc)[2][2][4][2], const Unit& u, int wr, int wc, int fr, int fq) const {
        const int row0 = u.pm * BM + wr * 64 + fr, col0 = (u.pn & 3) * BM + wc * 32 + 8 * fq;
#pragma unroll
        for (int ai = 0; ai < 2; ++ai)
#pragma unroll
            for (int m = 0; m < 4; ++m) { const int row = row0 + ai * HALF + m * 16; const float gt = gate[row]; bf16_t* rowp = Y + (size_t)row * 1024 + col0;
#pragma unroll
                for (int bj = 0; bj < 2; ++bj) { const f32x4 v0 = acc[ai][bj][m][0] * gt, v1 = acc[ai][bj][m][1] * gt;
                    u32x4 w; w.x = cvt_pk_bf16(v0[0], v0[1]); w.y = cvt_pk_bf16(v0[2], v0[3]); w.z = cvt_pk_bf16(v1[0], v1[1]); w.w = cvt_pk_bf16(v1[2], v1[3]);
                    *(u32x4*)(rowp + bj * HALF) = w; } }
    }
};
struct MoeOrder {
    int tb[9]; int npn, G, c;
    __device__ __forceinline__ bool next(int i, Unit& u) const {
        const int L = i * G + c; if (L >= tb[8] * npn) return false;
        const int t = L / npn, j = L - t * npn; int e = 0;
#pragma unroll
        for (int k = 1; k < 8; ++k) e += (t >= tb[k]) ? 1 : 0;
        u.pm = t; u.pn = e * npn + j; return true;
    }
    __device__ __forceinline__ void a_ready(const Unit&) const {}
    __device__ __forceinline__ void done(const Unit&) const {}
};

template <class Epi, class Sched, bool ALIGN_EPI = false, bool SP2 = false>
__device__ __forceinline__ void gemm_phase(PG8_LAS unsigned char* lds, const Gemm g, const Sched& S, const Epi& E) {
    const int tid = threadIdx.x, wid = __builtin_amdgcn_readfirstlane(tid >> 6), lane = tid & 63, wr = wid >> 2, wc = wid & 3, fr = lane & 15, fq = lane >> 4;
    const int K = g.K, nt = K / BK;
    unsigned voffA[2], voffB[2];
#pragma unroll
    for (int i = 0; i < 2; ++i) { int R, C; stage_rc(tid * 16 + i * 8192, R, C); const int Rb = Epi::PERM ? ((R & ~31) + perm32(R & 31)) : R;
        voffA[i] = (unsigned)(R * K + C) * 2u; voffB[i] = (unsigned)(Rb * K + C) * 2u; }
    const size_t kstep = (size_t)(BK * 2);
    const size_t hstep = (size_t)HALF * K * 2;
    const size_t tstep = 2 * hstep;
    const unsigned ldsw = (unsigned)wid * 1024u;
    const int aoff = lds_byte(wr * 64 + fr, fq * 8), boff = lds_byte(wc * 32 + fr, fq * 8);
#define PG8_SA(b, h) (((b) * 2 + (h)) * HTB)
#define PG8_SB(b, h) ((4 + (b) * 2 + (h)) * HTB)
#define PG8_STAGE(bufoff, gbase, voff) do { _Pragma("unroll") for (int _i = 0; _i < 2; ++_i) \
        __builtin_amdgcn_global_load_lds((const unsigned*)((const char*)(gbase) + (voff)[_i]), (PG8_LAS unsigned*)(lds + (bufoff) + ldsw + _i * 8192), 16, 0, 0); } while (0)
#define PG8_LDA(dst, b, h) do { _Pragma("unroll") for (int m = 0; m < 4; ++m) _Pragma("unroll") for (int k = 0; k < 2; ++k) dst[m][k] = *(const PG8_LAS bf16x8*)(lds + PG8_SA(b, h) + aoff + m * 2048 + k * 1024); } while (0)
#define PG8_LDB(dst, b, h) do { _Pragma("unroll") for (int n = 0; n < 2; ++n) _Pragma("unroll") for (int k = 0; k < 2; ++k) dst[n][k] = *(const PG8_LAS bf16x8*)(lds + PG8_SB(b, h) + boff + n * 2048 + k * 1024); } while (0)
#define PG8_MMA(ai, bj, At, Bt) do { __builtin_amdgcn_s_setprio(1); _Pragma("unroll") for (int m = 0; m < 4; ++m) _Pragma("unroll") for (int n = 0; n < 2; ++n) _Pragma("unroll") for (int k = 0; k < 2; ++k) \
        acc[ai][bj][m][n] = __builtin_amdgcn_mfma_f32_16x16x32_bf16(Bt[n][k], At[m][k], acc[ai][bj][m][n], 0, 0, 0); __builtin_amdgcn_s_setprio(0); } while (0)
#define PG8_WAIT_V(n) asm volatile("s_waitcnt vmcnt(" #n ")" ::: "memory")
#define PG8_WAIT_L(n) asm volatile("s_waitcnt lgkmcnt(" #n ")" ::: "memory")
#define PG8_BAR __builtin_amdgcn_s_barrier()
#define PG8_SCHED __builtin_amdgcn_sched_barrier(0)
    Unit cur, nxt; int ui = 0;
    if (!S.next(0, cur)) return;
    f32x4 acc[2][2][4][2];
#pragma unroll
    for (int a = 0; a < 2; ++a)
#pragma unroll
        for (int b = 0; b < 2; ++b)
#pragma unroll
            for (int m = 0; m < 4; ++m)
#pragma unroll
                for (int n = 0; n < 2; ++n) acc[a][b][m][n] = (f32x4){0.f, 0.f, 0.f, 0.f};
    bf16x8 At[4][2], B0[2][2], B1[2][2];
    const char* cA = (const char*)g.A + (size_t)cur.pm * tstep; const char* cB = (const char*)g.Bt + (size_t)cur.pn * tstep;
    S.a_ready(cur);
    if constexpr (SP2) {
        PG8_STAGE(PG8_SB(0, 0), cB, voffB); PG8_STAGE(PG8_SB(0, 1), cB + hstep, voffB); PG8_STAGE(PG8_SA(0, 0), cA, voffA); PG8_STAGE(PG8_SA(0, 1), cA + hstep, voffA);
        if (wr == 1) PG8_BAR;
        PG8_WAIT_V(2); PG8_BAR;
        PG8_STAGE(PG8_SB(1, 0), cB + kstep, voffB); PG8_STAGE(PG8_SA(1, 0), cA + kstep, voffA); PG8_STAGE(PG8_SB(1, 1), cB + hstep + kstep, voffB);
        PG8_WAIT_V(6); PG8_BAR;
    } else {
        PG8_STAGE(PG8_SB(0, 0), cB, voffB); PG8_STAGE(PG8_SA(0, 0), cA, voffA); PG8_STAGE(PG8_SB(0, 1), cB + hstep, voffB); PG8_STAGE(PG8_SA(0, 1), cA + hstep, voffA);
        if (wr == 1) PG8_BAR;
        PG8_WAIT_V(4); PG8_BAR;
        PG8_STAGE(PG8_SB(1, 0), cB + kstep, voffB); PG8_STAGE(PG8_SA(1, 0), cA + kstep, voffA); PG8_STAGE(PG8_SB(1, 1), cB + hstep + kstep, voffB);
        PG8_WAIT_V(6); PG8_BAR;
    }
    for (;;) {
        const bool has_next = S.next(ui + 1, nxt);
        const char* nA = has_next ? (const char*)g.A + (size_t)nxt.pm * tstep : cA; const char* nB = has_next ? (const char*)g.Bt + (size_t)nxt.pn * tstep : cB;
        for (int t = 0; t < nt; t += 2) {
            const bool last = (t == nt - 2);
            const char* a1 = cA + (size_t)(t + 1) * kstep;
            const char* a2 = last ? nA : cA + (size_t)(t + 2) * kstep; const char* b2 = last ? nB : cB + (size_t)(t + 2) * kstep;
            const char* a3 = a2 + kstep; const char* b3 = b2 + kstep;
            if (last && has_next) S.a_ready(nxt);
            if constexpr (SP2) {
            PG8_LDB(B0, 0, 0); PG8_LDB(B1, 0, 1); PG8_SCHED; PG8_LDA(At, 0, 0); PG8_STAGE(PG8_SA(1, 1), a1 + hstep, voffA);
            PG8_WAIT_V(8); PG8_WAIT_L(0); PG8_BAR; PG8_MMA(0, 0, At, B0); PG8_MMA(0, 1, At, B1); PG8_BAR; PG8_SCHED;
            PG8_LDA(At, 0, 1); PG8_STAGE(PG8_SB(0, 0), b2, voffB); PG8_STAGE(PG8_SB(0, 1), b2 + hstep, voffB); PG8_STAGE(PG8_SA(0, 0), a2, voffA);
            PG8_WAIT_V(8); PG8_WAIT_L(0); PG8_BAR; PG8_MMA(1, 0, At, B0); PG8_MMA(1, 1, At, B1); PG8_BAR; PG8_SCHED;
            PG8_LDB(B0, 1, 0); PG8_LDB(B1, 1, 1); PG8_SCHED; PG8_LDA(At, 1, 0); PG8_STAGE(PG8_SA(0, 1), a2 + hstep, voffA);
            PG8_WAIT_V(8); PG8_WAIT_L(0); PG8_BAR; PG8_MMA(0, 0, At, B0); PG8_MMA(0, 1, At, B1); PG8_BAR; PG8_SCHED;
            PG8_LDA(At, 1, 1); PG8_STAGE(PG8_SB(1, 0), b3, voffB); PG8_STAGE(PG8_SB(1, 1), b3 + hstep, voffB); PG8_STAGE(PG8_SA(1, 0), a3, voffA);
            PG8_WAIT_V(8); PG8_WAIT_L(0); PG8_BAR; PG8_MMA(1, 0, At, B0); PG8_MMA(1, 1, At, B1); PG8_BAR; PG8_SCHED;
            } else {
            PG8_LDB(B0, 0, 0); PG8_SCHED; PG8_LDA(At, 0, 0); PG8_STAGE(PG8_SA(1, 1), a1 + hstep, voffA);
            PG8_WAIT_L(8); PG8_BAR; PG8_WAIT_L(0); PG8_MMA(0, 0, At, B0); PG8_BAR; PG8_SCHED;
            PG8_LDB(B1, 0, 1); PG8_STAGE(PG8_SB(0, 0), b2, voffB);
            PG8_BAR; PG8_WAIT_L(0); PG8_MMA(0, 1, At, B1); PG8_BAR;
            PG8_LDA(At, 0, 1); PG8_STAGE(PG8_SA(0, 0), a2, voffA);
            PG8_BAR; PG8_WAIT_L(0); PG8_MMA(1, 0, At, B0); PG8_BAR; PG8_SCHED;
            PG8_STAGE(PG8_SB(0, 1), b2 + hstep, voffB);
            PG8_WAIT_V(6); PG8_BAR; PG8_MMA(1, 1, At, B1); PG8_BAR;
            PG8_LDB(B0, 1, 0); PG8_SCHED; PG8_LDA(At, 1, 0); PG8_STAGE(PG8_SA(0, 1), a2 + hstep, voffA);
            PG8_WAIT_L(8); PG8_BAR; PG8_WAIT_L(0); PG8_MMA(0, 0, At, B0); PG8_BAR; PG8_SCHED;
            PG8_LDB(B1, 1, 1); PG8_STAGE(PG8_SB(1, 0), b3, voffB);
            PG8_BAR; PG8_WAIT_L(0); PG8_MMA(0, 1, At, B1); PG8_BAR;
            PG8_LDA(At, 1, 1); PG8_STAGE(PG8_SA(1, 0), a3, voffA);
            PG8_BAR; PG8_WAIT_L(0); PG8_MMA(1, 0, At, B0); PG8_BAR; PG8_SCHED;
            PG8_STAGE(PG8_SB(1, 1), b3 + hstep, voffB);
            PG8_WAIT_V(6); PG8_BAR; PG8_MMA(1, 1, At, B1); PG8_BAR;
            }
        }
        if constexpr (ALIGN_EPI) { if (wr == 0) PG8_BAR; }
        if constexpr (!Epi::AFTER_DRAIN) { E(acc, cur, wr, wc, fr, fq); S.done(cur); }
        if (!has_next) break;
#pragma unroll
        for (int a = 0; a < 2; ++a)
#pragma unroll
            for (int b = 0; b < 2; ++b)
#pragma unroll
                for (int m = 0; m < 4; ++m)
#pragma unroll
                    for (int n = 0; n < 2; ++n) acc[a][b][m][n] = (f32x4){0.f, 0.f, 0.f, 0.f};
        cur = nxt; cA = nA; cB = nB; ++ui;
        if constexpr (ALIGN_EPI) { if (wr == 1) PG8_BAR; }
    }
    PG8_WAIT_V(0);
    if constexpr (!ALIGN_EPI) { if (wr == 0) PG8_BAR; }
    PG8_BAR;
    if constexpr (Epi::AFTER_DRAIN) { E.fused(acc, cur, wr, wc, fr, fq, lds, wid, lane); S.done(cur); }
#undef PG8_SA
#undef PG8_SB
#undef PG8_STAGE
#undef PG8_LDA
#undef PG8_LDB
#undef PG8_MMA
#undef PG8_WAIT_V
#undef PG8_WAIT_L
#undef PG8_BAR
#undef PG8_SCHED
}
}

constexpr int NWAVES = 8;
constexpr int BATCH = 2, SEQ = 8192, D = 1024, M = BATCH * SEQ;
constexpr int HD = 128, NH = 8, NKV = 2, NIH = 8, IDX = 64, TOPK = 256;
constexpr int A_IN = 2120, FF = 2816, NE = 8;
constexpr int MAXSLOT = 34816;
constexpr float QSCALE = 0.12751743082459868f;
constexpr float SBSCALE = 0.08838834764831845f;
constexpr float WISCALE = 0.04419417382415922f;
constexpr size_t MiB = 1u << 20;
constexpr size_t WS_CTL = 0, CTL_ZERO_BYTES = 1 * MiB;
constexpr size_t WS_WIN = 2 * MiB, WS_WTAIL = 6 * MiB, WS_WOA = 7 * MiB, WS_WGU = 9 * MiB, WS_WD = 20 * MiB, WS_WKVQ = 26 * MiB, WS_WOB = 32 * MiB, WS_WGUM = 34 * MiB, WS_WDM = 122 * MiB;
constexpr size_t WS_H = 166 * MiB, WS_XB = 230 * MiB, WS_SS0 = 262 * MiB, WS_SS1 = 263 * MiB, WS_SS2 = 264 * MiB, WS_SS3 = 265 * MiB;
constexpr size_t WS_T = 266 * MiB;
constexpr size_t WS_PROJ = WS_T, WS_QF = 330 * MiB, WS_KVF = 362 * MiB, WS_QIF = 378 * MiB, WS_KIF = 394 * MiB, WS_WIF = 396 * MiB, WS_SEL = 397 * MiB, WS_AO = 413 * MiB;
constexpr size_t WS_HF = WS_T, WS_KQ = WS_T, WS_VT = 330 * MiB;
constexpr size_t WS_XPERM = WS_T, WS_HM = 334 * MiB, WS_Y = 521 * MiB;
constexpr size_t WS_RT = 590 * MiB;
constexpr size_t WS_RSTDS = 591 * MiB, WS_GATES = 591 * MiB + 512 * 1024, WS_END = 592 * MiB;
constexpr int CW_CNT = 64;
constexpr int CW_BAR = 4096;
constexpr int RING_BYTES = 131072, LDSCTL_OFF = RING_BYTES, MISC_OFF = LDSCTL_OFF + 320, LDS_BYTES = 147456;

#define GAS __attribute__((address_space(1)))
#define LAS __attribute__((address_space(3)))
typedef unsigned short bf16;
typedef unsigned v4u __attribute__((ext_vector_type(4)));
typedef unsigned v2u __attribute__((ext_vector_type(2)));
typedef float f32x4 __attribute__((ext_vector_type(4)));
typedef short bf16x8 __attribute__((ext_vector_type(8)));
typedef float f32x16 __attribute__((ext_vector_type(16)));
typedef GAS unsigned gu32;
#define RLX_AGENT __ATOMIC_RELAXED, __HIP_MEMORY_SCOPE_AGENT
#define LDS_WAIT() asm volatile("s_waitcnt lgkmcnt(0)" ::: "memory")
#define VM_WAIT() asm volatile("s_waitcnt vmcnt(0)" ::: "memory")
__device__ __forceinline__ unsigned f2bf(float f) { unsigned u = __builtin_bit_cast(unsigned, f); return (u + 0x7fffu + ((u >> 16) & 1u)) >> 16; }
__device__ __forceinline__ unsigned pk2(float lo, float hi) { return f2bf(lo) | (f2bf(hi) << 16); }
__device__ __forceinline__ float bflo(unsigned w) { return __uint_as_float(w << 16); }
__device__ __forceinline__ float bfhi(unsigned w) { return __uint_as_float(w & 0xffff0000u); }
__device__ __forceinline__ float wave_sum(float v) {
#pragma unroll
    for (int o = 1; o < 64; o <<= 1) v += __shfl_xor(v, o);
    return v;
}
__device__ __forceinline__ float wave_max(float v) {
#pragma unroll
    for (int o = 1; o < 64; o <<= 1) v = fmaxf(v, __shfl_xor(v, o));
    return v;
}
__device__ __forceinline__ void sincos_acc(float a, float& c, float& s) {
    const double x = (double)a; const double n = __builtin_rint(x * 0.63661977236758134308);
    const double r = __builtin_fma(-n, 6.123233995736766035869e-17, __builtin_fma(-n, 1.57079632679489655800, x)); const double r2 = r * r;
    double sn = 1.0 - r2 * (1.0 / 156.0); sn = 1.0 - r2 * (1.0 / 110.0) * sn; sn = 1.0 - r2 * (1.0 / 72.0) * sn; sn = 1.0 - r2 * (1.0 / 42.0) * sn; sn = 1.0 - r2 * (1.0 / 20.0) * sn; sn = 1.0 - r2 * (1.0 / 6.0) * sn; sn *= r;
    double cs = 1.0 - r2 * (1.0 / 182.0); cs = 1.0 - r2 * (1.0 / 132.0) * cs; cs = 1.0 - r2 * (1.0 / 90.0) * cs; cs = 1.0 - r2 * (1.0 / 56.0) * cs; cs = 1.0 - r2 * (1.0 / 30.0) * cs; cs = 1.0 - r2 * (1.0 / 12.0) * cs; cs = 1.0 - r2 * 0.5 * cs;
    const int q = ((int)n) & 3;
    const double cq = (q == 0) ? cs : (q == 1) ? -sn : (q == 2) ? -cs : sn;
    const double sq = (q == 0) ? sn : (q == 1) ? cs : (q == 2) ? -sn : -cs;
    c = (float)cq; s = (float)sq;
}
__device__ const float INV_Q[16] = {1.000000000e+00f, 4.403665960e-01f, 1.939227432e-01f, 8.539710194e-02f, 3.760603070e-02f, 1.656043902e-02f, 7.292664610e-03f, 3.211445874e-03f,
                                    1.414213562e-03f, 6.227723788e-04f, 2.742481884e-04f, 1.207697351e-04f, 5.318296098e-05f, 2.341999971e-05f, 1.031338616e-05f, 4.541670478e-06f};
__device__ const float INV_I[8] = {1.000000000e+00f, 1.939227432e-01f, 3.760603070e-02f, 7.292664610e-03f, 1.414213562e-03f, 2.742481884e-04f, 5.318296098e-05f, 1.031338616e-05f};

#define XB_TMO      128
#define XB_XCNT(j)  (256  + 64 * (j))
#define XB_XSUB(j)  (1280 + 64 * (j))
#define XB_XGEN(j)  (2304 + 64 * (j))
#define XB_TOP      3328
#define XB_TOPGEN   3392
#define XCD_BAR_WORDS 3456
#define XB_SPIN_CAP (1u << 18)

__device__ __forceinline__ unsigned xb_ld(unsigned* p)              { return __hip_atomic_load(p, __ATOMIC_RELAXED, __HIP_MEMORY_SCOPE_AGENT); }
__device__ __forceinline__ unsigned xb_add(unsigned* p, unsigned v) { return __hip_atomic_fetch_add(p, v, __ATOMIC_RELAXED, __HIP_MEMORY_SCOPE_AGENT); }
__device__ __forceinline__ unsigned xb_xcc_id() { return (unsigned)__builtin_amdgcn_s_getreg((3 << 11) | 20) & 0xFu; }
#define XB_SPIN(cond, bar) do { unsigned _sp = 0; while (cond) { __builtin_amdgcn_s_sleep(1); \
    if ((++_sp & 255u) == 0u) { if (xb_ld(&(bar)[XB_TMO])) break; if (_sp > XB_SPIN_CAP) { atomicAdd(&(bar)[XB_TMO], 1u); break; } } } } while (0)

struct XcdBarrier {
    unsigned* bar; unsigned x;
    volatile LAS unsigned* st;
};

__device__ __forceinline__ XcdBarrier xcd_barrier_post(unsigned* bar, volatile LAS unsigned* st) {
    XcdBarrier b; b.bar = bar; b.x = xb_xcc_id(); b.st = st;
    if (threadIdx.x == 0) (void)xb_add(&bar[XB_XCNT(b.x)], 1u);
    return b;
}
__device__ __forceinline__ void xcd_barrier_complete(unsigned* bar, unsigned x, unsigned& nloc, unsigned& nx) {
    const unsigned G = gridDim.x * gridDim.y * gridDim.z;
    unsigned sum, cnt, mine, sp = 0u;
    for (;;) {
        sum = 0u; cnt = 0u; mine = 0u;
#pragma unroll
        for (unsigned j = 0; j < 16; ++j) { const unsigned c = xb_ld(&bar[XB_XCNT(j)]); sum += c; cnt += (c > 0u) ? 1u : 0u; mine = (j == x) ? c : mine; }
        if (sum == G) break;
        __builtin_amdgcn_s_sleep(1);
        if ((++sp & 255u) == 0u) { if (xb_ld(&bar[XB_TMO])) break; if (sp > XB_SPIN_CAP) { atomicAdd(&bar[XB_TMO], 1u); break; } }
    }
    nloc = mine > 0u ? mine : 1u; nx = cnt > 0u ? cnt : 1u;
}

__device__ __forceinline__ void xcd_barrier(const XcdBarrier& b) {
    asm volatile("s_waitcnt vmcnt(0)" ::: "memory");
    __syncthreads();
    if (threadIdx.x == 0) {
        unsigned* bar = b.bar;
        __builtin_amdgcn_s_waitcnt(0);
        unsigned nloc = b.st[0], nx = b.st[1];
        if (nloc == 0u) { xcd_barrier_complete(bar, b.x, nloc, nx); b.st[0] = nloc; b.st[1] = nx; }
        const unsigned old = xb_add(&bar[XB_XSUB(b.x)], 1u);
        const unsigned gen = old / nloc;
        if (old + 1u == (gen + 1u) * nloc) {
            __builtin_amdgcn_fence(__ATOMIC_RELEASE, "agent");
            asm volatile("s_waitcnt vmcnt(0)" ::: "memory");
            const unsigned og = xb_add(&bar[XB_TOP], 1u);
            const unsigned tg = og / nx;
            if (og + 1u == (tg + 1u) * nx) xb_add(&bar[XB_TOPGEN], 1u);
            else XB_SPIN(xb_ld(&bar[XB_TOPGEN]) == tg, bar);
            __builtin_amdgcn_fence(__ATOMIC_ACQUIRE, "agent");
            xb_add(&bar[XB_XGEN(b.x)], 1u);
            asm volatile("s_waitcnt vmcnt(0)" ::: "memory");
        } else {
            XB_SPIN(xb_ld(&bar[XB_XGEN(b.x)]) == gen, bar);
            __builtin_amdgcn_fence(__ATOMIC_ACQUIRE, "agent");
            asm volatile("s_waitcnt vmcnt(0)" ::: "memory");
        }
    }
    __syncthreads();
}

struct Frame {
    LAS unsigned char* lds;
    volatile LAS unsigned* MISC;
    gu32* ctl;
    int tid, lane, wave, G, bid;
    const float* in[17];
    float* out; unsigned char* ws;
};
enum { IN_X = 0, IN_ANORM, IN_AWIN, IN_AQN, IN_AKN, IN_AWOUT, IN_KVNORM, IN_KVW, IN_BNORM, IN_BWQ, IN_BWOUT, IN_FFNNORM, IN_DGU, IN_DDN, IN_ROUTER, IN_MGU, IN_MDN };

__device__ __forceinline__ void tr_item(const float* W, size_t ldw, int K, int k0, int csrc0, int cend, bf16* WT, int drow0, const float* gain, float scale, LAS float* scr, int lane) {
#pragma unroll 8
    for (int i = 0; i < 32; ++i) { const int kk = 2 * i + (lane >> 5); const int c = csrc0 + (lane & 31);
        const float v = (c < cend) ? W[(size_t)(k0 + kk) * ldw + c] : 0.f; const float g = gain ? gain[k0 + kk] * scale : scale; scr[kk * 33 + (lane & 31)] = v * g; }
    LDS_WAIT(); asm volatile("" ::: "memory");
    const int c8 = lane & 7;
#pragma unroll
    for (int j = 0; j < 4; ++j) { const int n = (lane >> 3) + 8 * j; const LAS float* s = scr + (8 * c8) * 33 + n;
        v4u o; o.x = pk2(s[0 * 33], s[1 * 33]); o.y = pk2(s[2 * 33], s[3 * 33]); o.z = pk2(s[4 * 33], s[5 * 33]); o.w = pk2(s[6 * 33], s[7 * 33]);
        *(GAS v4u*)(WT + (size_t)(drow0 + n) * K + k0 + 8 * c8) = o; }
    LDS_WAIT(); asm volatile("" ::: "memory");
}
__device__ __forceinline__ int gu_row(int c0) { return (c0 < FF) ? ((c0 >> 7) * 256 + (c0 & 127)) : (((c0 - FF) >> 7) * 256 + 128 + ((c0 - FF) & 127)); }
__device__ __forceinline__ void p0_prologue(Frame& F) {
    LAS float* scr = (LAS float*)(F.lds + F.wave * 16384);
    const int gw = F.wave * F.G + F.bid, NGW = F.G * NWAVES;
    unsigned char* ws = F.ws;
    constexpr int I_WIN = 16 * 64, I_TAIL = 16 * 3, I_SQ = 16 * 32, I_GU = 16 * 176, I_DN = 44 * 32, I_KV = 16 * 64;
    constexpr int NITEMS = I_WIN + I_TAIL + I_SQ + I_GU + I_DN + I_KV + I_SQ + I_SQ + NE * I_GU + NE * I_DN;
    for (int it = gw; it < NITEMS; it += NGW) {
        int r = it;
        if (r < I_WIN) { const int kb = r / 64, nb = r % 64; tr_item(F.in[IN_AWIN], A_IN, D, 64 * kb, 32 * nb, A_IN, (bf16*)(ws + WS_WIN), 32 * nb, F.in[IN_ANORM], 1.f, scr, F.lane); continue; } r -= I_WIN;
        if (r < I_TAIL) { const int kb = r / 3, nb = r % 3; tr_item(F.in[IN_AWIN], A_IN, D, 64 * kb, 2048 + 32 * nb, A_IN, (bf16*)(ws + WS_WTAIL), 32 * nb, F.in[IN_ANORM], 1.f, scr, F.lane); continue; } r -= I_TAIL;
        if (r < I_SQ) { const int kb = r / 32, nb = r % 32; tr_item(F.in[IN_AWOUT], D, D, 64 * kb, 32 * nb, D, (bf16*)(ws + WS_WOA), 32 * nb, nullptr, 1.f, scr, F.lane); continue; } r -= I_SQ;
        if (r < I_GU) { const int kb = r / 176, nb = r % 176; tr_item(F.in[IN_DGU], 2 * FF, D, 64 * kb, 32 * nb, 2 * FF, (bf16*)(ws + WS_WGU), gu_row(32 * nb), F.in[IN_FFNNORM], 1.f, scr, F.lane); continue; } r -= I_GU;
        if (r < I_DN) { const int kb = r / 32, nb = r % 32; tr_item(F.in[IN_DDN], D, FF, 64 * kb, 32 * nb, D, (bf16*)(ws + WS_WD), 32 * nb, nullptr, 1.f, scr, F.lane); continue; } r -= I_DN;
        if (r < I_KV) { const int kb = r / 64, nb = r % 64; tr_item(F.in[IN_KVW], 2 * D, D, 64 * kb, 32 * nb, 2 * D, (bf16*)(ws + WS_WKVQ), (nb < 32) ? 32 * nb : 1024 + 32 * nb, F.in[IN_KVNORM], 1.f, scr, F.lane); continue; } r -= I_KV;
        if (r < I_SQ) { const int kb = r / 32, nb = r % 32; tr_item(F.in[IN_BWQ], D, D, 64 * kb, 32 * nb, D, (bf16*)(ws + WS_WKVQ), 1024 + 32 * nb, F.in[IN_BNORM], SBSCALE, scr, F.lane); continue; } r -= I_SQ;
        if (r < I_SQ) { const int kb = r / 32, nb = r % 32; tr_item(F.in[IN_BWOUT], D, D, 64 * kb, 32 * nb, D, (bf16*)(ws + WS_WOB), 32 * nb, nullptr, 1.f, scr, F.lane); continue; } r -= I_SQ;
        if (r < NE * I_GU) { const int e = r / I_GU, rr = r % I_GU, kb = rr / 176, nb = rr % 176;
            tr_item(F.in[IN_MGU] + (size_t)e * D * 2 * FF, 2 * FF, D, 64 * kb, 32 * nb, 2 * FF, (bf16*)(ws + WS_WGUM), e * 2 * FF + gu_row(32 * nb), F.in[IN_FFNNORM] + D, 1.f, scr, F.lane); continue; } r -= NE * I_GU;
        { const int e = r / I_DN, rr = r % I_DN, kb = rr / 32, nb = rr % 32;
            tr_item(F.in[IN_MDN] + (size_t)e * FF * D, D, FF, 64 * kb, 32 * nb, D, (bf16*)(ws + WS_WDM), e * D + 32 * nb, nullptr, 1.f, scr, F.lane); }
    }
    const float* x = F.in[IN_X]; bf16* XB = (bf16*)(ws + WS_XB); float* SS0 = (float*)(ws + WS_SS0);
    for (int m = gw; m < M; m += NGW) {
        const GAS f32x4* xr = (const GAS f32x4*)(x + (size_t)m * D) + F.lane; f32x4 v[4]; float s = 0.f;
#pragma unroll
        for (int j = 0; j < 4; ++j) { v[j] = xr[64 * j]; s += (v[j].x * v[j].x + v[j].y * v[j].y) + (v[j].z * v[j].z + v[j].w * v[j].w); }
        s = wave_sum(s);
        GAS unsigned long long* o8 = (GAS unsigned long long*)(XB + (size_t)m * D) + F.lane;
#pragma unroll
        for (int j = 0; j < 4; ++j) o8[64 * j] = (unsigned long long)pk2(v[j].x, v[j].y) | ((unsigned long long)pk2(v[j].z, v[j].w) << 32);
        if (F.lane < 16) SS0[(size_t)m * 16 + F.lane] = (F.lane == 0) ? s : 0.f;
    }
}

__device__ __forceinline__ void rope8(float (&y)[8], bool isx1, bool isx2, int i0, int pshift, float pos, const float* inv) {
#pragma unroll
    for (int e = 0; e < 8; ++e) {
        const float other = __shfl_xor(y[e], pshift);
        if (isx1 || isx2) { float c, s; sincos_acc(pos * inv[i0 + e], c, s); y[e] = isx1 ? (y[e] * c - other * s) : (y[e] * c + other * s); }
    }
}
__device__ __forceinline__ void unpack8(const v4u w, float (&y)[8]) { y[0] = bflo(w.x); y[1] = bfhi(w.x); y[2] = bflo(w.y); y[3] = bfhi(w.y); y[4] = bflo(w.z); y[5] = bfhi(w.z); y[6] = bflo(w.w); y[7] = bfhi(w.w); }
__device__ __forceinline__ v4u pack8(const float (&y)[8]) { v4u o; o.x = pk2(y[0], y[1]); o.y = pk2(y[2], y[3]); o.z = pk2(y[4], y[5]); o.w = pk2(y[6], y[7]); return o; }
__device__ __forceinline__ void p2_post(Frame& F) {
    unsigned char* ws = F.ws; const int lane = F.lane;
    const bf16* PROJ = (const bf16*)(ws + WS_PROJ); const bf16* XB = (const bf16*)(ws + WS_XB); const bf16* WT = (const bf16*)(ws + WS_WTAIL); const float* SS0 = (const float*)(ws + WS_SS0);
    bf16* QF = (bf16*)(ws + WS_QF); bf16* KVF = (bf16*)(ws + WS_KVF); bf16* QIF = (bf16*)(ws + WS_QIF); bf16* KIF = (bf16*)(ws + WS_KIF); float* WIF = (float*)(ws + WS_WIF);
    const float* qnw = F.in[IN_AQN]; const float* knw = F.in[IN_AKN];
    const int gw = F.wave * F.G + F.bid, NGW = F.G * NWAVES;
    for (int task = gw; task < M / 16; task += NGW) {
        const int row0 = task * 16;
        f32x4 acc[5];
#pragma unroll
        for (int c = 0; c < 5; ++c) acc[c] = (f32x4){0.f, 0.f, 0.f, 0.f};
        const bf16* ap = XB + (size_t)(row0 + (lane & 15)) * D + 8 * (lane >> 4);
        const bf16* bp = WT + (size_t)(lane & 15) * D + 8 * (lane >> 4);
#pragma unroll 4
        for (int j = 0; j < 32; ++j) {
            const bf16x8 a = *(const bf16x8*)(ap + 32 * j);
#pragma unroll
            for (int c = 0; c < 5; ++c) { const bf16x8 b = *(const bf16x8*)(bp + (size_t)(16 * c) * D + 32 * j); acc[c] = __builtin_amdgcn_mfma_f32_16x16x32_bf16(a, b, acc[c], 0, 0, 0); }
        }
#pragma unroll
        for (int reg = 0; reg < 4; ++reg) {
            const int row = row0 + 4 * (lane >> 4) + reg; const float rs = pg8::rstd16(SS0 + (size_t)row * 16); const float pos = (float)(row & (SEQ - 1));
            const int d = lane & 15;
            float v0 = acc[0][reg] * rs; const float other = __shfl_xor(v0, 8);
            { float c, s; sincos_acc(pos * INV_I[d & 7], c, s); v0 = (d < 8) ? (v0 * c - other * s) : (v0 * c + other * s); }
            KIF[(size_t)row * IDX + d] = (bf16)f2bf(v0);
#pragma unroll
            for (int c = 1; c < 4; ++c) KIF[(size_t)row * IDX + 16 * c + d] = (bf16)f2bf(acc[c][reg] * rs);
            if (d < 8) WIF[(size_t)row * 8 + d] = acc[4][reg] * rs * WISCALE;
        }
        for (int r = 0; r < 16; ++r) {
            const int row = row0 + r, b = row >> 13, t = row & (SEQ - 1); const float pos = (float)t;
            const bf16* pr = PROJ + (size_t)row * 2048 + 8 * lane;
            v4u w[4];
#pragma unroll
            for (int j = 0; j < 4; ++j) w[j] = *(const v4u*)(pr + 512 * j);
#pragma unroll
            for (int j = 0; j < 2; ++j) {
                float y[8]; unpack8(w[j], y); float ss = 0.f;
#pragma unroll
                for (int e = 0; e < 8; ++e) ss += y[e] * y[e];
                ss += __shfl_xor(ss, 1); ss += __shfl_xor(ss, 2); ss += __shfl_xor(ss, 4); ss += __shfl_xor(ss, 8);
                const float rs = 1.0f / sqrtf(ss * (1.0f / 128.0f) + 1e-6f); const int c8 = (lane & 15) * 8;
#pragma unroll
                for (int e = 0; e < 8; ++e) y[e] = y[e] * rs * qnw[c8 + e];
                rope8(y, c8 < 16, c8 >= 16 && c8 < 32, c8 & 15, 2, pos, INV_Q);
#pragma unroll
                for (int e = 0; e < 8; ++e) y[e] *= QSCALE;
                *(v4u*)(QF + (size_t)row * D + 512 * j + 8 * lane) = pack8(y);
            }
            {
                float y[8]; unpack8(w[2], y); float ss = 0.f;
#pragma unroll
                for (int e = 0; e < 8; ++e) ss += y[e] * y[e];
                ss += __shfl_xor(ss, 1); ss += __shfl_xor(ss, 2); ss += __shfl_xor(ss, 4); ss += __shfl_xor(ss, 8);
                const bool isk = lane < 32; const float rs = 1.0f / sqrtf(ss * (1.0f / 128.0f) + 1e-6f); const int c8 = (lane & 15) * 8;
                if (isk) {
#pragma unroll
                    for (int e = 0; e < 8; ++e) y[e] = y[e] * rs * knw[c8 + e];
                }
                rope8(y, isk && c8 < 16, isk && c8 >= 16 && c8 < 32, c8 & 15, 2, pos, INV_Q);
                const int kvh = (lane >> 4) & 1;
                *(v4u*)(KVF + ((size_t)(b * NKV + kvh) * SEQ + t) * 256 + (isk ? 0 : 128) + c8) = pack8(y);
            }
            {
                float y[8]; unpack8(w[3], y); const int c8 = (lane & 7) * 8;
                rope8(y, c8 == 0, c8 == 8, 0, 1, pos, INV_I);
                *(v4u*)(QIF + (size_t)row * 512 + 8 * lane) = pack8(y);
            }
        }
    }
}

__device__ __forceinline__ unsigned f2key(float f) { const unsigned u = __float_as_uint(f); return (u & 0x80000000u) ? ~u : (u | 0x80000000u); }
__device__ __forceinline__ void p3_index_naive(Frame& F) {
    unsigned char* ws = F.ws; const int tid = F.tid, lane = F.lane, wave = F.wave;
    const bf16* QIF = (const bf16*)(ws + WS_QIF); const bf16* KIF = (const bf16*)(ws + WS_KIF); const float* WIF = (const float*)(ws + WS_WIF); int* SEL = (int*)(ws + WS_SEL);
    LAS unsigned* keys = (LAS unsigned*)F.lds;
    LAS float* qis = (LAS float*)(F.lds + 32768);
    LAS float* wl = (LAS float*)(F.lds + 32768 + 2048);
    LAS unsigned* hist = (LAS unsigned*)(F.lds + 36864);
    LAS unsigned* ctl = (LAS unsigned*)(F.lds + 36864 + 1024);
    LAS unsigned* wcnt = (LAS unsigned*)(F.lds + 36864 + 1024 + 64);
    for (int qi = F.bid; qi < M; qi += F.G) {
        const int row = qi, b = row >> 13, t = row & (SEQ - 1), n = t + 1;
        int* sel = SEL + (size_t)row * TOPK;
        if (n <= TOPK) { if (tid < TOPK) sel[tid] = tid < n ? tid : 0; continue; }
        qis[tid] = __uint_as_float((unsigned)QIF[(size_t)row * 512 + tid] << 16);
        if (tid < 8) wl[tid] = WIF[(size_t)row * 8 + tid];
        __syncthreads();
        for (int s = tid; s < n; s += 512) {
            const v4u* kp = (const v4u*)(KIF + ((size_t)(b << 13) + s) * IDX);
            float kf[64];
#pragma unroll
            for (int j = 0; j < 8; ++j) { const v4u w = kp[j]; kf[8 * j] = bflo(w.x); kf[8 * j + 1] = bfhi(w.x); kf[8 * j + 2] = bflo(w.y); kf[8 * j + 3] = bfhi(w.y); kf[8 * j + 4] = bflo(w.z); kf[8 * j + 5] = bfhi(w.z); kf[8 * j + 6] = bflo(w.w); kf[8 * j + 7] = bfhi(w.w); }
            float sc = 0.f;
#pragma unroll
            for (int h = 0; h < 8; ++h) { float d = 0.f; asm volatile("" ::: "memory");
#pragma unroll
                for (int dd = 0; dd < 64; ++dd) d += qis[h * 64 + dd] * kf[dd];
                sc += wl[h] * fmaxf(d, 0.f); }
            keys[s] = f2key(sc + 0.0f);
        }
        __syncthreads();
        unsigned prefix = 0u, mask = 0u, need = TOPK;
        for (int pass = 0; pass < 4; ++pass) {
            const int shift = 24 - 8 * pass;
            if (tid < 256) hist[tid] = 0u;
            __syncthreads();
            for (int s = tid; s < n; s += 512) { const unsigned k = keys[s]; if ((k & mask) == prefix) __hip_atomic_fetch_add(&hist[(k >> shift) & 255u], 1u, __ATOMIC_RELAXED, __HIP_MEMORY_SCOPE_WORKGROUP); }
            __syncthreads();
            if (tid < 64) {
                const unsigned h0 = hist[4 * lane], h1 = hist[4 * lane + 1], h2 = hist[4 * lane + 2], h3 = hist[4 * lane + 3]; const unsigned tot = h0 + h1 + h2 + h3;
                unsigned incl = tot;
#pragma unroll
                for (int o = 1; o < 64; o <<= 1) { const unsigned v = __shfl_down(incl, o); if (lane + o < 64) incl += v; }
                const unsigned above = incl - tot;
                if (above < need && need <= above + tot) {
                    unsigned a = above; unsigned bin;
                    if (a + h3 >= need) bin = 3; else { a += h3; if (a + h2 >= need) bin = 2; else { a += h2; if (a + h1 >= need) bin = 1; else { a += h1; bin = 0; } } }
                    ctl[0] = 4 * lane + bin; ctl[1] = need - a;
                }
            }
            __syncthreads();
            prefix |= ctl[0] << shift; mask |= 255u << shift; need = ctl[1];
            __syncthreads();
        }
        const unsigned thr = prefix, n_gt = TOPK - need;
        unsigned base_gt = 0u, base_eq = 0u;
        for (int s0 = 0; s0 < n; s0 += 512) {
            const int s = s0 + tid; const unsigned k = s < n ? keys[s] : 0u; const bool gt = (s < n) && (k > thr); const bool eq = (s < n) && (k == thr);
            const unsigned long long bg = __ballot(gt), be = __ballot(eq); const unsigned long long lt = (1ull << lane) - 1ull;
            const unsigned rg = __popcll(bg & lt), re = __popcll(be & lt);
            if (lane == 0) { wcnt[wave] = __popcll(bg); wcnt[8 + wave] = __popcll(be); }
            __syncthreads();
            unsigned og = base_gt, oe = base_eq, tg = 0u, te = 0u;
#pragma unroll
            for (int w = 0; w < 8; ++w) { const unsigned cg = wcnt[w], ce = wcnt[8 + w]; if (w < wave) { og += cg; oe += ce; } tg += cg; te += ce; }
            if (gt) sel[og + rg] = s;
            if (eq && oe + re < need) sel[n_gt + oe + re] = s;
            base_gt += tg; base_eq += te;
            __syncthreads();
        }
    }
}

__device__ __forceinline__ void p4_dsa_naive(Frame& F) {
    unsigned char* ws = F.ws; const int lane = F.lane;
    const bf16* QF = (const bf16*)(ws + WS_QF); const bf16* KVF = (const bf16*)(ws + WS_KVF); const int* SEL = (const int*)(ws + WS_SEL); bf16* AO = (bf16*)(ws + WS_AO);
    LAS f32x4* sc = (LAS f32x4*)(F.lds + F.wave * 4096);
    const int gw = F.wave * F.G + F.bid, NGW = F.G * NWAVES;
    for (int p = gw; p < 2 * M; p += NGW) {
        const int row = p >> 1, kvh = p & 1, b = row >> 13, t = row & (SEQ - 1); const int cnt = (t + 1 < TOPK) ? (t + 1) : TOPK;
        const int* sel = SEL + (size_t)row * TOPK;
        int myidx[4];
#pragma unroll
        for (int j = 0; j < 4; ++j) myidx[j] = sel[lane + 64 * j];
        float qa[4], qb[4];
#pragma unroll
        for (int g = 0; g < 4; ++g) { const unsigned w = *(const unsigned*)(QF + (size_t)row * D + (kvh * 4 + g) * HD + 2 * lane); qa[g] = bflo(w); qb[g] = bfhi(w); }
        const bf16* kvb = KVF + (size_t)(b * NKV + kvh) * SEQ * 256 + 2 * lane;
#pragma unroll
        for (int j = 0; j < 4; ++j) {
            const int lim = cnt - 64 * j < 64 ? cnt - 64 * j : 64;
            for (int i = 0; i < lim; ++i) {
                const int key = __builtin_amdgcn_readlane(myidx[j], i);
                const unsigned w = *(const unsigned*)(kvb + (size_t)key * 256); const float k0 = bflo(w), k1 = bfhi(w);
                f32x4 d;
                d[0] = wave_sum(qa[0] * k0 + qb[0] * k1); d[1] = wave_sum(qa[1] * k0 + qb[1] * k1); d[2] = wave_sum(qa[2] * k0 + qb[2] * k1); d[3] = wave_sum(qa[3] * k0 + qb[3] * k1);
                if (lane == 0) sc[64 * j + i] = d;
            }
        }
        float mx[4] = {-INFINITY, -INFINITY, -INFINITY, -INFINITY};
#pragma unroll
        for (int j = 0; j < 4; ++j) { const int pp = lane + 64 * j; if (pp < cnt) { const f32x4 v = sc[pp];
#pragma unroll
            for (int g = 0; g < 4; ++g) mx[g] = fmaxf(mx[g], v[g]); } }
#pragma unroll
        for (int g = 0; g < 4; ++g) mx[g] = wave_max(mx[g]);
        float sm[4] = {0.f, 0.f, 0.f, 0.f};
#pragma unroll
        for (int j = 0; j < 4; ++j) { const int pp = lane + 64 * j; if (pp < cnt) { f32x4 v = sc[pp];
#pragma unroll
            for (int g = 0; g < 4; ++g) { v[g] = __builtin_amdgcn_exp2f(v[g] - mx[g]); sm[g] += v[g]; }
            sc[pp] = v; } }
#pragma unroll
        for (int g = 0; g < 4; ++g) sm[g] = 1.0f / wave_sum(sm[g]);
        float oa[4] = {0.f, 0.f, 0.f, 0.f}, ob[4] = {0.f, 0.f, 0.f, 0.f};
#pragma unroll
        for (int j = 0; j < 4; ++j) {
            const int lim = cnt - 64 * j < 64 ? cnt - 64 * j : 64;
            for (int i = 0; i < lim; ++i) {
                const int key = __builtin_amdgcn_readlane(myidx[j], i);
                const unsigned w = *(const unsigned*)(kvb + (size_t)key * 256 + 128); const float v0 = bflo(w), v1 = bfhi(w);
                const f32x4 pr = sc[64 * j + i];
#pragma unroll
                for (int g = 0; g < 4; ++g) { oa[g] += pr[g] * v0; ob[g] += pr[g] * v1; }
            }
        }
#pragma unroll
        for (int g = 0; g < 4; ++g) *(unsigned*)(AO + (size_t)row * D + (kvh * 4 + g) * HD + 2 * lane) = pk2(oa[g] * sm[g], ob[g] * sm[g]);
    }
}

typedef short v4i16_t __attribute__((ext_vector_type(4)));
typedef int v4i __attribute__((ext_vector_type(4)));
__device__ __forceinline__ v4i16_t tr16(LAS unsigned char* p) { return __builtin_amdgcn_ds_read_tr16_b64_v4i16((LAS v4i16_t*)p); }
__device__ __forceinline__ void p4_dsa(Frame& F) {
    unsigned char* ws = F.ws; const int lane = F.lane, nh = lane & 15, kg = lane >> 4;
    const bf16* QF = (const bf16*)(ws + WS_QF); const bf16* KVF = (const bf16*)(ws + WS_KVF); const int* SEL = (const int*)(ws + WS_SEL); bf16* AO = (bf16*)(ws + WS_AO);
    LAS unsigned char* wl = F.lds + F.wave * 10240; LAS int* selw = (LAS int*)wl; LAS unsigned char* vb = wl + 1024;
    const int gw = F.wave * F.G + F.bid, NGW = F.G * NWAVES;
    LAS unsigned char* trp = vb + (4 * kg + ((lane >> 2) & 3)) * 288 + 8 * (lane & 3);
    for (int row = gw; row < M; row += NGW) {
        const int b = row >> 13, t = row & (SEQ - 1); const int cnt = (t + 1 < TOPK) ? (t + 1) : TOPK;
        *(LAS v4i*)(selw + 4 * lane) = *(const v4i*)(SEL + (size_t)row * TOPK + 4 * lane);
#pragma unroll 1
        for (int kvh = 0; kvh < NKV; ++kvh) {
            const bf16* kvb = KVF + (size_t)(b * NKV + kvh) * SEQ * 256;
            const bf16* qp = QF + (size_t)row * D + (kvh * 4 + (nh & 3)) * HD + 32 * kg;
            bf16x8 qf[4];
#pragma unroll
            for (int s = 0; s < 4; ++s) { qf[s] = *(const bf16x8*)(qp + 8 * s); if (nh >= 4) qf[s] = (bf16x8){0, 0, 0, 0, 0, 0, 0, 0}; }
            f32x4 S[16];
#pragma unroll
            for (int T = 0; T < 16; ++T) {
                const int key = selw[16 * T + nh]; const bf16* kp = kvb + (size_t)key * 256 + 32 * kg;
                const bf16x8 k0 = *(const bf16x8*)(kp), k1 = *(const bf16x8*)(kp + 8), k2 = *(const bf16x8*)(kp + 16), k3 = *(const bf16x8*)(kp + 24);
                f32x4 a = (f32x4){0.f, 0.f, 0.f, 0.f};
                a = __builtin_amdgcn_mfma_f32_16x16x32_bf16(k0, qf[0], a, 0, 0, 0); a = __builtin_amdgcn_mfma_f32_16x16x32_bf16(k1, qf[1], a, 0, 0, 0);
                a = __builtin_amdgcn_mfma_f32_16x16x32_bf16(k2, qf[2], a, 0, 0, 0); a = __builtin_amdgcn_mfma_f32_16x16x32_bf16(k3, qf[3], a, 0, 0, 0);
                S[T] = a;
            }
            float mx = -INFINITY;
#pragma unroll
            for (int T = 0; T < 16; ++T)
#pragma unroll
                for (int r = 0; r < 4; ++r) { const float v = (16 * T + 4 * kg + r < cnt) ? S[T][r] : -INFINITY; S[T][r] = v; mx = fmaxf(mx, v); }
            mx = fmaxf(mx, __shfl_xor(mx, 16)); mx = fmaxf(mx, __shfl_xor(mx, 32));
            float sum = 0.f;
#pragma unroll
            for (int T = 0; T < 16; ++T)
#pragma unroll
                for (int r = 0; r < 4; ++r) { const float e = __builtin_amdgcn_exp2f(S[T][r] - mx); S[T][r] = e; sum += e; }
            sum += __shfl_xor(sum, 16); sum += __shfl_xor(sum, 32);
            f32x4 O[8];
#pragma unroll
            for (int d = 0; d < 8; ++d) O[d] = (f32x4){0.f, 0.f, 0.f, 0.f};
            v4u g[8];
#pragma unroll
            for (int i = 0; i < 8; ++i) { const int key = selw[4 * i + kg]; g[i] = *(const v4u*)(kvb + (size_t)key * 256 + 128 + 8 * nh); }
#pragma unroll
            for (int c = 0; c < 8; ++c) {
#pragma unroll
                for (int i = 0; i < 8; ++i) *(LAS v4u*)(vb + (4 * i + kg) * 288 + nh * 16) = g[i];
                if (c < 7) {
#pragma unroll
                    for (int i = 0; i < 8; ++i) { const int key = selw[32 * (c + 1) + 4 * i + kg]; g[i] = *(const v4u*)(kvb + (size_t)key * 256 + 128 + 8 * nh); }
                }
                v4u pw; pw.x = pg8::cvt_pk_bf16(S[2 * c][0], S[2 * c][1]); pw.y = pg8::cvt_pk_bf16(S[2 * c][2], S[2 * c][3]); pw.z = pg8::cvt_pk_bf16(S[2 * c + 1][0], S[2 * c + 1][1]); pw.w = pg8::cvt_pk_bf16(S[2 * c + 1][2], S[2 * c + 1][3]);
                const bf16x8 pa = __builtin_bit_cast(bf16x8, pw);
#pragma unroll
                for (int d = 0; d < 8; ++d) {
                    const v4i16_t lo = tr16(trp + 32 * d), hi4 = tr16(trp + 16 * 288 + 32 * d);
                    const bf16x8 vfr = (bf16x8){lo[0], lo[1], lo[2], lo[3], hi4[0], hi4[1], hi4[2], hi4[3]};
                    O[d] = __builtin_amdgcn_mfma_f32_16x16x32_bf16(pa, vfr, O[d], 0, 0, 0);
                }
            }
            const float i0 = 1.0f / __builtin_bit_cast(float, __builtin_amdgcn_readlane(__builtin_bit_cast(int, sum), 0)), i1 = 1.0f / __builtin_bit_cast(float, __builtin_amdgcn_readlane(__builtin_bit_cast(int, sum), 1));
            const float i2 = 1.0f / __builtin_bit_cast(float, __builtin_amdgcn_readlane(__builtin_bit_cast(int, sum), 2)), i3 = 1.0f / __builtin_bit_cast(float, __builtin_amdgcn_readlane(__builtin_bit_cast(int, sum), 3));
            LAS bf16* ost = (LAS bf16*)vb;
            if (kg == 0) {
#pragma unroll
                for (int d = 0; d < 8; ++d) { ost[0 * 128 + 16 * d + nh] = (bf16)f2bf(O[d][0] * i0); ost[1 * 128 + 16 * d + nh] = (bf16)f2bf(O[d][1] * i1); ost[2 * 128 + 16 * d + nh] = (bf16)f2bf(O[d][2] * i2); ost[3 * 128 + 16 * d + nh] = (bf16)f2bf(O[d][3] * i3); }
            }
            const v4u ov = *(LAS v4u*)(vb + 16 * lane);
            *(v4u*)(AO + (size_t)row * D + (kvh * 4 + kg) * HD + 8 * nh) = ov;
        }
    }
}

__device__ __forceinline__ void p9_sb(Frame& F) {
    unsigned char* ws = F.ws; const int lane = F.lane, n = lane & 31, hi = lane >> 5;
    const bf16* KQ = (const bf16*)(ws + WS_KQ); const bf16* VT = (const bf16*)(ws + WS_VT); bf16* AO = (bf16*)(ws + WS_AO);
    const int gw = F.wave * F.G + F.bid, NGW = F.G * NWAVES;
    const int koff = 16 * (n >> 4) + 8 * ((n >> 2) & 1) + 4 * ((n >> 3) & 1) + (n & 3);
    constexpr float LOG2E = 1.4426950408889634f, LN2 = 0.6931471805599453f;
    for (int u = gw; u < (M / 32) * NH; u += NGW) {
        const int h = u & 7, blk = u >> 3, b = blk >> 8, qb = blk & 255, q0 = 32 * qb, t = q0 + n;
        const bf16* qp = KQ + (size_t)(b * SEQ + q0 + n) * 2048 + 1024 + h * HD + 64 * hi;
        bf16x8 qf[8];
#pragma unroll
        for (int s = 0; s < 8; ++s) qf[s] = *(const bf16x8*)(qp + 8 * s);
        f32x16 o[4];
#pragma unroll
        for (int mt = 0; mt < 4; ++mt)
#pragma unroll
            for (int r = 0; r < 16; ++r) o[mt][r] = 0.f;
        float C = 0.f;
        for (int kb = qb; kb >= 0; --kb) {
            const int k0 = 32 * kb;
            const bf16* kp = KQ + (size_t)(b * SEQ + k0 + koff) * 2048 + h * HD + 64 * hi;
            bf16x8 kf[8];
#pragma unroll
            for (int s = 0; s < 8; ++s) kf[s] = *(const bf16x8*)(kp + 8 * s);
            bf16x8 vf[4][2];
#pragma unroll
            for (int mt = 0; mt < 4; ++mt)
#pragma unroll
                for (int sp = 0; sp < 2; ++sp) vf[mt][sp] = *(const bf16x8*)(VT + (size_t)(h * HD + 32 * mt + n) * M + b * SEQ + k0 + 16 * sp + 8 * hi);
            f32x16 z;
#pragma unroll
            for (int r = 0; r < 16; ++r) z[r] = 0.f;
#pragma unroll
            for (int s = 0; s < 8; ++s) z = __builtin_amdgcn_mfma_f32_32x32x16_bf16(kf[s], qf[s], z, 0, 0, 0);
            float lk[16], lb[16];
#pragma unroll
            for (int r = 0; r < 16; ++r) {
                const int key = k0 + ((r < 8) ? (8 * hi + r) : (16 + 8 * hi + (r - 8)));
                const float zz = z[r]; const float L = __builtin_amdgcn_logf(1.0f + __builtin_amdgcn_exp2f(-fabsf(zz) * LOG2E)) * LN2;
                const bool valid = key < t;
                lk[r] = valid ? (-fmaxf(zz, 0.f) - L) : 0.f;
                lb[r] = valid ? (fminf(zz, 0.f) - L) : -INFINITY;
            }
            float suf[16];
            suf[7] = 0.f; suf[15] = 0.f;
#pragma unroll
            for (int i = 6; i >= 0; --i) { suf[i] = suf[i + 1] + lk[i + 1]; suf[8 + i] = suf[9 + i] + lk[9 + i]; }
            const float T0 = suf[0] + lk[0], T1 = suf[8] + lk[8];
            const float P0 = __shfl_xor(T0, 32), P1 = __shfl_xor(T1, 32);
            const float base1 = C + (hi ? 0.f : P1), base0 = C + (hi ? (T1 + P1) : (P0 + T1 + P1));
            unsigned pw[8];
#pragma unroll
            for (int r = 0; r < 16; r += 2) {
                const float a0 = __builtin_amdgcn_exp2f((lb[r] + ((r < 8) ? base0 : base1) + suf[r]) * LOG2E), a1 = __builtin_amdgcn_exp2f((lb[r + 1] + ((r < 8) ? base0 : base1) + suf[r + 1]) * LOG2E);
                pw[r >> 1] = pg8::cvt_pk_bf16(a0, a1);
            }
            C += (T0 + T1) + (P0 + P1);
            const bf16x8 pa0 = __builtin_bit_cast(bf16x8, (v4u){pw[0], pw[1], pw[2], pw[3]}), pa1 = __builtin_bit_cast(bf16x8, (v4u){pw[4], pw[5], pw[6], pw[7]});
#pragma unroll
            for (int mt = 0; mt < 4; ++mt) { o[mt] = __builtin_amdgcn_mfma_f32_32x32x16_bf16(vf[mt][0], pa0, o[mt], 0, 0, 0); o[mt] = __builtin_amdgcn_mfma_f32_32x32x16_bf16(vf[mt][1], pa1, o[mt], 0, 0, 0); }
            if (__all(C < -44.0f)) break;
        }
        bf16* op = AO + (size_t)(b * SEQ + q0 + n) * D + h * HD + 4 * hi;
#pragma unroll
        for (int mt = 0; mt < 4; ++mt)
#pragma unroll
            for (int g = 0; g < 4; ++g) { v2u w; w.x = pg8::cvt_pk_bf16(o[mt][4 * g], o[mt][4 * g + 1]); w.y = pg8::cvt_pk_bf16(o[mt][4 * g + 2], o[mt][4 * g + 3]); *(v2u*)(op + 32 * mt + 8 * g) = w; }
    }
}

__device__ __forceinline__ void p11_router(Frame& F) {
    unsigned char* ws = F.ws; const int tid = F.tid, lane = F.lane, wave = F.wave;
    const float* H = (const float*)(ws + WS_H); const float* gn = F.in[IN_FFNNORM] + D; const float* Wr = F.in[IN_ROUTER];
    int* TOPE = (int*)(ws + WS_RT); int* POS = (int*)(ws + WS_RT + 128 * 1024); float* GATE = (float*)(ws + WS_RT + 256 * 1024); float* RSTD3 = (float*)(ws + WS_RT + 384 * 1024);
    LAS unsigned* lcnt = (LAS unsigned*)F.lds;
    LAS unsigned* gb = (LAS unsigned*)(F.lds + 64);
    LAS int* ltok = (LAS int*)(F.lds + 128);
    LAS float* lgt = (LAS float*)(F.lds + 128 + 1024);
    for (int chunk = F.bid; chunk < M / 64; chunk += F.G) {
        if (tid < 8) lcnt[tid] = 0u;
        __syncthreads();
        for (int r = 0; r < 8; ++r) {
            const int row = chunk * 64 + wave * 8 + r;
            const GAS f32x4* xr = (const GAS f32x4*)(H + (size_t)row * D) + lane; f32x4 v[4]; float ss = 0.f;
#pragma unroll
            for (int j = 0; j < 4; ++j) { v[j] = xr[64 * j]; ss += (v[j].x * v[j].x + v[j].y * v[j].y) + (v[j].z * v[j].z + v[j].w * v[j].w); }
            ss = wave_sum(ss); const float rs = 1.0f / sqrtf(ss * (1.0f / 1024.0f) + 1e-6f);
            float lg[8] = {0.f, 0.f, 0.f, 0.f, 0.f, 0.f, 0.f, 0.f};
#pragma unroll
            for (int j = 0; j < 4; ++j)
#pragma unroll
                for (int i = 0; i < 4; ++i) { const int k = 256 * j + 4 * lane + i; const float xv = v[j][i] * gn[k]; const f32x4 w0 = *(const f32x4*)(Wr + (size_t)k * 8), w1 = *(const f32x4*)(Wr + (size_t)k * 8 + 4);
                    lg[0] += xv * w0[0]; lg[1] += xv * w0[1]; lg[2] += xv * w0[2]; lg[3] += xv * w0[3]; lg[4] += xv * w1[0]; lg[5] += xv * w1[1]; lg[6] += xv * w1[2]; lg[7] += xv * w1[3]; }
#pragma unroll
            for (int e = 0; e < 8; ++e) lg[e] = wave_sum(lg[e]) * rs;
            int i1 = 0; float l1 = lg[0];
#pragma unroll
            for (int e = 1; e < 8; ++e) if (lg[e] > l1) { l1 = lg[e]; i1 = e; }
            int i2 = -1; float l2 = -INFINITY;
#pragma unroll
            for (int e = 0; e < 8; ++e) if (e != i1 && lg[e] > l2) { l2 = lg[e]; i2 = e; }
            const float g1 = 1.0f / (1.0f + __expf(l2 - l1)), g2 = 1.0f - g1;
            if (lane == 0) {
                const unsigned p1 = __hip_atomic_fetch_add(&lcnt[i1], 1u, __ATOMIC_RELAXED, __HIP_MEMORY_SCOPE_WORKGROUP), p2 = __hip_atomic_fetch_add(&lcnt[i2], 1u, __ATOMIC_RELAXED, __HIP_MEMORY_SCOPE_WORKGROUP);
                const int ti = wave * 8 + r; ltok[ti * 4 + 0] = i1; ltok[ti * 4 + 1] = i2; ltok[ti * 4 + 2] = (int)p1; ltok[ti * 4 + 3] = (int)p2;
                lgt[ti * 4 + 0] = g1; lgt[ti * 4 + 1] = g2; lgt[ti * 4 + 2] = rs;
            }
        }
        __syncthreads();
        if (tid < 8) gb[tid] = __hip_atomic_fetch_add(F.ctl + CW_CNT + tid, lcnt[tid], RLX_AGENT);
        __syncthreads();
        if (tid < 64) { const int row = chunk * 64 + tid; const int e1 = ltok[tid * 4], e2 = ltok[tid * 4 + 1];
            TOPE[row * 2] = e1; TOPE[row * 2 + 1] = e2; POS[row * 2] = (int)gb[e1] + ltok[tid * 4 + 2]; POS[row * 2 + 1] = (int)gb[e2] + ltok[tid * 4 + 3];
            GATE[row * 2] = lgt[tid * 4]; GATE[row * 2 + 1] = lgt[tid * 4 + 1]; RSTD3[row] = lgt[tid * 4 + 2]; }
        __syncthreads();
    }
}
__device__ __forceinline__ void moe_bases(Frame& F, int (&tb)[9]) {
    int acc = 0;
#pragma unroll
    for (int e = 0; e < 8; ++e) { tb[e] = acc; const unsigned c = __hip_atomic_load(F.ctl + CW_CNT + e, RLX_AGENT); acc += (int)((c + 255u) >> 8); }
    tb[8] = acc;
}
__device__ __forceinline__ void p12_permute(Frame& F) {
    unsigned char* ws = F.ws; const int lane = F.lane;
    const int* TOPE = (const int*)(ws + WS_RT); const int* POS = (const int*)(ws + WS_RT + 128 * 1024); const float* GATE = (const float*)(ws + WS_RT + 256 * 1024); const float* RSTD3 = (const float*)(ws + WS_RT + 384 * 1024);
    int* SLOT = (int*)(ws + WS_RT + 512 * 1024); float* RSTDS = (float*)(ws + WS_RSTDS); float* GATES = (float*)(ws + WS_GATES);
    const bf16* XB = (const bf16*)(ws + WS_XB); bf16* XP = (bf16*)(ws + WS_XPERM);
    int tb[9]; moe_bases(F, tb);
    const int gw = F.wave * F.G + F.bid, NGW = F.G * NWAVES;
    for (int i = gw; i < 2 * M; i += NGW) {
        const int row = i >> 1; const int e = TOPE[i]; int base = 0;
#pragma unroll
        for (int k = 0; k < 8; ++k) base = (e == k) ? tb[k] : base;
        const int slot = base * 256 + POS[i];
        const v4u* src = (const v4u*)(XB + (size_t)row * D) + lane; v4u* dst = (v4u*)(XP + (size_t)slot * D) + lane;
        const v4u a = src[0], c = src[64]; dst[0] = a; dst[64] = c;
        if (lane == 0) { SLOT[i] = slot; RSTDS[slot] = RSTD3[row]; GATES[slot] = GATE[i]; }
    }
}
__device__ __forceinline__ void p15_combine(Frame& F) {
    unsigned char* ws = F.ws; const int lane = F.lane;
    const float* H = (const float*)(ws + WS_H); const bf16* Y = (const bf16*)(ws + WS_Y); const int* SLOT = (const int*)(ws + WS_RT + 512 * 1024);
    const int gw = F.wave * F.G + F.bid, NGW = F.G * NWAVES;
    for (int row = gw; row < M; row += NGW) {
        const int s1 = SLOT[row * 2], s2 = SLOT[row * 2 + 1];
        const GAS f32x4* hr = (const GAS f32x4*)(H + (size_t)row * D) + lane; GAS f32x4* orow = (GAS f32x4*)(F.out + (size_t)row * D) + lane;
        const GAS v2u* y1 = (const GAS v2u*)(Y + (size_t)s1 * D) + lane; const GAS v2u* y2 = (const GAS v2u*)(Y + (size_t)s2 * D) + lane;
#pragma unroll
        for (int j = 0; j < 4; ++j) { const f32x4 h = hr[64 * j]; const v2u a = y1[64 * j], c = y2[64 * j]; f32x4 o;
            o.x = h.x + (bflo(a.x) + bflo(c.x)); o.y = h.y + (bfhi(a.x) + bfhi(c.x)); o.z = h.z + (bflo(a.y) + bflo(c.y)); o.w = h.w + (bfhi(a.y) + bfhi(c.y)); orow[64 * j] = o; }
    }
}

constexpr int N_PHASES = 16;
#ifndef MK_ONE_LAUNCH
#define MK_ONE_LAUNCH 1
#endif
struct Args { const float* in[17]; float* out; unsigned char* ws; int ph_lo, ph_hi; };
__global__ void __launch_bounds__(NWAVES * 64, 2) yoco_fwd(Args args) {
    extern __shared__ __attribute__((aligned(16))) unsigned char lds[];
    Frame F;
    F.lds = (LAS unsigned char*)lds; F.MISC = (volatile LAS unsigned*)(F.lds + MISC_OFF);
    F.tid = threadIdx.x; F.lane = F.tid & 63; F.wave = __builtin_amdgcn_readfirstlane(F.tid >> 6); F.G = gridDim.x; F.bid = blockIdx.x;
    F.ws = args.ws; F.ctl = (gu32*)(args.ws + WS_CTL); F.out = args.out;
#pragma unroll
    for (int i = 0; i < 17; ++i) F.in[i] = args.in[i];
    for (int u = F.tid; u < (LDS_BYTES - LDSCTL_OFF) / 4; u += NWAVES * 64) ((LAS unsigned*)(F.lds + LDSCTL_OFF))[u] = 0u;
    __syncthreads();
    unsigned char* ws = args.ws;
    XcdBarrier bar; bar.bar = (unsigned*)(F.ctl + CW_BAR); bar.x = 0; bar.st = nullptr;
    if (MK_ONE_LAUNCH) bar = xcd_barrier_post((unsigned*)(F.ctl + CW_BAR), F.MISC + 8);
    const int lo = args.ph_lo, hi = args.ph_hi;
#define IN(k) (lo <= (k) && (k) < hi)
#define SEAM(k) do { if (MK_ONE_LAUNCH && IN((k) + 1)) xcd_barrier(bar); } while (0)
    bf16* XB = (bf16*)(ws + WS_XB); float* H = (float*)(ws + WS_H); bf16* AO = (bf16*)(ws + WS_AO);

    if (IN(0)) { p0_prologue(F); SEAM(0); }
    if (IN(1)) {
        pg8::Gemm g{XB, (const bf16*)(ws + WS_WIN), M, 2048, D}; pg8::StaticOrder S; S.init(M, 2048, F.G, F.bid);
        pg8::EpiScaleBf16 E{(bf16*)(ws + WS_PROJ), 2048, (const float*)(ws + WS_SS0)};
        pg8::gemm_phase<pg8::EpiScaleBf16, pg8::StaticOrder, true, true>(F.lds, g, S, E); SEAM(1); }
    if (IN(2)) { p2_post(F); SEAM(2); }
    if (IN(3)) { p3_index_naive(F); SEAM(3); }
    if (IN(4)) { p4_dsa(F); SEAM(4); }
    if (IN(5)) {
        pg8::Gemm g{AO, (const bf16*)(ws + WS_WOA), M, D, D}; pg8::StaticOrder S; S.init(M, D, F.G, F.bid);
        pg8::EpiResid E{F.in[IN_X], H, XB, (float*)(ws + WS_SS1)};
        pg8::gemm_phase<pg8::EpiResid, pg8::StaticOrder, true, true>(F.lds, g, S, E); SEAM(5); }
    if (IN(6)) {
        pg8::Gemm g{XB, (const bf16*)(ws + WS_WGU), M, 2 * FF, D}; pg8::StaticOrder S; S.init(M, 2 * FF, F.G, F.bid);
        pg8::EpiSwiGLU<false> E{(bf16*)(ws + WS_HF), FF, (const float*)(ws + WS_SS1)};
        pg8::gemm_phase<pg8::EpiSwiGLU<false>, pg8::StaticOrder, true, true>(F.lds, g, S, E); SEAM(6); }
    if (IN(7)) {
        pg8::Gemm g{(const bf16*)(ws + WS_HF), (const bf16*)(ws + WS_WD), M, D, FF}; pg8::StaticOrder S; S.init(M, D, F.G, F.bid);
        pg8::EpiResid E{H, H, XB, (float*)(ws + WS_SS2)};
        pg8::gemm_phase<pg8::EpiResid, pg8::StaticOrder, true, true>(F.lds, g, S, E); SEAM(7); }
    if (IN(8)) {
        { pg8::Gemm g{XB, (const bf16*)(ws + WS_WKVQ), M, 2048, D}; pg8::StaticOrder S; S.init(M, 2048, F.G, F.bid);
          pg8::EpiScaleBf16 E{(bf16*)(ws + WS_KQ), 2048, (const float*)(ws + WS_SS2)};
          pg8::gemm_phase<pg8::EpiScaleBf16, pg8::StaticOrder, true, true>(F.lds, g, S, E); }
        { pg8::Gemm g{(const bf16*)(ws + WS_WKVQ) + (size_t)2048 * D, XB, D, M, D}; pg8::StaticOrder S; S.init(D, M, F.G, F.bid);
          pg8::EpiScaleColBf16 E{(bf16*)(ws + WS_VT), M, (const float*)(ws + WS_SS2)};
          pg8::gemm_phase<pg8::EpiScaleColBf16, pg8::StaticOrder, true, true>(F.lds, g, S, E); }
        SEAM(8); }
    if (IN(9)) { p9_sb(F); SEAM(9); }
    if (IN(10)) {
        pg8::Gemm g{AO, (const bf16*)(ws + WS_WOB), M, D, D}; pg8::StaticOrder S; S.init(M, D, F.G, F.bid);
        pg8::EpiResid E{H, H, XB, (float*)(ws + WS_SS3)};
        pg8::gemm_phase<pg8::EpiResid, pg8::StaticOrder, true, true>(F.lds, g, S, E); SEAM(10); }
    if (IN(11)) { p11_router(F); SEAM(11); }
    if (IN(12)) { p12_permute(F); SEAM(12); }
    if (IN(13)) {
        pg8::MoeOrder S; moe_bases(F, S.tb); S.npn = 22; S.G = F.G; S.c = F.bid;
        pg8::Gemm g{(const bf16*)(ws + WS_XPERM), (const bf16*)(ws + WS_WGUM), MAXSLOT, NE * 2 * FF, D};
        pg8::EpiSwiGLU<true> E{(bf16*)(ws + WS_HM), FF, (const float*)(ws + WS_RSTDS)};
        pg8::gemm_phase<pg8::EpiSwiGLU<true>, pg8::MoeOrder, true, true>(F.lds, g, S, E); SEAM(13); }
    if (IN(14)) {
        pg8::MoeOrder S; moe_bases(F, S.tb); S.npn = 4; S.G = F.G; S.c = F.bid;
        pg8::Gemm g{(const bf16*)(ws + WS_HM), (const bf16*)(ws + WS_WDM), MAXSLOT, NE * D, FF};
        pg8::EpiGateBf16 E{(bf16*)(ws + WS_Y), (const float*)(ws + WS_GATES)};
        pg8::gemm_phase<pg8::EpiGateBf16, pg8::MoeOrder, true, true>(F.lds, g, S, E); SEAM(14); }
    if (IN(15)) { p15_combine(F); }
#undef IN
#undef SEAM
}

extern "C" void kernel_launch(void* const* d_in, const int* in_sizes, int n_in, void* d_out, int out_size, void* d_ws, size_t ws_size, hipStream_t stream) {
    static int grid = 0;
    if (grid == 0) {
        if (n_in != 17 || out_size != M * D || ws_size < WS_END) { fprintf(stderr, "kernel_launch: unexpected problem (n_in %d, out %d, ws %zu < %zu)\n", n_in, out_size, ws_size, (size_t)WS_END); grid = -1; return; }
        int dev = 0, cus = 0, per_cu = 0;
        if (hipGetDevice(&dev) != hipSuccess || hipDeviceGetAttribute(&cus, hipDeviceAttributeMultiprocessorCount, dev) != hipSuccess) { grid = -1; return; }
        if (hipFuncSetAttribute((const void*)yoco_fwd, hipFuncAttributeMaxDynamicSharedMemorySize, LDS_BYTES) != hipSuccess) { fprintf(stderr, "kernel_launch: hipFuncSetAttribute failed\n"); grid = -1; return; }
        if (hipOccupancyMaxActiveBlocksPerMultiprocessor(&per_cu, (const void*)yoco_fwd, NWAVES * 64, LDS_BYTES) != hipSuccess || per_cu < 1) fprintf(stderr, "kernel_launch: occupancy query says %d\n", per_cu);
        (void)hipGetLastError();
        grid = cus;
    }
    if (grid < 0) return;
    if (hipMemsetAsync((char*)d_ws + WS_CTL, 0, CTL_ZERO_BYTES, stream) != hipSuccess) return;
    Args a{};
    for (int i = 0; i < 17; ++i) a.in[i] = (const float*)d_in[i];
    a.out = (float*)d_out; a.ws = (unsigned char*)d_ws;
#if MK_ONE_LAUNCH
    a.ph_lo = 0; a.ph_hi = N_PHASES;
    hipLaunchKernelGGL(yoco_fwd, dim3(grid), dim3(NWAVES * 64), LDS_BYTES, stream, a);
#else
    for (int p = 0; p < N_PHASES; ++p) { a.ph_lo = p; a.ph_hi = p + 1; hipLaunchKernelGGL(yoco_fwd, dim3(grid), dim3(NWAVES * 64), LDS_BYTES, stream, a); }
#endif
}
```

```cpp
#include <hip/hip_runtime.h>
#include <cstdio>
#include <cstdint>
namespace pg8 {
#define PG8_LAS __attribute__((address_space(3)))
typedef unsigned short bf16_t;
typedef short bf16x8 __attribute__((ext_vector_type(8)));
typedef float f32x4 __attribute__((ext_vector_type(4)));
typedef unsigned u32x4 __attribute__((ext_vector_type(4)));
constexpr int BM = 256, BK = 64, HALF = 128, HTB = HALF * BK * 2  , STAGE_BYTES = 8 * HTB, NXCD = 8, WGM = 8;

__host__ __device__ __forceinline__ int lds_byte(int r, int c) { const int st = (r >> 4) * 2 + (c >> 5), rr = r & 15, cc = c & 31, ob = rr * 64 + cc * 2; return st * 1024 + (ob ^ (((ob >> 9) & 1) << 5)); }
__host__ __device__ __forceinline__ void stage_rc(int b, int& R, int& C) { const int st = b / 1024, sb = b % 1024, swz = sb ^ (((sb >> 9) & 1) << 5); R = (st >> 1) * 16 + swz / 64; C = (st & 1) * 32 + (swz % 64) / 2; }
__host__ __device__ __forceinline__ int perm32(int rho) { const int n = rho >> 4, i = rho & 15; return 8 * (i >> 2) + 4 * n + (i & 3); }

struct Unit { int pm, pn; };
struct Gemm { const bf16_t* A; const bf16_t* Bt; int M, N, K; };

struct StaticOrder {
    int nM, nN, nwg, G, c;
    __host__ __device__ void init(int M, int N, int G_, int c_) { nM = M / BM; nN = N / BM; nwg = nM * nN; G = G_; c = c_; }
    __host__ __device__ bool next(int i, Unit& u) const {
        const long L = (long)i * G + c; if (L >= nwg) return false;
        int wgid = (int)L; { const int q = nwg / NXCD, r = nwg % NXCD, xcd = wgid % NXCD, off = wgid / NXCD; wgid = (xcd < r ? xcd * (q + 1) : r * (q + 1) + (xcd - r) * q) + off; }
        const int nig = WGM * nN, gid = wgid / nig, fm = gid * WGM, gsz = (nM - fm) < WGM ? (nM - fm) : WGM;
        u.pm = fm + ((wgid % nig) % gsz); u.pn = (wgid % nig) / gsz; return true;
    }
    __device__ __forceinline__ void a_ready(const Unit&) const {}
    __device__ __forceinline__ void done(const Unit&) const {}
};

__device__ __forceinline__ unsigned cvt_pk_bf16(float lo, float hi) { unsigned r; asm volatile("v_cvt_pk_bf16_f32 %0, %1, %2" : "=v"(r) : "v"(lo), "v"(hi)); return r; }
typedef unsigned u32x2 __attribute__((ext_vector_type(2)));
constexpr float RMS_EPS = 1e-6f;
__device__ __forceinline__ float rstd16(const float* p) {
    const f32x4 a = *(const f32x4*)p, b = *(const f32x4*)(p + 4), c = *(const f32x4*)(p + 8), d = *(const f32x4*)(p + 12);
    const float s = (((a[0] + a[1]) + (a[2] + a[3])) + ((b[0] + b[1]) + (b[2] + b[3]))) + (((c[0] + c[1]) + (c[2] + c[3])) + ((d[0] + d[1]) + (d[2] + d[3])));
    return 1.0f / sqrtf(s * (1.0f / 1024.0f) + RMS_EPS);
}
struct EpiScaleBf16 {
    static constexpr bool PERM = true, AFTER_DRAIN = false;
    bf16_t* O; int ldc; const float* ss;
    __device__ __forceinline__ void operator()(const f32x4 (&acc)[2][2][4][2], const Unit& u, int wr, int wc, int fr, int fq) const {
        const int row0 = u.pm * BM + wr * 64 + fr, col0 = u.pn * BM + wc * 32 + 8 * fq;
#pragma unroll
        for (int ai = 0; ai < 2; ++ai)
#pragma unroll
            for (int m = 0; m < 4; ++m) { const int row = row0 + ai * HALF + m * 16; const float rs = rstd16(ss + (size_t)row * 16); bf16_t* rowp = O + (size_t)row * ldc + col0;
#pragma unroll
                for (int bj = 0; bj < 2; ++bj) { const f32x4 v0 = acc[ai][bj][m][0] * rs, v1 = acc[ai][bj][m][1] * rs;
                    u32x4 w; w.x = cvt_pk_bf16(v0[0], v0[1]); w.y = cvt_pk_bf16(v0[2], v0[3]); w.z = cvt_pk_bf16(v1[0], v1[1]); w.w = cvt_pk_bf16(v1[2], v1[3]);
                    *(u32x4*)(rowp + bj * HALF) = w; } }
    }
};
struct EpiScaleColBf16 {
    static constexpr bool PERM = true, AFTER_DRAIN = false;
    bf16_t* O; int ldc; const float* ss;
    __device__ __forceinline__ void operator()(const f32x4 (&acc)[2][2][4][2], const Unit& u, int wr, int wc, int fr, int fq) const {
        const int row0 = u.pm * BM + wr * 64 + fr, col0 = u.pn * BM + wc * 32 + 8 * fq;
        f32x4 rs[2][2];
#pragma unroll
        for (int bj = 0; bj < 2; ++bj)
#pragma unroll
            for (int n = 0; n < 2; ++n)
#pragma unroll
                for (int e = 0; e < 4; ++e) rs[bj][n][e] = rstd16(ss + (size_t)(col0 + bj * HALF + 4 * n + e) * 16);
#pragma unroll
        for (int ai = 0; ai < 2; ++ai)
#pragma unroll
            for (int m = 0; m < 4; ++m) { const int row = row0 + ai * HALF + m * 16; bf16_t* rowp = O + (size_t)row * ldc + col0;
#pragma unroll
                for (int bj = 0; bj < 2; ++bj) { const f32x4 v0 = acc[ai][bj][m][0] * rs[bj][0], v1 = acc[ai][bj][m][1] * rs[bj][1];
                    u32x4 w; w.x = cvt_pk_bf16(v0[0], v0[1]); w.y = cvt_pk_bf16(v0[2], v0[3]); w.z = cvt_pk_bf16(v1[0], v1[1]); w.w = cvt_pk_bf16(v1[2], v1[3]);
                    *(u32x4*)(rowp + bj * HALF) = w; } }
    }
};
struct EpiResid {
    static constexpr bool PERM = false, AFTER_DRAIN = false;
    const float* base; float* H; bf16_t* XB; float* ssp;
    __device__ __forceinline__ void operator()(const f32x4 (&acc)[2][2][4][2], const Unit& u, int wr, int wc, int fr, int fq) const {
        const int row0 = u.pm * BM + wr * 64 + fr, col0 = u.pn * BM + wc * 32 + 4 * fq;
#pragma unroll
        for (int ai = 0; ai < 2; ++ai)
#pragma unroll
            for (int m = 0; m < 4; ++m) { const int row = row0 + ai * HALF + m * 16; float q = 0.f;
#pragma unroll
                for (int bj = 0; bj < 2; ++bj)
#pragma unroll
                    for (int n = 0; n < 2; ++n) { const size_t off = (size_t)row * 1024 + col0 + bj * HALF + n * 16;
                        const f32x4 v = *(const f32x4*)(base + off) + acc[ai][bj][m][n]; *(f32x4*)(H + off) = v;
                        q += (v[0] * v[0] + v[1] * v[1]) + (v[2] * v[2] + v[3] * v[3]);
                        u32x2 w; w.x = cvt_pk_bf16(v[0], v[1]); w.y = cvt_pk_bf16(v[2], v[3]); *(u32x2*)(XB + off) = w; }
                q += __shfl_xor(q, 16); q += __shfl_xor(q, 32);
                if (fq == 0) ssp[(size_t)row * 16 + u.pn * 4 + wc] = q; }
    }
};
__device__ __forceinline__ float silu_mul(float g, float u) { return g * __builtin_amdgcn_rcpf(1.0f + __builtin_amdgcn_exp2f(g * -1.4426950408889634f)) * u; }
template <bool MOE> struct EpiSwiGLU {
    static constexpr bool PERM = true, AFTER_DRAIN = false;
    bf16_t* O; int ldc; const float* ss;
    __device__ __forceinline__ void operator()(const f32x4 (&acc)[2][2][4][2], const Unit& u, int wr, int wc, int fr, int fq) const {
        const int row0 = u.pm * BM + wr * 64 + fr; const int pnl = MOE ? (u.pn % 22) : u.pn; const int col0 = pnl * HALF + wc * 32 + 8 * fq;
#pragma unroll
        for (int ai = 0; ai < 2; ++ai)
#pragma unroll
            for (int m = 0; m < 4; ++m) { const int row = row0 + ai * HALF + m * 16; const float rs = MOE ? ss[row] : rstd16(ss + (size_t)row * 16);
                const f32x4 g0 = acc[ai][0][m][0] * rs, g1 = acc[ai][0][m][1] * rs, u0 = acc[ai][1][m][0] * rs, u1 = acc[ai][1][m][1] * rs;
                u32x4 w; w.x = cvt_pk_bf16(silu_mul(g0[0], u0[0]), silu_mul(g0[1], u0[1])); w.y = cvt_pk_bf16(silu_mul(g0[2], u0[2]), silu_mul(g0[3], u0[3]));
                w.z = cvt_pk_bf16(silu_mul(g1[0], u1[0]), silu_mul(g1[1], u1[1])); w.w = cvt_pk_bf16(silu_mul(g1[2], u1[2]), silu_mul(g1[3], u1[3]));
                *(u32x4*)(O + (size_t)row * ldc + col0) = w; }
    }
};
struct EpiGateBf16 {
    static constexpr bool PERM = true, AFTER_DRAIN = false;
    bf16_t* Y; const float* gate;
    __device__ __forceinline__ void operator()(const f32x4 (&acc)[2][2][4][2], const Unit& u, int wr, int wc, int fr, int fq) const {
        const int row0 = u.pm * BM + wr * 64 + fr, col0 = (u.pn & 3) * BM + wc * 32 + 8 * fq;
#pragma unroll
        for (int ai = 0; ai < 2; ++ai)
#pragma unroll
            for (int m = 0; m < 4; ++m) { const int row = row0 + ai * HALF + m * 16; const float gt = gate[row]; bf16_t* rowp = Y + (size_t)row * 1024 + col0;
#pragma unroll
                for (int bj = 0; bj < 2; ++bj) { const f32x4 v0 = acc[ai][bj][m][0] * gt, v1 = acc[ai][bj][m][1] * gt;
                    u32x4 w; w.x = cvt_pk_bf16(v0[0], v0[1]); w.y = cvt_pk_bf16(v0[2], v0[3]); w.z = cvt_pk_bf16(v1[0], v1[1]); w.w = cvt_pk_bf16(v1[2], v1[3]);
                    *(u32x4*)(rowp + bj * HALF) = w; } }
    }
};
struct MoeOrder {
    int tb[9]; int npn, G, c;
    __device__ __forceinline__ bool next(int i, Unit& u) const {
        const int L = i * G + c; if (L >= tb[8] * npn) return false;
        const int t = L / npn, j = L - t * npn; int e = 0;
#pragma unroll
        for (int k = 1; k < 8; ++k) e += (t >= tb[k]) ? 1 : 0;
        u.pm = t; u.pn = e * npn + j; return true;
    }
    __device__ __forceinline__ void a_ready(const Unit&) const {}
    __device__ __forceinline__ void done(const Unit&) const {}
};

template <class Epi, class Sched, bool ALIGN_EPI = false, bool SP2 = false>
__device__ __forceinline__ void gemm_phase(PG8_LAS unsigned char* lds, const Gemm g, const Sched& S, const Epi& E) {
    const int tid = threadIdx.x, wid = __builtin_amdgcn_readfirstlane(tid >> 6), lane = tid & 63, wr = wid >> 2, wc = wid & 3, fr = lane & 15, fq = lane >> 4;
    const int K = g.K, nt = K / BK;
    unsigned voffA[2], voffB[2];
#pragma unroll
    for (int i = 0; i < 2; ++i) { int R, C; stage_rc(tid * 16 + i * 8192, R, C); const int Rb = Epi::PERM ? ((R & ~31) + perm32(R & 31)) : R;
        voffA[i] = (unsigned)(R * K + C) * 2u; voffB[i] = (unsigned)(Rb * K + C) * 2u; }
    const size_t kstep = (size_t)(BK * 2);
    const size_t hstep = (size_t)HALF * K * 2;
    const size_t tstep = 2 * hstep;
    const unsigned ldsw = (unsigned)wid * 1024u;
    const int aoff = lds_byte(wr * 64 + fr, fq * 8), boff = lds_byte(wc * 32 + fr, fq * 8);
#define PG8_SA(b, h) (((b) * 2 + (h)) * HTB)
#define PG8_SB(b, h) ((4 + (b) * 2 + (h)) * HTB)
#define PG8_STAGE(bufoff, gbase, voff) do { _Pragma("unroll") for (int _i = 0; _i < 2; ++_i) \
        __builtin_amdgcn_global_load_lds((const unsigned*)((const char*)(gbase) + (voff)[_i]), (PG8_LAS unsigned*)(lds + (bufoff) + ldsw + _i * 8192), 16, 0, 0); } while (0)
#define PG8_LDA(dst, b, h) do { _Pragma("unroll") for (int m = 0; m < 4; ++m) _Pragma("unroll") for (int k = 0; k < 2; ++k) dst[m][k] = *(const PG8_LAS bf16x8*)(lds + PG8_SA(b, h) + aoff + m * 2048 + k * 1024); } while (0)
#define PG8_LDB(dst, b, h) do { _Pragma("unroll") for (int n = 0; n < 2; ++n) _Pragma("unroll") for (int k = 0; k < 2; ++k) dst[n][k] = *(const PG8_LAS bf16x8*)(lds + PG8_SB(b, h) + boff + n * 2048 + k * 1024); } while (0)
#define PG8_MMA(ai, bj, At, Bt) do { __builtin_amdgcn_s_setprio(1); _Pragma("unroll") for (int m = 0; m < 4; ++m) _Pragma("unroll") for (int n = 0; n < 2; ++n) _Pragma("unroll") for (int k = 0; k < 2; ++k) \
        acc[ai][bj][m][n] = __builtin_amdgcn_mfma_f32_16x16x32_bf16(Bt[n][k], At[m][k], acc[ai][bj][m][n], 0, 0, 0); __builtin_amdgcn_s_setprio(0); } while (0)
#define PG8_WAIT_V(n) asm volatile("s_waitcnt vmcnt(" #n ")" ::: "memory")
#define PG8_WAIT_L(n) asm volatile("s_waitcnt lgkmcnt(" #n ")" ::: "memory")
#define PG8_BAR __builtin_amdgcn_s_barrier()
#define PG8_SCHED __builtin_amdgcn_sched_barrier(0)
    Unit cur, nxt; int ui = 0;
    if (!S.next(0, cur)) return;
    f32x4 acc[2][2][4][2];
#pragma unroll
    for (int a = 0; a < 2; ++a)
#pragma unroll
        for (int b = 0; b < 2; ++b)
#pragma unroll
            for (int m = 0; m < 4; ++m)
#pragma unroll
                for (int n = 0; n < 2; ++n) acc[a][b][m][n] = (f32x4){0.f, 0.f, 0.f, 0.f};
    bf16x8 At[4][2], B0[2][2], B1[2][2];
    const char* cA = (const char*)g.A + (size_t)cur.pm * tstep; const char* cB = (const char*)g.Bt + (size_t)cur.pn * tstep;
    S.a_ready(cur);
    if constexpr (SP2) {
        PG8_STAGE(PG8_SB(0, 0), cB, voffB); PG8_STAGE(PG8_SB(0, 1), cB + hstep, voffB); PG8_STAGE(PG8_SA(0, 0), cA, voffA); PG8_STAGE(PG8_SA(0, 1), cA + hstep, voffA);
        if (wr == 1) PG8_BAR;
        PG8_WAIT_V(2); PG8_BAR;
        PG8_STAGE(PG8_SB(1, 0), cB + kstep, voffB); PG8_STAGE(PG8_SA(1, 0), cA + kstep, voffA); PG8_STAGE(PG8_SB(1, 1), cB + hstep + kstep, voffB);
        PG8_WAIT_V(6); PG8_BAR;
    } else {
        PG8_STAGE(PG8_SB(0, 0), cB, voffB); PG8_STAGE(PG8_SA(0, 0), cA, voffA); PG8_STAGE(PG8_SB(0, 1), cB + hstep, voffB); PG8_STAGE(PG8_SA(0, 1), cA + hstep, voffA);
        if (wr == 1) PG8_BAR;
        PG8_WAIT_V(4); PG8_BAR;
        PG8_STAGE(PG8_SB(1, 0), cB + kstep, voffB); PG8_STAGE(PG8_SA(1, 0), cA + kstep, voffA); PG8_STAGE(PG8_SB(1, 1), cB + hstep + kstep, voffB);
        PG8_WAIT_V(6); PG8_BAR;
    }
    for (;;) {
        const bool has_next = S.next(ui + 1, nxt);
        const char* nA = has_next ? (const char*)g.A + (size_t)nxt.pm * tstep : cA; const char* nB = has_next ? (const char*)g.Bt + (size_t)nxt.pn * tstep : cB;
        for (int t = 0; t < nt; t += 2) {
            const bool last = (t == nt - 2);
            const char* a1 = cA + (size_t)(t + 1) * kstep;
            const char* a2 = last ? nA : cA + (size_t)(t + 2) * kstep; const char* b2 = last ? nB : cB + (size_t)(t + 2) * kstep;
            const char* a3 = a2 + kstep; const char* b3 = b2 + kstep;
            if (last && has_next) S.a_ready(nxt);
            if constexpr (SP2) {
            PG8_LDB(B0, 0, 0); PG8_LDB(B1, 0, 1); PG8_SCHED; PG8_LDA(At, 0, 0); PG8_STAGE(PG8_SA(1, 1), a1 + hstep, voffA);
            PG8_WAIT_V(8); PG8_WAIT_L(0); PG8_BAR; PG8_MMA(0, 0, At, B0); PG8_MMA(0, 1, At, B1); PG8_BAR; PG8_SCHED;
            PG8_LDA(At, 0, 1); PG8_STAGE(PG8_SB(0, 0), b2, voffB); PG8_STAGE(PG8_SB(0, 1), b2 + hstep, voffB); PG8_STAGE(PG8_SA(0, 0), a2, voffA);
            PG8_WAIT_V(8); PG8_WAIT_L(0); PG8_BAR; PG8_MMA(1, 0, At, B0); PG8_MMA(1, 1, At, B1); PG8_BAR; PG8_SCHED;
            PG8_LDB(B0, 1, 0); PG8_LDB(B1, 1, 1); PG8_SCHED; PG8_LDA(At, 1, 0); PG8_STAGE(PG8_SA(0, 1), a2 + hstep, voffA);
            PG8_WAIT_V(8); PG8_WAIT_L(0); PG8_BAR; PG8_MMA(0, 0, At, B0); PG8_MMA(0, 1, At, B1); PG8_BAR; PG8_SCHED;
            PG8_LDA(At, 1, 1); PG8_STAGE(PG8_SB(1, 0), b3, voffB); PG8_STAGE(PG8_SB(1, 1), b3 + hstep, voffB); PG8_STAGE(PG8_SA(1, 0), a3, voffA);
            PG8_WAIT_V(8); PG8_WAIT_L(0); PG8_BAR; PG8_MMA(1, 0, At, B0); PG8_MMA(1, 1, At, B1); PG8_BAR; PG8_SCHED;
            } else {
            PG8_LDB(B0, 0, 0); PG8_SCHED; PG8_LDA(At, 0, 0); PG8_STAGE(PG8_SA(1, 1), a1 + hstep, voffA);
            PG8_WAIT_L(8); PG8_BAR; PG8_WAIT_L(0); PG8_MMA(0, 0, At, B0); PG8_BAR; PG8_SCHED;
            PG8_LDB(B1, 0, 1); PG8_STAGE(PG8_SB(0, 0), b2, voffB);
            PG8_BAR; PG8_WAIT_L(0); PG8_MMA(0, 1, At, B1); PG8_BAR;
            PG8_LDA(At, 0, 1); PG8_STAGE(PG8_SA(0, 0), a2, voffA);
            PG8_BAR; PG8_WAIT_L(0); PG8_MMA(1, 0, At, B0); PG8_BAR; PG8_SCHED;
            PG8_STAGE(PG8_SB(0, 1), b2 + hstep, voffB);
            PG8_WAIT_V(6); PG8_BAR; PG8_MMA(1, 1, At, B1); PG8_BAR;
            PG8_LDB(B0, 1, 0); PG8_SCHED; PG8_LDA(At, 1, 0); PG8_STAGE(PG8_SA(0, 1), a2 + hstep, voffA);
            PG8_WAIT_L(8); PG8_BAR; PG8_WAIT_L(0); PG8_MMA(0, 0, At, B0); PG8_BAR; PG8_SCHED;
            PG8_LDB(B1, 1, 1); PG8_STAGE(PG8_SB(1, 0), b3, voffB);
            PG8_BAR; PG8_WAIT_L(0); PG8_MMA(0, 1, At, B1); PG8_BAR;
            PG8_LDA(At, 1, 1); PG8_STAGE(PG8_SA(1, 0), a3, voffA);
            PG8_BAR; PG8_WAIT_L(0); PG8_MMA(1, 0, At, B0); PG8_BAR; PG8_SCHED;
            PG8_STAGE(PG8_SB(1, 1), b3 + hstep, voffB);
            PG8_WAIT_V(6); PG8_BAR; PG8_MMA(1, 1, At, B1); PG8_BAR;
            }
        }
        if constexpr (ALIGN_EPI) { if (wr == 0) PG8_BAR; }
        if constexpr (!Epi::AFTER_DRAIN) { E(acc, cur, wr, wc, fr, fq); S.done(cur); }
        if (!has_next) break;
#pragma unroll
        for (int a = 0; a < 2; ++a)
#pragma unroll
            for (int b = 0; b < 2; ++b)
#pragma unroll
                for (int m = 0; m < 4; ++m)
#pragma unroll
                    for (int n = 0; n < 2; ++n) acc[a][b][m][n] = (f32x4){0.f, 0.f, 0.f, 0.f};
        cur = nxt; cA = nA; cB = nB; ++ui;
        if constexpr (ALIGN_EPI) { if (wr == 1) PG8_BAR; }
    }
    PG8_WAIT_V(0);
    if constexpr (!ALIGN_EPI) { if (wr == 0) PG8_BAR; }
    PG8_BAR;
    if constexpr (Epi::AFTER_DRAIN) { E.fused(acc, cur, wr, wc, fr, fq, lds, wid, lane); S.done(cur); }
#undef PG8_SA
#undef PG8_SB
#undef PG8_STAGE
#undef PG8_LDA
#undef PG8_LDB
#undef PG8_MMA
#undef PG8_WAIT_V
#undef PG8_WAIT_L
#undef PG8_BAR
#undef PG8_SCHED
}
}

constexpr int NWAVES = 8;
constexpr int BATCH = 2, SEQ = 8192, D = 1024, M = BATCH * SEQ;
constexpr int HD = 128, NH = 8, NKV = 2, NIH = 8, IDX = 64, TOPK = 256;
constexpr int A_IN = 2120, FF = 2816, NE = 8;
constexpr int MAXSLOT = 34816;
constexpr float QSCALE = 0.12751743082459868f;
constexpr float SBSCALE = 0.08838834764831845f;
constexpr float WISCALE = 0.04419417382415922f;
constexpr size_t MiB = 1u << 20;
constexpr size_t WS_CTL = 0, CTL_ZERO_BYTES = 1 * MiB;
constexpr size_t WS_WIN = 2 * MiB, WS_WTAIL = 6 * MiB, WS_WOA = 7 * MiB, WS_WGU = 9 * MiB, WS_WD = 20 * MiB, WS_WKVQ = 26 * MiB, WS_WOB = 32 * MiB, WS_WGUM = 34 * MiB, WS_WDM = 122 * MiB;
constexpr size_t WS_H = 166 * MiB, WS_XB = 230 * MiB, WS_SS0 = 262 * MiB, WS_SS1 = 263 * MiB, WS_SS2 = 264 * MiB, WS_SS3 = 265 * MiB;
constexpr size_t WS_T = 266 * MiB;
constexpr size_t WS_PROJ = WS_T, WS_QF = 330 * MiB, WS_KVF = 362 * MiB, WS_QIF = 378 * MiB, WS_KIF = 394 * MiB, WS_WIF = 396 * MiB, WS_SEL = 397 * MiB, WS_AO = 413 * MiB;
constexpr size_t WS_HF = WS_T, WS_KQ = WS_T, WS_VT = 330 * MiB;
constexpr size_t WS_XPERM = WS_T, WS_HM = 334 * MiB, WS_Y = 521 * MiB;
constexpr size_t WS_RT = 590 * MiB;
constexpr size_t WS_RSTDS = 591 * MiB, WS_GATES = 591 * MiB + 512 * 1024, WS_END = 592 * MiB;
constexpr int CW_CNT = 64;
constexpr int CW_BAR = 4096;
constexpr int RING_BYTES = 131072, LDSCTL_OFF = RING_BYTES, MISC_OFF = LDSCTL_OFF + 320, LDS_BYTES = 147456;

#define GAS __attribute__((address_space(1)))
#define LAS __attribute__((address_space(3)))
typedef unsigned short bf16;
typedef unsigned v4u __attribute__((ext_vector_type(4)));
typedef unsigned v2u __attribute__((ext_vector_type(2)));
typedef float f32x4 __attribute__((ext_vector_type(4)));
typedef short bf16x8 __attribute__((ext_vector_type(8)));
typedef float f32x16 __attribute__((ext_vector_type(16)));
typedef GAS unsigned gu32;
#define RLX_AGENT __ATOMIC_RELAXED, __HIP_MEMORY_SCOPE_AGENT
#define LDS_WAIT() asm volatile("s_waitcnt lgkmcnt(0)" ::: "memory")
#define VM_WAIT() asm volatile("s_waitcnt vmcnt(0)" ::: "memory")
__device__ __forceinline__ unsigned f2bf(float f) { unsigned u = __builtin_bit_cast(unsigned, f); return (u + 0x7fffu + ((u >> 16) & 1u)) >> 16; }
__device__ __forceinline__ unsigned pk2(float lo, float hi) { return f2bf(lo) | (f2bf(hi) << 16); }
__device__ __forceinline__ float bflo(unsigned w) { return __uint_as_float(w << 16); }
__device__ __forceinline__ float bfhi(unsigned w) { return __uint_as_float(w & 0xffff0000u); }
__device__ __forceinline__ float wave_sum(float v) {
#pragma unroll
    for (int o = 1; o < 64; o <<= 1) v += __shfl_xor(v, o);
    return v;
}
__device__ __forceinline__ float wave_max(float v) {
#pragma unroll
    for (int o = 1; o < 64; o <<= 1) v = fmaxf(v, __shfl_xor(v, o));
    return v;
}
__device__ __forceinline__ void sincos_acc(float a, float& c, float& s) {
    const double x = (double)a; const double n = __builtin_rint(x * 0.63661977236758134308);
    const double r = __builtin_fma(-n, 6.123233995736766035869e-17, __builtin_fma(-n, 1.57079632679489655800, x)); const double r2 = r * r;
    double sn = 1.0 - r2 * (1.0 / 156.0); sn = 1.0 - r2 * (1.0 / 110.0) * sn; sn = 1.0 - r2 * (1.0 / 72.0) * sn; sn = 1.0 - r2 * (1.0 / 42.0) * sn; sn = 1.0 - r2 * (1.0 / 20.0) * sn; sn = 1.0 - r2 * (1.0 / 6.0) * sn; sn *= r;
    double cs = 1.0 - r2 * (1.0 / 182.0); cs = 1.0 - r2 * (1.0 / 132.0) * cs; cs = 1.0 - r2 * (1.0 / 90.0) * cs; cs = 1.0 - r2 * (1.0 / 56.0) * cs; cs = 1.0 - r2 * (1.0 / 30.0) * cs; cs = 1.0 - r2 * (1.0 / 12.0) * cs; cs = 1.0 - r2 * 0.5 * cs;
    const int q = ((int)n) & 3;
    const double cq = (q == 0) ? cs : (q == 1) ? -sn : (q == 2) ? -cs : sn;
    const double sq = (q == 0) ? sn : (q == 1) ? cs : (q == 2) ? -sn : -cs;
    c = (float)cq; s = (float)sq;
}
__device__ const float INV_Q[16] = {1.000000000e+00f, 4.403665960e-01f, 1.939227432e-01f, 8.539710194e-02f, 3.760603070e-02f, 1.656043902e-02f, 7.292664610e-03f, 3.211445874e-03f,
                                    1.414213562e-03f, 6.227723788e-04f, 2.742481884e-04f, 1.207697351e-04f, 5.318296098e-05f, 2.341999971e-05f, 1.031338616e-05f, 4.541670478e-06f};
__device__ const float INV_I[8] = {1.000000000e+00f, 1.939227432e-01f, 3.760603070e-02f, 7.292664610e-03f, 1.414213562e-03f, 2.742481884e-04f, 5.318296098e-05f, 1.031338616e-05f};

#define XB_TMO      128
#define XB_XCNT(j)  (256  + 64 * (j))
#define XB_XSUB(j)  (1280 + 64 * (j))
#define XB_XGEN(j)  (2304 + 64 * (j))
#define XB_TOP      3328
#define XB_TOPGEN   3392
#define XCD_BAR_WORDS 3456
#define XB_SPIN_CAP (1u << 18)

__device__ __forceinline__ unsigned xb_ld(unsigned* p)              { return __hip_atomic_load(p, __ATOMIC_RELAXED, __HIP_MEMORY_SCOPE_AGENT); }
__device__ __forceinline__ unsigned xb_add(unsigned* p, unsigned v) { return __hip_atomic_fetch_add(p, v, __ATOMIC_RELAXED, __HIP_MEMORY_SCOPE_AGENT); }
__device__ __forceinline__ unsigned xb_xcc_id() { return (unsigned)__builtin_amdgcn_s_getreg((3 << 11) | 20) & 0xFu; }
#define XB_SPIN(cond, bar) do { unsigned _sp = 0; while (cond) { __builtin_amdgcn_s_sleep(1); \
    if ((++_sp & 255u) == 0u) { if (xb_ld(&(bar)[XB_TMO])) break; if (_sp > XB_SPIN_CAP) { atomicAdd(&(bar)[XB_TMO], 1u); break; } } } } while (0)

struct XcdBarrier {
    unsigned* bar; unsigned x;
    volatile LAS unsigned* st;
};

__device__ __forceinline__ XcdBarrier xcd_barrier_post(unsigned* bar, volatile LAS unsigned* st) {
    XcdBarrier b; b.bar = bar; b.x = xb_xcc_id(); b.st = st;
    if (threadIdx.x == 0) (void)xb_add(&bar[XB_XCNT(b.x)], 1u);
    return b;
}
__device__ __forceinline__ void xcd_barrier_complete(unsigned* bar, unsigned x, unsigned& nloc, unsigned& nx) {
    const unsigned G = gridDim.x * gridDim.y * gridDim.z;
    unsigned sum, cnt, mine, sp = 0u;
    for (;;) {
        sum = 0u; cnt = 0u; mine = 0u;
#pragma unroll
        for (unsigned j = 0; j < 16; ++j) { const unsigned c = xb_ld(&bar[XB_XCNT(j)]); sum += c; cnt += (c > 0u) ? 1u : 0u; mine = (j == x) ? c : mine; }
        if (sum == G) break;
        __builtin_amdgcn_s_sleep(1);
        if ((++sp & 255u) == 0u) { if (xb_ld(&bar[XB_TMO])) break; if (sp > XB_SPIN_CAP) { atomicAdd(&bar[XB_TMO], 1u); break; } }
    }
    nloc = mine > 0u ? mine : 1u; nx = cnt > 0u ? cnt : 1u;
}

__device__ __forceinline__ void xcd_barrier(const XcdBarrier& b) {
    asm volatile("s_waitcnt vmcnt(0)" ::: "memory");
    __syncthreads();
    if (threadIdx.x == 0) {
        unsigned* bar = b.bar;
        __builtin_amdgcn_s_waitcnt(0);
        unsigned nloc = b.st[0], nx = b.st[1];
        if (nloc == 0u) { xcd_barrier_complete(bar, b.x, nloc, nx); b.st[0] = nloc; b.st[1] = nx; }
        const unsigned old = xb_add(&bar[XB_XSUB(b.x)], 1u);
        const unsigned gen = old / nloc;
        if (old + 1u == (gen + 1u) * nloc) {
            __builtin_amdgcn_fence(__ATOMIC_RELEASE, "agent");
            asm volatile("s_waitcnt vmcnt(0)" ::: "memory");
            const unsigned og = xb_add(&bar[XB_TOP], 1u);
            const unsigned tg = og / nx;
            if (og + 1u == (tg + 1u) * nx) xb_add(&bar[XB_TOPGEN], 1u);
            else XB_SPIN(xb_ld(&bar[XB_TOPGEN]) == tg, bar);
            __builtin_amdgcn_fence(__ATOMIC_ACQUIRE, "agent");
            xb_add(&bar[XB_XGEN(b.x)], 1u);
            asm volatile("s_waitcnt vmcnt(0)" ::: "memory");
        } else {
            XB_SPIN(xb_ld(&bar[XB_XGEN(b.x)]) == gen, bar);
            __builtin_amdgcn_fence(__ATOMIC_ACQUIRE, "agent");
            asm volatile("s_waitcnt vmcnt(0)" ::: "memory");
        }
    }
    __syncthreads();
}

struct Frame {
    LAS unsigned char* lds;
    volatile LAS unsigned* MISC;
    gu32* ctl;
    int tid, lane, wave, G, bid;
    const float* in[17];
    float* out; unsigned char* ws;
};
enum { IN_X = 0, IN_ANORM, IN_AWIN, IN_AQN, IN_AKN, IN_AWOUT, IN_KVNORM, IN_KVW, IN_BNORM, IN_BWQ, IN_BWOUT, IN_FFNNORM, IN_DGU, IN_DDN, IN_ROUTER, IN_MGU, IN_MDN };

__device__ __forceinline__ void tr_item(const float* W, size_t ldw, int K, int k0, int csrc0, int cend, bf16* WT, int drow0, const float* gain, float scale, LAS float* scr, int lane) {
#pragma unroll 8
    for (int i = 0; i < 32; ++i) { const int kk = 2 * i + (lane >> 5); const int c = csrc0 + (lane & 31);
        const float v = (c < cend) ? W[(size_t)(k0 + kk) * ldw + c] : 0.f; const float g = gain ? gain[k0 + kk] * scale : scale; scr[kk * 33 + (lane & 31)] = v * g; }
    LDS_WAIT(); asm volatile("" ::: "memory");
    const int c8 = lane & 7;
#pragma unroll
    for (int j = 0; j < 4; ++j) { const int n = (lane >> 3) + 8 * j; const LAS float* s = scr + (8 * c8) * 33 + n;
        v4u o; o.x = pk2(s[0 * 33], s[1 * 33]); o.y = pk2(s[2 * 33], s[3 * 33]); o.z = pk2(s[4 * 33], s[5 * 33]); o.w = pk2(s[6 * 33], s[7 * 33]);
        *(GAS v4u*)(WT + (size_t)(drow0 + n) * K + k0 + 8 * c8) = o; }
    LDS_WAIT(); asm volatile("" ::: "memory");
}
__device__ __forceinline__ int gu_row(int c0) { return (c0 < FF) ? ((c0 >> 7) * 256 + (c0 & 127)) : (((c0 - FF) >> 7) * 256 + 128 + ((c0 - FF) & 127)); }
__device__ __forceinline__ void p0_prologue(Frame& F) {
    LAS float* scr = (LAS float*)(F.lds + F.wave * 16384);
    const int gw = F.wave * F.G + F.bid, NGW = F.G * NWAVES;
    unsigned char* ws = F.ws;
    constexpr int I_WIN = 16 * 64, I_TAIL = 16 * 3, I_SQ = 16 * 32, I_GU = 16 * 176, I_DN = 44 * 32, I_KV = 16 * 64;
    constexpr int NITEMS = I_WIN + I_TAIL + I_SQ + I_GU + I_DN + I_KV + I_SQ + I_SQ + NE * I_GU + NE * I_DN;
    for (int it = gw; it < NITEMS; it += NGW) {
        int r = it;
        if (r < I_WIN) { const int kb = r / 64, nb = r % 64; tr_item(F.in[IN_AWIN], A_IN, D, 64 * kb, 32 * nb, A_IN, (bf16*)(ws + WS_WIN), 32 * nb, F.in[IN_ANORM], 1.f, scr, F.lane); continue; } r -= I_WIN;
        if (r < I_TAIL) { const int kb = r / 3, nb = r % 3; tr_item(F.in[IN_AWIN], A_IN, D, 64 * kb, 2048 + 32 * nb, A_IN, (bf16*)(ws + WS_WTAIL), 32 * nb, F.in[IN_ANORM], 1.f, scr, F.lane); continue; } r -= I_TAIL;
        if (r < I_SQ) { const int kb = r / 32, nb = r % 32; tr_item(F.in[IN_AWOUT], D, D, 64 * kb, 32 * nb, D, (bf16*)(ws + WS_WOA), 32 * nb, nullptr, 1.f, scr, F.lane); continue; } r -= I_SQ;
        if (r < I_GU) { const int kb = r / 176, nb = r % 176; tr_item(F.in[IN_DGU], 2 * FF, D, 64 * kb, 32 * nb, 2 * FF, (bf16*)(ws + WS_WGU), gu_row(32 * nb), F.in[IN_FFNNORM], 1.f, scr, F.lane); continue; } r -= I_GU;
        if (r < I_DN) { const int kb = r / 32, nb = r % 32; tr_item(F.in[IN_DDN], D, FF, 64 * kb, 32 * nb, D, (bf16*)(ws + WS_WD), 32 * nb, nullptr, 1.f, scr, F.lane); continue; } r -= I_DN;
        if (r < I_KV) { const int kb = r / 64, nb = r % 64; tr_item(F.in[IN_KVW], 2 * D, D, 64 * kb, 32 * nb, 2 * D, (bf16*)(ws + WS_WKVQ), (nb < 32) ? 32 * nb : 1024 + 32 * nb, F.in[IN_KVNORM], 1.f, scr, F.lane); continue; } r -= I_KV;
        if (r < I_SQ) { const int kb = r / 32, nb = r % 32; tr_item(F.in[IN_BWQ], D, D, 64 * kb, 32 * nb, D, (bf16*)(ws + WS_WKVQ), 1024 + 32 * nb, F.in[IN_BNORM], SBSCALE, scr, F.lane); continue; } r -= I_SQ;
        if (r < I_SQ) { const int kb = r / 32, nb = r % 32; tr_item(F.in[IN_BWOUT], D, D, 64 * kb, 32 * nb, D, (bf16*)(ws + WS_WOB), 32 * nb, nullptr, 1.f, scr, F.lane); continue; } r -= I_SQ;
        if (r < NE * I_GU) { const int e = r / I_GU, rr = r % I_GU, kb = rr / 176, nb = rr % 176;
            tr_item(F.in[IN_MGU] + (size_t)e * D * 2 * FF, 2 * FF, D, 64 * kb, 32 * nb, 2 * FF, (bf16*)(ws + WS_WGUM), e * 2 * FF + gu_row(32 * nb), F.in[IN_FFNNORM] + D, 1.f, scr, F.lane); continue; } r -= NE * I_GU;
        { const int e = r / I_DN, rr = r % I_DN, kb = rr / 32, nb = rr % 32;
            tr_item(F.in[IN_MDN] + (size_t)e * FF * D, D, FF, 64 * kb, 32 * nb, D, (bf16*)(ws + WS_WDM), e * D + 32 * nb, nullptr, 1.f, scr, F.lane); }
    }
    const float* x = F.in[IN_X]; bf16* XB = (bf16*)(ws + WS_XB); float* SS0 = (float*)(ws + WS_SS0);
    for (int m = gw; m < M; m += NGW) {
        const GAS f32x4* xr = (const GAS f32x4*)(x + (size_t)m * D) + F.lane; f32x4 v[4]; float s = 0.f;
#pragma unroll
        for (int j = 0; j < 4; ++j) { v[j] = xr[64 * j]; s += (v[j].x * v[j].x + v[j].y * v[j].y) + (v[j].z * v[j].z + v[j].w * v[j].w); }
        s = wave_sum(s);
        GAS unsigned long long* o8 = (GAS unsigned long long*)(XB + (size_t)m * D) + F.lane;
#pragma unroll
        for (int j = 0; j < 4; ++j) o8[64 * j] = (unsigned long long)pk2(v[j].x, v[j].y) | ((unsigned long long)pk2(v[j].z, v[j].w) << 32);
        if (F.lane < 16) SS0[(size_t)m * 16 + F.lane] = (F.lane == 0) ? s : 0.f;
    }
}

__device__ __forceinline__ void rope8(float (&y)[8], bool isx1, bool isx2, int i0, int pshift, float pos, const float* inv) {
#pragma unroll
    for (int e = 0; e < 8; ++e) {
        const float other = __shfl_xor(y[e], pshift);
        if (isx1 || isx2) { float c, s; sincos_acc(pos * inv[i0 + e], c, s); y[e] = isx1 ? (y[e] * c - other * s) : (y[e] * c + other * s); }
    }
}
__device__ __forceinline__ void unpack8(const v4u w, float (&y)[8]) { y[0] = bflo(w.x); y[1] = bfhi(w.x); y[2] = bflo(w.y); y[3] = bfhi(w.y); y[4] = bflo(w.z); y[5] = bfhi(w.z); y[6] = bflo(w.w); y[7] = bfhi(w.w); }
__device__ __forceinline__ v4u pack8(const float (&y)[8]) { v4u o; o.x = pk2(y[0], y[1]); o.y = pk2(y[2], y[3]); o.z = pk2(y[4], y[5]); o.w = pk2(y[6], y[7]); return o; }
__device__ __forceinline__ void p2_post(Frame& F) {
    unsigned char* ws = F.ws; const int lane = F.lane;
    const bf16* PROJ = (const bf16*)(ws + WS_PROJ); const bf16* XB = (const bf16*)(ws + WS_XB); const bf16* WT = (const bf16*)(ws + WS_WTAIL); const float* SS0 = (const float*)(ws + WS_SS0);
    bf16* QF = (bf16*)(ws + WS_QF); bf16* KVF = (bf16*)(ws + WS_KVF); bf16* QIF = (bf16*)(ws + WS_QIF); bf16* KIF = (bf16*)(ws + WS_KIF); float* WIF = (float*)(ws + WS_WIF);
    const float* qnw = F.in[IN_AQN]; const float* knw = F.in[IN_AKN];
    const int gw = F.wave * F.G + F.bid, NGW = F.G * NWAVES;
    for (int task = gw; task < M / 16; task += NGW) {
        const int row0 = task * 16;
        f32x4 acc[5];
#pragma unroll
        for (int c = 0; c < 5; ++c) acc[c] = (f32x4){0.f, 0.f, 0.f, 0.f};
        const bf16* ap = XB + (size_t)(row0 + (lane & 15)) * D + 8 * (lane >> 4);
        const bf16* bp = WT + (size_t)(lane & 15) * D + 8 * (lane >> 4);
#pragma unroll 4
        for (int j = 0; j < 32; ++j) {
            const bf16x8 a = *(const bf16x8*)(ap + 32 * j);
#pragma unroll
            for (int c = 0; c < 5; ++c) { const bf16x8 b = *(const bf16x8*)(bp + (size_t)(16 * c) * D + 32 * j); acc[c] = __builtin_amdgcn_mfma_f32_16x16x32_bf16(a, b, acc[c], 0, 0, 0); }
        }
#pragma unroll
        for (int reg = 0; reg < 4; ++reg) {
            const int row = row0 + 4 * (lane >> 4) + reg; const float rs = pg8::rstd16(SS0 + (size_t)row * 16); const float pos = (float)(row & (SEQ - 1));
            const int d = lane & 15;
            float v0 = acc[0][reg] * rs; const float other = __shfl_xor(v0, 8);
            { float c, s; sincos_acc(pos * INV_I[d & 7], c, s); v0 = (d < 8) ? (v0 * c - other * s) : (v0 * c + other * s); }
            KIF[(size_t)row * IDX + d] = (bf16)f2bf(v0);
#pragma unroll
            for (int c = 1; c < 4; ++c) KIF[(size_t)row * IDX + 16 * c + d] = (bf16)f2bf(acc[c][reg] * rs);
            if (d < 8) WIF[(size_t)row * 8 + d] = acc[4][reg] * rs * WISCALE;
        }
        for (int r = 0; r < 16; ++r) {
            const int row = row0 + r, b = row >> 13, t = row & (SEQ - 1); const float pos = (float)t;
            const bf16* pr = PROJ + (size_t)row * 2048 + 8 * lane;
            v4u w[4];
#pragma unroll
            for (int j = 0; j < 4; ++j) w[j] = *(const v4u*)(pr + 512 * j);
#pragma unroll
            for (int j = 0; j < 2; ++j) {
                float y[8]; unpack8(w[j], y); float ss = 0.f;
#pragma unroll
                for (int e = 0; e < 8; ++e) ss += y[e] * y[e];
                ss += __shfl_xor(ss, 1); ss += __shfl_xor(ss, 2); ss += __shfl_xor(ss, 4); ss += __shfl_xor(ss, 8);
                const float rs = 1.0f / sqrtf(ss * (1.0f / 128.0f) + 1e-6f); const int c8 = (lane & 15) * 8;
#pragma unroll
                for (int e = 0; e < 8; ++e) y[e] = y[e] * rs * qnw[c8 + e];
                rope8(y, c8 < 16, c8 >= 16 && c8 < 32, c8 & 15, 2, pos, INV_Q);
#pragma unroll
                for (int e = 0; e < 8; ++e) y[e] *= QSCALE;
                *(v4u*)(QF + (size_t)row * D + 512 * j + 8 * lane) = pack8(y);
            }
            {
                float y[8]; unpack8(w[2], y); float ss = 0.f;
#pragma unroll
                for (int e = 0; e < 8; ++e) ss += y[e] * y[e];
                ss += __shfl_xor(ss, 1); ss += __shfl_xor(ss, 2); ss += __shfl_xor(ss, 4); ss += __shfl_xor(ss, 8);
                const bool isk = lane < 32; const float rs = 1.0f / sqrtf(ss * (1.0f / 128.0f) + 1e-6f); const int c8 = (lane & 15) * 8;
                if (isk) {
#pragma unroll
                    for (int e = 0; e < 8; ++e) y[e] = y[e] * rs * knw[c8 + e];
                }
                rope8(y, isk && c8 < 16, isk && c8 >= 16 && c8 < 32, c8 & 15, 2, pos, INV_Q);
                const int kvh = (lane >> 4) & 1;
                *(v4u*)(KVF + ((size_t)(b * NKV + kvh) * SEQ + t) * 256 + (isk ? 0 : 128) + c8) = pack8(y);
            }
            {
                float y[8]; unpack8(w[3], y); const int c8 = (lane & 7) * 8;
                rope8(y, c8 == 0, c8 == 8, 0, 1, pos, INV_I);
                *(v4u*)(QIF + (size_t)row * 512 + 8 * lane) = pack8(y);
            }
        }
    }
}

__device__ __forceinline__ unsigned f2key(float f) { const unsigned u = __float_as_uint(f); return (u & 0x80000000u) ? ~u : (u | 0x80000000u); }
__device__ __forceinline__ void p3_query_naive(unsigned char* ws, LAS unsigned char* lds, int row, int* SEL) {
    const int tid = threadIdx.x, lane = tid & 63, wave = tid >> 6;
    const bf16* QIF = (const bf16*)(ws + WS_QIF); const bf16* KIF = (const bf16*)(ws + WS_KIF); const float* WIF = (const float*)(ws + WS_WIF);
    LAS unsigned* keys = (LAS unsigned*)lds;
    LAS float* qis = (LAS float*)(lds + 32768);
    LAS float* wl = (LAS float*)(lds + 32768 + 2048);
    LAS unsigned* hist = (LAS unsigned*)(lds + 36864);
    LAS unsigned* ctl = (LAS unsigned*)(lds + 36864 + 1024);
    LAS unsigned* wcnt = (LAS unsigned*)(lds + 36864 + 1024 + 64);
    {
        const int b = row >> 13, t = row & (SEQ - 1), n = t + 1;
        int* sel = SEL + (size_t)row * TOPK;
        if (n <= TOPK) { if (tid < TOPK) sel[tid] = tid < n ? tid : 0; return; }
        __syncthreads();
        qis[tid] = __uint_as_float((unsigned)QIF[(size_t)row * 512 + tid] << 16);
        if (tid < 8) wl[tid] = WIF[(size_t)row * 8 + tid];
        __syncthreads();
        for (int s = tid; s < n; s += 512) {
            const v4u* kp = (const v4u*)(KIF + ((size_t)(b << 13) + s) * IDX);
            float kf[64];
#pragma unroll
            for (int j = 0; j < 8; ++j) { const v4u w = kp[j]; kf[8 * j] = bflo(w.x); kf[8 * j + 1] = bfhi(w.x); kf[8 * j + 2] = bflo(w.y); kf[8 * j + 3] = bfhi(w.y); kf[8 * j + 4] = bflo(w.z); kf[8 * j + 5] = bfhi(w.z); kf[8 * j + 6] = bflo(w.w); kf[8 * j + 7] = bfhi(w.w); }
            float sc = 0.f;
#pragma unroll
            for (int h = 0; h < 8; ++h) { float d = 0.f; asm volatile("" ::: "memory");
#pragma unroll
                for (int dd = 0; dd < 64; ++dd) d += qis[h * 64 + dd] * kf[dd];
                sc += wl[h] * fmaxf(d, 0.f); }
            keys[s] = f2key(sc + 0.0f);
        }
        __syncthreads();
        unsigned prefix = 0u, mask = 0u, need = TOPK;
        for (int pass = 0; pass < 4; ++pass) {
            const int shift = 24 - 8 * pass;
            if (tid < 256) hist[tid] = 0u;
            __syncthreads();
            for (int s = tid; s < n; s += 512) { const unsigned k = keys[s]; if ((k & mask) == prefix) __hip_atomic_fetch_add(&hist[(k >> shift) & 255u], 1u, __ATOMIC_RELAXED, __HIP_MEMORY_SCOPE_WORKGROUP); }
            __syncthreads();
            if (tid < 64) {
                const unsigned h0 = hist[4 * lane], h1 = hist[4 * lane + 1], h2 = hist[4 * lane + 2], h3 = hist[4 * lane + 3]; const unsigned tot = h0 + h1 + h2 + h3;
                unsigned incl = tot;
#pragma unroll
                for (int o = 1; o < 64; o <<= 1) { const unsigned v = __shfl_down(incl, o); if (lane + o < 64) incl += v; }
                const unsigned above = incl - tot;
                if (above < need && need <= above + tot) {
                    unsigned a = above; unsigned bin;
                    if (a + h3 >= need) bin = 3; else { a += h3; if (a + h2 >= need) bin = 2; else { a += h2; if (a + h1 >= need) bin = 1; else { a += h1; bin = 0; } } }
                    ctl[0] = 4 * lane + bin; ctl[1] = need - a;
                }
            }
            __syncthreads();
            prefix |= ctl[0] << shift; mask |= 255u << shift; need = ctl[1];
            __syncthreads();
        }
        const unsigned thr = prefix, n_gt = TOPK - need;
        unsigned base_gt = 0u, base_eq = 0u;
        for (int s0 = 0; s0 < n; s0 += 512) {
            const int s = s0 + tid; const unsigned k = s < n ? keys[s] : 0u; const bool gt = (s < n) && (k > thr); const bool eq = (s < n) && (k == thr);
            const unsigned long long bg = __ballot(gt), be = __ballot(eq); const unsigned long long lt = (1ull << lane) - 1ull;
            const unsigned rg = __popcll(bg & lt), re = __popcll(be & lt);
            if (lane == 0) { wcnt[wave] = __popcll(bg); wcnt[8 + wave] = __popcll(be); }
            __syncthreads();
            unsigned og = base_gt, oe = base_eq, tg = 0u, te = 0u;
#pragma unroll
            for (int w = 0; w < 8; ++w) { const unsigned cg = wcnt[w], ce = wcnt[8 + w]; if (w < wave) { og += cg; oe += ce; } tg += cg; te += ce; }
            if (gt) sel[og + rg] = s;
            if (eq && oe + re < need) sel[n_gt + oe + re] = s;
            base_gt += tg; base_eq += te;
            __syncthreads();
        }
    }
}

#define WAVE_SYNC() asm volatile("s_waitcnt lgkmcnt(0)" ::: "memory")
constexpr int P3_HIST = 0, P3_H2 = 65536, P3_BM = 98304, P3_QS = 114688, P3_FLAG = P3_QS + 512, P3_CAP = 512;
__device__ __forceinline__ void find_bin_2048(LAS const unsigned* hist, unsigned need, int lane, unsigned& bin_out, unsigned& need_out, unsigned& cnt_out, bool& ok) {
    unsigned w[16]; unsigned tot = 0u;
#pragma unroll
    for (int i = 0; i < 16; ++i) { w[i] = hist[16 * lane + i]; tot += (w[i] & 0xffffu) + (w[i] >> 16); }
    unsigned incl = tot;
#pragma unroll
    for (int o = 1; o < 64; o <<= 1) { const unsigned v = __shfl_down(incl, o); if (lane + o < 64) incl += v; }
    const unsigned above = incl - tot;
    const bool mine = (above < need) && (need <= above + tot);
    unsigned a = above, fb = 0u, fn = 0u, fc = 0u; bool found = false;
#pragma unroll
    for (int i = 15; i >= 0; --i) {
        const unsigned h1 = w[i] >> 16, h0 = w[i] & 0xffffu;
        if (!found) { if (a + h1 >= need) { found = true; fb = 32u * lane + 2u * i + 1u; fn = need - a; fc = h1; } else a += h1; }
        if (!found) { if (a + h0 >= need) { found = true; fb = 32u * lane + 2u * i; fn = need - a; fc = h0; } else a += h0; }
    }
    const unsigned long long bm = __ballot(mine);
    ok = (bm != 0ull);
    const int src = ok ? (__ffsll((long long)bm) - 1) : 0;
    bin_out = (unsigned)__builtin_amdgcn_readlane((int)fb, src); need_out = (unsigned)__builtin_amdgcn_readlane((int)fn, src); cnt_out = (unsigned)__builtin_amdgcn_readlane((int)fc, src);
}
template <int PASS> __device__ __forceinline__ void p3_score_pass(const bf16x8 (&af)[2][4], const float (&wv)[2][16], const bf16* kib, int t0, int nt, int wave, int n, int hi,
                                                                  LAS unsigned char* lds, const unsigned (&thr)[2][2]) {
    LAS unsigned* HIST = (LAS unsigned*)(lds + P3_HIST); LAS unsigned* BM = (LAS unsigned*)(lds + P3_BM); LAS unsigned* QS = (LAS unsigned*)(lds + P3_QS);
    const int kmax = t0 + 15;
    bf16x8 bc[4], bn[4];
    const int qh = 8 * (wave >> 2), w4 = wave & 3;
    { const int k = (32 * w4 + n < kmax) ? (32 * w4 + n) : kmax; const bf16* kp = kib + (size_t)k * IDX + 32 * hi;
#pragma unroll
      for (int s = 0; s < 4; ++s) bc[s] = *(const bf16x8*)(kp + 8 * s); }
    for (int tile = w4; tile < nt; tile += 4) {
        { const int tn = (tile + 4 < nt) ? tile + 4 : tile; const int k = (32 * tn + n < kmax) ? (32 * tn + n) : kmax; const bf16* kp = kib + (size_t)k * IDX + 32 * hi;
#pragma unroll
          for (int s = 0; s < 4; ++s) bn[s] = *(const bf16x8*)(kp + 8 * s); }
        const int key = 32 * tile + n; const bool full = (32 * tile + 31 <= t0);
#pragma unroll
        for (int mt = 0; mt < 2; ++mt) {
            f32x16 acc;
#pragma unroll
            for (int r = 0; r < 16; ++r) acc[r] = 0.f;
#pragma unroll
            for (int s = 0; s < 4; ++s) acc = __builtin_amdgcn_mfma_f32_32x32x16_bf16(af[mt][s], bc[s], acc, 0, 0, 0);
            float s0 = 0.f, s1 = 0.f;
#pragma unroll
            for (int r = 0; r < 8; ++r) { s0 = __builtin_fmaf(wv[mt][r], fmaxf(acc[r], 0.f), s0); s1 = __builtin_fmaf(wv[mt][8 + r], fmaxf(acc[8 + r], 0.f), s1); }
#pragma unroll
            for (int j = 0; j < 2; ++j) {
                const int q = qh + 4 * mt + hi + 2 * j; const float sc = j ? s1 : s0; const bool valid = full || (key <= t0 + q);
                const unsigned k32 = f2key(sc + 0.0f), bin = k32 >> 21;
                if (valid) {
                    if (PASS == 1) { __hip_atomic_fetch_add(&HIST[q * 1024 + (bin >> 1)], 1u << (16 * (bin & 1u)), __ATOMIC_RELAXED, __HIP_MEMORY_SCOPE_WORKGROUP); }
                    else {
                        if (bin > thr[mt][j]) { __hip_atomic_fetch_or(&BM[q * 256 + (key >> 5)], 1u << (key & 31), __ATOMIC_RELAXED, __HIP_MEMORY_SCOPE_WORKGROUP); }
                        else if (bin == thr[mt][j]) { const unsigned pos = __hip_atomic_fetch_add(&QS[q * 8 + 3], 1u, __ATOMIC_RELAXED, __HIP_MEMORY_SCOPE_WORKGROUP);
                            if (pos < (unsigned)P3_CAP) { HIST[q * 1024 + 2 * pos] = k32; HIST[q * 1024 + 2 * pos + 1] = (unsigned)key; } }
                    }
                }
            }
        }
#pragma unroll
        for (int s = 0; s < 4; ++s) bc[s] = bn[s];
    }
}
__device__ __forceinline__ void p3_index(Frame& F) {
    unsigned char* ws = F.ws; const int tid = F.tid, lane = F.lane, wave = F.wave, n = lane & 31, hi = lane >> 5;
    const bf16* QIF = (const bf16*)(ws + WS_QIF); const bf16* KIF = (const bf16*)(ws + WS_KIF); const float* WIF = (const float*)(ws + WS_WIF); int* SEL = (int*)(ws + WS_SEL);
    LAS unsigned char* lds = F.lds;
    LAS unsigned* HIST = (LAS unsigned*)(lds + P3_HIST); LAS unsigned* H2 = (LAS unsigned*)(lds + P3_H2 + wave * 4096); LAS unsigned* BM = (LAS unsigned*)(lds + P3_BM); LAS unsigned* QS = (LAS unsigned*)(lds + P3_QS);
    LAS unsigned* FLAG = (LAS unsigned*)(lds + P3_FLAG); LAS unsigned* FBL = (LAS unsigned*)(lds + P3_QS + 1024);
    if (tid == 0) FBL[0] = 0u;
    __syncthreads();
    for (int ps = F.bid; ps < 512; ps += F.G) {
        const int b = ps >> 8, wq = ps & 255;
#pragma unroll 1
        for (int half = 0; half < 2; ++half) {
            const int idx = half ? (511 - wq) : wq; const int t0 = 16 * idx, row0 = (b << 13) + t0;
            if (idx < 16) {
                for (int e = tid; e < 16 * TOPK; e += 512) { const int q = e >> 8, i = e & 255; SEL[(size_t)(row0 + q) * TOPK + i] = (i <= t0 + q) ? i : 0; }
                continue;
            }
            for (int e = tid; e < 16384; e += 512) HIST[e] = 0u;
            for (int e = tid; e < 4096; e += 512) BM[e] = 0u;
            if (tid < 132) QS[tid] = 0u;
            bf16x8 af[2][4]; float wv[2][16]; const int qh = 8 * (wave >> 2);
            { const int head = (n & 3) + 4 * ((n >> 3) & 1), q4 = ((n >> 2) & 1) + 2 * (n >> 4);
#pragma unroll
              for (int mt = 0; mt < 2; ++mt) { const bf16* ap = QIF + (size_t)(row0 + qh + 4 * mt + q4) * 512 + head * IDX + 32 * hi;
#pragma unroll
                  for (int s = 0; s < 4; ++s) af[mt][s] = *(const bf16x8*)(ap + 8 * s);
#pragma unroll
                  for (int r = 0; r < 16; ++r) wv[mt][r] = WIF[(size_t)(row0 + qh + 4 * mt + hi + 2 * (r >> 3)) * 8 + (r & 7)]; } }
            const int nt = (t0 + 16 + 31) >> 5; const bf16* kib = KIF + (size_t)(b << 13) * IDX;
            unsigned thr[2][2] = {{0u, 0u}, {0u, 0u}};
            __syncthreads();
            p3_score_pass<1>(af, wv, kib, t0, nt, wave, n, hi, lds, thr);
            __syncthreads();
#pragma unroll 1
            for (int qq = 0; qq < 2; ++qq) { const int q = 2 * wave + qq; unsigned bin, need, cnt; bool ok;
                find_bin_2048(HIST + q * 1024, (unsigned)TOPK, lane, bin, need, cnt, ok);
                if (lane == 0) { QS[q * 8 + 0] = bin; QS[q * 8 + 1] = need; QS[q * 8 + 2] = cnt; if (!ok || cnt > (unsigned)P3_CAP) FLAG[0] = 1u; } }
            __syncthreads();
            if (FLAG[0] != 0u) {
                if (tid == 0) { const unsigned k = FBL[0]; if (k < 15u) { FBL[1 + k] = (unsigned)row0; FBL[0] = k + 1u; } }
                __syncthreads();
                continue;
            }
#pragma unroll
            for (int mt = 0; mt < 2; ++mt)
#pragma unroll
                for (int j = 0; j < 2; ++j) thr[mt][j] = QS[(qh + 4 * mt + hi + 2 * j) * 8];
            __syncthreads();
            p3_score_pass<2>(af, wv, kib, t0, nt, wave, n, hi, lds, thr);
            __syncthreads();
#pragma unroll 1
            for (int qq = 0; qq < 2; ++qq) {
                const int q = 2 * wave + qq; LAS unsigned* cand = HIST + q * 1024; LAS unsigned* bmq = BM + q * 256;
                const unsigned needA = QS[q * 8 + 1], c = QS[q * 8 + 2];
#pragma unroll
                for (int i = 0; i < 16; ++i) H2[16 * lane + i] = 0u;
                for (unsigned i = lane; i < c; i += 64) { const unsigned bb = (cand[2 * i] >> 10) & 2047u; __hip_atomic_fetch_add(&H2[bb >> 1], 1u << (16 * (bb & 1u)), __ATOMIC_RELAXED, __HIP_MEMORY_SCOPE_WORKGROUP); }
                WAVE_SYNC();
                unsigned binB, needB, cntB; bool okB;
                find_bin_2048(H2, needA, lane, binB, needB, cntB, okB);
                unsigned lcn = 0u;
                for (unsigned i0 = 0; i0 < c; i0 += 64) { const unsigned i = i0 + lane; const bool in = i < c; const unsigned k32 = in ? cand[2 * i] : 0u, ki = in ? (cand[2 * i + 1] & 8191u) : 0u; const unsigned bb = (k32 >> 10) & 2047u;
                    if (in && bb > binB) __hip_atomic_fetch_or(&bmq[ki >> 5], 1u << (ki & 31), __ATOMIC_RELAXED, __HIP_MEMORY_SCOPE_WORKGROUP);
                    const bool isC = in && (bb == binB); const unsigned long long mC = __ballot(isC);
                    if (isC) { const unsigned pos = lcn + (unsigned)__popcll(mC & ((1ull << lane) - 1ull)); H2[2 * pos] = k32; H2[2 * pos + 1] = ki; }
                    lcn += (unsigned)__popcll(mC); }
                WAVE_SYNC();
                for (unsigned i0 = 0; i0 < lcn; i0 += 64) { const unsigned i = i0 + lane; const bool in = i < lcn; const unsigned k32 = in ? H2[2 * i] : 0u, ki = in ? H2[2 * i + 1] : 0u; unsigned rank = 0u;
                    for (unsigned j = 0; j < lcn; ++j) { const unsigned kj = H2[2 * j], ij = H2[2 * j + 1]; rank += (kj > k32 || (kj == k32 && ij < ki)) ? 1u : 0u; }
                    if (in && rank < needB) __hip_atomic_fetch_or(&bmq[ki >> 5], 1u << (ki & 31), __ATOMIC_RELAXED, __HIP_MEMORY_SCOPE_WORKGROUP); }
                WAVE_SYNC();
                unsigned w0 = bmq[4 * lane], w1 = bmq[4 * lane + 1], w2 = bmq[4 * lane + 2], w3 = bmq[4 * lane + 3];
                const unsigned mycnt = __popc(w0) + __popc(w1) + __popc(w2) + __popc(w3);
                unsigned incl = mycnt;
#pragma unroll
                for (int o = 1; o < 64; o <<= 1) { const unsigned v = __shfl_up(incl, o); if (lane >= o) incl += v; }
                unsigned pos = incl - mycnt; int* sel = SEL + (size_t)(row0 + q) * TOPK;
#pragma unroll
                for (int wi = 0; wi < 4; ++wi) { unsigned w = (wi == 0) ? w0 : (wi == 1) ? w1 : (wi == 2) ? w2 : w3;
                    while (w) { const int bit = __ffs((int)w) - 1; if (pos < (unsigned)TOPK) sel[pos] = 128 * lane + 32 * wi + bit; ++pos; w &= w - 1u; } }
            }
            __syncthreads();
        }
    }
    __syncthreads();
    const unsigned nfb = FBL[0];
    for (unsigned k = 0; k < nfb; ++k) { const int r0 = (int)FBL[1 + k]; __syncthreads();
        for (int q = 0; q < 16; ++q) p3_query_naive(ws, lds, r0 + q, SEL); }
}

__device__ __forceinline__ void p4_dsa_naive(Frame& F) {
    unsigned char* ws = F.ws; const int lane = F.lane;
    const bf16* QF = (const bf16*)(ws + WS_QF); const bf16* KVF = (const bf16*)(ws + WS_KVF); const int* SEL = (const int*)(ws + WS_SEL); bf16* AO = (bf16*)(ws + WS_AO);
    LAS f32x4* sc = (LAS f32x4*)(F.lds + F.wave * 4096);
    const int gw = F.wave * F.G + F.bid, NGW = F.G * NWAVES;
    for (int p = gw; p < 2 * M; p += NGW) {
        const int row = p >> 1, kvh = p & 1, b = row >> 13, t = row & (SEQ - 1); const int cnt = (t + 1 < TOPK) ? (t + 1) : TOPK;
        const int* sel = SEL + (size_t)row * TOPK;
        int myidx[4];
#pragma unroll
        for (int j = 0; j < 4; ++j) myidx[j] = sel[lane + 64 * j];
        float qa[4], qb[4];
#pragma unroll
        for (int g = 0; g < 4; ++g) { const unsigned w = *(const unsigned*)(QF + (size_t)row * D + (kvh * 4 + g) * HD + 2 * lane); qa[g] = bflo(w); qb[g] = bfhi(w); }
        const bf16* kvb = KVF + (size_t)(b * NKV + kvh) * SEQ * 256 + 2 * lane;
#pragma unroll
        for (int j = 0; j < 4; ++j) {
            const int lim = cnt - 64 * j < 64 ? cnt - 64 * j : 64;
            for (int i = 0; i < lim; ++i) {
                const int key = __builtin_amdgcn_readlane(myidx[j], i);
                const unsigned w = *(const unsigned*)(kvb + (size_t)key * 256); const float k0 = bflo(w), k1 = bfhi(w);
                f32x4 d;
                d[0] = wave_sum(qa[0] * k0 + qb[0] * k1); d[1] = wave_sum(qa[1] * k0 + qb[1] * k1); d[2] = wave_sum(qa[2] * k0 + qb[2] * k1); d[3] = wave_sum(qa[3] * k0 + qb[3] * k1);
                if (lane == 0) sc[64 * j + i] = d;
            }
        }
        float mx[4] = {-INFINITY, -INFINITY, -INFINITY, -INFINITY};
#pragma unroll
        for (int j = 0; j < 4; ++j) { const int pp = lane + 64 * j; if (pp < cnt) { const f32x4 v = sc[pp];
#pragma unroll
            for (int g = 0; g < 4; ++g) mx[g] = fmaxf(mx[g], v[g]); } }
#pragma unroll
        for (int g = 0; g < 4; ++g) mx[g] = wave_max(mx[g]);
        float sm[4] = {0.f, 0.f, 0.f, 0.f};
#pragma unroll
        for (int j = 0; j < 4; ++j) { const int pp = lane + 64 * j; if (pp < cnt) { f32x4 v = sc[pp];
#pragma unroll
            for (int g = 0; g < 4; ++g) { v[g] = __builtin_amdgcn_exp2f(v[g] - mx[g]); sm[g] += v[g]; }
            sc[pp] = v; } }
#pragma unroll
        for (int g = 0; g < 4; ++g) sm[g] = 1.0f / wave_sum(sm[g]);
        float oa[4] = {0.f, 0.f, 0.f, 0.f}, ob[4] = {0.f, 0.f, 0.f, 0.f};
#pragma unroll
        for (int j = 0; j < 4; ++j) {
            const int lim = cnt - 64 * j < 64 ? cnt - 64 * j : 64;
            for (int i = 0; i < lim; ++i) {
                const int key = __builtin_amdgcn_readlane(myidx[j], i);
                const unsigned w = *(const unsigned*)(kvb + (size_t)key * 256 + 128); const float v0 = bflo(w), v1 = bfhi(w);
                const f32x4 pr = sc[64 * j + i];
#pragma unroll
                for (int g = 0; g < 4; ++g) { oa[g] += pr[g] * v0; ob[g] += pr[g] * v1; }
            }
        }
#pragma unroll
        for (int g = 0; g < 4; ++g) *(unsigned*)(AO + (size_t)row * D + (kvh * 4 + g) * HD + 2 * lane) = pk2(oa[g] * sm[g], ob[g] * sm[g]);
    }
}

typedef short v4i16_t __attribute__((ext_vector_type(4)));
typedef int v4i __attribute__((ext_vector_type(4)));
__device__ __forceinline__ v4i16_t tr16(LAS unsigned char* p) { return __builtin_amdgcn_ds_read_tr16_b64_v4i16((LAS v4i16_t*)p); }
__device__ __forceinline__ void p4_dsa(Frame& F) {
    unsigned char* ws = F.ws; const int lane = F.lane, nh = lane & 15, kg = lane >> 4;
    const bf16* QF = (const bf16*)(ws + WS_QF); const bf16* KVF = (const bf16*)(ws + WS_KVF); const int* SEL = (const int*)(ws + WS_SEL); bf16* AO = (bf16*)(ws + WS_AO);
    LAS unsigned char* wl = F.lds + F.wave * 10240; LAS int* selw = (LAS int*)wl; LAS unsigned char* vb = wl + 1024;
    const int gw = F.wave * F.G + F.bid, NGW = F.G * NWAVES;
    LAS unsigned char* trp = vb + (4 * kg + ((lane >> 2) & 3)) * 288 + 8 * (lane & 3);
    for (int row = gw; row < M; row += NGW) {
        const int b = row >> 13, t = row & (SEQ - 1); const int cnt = (t + 1 < TOPK) ? (t + 1) : TOPK;
        *(LAS v4i*)(selw + 4 * lane) = *(const v4i*)(SEL + (size_t)row * TOPK + 4 * lane);
        WAVE_SYNC();
#pragma unroll 1
        for (int kvh = 0; kvh < NKV; ++kvh) {
            const bf16* kvb = KVF + (size_t)(b * NKV + kvh) * SEQ * 256;
            const bf16* qp = QF + (size_t)row * D + (kvh * 4 + (nh & 3)) * HD + 32 * kg;
            bf16x8 qf[4];
#pragma unroll
            for (int s = 0; s < 4; ++s) { qf[s] = *(const bf16x8*)(qp + 8 * s); if (nh >= 4) qf[s] = (bf16x8){0, 0, 0, 0, 0, 0, 0, 0}; }
            f32x4 S[16];
#pragma unroll
            for (int T = 0; T < 16; ++T) {
                const int key = selw[16 * T + nh] & (SEQ - 1); const bf16* kp = kvb + (size_t)key * 256 + 32 * kg;
                const bf16x8 k0 = *(const bf16x8*)(kp), k1 = *(const bf16x8*)(kp + 8), k2 = *(const bf16x8*)(kp + 16), k3 = *(const bf16x8*)(kp + 24);
                f32x4 a = (f32x4){0.f, 0.f, 0.f, 0.f};
                a = __builtin_amdgcn_mfma_f32_16x16x32_bf16(k0, qf[0], a, 0, 0, 0); a = __builtin_amdgcn_mfma_f32_16x16x32_bf16(k1, qf[1], a, 0, 0, 0);
                a = __builtin_amdgcn_mfma_f32_16x16x32_bf16(k2, qf[2], a, 0, 0, 0); a = __builtin_amdgcn_mfma_f32_16x16x32_bf16(k3, qf[3], a, 0, 0, 0);
                S[T] = a;
            }
            float mx = -INFINITY;
#pragma unroll
            for (int T = 0; T < 16; ++T)
#pragma unroll
                for (int r = 0; r < 4; ++r) { const float v = (16 * T + 4 * kg + r < cnt) ? S[T][r] : -INFINITY; S[T][r] = v; mx = fmaxf(mx, v); }
            mx = fmaxf(mx, __shfl_xor(mx, 16)); mx = fmaxf(mx, __shfl_xor(mx, 32));
            float sum = 0.f;
#pragma unroll
            for (int T = 0; T < 16; ++T)
#pragma unroll
                for (int r = 0; r < 4; ++r) { const float e = __builtin_amdgcn_exp2f(S[T][r] - mx); S[T][r] = e; sum += e; }
            sum += __shfl_xor(sum, 16); sum += __shfl_xor(sum, 32);
            f32x4 O[8];
#pragma unroll
            for (int d = 0; d < 8; ++d) O[d] = (f32x4){0.f, 0.f, 0.f, 0.f};
            v4u g[8];
#pragma unroll
            for (int i = 0; i < 8; ++i) { const int key = selw[4 * i + kg] & (SEQ - 1); g[i] = *(const v4u*)(kvb + (size_t)key * 256 + 128 + 8 * nh); }
#pragma unroll
            for (int c = 0; c < 8; ++c) {
#pragma unroll
                for (int i = 0; i < 8; ++i) *(LAS v4u*)(vb + (4 * i + kg) * 288 + nh * 16) = g[i];
                if (c < 7) {
#pragma unroll
                    for (int i = 0; i < 8; ++i) { const int key = selw[32 * (c + 1) + 4 * i + kg] & (SEQ - 1); g[i] = *(const v4u*)(kvb + (size_t)key * 256 + 128 + 8 * nh); }
                }
                v4u pw; pw.x = pg8::cvt_pk_bf16(S[2 * c][0], S[2 * c][1]); pw.y = pg8::cvt_pk_bf16(S[2 * c][2], S[2 * c][3]); pw.z = pg8::cvt_pk_bf16(S[2 * c + 1][0], S[2 * c + 1][1]); pw.w = pg8::cvt_pk_bf16(S[2 * c + 1][2], S[2 * c + 1][3]);
                const bf16x8 pa = __builtin_bit_cast(bf16x8, pw);
#pragma unroll
                for (int d = 0; d < 8; ++d) {
                    const v4i16_t lo = tr16(trp + 32 * d), hi4 = tr16(trp + 16 * 288 + 32 * d);
                    const bf16x8 vfr = (bf16x8){lo[0], lo[1], lo[2], lo[3], hi4[0], hi4[1], hi4[2], hi4[3]};
                    O[d] = __builtin_amdgcn_mfma_f32_16x16x32_bf16(pa, vfr, O[d], 0, 0, 0);
                }
            }
            const float i0 = 1.0f / __builtin_bit_cast(float, __builtin_amdgcn_readlane(__builtin_bit_cast(int, sum), 0)), i1 = 1.0f / __builtin_bit_cast(float, __builtin_amdgcn_readlane(__builtin_bit_cast(int, sum), 1));
            const float i2 = 1.0f / __builtin_bit_cast(float, __builtin_amdgcn_readlane(__builtin_bit_cast(int, sum), 2)), i3 = 1.0f / __builtin_bit_cast(float, __builtin_amdgcn_readlane(__builtin_bit_cast(int, sum), 3));
            LAS bf16* ost = (LAS bf16*)vb;
            if (kg == 0) {
#pragma unroll
                for (int d = 0; d < 8; ++d) { ost[0 * 128 + 16 * d + nh] = (bf16)f2bf(O[d][0] * i0); ost[1 * 128 + 16 * d + nh] = (bf16)f2bf(O[d][1] * i1); ost[2 * 128 + 16 * d + nh] = (bf16)f2bf(O[d][2] * i2); ost[3 * 128 + 16 * d + nh] = (bf16)f2bf(O[d][3] * i3); }
            }
            WAVE_SYNC();
            const v4u ov = *(LAS v4u*)(vb + 16 * lane);
            *(v4u*)(AO + (size_t)row * D + (kvh * 4 + kg) * HD + 8 * nh) = ov;
        }
    }
}

__device__ __forceinline__ void p9_sb(Frame& F) {
    unsigned char* ws = F.ws; const int lane = F.lane, n = lane & 31, hi = lane >> 5;
    const bf16* KQ = (const bf16*)(ws + WS_KQ); const bf16* VT = (const bf16*)(ws + WS_VT); bf16* AO = (bf16*)(ws + WS_AO);
    const int gw = F.wave * F.G + F.bid, NGW = F.G * NWAVES;
    const int koff = 16 * (n >> 4) + 8 * ((n >> 2) & 1) + 4 * ((n >> 3) & 1) + (n & 3);
    constexpr float LOG2E = 1.4426950408889634f, LN2 = 0.6931471805599453f;
    for (int u = gw; u < (M / 32) * NH; u += NGW) {
        const int h = u & 7, blk = u >> 3, b = blk >> 8, qb = blk & 255, q0 = 32 * qb, t = q0 + n;
        const bf16* qp = KQ + (size_t)(b * SEQ + q0 + n) * 2048 + 1024 + h * HD + 64 * hi;
        bf16x8 qf[8];
#pragma unroll
        for (int s = 0; s < 8; ++s) qf[s] = *(const bf16x8*)(qp + 8 * s);
        f32x16 o[4];
#pragma unroll
        for (int mt = 0; mt < 4; ++mt)
#pragma unroll
            for (int r = 0; r < 16; ++r) o[mt][r] = 0.f;
        float C = 0.f;
        for (int kb = qb; kb >= 0; --kb) {
            const int k0 = 32 * kb;
            const bf16* kp = KQ + (size_t)(b * SEQ + k0 + koff) * 2048 + h * HD + 64 * hi;
            bf16x8 kf[8];
#pragma unroll
            for (int s = 0; s < 8; ++s) kf[s] = *(const bf16x8*)(kp + 8 * s);
            bf16x8 vf[4][2];
#pragma unroll
            for (int mt = 0; mt < 4; ++mt)
#pragma unroll
                for (int sp = 0; sp < 2; ++sp) vf[mt][sp] = *(const bf16x8*)(VT + (size_t)(h * HD + 32 * mt + n) * M + b * SEQ + k0 + 16 * sp + 8 * hi);
            f32x16 z;
#pragma unroll
            for (int r = 0; r < 16; ++r) z[r] = 0.f;
#pragma unroll
            for (int s = 0; s < 8; ++s) z = __builtin_amdgcn_mfma_f32_32x32x16_bf16(kf[s], qf[s], z, 0, 0, 0);
            float lk[16], lb[16];
#pragma unroll
            for (int r = 0; r < 16; ++r) {
                const int key = k0 + ((r < 8) ? (8 * hi + r) : (16 + 8 * hi + (r - 8)));
                const float zz = z[r]; const float L = __builtin_amdgcn_logf(1.0f + __builtin_amdgcn_exp2f(-fabsf(zz) * LOG2E)) * LN2;
                const bool valid = key < t;
                lk[r] = valid ? (-fmaxf(zz, 0.f) - L) : 0.f;
                lb[r] = valid ? (fminf(zz, 0.f) - L) : -INFINITY;
            }
            float suf[16];
            suf[7] = 0.f; suf[15] = 0.f;
#pragma unroll
            for (int i = 6; i >= 0; --i) { suf[i] = suf[i + 1] + lk[i + 1]; suf[8 + i] = suf[9 + i] + lk[9 + i]; }
            const float T0 = suf[0] + lk[0], T1 = suf[8] + lk[8];
            const float P0 = __shfl_xor(T0, 32), P1 = __shfl_xor(T1, 32);
            const float base1 = C + (hi ? 0.f : P1), base0 = C + (hi ? (T1 + P1) : (P0 + T1 + P1));
            unsigned pw[8];
#pragma unroll
            for (int r = 0; r < 16; r += 2) {
                const float a0 = __builtin_amdgcn_exp2f((lb[r] + ((r < 8) ? base0 : base1) + suf[r]) * LOG2E), a1 = __builtin_amdgcn_exp2f((lb[r + 1] + ((r < 8) ? base0 : base1) + suf[r + 1]) * LOG2E);
                pw[r >> 1] = pg8::cvt_pk_bf16(a0, a1);
            }
            C += (T0 + T1) + (P0 + P1);
            const bf16x8 pa0 = __builtin_bit_cast(bf16x8, (v4u){pw[0], pw[1], pw[2], pw[3]}), pa1 = __builtin_bit_cast(bf16x8, (v4u){pw[4], pw[5], pw[6], pw[7]});
#pragma unroll
            for (int mt = 0; mt < 4; ++mt) { o[mt] = __builtin_amdgcn_mfma_f32_32x32x16_bf16(vf[mt][0], pa0, o[mt], 0, 0, 0); o[mt] = __builtin_amdgcn_mfma_f32_32x32x16_bf16(vf[mt][1], pa1, o[mt], 0, 0, 0); }
            if (__all(C < -44.0f)) break;
        }
        bf16* op = AO + (size_t)(b * SEQ + q0 + n) * D + h * HD + 4 * hi;
#pragma unroll
        for (int mt = 0; mt < 4; ++mt)
#pragma unroll
            for (int g = 0; g < 4; ++g) { v2u w; w.x = pg8::cvt_pk_bf16(o[mt][4 * g], o[mt][4 * g + 1]); w.y = pg8::cvt_pk_bf16(o[mt][4 * g + 2], o[mt][4 * g + 3]); *(v2u*)(op + 32 * mt + 8 * g) = w; }
    }
}

__device__ __forceinline__ void p11_router(Frame& F) {
    unsigned char* ws = F.ws; const int tid = F.tid, lane = F.lane, wave = F.wave;
    const float* H = (const float*)(ws + WS_H); const float* gn = F.in[IN_FFNNORM] + D; const float* Wr = F.in[IN_ROUTER];
    int* TOPE = (int*)(ws + WS_RT); int* POS = (int*)(ws + WS_RT + 128 * 1024); float* GATE = (float*)(ws + WS_RT + 256 * 1024); float* RSTD3 = (float*)(ws + WS_RT + 384 * 1024);
    LAS unsigned* lcnt = (LAS unsigned*)F.lds;
    LAS unsigned* gb = (LAS unsigned*)(F.lds + 64);
    LAS int* ltok = (LAS int*)(F.lds + 128);
    LAS float* lgt = (LAS float*)(F.lds + 128 + 1024);
    for (int chunk = F.bid; chunk < M / 64; chunk += F.G) {
        if (tid < 8) lcnt[tid] = 0u;
        __syncthreads();
        for (int r = 0; r < 8; ++r) {
            const int row = chunk * 64 + wave * 8 + r;
            const GAS f32x4* xr = (const GAS f32x4*)(H + (size_t)row * D) + lane; f32x4 v[4]; float ss = 0.f;
#pragma unroll
            for (int j = 0; j < 4; ++j) { v[j] = xr[64 * j]; ss += (v[j].x * v[j].x + v[j].y * v[j].y) + (v[j].z * v[j].z + v[j].w * v[j].w); }
            ss = wave_sum(ss); const float rs = 1.0f / sqrtf(ss * (1.0f / 1024.0f) + 1e-6f);
            float lg[8] = {0.f, 0.f, 0.f, 0.f, 0.f, 0.f, 0.f, 0.f};
#pragma unroll
            for (int j = 0; j < 4; ++j)
#pragma unroll
                for (int i = 0; i < 4; ++i) { const int k = 256 * j + 4 * lane + i; const float xv = v[j][i] * gn[k]; const f32x4 w0 = *(const f32x4*)(Wr + (size_t)k * 8), w1 = *(const f32x4*)(Wr + (size_t)k * 8 + 4);
                    lg[0] += xv * w0[0]; lg[1] += xv * w0[1]; lg[2] += xv * w0[2]; lg[3] += xv * w0[3]; lg[4] += xv * w1[0]; lg[5] += xv * w1[1]; lg[6] += xv * w1[2]; lg[7] += xv * w1[3]; }
#pragma unroll
            for (int e = 0; e < 8; ++e) lg[e] = wave_sum(lg[e]) * rs;
            int i1 = 0; float l1 = lg[0];
#pragma unroll
            for (int e = 1; e < 8; ++e) if (lg[e] > l1) { l1 = lg[e]; i1 = e; }
            int i2 = -1; float l2 = -INFINITY;
#pragma unroll
            for (int e = 0; e < 8; ++e) if (e != i1 && lg[e] > l2) { l2 = lg[e]; i2 = e; }
            const float g1 = 1.0f / (1.0f + __expf(l2 - l1)), g2 = 1.0f - g1;
            if (lane == 0) {
                const unsigned p1 = __hip_atomic_fetch_add(&lcnt[i1], 1u, __ATOMIC_RELAXED, __HIP_MEMORY_SCOPE_WORKGROUP), p2 = __hip_atomic_fetch_add(&lcnt[i2], 1u, __ATOMIC_RELAXED, __HIP_MEMORY_SCOPE_WORKGROUP);
                const int ti = wave * 8 + r; ltok[ti * 4 + 0] = i1; ltok[ti * 4 + 1] = i2; ltok[ti * 4 + 2] = (int)p1; ltok[ti * 4 + 3] = (int)p2;
                lgt[ti * 4 + 0] = g1; lgt[ti * 4 + 1] = g2; lgt[ti * 4 + 2] = rs;
            }
        }
        __syncthreads();
        if (tid < 8) gb[tid] = __hip_atomic_fetch_add(F.ctl + CW_CNT + tid, lcnt[tid], RLX_AGENT);
        __syncthreads();
        if (tid < 64) { const int row = chunk * 64 + tid; const int e1 = ltok[tid * 4], e2 = ltok[tid * 4 + 1];
            TOPE[row * 2] = e1; TOPE[row * 2 + 1] = e2; POS[row * 2] = (int)gb[e1] + ltok[tid * 4 + 2]; POS[row * 2 + 1] = (int)gb[e2] + ltok[tid * 4 + 3];
            GATE[row * 2] = lgt[tid * 4]; GATE[row * 2 + 1] = lgt[tid * 4 + 1]; RSTD3[row] = lgt[tid * 4 + 2]; }
        __syncthreads();
    }
}
__device__ __forceinline__ void moe_bases(Frame& F, int (&tb)[9]) {
    int acc = 0;
#pragma unroll
    for (int e = 0; e < 8; ++e) { tb[e] = acc; const unsigned c = __hip_atomic_load(F.ctl + CW_CNT + e, RLX_AGENT); acc += (int)((c + 255u) >> 8); }
    tb[8] = acc;
}
__device__ __forceinline__ void p12_permute(Frame& F) {
    unsigned char* ws = F.ws; const int lane = F.lane;
    const int* TOPE = (const int*)(ws + WS_RT); const int* POS = (const int*)(ws + WS_RT + 128 * 1024); const float* GATE = (const float*)(ws + WS_RT + 256 * 1024); const float* RSTD3 = (const float*)(ws + WS_RT + 384 * 1024);
    int* SLOT = (int*)(ws + WS_RT + 512 * 1024); float* RSTDS = (float*)(ws + WS_RSTDS); float* GATES = (float*)(ws + WS_GATES);
    const bf16* XB = (const bf16*)(ws + WS_XB); bf16* XP = (bf16*)(ws + WS_XPERM);
    int tb[9]; moe_bases(F, tb);
    const int gw = F.wave * F.G + F.bid, NGW = F.G * NWAVES;
    for (int i = gw; i < 2 * M; i += NGW) {
        const int row = i >> 1; const int e = TOPE[i]; int base = 0;
#pragma unroll
        for (int k = 0; k < 8; ++k) base = (e == k) ? tb[k] : base;
        const int slot = base * 256 + POS[i];
        const v4u* src = (const v4u*)(XB + (size_t)row * D) + lane; v4u* dst = (v4u*)(XP + (size_t)slot * D) + lane;
        const v4u a = src[0], c = src[64]; dst[0] = a; dst[64] = c;
        if (lane == 0) { SLOT[i] = slot; RSTDS[slot] = RSTD3[row]; GATES[slot] = GATE[i]; }
    }
}
__device__ __forceinline__ void p15_combine(Frame& F) {
    unsigned char* ws = F.ws; const int lane = F.lane;
    const float* H = (const float*)(ws + WS_H); const bf16* Y = (const bf16*)(ws + WS_Y); const int* SLOT = (const int*)(ws + WS_RT + 512 * 1024);
    const int gw = F.wave * F.G + F.bid, NGW = F.G * NWAVES;
    for (int row = gw; row < M; row += NGW) {
        const int s1 = SLOT[row * 2], s2 = SLOT[row * 2 + 1];
        const GAS f32x4* hr = (const GAS f32x4*)(H + (size_t)row * D) + lane; GAS f32x4* orow = (GAS f32x4*)(F.out + (size_t)row * D) + lane;
        const GAS v2u* y1 = (const GAS v2u*)(Y + (size_t)s1 * D) + lane; const GAS v2u* y2 = (const GAS v2u*)(Y + (size_t)s2 * D) + lane;
#pragma unroll
        for (int j = 0; j < 4; ++j) { const f32x4 h = hr[64 * j]; const v2u a = y1[64 * j], c = y2[64 * j]; f32x4 o;
            o.x = h.x + (bflo(a.x) + bflo(c.x)); o.y = h.y + (bfhi(a.x) + bfhi(c.x)); o.z = h.z + (bflo(a.y) + bflo(c.y)); o.w = h.w + (bfhi(a.y) + bfhi(c.y)); orow[64 * j] = o; }
    }
}

constexpr int N_PHASES = 16;
#ifndef MK_ONE_LAUNCH
#define MK_ONE_LAUNCH 1
#endif
struct Args { const float* in[17]; float* out; unsigned char* ws; int ph_lo, ph_hi; };
__global__ void __launch_bounds__(NWAVES * 64, 2) yoco_fwd(Args args) {
    extern __shared__ __attribute__((aligned(16))) unsigned char lds[];
    Frame F;
    F.lds = (LAS unsigned char*)lds; F.MISC = (volatile LAS unsigned*)(F.lds + MISC_OFF);
    F.tid = threadIdx.x; F.lane = F.tid & 63; F.wave = __builtin_amdgcn_readfirstlane(F.tid >> 6); F.G = gridDim.x; F.bid = blockIdx.x;
    F.ws = args.ws; F.ctl = (gu32*)(args.ws + WS_CTL); F.out = args.out;
#pragma unroll
    for (int i = 0; i < 17; ++i) F.in[i] = args.in[i];
    for (int u = F.tid; u < (LDS_BYTES - LDSCTL_OFF) / 4; u += NWAVES * 64) ((LAS unsigned*)(F.lds + LDSCTL_OFF))[u] = 0u;
    __syncthreads();
    unsigned char* ws = args.ws;
    XcdBarrier bar; bar.bar = (unsigned*)(F.ctl + CW_BAR); bar.x = 0; bar.st = nullptr;
    if (MK_ONE_LAUNCH) bar = xcd_barrier_post((unsigned*)(F.ctl + CW_BAR), F.MISC + 8);
    const int lo = args.ph_lo, hi = args.ph_hi;
#define IN(k) (lo <= (k) && (k) < hi)
#define SEAM(k) do { if (MK_ONE_LAUNCH && IN((k) + 1)) xcd_barrier(bar); } while (0)
    bf16* XB = (bf16*)(ws + WS_XB); float* H = (float*)(ws + WS_H); bf16* AO = (bf16*)(ws + WS_AO);

    if (IN(0)) { p0_prologue(F); SEAM(0); }
    if (IN(1)) {
        pg8::Gemm g{XB, (const bf16*)(ws + WS_WIN), M, 2048, D}; pg8::StaticOrder S; S.init(M, 2048, F.G, F.bid);
        pg8::EpiScaleBf16 E{(bf16*)(ws + WS_PROJ), 2048, (const float*)(ws + WS_SS0)};
        pg8::gemm_phase<pg8::EpiScaleBf16, pg8::StaticOrder, true, true>(F.lds, g, S, E); SEAM(1); }
    if (IN(2)) { p2_post(F); SEAM(2); }
    if (IN(3)) { p3_index(F); SEAM(3); }
    if (IN(4)) { p4_dsa(F); SEAM(4); }
    if (IN(5)) {
        pg8::Gemm g{AO, (const bf16*)(ws + WS_WOA), M, D, D}; pg8::StaticOrder S; S.init(M, D, F.G, F.bid);
        pg8::EpiResid E{F.in[IN_X], H, XB, (float*)(ws + WS_SS1)};
        pg8::gemm_phase<pg8::EpiResid, pg8::StaticOrder, true, true>(F.lds, g, S, E); SEAM(5); }
    if (IN(6)) {
        pg8::Gemm g{XB, (const bf16*)(ws + WS_WGU), M, 2 * FF, D}; pg8::StaticOrder S; S.init(M, 2 * FF, F.G, F.bid);
        pg8::EpiSwiGLU<false> E{(bf16*)(ws + WS_HF), FF, (const float*)(ws + WS_SS1)};
        pg8::gemm_phase<pg8::EpiSwiGLU<false>, pg8::StaticOrder, true, true>(F.lds, g, S, E); SEAM(6); }
    if (IN(7)) {
        pg8::Gemm g{(const bf16*)(ws + WS_HF), (const bf16*)(ws + WS_WD), M, D, FF}; pg8::StaticOrder S; S.init(M, D, F.G, F.bid);
        pg8::EpiResid E{H, H, XB, (float*)(ws + WS_SS2)};
        pg8::gemm_phase<pg8::EpiResid, pg8::StaticOrder, true, true>(F.lds, g, S, E); SEAM(7); }
    if (IN(8)) {
        { pg8::Gemm g{XB, (const bf16*)(ws + WS_WKVQ), M, 2048, D}; pg8::StaticOrder S; S.init(M, 2048, F.G, F.bid);
          pg8::EpiScaleBf16 E{(bf16*)(ws + WS_KQ), 2048, (const float*)(ws + WS_SS2)};
          pg8::gemm_phase<pg8::EpiScaleBf16, pg8::StaticOrder, true, true>(F.lds, g, S, E); }
        { pg8::Gemm g{(const bf16*)(ws + WS_WKVQ) + (size_t)2048 * D, XB, D, M, D}; pg8::StaticOrder S; S.init(D, M, F.G, F.bid);
          pg8::EpiScaleColBf16 E{(bf16*)(ws + WS_VT), M, (const float*)(ws + WS_SS2)};
          pg8::gemm_phase<pg8::EpiScaleColBf16, pg8::StaticOrder, true, true>(F.lds, g, S, E); }
        SEAM(8); }
    if (IN(9)) { p9_sb(F); SEAM(9); }
    if (IN(10)) {
        pg8::Gemm g{AO, (const bf16*)(ws + WS_WOB), M, D, D}; pg8::StaticOrder S; S.init(M, D, F.G, F.bid);
        pg8::EpiResid E{H, H, XB, (float*)(ws + WS_SS3)};
        pg8::gemm_phase<pg8::EpiResid, pg8::StaticOrder, true, true>(F.lds, g, S, E); SEAM(10); }
    if (IN(11)) { p11_router(F); SEAM(11); }
    if (IN(12)) { p12_permute(F); SEAM(12); }
    if (IN(13)) {
        pg8::MoeOrder S; moe_bases(F, S.tb); S.npn = 22; S.G = F.G; S.c = F.bid;
        pg8::Gemm g{(const bf16*)(ws + WS_XPERM), (const bf16*)(ws + WS_WGUM), MAXSLOT, NE * 2 * FF, D};
        pg8::EpiSwiGLU<true> E{(bf16*)(ws + WS_HM), FF, (const float*)(ws + WS_RSTDS)};
        pg8::gemm_phase<pg8::EpiSwiGLU<true>, pg8::MoeOrder, true, true>(F.lds, g, S, E); SEAM(13); }
    if (IN(14)) {
        pg8::MoeOrder S; moe_bases(F, S.tb); S.npn = 4; S.G = F.G; S.c = F.bid;
        pg8::Gemm g{(const bf16*)(ws + WS_HM), (const bf16*)(ws + WS_WDM), MAXSLOT, NE * D, FF};
        pg8::EpiGateBf16 E{(bf16*)(ws + WS_Y), (const float*)(ws + WS_GATES)};
        pg8::gemm_phase<pg8::EpiGateBf16, pg8::MoeOrder, true, true>(F.lds, g, S, E); SEAM(14); }
    if (IN(15)) { p15_combine(F); }
#undef IN
#undef SEAM
}

extern "C" void kernel_launch(void* const* d_in, const int* in_sizes, int n_in, void* d_out, int out_size, void* d_ws, size_t ws_size, hipStream_t stream) {
    static int grid = 0;
    if (grid == 0) {
        if (n_in != 17 || out_size != M * D || ws_size < WS_END) { fprintf(stderr, "kernel_launch: unexpected problem (n_in %d, out %d, ws %zu < %zu)\n", n_in, out_size, ws_size, (size_t)WS_END); grid = -1; return; }
        int dev = 0, cus = 0, per_cu = 0;
        if (hipGetDevice(&dev) != hipSuccess || hipDeviceGetAttribute(&cus, hipDeviceAttributeMultiprocessorCount, dev) != hipSuccess) { grid = -1; return; }
        if (hipFuncSetAttribute((const void*)yoco_fwd, hipFuncAttributeMaxDynamicSharedMemorySize, LDS_BYTES) != hipSuccess) { fprintf(stderr, "kernel_launch: hipFuncSetAttribute failed\n"); grid = -1; return; }
        if (hipOccupancyMaxActiveBlocksPerMultiprocessor(&per_cu, (const void*)yoco_fwd, NWAVES * 64, LDS_BYTES) != hipSuccess || per_cu < 1) fprintf(stderr, "kernel_launch: occupancy query says %d\n", per_cu);
        (void)hipGetLastError();
        grid = cus;
    }
    if (grid < 0) return;
    if (hipMemsetAsync((char*)d_ws + WS_CTL, 0, CTL_ZERO_BYTES, stream) != hipSuccess) return;
    Args a{};
    for (int i = 0; i < 17; ++i) a.in[i] = (const float*)d_in[i];
    a.out = (float*)d_out; a.ws = (unsigned char*)d_ws;
#if MK_ONE_LAUNCH
    a.ph_lo = 0; a.ph_hi = N_PHASES;
    hipLaunchKernelGGL(yoco_fwd, dim3(grid), dim3(NWAVES * 64), LDS_BYTES, stream, a);
#else
    for (int p = 0; p < N_PHASES; ++p) { a.ph_lo = p; a.ph_hi = p + 1; hipLaunchKernelGGL(yoco_fwd, dim3(grid), dim3(NWAVES * 64), LDS_BYTES, stream, a); }
#endif
}
```

```cpp
#include <hip/hip_runtime.h>
#include <cstdio>
#include <cstdint>
namespace pg8 {
#define PG8_LAS __attribute__((address_space(3)))
typedef unsigned short bf16_t;
typedef short bf16x8 __attribute__((ext_vector_type(8)));
typedef float f32x4 __attribute__((ext_vector_type(4)));
typedef unsigned u32x4 __attribute__((ext_vector_type(4)));
constexpr int BM = 256, BK = 64, HALF = 128, HTB = HALF * BK * 2  , STAGE_BYTES = 8 * HTB, NXCD = 8, WGM = 8;

__host__ __device__ __forceinline__ int lds_byte(int r, int c) { const int st = (r >> 4) * 2 + (c >> 5), rr = r & 15, cc = c & 31, ob = rr * 64 + cc * 2; return st * 1024 + (ob ^ (((ob >> 9) & 1) << 5)); }
__host__ __device__ __forceinline__ void stage_rc(int b, int& R, int& C) { const int st = b / 1024, sb = b % 1024, swz = sb ^ (((sb >> 9) & 1) << 5); R = (st >> 1) * 16 + swz / 64; C = (st & 1) * 32 + (swz % 64) / 2; }
__host__ __device__ __forceinline__ int perm32(int rho) { const int n = rho >> 4, i = rho & 15; return 8 * (i >> 2) + 4 * n + (i & 3); }

struct Unit { int pm, pn; };
struct Gemm { const bf16_t* A; const bf16_t* Bt; int M, N, K; };

struct StaticOrder {
    int nM, nN, nwg, G, c;
    __host__ __device__ void init(int M, int N, int G_, int c_) { nM = M / BM; nN = N / BM; nwg = nM * nN; G = G_; c = c_; }
    __host__ __device__ bool next(int i, Unit& u) const {
        const long L = (long)i * G + c; if (L >= nwg) return false;
        int wgid = (int)L; { const int q = nwg / NXCD, r = nwg % NXCD, xcd = wgid % NXCD, off = wgid / NXCD; wgid = (xcd < r ? xcd * (q + 1) : r * (q + 1) + (xcd - r) * q) + off; }
        const int nig = WGM * nN, gid = wgid / nig, fm = gid * WGM, gsz = (nM - fm) < WGM ? (nM - fm) : WGM;
        u.pm = fm + ((wgid % nig) % gsz); u.pn = (wgid % nig) / gsz; return true;
    }
    __device__ __forceinline__ void a_ready(const Unit&) const {}
    __device__ __forceinline__ void done(const Unit&) const {}
};

__device__ __forceinline__ unsigned cvt_pk_bf16(float lo, float hi) { unsigned r; asm volatile("v_cvt_pk_bf16_f32 %0, %1, %2" : "=v"(r) : "v"(lo), "v"(hi)); return r; }
typedef unsigned u32x2 __attribute__((ext_vector_type(2)));
constexpr float RMS_EPS = 1e-6f;
__device__ __forceinline__ float rstd16(const float* p) {
    const f32x4 a = *(const f32x4*)p, b = *(const f32x4*)(p + 4), c = *(const f32x4*)(p + 8), d = *(const f32x4*)(p + 12);
    const float s = (((a[0] + a[1]) + (a[2] + a[3])) + ((b[0] + b[1]) + (b[2] + b[3]))) + (((c[0] + c[1]) + (c[2] + c[3])) + ((d[0] + d[1]) + (d[2] + d[3])));
    return 1.0f / sqrtf(s * (1.0f / 1024.0f) + RMS_EPS);
}
struct EpiScaleBf16 {
    static constexpr bool PERM = true, AFTER_DRAIN = false;
    bf16_t* O; int ldc; const float* ss;
    __device__ __forceinline__ void operator()(const f32x4 (&acc)[2][2][4][2], const Unit& u, int wr, int wc, int fr, int fq) const {
        const int row0 = u.pm * BM + wr * 64 + fr, col0 = u.pn * BM + wc * 32 + 8 * fq;
#pragma unroll
        for (int ai = 0; ai < 2; ++ai)
#pragma unroll
            for (int m = 0; m < 4; ++m) { const int row = row0 + ai * HALF + m * 16; const float rs = rstd16(ss + (size_t)row * 16); bf16_t* rowp = O + (size_t)row * ldc + col0;
#pragma unroll
                for (int bj = 0; bj < 2; ++bj) { const f32x4 v0 = acc[ai][bj][m][0] * rs, v1 = acc[ai][bj][m][1] * rs;
                    u32x4 w; w.x = cvt_pk_bf16(v0[0], v0[1]); w.y = cvt_pk_bf16(v0[2], v0[3]); w.z = cvt_pk_bf16(v1[0], v1[1]); w.w = cvt_pk_bf16(v1[2], v1[3]);
                    *(u32x4*)(rowp + bj * HALF) = w; } }
    }
};
struct EpiScaleColBf16 {
    static constexpr bool PERM = true, AFTER_DRAIN = false;
    bf16_t* O; int ldc; const float* ss;
    __device__ __forceinline__ void operator()(const f32x4 (&acc)[2][2][4][2], const Unit& u, int wr, int wc, int fr, int fq) const {
        const int row0 = u.pm * BM + wr * 64 + fr, col0 = u.pn * BM + wc * 32 + 8 * fq;
        f32x4 rs[2][2];
#pragma unroll
        for (int bj = 0; bj < 2; ++bj)
#pragma unroll
            for (int n = 0; n < 2; ++n)
#pragma unroll
                for (int e = 0; e < 4; ++e) rs[bj][n][e] = rstd16(ss + (size_t)(col0 + bj * HALF + 4 * n + e) * 16);
#pragma unroll
        for (int ai = 0; ai < 2; ++ai)
#pragma unroll
            for (int m = 0; m < 4; ++m) { const int row = row0 + ai * HALF + m * 16; bf16_t* rowp = O + (size_t)row * ldc + col0;
#pragma unroll
                for (int bj = 0; bj < 2; ++bj) { const f32x4 v0 = acc[ai][bj][m][0] * rs[bj][0], v1 = acc[ai][bj][m][1] * rs[bj][1];
                    u32x4 w; w.x = cvt_pk_bf16(v0[0], v0[1]); w.y = cvt_pk_bf16(v0[2], v0[3]); w.z = cvt_pk_bf16(v1[0], v1[1]); w.w = cvt_pk_bf16(v1[2], v1[3]);
                    *(u32x4*)(rowp + bj * HALF) = w; } }
    }
};
struct EpiResid {
    static constexpr bool PERM = false, AFTER_DRAIN = false;
    const float* base; float* H; bf16_t* XB; float* ssp;
    __device__ __forceinline__ void operator()(const f32x4 (&acc)[2][2][4][2], const Unit& u, int wr, int wc, int fr, int fq) const {
        const int row0 = u.pm * BM + wr * 64 + fr, col0 = u.pn * BM + wc * 32 + 4 * fq;
#pragma unroll
        for (int ai = 0; ai < 2; ++ai)
#pragma unroll
            for (int m = 0; m < 4; ++m) { const int row = row0 + ai * HALF + m * 16; float q = 0.f;
#pragma unroll
                for (int bj = 0; bj < 2; ++bj)
#pragma unroll
                    for (int n = 0; n < 2; ++n) { const size_t off = (size_t)row * 1024 + col0 + bj * HALF + n * 16;
                        const f32x4 v = *(const f32x4*)(base + off) + acc[ai][bj][m][n]; *(f32x4*)(H + off) = v;
                        q += (v[0] * v[0] + v[1] * v[1]) + (v[2] * v[2] + v[3] * v[3]);
                        u32x2 w; w.x = cvt_pk_bf16(v[0], v[1]); w.y = cvt_pk_bf16(v[2], v[3]); *(u32x2*)(XB + off) = w; }
                q += __shfl_xor(q, 16); q += __shfl_xor(q, 32);
                if (fq == 0) ssp[(size_t)row * 16 + u.pn * 4 + wc] = q; }
    }
};
__device__ __forceinline__ float silu_mul(float g, float u) { return g * __builtin_amdgcn_rcpf(1.0f + __builtin_amdgcn_exp2f(g * -1.4426950408889634f)) * u; }
template <bool MOE> struct EpiSwiGLU {
    static constexpr bool PERM = true, AFTER_DRAIN = false;
    bf16_t* O; int ldc; const float* ss;
    __device__ __forceinline__ void operator()(const f32x4 (&acc)[2][2][4][2], const Unit& u, int wr, int wc, int fr, int fq) const {
        const int row0 = u.pm * BM + wr * 64 + fr; const int pnl = MOE ? (u.pn % 22) : u.pn; const int col0 = pnl * HALF + wc * 32 + 8 * fq;
#pragma unroll
        for (int ai = 0; ai < 2; ++ai)
#pragma unroll
            for (int m = 0; m < 4; ++m) { const int row = row0 + ai * HALF + m * 16; const float rs = MOE ? ss[row] : rstd16(ss + (size_t)row * 16);
                const f32x4 g0 = acc[ai][0][m][0] * rs, g1 = acc[ai][0][m][1] * rs, u0 = acc[ai][1][m][0] * rs, u1 = acc[ai][1][m][1] * rs;
                u32x4 w; w.x = cvt_pk_bf16(silu_mul(g0[0], u0[0]), silu_mul(g0[1], u0[1])); w.y = cvt_pk_bf16(silu_mul(g0[2], u0[2]), silu_mul(g0[3], u0[3]));
                w.z = cvt_pk_bf16(silu_mul(g1[0], u1[0]), silu_mul(g1[1], u1[1])); w.w = cvt_pk_bf16(silu_mul(g1[2], u1[2]), silu_mul(g1[3], u1[3]));
                *(u32x4*)(O + (size_t)row * ldc + col0) = w; }
    }
};
struct EpiGateBf16 {
    static constexpr bool PERM = true, AFTER_DRAIN = false;
    bf16_t* Y; const float* gate;
    __device__ __forceinline__ void operator()(const f32x4 (&acc)[2][2][4][2], const Unit& u, int wr, int wc, int fr, int fq) const {
        const int row0 = u.pm * BM + wr * 64 + fr, col0 = (u.pn & 3) * BM + wc * 32 + 8 * fq;
#pragma unroll
        for (int ai = 0; ai < 2; ++ai)
#pragma unroll
            for (int m = 0; m < 4; ++m) { const int row = row0 + ai * HALF + m * 16; const float gt = gate[row]; bf16_t* rowp = Y + (size_t)row * 1024 + col0;
#pragma unroll
                for (int bj = 0; bj < 2; ++bj) { const f32x4 v0 = acc[ai][bj][m][0] * gt, v1 = acc[ai][bj][m][1] * gt;
                    u32x4 w; w.x = cvt_pk_bf16(v0[0], v0[1]); w.y = cvt_pk_bf16(v0[2], v0[3]); w.z = cvt_pk_bf16(v1[0], v1[1]); w.w = cvt_pk_bf16(v1[2], v1[3]);
                    *(u32x4*)(rowp + bj * HALF) = w; } }
    }
};
struct MoeOrder {
    int tb[9]; int npn, G, c;
    __device__ __forceinline__ bool next(int i, Unit& u) const {
        const int L = i * G + c; if (L >= tb[8] * npn) return false;
        const int t = L / npn, j = L - t * npn; int e = 0;
#pragma unroll
        for (int k = 1; k < 8; ++k) e += (t >= tb[k]) ? 1 : 0;
        u.pm = t; u.pn = e * npn + j; return true;
    }
    __device__ __forceinline__ void a_ready(const Unit&) const {}
    __device__ __forceinline__ void done(const Unit&) const {}
};

template <class Epi, class Sched, bool ALIGN_EPI = false, bool SP2 = false>
__device__ __forceinline__ void gemm_phase(PG8_LAS unsigned char* lds, const Gemm g, const Sched& S, const Epi& E) {
    const int tid = threadIdx.x, wid = __builtin_amdgcn_readfirstlane(tid >> 6), lane = tid & 63, wr = wid >> 2, wc = wid & 3, fr = lane & 15, fq = lane >> 4;
    const int K = g.K, nt = K / BK;
    unsigned voffA[2], voffB[2];
#pragma unroll
    for (int i = 0; i < 2; ++i) { int R, C; stage_rc(tid * 16 + i * 8192, R, C); const int Rb = Epi::PERM ? ((R & ~31) + perm32(R & 31)) : R;
        voffA[i] = (unsigned)(R * K + C) * 2u; voffB[i] = (unsigned)(Rb * K + C) * 2u; }
    const size_t kstep = (size_t)(BK * 2);
    const size_t hstep = (size_t)HALF * K * 2;
    const size_t tstep = 2 * hstep;
    const unsigned ldsw = (unsigned)wid * 1024u;
    const int aoff = lds_byte(wr * 64 + fr, fq * 8), boff = lds_byte(wc * 32 + fr, fq * 8);
#define PG8_SA(b, h) (((b) * 2 + (h)) * HTB)
#define PG8_SB(b, h) ((4 + (b) * 2 + (h)) * HTB)
#define PG8_STAGE(bufoff, gbase, voff) do { _Pragma("unroll") for (int _i = 0; _i < 2; ++_i) \
        __builtin_amdgcn_global_load_lds((const unsigned*)((const char*)(gbase) + (voff)[_i]), (PG8_LAS unsigned*)(lds + (bufoff) + ldsw + _i * 8192), 16, 0, 0); } while (0)
#define PG8_LDA(dst, b, h) do { _Pragma("unroll") for (int m = 0; m < 4; ++m) _Pragma("unroll") for (int k = 0; k < 2; ++k) dst[m][k] = *(const PG8_LAS bf16x8*)(lds + PG8_SA(b, h) + aoff + m * 2048 + k * 1024); } while (0)
#define PG8_LDB(dst, b, h) do { _Pragma("unroll") for (int n = 0; n < 2; ++n) _Pragma("unroll") for (int k = 0; k < 2; ++k) dst[n][k] = *(const PG8_LAS bf16x8*)(lds + PG8_SB(b, h) + boff + n * 2048 + k * 1024); } while (0)
#define PG8_MMA(ai, bj, At, Bt) do { __builtin_amdgcn_s_setprio(1); _Pragma("unroll") for (int m = 0; m < 4; ++m) _Pragma("unroll") for (int n = 0; n < 2; ++n) _Pragma("unroll") for (int k = 0; k < 2; ++k) \
        acc[ai][bj][m][n] = __builtin_amdgcn_mfma_f32_16x16x32_bf16(Bt[n][k], At[m][k], acc[ai][bj][m][n], 0, 0, 0); __builtin_amdgcn_s_setprio(0); } while (0)
#define PG8_WAIT_V(n) asm volatile("s_waitcnt vmcnt(" #n ")" ::: "memory")
#define PG8_WAIT_L(n) asm volatile("s_waitcnt lgkmcnt(" #n ")" ::: "memory")
#define PG8_BAR __builtin_amdgcn_s_barrier()
#define PG8_SCHED __builtin_amdgcn_sched_barrier(0)
    Unit cur, nxt; int ui = 0;
    if (!S.next(0, cur)) return;
    f32x4 acc[2][2][4][2];
#pragma unroll
    for (int a = 0; a < 2; ++a)
#pragma unroll
        for (int b = 0; b < 2; ++b)
#pragma unroll
            for (int m = 0; m < 4; ++m)
#pragma unroll
                for (int n = 0; n < 2; ++n) acc[a][b][m][n] = (f32x4){0.f, 0.f, 0.f, 0.f};
    bf16x8 At[4][2], B0[2][2], B1[2][2];
    const char* cA = (const char*)g.A + (size_t)cur.pm * tstep; const char* cB = (const char*)g.Bt + (size_t)cur.pn * tstep;
    S.a_ready(cur);
    if constexpr (SP2) {
        PG8_STAGE(PG8_SB(0, 0), cB, voffB); PG8_STAGE(PG8_SB(0, 1), cB + hstep, voffB); PG8_STAGE(PG8_SA(0, 0), cA, voffA); PG8_STAGE(PG8_SA(0, 1), cA + hstep, voffA);
        if (wr == 1) PG8_BAR;
        PG8_WAIT_V(2); PG8_BAR;
        PG8_STAGE(PG8_SB(1, 0), cB + kstep, voffB); PG8_STAGE(PG8_SA(1, 0), cA + kstep, voffA); PG8_STAGE(PG8_SB(1, 1), cB + hstep + kstep, voffB);
        PG8_WAIT_V(6); PG8_BAR;
    } else {
        PG8_STAGE(PG8_SB(0, 0), cB, voffB); PG8_STAGE(PG8_SA(0, 0), cA, voffA); PG8_STAGE(PG8_SB(0, 1), cB + hstep, voffB); PG8_STAGE(PG8_SA(0, 1), cA + hstep, voffA);
        if (wr == 1) PG8_BAR;
        PG8_WAIT_V(4); PG8_BAR;
        PG8_STAGE(PG8_SB(1, 0), cB + kstep, voffB); PG8_STAGE(PG8_SA(1, 0), cA + kstep, voffA); PG8_STAGE(PG8_SB(1, 1), cB + hstep + kstep, voffB);
        PG8_WAIT_V(6); PG8_BAR;
    }
    for (;;) {
        const bool has_next = S.next(ui + 1, nxt);
        const char* nA = has_next ? (const char*)g.A + (size_t)nxt.pm * tstep : cA; const char* nB = has_next ? (const char*)g.Bt + (size_t)nxt.pn * tstep : cB;
        for (int t = 0; t < nt; t += 2) {
            const bool last = (t == nt - 2);
            const char* a1 = cA + (size_t)(t + 1) * kstep;
            const char* a2 = last ? nA : cA + (size_t)(t + 2) * kstep; const char* b2 = last ? nB : cB + (size_t)(t + 2) * kstep;
            const char* a3 = a2 + kstep; const char* b3 = b2 + kstep;
            if (last && has_next) S.a_ready(nxt);
            if constexpr (SP2) {
            PG8_LDB(B0, 0, 0); PG8_LDB(B1, 0, 1); PG8_SCHED; PG8_LDA(At, 0, 0); PG8_STAGE(PG8_SA(1, 1), a1 + hstep, voffA);
            PG8_WAIT_V(8); PG8_WAIT_L(0); PG8_BAR; PG8_MMA(0, 0, At, B0); PG8_MMA(0, 1, At, B1); PG8_BAR; PG8_SCHED;
            PG8_LDA(At, 0, 1); PG8_STAGE(PG8_SB(0, 0), b2, voffB); PG8_STAGE(PG8_SB(0, 1), b2 + hstep, voffB); PG8_STAGE(PG8_SA(0, 0), a2, voffA);
            PG8_WAIT_V(8); PG8_WAIT_L(0); PG8_BAR; PG8_MMA(1, 0, At, B0); PG8_MMA(1, 1, At, B1); PG8_BAR; PG8_SCHED;
            PG8_LDB(B0, 1, 0); PG8_LDB(B1, 1, 1); PG8_SCHED; PG8_LDA(At, 1, 0); PG8_STAGE(PG8_SA(0, 1), a2 + hstep, voffA);
            PG8_WAIT_V(8); PG8_WAIT_L(0); PG8_BAR; PG8_MMA(0, 0, At, B0); PG8_MMA(0, 1, At, B1); PG8_BAR; PG8_SCHED;
            PG8_LDA(At, 1, 1); PG8_STAGE(PG8_SB(1, 0), b3, voffB); PG8_STAGE(PG8_SB(1, 1), b3 + hstep, voffB); PG8_STAGE(PG8_SA(1, 0), a3, voffA);
            PG8_WAIT_V(8); PG8_WAIT_L(0); PG8_BAR; PG8_MMA(1, 0, At, B0); PG8_MMA(1, 1, At, B1); PG8_BAR; PG8_SCHED;
            } else {
            PG8_LDB(B0, 0, 0); PG8_SCHED; PG8_LDA(At, 0, 0); PG8_STAGE(PG8_SA(1, 1), a1 + hstep, voffA);
            PG8_WAIT_L(8); PG8_BAR; PG8_WAIT_L(0); PG8_MMA(0, 0, At, B0); PG8_BAR; PG8_SCHED;
            PG8_LDB(B1, 0, 1); PG8_STAGE(PG8_SB(0, 0), b2, voffB);
            PG8_BAR; PG8_WAIT_L(0); PG8_MMA(0, 1, At, B1); PG8_BAR;
            PG8_LDA(At, 0, 1); PG8_STAGE(PG8_SA(0, 0), a2, voffA);
            PG8_BAR; PG8_WAIT_L(0); PG8_MMA(1, 0, At, B0); PG8_BAR; PG8_SCHED;
            PG8_STAGE(PG8_SB(0, 1), b2 + hstep, voffB);
            PG8_WAIT_V(6); PG8_BAR; PG8_MMA(1, 1, At, B1); PG8_BAR;
            PG8_LDB(B0, 1, 0); PG8_SCHED; PG8_LDA(At, 1, 0); PG8_STAGE(PG8_SA(0, 1), a2 + hstep, voffA);
            PG8_WAIT_L(8); PG8_BAR; PG8_WAIT_L(0); PG8_MMA(0, 0, At, B0); PG8_BAR; PG8_SCHED;
            PG8_LDB(B1, 1, 1); PG8_STAGE(PG8_SB(1, 0), b3, voffB);
            PG8_BAR; PG8_WAIT_L(0); PG8_MMA(0, 1, At, B1); PG8_BAR;
            PG8_LDA(At, 1, 1); PG8_STAGE(PG8_SA(1, 0), a3, voffA);
            PG8_BAR; PG8_WAIT_L(0); PG8_MMA(1, 0, At, B0); PG8_BAR; PG8_SCHED;
            PG8_STAGE(PG8_SB(1, 1), b3 + hstep, voffB);
            PG8_WAIT_V(6); PG8_BAR; PG8_MMA(1, 1, At, B1); PG8_BAR;
            }
        }
        if constexpr (ALIGN_EPI) { if (wr == 0) PG8_BAR; }
        if constexpr (!Epi::AFTER_DRAIN) { E(acc, cur, wr, wc, fr, fq); S.done(cur); }
        if (!has_next) break;
#pragma unroll
        for (int a = 0; a < 2; ++a)
#pragma unroll
            for (int b = 0; b < 2; ++b)
#pragma unroll
                for (int m = 0; m < 4; ++m)
#pragma unroll
                    for (int n = 0; n < 2; ++n) acc[a][b][m][n] = (f32x4){0.f, 0.f, 0.f, 0.f};
        cur = nxt; cA = nA; cB = nB; ++ui;
        if constexpr (ALIGN_EPI) { if (wr == 1) PG8_BAR; }
    }
    PG8_WAIT_V(0);
    if constexpr (!ALIGN_EPI) { if (wr == 0) PG8_BAR; }
    PG8_BAR;
    if constexpr (Epi::AFTER_DRAIN) { E.fused(acc, cur, wr, wc, fr, fq, lds, wid, lane); S.done(cur); }
#undef PG8_SA
#undef PG8_SB
#undef PG8_STAGE
#undef PG8_LDA
#undef PG8_LDB
#undef PG8_MMA
#undef PG8_WAIT_V
#undef PG8_WAIT_L
#undef PG8_BAR
#undef PG8_SCHED
}
}

constexpr int NWAVES = 8;
constexpr int BATCH = 2, SEQ = 8192, D = 1024, M = BATCH * SEQ;
constexpr int HD = 128, NH = 8, NKV = 2, NIH = 8, IDX = 64, TOPK = 256;
constexpr int A_IN = 2120, FF = 2816, NE = 8;
constexpr int MAXSLOT = 34816;
constexpr float QSCALE = 0.12751743082459868f;
constexpr float SBSCALE = 0.08838834764831845f;
constexpr float WISCALE = 0.04419417382415922f;
constexpr size_t MiB = 1u << 20;
constexpr size_t WS_CTL = 0, CTL_ZERO_BYTES = 1 * MiB;
constexpr size_t WS_WIN = 2 * MiB, WS_WTAIL = 6 * MiB, WS_WOA = 7 * MiB, WS_WGU = 9 * MiB, WS_WD = 20 * MiB, WS_WKVQ = 26 * MiB, WS_WOB = 32 * MiB, WS_WGUM = 34 * MiB, WS_WDM = 122 * MiB;
constexpr size_t WS_H = 166 * MiB, WS_XB = 230 * MiB, WS_SS0 = 262 * MiB, WS_SS1 = 263 * MiB, WS_SS2 = 264 * MiB, WS_SS3 = 265 * MiB;
constexpr size_t WS_T = 266 * MiB;
constexpr size_t WS_PROJ = WS_T, WS_QF = 330 * MiB, WS_KVF = 362 * MiB, WS_QIF = 378 * MiB, WS_KIF = 394 * MiB, WS_WIF = 396 * MiB, WS_SEL = 397 * MiB, WS_AO = 413 * MiB;
constexpr size_t WS_HF = WS_T, WS_KQ = WS_T, WS_VT = 330 * MiB;
constexpr size_t WS_XPERM = WS_T, WS_HM = 334 * MiB, WS_Y = 521 * MiB;
constexpr size_t WS_RT = 590 * MiB;
constexpr size_t WS_RSTDS = 591 * MiB, WS_GATES = 591 * MiB + 512 * 1024, WS_END = 592 * MiB;
constexpr int CW_CNT = 64;
constexpr int CW_BAR = 4096;
constexpr int RING_BYTES = 131072, LDSCTL_OFF = RING_BYTES, MISC_OFF = LDSCTL_OFF + 320, LDS_BYTES = 147456;

#define GAS __attribute__((address_space(1)))
#define LAS __attribute__((address_space(3)))
typedef unsigned short bf16;
typedef unsigned v4u __attribute__((ext_vector_type(4)));
typedef unsigned v2u __attribute__((ext_vector_type(2)));
typedef float f32x4 __attribute__((ext_vector_type(4)));
typedef short bf16x8 __attribute__((ext_vector_type(8)));
typedef float f32x16 __attribute__((ext_vector_type(16)));
typedef GAS unsigned gu32;
#define RLX_AGENT __ATOMIC_RELAXED, __HIP_MEMORY_SCOPE_AGENT
#define LDS_WAIT() asm volatile("s_waitcnt lgkmcnt(0)" ::: "memory")
#define VM_WAIT() asm volatile("s_waitcnt vmcnt(0)" ::: "memory")
__device__ __forceinline__ unsigned f2bf(float f) { unsigned u = __builtin_bit_cast(unsigned, f); return (u + 0x7fffu + ((u >> 16) & 1u)) >> 16; }
__device__ __forceinline__ unsigned pk2(float lo, float hi) { return f2bf(lo) | (f2bf(hi) << 16); }
__device__ __forceinline__ float bflo(unsigned w) { return __uint_as_float(w << 16); }
__device__ __forceinline__ float bfhi(unsigned w) { return __uint_as_float(w & 0xffff0000u); }
__device__ __forceinline__ float wave_sum(float v) {
#pragma unroll
    for (int o = 1; o < 64; o <<= 1) v += __shfl_xor(v, o);
    return v;
}
__device__ __forceinline__ float wave_max(float v) {
#pragma unroll
    for (int o = 1; o < 64; o <<= 1) v = fmaxf(v, __shfl_xor(v, o));
    return v;
}
__device__ __forceinline__ void sincos_acc(float a, float& c, float& s) {
    const double x = (double)a; const double n = __builtin_rint(x * 0.63661977236758134308);
    const double r = __builtin_fma(-n, 6.123233995736766035869e-17, __builtin_fma(-n, 1.57079632679489655800, x)); const double r2 = r * r;
    double sn = 1.0 - r2 * (1.0 / 156.0); sn = 1.0 - r2 * (1.0 / 110.0) * sn; sn = 1.0 - r2 * (1.0 / 72.0) * sn; sn = 1.0 - r2 * (1.0 / 42.0) * sn; sn = 1.0 - r2 * (1.0 / 20.0) * sn; sn = 1.0 - r2 * (1.0 / 6.0) * sn; sn *= r;
    double cs = 1.0 - r2 * (1.0 / 182.0); cs = 1.0 - r2 * (1.0 / 132.0) * cs; cs = 1.0 - r2 * (1.0 / 90.0) * cs; cs = 1.0 - r2 * (1.0 / 56.0) * cs; cs = 1.0 - r2 * (1.0 / 30.0) * cs; cs = 1.0 - r2 * (1.0 / 12.0) * cs; cs = 1.0 - r2 * 0.5 * cs;
    const int q = ((int)n) & 3;
    const double cq = (q == 0) ? cs : (q == 1) ? -sn : (q == 2) ? -cs : sn;
    const double sq = (q == 0) ? sn : (q == 1) ? cs : (q == 2) ? -sn : -cs;
    c = (float)cq; s = (float)sq;
}
__device__ const float INV_Q[16] = {1.000000000e+00f, 4.403665960e-01f, 1.939227432e-01f, 8.539710194e-02f, 3.760603070e-02f, 1.656043902e-02f, 7.292664610e-03f, 3.211445874e-03f,
                                    1.414213562e-03f, 6.227723788e-04f, 2.742481884e-04f, 1.207697351e-04f, 5.318296098e-05f, 2.341999971e-05f, 1.031338616e-05f, 4.541670478e-06f};
__device__ const float INV_I[8] = {1.000000000e+00f, 1.939227432e-01f, 3.760603070e-02f, 7.292664610e-03f, 1.414213562e-03f, 2.742481884e-04f, 5.318296098e-05f, 1.031338616e-05f};

#define XB_TMO      128
#define XB_XCNT(j)  (256  + 64 * (j))
#define XB_XSUB(j)  (1280 + 64 * (j))
#define XB_XGEN(j)  (2304 + 64 * (j))
#define XB_TOP      3328
#define XB_TOPGEN   3392
#define XCD_BAR_WORDS 3456
#define XB_SPIN_CAP (1u << 18)

__device__ __forceinline__ unsigned xb_ld(unsigned* p)              { return __hip_atomic_load(p, __ATOMIC_RELAXED, __HIP_MEMORY_SCOPE_AGENT); }
__device__ __forceinline__ unsigned xb_add(unsigned* p, unsigned v) { return __hip_atomic_fetch_add(p, v, __ATOMIC_RELAXED, __HIP_MEMORY_SCOPE_AGENT); }
__device__ __forceinline__ unsigned xb_xcc_id() { return (unsigned)__builtin_amdgcn_s_getreg((3 << 11) | 20) & 0xFu; }
#define XB_SPIN(cond, bar) do { unsigned _sp = 0; while (cond) { __builtin_amdgcn_s_sleep(1); \
    if ((++_sp & 255u) == 0u) { if (xb_ld(&(bar)[XB_TMO])) break; if (_sp > XB_SPIN_CAP) { atomicAdd(&(bar)[XB_TMO], 1u); break; } } } } while (0)

struct XcdBarrier {
    unsigned* bar; unsigned x;
    volatile LAS unsigned* st;
};

__device__ __forceinline__ XcdBarrier xcd_barrier_post(unsigned* bar, volatile LAS unsigned* st) {
    XcdBarrier b; b.bar = bar; b.x = xb_xcc_id(); b.st = st;
    if (threadIdx.x == 0) (void)xb_add(&bar[XB_XCNT(b.x)], 1u);
    return b;
}
__device__ __forceinline__ void xcd_barrier_complete(unsigned* bar, unsigned x, unsigned& nloc, unsigned& nx) {
    const unsigned G = gridDim.x * gridDim.y * gridDim.z;
    unsigned sum, cnt, mine, sp = 0u;
    for (;;) {
        sum = 0u; cnt = 0u; mine = 0u;
#pragma unroll
        for (unsigned j = 0; j < 16; ++j) { const unsigned c = xb_ld(&bar[XB_XCNT(j)]); sum += c; cnt += (c > 0u) ? 1u : 0u; mine = (j == x) ? c : mine; }
        if (sum == G) break;
        __builtin_amdgcn_s_sleep(1);
        if ((++sp & 255u) == 0u) { if (xb_ld(&bar[XB_TMO])) break; if (sp > XB_SPIN_CAP) { atomicAdd(&bar[XB_TMO], 1u); break; } }
    }
    nloc = mine > 0u ? mine : 1u; nx = cnt > 0u ? cnt : 1u;
}

__device__ __forceinline__ void xcd_barrier(const XcdBarrier& b) {
    asm volatile("s_waitcnt vmcnt(0)" ::: "memory");
    __syncthreads();
    if (threadIdx.x == 0) {
        unsigned* bar = b.bar;
        __builtin_amdgcn_s_waitcnt(0);
        unsigned nloc = b.st[0], nx = b.st[1];
        if (nloc == 0u) { xcd_barrier_complete(bar, b.x, nloc, nx); b.st[0] = nloc; b.st[1] = nx; }
        const unsigned old = xb_add(&bar[XB_XSUB(b.x)], 1u);
        const unsigned gen = old / nloc;
        if (old + 1u == (gen + 1u) * nloc) {
            __builtin_amdgcn_fence(__ATOMIC_RELEASE, "agent");
            asm volatile("s_waitcnt vmcnt(0)" ::: "memory");
            const unsigned og = xb_add(&bar[XB_TOP], 1u);
            const unsigned tg = og / nx;
            if (og + 1u == (tg + 1u) * nx) xb_add(&bar[XB_TOPGEN], 1u);
            else XB_SPIN(xb_ld(&bar[XB_TOPGEN]) == tg, bar);
            __builtin_amdgcn_fence(__ATOMIC_ACQUIRE, "agent");
            xb_add(&bar[XB_XGEN(b.x)], 1u);
            asm volatile("s_waitcnt vmcnt(0)" ::: "memory");
        } else {
            XB_SPIN(xb_ld(&bar[XB_XGEN(b.x)]) == gen, bar);
            __builtin_amdgcn_fence(__ATOMIC_ACQUIRE, "agent");
            asm volatile("s_waitcnt vmcnt(0)" ::: "memory");
        }
    }
    __syncthreads();
}

struct Frame {
    LAS unsigned char* lds;
    volatile LAS unsigned* MISC;
    gu32* ctl;
    int tid, lane, wave, G, bid;
    const float* in[17];
    float* out; unsigned char* ws;
};
enum { IN_X = 0, IN_ANORM, IN_AWIN, IN_AQN, IN_AKN, IN_AWOUT, IN_KVNORM, IN_KVW, IN_BNORM, IN_BWQ, IN_BWOUT, IN_FFNNORM, IN_DGU, IN_DDN, IN_ROUTER, IN_MGU, IN_MDN };

__device__ __forceinline__ void tr_item(const float* W, size_t ldw, int K, int k0, int csrc0, int cend, bf16* WT, int drow0, const float* gain, float scale, LAS float* scr, int lane) {
#pragma unroll 8
    for (int i = 0; i < 32; ++i) { const int kk = 2 * i + (lane >> 5); const int c = csrc0 + (lane & 31);
        const float v = (c < cend) ? W[(size_t)(k0 + kk) * ldw + c] : 0.f; const float g = gain ? gain[k0 + kk] * scale : scale; scr[kk * 33 + (lane & 31)] = v * g; }
    LDS_WAIT(); asm volatile("" ::: "memory");
    const int c8 = lane & 7;
#pragma unroll
    for (int j = 0; j < 4; ++j) { const int n = (lane >> 3) + 8 * j; const LAS float* s = scr + (8 * c8) * 33 + n;
        v4u o; o.x = pk2(s[0 * 33], s[1 * 33]); o.y = pk2(s[2 * 33], s[3 * 33]); o.z = pk2(s[4 * 33], s[5 * 33]); o.w = pk2(s[6 * 33], s[7 * 33]);
        *(GAS v4u*)(WT + (size_t)(drow0 + n) * K + k0 + 8 * c8) = o; }
    LDS_WAIT(); asm volatile("" ::: "memory");
}
__device__ __forceinline__ int gu_row(int c0) { return (c0 < FF) ? ((c0 >> 7) * 256 + (c0 & 127)) : (((c0 - FF) >> 7) * 256 + 128 + ((c0 - FF) & 127)); }
__device__ __forceinline__ void p0_prologue(Frame& F) {
    LAS float* scr = (LAS float*)(F.lds + F.wave * 16384);
    const int gw = F.wave * F.G + F.bid, NGW = F.G * NWAVES;
    unsigned char* ws = F.ws;
    constexpr int I_WIN = 16 * 64, I_TAIL = 16 * 3, I_SQ = 16 * 32, I_GU = 16 * 176, I_DN = 44 * 32, I_KV = 16 * 64;
    constexpr int NITEMS = I_WIN + I_TAIL + I_SQ + I_GU + I_DN + I_KV + I_SQ + I_SQ + NE * I_GU + NE * I_DN;
    for (int it = gw; it < NITEMS; it += NGW) {
        int r = it;
        if (r < I_WIN) { const int kb = r / 64, nb = r % 64; tr_item(F.in[IN_AWIN], A_IN, D, 64 * kb, 32 * nb, A_IN, (bf16*)(ws + WS_WIN), 32 * nb, F.in[IN_ANORM], 1.f, scr, F.lane); continue; } r -= I_WIN;
        if (r < I_TAIL) { const int kb = r / 3, nb = r % 3; tr_item(F.in[IN_AWIN], A_IN, D, 64 * kb, 2048 + 32 * nb, A_IN, (bf16*)(ws + WS_WTAIL), 32 * nb, F.in[IN_ANORM], 1.f, scr, F.lane); continue; } r -= I_TAIL;
        if (r < I_SQ) { const int kb = r / 32, nb = r % 32; tr_item(F.in[IN_AWOUT], D, D, 64 * kb, 32 * nb, D, (bf16*)(ws + WS_WOA), 32 * nb, nullptr, 1.f, scr, F.lane); continue; } r -= I_SQ;
        if (r < I_GU) { const int kb = r / 176, nb = r % 176; tr_item(F.in[IN_DGU], 2 * FF, D, 64 * kb, 32 * nb, 2 * FF, (bf16*)(ws + WS_WGU), gu_row(32 * nb), F.in[IN_FFNNORM], 1.f, scr, F.lane); continue; } r -= I_GU;
        if (r < I_DN) { const int kb = r / 32, nb = r % 32; tr_item(F.in[IN_DDN], D, FF, 64 * kb, 32 * nb, D, (bf16*)(ws + WS_WD), 32 * nb, nullptr, 1.f, scr, F.lane); continue; } r -= I_DN;
        if (r < I_KV) { const int kb = r / 64, nb = r % 64; tr_item(F.in[IN_KVW], 2 * D, D, 64 * kb, 32 * nb, 2 * D, (bf16*)(ws + WS_WKVQ), (nb < 32) ? 32 * nb : 1024 + 32 * nb, F.in[IN_KVNORM], 1.f, scr, F.lane); continue; } r -= I_KV;
        if (r < I_SQ) { const int kb = r / 32, nb = r % 32; tr_item(F.in[IN_BWQ], D, D, 64 * kb, 32 * nb, D, (bf16*)(ws + WS_WKVQ), 1024 + 32 * nb, F.in[IN_BNORM], SBSCALE, scr, F.lane); continue; } r -= I_SQ;
        if (r < I_SQ) { const int kb = r / 32, nb = r % 32; tr_item(F.in[IN_BWOUT], D, D, 64 * kb, 32 * nb, D, (bf16*)(ws + WS_WOB), 32 * nb, nullptr, 1.f, scr, F.lane); continue; } r -= I_SQ;
        if (r < NE * I_GU) { const int e = r / I_GU, rr = r % I_GU, kb = rr / 176, nb = rr % 176;
            tr_item(F.in[IN_MGU] + (size_t)e * D * 2 * FF, 2 * FF, D, 64 * kb, 32 * nb, 2 * FF, (bf16*)(ws + WS_WGUM), e * 2 * FF + gu_row(32 * nb), F.in[IN_FFNNORM] + D, 1.f, scr, F.lane); continue; } r -= NE * I_GU;
        { const int e = r / I_DN, rr = r % I_DN, kb = rr / 32, nb = rr % 32;
            tr_item(F.in[IN_MDN] + (size_t)e * FF * D, D, FF, 64 * kb, 32 * nb, D, (bf16*)(ws + WS_WDM), e * D + 32 * nb, nullptr, 1.f, scr, F.lane); }
    }
    const float* x = F.in[IN_X]; bf16* XB = (bf16*)(ws + WS_XB); float* SS0 = (float*)(ws + WS_SS0);
    for (int m = gw; m < M; m += NGW) {
        const GAS f32x4* xr = (const GAS f32x4*)(x + (size_t)m * D) + F.lane; f32x4 v[4]; float s = 0.f;
#pragma unroll
        for (int j = 0; j < 4; ++j) { v[j] = xr[64 * j]; s += (v[j].x * v[j].x + v[j].y * v[j].y) + (v[j].z * v[j].z + v[j].w * v[j].w); }
        s = wave_sum(s);
        GAS unsigned long long* o8 = (GAS unsigned long long*)(XB + (size_t)m * D) + F.lane;
#pragma unroll
        for (int j = 0; j < 4; ++j) o8[64 * j] = (unsigned long long)pk2(v[j].x, v[j].y) | ((unsigned long long)pk2(v[j].z, v[j].w) << 32);
        if (F.lane < 16) SS0[(size_t)m * 16 + F.lane] = (F.lane == 0) ? s : 0.f;
    }
}

#define WAVE_SYNC() asm volatile("s_waitcnt lgkmcnt(0)" ::: "memory")
__device__ __forceinline__ void rope8(float (&y)[8], bool isx1, bool isx2, int i0, int pshift, LAS const float* tab) {
#pragma unroll
    for (int e = 0; e < 8; ++e) {
        const float other = __shfl_xor(y[e], pshift); const float c = tab[2 * (i0 + e)], s = tab[2 * (i0 + e) + 1];
        y[e] = isx1 ? (y[e] * c - other * s) : (isx2 ? (y[e] * c + other * s) : y[e]);
    }
}
__device__ __forceinline__ void unpack8(const v4u w, float (&y)[8]) { y[0] = bflo(w.x); y[1] = bfhi(w.x); y[2] = bflo(w.y); y[3] = bfhi(w.y); y[4] = bflo(w.z); y[5] = bfhi(w.z); y[6] = bflo(w.w); y[7] = bfhi(w.w); }
__device__ __forceinline__ v4u pack8(const float (&y)[8]) { v4u o; o.x = pk2(y[0], y[1]); o.y = pk2(y[2], y[3]); o.z = pk2(y[4], y[5]); o.w = pk2(y[6], y[7]); return o; }
__device__ __forceinline__ void p2_post(Frame& F) {
    unsigned char* ws = F.ws; const int lane = F.lane;
    const bf16* PROJ = (const bf16*)(ws + WS_PROJ); const bf16* XB = (const bf16*)(ws + WS_XB); const bf16* WT = (const bf16*)(ws + WS_WTAIL); const float* SS0 = (const float*)(ws + WS_SS0);
    bf16* QF = (bf16*)(ws + WS_QF); bf16* KVF = (bf16*)(ws + WS_KVF); bf16* QIF = (bf16*)(ws + WS_QIF); bf16* KIF = (bf16*)(ws + WS_KIF); float* WIF = (float*)(ws + WS_WIF);
    const float* qnw = F.in[IN_AQN]; const float* knw = F.in[IN_AKN];
    LAS float* tab = (LAS float*)(F.lds + F.wave * 256);
    const int gw = F.wave * F.G + F.bid, NGW = F.G * NWAVES;
    for (int task = gw; task < M / 8; task += NGW) {
        const int row0 = task * 8;
        f32x4 acc[5];
#pragma unroll
        for (int c = 0; c < 5; ++c) acc[c] = (f32x4){0.f, 0.f, 0.f, 0.f};
        const bf16* ap = XB + (size_t)(row0 + (lane & 7)) * D + 8 * (lane >> 4);
        const bf16* bp = WT + (size_t)(lane & 15) * D + 8 * (lane >> 4);
#pragma unroll 4
        for (int j = 0; j < 32; ++j) {
            const bf16x8 a = *(const bf16x8*)(ap + 32 * j);
#pragma unroll
            for (int c = 0; c < 5; ++c) { const bf16x8 b = *(const bf16x8*)(bp + (size_t)(16 * c) * D + 32 * j); acc[c] = __builtin_amdgcn_mfma_f32_16x16x32_bf16(a, b, acc[c], 0, 0, 0); }
        }
        if (lane < 32) {
#pragma unroll
            for (int reg = 0; reg < 4; ++reg) {
                const int row = row0 + 4 * (lane >> 4) + reg; const float rs = pg8::rstd16(SS0 + (size_t)row * 16); const float pos = (float)(row & (SEQ - 1));
                const int d = lane & 15;
                float v0 = acc[0][reg] * rs; const float other = __shfl_xor(v0, 8);
                { float c, s; sincos_acc(pos * INV_I[d & 7], c, s); v0 = (d < 8) ? (v0 * c - other * s) : (v0 * c + other * s); }
                KIF[(size_t)row * IDX + d] = (bf16)f2bf(v0);
#pragma unroll
                for (int c = 1; c < 4; ++c) KIF[(size_t)row * IDX + 16 * c + d] = (bf16)f2bf(acc[c][reg] * rs);
                if (d < 8) WIF[(size_t)row * 8 + d] = acc[4][reg] * rs * WISCALE;
            }
        }
        for (int r = 0; r < 8; ++r) {
            const int row = row0 + r, b = row >> 13, t = row & (SEQ - 1); const float pos = (float)t;
            const bf16* pr = PROJ + (size_t)row * 2048 + 8 * lane;
            v4u w[4];
#pragma unroll
            for (int j = 0; j < 4; ++j) w[j] = *(const v4u*)(pr + 512 * j);
            if (lane < 24) { float c, s; sincos_acc(pos * ((lane < 16) ? INV_Q[lane & 15] : INV_I[lane & 7]), c, s); tab[2 * lane] = c; tab[2 * lane + 1] = s; }
            WAVE_SYNC();
#pragma unroll
            for (int j = 0; j < 2; ++j) {
                float y[8]; unpack8(w[j], y); float ss = 0.f;
#pragma unroll
                for (int e = 0; e < 8; ++e) ss += y[e] * y[e];
                ss += __shfl_xor(ss, 1); ss += __shfl_xor(ss, 2); ss += __shfl_xor(ss, 4); ss += __shfl_xor(ss, 8);
                const float rs = 1.0f / sqrtf(ss * (1.0f / 128.0f) + 1e-6f); const int c8 = (lane & 15) * 8;
#pragma unroll
                for (int e = 0; e < 8; ++e) y[e] = y[e] * rs * qnw[c8 + e];
                rope8(y, c8 < 16, c8 >= 16 && c8 < 32, c8 & 15, 2, tab);
#pragma unroll
                for (int e = 0; e < 8; ++e) y[e] *= QSCALE;
                *(v4u*)(QF + (size_t)row * D + 512 * j + 8 * lane) = pack8(y);
            }
            {
                float y[8]; unpack8(w[2], y); float ss = 0.f;
#pragma unroll
                for (int e = 0; e < 8; ++e) ss += y[e] * y[e];
                ss += __shfl_xor(ss, 1); ss += __shfl_xor(ss, 2); ss += __shfl_xor(ss, 4); ss += __shfl_xor(ss, 8);
                const bool isk = lane < 32; const float rs = 1.0f / sqrtf(ss * (1.0f / 128.0f) + 1e-6f); const int c8 = (lane & 15) * 8;
                if (isk) {
#pragma unroll
                    for (int e = 0; e < 8; ++e) y[e] = y[e] * rs * knw[c8 + e];
                }
                rope8(y, isk && c8 < 16, isk && c8 >= 16 && c8 < 32, c8 & 15, 2, tab);
                const int kvh = (lane >> 4) & 1;
                *(v4u*)(KVF + ((size_t)(b * NKV + kvh) * SEQ + t) * 256 + (isk ? 0 : 128) + c8) = pack8(y);
            }
            {
                float y[8]; unpack8(w[3], y); const int c8 = (lane & 7) * 8;
                rope8(y, c8 == 0, c8 == 8, 16, 1, tab);
                *(v4u*)(QIF + (size_t)row * 512 + 8 * lane) = pack8(y);
            }
            WAVE_SYNC();
        }
    }
}

__device__ __forceinline__ unsigned f2key(float f) { const unsigned u = __float_as_uint(f); return (u & 0x80000000u) ? ~u : (u | 0x80000000u); }
__device__ __forceinline__ void p3_query_naive(unsigned char* ws, LAS unsigned char* lds, int row, int* SEL) {
    const int tid = threadIdx.x, lane = tid & 63, wave = tid >> 6;
    const bf16* QIF = (const bf16*)(ws + WS_QIF); const bf16* KIF = (const bf16*)(ws + WS_KIF); const float* WIF = (const float*)(ws + WS_WIF);
    LAS unsigned* keys = (LAS unsigned*)lds;
    LAS float* qis = (LAS float*)(lds + 32768);
    LAS float* wl = (LAS float*)(lds + 32768 + 2048);
    LAS unsigned* hist = (LAS unsigned*)(lds + 36864);
    LAS unsigned* ctl = (LAS unsigned*)(lds + 36864 + 1024);
    LAS unsigned* wcnt = (LAS unsigned*)(lds + 36864 + 1024 + 64);
    {
        const int b = row >> 13, t = row & (SEQ - 1), n = t + 1;
        int* sel = SEL + (size_t)row * TOPK;
        if (n <= TOPK) { if (tid < TOPK) sel[tid] = tid < n ? tid : 0; return; }
        __syncthreads();
        qis[tid] = __uint_as_float((unsigned)QIF[(size_t)row * 512 + tid] << 16);
        if (tid < 8) wl[tid] = WIF[(size_t)row * 8 + tid];
        __syncthreads();
        for (int s = tid; s < n; s += 512) {
            const v4u* kp = (const v4u*)(KIF + ((size_t)(b << 13) + s) * IDX);
            float kf[64];
#pragma unroll
            for (int j = 0; j < 8; ++j) { const v4u w = kp[j]; kf[8 * j] = bflo(w.x); kf[8 * j + 1] = bfhi(w.x); kf[8 * j + 2] = bflo(w.y); kf[8 * j + 3] = bfhi(w.y); kf[8 * j + 4] = bflo(w.z); kf[8 * j + 5] = bfhi(w.z); kf[8 * j + 6] = bflo(w.w); kf[8 * j + 7] = bfhi(w.w); }
            float sc = 0.f;
#pragma unroll
            for (int h = 0; h < 8; ++h) { float d = 0.f; asm volatile("" ::: "memory");
#pragma unroll
                for (int dd = 0; dd < 64; ++dd) d += qis[h * 64 + dd] * kf[dd];
                sc += wl[h] * fmaxf(d, 0.f); }
            keys[s] = f2key(sc + 0.0f);
        }
        __syncthreads();
        unsigned prefix = 0u, mask = 0u, need = TOPK;
        for (int pass = 0; pass < 4; ++pass) {
            const int shift = 24 - 8 * pass;
            if (tid < 256) hist[tid] = 0u;
            __syncthreads();
            for (int s = tid; s < n; s += 512) { const unsigned k = keys[s]; if ((k & mask) == prefix) __hip_atomic_fetch_add(&hist[(k >> shift) & 255u], 1u, __ATOMIC_RELAXED, __HIP_MEMORY_SCOPE_WORKGROUP); }
            __syncthreads();
            if (tid < 64) {
                const unsigned h0 = hist[4 * lane], h1 = hist[4 * lane + 1], h2 = hist[4 * lane + 2], h3 = hist[4 * lane + 3]; const unsigned tot = h0 + h1 + h2 + h3;
                unsigned incl = tot;
#pragma unroll
                for (int o = 1; o < 64; o <<= 1) { const unsigned v = __shfl_down(incl, o); if (lane + o < 64) incl += v; }
                const unsigned above = incl - tot;
                if (above < need && need <= above + tot) {
                    unsigned a = above; unsigned bin;
                    if (a + h3 >= need) bin = 3; else { a += h3; if (a + h2 >= need) bin = 2; else { a += h2; if (a + h1 >= need) bin = 1; else { a += h1; bin = 0; } } }
                    ctl[0] = 4 * lane + bin; ctl[1] = need - a;
                }
            }
            __syncthreads();
            prefix |= ctl[0] << shift; mask |= 255u << shift; need = ctl[1];
            __syncthreads();
        }
        const unsigned thr = prefix, n_gt = TOPK - need;
        unsigned base_gt = 0u, base_eq = 0u;
        for (int s0 = 0; s0 < n; s0 += 512) {
            const int s = s0 + tid; const unsigned k = s < n ? keys[s] : 0u; const bool gt = (s < n) && (k > thr); const bool eq = (s < n) && (k == thr);
            const unsigned long long bg = __ballot(gt), be = __ballot(eq); const unsigned long long lt = (1ull << lane) - 1ull;
            const unsigned rg = __popcll(bg & lt), re = __popcll(be & lt);
            if (lane == 0) { wcnt[wave] = __popcll(bg); wcnt[8 + wave] = __popcll(be); }
            __syncthreads();
            unsigned og = base_gt, oe = base_eq, tg = 0u, te = 0u;
#pragma unroll
            for (int w = 0; w < 8; ++w) { const unsigned cg = wcnt[w], ce = wcnt[8 + w]; if (w < wave) { og += cg; oe += ce; } tg += cg; te += ce; }
            if (gt) sel[og + rg] = s;
            if (eq && oe + re < need) sel[n_gt + oe + re] = s;
            base_gt += tg; base_eq += te;
            __syncthreads();
        }
    }
}

constexpr int P3_HIST = 0, P3_H2 = 65536, P3_BM = 98304, P3_QS = 114688, P3_FLAG = P3_QS + 512, P3_CAP = 512;
__device__ __forceinline__ void find_bin_2048(LAS const unsigned* hist, unsigned need, int lane, unsigned& bin_out, unsigned& need_out, unsigned& cnt_out, bool& ok) {
    unsigned w[16]; unsigned tot = 0u;
#pragma unroll
    for (int i = 0; i < 16; ++i) { w[i] = hist[16 * lane + i]; tot += (w[i] & 0xffffu) + (w[i] >> 16); }
    unsigned incl = tot;
#pragma unroll
    for (int o = 1; o < 64; o <<= 1) { const unsigned v = __shfl_down(incl, o); if (lane + o < 64) incl += v; }
    const unsigned above = incl - tot;
    const bool mine = (above < need) && (need <= above + tot);
    unsigned a = above, fb = 0u, fn = 0u, fc = 0u; bool found = false;
#pragma unroll
    for (int i = 15; i >= 0; --i) {
        const unsigned h1 = w[i] >> 16, h0 = w[i] & 0xffffu;
        if (!found) { if (a + h1 >= need) { found = true; fb = 32u * lane + 2u * i + 1u; fn = need - a; fc = h1; } else a += h1; }
        if (!found) { if (a + h0 >= need) { found = true; fb = 32u * lane + 2u * i; fn = need - a; fc = h0; } else a += h0; }
    }
    const unsigned long long bm = __ballot(mine);
    ok = (bm != 0ull);
    const int src = ok ? (__ffsll((long long)bm) - 1) : 0;
    bin_out = (unsigned)__builtin_amdgcn_readlane((int)fb, src); need_out = (unsigned)__builtin_amdgcn_readlane((int)fn, src); cnt_out = (unsigned)__builtin_amdgcn_readlane((int)fc, src);
}
__device__ __forceinline__ unsigned bin11(float sc) { const unsigned u = __float_as_uint(sc); const int m = (int)((u & 0x7fffffffu) >> 17) - 7360; const unsigned mc = (unsigned)(m < 0 ? 0 : (m > 1023 ? 1023 : m)); return (u >> 31) ? (1023u - mc) : (1024u + mc); }
template <int PASS> __device__ __forceinline__ void p3_score_pass(const bf16x8 (&af)[2][4], const float (&wv)[2][16], const bf16* kib, int t0, int nt, int wave, int n, int hi,
                                                                  LAS unsigned char* lds, const unsigned (&thr)[2][2]) {
    LAS unsigned* HIST = (LAS unsigned*)(lds + P3_HIST); LAS unsigned* BM = (LAS unsigned*)(lds + P3_BM); LAS unsigned* QS = (LAS unsigned*)(lds + P3_QS);
    const int kmax = t0 + 15;
    bf16x8 bc[4], bn[4];
    const int qh = 8 * (wave >> 2), w4 = wave & 3;
    { const int k = (32 * w4 + n < kmax) ? (32 * w4 + n) : kmax; const bf16* kp = kib + (size_t)k * IDX + 32 * hi;
#pragma unroll
      for (int s = 0; s < 4; ++s) bc[s] = *(const bf16x8*)(kp + 8 * s); }
    for (int tile = w4; tile < nt; tile += 4) {
        { const int tn = (tile + 4 < nt) ? tile + 4 : tile; const int k = (32 * tn + n < kmax) ? (32 * tn + n) : kmax; const bf16* kp = kib + (size_t)k * IDX + 32 * hi;
#pragma unroll
          for (int s = 0; s < 4; ++s) bn[s] = *(const bf16x8*)(kp + 8 * s); }
        const int key = 32 * tile + n; const bool full = (32 * tile + 31 <= t0);
#pragma unroll
        for (int mt = 0; mt < 2; ++mt) {
            f32x16 acc;
#pragma unroll
            for (int r = 0; r < 16; ++r) acc[r] = 0.f;
#pragma unroll
            for (int s = 0; s < 4; ++s) acc = __builtin_amdgcn_mfma_f32_32x32x16_bf16(af[mt][s], bc[s], acc, 0, 0, 0);
            float s0 = 0.f, s1 = 0.f;
#pragma unroll
            for (int r = 0; r < 8; ++r) { s0 = __builtin_fmaf(wv[mt][r], fmaxf(acc[r], 0.f), s0); s1 = __builtin_fmaf(wv[mt][8 + r], fmaxf(acc[8 + r], 0.f), s1); }
#pragma unroll
            for (int j = 0; j < 2; ++j) {
                const int q = qh + 4 * mt + hi + 2 * j; const float sc = j ? s1 : s0; const bool valid = full || (key <= t0 + q);
                const float scz = sc + 0.0f; const unsigned k32 = f2key(scz), bin = bin11(scz);
                if (valid) {
                    if (PASS == 1) { __hip_atomic_fetch_add(&HIST[q * 1024 + (bin >> 1)], 1u << (16 * (bin & 1u)), __ATOMIC_RELAXED, __HIP_MEMORY_SCOPE_WORKGROUP); }
                    else {
                        if (bin > thr[mt][j]) { __hip_atomic_fetch_or(&BM[q * 256 + (key >> 5)], 1u << (key & 31), __ATOMIC_RELAXED, __HIP_MEMORY_SCOPE_WORKGROUP); }
                        else if (bin == thr[mt][j]) { const unsigned pos = __hip_atomic_fetch_add(&QS[q * 8 + 3], 1u, __ATOMIC_RELAXED, __HIP_MEMORY_SCOPE_WORKGROUP);
                            if (pos < (unsigned)P3_CAP) { HIST[q * 1024 + 2 * pos] = k32; HIST[q * 1024 + 2 * pos + 1] = (unsigned)key; } }
                    }
                }
            }
        }
#pragma unroll
        for (int s = 0; s < 4; ++s) bc[s] = bn[s];
    }
}
__device__ __forceinline__ void p3_index(Frame& F) {
    unsigned char* ws = F.ws; const int tid = F.tid, lane = F.lane, wave = F.wave, n = lane & 31, hi = lane >> 5;
    const bf16* QIF = (const bf16*)(ws + WS_QIF); const bf16* KIF = (const bf16*)(ws + WS_KIF); const float* WIF = (const float*)(ws + WS_WIF); int* SEL = (int*)(ws + WS_SEL);
    LAS unsigned char* lds = F.lds;
    LAS unsigned* HIST = (LAS unsigned*)(lds + P3_HIST); LAS unsigned* H2 = (LAS unsigned*)(lds + P3_H2 + wave * 4096); LAS unsigned* BM = (LAS unsigned*)(lds + P3_BM); LAS unsigned* QS = (LAS unsigned*)(lds + P3_QS);
    LAS unsigned* FLAG = (LAS unsigned*)(lds + P3_FLAG); LAS unsigned* FBL = (LAS unsigned*)(lds + P3_QS + 1024);
    if (tid == 0) FBL[0] = 0u;
    __syncthreads();
    for (int ps = F.bid; ps < 512; ps += F.G) {
        const int b = ps >> 8, wq = ps & 255;
#pragma unroll 1
        for (int half = 0; half < 2; ++half) {
            const int idx = half ? (511 - wq) : wq; const int t0 = 16 * idx, row0 = (b << 13) + t0;
            if (idx < 16) {
                for (int e = tid; e < 16 * TOPK; e += 512) { const int q = e >> 8, i = e & 255; SEL[(size_t)(row0 + q) * TOPK + i] = (i <= t0 + q) ? i : 0; }
                continue;
            }
            for (int e = tid; e < 16384; e += 512) HIST[e] = 0u;
            for (int e = tid; e < 4096; e += 512) BM[e] = 0u;
            if (tid < 132) QS[tid] = 0u;
            bf16x8 af[2][4]; float wv[2][16]; const int qh = 8 * (wave >> 2);
            { const int head = (n & 3) + 4 * ((n >> 3) & 1), q4 = ((n >> 2) & 1) + 2 * (n >> 4);
#pragma unroll
              for (int mt = 0; mt < 2; ++mt) { const bf16* ap = QIF + (size_t)(row0 + qh + 4 * mt + q4) * 512 + head * IDX + 32 * hi;
#pragma unroll
                  for (int s = 0; s < 4; ++s) af[mt][s] = *(const bf16x8*)(ap + 8 * s);
#pragma unroll
                  for (int r = 0; r < 16; ++r) wv[mt][r] = WIF[(size_t)(row0 + qh + 4 * mt + hi + 2 * (r >> 3)) * 8 + (r & 7)]; } }
            const int nt = (t0 + 16 + 31) >> 5; const bf16* kib = KIF + (size_t)(b << 13) * IDX;
            unsigned thr[2][2] = {{0u, 0u}, {0u, 0u}};
            __syncthreads();
            p3_score_pass<1>(af, wv, kib, t0, nt, wave, n, hi, lds, thr);
            __syncthreads();
#pragma unroll 1
            for (int qq = 0; qq < 2; ++qq) { const int q = 2 * wave + qq; unsigned bin, need, cnt; bool ok;
                find_bin_2048(HIST + q * 1024, (unsigned)TOPK, lane, bin, need, cnt, ok);
                if (lane == 0) { const bool defer = !ok || cnt > (unsigned)P3_CAP; QS[q * 8 + 0] = defer ? 4096u : bin; QS[q * 8 + 1] = need; QS[q * 8 + 2] = cnt; QS[q * 8 + 4] = defer ? 1u : 0u;
                    if (defer) { const unsigned k = __hip_atomic_fetch_add(&FBL[0], 1u, __ATOMIC_RELAXED, __HIP_MEMORY_SCOPE_WORKGROUP); if (k < 63u) FBL[1 + k] = (unsigned)(row0 + q); } } }
            __syncthreads();
#pragma unroll
            for (int mt = 0; mt < 2; ++mt)
#pragma unroll
                for (int j = 0; j < 2; ++j) thr[mt][j] = QS[(qh + 4 * mt + hi + 2 * j) * 8];
            __syncthreads();
            p3_score_pass<2>(af, wv, kib, t0, nt, wave, n, hi, lds, thr);
            __syncthreads();
#pragma unroll 1
            for (int qq = 0; qq < 2; ++qq) {
                const int q = 2 * wave + qq; LAS unsigned* cand = HIST + q * 1024; LAS unsigned* bmq = BM + q * 256;
                const unsigned needA = QS[q * 8 + 1], c = QS[q * 8 + 2];
                if (QS[q * 8 + 4] != 0u) continue;
                for (unsigned i0 = 0; i0 < c; i0 += 64) { const unsigned i = i0 + lane; const bool in = i < c; const unsigned k32 = in ? cand[2 * i] : 0u, ki = in ? (cand[2 * i + 1] & 8191u) : 0u; unsigned rank = 0u;
                    for (unsigned j = 0; j < c; ++j) { const unsigned kj = cand[2 * j], ij = cand[2 * j + 1]; rank += (kj > k32 || (kj == k32 && ij < ki)) ? 1u : 0u; }
                    if (in && rank < needA) __hip_atomic_fetch_or(&bmq[ki >> 5], 1u << (ki & 31), __ATOMIC_RELAXED, __HIP_MEMORY_SCOPE_WORKGROUP); }
                WAVE_SYNC();
                unsigned w0 = bmq[4 * lane], w1 = bmq[4 * lane + 1], w2 = bmq[4 * lane + 2], w3 = bmq[4 * lane + 3];
                const unsigned mycnt = __popc(w0) + __popc(w1) + __popc(w2) + __popc(w3);
                unsigned incl = mycnt;
#pragma unroll
                for (int o = 1; o < 64; o <<= 1) { const unsigned v = __shfl_up(incl, o); if (lane >= o) incl += v; }
                unsigned pos = incl - mycnt; int* sel = SEL + (size_t)(row0 + q) * TOPK;
#pragma unroll
                for (int wi = 0; wi < 4; ++wi) { unsigned w = (wi == 0) ? w0 : (wi == 1) ? w1 : (wi == 2) ? w2 : w3;
                    while (w) { const int bit = __ffs((int)w) - 1; if (pos < (unsigned)TOPK) sel[pos] = 128 * lane + 32 * wi + bit; ++pos; w &= w - 1u; } }
            }
            __syncthreads();
        }
    }
    __syncthreads();
    const unsigned nfb = FBL[0];
    for (unsigned k = 0; k < nfb && k < 63u; ++k) { const int r0 = (int)FBL[1 + k]; __syncthreads(); p3_query_naive(ws, lds, r0, SEL); }
}

__device__ __forceinline__ void p4_dsa_naive(Frame& F) {
    unsigned char* ws = F.ws; const int lane = F.lane;
    const bf16* QF = (const bf16*)(ws + WS_QF); const bf16* KVF = (const bf16*)(ws + WS_KVF); const int* SEL = (const int*)(ws + WS_SEL); bf16* AO = (bf16*)(ws + WS_AO);
    LAS f32x4* sc = (LAS f32x4*)(F.lds + F.wave * 4096);
    const int gw = F.wave * F.G + F.bid, NGW = F.G * NWAVES;
    for (int p = gw; p < 2 * M; p += NGW) {
        const int row = p >> 1, kvh = p & 1, b = row >> 13, t = row & (SEQ - 1); const int cnt = (t + 1 < TOPK) ? (t + 1) : TOPK;
        const int* sel = SEL + (size_t)row * TOPK;
        int myidx[4];
#pragma unroll
        for (int j = 0; j < 4; ++j) myidx[j] = sel[lane + 64 * j];
        float qa[4], qb[4];
#pragma unroll
        for (int g = 0; g < 4; ++g) { const unsigned w = *(const unsigned*)(QF + (size_t)row * D + (kvh * 4 + g) * HD + 2 * lane); qa[g] = bflo(w); qb[g] = bfhi(w); }
        const bf16* kvb = KVF + (size_t)(b * NKV + kvh) * SEQ * 256 + 2 * lane;
#pragma unroll
        for (int j = 0; j < 4; ++j) {
            const int lim = cnt - 64 * j < 64 ? cnt - 64 * j : 64;
            for (int i = 0; i < lim; ++i) {
                const int key = __builtin_amdgcn_readlane(myidx[j], i);
                const unsigned w = *(const unsigned*)(kvb + (size_t)key * 256); const float k0 = bflo(w), k1 = bfhi(w);
                f32x4 d;
                d[0] = wave_sum(qa[0] * k0 + qb[0] * k1); d[1] = wave_sum(qa[1] * k0 + qb[1] * k1); d[2] = wave_sum(qa[2] * k0 + qb[2] * k1); d[3] = wave_sum(qa[3] * k0 + qb[3] * k1);
                if (lane == 0) sc[64 * j + i] = d;
            }
        }
        float mx[4] = {-INFINITY, -INFINITY, -INFINITY, -INFINITY};
#pragma unroll
        for (int j = 0; j < 4; ++j) { const int pp = lane + 64 * j; if (pp < cnt) { const f32x4 v = sc[pp];
#pragma unroll
            for (int g = 0; g < 4; ++g) mx[g] = fmaxf(mx[g], v[g]); } }
#pragma unroll
        for (int g = 0; g < 4; ++g) mx[g] = wave_max(mx[g]);
        float sm[4] = {0.f, 0.f, 0.f, 0.f};
#pragma unroll
        for (int j = 0; j < 4; ++j) { const int pp = lane + 64 * j; if (pp < cnt) { f32x4 v = sc[pp];
#pragma unroll
            for (int g = 0; g < 4; ++g) { v[g] = __builtin_amdgcn_exp2f(v[g] - mx[g]); sm[g] += v[g]; }
            sc[pp] = v; } }
#pragma unroll
        for (int g = 0; g < 4; ++g) sm[g] = 1.0f / wave_sum(sm[g]);
        float oa[4] = {0.f, 0.f, 0.f, 0.f}, ob[4] = {0.f, 0.f, 0.f, 0.f};
#pragma unroll
        for (int j = 0; j < 4; ++j) {
            const int lim = cnt - 64 * j < 64 ? cnt - 64 * j : 64;
            for (int i = 0; i < lim; ++i) {
                const int key = __builtin_amdgcn_readlane(myidx[j], i);
                const unsigned w = *(const unsigned*)(kvb + (size_t)key * 256 + 128); const float v0 = bflo(w), v1 = bfhi(w);
                const f32x4 pr = sc[64 * j + i];
#pragma unroll
                for (int g = 0; g < 4; ++g) { oa[g] += pr[g] * v0; ob[g] += pr[g] * v1; }
            }
        }
#pragma unroll
        for (int g = 0; g < 4; ++g) *(unsigned*)(AO + (size_t)row * D + (kvh * 4 + g) * HD + 2 * lane) = pk2(oa[g] * sm[g], ob[g] * sm[g]);
    }
}

typedef short v4i16_t __attribute__((ext_vector_type(4)));
typedef int v4i __attribute__((ext_vector_type(4)));
__device__ __forceinline__ v4i16_t tr16(LAS unsigned char* p) { return __builtin_amdgcn_ds_read_tr16_b64_v4i16((LAS v4i16_t*)p); }
__device__ __forceinline__ void p4_dsa(Frame& F) {
    unsigned char* ws = F.ws; const int lane = F.lane, nh = lane & 15, kg = lane >> 4;
    const bf16* QF = (const bf16*)(ws + WS_QF); const bf16* KVF = (const bf16*)(ws + WS_KVF); const int* SEL = (const int*)(ws + WS_SEL); bf16* AO = (bf16*)(ws + WS_AO);
    LAS unsigned char* wl = F.lds + F.wave * 10240; LAS int* selw = (LAS int*)wl; LAS unsigned char* vb = wl + 1024;
    const int gw = F.wave * F.G + F.bid, NGW = F.G * NWAVES;
    LAS unsigned char* trp = vb + (4 * kg + ((lane >> 2) & 3)) * 288 + 8 * (lane & 3);
#pragma unroll 1
    for (int combo = 0; combo < BATCH * NKV; ++combo) {
        const int b = combo >> 1, kvh = combo & 1;
#pragma unroll 1
        for (int t = gw; t < SEQ; t += NGW) {
            const int row = (b << 13) + t; const int cnt = (t + 1 < TOPK) ? (t + 1) : TOPK;
            *(LAS v4i*)(selw + 4 * lane) = *(const v4i*)(SEL + (size_t)row * TOPK + 4 * lane);
            WAVE_SYNC();
            {
            const bf16* kvb = KVF + (size_t)(b * NKV + kvh) * SEQ * 256;
            const bf16* qp = QF + (size_t)row * D + (kvh * 4 + (nh & 3)) * HD + 32 * kg;
            bf16x8 qf[4];
#pragma unroll
            for (int s = 0; s < 4; ++s) { qf[s] = *(const bf16x8*)(qp + 8 * s); if (nh >= 4) qf[s] = (bf16x8){0, 0, 0, 0, 0, 0, 0, 0}; }
            f32x4 S[16];
#pragma unroll
            for (int T = 0; T < 16; ++T) {
                const int key = selw[16 * T + nh] & (SEQ - 1); const bf16* kp = kvb + (size_t)key * 256 + 32 * kg;
                const bf16x8 k0 = *(const bf16x8*)(kp), k1 = *(const bf16x8*)(kp + 8), k2 = *(const bf16x8*)(kp + 16), k3 = *(const bf16x8*)(kp + 24);
                f32x4 a = (f32x4){0.f, 0.f, 0.f, 0.f};
                a = __builtin_amdgcn_mfma_f32_16x16x32_bf16(k0, qf[0], a, 0, 0, 0); a = __builtin_amdgcn_mfma_f32_16x16x32_bf16(k1, qf[1], a, 0, 0, 0);
                a = __builtin_amdgcn_mfma_f32_16x16x32_bf16(k2, qf[2], a, 0, 0, 0); a = __builtin_amdgcn_mfma_f32_16x16x32_bf16(k3, qf[3], a, 0, 0, 0);
                S[T] = a;
            }
            float mx = -INFINITY;
#pragma unroll
            for (int T = 0; T < 16; ++T)
#pragma unroll
                for (int r = 0; r < 4; ++r) { const float v = (16 * T + 4 * kg + r < cnt) ? S[T][r] : -INFINITY; S[T][r] = v; mx = fmaxf(mx, v); }
            mx = fmaxf(mx, __shfl_xor(mx, 16)); mx = fmaxf(mx, __shfl_xor(mx, 32));
            float sum = 0.f;
#pragma unroll
            for (int T = 0; T < 16; ++T)
#pragma unroll
                for (int r = 0; r < 4; ++r) { const float e = __builtin_amdgcn_exp2f(S[T][r] - mx); S[T][r] = e; sum += e; }
            sum += __shfl_xor(sum, 16); sum += __shfl_xor(sum, 32);
            f32x4 O[8];
#pragma unroll
            for (int d = 0; d < 8; ++d) O[d] = (f32x4){0.f, 0.f, 0.f, 0.f};
            v4u g[8];
#pragma unroll
            for (int i = 0; i < 8; ++i) { const int key = selw[4 * i + kg] & (SEQ - 1); g[i] = *(const v4u*)(kvb + (size_t)key * 256 + 128 + 8 * nh); }
#pragma unroll
            for (int c = 0; c < 8; ++c) {
#pragma unroll
                for (int i = 0; i < 8; ++i) *(LAS v4u*)(vb + (4 * i + kg) * 288 + nh * 16) = g[i];
                if (c < 7) {
#pragma unroll
                    for (int i = 0; i < 8; ++i) { const int key = selw[32 * (c + 1) + 4 * i + kg] & (SEQ - 1); g[i] = *(const v4u*)(kvb + (size_t)key * 256 + 128 + 8 * nh); }
                }
                v4u pw; pw.x = pg8::cvt_pk_bf16(S[2 * c][0], S[2 * c][1]); pw.y = pg8::cvt_pk_bf16(S[2 * c][2], S[2 * c][3]); pw.z = pg8::cvt_pk_bf16(S[2 * c + 1][0], S[2 * c + 1][1]); pw.w = pg8::cvt_pk_bf16(S[2 * c + 1][2], S[2 * c + 1][3]);
                const bf16x8 pa = __builtin_bit_cast(bf16x8, pw);
#pragma unroll
                for (int d = 0; d < 8; ++d) {
                    const v4i16_t lo = tr16(trp + 32 * d), hi4 = tr16(trp + 16 * 288 + 32 * d);
                    const bf16x8 vfr = (bf16x8){lo[0], lo[1], lo[2], lo[3], hi4[0], hi4[1], hi4[2], hi4[3]};
                    O[d] = __builtin_amdgcn_mfma_f32_16x16x32_bf16(pa, vfr, O[d], 0, 0, 0);
                }
            }
            const float i0 = 1.0f / __builtin_bit_cast(float, __builtin_amdgcn_readlane(__builtin_bit_cast(int, sum), 0)), i1 = 1.0f / __builtin_bit_cast(float, __builtin_amdgcn_readlane(__builtin_bit_cast(int, sum), 1));
            const float i2 = 1.0f / __builtin_bit_cast(float, __builtin_amdgcn_readlane(__builtin_bit_cast(int, sum), 2)), i3 = 1.0f / __builtin_bit_cast(float, __builtin_amdgcn_readlane(__builtin_bit_cast(int, sum), 3));
            LAS bf16* ost = (LAS bf16*)vb;
            if (kg == 0) {
#pragma unroll
                for (int d = 0; d < 8; ++d) { ost[0 * 128 + 16 * d + nh] = (bf16)f2bf(O[d][0] * i0); ost[1 * 128 + 16 * d + nh] = (bf16)f2bf(O[d][1] * i1); ost[2 * 128 + 16 * d + nh] = (bf16)f2bf(O[d][2] * i2); ost[3 * 128 + 16 * d + nh] = (bf16)f2bf(O[d][3] * i3); }
            }
            WAVE_SYNC();
            const v4u ov = *(LAS v4u*)(vb + 16 * lane);
            *(v4u*)(AO + (size_t)row * D + (kvh * 4 + kg) * HD + 8 * nh) = ov;
            }
        }
    }
}

__device__ __forceinline__ void p9_sb(Frame& F) {
    unsigned char* ws = F.ws; const int lane = F.lane, n = lane & 31, hi = lane >> 5;
    const bf16* KQ = (const bf16*)(ws + WS_KQ); const bf16* VT = (const bf16*)(ws + WS_VT); bf16* AO = (bf16*)(ws + WS_AO);
    const int gw = F.wave * F.G + F.bid, NGW = F.G * NWAVES;
    const int koff = 16 * (n >> 4) + 8 * ((n >> 2) & 1) + 4 * ((n >> 3) & 1) + (n & 3);
    constexpr float LOG2E = 1.4426950408889634f, LN2 = 0.6931471805599453f;
    for (int u = gw; u < (M / 32) * NH; u += NGW) {
        const int h = u & 7, blk = u >> 3, b = blk >> 8, qb = blk & 255, q0 = 32 * qb, t = q0 + n;
        const bf16* qp = KQ + (size_t)(b * SEQ + q0 + n) * 2048 + 1024 + h * HD + 64 * hi;
        bf16x8 qf[8];
#pragma unroll
        for (int s = 0; s < 8; ++s) qf[s] = *(const bf16x8*)(qp + 8 * s);
        f32x16 o[4];
#pragma unroll
        for (int mt = 0; mt < 4; ++mt)
#pragma unroll
            for (int r = 0; r < 16; ++r) o[mt][r] = 0.f;
        float C = 0.f;
        for (int kb = qb; kb >= 0; --kb) {
            const int k0 = 32 * kb;
            const bf16* kp = KQ + (size_t)(b * SEQ + k0 + koff) * 2048 + h * HD + 64 * hi;
            bf16x8 kf[8];
#pragma unroll
            for (int s = 0; s < 8; ++s) kf[s] = *(const bf16x8*)(kp + 8 * s);
            bf16x8 vf[4][2];
#pragma unroll
            for (int mt = 0; mt < 4; ++mt)
#pragma unroll
                for (int sp = 0; sp < 2; ++sp) vf[mt][sp] = *(const bf16x8*)(VT + (size_t)(h * HD + 32 * mt + n) * M + b * SEQ + k0 + 16 * sp + 8 * hi);
            f32x16 z;
#pragma unroll
            for (int r = 0; r < 16; ++r) z[r] = 0.f;
#pragma unroll
            for (int s = 0; s < 8; ++s) z = __builtin_amdgcn_mfma_f32_32x32x16_bf16(kf[s], qf[s], z, 0, 0, 0);
            float lk[16], lb[16];
#pragma unroll
            for (int r = 0; r < 16; ++r) {
                const int key = k0 + ((r < 8) ? (8 * hi + r) : (16 + 8 * hi + (r - 8)));
                const float zz = z[r]; const float L = __builtin_amdgcn_logf(1.0f + __builtin_amdgcn_exp2f(-fabsf(zz) * LOG2E)) * LN2;
                const bool valid = key < t;
                lk[r] = valid ? (-fmaxf(zz, 0.f) - L) : 0.f;
                lb[r] = valid ? (fminf(zz, 0.f) - L) : -INFINITY;
            }
            float suf[16];
            suf[7] = 0.f; suf[15] = 0.f;
#pragma unroll
            for (int i = 6; i >= 0; --i) { suf[i] = suf[i + 1] + lk[i + 1]; suf[8 + i] = suf[9 + i] + lk[9 + i]; }
            const float T0 = suf[0] + lk[0], T1 = suf[8] + lk[8];
            const float P0 = __shfl_xor(T0, 32), P1 = __shfl_xor(T1, 32);
            const float base1 = C + (hi ? 0.f : P1), base0 = C + (hi ? (T1 + P1) : (P0 + T1 + P1));
            unsigned pw[8];
#pragma unroll
            for (int r = 0; r < 16; r += 2) {
                const float a0 = __builtin_amdgcn_exp2f((lb[r] + ((r < 8) ? base0 : base1) + suf[r]) * LOG2E), a1 = __builtin_amdgcn_exp2f((lb[r + 1] + ((r < 8) ? base0 : base1) + suf[r + 1]) * LOG2E);
                pw[r >> 1] = pg8::cvt_pk_bf16(a0, a1);
            }
            C += (T0 + T1) + (P0 + P1);
            const bf16x8 pa0 = __builtin_bit_cast(bf16x8, (v4u){pw[0], pw[1], pw[2], pw[3]}), pa1 = __builtin_bit_cast(bf16x8, (v4u){pw[4], pw[5], pw[6], pw[7]});
#pragma unroll
            for (int mt = 0; mt < 4; ++mt) { o[mt] = __builtin_amdgcn_mfma_f32_32x32x16_bf16(vf[mt][0], pa0, o[mt], 0, 0, 0); o[mt] = __builtin_amdgcn_mfma_f32_32x32x16_bf16(vf[mt][1], pa1, o[mt], 0, 0, 0); }
            if (__all(C < -44.0f)) break;
        }
        bf16* op = AO + (size_t)(b * SEQ + q0 + n) * D + h * HD + 4 * hi;
#pragma unroll
        for (int mt = 0; mt < 4; ++mt)
#pragma unroll
            for (int g = 0; g < 4; ++g) { v2u w; w.x = pg8::cvt_pk_bf16(o[mt][4 * g], o[mt][4 * g + 1]); w.y = pg8::cvt_pk_bf16(o[mt][4 * g + 2], o[mt][4 * g + 3]); *(v2u*)(op + 32 * mt + 8 * g) = w; }
    }
}

__device__ __forceinline__ void p11_router(Frame& F) {
    unsigned char* ws = F.ws; const int tid = F.tid, lane = F.lane, wave = F.wave;
    const float* H = (const float*)(ws + WS_H); const float* gn = F.in[IN_FFNNORM] + D; const float* Wr = F.in[IN_ROUTER];
    int* TOPE = (int*)(ws + WS_RT); int* POS = (int*)(ws + WS_RT + 128 * 1024); float* GATE = (float*)(ws + WS_RT + 256 * 1024); float* RSTD3 = (float*)(ws + WS_RT + 384 * 1024);
    LAS unsigned* lcnt = (LAS unsigned*)F.lds;
    LAS unsigned* gb = (LAS unsigned*)(F.lds + 64);
    LAS int* ltok = (LAS int*)(F.lds + 128);
    LAS float* lgt = (LAS float*)(F.lds + 128 + 1024);
    for (int chunk = F.bid; chunk < M / 64; chunk += F.G) {
        if (tid < 8) lcnt[tid] = 0u;
        __syncthreads();
        for (int r = 0; r < 8; ++r) {
            const int row = chunk * 64 + wave * 8 + r;
            const GAS f32x4* xr = (const GAS f32x4*)(H + (size_t)row * D) + lane; f32x4 v[4]; float ss = 0.f;
#pragma unroll
            for (int j = 0; j < 4; ++j) { v[j] = xr[64 * j]; ss += (v[j].x * v[j].x + v[j].y * v[j].y) + (v[j].z * v[j].z + v[j].w * v[j].w); }
            ss = wave_sum(ss); const float rs = 1.0f / sqrtf(ss * (1.0f / 1024.0f) + 1e-6f);
            float lg[8] = {0.f, 0.f, 0.f, 0.f, 0.f, 0.f, 0.f, 0.f};
#pragma unroll
            for (int j = 0; j < 4; ++j)
#pragma unroll
                for (int i = 0; i < 4; ++i) { const int k = 256 * j + 4 * lane + i; const float xv = v[j][i] * gn[k]; const f32x4 w0 = *(const f32x4*)(Wr + (size_t)k * 8), w1 = *(const f32x4*)(Wr + (size_t)k * 8 + 4);
                    lg[0] += xv * w0[0]; lg[1] += xv * w0[1]; lg[2] += xv * w0[2]; lg[3] += xv * w0[3]; lg[4] += xv * w1[0]; lg[5] += xv * w1[1]; lg[6] += xv * w1[2]; lg[7] += xv * w1[3]; }
#pragma unroll
            for (int e = 0; e < 8; ++e) lg[e] = wave_sum(lg[e]) * rs;
            int i1 = 0; float l1 = lg[0];
#pragma unroll
            for (int e = 1; e < 8; ++e) if (lg[e] > l1) { l1 = lg[e]; i1 = e; }
            int i2 = -1; float l2 = -INFINITY;
#pragma unroll
            for (int e = 0; e < 8; ++e) if (e != i1 && lg[e] > l2) { l2 = lg[e]; i2 = e; }
            const float g1 = 1.0f / (1.0f + __expf(l2 - l1)), g2 = 1.0f - g1;
            if (lane == 0) {
                const unsigned p1 = __hip_atomic_fetch_add(&lcnt[i1], 1u, __ATOMIC_RELAXED, __HIP_MEMORY_SCOPE_WORKGROUP), p2 = __hip_atomic_fetch_add(&lcnt[i2], 1u, __ATOMIC_RELAXED, __HIP_MEMORY_SCOPE_WORKGROUP);
                const int ti = wave * 8 + r; ltok[ti * 4 + 0] = i1; ltok[ti * 4 + 1] = i2; ltok[ti * 4 + 2] = (int)p1; ltok[ti * 4 + 3] = (int)p2;
                lgt[ti * 4 + 0] = g1; lgt[ti * 4 + 1] = g2; lgt[ti * 4 + 2] = rs;
            }
        }
        __syncthreads();
        if (tid < 8) gb[tid] = __hip_atomic_fetch_add(F.ctl + CW_CNT + tid, lcnt[tid], RLX_AGENT);
        __syncthreads();
        if (tid < 64) { const int row = chunk * 64 + tid; const int e1 = ltok[tid * 4], e2 = ltok[tid * 4 + 1];
            TOPE[row * 2] = e1; TOPE[row * 2 + 1] = e2; POS[row * 2] = (int)gb[e1] + ltok[tid * 4 + 2]; POS[row * 2 + 1] = (int)gb[e2] + ltok[tid * 4 + 3];
            GATE[row * 2] = lgt[tid * 4]; GATE[row * 2 + 1] = lgt[tid * 4 + 1]; RSTD3[row] = lgt[tid * 4 + 2]; }
        __syncthreads();
    }
}
__device__ __forceinline__ void moe_bases(Frame& F, int (&tb)[9]) {
    int acc = 0;
#pragma unroll
    for (int e = 0; e < 8; ++e) { tb[e] = acc; const unsigned c = __hip_atomic_load(F.ctl + CW_CNT + e, RLX_AGENT); acc += (int)((c + 255u) >> 8); }
    tb[8] = acc;
}
__device__ __forceinline__ void p12_permute(Frame& F) {
    unsigned char* ws = F.ws; const int lane = F.lane;
    const int* TOPE = (const int*)(ws + WS_RT); const int* POS = (const int*)(ws + WS_RT + 128 * 1024); const float* GATE = (const float*)(ws + WS_RT + 256 * 1024); const float* RSTD3 = (const float*)(ws + WS_RT + 384 * 1024);
    int* SLOT = (int*)(ws + WS_RT + 512 * 1024); float* RSTDS = (float*)(ws + WS_RSTDS); float* GATES = (float*)(ws + WS_GATES);
    const bf16* XB = (const bf16*)(ws + WS_XB); bf16* XP = (bf16*)(ws + WS_XPERM);
    int tb[9]; moe_bases(F, tb);
    const int gw = F.wave * F.G + F.bid, NGW = F.G * NWAVES;
    for (int i = gw; i < 2 * M; i += NGW) {
        const int row = i >> 1; const int e = TOPE[i]; int base = 0;
#pragma unroll
        for (int k = 0; k < 8; ++k) base = (e == k) ? tb[k] : base;
        const int slot = base * 256 + POS[i];
        const v4u* src = (const v4u*)(XB + (size_t)row * D) + lane; v4u* dst = (v4u*)(XP + (size_t)slot * D) + lane;
        const v4u a = src[0], c = src[64]; dst[0] = a; dst[64] = c;
        if (lane == 0) { SLOT[i] = slot; RSTDS[slot] = RSTD3[row]; GATES[slot] = GATE[i]; }
    }
}
__device__ __forceinline__ void p15_combine(Frame& F) {
    unsigned char* ws = F.ws; const int lane = F.lane;
    const float* H = (const float*)(ws + WS_H); const bf16* Y = (const bf16*)(ws + WS_Y); const int* SLOT = (const int*)(ws + WS_RT + 512 * 1024);
    const int gw = F.wave * F.G + F.bid, NGW = F.G * NWAVES;
    for (int row = gw; row < M; row += NGW) {
        const int s1 = SLOT[row * 2], s2 = SLOT[row * 2 + 1];
        const GAS f32x4* hr = (const GAS f32x4*)(H + (size_t)row * D) + lane; GAS f32x4* orow = (GAS f32x4*)(F.out + (size_t)row * D) + lane;
        const GAS v2u* y1 = (const GAS v2u*)(Y + (size_t)s1 * D) + lane; const GAS v2u* y2 = (const GAS v2u*)(Y + (size_t)s2 * D) + lane;
#pragma unroll
        for (int j = 0; j < 4; ++j) { const f32x4 h = hr[64 * j]; const v2u a = y1[64 * j], c = y2[64 * j]; f32x4 o;
            o.x = h.x + (bflo(a.x) + bflo(c.x)); o.y = h.y + (bfhi(a.x) + bfhi(c.x)); o.z = h.z + (bflo(a.y) + bflo(c.y)); o.w = h.w + (bfhi(a.y) + bfhi(c.y)); orow[64 * j] = o; }
    }
}

constexpr int N_PHASES = 16;
#ifndef MK_ONE_LAUNCH
#define MK_ONE_LAUNCH 1
#endif
struct Args { const float* in[17]; float* out; unsigned char* ws; int ph_lo, ph_hi; };
__global__ void __launch_bounds__(NWAVES * 64, 2) yoco_fwd(Args args) {
    extern __shared__ __attribute__((aligned(16))) unsigned char lds[];
    Frame F;
    F.lds = (LAS unsigned char*)lds; F.MISC = (volatile LAS unsigned*)(F.lds + MISC_OFF);
    F.tid = threadIdx.x; F.lane = F.tid & 63; F.wave = __builtin_amdgcn_readfirstlane(F.tid >> 6); F.G = gridDim.x; F.bid = blockIdx.x;
    F.ws = args.ws; F.ctl = (gu32*)(args.ws + WS_CTL); F.out = args.out;
#pragma unroll
    for (int i = 0; i < 17; ++i) F.in[i] = args.in[i];
    for (int u = F.tid; u < (LDS_BYTES - LDSCTL_OFF) / 4; u += NWAVES * 64) ((LAS unsigned*)(F.lds + LDSCTL_OFF))[u] = 0u;
    __syncthreads();
    unsigned char* ws = args.ws;
    XcdBarrier bar; bar.bar = (unsigned*)(F.ctl + CW_BAR); bar.x = 0; bar.st = nullptr;
    if (MK_ONE_LAUNCH) bar = xcd_barrier_post((unsigned*)(F.ctl + CW_BAR), F.MISC + 8);
    const int lo = args.ph_lo, hi = args.ph_hi;
#define IN(k) (lo <= (k) && (k) < hi)
#define SEAM(k) do { if (MK_ONE_LAUNCH && IN((k) + 1)) xcd_barrier(bar); } while (0)
    bf16* XB = (bf16*)(ws + WS_XB); float* H = (float*)(ws + WS_H); bf16* AO = (bf16*)(ws + WS_AO);

#ifndef PROBE_DUP
#define PROBE_DUP -1
#endif
    if (IN(0)) { p0_prologue(F); if (PROBE_DUP == 0) p0_prologue(F); SEAM(0); }
    if (IN(1)) {
        pg8::Gemm g{XB, (const bf16*)(ws + WS_WIN), M, 2048, D}; pg8::StaticOrder S; S.init(M, 2048, F.G, F.bid);
        pg8::EpiScaleBf16 E{(bf16*)(ws + WS_PROJ), 2048, (const float*)(ws + WS_SS0)};
        pg8::gemm_phase<pg8::EpiScaleBf16, pg8::StaticOrder, true, true>(F.lds, g, S, E); SEAM(1); }
    if (IN(2)) { p2_post(F); if (PROBE_DUP == 2) p2_post(F); SEAM(2); }
    if (IN(3)) { p3_index(F); if (PROBE_DUP == 3) { __syncthreads(); p3_index(F); } SEAM(3); }
    if (IN(4)) { p4_dsa(F); if (PROBE_DUP == 4) p4_dsa(F); SEAM(4); }
    if (IN(5)) {
        pg8::Gemm g{AO, (const bf16*)(ws + WS_WOA), M, D, D}; pg8::StaticOrder S; S.init(M, D, F.G, F.bid);
        pg8::EpiResid E{F.in[IN_X], H, XB, (float*)(ws + WS_SS1)};
        pg8::gemm_phase<pg8::EpiResid, pg8::StaticOrder, true, true>(F.lds, g, S, E); SEAM(5); }
    if (IN(6)) {
        pg8::Gemm g{XB, (const bf16*)(ws + WS_WGU), M, 2 * FF, D}; pg8::StaticOrder S; S.init(M, 2 * FF, F.G, F.bid);
        pg8::EpiSwiGLU<false> E{(bf16*)(ws + WS_HF), FF, (const float*)(ws + WS_SS1)};
        pg8::gemm_phase<pg8::EpiSwiGLU<false>, pg8::StaticOrder, true, true>(F.lds, g, S, E); SEAM(6); }
    if (IN(7)) {
        pg8::Gemm g{(const bf16*)(ws + WS_HF), (const bf16*)(ws + WS_WD), M, D, FF}; pg8::StaticOrder S; S.init(M, D, F.G, F.bid);
        pg8::EpiResid E{H, H, XB, (float*)(ws + WS_SS2)};
        pg8::gemm_phase<pg8::EpiResid, pg8::StaticOrder, true, true>(F.lds, g, S, E); SEAM(7); }
    if (IN(8)) {
        { pg8::Gemm g{XB, (const bf16*)(ws + WS_WKVQ), M, 2048, D}; pg8::StaticOrder S; S.init(M, 2048, F.G, F.bid);
          pg8::EpiScaleBf16 E{(bf16*)(ws + WS_KQ), 2048, (const float*)(ws + WS_SS2)};
          pg8::gemm_phase<pg8::EpiScaleBf16, pg8::StaticOrder, true, true>(F.lds, g, S, E); }
        { pg8::Gemm g{(const bf16*)(ws + WS_WKVQ) + (size_t)2048 * D, XB, D, M, D}; pg8::StaticOrder S; S.init(D, M, F.G, F.bid);
          pg8::EpiScaleColBf16 E{(bf16*)(ws + WS_VT), M, (const float*)(ws + WS_SS2)};
          pg8::gemm_phase<pg8::EpiScaleColBf16, pg8::StaticOrder, true, true>(F.lds, g, S, E); }
        SEAM(8); }
    if (IN(9)) { p9_sb(F); if (PROBE_DUP == 9) p9_sb(F); SEAM(9); }
    if (IN(10)) {
        pg8::Gemm g{AO, (const bf16*)(ws + WS_WOB), M, D, D}; pg8::StaticOrder S; S.init(M, D, F.G, F.bid);
        pg8::EpiResid E{H, H, XB, (float*)(ws + WS_SS3)};
        pg8::gemm_phase<pg8::EpiResid, pg8::StaticOrder, true, true>(F.lds, g, S, E); SEAM(10); }
    if (IN(11)) { p11_router(F); SEAM(11); }
    if (IN(12)) { p12_permute(F); if (PROBE_DUP == 12) p12_permute(F); SEAM(12); }
    if (IN(13)) {
        pg8::MoeOrder S; moe_bases(F, S.tb); S.npn = 22; S.G = F.G; S.c = F.bid;
        pg8::Gemm g{(const bf16*)(ws + WS_XPERM), (const bf16*)(ws + WS_WGUM), MAXSLOT, NE * 2 * FF, D};
        pg8::EpiSwiGLU<true> E{(bf16*)(ws + WS_HM), FF, (const float*)(ws + WS_RSTDS)};
        pg8::gemm_phase<pg8::EpiSwiGLU<true>, pg8::MoeOrder, true, true>(F.lds, g, S, E); SEAM(13); }
    if (IN(14)) {
        pg8::MoeOrder S; moe_bases(F, S.tb); S.npn = 4; S.G = F.G; S.c = F.bid;
        pg8::Gemm g{(const bf16*)(ws + WS_HM), (const bf16*)(ws + WS_WDM), MAXSLOT, NE * D, FF};
        pg8::EpiGateBf16 E{(bf16*)(ws + WS_Y), (const float*)(ws + WS_GATES)};
        pg8::gemm_phase<pg8::EpiGateBf16, pg8::MoeOrder, true, true>(F.lds, g, S, E); SEAM(14); }
    if (IN(15)) { p15_combine(F); if (PROBE_DUP == 15) p15_combine(F); }
#undef IN
#undef SEAM
}

extern "C" void kernel_launch(void* const* d_in, const int* in_sizes, int n_in, void* d_out, int out_size, void* d_ws, size_t ws_size, hipStream_t stream) {
    static int grid = 0;
    if (grid == 0) {
        if (n_in != 17 || out_size != M * D || ws_size < WS_END) { fprintf(stderr, "kernel_launch: unexpected problem (n_in %d, out %d, ws %zu < %zu)\n", n_in, out_size, ws_size, (size_t)WS_END); grid = -1; return; }
        int dev = 0, cus = 0, per_cu = 0;
        if (hipGetDevice(&dev) != hipSuccess || hipDeviceGetAttribute(&cus, hipDeviceAttributeMultiprocessorCount, dev) != hipSuccess) { grid = -1; return; }
        if (hipFuncSetAttribute((const void*)yoco_fwd, hipFuncAttributeMaxDynamicSharedMemorySize, LDS_BYTES) != hipSuccess) { fprintf(stderr, "kernel_launch: hipFuncSetAttribute failed\n"); grid = -1; return; }
        if (hipOccupancyMaxActiveBlocksPerMultiprocessor(&per_cu, (const void*)yoco_fwd, NWAVES * 64, LDS_BYTES) != hipSuccess || per_cu < 1) fprintf(stderr, "kernel_launch: occupancy query says %d\n", per_cu);
        (void)hipGetLastError();
        grid = cus;
    }
    if (grid < 0) return;
    if (hipMemsetAsync((char*)d_ws + WS_CTL, 0, CTL_ZERO_BYTES, stream) != hipSuccess) return;
    Args a{};
    for (int i = 0; i < 17; ++i) a.in[i] = (const float*)d_in[i];
    a.out = (float*)d_out; a.ws = (unsigned char*)d_ws;
#if MK_ONE_LAUNCH
    a.ph_lo = 0; a.ph_hi = N_PHASES;
    hipLaunchKernelGGL(yoco_fwd, dim3(grid), dim3(NWAVES * 64), LDS_BYTES, stream, a);
#else
    for (int p = 0; p < N_PHASES; ++p) { a.ph_lo = p; a.ph_hi = p + 1; hipLaunchKernelGGL(yoco_fwd, dim3(grid), dim3(NWAVES * 64), LDS_BYTES, stream, a); }
#endif
}
```

```cpp
#include <hip/hip_runtime.h>
#include <cstdio>
#include <cstdint>
namespace pg8 {
#define PG8_LAS __attribute__((address_space(3)))
typedef unsigned short bf16_t;
typedef short bf16x8 __attribute__((ext_vector_type(8)));
typedef float f32x4 __attribute__((ext_vector_type(4)));
typedef unsigned u32x4 __attribute__((ext_vector_type(4)));
constexpr int BM = 256, BK = 64, HALF = 128, HTB = HALF * BK * 2  , STAGE_BYTES = 8 * HTB, NXCD = 8, WGM = 8;

__host__ __device__ __forceinline__ int lds_byte(int r, int c) { const int st = (r >> 4) * 2 + (c >> 5), rr = r & 15, cc = c & 31, ob = rr * 64 + cc * 2; return st * 1024 + (ob ^ (((ob >> 9) & 1) << 5)); }
__host__ __device__ __forceinline__ void stage_rc(int b, int& R, int& C) { const int st = b / 1024, sb = b % 1024, swz = sb ^ (((sb >> 9) & 1) << 5); R = (st >> 1) * 16 + swz / 64; C = (st & 1) * 32 + (swz % 64) / 2; }
__host__ __device__ __forceinline__ int perm32(int rho) { const int n = rho >> 4, i = rho & 15; return 8 * (i >> 2) + 4 * n + (i & 3); }

struct Unit { int pm, pn; };
struct Gemm { const bf16_t* A; const bf16_t* Bt; int M, N, K; };

struct StaticOrder {
    int nM, nN, nwg, G, c;
    __host__ __device__ void init(int M, int N, int G_, int c_) { nM = M / BM; nN = N / BM; nwg = nM * nN; G = G_; c = c_; }
    __host__ __device__ bool next(int i, Unit& u) const {
        const long L = (long)i * G + c; if (L >= nwg) return false;
        int wgid = (int)L; { const int q = nwg / NXCD, r = nwg % NXCD, xcd = wgid % NXCD, off = wgid / NXCD; wgid = (xcd < r ? xcd * (q + 1) : r * (q + 1) + (xcd - r) * q) + off; }
        const int nig = WGM * nN, gid = wgid / nig, fm = gid * WGM, gsz = (nM - fm) < WGM ? (nM - fm) : WGM;
        u.pm = fm + ((wgid % nig) % gsz); u.pn = (wgid % nig) / gsz; return true;
    }
    __device__ __forceinline__ void a_ready(const Unit&) const {}
    __device__ __forceinline__ void done(const Unit&) const {}
};

__device__ __forceinline__ unsigned cvt_pk_bf16(float lo, float hi) { unsigned r; asm volatile("v_cvt_pk_bf16_f32 %0, %1, %2" : "=v"(r) : "v"(lo), "v"(hi)); return r; }
typedef unsigned u32x2 __attribute__((ext_vector_type(2)));
constexpr float RMS_EPS = 1e-6f;
__device__ __forceinline__ float rstd16(const float* p) {
    const f32x4 a = *(const f32x4*)p, b = *(const f32x4*)(p + 4), c = *(const f32x4*)(p + 8), d = *(const f32x4*)(p + 12);
    const float s = (((a[0] + a[1]) + (a[2] + a[3])) + ((b[0] + b[1]) + (b[2] + b[3]))) + (((c[0] + c[1]) + (c[2] + c[3])) + ((d[0] + d[1]) + (d[2] + d[3])));
    return 1.0f / sqrtf(s * (1.0f / 1024.0f) + RMS_EPS);
}
struct EpiScaleBf16 {
    static constexpr bool PERM = true, AFTER_DRAIN = false;
    bf16_t* O; int ldc; const float* ss;
    __device__ __forceinline__ void operator()(const f32x4 (&acc)[2][2][4][2], const Unit& u, int wr, int wc, int fr, int fq) const {
        const int row0 = u.pm * BM + wr * 64 + fr, col0 = u.pn * BM + wc * 32 + 8 * fq;
#pragma unroll
        for (int ai = 0; ai < 2; ++ai)
#pragma unroll
            for (int m = 0; m < 4; ++m) { const int row = row0 + ai * HALF + m * 16; const float rs = rstd16(ss + (size_t)row * 16); bf16_t* rowp = O + (size_t)row * ldc + col0;
#pragma unroll
                for (int bj = 0; bj < 2; ++bj) { const f32x4 v0 = acc[ai][bj][m][0] * rs, v1 = acc[ai][bj][m][1] * rs;
                    u32x4 w; w.x = cvt_pk_bf16(v0[0], v0[1]); w.y = cvt_pk_bf16(v0[2], v0[3]); w.z = cvt_pk_bf16(v1[0], v1[1]); w.w = cvt_pk_bf16(v1[2], v1[3]);
                    *(u32x4*)(rowp + bj * HALF) = w; } }
    }
};
struct EpiScaleColBf16 {
    static constexpr bool PERM = true, AFTER_DRAIN = false;
    bf16_t* O; int ldc; const float* ss;
    __device__ __forceinline__ void operator()(const f32x4 (&acc)[2][2][4][2], const Unit& u, int wr, int wc, int fr, int fq) const {
        const int row0 = u.pm * BM + wr * 64 + fr, col0 = u.pn * BM + wc * 32 + 8 * fq;
        f32x4 rs[2][2];
#pragma unroll
        for (int bj = 0; bj < 2; ++bj)
#pragma unroll
            for (int n = 0; n < 2; ++n)
#pragma unroll
                for (int e = 0; e < 4; ++e) rs[bj][n][e] = rstd16(ss + (size_t)(col0 + bj * HALF + 4 * n + e) * 16);
#pragma unroll
        for (int ai = 0; ai < 2; ++ai)
#pragma unroll
            for (int m = 0; m < 4; ++m) { const int row = row0 + ai * HALF + m * 16; bf16_t* rowp = O + (size_t)row * ldc + col0;
#pragma unroll
                for (int bj = 0; bj < 2; ++bj) { const f32x4 v0 = acc[ai][bj][m][0] * rs[bj][0], v1 = acc[ai][bj][m][1] * rs[bj][1];
                    u32x4 w; w.x = cvt_pk_bf16(v0[0], v0[1]); w.y = cvt_pk_bf16(v0[2], v0[3]); w.z = cvt_pk_bf16(v1[0], v1[1]); w.w = cvt_pk_bf16(v1[2], v1[3]);
                    *(u32x4*)(rowp + bj * HALF) = w; } }
    }
};
struct EpiResid {
    static constexpr bool PERM = false, AFTER_DRAIN = false;
    const float* base; float* H; bf16_t* XB; float* ssp;
    __device__ __forceinline__ void operator()(const f32x4 (&acc)[2][2][4][2], const Unit& u, int wr, int wc, int fr, int fq) const {
        const int row0 = u.pm * BM + wr * 64 + fr, col0 = u.pn * BM + wc * 32 + 4 * fq;
#pragma unroll
        for (int ai = 0; ai < 2; ++ai)
#pragma unroll
            for (int m = 0; m < 4; ++m) { const int row = row0 + ai * HALF + m * 16; float q = 0.f;
#pragma unroll
                for (int bj = 0; bj < 2; ++bj)
#pragma unroll
                    for (int n = 0; n < 2; ++n) { const size_t off = (size_t)row * 1024 + col0 + bj * HALF + n * 16;
                        const f32x4 v = *(const f32x4*)(base + off) + acc[ai][bj][m][n]; *(f32x4*)(H + off) = v;
                        q += (v[0] * v[0] + v[1] * v[1]) + (v[2] * v[2] + v[3] * v[3]);
                        u32x2 w; w.x = cvt_pk_bf16(v[0], v[1]); w.y = cvt_pk_bf16(v[2], v[3]); *(u32x2*)(XB + off) = w; }
                q += __shfl_xor(q, 16); q += __shfl_xor(q, 32);
                if (fq == 0) ssp[(size_t)row * 16 + u.pn * 4 + wc] = q; }
    }
};
__device__ __forceinline__ float silu_mul(float g, float u) { return g * __builtin_amdgcn_rcpf(1.0f + __builtin_amdgcn_exp2f(g * -1.4426950408889634f)) * u; }
template <bool MOE> struct EpiSwiGLU {
    static constexpr bool PERM = true, AFTER_DRAIN = false;
    bf16_t* O; int ldc; const float* ss;
    __device__ __forceinline__ void operator()(const f32x4 (&acc)[2][2][4][2], const Unit& u, int wr, int wc, int fr, int fq) const {
        const int row0 = u.pm * BM + wr * 64 + fr; const int pnl = MOE ? (u.pn % 22) : u.pn; const int col0 = pnl * HALF + wc * 32 + 8 * fq;
#pragma unroll
        for (int ai = 0; ai < 2; ++ai)
#pragma unroll
            for (int m = 0; m < 4; ++m) { const int row = row0 + ai * HALF + m * 16; const float rs = MOE ? ss[row] : rstd16(ss + (size_t)row * 16);
                const f32x4 g0 = acc[ai][0][m][0] * rs, g1 = acc[ai][0][m][1] * rs, u0 = acc[ai][1][m][0] * rs, u1 = acc[ai][1][m][1] * rs;
                u32x4 w; w.x = cvt_pk_bf16(silu_mul(g0[0], u0[0]), silu_mul(g0[1], u0[1])); w.y = cvt_pk_bf16(silu_mul(g0[2], u0[2]), silu_mul(g0[3], u0[3]));
                w.z = cvt_pk_bf16(silu_mul(g1[0], u1[0]), silu_mul(g1[1], u1[1])); w.w = cvt_pk_bf16(silu_mul(g1[2], u1[2]), silu_mul(g1[3], u1[3]));
                *(u32x4*)(O + (size_t)row * ldc + col0) = w; }
    }
};
struct EpiGateBf16 {
    static constexpr bool PERM = true, AFTER_DRAIN = false;
    bf16_t* Y; const float* gate;
    __device__ __forceinline__ void operator()(const f32x4 (&acc)[2][2][4][2], const Unit& u, int wr, int wc, int fr, int fq) const {
        const int row0 = u.pm * BM + wr * 64 + fr, col0 = (u.pn & 3) * BM + wc * 32 + 8 * fq;
#pragma unroll
        for (int ai = 0; ai < 2; ++ai)
#pragma unroll
            for (int m = 0; m < 4; ++m) { const int row = row0 + ai * HALF + m * 16; const float gt = gate[row]; bf16_t* rowp = Y + (size_t)row * 1024 + col0;
#pragma unroll
                for (int bj = 0; bj < 2; ++bj) { const f32x4 v0 = acc[ai][bj][m][0] * gt, v1 = acc[ai][bj][m][1] * gt;
                    u32x4 w; w.x = cvt_pk_bf16(v0[0], v0[1]); w.y = cvt_pk_bf16(v0[2], v0[3]); w.z = cvt_pk_bf16(v1[0], v1[1]); w.w = cvt_pk_bf16(v1[2], v1[3]);
                    *(u32x4*)(rowp + bj * HALF) = w; } }
    }
};
struct MoeOrder {
    int tb[9]; int npn, G, c;
    __device__ __forceinline__ bool next(int i, Unit& u) const {
        const int L = i * G + c; if (L >= tb[8] * npn) return false;
        const int t = L / npn, j = L - t * npn; int e = 0;
#pragma unroll
        for (int k = 1; k < 8; ++k) e += (t >= tb[k]) ? 1 : 0;
        u.pm = t; u.pn = e * npn + j; return true;
    }
    __device__ __forceinline__ void a_ready(const Unit&) const {}
    __device__ __forceinline__ void done(const Unit&) const {}
};

template <class Epi, class Sched, bool ALIGN_EPI = false, bool SP2 = false>
__device__ __forceinline__ void gemm_phase(PG8_LAS unsigned char* lds, const Gemm g, const Sched& S, const Epi& E) {
    const int tid = threadIdx.x, wid = __builtin_amdgcn_readfirstlane(tid >> 6), lane = tid & 63, wr = wid >> 2, wc = wid & 3, fr = lane & 15, fq = lane >> 4;
    const int K = g.K, nt = K / BK;
    unsigned voffA[2], voffB[2];
#pragma unroll
    for (int i = 0; i < 2; ++i) { int R, C; stage_rc(tid * 16 + i * 8192, R, C); const int Rb = Epi::PERM ? ((R & ~31) + perm32(R & 31)) : R;
        voffA[i] = (unsigned)(R * K + C) * 2u; voffB[i] = (unsigned)(Rb * K + C) * 2u; }
    const size_t kstep = (size_t)(BK * 2);
    const size_t hstep = (size_t)HALF * K * 2;
    const size_t tstep = 2 * hstep;
    const unsigned ldsw = (unsigned)wid * 1024u;
    const int aoff = lds_byte(wr * 64 + fr, fq * 8), boff = lds_byte(wc * 32 + fr, fq * 8);
#define PG8_SA(b, h) (((b) * 2 + (h)) * HTB)
#define PG8_SB(b, h) ((4 + (b) * 2 + (h)) * HTB)
#define PG8_STAGE(bufoff, gbase, voff) do { _Pragma("unroll") for (int _i = 0; _i < 2; ++_i) \
        __builtin_amdgcn_global_load_lds((const unsigned*)((const char*)(gbase) + (voff)[_i]), (PG8_LAS unsigned*)(lds + (bufoff) + ldsw + _i * 8192), 16, 0, 0); } while (0)
#define PG8_LDA(dst, b, h) do { _Pragma("unroll") for (int m = 0; m < 4; ++m) _Pragma("unroll") for (int k = 0; k < 2; ++k) dst[m][k] = *(const PG8_LAS bf16x8*)(lds + PG8_SA(b, h) + aoff + m * 2048 + k * 1024); } while (0)
#define PG8_LDB(dst, b, h) do { _Pragma("unroll") for (int n = 0; n < 2; ++n) _Pragma("unroll") for (int k = 0; k < 2; ++k) dst[n][k] = *(const PG8_LAS bf16x8*)(lds + PG8_SB(b, h) + boff + n * 2048 + k * 1024); } while (0)
#define PG8_MMA(ai, bj, At, Bt) do { __builtin_amdgcn_s_setprio(1); _Pragma("unroll") for (int m = 0; m < 4; ++m) _Pragma("unroll") for (int n = 0; n < 2; ++n) _Pragma("unroll") for (int k = 0; k < 2; ++k) \
        acc[ai][bj][m][n] = __builtin_amdgcn_mfma_f32_16x16x32_bf16(Bt[n][k], At[m][k], acc[ai][bj][m][n], 0, 0, 0); __builtin_amdgcn_s_setprio(0); } while (0)
#define PG8_WAIT_V(n) asm volatile("s_waitcnt vmcnt(" #n ")" ::: "memory")
#define PG8_WAIT_L(n) asm volatile("s_waitcnt lgkmcnt(" #n ")" ::: "memory")
#define PG8_BAR __builtin_amdgcn_s_barrier()
#define PG8_SCHED __builtin_amdgcn_sched_barrier(0)
    Unit cur, nxt; int ui = 0;
    if (!S.next(0, cur)) return;
    f32x4 acc[2][2][4][2];
#pragma unroll
    for (int a = 0; a < 2; ++a)
#pragma unroll
        for (int b = 0; b < 2; ++b)
#pragma unroll
            for (int m = 0; m < 4; ++m)
#pragma unroll
                for (int n = 0; n < 2; ++n) acc[a][b][m][n] = (f32x4){0.f, 0.f, 0.f, 0.f};
    bf16x8 At[4][2], B0[2][2], B1[2][2];
    const char* cA = (const char*)g.A + (size_t)cur.pm * tstep; const char* cB = (const char*)g.Bt + (size_t)cur.pn * tstep;
    S.a_ready(cur);
    if constexpr (SP2) {
        PG8_STAGE(PG8_SB(0, 0), cB, voffB); PG8_STAGE(PG8_SB(0, 1), cB + hstep, voffB); PG8_STAGE(PG8_SA(0, 0), cA, voffA); PG8_STAGE(PG8_SA(0, 1), cA + hstep, voffA);
        if (wr == 1) PG8_BAR;
        PG8_WAIT_V(2); PG8_BAR;
        PG8_STAGE(PG8_SB(1, 0), cB + kstep, voffB); PG8_STAGE(PG8_SA(1, 0), cA + kstep, voffA); PG8_STAGE(PG8_SB(1, 1), cB + hstep + kstep, voffB);
        PG8_WAIT_V(6); PG8_BAR;
    } else {
        PG8_STAGE(PG8_SB(0, 0), cB, voffB); PG8_STAGE(PG8_SA(0, 0), cA, voffA); PG8_STAGE(PG8_SB(0, 1), cB + hstep, voffB); PG8_STAGE(PG8_SA(0, 1), cA + hstep, voffA);
        if (wr == 1) PG8_BAR;
        PG8_WAIT_V(4); PG8_BAR;
        PG8_STAGE(PG8_SB(1, 0), cB + kstep, voffB); PG8_STAGE(PG8_SA(1, 0), cA + kstep, voffA); PG8_STAGE(PG8_SB(1, 1), cB + hstep + kstep, voffB);
        PG8_WAIT_V(6); PG8_BAR;
    }
    for (;;) {
        const bool has_next = S.next(ui + 1, nxt);
        const char* nA = has_next ? (const char*)g.A + (size_t)nxt.pm * tstep : cA; const char* nB = has_next ? (const char*)g.Bt + (size_t)nxt.pn * tstep : cB;
        for (int t = 0; t < nt; t += 2) {
            const bool last = (t == nt - 2);
            const char* a1 = cA + (size_t)(t + 1) * kstep;
            const char* a2 = last ? nA : cA + (size_t)(t + 2) * kstep; const char* b2 = last ? nB : cB + (size_t)(t + 2) * kstep;
            const char* a3 = a2 + kstep; const char* b3 = b2 + kstep;
            if (last && has_next) S.a_ready(nxt);
            if constexpr (SP2) {
            PG8_LDB(B0, 0, 0); PG8_LDB(B1, 0, 1); PG8_SCHED; PG8_LDA(At, 0, 0); PG8_STAGE(PG8_SA(1, 1), a1 + hstep, voffA);
            PG8_WAIT_V(8); PG8_WAIT_L(0); PG8_BAR; PG8_MMA(0, 0, At, B0); PG8_MMA(0, 1, At, B1); PG8_BAR; PG8_SCHED;
            PG8_LDA(At, 0, 1); PG8_STAGE(PG8_SB(0, 0), b2, voffB); PG8_STAGE(PG8_SB(0, 1), b2 + hstep, voffB); PG8_STAGE(PG8_SA(0, 0), a2, voffA);
            PG8_WAIT_V(8); PG8_WAIT_L(0); PG8_BAR; PG8_MMA(1, 0, At, B0); PG8_MMA(1, 1, At, B1); PG8_BAR; PG8_SCHED;
            PG8_LDB(B0, 1, 0); PG8_LDB(B1, 1, 1); PG8_SCHED; PG8_LDA(At, 1, 0); PG8_STAGE(PG8_SA(0, 1), a2 + hstep, voffA);
            PG8_WAIT_V(8); PG8_WAIT_L(0); PG8_BAR; PG8_MMA(0, 0, At, B0); PG8_MMA(0, 1, At, B1); PG8_BAR; PG8_SCHED;
            PG8_LDA(At, 1, 1); PG8_STAGE(PG8_SB(1, 0), b3, voffB); PG8_STAGE(PG8_SB(1, 1), b3 + hstep, voffB); PG8_STAGE(PG8_SA(1, 0), a3, voffA);
            PG8_WAIT_V(8); PG8_WAIT_L(0); PG8_BAR; PG8_MMA(1, 0, At, B0); PG8_MMA(1, 1, At, B1); PG8_BAR; PG8_SCHED;
            } else {
            PG8_LDB(B0, 0, 0); PG8_SCHED; PG8_LDA(At, 0, 0); PG8_STAGE(PG8_SA(1, 1), a1 + hstep, voffA);
            PG8_WAIT_L(8); PG8_BAR; PG8_WAIT_L(0); PG8_MMA(0, 0, At, B0); PG8_BAR; PG8_SCHED;
            PG8_LDB(B1, 0, 1); PG8_STAGE(PG8_SB(0, 0), b2, voffB);
            PG8_BAR; PG8_WAIT_L(0); PG8_MMA(0, 1, At, B1); PG8_BAR;
            PG8_LDA(At, 0, 1); PG8_STAGE(PG8_SA(0, 0), a2, voffA);
            PG8_BAR; PG8_WAIT_L(0); PG8_MMA(1, 0, At, B0); PG8_BAR; PG8_SCHED;
            PG8_STAGE(PG8_SB(0, 1), b2 + hstep, voffB);
            PG8_WAIT_V(6); PG8_BAR; PG8_MMA(1, 1, At, B1); PG8_BAR;
            PG8_LDB(B0, 1, 0); PG8_SCHED; PG8_LDA(At, 1, 0); PG8_STAGE(PG8_SA(0, 1), a2 + hstep, voffA);
            PG8_WAIT_L(8); PG8_BAR; PG8_WAIT_L(0); PG8_MMA(0, 0, At, B0); PG8_BAR; PG8_SCHED;
            PG8_LDB(B1, 1, 1); PG8_STAGE(PG8_SB(1, 0), b3, voffB);
            PG8_BAR; PG8_WAIT_L(0); PG8_MMA(0, 1, At, B1); PG8_BAR;
            PG8_LDA(At, 1, 1); PG8_STAGE(PG8_SA(1, 0), a3, voffA);
            PG8_BAR; PG8_WAIT_L(0); PG8_MMA(1, 0, At, B0); PG8_BAR; PG8_SCHED;
            PG8_STAGE(PG8_SB(1, 1), b3 + hstep, voffB);
            PG8_WAIT_V(6); PG8_BAR; PG8_MMA(1, 1, At, B1); PG8_BAR;
            }
        }
        if constexpr (ALIGN_EPI) { if (wr == 0) PG8_BAR; }
        if constexpr (!Epi::AFTER_DRAIN) { E(acc, cur, wr, wc, fr, fq); S.done(cur); }
        if (!has_next) break;
#pragma unroll
        for (int a = 0; a < 2; ++a)
#pragma unroll
            for (int b = 0; b < 2; ++b)
#pragma unroll
                for (int m = 0; m < 4; ++m)
#pragma unroll
                    for (int n = 0; n < 2; ++n) acc[a][b][m][n] = (f32x4){0.f, 0.f, 0.f, 0.f};
        cur = nxt; cA = nA; cB = nB; ++ui;
        if constexpr (ALIGN_EPI) { if (wr == 1) PG8_BAR; }
    }
    PG8_WAIT_V(0);
    if constexpr (!ALIGN_EPI) { if (wr == 0) PG8_BAR; }
    PG8_BAR;
    if constexpr (Epi::AFTER_DRAIN) { E.fused(acc, cur, wr, wc, fr, fq, lds, wid, lane); S.done(cur); }
#undef PG8_SA
#undef PG8_SB
#undef PG8_STAGE
#undef PG8_LDA
#undef PG8_LDB
#undef PG8_MMA
#undef PG8_WAIT_V
#undef PG8_WAIT_L
#undef PG8_BAR
#undef PG8_SCHED
}
}

constexpr int NWAVES = 8;
constexpr int BATCH = 2, SEQ = 8192, D = 1024, M = BATCH * SEQ;
constexpr int HD = 128, NH = 8, NKV = 2, NIH = 8, IDX = 64, TOPK = 256;
constexpr int A_IN = 2120, FF = 2816, NE = 8;
constexpr int MAXSLOT = 34816;
constexpr float QSCALE = 0.12751743082459868f;
constexpr float SBSCALE = 0.08838834764831845f;
constexpr float WISCALE = 0.04419417382415922f;
constexpr size_t MiB = 1u << 20;
constexpr size_t WS_CTL = 0, CTL_ZERO_BYTES = 1 * MiB;
constexpr size_t WS_WIN = 2 * MiB, WS_WTAIL = 6 * MiB, WS_WOA = 7 * MiB, WS_WGU = 9 * MiB, WS_WD = 20 * MiB, WS_WKVQ = 26 * MiB, WS_WOB = 32 * MiB, WS_WGUM = 34 * MiB, WS_WDM = 122 * MiB;
constexpr size_t WS_H = 166 * MiB, WS_XB = 230 * MiB, WS_SS0 = 262 * MiB, WS_SS1 = 263 * MiB, WS_SS2 = 264 * MiB, WS_SS3 = 265 * MiB;
constexpr size_t WS_T = 266 * MiB;
constexpr size_t WS_PROJ = WS_T, WS_QF = 330 * MiB, WS_KVF = 362 * MiB, WS_QIF = 378 * MiB, WS_KIF = 394 * MiB, WS_WIF = 396 * MiB, WS_SEL = 397 * MiB, WS_AO = 413 * MiB;
constexpr size_t WS_HF = WS_T, WS_KQ = WS_T, WS_VT = 330 * MiB;
constexpr size_t WS_XPERM = WS_T, WS_HM = 334 * MiB, WS_Y = 521 * MiB;
constexpr size_t WS_RT = 590 * MiB;
constexpr size_t WS_RSTDS = 591 * MiB, WS_GATES = 591 * MiB + 512 * 1024, WS_END = 592 * MiB;
constexpr int CW_CNT = 64;
constexpr int CW_BAR = 4096;
constexpr int RING_BYTES = 131072, LDSCTL_OFF = RING_BYTES, MISC_OFF = LDSCTL_OFF + 320, LDS_BYTES = 147456;

#define GAS __attribute__((address_space(1)))
#define LAS __attribute__((address_space(3)))
typedef unsigned short bf16;
typedef unsigned v4u __attribute__((ext_vector_type(4)));
typedef unsigned v2u __attribute__((ext_vector_type(2)));
typedef float f32x4 __attribute__((ext_vector_type(4)));
typedef short bf16x8 __attribute__((ext_vector_type(8)));
typedef float f32x16 __attribute__((ext_vector_type(16)));
typedef GAS unsigned gu32;
#define RLX_AGENT __ATOMIC_RELAXED, __HIP_MEMORY_SCOPE_AGENT
#define LDS_WAIT() asm volatile("s_waitcnt lgkmcnt(0)" ::: "memory")
#define VM_WAIT() asm volatile("s_waitcnt vmcnt(0)" ::: "memory")
__device__ __forceinline__ unsigned f2bf(float f) { unsigned u = __builtin_bit_cast(unsigned, f); return (u + 0x7fffu + ((u >> 16) & 1u)) >> 16; }
__device__ __forceinline__ unsigned pk2(float lo, float hi) { return f2bf(lo) | (f2bf(hi) << 16); }
__device__ __forceinline__ float bflo(unsigned w) { return __uint_as_float(w << 16); }
__device__ __forceinline__ float bfhi(unsigned w) { return __uint_as_float(w & 0xffff0000u); }
__device__ __forceinline__ float wave_sum(float v) {
#pragma unroll
    for (int o = 1; o < 64; o <<= 1) v += __shfl_xor(v, o);
    return v;
}
__device__ __forceinline__ float wave_max(float v) {
#pragma unroll
    for (int o = 1; o < 64; o <<= 1) v = fmaxf(v, __shfl_xor(v, o));
    return v;
}
__device__ __forceinline__ void sincos_acc(float a, float& c, float& s) {
    const double x = (double)a; const double n = __builtin_rint(x * 0.63661977236758134308);
    const double r = __builtin_fma(-n, 6.123233995736766035869e-17, __builtin_fma(-n, 1.57079632679489655800, x)); const double r2 = r * r;
    double sn = 1.0 - r2 * (1.0 / 156.0); sn = 1.0 - r2 * (1.0 / 110.0) * sn; sn = 1.0 - r2 * (1.0 / 72.0) * sn; sn = 1.0 - r2 * (1.0 / 42.0) * sn; sn = 1.0 - r2 * (1.0 / 20.0) * sn; sn = 1.0 - r2 * (1.0 / 6.0) * sn; sn *= r;
    double cs = 1.0 - r2 * (1.0 / 182.0); cs = 1.0 - r2 * (1.0 / 132.0) * cs; cs = 1.0 - r2 * (1.0 / 90.0) * cs; cs = 1.0 - r2 * (1.0 / 56.0) * cs; cs = 1.0 - r2 * (1.0 / 30.0) * cs; cs = 1.0 - r2 * (1.0 / 12.0) * cs; cs = 1.0 - r2 * 0.5 * cs;
    const int q = ((int)n) & 3;
    const double cq = (q == 0) ? cs : (q == 1) ? -sn : (q == 2) ? -cs : sn;
    const double sq = (q == 0) ? sn : (q == 1) ? cs : (q == 2) ? -sn : -cs;
    c = (float)cq; s = (float)sq;
}
__device__ const float INV_Q[16] = {1.000000000e+00f, 4.403665960e-01f, 1.939227432e-01f, 8.539710194e-02f, 3.760603070e-02f, 1.656043902e-02f, 7.292664610e-03f, 3.211445874e-03f,
                                    1.414213562e-03f, 6.227723788e-04f, 2.742481884e-04f, 1.207697351e-04f, 5.318296098e-05f, 2.341999971e-05f, 1.031338616e-05f, 4.541670478e-06f};
__device__ const float INV_I[8] = {1.000000000e+00f, 1.939227432e-01f, 3.760603070e-02f, 7.292664610e-03f, 1.414213562e-03f, 2.742481884e-04f, 5.318296098e-05f, 1.031338616e-05f};

#define XB_TMO      128
#define XB_XCNT(j)  (256  + 64 * (j))
#define XB_XSUB(j)  (1280 + 64 * (j))
#define XB_XGEN(j)  (2304 + 64 * (j))
#define XB_TOP      3328
#define XB_TOPGEN   3392
#define XCD_BAR_WORDS 3456
#define XB_SPIN_CAP (1u << 18)

__device__ __forceinline__ unsigned xb_ld(unsigned* p)              { return __hip_atomic_load(p, __ATOMIC_RELAXED, __HIP_MEMORY_SCOPE_AGENT); }
__device__ __forceinline__ unsigned xb_add(unsigned* p, unsigned v) { return __hip_atomic_fetch_add(p, v, __ATOMIC_RELAXED, __HIP_MEMORY_SCOPE_AGENT); }
__device__ __forceinline__ unsigned xb_xcc_id() { return (unsigned)__builtin_amdgcn_s_getreg((3 << 11) | 20) & 0xFu; }
#define XB_SPIN(cond, bar) do { unsigned _sp = 0; while (cond) { __builtin_amdgcn_s_sleep(1); \
    if ((++_sp & 255u) == 0u) { if (xb_ld(&(bar)[XB_TMO])) break; if (_sp > XB_SPIN_CAP) { atomicAdd(&(bar)[XB_TMO], 1u); break; } } } } while (0)

struct XcdBarrier {
    unsigned* bar; unsigned x;
    volatile LAS unsigned* st;
};

__device__ __forceinline__ XcdBarrier xcd_barrier_post(unsigned* bar, volatile LAS unsigned* st) {
    XcdBarrier b; b.bar = bar; b.x = xb_xcc_id(); b.st = st;
    if (threadIdx.x == 0) (void)xb_add(&bar[XB_XCNT(b.x)], 1u);
    return b;
}
__device__ __forceinline__ void xcd_barrier_complete(unsigned* bar, unsigned x, unsigned& nloc, unsigned& nx) {
    const unsigned G = gridDim.x * gridDim.y * gridDim.z;
    unsigned sum, cnt, mine, sp = 0u;
    for (;;) {
        sum = 0u; cnt = 0u; mine = 0u;
#pragma unroll
        for (unsigned j = 0; j < 16; ++j) { const unsigned c = xb_ld(&bar[XB_XCNT(j)]); sum += c; cnt += (c > 0u) ? 1u : 0u; mine = (j == x) ? c : mine; }
        if (sum == G) break;
        __builtin_amdgcn_s_sleep(1);
        if ((++sp & 255u) == 0u) { if (xb_ld(&bar[XB_TMO])) break; if (sp > XB_SPIN_CAP) { atomicAdd(&bar[XB_TMO], 1u); break; } }
    }
    nloc = mine > 0u ? mine : 1u; nx = cnt > 0u ? cnt : 1u;
}

__device__ __forceinline__ void xcd_barrier(const XcdBarrier& b) {
    asm volatile("s_waitcnt vmcnt(0)" ::: "memory");
    __syncthreads();
    if (threadIdx.x == 0) {
        unsigned* bar = b.bar;
        __builtin_amdgcn_s_waitcnt(0);
        unsigned nloc = b.st[0], nx = b.st[1];
        if (nloc == 0u) { xcd_barrier_complete(bar, b.x, nloc, nx); b.st[0] = nloc; b.st[1] = nx; }
        const unsigned old = xb_add(&bar[XB_XSUB(b.x)], 1u);
        const unsigned gen = old / nloc;
        if (old + 1u == (gen + 1u) * nloc) {
            __builtin_amdgcn_fence(__ATOMIC_RELEASE, "agent");
            asm volatile("s_waitcnt vmcnt(0)" ::: "memory");
            const unsigned og = xb_add(&bar[XB_TOP], 1u);
            const unsigned tg = og / nx;
            if (og + 1u == (tg + 1u) * nx) xb_add(&bar[XB_TOPGEN], 1u);
            else XB_SPIN(xb_ld(&bar[XB_TOPGEN]) == tg, bar);
            __builtin_amdgcn_fence(__ATOMIC_ACQUIRE, "agent");
            xb_add(&bar[XB_XGEN(b.x)], 1u);
            asm volatile("s_waitcnt vmcnt(0)" ::: "memory");
        } else {
            XB_SPIN(xb_ld(&bar[XB_XGEN(b.x)]) == gen, bar);
            __builtin_amdgcn_fence(__ATOMIC_ACQUIRE, "agent");
            asm volatile("s_waitcnt vmcnt(0)" ::: "memory");
        }
    }
    __syncthreads();
}

struct Frame {
    LAS unsigned char* lds;
    volatile LAS unsigned* MISC;
    gu32* ctl;
    int tid, lane, wave, G, bid;
    const float* in[17];
    float* out; unsigned char* ws;
};
enum { IN_X = 0, IN_ANORM, IN_AWIN, IN_AQN, IN_AKN, IN_AWOUT, IN_KVNORM, IN_KVW, IN_BNORM, IN_BWQ, IN_BWOUT, IN_FFNNORM, IN_DGU, IN_DDN, IN_ROUTER, IN_MGU, IN_MDN };

__device__ __forceinline__ void tr_item(const float* W, size_t ldw, int K, int k0, int csrc0, int cend, bf16* WT, int drow0, const float* gain, float scale, LAS float* scr, int lane) {
#pragma unroll 8
    for (int i = 0; i < 32; ++i) { const int kk = 2 * i + (lane >> 5); const int c = csrc0 + (lane & 31);
        const float v = (c < cend) ? W[(size_t)(k0 + kk) * ldw + c] : 0.f; const float g = gain ? gain[k0 + kk] * scale : scale; scr[kk * 33 + (lane & 31)] = v * g; }
    LDS_WAIT(); asm volatile("" ::: "memory");
    const int c8 = lane & 7;
#pragma unroll
    for (int j = 0; j < 4; ++j) { const int n = (lane >> 3) + 8 * j; const LAS float* s = scr + (8 * c8) * 33 + n;
        v4u o; o.x = pk2(s[0 * 33], s[1 * 33]); o.y = pk2(s[2 * 33], s[3 * 33]); o.z = pk2(s[4 * 33], s[5 * 33]); o.w = pk2(s[6 * 33], s[7 * 33]);
        *(GAS v4u*)(WT + (size_t)(drow0 + n) * K + k0 + 8 * c8) = o; }
    LDS_WAIT(); asm volatile("" ::: "memory");
}
__device__ __forceinline__ int gu_row(int c0) { return (c0 < FF) ? ((c0 >> 7) * 256 + (c0 & 127)) : (((c0 - FF) >> 7) * 256 + 128 + ((c0 - FF) & 127)); }
__device__ __forceinline__ void p0_prologue(Frame& F) {
    LAS float* scr = (LAS float*)(F.lds + F.wave * 16384);
    const int gw = F.wave * F.G + F.bid, NGW = F.G * NWAVES;
    unsigned char* ws = F.ws;
    constexpr int I_WIN = 16 * 64, I_TAIL = 16 * 3, I_SQ = 16 * 32, I_GU = 16 * 176, I_DN = 44 * 32, I_KV = 16 * 64;
    constexpr int NITEMS = I_WIN + I_TAIL + I_SQ + I_GU + I_DN + I_KV + I_SQ + I_SQ + NE * I_GU + NE * I_DN;
    for (int it = gw; it < NITEMS; it += NGW) {
        int r = it;
        if (r < I_WIN) { const int kb = r / 64, nb = r % 64; tr_item(F.in[IN_AWIN], A_IN, D, 64 * kb, 32 * nb, A_IN, (bf16*)(ws + WS_WIN), 32 * nb, F.in[IN_ANORM], 1.f, scr, F.lane); continue; } r -= I_WIN;
        if (r < I_TAIL) { const int kb = r / 3, nb = r % 3; tr_item(F.in[IN_AWIN], A_IN, D, 64 * kb, 2048 + 32 * nb, A_IN, (bf16*)(ws + WS_WTAIL), 32 * nb, F.in[IN_ANORM], 1.f, scr, F.lane); continue; } r -= I_TAIL;
        if (r < I_SQ) { const int kb = r / 32, nb = r % 32; tr_item(F.in[IN_AWOUT], D, D, 64 * kb, 32 * nb, D, (bf16*)(ws + WS_WOA), 32 * nb, nullptr, 1.f, scr, F.lane); continue; } r -= I_SQ;
        if (r < I_GU) { const int kb = r / 176, nb = r % 176; tr_item(F.in[IN_DGU], 2 * FF, D, 64 * kb, 32 * nb, 2 * FF, (bf16*)(ws + WS_WGU), gu_row(32 * nb), F.in[IN_FFNNORM], 1.f, scr, F.lane); continue; } r -= I_GU;
        if (r < I_DN) { const int kb = r / 32, nb = r % 32; tr_item(F.in[IN_DDN], D, FF, 64 * kb, 32 * nb, D, (bf16*)(ws + WS_WD), 32 * nb, nullptr, 1.f, scr, F.lane); continue; } r -= I_DN;
        if (r < I_KV) { const int kb = r / 64, nb = r % 64; tr_item(F.in[IN_KVW], 2 * D, D, 64 * kb, 32 * nb, 2 * D, (bf16*)(ws + WS_WKVQ), (nb < 32) ? 32 * nb : 1024 + 32 * nb, F.in[IN_KVNORM], 1.f, scr, F.lane); continue; } r -= I_KV;
        if (r < I_SQ) { const int kb = r / 32, nb = r % 32; tr_item(F.in[IN_BWQ], D, D, 64 * kb, 32 * nb, D, (bf16*)(ws + WS_WKVQ), 1024 + 32 * nb, F.in[IN_BNORM], SBSCALE, scr, F.lane); continue; } r -= I_SQ;
        if (r < I_SQ) { const int kb = r / 32, nb = r % 32; tr_item(F.in[IN_BWOUT], D, D, 64 * kb, 32 * nb, D, (bf16*)(ws + WS_WOB), 32 * nb, nullptr, 1.f, scr, F.lane); continue; } r -= I_SQ;
        if (r < NE * I_GU) { const int e = r / I_GU, rr = r % I_GU, kb = rr / 176, nb = rr % 176;
            tr_item(F.in[IN_MGU] + (size_t)e * D * 2 * FF, 2 * FF, D, 64 * kb, 32 * nb, 2 * FF, (bf16*)(ws + WS_WGUM), e * 2 * FF + gu_row(32 * nb), F.in[IN_FFNNORM] + D, 1.f, scr, F.lane); continue; } r -= NE * I_GU;
        { const int e = r / I_DN, rr = r % I_DN, kb = rr / 32, nb = rr % 32;
            tr_item(F.in[IN_MDN] + (size_t)e * FF * D, D, FF, 64 * kb, 32 * nb, D, (bf16*)(ws + WS_WDM), e * D + 32 * nb, nullptr, 1.f, scr, F.lane); }
    }
    const float* x = F.in[IN_X]; bf16* XB = (bf16*)(ws + WS_XB); float* SS0 = (float*)(ws + WS_SS0);
    for (int m = gw; m < M; m += NGW) {
        const GAS f32x4* xr = (const GAS f32x4*)(x + (size_t)m * D) + F.lane; f32x4 v[4]; float s = 0.f;
#pragma unroll
        for (int j = 0; j < 4; ++j) { v[j] = xr[64 * j]; s += (v[j].x * v[j].x + v[j].y * v[j].y) + (v[j].z * v[j].z + v[j].w * v[j].w); }
        s = wave_sum(s);
        GAS unsigned long long* o8 = (GAS unsigned long long*)(XB + (size_t)m * D) + F.lane;
#pragma unroll
        for (int j = 0; j < 4; ++j) o8[64 * j] = (unsigned long long)pk2(v[j].x, v[j].y) | ((unsigned long long)pk2(v[j].z, v[j].w) << 32);
        if (F.lane < 16) SS0[(size_t)m * 16 + F.lane] = (F.lane == 0) ? s : 0.f;
    }
}

#define WAVE_SYNC() asm volatile("s_waitcnt lgkmcnt(0)" ::: "memory")
__device__ __forceinline__ void rope8(float (&y)[8], bool isx1, bool isx2, int i0, int pshift, LAS const float* tab) {
#pragma unroll
    for (int e = 0; e < 8; ++e) {
        const float other = __shfl_xor(y[e], pshift); const float c = tab[2 * (i0 + e)], s = tab[2 * (i0 + e) + 1];
        y[e] = isx1 ? (y[e] * c - other * s) : (isx2 ? (y[e] * c + other * s) : y[e]);
    }
}
__device__ __forceinline__ size_t kif_off(int grow, int d) { return ((((size_t)(grow >> 5) * 4 + ((d >> 3) & 3)) * 2 + (d >> 5)) * 32 + (grow & 31)) * 8 + (d & 7); }
__device__ __forceinline__ void unpack8(const v4u w, float (&y)[8]) { y[0] = bflo(w.x); y[1] = bfhi(w.x); y[2] = bflo(w.y); y[3] = bfhi(w.y); y[4] = bflo(w.z); y[5] = bfhi(w.z); y[6] = bflo(w.w); y[7] = bfhi(w.w); }
__device__ __forceinline__ v4u pack8(const float (&y)[8]) { v4u o; o.x = pk2(y[0], y[1]); o.y = pk2(y[2], y[3]); o.z = pk2(y[4], y[5]); o.w = pk2(y[6], y[7]); return o; }
__device__ __forceinline__ void p2_post(Frame& F) {
    unsigned char* ws = F.ws; const int lane = F.lane;
    const bf16* PROJ = (const bf16*)(ws + WS_PROJ); const bf16* XB = (const bf16*)(ws + WS_XB); const bf16* WT = (const bf16*)(ws + WS_WTAIL); const float* SS0 = (const float*)(ws + WS_SS0);
    bf16* QF = (bf16*)(ws + WS_QF); bf16* KVF = (bf16*)(ws + WS_KVF); bf16* QIF = (bf16*)(ws + WS_QIF); bf16* KIF = (bf16*)(ws + WS_KIF); float* WIF = (float*)(ws + WS_WIF);
    const float* qnw = F.in[IN_AQN]; const float* knw = F.in[IN_AKN];
    LAS float* tab = (LAS float*)(F.lds + F.wave * 256);
    const int gw = F.wave * F.G + F.bid, NGW = F.G * NWAVES;
    for (int task = gw; task < M / 8; task += NGW) {
        const int row0 = task * 8;
        f32x4 acc[5];
#pragma unroll
        for (int c = 0; c < 5; ++c) acc[c] = (f32x4){0.f, 0.f, 0.f, 0.f};
        const bf16* ap = XB + (size_t)(row0 + (lane & 7)) * D + 8 * (lane >> 4);
        const bf16* bp = WT + (size_t)(lane & 15) * D + 8 * (lane >> 4);
#pragma unroll 4
        for (int j = 0; j < 32; ++j) {
            const bf16x8 a = *(const bf16x8*)(ap + 32 * j);
#pragma unroll
            for (int c = 0; c < 5; ++c) { const bf16x8 b = *(const bf16x8*)(bp + (size_t)(16 * c) * D + 32 * j); acc[c] = __builtin_amdgcn_mfma_f32_16x16x32_bf16(a, b, acc[c], 0, 0, 0); }
        }
        if (lane < 32) {
#pragma unroll
            for (int reg = 0; reg < 4; ++reg) {
                const int row = row0 + 4 * (lane >> 4) + reg; const float rs = pg8::rstd16(SS0 + (size_t)row * 16); const float pos = (float)(row & (SEQ - 1));
                const int d = lane & 15;
                float v0 = acc[0][reg] * rs; const float other = __shfl_xor(v0, 8);
                { float c, s; sincos_acc(pos * INV_I[d & 7], c, s); v0 = (d < 8) ? (v0 * c - other * s) : (v0 * c + other * s); }
                KIF[kif_off(row, d)] = (bf16)f2bf(v0);
#pragma unroll
                for (int c = 1; c < 4; ++c) KIF[kif_off(row, 16 * c + d)] = (bf16)f2bf(acc[c][reg] * rs);
                if (d < 8) WIF[(size_t)row * 8 + d] = acc[4][reg] * rs * WISCALE;
            }
        }
        for (int r = 0; r < 8; ++r) {
            const int row = row0 + r, b = row >> 13, t = row & (SEQ - 1); const float pos = (float)t;
            const bf16* pr = PROJ + (size_t)row * 2048 + 8 * lane;
            v4u w[4];
#pragma unroll
            for (int j = 0; j < 4; ++j) w[j] = *(const v4u*)(pr + 512 * j);
            if (lane < 24) { float c, s; sincos_acc(pos * ((lane < 16) ? INV_Q[lane & 15] : INV_I[lane & 7]), c, s); tab[2 * lane] = c; tab[2 * lane + 1] = s; }
            WAVE_SYNC();
#pragma unroll
            for (int j = 0; j < 2; ++j) {
                float y[8]; unpack8(w[j], y); float ss = 0.f;
#pragma unroll
                for (int e = 0; e < 8; ++e) ss += y[e] * y[e];
                ss += __shfl_xor(ss, 1); ss += __shfl_xor(ss, 2); ss += __shfl_xor(ss, 4); ss += __shfl_xor(ss, 8);
                const float rs = 1.0f / sqrtf(ss * (1.0f / 128.0f) + 1e-6f); const int c8 = (lane & 15) * 8;
#pragma unroll
                for (int e = 0; e < 8; ++e) y[e] = y[e] * rs * qnw[c8 + e];
                rope8(y, c8 < 16, c8 >= 16 && c8 < 32, c8 & 15, 2, tab);
#pragma unroll
                for (int e = 0; e < 8; ++e) y[e] *= QSCALE;
                *(v4u*)(QF + (size_t)row * D + 512 * j + 8 * lane) = pack8(y);
            }
            {
                float y[8]; unpack8(w[2], y); float ss = 0.f;
#pragma unroll
                for (int e = 0; e < 8; ++e) ss += y[e] * y[e];
                ss += __shfl_xor(ss, 1); ss += __shfl_xor(ss, 2); ss += __shfl_xor(ss, 4); ss += __shfl_xor(ss, 8);
                const bool isk = lane < 32; const float rs = 1.0f / sqrtf(ss * (1.0f / 128.0f) + 1e-6f); const int c8 = (lane & 15) * 8;
                if (isk) {
#pragma unroll
                    for (int e = 0; e < 8; ++e) y[e] = y[e] * rs * knw[c8 + e];
                }
                rope8(y, isk && c8 < 16, isk && c8 >= 16 && c8 < 32, c8 & 15, 2, tab);
                const int kvh = (lane >> 4) & 1;
                *(v4u*)(KVF + ((size_t)(b * NKV + kvh) * SEQ + t) * 256 + (isk ? 0 : 128) + c8) = pack8(y);
            }
            {
                float y[8]; unpack8(w[3], y); const int c8 = (lane & 7) * 8;
                rope8(y, c8 == 0, c8 == 8, 16, 1, tab);
                *(v4u*)(QIF + (size_t)row * 512 + 8 * lane) = pack8(y);
            }
            WAVE_SYNC();
        }
    }
}

__device__ __forceinline__ unsigned f2key(float f) { const unsigned u = __float_as_uint(f); return (u & 0x80000000u) ? ~u : (u | 0x80000000u); }
__device__ __forceinline__ void p3_query_naive(unsigned char* ws, LAS unsigned char* lds, int row, int* SEL) {
    const int tid = threadIdx.x, lane = tid & 63, wave = tid >> 6;
    const bf16* QIF = (const bf16*)(ws + WS_QIF); const bf16* KIF = (const bf16*)(ws + WS_KIF); const float* WIF = (const float*)(ws + WS_WIF);
    LAS unsigned* keys = (LAS unsigned*)lds;
    LAS float* qis = (LAS float*)(lds + 32768);
    LAS float* wl = (LAS float*)(lds + 32768 + 2048);
    LAS unsigned* hist = (LAS unsigned*)(lds + 36864);
    LAS unsigned* ctl = (LAS unsigned*)(lds + 36864 + 1024);
    LAS unsigned* wcnt = (LAS unsigned*)(lds + 36864 + 1024 + 64);
    {
        const int b = row >> 13, t = row & (SEQ - 1), n = t + 1;
        int* sel = SEL + (size_t)row * TOPK;
        if (n <= TOPK) { if (tid < TOPK) sel[tid] = tid < n ? tid : 0; return; }
        __syncthreads();
        qis[tid] = __uint_as_float((unsigned)QIF[(size_t)row * 512 + tid] << 16);
        if (tid < 8) wl[tid] = WIF[(size_t)row * 8 + tid];
        __syncthreads();
        for (int s = tid; s < n; s += 512) {
            const int grow = (b << 13) + s;
            float kf[64];
#pragma unroll
            for (int j = 0; j < 8; ++j) { const v4u w = *(const v4u*)(KIF + kif_off(grow, 8 * j)); kf[8 * j] = bflo(w.x); kf[8 * j + 1] = bfhi(w.x); kf[8 * j + 2] = bflo(w.y); kf[8 * j + 3] = bfhi(w.y); kf[8 * j + 4] = bflo(w.z); kf[8 * j + 5] = bfhi(w.z); kf[8 * j + 6] = bflo(w.w); kf[8 * j + 7] = bfhi(w.w); }
            float sc = 0.f;
#pragma unroll
            for (int h = 0; h < 8; ++h) { float d = 0.f; asm volatile("" ::: "memory");
#pragma unroll
                for (int dd = 0; dd < 64; ++dd) d += qis[h * 64 + dd] * kf[dd];
                sc += wl[h] * fmaxf(d, 0.f); }
            keys[s] = f2key(sc + 0.0f);
        }
        __syncthreads();
        unsigned prefix = 0u, mask = 0u, need = TOPK;
        for (int pass = 0; pass < 4; ++pass) {
            const int shift = 24 - 8 * pass;
            if (tid < 256) hist[tid] = 0u;
            __syncthreads();
            for (int s = tid; s < n; s += 512) { const unsigned k = keys[s]; if ((k & mask) == prefix) __hip_atomic_fetch_add(&hist[(k >> shift) & 255u], 1u, __ATOMIC_RELAXED, __HIP_MEMORY_SCOPE_WORKGROUP); }
            __syncthreads();
            if (tid < 64) {
                const unsigned h0 = hist[4 * lane], h1 = hist[4 * lane + 1], h2 = hist[4 * lane + 2], h3 = hist[4 * lane + 3]; const unsigned tot = h0 + h1 + h2 + h3;
                unsigned incl = tot;
#pragma unroll
                for (int o = 1; o < 64; o <<= 1) { const unsigned v = __shfl_down(incl, o); if (lane + o < 64) incl += v; }
                const unsigned above = incl - tot;
                if (above < need && need <= above + tot) {
                    unsigned a = above; unsigned bin;
                    if (a + h3 >= need) bin = 3; else { a += h3; if (a + h2 >= need) bin = 2; else { a += h2; if (a + h1 >= need) bin = 1; else { a += h1; bin = 0; } } }
                    ctl[0] = 4 * lane + bin; ctl[1] = need - a;
                }
            }
            __syncthreads();
            prefix |= ctl[0] << shift; mask |= 255u << shift; need = ctl[1];
            __syncthreads();
        }
        const unsigned thr = prefix, n_gt = TOPK - need;
        unsigned base_gt = 0u, base_eq = 0u;
        for (int s0 = 0; s0 < n; s0 += 512) {
            const int s = s0 + tid; const unsigned k = s < n ? keys[s] : 0u; const bool gt = (s < n) && (k > thr); const bool eq = (s < n) && (k == thr);
            const unsigned long long bg = __ballot(gt), be = __ballot(eq); const unsigned long long lt = (1ull << lane) - 1ull;
            const unsigned rg = __popcll(bg & lt), re = __popcll(be & lt);
            if (lane == 0) { wcnt[wave] = __popcll(bg); wcnt[8 + wave] = __popcll(be); }
            __syncthreads();
            unsigned og = base_gt, oe = base_eq, tg = 0u, te = 0u;
#pragma unroll
            for (int w = 0; w < 8; ++w) { const unsigned cg = wcnt[w], ce = wcnt[8 + w]; if (w < wave) { og += cg; oe += ce; } tg += cg; te += ce; }
            if (gt) sel[og + rg] = s;
            if (eq && oe + re < need) sel[n_gt + oe + re] = s;
            base_gt += tg; base_eq += te;
            __syncthreads();
        }
    }
}

constexpr int P3_HIST = 0, P3_H2 = 65536, P3_BM = 98304, P3_QS = 114688, P3_FLAG = P3_QS + 512, P3_CAP = 512;
__device__ __forceinline__ void find_bin_2048(LAS const unsigned* hist, unsigned need, int lane, unsigned& bin_out, unsigned& need_out, unsigned& cnt_out, bool& ok) {
    unsigned w[16]; unsigned tot = 0u;
#pragma unroll
    for (int i = 0; i < 16; ++i) { w[i] = hist[16 * lane + i]; tot += (w[i] & 0xffffu) + (w[i] >> 16); }
    unsigned incl = tot;
#pragma unroll
    for (int o = 1; o < 64; o <<= 1) { const unsigned v = __shfl_down(incl, o); if (lane + o < 64) incl += v; }
    const unsigned above = incl - tot;
    const bool mine = (above < need) && (need <= above + tot);
    unsigned a = above, fb = 0u, fn = 0u, fc = 0u; bool found = false;
#pragma unroll
    for (int i = 15; i >= 0; --i) {
        const unsigned h1 = w[i] >> 16, h0 = w[i] & 0xffffu;
        if (!found) { if (a + h1 >= need) { found = true; fb = 32u * lane + 2u * i + 1u; fn = need - a; fc = h1; } else a += h1; }
        if (!found) { if (a + h0 >= need) { found = true; fb = 32u * lane + 2u * i; fn = need - a; fc = h0; } else a += h0; }
    }
    const unsigned long long bm = __ballot(mine);
    ok = (bm != 0ull);
    const int src = ok ? (__ffsll((long long)bm) - 1) : 0;
    bin_out = (unsigned)__builtin_amdgcn_readlane((int)fb, src); need_out = (unsigned)__builtin_amdgcn_readlane((int)fn, src); cnt_out = (unsigned)__builtin_amdgcn_readlane((int)fc, src);
}
__device__ __forceinline__ unsigned bin11(float sc) { const unsigned u = __float_as_uint(sc); const int m = (int)((u & 0x7fffffffu) >> 17) - 7360; const unsigned mc = (unsigned)(m < 0 ? 0 : (m > 1023 ? 1023 : m)); return (u >> 31) ? (1023u - mc) : (1024u + mc); }
__device__ __forceinline__ float relu_i(float x) { const int xi = __builtin_bit_cast(int, x); const int ri = (xi < 0) ? 0 : xi; return __builtin_bit_cast(float, ri); }
#define RELU(x) relu_i(x)
template <int PASS> __device__ __forceinline__ void p3_score_pass(const bf16x8 (&af)[2][4], const float (&wv)[2][16], const bf16* kib, int t0, int nt, int wave, int n, int hi,
                                                                  LAS unsigned char* lds, const unsigned (&thr)[2][2], int rot) {
    LAS unsigned* HIST = (LAS unsigned*)(lds + P3_HIST); LAS unsigned* BM = (LAS unsigned*)(lds + P3_BM); LAS unsigned* QS = (LAS unsigned*)(lds + P3_QS);
    const int kmax = t0 + 15;
    bf16x8 bc[4], bn[4];
    const int qh = 8 * (wave >> 2), w4 = wave & 3;
    const int cnt4 = (nt - w4 + 3) >> 2; const int r0 = rot % cnt4;
    bf16x8 bq[4][4];
#define P3_LOADB(u, j) do { int jj_ = r0 + (j); jj_ = (jj_ >= cnt4) ? jj_ - cnt4 : jj_; const int t_ = w4 + 4 * jj_; \
        const bf16* kp_ = kib + ((size_t)t_ * 8 + hi) * 256 + n * 8; _Pragma("unroll") for (int s = 0; s < 4; ++s) bq[u][s] = *(const bf16x8*)(kp_ + s * 512); } while (0)
#pragma unroll
    for (int u = 0; u < 4; ++u) P3_LOADB(u, (u < cnt4) ? u : 0);
    for (int i0 = 0; i0 < cnt4; i0 += 4) {
#pragma unroll
        for (int u = 0; u < 4; ++u) {
            if (i0 + u < cnt4) {
                int jj = r0 + i0 + u; jj = (jj >= cnt4) ? jj - cnt4 : jj; const int tile = w4 + 4 * jj;
                const int key = 32 * tile + n; const bool full = (32 * tile + 31 <= t0);
                f32x16 acc0, acc1;
#pragma unroll
                for (int r = 0; r < 16; ++r) { acc0[r] = 0.f; acc1[r] = 0.f; }
#pragma unroll
                for (int s = 0; s < 4; ++s) acc0 = __builtin_amdgcn_mfma_f32_32x32x16_bf16(af[0][s], bq[u][s], acc0, 0, 0, 0);
#pragma unroll
                for (int s = 0; s < 4; ++s) acc1 = __builtin_amdgcn_mfma_f32_32x32x16_bf16(af[1][s], bq[u][s], acc1, 0, 0, 0);
                float sc4[4] = {0.f, 0.f, 0.f, 0.f};
#pragma unroll
                for (int r = 0; r < 8; ++r) { sc4[0] = __builtin_fmaf(wv[0][r], RELU(acc0[r]), sc4[0]); sc4[1] = __builtin_fmaf(wv[0][8 + r], RELU(acc0[8 + r]), sc4[1]); }
#pragma unroll
                for (int r = 0; r < 8; ++r) { sc4[2] = __builtin_fmaf(wv[1][r], RELU(acc1[r]), sc4[2]); sc4[3] = __builtin_fmaf(wv[1][8 + r], RELU(acc1[8 + r]), sc4[3]); }
#pragma unroll
                for (int e = 0; e < 4; ++e) {
                    const int mt = e >> 1, j = e & 1; const int q = qh + 4 * mt + hi + 2 * j; const bool valid = full || (key <= t0 + q);
                    const float scz = sc4[e] + 0.0f; const unsigned bin = bin11(scz);
                    if (PASS == 1) { if (valid) __hip_atomic_fetch_add(&HIST[q * 1024 + (bin >> 1)], 1u << (16 * (bin & 1u)), __ATOMIC_RELAXED, __HIP_MEMORY_SCOPE_WORKGROUP); }
                    else {
                        if (valid && bin > thr[mt][j]) { __hip_atomic_fetch_or(&BM[q * 256 + (key >> 5)], 1u << (key & 31), __ATOMIC_RELAXED, __HIP_MEMORY_SCOPE_WORKGROUP); }
                        else if (valid && bin == thr[mt][j]) { const unsigned pos = __hip_atomic_fetch_add(&QS[q * 8 + 3], 1u, __ATOMIC_RELAXED, __HIP_MEMORY_SCOPE_WORKGROUP);
                            if (pos < (unsigned)P3_CAP) { HIST[q * 1024 + 2 * pos] = f2key(scz); HIST[q * 1024 + 2 * pos + 1] = (unsigned)key; } }
                    }
                }
            }
            { const int jn = (i0 + u + 4 < cnt4) ? (i0 + u + 4) : (cnt4 - 1); P3_LOADB(u, jn); }
        }
    }
#undef P3_LOADB
}
__device__ __forceinline__ void p3_index(Frame& F) {
    unsigned char* ws = F.ws; const int tid = F.tid, lane = F.lane, wave = F.wave, n = lane & 31, hi = lane >> 5;
    const bf16* QIF = (const bf16*)(ws + WS_QIF); const bf16* KIF = (const bf16*)(ws + WS_KIF); const float* WIF = (const float*)(ws + WS_WIF); int* SEL = (int*)(ws + WS_SEL);
    LAS unsigned char* lds = F.lds;
    LAS unsigned* HIST = (LAS unsigned*)(lds + P3_HIST); LAS unsigned* H2 = (LAS unsigned*)(lds + P3_H2 + wave * 4096); LAS unsigned* BM = (LAS unsigned*)(lds + P3_BM); LAS unsigned* QS = (LAS unsigned*)(lds + P3_QS);
    LAS unsigned* FLAG = (LAS unsigned*)(lds + P3_FLAG); LAS unsigned* FBL = (LAS unsigned*)(lds + P3_QS + 1024);
    if (tid == 0) FBL[0] = 0u;
    __syncthreads();
    for (int ps = F.bid; ps < 512; ps += F.G) {
        const int b = ps >> 8, wq = ps & 255;
#pragma unroll 1
        for (int half = 0; half < 2; ++half) {
            const int idx = half ? (511 - wq) : wq; const int t0 = 16 * idx, row0 = (b << 13) + t0;
            if (idx < 16) {
                for (int e = tid; e < 16 * TOPK; e += 512) { const int q = e >> 8, i = e & 255; SEL[(size_t)(row0 + q) * TOPK + i] = (i <= t0 + q) ? i : 0; }
                continue;
            }
            for (int e = tid; e < 16384; e += 512) HIST[e] = 0u;
            for (int e = tid; e < 4096; e += 512) BM[e] = 0u;
            if (tid < 132) QS[tid] = 0u;
            bf16x8 af[2][4]; float wv[2][16]; const int qh = 8 * (wave >> 2);
            { const int head = (n & 3) + 4 * ((n >> 3) & 1), q4 = ((n >> 2) & 1) + 2 * (n >> 4);
#pragma unroll
              for (int mt = 0; mt < 2; ++mt) { const bf16* ap = QIF + (size_t)(row0 + qh + 4 * mt + q4) * 512 + head * IDX + 32 * hi;
#pragma unroll
                  for (int s = 0; s < 4; ++s) af[mt][s] = *(const bf16x8*)(ap + 8 * s);
#pragma unroll
                  for (int r = 0; r < 16; ++r) wv[mt][r] = WIF[(size_t)(row0 + qh + 4 * mt + hi + 2 * (r >> 3)) * 8 + (r & 7)]; } }
            const int nt = (t0 + 16 + 31) >> 5; const bf16* kib = KIF + (size_t)(b << 13) * IDX;
            unsigned thr[2][2] = {{0u, 0u}, {0u, 0u}};
            __syncthreads();
            p3_score_pass<1>(af, wv, kib, t0, nt, wave, n, hi, lds, thr, F.bid * 5);
            __syncthreads();
#pragma unroll 1
            for (int qq = 0; qq < 2; ++qq) { const int q = 2 * wave + qq; unsigned bin, need, cnt; bool ok;
                find_bin_2048(HIST + q * 1024, (unsigned)TOPK, lane, bin, need, cnt, ok);
                if (lane == 0) { const bool defer = !ok || cnt > (unsigned)P3_CAP; QS[q * 8 + 0] = defer ? 4096u : bin; QS[q * 8 + 1] = need; QS[q * 8 + 2] = cnt; QS[q * 8 + 4] = defer ? 1u : 0u;
                    if (defer) { const unsigned k = __hip_atomic_fetch_add(&FBL[0], 1u, __ATOMIC_RELAXED, __HIP_MEMORY_SCOPE_WORKGROUP); if (k < 63u) FBL[1 + k] = (unsigned)(row0 + q); } } }
            __syncthreads();
#pragma unroll
            for (int mt = 0; mt < 2; ++mt)
#pragma unroll
                for (int j = 0; j < 2; ++j) thr[mt][j] = QS[(qh + 4 * mt + hi + 2 * j) * 8];
            __syncthreads();
            p3_score_pass<2>(af, wv, kib, t0, nt, wave, n, hi, lds, thr, F.bid * 5 + 3);
            __syncthreads();
#pragma unroll 1
            for (int qq = 0; qq < 2; ++qq) {
                const int q = 2 * wave + qq; LAS unsigned* cand = HIST + q * 1024; LAS unsigned* bmq = BM + q * 256;
                const unsigned needA = QS[q * 8 + 1], c = QS[q * 8 + 2];
                if (QS[q * 8 + 4] != 0u) continue;
                for (unsigned i0 = 0; i0 < c; i0 += 64) { const unsigned i = i0 + lane; const bool in = i < c; const unsigned k32 = in ? cand[2 * i] : 0u, ki = in ? (cand[2 * i + 1] & 8191u) : 0u; unsigned rank = 0u;
                    for (unsigned j = 0; j < c; ++j) { const unsigned kj = cand[2 * j], ij = cand[2 * j + 1]; rank += (kj > k32 || (kj == k32 && ij < ki)) ? 1u : 0u; }
                    if (in && rank < needA) __hip_atomic_fetch_or(&bmq[ki >> 5], 1u << (ki & 31), __ATOMIC_RELAXED, __HIP_MEMORY_SCOPE_WORKGROUP); }
                WAVE_SYNC();
                unsigned w0 = bmq[4 * lane], w1 = bmq[4 * lane + 1], w2 = bmq[4 * lane + 2], w3 = bmq[4 * lane + 3];
                const unsigned mycnt = __popc(w0) + __popc(w1) + __popc(w2) + __popc(w3);
                unsigned incl = mycnt;
#pragma unroll
                for (int o = 1; o < 64; o <<= 1) { const unsigned v = __shfl_up(incl, o); if (lane >= o) incl += v; }
                unsigned pos = incl - mycnt; int* sel = SEL + (size_t)(row0 + q) * TOPK;
#pragma unroll
                for (int wi = 0; wi < 4; ++wi) { unsigned w = (wi == 0) ? w0 : (wi == 1) ? w1 : (wi == 2) ? w2 : w3;
                    while (w) { const int bit = __ffs((int)w) - 1; if (pos < (unsigned)TOPK) sel[pos] = 128 * lane + 32 * wi + bit; ++pos; w &= w - 1u; } }
            }
            __syncthreads();
        }
    }
    __syncthreads();
    const unsigned nfb = FBL[0];
    for (unsigned k = 0; k < nfb && k < 63u; ++k) { const int r0 = (int)FBL[1 + k]; __syncthreads(); p3_query_naive(ws, lds, r0, SEL); }
}

__device__ __forceinline__ void p4_dsa_naive(Frame& F) {
    unsigned char* ws = F.ws; const int lane = F.lane;
    const bf16* QF = (const bf16*)(ws + WS_QF); const bf16* KVF = (const bf16*)(ws + WS_KVF); const int* SEL = (const int*)(ws + WS_SEL); bf16* AO = (bf16*)(ws + WS_AO);
    LAS f32x4* sc = (LAS f32x4*)(F.lds + F.wave * 4096);
    const int gw = F.wave * F.G + F.bid, NGW = F.G * NWAVES;
    for (int p = gw; p < 2 * M; p += NGW) {
        const int row = p >> 1, kvh = p & 1, b = row >> 13, t = row & (SEQ - 1); const int cnt = (t + 1 < TOPK) ? (t + 1) : TOPK;
        const int* sel = SEL + (size_t)row * TOPK;
        int myidx[4];
#pragma unroll
        for (int j = 0; j < 4; ++j) myidx[j] = sel[lane + 64 * j];
        float qa[4], qb[4];
#pragma unroll
        for (int g = 0; g < 4; ++g) { const unsigned w = *(const unsigned*)(QF + (size_t)row * D + (kvh * 4 + g) * HD + 2 * lane); qa[g] = bflo(w); qb[g] = bfhi(w); }
        const bf16* kvb = KVF + (size_t)(b * NKV + kvh) * SEQ * 256 + 2 * lane;
#pragma unroll
        for (int j = 0; j < 4; ++j) {
            const int lim = cnt - 64 * j < 64 ? cnt - 64 * j : 64;
            for (int i = 0; i < lim; ++i) {
                const int key = __builtin_amdgcn_readlane(myidx[j], i);
                const unsigned w = *(const unsigned*)(kvb + (size_t)key * 256); const float k0 = bflo(w), k1 = bfhi(w);
                f32x4 d;
                d[0] = wave_sum(qa[0] * k0 + qb[0] * k1); d[1] = wave_sum(qa[1] * k0 + qb[1] * k1); d[2] = wave_sum(qa[2] * k0 + qb[2] * k1); d[3] = wave_sum(qa[3] * k0 + qb[3] * k1);
                if (lane == 0) sc[64 * j + i] = d;
            }
        }
        float mx[4] = {-INFINITY, -INFINITY, -INFINITY, -INFINITY};
#pragma unroll
        for (int j = 0; j < 4; ++j) { const int pp = lane + 64 * j; if (pp < cnt) { const f32x4 v = sc[pp];
#pragma unroll
            for (int g = 0; g < 4; ++g) mx[g] = fmaxf(mx[g], v[g]); } }
#pragma unroll
        for (int g = 0; g < 4; ++g) mx[g] = wave_max(mx[g]);
        float sm[4] = {0.f, 0.f, 0.f, 0.f};
#pragma unroll
        for (int j = 0; j < 4; ++j) { const int pp = lane + 64 * j; if (pp < cnt) { f32x4 v = sc[pp];
#pragma unroll
            for (int g = 0; g < 4; ++g) { v[g] = __builtin_amdgcn_exp2f(v[g] - mx[g]); sm[g] += v[g]; }
            sc[pp] = v; } }
#pragma unroll
        for (int g = 0; g < 4; ++g) sm[g] = 1.0f / wave_sum(sm[g]);
        float oa[4] = {0.f, 0.f, 0.f, 0.f}, ob[4] = {0.f, 0.f, 0.f, 0.f};
#pragma unroll
        for (int j = 0; j < 4; ++j) {
            const int lim = cnt - 64 * j < 64 ? cnt - 64 * j : 64;
            for (int i = 0; i < lim; ++i) {
                const int key = __builtin_amdgcn_readlane(myidx[j], i);
                const unsigned w = *(const unsigned*)(kvb + (size_t)key * 256 + 128); const float v0 = bflo(w), v1 = bfhi(w);
                const f32x4 pr = sc[64 * j + i];
#pragma unroll
                for (int g = 0; g < 4; ++g) { oa[g] += pr[g] * v0; ob[g] += pr[g] * v1; }
            }
        }
#pragma unroll
        for (int g = 0; g < 4; ++g) *(unsigned*)(AO + (size_t)row * D + (kvh * 4 + g) * HD + 2 * lane) = pk2(oa[g] * sm[g], ob[g] * sm[g]);
    }
}

typedef short v4i16_t __attribute__((ext_vector_type(4)));
typedef int v4i __attribute__((ext_vector_type(4)));
__device__ __forceinline__ v4i16_t tr16(LAS unsigned char* p) { return __builtin_amdgcn_ds_read_tr16_b64_v4i16((LAS v4i16_t*)p); }
__device__ __forceinline__ void p4_dsa(Frame& F) {
    unsigned char* ws = F.ws; const int lane = F.lane, nh = lane & 15, kg = lane >> 4;
    const bf16* QF = (const bf16*)(ws + WS_QF); const bf16* KVF = (const bf16*)(ws + WS_KVF); const int* SEL = (const int*)(ws + WS_SEL); bf16* AO = (bf16*)(ws + WS_AO);
    LAS unsigned char* wl = F.lds + F.wave * 10240; LAS int* selw = (LAS int*)wl; LAS unsigned char* vb = wl + 1024;
    const int gw = F.wave * F.G + F.bid, NGW = F.G * NWAVES;
    LAS unsigned char* trp = vb + (4 * kg + ((lane >> 2) & 3)) * 288 + 8 * (lane & 3);
#pragma unroll 1
    for (int combo = 0; combo < BATCH * NKV; ++combo) {
        const int b = combo >> 1, kvh = combo & 1;
#pragma unroll 1
        for (int t = gw; t < SEQ; t += NGW) {
            const int row = (b << 13) + t; const int cnt = (t + 1 < TOPK) ? (t + 1) : TOPK;
            *(LAS v4i*)(selw + 4 * lane) = *(const v4i*)(SEL + (size_t)row * TOPK + 4 * lane);
            WAVE_SYNC();
            {
            const bf16* kvb = KVF + (size_t)(b * NKV + kvh) * SEQ * 256;
            const bf16* qp = QF + (size_t)row * D + (kvh * 4 + (nh & 3)) * HD + 8 * kg;
            bf16x8 qf[4];
#pragma unroll
            for (int s = 0; s < 4; ++s) { qf[s] = *(const bf16x8*)(qp + 32 * s); if (nh >= 4) qf[s] = (bf16x8){0, 0, 0, 0, 0, 0, 0, 0}; }
            f32x4 S[16];
            bf16x8 kq[2][2][4];
#define P4_LOADK(buf, batch) do { _Pragma("unroll") for (int tt = 0; tt < 2; ++tt) { const bf16* kp_ = kvb + (size_t)(selw[16 * (2 * (batch) + tt) + nh] & (SEQ - 1)) * 256 + 8 * kg; \
                _Pragma("unroll") for (int s = 0; s < 4; ++s) kq[buf][tt][s] = *(const bf16x8*)(kp_ + 32 * s); } } while (0)
            P4_LOADK(0, 0);
#pragma unroll
            for (int bt = 0; bt < 8; ++bt) {
                if (bt < 7) P4_LOADK((bt + 1) & 1, bt + 1);
                asm volatile("" ::: "memory");
#pragma unroll
                for (int tt = 0; tt < 2; ++tt) {
                    f32x4 a = (f32x4){0.f, 0.f, 0.f, 0.f};
#pragma unroll
                    for (int s = 0; s < 4; ++s) a = __builtin_amdgcn_mfma_f32_16x16x32_bf16(kq[bt & 1][tt][s], qf[s], a, 0, 0, 0);
                    S[2 * bt + tt] = a;
                }
            }
#undef P4_LOADK
            float mx = -INFINITY;
#pragma unroll
            for (int T = 0; T < 16; ++T)
#pragma unroll
                for (int r = 0; r < 4; ++r) { const float v = (16 * T + 4 * kg + r < cnt) ? S[T][r] : -INFINITY; S[T][r] = v; mx = fmaxf(mx, v); }
            mx = fmaxf(mx, __shfl_xor(mx, 16)); mx = fmaxf(mx, __shfl_xor(mx, 32));
            float sum = 0.f;
#pragma unroll
            for (int T = 0; T < 16; ++T)
#pragma unroll
                for (int r = 0; r < 4; ++r) { const float e = __builtin_amdgcn_exp2f(S[T][r] - mx); S[T][r] = e; sum += e; }
            sum += __shfl_xor(sum, 16); sum += __shfl_xor(sum, 32);
            bf16x8 pa[8];
#pragma unroll
            for (int c = 0; c < 8; ++c) { v4u pw; pw.x = pg8::cvt_pk_bf16(S[2 * c][0], S[2 * c][1]); pw.y = pg8::cvt_pk_bf16(S[2 * c][2], S[2 * c][3]); pw.z = pg8::cvt_pk_bf16(S[2 * c + 1][0], S[2 * c + 1][1]); pw.w = pg8::cvt_pk_bf16(S[2 * c + 1][2], S[2 * c + 1][3]); pa[c] = __builtin_bit_cast(bf16x8, pw); }
            f32x4 O[8];
#pragma unroll
            for (int d = 0; d < 8; ++d) O[d] = (f32x4){0.f, 0.f, 0.f, 0.f};
            v4u g[2][8];
#define P4_LOADV(buf, c_) do { _Pragma("unroll") for (int i = 0; i < 8; ++i) { const int key_ = selw[32 * (c_) + 4 * i + kg] & (SEQ - 1); g[buf][i] = *(const v4u*)(kvb + (size_t)key_ * 256 + 128 + 8 * nh); } } while (0)
            P4_LOADV(0, 0); P4_LOADV(1, 1);
#pragma unroll
            for (int c = 0; c < 8; ++c) {
#pragma unroll
                for (int i = 0; i < 8; ++i) *(LAS v4u*)(vb + (4 * i + kg) * 288 + nh * 16) = g[c & 1][i];
                asm volatile("" ::: "memory");
                if (c < 6) P4_LOADV(c & 1, c + 2);
#pragma unroll
                for (int d = 0; d < 8; ++d) {
                    const v4i16_t lo = tr16(trp + 32 * d), hi4 = tr16(trp + 16 * 288 + 32 * d);
                    const bf16x8 vfr = (bf16x8){lo[0], lo[1], lo[2], lo[3], hi4[0], hi4[1], hi4[2], hi4[3]};
                    O[d] = __builtin_amdgcn_mfma_f32_16x16x32_bf16(pa[c], vfr, O[d], 0, 0, 0);
                }
            }
#undef P4_LOADV
            const float i0 = 1.0f / __builtin_bit_cast(float, __builtin_amdgcn_readlane(__builtin_bit_cast(int, sum), 0)), i1 = 1.0f / __builtin_bit_cast(float, __builtin_amdgcn_readlane(__builtin_bit_cast(int, sum), 1));
            const float i2 = 1.0f / __builtin_bit_cast(float, __builtin_amdgcn_readlane(__builtin_bit_cast(int, sum), 2)), i3 = 1.0f / __builtin_bit_cast(float, __builtin_amdgcn_readlane(__builtin_bit_cast(int, sum), 3));
            LAS bf16* ost = (LAS bf16*)vb;
            if (kg == 0) {
#pragma unroll
                for (int d = 0; d < 8; ++d) { ost[0 * 128 + 16 * d + nh] = (bf16)f2bf(O[d][0] * i0); ost[1 * 128 + 16 * d + nh] = (bf16)f2bf(O[d][1] * i1); ost[2 * 128 + 16 * d + nh] = (bf16)f2bf(O[d][2] * i2); ost[3 * 128 + 16 * d + nh] = (bf16)f2bf(O[d][3] * i3); }
            }
            WAVE_SYNC();
            const v4u ov = *(LAS v4u*)(vb + 16 * lane);
            *(v4u*)(AO + (size_t)row * D + (kvh * 4 + kg) * HD + 8 * nh) = ov;
            }
        }
    }
}

__device__ __forceinline__ void p9_sb(Frame& F) {
    unsigned char* ws = F.ws; const int lane = F.lane, n = lane & 31, hi = lane >> 5;
    const bf16* KQ = (const bf16*)(ws + WS_KQ); const bf16* VT = (const bf16*)(ws + WS_VT); bf16* AO = (bf16*)(ws + WS_AO);
    const int gw = F.wave * F.G + F.bid, NGW = F.G * NWAVES;
    const int koff = 16 * (n >> 4) + 8 * ((n >> 2) & 1) + 4 * ((n >> 3) & 1) + (n & 3);
    constexpr float LOG2E = 1.4426950408889634f, LN2 = 0.6931471805599453f;
    for (int u = gw; u < (M / 32) * NH; u += NGW) {
        const int h = u & 7, blk = u >> 3, b = blk >> 8, qb = blk & 255, q0 = 32 * qb, t = q0 + n;
        const bf16* qp = KQ + (size_t)(b * SEQ + q0 + n) * 2048 + 1024 + h * HD + 64 * hi;
        bf16x8 qf[8];
#pragma unroll
        for (int s = 0; s < 8; ++s) qf[s] = *(const bf16x8*)(qp + 8 * s);
        f32x16 o[4];
#pragma unroll
        for (int mt = 0; mt < 4; ++mt)
#pragma unroll
            for (int r = 0; r < 16; ++r) o[mt][r] = 0.f;
        float C = 0.f;
        for (int kb = qb; kb >= 0; --kb) {
            const int k0 = 32 * kb;
            const bf16* kp = KQ + (size_t)(b * SEQ + k0 + koff) * 2048 + h * HD + 64 * hi;
            bf16x8 kf[8];
#pragma unroll
            for (int s = 0; s < 8; ++s) kf[s] = *(const bf16x8*)(kp + 8 * s);
            bf16x8 vf[4][2];
#pragma unroll
            for (int mt = 0; mt < 4; ++mt)
#pragma unroll
                for (int sp = 0; sp < 2; ++sp) vf[mt][sp] = *(const bf16x8*)(VT + (size_t)(h * HD + 32 * mt + n) * M + b * SEQ + k0 + 16 * sp + 8 * hi);
            f32x16 z;
#pragma unroll
            for (int r = 0; r < 16; ++r) z[r] = 0.f;
#pragma unroll
            for (int s = 0; s < 8; ++s) z = __builtin_amdgcn_mfma_f32_32x32x16_bf16(kf[s], qf[s], z, 0, 0, 0);
            float lk[16], lb[16];
#pragma unroll
            for (int r = 0; r < 16; ++r) {
                const int key = k0 + ((r < 8) ? (8 * hi + r) : (16 + 8 * hi + (r - 8)));
                const float zz = z[r]; const float L = __builtin_amdgcn_logf(1.0f + __builtin_amdgcn_exp2f(-fabsf(zz) * LOG2E)) * LN2;
                const bool valid = key < t;
                lk[r] = valid ? (-fmaxf(zz, 0.f) - L) : 0.f;
                lb[r] = valid ? (fminf(zz, 0.f) - L) : -INFINITY;
            }
            float suf[16];
            suf[7] = 0.f; suf[15] = 0.f;
#pragma unroll
            for (int i = 6; i >= 0; --i) { suf[i] = suf[i + 1] + lk[i + 1]; suf[8 + i] = suf[9 + i] + lk[9 + i]; }
            const float T0 = suf[0] + lk[0], T1 = suf[8] + lk[8];
            const float P0 = __shfl_xor(T0, 32), P1 = __shfl_xor(T1, 32);
            const float base1 = C + (hi ? 0.f : P1), base0 = C + (hi ? (T1 + P1) : (P0 + T1 + P1));
            unsigned pw[8];
#pragma unroll
            for (int r = 0; r < 16; r += 2) {
                const float a0 = __builtin_amdgcn_exp2f((lb[r] + ((r < 8) ? base0 : base1) + suf[r]) * LOG2E), a1 = __builtin_amdgcn_exp2f((lb[r + 1] + ((r < 8) ? base0 : base1) + suf[r + 1]) * LOG2E);
                pw[r >> 1] = pg8::cvt_pk_bf16(a0, a1);
            }
            C += (T0 + T1) + (P0 + P1);
            const bf16x8 pa0 = __builtin_bit_cast(bf16x8, (v4u){pw[0], pw[1], pw[2], pw[3]}), pa1 = __builtin_bit_cast(bf16x8, (v4u){pw[4], pw[5], pw[6], pw[7]});
#pragma unroll
            for (int mt = 0; mt < 4; ++mt) { o[mt] = __builtin_amdgcn_mfma_f32_32x32x16_bf16(vf[mt][0], pa0, o[mt], 0, 0, 0); o[mt] = __builtin_amdgcn_mfma_f32_32x32x16_bf16(vf[mt][1], pa1, o[mt], 0, 0, 0); }
            if (__all(C < -44.0f)) break;
        }
        bf16* op = AO + (size_t)(b * SEQ + q0 + n) * D + h * HD + 4 * hi;
#pragma unroll
        for (int mt = 0; mt < 4; ++mt)
#pragma unroll
            for (int g = 0; g < 4; ++g) { v2u w; w.x = pg8::cvt_pk_bf16(o[mt][4 * g], o[mt][4 * g + 1]); w.y = pg8::cvt_pk_bf16(o[mt][4 * g + 2], o[mt][4 * g + 3]); *(v2u*)(op + 32 * mt + 8 * g) = w; }
    }
}

__device__ __forceinline__ void p11_router(Frame& F) {
    unsigned char* ws = F.ws; const int tid = F.tid, lane = F.lane, wave = F.wave;
    const float* H = (const float*)(ws + WS_H); const float* gn = F.in[IN_FFNNORM] + D; const float* Wr = F.in[IN_ROUTER];
    int* TOPE = (int*)(ws + WS_RT); int* POS = (int*)(ws + WS_RT + 128 * 1024); float* GATE = (float*)(ws + WS_RT + 256 * 1024); float* RSTD3 = (float*)(ws + WS_RT + 384 * 1024);
    LAS unsigned* lcnt = (LAS unsigned*)F.lds;
    LAS unsigned* gb = (LAS unsigned*)(F.lds + 64);
    LAS int* ltok = (LAS int*)(F.lds + 128);
    LAS float* lgt = (LAS float*)(F.lds + 128 + 1024);
    for (int chunk = F.bid; chunk < M / 64; chunk += F.G) {
        if (tid < 8) lcnt[tid] = 0u;
        __syncthreads();
        for (int r = 0; r < 8; ++r) {
            const int row = chunk * 64 + wave * 8 + r;
            const GAS f32x4* xr = (const GAS f32x4*)(H + (size_t)row * D) + lane; f32x4 v[4]; float ss = 0.f;
#pragma unroll
            for (int j = 0; j < 4; ++j) { v[j] = xr[64 * j]; ss += (v[j].x * v[j].x + v[j].y * v[j].y) + (v[j].z * v[j].z + v[j].w * v[j].w); }
            ss = wave_sum(ss); const float rs = 1.0f / sqrtf(ss * (1.0f / 1024.0f) + 1e-6f);
            float lg[8] = {0.f, 0.f, 0.f, 0.f, 0.f, 0.f, 0.f, 0.f};
#pragma unroll
            for (int j = 0; j < 4; ++j)
#pragma unroll
                for (int i = 0; i < 4; ++i) { const int k = 256 * j + 4 * lane + i; const float xv = v[j][i] * gn[k]; const f32x4 w0 = *(const f32x4*)(Wr + (size_t)k * 8), w1 = *(const f32x4*)(Wr + (size_t)k * 8 + 4);
                    lg[0] += xv * w0[0]; lg[1] += xv * w0[1]; lg[2] += xv * w0[2]; lg[3] += xv * w0[3]; lg[4] += xv * w1[0]; lg[5] += xv * w1[1]; lg[6] += xv * w1[2]; lg[7] += xv * w1[3]; }
#pragma unroll
            for (int e = 0; e < 8; ++e) lg[e] = wave_sum(lg[e]) * rs;
            int i1 = 0; float l1 = lg[0];
#pragma unroll
            for (int e = 1; e < 8; ++e) if (lg[e] > l1) { l1 = lg[e]; i1 = e; }
            int i2 = -1; float l2 = -INFINITY;
#pragma unroll
            for (int e = 0; e < 8; ++e) if (e != i1 && lg[e] > l2) { l2 = lg[e]; i2 = e; }
            const float g1 = 1.0f / (1.0f + __expf(l2 - l1)), g2 = 1.0f - g1;
            if (lane == 0) {
                const unsigned p1 = __hip_atomic_fetch_add(&lcnt[i1], 1u, __ATOMIC_RELAXED, __HIP_MEMORY_SCOPE_WORKGROUP), p2 = __hip_atomic_fetch_add(&lcnt[i2], 1u, __ATOMIC_RELAXED, __HIP_MEMORY_SCOPE_WORKGROUP);
                const int ti = wave * 8 + r; ltok[ti * 4 + 0] = i1; ltok[ti * 4 + 1] = i2; ltok[ti * 4 + 2] = (int)p1; ltok[ti * 4 + 3] = (int)p2;
                lgt[ti * 4 + 0] = g1; lgt[ti * 4 + 1] = g2; lgt[ti * 4 + 2] = rs;
            }
        }
        __syncthreads();
        if (tid < 8) gb[tid] = __hip_atomic_fetch_add(F.ctl + CW_CNT + tid, lcnt[tid], RLX_AGENT);
        __syncthreads();
        if (tid < 64) { const int row = chunk * 64 + tid; const int e1 = ltok[tid * 4], e2 = ltok[tid * 4 + 1];
            TOPE[row * 2] = e1; TOPE[row * 2 + 1] = e2; POS[row * 2] = (int)gb[e1] + ltok[tid * 4 + 2]; POS[row * 2 + 1] = (int)gb[e2] + ltok[tid * 4 + 3];
            GATE[row * 2] = lgt[tid * 4]; GATE[row * 2 + 1] = lgt[tid * 4 + 1]; RSTD3[row] = lgt[tid * 4 + 2]; }
        __syncthreads();
    }
}
__device__ __forceinline__ void moe_bases(Frame& F, int (&tb)[9]) {
    int acc = 0;
#pragma unroll
    for (int e = 0; e < 8; ++e) { tb[e] = acc; const unsigned c = __hip_atomic_load(F.ctl + CW_CNT + e, RLX_AGENT); acc += (int)((c + 255u) >> 8); }
    tb[8] = acc;
}
__device__ __forceinline__ void p12_permute(Frame& F) {
    unsigned char* ws = F.ws; const int lane = F.lane;
    const int* TOPE = (const int*)(ws + WS_RT); const int* POS = (const int*)(ws + WS_RT + 128 * 1024); const float* GATE = (const float*)(ws + WS_RT + 256 * 1024); const float* RSTD3 = (const float*)(ws + WS_RT + 384 * 1024);
    int* SLOT = (int*)(ws + WS_RT + 512 * 1024); float* RSTDS = (float*)(ws + WS_RSTDS); float* GATES = (float*)(ws + WS_GATES);
    const bf16* XB = (const bf16*)(ws + WS_XB); bf16* XP = (bf16*)(ws + WS_XPERM);
    int tb[9]; moe_bases(F, tb);
    const int gw = F.wave * F.G + F.bid, NGW = F.G * NWAVES;
    for (int i = gw; i < 2 * M; i += NGW) {
        const int row = i >> 1; const int e = TOPE[i]; int base = 0;
#pragma unroll
        for (int k = 0; k < 8; ++k) base = (e == k) ? tb[k] : base;
        const int slot = base * 256 + POS[i];
        const v4u* src = (const v4u*)(XB + (size_t)row * D) + lane; v4u* dst = (v4u*)(XP + (size_t)slot * D) + lane;
        const v4u a = src[0], c = src[64]; dst[0] = a; dst[64] = c;
        if (lane == 0) { SLOT[i] = slot; RSTDS[slot] = RSTD3[row]; GATES[slot] = GATE[i]; }
    }
}
__device__ __forceinline__ void p15_combine(Frame& F) {
    unsigned char* ws = F.ws; const int lane = F.lane;
    const float* H = (const float*)(ws + WS_H); const bf16* Y = (const bf16*)(ws + WS_Y); const int* SLOT = (const int*)(ws + WS_RT + 512 * 1024);
    const int gw = F.wave * F.G + F.bid, NGW = F.G * NWAVES;
    for (int row = gw; row < M; row += NGW) {
        const int s1 = SLOT[row * 2], s2 = SLOT[row * 2 + 1];
        const GAS f32x4* hr = (const GAS f32x4*)(H + (size_t)row * D) + lane; GAS f32x4* orow = (GAS f32x4*)(F.out + (size_t)row * D) + lane;
        const GAS v2u* y1 = (const GAS v2u*)(Y + (size_t)s1 * D) + lane; const GAS v2u* y2 = (const GAS v2u*)(Y + (size_t)s2 * D) + lane;
#pragma unroll
        for (int j = 0; j < 4; ++j) { const f32x4 h = hr[64 * j]; const v2u a = y1[64 * j], c = y2[64 * j]; f32x4 o;
            o.x = h.x + (bflo(a.x) + bflo(c.x)); o.y = h.y + (bfhi(a.x) + bfhi(c.x)); o.z = h.z + (bflo(a.y) + bflo(c.y)); o.w = h.w + (bfhi(a.y) + bfhi(c.y)); orow[64 * j] = o; }
    }
}

constexpr int N_PHASES = 16;
#ifndef MK_ONE_LAUNCH
#define MK_ONE_LAUNCH 1
#endif
struct Args { const float* in[17]; float* out; unsigned char* ws; int ph_lo, ph_hi; };
__global__ void __launch_bounds__(NWAVES * 64, 2) yoco_fwd(Args args) {
    extern __shared__ __attribute__((aligned(16))) unsigned char lds[];
    Frame F;
    F.lds = (LAS unsigned char*)lds; F.MISC = (volatile LAS unsigned*)(F.lds + MISC_OFF);
    F.tid = threadIdx.x; F.lane = F.tid & 63; F.wave = __builtin_amdgcn_readfirstlane(F.tid >> 6); F.G = gridDim.x; F.bid = blockIdx.x;
    F.ws = args.ws; F.ctl = (gu32*)(args.ws + WS_CTL); F.out = args.out;
#pragma unroll
    for (int i = 0; i < 17; ++i) F.in[i] = args.in[i];
    for (int u = F.tid; u < (LDS_BYTES - LDSCTL_OFF) / 4; u += NWAVES * 64) ((LAS unsigned*)(F.lds + LDSCTL_OFF))[u] = 0u;
    __syncthreads();
    unsigned char* ws = args.ws;
    XcdBarrier bar; bar.bar = (unsigned*)(F.ctl + CW_BAR); bar.x = 0; bar.st = nullptr;
    if (MK_ONE_LAUNCH) bar = xcd_barrier_post((unsigned*)(F.ctl + CW_BAR), F.MISC + 8);
    const int lo = args.ph_lo, hi = args.ph_hi;
#define IN(k) (lo <= (k) && (k) < hi)
#define SEAM(k) do { if (MK_ONE_LAUNCH && IN((k) + 1)) xcd_barrier(bar); } while (0)
    bf16* XB = (bf16*)(ws + WS_XB); float* H = (float*)(ws + WS_H); bf16* AO = (bf16*)(ws + WS_AO);

#ifndef PROBE_DUP
#define PROBE_DUP -1
#endif
#ifndef PROBE_T
#define PROBE_T -1
#endif
#ifndef PROBE_TMODE
#define PROBE_TMODE 0
#endif
#define PH_BEGIN(k) unsigned long long phb_ = 0; if (PROBE_T == (k)) phb_ = __builtin_amdgcn_s_memrealtime();
#define PH_END(k) if (PROBE_T == (k)) { __syncthreads(); if (F.tid == 0) { const unsigned d_ = (unsigned)(__builtin_amdgcn_s_memrealtime() - phb_); if (PROBE_TMODE == 0) __hip_atomic_fetch_max(F.ctl + 140, d_, RLX_AGENT); else if (PROBE_TMODE == 1) __hip_atomic_fetch_max(F.ctl + 141, 0xffffffffu - d_, RLX_AGENT); else if (F.bid == 0) __hip_atomic_store(F.ctl + 140, d_, RLX_AGENT); } }
    if (IN(0)) { PH_BEGIN(0) p0_prologue(F); if (PROBE_DUP == 0) p0_prologue(F); PH_END(0) SEAM(0); }
    if (IN(1)) { PH_BEGIN(1)
        pg8::Gemm g{XB, (const bf16*)(ws + WS_WIN), M, 2048, D}; pg8::StaticOrder S; S.init(M, 2048, F.G, F.bid);
        pg8::EpiScaleBf16 E{(bf16*)(ws + WS_PROJ), 2048, (const float*)(ws + WS_SS0)};
        pg8::gemm_phase<pg8::EpiScaleBf16, pg8::StaticOrder, true, true>(F.lds, g, S, E); PH_END(1) SEAM(1); }
    if (IN(2)) { PH_BEGIN(2) p2_post(F); if (PROBE_DUP == 2) p2_post(F); PH_END(2) SEAM(2); }
    if (IN(3)) { PH_BEGIN(3) p3_index(F); if (PROBE_DUP == 3) { __syncthreads(); p3_index(F); } PH_END(3) SEAM(3); }
    if (IN(4)) { PH_BEGIN(4) p4_dsa(F); if (PROBE_DUP == 4) p4_dsa(F); PH_END(4) SEAM(4); }
    if (IN(5)) { PH_BEGIN(5)
        pg8::Gemm g{AO, (const bf16*)(ws + WS_WOA), M, D, D}; pg8::StaticOrder S; S.init(M, D, F.G, F.bid);
        pg8::EpiResid E{F.in[IN_X], H, XB, (float*)(ws + WS_SS1)};
        pg8::gemm_phase<pg8::EpiResid, pg8::StaticOrder, true, true>(F.lds, g, S, E); PH_END(5) SEAM(5); }
    if (IN(6)) { PH_BEGIN(6)
        pg8::Gemm g{XB, (const bf16*)(ws + WS_WGU), M, 2 * FF, D}; pg8::StaticOrder S; S.init(M, 2 * FF, F.G, F.bid);
        pg8::EpiSwiGLU<false> E{(bf16*)(ws + WS_HF), FF, (const float*)(ws + WS_SS1)};
        pg8::gemm_phase<pg8::EpiSwiGLU<false>, pg8::StaticOrder, true, true>(F.lds, g, S, E); PH_END(6) SEAM(6); }
    if (IN(7)) { PH_BEGIN(7)
        pg8::Gemm g{(const bf16*)(ws + WS_HF), (const bf16*)(ws + WS_WD), M, D, FF}; pg8::StaticOrder S; S.init(M, D, F.G, F.bid);
        pg8::EpiResid E{H, H, XB, (float*)(ws + WS_SS2)};
        pg8::gemm_phase<pg8::EpiResid, pg8::StaticOrder, true, true>(F.lds, g, S, E); PH_END(7) SEAM(7); }
    if (IN(8)) { PH_BEGIN(8)
        { pg8::Gemm g{XB, (const bf16*)(ws + WS_WKVQ), M, 2048, D}; pg8::StaticOrder S; S.init(M, 2048, F.G, F.bid);
          pg8::EpiScaleBf16 E{(bf16*)(ws + WS_KQ), 2048, (const float*)(ws + WS_SS2)};
          pg8::gemm_phase<pg8::EpiScaleBf16, pg8::StaticOrder, true, true>(F.lds, g, S, E); }
        { pg8::Gemm g{(const bf16*)(ws + WS_WKVQ) + (size_t)2048 * D, XB, D, M, D}; pg8::StaticOrder S; S.init(D, M, F.G, F.bid);
          pg8::EpiScaleColBf16 E{(bf16*)(ws + WS_VT), M, (const float*)(ws + WS_SS2)};
          pg8::gemm_phase<pg8::EpiScaleColBf16, pg8::StaticOrder, true, true>(F.lds, g, S, E); }
        PH_END(8) SEAM(8); }
    if (IN(9)) { PH_BEGIN(9) p9_sb(F); if (PROBE_DUP == 9) p9_sb(F); PH_END(9) SEAM(9); }
    if (IN(10)) { PH_BEGIN(10)
        pg8::Gemm g{AO, (const bf16*)(ws + WS_WOB), M, D, D}; pg8::StaticOrder S; S.init(M, D, F.G, F.bid);
        pg8::EpiResid E{H, H, XB, (float*)(ws + WS_SS3)};
        pg8::gemm_phase<pg8::EpiResid, pg8::StaticOrder, true, true>(F.lds, g, S, E); PH_END(10) SEAM(10); }
    if (IN(11)) { PH_BEGIN(11) p11_router(F); PH_END(11) SEAM(11); }
    if (IN(12)) { PH_BEGIN(12) p12_permute(F); if (PROBE_DUP == 12) p12_permute(F); PH_END(12) SEAM(12); }
    if (IN(13)) { PH_BEGIN(13)
        pg8::MoeOrder S; moe_bases(F, S.tb); S.npn = 22; S.G = F.G; S.c = F.bid;
        pg8::Gemm g{(const bf16*)(ws + WS_XPERM), (const bf16*)(ws + WS_WGUM), MAXSLOT, NE * 2 * FF, D};
        pg8::EpiSwiGLU<true> E{(bf16*)(ws + WS_HM), FF, (const float*)(ws + WS_RSTDS)};
        pg8::gemm_phase<pg8::EpiSwiGLU<true>, pg8::MoeOrder, true, true>(F.lds, g, S, E); PH_END(13) SEAM(13); }
    if (IN(14)) { PH_BEGIN(14)
        pg8::MoeOrder S; moe_bases(F, S.tb); S.npn = 4; S.G = F.G; S.c = F.bid;
        pg8::Gemm g{(const bf16*)(ws + WS_HM), (const bf16*)(ws + WS_WDM), MAXSLOT, NE * D, FF};
        pg8::EpiGateBf16 E{(bf16*)(ws + WS_Y), (const float*)(ws + WS_GATES)};
        pg8::gemm_phase<pg8::EpiGateBf16, pg8::MoeOrder, true, true>(F.lds, g, S, E); PH_END(14) SEAM(14); }
    if (IN(15)) { PH_BEGIN(15) p15_combine(F); if (PROBE_DUP == 15) p15_combine(F); PH_END(15) }
    if (PROBE_T >= 0 && MK_ONE_LAUNCH) { if (PROBE_TMODE == 1 && F.bid == 0 && F.tid == 0) { } xcd_barrier(bar); if (F.bid == 0 && F.tid == 0) { unsigned d_ = __hip_atomic_load(F.ctl + (PROBE_TMODE == 1 ? 141 : 140), RLX_AGENT); if (PROBE_TMODE == 1) d_ = 0xffffffffu - d_; const unsigned long long t0_ = __builtin_amdgcn_s_memrealtime(); while (__builtin_amdgcn_s_memrealtime() - t0_ < (unsigned long long)d_) __builtin_amdgcn_s_sleep(8); } }
#undef IN
#undef SEAM
}

extern "C" void kernel_launch(void* const* d_in, const int* in_sizes, int n_in, void* d_out, int out_size, void* d_ws, size_t ws_size, hipStream_t stream) {
    static int grid = 0;
    if (grid == 0) {
        if (n_in != 17 || out_size != M * D || ws_size < WS_END) { fprintf(stderr, "kernel_launch: unexpected problem (n_in %d, out %d, ws %zu < %zu)\n", n_in, out_size, ws_size, (size_t)WS_END); grid = -1; return; }
        int dev = 0, cus = 0, per_cu = 0;
        if (hipGetDevice(&dev) != hipSuccess || hipDeviceGetAttribute(&cus, hipDeviceAttributeMultiprocessorCount, dev) != hipSuccess) { grid = -1; return; }
        if (hipFuncSetAttribute((const void*)yoco_fwd, hipFuncAttributeMaxDynamicSharedMemorySize, LDS_BYTES) != hipSuccess) { fprintf(stderr, "kernel_launch: hipFuncSetAttribute failed\n"); grid = -1; return; }
        if (hipOccupancyMaxActiveBlocksPerMultiprocessor(&per_cu, (const void*)yoco_fwd, NWAVES * 64, LDS_BYTES) != hipSuccess || per_cu < 1) fprintf(stderr, "kernel_launch: occupancy query says %d\n", per_cu);
        (void)hipGetLastError();
        grid = cus;
    }
    if (grid < 0) return;
    if (hipMemsetAsync((char*)d_ws + WS_CTL, 0, CTL_ZERO_BYTES, stream) != hipSuccess) return;
    Args a{};
    for (int i = 0; i < 17; ++i) a.in[i] = (const float*)d_in[i];
    a.out = (float*)d_out; a.ws = (unsigned char*)d_ws;
#if MK_ONE_LAUNCH
    a.ph_lo = 0; a.ph_hi = N_PHASES;
    hipLaunchKernelGGL(yoco_fwd, dim3(grid), dim3(NWAVES * 64), LDS_BYTES, stream, a);
#else
    for (int p = 0; p < N_PHASES; ++p) { a.ph_lo = p; a.ph_hi = p + 1; hipLaunchKernelGGL(yoco_fwd, dim3(grid), dim3(NWAVES * 64), LDS_BYTES, stream, a); }
#endif
}
```

```cpp
#include <hip/hip_runtime.h>
#include <cstdio>
#include <cstdint>
namespace pg8 {
#define PG8_LAS __attribute__((address_space(3)))
typedef unsigned short bf16_t;
typedef short bf16x8 __attribute__((ext_vector_type(8)));
typedef float f32x4 __attribute__((ext_vector_type(4)));
typedef unsigned u32x4 __attribute__((ext_vector_type(4)));
constexpr int BM = 256, BK = 64, HALF = 128, HTB = HALF * BK * 2  , STAGE_BYTES = 8 * HTB, NXCD = 8, WGM = 8;

__host__ __device__ __forceinline__ int lds_byte(int r, int c) { const int st = (r >> 4) * 2 + (c >> 5), rr = r & 15, cc = c & 31, ob = rr * 64 + cc * 2; return st * 1024 + (ob ^ (((ob >> 9) & 1) << 5)); }
__host__ __device__ __forceinline__ void stage_rc(int b, int& R, int& C) { const int st = b / 1024, sb = b % 1024, swz = sb ^ (((sb >> 9) & 1) << 5); R = (st >> 1) * 16 + swz / 64; C = (st & 1) * 32 + (swz % 64) / 2; }
__host__ __device__ __forceinline__ int perm32(int rho) { const int n = rho >> 4, i = rho & 15; return 8 * (i >> 2) + 4 * n + (i & 3); }

struct Unit { int pm, pn; int koff = 0; };
struct Gemm { const bf16_t* A; const bf16_t* Bt; int M, N, K; int ld = 0; };

struct StaticOrder {
    int nM, nN, nwg, G, c;
    __host__ __device__ void init(int M, int N, int G_, int c_) { nM = M / BM; nN = N / BM; nwg = nM * nN; G = G_; c = c_; }
    __host__ __device__ bool next(int i, Unit& u) const {
        const long L = (long)i * G + c; if (L >= nwg) return false;
        int wgid = (int)L; { const int q = nwg / NXCD, r = nwg % NXCD, xcd = wgid % NXCD, off = wgid / NXCD; wgid = (xcd < r ? xcd * (q + 1) : r * (q + 1) + (xcd - r) * q) + off; }
        const int nig = WGM * nN, gid = wgid / nig, fm = gid * WGM, gsz = (nM - fm) < WGM ? (nM - fm) : WGM;
        u.pm = fm + ((wgid % nig) % gsz); u.pn = (wgid % nig) / gsz; return true;
    }
    __device__ __forceinline__ void a_ready(const Unit&) const {}
    __device__ __forceinline__ void done(const Unit&) const {}
};

__device__ __forceinline__ unsigned cvt_pk_bf16(float lo, float hi) { unsigned r; asm volatile("v_cvt_pk_bf16_f32 %0, %1, %2" : "=v"(r) : "v"(lo), "v"(hi)); return r; }
typedef unsigned u32x2 __attribute__((ext_vector_type(2)));
constexpr float RMS_EPS = 1e-6f;
__device__ __forceinline__ float rstd16(const float* p) {
    const f32x4 a = *(const f32x4*)p, b = *(const f32x4*)(p + 4), c = *(const f32x4*)(p + 8), d = *(const f32x4*)(p + 12);
    const float s = (((a[0] + a[1]) + (a[2] + a[3])) + ((b[0] + b[1]) + (b[2] + b[3]))) + (((c[0] + c[1]) + (c[2] + c[3])) + ((d[0] + d[1]) + (d[2] + d[3])));
    return 1.0f / sqrtf(s * (1.0f / 1024.0f) + RMS_EPS);
}
struct EpiScaleBf16 {
    static constexpr bool PERM = true, AFTER_DRAIN = false;
    bf16_t* O; int ldc; const float* ss;
    __device__ __forceinline__ void operator()(const f32x4 (&acc)[2][2][4][2], const Unit& u, int wr, int wc, int fr, int fq) const {
        const int row0 = u.pm * BM + wr * 64 + fr, col0 = u.pn * BM + wc * 32 + 8 * fq;
        float rsv[2][4];
#pragma unroll
        for (int ai = 0; ai < 2; ++ai)
#pragma unroll
            for (int m = 0; m < 4; ++m) rsv[ai][m] = rstd16(ss + (size_t)(row0 + ai * HALF + m * 16) * 16);
#pragma unroll
        for (int ai = 0; ai < 2; ++ai)
#pragma unroll
            for (int m = 0; m < 4; ++m) { const int row = row0 + ai * HALF + m * 16; const float rs = rsv[ai][m]; bf16_t* rowp = O + (size_t)row * ldc + col0;
#pragma unroll
                for (int bj = 0; bj < 2; ++bj) { const f32x4 v0 = acc[ai][bj][m][0] * rs, v1 = acc[ai][bj][m][1] * rs;
                    u32x4 w; w.x = cvt_pk_bf16(v0[0], v0[1]); w.y = cvt_pk_bf16(v0[2], v0[3]); w.z = cvt_pk_bf16(v1[0], v1[1]); w.w = cvt_pk_bf16(v1[2], v1[3]);
                    *(u32x4*)(rowp + bj * HALF) = w; } }
    }
};
struct EpiScaleColBf16 {
    static constexpr bool PERM = true, AFTER_DRAIN = false;
    bf16_t* O; int ldc; const float* ss;
    __device__ __forceinline__ void operator()(const f32x4 (&acc)[2][2][4][2], const Unit& u, int wr, int wc, int fr, int fq) const {
        const int row0 = u.pm * BM + wr * 64 + fr, col0 = u.pn * BM + wc * 32 + 8 * fq;
        f32x4 rs[2][2];
#pragma unroll
        for (int bj = 0; bj < 2; ++bj)
#pragma unroll
            for (int n = 0; n < 2; ++n)
#pragma unroll
                for (int e = 0; e < 4; ++e) rs[bj][n][e] = rstd16(ss + (size_t)(col0 + bj * HALF + 4 * n + e) * 16);
#pragma unroll
        for (int ai = 0; ai < 2; ++ai)
#pragma unroll
            for (int m = 0; m < 4; ++m) { const int row = row0 + ai * HALF + m * 16; bf16_t* rowp = O + (size_t)row * ldc + col0;
#pragma unroll
                for (int bj = 0; bj < 2; ++bj) { const f32x4 v0 = acc[ai][bj][m][0] * rs[bj][0], v1 = acc[ai][bj][m][1] * rs[bj][1];
                    u32x4 w; w.x = cvt_pk_bf16(v0[0], v0[1]); w.y = cvt_pk_bf16(v0[2], v0[3]); w.z = cvt_pk_bf16(v1[0], v1[1]); w.w = cvt_pk_bf16(v1[2], v1[3]);
                    *(u32x4*)(rowp + bj * HALF) = w; } }
    }
};
struct EpiResid {
    static constexpr bool PERM = false, AFTER_DRAIN = false;
    const float* base; float* H; bf16_t* XB; float* ssp;
    __device__ __forceinline__ void operator()(const f32x4 (&acc)[2][2][4][2], const Unit& u, int wr, int wc, int fr, int fq) const {
        const int row0 = u.pm * BM + wr * 64 + fr, col0 = u.pn * BM + wc * 32 + 4 * fq;
#pragma unroll
        for (int ai = 0; ai < 2; ++ai) {
            f32x4 bv[4][2][2];
#pragma unroll
            for (int m = 0; m < 4; ++m)
#pragma unroll
                for (int bj = 0; bj < 2; ++bj)
#pragma unroll
                    for (int n = 0; n < 2; ++n) bv[m][bj][n] = *(const f32x4*)(base + (size_t)(row0 + ai * HALF + m * 16) * 1024 + col0 + bj * HALF + n * 16);
#pragma unroll
            for (int m = 0; m < 4; ++m) { const int row = row0 + ai * HALF + m * 16; float q = 0.f;
#pragma unroll
                for (int bj = 0; bj < 2; ++bj)
#pragma unroll
                    for (int n = 0; n < 2; ++n) { const size_t off = (size_t)row * 1024 + col0 + bj * HALF + n * 16;
                        const f32x4 v = bv[m][bj][n] + acc[ai][bj][m][n]; *(f32x4*)(H + off) = v;
                        q += (v[0] * v[0] + v[1] * v[1]) + (v[2] * v[2] + v[3] * v[3]);
                        u32x2 w; w.x = cvt_pk_bf16(v[0], v[1]); w.y = cvt_pk_bf16(v[2], v[3]); *(u32x2*)(XB + off) = w; }
                q += __shfl_xor(q, 16); q += __shfl_xor(q, 32);
                if (fq == 0) ssp[(size_t)row * 16 + u.pn * 4 + wc] = q; }
        }
    }
};
__device__ __forceinline__ float silu_mul(float g, float u) { return g * __builtin_amdgcn_rcpf(1.0f + __builtin_amdgcn_exp2f(g * -1.4426950408889634f)) * u; }
template <bool MOE> struct EpiSwiGLU {
    static constexpr bool PERM = true, AFTER_DRAIN = false;
    bf16_t* O; int ldc; const float* ss;
    __device__ __forceinline__ void operator()(const f32x4 (&acc)[2][2][4][2], const Unit& u, int wr, int wc, int fr, int fq) const {
        const int row0 = u.pm * BM + wr * 64 + fr; const int pnl = MOE ? (u.pn % 22) : u.pn; const int col0 = pnl * HALF + wc * 32 + 8 * fq;
        float rsv[2][4];
#pragma unroll
        for (int ai = 0; ai < 2; ++ai)
#pragma unroll
            for (int m = 0; m < 4; ++m) { const int row = row0 + ai * HALF + m * 16; rsv[ai][m] = MOE ? ss[row] : rstd16(ss + (size_t)row * 16); }
#pragma unroll
        for (int ai = 0; ai < 2; ++ai)
#pragma unroll
            for (int m = 0; m < 4; ++m) { const int row = row0 + ai * HALF + m * 16; const float rs = rsv[ai][m];
                const f32x4 g0 = acc[ai][0][m][0] * rs, g1 = acc[ai][0][m][1] * rs, u0 = acc[ai][1][m][0] * rs, u1 = acc[ai][1][m][1] * rs;
                u32x4 w; w.x = cvt_pk_bf16(silu_mul(g0[0], u0[0]), silu_mul(g0[1], u0[1])); w.y = cvt_pk_bf16(silu_mul(g0[2], u0[2]), silu_mul(g0[3], u0[3]));
                w.z = cvt_pk_bf16(silu_mul(g1[0], u1[0]), silu_mul(g1[1], u1[1])); w.w = cvt_pk_bf16(silu_mul(g1[2], u1[2]), silu_mul(g1[3], u1[3]));
                *(u32x4*)(O + (size_t)row * ldc + col0) = w; }
    }
};
struct EpiGateBf16 {
    static constexpr bool PERM = true, AFTER_DRAIN = false;
    bf16_t* Y; const float* gate;
    __device__ __forceinline__ void operator()(const f32x4 (&acc)[2][2][4][2], const Unit& u, int wr, int wc, int fr, int fq) const {
        const int row0 = u.pm * BM + wr * 64 + fr, col0 = (u.pn & 3) * BM + wc * 32 + 8 * fq;
        float gtv[2][4];
#pragma unroll
        for (int ai = 0; ai < 2; ++ai)
#pragma unroll
            for (int m = 0; m < 4; ++m) gtv[ai][m] = gate[row0 + ai * HALF + m * 16];
#pragma unroll
        for (int ai = 0; ai < 2; ++ai)
#pragma unroll
            for (int m = 0; m < 4; ++m) { const int row = row0 + ai * HALF + m * 16; const float gt = gtv[ai][m]; bf16_t* rowp = Y + (size_t)row * 1024 + col0;
#pragma unroll
                for (int bj = 0; bj < 2; ++bj) { const f32x4 v0 = acc[ai][bj][m][0] * gt, v1 = acc[ai][bj][m][1] * gt;
                    u32x4 w; w.x = cvt_pk_bf16(v0[0], v0[1]); w.y = cvt_pk_bf16(v0[2], v0[3]); w.z = cvt_pk_bf16(v1[0], v1[1]); w.w = cvt_pk_bf16(v1[2], v1[3]);
                    *(u32x4*)(rowp + bj * HALF) = w; } }
    }
};
struct EpiPartF32 {
    static constexpr bool PERM = false, AFTER_DRAIN = false;
    float* YP;
    __device__ __forceinline__ void operator()(const f32x4 (&acc)[2][2][4][2], const Unit& u, int wr, int wc, int fr, int fq) const {
        const int e = u.pn >> 2, c = (u.koff != 0) ? 1 : 0; const int r0 = wr * 64 + fr, col0 = (u.pn & 3) * BM + wc * 32 + 4 * fq;
        float* base = YP + (size_t)((c * 8 + e) * 256) * 1024;
#pragma unroll
        for (int ai = 0; ai < 2; ++ai)
#pragma unroll
            for (int m = 0; m < 4; ++m) { float* rowp = base + (size_t)(r0 + ai * HALF + m * 16) * 1024 + col0;
#pragma unroll
                for (int bj = 0; bj < 2; ++bj)
#pragma unroll
                    for (int n = 0; n < 2; ++n) *(f32x4*)(rowp + bj * HALF + n * 16) = acc[ai][bj][m][n]; }
    }
};
struct MoeFb { unsigned p0, p1, p2, p3, p4; };
__device__ __forceinline__ int moe_fb(const MoeFb& f, int k) { const int q = k >> 1; const unsigned w = (q == 0) ? f.p0 : (q == 1) ? f.p1 : (q == 2) ? f.p2 : (q == 3) ? f.p3 : f.p4; return (int)((k & 1) ? (w >> 16) : (w & 0xffffu)); }
struct MoeFullOrder {
    MoeFb fbp; unsigned hasmask; int G, c;
    __device__ __forceinline__ bool next(int i, Unit& u) const {
        const int L = i * G + c; if (L >= moe_fb(fbp, 8) * 4) return false;
        const int t = L >> 2, j = L & 3; int e = 0;
#pragma unroll
        for (int k = 1; k < 8; ++k) e += (t >= moe_fb(fbp, k)) ? 1 : 0;
        u.pm = t + __popc(hasmask & ((1u << e) - 1u)); u.pn = e * 4 + j; u.koff = 0; return true;
    }
    __device__ __forceinline__ void a_ready(const Unit&) const {}
    __device__ __forceinline__ void done(const Unit&) const {}
};
struct MoeRemOrder {
    MoeFb fbp; unsigned hasmask; int G, c;
    __device__ __forceinline__ bool next(int i, Unit& u) const {
        const int L = i * G + c; if (L >= __popc(hasmask) * 8) return false;
        const int r = L >> 3, j = (L >> 1) & 3, ch = L & 1; int e = 0, seen = 0;
#pragma unroll
        for (int k = 0; k < 8; ++k) { const bool has = (hasmask >> k) & 1u; if (has && seen == r) e = k; seen += has ? 1 : 0; }
        u.pm = moe_fb(fbp, e + 1) + __popc(hasmask & ((2u << e) - 1u)) - 1; u.pn = e * 4 + j; u.koff = ch * (1408 * 2); return true;
    }
    __device__ __forceinline__ void a_ready(const Unit&) const {}
    __device__ __forceinline__ void done(const Unit&) const {}
};
struct MoeOrder {
    int tb[9]; int npn, G, c;
    __device__ __forceinline__ bool next(int i, Unit& u) const {
        const int L = i * G + c; if (L >= tb[8] * npn) return false;
        const int t = L / npn, j = L - t * npn; int e = 0;
#pragma unroll
        for (int k = 1; k < 8; ++k) e += (t >= tb[k]) ? 1 : 0;
        u.pm = t; u.pn = e * npn + j; return true;
    }
    __device__ __forceinline__ void a_ready(const Unit&) const {}
    __device__ __forceinline__ void done(const Unit&) const {}
};

template <class Epi, class Sched, bool ALIGN_EPI = false, bool SP2 = false>
__device__ __forceinline__ void gemm_phase(PG8_LAS unsigned char* lds, const Gemm g, const Sched& S, const Epi& E) {
    const int tid = threadIdx.x, wid = __builtin_amdgcn_readfirstlane(tid >> 6), lane = tid & 63, wr = wid >> 2, wc = wid & 3, fr = lane & 15, fq = lane >> 4;
    const int K = g.K, nt = K / BK, LD = g.ld ? g.ld : g.K;
    unsigned voffA[2], voffB[2];
#pragma unroll
    for (int i = 0; i < 2; ++i) { int R, C; stage_rc(tid * 16 + i * 8192, R, C); const int Rb = Epi::PERM ? ((R & ~31) + perm32(R & 31)) : R;
        voffA[i] = (unsigned)(R * LD + C) * 2u; voffB[i] = (unsigned)(Rb * LD + C) * 2u; }
    const size_t kstep = (size_t)(BK * 2);
    const size_t hstep = (size_t)HALF * LD * 2;
    const size_t tstep = 2 * hstep;
    const unsigned ldsw = (unsigned)wid * 1024u;
    const int aoff = lds_byte(wr * 64 + fr, fq * 8), boff = lds_byte(wc * 32 + fr, fq * 8);
#define PG8_SA(b, h) (((b) * 2 + (h)) * HTB)
#define PG8_SB(b, h) ((4 + (b) * 2 + (h)) * HTB)
#define PG8_STAGE(bufoff, gbase, voff) do { _Pragma("unroll") for (int _i = 0; _i < 2; ++_i) \
        __builtin_amdgcn_global_load_lds((const unsigned*)((const char*)(gbase) + (voff)[_i]), (PG8_LAS unsigned*)(lds + (bufoff) + ldsw + _i * 8192), 16, 0, 0); } while (0)
#define PG8_LDA(dst, b, h) do { _Pragma("unroll") for (int m = 0; m < 4; ++m) _Pragma("unroll") for (int k = 0; k < 2; ++k) dst[m][k] = *(const PG8_LAS bf16x8*)(lds + PG8_SA(b, h) + aoff + m * 2048 + k * 1024); } while (0)
#define PG8_LDB(dst, b, h) do { _Pragma("unroll") for (int n = 0; n < 2; ++n) _Pragma("unroll") for (int k = 0; k < 2; ++k) dst[n][k] = *(const PG8_LAS bf16x8*)(lds + PG8_SB(b, h) + boff + n * 2048 + k * 1024); } while (0)
#define PG8_MMA(ai, bj, At, Bt) do { __builtin_amdgcn_s_setprio(1); _Pragma("unroll") for (int m = 0; m < 4; ++m) _Pragma("unroll") for (int n = 0; n < 2; ++n) _Pragma("unroll") for (int k = 0; k < 2; ++k) \
        acc[ai][bj][m][n] = __builtin_amdgcn_mfma_f32_16x16x32_bf16(Bt[n][k], At[m][k], acc[ai][bj][m][n], 0, 0, 0); __builtin_amdgcn_s_setprio(0); } while (0)
#define PG8_WAIT_V(n) asm volatile("s_waitcnt vmcnt(" #n ")" ::: "memory")
#define PG8_WAIT_L(n) asm volatile("s_waitcnt lgkmcnt(" #n ")" ::: "memory")
#define PG8_BAR __builtin_amdgcn_s_barrier()
#define PG8_SCHED __builtin_amdgcn_sched_barrier(0)
    Unit cur, nxt; int ui = 0;
    if (!S.next(0, cur)) return;
    f32x4 acc[2][2][4][2];
#pragma unroll
    for (int a = 0; a < 2; ++a)
#pragma unroll
        for (int b = 0; b < 2; ++b)
#pragma unroll
            for (int m = 0; m < 4; ++m)
#pragma unroll
                for (int n = 0; n < 2; ++n) acc[a][b][m][n] = (f32x4){0.f, 0.f, 0.f, 0.f};
    bf16x8 At[4][2], B0[2][2], B1[2][2];
    const char* cA = (const char*)g.A + (size_t)cur.pm * tstep + cur.koff; const char* cB = (const char*)g.Bt + (size_t)cur.pn * tstep + cur.koff;
    S.a_ready(cur);
    if constexpr (SP2) {
        PG8_STAGE(PG8_SB(0, 0), cB, voffB); PG8_STAGE(PG8_SB(0, 1), cB + hstep, voffB); PG8_STAGE(PG8_SA(0, 0), cA, voffA); PG8_STAGE(PG8_SA(0, 1), cA + hstep, voffA);
        if (wr == 1) PG8_BAR;
        PG8_WAIT_V(2); PG8_BAR;
        PG8_STAGE(PG8_SB(1, 0), cB + kstep, voffB); PG8_STAGE(PG8_SA(1, 0), cA + kstep, voffA); PG8_STAGE(PG8_SB(1, 1), cB + hstep + kstep, voffB);
        PG8_WAIT_V(6); PG8_BAR;
    } else {
        PG8_STAGE(PG8_SB(0, 0), cB, voffB); PG8_STAGE(PG8_SA(0, 0), cA, voffA); PG8_STAGE(PG8_SB(0, 1), cB + hstep, voffB); PG8_STAGE(PG8_SA(0, 1), cA + hstep, voffA);
        if (wr == 1) PG8_BAR;
        PG8_WAIT_V(4); PG8_BAR;
        PG8_STAGE(PG8_SB(1, 0), cB + kstep, voffB); PG8_STAGE(PG8_SA(1, 0), cA + kstep, voffA); PG8_STAGE(PG8_SB(1, 1), cB + hstep + kstep, voffB);
        PG8_WAIT_V(6); PG8_BAR;
    }
    for (;;) {
        const bool has_next = S.next(ui + 1, nxt);
        const char* nA = has_next ? (const char*)g.A + (size_t)nxt.pm * tstep + nxt.koff : cA; const char* nB = has_next ? (const char*)g.Bt + (size_t)nxt.pn * tstep + nxt.koff : cB;
        for (int t = 0; t < nt; t += 2) {
            const bool last = (t == nt - 2);
            const char* a1 = cA + (size_t)(t + 1) * kstep;
            const char* a2 = last ? nA : cA + (size_t)(t + 2) * kstep; const char* b2 = last ? nB : cB + (size_t)(t + 2) * kstep;
            const char* a3 = a2 + kstep; const char* b3 = b2 + kstep;
            if (last && has_next) S.a_ready(nxt);
            if constexpr (SP2) {
            PG8_LDB(B0, 0, 0); PG8_LDB(B1, 0, 1); PG8_SCHED; PG8_LDA(At, 0, 0); PG8_STAGE(PG8_SA(1, 1), a1 + hstep, voffA);
            PG8_WAIT_V(8); PG8_WAIT_L(0); PG8_BAR; PG8_MMA(0, 0, At, B0); PG8_MMA(0, 1, At, B1); PG8_BAR; PG8_SCHED;
            PG8_LDA(At, 0, 1); PG8_STAGE(PG8_SB(0, 0), b2, voffB); PG8_STAGE(PG8_SB(0, 1), b2 + hstep, voffB); PG8_STAGE(PG8_SA(0, 0), a2, voffA);
            PG8_WAIT_V(8); PG8_WAIT_L(0); PG8_BAR; PG8_MMA(1, 0, At, B0); PG8_MMA(1, 1, At, B1); PG8_BAR; PG8_SCHED;
            PG8_LDB(B0, 1, 0); PG8_LDB(B1, 1, 1); PG8_SCHED; PG8_LDA(At, 1, 0); PG8_STAGE(PG8_SA(0, 1), a2 + hstep, voffA);
            PG8_WAIT_V(8); PG8_WAIT_L(0); PG8_BAR; PG8_MMA(0, 0, At, B0); PG8_MMA(0, 1, At, B1); PG8_BAR; PG8_SCHED;
            PG8_LDA(At, 1, 1); PG8_STAGE(PG8_SB(1, 0), b3, voffB); PG8_STAGE(PG8_SB(1, 1), b3 + hstep, voffB); PG8_STAGE(PG8_SA(1, 0), a3, voffA);
            PG8_WAIT_V(8); PG8_WAIT_L(0); PG8_BAR; PG8_MMA(1, 0, At, B0); PG8_MMA(1, 1, At, B1); PG8_BAR; PG8_SCHED;
            } else {
            PG8_LDB(B0, 0, 0); PG8_SCHED; PG8_LDA(At, 0, 0); PG8_STAGE(PG8_SA(1, 1), a1 + hstep, voffA);
            PG8_WAIT_L(8); PG8_BAR; PG8_WAIT_L(0); PG8_MMA(0, 0, At, B0); PG8_BAR; PG8_SCHED;
            PG8_LDB(B1, 0, 1); PG8_STAGE(PG8_SB(0, 0), b2, voffB);
            PG8_BAR; PG8_WAIT_L(0); PG8_MMA(0, 1, At, B1); PG8_BAR;
            PG8_LDA(At, 0, 1); PG8_STAGE(PG8_SA(0, 0), a2, voffA);
            PG8_BAR; PG8_WAIT_L(0); PG8_MMA(1, 0, At, B0); PG8_BAR; PG8_SCHED;
            PG8_STAGE(PG8_SB(0, 1), b2 + hstep, voffB);
            PG8_WAIT_V(6); PG8_BAR; PG8_MMA(1, 1, At, B1); PG8_BAR;
            PG8_LDB(B0, 1, 0); PG8_SCHED; PG8_LDA(At, 1, 0); PG8_STAGE(PG8_SA(0, 1), a2 + hstep, voffA);
            PG8_WAIT_L(8); PG8_BAR; PG8_WAIT_L(0); PG8_MMA(0, 0, At, B0); PG8_BAR; PG8_SCHED;
            PG8_LDB(B1, 1, 1); PG8_STAGE(PG8_SB(1, 0), b3, voffB);
            PG8_BAR; PG8_WAIT_L(0); PG8_MMA(0, 1, At, B1); PG8_BAR;
            PG8_LDA(At, 1, 1); PG8_STAGE(PG8_SA(1, 0), a3, voffA);
            PG8_BAR; PG8_WAIT_L(0); PG8_MMA(1, 0, At, B0); PG8_BAR; PG8_SCHED;
            PG8_STAGE(PG8_SB(1, 1), b3 + hstep, voffB);
            PG8_WAIT_V(6); PG8_BAR; PG8_MMA(1, 1, At, B1); PG8_BAR;
            }
        }
        if constexpr (ALIGN_EPI) { if (wr == 0) PG8_BAR; }
        if constexpr (!Epi::AFTER_DRAIN) { E(acc, cur, wr, wc, fr, fq); S.done(cur); }
        if (!has_next) break;
#pragma unroll
        for (int a = 0; a < 2; ++a)
#pragma unroll
            for (int b = 0; b < 2; ++b)
#pragma unroll
                for (int m = 0; m < 4; ++m)
#pragma unroll
                    for (int n = 0; n < 2; ++n) acc[a][b][m][n] = (f32x4){0.f, 0.f, 0.f, 0.f};
        cur = nxt; cA = nA; cB = nB; ++ui;
        if constexpr (ALIGN_EPI) { if (wr == 1) PG8_BAR; }
    }
    PG8_WAIT_V(0);
    if constexpr (!ALIGN_EPI) { if (wr == 0) PG8_BAR; }
    PG8_BAR;
    if constexpr (Epi::AFTER_DRAIN) { E.fused(acc, cur, wr, wc, fr, fq, lds, wid, lane); S.done(cur); }
#undef PG8_SA
#undef PG8_SB
#undef PG8_STAGE
#undef PG8_LDA
#undef PG8_LDB
#undef PG8_MMA
#undef PG8_WAIT_V
#undef PG8_WAIT_L
#undef PG8_BAR
#undef PG8_SCHED
}
}

constexpr int NWAVES = 8;
constexpr int BATCH = 2, SEQ = 8192, D = 1024, M = BATCH * SEQ;
constexpr int HD = 128, NH = 8, NKV = 2, NIH = 8, IDX = 64, TOPK = 256;
constexpr int A_IN = 2120, FF = 2816, NE = 8;
constexpr int MAXSLOT = 34816;
constexpr float QSCALE = 0.12751743082459868f;
constexpr float SBSCALE = 0.08838834764831845f;
constexpr float WISCALE = 0.04419417382415922f;
constexpr size_t MiB = 1u << 20;
constexpr size_t WS_CTL = 0, CTL_ZERO_BYTES = 1 * MiB;
constexpr size_t WS_WIN = 2 * MiB, WS_WTAIL = 6 * MiB, WS_WOA = 7 * MiB, WS_WGU = 9 * MiB, WS_WD = 20 * MiB, WS_WKVQ = 26 * MiB, WS_WOB = 32 * MiB, WS_WGUM = 34 * MiB, WS_WDM = 122 * MiB;
constexpr size_t WS_H = 166 * MiB, WS_XB = 230 * MiB, WS_SS0 = 262 * MiB, WS_SS1 = 263 * MiB, WS_SS2 = 264 * MiB, WS_SS3 = 265 * MiB;
constexpr size_t WS_T = 266 * MiB;
constexpr size_t WS_PROJ = WS_T, WS_QF = 330 * MiB, WS_KVF = 362 * MiB, WS_QIF = 378 * MiB, WS_KIF = 394 * MiB, WS_WIF = 396 * MiB, WS_SEL = 397 * MiB, WS_AO = 413 * MiB;
constexpr size_t WS_HF = WS_T, WS_KQ = WS_T, WS_VT = 330 * MiB;
constexpr size_t WS_XPERM = WS_T, WS_HM = 334 * MiB, WS_Y = 521 * MiB;
constexpr size_t WS_RT = 590 * MiB;
constexpr size_t WS_RSTDS = 591 * MiB, WS_GATES = 591 * MiB + 512 * 1024, WS_YP = 592 * MiB, WS_END = 608 * MiB;
constexpr int CW_CNT = 64;
constexpr int CW_BAR = 4096;
constexpr int RING_BYTES = 131072, LDSCTL_OFF = RING_BYTES, MISC_OFF = LDSCTL_OFF + 320, LDS_BYTES = 147456;

#define GAS __attribute__((address_space(1)))
#define LAS __attribute__((address_space(3)))
typedef unsigned short bf16;
typedef unsigned v4u __attribute__((ext_vector_type(4)));
typedef unsigned v2u __attribute__((ext_vector_type(2)));
typedef float f32x4 __attribute__((ext_vector_type(4)));
typedef short bf16x8 __attribute__((ext_vector_type(8)));
typedef float f32x16 __attribute__((ext_vector_type(16)));
typedef GAS unsigned gu32;
#define RLX_AGENT __ATOMIC_RELAXED, __HIP_MEMORY_SCOPE_AGENT
#define LDS_WAIT() asm volatile("s_waitcnt lgkmcnt(0)" ::: "memory")
#define VM_WAIT() asm volatile("s_waitcnt vmcnt(0)" ::: "memory")
__device__ __forceinline__ unsigned f2bf(float f) { unsigned u = __builtin_bit_cast(unsigned, f); return (u + 0x7fffu + ((u >> 16) & 1u)) >> 16; }
__device__ __forceinline__ unsigned pk2(float lo, float hi) { return f2bf(lo) | (f2bf(hi) << 16); }
__device__ __forceinline__ float bflo(unsigned w) { return __uint_as_float(w << 16); }
__device__ __forceinline__ float bfhi(unsigned w) { return __uint_as_float(w & 0xffff0000u); }
__device__ __forceinline__ float wave_sum(float v) {
#pragma unroll
    for (int o = 1; o < 64; o <<= 1) v += __shfl_xor(v, o);
    return v;
}
__device__ __forceinline__ float wave_max(float v) {
#pragma unroll
    for (int o = 1; o < 64; o <<= 1) v = fmaxf(v, __shfl_xor(v, o));
    return v;
}
__device__ __forceinline__ void sincos_acc(float a, float& c, float& s) {
    const double x = (double)a; const double n = __builtin_rint(x * 0.63661977236758134308);
    const double r = __builtin_fma(-n, 6.123233995736766035869e-17, __builtin_fma(-n, 1.57079632679489655800, x)); const double r2 = r * r;
    double sn = 1.0 - r2 * (1.0 / 156.0); sn = 1.0 - r2 * (1.0 / 110.0) * sn; sn = 1.0 - r2 * (1.0 / 72.0) * sn; sn = 1.0 - r2 * (1.0 / 42.0) * sn; sn = 1.0 - r2 * (1.0 / 20.0) * sn; sn = 1.0 - r2 * (1.0 / 6.0) * sn; sn *= r;
    double cs = 1.0 - r2 * (1.0 / 182.0); cs = 1.0 - r2 * (1.0 / 132.0) * cs; cs = 1.0 - r2 * (1.0 / 90.0) * cs; cs = 1.0 - r2 * (1.0 / 56.0) * cs; cs = 1.0 - r2 * (1.0 / 30.0) * cs; cs = 1.0 - r2 * (1.0 / 12.0) * cs; cs = 1.0 - r2 * 0.5 * cs;
    const int q = ((int)n) & 3;
    const double cq = (q == 0) ? cs : (q == 1) ? -sn : (q == 2) ? -cs : sn;
    const double sq = (q == 0) ? sn : (q == 1) ? cs : (q == 2) ? -sn : -cs;
    c = (float)cq; s = (float)sq;
}
__device__ const float INV_Q[16] = {1.000000000e+00f, 4.403665960e-01f, 1.939227432e-01f, 8.539710194e-02f, 3.760603070e-02f, 1.656043902e-02f, 7.292664610e-03f, 3.211445874e-03f,
                                    1.414213562e-03f, 6.227723788e-04f, 2.742481884e-04f, 1.207697351e-04f, 5.318296098e-05f, 2.341999971e-05f, 1.031338616e-05f, 4.541670478e-06f};
__device__ const float INV_I[8] = {1.000000000e+00f, 1.939227432e-01f, 3.760603070e-02f, 7.292664610e-03f, 1.414213562e-03f, 2.742481884e-04f, 5.318296098e-05f, 1.031338616e-05f};

#define XB_TMO      128
#define XB_XCNT(j)  (256  + 64 * (j))
#define XB_XSUB(j)  (1280 + 64 * (j))
#define XB_XGEN(j)  (2304 + 64 * (j))
#define XB_TOP      3328
#define XB_TOPGEN   3392
#define XCD_BAR_WORDS 3456
#define XB_SPIN_CAP (1u << 18)

__device__ __forceinline__ unsigned xb_ld(unsigned* p)              { return __hip_atomic_load(p, __ATOMIC_RELAXED, __HIP_MEMORY_SCOPE_AGENT); }
__device__ __forceinline__ unsigned xb_add(unsigned* p, unsigned v) { return __hip_atomic_fetch_add(p, v, __ATOMIC_RELAXED, __HIP_MEMORY_SCOPE_AGENT); }
__device__ __forceinline__ unsigned xb_xcc_id() { return (unsigned)__builtin_amdgcn_s_getreg((3 << 11) | 20) & 0xFu; }
#define XB_SPIN(cond, bar) do { unsigned _sp = 0; while (cond) { __builtin_amdgcn_s_sleep(1); \
    if ((++_sp & 255u) == 0u) { if (xb_ld(&(bar)[XB_TMO])) break; if (_sp > XB_SPIN_CAP) { atomicAdd(&(bar)[XB_TMO], 1u); break; } } } } while (0)

struct XcdBarrier {
    unsigned* bar; unsigned x;
    volatile LAS unsigned* st;
};

__device__ __forceinline__ XcdBarrier xcd_barrier_post(unsigned* bar, volatile LAS unsigned* st) {
    XcdBarrier b; b.bar = bar; b.x = xb_xcc_id(); b.st = st;
    if (threadIdx.x == 0) (void)xb_add(&bar[XB_XCNT(b.x)], 1u);
    return b;
}
__device__ __forceinline__ void xcd_barrier_complete(unsigned* bar, unsigned x, unsigned& nloc, unsigned& nx) {
    const unsigned G = gridDim.x * gridDim.y * gridDim.z;
    unsigned sum, cnt, mine, sp = 0u;
    for (;;) {
        sum = 0u; cnt = 0u; mine = 0u;
#pragma unroll
        for (unsigned j = 0; j < 16; ++j) { const unsigned c = xb_ld(&bar[XB_XCNT(j)]); sum += c; cnt += (c > 0u) ? 1u : 0u; mine = (j == x) ? c : mine; }
        if (sum == G) break;
        __builtin_amdgcn_s_sleep(1);
        if ((++sp & 255u) == 0u) { if (xb_ld(&bar[XB_TMO])) break; if (sp > XB_SPIN_CAP) { atomicAdd(&bar[XB_TMO], 1u); break; } }
    }
    nloc = mine > 0u ? mine : 1u; nx = cnt > 0u ? cnt : 1u;
}

__device__ __forceinline__ void xcd_barrier(const XcdBarrier& b) {
    asm volatile("s_waitcnt vmcnt(0)" ::: "memory");
    __syncthreads();
    if (threadIdx.x == 0) {
        unsigned* bar = b.bar;
        __builtin_amdgcn_s_waitcnt(0);
        unsigned nloc = b.st[0], nx = b.st[1];
        if (nloc == 0u) { xcd_barrier_complete(bar, b.x, nloc, nx); b.st[0] = nloc; b.st[1] = nx; }
        const unsigned old = xb_add(&bar[XB_XSUB(b.x)], 1u);
        const unsigned gen = old / nloc;
        if (old + 1u == (gen + 1u) * nloc) {
            __builtin_amdgcn_fence(__ATOMIC_RELEASE, "agent");
            asm volatile("s_waitcnt vmcnt(0)" ::: "memory");
            const unsigned og = xb_add(&bar[XB_TOP], 1u);
            const unsigned tg = og / nx;
            if (og + 1u == (tg + 1u) * nx) xb_add(&bar[XB_TOPGEN], 1u);
            else XB_SPIN(xb_ld(&bar[XB_TOPGEN]) == tg, bar);
            __builtin_amdgcn_fence(__ATOMIC_ACQUIRE, "agent");
            xb_add(&bar[XB_XGEN(b.x)], 1u);
            asm volatile("s_waitcnt vmcnt(0)" ::: "memory");
        } else {
            XB_SPIN(xb_ld(&bar[XB_XGEN(b.x)]) == gen, bar);
            __builtin_amdgcn_fence(__ATOMIC_ACQUIRE, "agent");
            asm volatile("s_waitcnt vmcnt(0)" ::: "memory");
        }
    }
    __syncthreads();
}

struct Frame {
    LAS unsigned char* lds;
    volatile LAS unsigned* MISC;
    gu32* ctl;
    int tid, lane, wave, G, bid;
    const float* in[17];
    float* out; unsigned char* ws;
};
enum { IN_X = 0, IN_ANORM, IN_AWIN, IN_AQN, IN_AKN, IN_AWOUT, IN_KVNORM, IN_KVW, IN_BNORM, IN_BWQ, IN_BWOUT, IN_FFNNORM, IN_DGU, IN_DDN, IN_ROUTER, IN_MGU, IN_MDN };

struct TrItem { const float* W; size_t ldw; int K, k0, csrc0, cend; bf16* WT; int drow0; const float* gain; float scale; };
__device__ __forceinline__ int gu_row(int c0) { return (c0 < FF) ? ((c0 >> 7) * 256 + (c0 & 127)) : (((c0 - FF) >> 7) * 256 + 128 + ((c0 - FF) & 127)); }
constexpr int I_WIN = 16 * 32, I_TAIL = 16 * 2, I_SQ = 16 * 16, I_GU = 16 * 88, I_DN = 44 * 16, I_KV = 16 * 32;
constexpr int TR_NITEMS = I_WIN + I_TAIL + I_SQ + I_GU + I_DN + I_KV + I_SQ + I_SQ + NE * I_GU + NE * I_DN;
__device__ __forceinline__ TrItem tr_decode(const Frame& F, int it) {
    unsigned char* ws = F.ws; int r = it; TrItem t;
    if (r < I_WIN) { const int kb = r / 32, nb = r % 32; t = TrItem{F.in[IN_AWIN], (size_t)A_IN, D, 64 * kb, 64 * nb, A_IN, (bf16*)(ws + WS_WIN), 64 * nb, F.in[IN_ANORM], 1.f}; return t; } r -= I_WIN;
    if (r < I_TAIL) { const int kb = r / 2, nb = r % 2; t = TrItem{F.in[IN_AWIN], (size_t)A_IN, D, 64 * kb, 2048 + 64 * nb, A_IN, (bf16*)(ws + WS_WTAIL), 64 * nb, F.in[IN_ANORM], 1.f}; return t; } r -= I_TAIL;
    if (r < I_SQ) { const int kb = r / 16, nb = r % 16; t = TrItem{F.in[IN_AWOUT], (size_t)D, D, 64 * kb, 64 * nb, D, (bf16*)(ws + WS_WOA), 64 * nb, nullptr, 1.f}; return t; } r -= I_SQ;
    if (r < I_GU) { const int kb = r / 88, nb = r % 88; t = TrItem{F.in[IN_DGU], (size_t)(2 * FF), D, 64 * kb, 64 * nb, 2 * FF, (bf16*)(ws + WS_WGU), gu_row(64 * nb), F.in[IN_FFNNORM], 1.f}; return t; } r -= I_GU;
    if (r < I_DN) { const int kb = r / 16, nb = r % 16; t = TrItem{F.in[IN_DDN], (size_t)D, FF, 64 * kb, 64 * nb, D, (bf16*)(ws + WS_WD), 64 * nb, nullptr, 1.f}; return t; } r -= I_DN;
    if (r < I_KV) { const int kb = r / 32, nb = r % 32; t = TrItem{F.in[IN_KVW], (size_t)(2 * D), D, 64 * kb, 64 * nb, 2 * D, (bf16*)(ws + WS_WKVQ), (nb < 16) ? 64 * nb : 1024 + 64 * nb, F.in[IN_KVNORM], 1.f}; return t; } r -= I_KV;
    if (r < I_SQ) { const int kb = r / 16, nb = r % 16; t = TrItem{F.in[IN_BWQ], (size_t)D, D, 64 * kb, 64 * nb, D, (bf16*)(ws + WS_WKVQ), 1024 + 64 * nb, F.in[IN_BNORM], SBSCALE}; return t; } r -= I_SQ;
    if (r < I_SQ) { const int kb = r / 16, nb = r % 16; t = TrItem{F.in[IN_BWOUT], (size_t)D, D, 64 * kb, 64 * nb, D, (bf16*)(ws + WS_WOB), 64 * nb, nullptr, 1.f}; return t; } r -= I_SQ;
    if (r < NE * I_GU) { const int e = r / I_GU, rr = r % I_GU, kb = rr / 88, nb = rr % 88;
        t = TrItem{F.in[IN_MGU] + (size_t)e * D * 2 * FF, (size_t)(2 * FF), D, 64 * kb, 64 * nb, 2 * FF, (bf16*)(ws + WS_WGUM), e * 2 * FF + gu_row(64 * nb), F.in[IN_FFNNORM] + D, 1.f}; return t; } r -= NE * I_GU;
    { const int e = r / I_DN, rr = r % I_DN, kb = rr / 16, nb = rr % 16;
      t = TrItem{F.in[IN_MDN] + (size_t)e * FF * D, (size_t)D, FF, 64 * kb, 64 * nb, D, (bf16*)(ws + WS_WDM), e * D + 64 * nb, nullptr, 1.f}; return t; }
}
__device__ __forceinline__ void tr_load(const TrItem& t, f32x4 (&v)[16], int lane) {
    const int r = lane >> 4, c = t.csrc0 + 4 * (lane & 15); const bool ok = c < t.cend; const float* src = t.W + (size_t)(t.k0 + r) * t.ldw + (ok ? c : 0);
#pragma unroll
    for (int i = 0; i < 16; ++i) { const f32x4 x = *(const f32x4*)(src + (size_t)(4 * i) * t.ldw); v[i] = ok ? x : (f32x4){0.f, 0.f, 0.f, 0.f}; }
}
__device__ __forceinline__ void tr_store(const TrItem& t, const f32x4 (&v)[16], LAS float* scr, int lane) {
    const int r = lane >> 4, c4 = lane & 15;
#pragma unroll
    for (int i = 0; i < 16; ++i) { const int k = 4 * i + r; const float g = t.gain ? t.gain[t.k0 + k] * t.scale : t.scale;
        *(LAS f32x4*)(scr + k * 64 + 4 * (c4 ^ ((k >> 3) & 7))) = v[i] * g; }
    LDS_WAIT(); asm volatile("" ::: "memory");
    const int c8 = lane & 7;
#pragma unroll
    for (int j = 0; j < 8; ++j) { const int n = (lane >> 3) + 8 * j; const LAS float* s = scr + (8 * c8) * 64 + (n ^ (c8 << 2));
        v4u o; o.x = pk2(s[0 * 64], s[1 * 64]); o.y = pk2(s[2 * 64], s[3 * 64]); o.z = pk2(s[4 * 64], s[5 * 64]); o.w = pk2(s[6 * 64], s[7 * 64]);
        *(GAS v4u*)(t.WT + (size_t)(t.drow0 + n) * t.K + t.k0 + 8 * c8) = o; }
    LDS_WAIT(); asm volatile("" ::: "memory");
}
__device__ __forceinline__ void p0_prologue(Frame& F) {
    LAS float* scr = (LAS float*)(F.lds + F.wave * 16384);
    const int gw = F.wave * F.G + F.bid, NGW = F.G * NWAVES;
    unsigned char* ws = F.ws;
    {
        f32x4 va[16], vb[16];
        int it = gw;
        if (it < TR_NITEMS) { TrItem cur = tr_decode(F, it); tr_load(cur, va, F.lane);
            for (;;) {
                const int nx = it + NGW; const bool has = nx < TR_NITEMS; TrItem nxt = cur;
                if (has) { nxt = tr_decode(F, nx); tr_load(nxt, vb, F.lane); }
                tr_store(cur, va, scr, F.lane);
                if (!has) break;
                it = nx + NGW; const bool has2 = it < TR_NITEMS; TrItem nn = nxt;
                if (has2) { nn = tr_decode(F, it); tr_load(nn, va, F.lane); }
                tr_store(nxt, vb, scr, F.lane);
                if (!has2) break;
                cur = nn;
            }
        }
    }
    const float* x = F.in[IN_X]; bf16* XB = (bf16*)(ws + WS_XB); float* SS0 = (float*)(ws + WS_SS0);
    for (int m = gw; m < M; m += NGW) {
        const GAS f32x4* xr = (const GAS f32x4*)(x + (size_t)m * D) + F.lane; f32x4 v[4]; float s = 0.f;
#pragma unroll
        for (int j = 0; j < 4; ++j) { v[j] = xr[64 * j]; s += (v[j].x * v[j].x + v[j].y * v[j].y) + (v[j].z * v[j].z + v[j].w * v[j].w); }
        s = wave_sum(s);
        GAS unsigned long long* o8 = (GAS unsigned long long*)(XB + (size_t)m * D) + F.lane;
#pragma unroll
        for (int j = 0; j < 4; ++j) o8[64 * j] = (unsigned long long)pk2(v[j].x, v[j].y) | ((unsigned long long)pk2(v[j].z, v[j].w) << 32);
        if (F.lane < 16) SS0[(size_t)m * 16 + F.lane] = (F.lane == 0) ? s : 0.f;
    }
}

#define WAVE_SYNC() asm volatile("s_waitcnt lgkmcnt(0)" ::: "memory")
__device__ __forceinline__ void rope8(float (&y)[8], bool isx1, bool isx2, int i0, int pshift, LAS const float* tab) {
#pragma unroll
    for (int e = 0; e < 8; ++e) {
        const float other = __shfl_xor(y[e], pshift); const float c = tab[2 * (i0 + e)], s = tab[2 * (i0 + e) + 1];
        y[e] = isx1 ? (y[e] * c - other * s) : (isx2 ? (y[e] * c + other * s) : y[e]);
    }
}
__device__ __forceinline__ size_t kif_off(int grow, int d) { return ((((size_t)(grow >> 5) * 4 + ((d >> 3) & 3)) * 2 + (d >> 5)) * 32 + (grow & 31)) * 8 + (d & 7); }
__device__ __forceinline__ void unpack8(const v4u w, float (&y)[8]) { y[0] = bflo(w.x); y[1] = bfhi(w.x); y[2] = bflo(w.y); y[3] = bfhi(w.y); y[4] = bflo(w.z); y[5] = bfhi(w.z); y[6] = bflo(w.w); y[7] = bfhi(w.w); }
__device__ __forceinline__ v4u pack8(const float (&y)[8]) { v4u o; o.x = pk2(y[0], y[1]); o.y = pk2(y[2], y[3]); o.z = pk2(y[4], y[5]); o.w = pk2(y[6], y[7]); return o; }
__device__ __forceinline__ void p2_post(Frame& F) {
    unsigned char* ws = F.ws; const int lane = F.lane;
    const bf16* PROJ = (const bf16*)(ws + WS_PROJ); const bf16* XB = (const bf16*)(ws + WS_XB); const bf16* WT = (const bf16*)(ws + WS_WTAIL); const float* SS0 = (const float*)(ws + WS_SS0);
    bf16* QF = (bf16*)(ws + WS_QF); bf16* KVF = (bf16*)(ws + WS_KVF); bf16* QIF = (bf16*)(ws + WS_QIF); bf16* KIF = (bf16*)(ws + WS_KIF); float* WIF = (float*)(ws + WS_WIF);
    const float* qnw = F.in[IN_AQN]; const float* knw = F.in[IN_AKN];
    LAS float* tab = (LAS float*)(F.lds + F.wave * 256);
    const int gw = F.wave * F.G + F.bid, NGW = F.G * NWAVES;
    for (int task = gw; task < M / 8; task += NGW) {
        const int row0 = task * 8;
        f32x4 acc[5];
#pragma unroll
        for (int c = 0; c < 5; ++c) acc[c] = (f32x4){0.f, 0.f, 0.f, 0.f};
        const bf16* ap = XB + (size_t)(row0 + (lane & 7)) * D + 8 * (lane >> 4);
        const bf16* bp = WT + (size_t)(lane & 15) * D + 8 * (lane >> 4);
#pragma unroll 4
        for (int j = 0; j < 32; ++j) {
            const bf16x8 a = *(const bf16x8*)(ap + 32 * j);
#pragma unroll
            for (int c = 0; c < 5; ++c) { const bf16x8 b = *(const bf16x8*)(bp + (size_t)(16 * c) * D + 32 * j); acc[c] = __builtin_amdgcn_mfma_f32_16x16x32_bf16(a, b, acc[c], 0, 0, 0); }
        }
        if (lane < 32) {
#pragma unroll
            for (int reg = 0; reg < 4; ++reg) {
                const int row = row0 + 4 * (lane >> 4) + reg; const float rs = pg8::rstd16(SS0 + (size_t)row * 16); const float pos = (float)(row & (SEQ - 1));
                const int d = lane & 15;
                float v0 = acc[0][reg] * rs; const float other = __shfl_xor(v0, 8);
                { float c, s; sincos_acc(pos * INV_I[d & 7], c, s); v0 = (d < 8) ? (v0 * c - other * s) : (v0 * c + other * s); }
                KIF[kif_off(row, d)] = (bf16)f2bf(v0);
#pragma unroll
                for (int c = 1; c < 4; ++c) KIF[kif_off(row, 16 * c + d)] = (bf16)f2bf(acc[c][reg] * rs);
                if (d < 8) WIF[(size_t)row * 8 + d] = acc[4][reg] * rs * WISCALE;
            }
        }
        for (int r = 0; r < 8; ++r) {
            const int row = row0 + r, b = row >> 13, t = row & (SEQ - 1); const float pos = (float)t;
            const bf16* pr = PROJ + (size_t)row * 2048 + 8 * lane;
            v4u w[4];
#pragma unroll
            for (int j = 0; j < 4; ++j) w[j] = *(const v4u*)(pr + 512 * j);
            if (lane < 24) { float c, s; sincos_acc(pos * ((lane < 16) ? INV_Q[lane & 15] : INV_I[lane & 7]), c, s); tab[2 * lane] = c; tab[2 * lane + 1] = s; }
            WAVE_SYNC();
#pragma unroll
            for (int j = 0; j < 2; ++j) {
                float y[8]; unpack8(w[j], y); float ss = 0.f;
#pragma unroll
                for (int e = 0; e < 8; ++e) ss += y[e] * y[e];
                ss += __shfl_xor(ss, 1); ss += __shfl_xor(ss, 2); ss += __shfl_xor(ss, 4); ss += __shfl_xor(ss, 8);
                const float rs = 1.0f / sqrtf(ss * (1.0f / 128.0f) + 1e-6f); const int c8 = (lane & 15) * 8;
#pragma unroll
                for (int e = 0; e < 8; ++e) y[e] = y[e] * rs * qnw[c8 + e];
                rope8(y, c8 < 16, c8 >= 16 && c8 < 32, c8 & 15, 2, tab);
#pragma unroll
                for (int e = 0; e < 8; ++e) y[e] *= QSCALE;
                *(v4u*)(QF + (size_t)row * D + 512 * j + 8 * lane) = pack8(y);
            }
            {
                float y[8]; unpack8(w[2], y); float ss = 0.f;
#pragma unroll
                for (int e = 0; e < 8; ++e) ss += y[e] * y[e];
                ss += __shfl_xor(ss, 1); ss += __shfl_xor(ss, 2); ss += __shfl_xor(ss, 4); ss += __shfl_xor(ss, 8);
                const bool isk = lane < 32; const float rs = 1.0f / sqrtf(ss * (1.0f / 128.0f) + 1e-6f); const int c8 = (lane & 15) * 8;
                if (isk) {
#pragma unroll
                    for (int e = 0; e < 8; ++e) y[e] = y[e] * rs * knw[c8 + e];
                }
                rope8(y, isk && c8 < 16, isk && c8 >= 16 && c8 < 32, c8 & 15, 2, tab);
                const int kvh = (lane >> 4) & 1;
                int w0 = __builtin_amdgcn_cvt_pk_fp8_f32(y[0], y[1], 0, false); w0 = __builtin_amdgcn_cvt_pk_fp8_f32(y[2], y[3], w0, true);
                int w1 = __builtin_amdgcn_cvt_pk_fp8_f32(y[4], y[5], 0, false); w1 = __builtin_amdgcn_cvt_pk_fp8_f32(y[6], y[7], w1, true);
                *(v2u*)((unsigned char*)KVF + ((size_t)(b * NKV + kvh) * SEQ + t) * 256 + (isk ? 0 : 128) + c8) = (v2u){(unsigned)w0, (unsigned)w1};
            }
            {
                float y[8]; unpack8(w[3], y); const int c8 = (lane & 7) * 8;
                rope8(y, c8 == 0, c8 == 8, 16, 1, tab);
                *(v4u*)(QIF + (size_t)row * 512 + 8 * lane) = pack8(y);
            }
            WAVE_SYNC();
        }
    }
}

__device__ __forceinline__ unsigned f2key(float f) { const unsigned u = __float_as_uint(f); return (u & 0x80000000u) ? ~u : (u | 0x80000000u); }
__device__ __forceinline__ void p3_query_naive(unsigned char* ws, LAS unsigned char* lds, int row, int* SEL) {
    const int tid = threadIdx.x, lane = tid & 63, wave = tid >> 6;
    const bf16* QIF = (const bf16*)(ws + WS_QIF); const bf16* KIF = (const bf16*)(ws + WS_KIF); const float* WIF = (const float*)(ws + WS_WIF);
    LAS unsigned* keys = (LAS unsigned*)lds;
    LAS float* qis = (LAS float*)(lds + 32768);
    LAS float* wl = (LAS float*)(lds + 32768 + 2048);
    LAS unsigned* hist = (LAS unsigned*)(lds + 36864);
    LAS unsigned* ctl = (LAS unsigned*)(lds + 36864 + 1024);
    LAS unsigned* wcnt = (LAS unsigned*)(lds + 36864 + 1024 + 64);
    {
        const int b = row >> 13, t = row & (SEQ - 1), n = t + 1;
        int* sel = SEL + (size_t)row * TOPK;
        if (n <= TOPK) { if (tid < TOPK) sel[tid] = tid < n ? tid : 0; return; }
        __syncthreads();
        qis[tid] = __uint_as_float((unsigned)QIF[(size_t)row * 512 + tid] << 16);
        if (tid < 8) wl[tid] = WIF[(size_t)row * 8 + tid];
        __syncthreads();
        for (int s = tid; s < n; s += 512) {
            const int grow = (b << 13) + s;
            float kf[64];
#pragma unroll
            for (int j = 0; j < 8; ++j) { const v4u w = *(const v4u*)(KIF + kif_off(grow, 8 * j)); kf[8 * j] = bflo(w.x); kf[8 * j + 1] = bfhi(w.x); kf[8 * j + 2] = bflo(w.y); kf[8 * j + 3] = bfhi(w.y); kf[8 * j + 4] = bflo(w.z); kf[8 * j + 5] = bfhi(w.z); kf[8 * j + 6] = bflo(w.w); kf[8 * j + 7] = bfhi(w.w); }
            float sc = 0.f;
#pragma unroll
            for (int h = 0; h < 8; ++h) { float d = 0.f; asm volatile("" ::: "memory");
#pragma unroll
                for (int dd = 0; dd < 64; ++dd) d += qis[h * 64 + dd] * kf[dd];
                sc += wl[h] * fmaxf(d, 0.f); }
            keys[s] = f2key(sc + 0.0f);
        }
        __syncthreads();
        unsigned prefix = 0u, mask = 0u, need = TOPK;
        for (int pass = 0; pass < 4; ++pass) {
            const int shift = 24 - 8 * pass;
            if (tid < 256) hist[tid] = 0u;
            __syncthreads();
            for (int s = tid; s < n; s += 512) { const unsigned k = keys[s]; if ((k & mask) == prefix) __hip_atomic_fetch_add(&hist[(k >> shift) & 255u], 1u, __ATOMIC_RELAXED, __HIP_MEMORY_SCOPE_WORKGROUP); }
            __syncthreads();
            if (tid < 64) {
                const unsigned h0 = hist[4 * lane], h1 = hist[4 * lane + 1], h2 = hist[4 * lane + 2], h3 = hist[4 * lane + 3]; const unsigned tot = h0 + h1 + h2 + h3;
                unsigned incl = tot;
#pragma unroll
                for (int o = 1; o < 64; o <<= 1) { const unsigned v = __shfl_down(incl, o); if (lane + o < 64) incl += v; }
                const unsigned above = incl - tot;
                if (above < need && need <= above + tot) {
                    unsigned a = above; unsigned bin;
                    if (a + h3 >= need) bin = 3; else { a += h3; if (a + h2 >= need) bin = 2; else { a += h2; if (a + h1 >= need) bin = 1; else { a += h1; bin = 0; } } }
                    ctl[0] = 4 * lane + bin; ctl[1] = need - a;
                }
            }
            __syncthreads();
            prefix |= ctl[0] << shift; mask |= 255u << shift; need = ctl[1];
            __syncthreads();
        }
        const unsigned thr = prefix, n_gt = TOPK - need;
        unsigned base_gt = 0u, base_eq = 0u;
        for (int s0 = 0; s0 < n; s0 += 512) {
            const int s = s0 + tid; const unsigned k = s < n ? keys[s] : 0u; const bool gt = (s < n) && (k > thr); const bool eq = (s < n) && (k == thr);
            const unsigned long long bg = __ballot(gt), be = __ballot(eq); const unsigned long long lt = (1ull << lane) - 1ull;
            const unsigned rg = __popcll(bg & lt), re = __popcll(be & lt);
            if (lane == 0) { wcnt[wave] = __popcll(bg); wcnt[8 + wave] = __popcll(be); }
            __syncthreads();
            unsigned og = base_gt, oe = base_eq, tg = 0u, te = 0u;
#pragma unroll
            for (int w = 0; w < 8; ++w) { const unsigned cg = wcnt[w], ce = wcnt[8 + w]; if (w < wave) { og += cg; oe += ce; } tg += cg; te += ce; }
            if (gt) sel[og + rg] = s;
            if (eq && oe + re < need) sel[n_gt + oe + re] = s;
            base_gt += tg; base_eq += te;
            __syncthreads();
        }
    }
}

constexpr int P3_HIST = 0, P3_H2 = 65536, P3_BM = 98304, P3_QS = 114688, P3_FLAG = P3_QS + 512, P3_CAP = 512;
__device__ __forceinline__ void find_bin_2048(LAS const unsigned* hist, unsigned need, int lane, unsigned& bin_out, unsigned& need_out, unsigned& cnt_out, bool& ok) {
    unsigned w[16]; unsigned tot = 0u;
#pragma unroll
    for (int i = 0; i < 16; ++i) { w[i] = hist[16 * lane + i]; tot += (w[i] & 0xffffu) + (w[i] >> 16); }
    unsigned incl = tot;
#pragma unroll
    for (int o = 1; o < 64; o <<= 1) { const unsigned v = __shfl_down(incl, o); if (lane + o < 64) incl += v; }
    const unsigned above = incl - tot;
    const bool mine = (above < need) && (need <= above + tot);
    unsigned a = above, fb = 0u, fn = 0u, fc = 0u; bool found = false;
#pragma unroll
    for (int i = 15; i >= 0; --i) {
        const unsigned h1 = w[i] >> 16, h0 = w[i] & 0xffffu;
        if (!found) { if (a + h1 >= need) { found = true; fb = 32u * lane + 2u * i + 1u; fn = need - a; fc = h1; } else a += h1; }
        if (!found) { if (a + h0 >= need) { found = true; fb = 32u * lane + 2u * i; fn = need - a; fc = h0; } else a += h0; }
    }
    const unsigned long long bm = __ballot(mine);
    ok = (bm != 0ull);
    const int src = ok ? (__ffsll((long long)bm) - 1) : 0;
    bin_out = (unsigned)__builtin_amdgcn_readlane((int)fb, src); need_out = (unsigned)__builtin_amdgcn_readlane((int)fn, src); cnt_out = (unsigned)__builtin_amdgcn_readlane((int)fc, src);
}
__device__ __forceinline__ unsigned bin11(float sc) { const unsigned u = __float_as_uint(sc); const int m = (int)((u & 0x7fffffffu) >> 17) - 7360; const unsigned mc = (unsigned)(m < 0 ? 0 : (m > 1023 ? 1023 : m)); return (u >> 31) ? (1023u - mc) : (1024u + mc); }
__device__ __forceinline__ float relu_i(float x) { const int xi = __builtin_bit_cast(int, x); const int ri = (xi < 0) ? 0 : xi; return __builtin_bit_cast(float, ri); }
#define RELU(x) relu_i(x)
template <int PASS> __device__ __forceinline__ void p3_score_pass(const bf16x8 (&af)[2][4], const float (&wv)[2][16], const bf16* kib, int t0, int nt, int wave, int n, int hi,
                                                                  LAS unsigned char* lds, const unsigned (&thr)[2][2], int rot) {
    LAS unsigned* HIST = (LAS unsigned*)(lds + P3_HIST); LAS unsigned* BM = (LAS unsigned*)(lds + P3_BM); LAS unsigned* QS = (LAS unsigned*)(lds + P3_QS);
    const int kmax = t0 + 15;
    bf16x8 bc[4], bn[4];
    const int qh = 8 * (wave >> 2), w4 = wave & 3;
    const int cnt4 = (nt - w4 + 3) >> 2; const int r0 = rot % cnt4;
    bf16x8 bq[4][4];
#define P3_LOADB(u, j) do { int jj_ = r0 + (j); jj_ = (jj_ >= cnt4) ? jj_ - cnt4 : jj_; const int t_ = w4 + 4 * jj_; \
        const bf16* kp_ = kib + ((size_t)t_ * 8 + hi) * 256 + n * 8; _Pragma("unroll") for (int s = 0; s < 4; ++s) bq[u][s] = *(const bf16x8*)(kp_ + s * 512); } while (0)
#pragma unroll
    for (int u = 0; u < 4; ++u) P3_LOADB(u, (u < cnt4) ? u : 0);
    for (int i0 = 0; i0 < cnt4; i0 += 4) {
#pragma unroll
        for (int u = 0; u < 4; ++u) {
            if (i0 + u < cnt4) {
                int jj = r0 + i0 + u; jj = (jj >= cnt4) ? jj - cnt4 : jj; const int tile = w4 + 4 * jj;
                const int key = 32 * tile + n; const bool full = (32 * tile + 31 <= t0);
                f32x16 acc0, acc1;
#pragma unroll
                for (int r = 0; r < 16; ++r) { acc0[r] = 0.f; acc1[r] = 0.f; }
#pragma unroll
                for (int s = 0; s < 4; ++s) acc0 = __builtin_amdgcn_mfma_f32_32x32x16_bf16(af[0][s], bq[u][s], acc0, 0, 0, 0);
#pragma unroll
                for (int s = 0; s < 4; ++s) acc1 = __builtin_amdgcn_mfma_f32_32x32x16_bf16(af[1][s], bq[u][s], acc1, 0, 0, 0);
                float sc4[4] = {0.f, 0.f, 0.f, 0.f};
#pragma unroll
                for (int r = 0; r < 8; ++r) { sc4[0] = __builtin_fmaf(wv[0][r], RELU(acc0[r]), sc4[0]); sc4[1] = __builtin_fmaf(wv[0][8 + r], RELU(acc0[8 + r]), sc4[1]); }
#pragma unroll
                for (int r = 0; r < 8; ++r) { sc4[2] = __builtin_fmaf(wv[1][r], RELU(acc1[r]), sc4[2]); sc4[3] = __builtin_fmaf(wv[1][8 + r], RELU(acc1[8 + r]), sc4[3]); }
#pragma unroll
                for (int e = 0; e < 4; ++e) {
                    const int mt = e >> 1, j = e & 1; const int q = qh + 4 * mt + hi + 2 * j; const bool valid = full || (key <= t0 + q);
                    const float scz = sc4[e] + 0.0f; const unsigned bin = bin11(scz);
                    if (PASS == 1) { if (valid) __hip_atomic_fetch_add(&HIST[q * 1024 + (bin >> 1)], 1u << (16 * (bin & 1u)), __ATOMIC_RELAXED, __HIP_MEMORY_SCOPE_WORKGROUP); }
                    else {
                        if (valid && bin > thr[mt][j]) { __hip_atomic_fetch_or(&BM[q * 256 + (key >> 5)], 1u << (key & 31), __ATOMIC_RELAXED, __HIP_MEMORY_SCOPE_WORKGROUP); }
                        else if (valid && bin == thr[mt][j]) { const unsigned pos = __hip_atomic_fetch_add(&QS[q * 8 + 3], 1u, __ATOMIC_RELAXED, __HIP_MEMORY_SCOPE_WORKGROUP);
                            if (pos < (unsigned)P3_CAP) { HIST[q * 1024 + 2 * pos] = f2key(scz); HIST[q * 1024 + 2 * pos + 1] = (unsigned)key; } }
                    }
                }
            }
            { const int jn = (i0 + u + 4 < cnt4) ? (i0 + u + 4) : (cnt4 - 1); P3_LOADB(u, jn); }
        }
    }
#undef P3_LOADB
}
__device__ __forceinline__ void p3_index(Frame& F) {
    unsigned char* ws = F.ws; const int tid = F.tid, lane = F.lane, wave = F.wave, n = lane & 31, hi = lane >> 5;
    const bf16* QIF = (const bf16*)(ws + WS_QIF); const bf16* KIF = (const bf16*)(ws + WS_KIF); const float* WIF = (const float*)(ws + WS_WIF); int* SEL = (int*)(ws + WS_SEL);
    LAS unsigned char* lds = F.lds;
    LAS unsigned* HIST = (LAS unsigned*)(lds + P3_HIST); LAS unsigned* H2 = (LAS unsigned*)(lds + P3_H2 + wave * 4096); LAS unsigned* BM = (LAS unsigned*)(lds + P3_BM); LAS unsigned* QS = (LAS unsigned*)(lds + P3_QS);
    LAS unsigned* FLAG = (LAS unsigned*)(lds + P3_FLAG); LAS unsigned* FBL = (LAS unsigned*)(lds + P3_QS + 1024);
    if (tid == 0) FBL[0] = 0u;
    __syncthreads();
    for (int ps = F.bid; ps < 512; ps += F.G) {
        const int b = ps >> 8, wq = ps & 255;
#pragma unroll 1
        for (int half = 0; half < 2; ++half) {
            const int idx = half ? (511 - wq) : wq; const int t0 = 16 * idx, row0 = (b << 13) + t0;
            if (idx < 16) {
                for (int e = tid; e < 16 * TOPK; e += 512) { const int q = e >> 8, i = e & 255; SEL[(size_t)(row0 + q) * TOPK + i] = (i <= t0 + q) ? i : 0; }
                continue;
            }
            for (int e = tid; e < 16384; e += 512) HIST[e] = 0u;
            for (int e = tid; e < 4096; e += 512) BM[e] = 0u;
            if (tid < 132) QS[tid] = 0u;
            bf16x8 af[2][4]; float wv[2][16]; const int qh = 8 * (wave >> 2);
            { const int head = (n & 3) + 4 * ((n >> 3) & 1), q4 = ((n >> 2) & 1) + 2 * (n >> 4);
#pragma unroll
              for (int mt = 0; mt < 2; ++mt) { const bf16* ap = QIF + (size_t)(row0 + qh + 4 * mt + q4) * 512 + head * IDX + 32 * hi;
#pragma unroll
                  for (int s = 0; s < 4; ++s) af[mt][s] = *(const bf16x8*)(ap + 8 * s);
#pragma unroll
                  for (int r = 0; r < 16; ++r) wv[mt][r] = WIF[(size_t)(row0 + qh + 4 * mt + hi + 2 * (r >> 3)) * 8 + (r & 7)]; } }
            const int nt = (t0 + 16 + 31) >> 5; const bf16* kib = KIF + (size_t)(b << 13) * IDX;
            unsigned thr[2][2] = {{0u, 0u}, {0u, 0u}};
            __syncthreads();
            p3_score_pass<1>(af, wv, kib, t0, nt, wave, n, hi, lds, thr, F.bid * 5);
            __syncthreads();
#pragma unroll 1
            for (int qq = 0; qq < 2; ++qq) { const int q = 2 * wave + qq; unsigned bin, need, cnt; bool ok;
                find_bin_2048(HIST + q * 1024, (unsigned)TOPK, lane, bin, need, cnt, ok);
                if (lane == 0) { const bool defer = !ok || cnt > (unsigned)P3_CAP; QS[q * 8 + 0] = defer ? 4096u : bin; QS[q * 8 + 1] = need; QS[q * 8 + 2] = cnt; QS[q * 8 + 4] = defer ? 1u : 0u;
                    if (defer) { const unsigned k = __hip_atomic_fetch_add(&FBL[0], 1u, __ATOMIC_RELAXED, __HIP_MEMORY_SCOPE_WORKGROUP); if (k < 63u) FBL[1 + k] = (unsigned)(row0 + q); } } }
            __syncthreads();
#pragma unroll
            for (int mt = 0; mt < 2; ++mt)
#pragma unroll
                for (int j = 0; j < 2; ++j) thr[mt][j] = QS[(qh + 4 * mt + hi + 2 * j) * 8];
            __syncthreads();
            p3_score_pass<2>(af, wv, kib, t0, nt, wave, n, hi, lds, thr, F.bid * 5 + 3);
            __syncthreads();
#pragma unroll 1
            for (int qq = 0; qq < 2; ++qq) {
                const int q = 2 * wave + qq; LAS unsigned* cand = HIST + q * 1024; LAS unsigned* bmq = BM + q * 256;
                const unsigned needA = QS[q * 8 + 1], c = QS[q * 8 + 2];
                if (QS[q * 8 + 4] != 0u) continue;
                for (unsigned i0 = 0; i0 < c; i0 += 64) { const unsigned i = i0 + lane; const bool in = i < c; const unsigned k32 = in ? cand[2 * i] : 0u, ki = in ? (cand[2 * i + 1] & 8191u) : 0u; unsigned rank = 0u;
                    for (unsigned j = 0; j < c; ++j) { const unsigned kj = cand[2 * j], ij = cand[2 * j + 1]; rank += (kj > k32 || (kj == k32 && ij < ki)) ? 1u : 0u; }
                    if (in && rank < needA) __hip_atomic_fetch_or(&bmq[ki >> 5], 1u << (ki & 31), __ATOMIC_RELAXED, __HIP_MEMORY_SCOPE_WORKGROUP); }
                WAVE_SYNC();
                unsigned w0 = bmq[4 * lane], w1 = bmq[4 * lane + 1], w2 = bmq[4 * lane + 2], w3 = bmq[4 * lane + 3];
                const unsigned mycnt = __popc(w0) + __popc(w1) + __popc(w2) + __popc(w3);
                unsigned incl = mycnt;
#pragma unroll
                for (int o = 1; o < 64; o <<= 1) { const unsigned v = __shfl_up(incl, o); if (lane >= o) incl += v; }
                unsigned pos = incl - mycnt; int* sel = SEL + (size_t)(row0 + q) * TOPK;
#pragma unroll
                for (int wi = 0; wi < 4; ++wi) { unsigned w = (wi == 0) ? w0 : (wi == 1) ? w1 : (wi == 2) ? w2 : w3;
                    while (w) { const int bit = __ffs((int)w) - 1; if (pos < (unsigned)TOPK) sel[pos] = 128 * lane + 32 * wi + bit; ++pos; w &= w - 1u; } }
            }
            __syncthreads();
        }
    }
    __syncthreads();
    const unsigned nfb = FBL[0];
    for (unsigned k = 0; k < nfb && k < 63u; ++k) { const int r0 = (int)FBL[1 + k]; __syncthreads(); p3_query_naive(ws, lds, r0, SEL); }
}

__device__ __forceinline__ void p4_dsa_naive(Frame& F) {
    unsigned char* ws = F.ws; const int lane = F.lane;
    const bf16* QF = (const bf16*)(ws + WS_QF); const bf16* KVF = (const bf16*)(ws + WS_KVF); const int* SEL = (const int*)(ws + WS_SEL); bf16* AO = (bf16*)(ws + WS_AO);
    LAS f32x4* sc = (LAS f32x4*)(F.lds + F.wave * 4096);
    const int gw = F.wave * F.G + F.bid, NGW = F.G * NWAVES;
    for (int p = gw; p < 2 * M; p += NGW) {
        const int row = p >> 1, kvh = p & 1, b = row >> 13, t = row & (SEQ - 1); const int cnt = (t + 1 < TOPK) ? (t + 1) : TOPK;
        const int* sel = SEL + (size_t)row * TOPK;
        int myidx[4];
#pragma unroll
        for (int j = 0; j < 4; ++j) myidx[j] = sel[lane + 64 * j];
        float qa[4], qb[4];
#pragma unroll
        for (int g = 0; g < 4; ++g) { const unsigned w = *(const unsigned*)(QF + (size_t)row * D + (kvh * 4 + g) * HD + 2 * lane); qa[g] = bflo(w); qb[g] = bfhi(w); }
        const bf16* kvb = KVF + (size_t)(b * NKV + kvh) * SEQ * 256 + 2 * lane;
#pragma unroll
        for (int j = 0; j < 4; ++j) {
            const int lim = cnt - 64 * j < 64 ? cnt - 64 * j : 64;
            for (int i = 0; i < lim; ++i) {
                const int key = __builtin_amdgcn_readlane(myidx[j], i);
                const unsigned w = *(const unsigned*)(kvb + (size_t)key * 256); const float k0 = bflo(w), k1 = bfhi(w);
                f32x4 d;
                d[0] = wave_sum(qa[0] * k0 + qb[0] * k1); d[1] = wave_sum(qa[1] * k0 + qb[1] * k1); d[2] = wave_sum(qa[2] * k0 + qb[2] * k1); d[3] = wave_sum(qa[3] * k0 + qb[3] * k1);
                if (lane == 0) sc[64 * j + i] = d;
            }
        }
        float mx[4] = {-INFINITY, -INFINITY, -INFINITY, -INFINITY};
#pragma unroll
        for (int j = 0; j < 4; ++j) { const int pp = lane + 64 * j; if (pp < cnt) { const f32x4 v = sc[pp];
#pragma unroll
            for (int g = 0; g < 4; ++g) mx[g] = fmaxf(mx[g], v[g]); } }
#pragma unroll
        for (int g = 0; g < 4; ++g) mx[g] = wave_max(mx[g]);
        float sm[4] = {0.f, 0.f, 0.f, 0.f};
#pragma unroll
        for (int j = 0; j < 4; ++j) { const int pp = lane + 64 * j; if (pp < cnt) { f32x4 v = sc[pp];
#pragma unroll
            for (int g = 0; g < 4; ++g) { v[g] = __builtin_amdgcn_exp2f(v[g] - mx[g]); sm[g] += v[g]; }
            sc[pp] = v; } }
#pragma unroll
        for (int g = 0; g < 4; ++g) sm[g] = 1.0f / wave_sum(sm[g]);
        float oa[4] = {0.f, 0.f, 0.f, 0.f}, ob[4] = {0.f, 0.f, 0.f, 0.f};
#pragma unroll
        for (int j = 0; j < 4; ++j) {
            const int lim = cnt - 64 * j < 64 ? cnt - 64 * j : 64;
            for (int i = 0; i < lim; ++i) {
                const int key = __builtin_amdgcn_readlane(myidx[j], i);
                const unsigned w = *(const unsigned*)(kvb + (size_t)key * 256 + 128); const float v0 = bflo(w), v1 = bfhi(w);
                const f32x4 pr = sc[64 * j + i];
#pragma unroll
                for (int g = 0; g < 4; ++g) { oa[g] += pr[g] * v0; ob[g] += pr[g] * v1; }
            }
        }
#pragma unroll
        for (int g = 0; g < 4; ++g) *(unsigned*)(AO + (size_t)row * D + (kvh * 4 + g) * HD + 2 * lane) = pk2(oa[g] * sm[g], ob[g] * sm[g]);
    }
}

typedef short v4i16_t __attribute__((ext_vector_type(4)));
typedef int v4i __attribute__((ext_vector_type(4)));
__device__ __forceinline__ v4i16_t tr16(LAS unsigned char* p) { return __builtin_amdgcn_ds_read_tr16_b64_v4i16((LAS v4i16_t*)p); }
typedef __bf16 bf16x2_t __attribute__((ext_vector_type(2)));
__device__ __forceinline__ unsigned dq2(unsigned w, bool hi) { return __builtin_bit_cast(unsigned, hi ? __builtin_amdgcn_cvt_scalef32_pk_bf16_fp8(w, 1.0f, true) : __builtin_amdgcn_cvt_scalef32_pk_bf16_fp8(w, 1.0f, false)); }
__device__ __forceinline__ bf16x8 dq8(unsigned w0, unsigned w1) { return __builtin_bit_cast(bf16x8, (v4u){dq2(w0, false), dq2(w0, true), dq2(w1, false), dq2(w1, true)}); }
__device__ __forceinline__ void p4_dsa(Frame& F) {
    unsigned char* ws = F.ws; const int lane = F.lane, nh = lane & 15, kg = lane >> 4;
    const bf16* QF = (const bf16*)(ws + WS_QF); const unsigned char* KV8 = (const unsigned char*)(ws + WS_KVF); const int* SEL = (const int*)(ws + WS_SEL); bf16* AO = (bf16*)(ws + WS_AO);
    LAS unsigned char* wl = F.lds + F.wave * 10240; LAS int* selw = (LAS int*)wl; LAS unsigned char* vb = wl + 1024;
    const int gw = F.wave * F.G + F.bid, NGW = F.G * NWAVES;
    LAS unsigned char* trp = vb + (4 * kg + ((lane >> 2) & 3)) * 288 + 8 * (lane & 3);
#pragma unroll 1
    for (int combo = 0; combo < BATCH * NKV; ++combo) {
        const int b = combo >> 1, kvh = combo & 1;
        const unsigned char* kvb = KV8 + (size_t)(b * NKV + kvh) * SEQ * 256;
#pragma unroll 1
        for (int t = gw; t < SEQ; t += NGW) {
            const int row = (b << 13) + t; const int cnt = (t + 1 < TOPK) ? (t + 1) : TOPK;
            *(LAS v4i*)(selw + 4 * lane) = *(const v4i*)(SEL + (size_t)row * TOPK + 4 * lane);
            WAVE_SYNC();
            const bf16* qp = QF + (size_t)row * D + (kvh * 4 + (nh & 3)) * HD + 32 * kg;
            bf16x8 qf[4];
#pragma unroll
            for (int s = 0; s < 4; ++s) { qf[s] = *(const bf16x8*)(qp + 8 * s); if (nh >= 4) qf[s] = (bf16x8){0, 0, 0, 0, 0, 0, 0, 0}; }
            f32x4 S[16];
            v4u kq[2][4][2];
#define P4_LOADK(buf, batch) do { _Pragma("unroll") for (int tt = 0; tt < 4; ++tt) { const unsigned char* kp_ = kvb + (size_t)(selw[16 * (4 * (batch) + tt) + nh] & (SEQ - 1)) * 256 + 32 * kg; \
                kq[buf][tt][0] = *(const v4u*)(kp_); kq[buf][tt][1] = *(const v4u*)(kp_ + 16); } } while (0)
            P4_LOADK(0, 0);
#pragma unroll
            for (int bt = 0; bt < 4; ++bt) {
                if (bt < 3) P4_LOADK((bt + 1) & 1, bt + 1);
                asm volatile("" ::: "memory");
#pragma unroll
                for (int tt = 0; tt < 4; ++tt) {
                    const v4u k0 = kq[bt & 1][tt][0], k1 = kq[bt & 1][tt][1];
                    f32x4 a = (f32x4){0.f, 0.f, 0.f, 0.f};
                    a = __builtin_amdgcn_mfma_f32_16x16x32_bf16(dq8(k0.x, k0.y), qf[0], a, 0, 0, 0); a = __builtin_amdgcn_mfma_f32_16x16x32_bf16(dq8(k0.z, k0.w), qf[1], a, 0, 0, 0);
                    a = __builtin_amdgcn_mfma_f32_16x16x32_bf16(dq8(k1.x, k1.y), qf[2], a, 0, 0, 0); a = __builtin_amdgcn_mfma_f32_16x16x32_bf16(dq8(k1.z, k1.w), qf[3], a, 0, 0, 0);
                    S[4 * bt + tt] = a;
                }
            }
#undef P4_LOADK
            float mx = -INFINITY;
#pragma unroll
            for (int T = 0; T < 16; ++T)
#pragma unroll
                for (int r = 0; r < 4; ++r) { const float v = (16 * T + 4 * kg + r < cnt) ? S[T][r] : -INFINITY; S[T][r] = v; mx = fmaxf(mx, v); }
            mx = fmaxf(mx, __shfl_xor(mx, 16)); mx = fmaxf(mx, __shfl_xor(mx, 32));
            float sum = 0.f;
#pragma unroll
            for (int T = 0; T < 16; ++T)
#pragma unroll
                for (int r = 0; r < 4; ++r) { const float e = __builtin_amdgcn_exp2f(S[T][r] - mx); S[T][r] = e; sum += e; }
            sum += __shfl_xor(sum, 16); sum += __shfl_xor(sum, 32);
            bf16x8 pa[8];
#pragma unroll
            for (int c = 0; c < 8; ++c) { v4u pw; pw.x = pg8::cvt_pk_bf16(S[2 * c][0], S[2 * c][1]); pw.y = pg8::cvt_pk_bf16(S[2 * c][2], S[2 * c][3]); pw.z = pg8::cvt_pk_bf16(S[2 * c + 1][0], S[2 * c + 1][1]); pw.w = pg8::cvt_pk_bf16(S[2 * c + 1][2], S[2 * c + 1][3]); pa[c] = __builtin_bit_cast(bf16x8, pw); }
            f32x4 O[8];
#pragma unroll
            for (int d = 0; d < 8; ++d) O[d] = (f32x4){0.f, 0.f, 0.f, 0.f};
            v4u g[3][4];
#define P4_LOADV(buf, c_) do { _Pragma("unroll") for (int i = 0; i < 4; ++i) { const int key_ = selw[32 * (c_) + (lane >> 3) + 8 * i] & (SEQ - 1); g[buf][i] = *(const v4u*)(kvb + (size_t)key_ * 256 + 128 + 16 * (lane & 7)); } } while (0)
            P4_LOADV(0, 0); P4_LOADV(1, 1); P4_LOADV(2, 2);
#pragma unroll
            for (int c = 0; c < 8; ++c) {
#pragma unroll
                for (int i = 0; i < 4; ++i) { const v4u gg = g[c % 3][i]; LAS unsigned char* dst = vb + ((lane >> 3) + 8 * i) * 288 + 32 * (lane & 7);
                    *(LAS v4u*)dst = __builtin_bit_cast(v4u, dq8(gg.x, gg.y)); *(LAS v4u*)(dst + 16) = __builtin_bit_cast(v4u, dq8(gg.z, gg.w)); }
                asm volatile("" ::: "memory");
                if (c < 5) P4_LOADV(c % 3, c + 3);
#pragma unroll
                for (int d = 0; d < 8; ++d) {
                    const v4i16_t lo = tr16(trp + 32 * d), hi4 = tr16(trp + 16 * 288 + 32 * d);
                    const bf16x8 vfr = (bf16x8){lo[0], lo[1], lo[2], lo[3], hi4[0], hi4[1], hi4[2], hi4[3]};
                    O[d] = __builtin_amdgcn_mfma_f32_16x16x32_bf16(pa[c], vfr, O[d], 0, 0, 0);
                }
            }
#undef P4_LOADV
            const float i0 = 1.0f / __builtin_bit_cast(float, __builtin_amdgcn_readlane(__builtin_bit_cast(int, sum), 0)), i1 = 1.0f / __builtin_bit_cast(float, __builtin_amdgcn_readlane(__builtin_bit_cast(int, sum), 1));
            const float i2 = 1.0f / __builtin_bit_cast(float, __builtin_amdgcn_readlane(__builtin_bit_cast(int, sum), 2)), i3 = 1.0f / __builtin_bit_cast(float, __builtin_amdgcn_readlane(__builtin_bit_cast(int, sum), 3));
            LAS bf16* ost = (LAS bf16*)vb;
            if (kg == 0) {
#pragma unroll
                for (int d = 0; d < 8; ++d) { ost[0 * 128 + 16 * d + nh] = (bf16)f2bf(O[d][0] * i0); ost[1 * 128 + 16 * d + nh] = (bf16)f2bf(O[d][1] * i1); ost[2 * 128 + 16 * d + nh] = (bf16)f2bf(O[d][2] * i2); ost[3 * 128 + 16 * d + nh] = (bf16)f2bf(O[d][3] * i3); }
            }
            WAVE_SYNC();
            const v4u ov = *(LAS v4u*)(vb + 16 * lane);
            *(v4u*)(AO + (size_t)row * D + (kvh * 4 + kg) * HD + 8 * nh) = ov;
            WAVE_SYNC();
        }
    }
}

__device__ __forceinline__ void p9_sb(Frame& F) {
    unsigned char* ws = F.ws; const int lane = F.lane, n = lane & 31, hi = lane >> 5;
    const bf16* KQ = (const bf16*)(ws + WS_KQ); const bf16* VT = (const bf16*)(ws + WS_VT); bf16* AO = (bf16*)(ws + WS_AO);
    const int gw = F.wave * F.G + F.bid, NGW = F.G * NWAVES;
    const int koff = 16 * (n >> 4) + 8 * ((n >> 2) & 1) + 4 * ((n >> 3) & 1) + (n & 3);
    constexpr float LOG2E = 1.4426950408889634f, LN2 = 0.6931471805599453f;
    for (int u = gw; u < (M / 32) * NH; u += NGW) {
        const int h = u & 7, blk = u >> 3, b = blk >> 8, qb = blk & 255, q0 = 32 * qb, t = q0 + n;
        const bf16* qp = KQ + (size_t)(b * SEQ + q0 + n) * 2048 + 1024 + h * HD + 64 * hi;
        bf16x8 qf[8];
#pragma unroll
        for (int s = 0; s < 8; ++s) qf[s] = *(const bf16x8*)(qp + 8 * s);
        f32x16 o[4];
#pragma unroll
        for (int mt = 0; mt < 4; ++mt)
#pragma unroll
            for (int r = 0; r < 16; ++r) o[mt][r] = 0.f;
        float C = 0.f;
        bf16x8 kf[8];
        { const bf16* kp = KQ + (size_t)(b * SEQ + 32 * qb + koff) * 2048 + h * HD + 64 * hi;
#pragma unroll
          for (int s = 0; s < 8; ++s) kf[s] = *(const bf16x8*)(kp + 8 * s); }
        for (int kb = qb; kb >= 0; --kb) {
            const int k0 = 32 * kb;
            bf16x8 vf[4][2];
#pragma unroll
            for (int mt = 0; mt < 4; ++mt)
#pragma unroll
                for (int sp = 0; sp < 2; ++sp) vf[mt][sp] = *(const bf16x8*)(VT + (size_t)(h * HD + 32 * mt + n) * M + b * SEQ + k0 + 16 * sp + 8 * hi);
            f32x16 z;
#pragma unroll
            for (int r = 0; r < 16; ++r) z[r] = 0.f;
#pragma unroll
            for (int s = 0; s < 8; ++s) z = __builtin_amdgcn_mfma_f32_32x32x16_bf16(kf[s], qf[s], z, 0, 0, 0);
            { const int kn = (kb > 0) ? kb - 1 : 0; const bf16* kp = KQ + (size_t)(b * SEQ + 32 * kn + koff) * 2048 + h * HD + 64 * hi;
#pragma unroll
              for (int s = 0; s < 8; ++s) kf[s] = *(const bf16x8*)(kp + 8 * s); }
            float lk[16], lb[16];
#pragma unroll
            for (int r = 0; r < 16; ++r) {
                const int key = k0 + ((r < 8) ? (8 * hi + r) : (16 + 8 * hi + (r - 8)));
                const float zz = z[r]; const float L = __builtin_amdgcn_logf(1.0f + __builtin_amdgcn_exp2f(-fabsf(zz) * LOG2E)) * LN2;
                const bool valid = key < t;
                lk[r] = valid ? (-fmaxf(zz, 0.f) - L) : 0.f;
                lb[r] = valid ? (fminf(zz, 0.f) - L) : -INFINITY;
            }
            float suf[16];
            suf[7] = 0.f; suf[15] = 0.f;
#pragma unroll
            for (int i = 6; i >= 0; --i) { suf[i] = suf[i + 1] + lk[i + 1]; suf[8 + i] = suf[9 + i] + lk[9 + i]; }
            const float T0 = suf[0] + lk[0], T1 = suf[8] + lk[8];
            const float P0 = __shfl_xor(T0, 32), P1 = __shfl_xor(T1, 32);
            const float base1 = C + (hi ? 0.f : P1), base0 = C + (hi ? (T1 + P1) : (P0 + T1 + P1));
            unsigned pw[8];
#pragma unroll
            for (int r = 0; r < 16; r += 2) {
                const float a0 = __builtin_amdgcn_exp2f((lb[r] + ((r < 8) ? base0 : base1) + suf[r]) * LOG2E), a1 = __builtin_amdgcn_exp2f((lb[r + 1] + ((r < 8) ? base0 : base1) + suf[r + 1]) * LOG2E);
                pw[r >> 1] = pg8::cvt_pk_bf16(a0, a1);
            }
            C += (T0 + T1) + (P0 + P1);
            const bf16x8 pa0 = __builtin_bit_cast(bf16x8, (v4u){pw[0], pw[1], pw[2], pw[3]}), pa1 = __builtin_bit_cast(bf16x8, (v4u){pw[4], pw[5], pw[6], pw[7]});
#pragma unroll
            for (int mt = 0; mt < 4; ++mt) { o[mt] = __builtin_amdgcn_mfma_f32_32x32x16_bf16(vf[mt][0], pa0, o[mt], 0, 0, 0); o[mt] = __builtin_amdgcn_mfma_f32_32x32x16_bf16(vf[mt][1], pa1, o[mt], 0, 0, 0); }
            if (__all(C < -44.0f)) break;
        }
        bf16* op = AO + (size_t)(b * SEQ + q0 + n) * D + h * HD + 4 * hi;
#pragma unroll
        for (int mt = 0; mt < 4; ++mt)
#pragma unroll
            for (int g = 0; g < 4; ++g) { v2u w; w.x = pg8::cvt_pk_bf16(o[mt][4 * g], o[mt][4 * g + 1]); w.y = pg8::cvt_pk_bf16(o[mt][4 * g + 2], o[mt][4 * g + 3]); *(v2u*)(op + 32 * mt + 8 * g) = w; }
    }
}

__device__ __forceinline__ void p11_router(Frame& F) {
    unsigned char* ws = F.ws; const int tid = F.tid, lane = F.lane, wave = F.wave;
    const float* H = (const float*)(ws + WS_H); const float* gn = F.in[IN_FFNNORM] + D; const float* Wr = F.in[IN_ROUTER];
    int* TOPE = (int*)(ws + WS_RT); int* POS = (int*)(ws + WS_RT + 128 * 1024); float* GATE = (float*)(ws + WS_RT + 256 * 1024); float* RSTD3 = (float*)(ws + WS_RT + 384 * 1024);
    LAS unsigned* lcnt = (LAS unsigned*)F.lds;
    LAS unsigned* gb = (LAS unsigned*)(F.lds + 64);
    LAS int* ltok = (LAS int*)(F.lds + 128);
    LAS float* lgt = (LAS float*)(F.lds + 128 + 1024);
    for (int chunk = F.bid; chunk < M / 64; chunk += F.G) {
        if (tid < 8) lcnt[tid] = 0u;
        __syncthreads();
        for (int r = 0; r < 8; ++r) {
            const int row = chunk * 64 + wave * 8 + r;
            const GAS f32x4* xr = (const GAS f32x4*)(H + (size_t)row * D) + lane; f32x4 v[4]; float ss = 0.f;
#pragma unroll
            for (int j = 0; j < 4; ++j) { v[j] = xr[64 * j]; ss += (v[j].x * v[j].x + v[j].y * v[j].y) + (v[j].z * v[j].z + v[j].w * v[j].w); }
            ss = wave_sum(ss); const float rs = 1.0f / sqrtf(ss * (1.0f / 1024.0f) + 1e-6f);
            float lg[8] = {0.f, 0.f, 0.f, 0.f, 0.f, 0.f, 0.f, 0.f};
#pragma unroll
            for (int j = 0; j < 4; ++j)
#pragma unroll
                for (int i = 0; i < 4; ++i) { const int k = 256 * j + 4 * lane + i; const float xv = v[j][i] * gn[k]; const f32x4 w0 = *(const f32x4*)(Wr + (size_t)k * 8), w1 = *(const f32x4*)(Wr + (size_t)k * 8 + 4);
                    lg[0] += xv * w0[0]; lg[1] += xv * w0[1]; lg[2] += xv * w0[2]; lg[3] += xv * w0[3]; lg[4] += xv * w1[0]; lg[5] += xv * w1[1]; lg[6] += xv * w1[2]; lg[7] += xv * w1[3]; }
#pragma unroll
            for (int e = 0; e < 8; ++e) lg[e] = wave_sum(lg[e]) * rs;
            int i1 = 0; float l1 = lg[0];
#pragma unroll
            for (int e = 1; e < 8; ++e) if (lg[e] > l1) { l1 = lg[e]; i1 = e; }
            int i2 = -1; float l2 = -INFINITY;
#pragma unroll
            for (int e = 0; e < 8; ++e) if (e != i1 && lg[e] > l2) { l2 = lg[e]; i2 = e; }
            const float g1 = 1.0f / (1.0f + __expf(l2 - l1)), g2 = 1.0f - g1;
            if (lane == 0) {
                const unsigned p1 = __hip_atomic_fetch_add(&lcnt[i1], 1u, __ATOMIC_RELAXED, __HIP_MEMORY_SCOPE_WORKGROUP), p2 = __hip_atomic_fetch_add(&lcnt[i2], 1u, __ATOMIC_RELAXED, __HIP_MEMORY_SCOPE_WORKGROUP);
                const int ti = wave * 8 + r; ltok[ti * 4 + 0] = i1; ltok[ti * 4 + 1] = i2; ltok[ti * 4 + 2] = (int)p1; ltok[ti * 4 + 3] = (int)p2;
                lgt[ti * 4 + 0] = g1; lgt[ti * 4 + 1] = g2; lgt[ti * 4 + 2] = rs;
            }
        }
        __syncthreads();
        if (tid < 8) gb[tid] = __hip_atomic_fetch_add(F.ctl + CW_CNT + tid, lcnt[tid], RLX_AGENT);
        __syncthreads();
        if (tid < 64) { const int row = chunk * 64 + tid; const int e1 = ltok[tid * 4], e2 = ltok[tid * 4 + 1];
            TOPE[row * 2] = e1; TOPE[row * 2 + 1] = e2; POS[row * 2] = (int)gb[e1] + ltok[tid * 4 + 2]; POS[row * 2 + 1] = (int)gb[e2] + ltok[tid * 4 + 3];
            GATE[row * 2] = lgt[tid * 4]; GATE[row * 2 + 1] = lgt[tid * 4 + 1]; RSTD3[row] = lgt[tid * 4 + 2]; }
        __syncthreads();
    }
}
__device__ __forceinline__ void moe_bases(Frame& F, int (&tb)[9]) {
    int acc = 0;
#pragma unroll
    for (int e = 0; e < 8; ++e) { tb[e] = acc; const unsigned c = __hip_atomic_load(F.ctl + CW_CNT + e, RLX_AGENT); acc += (int)((c + 255u) >> 8); }
    tb[8] = acc;
}
__device__ __forceinline__ void p12_permute(Frame& F) {
    unsigned char* ws = F.ws; const int lane = F.lane;
    const int* TOPE = (const int*)(ws + WS_RT); const int* POS = (const int*)(ws + WS_RT + 128 * 1024); const float* GATE = (const float*)(ws + WS_RT + 256 * 1024); const float* RSTD3 = (const float*)(ws + WS_RT + 384 * 1024);
    int* SLOT = (int*)(ws + WS_RT + 512 * 1024); float* RSTDS = (float*)(ws + WS_RSTDS); float* GATES = (float*)(ws + WS_GATES);
    const bf16* XB = (const bf16*)(ws + WS_XB); bf16* XP = (bf16*)(ws + WS_XPERM);
    int tb[9]; moe_bases(F, tb);
    const int gw = F.wave * F.G + F.bid, NGW = F.G * NWAVES;
    for (int i = gw; i < 2 * M; i += NGW) {
        const int row = i >> 1; const int e = TOPE[i]; int base = 0;
#pragma unroll
        for (int k = 0; k < 8; ++k) base = (e == k) ? tb[k] : base;
        const int slot = base * 256 + POS[i];
        const v4u* src = (const v4u*)(XB + (size_t)row * D) + lane; v4u* dst = (v4u*)(XP + (size_t)slot * D) + lane;
        const v4u a = src[0], c = src[64]; dst[0] = a; dst[64] = c;
        if (lane == 0) { SLOT[i] = slot; RSTDS[slot] = RSTD3[row]; GATES[slot] = GATE[i]; }
    }
}
__device__ __forceinline__ void p15_combine(Frame& F) {
    unsigned char* ws = F.ws; const int lane = F.lane;
    const float* H = (const float*)(ws + WS_H); const bf16* Y = (const bf16*)(ws + WS_Y); const int* SLOT = (const int*)(ws + WS_RT + 512 * 1024);
    const int gw = F.wave * F.G + F.bid, NGW = F.G * NWAVES;
    for (int row = gw; row < M; row += NGW) {
        const int s1 = SLOT[row * 2], s2 = SLOT[row * 2 + 1];
        const GAS f32x4* hr = (const GAS f32x4*)(H + (size_t)row * D) + lane; GAS f32x4* orow = (GAS f32x4*)(F.out + (size_t)row * D) + lane;
        const GAS v2u* y1 = (const GAS v2u*)(Y + (size_t)s1 * D) + lane; const GAS v2u* y2 = (const GAS v2u*)(Y + (size_t)s2 * D) + lane;
#pragma unroll
        for (int j = 0; j < 4; ++j) { const f32x4 h = hr[64 * j]; const v2u a = y1[64 * j], c = y2[64 * j]; f32x4 o;
            o.x = h.x + (bflo(a.x) + bflo(c.x)); o.y = h.y + (bfhi(a.x) + bfhi(c.x)); o.z = h.z + (bflo(a.y) + bflo(c.y)); o.w = h.w + (bfhi(a.y) + bfhi(c.y)); orow[64 * j] = o; }
    }
}

constexpr int N_PHASES = 16;
#ifndef MK_ONE_LAUNCH
#define MK_ONE_LAUNCH 1
#endif
struct Args { const float* in[17]; float* out; unsigned char* ws; int ph_lo, ph_hi; };
__global__ void __launch_bounds__(NWAVES * 64, 2) yoco_fwd(Args args) {
    extern __shared__ __attribute__((aligned(16))) unsigned char lds[];
    Frame F;
    F.lds = (LAS unsigned char*)lds; F.MISC = (volatile LAS unsigned*)(F.lds + MISC_OFF);
    F.tid = threadIdx.x; F.lane = F.tid & 63; F.wave = __builtin_amdgcn_readfirstlane(F.tid >> 6); F.G = gridDim.x; F.bid = blockIdx.x;
    F.ws = args.ws; F.ctl = (gu32*)(args.ws + WS_CTL); F.out = args.out;
#pragma unroll
    for (int i = 0; i < 17; ++i) F.in[i] = args.in[i];
    for (int u = F.tid; u < (LDS_BYTES - LDSCTL_OFF) / 4; u += NWAVES * 64) ((LAS unsigned*)(F.lds + LDSCTL_OFF))[u] = 0u;
    __syncthreads();
    unsigned char* ws = args.ws;
    XcdBarrier bar; bar.bar = (unsigned*)(F.ctl + CW_BAR); bar.x = 0; bar.st = nullptr;
    if (MK_ONE_LAUNCH) bar = xcd_barrier_post((unsigned*)(F.ctl + CW_BAR), F.MISC + 8);
    const int lo = args.ph_lo, hi = args.ph_hi;
#define IN(k) (lo <= (k) && (k) < hi)
#define SEAM(k) do { if (MK_ONE_LAUNCH && IN((k) + 1)) xcd_barrier(bar); } while (0)
    bf16* XB = (bf16*)(ws + WS_XB); float* H = (float*)(ws + WS_H); bf16* AO = (bf16*)(ws + WS_AO);

#ifndef PROBE_DUP
#define PROBE_DUP -1
#endif
#ifndef PROBE_T
#define PROBE_T -1
#endif
#ifndef PROBE_TMODE
#define PROBE_TMODE 0
#endif
#define PH_BEGIN(k) unsigned long long phb_ = 0; if (PROBE_T == (k)) phb_ = __builtin_amdgcn_s_memrealtime();
#define PH_END(k) if (PROBE_T == (k)) { __syncthreads(); if (F.tid == 0) { const unsigned d_ = (unsigned)(__builtin_amdgcn_s_memrealtime() - phb_); if (PROBE_TMODE == 0) __hip_atomic_fetch_max(F.ctl + 140, d_, RLX_AGENT); else if (PROBE_TMODE == 1) __hip_atomic_fetch_max(F.ctl + 141, 0xffffffffu - d_, RLX_AGENT); else if (F.bid == 0) __hip_atomic_store(F.ctl + 140, d_, RLX_AGENT); } }
    if (IN(0)) { PH_BEGIN(0) p0_prologue(F); if (PROBE_DUP == 0) p0_prologue(F); PH_END(0) SEAM(0); }
    if (IN(1)) { PH_BEGIN(1)
        pg8::Gemm g{XB, (const bf16*)(ws + WS_WIN), M, 2048, D}; pg8::StaticOrder S; S.init(M, 2048, F.G, F.bid);
        pg8::EpiScaleBf16 E{(bf16*)(ws + WS_PROJ), 2048, (const float*)(ws + WS_SS0)};
        pg8::gemm_phase<pg8::EpiScaleBf16, pg8::StaticOrder, true, true>(F.lds, g, S, E); PH_END(1) SEAM(1); }
    if (IN(2)) { PH_BEGIN(2) p2_post(F); if (PROBE_DUP == 2) p2_post(F); PH_END(2) SEAM(2); }
    if (IN(3)) { PH_BEGIN(3) p3_index(F); if (PROBE_DUP == 3) { __syncthreads(); p3_index(F); } PH_END(3) SEAM(3); }
    if (IN(4)) { PH_BEGIN(4) p4_dsa(F); if (PROBE_DUP == 4) p4_dsa(F); PH_END(4) SEAM(4); }
    if (IN(5)) { PH_BEGIN(5)
        pg8::Gemm g{AO, (const bf16*)(ws + WS_WOA), M, D, D}; pg8::StaticOrder S; S.init(M, D, F.G, F.bid);
        pg8::EpiResid E{F.in[IN_X], H, XB, (float*)(ws + WS_SS1)};
        pg8::gemm_phase<pg8::EpiResid, pg8::StaticOrder, true, true>(F.lds, g, S, E); PH_END(5) SEAM(5); }
    if (IN(6)) { PH_BEGIN(6)
        pg8::Gemm g{XB, (const bf16*)(ws + WS_WGU), M, 2 * FF, D}; pg8::StaticOrder S; S.init(M, 2 * FF, F.G, F.bid);
        pg8::EpiSwiGLU<false> E{(bf16*)(ws + WS_HF), FF, (const float*)(ws + WS_SS1)};
        pg8::gemm_phase<pg8::EpiSwiGLU<false>, pg8::StaticOrder, true, true>(F.lds, g, S, E); PH_END(6) SEAM(6); }
    if (IN(7)) { PH_BEGIN(7)
        pg8::Gemm g{(const bf16*)(ws + WS_HF), (const bf16*)(ws + WS_WD), M, D, FF}; pg8::StaticOrder S; S.init(M, D, F.G, F.bid);
        pg8::EpiResid E{H, H, XB, (float*)(ws + WS_SS2)};
        pg8::gemm_phase<pg8::EpiResid, pg8::StaticOrder, true, true>(F.lds, g, S, E); PH_END(7) SEAM(7); }
    if (IN(8)) { PH_BEGIN(8)
        { pg8::Gemm g{XB, (const bf16*)(ws + WS_WKVQ), M, 2048, D}; pg8::StaticOrder S; S.init(M, 2048, F.G, F.bid);
          pg8::EpiScaleBf16 E{(bf16*)(ws + WS_KQ), 2048, (const float*)(ws + WS_SS2)};
          pg8::gemm_phase<pg8::EpiScaleBf16, pg8::StaticOrder, true, true>(F.lds, g, S, E); }
        { pg8::Gemm g{(const bf16*)(ws + WS_WKVQ) + (size_t)2048 * D, XB, D, M, D}; pg8::StaticOrder S; S.init(D, M, F.G, F.bid);
          pg8::EpiScaleColBf16 E{(bf16*)(ws + WS_VT), M, (const float*)(ws + WS_SS2)};
          pg8::gemm_phase<pg8::EpiScaleColBf16, pg8::StaticOrder, true, true>(F.lds, g, S, E); }
        PH_END(8) SEAM(8); }
    if (IN(9)) { PH_BEGIN(9) p9_sb(F); if (PROBE_DUP == 9) p9_sb(F); PH_END(9) SEAM(9); }
    if (IN(10)) { PH_BEGIN(10)
        pg8::Gemm g{AO, (const bf16*)(ws + WS_WOB), M, D, D}; pg8::StaticOrder S; S.init(M, D, F.G, F.bid);
        pg8::EpiResid E{H, H, XB, (float*)(ws + WS_SS3)};
        pg8::gemm_phase<pg8::EpiResid, pg8::StaticOrder, true, true>(F.lds, g, S, E); PH_END(10) SEAM(10); }
    if (IN(11)) { PH_BEGIN(11) p11_router(F); PH_END(11) SEAM(11); }
    if (IN(12)) { PH_BEGIN(12) p12_permute(F); if (PROBE_DUP == 12) p12_permute(F); PH_END(12) SEAM(12); }
    if (IN(13)) { PH_BEGIN(13)
        pg8::MoeOrder S; moe_bases(F, S.tb); S.npn = 22; S.G = F.G; S.c = F.bid;
        pg8::Gemm g{(const bf16*)(ws + WS_XPERM), (const bf16*)(ws + WS_WGUM), MAXSLOT, NE * 2 * FF, D};
        pg8::EpiSwiGLU<true> E{(bf16*)(ws + WS_HM), FF, (const float*)(ws + WS_RSTDS)};
        pg8::gemm_phase<pg8::EpiSwiGLU<true>, pg8::MoeOrder, true, true>(F.lds, g, S, E); PH_END(13) SEAM(13); }
    if (IN(14)) { PH_BEGIN(14)
        pg8::MoeOrder S; moe_bases(F, S.tb); S.npn = 4; S.G = F.G; S.c = F.bid;
        pg8::Gemm g{(const bf16*)(ws + WS_HM), (const bf16*)(ws + WS_WDM), MAXSLOT, NE * D, FF};
        pg8::EpiGateBf16 E{(bf16*)(ws + WS_Y), (const float*)(ws + WS_GATES)};
        pg8::gemm_phase<pg8::EpiGateBf16, pg8::MoeOrder, true, true>(F.lds, g, S, E); PH_END(14) SEAM(14); }
    if (IN(15)) { PH_BEGIN(15) p15_combine(F); if (PROBE_DUP == 15) p15_combine(F); PH_END(15) }
    if (PROBE_T >= 0 && MK_ONE_LAUNCH) { if (PROBE_TMODE == 1 && F.bid == 0 && F.tid == 0) { } xcd_barrier(bar); if (F.bid == 0 && F.tid == 0) { unsigned d_ = __hip_atomic_load(F.ctl + (PROBE_TMODE == 1 ? 141 : 140), RLX_AGENT); if (PROBE_TMODE == 1) d_ = 0xffffffffu - d_; const unsigned long long t0_ = __builtin_amdgcn_s_memrealtime(); while (__builtin_amdgcn_s_memrealtime() - t0_ < (unsigned long long)d_) __builtin_amdgcn_s_sleep(8); } }
#undef IN
#undef SEAM
}

extern "C" void kernel_launch(void* const* d_in, const int* in_sizes, int n_in, void* d_out, int out_size, void* d_ws, size_t ws_size, hipStream_t stream) {
    static int grid = 0;
    if (grid == 0) {
        if (n_in != 17 || out_size != M * D || ws_size < WS_END) { fprintf(stderr, "kernel_launch: unexpected problem (n_in %d, out %d, ws %zu < %zu)\n", n_in, out_size, ws_size, (size_t)WS_END); grid = -1; return; }
        int dev = 0, cus = 0, per_cu = 0;
        if (hipGetDevice(&dev) != hipSuccess || hipDeviceGetAttribute(&cus, hipDeviceAttributeMultiprocessorCount, dev) != hipSuccess) { grid = -1; return; }
        if (hipFuncSetAttribute((const void*)yoco_fwd, hipFuncAttributeMaxDynamicSharedMemorySize, LDS_BYTES) != hipSuccess) { fprintf(stderr, "kernel_launch: hipFuncSetAttribute failed\n"); grid = -1; return; }
        if (hipOccupancyMaxActiveBlocksPerMultiprocessor(&per_cu, (const void*)yoco_fwd, NWAVES * 64, LDS_BYTES) != hipSuccess || per_cu < 1) fprintf(stderr, "kernel_launch: occupancy query says %d\n", per_cu);
        (void)hipGetLastError();
        grid = cus;
    }
    if (grid < 0) return;
    if (hipMemsetAsync((char*)d_ws + WS_CTL, 0, CTL_ZERO_BYTES, stream) != hipSuccess) return;
    Args a{};
    for (int i = 0; i < 17; ++i) a.in[i] = (const float*)d_in[i];
    a.out = (float*)d_out; a.ws = (unsigned char*)d_ws;
#if MK_ONE_LAUNCH
    a.ph_lo = 0; a.ph_hi = N_PHASES;
    hipLaunchKernelGGL(yoco_fwd, dim3(grid), dim3(NWAVES * 64), LDS_BYTES, stream, a);
#else
    for (int p = 0; p < N_PHASES; ++p) { a.ph_lo = p; a.ph_hi = p + 1; hipLaunchKernelGGL(yoco_fwd, dim3(grid), dim3(NWAVES * 64), LDS_BYTES, stream, a); }
#endif
}
```

```cpp
#include <hip/hip_runtime.h>
#include <cstdio>
#include <cstdint>
namespace pg8 {
#define PG8_LAS __attribute__((address_space(3)))
typedef unsigned short bf16_t;
typedef short bf16x8 __attribute__((ext_vector_type(8)));
typedef float f32x4 __attribute__((ext_vector_type(4)));
typedef unsigned u32x4 __attribute__((ext_vector_type(4)));
constexpr int BM = 256, BK = 64, HALF = 128, HTB = HALF * BK * 2  , STAGE_BYTES = 8 * HTB, NXCD = 8, WGM = 8;

__host__ __device__ __forceinline__ int lds_byte(int r, int c) { const int st = (r >> 4) * 2 + (c >> 5), rr = r & 15, cc = c & 31, ob = rr * 64 + cc * 2; return st * 1024 + (ob ^ (((ob >> 9) & 1) << 5)); }
__host__ __device__ __forceinline__ void stage_rc(int b, int& R, int& C) { const int st = b / 1024, sb = b % 1024, swz = sb ^ (((sb >> 9) & 1) << 5); R = (st >> 1) * 16 + swz / 64; C = (st & 1) * 32 + (swz % 64) / 2; }
__host__ __device__ __forceinline__ int perm32(int rho) { const int n = rho >> 4, i = rho & 15; return 8 * (i >> 2) + 4 * n + (i & 3); }

struct Unit { int pm, pn; int koff = 0; };
struct Gemm { const bf16_t* A; const bf16_t* Bt; int M, N, K; int ld = 0; };

struct StaticOrder {
    int nM, nN, nwg, G, c;
    __host__ __device__ void init(int M, int N, int G_, int c_) { nM = M / BM; nN = N / BM; nwg = nM * nN; G = G_; c = c_; }
    __host__ __device__ bool next(int i, Unit& u) const {
        const long L = (long)i * G + c; if (L >= nwg) return false;
        int wgid = (int)L; { const int q = nwg / NXCD, r = nwg % NXCD, xcd = wgid % NXCD, off = wgid / NXCD; wgid = (xcd < r ? xcd * (q + 1) : r * (q + 1) + (xcd - r) * q) + off; }
        const int nig = WGM * nN, gid = wgid / nig, fm = gid * WGM, gsz = (nM - fm) < WGM ? (nM - fm) : WGM;
        u.pm = fm + ((wgid % nig) % gsz); u.pn = (wgid % nig) / gsz; return true;
    }
    __device__ __forceinline__ void a_ready(const Unit&) const {}
    __device__ __forceinline__ void done(const Unit&) const {}
};

__device__ __forceinline__ unsigned cvt_pk_bf16(float lo, float hi) { unsigned r; asm volatile("v_cvt_pk_bf16_f32 %0, %1, %2" : "=v"(r) : "v"(lo), "v"(hi)); return r; }
typedef unsigned u32x2 __attribute__((ext_vector_type(2)));
constexpr float RMS_EPS = 1e-6f;
__device__ __forceinline__ float rstd16(const float* p) {
    const f32x4 a = *(const f32x4*)p, b = *(const f32x4*)(p + 4), c = *(const f32x4*)(p + 8), d = *(const f32x4*)(p + 12);
    const float s = (((a[0] + a[1]) + (a[2] + a[3])) + ((b[0] + b[1]) + (b[2] + b[3]))) + (((c[0] + c[1]) + (c[2] + c[3])) + ((d[0] + d[1]) + (d[2] + d[3])));
    return 1.0f / sqrtf(s * (1.0f / 1024.0f) + RMS_EPS);
}
struct EpiScaleBf16 {
    static constexpr bool PERM = true, AFTER_DRAIN = false;
    bf16_t* O; int ldc; const float* ss;
    __device__ __forceinline__ void operator()(const f32x4 (&acc)[2][2][4][2], const Unit& u, int wr, int wc, int fr, int fq) const {
        const int row0 = u.pm * BM + wr * 64 + fr, col0 = u.pn * BM + wc * 32 + 8 * fq;
        float rsv[2][4];
#pragma unroll
        for (int ai = 0; ai < 2; ++ai)
#pragma unroll
            for (int m = 0; m < 4; ++m) rsv[ai][m] = rstd16(ss + (size_t)(row0 + ai * HALF + m * 16) * 16);
#pragma unroll
        for (int ai = 0; ai < 2; ++ai)
#pragma unroll
            for (int m = 0; m < 4; ++m) { const int row = row0 + ai * HALF + m * 16; const float rs = rsv[ai][m]; bf16_t* rowp = O + (size_t)row * ldc + col0;
#pragma unroll
                for (int bj = 0; bj < 2; ++bj) { const f32x4 v0 = acc[ai][bj][m][0] * rs, v1 = acc[ai][bj][m][1] * rs;
                    u32x4 w; w.x = cvt_pk_bf16(v0[0], v0[1]); w.y = cvt_pk_bf16(v0[2], v0[3]); w.z = cvt_pk_bf16(v1[0], v1[1]); w.w = cvt_pk_bf16(v1[2], v1[3]);
                    *(u32x4*)(rowp + bj * HALF) = w; } }
    }
};
struct EpiPlainBf16 {
    static constexpr bool PERM = true, AFTER_DRAIN = false;
    bf16_t* O; int ldc; int pnmask;
    __device__ __forceinline__ void operator()(const f32x4 (&acc)[2][2][4][2], const Unit& u, int wr, int wc, int fr, int fq) const {
        const int row0 = u.pm * BM + wr * 64 + fr, col0 = (u.pn & pnmask) * BM + wc * 32 + 8 * fq;
#pragma unroll
        for (int ai = 0; ai < 2; ++ai)
#pragma unroll
            for (int m = 0; m < 4; ++m) { bf16_t* rowp = O + (size_t)(row0 + ai * HALF + m * 16) * ldc + col0;
#pragma unroll
                for (int bj = 0; bj < 2; ++bj) { const f32x4 v0 = acc[ai][bj][m][0], v1 = acc[ai][bj][m][1];
                    u32x4 w; w.x = cvt_pk_bf16(v0[0], v0[1]); w.y = cvt_pk_bf16(v0[2], v0[3]); w.z = cvt_pk_bf16(v1[0], v1[1]); w.w = cvt_pk_bf16(v1[2], v1[3]);
                    *(u32x4*)(rowp + bj * HALF) = w; } }
    }
};
struct EpiScaleColBf16 {
    static constexpr bool PERM = true, AFTER_DRAIN = false;
    bf16_t* O; int ldc; const float* ss;
    __device__ __forceinline__ void operator()(const f32x4 (&acc)[2][2][4][2], const Unit& u, int wr, int wc, int fr, int fq) const {
        const int row0 = u.pm * BM + wr * 64 + fr, col0 = u.pn * BM + wc * 32 + 8 * fq;
        f32x4 rs[2][2];
#pragma unroll
        for (int bj = 0; bj < 2; ++bj)
#pragma unroll
            for (int n = 0; n < 2; ++n)
#pragma unroll
                for (int e = 0; e < 4; ++e) rs[bj][n][e] = rstd16(ss + (size_t)(col0 + bj * HALF + 4 * n + e) * 16);
#pragma unroll
        for (int ai = 0; ai < 2; ++ai)
#pragma unroll
            for (int m = 0; m < 4; ++m) { const int row = row0 + ai * HALF + m * 16; bf16_t* rowp = O + (size_t)row * ldc + col0;
#pragma unroll
                for (int bj = 0; bj < 2; ++bj) { const f32x4 v0 = acc[ai][bj][m][0] * rs[bj][0], v1 = acc[ai][bj][m][1] * rs[bj][1];
                    u32x4 w; w.x = cvt_pk_bf16(v0[0], v0[1]); w.y = cvt_pk_bf16(v0[2], v0[3]); w.z = cvt_pk_bf16(v1[0], v1[1]); w.w = cvt_pk_bf16(v1[2], v1[3]);
                    *(u32x4*)(rowp + bj * HALF) = w; } }
    }
};
struct EpiResid {
    static constexpr bool PERM = false, AFTER_DRAIN = false;
    const float* base; float* H; bf16_t* XB; float* ssp;
    __device__ __forceinline__ void operator()(const f32x4 (&acc)[2][2][4][2], const Unit& u, int wr, int wc, int fr, int fq) const {
        const int row0 = u.pm * BM + wr * 64 + fr, col0 = u.pn * BM + wc * 32 + 4 * fq;
#pragma unroll
        for (int ai = 0; ai < 2; ++ai) {
            f32x4 bv[4][2][2];
#pragma unroll
            for (int m = 0; m < 4; ++m)
#pragma unroll
                for (int bj = 0; bj < 2; ++bj)
#pragma unroll
                    for (int n = 0; n < 2; ++n) bv[m][bj][n] = *(const f32x4*)(base + (size_t)(row0 + ai * HALF + m * 16) * 1024 + col0 + bj * HALF + n * 16);
#pragma unroll
            for (int m = 0; m < 4; ++m) { const int row = row0 + ai * HALF + m * 16; float q = 0.f;
#pragma unroll
                for (int bj = 0; bj < 2; ++bj)
#pragma unroll
                    for (int n = 0; n < 2; ++n) { const size_t off = (size_t)row * 1024 + col0 + bj * HALF + n * 16;
                        const f32x4 v = bv[m][bj][n] + acc[ai][bj][m][n]; *(f32x4*)(H + off) = v;
                        q += (v[0] * v[0] + v[1] * v[1]) + (v[2] * v[2] + v[3] * v[3]);
                        u32x2 w; w.x = cvt_pk_bf16(v[0], v[1]); w.y = cvt_pk_bf16(v[2], v[3]); *(u32x2*)(XB + off) = w; }
                q += __shfl_xor(q, 16); q += __shfl_xor(q, 32);
                if (fq == 0) ssp[(size_t)row * 16 + u.pn * 4 + wc] = q; }
        }
    }
};
__device__ __forceinline__ float silu_mul(float g, float u) { return g * __builtin_amdgcn_rcpf(1.0f + __builtin_amdgcn_exp2f(g * -1.4426950408889634f)) * u; }
template <bool MOE> struct EpiSwiGLU {
    static constexpr bool PERM = true, AFTER_DRAIN = false;
    bf16_t* O; int ldc; const float* ss;
    __device__ __forceinline__ void operator()(const f32x4 (&acc)[2][2][4][2], const Unit& u, int wr, int wc, int fr, int fq) const {
        const int row0 = u.pm * BM + wr * 64 + fr; const int pnl = MOE ? (u.pn % 22) : u.pn; const int col0 = pnl * HALF + wc * 32 + 8 * fq;
        float rsv[2][4];
#pragma unroll
        for (int ai = 0; ai < 2; ++ai)
#pragma unroll
            for (int m = 0; m < 4; ++m) { const int row = row0 + ai * HALF + m * 16; rsv[ai][m] = MOE ? 1.0f : rstd16(ss + (size_t)row * 16); }
#pragma unroll
        for (int ai = 0; ai < 2; ++ai)
#pragma unroll
            for (int m = 0; m < 4; ++m) { const int row = row0 + ai * HALF + m * 16; const float rs = rsv[ai][m];
                const f32x4 g0 = acc[ai][0][m][0] * rs, g1 = acc[ai][0][m][1] * rs, u0 = acc[ai][1][m][0] * rs, u1 = acc[ai][1][m][1] * rs;
                u32x4 w; w.x = cvt_pk_bf16(silu_mul(g0[0], u0[0]), silu_mul(g0[1], u0[1])); w.y = cvt_pk_bf16(silu_mul(g0[2], u0[2]), silu_mul(g0[3], u0[3]));
                w.z = cvt_pk_bf16(silu_mul(g1[0], u1[0]), silu_mul(g1[1], u1[1])); w.w = cvt_pk_bf16(silu_mul(g1[2], u1[2]), silu_mul(g1[3], u1[3]));
                *(u32x4*)(O + (size_t)row * ldc + col0) = w; }
    }
};
struct MoeOrder {
    int tb[9]; int npn, G, c;
    __device__ __forceinline__ bool next(int i, Unit& u) const {
        const int L = i * G + c; if (L >= tb[8] * npn) return false;
        const int t = L / npn, j = L - t * npn; int e = 0;
#pragma unroll
        for (int k = 1; k < 8; ++k) e += (t >= tb[k]) ? 1 : 0;
        u.pm = t; u.pn = e * npn + j; return true;
    }
    __device__ __forceinline__ void a_ready(const Unit&) const {}
    __device__ __forceinline__ void done(const Unit&) const {}
};

template <class Epi, class Sched, bool ALIGN_EPI = false, bool SP2 = false>
__device__ __forceinline__ void gemm_phase(PG8_LAS unsigned char* lds, const Gemm g, const Sched& S, const Epi& E) {
    const int tid = threadIdx.x, wid = __builtin_amdgcn_readfirstlane(tid >> 6), lane = tid & 63, wr = wid >> 2, wc = wid & 3, fr = lane & 15, fq = lane >> 4;
    const int K = g.K, nt = K / BK, LD = g.ld ? g.ld : g.K;
    unsigned voffA[2], voffB[2];
#pragma unroll
    for (int i = 0; i < 2; ++i) { int R, C; stage_rc(tid * 16 + i * 8192, R, C); const int Rb = Epi::PERM ? ((R & ~31) + perm32(R & 31)) : R;
        voffA[i] = (unsigned)(R * LD + C) * 2u; voffB[i] = (unsigned)(Rb * LD + C) * 2u; }
    const size_t kstep = (size_t)(BK * 2);
    const size_t hstep = (size_t)HALF * LD * 2;
    const size_t tstep = 2 * hstep;
    const unsigned ldsw = (unsigned)wid * 1024u;
    const int aoff = lds_byte(wr * 64 + fr, fq * 8), boff = lds_byte(wc * 32 + fr, fq * 8);
#define PG8_SA(b, h) (((b) * 2 + (h)) * HTB)
#define PG8_SB(b, h) ((4 + (b) * 2 + (h)) * HTB)
#define PG8_STAGE(bufoff, gbase, voff) do { _Pragma("unroll") for (int _i = 0; _i < 2; ++_i) \
        __builtin_amdgcn_global_load_lds((const unsigned*)((const char*)(gbase) + (voff)[_i]), (PG8_LAS unsigned*)(lds + (bufoff) + ldsw + _i * 8192), 16, 0, 0); } while (0)
#define PG8_LDA(dst, b, h) do { _Pragma("unroll") for (int m = 0; m < 4; ++m) _Pragma("unroll") for (int k = 0; k < 2; ++k) dst[m][k] = *(const PG8_LAS bf16x8*)(lds + PG8_SA(b, h) + aoff + m * 2048 + k * 1024); } while (0)
#define PG8_LDB(dst, b, h) do { _Pragma("unroll") for (int n = 0; n < 2; ++n) _Pragma("unroll") for (int k = 0; k < 2; ++k) dst[n][k] = *(const PG8_LAS bf16x8*)(lds + PG8_SB(b, h) + boff + n * 2048 + k * 1024); } while (0)
#define PG8_MMA(ai, bj, At, Bt) do { __builtin_amdgcn_s_setprio(1); _Pragma("unroll") for (int m = 0; m < 4; ++m) _Pragma("unroll") for (int n = 0; n < 2; ++n) _Pragma("unroll") for (int k = 0; k < 2; ++k) \
        acc[ai][bj][m][n] = __builtin_amdgcn_mfma_f32_16x16x32_bf16(Bt[n][k], At[m][k], acc[ai][bj][m][n], 0, 0, 0); __builtin_amdgcn_s_setprio(0); } while (0)
#define PG8_WAIT_V(n) asm volatile("s_waitcnt vmcnt(" #n ")" ::: "memory")
#define PG8_WAIT_L(n) asm volatile("s_waitcnt lgkmcnt(" #n ")" ::: "memory")
#define PG8_BAR __builtin_amdgcn_s_barrier()
#define PG8_SCHED __builtin_amdgcn_sched_barrier(0)
    Unit cur, nxt; int ui = 0;
    if (!S.next(0, cur)) return;
    f32x4 acc[2][2][4][2];
#pragma unroll
    for (int a = 0; a < 2; ++a)
#pragma unroll
        for (int b = 0; b < 2; ++b)
#pragma unroll
            for (int m = 0; m < 4; ++m)
#pragma unroll
                for (int n = 0; n < 2; ++n) acc[a][b][m][n] = (f32x4){0.f, 0.f, 0.f, 0.f};
    bf16x8 At[4][2], B0[2][2], B1[2][2];
    const char* cA = (const char*)g.A + (size_t)cur.pm * tstep + cur.koff; const char* cB = (const char*)g.Bt + (size_t)cur.pn * tstep + cur.koff;
    S.a_ready(cur);
    if constexpr (SP2) {
        PG8_STAGE(PG8_SB(0, 0), cB, voffB); PG8_STAGE(PG8_SB(0, 1), cB + hstep, voffB); PG8_STAGE(PG8_SA(0, 0), cA, voffA); PG8_STAGE(PG8_SA(0, 1), cA + hstep, voffA);
        if (wr == 1) PG8_BAR;
        PG8_WAIT_V(2); PG8_BAR;
        PG8_STAGE(PG8_SB(1, 0), cB + kstep, voffB); PG8_STAGE(PG8_SA(1, 0), cA + kstep, voffA); PG8_STAGE(PG8_SB(1, 1), cB + hstep + kstep, voffB);
        PG8_WAIT_V(6); PG8_BAR;
    } else {
        PG8_STAGE(PG8_SB(0, 0), cB, voffB); PG8_STAGE(PG8_SA(0, 0), cA, voffA); PG8_STAGE(PG8_SB(0, 1), cB + hstep, voffB); PG8_STAGE(PG8_SA(0, 1), cA + hstep, voffA);
        if (wr == 1) PG8_BAR;
        PG8_WAIT_V(4); PG8_BAR;
        PG8_STAGE(PG8_SB(1, 0), cB + kstep, voffB); PG8_STAGE(PG8_SA(1, 0), cA + kstep, voffA); PG8_STAGE(PG8_SB(1, 1), cB + hstep + kstep, voffB);
        PG8_WAIT_V(6); PG8_BAR;
    }
    for (;;) {
        const bool has_next = S.next(ui + 1, nxt);
        const char* nA = has_next ? (const char*)g.A + (size_t)nxt.pm * tstep + nxt.koff : cA; const char* nB = has_next ? (const char*)g.Bt + (size_t)nxt.pn * tstep + nxt.koff : cB;
        for (int t = 0; t < nt; t += 2) {
            const bool last = (t == nt - 2);
            const char* a1 = cA + (size_t)(t + 1) * kstep;
            const char* a2 = last ? nA : cA + (size_t)(t + 2) * kstep; const char* b2 = last ? nB : cB + (size_t)(t + 2) * kstep;
            const char* a3 = a2 + kstep; const char* b3 = b2 + kstep;
            if (last && has_next) S.a_ready(nxt);
            if constexpr (SP2) {
            PG8_LDB(B0, 0, 0); PG8_LDB(B1, 0, 1); PG8_SCHED; PG8_LDA(At, 0, 0); PG8_STAGE(PG8_SA(1, 1), a1 + hstep, voffA);
            PG8_WAIT_V(8); PG8_WAIT_L(0); PG8_BAR; PG8_MMA(0, 0, At, B0); PG8_MMA(0, 1, At, B1); PG8_BAR; PG8_SCHED;
            PG8_LDA(At, 0, 1); PG8_STAGE(PG8_SB(0, 0), b2, voffB); PG8_STAGE(PG8_SB(0, 1), b2 + hstep, voffB); PG8_STAGE(PG8_SA(0, 0), a2, voffA);
            PG8_WAIT_V(8); PG8_WAIT_L(0); PG8_BAR; PG8_MMA(1, 0, At, B0); PG8_MMA(1, 1, At, B1); PG8_BAR; PG8_SCHED;
            PG8_LDB(B0, 1, 0); PG8_LDB(B1, 1, 1); PG8_SCHED; PG8_LDA(At, 1, 0); PG8_STAGE(PG8_SA(0, 1), a2 + hstep, voffA);
            PG8_WAIT_V(8); PG8_WAIT_L(0); PG8_BAR; PG8_MMA(0, 0, At, B0); PG8_MMA(0, 1, At, B1); PG8_BAR; PG8_SCHED;
            PG8_LDA(At, 1, 1); PG8_STAGE(PG8_SB(1, 0), b3, voffB); PG8_STAGE(PG8_SB(1, 1), b3 + hstep, voffB); PG8_STAGE(PG8_SA(1, 0), a3, voffA);
            PG8_WAIT_V(8); PG8_WAIT_L(0); PG8_BAR; PG8_MMA(1, 0, At, B0); PG8_MMA(1, 1, At, B1); PG8_BAR; PG8_SCHED;
            } else {
            PG8_LDB(B0, 0, 0); PG8_SCHED; PG8_LDA(At, 0, 0); PG8_STAGE(PG8_SA(1, 1), a1 + hstep, voffA);
            PG8_WAIT_L(8); PG8_BAR; PG8_WAIT_L(0); PG8_MMA(0, 0, At, B0); PG8_BAR; PG8_SCHED;
            PG8_LDB(B1, 0, 1); PG8_STAGE(PG8_SB(0, 0), b2, voffB);
            PG8_BAR; PG8_WAIT_L(0); PG8_MMA(0, 1, At, B1); PG8_BAR;
            PG8_LDA(At, 0, 1); PG8_STAGE(PG8_SA(0, 0), a2, voffA);
            PG8_BAR; PG8_WAIT_L(0); PG8_MMA(1, 0, At, B0); PG8_BAR; PG8_SCHED;
            PG8_STAGE(PG8_SB(0, 1), b2 + hstep, voffB);
            PG8_WAIT_V(6); PG8_BAR; PG8_MMA(1, 1, At, B1); PG8_BAR;
            PG8_LDB(B0, 1, 0); PG8_SCHED; PG8_LDA(At, 1, 0); PG8_STAGE(PG8_SA(0, 1), a2 + hstep, voffA);
            PG8_WAIT_L(8); PG8_BAR; PG8_WAIT_L(0); PG8_MMA(0, 0, At, B0); PG8_BAR; PG8_SCHED;
            PG8_LDB(B1, 1, 1); PG8_STAGE(PG8_SB(1, 0), b3, voffB);
            PG8_BAR; PG8_WAIT_L(0); PG8_MMA(0, 1, At, B1); PG8_BAR;
            PG8_LDA(At, 1, 1); PG8_STAGE(PG8_SA(1, 0), a3, voffA);
            PG8_BAR; PG8_WAIT_L(0); PG8_MMA(1, 0, At, B0); PG8_BAR; PG8_SCHED;
            PG8_STAGE(PG8_SB(1, 1), b3 + hstep, voffB);
            PG8_WAIT_V(6); PG8_BAR; PG8_MMA(1, 1, At, B1); PG8_BAR;
            }
        }
        if constexpr (ALIGN_EPI) { if (wr == 0) PG8_BAR; }
        if constexpr (!Epi::AFTER_DRAIN) { E(acc, cur, wr, wc, fr, fq); S.done(cur); }
        if (!has_next) break;
#pragma unroll
        for (int a = 0; a < 2; ++a)
#pragma unroll
            for (int b = 0; b < 2; ++b)
#pragma unroll
                for (int m = 0; m < 4; ++m)
#pragma unroll
                    for (int n = 0; n < 2; ++n) acc[a][b][m][n] = (f32x4){0.f, 0.f, 0.f, 0.f};
        cur = nxt; cA = nA; cB = nB; ++ui;
        if constexpr (ALIGN_EPI) { if (wr == 1) PG8_BAR; }
    }
    PG8_WAIT_V(0);
    if constexpr (!ALIGN_EPI) { if (wr == 0) PG8_BAR; }
    PG8_BAR;
    if constexpr (Epi::AFTER_DRAIN) { E.fused(acc, cur, wr, wc, fr, fq, lds, wid, lane); S.done(cur); }
#undef PG8_SA
#undef PG8_SB
#undef PG8_STAGE
#undef PG8_LDA
#undef PG8_LDB
#undef PG8_MMA
#undef PG8_WAIT_V
#undef PG8_WAIT_L
#undef PG8_BAR
#undef PG8_SCHED
}
}

constexpr int NWAVES = 8;
constexpr int BATCH = 2, SEQ = 8192, D = 1024, M = BATCH * SEQ;
constexpr int HD = 128, NH = 8, NKV = 2, NIH = 8, IDX = 64, TOPK = 256;
constexpr int A_IN = 2120, FF = 2816, NE = 8;
constexpr int MAXSLOT = 34816;
constexpr float QSCALE = 0.12751743082459868f;
constexpr float SBSCALE = 0.08838834764831845f;
constexpr float WISCALE = 0.04419417382415922f;
constexpr size_t MiB = 1u << 20;
constexpr size_t WS_CTL = 0, CTL_ZERO_BYTES = 1 * MiB;
constexpr size_t WS_WIN = 2 * MiB, WS_WTAIL = 6 * MiB, WS_WOA = 7 * MiB, WS_WGU = 9 * MiB, WS_WD = 20 * MiB, WS_WKVQ = 26 * MiB, WS_WOB = 32 * MiB, WS_WGUM = 34 * MiB, WS_WDM = 122 * MiB;
constexpr size_t WS_H = 166 * MiB, WS_XB = 230 * MiB, WS_SS0 = 262 * MiB, WS_SS1 = 263 * MiB, WS_SS2 = 264 * MiB, WS_SS3 = 265 * MiB;
constexpr size_t WS_T = 266 * MiB;
constexpr size_t WS_PROJ = WS_T, WS_QF = 330 * MiB, WS_KVF = 362 * MiB, WS_QIF = 378 * MiB, WS_KIF = 394 * MiB, WS_WIF = 396 * MiB, WS_SEL = 397 * MiB, WS_AO = 413 * MiB;
constexpr size_t WS_HF = WS_T, WS_KQ = WS_T, WS_VT = 330 * MiB;
constexpr size_t WS_XPERM = WS_T, WS_HM = 334 * MiB, WS_Y = 521 * MiB;
constexpr size_t WS_RT = 590 * MiB;
constexpr size_t WS_END = 591 * MiB;
constexpr int CW_CNT = 64;
constexpr int CW_BAR = 4096;
constexpr int RING_BYTES = 131072, LDSCTL_OFF = RING_BYTES, MISC_OFF = LDSCTL_OFF + 320, LDS_BYTES = 147456;

#define GAS __attribute__((address_space(1)))
#define LAS __attribute__((address_space(3)))
typedef unsigned short bf16;
typedef unsigned v4u __attribute__((ext_vector_type(4)));
typedef unsigned v2u __attribute__((ext_vector_type(2)));
typedef float f32x4 __attribute__((ext_vector_type(4)));
typedef short bf16x8 __attribute__((ext_vector_type(8)));
typedef float f32x16 __attribute__((ext_vector_type(16)));
typedef GAS unsigned gu32;
#define RLX_AGENT __ATOMIC_RELAXED, __HIP_MEMORY_SCOPE_AGENT
#define LDS_WAIT() asm volatile("s_waitcnt lgkmcnt(0)" ::: "memory")
#define VM_WAIT() asm volatile("s_waitcnt vmcnt(0)" ::: "memory")
__device__ __forceinline__ unsigned f2bf(float f) { unsigned u = __builtin_bit_cast(unsigned, f); return (u + 0x7fffu + ((u >> 16) & 1u)) >> 16; }
__device__ __forceinline__ unsigned pk2(float lo, float hi) { return f2bf(lo) | (f2bf(hi) << 16); }
__device__ __forceinline__ float bflo(unsigned w) { return __uint_as_float(w << 16); }
__device__ __forceinline__ float bfhi(unsigned w) { return __uint_as_float(w & 0xffff0000u); }
__device__ __forceinline__ float wave_sum(float v) {
#pragma unroll
    for (int o = 1; o < 64; o <<= 1) v += __shfl_xor(v, o);
    return v;
}
__device__ __forceinline__ float wave_max(float v) {
#pragma unroll
    for (int o = 1; o < 64; o <<= 1) v = fmaxf(v, __shfl_xor(v, o));
    return v;
}
__device__ __forceinline__ void sincos_acc(float a, float& c, float& s) {
    const double x = (double)a; const double n = __builtin_rint(x * 0.63661977236758134308);
    const double r = __builtin_fma(-n, 6.123233995736766035869e-17, __builtin_fma(-n, 1.57079632679489655800, x)); const double r2 = r * r;
    double sn = 1.0 - r2 * (1.0 / 156.0); sn = 1.0 - r2 * (1.0 / 110.0) * sn; sn = 1.0 - r2 * (1.0 / 72.0) * sn; sn = 1.0 - r2 * (1.0 / 42.0) * sn; sn = 1.0 - r2 * (1.0 / 20.0) * sn; sn = 1.0 - r2 * (1.0 / 6.0) * sn; sn *= r;
    double cs = 1.0 - r2 * (1.0 / 182.0); cs = 1.0 - r2 * (1.0 / 132.0) * cs; cs = 1.0 - r2 * (1.0 / 90.0) * cs; cs = 1.0 - r2 * (1.0 / 56.0) * cs; cs = 1.0 - r2 * (1.0 / 30.0) * cs; cs = 1.0 - r2 * (1.0 / 12.0) * cs; cs = 1.0 - r2 * 0.5 * cs;
    const int q = ((int)n) & 3;
    const double cq = (q == 0) ? cs : (q == 1) ? -sn : (q == 2) ? -cs : sn;
    const double sq = (q == 0) ? sn : (q == 1) ? cs : (q == 2) ? -sn : -cs;
    c = (float)cq; s = (float)sq;
}
__device__ const float INV_Q[16] = {1.000000000e+00f, 4.403665960e-01f, 1.939227432e-01f, 8.539710194e-02f, 3.760603070e-02f, 1.656043902e-02f, 7.292664610e-03f, 3.211445874e-03f,
                                    1.414213562e-03f, 6.227723788e-04f, 2.742481884e-04f, 1.207697351e-04f, 5.318296098e-05f, 2.341999971e-05f, 1.031338616e-05f, 4.541670478e-06f};
__device__ const float INV_I[8] = {1.000000000e+00f, 1.939227432e-01f, 3.760603070e-02f, 7.292664610e-03f, 1.414213562e-03f, 2.742481884e-04f, 5.318296098e-05f, 1.031338616e-05f};

#define XB_TMO      128
#define XB_XCNT(j)  (256  + 64 * (j))
#define XB_XSUB(j)  (1280 + 64 * (j))
#define XB_XGEN(j)  (2304 + 64 * (j))
#define XB_TOP      3328
#define XB_TOPGEN   3392
#define XCD_BAR_WORDS 3456
#define XB_SPIN_CAP (1u << 18)

__device__ __forceinline__ unsigned xb_ld(unsigned* p)              { return __hip_atomic_load(p, __ATOMIC_RELAXED, __HIP_MEMORY_SCOPE_AGENT); }
__device__ __forceinline__ unsigned xb_add(unsigned* p, unsigned v) { return __hip_atomic_fetch_add(p, v, __ATOMIC_RELAXED, __HIP_MEMORY_SCOPE_AGENT); }
__device__ __forceinline__ unsigned xb_xcc_id() { return (unsigned)__builtin_amdgcn_s_getreg((3 << 11) | 20) & 0xFu; }
#define XB_SPIN(cond, bar) do { unsigned _sp = 0; while (cond) { __builtin_amdgcn_s_sleep(1); \
    if ((++_sp & 255u) == 0u) { if (xb_ld(&(bar)[XB_TMO])) break; if (_sp > XB_SPIN_CAP) { atomicAdd(&(bar)[XB_TMO], 1u); break; } } } } while (0)

struct XcdBarrier {
    unsigned* bar; unsigned x;
    volatile LAS unsigned* st;
};

__device__ __forceinline__ XcdBarrier xcd_barrier_post(unsigned* bar, volatile LAS unsigned* st) {
    XcdBarrier b; b.bar = bar; b.x = xb_xcc_id(); b.st = st;
    if (threadIdx.x == 0) (void)xb_add(&bar[XB_XCNT(b.x)], 1u);
    return b;
}
__device__ __forceinline__ void xcd_barrier_complete(unsigned* bar, unsigned x, unsigned& nloc, unsigned& nx) {
    const unsigned G = gridDim.x * gridDim.y * gridDim.z;
    unsigned sum, cnt, mine, sp = 0u;
    for (;;) {
        sum = 0u; cnt = 0u; mine = 0u;
#pragma unroll
        for (unsigned j = 0; j < 16; ++j) { const unsigned c = xb_ld(&bar[XB_XCNT(j)]); sum += c; cnt += (c > 0u) ? 1u : 0u; mine = (j == x) ? c : mine; }
        if (sum == G) break;
        __builtin_amdgcn_s_sleep(1);
        if ((++sp & 255u) == 0u) { if (xb_ld(&bar[XB_TMO])) break; if (sp > XB_SPIN_CAP) { atomicAdd(&bar[XB_TMO], 1u); break; } }
    }
    nloc = mine > 0u ? mine : 1u; nx = cnt > 0u ? cnt : 1u;
}

__device__ __forceinline__ void xcd_barrier(const XcdBarrier& b) {
    asm volatile("s_waitcnt vmcnt(0)" ::: "memory");
    __syncthreads();
    if (threadIdx.x == 0) {
        unsigned* bar = b.bar;
        __builtin_amdgcn_s_waitcnt(0);
        unsigned nloc = b.st[0], nx = b.st[1];
        if (nloc == 0u) { xcd_barrier_complete(bar, b.x, nloc, nx); b.st[0] = nloc; b.st[1] = nx; }
        const unsigned old = xb_add(&bar[XB_XSUB(b.x)], 1u);
        const unsigned gen = old / nloc;
        if (old + 1u == (gen + 1u) * nloc) {
            __builtin_amdgcn_fence(__ATOMIC_RELEASE, "agent");
            asm volatile("s_waitcnt vmcnt(0)" ::: "memory");
            const unsigned og = xb_add(&bar[XB_TOP], 1u);
            const unsigned tg = og / nx;
            if (og + 1u == (tg + 1u) * nx) xb_add(&bar[XB_TOPGEN], 1u);
            else XB_SPIN(xb_ld(&bar[XB_TOPGEN]) == tg, bar);
            __builtin_amdgcn_fence(__ATOMIC_ACQUIRE, "agent");
            xb_add(&bar[XB_XGEN(b.x)], 1u);
            asm volatile("s_waitcnt vmcnt(0)" ::: "memory");
        } else {
            XB_SPIN(xb_ld(&bar[XB_XGEN(b.x)]) == gen, bar);
            __builtin_amdgcn_fence(__ATOMIC_ACQUIRE, "agent");
            asm volatile("s_waitcnt vmcnt(0)" ::: "memory");
        }
    }
    __syncthreads();
}

struct Frame {
    LAS unsigned char* lds;
    volatile LAS unsigned* MISC;
    gu32* ctl;
    int tid, lane, wave, G, bid;
    const float* in[17];
    float* out; unsigned char* ws;
};
enum { IN_X = 0, IN_ANORM, IN_AWIN, IN_AQN, IN_AKN, IN_AWOUT, IN_KVNORM, IN_KVW, IN_BNORM, IN_BWQ, IN_BWOUT, IN_FFNNORM, IN_DGU, IN_DDN, IN_ROUTER, IN_MGU, IN_MDN };

struct TrItem { const float* W; size_t ldw; int K, k0, csrc0, cend; bf16* WT; int drow0; const float* gain; float scale; };
__device__ __forceinline__ int gu_row(int c0) { return (c0 < FF) ? ((c0 >> 7) * 256 + (c0 & 127)) : (((c0 - FF) >> 7) * 256 + 128 + ((c0 - FF) & 127)); }
constexpr int I_WIN = 16 * 32, I_TAIL = 16 * 2, I_SQ = 16 * 16, I_GU = 16 * 88, I_DN = 44 * 16, I_KV = 16 * 32;
constexpr int TR_NITEMS = I_WIN + I_TAIL + I_SQ + I_GU + I_DN + I_KV + I_SQ + I_SQ + NE * I_GU + NE * I_DN;
__device__ __forceinline__ TrItem tr_decode(const Frame& F, int it) {
    unsigned char* ws = F.ws; int r = it; TrItem t;
    if (r < I_WIN) { const int kb = r / 32, nb = r % 32; t = TrItem{F.in[IN_AWIN], (size_t)A_IN, D, 64 * kb, 64 * nb, A_IN, (bf16*)(ws + WS_WIN), 64 * nb, F.in[IN_ANORM], 1.f}; return t; } r -= I_WIN;
    if (r < I_TAIL) { const int kb = r / 2, nb = r % 2; t = TrItem{F.in[IN_AWIN], (size_t)A_IN, D, 64 * kb, 2048 + 64 * nb, A_IN, (bf16*)(ws + WS_WTAIL), 64 * nb, F.in[IN_ANORM], 1.f}; return t; } r -= I_TAIL;
    if (r < I_SQ) { const int kb = r / 16, nb = r % 16; t = TrItem{F.in[IN_AWOUT], (size_t)D, D, 64 * kb, 64 * nb, D, (bf16*)(ws + WS_WOA), 64 * nb, nullptr, 1.f}; return t; } r -= I_SQ;
    if (r < I_GU) { const int kb = r / 88, nb = r % 88; t = TrItem{F.in[IN_DGU], (size_t)(2 * FF), D, 64 * kb, 64 * nb, 2 * FF, (bf16*)(ws + WS_WGU), gu_row(64 * nb), F.in[IN_FFNNORM], 1.f}; return t; } r -= I_GU;
    if (r < I_DN) { const int kb = r / 16, nb = r % 16; t = TrItem{F.in[IN_DDN], (size_t)D, FF, 64 * kb, 64 * nb, D, (bf16*)(ws + WS_WD), 64 * nb, nullptr, 1.f}; return t; } r -= I_DN;
    if (r < I_KV) { const int kb = r / 32, nb = r % 32; t = TrItem{F.in[IN_KVW], (size_t)(2 * D), D, 64 * kb, 64 * nb, 2 * D, (bf16*)(ws + WS_WKVQ), (nb < 16) ? 64 * nb : 1024 + 64 * nb, F.in[IN_KVNORM], 1.f}; return t; } r -= I_KV;
    if (r < I_SQ) { const int kb = r / 16, nb = r % 16; t = TrItem{F.in[IN_BWQ], (size_t)D, D, 64 * kb, 64 * nb, D, (bf16*)(ws + WS_WKVQ), 1024 + 64 * nb, F.in[IN_BNORM], SBSCALE}; return t; } r -= I_SQ;
    if (r < I_SQ) { const int kb = r / 16, nb = r % 16; t = TrItem{F.in[IN_BWOUT], (size_t)D, D, 64 * kb, 64 * nb, D, (bf16*)(ws + WS_WOB), 64 * nb, nullptr, 1.f}; return t; } r -= I_SQ;
    if (r < NE * I_GU) { const int e = r / I_GU, rr = r % I_GU, kb = rr / 88, nb = rr % 88;
        t = TrItem{F.in[IN_MGU] + (size_t)e * D * 2 * FF, (size_t)(2 * FF), D, 64 * kb, 64 * nb, 2 * FF, (bf16*)(ws + WS_WGUM), e * 2 * FF + gu_row(64 * nb), F.in[IN_FFNNORM] + D, 1.f}; return t; } r -= NE * I_GU;
    { const int e = r / I_DN, rr = r % I_DN, kb = rr / 16, nb = rr % 16;
      t = TrItem{F.in[IN_MDN] + (size_t)e * FF * D, (size_t)D, FF, 64 * kb, 64 * nb, D, (bf16*)(ws + WS_WDM), e * D + 64 * nb, nullptr, 1.f}; return t; }
}
__device__ __forceinline__ void tr_load(const TrItem& t, f32x4 (&v)[16], int lane) {
    const int r = lane >> 4, c = t.csrc0 + 4 * (lane & 15); const bool ok = c < t.cend; const float* src = t.W + (size_t)(t.k0 + r) * t.ldw + (ok ? c : 0);
#pragma unroll
    for (int i = 0; i < 16; ++i) { const f32x4 x = *(const f32x4*)(src + (size_t)(4 * i) * t.ldw); v[i] = ok ? x : (f32x4){0.f, 0.f, 0.f, 0.f}; }
}
__device__ __forceinline__ void tr_store(const TrItem& t, const f32x4 (&v)[16], LAS float* scr, int lane) {
    const int r = lane >> 4, c4 = lane & 15;
#pragma unroll
    for (int i = 0; i < 16; ++i) { const int k = 4 * i + r; const float g = t.gain ? t.gain[t.k0 + k] * t.scale : t.scale;
        *(LAS f32x4*)(scr + k * 64 + 4 * (c4 ^ ((k >> 3) & 7))) = v[i] * g; }
    LDS_WAIT(); asm volatile("" ::: "memory");
    const int c8 = lane & 7;
#pragma unroll
    for (int j = 0; j < 8; ++j) { const int n = (lane >> 3) + 8 * j; const LAS float* s = scr + (8 * c8) * 64 + (n ^ (c8 << 2));
        v4u o; o.x = pk2(s[0 * 64], s[1 * 64]); o.y = pk2(s[2 * 64], s[3 * 64]); o.z = pk2(s[4 * 64], s[5 * 64]); o.w = pk2(s[6 * 64], s[7 * 64]);
        *(GAS v4u*)(t.WT + (size_t)(t.drow0 + n) * t.K + t.k0 + 8 * c8) = o; }
    LDS_WAIT(); asm volatile("" ::: "memory");
}
__device__ __forceinline__ void p0_prologue(Frame& F) {
    LAS float* scr = (LAS float*)(F.lds + F.wave * 16384);
    const int gw = F.wave * F.G + F.bid, NGW = F.G * NWAVES;
    unsigned char* ws = F.ws;
    {
        f32x4 va[16], vb[16];
        int it = gw;
        if (it < TR_NITEMS) { TrItem cur = tr_decode(F, it); tr_load(cur, va, F.lane);
            for (;;) {
                const int nx = it + NGW; const bool has = nx < TR_NITEMS; TrItem nxt = cur;
                if (has) { nxt = tr_decode(F, nx); tr_load(nxt, vb, F.lane); }
                tr_store(cur, va, scr, F.lane);
                if (!has) break;
                it = nx + NGW; const bool has2 = it < TR_NITEMS; TrItem nn = nxt;
                if (has2) { nn = tr_decode(F, it); tr_load(nn, va, F.lane); }
                tr_store(nxt, vb, scr, F.lane);
                if (!has2) break;
                cur = nn;
            }
        }
    }
    const float* x = F.in[IN_X]; bf16* XB = (bf16*)(ws + WS_XB);
    for (int m = gw; m < M; m += NGW) {
        const GAS f32x4* xr = (const GAS f32x4*)(x + (size_t)m * D) + F.lane; f32x4 v[4]; float s = 0.f;
#pragma unroll
        for (int j = 0; j < 4; ++j) { v[j] = xr[64 * j]; s += (v[j].x * v[j].x + v[j].y * v[j].y) + (v[j].z * v[j].z + v[j].w * v[j].w); }
        s = wave_sum(s); const float rs = 1.0f / sqrtf(s * (1.0f / 1024.0f) + 1e-6f);
        GAS unsigned long long* o8 = (GAS unsigned long long*)(XB + (size_t)m * D) + F.lane;
#pragma unroll
        for (int j = 0; j < 4; ++j) o8[64 * j] = (unsigned long long)pk2(v[j].x * rs, v[j].y * rs) | ((unsigned long long)pk2(v[j].z * rs, v[j].w * rs) << 32);
    }
}

#define WAVE_SYNC() asm volatile("s_waitcnt lgkmcnt(0)" ::: "memory")
__device__ __forceinline__ void rope8(float (&y)[8], bool isx1, bool isx2, int i0, int pshift, LAS const float* tab) {
#pragma unroll
    for (int e = 0; e < 8; ++e) {
        const float other = __shfl_xor(y[e], pshift); const float c = tab[2 * (i0 + e)], s = tab[2 * (i0 + e) + 1];
        y[e] = isx1 ? (y[e] * c - other * s) : (isx2 ? (y[e] * c + other * s) : y[e]);
    }
}
__device__ __forceinline__ size_t kif_off(int grow, int d) { return ((((size_t)(grow >> 5) * 4 + ((d >> 3) & 3)) * 2 + (d >> 5)) * 32 + (grow & 31)) * 8 + (d & 7); }
__device__ __forceinline__ void unpack8(const v4u w, float (&y)[8]) { y[0] = bflo(w.x); y[1] = bfhi(w.x); y[2] = bflo(w.y); y[3] = bfhi(w.y); y[4] = bflo(w.z); y[5] = bfhi(w.z); y[6] = bflo(w.w); y[7] = bfhi(w.w); }
__device__ __forceinline__ v4u pack8(const float (&y)[8]) { v4u o; o.x = pk2(y[0], y[1]); o.y = pk2(y[2], y[3]); o.z = pk2(y[4], y[5]); o.w = pk2(y[6], y[7]); return o; }
__device__ __forceinline__ void p2_post(Frame& F) {
    unsigned char* ws = F.ws; const int lane = F.lane;
    const bf16* PROJ = (const bf16*)(ws + WS_PROJ); const bf16* XB = (const bf16*)(ws + WS_XB); const bf16* WT = (const bf16*)(ws + WS_WTAIL);
    bf16* QF = (bf16*)(ws + WS_QF); bf16* KVF = (bf16*)(ws + WS_KVF); bf16* QIF = (bf16*)(ws + WS_QIF); bf16* KIF = (bf16*)(ws + WS_KIF); float* WIF = (float*)(ws + WS_WIF);
    const float* qnw = F.in[IN_AQN]; const float* knw = F.in[IN_AKN];
    LAS float* tab = (LAS float*)(F.lds + F.wave * 256);
    const int gw = F.wave * F.G + F.bid, NGW = F.G * NWAVES;
    for (int task = gw; task < M / 8; task += NGW) {
        const int row0 = task * 8;
        f32x4 acc[5];
#pragma unroll
        for (int c = 0; c < 5; ++c) acc[c] = (f32x4){0.f, 0.f, 0.f, 0.f};
        const bf16* ap = XB + (size_t)(row0 + (lane & 7)) * D + 8 * (lane >> 4);
        const bf16* bp = WT + (size_t)(lane & 15) * D + 8 * (lane >> 4);
#pragma unroll 4
        for (int j = 0; j < 32; ++j) {
            const bf16x8 a = *(const bf16x8*)(ap + 32 * j);
#pragma unroll
            for (int c = 0; c < 5; ++c) { const bf16x8 b = *(const bf16x8*)(bp + (size_t)(16 * c) * D + 32 * j); acc[c] = __builtin_amdgcn_mfma_f32_16x16x32_bf16(a, b, acc[c], 0, 0, 0); }
        }
        if (lane < 32) {
#pragma unroll
            for (int reg = 0; reg < 4; ++reg) {
                const int row = row0 + 4 * (lane >> 4) + reg; const float rs = 1.0f; const float pos = (float)(row & (SEQ - 1));
                const int d = lane & 15;
                float v0 = acc[0][reg] * rs; const float other = __shfl_xor(v0, 8);
                { float c, s; sincos_acc(pos * INV_I[d & 7], c, s); v0 = (d < 8) ? (v0 * c - other * s) : (v0 * c + other * s); }
                KIF[kif_off(row, d)] = (bf16)f2bf(v0);
#pragma unroll
                for (int c = 1; c < 4; ++c) KIF[kif_off(row, 16 * c + d)] = (bf16)f2bf(acc[c][reg] * rs);
                if (d < 8) WIF[(size_t)row * 8 + d] = acc[4][reg] * rs * WISCALE;
            }
        }
        for (int r = 0; r < 8; ++r) {
            const int row = row0 + r, b = row >> 13, t = row & (SEQ - 1); const float pos = (float)t;
            const bf16* pr = PROJ + (size_t)row * 2048 + 8 * lane;
            v4u w[4];
#pragma unroll
            for (int j = 0; j < 4; ++j) w[j] = *(const v4u*)(pr + 512 * j);
            if (lane < 24) { float c, s; sincos_acc(pos * ((lane < 16) ? INV_Q[lane & 15] : INV_I[lane & 7]), c, s); tab[2 * lane] = c; tab[2 * lane + 1] = s; }
            WAVE_SYNC();
#pragma unroll
            for (int j = 0; j < 2; ++j) {
                float y[8]; unpack8(w[j], y); float ss = 0.f;
#pragma unroll
                for (int e = 0; e < 8; ++e) ss += y[e] * y[e];
                ss += __shfl_xor(ss, 1); ss += __shfl_xor(ss, 2); ss += __shfl_xor(ss, 4); ss += __shfl_xor(ss, 8);
                const float rs = 1.0f / sqrtf(ss * (1.0f / 128.0f) + 1e-6f); const int c8 = (lane & 15) * 8;
#pragma unroll
                for (int e = 0; e < 8; ++e) y[e] = y[e] * rs * qnw[c8 + e];
                rope8(y, c8 < 16, c8 >= 16 && c8 < 32, c8 & 15, 2, tab);
#pragma unroll
                for (int e = 0; e < 8; ++e) y[e] *= QSCALE;
                *(v4u*)(QF + (size_t)row * D + 512 * j + 8 * lane) = pack8(y);
            }
            {
                float y[8]; unpack8(w[2], y); float ss = 0.f;
#pragma unroll
                for (int e = 0; e < 8; ++e) ss += y[e] * y[e];
                ss += __shfl_xor(ss, 1); ss += __shfl_xor(ss, 2); ss += __shfl_xor(ss, 4); ss += __shfl_xor(ss, 8);
                const bool isk = lane < 32; const float rs = 1.0f / sqrtf(ss * (1.0f / 128.0f) + 1e-6f); const int c8 = (lane & 15) * 8;
                if (isk) {
#pragma unroll
                    for (int e = 0; e < 8; ++e) y[e] = y[e] * rs * knw[c8 + e];
                }
                rope8(y, isk && c8 < 16, isk && c8 >= 16 && c8 < 32, c8 & 15, 2, tab);
                const int kvh = (lane >> 4) & 1;
                int w0 = __builtin_amdgcn_cvt_pk_fp8_f32(y[0], y[1], 0, false); w0 = __builtin_amdgcn_cvt_pk_fp8_f32(y[2], y[3], w0, true);
                int w1 = __builtin_amdgcn_cvt_pk_fp8_f32(y[4], y[5], 0, false); w1 = __builtin_amdgcn_cvt_pk_fp8_f32(y[6], y[7], w1, true);
                *(v2u*)((unsigned char*)KVF + ((size_t)(b * NKV + kvh) * SEQ + t) * 256 + (isk ? 0 : 128) + c8) = (v2u){(unsigned)w0, (unsigned)w1};
            }
            {
                float y[8]; unpack8(w[3], y); const int c8 = (lane & 7) * 8;
                rope8(y, c8 == 0, c8 == 8, 16, 1, tab);
                *(v4u*)(QIF + (size_t)row * 512 + 8 * lane) = pack8(y);
            }
            WAVE_SYNC();
        }
    }
}

__device__ __forceinline__ unsigned f2key(float f) { const unsigned u = __float_as_uint(f); return (u & 0x80000000u) ? ~u : (u | 0x80000000u); }
__device__ __forceinline__ void p3_query_naive(unsigned char* ws, LAS unsigned char* lds, int row, int* SEL) {
    const int tid = threadIdx.x, lane = tid & 63, wave = tid >> 6;
    const bf16* QIF = (const bf16*)(ws + WS_QIF); const bf16* KIF = (const bf16*)(ws + WS_KIF); const float* WIF = (const float*)(ws + WS_WIF);
    LAS unsigned* keys = (LAS unsigned*)lds;
    LAS float* qis = (LAS float*)(lds + 32768);
    LAS float* wl = (LAS float*)(lds + 32768 + 2048);
    LAS unsigned* hist = (LAS unsigned*)(lds + 36864);
    LAS unsigned* ctl = (LAS unsigned*)(lds + 36864 + 1024);
    LAS unsigned* wcnt = (LAS unsigned*)(lds + 36864 + 1024 + 64);
    {
        const int b = row >> 13, t = row & (SEQ - 1), n = t + 1;
        int* sel = SEL + (size_t)row * TOPK;
        if (n <= TOPK) { if (tid < TOPK) sel[tid] = tid < n ? tid : 0; return; }
        __syncthreads();
        qis[tid] = __uint_as_float((unsigned)QIF[(size_t)row * 512 + tid] << 16);
        if (tid < 8) wl[tid] = WIF[(size_t)row * 8 + tid];
        __syncthreads();
        for (int s = tid; s < n; s += 512) {
            const int grow = (b << 13) + s;
            float kf[64];
#pragma unroll
            for (int j = 0; j < 8; ++j) { const v4u w = *(const v4u*)(KIF + kif_off(grow, 8 * j)); kf[8 * j] = bflo(w.x); kf[8 * j + 1] = bfhi(w.x); kf[8 * j + 2] = bflo(w.y); kf[8 * j + 3] = bfhi(w.y); kf[8 * j + 4] = bflo(w.z); kf[8 * j + 5] = bfhi(w.z); kf[8 * j + 6] = bflo(w.w); kf[8 * j + 7] = bfhi(w.w); }
            float sc = 0.f;
#pragma unroll
            for (int h = 0; h < 8; ++h) { float d = 0.f; asm volatile("" ::: "memory");
#pragma unroll
                for (int dd = 0; dd < 64; ++dd) d += qis[h * 64 + dd] * kf[dd];
                sc += wl[h] * fmaxf(d, 0.f); }
            keys[s] = f2key(sc + 0.0f);
        }
        __syncthreads();
        unsigned prefix = 0u, mask = 0u, need = TOPK;
        for (int pass = 0; pass < 4; ++pass) {
            const int shift = 24 - 8 * pass;
            if (tid < 256) hist[tid] = 0u;
            __syncthreads();
            for (int s = tid; s < n; s += 512) { const unsigned k = keys[s]; if ((k & mask) == prefix) __hip_atomic_fetch_add(&hist[(k >> shift) & 255u], 1u, __ATOMIC_RELAXED, __HIP_MEMORY_SCOPE_WORKGROUP); }
            __syncthreads();
            if (tid < 64) {
                const unsigned h0 = hist[4 * lane], h1 = hist[4 * lane + 1], h2 = hist[4 * lane + 2], h3 = hist[4 * lane + 3]; const unsigned tot = h0 + h1 + h2 + h3;
                unsigned incl = tot;
#pragma unroll
                for (int o = 1; o < 64; o <<= 1) { const unsigned v = __shfl_down(incl, o); if (lane + o < 64) incl += v; }
                const unsigned above = incl - tot;
                if (above < need && need <= above + tot) {
                    unsigned a = above; unsigned bin;
                    if (a + h3 >= need) bin = 3; else { a += h3; if (a + h2 >= need) bin = 2; else { a += h2; if (a + h1 >= need) bin = 1; else { a += h1; bin = 0; } } }
                    ctl[0] = 4 * lane + bin; ctl[1] = need - a;
                }
            }
            __syncthreads();
            prefix |= ctl[0] << shift; mask |= 255u << shift; need = ctl[1];
            __syncthreads();
        }
        const unsigned thr = prefix, n_gt = TOPK - need;
        unsigned base_gt = 0u, base_eq = 0u;
        for (int s0 = 0; s0 < n; s0 += 512) {
            const int s = s0 + tid; const unsigned k = s < n ? keys[s] : 0u; const bool gt = (s < n) && (k > thr); const bool eq = (s < n) && (k == thr);
            const unsigned long long bg = __ballot(gt), be = __ballot(eq); const unsigned long long lt = (1ull << lane) - 1ull;
            const unsigned rg = __popcll(bg & lt), re = __popcll(be & lt);
            if (lane == 0) { wcnt[wave] = __popcll(bg); wcnt[8 + wave] = __popcll(be); }
            __syncthreads();
            unsigned og = base_gt, oe = base_eq, tg = 0u, te = 0u;
#pragma unroll
            for (int w = 0; w < 8; ++w) { const unsigned cg = wcnt[w], ce = wcnt[8 + w]; if (w < wave) { og += cg; oe += ce; } tg += cg; te += ce; }
            if (gt) sel[og + rg] = s;
            if (eq && oe + re < need) sel[n_gt + oe + re] = s;
            base_gt += tg; base_eq += te;
            __syncthreads();
        }
    }
}

constexpr int P3_HIST = 0, P3_H2 = 65536, P3_BM = 98304, P3_QS = 114688, P3_FLAG = P3_QS + 512, P3_CAP = 512;
__device__ __forceinline__ void find_bin_2048(LAS const unsigned* hist, unsigned need, int lane, unsigned& bin_out, unsigned& need_out, unsigned& cnt_out, bool& ok) {
    unsigned w[16]; unsigned tot = 0u;
#pragma unroll
    for (int i = 0; i < 16; ++i) { w[i] = hist[16 * lane + i]; tot += (w[i] & 0xffffu) + (w[i] >> 16); }
    unsigned incl = tot;
#pragma unroll
    for (int o = 1; o < 64; o <<= 1) { const unsigned v = __shfl_down(incl, o); if (lane + o < 64) incl += v; }
    const unsigned above = incl - tot;
    const bool mine = (above < need) && (need <= above + tot);
    unsigned a = above, fb = 0u, fn = 0u, fc = 0u; bool found = false;
#pragma unroll
    for (int i = 15; i >= 0; --i) {
        const unsigned h1 = w[i] >> 16, h0 = w[i] & 0xffffu;
        if (!found) { if (a + h1 >= need) { found = true; fb = 32u * lane + 2u * i + 1u; fn = need - a; fc = h1; } else a += h1; }
        if (!found) { if (a + h0 >= need) { found = true; fb = 32u * lane + 2u * i; fn = need - a; fc = h0; } else a += h0; }
    }
    const unsigned long long bm = __ballot(mine);
    ok = (bm != 0ull);
    const int src = ok ? (__ffsll((long long)bm) - 1) : 0;
    bin_out = (unsigned)__builtin_amdgcn_readlane((int)fb, src); need_out = (unsigned)__builtin_amdgcn_readlane((int)fn, src); cnt_out = (unsigned)__builtin_amdgcn_readlane((int)fc, src);
}
__device__ __forceinline__ unsigned bin11(float sc) { const unsigned u = __float_as_uint(sc); const int m = (int)((u & 0x7fffffffu) >> 17) - 7360; const unsigned mc = (unsigned)(m < 0 ? 0 : (m > 1023 ? 1023 : m)); return (u >> 31) ? (1023u - mc) : (1024u + mc); }
__device__ __forceinline__ float relu_i(float x) { const int xi = __builtin_bit_cast(int, x); const int ri = (xi < 0) ? 0 : xi; return __builtin_bit_cast(float, ri); }
#define RELU(x) relu_i(x)
typedef _Float16 f16x8 __attribute__((ext_vector_type(8)));
typedef short s16x2 __attribute__((ext_vector_type(2)));
__device__ __forceinline__ unsigned pk_relu_f16(float a, float b) { const s16x2 h = __builtin_bit_cast(s16x2, __builtin_amdgcn_cvt_pkrtz(a, b)); return __builtin_bit_cast(unsigned, __builtin_elementwise_max(h, (s16x2){0, 0})); }
template <int PASS> __device__ __forceinline__ void p3_score_pass(const bf16x8 (&af)[2][4], const f16x8 (&wa)[2][2], const bf16* kib, int t0, int nt, int wave, int n, int hi,
                                                                  LAS unsigned char* lds, const unsigned (&thr)[2][2], int rot) {
    LAS unsigned* HIST = (LAS unsigned*)(lds + P3_HIST); LAS unsigned* BM = (LAS unsigned*)(lds + P3_BM); LAS unsigned* QS = (LAS unsigned*)(lds + P3_QS);
    const int kmax = t0 + 15;
    bf16x8 bc[4], bn[4];
    const int qh = 8 * (wave >> 2), w4 = wave & 3;
    const int cnt4 = (nt - w4 + 3) >> 2; const int r0 = rot % cnt4;
    bf16x8 bq[4][4];
#define P3_LOADB(u, j) do { int jj_ = r0 + (j); jj_ = (jj_ >= cnt4) ? jj_ - cnt4 : jj_; const int t_ = w4 + 4 * jj_; \
        const bf16* kp_ = kib + ((size_t)t_ * 8 + hi) * 256 + n * 8; _Pragma("unroll") for (int s = 0; s < 4; ++s) bq[u][s] = *(const bf16x8*)(kp_ + s * 512); } while (0)
#pragma unroll
    for (int u = 0; u < 4; ++u) P3_LOADB(u, (u < cnt4) ? u : 0);
    for (int i0 = 0; i0 < cnt4; i0 += 4) {
#pragma unroll
        for (int u = 0; u < 4; ++u) {
            if (i0 + u < cnt4) {
                int jj = r0 + i0 + u; jj = (jj >= cnt4) ? jj - cnt4 : jj; const int tile = w4 + 4 * jj;
                const int key = 32 * tile + n; const bool full = (32 * tile + 31 <= t0);
                f32x16 acc0, acc1;
#pragma unroll
                for (int r = 0; r < 16; ++r) { acc0[r] = 0.f; acc1[r] = 0.f; }
#pragma unroll
                for (int s = 0; s < 4; ++s) acc0 = __builtin_amdgcn_mfma_f32_32x32x16_bf16(af[0][s], bq[u][s], acc0, 0, 0, 0);
#pragma unroll
                for (int s = 0; s < 4; ++s) acc1 = __builtin_amdgcn_mfma_f32_32x32x16_bf16(af[1][s], bq[u][s], acc1, 0, 0, 0);
                float sc4[4];
                {
                    f32x16 y0, y1;
#pragma unroll
                    for (int r = 0; r < 16; ++r) { y0[r] = 0.f; y1[r] = 0.f; }
                    const f16x8 x00 = __builtin_bit_cast(f16x8, (v4u){pk_relu_f16(acc0[0], acc0[1]), pk_relu_f16(acc0[2], acc0[3]), pk_relu_f16(acc0[4], acc0[5]), pk_relu_f16(acc0[6], acc0[7])});
                    const f16x8 x01 = __builtin_bit_cast(f16x8, (v4u){pk_relu_f16(acc0[8], acc0[9]), pk_relu_f16(acc0[10], acc0[11]), pk_relu_f16(acc0[12], acc0[13]), pk_relu_f16(acc0[14], acc0[15])});
                    const f16x8 x10 = __builtin_bit_cast(f16x8, (v4u){pk_relu_f16(acc1[0], acc1[1]), pk_relu_f16(acc1[2], acc1[3]), pk_relu_f16(acc1[4], acc1[5]), pk_relu_f16(acc1[6], acc1[7])});
                    const f16x8 x11 = __builtin_bit_cast(f16x8, (v4u){pk_relu_f16(acc1[8], acc1[9]), pk_relu_f16(acc1[10], acc1[11]), pk_relu_f16(acc1[12], acc1[13]), pk_relu_f16(acc1[14], acc1[15])});
                    y0 = __builtin_amdgcn_mfma_f32_32x32x16_f16(wa[0][0], x00, y0, 0, 0, 0); y1 = __builtin_amdgcn_mfma_f32_32x32x16_f16(wa[1][0], x10, y1, 0, 0, 0);
                    y0 = __builtin_amdgcn_mfma_f32_32x32x16_f16(wa[0][1], x01, y0, 0, 0, 0); y1 = __builtin_amdgcn_mfma_f32_32x32x16_f16(wa[1][1], x11, y1, 0, 0, 0);
                    sc4[0] = y0[0]; sc4[1] = y0[1]; sc4[2] = y1[0]; sc4[3] = y1[1];
                }
                unsigned bin4[4]; float scz4[4]; bool val4[4];
#pragma unroll
                for (int e = 0; e < 4; ++e) { scz4[e] = sc4[e] + 0.0f; bin4[e] = bin11(scz4[e]); val4[e] = full || (key <= t0 + qh + 4 * (e >> 1) + hi + 2 * (e & 1)); }
                if (PASS == 1) {
                    if (full) {
#pragma unroll
                        for (int e = 0; e < 4; ++e) { const int q = qh + 4 * (e >> 1) + hi + 2 * (e & 1); __hip_atomic_fetch_add(&HIST[q * 1024 + (bin4[e] >> 1)], 1u << (16 * (bin4[e] & 1u)), __ATOMIC_RELAXED, __HIP_MEMORY_SCOPE_WORKGROUP); }
                    } else {
#pragma unroll
                        for (int e = 0; e < 4; ++e) { const int q = qh + 4 * (e >> 1) + hi + 2 * (e & 1); if (val4[e]) __hip_atomic_fetch_add(&HIST[q * 1024 + (bin4[e] >> 1)], 1u << (16 * (bin4[e] & 1u)), __ATOMIC_RELAXED, __HIP_MEMORY_SCOPE_WORKGROUP); }
                    }
                } else if (PASS == 2) {
                    unsigned long long ab4[4]; bool cand4[4]; bool anyc = false;
#pragma unroll
                    for (int e = 0; e < 4; ++e) { ab4[e] = __ballot(val4[e] && bin4[e] > thr[e >> 1][e & 1]); cand4[e] = val4[e] && bin4[e] == thr[e >> 1][e & 1]; anyc = anyc || cand4[e]; }
                    if (n == 0) {
#pragma unroll
                        for (int e = 0; e < 4; ++e) { const int q = qh + 4 * (e >> 1) + hi + 2 * (e & 1); BM[q * 256 + tile] = hi ? (unsigned)(ab4[e] >> 32) : (unsigned)ab4[e]; }
                    }
                    if (__ballot(anyc) != 0ull) {
#pragma unroll
                        for (int e = 0; e < 4; ++e) if (cand4[e]) { const int q = qh + 4 * (e >> 1) + hi + 2 * (e & 1); const unsigned pos = __hip_atomic_fetch_add(&QS[q * 8 + 3], 1u, __ATOMIC_RELAXED, __HIP_MEMORY_SCOPE_WORKGROUP);
                            if (pos < (unsigned)P3_CAP) { HIST[q * 1024 + 2 * pos] = f2key(scz4[e]); HIST[q * 1024 + 2 * pos + 1] = (unsigned)key; } }
                    }
                }
            }
            { const int jn = (i0 + u + 4 < cnt4) ? (i0 + u + 4) : (cnt4 - 1); P3_LOADB(u, jn); }
        }
    }
#undef P3_LOADB
}
__device__ __forceinline__ void p3_index(Frame& F) {
    unsigned char* ws = F.ws; const int tid = F.tid, lane = F.lane, wave = F.wave, n = lane & 31, hi = lane >> 5;
    const bf16* QIF = (const bf16*)(ws + WS_QIF); const bf16* KIF = (const bf16*)(ws + WS_KIF); const float* WIF = (const float*)(ws + WS_WIF); int* SEL = (int*)(ws + WS_SEL);
    LAS unsigned char* lds = F.lds;
    LAS unsigned* HIST = (LAS unsigned*)(lds + P3_HIST); LAS unsigned* H2 = (LAS unsigned*)(lds + P3_H2 + wave * 4096); LAS unsigned* BM = (LAS unsigned*)(lds + P3_BM); LAS unsigned* QS = (LAS unsigned*)(lds + P3_QS);
    LAS unsigned* FLAG = (LAS unsigned*)(lds + P3_FLAG); LAS unsigned* FBL = (LAS unsigned*)(lds + P3_QS + 1024);
    if (tid == 0) FBL[0] = 0u;
    __syncthreads();
    for (int ps = F.bid; ps < 512; ps += F.G) {
        const int b = ps >> 8, wq = ps & 255;
#pragma unroll 1
        for (int half = 0; half < 2; ++half) {
            const int idx = half ? (511 - wq) : wq; const int t0 = 16 * idx, row0 = (b << 13) + t0;
            if (idx < 16) {
                for (int e = tid; e < 16 * TOPK; e += 512) { const int q = e >> 8, i = e & 255; SEL[(size_t)(row0 + q) * TOPK + i] = (i <= t0 + q) ? i : 0; }
                continue;
            }
            for (int e = tid; e < 16384; e += 512) HIST[e] = 0u;
            for (int e = tid; e < 4096; e += 512) BM[e] = 0u;
            if (tid < 132) QS[tid] = 0u;
            bf16x8 af[2][4]; f16x8 wa[2][2]; const int qh = 8 * (wave >> 2);
            { const int head = (n & 3) + 4 * ((n >> 3) & 1), q4 = ((n >> 2) & 1) + 2 * (n >> 4);
#pragma unroll
              for (int mt = 0; mt < 2; ++mt) { const bf16* ap = QIF + (size_t)(row0 + qh + 4 * mt + q4) * 512 + head * IDX + 32 * hi;
#pragma unroll
                  for (int s = 0; s < 4; ++s) af[mt][s] = *(const bf16x8*)(ap + 8 * s);
#pragma unroll
                  for (int sp = 0; sp < 2; ++sp) {
                      const bool on = (sp == 0) ? ((n == 0 && hi == 0) || (n == 4 && hi == 1)) : ((n == 1 && hi == 0) || (n == 5 && hi == 1));
                      const float* wp = WIF + (size_t)(row0 + qh + 4 * mt + hi + 2 * sp) * 8; const f32x4 w0 = *(const f32x4*)wp, w1 = *(const f32x4*)(wp + 4);
                      f16x8 t; t[0] = (_Float16)w0[0]; t[1] = (_Float16)w0[1]; t[2] = (_Float16)w0[2]; t[3] = (_Float16)w0[3]; t[4] = (_Float16)w1[0]; t[5] = (_Float16)w1[1]; t[6] = (_Float16)w1[2]; t[7] = (_Float16)w1[3];
                      if (!on) t = (f16x8){0, 0, 0, 0, 0, 0, 0, 0};
                      wa[mt][sp] = t; } } }
            const int nt = (t0 + 16 + 31) >> 5; const bf16* kib = KIF + (size_t)(b << 13) * IDX;
            unsigned thr[2][2] = {{0u, 0u}, {0u, 0u}};
            __syncthreads();
            p3_score_pass<1>(af, wa, kib, t0, nt, wave, n, hi, lds, thr, F.bid * 5);
            __syncthreads();
#pragma unroll 1
            for (int qq = 0; qq < 2; ++qq) { const int q = 2 * wave + qq; unsigned bin, need, cnt; bool ok;
                find_bin_2048(HIST + q * 1024, (unsigned)TOPK, lane, bin, need, cnt, ok);
                if (lane == 0) { const bool defer = !ok || cnt > (unsigned)P3_CAP; QS[q * 8 + 0] = defer ? 4096u : bin; QS[q * 8 + 1] = need; QS[q * 8 + 2] = cnt; QS[q * 8 + 4] = defer ? 1u : 0u;
                    if (defer) { const unsigned k = __hip_atomic_fetch_add(&FBL[0], 1u, __ATOMIC_RELAXED, __HIP_MEMORY_SCOPE_WORKGROUP); if (k < 63u) FBL[1 + k] = (unsigned)(row0 + q); } } }
            __syncthreads();
#pragma unroll
            for (int mt = 0; mt < 2; ++mt)
#pragma unroll
                for (int j = 0; j < 2; ++j) thr[mt][j] = QS[(qh + 4 * mt + hi + 2 * j) * 8];
            __syncthreads();
            p3_score_pass<2>(af, wa, kib, t0, nt, wave, n, hi, lds, thr, F.bid * 5 + 3);
            __syncthreads();
#pragma unroll 1
            for (int qq = 0; qq < 2; ++qq) {
                const int q = 2 * wave + qq; LAS unsigned* cand = HIST + q * 1024; LAS unsigned* bmq = BM + q * 256;
                const unsigned needA = QS[q * 8 + 1], c = QS[q * 8 + 2];
                if (QS[q * 8 + 4] != 0u) continue;
                for (unsigned i0 = 0; i0 < c; i0 += 64) { const unsigned i = i0 + lane; const bool in = i < c; const unsigned k32 = in ? cand[2 * i] : 0u, ki = in ? (cand[2 * i + 1] & 8191u) : 0u; unsigned rank = 0u;
                    for (unsigned j = 0; j < c; ++j) { const unsigned kj = cand[2 * j], ij = cand[2 * j + 1]; rank += (kj > k32 || (kj == k32 && ij < ki)) ? 1u : 0u; }
                    if (in && rank < needA) __hip_atomic_fetch_or(&bmq[ki >> 5], 1u << (ki & 31), __ATOMIC_RELAXED, __HIP_MEMORY_SCOPE_WORKGROUP); }
                WAVE_SYNC();
                unsigned w0 = bmq[4 * lane], w1 = bmq[4 * lane + 1], w2 = bmq[4 * lane + 2], w3 = bmq[4 * lane + 3];
                const unsigned mycnt = __popc(w0) + __popc(w1) + __popc(w2) + __popc(w3);
                unsigned incl = mycnt;
#pragma unroll
                for (int o = 1; o < 64; o <<= 1) { const unsigned v = __shfl_up(incl, o); if (lane >= o) incl += v; }
                unsigned pos = incl - mycnt; int* sel = SEL + (size_t)(row0 + q) * TOPK;
#pragma unroll
                for (int wi = 0; wi < 4; ++wi) { unsigned w = (wi == 0) ? w0 : (wi == 1) ? w1 : (wi == 2) ? w2 : w3;
                    while (w) { const int bit = __ffs((int)w) - 1; if (pos < (unsigned)TOPK) sel[pos] = 128 * lane + 32 * wi + bit; ++pos; w &= w - 1u; } }
            }
            __syncthreads();
        }
    }
    __syncthreads();
    const unsigned nfb = FBL[0];
    for (unsigned k = 0; k < nfb && k < 63u; ++k) { const int r0 = (int)FBL[1 + k]; __syncthreads(); p3_query_naive(ws, lds, r0, SEL); }
}

typedef short v4i16_t __attribute__((ext_vector_type(4)));
typedef int v4i __attribute__((ext_vector_type(4)));
__device__ __forceinline__ v4i16_t tr16(LAS unsigned char* p) { return __builtin_amdgcn_ds_read_tr16_b64_v4i16((LAS v4i16_t*)p); }
typedef __bf16 bf16x2_t __attribute__((ext_vector_type(2)));
__device__ __forceinline__ unsigned dq2(unsigned w, bool hi) { return __builtin_bit_cast(unsigned, hi ? __builtin_amdgcn_cvt_scalef32_pk_bf16_fp8(w, 1.0f, true) : __builtin_amdgcn_cvt_scalef32_pk_bf16_fp8(w, 1.0f, false)); }
__device__ __forceinline__ bf16x8 dq8(unsigned w0, unsigned w1) { return __builtin_bit_cast(bf16x8, (v4u){dq2(w0, false), dq2(w0, true), dq2(w1, false), dq2(w1, true)}); }
__device__ __forceinline__ void p4_dsa(Frame& F) {
    unsigned char* ws = F.ws; const int lane = F.lane, nh = lane & 15, kg = lane >> 4;
    const bf16* QF = (const bf16*)(ws + WS_QF); const unsigned char* KV8 = (const unsigned char*)(ws + WS_KVF); const int* SEL = (const int*)(ws + WS_SEL); bf16* AO = (bf16*)(ws + WS_AO);
    LAS unsigned char* wl = F.lds + F.wave * 10240; LAS int* selw = (LAS int*)wl; LAS unsigned char* vb = wl + 1024;
    const int gw = F.wave * F.G + F.bid, NGW = F.G * NWAVES;
    LAS unsigned char* trp = vb + (4 * kg + ((lane >> 2) & 3)) * 288 + 8 * (lane & 3);
#pragma unroll 1
    for (int combo = 0; combo < BATCH * NKV; ++combo) {
        const int b = combo >> 1, kvh = combo & 1;
        const unsigned char* kvb = KV8 + (size_t)(b * NKV + kvh) * SEQ * 256;
#pragma unroll 1
        for (int t = gw; t < SEQ; t += NGW) {
            const int row = (b << 13) + t; const int cnt = (t + 1 < TOPK) ? (t + 1) : TOPK;
            *(LAS v4i*)(selw + 4 * lane) = *(const v4i*)(SEL + (size_t)row * TOPK + 4 * lane);
            WAVE_SYNC();
            const bf16* qp = QF + (size_t)row * D + (kvh * 4 + (nh & 3)) * HD + 32 * kg;
            bf16x8 qf[4];
#pragma unroll
            for (int s = 0; s < 4; ++s) { qf[s] = *(const bf16x8*)(qp + 8 * s); if (nh >= 4) qf[s] = (bf16x8){0, 0, 0, 0, 0, 0, 0, 0}; }
            f32x4 S[16];
            v4u kq[2][4][2];
#define P4_LOADK(buf, batch) do { _Pragma("unroll") for (int tt = 0; tt < 4; ++tt) { const unsigned char* kp_ = kvb + (size_t)(selw[16 * (4 * (batch) + tt) + nh] & (SEQ - 1)) * 256 + 32 * kg; \
                kq[buf][tt][0] = *(const v4u*)(kp_); kq[buf][tt][1] = *(const v4u*)(kp_ + 16); } } while (0)
            P4_LOADK(0, 0);
#pragma unroll
            for (int bt = 0; bt < 4; ++bt) {
                if (bt < 3) P4_LOADK((bt + 1) & 1, bt + 1);
                asm volatile("" ::: "memory");
#pragma unroll
                for (int tt = 0; tt < 4; ++tt) {
                    const v4u k0 = kq[bt & 1][tt][0], k1 = kq[bt & 1][tt][1];
                    f32x4 a = (f32x4){0.f, 0.f, 0.f, 0.f};
                    a = __builtin_amdgcn_mfma_f32_16x16x32_bf16(dq8(k0.x, k0.y), qf[0], a, 0, 0, 0); a = __builtin_amdgcn_mfma_f32_16x16x32_bf16(dq8(k0.z, k0.w), qf[1], a, 0, 0, 0);
                    a = __builtin_amdgcn_mfma_f32_16x16x32_bf16(dq8(k1.x, k1.y), qf[2], a, 0, 0, 0); a = __builtin_amdgcn_mfma_f32_16x16x32_bf16(dq8(k1.z, k1.w), qf[3], a, 0, 0, 0);
                    S[4 * bt + tt] = a;
                }
            }
#undef P4_LOADK
            float mx = -INFINITY;
#pragma unroll
            for (int T = 0; T < 16; ++T)
#pragma unroll
                for (int r = 0; r < 4; ++r) { const float v = (16 * T + 4 * kg + r < cnt) ? S[T][r] : -INFINITY; S[T][r] = v; mx = fmaxf(mx, v); }
            mx = fmaxf(mx, __shfl_xor(mx, 16)); mx = fmaxf(mx, __shfl_xor(mx, 32));
            float sum = 0.f;
#pragma unroll
            for (int T = 0; T < 16; ++T)
#pragma unroll
                for (int r = 0; r < 4; ++r) { const float e = __builtin_amdgcn_exp2f(S[T][r] - mx); S[T][r] = e; sum += e; }
            sum += __shfl_xor(sum, 16); sum += __shfl_xor(sum, 32);
            bf16x8 pa[8];
#pragma unroll
            for (int c = 0; c < 8; ++c) { v4u pw; pw.x = pg8::cvt_pk_bf16(S[2 * c][0], S[2 * c][1]); pw.y = pg8::cvt_pk_bf16(S[2 * c][2], S[2 * c][3]); pw.z = pg8::cvt_pk_bf16(S[2 * c + 1][0], S[2 * c + 1][1]); pw.w = pg8::cvt_pk_bf16(S[2 * c + 1][2], S[2 * c + 1][3]); pa[c] = __builtin_bit_cast(bf16x8, pw); }
            f32x4 O[8];
#pragma unroll
            for (int d = 0; d < 8; ++d) O[d] = (f32x4){0.f, 0.f, 0.f, 0.f};
            v4u g[3][4];
#define P4_LOADV(buf, c_) do { _Pragma("unroll") for (int i = 0; i < 4; ++i) { const int key_ = selw[32 * (c_) + (lane >> 3) + 8 * i] & (SEQ - 1); g[buf][i] = *(const v4u*)(kvb + (size_t)key_ * 256 + 128 + 16 * (lane & 7)); } } while (0)
            P4_LOADV(0, 0); P4_LOADV(1, 1); P4_LOADV(2, 2);
#pragma unroll
            for (int c = 0; c < 8; ++c) {
#pragma unroll
                for (int i = 0; i < 4; ++i) { const v4u gg = g[c % 3][i]; LAS unsigned char* dst = vb + ((lane >> 3) + 8 * i) * 288 + 32 * (lane & 7);
                    *(LAS v4u*)dst = __builtin_bit_cast(v4u, dq8(gg.x, gg.y)); *(LAS v4u*)(dst + 16) = __builtin_bit_cast(v4u, dq8(gg.z, gg.w)); }
                asm volatile("" ::: "memory");
                if (c < 5) P4_LOADV(c % 3, c + 3);
#pragma unroll
                for (int d = 0; d < 8; ++d) {
                    const v4i16_t lo = tr16(trp + 32 * d), hi4 = tr16(trp + 16 * 288 + 32 * d);
                    const bf16x8 vfr = (bf16x8){lo[0], lo[1], lo[2], lo[3], hi4[0], hi4[1], hi4[2], hi4[3]};
                    O[d] = __builtin_amdgcn_mfma_f32_16x16x32_bf16(pa[c], vfr, O[d], 0, 0, 0);
                }
            }
#undef P4_LOADV
            const float i0 = 1.0f / __builtin_bit_cast(float, __builtin_amdgcn_readlane(__builtin_bit_cast(int, sum), 0)), i1 = 1.0f / __builtin_bit_cast(float, __builtin_amdgcn_readlane(__builtin_bit_cast(int, sum), 1));
            const float i2 = 1.0f / __builtin_bit_cast(float, __builtin_amdgcn_readlane(__builtin_bit_cast(int, sum), 2)), i3 = 1.0f / __builtin_bit_cast(float, __builtin_amdgcn_readlane(__builtin_bit_cast(int, sum), 3));
            LAS bf16* ost = (LAS bf16*)vb;
            if (kg == 0) {
#pragma unroll
                for (int d = 0; d < 8; ++d) { ost[0 * 128 + 16 * d + nh] = (bf16)f2bf(O[d][0] * i0); ost[1 * 128 + 16 * d + nh] = (bf16)f2bf(O[d][1] * i1); ost[2 * 128 + 16 * d + nh] = (bf16)f2bf(O[d][2] * i2); ost[3 * 128 + 16 * d + nh] = (bf16)f2bf(O[d][3] * i3); }
            }
            WAVE_SYNC();
            const v4u ov = *(LAS v4u*)(vb + 16 * lane);
            *(v4u*)(AO + (size_t)row * D + (kvh * 4 + kg) * HD + 8 * nh) = ov;
            WAVE_SYNC();
        }
    }
}

__device__ __forceinline__ void p9_sb(Frame& F) {
    unsigned char* ws = F.ws; const int lane = F.lane, n = lane & 31, hi = lane >> 5;
    const bf16* KQ = (const bf16*)(ws + WS_KQ); const bf16* VT = (const bf16*)(ws + WS_VT); bf16* AO = (bf16*)(ws + WS_AO);
    const int gw = F.wave * F.G + F.bid, NGW = F.G * NWAVES;
    const int koff = 16 * (n >> 4) + 8 * ((n >> 2) & 1) + 4 * ((n >> 3) & 1) + (n & 3);
    constexpr float LOG2E = 1.4426950408889634f, LN2 = 0.6931471805599453f;
    for (int u = gw; u < (M / 32) * NH; u += NGW) {
        const int h = u & 7, blk = u >> 3, b = blk >> 8, qb = blk & 255, q0 = 32 * qb, t = q0 + n;
        const bf16* qp = KQ + (size_t)(b * SEQ + q0 + n) * 2048 + 1024 + h * HD + 64 * hi;
        bf16x8 qf[8];
#pragma unroll
        for (int s = 0; s < 8; ++s) qf[s] = *(const bf16x8*)(qp + 8 * s);
        f32x16 o[4];
#pragma unroll
        for (int mt = 0; mt < 4; ++mt)
#pragma unroll
            for (int r = 0; r < 16; ++r) o[mt][r] = 0.f;
        float C = 0.f;
        bf16x8 kf[8];
        { const bf16* kp = KQ + (size_t)(b * SEQ + 32 * qb + koff) * 2048 + h * HD + 64 * hi;
#pragma unroll
          for (int s = 0; s < 8; ++s) kf[s] = *(const bf16x8*)(kp + 8 * s); }
        for (int kb = qb; kb >= 0; --kb) {
            const int k0 = 32 * kb;
            bf16x8 vf[4][2];
#pragma unroll
            for (int mt = 0; mt < 4; ++mt)
#pragma unroll
                for (int sp = 0; sp < 2; ++sp) vf[mt][sp] = *(const bf16x8*)(VT + (size_t)(h * HD + 32 * mt + n) * M + b * SEQ + k0 + 16 * sp + 8 * hi);
            f32x16 z;
#pragma unroll
            for (int r = 0; r < 16; ++r) z[r] = 0.f;
#pragma unroll
            for (int s = 0; s < 8; ++s) z = __builtin_amdgcn_mfma_f32_32x32x16_bf16(kf[s], qf[s], z, 0, 0, 0);
            { const int kn = (kb > 0) ? kb - 1 : 0; const bf16* kp = KQ + (size_t)(b * SEQ + 32 * kn + koff) * 2048 + h * HD + 64 * hi;
#pragma unroll
              for (int s = 0; s < 8; ++s) kf[s] = *(const bf16x8*)(kp + 8 * s); }
            float lk[16], lb[16];
#pragma unroll
            for (int r = 0; r < 16; ++r) {
                const int key = k0 + ((r < 8) ? (8 * hi + r) : (16 + 8 * hi + (r - 8)));
                const float zz = z[r]; const float L = __builtin_amdgcn_logf(1.0f + __builtin_amdgcn_exp2f(-fabsf(zz) * LOG2E)) * LN2;
                const bool valid = key < t;
                lk[r] = valid ? (-fmaxf(zz, 0.f) - L) : 0.f;
                lb[r] = valid ? (fminf(zz, 0.f) - L) : -INFINITY;
            }
            float suf[16];
            suf[7] = 0.f; suf[15] = 0.f;
#pragma unroll
            for (int i = 6; i >= 0; --i) { suf[i] = suf[i + 1] + lk[i + 1]; suf[8 + i] = suf[9 + i] + lk[9 + i]; }
            const float T0 = suf[0] + lk[0], T1 = suf[8] + lk[8];
            const float P0 = __shfl_xor(T0, 32), P1 = __shfl_xor(T1, 32);
            const float base1 = C + (hi ? 0.f : P1), base0 = C + (hi ? (T1 + P1) : (P0 + T1 + P1));
            unsigned pw[8];
#pragma unroll
            for (int r = 0; r < 16; r += 2) {
                const float a0 = __builtin_amdgcn_exp2f((lb[r] + ((r < 8) ? base0 : base1) + suf[r]) * LOG2E), a1 = __builtin_amdgcn_exp2f((lb[r + 1] + ((r < 8) ? base0 : base1) + suf[r + 1]) * LOG2E);
                pw[r >> 1] = pg8::cvt_pk_bf16(a0, a1);
            }
            C += (T0 + T1) + (P0 + P1);
            const bf16x8 pa0 = __builtin_bit_cast(bf16x8, (v4u){pw[0], pw[1], pw[2], pw[3]}), pa1 = __builtin_bit_cast(bf16x8, (v4u){pw[4], pw[5], pw[6], pw[7]});
#pragma unroll
            for (int mt = 0; mt < 4; ++mt) { o[mt] = __builtin_amdgcn_mfma_f32_32x32x16_bf16(vf[mt][0], pa0, o[mt], 0, 0, 0); o[mt] = __builtin_amdgcn_mfma_f32_32x32x16_bf16(vf[mt][1], pa1, o[mt], 0, 0, 0); }
            if (__all(C < -44.0f)) break;
        }
        bf16* op = AO + (size_t)(b * SEQ + q0 + n) * D + h * HD + 4 * hi;
#pragma unroll
        for (int mt = 0; mt < 4; ++mt)
#pragma unroll
            for (int g = 0; g < 4; ++g) { v2u w; w.x = pg8::cvt_pk_bf16(o[mt][4 * g], o[mt][4 * g + 1]); w.y = pg8::cvt_pk_bf16(o[mt][4 * g + 2], o[mt][4 * g + 3]); *(v2u*)(op + 32 * mt + 8 * g) = w; }
    }
}

__device__ __forceinline__ void p11_router(Frame& F) {
    unsigned char* ws = F.ws; const int tid = F.tid, lane = F.lane, wave = F.wave;
    const float* H = (const float*)(ws + WS_H); const float* gn = F.in[IN_FFNNORM] + D; const float* Wr = F.in[IN_ROUTER];
    int* TOPE = (int*)(ws + WS_RT); int* POS = (int*)(ws + WS_RT + 128 * 1024); float* GATE = (float*)(ws + WS_RT + 256 * 1024); float* RSTD3 = (float*)(ws + WS_RT + 384 * 1024);
    LAS unsigned* lcnt = (LAS unsigned*)F.lds;
    LAS unsigned* gb = (LAS unsigned*)(F.lds + 64);
    LAS int* ltok = (LAS int*)(F.lds + 128);
    LAS float* lgt = (LAS float*)(F.lds + 128 + 1024);
    for (int chunk = F.bid; chunk < M / 64; chunk += F.G) {
        if (tid < 8) lcnt[tid] = 0u;
        __syncthreads();
        for (int r = 0; r < 8; ++r) {
            const int row = chunk * 64 + wave * 8 + r;
            const GAS f32x4* xr = (const GAS f32x4*)(H + (size_t)row * D) + lane; f32x4 v[4]; float ss = 0.f;
#pragma unroll
            for (int j = 0; j < 4; ++j) { v[j] = xr[64 * j]; ss += (v[j].x * v[j].x + v[j].y * v[j].y) + (v[j].z * v[j].z + v[j].w * v[j].w); }
            ss = wave_sum(ss); const float rs = 1.0f / sqrtf(ss * (1.0f / 1024.0f) + 1e-6f);
            float lg[8] = {0.f, 0.f, 0.f, 0.f, 0.f, 0.f, 0.f, 0.f};
#pragma unroll
            for (int j = 0; j < 4; ++j)
#pragma unroll
                for (int i = 0; i < 4; ++i) { const int k = 256 * j + 4 * lane + i; const float xv = v[j][i] * gn[k]; const f32x4 w0 = *(const f32x4*)(Wr + (size_t)k * 8), w1 = *(const f32x4*)(Wr + (size_t)k * 8 + 4);
                    lg[0] += xv * w0[0]; lg[1] += xv * w0[1]; lg[2] += xv * w0[2]; lg[3] += xv * w0[3]; lg[4] += xv * w1[0]; lg[5] += xv * w1[1]; lg[6] += xv * w1[2]; lg[7] += xv * w1[3]; }
#pragma unroll
            for (int e = 0; e < 8; ++e) lg[e] = wave_sum(lg[e]) * rs;
            int i1 = 0; float l1 = lg[0];
#pragma unroll
            for (int e = 1; e < 8; ++e) if (lg[e] > l1) { l1 = lg[e]; i1 = e; }
            int i2 = -1; float l2 = -INFINITY;
#pragma unroll
            for (int e = 0; e < 8; ++e) if (e != i1 && lg[e] > l2) { l2 = lg[e]; i2 = e; }
            const float g1 = 1.0f / (1.0f + __expf(l2 - l1)), g2 = 1.0f - g1;
            if (lane == 0) {
                const unsigned p1 = __hip_atomic_fetch_add(&lcnt[i1], 1u, __ATOMIC_RELAXED, __HIP_MEMORY_SCOPE_WORKGROUP), p2 = __hip_atomic_fetch_add(&lcnt[i2], 1u, __ATOMIC_RELAXED, __HIP_MEMORY_SCOPE_WORKGROUP);
                const int ti = wave * 8 + r; ltok[ti * 4 + 0] = i1; ltok[ti * 4 + 1] = i2; ltok[ti * 4 + 2] = (int)p1; ltok[ti * 4 + 3] = (int)p2;
                lgt[ti * 4 + 0] = g1; lgt[ti * 4 + 1] = g2; lgt[ti * 4 + 2] = rs;
            }
        }
        __syncthreads();
        if (tid < 8) gb[tid] = __hip_atomic_fetch_add(F.ctl + CW_CNT + tid, lcnt[tid], RLX_AGENT);
        __syncthreads();
        if (tid < 64) { const int row = chunk * 64 + tid; const int e1 = ltok[tid * 4], e2 = ltok[tid * 4 + 1];
            TOPE[row * 2] = e1; TOPE[row * 2 + 1] = e2; POS[row * 2] = (int)gb[e1] + ltok[tid * 4 + 2]; POS[row * 2 + 1] = (int)gb[e2] + ltok[tid * 4 + 3];
            GATE[row * 2] = lgt[tid * 4]; GATE[row * 2 + 1] = lgt[tid * 4 + 1]; RSTD3[row] = lgt[tid * 4 + 2]; }
        __syncthreads();
    }
}
__device__ __forceinline__ void moe_bases(Frame& F, int (&tb)[9]) {
    int acc = 0;
#pragma unroll
    for (int e = 0; e < 8; ++e) { tb[e] = acc; const unsigned c = __hip_atomic_load(F.ctl + CW_CNT + e, RLX_AGENT); acc += (int)((c + 255u) >> 8); }
    tb[8] = acc;
}
__device__ __forceinline__ void p12_permute(Frame& F) {
    unsigned char* ws = F.ws; const int lane = F.lane;
    const int* TOPE = (const int*)(ws + WS_RT); const int* POS = (const int*)(ws + WS_RT + 128 * 1024); const float* RSTD3 = (const float*)(ws + WS_RT + 384 * 1024);
    int* SLOT = (int*)(ws + WS_RT + 512 * 1024);
    const float* H = (const float*)(ws + WS_H); bf16* XP = (bf16*)(ws + WS_XPERM);
    int tb[9]; moe_bases(F, tb);
    const int gw = F.wave * F.G + F.bid, NGW = F.G * NWAVES;
    for (int i = gw; i < 2 * M; i += NGW) {
        const int row = i >> 1; const int e = TOPE[i]; int base = 0;
#pragma unroll
        for (int k = 0; k < 8; ++k) base = (e == k) ? tb[k] : base;
        const int slot = base * 256 + POS[i];
        const float rs = RSTD3[row];
        const GAS f32x4* src = (const GAS f32x4*)(H + (size_t)row * D) + lane; GAS unsigned long long* dst = (GAS unsigned long long*)(XP + (size_t)slot * D) + lane;
#pragma unroll
        for (int j = 0; j < 4; ++j) { const f32x4 v = src[64 * j]; dst[64 * j] = (unsigned long long)pk2(v.x * rs, v.y * rs) | ((unsigned long long)pk2(v.z * rs, v.w * rs) << 32); }
        if (lane == 0) SLOT[i] = slot;
    }
}
__device__ __forceinline__ void p15_combine(Frame& F) {
    unsigned char* ws = F.ws; const int lane = F.lane;
    const float* H = (const float*)(ws + WS_H); const bf16* Y = (const bf16*)(ws + WS_Y); const int* SLOT = (const int*)(ws + WS_RT + 512 * 1024); const float* GATE = (const float*)(ws + WS_RT + 256 * 1024);
    const int gw = F.wave * F.G + F.bid, NGW = F.G * NWAVES;
    for (int row = gw; row < M; row += NGW) {
        const int s1 = SLOT[row * 2], s2 = SLOT[row * 2 + 1]; const float g1 = GATE[row * 2], g2 = GATE[row * 2 + 1];
        const GAS f32x4* hr = (const GAS f32x4*)(H + (size_t)row * D) + lane; GAS f32x4* orow = (GAS f32x4*)(F.out + (size_t)row * D) + lane;
        const GAS v2u* y1 = (const GAS v2u*)(Y + (size_t)s1 * D) + lane; const GAS v2u* y2 = (const GAS v2u*)(Y + (size_t)s2 * D) + lane;
#pragma unroll
        for (int j = 0; j < 4; ++j) { const f32x4 h = hr[64 * j]; const v2u a = y1[64 * j], c = y2[64 * j]; f32x4 o;
            o.x = h.x + (g1 * bflo(a.x) + g2 * bflo(c.x)); o.y = h.y + (g1 * bfhi(a.x) + g2 * bfhi(c.x)); o.z = h.z + (g1 * bflo(a.y) + g2 * bflo(c.y)); o.w = h.w + (g1 * bfhi(a.y) + g2 * bfhi(c.y)); orow[64 * j] = o; }
    }
}

constexpr int N_PHASES = 16;
#ifndef MK_ONE_LAUNCH
#define MK_ONE_LAUNCH 1
#endif
struct Args { const float* in[17]; float* out; unsigned char* ws; int ph_lo, ph_hi; };
__global__ void __launch_bounds__(NWAVES * 64, 2) yoco_fwd(Args args) {
    extern __shared__ __attribute__((aligned(16))) unsigned char lds[];
    Frame F;
    F.lds = (LAS unsigned char*)lds; F.MISC = (volatile LAS unsigned*)(F.lds + MISC_OFF);
    F.tid = threadIdx.x; F.lane = F.tid & 63; F.wave = __builtin_amdgcn_readfirstlane(F.tid >> 6); F.G = gridDim.x; F.bid = blockIdx.x;
    F.ws = args.ws; F.ctl = (gu32*)(args.ws + WS_CTL); F.out = args.out;
#pragma unroll
    for (int i = 0; i < 17; ++i) F.in[i] = args.in[i];
    for (int u = F.tid; u < (LDS_BYTES - LDSCTL_OFF) / 4; u += NWAVES * 64) ((LAS unsigned*)(F.lds + LDSCTL_OFF))[u] = 0u;
    __syncthreads();
    unsigned char* ws = args.ws;
    XcdBarrier bar; bar.bar = (unsigned*)(F.ctl + CW_BAR); bar.x = 0; bar.st = nullptr;
    if (MK_ONE_LAUNCH) bar = xcd_barrier_post((unsigned*)(F.ctl + CW_BAR), F.MISC + 8);
    const int lo = args.ph_lo, hi = args.ph_hi;
#define IN(k) (lo <= (k) && (k) < hi)
#define SEAM(k) do { if (MK_ONE_LAUNCH && IN((k) + 1)) xcd_barrier(bar); } while (0)
    bf16* XB = (bf16*)(ws + WS_XB); float* H = (float*)(ws + WS_H); bf16* AO = (bf16*)(ws + WS_AO);

    if (IN(0)) { p0_prologue(F); SEAM(0); }
    if (IN(1)) {
        pg8::Gemm g{XB, (const bf16*)(ws + WS_WIN), M, 2048, D}; pg8::StaticOrder S; S.init(M, 2048, F.G, F.bid);
        pg8::EpiPlainBf16 E{(bf16*)(ws + WS_PROJ), 2048, 0xffff};
        pg8::gemm_phase<pg8::EpiPlainBf16, pg8::StaticOrder, true, true>(F.lds, g, S, E); SEAM(1); }
    if (IN(2)) { p2_post(F); SEAM(2); }
    if (IN(3)) { p3_index(F); SEAM(3); }
    if (IN(4)) { p4_dsa(F); SEAM(4); }
    if (IN(5)) {
        pg8::Gemm g{AO, (const bf16*)(ws + WS_WOA), M, D, D}; pg8::StaticOrder S; S.init(M, D, F.G, F.bid);
        pg8::EpiResid E{F.in[IN_X], H, XB, (float*)(ws + WS_SS1)};
        pg8::gemm_phase<pg8::EpiResid, pg8::StaticOrder, true, true>(F.lds, g, S, E); SEAM(5); }
    if (IN(6)) {
        pg8::Gemm g{XB, (const bf16*)(ws + WS_WGU), M, 2 * FF, D}; pg8::StaticOrder S; S.init(M, 2 * FF, F.G, F.bid);
        pg8::EpiSwiGLU<false> E{(bf16*)(ws + WS_HF), FF, (const float*)(ws + WS_SS1)};
        pg8::gemm_phase<pg8::EpiSwiGLU<false>, pg8::StaticOrder, true, true>(F.lds, g, S, E); SEAM(6); }
    if (IN(7)) {
        pg8::Gemm g{(const bf16*)(ws + WS_HF), (const bf16*)(ws + WS_WD), M, D, FF}; pg8::StaticOrder S; S.init(M, D, F.G, F.bid);
        pg8::EpiResid E{H, H, XB, (float*)(ws + WS_SS2)};
        pg8::gemm_phase<pg8::EpiResid, pg8::StaticOrder, true, true>(F.lds, g, S, E); SEAM(7); }
    if (IN(8)) {
        { pg8::Gemm g{XB, (const bf16*)(ws + WS_WKVQ), M, 2048, D}; pg8::StaticOrder S; S.init(M, 2048, F.G, F.bid);
          pg8::EpiScaleBf16 E{(bf16*)(ws + WS_KQ), 2048, (const float*)(ws + WS_SS2)};
          pg8::gemm_phase<pg8::EpiScaleBf16, pg8::StaticOrder, true, true>(F.lds, g, S, E); }
        { pg8::Gemm g{(const bf16*)(ws + WS_WKVQ) + (size_t)2048 * D, XB, D, M, D}; pg8::StaticOrder S; S.init(D, M, F.G, F.bid);
          pg8::EpiScaleColBf16 E{(bf16*)(ws + WS_VT), M, (const float*)(ws + WS_SS2)};
          pg8::gemm_phase<pg8::EpiScaleColBf16, pg8::StaticOrder, true, true>(F.lds, g, S, E); }
        SEAM(8); }
    if (IN(9)) { p9_sb(F); SEAM(9); }
    if (IN(10)) {
        pg8::Gemm g{AO, (const bf16*)(ws + WS_WOB), M, D, D}; pg8::StaticOrder S; S.init(M, D, F.G, F.bid);
        pg8::EpiResid E{H, H, XB, (float*)(ws + WS_SS3)};
        pg8::gemm_phase<pg8::EpiResid, pg8::StaticOrder, true, true>(F.lds, g, S, E); SEAM(10); }
    if (IN(11)) { p11_router(F); SEAM(11); }
    if (IN(12)) { p12_permute(F); SEAM(12); }
    if (IN(13)) {
        pg8::MoeOrder S; moe_bases(F, S.tb); S.npn = 22; S.G = F.G; S.c = F.bid;
        pg8::Gemm g{(const bf16*)(ws + WS_XPERM), (const bf16*)(ws + WS_WGUM), MAXSLOT, NE * 2 * FF, D};
        pg8::EpiSwiGLU<true> E{(bf16*)(ws + WS_HM), FF, nullptr};
        pg8::gemm_phase<pg8::EpiSwiGLU<true>, pg8::MoeOrder, true, true>(F.lds, g, S, E); SEAM(13); }
    if (IN(14)) {
        pg8::MoeOrder S; moe_bases(F, S.tb); S.npn = 4; S.G = F.G; S.c = F.bid;
        pg8::Gemm g{(const bf16*)(ws + WS_HM), (const bf16*)(ws + WS_WDM), MAXSLOT, NE * D, FF};
        pg8::EpiPlainBf16 E{(bf16*)(ws + WS_Y), D, 3};
        pg8::gemm_phase<pg8::EpiPlainBf16, pg8::MoeOrder, true, true>(F.lds, g, S, E); SEAM(14); }
    if (IN(15)) { p15_combine(F); }
#undef IN
#undef SEAM
}

extern "C" void kernel_launch(void* const* d_in, const int* in_sizes, int n_in, void* d_out, int out_size, void* d_ws, size_t ws_size, hipStream_t stream) {
    static int grid = 0;
    if (grid == 0) {
        if (n_in != 17 || out_size != M * D || ws_size < WS_END) { fprintf(stderr, "kernel_launch: unexpected problem (n_in %d, out %d, ws %zu < %zu)\n", n_in, out_size, ws_size, (size_t)WS_END); grid = -1; return; }
        int dev = 0, cus = 0, per_cu = 0;
        if (hipGetDevice(&dev) != hipSuccess || hipDeviceGetAttribute(&cus, hipDeviceAttributeMultiprocessorCount, dev) != hipSuccess) { grid = -1; return; }
        if (hipFuncSetAttribute((const void*)yoco_fwd, hipFuncAttributeMaxDynamicSharedMemorySize, LDS_BYTES) != hipSuccess) { fprintf(stderr, "kernel_launch: hipFuncSetAttribute failed\n"); grid = -1; return; }
        if (hipOccupancyMaxActiveBlocksPerMultiprocessor(&per_cu, (const void*)yoco_fwd, NWAVES * 64, LDS_BYTES) != hipSuccess || per_cu < 1) fprintf(stderr, "kernel_launch: occupancy query says %d\n", per_cu);
        (void)hipGetLastError();
        grid = cus;
    }
    if (grid < 0) return;
    if (hipMemsetAsync((char*)d_ws + WS_CTL, 0, CTL_ZERO_BYTES, stream) != hipSuccess) return;
    Args a{};
    for (int i = 0; i < 17; ++i) a.in[i] = (const float*)d_in[i];
    a.out = (float*)d_out; a.ws = (unsigned char*)d_ws;
#if MK_ONE_LAUNCH
    a.ph_lo = 0; a.ph_hi = N_PHASES;
    hipLaunchKernelGGL(yoco_fwd, dim3(grid), dim3(NWAVES * 64), LDS_BYTES, stream, a);
#else
    for (int p = 0; p < N_PHASES; ++p) { a.ph_lo = p; a.ph_hi = p + 1; hipLaunchKernelGGL(yoco_fwd, dim3(grid), dim3(NWAVES * 64), LDS_BYTES, stream, a); }
#endif
}
```

```cpp
#include <hip/hip_runtime.h>
#include <cstdio>
#include <cstdint>
namespace pg8 {
#define PG8_LAS __attribute__((address_space(3)))
typedef unsigned short bf16_t;
typedef short bf16x8 __attribute__((ext_vector_type(8)));
typedef float f32x4 __attribute__((ext_vector_type(4)));
typedef unsigned u32x4 __attribute__((ext_vector_type(4)));
constexpr int BM = 256, BK = 64, HALF = 128, HTB = HALF * BK * 2  , STAGE_BYTES = 8 * HTB, NXCD = 8, WGM = 8;

__host__ __device__ __forceinline__ int lds_byte(int r, int c) { const int st = (r >> 4) * 2 + (c >> 5), rr = r & 15, cc = c & 31, ob = rr * 64 + cc * 2; return st * 1024 + (ob ^ (((ob >> 9) & 1) << 5)); }
__host__ __device__ __forceinline__ void stage_rc(int b, int& R, int& C) { const int st = b / 1024, sb = b % 1024, swz = sb ^ (((sb >> 9) & 1) << 5); R = (st >> 1) * 16 + swz / 64; C = (st & 1) * 32 + (swz % 64) / 2; }
__host__ __device__ __forceinline__ int perm32(int rho) { const int n = rho >> 4, i = rho & 15; return 8 * (i >> 2) + 4 * n + (i & 3); }

struct Unit { int pm, pn; int koff = 0; };
struct Gemm { const bf16_t* A; const bf16_t* Bt; int M, N, K; int ld = 0; };

struct StaticOrder {
    int nM, nN, nwg, G, c;
    __host__ __device__ void init(int M, int N, int G_, int c_) { nM = M / BM; nN = N / BM; nwg = nM * nN; G = G_; c = c_; }
    __host__ __device__ bool next(int i, Unit& u) const {
        const long L = (long)i * G + c; if (L >= nwg) return false;
        int wgid = (int)L; { const int q = nwg / NXCD, r = nwg % NXCD, xcd = wgid % NXCD, off = wgid / NXCD; wgid = (xcd < r ? xcd * (q + 1) : r * (q + 1) + (xcd - r) * q) + off; }
        const int nig = WGM * nN, gid = wgid / nig, fm = gid * WGM, gsz = (nM - fm) < WGM ? (nM - fm) : WGM;
        u.pm = fm + ((wgid % nig) % gsz); u.pn = (wgid % nig) / gsz; return true;
    }
    __device__ __forceinline__ void a_ready(const Unit&) const {}
    __device__ __forceinline__ void done(const Unit&) const {}
};

__device__ __forceinline__ unsigned cvt_pk_bf16(float lo, float hi) { unsigned r; asm volatile("v_cvt_pk_bf16_f32 %0, %1, %2" : "=v"(r) : "v"(lo), "v"(hi)); return r; }
typedef unsigned u32x2 __attribute__((ext_vector_type(2)));
constexpr float RMS_EPS = 1e-6f;
__device__ __forceinline__ float rstd16(const float* p) {
    const f32x4 a = *(const f32x4*)p, b = *(const f32x4*)(p + 4), c = *(const f32x4*)(p + 8), d = *(const f32x4*)(p + 12);
    const float s = (((a[0] + a[1]) + (a[2] + a[3])) + ((b[0] + b[1]) + (b[2] + b[3]))) + (((c[0] + c[1]) + (c[2] + c[3])) + ((d[0] + d[1]) + (d[2] + d[3])));
    return 1.0f / sqrtf(s * (1.0f / 1024.0f) + RMS_EPS);
}
struct EpiScaleBf16 {
    static constexpr bool PERM = true, AFTER_DRAIN = false;
    bf16_t* O; int ldc; const float* ss;
    __device__ __forceinline__ void operator()(const f32x4 (&acc)[2][2][4][2], const Unit& u, int wr, int wc, int fr, int fq) const {
        const int row0 = u.pm * BM + wr * 64 + fr, col0 = u.pn * BM + wc * 32 + 8 * fq;
        float rsv[2][4];
#pragma unroll
        for (int ai = 0; ai < 2; ++ai)
#pragma unroll
            for (int m = 0; m < 4; ++m) rsv[ai][m] = rstd16(ss + (size_t)(row0 + ai * HALF + m * 16) * 16);
#pragma unroll
        for (int ai = 0; ai < 2; ++ai)
#pragma unroll
            for (int m = 0; m < 4; ++m) { const int row = row0 + ai * HALF + m * 16; const float rs = rsv[ai][m]; bf16_t* rowp = O + (size_t)row * ldc + col0;
#pragma unroll
                for (int bj = 0; bj < 2; ++bj) { const f32x4 v0 = acc[ai][bj][m][0] * rs, v1 = acc[ai][bj][m][1] * rs;
                    u32x4 w; w.x = cvt_pk_bf16(v0[0], v0[1]); w.y = cvt_pk_bf16(v0[2], v0[3]); w.z = cvt_pk_bf16(v1[0], v1[1]); w.w = cvt_pk_bf16(v1[2], v1[3]);
                    *(u32x4*)(rowp + bj * HALF) = w; } }
    }
};
struct EpiPlainBf16 {
    static constexpr bool PERM = true, AFTER_DRAIN = false;
    bf16_t* O; int ldc; int pnmask;
    __device__ __forceinline__ void operator()(const f32x4 (&acc)[2][2][4][2], const Unit& u, int wr, int wc, int fr, int fq) const {
        const int row0 = u.pm * BM + wr * 64 + fr, col0 = (u.pn & pnmask) * BM + wc * 32 + 8 * fq;
#pragma unroll
        for (int ai = 0; ai < 2; ++ai)
#pragma unroll
            for (int m = 0; m < 4; ++m) { bf16_t* rowp = O + (size_t)(row0 + ai * HALF + m * 16) * ldc + col0;
#pragma unroll
                for (int bj = 0; bj < 2; ++bj) { const f32x4 v0 = acc[ai][bj][m][0], v1 = acc[ai][bj][m][1];
                    u32x4 w; w.x = cvt_pk_bf16(v0[0], v0[1]); w.y = cvt_pk_bf16(v0[2], v0[3]); w.z = cvt_pk_bf16(v1[0], v1[1]); w.w = cvt_pk_bf16(v1[2], v1[3]);
                    *(u32x4*)(rowp + bj * HALF) = w; } }
    }
};
struct EpiScaleColBf16 {
    static constexpr bool PERM = true, AFTER_DRAIN = false;
    bf16_t* O; int ldc; const float* ss;
    __device__ __forceinline__ void operator()(const f32x4 (&acc)[2][2][4][2], const Unit& u, int wr, int wc, int fr, int fq) const {
        const int row0 = u.pm * BM + wr * 64 + fr, col0 = u.pn * BM + wc * 32 + 8 * fq;
        f32x4 rs[2][2];
#pragma unroll
        for (int bj = 0; bj < 2; ++bj)
#pragma unroll
            for (int n = 0; n < 2; ++n)
#pragma unroll
                for (int e = 0; e < 4; ++e) rs[bj][n][e] = rstd16(ss + (size_t)(col0 + bj * HALF + 4 * n + e) * 16);
#pragma unroll
        for (int ai = 0; ai < 2; ++ai)
#pragma unroll
            for (int m = 0; m < 4; ++m) { const int row = row0 + ai * HALF + m * 16; bf16_t* rowp = O + (size_t)row * ldc + col0;
#pragma unroll
                for (int bj = 0; bj < 2; ++bj) { const f32x4 v0 = acc[ai][bj][m][0] * rs[bj][0], v1 = acc[ai][bj][m][1] * rs[bj][1];
                    u32x4 w; w.x = cvt_pk_bf16(v0[0], v0[1]); w.y = cvt_pk_bf16(v0[2], v0[3]); w.z = cvt_pk_bf16(v1[0], v1[1]); w.w = cvt_pk_bf16(v1[2], v1[3]);
                    *(u32x4*)(rowp + bj * HALF) = w; } }
    }
};
struct EpiResid {
    static constexpr bool PERM = false, AFTER_DRAIN = false;
    const float* base; float* H; bf16_t* XB; float* ssp;
    __device__ __forceinline__ void operator()(const f32x4 (&acc)[2][2][4][2], const Unit& u, int wr, int wc, int fr, int fq) const {
        const int row0 = u.pm * BM + wr * 64 + fr, col0 = u.pn * BM + wc * 32 + 4 * fq;
#pragma unroll
        for (int ai = 0; ai < 2; ++ai) {
            f32x4 bv[4][2][2];
#pragma unroll
            for (int m = 0; m < 4; ++m)
#pragma unroll
                for (int bj = 0; bj < 2; ++bj)
#pragma unroll
                    for (int n = 0; n < 2; ++n) bv[m][bj][n] = *(const f32x4*)(base + (size_t)(row0 + ai * HALF + m * 16) * 1024 + col0 + bj * HALF + n * 16);
#pragma unroll
            for (int m = 0; m < 4; ++m) { const int row = row0 + ai * HALF + m * 16; float q = 0.f;
#pragma unroll
                for (int bj = 0; bj < 2; ++bj)
#pragma unroll
                    for (int n = 0; n < 2; ++n) { const size_t off = (size_t)row * 1024 + col0 + bj * HALF + n * 16;
                        const f32x4 v = bv[m][bj][n] + acc[ai][bj][m][n]; *(f32x4*)(H + off) = v;
                        q += (v[0] * v[0] + v[1] * v[1]) + (v[2] * v[2] + v[3] * v[3]);
                        u32x2 w; w.x = cvt_pk_bf16(v[0], v[1]); w.y = cvt_pk_bf16(v[2], v[3]); *(u32x2*)(XB + off) = w; }
                q += __shfl_xor(q, 16); q += __shfl_xor(q, 32);
                if (fq == 0) ssp[(size_t)row * 16 + u.pn * 4 + wc] = q; }
        }
    }
};
__device__ __forceinline__ float silu_mul(float g, float u) { return g * __builtin_amdgcn_rcpf(1.0f + __builtin_amdgcn_exp2f(g * -1.4426950408889634f)) * u; }
template <bool MOE> struct EpiSwiGLU {
    static constexpr bool PERM = true, AFTER_DRAIN = false;
    bf16_t* O; int ldc; const float* ss;
    __device__ __forceinline__ void operator()(const f32x4 (&acc)[2][2][4][2], const Unit& u, int wr, int wc, int fr, int fq) const {
        const int row0 = u.pm * BM + wr * 64 + fr; const int pnl = MOE ? (u.pn % 22) : u.pn; const int col0 = pnl * HALF + wc * 32 + 8 * fq;
        float rsv[2][4];
#pragma unroll
        for (int ai = 0; ai < 2; ++ai)
#pragma unroll
            for (int m = 0; m < 4; ++m) { const int row = row0 + ai * HALF + m * 16; rsv[ai][m] = MOE ? 1.0f : rstd16(ss + (size_t)row * 16); }
#pragma unroll
        for (int ai = 0; ai < 2; ++ai)
#pragma unroll
            for (int m = 0; m < 4; ++m) { const int row = row0 + ai * HALF + m * 16; const float rs = rsv[ai][m];
                const f32x4 g0 = acc[ai][0][m][0] * rs, g1 = acc[ai][0][m][1] * rs, u0 = acc[ai][1][m][0] * rs, u1 = acc[ai][1][m][1] * rs;
                u32x4 w; w.x = cvt_pk_bf16(silu_mul(g0[0], u0[0]), silu_mul(g0[1], u0[1])); w.y = cvt_pk_bf16(silu_mul(g0[2], u0[2]), silu_mul(g0[3], u0[3]));
                w.z = cvt_pk_bf16(silu_mul(g1[0], u1[0]), silu_mul(g1[1], u1[1])); w.w = cvt_pk_bf16(silu_mul(g1[2], u1[2]), silu_mul(g1[3], u1[3]));
                *(u32x4*)(O + (size_t)row * ldc + col0) = w; }
    }
};
struct MoeOrder {
    int tb[9]; int npn, G, c;
    __device__ __forceinline__ bool next(int i, Unit& u) const {
        const int L = i * G + c; if (L >= tb[8] * npn) return false;
        const int t = L / npn, j = L - t * npn; int e = 0;
#pragma unroll
        for (int k = 1; k < 8; ++k) e += (t >= tb[k]) ? 1 : 0;
        u.pm = t; u.pn = e * npn + j; return true;
    }
    __device__ __forceinline__ void a_ready(const Unit&) const {}
    __device__ __forceinline__ void done(const Unit&) const {}
};

template <class Epi, class Sched, bool ALIGN_EPI = false, bool SP2 = false>
__device__ __forceinline__ void gemm_phase(PG8_LAS unsigned char* lds, const Gemm g, const Sched& S, const Epi& E) {
    const int tid = threadIdx.x, wid = __builtin_amdgcn_readfirstlane(tid >> 6), lane = tid & 63, wr = wid >> 2, wc = wid & 3, fr = lane & 15, fq = lane >> 4;
    const int K = g.K, nt = K / BK, LD = g.ld ? g.ld : g.K;
    unsigned voffA[2], voffB[2];
#pragma unroll
    for (int i = 0; i < 2; ++i) { int R, C; stage_rc(tid * 16 + i * 8192, R, C); const int Rb = Epi::PERM ? ((R & ~31) + perm32(R & 31)) : R;
        voffA[i] = (unsigned)(R * LD + C) * 2u; voffB[i] = (unsigned)(Rb * LD + C) * 2u; }
    const size_t kstep = (size_t)(BK * 2);
    const size_t hstep = (size_t)HALF * LD * 2;
    const size_t tstep = 2 * hstep;
    const unsigned ldsw = (unsigned)wid * 1024u;
    const int aoff = lds_byte(wr * 64 + fr, fq * 8), boff = lds_byte(wc * 32 + fr, fq * 8);
#define PG8_SA(b, h) (((b) * 2 + (h)) * HTB)
#define PG8_SB(b, h) ((4 + (b) * 2 + (h)) * HTB)
#define PG8_STAGE(bufoff, gbase, voff) do { _Pragma("unroll") for (int _i = 0; _i < 2; ++_i) \
        __builtin_amdgcn_global_load_lds((const unsigned*)((const char*)(gbase) + (voff)[_i]), (PG8_LAS unsigned*)(lds + (bufoff) + ldsw + _i * 8192), 16, 0, 0); } while (0)
#define PG8_LDA(dst, b, h) do { _Pragma("unroll") for (int m = 0; m < 4; ++m) _Pragma("unroll") for (int k = 0; k < 2; ++k) dst[m][k] = *(const PG8_LAS bf16x8*)(lds + PG8_SA(b, h) + aoff + m * 2048 + k * 1024); } while (0)
#define PG8_LDB(dst, b, h) do { _Pragma("unroll") for (int n = 0; n < 2; ++n) _Pragma("unroll") for (int k = 0; k < 2; ++k) dst[n][k] = *(const PG8_LAS bf16x8*)(lds + PG8_SB(b, h) + boff + n * 2048 + k * 1024); } while (0)
#define PG8_MMA(ai, bj, At, Bt) do { __builtin_amdgcn_s_setprio(1); _Pragma("unroll") for (int m = 0; m < 4; ++m) _Pragma("unroll") for (int n = 0; n < 2; ++n) _Pragma("unroll") for (int k = 0; k < 2; ++k) \
        acc[ai][bj][m][n] = __builtin_amdgcn_mfma_f32_16x16x32_bf16(Bt[n][k], At[m][k], acc[ai][bj][m][n], 0, 0, 0); __builtin_amdgcn_s_setprio(0); } while (0)
#define PG8_WAIT_V(n) asm volatile("s_waitcnt vmcnt(" #n ")" ::: "memory")
#define PG8_WAIT_L(n) asm volatile("s_waitcnt lgkmcnt(" #n ")" ::: "memory")
#define PG8_BAR __builtin_amdgcn_s_barrier()
#define PG8_SCHED __builtin_amdgcn_sched_barrier(0)
    Unit cur, nxt; int ui = 0;
    if (!S.next(0, cur)) return;
    f32x4 acc[2][2][4][2];
#pragma unroll
    for (int a = 0; a < 2; ++a)
#pragma unroll
        for (int b = 0; b < 2; ++b)
#pragma unroll
            for (int m = 0; m < 4; ++m)
#pragma unroll
                for (int n = 0; n < 2; ++n) acc[a][b][m][n] = (f32x4){0.f, 0.f, 0.f, 0.f};
    bf16x8 At[4][2], B0[2][2], B1[2][2];
    const char* cA = (const char*)g.A + (size_t)cur.pm * tstep + cur.koff; const char* cB = (const char*)g.Bt + (size_t)cur.pn * tstep + cur.koff;
    S.a_ready(cur);
    if constexpr (SP2) {
        PG8_STAGE(PG8_SB(0, 0), cB, voffB); PG8_STAGE(PG8_SB(0, 1), cB + hstep, voffB); PG8_STAGE(PG8_SA(0, 0), cA, voffA); PG8_STAGE(PG8_SA(0, 1), cA + hstep, voffA);
        if (wr == 1) PG8_BAR;
        PG8_WAIT_V(2); PG8_BAR;
        PG8_STAGE(PG8_SB(1, 0), cB + kstep, voffB); PG8_STAGE(PG8_SA(1, 0), cA + kstep, voffA); PG8_STAGE(PG8_SB(1, 1), cB + hstep + kstep, voffB);
        PG8_WAIT_V(6); PG8_BAR;
    } else {
        PG8_STAGE(PG8_SB(0, 0), cB, voffB); PG8_STAGE(PG8_SA(0, 0), cA, voffA); PG8_STAGE(PG8_SB(0, 1), cB + hstep, voffB); PG8_STAGE(PG8_SA(0, 1), cA + hstep, voffA);
        if (wr == 1) PG8_BAR;
        PG8_WAIT_V(4); PG8_BAR;
        PG8_STAGE(PG8_SB(1, 0), cB + kstep, voffB); PG8_STAGE(PG8_SA(1, 0), cA + kstep, voffA); PG8_STAGE(PG8_SB(1, 1), cB + hstep + kstep, voffB);
        PG8_WAIT_V(6); PG8_BAR;
    }
    for (;;) {
        const bool has_next = S.next(ui + 1, nxt);
        const char* nA = has_next ? (const char*)g.A + (size_t)nxt.pm * tstep + nxt.koff : cA; const char* nB = has_next ? (const char*)g.Bt + (size_t)nxt.pn * tstep + nxt.koff : cB;
        for (int t = 0; t < nt; t += 2) {
            const bool last = (t == nt - 2);
            const char* a1 = cA + (size_t)(t + 1) * kstep;
            const char* a2 = last ? nA : cA + (size_t)(t + 2) * kstep; const char* b2 = last ? nB : cB + (size_t)(t + 2) * kstep;
            const char* a3 = a2 + kstep; const char* b3 = b2 + kstep;
            if (last && has_next) S.a_ready(nxt);
            if constexpr (SP2) {
            PG8_LDB(B0, 0, 0); PG8_LDB(B1, 0, 1); PG8_SCHED; PG8_LDA(At, 0, 0); PG8_STAGE(PG8_SA(1, 1), a1 + hstep, voffA);
            PG8_WAIT_V(8); PG8_WAIT_L(0); PG8_BAR; PG8_MMA(0, 0, At, B0); PG8_MMA(0, 1, At, B1); PG8_BAR; PG8_SCHED;
            PG8_LDA(At, 0, 1); PG8_STAGE(PG8_SB(0, 0), b2, voffB); PG8_STAGE(PG8_SB(0, 1), b2 + hstep, voffB); PG8_STAGE(PG8_SA(0, 0), a2, voffA);
            PG8_WAIT_V(8); PG8_WAIT_L(0); PG8_BAR; PG8_MMA(1, 0, At, B0); PG8_MMA(1, 1, At, B1); PG8_BAR; PG8_SCHED;
            PG8_LDB(B0, 1, 0); PG8_LDB(B1, 1, 1); PG8_SCHED; PG8_LDA(At, 1, 0); PG8_STAGE(PG8_SA(0, 1), a2 + hstep, voffA);
            PG8_WAIT_V(8); PG8_WAIT_L(0); PG8_BAR; PG8_MMA(0, 0, At, B0); PG8_MMA(0, 1, At, B1); PG8_BAR; PG8_SCHED;
            PG8_LDA(At, 1, 1); PG8_STAGE(PG8_SB(1, 0), b3, voffB); PG8_STAGE(PG8_SB(1, 1), b3 + hstep, voffB); PG8_STAGE(PG8_SA(1, 0), a3, voffA);
            PG8_WAIT_V(8); PG8_WAIT_L(0); PG8_BAR; PG8_MMA(1, 0, At, B0); PG8_MMA(1, 1, At, B1); PG8_BAR; PG8_SCHED;
            } else {
            PG8_LDB(B0, 0, 0); PG8_SCHED; PG8_LDA(At, 0, 0); PG8_STAGE(PG8_SA(1, 1), a1 + hstep, voffA);
            PG8_WAIT_L(8); PG8_BAR; PG8_WAIT_L(0); PG8_MMA(0, 0, At, B0); PG8_BAR; PG8_SCHED;
            PG8_LDB(B1, 0, 1); PG8_STAGE(PG8_SB(0, 0), b2, voffB);
            PG8_BAR; PG8_WAIT_L(0); PG8_MMA(0, 1, At, B1); PG8_BAR;
            PG8_LDA(At, 0, 1); PG8_STAGE(PG8_SA(0, 0), a2, voffA);
            PG8_BAR; PG8_WAIT_L(0); PG8_MMA(1, 0, At, B0); PG8_BAR; PG8_SCHED;
            PG8_STAGE(PG8_SB(0, 1), b2 + hstep, voffB);
            PG8_WAIT_V(6); PG8_BAR; PG8_MMA(1, 1, At, B1); PG8_BAR;
            PG8_LDB(B0, 1, 0); PG8_SCHED; PG8_LDA(At, 1, 0); PG8_STAGE(PG8_SA(0, 1), a2 + hstep, voffA);
            PG8_WAIT_L(8); PG8_BAR; PG8_WAIT_L(0); PG8_MMA(0, 0, At, B0); PG8_BAR; PG8_SCHED;
            PG8_LDB(B1, 1, 1); PG8_STAGE(PG8_SB(1, 0), b3, voffB);
            PG8_BAR; PG8_WAIT_L(0); PG8_MMA(0, 1, At, B1); PG8_BAR;
            PG8_LDA(At, 1, 1); PG8_STAGE(PG8_SA(1, 0), a3, voffA);
            PG8_BAR; PG8_WAIT_L(0); PG8_MMA(1, 0, At, B0); PG8_BAR; PG8_SCHED;
            PG8_STAGE(PG8_SB(1, 1), b3 + hstep, voffB);
            PG8_WAIT_V(6); PG8_BAR; PG8_MMA(1, 1, At, B1); PG8_BAR;
            }
        }
        if constexpr (ALIGN_EPI) { if (wr == 0) PG8_BAR; }
        if constexpr (!Epi::AFTER_DRAIN) { E(acc, cur, wr, wc, fr, fq); S.done(cur); }
        if (!has_next) break;
#pragma unroll
        for (int a = 0; a < 2; ++a)
#pragma unroll
            for (int b = 0; b < 2; ++b)
#pragma unroll
                for (int m = 0; m < 4; ++m)
#pragma unroll
                    for (int n = 0; n < 2; ++n) acc[a][b][m][n] = (f32x4){0.f, 0.f, 0.f, 0.f};
        cur = nxt; cA = nA; cB = nB; ++ui;
        if constexpr (ALIGN_EPI) { if (wr == 1) PG8_BAR; }
    }
    PG8_WAIT_V(0);
    if constexpr (!ALIGN_EPI) { if (wr == 0) PG8_BAR; }
    PG8_BAR;
    if constexpr (Epi::AFTER_DRAIN) { E.fused(acc, cur, wr, wc, fr, fq, lds, wid, lane); S.done(cur); }
#undef PG8_SA
#undef PG8_SB
#undef PG8_STAGE
#undef PG8_LDA
#undef PG8_LDB
#undef PG8_MMA
#undef PG8_WAIT_V
#undef PG8_WAIT_L
#undef PG8_BAR
#undef PG8_SCHED
}
}

constexpr int NWAVES = 8;
constexpr int BATCH = 2, SEQ = 8192, D = 1024, M = BATCH * SEQ;
constexpr int HD = 128, NH = 8, NKV = 2, NIH = 8, IDX = 64, TOPK = 256;
constexpr int A_IN = 2120, FF = 2816, NE = 8;
constexpr int MAXSLOT = 34816;
constexpr float QSCALE = 0.12751743082459868f;
constexpr float SBSCALE = 0.08838834764831845f;
constexpr float WISCALE = 0.04419417382415922f;
constexpr size_t MiB = 1u << 20;
constexpr size_t WS_CTL = 0, CTL_ZERO_BYTES = 1 * MiB;
constexpr size_t WS_WIN = 2 * MiB, WS_WTAIL = 6 * MiB, WS_WOA = 7 * MiB, WS_WGU = 9 * MiB, WS_WD = 20 * MiB, WS_WKVQ = 26 * MiB, WS_WOB = 32 * MiB, WS_WGUM = 34 * MiB, WS_WDM = 122 * MiB;
constexpr size_t WS_H = 166 * MiB, WS_XB = 230 * MiB, WS_SS0 = 262 * MiB, WS_SS1 = 263 * MiB, WS_SS2 = 264 * MiB, WS_SS3 = 265 * MiB;
constexpr size_t WS_T = 266 * MiB;
constexpr size_t WS_PROJ = WS_T, WS_QF = 330 * MiB, WS_KVF = 362 * MiB, WS_QIF = 378 * MiB, WS_KIF = 394 * MiB, WS_WIF = 396 * MiB, WS_SEL = 397 * MiB, WS_AO = 413 * MiB;
constexpr size_t WS_HF = WS_T, WS_KQ = WS_T, WS_VT = 330 * MiB;
constexpr size_t WS_XPERM = WS_T, WS_HM = 334 * MiB, WS_Y = 521 * MiB;
constexpr size_t WS_RT = 590 * MiB;
constexpr size_t WS_END = 591 * MiB;
constexpr int CW_CNT = 64;
constexpr int CW_BAR = 4096;
constexpr int RING_BYTES = 131072, LDSCTL_OFF = RING_BYTES, MISC_OFF = LDSCTL_OFF + 320, LDS_BYTES = 147456;

#define GAS __attribute__((address_space(1)))
#define LAS __attribute__((address_space(3)))
typedef unsigned short bf16;
typedef unsigned v4u __attribute__((ext_vector_type(4)));
typedef unsigned v2u __attribute__((ext_vector_type(2)));
typedef float f32x4 __attribute__((ext_vector_type(4)));
typedef short bf16x8 __attribute__((ext_vector_type(8)));
typedef float f32x16 __attribute__((ext_vector_type(16)));
typedef GAS unsigned gu32;
#define RLX_AGENT __ATOMIC_RELAXED, __HIP_MEMORY_SCOPE_AGENT
#define LDS_WAIT() asm volatile("s_waitcnt lgkmcnt(0)" ::: "memory")
#define VM_WAIT() asm volatile("s_waitcnt vmcnt(0)" ::: "memory")
__device__ __forceinline__ unsigned f2bf(float f) { unsigned u = __builtin_bit_cast(unsigned, f); return (u + 0x7fffu + ((u >> 16) & 1u)) >> 16; }
__device__ __forceinline__ unsigned pk2(float lo, float hi) { return f2bf(lo) | (f2bf(hi) << 16); }
__device__ __forceinline__ float bflo(unsigned w) { return __uint_as_float(w << 16); }
__device__ __forceinline__ float bfhi(unsigned w) { return __uint_as_float(w & 0xffff0000u); }
__device__ __forceinline__ float wave_sum(float v) {
#pragma unroll
    for (int o = 1; o < 64; o <<= 1) v += __shfl_xor(v, o);
    return v;
}
__device__ __forceinline__ float wave_max(float v) {
#pragma unroll
    for (int o = 1; o < 64; o <<= 1) v = fmaxf(v, __shfl_xor(v, o));
    return v;
}
__device__ __forceinline__ void sincos_acc(float a, float& c, float& s) {
    const double x = (double)a; const double n = __builtin_rint(x * 0.63661977236758134308);
    const double r = __builtin_fma(-n, 6.123233995736766035869e-17, __builtin_fma(-n, 1.57079632679489655800, x)); const double r2 = r * r;
    double sn = 1.0 - r2 * (1.0 / 156.0); sn = 1.0 - r2 * (1.0 / 110.0) * sn; sn = 1.0 - r2 * (1.0 / 72.0) * sn; sn = 1.0 - r2 * (1.0 / 42.0) * sn; sn = 1.0 - r2 * (1.0 / 20.0) * sn; sn = 1.0 - r2 * (1.0 / 6.0) * sn; sn *= r;
    double cs = 1.0 - r2 * (1.0 / 182.0); cs = 1.0 - r2 * (1.0 / 132.0) * cs; cs = 1.0 - r2 * (1.0 / 90.0) * cs; cs = 1.0 - r2 * (1.0 / 56.0) * cs; cs = 1.0 - r2 * (1.0 / 30.0) * cs; cs = 1.0 - r2 * (1.0 / 12.0) * cs; cs = 1.0 - r2 * 0.5 * cs;
    const int q = ((int)n) & 3;
    const double cq = (q == 0) ? cs : (q == 1) ? -sn : (q == 2) ? -cs : sn;
    const double sq = (q == 0) ? sn : (q == 1) ? cs : (q == 2) ? -sn : -cs;
    c = (float)cq; s = (float)sq;
}
__device__ const float INV_Q[16] = {1.000000000e+00f, 4.403665960e-01f, 1.939227432e-01f, 8.539710194e-02f, 3.760603070e-02f, 1.656043902e-02f, 7.292664610e-03f, 3.211445874e-03f,
                                    1.414213562e-03f, 6.227723788e-04f, 2.742481884e-04f, 1.207697351e-04f, 5.318296098e-05f, 2.341999971e-05f, 1.031338616e-05f, 4.541670478e-06f};
__device__ const float INV_I[8] = {1.000000000e+00f, 1.939227432e-01f, 3.760603070e-02f, 7.292664610e-03f, 1.414213562e-03f, 2.742481884e-04f, 5.318296098e-05f, 1.031338616e-05f};

#define XB_TMO      128
#define XB_XCNT(j)  (256  + 64 * (j))
#define XB_XSUB(j)  (1280 + 64 * (j))
#define XB_XGEN(j)  (2304 + 64 * (j))
#define XB_TOP      3328
#define XB_TOPGEN   3392
#define XCD_BAR_WORDS 3456
#define XB_SPIN_CAP (1u << 18)

__device__ __forceinline__ unsigned xb_ld(unsigned* p)              { return __hip_atomic_load(p, __ATOMIC_RELAXED, __HIP_MEMORY_SCOPE_AGENT); }
__device__ __forceinline__ unsigned xb_add(unsigned* p, unsigned v) { return __hip_atomic_fetch_add(p, v, __ATOMIC_RELAXED, __HIP_MEMORY_SCOPE_AGENT); }
__device__ __forceinline__ unsigned xb_xcc_id() { return (unsigned)__builtin_amdgcn_s_getreg((3 << 11) | 20) & 0xFu; }
#define XB_SPIN(cond, bar) do { unsigned _sp = 0; while (cond) { __builtin_amdgcn_s_sleep(1); \
    if ((++_sp & 255u) == 0u) { if (xb_ld(&(bar)[XB_TMO])) break; if (_sp > XB_SPIN_CAP) { atomicAdd(&(bar)[XB_TMO], 1u); break; } } } } while (0)

struct XcdBarrier {
    unsigned* bar; unsigned x;
    volatile LAS unsigned* st;
};

__device__ __forceinline__ XcdBarrier xcd_barrier_post(unsigned* bar, volatile LAS unsigned* st) {
    XcdBarrier b; b.bar = bar; b.x = xb_xcc_id(); b.st = st;
    if (threadIdx.x == 0) (void)xb_add(&bar[XB_XCNT(b.x)], 1u);
    return b;
}
__device__ __forceinline__ void xcd_barrier_complete(unsigned* bar, unsigned x, unsigned& nloc, unsigned& nx) {
    const unsigned G = gridDim.x * gridDim.y * gridDim.z;
    unsigned sum, cnt, mine, sp = 0u;
    for (;;) {
        sum = 0u; cnt = 0u; mine = 0u;
#pragma unroll
        for (unsigned j = 0; j < 16; ++j) { const unsigned c = xb_ld(&bar[XB_XCNT(j)]); sum += c; cnt += (c > 0u) ? 1u : 0u; mine = (j == x) ? c : mine; }
        if (sum == G) break;
        __builtin_amdgcn_s_sleep(1);
        if ((++sp & 255u) == 0u) { if (xb_ld(&bar[XB_TMO])) break; if (sp > XB_SPIN_CAP) { atomicAdd(&bar[XB_TMO], 1u); break; } }
    }
    nloc = mine > 0u ? mine : 1u; nx = cnt > 0u ? cnt : 1u;
}

__device__ __forceinline__ void xcd_barrier(const XcdBarrier& b) {
    asm volatile("s_waitcnt vmcnt(0)" ::: "memory");
    __syncthreads();
    if (threadIdx.x == 0) {
        unsigned* bar = b.bar;
        __builtin_amdgcn_s_waitcnt(0);
        unsigned nloc = b.st[0], nx = b.st[1];
        if (nloc == 0u) { xcd_barrier_complete(bar, b.x, nloc, nx); b.st[0] = nloc; b.st[1] = nx; }
        const unsigned old = xb_add(&bar[XB_XSUB(b.x)], 1u);
        const unsigned gen = old / nloc;
        if (old + 1u == (gen + 1u) * nloc) {
            __builtin_amdgcn_fence(__ATOMIC_RELEASE, "agent");
            asm volatile("s_waitcnt vmcnt(0)" ::: "memory");
            const unsigned og = xb_add(&bar[XB_TOP], 1u);
            const unsigned tg = og / nx;
            if (og + 1u == (tg + 1u) * nx) xb_add(&bar[XB_TOPGEN], 1u);
            else XB_SPIN(xb_ld(&bar[XB_TOPGEN]) == tg, bar);
            __builtin_amdgcn_fence(__ATOMIC_ACQUIRE, "agent");
            xb_add(&bar[XB_XGEN(b.x)], 1u);
            asm volatile("s_waitcnt vmcnt(0)" ::: "memory");
        } else {
            XB_SPIN(xb_ld(&bar[XB_XGEN(b.x)]) == gen, bar);
            __builtin_amdgcn_fence(__ATOMIC_ACQUIRE, "agent");
            asm volatile("s_waitcnt vmcnt(0)" ::: "memory");
        }
    }
    __syncthreads();
}

struct Frame {
    LAS unsigned char* lds;
    volatile LAS unsigned* MISC;
    gu32* ctl;
    int tid, lane, wave, G, bid;
    const float* in[17];
    float* out; unsigned char* ws;
};
enum { IN_X = 0, IN_ANORM, IN_AWIN, IN_AQN, IN_AKN, IN_AWOUT, IN_KVNORM, IN_KVW, IN_BNORM, IN_BWQ, IN_BWOUT, IN_FFNNORM, IN_DGU, IN_DDN, IN_ROUTER, IN_MGU, IN_MDN };

struct TrItem { const float* W; size_t ldw; int K, k0, csrc0, cend; bf16* WT; int drow0; const float* gain; float scale; };
__device__ __forceinline__ int gu_row(int c0) { return (c0 < FF) ? ((c0 >> 7) * 256 + (c0 & 127)) : (((c0 - FF) >> 7) * 256 + 128 + ((c0 - FF) & 127)); }
constexpr int I_WIN = 16 * 32, I_TAIL = 16 * 2, I_SQ = 16 * 16, I_GU = 16 * 88, I_DN = 44 * 16, I_KV = 16 * 32;
constexpr int TR_NITEMS = I_WIN + I_TAIL + I_SQ + I_GU + I_DN + I_KV + I_SQ + I_SQ + NE * I_GU + NE * I_DN;
__device__ __forceinline__ TrItem tr_decode(const Frame& F, int it) {
    unsigned char* ws = F.ws; int r = it; TrItem t;
    if (r < I_WIN) { const int kb = r / 32, nb = r % 32; t = TrItem{F.in[IN_AWIN], (size_t)A_IN, D, 64 * kb, 64 * nb, A_IN, (bf16*)(ws + WS_WIN), 64 * nb, F.in[IN_ANORM], 1.f}; return t; } r -= I_WIN;
    if (r < I_TAIL) { const int kb = r / 2, nb = r % 2; t = TrItem{F.in[IN_AWIN], (size_t)A_IN, D, 64 * kb, 2048 + 64 * nb, A_IN, (bf16*)(ws + WS_WTAIL), 64 * nb, F.in[IN_ANORM], 1.f}; return t; } r -= I_TAIL;
    if (r < I_SQ) { const int kb = r / 16, nb = r % 16; t = TrItem{F.in[IN_AWOUT], (size_t)D, D, 64 * kb, 64 * nb, D, (bf16*)(ws + WS_WOA), 64 * nb, nullptr, 1.f}; return t; } r -= I_SQ;
    if (r < I_GU) { const int kb = r / 88, nb = r % 88; t = TrItem{F.in[IN_DGU], (size_t)(2 * FF), D, 64 * kb, 64 * nb, 2 * FF, (bf16*)(ws + WS_WGU), gu_row(64 * nb), F.in[IN_FFNNORM], 1.f}; return t; } r -= I_GU;
    if (r < I_DN) { const int kb = r / 16, nb = r % 16; t = TrItem{F.in[IN_DDN], (size_t)D, FF, 64 * kb, 64 * nb, D, (bf16*)(ws + WS_WD), 64 * nb, nullptr, 1.f}; return t; } r -= I_DN;
    if (r < I_KV) { const int kb = r / 32, nb = r % 32; t = TrItem{F.in[IN_KVW], (size_t)(2 * D), D, 64 * kb, 64 * nb, 2 * D, (bf16*)(ws + WS_WKVQ), (nb < 16) ? 64 * nb : 1024 + 64 * nb, F.in[IN_KVNORM], 1.f}; return t; } r -= I_KV;
    if (r < I_SQ) { const int kb = r / 16, nb = r % 16; t = TrItem{F.in[IN_BWQ], (size_t)D, D, 64 * kb, 64 * nb, D, (bf16*)(ws + WS_WKVQ), 1024 + 64 * nb, F.in[IN_BNORM], SBSCALE}; return t; } r -= I_SQ;
    if (r < I_SQ) { const int kb = r / 16, nb = r % 16; t = TrItem{F.in[IN_BWOUT], (size_t)D, D, 64 * kb, 64 * nb, D, (bf16*)(ws + WS_WOB), 64 * nb, nullptr, 1.f}; return t; } r -= I_SQ;
    if (r < NE * I_GU) { const int e = r / I_GU, rr = r % I_GU, kb = rr / 88, nb = rr % 88;
        t = TrItem{F.in[IN_MGU] + (size_t)e * D * 2 * FF, (size_t)(2 * FF), D, 64 * kb, 64 * nb, 2 * FF, (bf16*)(ws + WS_WGUM), e * 2 * FF + gu_row(64 * nb), F.in[IN_FFNNORM] + D, 1.f}; return t; } r -= NE * I_GU;
    { const int e = r / I_DN, rr = r % I_DN, kb = rr / 16, nb = rr % 16;
      t = TrItem{F.in[IN_MDN] + (size_t)e * FF * D, (size_t)D, FF, 64 * kb, 64 * nb, D, (bf16*)(ws + WS_WDM), e * D + 64 * nb, nullptr, 1.f}; return t; }
}
__device__ __forceinline__ void tr_load(const TrItem& t, f32x4 (&v)[16], int lane) {
    const int r = lane >> 4, c = t.csrc0 + 4 * (lane & 15); const bool ok = c < t.cend; const float* src = t.W + (size_t)(t.k0 + r) * t.ldw + (ok ? c : 0);
#pragma unroll
    for (int i = 0; i < 16; ++i) { const f32x4 x = __builtin_nontemporal_load((const f32x4*)(src + (size_t)(4 * i) * t.ldw)); v[i] = ok ? x : (f32x4){0.f, 0.f, 0.f, 0.f}; }
}
__device__ __forceinline__ void tr_store(const TrItem& t, const f32x4 (&v)[16], LAS float* scr, int lane) {
    const int r = lane >> 4, c4 = lane & 15;
#pragma unroll
    for (int i = 0; i < 16; ++i) { const int k = 4 * i + r; const float g = t.gain ? t.gain[t.k0 + k] * t.scale : t.scale;
        *(LAS f32x4*)(scr + k * 64 + 4 * (c4 ^ ((k >> 3) & 7))) = v[i] * g; }
    LDS_WAIT(); asm volatile("" ::: "memory");
    const int c8 = lane & 7;
#pragma unroll
    for (int j = 0; j < 8; ++j) { const int n = (lane >> 3) + 8 * j; const LAS float* s = scr + (8 * c8) * 64 + (n ^ (c8 << 2));
        v4u o; o.x = pk2(s[0 * 64], s[1 * 64]); o.y = pk2(s[2 * 64], s[3 * 64]); o.z = pk2(s[4 * 64], s[5 * 64]); o.w = pk2(s[6 * 64], s[7 * 64]);
        *(GAS v4u*)(t.WT + (size_t)(t.drow0 + n) * t.K + t.k0 + 8 * c8) = o; }
    LDS_WAIT(); asm volatile("" ::: "memory");
}
__device__ __forceinline__ void p0_prologue(Frame& F) {
    LAS float* scr = (LAS float*)(F.lds + F.wave * 16384);
    const int gw = F.wave * F.G + F.bid, NGW = F.G * NWAVES;
    unsigned char* ws = F.ws;
    {
        f32x4 va[16], vb[16];
        int it = gw;
        if (it < TR_NITEMS) { TrItem cur = tr_decode(F, it); tr_load(cur, va, F.lane);
            for (;;) {
                const int nx = it + NGW; const bool has = nx < TR_NITEMS; TrItem nxt = cur;
                if (has) { nxt = tr_decode(F, nx); tr_load(nxt, vb, F.lane); }
                tr_store(cur, va, scr, F.lane);
                if (!has) break;
                it = nx + NGW; const bool has2 = it < TR_NITEMS; TrItem nn = nxt;
                if (has2) { nn = tr_decode(F, it); tr_load(nn, va, F.lane); }
                tr_store(nxt, vb, scr, F.lane);
                if (!has2) break;
                cur = nn;
            }
        }
    }
    const float* x = F.in[IN_X]; bf16* XB = (bf16*)(ws + WS_XB);
    for (int m = gw; m < M; m += NGW) {
        const GAS f32x4* xr = (const GAS f32x4*)(x + (size_t)m * D) + F.lane; f32x4 v[4]; float s = 0.f;
#pragma unroll
        for (int j = 0; j < 4; ++j) { v[j] = xr[64 * j]; s += (v[j].x * v[j].x + v[j].y * v[j].y) + (v[j].z * v[j].z + v[j].w * v[j].w); }
        s = wave_sum(s); const float rs = 1.0f / sqrtf(s * (1.0f / 1024.0f) + 1e-6f);
        GAS unsigned long long* o8 = (GAS unsigned long long*)(XB + (size_t)m * D) + F.lane;
#pragma unroll
        for (int j = 0; j < 4; ++j) o8[64 * j] = (unsigned long long)pk2(v[j].x * rs, v[j].y * rs) | ((unsigned long long)pk2(v[j].z * rs, v[j].w * rs) << 32);
    }
}

#define WAVE_SYNC() asm volatile("s_waitcnt lgkmcnt(0)" ::: "memory")
__device__ __forceinline__ void rope8(float (&y)[8], bool isx1, bool isx2, int i0, int pshift, LAS const float* tab) {
#pragma unroll
    for (int e = 0; e < 8; ++e) {
        const float other = __shfl_xor(y[e], pshift); const float c = tab[2 * (i0 + e)], s = tab[2 * (i0 + e) + 1];
        y[e] = isx1 ? (y[e] * c - other * s) : (isx2 ? (y[e] * c + other * s) : y[e]);
    }
}
__device__ __forceinline__ size_t kif_off(int grow, int d) { return ((((size_t)(grow >> 5) * 4 + ((d >> 3) & 3)) * 2 + (d >> 5)) * 32 + (grow & 31)) * 8 + (d & 7); }
__device__ __forceinline__ void unpack8(const v4u w, float (&y)[8]) { y[0] = bflo(w.x); y[1] = bfhi(w.x); y[2] = bflo(w.y); y[3] = bfhi(w.y); y[4] = bflo(w.z); y[5] = bfhi(w.z); y[6] = bflo(w.w); y[7] = bfhi(w.w); }
__device__ __forceinline__ v4u pack8(const float (&y)[8]) { v4u o; o.x = pk2(y[0], y[1]); o.y = pk2(y[2], y[3]); o.z = pk2(y[4], y[5]); o.w = pk2(y[6], y[7]); return o; }
__device__ __forceinline__ void p2_post(Frame& F) {
    unsigned char* ws = F.ws; const int lane = F.lane;
    const bf16* PROJ = (const bf16*)(ws + WS_PROJ); const bf16* XB = (const bf16*)(ws + WS_XB); const bf16* WT = (const bf16*)(ws + WS_WTAIL);
    bf16* QF = (bf16*)(ws + WS_QF); bf16* KVF = (bf16*)(ws + WS_KVF); bf16* QIF = (bf16*)(ws + WS_QIF); bf16* KIF = (bf16*)(ws + WS_KIF); float* WIF = (float*)(ws + WS_WIF);
    const float* qnw = F.in[IN_AQN]; const float* knw = F.in[IN_AKN];
    LAS float* tab = (LAS float*)(F.lds + F.wave * 256);
    const int gw = F.wave * F.G + F.bid, NGW = F.G * NWAVES;
    for (int task = gw; task < M / 8; task += NGW) {
        const int row0 = task * 8;
        f32x4 acc[5];
#pragma unroll
        for (int c = 0; c < 5; ++c) acc[c] = (f32x4){0.f, 0.f, 0.f, 0.f};
        const bf16* ap = XB + (size_t)(row0 + (lane & 7)) * D + 8 * (lane >> 4);
        const bf16* bp = WT + (size_t)(lane & 15) * D + 8 * (lane >> 4);
#pragma unroll 4
        for (int j = 0; j < 32; ++j) {
            const bf16x8 a = *(const bf16x8*)(ap + 32 * j);
#pragma unroll
            for (int c = 0; c < 5; ++c) { const bf16x8 b = *(const bf16x8*)(bp + (size_t)(16 * c) * D + 32 * j); acc[c] = __builtin_amdgcn_mfma_f32_16x16x32_bf16(a, b, acc[c], 0, 0, 0); }
        }
        if (lane < 32) {
#pragma unroll
            for (int reg = 0; reg < 4; ++reg) {
                const int row = row0 + 4 * (lane >> 4) + reg; const float rs = 1.0f; const float pos = (float)(row & (SEQ - 1));
                const int d = lane & 15;
                float v0 = acc[0][reg] * rs; const float other = __shfl_xor(v0, 8);
                { float c, s; sincos_acc(pos * INV_I[d & 7], c, s); v0 = (d < 8) ? (v0 * c - other * s) : (v0 * c + other * s); }
                KIF[kif_off(row, d)] = (bf16)f2bf(v0);
#pragma unroll
                for (int c = 1; c < 4; ++c) KIF[kif_off(row, 16 * c + d)] = (bf16)f2bf(acc[c][reg] * rs);
                if (d < 8) WIF[(size_t)row * 8 + d] = acc[4][reg] * rs * WISCALE;
            }
        }
        for (int r = 0; r < 8; ++r) {
            const int row = row0 + r, b = row >> 13, t = row & (SEQ - 1); const float pos = (float)t;
            const bf16* pr = PROJ + (size_t)row * 2048 + 8 * lane;
            v4u w[4];
#pragma unroll
            for (int j = 0; j < 4; ++j) w[j] = __builtin_nontemporal_load((const v4u*)(pr + 512 * j));
            if (lane < 24) { float c, s; sincos_acc(pos * ((lane < 16) ? INV_Q[lane & 15] : INV_I[lane & 7]), c, s); tab[2 * lane] = c; tab[2 * lane + 1] = s; }
            WAVE_SYNC();
#pragma unroll
            for (int j = 0; j < 2; ++j) {
                float y[8]; unpack8(w[j], y); float ss = 0.f;
#pragma unroll
                for (int e = 0; e < 8; ++e) ss += y[e] * y[e];
                ss += __shfl_xor(ss, 1); ss += __shfl_xor(ss, 2); ss += __shfl_xor(ss, 4); ss += __shfl_xor(ss, 8);
                const float rs = 1.0f / sqrtf(ss * (1.0f / 128.0f) + 1e-6f); const int c8 = (lane & 15) * 8;
#pragma unroll
                for (int e = 0; e < 8; ++e) y[e] = y[e] * rs * qnw[c8 + e];
                rope8(y, c8 < 16, c8 >= 16 && c8 < 32, c8 & 15, 2, tab);
#pragma unroll
                for (int e = 0; e < 8; ++e) y[e] *= QSCALE;
                *(v4u*)(QF + (size_t)row * D + 512 * j + 8 * lane) = pack8(y);
            }
            {
                float y[8]; unpack8(w[2], y); float ss = 0.f;
#pragma unroll
                for (int e = 0; e < 8; ++e) ss += y[e] * y[e];
                ss += __shfl_xor(ss, 1); ss += __shfl_xor(ss, 2); ss += __shfl_xor(ss, 4); ss += __shfl_xor(ss, 8);
                const bool isk = lane < 32; const float rs = 1.0f / sqrtf(ss * (1.0f / 128.0f) + 1e-6f); const int c8 = (lane & 15) * 8;
                if (isk) {
#pragma unroll
                    for (int e = 0; e < 8; ++e) y[e] = y[e] * rs * knw[c8 + e];
                }
                rope8(y, isk && c8 < 16, isk && c8 >= 16 && c8 < 32, c8 & 15, 2, tab);
                const int kvh = (lane >> 4) & 1;
                int w0 = __builtin_amdgcn_cvt_pk_fp8_f32(y[0], y[1], 0, false); w0 = __builtin_amdgcn_cvt_pk_fp8_f32(y[2], y[3], w0, true);
                int w1 = __builtin_amdgcn_cvt_pk_fp8_f32(y[4], y[5], 0, false); w1 = __builtin_amdgcn_cvt_pk_fp8_f32(y[6], y[7], w1, true);
                *(v2u*)((unsigned char*)KVF + ((size_t)(b * NKV + kvh) * SEQ + t) * 256 + (isk ? 0 : 128) + c8) = (v2u){(unsigned)w0, (unsigned)w1};
            }
            {
                float y[8]; unpack8(w[3], y); const int c8 = (lane & 7) * 8;
                rope8(y, c8 == 0, c8 == 8, 16, 1, tab);
                *(v4u*)(QIF + (size_t)row * 512 + 8 * lane) = pack8(y);
            }
            WAVE_SYNC();
        }
    }
}

__device__ __forceinline__ unsigned f2key(float f) { const unsigned u = __float_as_uint(f); return (u & 0x80000000u) ? ~u : (u | 0x80000000u); }
__device__ __forceinline__ void p3_query_naive(unsigned char* ws, LAS unsigned char* lds, int row, int* SEL) {
    const int tid = threadIdx.x, lane = tid & 63, wave = tid >> 6;
    const bf16* QIF = (const bf16*)(ws + WS_QIF); const bf16* KIF = (const bf16*)(ws + WS_KIF); const float* WIF = (const float*)(ws + WS_WIF);
    LAS unsigned* keys = (LAS unsigned*)lds;
    LAS float* qis = (LAS float*)(lds + 32768);
    LAS float* wl = (LAS float*)(lds + 32768 + 2048);
    LAS unsigned* hist = (LAS unsigned*)(lds + 36864);
    LAS unsigned* ctl = (LAS unsigned*)(lds + 36864 + 1024);
    LAS unsigned* wcnt = (LAS unsigned*)(lds + 36864 + 1024 + 64);
    {
        const int b = row >> 13, t = row & (SEQ - 1), n = t + 1;
        int* sel = SEL + (size_t)row * TOPK;
        if (n <= TOPK) { if (tid < TOPK) sel[tid] = tid < n ? tid : 0; return; }
        __syncthreads();
        qis[tid] = __uint_as_float((unsigned)QIF[(size_t)row * 512 + tid] << 16);
        if (tid < 8) wl[tid] = WIF[(size_t)row * 8 + tid];
        __syncthreads();
        for (int s = tid; s < n; s += 512) {
            const int grow = (b << 13) + s;
            float kf[64];
#pragma unroll
            for (int j = 0; j < 8; ++j) { const v4u w = *(const v4u*)(KIF + kif_off(grow, 8 * j)); kf[8 * j] = bflo(w.x); kf[8 * j + 1] = bfhi(w.x); kf[8 * j + 2] = bflo(w.y); kf[8 * j + 3] = bfhi(w.y); kf[8 * j + 4] = bflo(w.z); kf[8 * j + 5] = bfhi(w.z); kf[8 * j + 6] = bflo(w.w); kf[8 * j + 7] = bfhi(w.w); }
            float sc = 0.f;
#pragma unroll
            for (int h = 0; h < 8; ++h) { float d = 0.f; asm volatile("" ::: "memory");
#pragma unroll
                for (int dd = 0; dd < 64; ++dd) d += qis[h * 64 + dd] * kf[dd];
                sc += wl[h] * fmaxf(d, 0.f); }
            keys[s] = f2key(sc + 0.0f);
        }
        __syncthreads();
        unsigned prefix = 0u, mask = 0u, need = TOPK;
        for (int pass = 0; pass < 4; ++pass) {
            const int shift = 24 - 8 * pass;
            if (tid < 256) hist[tid] = 0u;
            __syncthreads();
            for (int s = tid; s < n; s += 512) { const unsigned k = keys[s]; if ((k & mask) == prefix) __hip_atomic_fetch_add(&hist[(k >> shift) & 255u], 1u, __ATOMIC_RELAXED, __HIP_MEMORY_SCOPE_WORKGROUP); }
            __syncthreads();
            if (tid < 64) {
                const unsigned h0 = hist[4 * lane], h1 = hist[4 * lane + 1], h2 = hist[4 * lane + 2], h3 = hist[4 * lane + 3]; const unsigned tot = h0 + h1 + h2 + h3;
                unsigned incl = tot;
#pragma unroll
                for (int o = 1; o < 64; o <<= 1) { const unsigned v = __shfl_down(incl, o); if (lane + o < 64) incl += v; }
                const unsigned above = incl - tot;
                if (above < need && need <= above + tot) {
                    unsigned a = above; unsigned bin;
                    if (a + h3 >= need) bin = 3; else { a += h3; if (a + h2 >= need) bin = 2; else { a += h2; if (a + h1 >= need) bin = 1; else { a += h1; bin = 0; } } }
                    ctl[0] = 4 * lane + bin; ctl[1] = need - a;
                }
            }
            __syncthreads();
            prefix |= ctl[0] << shift; mask |= 255u << shift; need = ctl[1];
            __syncthreads();
        }
        const unsigned thr = prefix, n_gt = TOPK - need;
        unsigned base_gt = 0u, base_eq = 0u;
        for (int s0 = 0; s0 < n; s0 += 512) {
            const int s = s0 + tid; const unsigned k = s < n ? keys[s] : 0u; const bool gt = (s < n) && (k > thr); const bool eq = (s < n) && (k == thr);
            const unsigned long long bg = __ballot(gt), be = __ballot(eq); const unsigned long long lt = (1ull << lane) - 1ull;
            const unsigned rg = __popcll(bg & lt), re = __popcll(be & lt);
            if (lane == 0) { wcnt[wave] = __popcll(bg); wcnt[8 + wave] = __popcll(be); }
            __syncthreads();
            unsigned og = base_gt, oe = base_eq, tg = 0u, te = 0u;
#pragma unroll
            for (int w = 0; w < 8; ++w) { const unsigned cg = wcnt[w], ce = wcnt[8 + w]; if (w < wave) { og += cg; oe += ce; } tg += cg; te += ce; }
            if (gt) sel[og + rg] = s;
            if (eq && oe + re < need) sel[n_gt + oe + re] = s;
            base_gt += tg; base_eq += te;
            __syncthreads();
        }
    }
}

constexpr int P3_HIST = 0, P3_H2 = 65536, P3_BM = 98304, P3_QS = 114688, P3_FLAG = P3_QS + 512, P3_CAP = 512;
__device__ __forceinline__ void find_bin_2048(LAS const unsigned* hist, unsigned need, int lane, unsigned& bin_out, unsigned& need_out, unsigned& cnt_out, bool& ok) {
    unsigned w[16]; unsigned tot = 0u;
#pragma unroll
    for (int i = 0; i < 16; ++i) { w[i] = hist[16 * lane + i]; tot += (w[i] & 0xffffu) + (w[i] >> 16); }
    unsigned incl = tot;
#pragma unroll
    for (int o = 1; o < 64; o <<= 1) { const unsigned v = __shfl_down(incl, o); if (lane + o < 64) incl += v; }
    const unsigned above = incl - tot;
    const bool mine = (above < need) && (need <= above + tot);
    unsigned a = above, fb = 0u, fn = 0u, fc = 0u; bool found = false;
#pragma unroll
    for (int i = 15; i >= 0; --i) {
        const unsigned h1 = w[i] >> 16, h0 = w[i] & 0xffffu;
        if (!found) { if (a + h1 >= need) { found = true; fb = 32u * lane + 2u * i + 1u; fn = need - a; fc = h1; } else a += h1; }
        if (!found) { if (a + h0 >= need) { found = true; fb = 32u * lane + 2u * i; fn = need - a; fc = h0; } else a += h0; }
    }
    const unsigned long long bm = __ballot(mine);
    ok = (bm != 0ull);
    const int src = ok ? (__ffsll((long long)bm) - 1) : 0;
    bin_out = (unsigned)__builtin_amdgcn_readlane((int)fb, src); need_out = (unsigned)__builtin_amdgcn_readlane((int)fn, src); cnt_out = (unsigned)__builtin_amdgcn_readlane((int)fc, src);
}
__device__ __forceinline__ unsigned bin11(float sc) { const unsigned u = __float_as_uint(sc); const int m = (int)((u & 0x7fffffffu) >> 17) - 7360; const unsigned mc = (unsigned)(m < 0 ? 0 : (m > 1023 ? 1023 : m)); return (u >> 31) ? (1023u - mc) : (1024u + mc); }
__device__ __forceinline__ float relu_i(float x) { const int xi = __builtin_bit_cast(int, x); const int ri = (xi < 0) ? 0 : xi; return __builtin_bit_cast(float, ri); }
#define RELU(x) relu_i(x)
typedef _Float16 f16x8 __attribute__((ext_vector_type(8)));
typedef short s16x2 __attribute__((ext_vector_type(2)));
__device__ __forceinline__ unsigned pk_relu_f16(float a, float b) { const s16x2 h = __builtin_bit_cast(s16x2, __builtin_amdgcn_cvt_pkrtz(a, b)); return __builtin_bit_cast(unsigned, __builtin_elementwise_max(h, (s16x2){0, 0})); }
template <int PASS> __device__ __forceinline__ void p3_score_pass(const bf16x8 (&af)[2][4], const f16x8 (&wa)[2][2], const bf16* kib, int t0, int nt, int wave, int n, int hi,
                                                                  LAS unsigned char* lds, const unsigned (&thr)[2][2], int rot) {
    LAS unsigned* HIST = (LAS unsigned*)(lds + P3_HIST); LAS unsigned* BM = (LAS unsigned*)(lds + P3_BM); LAS unsigned* QS = (LAS unsigned*)(lds + P3_QS);
    const int kmax = t0 + 15;
    bf16x8 bc[4], bn[4];
    const int qh = 8 * (wave >> 2), w4 = wave & 3;
    const int cnt4 = (nt - w4 + 3) >> 2; const int r0 = rot % cnt4;
    bf16x8 bq[4][4];
#define P3_LOADB(u, j) do { int jj_ = r0 + (j); jj_ = (jj_ >= cnt4) ? jj_ - cnt4 : jj_; const int t_ = w4 + 4 * jj_; \
        const bf16* kp_ = kib + ((size_t)t_ * 8 + hi) * 256 + n * 8; _Pragma("unroll") for (int s = 0; s < 4; ++s) bq[u][s] = *(const bf16x8*)(kp_ + s * 512); } while (0)
#pragma unroll
    for (int u = 0; u < 4; ++u) P3_LOADB(u, (u < cnt4) ? u : 0);
    for (int i0 = 0; i0 < cnt4; i0 += 4) {
#pragma unroll
        for (int u = 0; u < 4; ++u) {
            if (i0 + u < cnt4) {
                int jj = r0 + i0 + u; jj = (jj >= cnt4) ? jj - cnt4 : jj; const int tile = w4 + 4 * jj;
                const int key = 32 * tile + n; const bool full = (32 * tile + 31 <= t0);
                f32x16 acc0, acc1;
#pragma unroll
                for (int r = 0; r < 16; ++r) { acc0[r] = 0.f; acc1[r] = 0.f; }
#pragma unroll
                for (int s = 0; s < 4; ++s) acc0 = __builtin_amdgcn_mfma_f32_32x32x16_bf16(af[0][s], bq[u][s], acc0, 0, 0, 0);
#pragma unroll
                for (int s = 0; s < 4; ++s) acc1 = __builtin_amdgcn_mfma_f32_32x32x16_bf16(af[1][s], bq[u][s], acc1, 0, 0, 0);
                float sc4[4];
                {
                    f32x16 y0, y1;
#pragma unroll
                    for (int r = 0; r < 16; ++r) { y0[r] = 0.f; y1[r] = 0.f; }
                    const f16x8 x00 = __builtin_bit_cast(f16x8, (v4u){pk_relu_f16(acc0[0], acc0[1]), pk_relu_f16(acc0[2], acc0[3]), pk_relu_f16(acc0[4], acc0[5]), pk_relu_f16(acc0[6], acc0[7])});
                    const f16x8 x01 = __builtin_bit_cast(f16x8, (v4u){pk_relu_f16(acc0[8], acc0[9]), pk_relu_f16(acc0[10], acc0[11]), pk_relu_f16(acc0[12], acc0[13]), pk_relu_f16(acc0[14], acc0[15])});
                    const f16x8 x10 = __builtin_bit_cast(f16x8, (v4u){pk_relu_f16(acc1[0], acc1[1]), pk_relu_f16(acc1[2], acc1[3]), pk_relu_f16(acc1[4], acc1[5]), pk_relu_f16(acc1[6], acc1[7])});
                    const f16x8 x11 = __builtin_bit_cast(f16x8, (v4u){pk_relu_f16(acc1[8], acc1[9]), pk_relu_f16(acc1[10], acc1[11]), pk_relu_f16(acc1[12], acc1[13]), pk_relu_f16(acc1[14], acc1[15])});
                    y0 = __builtin_amdgcn_mfma_f32_32x32x16_f16(wa[0][0], x00, y0, 0, 0, 0); y1 = __builtin_amdgcn_mfma_f32_32x32x16_f16(wa[1][0], x10, y1, 0, 0, 0);
                    y0 = __builtin_amdgcn_mfma_f32_32x32x16_f16(wa[0][1], x01, y0, 0, 0, 0); y1 = __builtin_amdgcn_mfma_f32_32x32x16_f16(wa[1][1], x11, y1, 0, 0, 0);
                    sc4[0] = y0[0]; sc4[1] = y0[1]; sc4[2] = y1[0]; sc4[3] = y1[1];
                }
                unsigned bin4[4]; float scz4[4]; bool val4[4];
#pragma unroll
                for (int e = 0; e < 4; ++e) { scz4[e] = sc4[e] + 0.0f; bin4[e] = bin11(scz4[e]); val4[e] = full || (key <= t0 + qh + 4 * (e >> 1) + hi + 2 * (e & 1)); }
                if (PASS == 1) {
                    if (full) {
#pragma unroll
                        for (int e = 0; e < 4; ++e) { const int q = qh + 4 * (e >> 1) + hi + 2 * (e & 1); __hip_atomic_fetch_add(&HIST[q * 1024 + (bin4[e] >> 1)], 1u << (16 * (bin4[e] & 1u)), __ATOMIC_RELAXED, __HIP_MEMORY_SCOPE_WORKGROUP); }
                    } else {
#pragma unroll
                        for (int e = 0; e < 4; ++e) { const int q = qh + 4 * (e >> 1) + hi + 2 * (e & 1); if (val4[e]) __hip_atomic_fetch_add(&HIST[q * 1024 + (bin4[e] >> 1)], 1u << (16 * (bin4[e] & 1u)), __ATOMIC_RELAXED, __HIP_MEMORY_SCOPE_WORKGROUP); }
                    }
                } else if (PASS == 2) {
                    unsigned long long ab4[4]; bool cand4[4]; bool anyc = false;
#pragma unroll
                    for (int e = 0; e < 4; ++e) { ab4[e] = __ballot(val4[e] && bin4[e] > thr[e >> 1][e & 1]); cand4[e] = val4[e] && bin4[e] == thr[e >> 1][e & 1]; anyc = anyc || cand4[e]; }
                    if (n == 0) {
#pragma unroll
                        for (int e = 0; e < 4; ++e) { const int q = qh + 4 * (e >> 1) + hi + 2 * (e & 1); BM[q * 256 + tile] = hi ? (unsigned)(ab4[e] >> 32) : (unsigned)ab4[e]; }
                    }
                    if (__ballot(anyc) != 0ull) {
#pragma unroll
                        for (int e = 0; e < 4; ++e) if (cand4[e]) { const int q = qh + 4 * (e >> 1) + hi + 2 * (e & 1); const unsigned pos = __hip_atomic_fetch_add(&QS[q * 8 + 3], 1u, __ATOMIC_RELAXED, __HIP_MEMORY_SCOPE_WORKGROUP);
                            if (pos < (unsigned)P3_CAP) { HIST[q * 1024 + 2 * pos] = f2key(scz4[e]); HIST[q * 1024 + 2 * pos + 1] = (unsigned)key; } }
                    }
                }
            }
            { const int jn = (i0 + u + 4 < cnt4) ? (i0 + u + 4) : (cnt4 - 1); P3_LOADB(u, jn); }
        }
    }
#undef P3_LOADB
}
__device__ __forceinline__ void p3_index(Frame& F) {
    unsigned char* ws = F.ws; const int tid = F.tid, lane = F.lane, wave = F.wave, n = lane & 31, hi = lane >> 5;
    const bf16* QIF = (const bf16*)(ws + WS_QIF); const bf16* KIF = (const bf16*)(ws + WS_KIF); const float* WIF = (const float*)(ws + WS_WIF); int* SEL = (int*)(ws + WS_SEL);
    LAS unsigned char* lds = F.lds;
    LAS unsigned* HIST = (LAS unsigned*)(lds + P3_HIST); LAS unsigned* H2 = (LAS unsigned*)(lds + P3_H2 + wave * 4096); LAS unsigned* BM = (LAS unsigned*)(lds + P3_BM); LAS unsigned* QS = (LAS unsigned*)(lds + P3_QS);
    LAS unsigned* FLAG = (LAS unsigned*)(lds + P3_FLAG); LAS unsigned* FBL = (LAS unsigned*)(lds + P3_QS + 1024);
    if (tid == 0) FBL[0] = 0u;
    __syncthreads();
    for (int ps = F.bid; ps < 512; ps += F.G) {
        const int b = ps >> 8, wq = ps & 255;
#pragma unroll 1
        for (int half = 0; half < 2; ++half) {
            const int idx = half ? (511 - wq) : wq; const int t0 = 16 * idx, row0 = (b << 13) + t0;
            if (idx < 16) {
                for (int e = tid; e < 16 * TOPK; e += 512) { const int q = e >> 8, i = e & 255; SEL[(size_t)(row0 + q) * TOPK + i] = (i <= t0 + q) ? i : 0; }
                continue;
            }
            for (int e = tid; e < 16384; e += 512) HIST[e] = 0u;
            for (int e = tid; e < 4096; e += 512) BM[e] = 0u;
            if (tid < 132) QS[tid] = 0u;
            bf16x8 af[2][4]; f16x8 wa[2][2]; const int qh = 8 * (wave >> 2);
            { const int head = (n & 3) + 4 * ((n >> 3) & 1), q4 = ((n >> 2) & 1) + 2 * (n >> 4);
#pragma unroll
              for (int mt = 0; mt < 2; ++mt) { const bf16* ap = QIF + (size_t)(row0 + qh + 4 * mt + q4) * 512 + head * IDX + 32 * hi;
#pragma unroll
                  for (int s = 0; s < 4; ++s) af[mt][s] = *(const bf16x8*)(ap + 8 * s);
#pragma unroll
                  for (int sp = 0; sp < 2; ++sp) {
                      const bool on = (sp == 0) ? ((n == 0 && hi == 0) || (n == 4 && hi == 1)) : ((n == 1 && hi == 0) || (n == 5 && hi == 1));
                      const float* wp = WIF + (size_t)(row0 + qh + 4 * mt + hi + 2 * sp) * 8; const f32x4 w0 = *(const f32x4*)wp, w1 = *(const f32x4*)(wp + 4);
                      f16x8 t; t[0] = (_Float16)w0[0]; t[1] = (_Float16)w0[1]; t[2] = (_Float16)w0[2]; t[3] = (_Float16)w0[3]; t[4] = (_Float16)w1[0]; t[5] = (_Float16)w1[1]; t[6] = (_Float16)w1[2]; t[7] = (_Float16)w1[3];
                      if (!on) t = (f16x8){0, 0, 0, 0, 0, 0, 0, 0};
                      wa[mt][sp] = t; } } }
            const int nt = (t0 + 16 + 31) >> 5; const bf16* kib = KIF + (size_t)(b << 13) * IDX;
            unsigned thr[2][2] = {{0u, 0u}, {0u, 0u}};
            __syncthreads();
            p3_score_pass<1>(af, wa, kib, t0, nt, wave, n, hi, lds, thr, F.bid * 5);
            __syncthreads();
#pragma unroll 1
            for (int qq = 0; qq < 2; ++qq) { const int q = 2 * wave + qq; unsigned bin, need, cnt; bool ok;
                find_bin_2048(HIST + q * 1024, (unsigned)TOPK, lane, bin, need, cnt, ok);
                if (lane == 0) { const bool defer = !ok || cnt > (unsigned)P3_CAP; QS[q * 8 + 0] = defer ? 4096u : bin; QS[q * 8 + 1] = need; QS[q * 8 + 2] = cnt; QS[q * 8 + 4] = defer ? 1u : 0u;
                    if (defer) { const unsigned k = __hip_atomic_fetch_add(&FBL[0], 1u, __ATOMIC_RELAXED, __HIP_MEMORY_SCOPE_WORKGROUP); if (k < 63u) FBL[1 + k] = (unsigned)(row0 + q); } } }
            __syncthreads();
#pragma unroll
            for (int mt = 0; mt < 2; ++mt)
#pragma unroll
                for (int j = 0; j < 2; ++j) thr[mt][j] = QS[(qh + 4 * mt + hi + 2 * j) * 8];
            __syncthreads();
            p3_score_pass<2>(af, wa, kib, t0, nt, wave, n, hi, lds, thr, F.bid * 5 + 3);
            __syncthreads();
#pragma unroll 1
            for (int qq = 0; qq < 2; ++qq) {
                const int q = 2 * wave + qq; LAS unsigned* cand = HIST + q * 1024; LAS unsigned* bmq = BM + q * 256;
                const unsigned needA = QS[q * 8 + 1], c = QS[q * 8 + 2];
                if (QS[q * 8 + 4] != 0u) continue;
                for (unsigned i0 = 0; i0 < c; i0 += 64) { const unsigned i = i0 + lane; const bool in = i < c; const unsigned k32 = in ? cand[2 * i] : 0u, ki = in ? (cand[2 * i + 1] & 8191u) : 0u; unsigned rank = 0u;
                    for (unsigned j = 0; j < c; ++j) { const unsigned kj = cand[2 * j], ij = cand[2 * j + 1]; rank += (kj > k32 || (kj == k32 && ij < ki)) ? 1u : 0u; }
                    if (in && rank < needA) __hip_atomic_fetch_or(&bmq[ki >> 5], 1u << (ki & 31), __ATOMIC_RELAXED, __HIP_MEMORY_SCOPE_WORKGROUP); }
                WAVE_SYNC();
                unsigned w0 = bmq[4 * lane], w1 = bmq[4 * lane + 1], w2 = bmq[4 * lane + 2], w3 = bmq[4 * lane + 3];
                const unsigned mycnt = __popc(w0) + __popc(w1) + __popc(w2) + __popc(w3);
                unsigned incl = mycnt;
#pragma unroll
                for (int o = 1; o < 64; o <<= 1) { const unsigned v = __shfl_up(incl, o); if (lane >= o) incl += v; }
                unsigned pos = incl - mycnt; int* sel = SEL + (size_t)(row0 + q) * TOPK;
#pragma unroll
                for (int wi = 0; wi < 4; ++wi) { unsigned w = (wi == 0) ? w0 : (wi == 1) ? w1 : (wi == 2) ? w2 : w3;
                    while (w) { const int bit = __ffs((int)w) - 1; if (pos < (unsigned)TOPK) sel[pos] = 128 * lane + 32 * wi + bit; ++pos; w &= w - 1u; } }
            }
            __syncthreads();
        }
    }
    __syncthreads();
    const unsigned nfb = FBL[0];
    for (unsigned k = 0; k < nfb && k < 63u; ++k) { const int r0 = (int)FBL[1 + k]; __syncthreads(); p3_query_naive(ws, lds, r0, SEL); }
}

typedef short v4i16_t __attribute__((ext_vector_type(4)));
typedef int v4i __attribute__((ext_vector_type(4)));
__device__ __forceinline__ v4i16_t tr16(LAS unsigned char* p) { return __builtin_amdgcn_ds_read_tr16_b64_v4i16((LAS v4i16_t*)p); }
typedef __bf16 bf16x2_t __attribute__((ext_vector_type(2)));
__device__ __forceinline__ unsigned dq2(unsigned w, bool hi) { return __builtin_bit_cast(unsigned, hi ? __builtin_amdgcn_cvt_scalef32_pk_bf16_fp8(w, 1.0f, true) : __builtin_amdgcn_cvt_scalef32_pk_bf16_fp8(w, 1.0f, false)); }
__device__ __forceinline__ bf16x8 dq8(unsigned w0, unsigned w1) { return __builtin_bit_cast(bf16x8, (v4u){dq2(w0, false), dq2(w0, true), dq2(w1, false), dq2(w1, true)}); }
__device__ __forceinline__ void p4_dsa(Frame& F) {
    unsigned char* ws = F.ws; const int lane = F.lane, nh = lane & 15, kg = lane >> 4;
    const bf16* QF = (const bf16*)(ws + WS_QF); const unsigned char* KV8 = (const unsigned char*)(ws + WS_KVF); const int* SEL = (const int*)(ws + WS_SEL); bf16* AO = (bf16*)(ws + WS_AO);
    LAS unsigned char* wl = F.lds + F.wave * 10240; LAS int* selw = (LAS int*)wl; LAS unsigned char* vb = wl + 1024;
    const int gw = F.wave * F.G + F.bid, NGW = F.G * NWAVES;
    LAS unsigned char* trp = vb + (4 * kg + ((lane >> 2) & 3)) * 288 + 8 * (lane & 3);
#pragma unroll 1
    for (int combo = 0; combo < BATCH * NKV; ++combo) {
        const int b = combo >> 1, kvh = combo & 1;
        const unsigned char* kvb = KV8 + (size_t)(b * NKV + kvh) * SEQ * 256;
#pragma unroll 1
        for (int t = gw; t < SEQ; t += NGW) {
            const int row = (b << 13) + t; const int cnt = (t + 1 < TOPK) ? (t + 1) : TOPK;
            *(LAS v4i*)(selw + 4 * lane) = *(const v4i*)(SEL + (size_t)row * TOPK + 4 * lane);
            WAVE_SYNC();
            const bf16* qp = QF + (size_t)row * D + (kvh * 4 + (nh & 3)) * HD + 32 * kg;
            bf16x8 qf[4];
#pragma unroll
            for (int s = 0; s < 4; ++s) { qf[s] = *(const bf16x8*)(qp + 8 * s); if (nh >= 4) qf[s] = (bf16x8){0, 0, 0, 0, 0, 0, 0, 0}; }
            f32x4 S[16];
            v4u kq[2][4][2];
#define P4_LOADK(buf, batch) do { _Pragma("unroll") for (int tt = 0; tt < 4; ++tt) { const unsigned char* kp_ = kvb + (size_t)(selw[16 * (4 * (batch) + tt) + nh] & (SEQ - 1)) * 256 + 32 * kg; \
                kq[buf][tt][0] = *(const v4u*)(kp_); kq[buf][tt][1] = *(const v4u*)(kp_ + 16); } } while (0)
            P4_LOADK(0, 0);
#pragma unroll
            for (int bt = 0; bt < 4; ++bt) {
                if (bt < 3) P4_LOADK((bt + 1) & 1, bt + 1);
                asm volatile("" ::: "memory");
#pragma unroll
                for (int tt = 0; tt < 4; ++tt) {
                    const v4u k0 = kq[bt & 1][tt][0], k1 = kq[bt & 1][tt][1];
                    f32x4 a = (f32x4){0.f, 0.f, 0.f, 0.f};
                    a = __builtin_amdgcn_mfma_f32_16x16x32_bf16(dq8(k0.x, k0.y), qf[0], a, 0, 0, 0); a = __builtin_amdgcn_mfma_f32_16x16x32_bf16(dq8(k0.z, k0.w), qf[1], a, 0, 0, 0);
                    a = __builtin_amdgcn_mfma_f32_16x16x32_bf16(dq8(k1.x, k1.y), qf[2], a, 0, 0, 0); a = __builtin_amdgcn_mfma_f32_16x16x32_bf16(dq8(k1.z, k1.w), qf[3], a, 0, 0, 0);
                    S[4 * bt + tt] = a;
                }
            }
#undef P4_LOADK
            float mx = -INFINITY;
#pragma unroll
            for (int T = 0; T < 16; ++T)
#pragma unroll
                for (int r = 0; r < 4; ++r) { const float v = (16 * T + 4 * kg + r < cnt) ? S[T][r] : -INFINITY; S[T][r] = v; mx = fmaxf(mx, v); }
            mx = fmaxf(mx, __shfl_xor(mx, 16)); mx = fmaxf(mx, __shfl_xor(mx, 32));
            float sum = 0.f;
#pragma unroll
            for (int T = 0; T < 16; ++T)
#pragma unroll
                for (int r = 0; r < 4; ++r) { const float e = __builtin_amdgcn_exp2f(S[T][r] - mx); S[T][r] = e; sum += e; }
            sum += __shfl_xor(sum, 16); sum += __shfl_xor(sum, 32);
            bf16x8 pa[8];
#pragma unroll
            for (int c = 0; c < 8; ++c) { v4u pw; pw.x = pg8::cvt_pk_bf16(S[2 * c][0], S[2 * c][1]); pw.y = pg8::cvt_pk_bf16(S[2 * c][2], S[2 * c][3]); pw.z = pg8::cvt_pk_bf16(S[2 * c + 1][0], S[2 * c + 1][1]); pw.w = pg8::cvt_pk_bf16(S[2 * c + 1][2], S[2 * c + 1][3]); pa[c] = __builtin_bit_cast(bf16x8, pw); }
            f32x4 O[8];
#pragma unroll
            for (int d = 0; d < 8; ++d) O[d] = (f32x4){0.f, 0.f, 0.f, 0.f};
            v4u g[3][4];
#define P4_LOADV(buf, c_) do { _Pragma("unroll") for (int i = 0; i < 4; ++i) { const int key_ = selw[32 * (c_) + (lane >> 3) + 8 * i] & (SEQ - 1); g[buf][i] = *(const v4u*)(kvb + (size_t)key_ * 256 + 128 + 16 * (lane & 7)); } } while (0)
            P4_LOADV(0, 0); P4_LOADV(1, 1); P4_LOADV(2, 2);
#pragma unroll
            for (int c = 0; c < 8; ++c) {
#pragma unroll
                for (int i = 0; i < 4; ++i) { const v4u gg = g[c % 3][i]; LAS unsigned char* dst = vb + ((lane >> 3) + 8 * i) * 288 + 32 * (lane & 7);
                    *(LAS v4u*)dst = __builtin_bit_cast(v4u, dq8(gg.x, gg.y)); *(LAS v4u*)(dst + 16) = __builtin_bit_cast(v4u, dq8(gg.z, gg.w)); }
                asm volatile("" ::: "memory");
                if (c < 5) P4_LOADV(c % 3, c + 3);
#pragma unroll
                for (int d = 0; d < 8; ++d) {
                    const v4i16_t lo = tr16(trp + 32 * d), hi4 = tr16(trp + 16 * 288 + 32 * d);
                    const bf16x8 vfr = (bf16x8){lo[0], lo[1], lo[2], lo[3], hi4[0], hi4[1], hi4[2], hi4[3]};
                    O[d] = __builtin_amdgcn_mfma_f32_16x16x32_bf16(pa[c], vfr, O[d], 0, 0, 0);
                }
            }
#undef P4_LOADV
            const float i0 = 1.0f / __builtin_bit_cast(float, __builtin_amdgcn_readlane(__builtin_bit_cast(int, sum), 0)), i1 = 1.0f / __builtin_bit_cast(float, __builtin_amdgcn_readlane(__builtin_bit_cast(int, sum), 1));
            const float i2 = 1.0f / __builtin_bit_cast(float, __builtin_amdgcn_readlane(__builtin_bit_cast(int, sum), 2)), i3 = 1.0f / __builtin_bit_cast(float, __builtin_amdgcn_readlane(__builtin_bit_cast(int, sum), 3));
            LAS bf16* ost = (LAS bf16*)vb;
            if (kg == 0) {
#pragma unroll
                for (int d = 0; d < 8; ++d) { ost[0 * 128 + 16 * d + nh] = (bf16)f2bf(O[d][0] * i0); ost[1 * 128 + 16 * d + nh] = (bf16)f2bf(O[d][1] * i1); ost[2 * 128 + 16 * d + nh] = (bf16)f2bf(O[d][2] * i2); ost[3 * 128 + 16 * d + nh] = (bf16)f2bf(O[d][3] * i3); }
            }
            WAVE_SYNC();
            const v4u ov = *(LAS v4u*)(vb + 16 * lane);
            *(v4u*)(AO + (size_t)row * D + (kvh * 4 + kg) * HD + 8 * nh) = ov;
            WAVE_SYNC();
        }
    }
}

__device__ __forceinline__ void p9_sb(Frame& F) {
    unsigned char* ws = F.ws; const int lane = F.lane, n = lane & 31, hi = lane >> 5;
    const bf16* KQ = (const bf16*)(ws + WS_KQ); const bf16* VT = (const bf16*)(ws + WS_VT); bf16* AO = (bf16*)(ws + WS_AO);
    const int gw = F.wave * F.G + F.bid, NGW = F.G * NWAVES;
    const int koff = 16 * (n >> 4) + 8 * ((n >> 2) & 1) + 4 * ((n >> 3) & 1) + (n & 3);
    constexpr float LOG2E = 1.4426950408889634f, LN2 = 0.6931471805599453f;
    for (int u = gw; u < (M / 32) * NH; u += NGW) {
        const int h = u & 7, blk = u >> 3, b = blk >> 8, qb = blk & 255, q0 = 32 * qb, t = q0 + n;
        const bf16* qp = KQ + (size_t)(b * SEQ + q0 + n) * 2048 + 1024 + h * HD + 64 * hi;
        bf16x8 qf[8];
#pragma unroll
        for (int s = 0; s < 8; ++s) qf[s] = *(const bf16x8*)(qp + 8 * s);
        f32x16 o[4];
#pragma unroll
        for (int mt = 0; mt < 4; ++mt)
#pragma unroll
            for (int r = 0; r < 16; ++r) o[mt][r] = 0.f;
        float C = 0.f;
        bf16x8 kf[8];
        { const bf16* kp = KQ + (size_t)(b * SEQ + 32 * qb + koff) * 2048 + h * HD + 64 * hi;
#pragma unroll
          for (int s = 0; s < 8; ++s) kf[s] = *(const bf16x8*)(kp + 8 * s); }
        for (int kb = qb; kb >= 0; --kb) {
            const int k0 = 32 * kb;
            bf16x8 vf[4][2];
#pragma unroll
            for (int mt = 0; mt < 4; ++mt)
#pragma unroll
                for (int sp = 0; sp < 2; ++sp) vf[mt][sp] = *(const bf16x8*)(VT + (size_t)(h * HD + 32 * mt + n) * M + b * SEQ + k0 + 16 * sp + 8 * hi);
            f32x16 z;
#pragma unroll
            for (int r = 0; r < 16; ++r) z[r] = 0.f;
#pragma unroll
            for (int s = 0; s < 8; ++s) z = __builtin_amdgcn_mfma_f32_32x32x16_bf16(kf[s], qf[s], z, 0, 0, 0);
            { const int kn = (kb > 0) ? kb - 1 : 0; const bf16* kp = KQ + (size_t)(b * SEQ + 32 * kn + koff) * 2048 + h * HD + 64 * hi;
#pragma unroll
              for (int s = 0; s < 8; ++s) kf[s] = *(const bf16x8*)(kp + 8 * s); }
            float lk[16], lb[16];
#pragma unroll
            for (int r = 0; r < 16; ++r) {
                const int key = k0 + ((r < 8) ? (8 * hi + r) : (16 + 8 * hi + (r - 8)));
                const float zz = z[r]; const float L = __builtin_amdgcn_logf(1.0f + __builtin_amdgcn_exp2f(-fabsf(zz) * LOG2E)) * LN2;
                const bool valid = key < t;
                lk[r] = valid ? (-fmaxf(zz, 0.f) - L) : 0.f;
                lb[r] = valid ? (fminf(zz, 0.f) - L) : -INFINITY;
            }
            float suf[16];
            suf[7] = 0.f; suf[15] = 0.f;
#pragma unroll
            for (int i = 6; i >= 0; --i) { suf[i] = suf[i + 1] + lk[i + 1]; suf[8 + i] = suf[9 + i] + lk[9 + i]; }
            const float T0 = suf[0] + lk[0], T1 = suf[8] + lk[8];
            const float P0 = __shfl_xor(T0, 32), P1 = __shfl_xor(T1, 32);
            const float base1 = C + (hi ? 0.f : P1), base0 = C + (hi ? (T1 + P1) : (P0 + T1 + P1));
            unsigned pw[8];
#pragma unroll
            for (int r = 0; r < 16; r += 2) {
                const float a0 = __builtin_amdgcn_exp2f((lb[r] + ((r < 8) ? base0 : base1) + suf[r]) * LOG2E), a1 = __builtin_amdgcn_exp2f((lb[r + 1] + ((r < 8) ? base0 : base1) + suf[r + 1]) * LOG2E);
                pw[r >> 1] = pg8::cvt_pk_bf16(a0, a1);
            }
            C += (T0 + T1) + (P0 + P1);
            const bf16x8 pa0 = __builtin_bit_cast(bf16x8, (v4u){pw[0], pw[1], pw[2], pw[3]}), pa1 = __builtin_bit_cast(bf16x8, (v4u){pw[4], pw[5], pw[6], pw[7]});
#pragma unroll
            for (int mt = 0; mt < 4; ++mt) { o[mt] = __builtin_amdgcn_mfma_f32_32x32x16_bf16(vf[mt][0], pa0, o[mt], 0, 0, 0); o[mt] = __builtin_amdgcn_mfma_f32_32x32x16_bf16(vf[mt][1], pa1, o[mt], 0, 0, 0); }
            if (__all(C < -44.0f)) break;
        }
        bf16* op = AO + (size_t)(b * SEQ + q0 + n) * D + h * HD + 4 * hi;
#pragma unroll
        for (int mt = 0; mt < 4; ++mt)
#pragma unroll
            for (int g = 0; g < 4; ++g) { v2u w; w.x = pg8::cvt_pk_bf16(o[mt][4 * g], o[mt][4 * g + 1]); w.y = pg8::cvt_pk_bf16(o[mt][4 * g + 2], o[mt][4 * g + 3]); *(v2u*)(op + 32 * mt + 8 * g) = w; }
    }
}

__device__ __forceinline__ void p11_router(Frame& F) {
    unsigned char* ws = F.ws; const int tid = F.tid, lane = F.lane, wave = F.wave;
    const float* H = (const float*)(ws + WS_H); const float* gn = F.in[IN_FFNNORM] + D; const float* Wr = F.in[IN_ROUTER];
    int* TOPE = (int*)(ws + WS_RT); int* POS = (int*)(ws + WS_RT + 128 * 1024); float* GATE = (float*)(ws + WS_RT + 256 * 1024); float* RSTD3 = (float*)(ws + WS_RT + 384 * 1024);
    LAS unsigned* lcnt = (LAS unsigned*)F.lds;
    LAS unsigned* gb = (LAS unsigned*)(F.lds + 64);
    LAS int* ltok = (LAS int*)(F.lds + 128);
    LAS float* lgt = (LAS float*)(F.lds + 128 + 1024);
    for (int chunk = F.bid; chunk < M / 64; chunk += F.G) {
        if (tid < 8) lcnt[tid] = 0u;
        __syncthreads();
        for (int r = 0; r < 8; ++r) {
            const int row = chunk * 64 + wave * 8 + r;
            const GAS f32x4* xr = (const GAS f32x4*)(H + (size_t)row * D) + lane; f32x4 v[4]; float ss = 0.f;
#pragma unroll
            for (int j = 0; j < 4; ++j) { v[j] = xr[64 * j]; ss += (v[j].x * v[j].x + v[j].y * v[j].y) + (v[j].z * v[j].z + v[j].w * v[j].w); }
            ss = wave_sum(ss); const float rs = 1.0f / sqrtf(ss * (1.0f / 1024.0f) + 1e-6f);
            float lg[8] = {0.f, 0.f, 0.f, 0.f, 0.f, 0.f, 0.f, 0.f};
#pragma unroll
            for (int j = 0; j < 4; ++j)
#pragma unroll
                for (int i = 0; i < 4; ++i) { const int k = 256 * j + 4 * lane + i; const float xv = v[j][i] * gn[k]; const f32x4 w0 = *(const f32x4*)(Wr + (size_t)k * 8), w1 = *(const f32x4*)(Wr + (size_t)k * 8 + 4);
                    lg[0] += xv * w0[0]; lg[1] += xv * w0[1]; lg[2] += xv * w0[2]; lg[3] += xv * w0[3]; lg[4] += xv * w1[0]; lg[5] += xv * w1[1]; lg[6] += xv * w1[2]; lg[7] += xv * w1[3]; }
#pragma unroll
            for (int e = 0; e < 8; ++e) lg[e] = wave_sum(lg[e]) * rs;
            int i1 = 0; float l1 = lg[0];
#pragma unroll
            for (int e = 1; e < 8; ++e) if (lg[e] > l1) { l1 = lg[e]; i1 = e; }
            int i2 = -1; float l2 = -INFINITY;
#pragma unroll
            for (int e = 0; e < 8; ++e) if (e != i1 && lg[e] > l2) { l2 = lg[e]; i2 = e; }
            const float g1 = 1.0f / (1.0f + __expf(l2 - l1)), g2 = 1.0f - g1;
            if (lane == 0) {
                const unsigned p1 = __hip_atomic_fetch_add(&lcnt[i1], 1u, __ATOMIC_RELAXED, __HIP_MEMORY_SCOPE_WORKGROUP), p2 = __hip_atomic_fetch_add(&lcnt[i2], 1u, __ATOMIC_RELAXED, __HIP_MEMORY_SCOPE_WORKGROUP);
                const int ti = wave * 8 + r; ltok[ti * 4 + 0] = i1; ltok[ti * 4 + 1] = i2; ltok[ti * 4 + 2] = (int)p1; ltok[ti * 4 + 3] = (int)p2;
                lgt[ti * 4 + 0] = g1; lgt[ti * 4 + 1] = g2; lgt[ti * 4 + 2] = rs;
            }
        }
        __syncthreads();
        if (tid < 8) gb[tid] = __hip_atomic_fetch_add(F.ctl + CW_CNT + tid, lcnt[tid], RLX_AGENT);
        __syncthreads();
        if (tid < 64) { const int row = chunk * 64 + tid; const int e1 = ltok[tid * 4], e2 = ltok[tid * 4 + 1];
            TOPE[row * 2] = e1; TOPE[row * 2 + 1] = e2; POS[row * 2] = (int)gb[e1] + ltok[tid * 4 + 2]; POS[row * 2 + 1] = (int)gb[e2] + ltok[tid * 4 + 3];
            GATE[row * 2] = lgt[tid * 4]; GATE[row * 2 + 1] = lgt[tid * 4 + 1]; RSTD3[row] = lgt[tid * 4 + 2]; }
        __syncthreads();
    }
}
__device__ __forceinline__ void moe_bases(Frame& F, int (&tb)[9]) {
    int acc = 0;
#pragma unroll
    for (int e = 0; e < 8; ++e) { tb[e] = acc; const unsigned c = __hip_atomic_load(F.ctl + CW_CNT + e, RLX_AGENT); acc += (int)((c + 255u) >> 8); }
    tb[8] = acc;
}
__device__ __forceinline__ void p12_permute(Frame& F) {
    unsigned char* ws = F.ws; const int lane = F.lane;
    const int* TOPE = (const int*)(ws + WS_RT); const int* POS = (const int*)(ws + WS_RT + 128 * 1024); const float* RSTD3 = (const float*)(ws + WS_RT + 384 * 1024);
    int* SLOT = (int*)(ws + WS_RT + 512 * 1024);
    const float* H = (const float*)(ws + WS_H); bf16* XP = (bf16*)(ws + WS_XPERM);
    int tb[9]; moe_bases(F, tb);
    const int gw = F.wave * F.G + F.bid, NGW = F.G * NWAVES;
    for (int i = gw; i < 2 * M; i += NGW) {
        const int row = i >> 1; const int e = TOPE[i]; int base = 0;
#pragma unroll
        for (int k = 0; k < 8; ++k) base = (e == k) ? tb[k] : base;
        const int slot = base * 256 + POS[i];
        const float rs = RSTD3[row];
        const GAS f32x4* src = (const GAS f32x4*)(H + (size_t)row * D) + lane; GAS unsigned long long* dst = (GAS unsigned long long*)(XP + (size_t)slot * D) + lane;
#pragma unroll
        for (int j = 0; j < 4; ++j) { const f32x4 v = src[64 * j]; dst[64 * j] = (unsigned long long)pk2(v.x * rs, v.y * rs) | ((unsigned long long)pk2(v.z * rs, v.w * rs) << 32); }
        if (lane == 0) SLOT[i] = slot;
    }
}
__device__ __forceinline__ void p15_combine(Frame& F) {
    unsigned char* ws = F.ws; const int lane = F.lane;
    const float* H = (const float*)(ws + WS_H); const bf16* Y = (const bf16*)(ws + WS_Y); const int* SLOT = (const int*)(ws + WS_RT + 512 * 1024); const float* GATE = (const float*)(ws + WS_RT + 256 * 1024);
    const int gw = F.wave * F.G + F.bid, NGW = F.G * NWAVES;
    for (int row = gw; row < M; row += NGW) {
        const int s1 = SLOT[row * 2], s2 = SLOT[row * 2 + 1]; const float g1 = GATE[row * 2], g2 = GATE[row * 2 + 1];
        const GAS f32x4* hr = (const GAS f32x4*)(H + (size_t)row * D) + lane; GAS f32x4* orow = (GAS f32x4*)(F.out + (size_t)row * D) + lane;
        const GAS v2u* y1 = (const GAS v2u*)(Y + (size_t)s1 * D) + lane; const GAS v2u* y2 = (const GAS v2u*)(Y + (size_t)s2 * D) + lane;
#pragma unroll
        for (int j = 0; j < 4; ++j) { const f32x4 h = __builtin_nontemporal_load(hr + 64 * j); const v2u a = __builtin_nontemporal_load(y1 + 64 * j), c = __builtin_nontemporal_load(y2 + 64 * j); f32x4 o;
            o.x = h.x + (g1 * bflo(a.x) + g2 * bflo(c.x)); o.y = h.y + (g1 * bfhi(a.x) + g2 * bfhi(c.x)); o.z = h.z + (g1 * bflo(a.y) + g2 * bflo(c.y)); o.w = h.w + (g1 * bfhi(a.y) + g2 * bfhi(c.y)); orow[64 * j] = o; }
    }
}

constexpr int N_PHASES = 16;
#ifndef MK_ONE_LAUNCH
#define MK_ONE_LAUNCH 1
#endif
struct Args { const float* in[17]; float* out; unsigned char* ws; int ph_lo, ph_hi; };
__global__ void __launch_bounds__(NWAVES * 64, 2) yoco_fwd(Args args) {
    extern __shared__ __attribute__((aligned(16))) unsigned char lds[];
    Frame F;
    F.lds = (LAS unsigned char*)lds; F.MISC = (volatile LAS unsigned*)(F.lds + MISC_OFF);
    F.tid = threadIdx.x; F.lane = F.tid & 63; F.wave = __builtin_amdgcn_readfirstlane(F.tid >> 6); F.G = gridDim.x; F.bid = blockIdx.x;
    F.ws = args.ws; F.ctl = (gu32*)(args.ws + WS_CTL); F.out = args.out;
#pragma unroll
    for (int i = 0; i < 17; ++i) F.in[i] = args.in[i];
    for (int u = F.tid; u < (LDS_BYTES - LDSCTL_OFF) / 4; u += NWAVES * 64) ((LAS unsigned*)(F.lds + LDSCTL_OFF))[u] = 0u;
    __syncthreads();
    unsigned char* ws = args.ws;
    XcdBarrier bar; bar.bar = (unsigned*)(F.ctl + CW_BAR); bar.x = 0; bar.st = nullptr;
    if (MK_ONE_LAUNCH) bar = xcd_barrier_post((unsigned*)(F.ctl + CW_BAR), F.MISC + 8);
    const int lo = args.ph_lo, hi = args.ph_hi;
#define IN(k) (lo <= (k) && (k) < hi)
#define SEAM(k) do { if (MK_ONE_LAUNCH && IN((k) + 1)) xcd_barrier(bar); } while (0)
    bf16* XB = (bf16*)(ws + WS_XB); float* H = (float*)(ws + WS_H); bf16* AO = (bf16*)(ws + WS_AO);

    if (IN(0)) { p0_prologue(F); SEAM(0); }
    if (IN(1)) {
        pg8::Gemm g{XB, (const bf16*)(ws + WS_WIN), M, 2048, D}; pg8::StaticOrder S; S.init(M, 2048, F.G, F.bid);
        pg8::EpiPlainBf16 E{(bf16*)(ws + WS_PROJ), 2048, 0xffff};
        pg8::gemm_phase<pg8::EpiPlainBf16, pg8::StaticOrder, true, true>(F.lds, g, S, E); SEAM(1); }
    if (IN(2)) { p2_post(F); SEAM(2); }
    if (IN(3)) { p3_index(F); SEAM(3); }
    if (IN(4)) { p4_dsa(F); SEAM(4); }
    if (IN(5)) {
        pg8::Gemm g{AO, (const bf16*)(ws + WS_WOA), M, D, D}; pg8::StaticOrder S; S.init(M, D, F.G, F.bid);
        pg8::EpiResid E{F.in[IN_X], H, XB, (float*)(ws + WS_SS1)};
        pg8::gemm_phase<pg8::EpiResid, pg8::StaticOrder, true, true>(F.lds, g, S, E); SEAM(5); }
    if (IN(6)) {
        pg8::Gemm g{XB, (const bf16*)(ws + WS_WGU), M, 2 * FF, D}; pg8::StaticOrder S; S.init(M, 2 * FF, F.G, F.bid);
        pg8::EpiSwiGLU<false> E{(bf16*)(ws + WS_HF), FF, (const float*)(ws + WS_SS1)};
        pg8::gemm_phase<pg8::EpiSwiGLU<false>, pg8::StaticOrder, true, true>(F.lds, g, S, E); SEAM(6); }
    if (IN(7)) {
        pg8::Gemm g{(const bf16*)(ws + WS_HF), (const bf16*)(ws + WS_WD), M, D, FF}; pg8::StaticOrder S; S.init(M, D, F.G, F.bid);
        pg8::EpiResid E{H, H, XB, (float*)(ws + WS_SS2)};
        pg8::gemm_phase<pg8::EpiResid, pg8::StaticOrder, true, true>(F.lds, g, S, E); SEAM(7); }
    if (IN(8)) {
        { pg8::Gemm g{XB, (const bf16*)(ws + WS_WKVQ), M, 2048, D}; pg8::StaticOrder S; S.init(M, 2048, F.G, F.bid);
          pg8::EpiScaleBf16 E{(bf16*)(ws + WS_KQ), 2048, (const float*)(ws + WS_SS2)};
          pg8::gemm_phase<pg8::EpiScaleBf16, pg8::StaticOrder, true, true>(F.lds, g, S, E); }
        { pg8::Gemm g{(const bf16*)(ws + WS_WKVQ) + (size_t)2048 * D, XB, D, M, D}; pg8::StaticOrder S; S.init(D, M, F.G, F.bid);
          pg8::EpiScaleColBf16 E{(bf16*)(ws + WS_VT), M, (const float*)(ws + WS_SS2)};
          pg8::gemm_phase<pg8::EpiScaleColBf16, pg8::StaticOrder, true, true>(F.lds, g, S, E); }
        SEAM(8); }
    if (IN(9)) { p9_sb(F); SEAM(9); }
    if (IN(10)) {
        pg8::Gemm g{AO, (const bf16*)(ws + WS_WOB), M, D, D}; pg8::StaticOrder S; S.init(M, D, F.G, F.bid);
        pg8::EpiResid E{H, H, XB, (float*)(ws + WS_SS3)};
        pg8::gemm_phase<pg8::EpiResid, pg8::StaticOrder, true, true>(F.lds, g, S, E); SEAM(10); }
    if (IN(11)) { p11_router(F); SEAM(11); }
    if (IN(12)) { p12_permute(F); SEAM(12); }
    if (IN(13)) {
        pg8::MoeOrder S; moe_bases(F, S.tb); S.npn = 22; S.G = F.G; S.c = F.bid;
        pg8::Gemm g{(const bf16*)(ws + WS_XPERM), (const bf16*)(ws + WS_WGUM), MAXSLOT, NE * 2 * FF, D};
        pg8::EpiSwiGLU<true> E{(bf16*)(ws + WS_HM), FF, nullptr};
        pg8::gemm_phase<pg8::EpiSwiGLU<true>, pg8::MoeOrder, true, true>(F.lds, g, S, E); SEAM(13); }
    if (IN(14)) {
        pg8::MoeOrder S; moe_bases(F, S.tb); S.npn = 4; S.G = F.G; S.c = F.bid;
        pg8::Gemm g{(const bf16*)(ws + WS_HM), (const bf16*)(ws + WS_WDM), MAXSLOT, NE * D, FF};
        pg8::EpiPlainBf16 E{(bf16*)(ws + WS_Y), D, 3};
        pg8::gemm_phase<pg8::EpiPlainBf16, pg8::MoeOrder, true, true>(F.lds, g, S, E); SEAM(14); }
    if (IN(15)) { p15_combine(F); }
#undef IN
#undef SEAM
}

extern "C" void kernel_launch(void* const* d_in, const int* in_sizes, int n_in, void* d_out, int out_size, void* d_ws, size_t ws_size, hipStream_t stream) {
    static int grid = 0;
    if (grid == 0) {
        if (n_in != 17 || out_size != M * D || ws_size < WS_END) { fprintf(stderr, "kernel_launch: unexpected problem (n_in %d, out %d, ws %zu < %zu)\n", n_in, out_size, ws_size, (size_t)WS_END); grid = -1; return; }
        int dev = 0, cus = 0, per_cu = 0;
        if (hipGetDevice(&dev) != hipSuccess || hipDeviceGetAttribute(&cus, hipDeviceAttributeMultiprocessorCount, dev) != hipSuccess) { grid = -1; return; }
        if (hipFuncSetAttribute((const void*)yoco_fwd, hipFuncAttributeMaxDynamicSharedMemorySize, LDS_BYTES) != hipSuccess) { fprintf(stderr, "kernel_launch: hipFuncSetAttribute failed\n"); grid = -1; return; }
        if (hipOccupancyMaxActiveBlocksPerMultiprocessor(&per_cu, (const void*)yoco_fwd, NWAVES * 64, LDS_BYTES) != hipSuccess || per_cu < 1) fprintf(stderr, "kernel_launch: occupancy query says %d\n", per_cu);
        (void)hipGetLastError();
        grid = cus;
    }
    if (grid < 0) return;
    if (hipMemsetAsync((char*)d_ws + WS_CTL, 0, CTL_ZERO_BYTES, stream) != hipSuccess) return;
    Args a{};
    for (int i = 0; i < 17; ++i) a.in[i] = (const float*)d_in[i];
    a.out = (float*)d_out; a.ws = (unsigned char*)d_ws;
#if MK_ONE_LAUNCH
    a.ph_lo = 0; a.ph_hi = N_PHASES;
    hipLaunchKernelGGL(yoco_fwd, dim3(grid), dim3(NWAVES * 64), LDS_BYTES, stream, a);
#else
    for (int p = 0; p < N_PHASES; ++p) { a.ph_lo = p; a.ph_hi = p + 1; hipLaunchKernelGGL(yoco_fwd, dim3(grid), dim3(NWAVES * 64), LDS_BYTES, stream, a); }
#endif
}
```

```cpp
#include <hip/hip_runtime.h>
#include <cstdio>
#include <cstdint>
namespace pg8 {
#define PG8_LAS __attribute__((address_space(3)))
typedef unsigned short bf16_t;
typedef short bf16x8 __attribute__((ext_vector_type(8)));
typedef float f32x4 __attribute__((ext_vector_type(4)));
typedef unsigned u32x4 __attribute__((ext_vector_type(4)));
typedef int i32x4 __attribute__((ext_vector_type(4)));
typedef int i32x8 __attribute__((ext_vector_type(8)));
constexpr int BM = 256, BK = 64, HALF = 128, HTB = HALF * BK * 2  , STAGE_BYTES = 8 * HTB, NXCD = 8, WGM = 8;

__host__ __device__ __forceinline__ int lds_byte(int r, int c) { const int st = (r >> 4) * 2 + (c >> 5), rr = r & 15, cc = c & 31, ob = rr * 64 + cc * 2; return st * 1024 + (ob ^ (((ob >> 9) & 1) << 5)); }
__host__ __device__ __forceinline__ void stage_rc(int b, int& R, int& C) { const int st = b / 1024, sb = b % 1024, swz = sb ^ (((sb >> 9) & 1) << 5); R = (st >> 1) * 16 + swz / 64; C = (st & 1) * 32 + (swz % 64) / 2; }
__host__ __device__ __forceinline__ int perm32(int rho) { const int n = rho >> 4, i = rho & 15; return 8 * (i >> 2) + 4 * n + (i & 3); }

struct Unit { int pm, pn; int koff = 0; };
struct Gemm { const bf16_t* A; const bf16_t* Bt; int M, N, K; int ld = 0; };

struct StaticOrder {
    int nM, nN, nwg, G, c;
    __host__ __device__ void init(int M, int N, int G_, int c_) { nM = M / BM; nN = N / BM; nwg = nM * nN; G = G_; c = c_; }
    __host__ __device__ bool next(int i, Unit& u) const {
        const long L = (long)i * G + c; if (L >= nwg) return false;
        int wgid = (int)L; { const int q = nwg / NXCD, r = nwg % NXCD, xcd = wgid % NXCD, off = wgid / NXCD; wgid = (xcd < r ? xcd * (q + 1) : r * (q + 1) + (xcd - r) * q) + off; }
        const int nig = WGM * nN, gid = wgid / nig, fm = gid * WGM, gsz = (nM - fm) < WGM ? (nM - fm) : WGM;
        u.pm = fm + ((wgid % nig) % gsz); u.pn = (wgid % nig) / gsz; return true;
    }
    __device__ __forceinline__ void a_ready(const Unit&) const {}
    __device__ __forceinline__ void done(const Unit&) const {}
};

__device__ __forceinline__ unsigned cvt_pk_bf16(float lo, float hi) { unsigned r; asm volatile("v_cvt_pk_bf16_f32 %0, %1, %2" : "=v"(r) : "v"(lo), "v"(hi)); return r; }
typedef unsigned u32x2 __attribute__((ext_vector_type(2)));
constexpr float RMS_EPS = 1e-6f;
__device__ __forceinline__ float rstd16(const float* p) {
    const f32x4 a = *(const f32x4*)p, b = *(const f32x4*)(p + 4), c = *(const f32x4*)(p + 8), d = *(const f32x4*)(p + 12);
    const float s = (((a[0] + a[1]) + (a[2] + a[3])) + ((b[0] + b[1]) + (b[2] + b[3]))) + (((c[0] + c[1]) + (c[2] + c[3])) + ((d[0] + d[1]) + (d[2] + d[3])));
    return 1.0f / sqrtf(s * (1.0f / 1024.0f) + RMS_EPS);
}
struct EpiScaleBf16 {
    static constexpr bool PERM = true, AFTER_DRAIN = false;
    bf16_t* O; int ldc; const float* ss;
    __device__ __forceinline__ void operator()(const f32x4 (&acc)[2][2][4][2], const Unit& u, int wr, int wc, int fr, int fq) const {
        const int row0 = u.pm * BM + wr * 64 + fr, col0 = u.pn * BM + wc * 32 + 8 * fq;
        float rsv[2][4];
#pragma unroll
        for (int ai = 0; ai < 2; ++ai)
#pragma unroll
            for (int m = 0; m < 4; ++m) rsv[ai][m] = rstd16(ss + (size_t)(row0 + ai * HALF + m * 16) * 16);
#pragma unroll
        for (int ai = 0; ai < 2; ++ai)
#pragma unroll
            for (int m = 0; m < 4; ++m) { const int row = row0 + ai * HALF + m * 16; const float rs = rsv[ai][m]; bf16_t* rowp = O + (size_t)row * ldc + col0;
#pragma unroll
                for (int bj = 0; bj < 2; ++bj) { const f32x4 v0 = acc[ai][bj][m][0] * rs, v1 = acc[ai][bj][m][1] * rs;
                    u32x4 w; w.x = cvt_pk_bf16(v0[0], v0[1]); w.y = cvt_pk_bf16(v0[2], v0[3]); w.z = cvt_pk_bf16(v1[0], v1[1]); w.w = cvt_pk_bf16(v1[2], v1[3]);
                    *(u32x4*)(rowp + bj * HALF) = w; } }
    }
};
struct EpiPlainBf16 {
    static constexpr bool PERM = true, AFTER_DRAIN = false;
    bf16_t* O; int ldc; int pnmask;
    __device__ __forceinline__ void operator()(const f32x4 (&acc)[2][2][4][2], const Unit& u, int wr, int wc, int fr, int fq) const {
        const int row0 = u.pm * BM + wr * 64 + fr, col0 = (u.pn & pnmask) * BM + wc * 32 + 8 * fq;
#pragma unroll
        for (int ai = 0; ai < 2; ++ai)
#pragma unroll
            for (int m = 0; m < 4; ++m) { bf16_t* rowp = O + (size_t)(row0 + ai * HALF + m * 16) * ldc + col0;
#pragma unroll
                for (int bj = 0; bj < 2; ++bj) { const f32x4 v0 = acc[ai][bj][m][0], v1 = acc[ai][bj][m][1];
                    u32x4 w; w.x = cvt_pk_bf16(v0[0], v0[1]); w.y = cvt_pk_bf16(v0[2], v0[3]); w.z = cvt_pk_bf16(v1[0], v1[1]); w.w = cvt_pk_bf16(v1[2], v1[3]);
                    *(u32x4*)(rowp + bj * HALF) = w; } }
    }
};
struct EpiScaleColBf16 {
    static constexpr bool PERM = true, AFTER_DRAIN = false;
    bf16_t* O; int ldc; const float* ss;
    __device__ __forceinline__ void operator()(const f32x4 (&acc)[2][2][4][2], const Unit& u, int wr, int wc, int fr, int fq) const {
        const int row0 = u.pm * BM + wr * 64 + fr, col0 = u.pn * BM + wc * 32 + 8 * fq;
        f32x4 rs[2][2];
#pragma unroll
        for (int bj = 0; bj < 2; ++bj)
#pragma unroll
            for (int n = 0; n < 2; ++n)
#pragma unroll
                for (int e = 0; e < 4; ++e) rs[bj][n][e] = rstd16(ss + (size_t)(col0 + bj * HALF + 4 * n + e) * 16);
#pragma unroll
        for (int ai = 0; ai < 2; ++ai)
#pragma unroll
            for (int m = 0; m < 4; ++m) { const int row = row0 + ai * HALF + m * 16; bf16_t* rowp = O + (size_t)row * ldc + col0;
#pragma unroll
                for (int bj = 0; bj < 2; ++bj) { const f32x4 v0 = acc[ai][bj][m][0] * rs[bj][0], v1 = acc[ai][bj][m][1] * rs[bj][1];
                    u32x4 w; w.x = cvt_pk_bf16(v0[0], v0[1]); w.y = cvt_pk_bf16(v0[2], v0[3]); w.z = cvt_pk_bf16(v1[0], v1[1]); w.w = cvt_pk_bf16(v1[2], v1[3]);
                    *(u32x4*)(rowp + bj * HALF) = w; } }
    }
};
struct EpiResid {
    static constexpr bool PERM = false, AFTER_DRAIN = false;
    const float* base; float* H; bf16_t* XB; float* ssp;
    __device__ __forceinline__ void operator()(const f32x4 (&acc)[2][2][4][2], const Unit& u, int wr, int wc, int fr, int fq) const {
        const int row0 = u.pm * BM + wr * 64 + fr, col0 = u.pn * BM + wc * 32 + 4 * fq;
#pragma unroll
        for (int ai = 0; ai < 2; ++ai) {
            f32x4 bv[4][2][2];
#pragma unroll
            for (int m = 0; m < 4; ++m)
#pragma unroll
                for (int bj = 0; bj < 2; ++bj)
#pragma unroll
                    for (int n = 0; n < 2; ++n) bv[m][bj][n] = *(const f32x4*)(base + (size_t)(row0 + ai * HALF + m * 16) * 1024 + col0 + bj * HALF + n * 16);
#pragma unroll
            for (int m = 0; m < 4; ++m) { const int row = row0 + ai * HALF + m * 16; float q = 0.f;
#pragma unroll
                for (int bj = 0; bj < 2; ++bj)
#pragma unroll
                    for (int n = 0; n < 2; ++n) { const size_t off = (size_t)row * 1024 + col0 + bj * HALF + n * 16;
                        const f32x4 v = bv[m][bj][n] + acc[ai][bj][m][n]; *(f32x4*)(H + off) = v;
                        q += (v[0] * v[0] + v[1] * v[1]) + (v[2] * v[2] + v[3] * v[3]);
                        u32x2 w; w.x = cvt_pk_bf16(v[0], v[1]); w.y = cvt_pk_bf16(v[2], v[3]); *(u32x2*)(XB + off) = w; }
                q += __shfl_xor(q, 16); q += __shfl_xor(q, 32);
                if (fq == 0) ssp[(size_t)row * 16 + u.pn * 4 + wc] = q; }
        }
    }
};
__device__ __forceinline__ float silu_mul(float g, float u) { return g * __builtin_amdgcn_rcpf(1.0f + __builtin_amdgcn_exp2f(g * -1.4426950408889634f)) * u; }
template <bool MOE> struct EpiSwiGLU {
    static constexpr bool PERM = true, AFTER_DRAIN = false;
    bf16_t* O; int ldc; const float* ss;
    __device__ __forceinline__ void operator()(const f32x4 (&acc)[2][2][4][2], const Unit& u, int wr, int wc, int fr, int fq) const {
        const int row0 = u.pm * BM + wr * 64 + fr; const int pnl = MOE ? (u.pn % 22) : u.pn; const int col0 = pnl * HALF + wc * 32 + 8 * fq;
        float rsv[2][4];
#pragma unroll
        for (int ai = 0; ai < 2; ++ai)
#pragma unroll
            for (int m = 0; m < 4; ++m) { const int row = row0 + ai * HALF + m * 16; rsv[ai][m] = MOE ? 1.0f : rstd16(ss + (size_t)row * 16); }
#pragma unroll
        for (int ai = 0; ai < 2; ++ai)
#pragma unroll
            for (int m = 0; m < 4; ++m) { const int row = row0 + ai * HALF + m * 16; const float rs = rsv[ai][m];
                const f32x4 g0 = acc[ai][0][m][0] * rs, g1 = acc[ai][0][m][1] * rs, u0 = acc[ai][1][m][0] * rs, u1 = acc[ai][1][m][1] * rs;
                u32x4 w; w.x = cvt_pk_bf16(silu_mul(g0[0], u0[0]), silu_mul(g0[1], u0[1])); w.y = cvt_pk_bf16(silu_mul(g0[2], u0[2]), silu_mul(g0[3], u0[3]));
                w.z = cvt_pk_bf16(silu_mul(g1[0], u1[0]), silu_mul(g1[1], u1[1])); w.w = cvt_pk_bf16(silu_mul(g1[2], u1[2]), silu_mul(g1[3], u1[3]));
                *(u32x4*)(O + (size_t)row * ldc + col0) = w; }
    }
};
constexpr float F8_SX = 16.f, F8_SWGU = 512.f, F8_SH = 16.f, F8_SWD = 1024.f;
__device__ __forceinline__ unsigned pk4_fp8(float a, float b, float c, float d) {
    a = __builtin_amdgcn_fmed3f(a, -448.f, 448.f); b = __builtin_amdgcn_fmed3f(b, -448.f, 448.f); c = __builtin_amdgcn_fmed3f(c, -448.f, 448.f); d = __builtin_amdgcn_fmed3f(d, -448.f, 448.f);
    int w = __builtin_amdgcn_cvt_pk_fp8_f32(a, b, 0, false); w = __builtin_amdgcn_cvt_pk_fp8_f32(c, d, w, true); return (unsigned)w;
}
struct EpiSwiGLUMoe8 {
    static constexpr bool PERM = true, AFTER_DRAIN = false;
    unsigned char* O; int ldc;
    __device__ __forceinline__ void operator()(const f32x4 (&acc)[2][2][4][2], const Unit& u, int wr, int wc, int fr, int fq) const {
        const int row0 = u.pm * BM + wr * 64 + fr; const int col0 = (u.pn % 22) * HALF + wc * 32 + 8 * fq; const float rs = 1.0f / (F8_SX * F8_SWGU);
#pragma unroll
        for (int ai = 0; ai < 2; ++ai)
#pragma unroll
            for (int m = 0; m < 4; ++m) { const int row = row0 + ai * HALF + m * 16;
                const f32x4 g0 = acc[ai][0][m][0] * rs, g1 = acc[ai][0][m][1] * rs, u0 = acc[ai][1][m][0] * F8_SH * rs, u1 = acc[ai][1][m][1] * F8_SH * rs;
                u32x2 w; w.x = pk4_fp8(silu_mul(g0[0], u0[0]), silu_mul(g0[1], u0[1]), silu_mul(g0[2], u0[2]), silu_mul(g0[3], u0[3]));
                w.y = pk4_fp8(silu_mul(g1[0], u1[0]), silu_mul(g1[1], u1[1]), silu_mul(g1[2], u1[2]), silu_mul(g1[3], u1[3]));
                *(u32x2*)(O + (size_t)row * ldc + col0) = w; }
    }
};
struct EpiScaledBf16 {
    static constexpr bool PERM = true, AFTER_DRAIN = false;
    bf16_t* O; int ldc; int pnmask; float sc;
    __device__ __forceinline__ void operator()(const f32x4 (&acc)[2][2][4][2], const Unit& u, int wr, int wc, int fr, int fq) const {
        const int row0 = u.pm * BM + wr * 64 + fr, col0 = (u.pn & pnmask) * BM + wc * 32 + 8 * fq;
#pragma unroll
        for (int ai = 0; ai < 2; ++ai)
#pragma unroll
            for (int m = 0; m < 4; ++m) { bf16_t* rowp = O + (size_t)(row0 + ai * HALF + m * 16) * ldc + col0;
#pragma unroll
                for (int bj = 0; bj < 2; ++bj) { const f32x4 v0 = acc[ai][bj][m][0] * sc, v1 = acc[ai][bj][m][1] * sc;
                    u32x4 w; w.x = cvt_pk_bf16(v0[0], v0[1]); w.y = cvt_pk_bf16(v0[2], v0[3]); w.z = cvt_pk_bf16(v1[0], v1[1]); w.w = cvt_pk_bf16(v1[2], v1[3]);
                    *(u32x4*)(rowp + bj * HALF) = w; } }
    }
};
struct MoeOrder {
    int tb[9]; int npn, G, c;
    __device__ __forceinline__ bool next(int i, Unit& u) const {
        const int L = i * G + c; if (L >= tb[8] * npn) return false;
        const int t = L / npn, j = L - t * npn; int e = 0;
#pragma unroll
        for (int k = 1; k < 8; ++k) e += (t >= tb[k]) ? 1 : 0;
        u.pm = t; u.pn = e * npn + j; return true;
    }
    __device__ __forceinline__ void a_ready(const Unit&) const {}
    __device__ __forceinline__ void done(const Unit&) const {}
};

template <class Epi, class Sched, bool ALIGN_EPI = false, bool SP2 = false, bool F8 = false>
__device__ __forceinline__ void gemm_phase(PG8_LAS unsigned char* lds, const Gemm g, const Sched& S, const Epi& E) {
    const int tid = threadIdx.x, wid = __builtin_amdgcn_readfirstlane(tid >> 6), lane = tid & 63, wr = wid >> 2, wc = wid & 3, fr = lane & 15, fq = lane >> 4;
    const int K = g.K, nt = K / BK, LD = g.ld ? g.ld : g.K;
    unsigned voffA[2], voffB[2];
#pragma unroll
    for (int i = 0; i < 2; ++i) { int R, C; stage_rc(tid * 16 + i * 8192, R, C); const int Rb = Epi::PERM ? ((R & ~31) + perm32(R & 31)) : R;
        voffA[i] = (unsigned)(R * LD + C) * 2u; voffB[i] = (unsigned)(Rb * LD + C) * 2u; }
    const size_t kstep = (size_t)(BK * 2);
    const size_t hstep = (size_t)HALF * LD * 2;
    const size_t tstep = 2 * hstep;
    const unsigned ldsw = (unsigned)wid * 1024u;
    const int aoff = lds_byte(wr * 64 + fr, fq * 8), boff = lds_byte(wc * 32 + fr, fq * 8);
#define PG8_SA(b, h) (((b) * 2 + (h)) * HTB)
#define PG8_SB(b, h) ((4 + (b) * 2 + (h)) * HTB)
#define PG8_STAGE(bufoff, gbase, voff) do { _Pragma("unroll") for (int _i = 0; _i < 2; ++_i) \
        __builtin_amdgcn_global_load_lds((const unsigned*)((const char*)(gbase) + (voff)[_i]), (PG8_LAS unsigned*)(lds + (bufoff) + ldsw + _i * 8192), 16, 0, 0); } while (0)
#define PG8_LD32(p) __builtin_shufflevector(*(const PG8_LAS i32x4*)(p), *(const PG8_LAS i32x4*)((p) + 1024), 0, 1, 2, 3, 4, 5, 6, 7)
#define PG8_LDA(dst, b, h) do { if constexpr (F8) { _Pragma("unroll") for (int m = 0; m < 4; ++m) dst##8[m] = PG8_LD32(lds + PG8_SA(b, h) + aoff + m * 2048); } else { \
        _Pragma("unroll") for (int m = 0; m < 4; ++m) _Pragma("unroll") for (int k = 0; k < 2; ++k) dst[m][k] = *(const PG8_LAS bf16x8*)(lds + PG8_SA(b, h) + aoff + m * 2048 + k * 1024); } } while (0)
#define PG8_LDB(dst, b, h) do { if constexpr (F8) { _Pragma("unroll") for (int n = 0; n < 2; ++n) dst##8[n] = PG8_LD32(lds + PG8_SB(b, h) + boff + n * 2048); } else { \
        _Pragma("unroll") for (int n = 0; n < 2; ++n) _Pragma("unroll") for (int k = 0; k < 2; ++k) dst[n][k] = *(const PG8_LAS bf16x8*)(lds + PG8_SB(b, h) + boff + n * 2048 + k * 1024); } } while (0)
#define PG8_MMA(ai, bj, At, Bt) do { __builtin_amdgcn_s_setprio(1); if constexpr (F8) { _Pragma("unroll") for (int m = 0; m < 4; ++m) _Pragma("unroll") for (int n = 0; n < 2; ++n) \
        asm("v_mfma_f32_16x16x128_f8f6f4 %0, %1, %2, %0" : "+v"(acc[ai][bj][m][n]) : "v"(Bt##8[n]), "v"(At##8[m])); } else { \
        _Pragma("unroll") for (int m = 0; m < 4; ++m) _Pragma("unroll") for (int n = 0; n < 2; ++n) _Pragma("unroll") for (int k = 0; k < 2; ++k) \
        acc[ai][bj][m][n] = __builtin_amdgcn_mfma_f32_16x16x32_bf16(Bt[n][k], At[m][k], acc[ai][bj][m][n], 0, 0, 0); } __builtin_amdgcn_s_setprio(0); } while (0)
#define PG8_WAIT_V(n) asm volatile("s_waitcnt vmcnt(" #n ")" ::: "memory")
#define PG8_WAIT_L(n) asm volatile("s_waitcnt lgkmcnt(" #n ")" ::: "memory")
#define PG8_BAR __builtin_amdgcn_s_barrier()
#define PG8_SCHED __builtin_amdgcn_sched_barrier(0)
    Unit cur, nxt; int ui = 0;
    if (!S.next(0, cur)) return;
    f32x4 acc[2][2][4][2];
#pragma unroll
    for (int a = 0; a < 2; ++a)
#pragma unroll
        for (int b = 0; b < 2; ++b)
#pragma unroll
            for (int m = 0; m < 4; ++m)
#pragma unroll
                for (int n = 0; n < 2; ++n) acc[a][b][m][n] = (f32x4){0.f, 0.f, 0.f, 0.f};
    bf16x8 At[4][2], B0[2][2], B1[2][2]; i32x8 At8[4], B08[2], B18[2];
    const char* cA = (const char*)g.A + (size_t)cur.pm * tstep + cur.koff; const char* cB = (const char*)g.Bt + (size_t)cur.pn * tstep + cur.koff;
    S.a_ready(cur);
    if constexpr (SP2) {
        PG8_STAGE(PG8_SB(0, 0), cB, voffB); PG8_STAGE(PG8_SB(0, 1), cB + hstep, voffB); PG8_STAGE(PG8_SA(0, 0), cA, voffA); PG8_STAGE(PG8_SA(0, 1), cA + hstep, voffA);
        if (wr == 1) PG8_BAR;
        PG8_WAIT_V(2); PG8_BAR;
        PG8_STAGE(PG8_SB(1, 0), cB + kstep, voffB); PG8_STAGE(PG8_SA(1, 0), cA + kstep, voffA); PG8_STAGE(PG8_SB(1, 1), cB + hstep + kstep, voffB);
        PG8_WAIT_V(6); PG8_BAR;
    } else {
        PG8_STAGE(PG8_SB(0, 0), cB, voffB); PG8_STAGE(PG8_SA(0, 0), cA, voffA); PG8_STAGE(PG8_SB(0, 1), cB + hstep, voffB); PG8_STAGE(PG8_SA(0, 1), cA + hstep, voffA);
        if (wr == 1) PG8_BAR;
        PG8_WAIT_V(4); PG8_BAR;
        PG8_STAGE(PG8_SB(1, 0), cB + kstep, voffB); PG8_STAGE(PG8_SA(1, 0), cA + kstep, voffA); PG8_STAGE(PG8_SB(1, 1), cB + hstep + kstep, voffB);
        PG8_WAIT_V(6); PG8_BAR;
    }
    for (;;) {
        const bool has_next = S.next(ui + 1, nxt);
        const char* nA = has_next ? (const char*)g.A + (size_t)nxt.pm * tstep + nxt.koff : cA; const char* nB = has_next ? (const char*)g.Bt + (size_t)nxt.pn * tstep + nxt.koff : cB;
#pragma clang loop unroll(disable)
        for (int t = 0; t < nt; t += 2) {
            const bool last = (t == nt - 2);
            const char* a1 = cA + (size_t)(t + 1) * kstep;
            const char* a2 = last ? nA : cA + (size_t)(t + 2) * kstep; const char* b2 = last ? nB : cB + (size_t)(t + 2) * kstep;
            const char* a3 = a2 + kstep; const char* b3 = b2 + kstep;
            if (last && has_next) S.a_ready(nxt);
            if constexpr (SP2) {
            PG8_LDB(B0, 0, 0); PG8_LDB(B1, 0, 1); PG8_SCHED; PG8_LDA(At, 0, 0); PG8_STAGE(PG8_SA(1, 1), a1 + hstep, voffA);
            PG8_WAIT_V(8); PG8_WAIT_L(0); PG8_BAR; PG8_MMA(0, 0, At, B0); PG8_MMA(0, 1, At, B1); PG8_BAR; PG8_SCHED;
            PG8_LDA(At, 0, 1); PG8_STAGE(PG8_SB(0, 0), b2, voffB); PG8_STAGE(PG8_SB(0, 1), b2 + hstep, voffB); PG8_STAGE(PG8_SA(0, 0), a2, voffA);
            PG8_WAIT_V(8); PG8_WAIT_L(0); PG8_BAR; PG8_MMA(1, 0, At, B0); PG8_MMA(1, 1, At, B1); PG8_BAR; PG8_SCHED;
            PG8_LDB(B0, 1, 0); PG8_LDB(B1, 1, 1); PG8_SCHED; PG8_LDA(At, 1, 0); PG8_STAGE(PG8_SA(0, 1), a2 + hstep, voffA);
            PG8_WAIT_V(8); PG8_WAIT_L(0); PG8_BAR; PG8_MMA(0, 0, At, B0); PG8_MMA(0, 1, At, B1); PG8_BAR; PG8_SCHED;
            PG8_LDA(At, 1, 1); PG8_STAGE(PG8_SB(1, 0), b3, voffB); PG8_STAGE(PG8_SB(1, 1), b3 + hstep, voffB); PG8_STAGE(PG8_SA(1, 0), a3, voffA);
            PG8_WAIT_V(8); PG8_WAIT_L(0); PG8_BAR; PG8_MMA(1, 0, At, B0); PG8_MMA(1, 1, At, B1); PG8_BAR; PG8_SCHED;
            } else {
            PG8_LDB(B0, 0, 0); PG8_SCHED; PG8_LDA(At, 0, 0); PG8_STAGE(PG8_SA(1, 1), a1 + hstep, voffA);
            PG8_WAIT_L(8); PG8_BAR; PG8_WAIT_L(0); PG8_MMA(0, 0, At, B0); PG8_BAR; PG8_SCHED;
            PG8_LDB(B1, 0, 1); PG8_STAGE(PG8_SB(0, 0), b2, voffB);
            PG8_BAR; PG8_WAIT_L(0); PG8_MMA(0, 1, At, B1); PG8_BAR;
            PG8_LDA(At, 0, 1); PG8_STAGE(PG8_SA(0, 0), a2, voffA);
            PG8_BAR; PG8_WAIT_L(0); PG8_MMA(1, 0, At, B0); PG8_BAR; PG8_SCHED;
            PG8_STAGE(PG8_SB(0, 1), b2 + hstep, voffB);
            PG8_WAIT_V(6); PG8_BAR; PG8_MMA(1, 1, At, B1); PG8_BAR;
            PG8_LDB(B0, 1, 0); PG8_SCHED; PG8_LDA(At, 1, 0); PG8_STAGE(PG8_SA(0, 1), a2 + hstep, voffA);
            PG8_WAIT_L(8); PG8_BAR; PG8_WAIT_L(0); PG8_MMA(0, 0, At, B0); PG8_BAR; PG8_SCHED;
            PG8_LDB(B1, 1, 1); PG8_STAGE(PG8_SB(1, 0), b3, voffB);
            PG8_BAR; PG8_WAIT_L(0); PG8_MMA(0, 1, At, B1); PG8_BAR;
            PG8_LDA(At, 1, 1); PG8_STAGE(PG8_SA(1, 0), a3, voffA);
            PG8_BAR; PG8_WAIT_L(0); PG8_MMA(1, 0, At, B0); PG8_BAR; PG8_SCHED;
            PG8_STAGE(PG8_SB(1, 1), b3 + hstep, voffB);
            PG8_WAIT_V(6); PG8_BAR; PG8_MMA(1, 1, At, B1); PG8_BAR;
            }
        }
        if constexpr (F8) asm volatile("s_nop 15\n\ts_nop 15" ::: "memory");
        if constexpr (ALIGN_EPI) { if (wr == 0) PG8_BAR; }
        if constexpr (!Epi::AFTER_DRAIN) { E(acc, cur, wr, wc, fr, fq); S.done(cur); }
        if (!has_next) break;
#pragma unroll
        for (int a = 0; a < 2; ++a)
#pragma unroll
            for (int b = 0; b < 2; ++b)
#pragma unroll
                for (int m = 0; m < 4; ++m)
#pragma unroll
                    for (int n = 0; n < 2; ++n) acc[a][b][m][n] = (f32x4){0.f, 0.f, 0.f, 0.f};
        cur = nxt; cA = nA; cB = nB; ++ui;
        if constexpr (ALIGN_EPI) { if (wr == 1) PG8_BAR; }
    }
    PG8_WAIT_V(0);
    if constexpr (!ALIGN_EPI) { if (wr == 0) PG8_BAR; }
    PG8_BAR;
    if constexpr (Epi::AFTER_DRAIN) { E.fused(acc, cur, wr, wc, fr, fq, lds, wid, lane); S.done(cur); }
#undef PG8_SA
#undef PG8_SB
#undef PG8_STAGE
#undef PG8_LDA
#undef PG8_LDB
#undef PG8_MMA
#undef PG8_LD32
#undef PG8_WAIT_V
#undef PG8_WAIT_L
#undef PG8_BAR
#undef PG8_SCHED
}
}

constexpr int NWAVES = 8;
constexpr int BATCH = 2, SEQ = 8192, D = 1024, M = BATCH * SEQ;
constexpr int HD = 128, NH = 8, NKV = 2, NIH = 8, IDX = 64, TOPK = 256;
constexpr int A_IN = 2120, FF = 2816, NE = 8;
constexpr int MAXSLOT = 34816;
constexpr float QSCALE = 0.12751743082459868f;
constexpr float SBSCALE = 0.08838834764831845f;
constexpr float WISCALE = 0.04419417382415922f;
constexpr size_t MiB = 1u << 20;
constexpr size_t WS_CTL = 0, CTL_ZERO_BYTES = 1 * MiB;
constexpr size_t WS_WIN = 2 * MiB, WS_WTAIL = 6 * MiB, WS_WOA = 7 * MiB, WS_WGU = 9 * MiB, WS_WD = 20 * MiB, WS_WKVQ = 26 * MiB, WS_WOB = 32 * MiB, WS_WGUM = 34 * MiB, WS_WDM = 122 * MiB;
constexpr size_t WS_H = 166 * MiB, WS_XB = 230 * MiB, WS_SS0 = 262 * MiB, WS_SS1 = 263 * MiB, WS_SS2 = 264 * MiB, WS_SS3 = 265 * MiB;
constexpr size_t WS_T = 266 * MiB;
constexpr size_t WS_PROJ = WS_T, WS_QF = 330 * MiB, WS_KVF = 362 * MiB, WS_QIF = 378 * MiB, WS_KIF = 394 * MiB, WS_WIF = 396 * MiB, WS_SEL = 397 * MiB, WS_AO = 413 * MiB;
constexpr size_t WS_HF = WS_T, WS_KQ = WS_T, WS_VT = 330 * MiB;
constexpr size_t WS_XPERM = WS_T, WS_HM = 334 * MiB, WS_Y = 521 * MiB;
constexpr size_t WS_RT = 590 * MiB;
constexpr size_t WS_END = 591 * MiB;
constexpr int CW_CNT = 64;
constexpr int CW_P3Q = 192;
constexpr int CW_BAR = 4096;
constexpr int RING_BYTES = 131072, LDSCTL_OFF = RING_BYTES, MISC_OFF = LDSCTL_OFF + 320, LDS_BYTES = 147456;

#define GAS __attribute__((address_space(1)))
#define LAS __attribute__((address_space(3)))
typedef unsigned short bf16;
typedef unsigned v4u __attribute__((ext_vector_type(4)));
typedef unsigned v2u __attribute__((ext_vector_type(2)));
typedef float f32x4 __attribute__((ext_vector_type(4)));
typedef short bf16x8 __attribute__((ext_vector_type(8)));
typedef float f32x16 __attribute__((ext_vector_type(16)));
typedef GAS unsigned gu32;
#define RLX_AGENT __ATOMIC_RELAXED, __HIP_MEMORY_SCOPE_AGENT
#define LDS_WAIT() asm volatile("s_waitcnt lgkmcnt(0)" ::: "memory")
#define VM_WAIT() asm volatile("s_waitcnt vmcnt(0)" ::: "memory")
__device__ __forceinline__ unsigned f2bf(float f) { unsigned u = __builtin_bit_cast(unsigned, f); return (u + 0x7fffu + ((u >> 16) & 1u)) >> 16; }
__device__ __forceinline__ unsigned pk2(float lo, float hi) { return f2bf(lo) | (f2bf(hi) << 16); }
__device__ __forceinline__ float bflo(unsigned w) { return __uint_as_float(w << 16); }
__device__ __forceinline__ float bfhi(unsigned w) { return __uint_as_float(w & 0xffff0000u); }
__device__ __forceinline__ float wave_sum(float v) {
#pragma unroll
    for (int o = 1; o < 64; o <<= 1) v += __shfl_xor(v, o);
    return v;
}
__device__ __forceinline__ float wave_max(float v) {
#pragma unroll
    for (int o = 1; o < 64; o <<= 1) v = fmaxf(v, __shfl_xor(v, o));
    return v;
}
__device__ __forceinline__ void sincos_acc(float a, float& c, float& s) {
    const double x = (double)a; const double n = __builtin_rint(x * 0.63661977236758134308);
    const double r = __builtin_fma(-n, 6.123233995736766035869e-17, __builtin_fma(-n, 1.57079632679489655800, x)); const double r2 = r * r;
    double sn = 1.0 - r2 * (1.0 / 156.0); sn = 1.0 - r2 * (1.0 / 110.0) * sn; sn = 1.0 - r2 * (1.0 / 72.0) * sn; sn = 1.0 - r2 * (1.0 / 42.0) * sn; sn = 1.0 - r2 * (1.0 / 20.0) * sn; sn = 1.0 - r2 * (1.0 / 6.0) * sn; sn *= r;
    double cs = 1.0 - r2 * (1.0 / 182.0); cs = 1.0 - r2 * (1.0 / 132.0) * cs; cs = 1.0 - r2 * (1.0 / 90.0) * cs; cs = 1.0 - r2 * (1.0 / 56.0) * cs; cs = 1.0 - r2 * (1.0 / 30.0) * cs; cs = 1.0 - r2 * (1.0 / 12.0) * cs; cs = 1.0 - r2 * 0.5 * cs;
    const int q = ((int)n) & 3;
    const double cq = (q == 0) ? cs : (q == 1) ? -sn : (q == 2) ? -cs : sn;
    const double sq = (q == 0) ? sn : (q == 1) ? cs : (q == 2) ? -sn : -cs;
    c = (float)cq; s = (float)sq;
}
__device__ const float INV_Q[16] = {1.000000000e+00f, 4.403665960e-01f, 1.939227432e-01f, 8.539710194e-02f, 3.760603070e-02f, 1.656043902e-02f, 7.292664610e-03f, 3.211445874e-03f,
                                    1.414213562e-03f, 6.227723788e-04f, 2.742481884e-04f, 1.207697351e-04f, 5.318296098e-05f, 2.341999971e-05f, 1.031338616e-05f, 4.541670478e-06f};
__device__ const float INV_I[8] = {1.000000000e+00f, 1.939227432e-01f, 3.760603070e-02f, 7.292664610e-03f, 1.414213562e-03f, 2.742481884e-04f, 5.318296098e-05f, 1.031338616e-05f};

#define XB_TMO      128
#define XB_XCNT(j)  (256  + 64 * (j))
#define XB_XSUB(j)  (1280 + 64 * (j))
#define XB_XGEN(j)  (2304 + 64 * (j))
#define XB_TOP      3328
#define XB_TOPGEN   3392
#define XCD_BAR_WORDS 3456
#define XB_SPIN_CAP (1u << 18)

__device__ __forceinline__ unsigned xb_ld(unsigned* p)              { return __hip_atomic_load(p, __ATOMIC_RELAXED, __HIP_MEMORY_SCOPE_AGENT); }
__device__ __forceinline__ unsigned xb_add(unsigned* p, unsigned v) { return __hip_atomic_fetch_add(p, v, __ATOMIC_RELAXED, __HIP_MEMORY_SCOPE_AGENT); }
__device__ __forceinline__ unsigned xb_xcc_id() { return (unsigned)__builtin_amdgcn_s_getreg((3 << 11) | 20) & 0xFu; }
#define XB_SPIN(cond, bar) do { unsigned _sp = 0; while (cond) { __builtin_amdgcn_s_sleep(1); \
    if ((++_sp & 255u) == 0u) { if (xb_ld(&(bar)[XB_TMO])) break; if (_sp > XB_SPIN_CAP) { atomicAdd(&(bar)[XB_TMO], 1u); break; } } } } while (0)

struct XcdBarrier {
    unsigned* bar; unsigned x;
    volatile LAS unsigned* st;
};

__device__ __forceinline__ XcdBarrier xcd_barrier_post(unsigned* bar, volatile LAS unsigned* st) {
    XcdBarrier b; b.bar = bar; b.x = xb_xcc_id(); b.st = st;
    if (threadIdx.x == 0) (void)xb_add(&bar[XB_XCNT(b.x)], 1u);
    return b;
}
__device__ __forceinline__ void xcd_barrier_complete(unsigned* bar, unsigned x, unsigned& nloc, unsigned& nx) {
    const unsigned G = gridDim.x * gridDim.y * gridDim.z;
    unsigned sum, cnt, mine, sp = 0u;
    for (;;) {
        sum = 0u; cnt = 0u; mine = 0u;
#pragma unroll
        for (unsigned j = 0; j < 16; ++j) { const unsigned c = xb_ld(&bar[XB_XCNT(j)]); sum += c; cnt += (c > 0u) ? 1u : 0u; mine = (j == x) ? c : mine; }
        if (sum == G) break;
        __builtin_amdgcn_s_sleep(1);
        if ((++sp & 255u) == 0u) { if (xb_ld(&bar[XB_TMO])) break; if (sp > XB_SPIN_CAP) { atomicAdd(&bar[XB_TMO], 1u); break; } }
    }
    nloc = mine > 0u ? mine : 1u; nx = cnt > 0u ? cnt : 1u;
}

__device__ __forceinline__ void xcd_barrier(const XcdBarrier& b) {
    asm volatile("s_waitcnt vmcnt(0)" ::: "memory");
    __syncthreads();
    if (threadIdx.x == 0) {
        unsigned* bar = b.bar;
        __builtin_amdgcn_s_waitcnt(0);
        unsigned nloc = b.st[0], nx = b.st[1];
        if (nloc == 0u) { xcd_barrier_complete(bar, b.x, nloc, nx); b.st[0] = nloc; b.st[1] = nx; }
        const unsigned old = xb_add(&bar[XB_XSUB(b.x)], 1u);
        const unsigned gen = old / nloc;
        if (old + 1u == (gen + 1u) * nloc) {
            __builtin_amdgcn_fence(__ATOMIC_RELEASE, "agent");
            asm volatile("s_waitcnt vmcnt(0)" ::: "memory");
            const unsigned og = xb_add(&bar[XB_TOP], 1u);
            const unsigned tg = og / nx;
            if (og + 1u == (tg + 1u) * nx) xb_add(&bar[XB_TOPGEN], 1u);
            else XB_SPIN(xb_ld(&bar[XB_TOPGEN]) == tg, bar);
            __builtin_amdgcn_fence(__ATOMIC_ACQUIRE, "agent");
            xb_add(&bar[XB_XGEN(b.x)], 1u);
            asm volatile("s_waitcnt vmcnt(0)" ::: "memory");
        } else {
            XB_SPIN(xb_ld(&bar[XB_XGEN(b.x)]) == gen, bar);
            __builtin_amdgcn_fence(__ATOMIC_ACQUIRE, "agent");
            asm volatile("s_waitcnt vmcnt(0)" ::: "memory");
        }
    }
    __syncthreads();
}

struct Frame {
    LAS unsigned char* lds;
    volatile LAS unsigned* MISC;
    gu32* ctl;
    int tid, lane, wave, G, bid;
    const float* in[17];
    float* out; unsigned char* ws;
};
enum { IN_X = 0, IN_ANORM, IN_AWIN, IN_AQN, IN_AKN, IN_AWOUT, IN_KVNORM, IN_KVW, IN_BNORM, IN_BWQ, IN_BWOUT, IN_FFNNORM, IN_DGU, IN_DDN, IN_ROUTER, IN_MGU, IN_MDN };

struct TrItem { const float* W; size_t ldw; int K, k0, csrc0, cend; bf16* WT; int drow0; const float* gain; float scale; int f8; };
__device__ __forceinline__ int gu_row(int c0) { return (c0 < FF) ? ((c0 >> 7) * 256 + (c0 & 127)) : (((c0 - FF) >> 7) * 256 + 128 + ((c0 - FF) & 127)); }
constexpr int I_WIN = 16 * 32, I_TAIL = 16 * 2, I_SQ = 16 * 16, I_GU = 16 * 88, I_DN = 44 * 16, I_KV = 16 * 32;
constexpr int TR_NITEMS = I_WIN + I_TAIL + I_SQ + I_GU + I_DN + I_KV + I_SQ + I_SQ + NE * I_GU + NE * I_DN;
__device__ __forceinline__ TrItem tr_decode(const Frame& F, int it) {
    unsigned char* ws = F.ws; int r = it; TrItem t;
    if (r < I_WIN) { const int kb = r / 32, nb = r % 32; t = TrItem{F.in[IN_AWIN], (size_t)A_IN, D, 64 * kb, 64 * nb, A_IN, (bf16*)(ws + WS_WIN), 64 * nb, F.in[IN_ANORM], 1.f}; return t; } r -= I_WIN;
    if (r < I_TAIL) { const int kb = r / 2, nb = r % 2; t = TrItem{F.in[IN_AWIN], (size_t)A_IN, D, 64 * kb, 2048 + 64 * nb, A_IN, (bf16*)(ws + WS_WTAIL), 64 * nb, F.in[IN_ANORM], 1.f}; return t; } r -= I_TAIL;
    if (r < I_SQ) { const int kb = r / 16, nb = r % 16; t = TrItem{F.in[IN_AWOUT], (size_t)D, D, 64 * kb, 64 * nb, D, (bf16*)(ws + WS_WOA), 64 * nb, nullptr, 1.f}; return t; } r -= I_SQ;
    if (r < I_GU) { const int kb = r / 88, nb = r % 88; t = TrItem{F.in[IN_DGU], (size_t)(2 * FF), D, 64 * kb, 64 * nb, 2 * FF, (bf16*)(ws + WS_WGU), gu_row(64 * nb), F.in[IN_FFNNORM], 1.f}; return t; } r -= I_GU;
    if (r < I_DN) { const int kb = r / 16, nb = r % 16; t = TrItem{F.in[IN_DDN], (size_t)D, FF, 64 * kb, 64 * nb, D, (bf16*)(ws + WS_WD), 64 * nb, nullptr, 1.f}; return t; } r -= I_DN;
    if (r < I_KV) { const int kb = r / 32, nb = r % 32; t = TrItem{F.in[IN_KVW], (size_t)(2 * D), D, 64 * kb, 64 * nb, 2 * D, (bf16*)(ws + WS_WKVQ), (nb < 16) ? 64 * nb : 1024 + 64 * nb, F.in[IN_KVNORM], 1.f}; return t; } r -= I_KV;
    if (r < I_SQ) { const int kb = r / 16, nb = r % 16; t = TrItem{F.in[IN_BWQ], (size_t)D, D, 64 * kb, 64 * nb, D, (bf16*)(ws + WS_WKVQ), 1024 + 64 * nb, F.in[IN_BNORM], SBSCALE}; return t; } r -= I_SQ;
    if (r < I_SQ) { const int kb = r / 16, nb = r % 16; t = TrItem{F.in[IN_BWOUT], (size_t)D, D, 64 * kb, 64 * nb, D, (bf16*)(ws + WS_WOB), 64 * nb, nullptr, 1.f}; return t; } r -= I_SQ;
    if (r < NE * I_GU) { const int e = r / I_GU, rr = r % I_GU, kb = rr / 88, nb = rr % 88;
        t = TrItem{F.in[IN_MGU] + (size_t)e * D * 2 * FF, (size_t)(2 * FF), D, 64 * kb, 64 * nb, 2 * FF, (bf16*)(ws + WS_WGUM), e * 2 * FF + gu_row(64 * nb), F.in[IN_FFNNORM] + D, pg8::F8_SWGU, 1}; return t; } r -= NE * I_GU;
    { const int e = r / I_DN, rr = r % I_DN, kb = rr / 16, nb = rr % 16;
      t = TrItem{F.in[IN_MDN] + (size_t)e * FF * D, (size_t)D, FF, 64 * kb, 64 * nb, D, (bf16*)(ws + WS_WDM), e * D + 64 * nb, nullptr, pg8::F8_SWD, 1}; return t; }
}
__device__ __forceinline__ void tr_load(const TrItem& t, f32x4 (&v)[16], int lane) {
    const int r = lane >> 4, c = t.csrc0 + 4 * (lane & 15); const bool ok = c < t.cend; const float* src = t.W + (size_t)(t.k0 + r) * t.ldw + (ok ? c : 0);
#pragma unroll
    for (int i = 0; i < 16; ++i) { const f32x4 x = __builtin_nontemporal_load((const f32x4*)(src + (size_t)(4 * i) * t.ldw)); v[i] = ok ? x : (f32x4){0.f, 0.f, 0.f, 0.f}; }
}
__device__ __forceinline__ void tr_store(const TrItem& t, const f32x4 (&v)[16], LAS float* scr, int lane) {
    const int r = lane >> 4, c4 = lane & 15;
#pragma unroll
    for (int i = 0; i < 16; ++i) { const int k = 4 * i + r; const float g = t.gain ? t.gain[t.k0 + k] * t.scale : t.scale;
        *(LAS f32x4*)(scr + k * 64 + 4 * (c4 ^ ((k >> 3) & 7))) = v[i] * g; }
    LDS_WAIT(); asm volatile("" ::: "memory");
    if (t.f8) {
        const int c4b = lane & 3;
#pragma unroll
        for (int j = 0; j < 4; ++j) { const int n = (lane >> 2) + 16 * j;
            const LAS float* s0 = scr + (16 * c4b) * 64 + (n ^ ((2 * c4b) << 2)); const LAS float* s1 = scr + (16 * c4b + 8) * 64 + (n ^ ((2 * c4b + 1) << 2));
            v4u o; o.x = pg8::pk4_fp8(s0[0 * 64], s0[1 * 64], s0[2 * 64], s0[3 * 64]); o.y = pg8::pk4_fp8(s0[4 * 64], s0[5 * 64], s0[6 * 64], s0[7 * 64]);
            o.z = pg8::pk4_fp8(s1[0 * 64], s1[1 * 64], s1[2 * 64], s1[3 * 64]); o.w = pg8::pk4_fp8(s1[4 * 64], s1[5 * 64], s1[6 * 64], s1[7 * 64]);
            *(GAS v4u*)((unsigned char*)t.WT + (size_t)(t.drow0 + n) * t.K + t.k0 + 16 * c4b) = o; }
    } else {
    const int c8 = lane & 7;
#pragma unroll
    for (int j = 0; j < 8; ++j) { const int n = (lane >> 3) + 8 * j; const LAS float* s = scr + (8 * c8) * 64 + (n ^ (c8 << 2));
        v4u o; o.x = pk2(s[0 * 64], s[1 * 64]); o.y = pk2(s[2 * 64], s[3 * 64]); o.z = pk2(s[4 * 64], s[5 * 64]); o.w = pk2(s[6 * 64], s[7 * 64]);
        *(GAS v4u*)(t.WT + (size_t)(t.drow0 + n) * t.K + t.k0 + 8 * c8) = o; }
    }
    LDS_WAIT(); asm volatile("" ::: "memory");
}
__device__ __forceinline__ void p0_prologue(Frame& F) {
    LAS float* scr = (LAS float*)(F.lds + F.wave * 16384);
    const int gw = F.wave * F.G + F.bid, NGW = F.G * NWAVES;
    unsigned char* ws = F.ws;
    {
        f32x4 va[16], vb[16];
        int it = gw;
        if (it < TR_NITEMS) { TrItem cur = tr_decode(F, it); tr_load(cur, va, F.lane);
            for (;;) {
                const int nx = it + NGW; const bool has = nx < TR_NITEMS; TrItem nxt = cur;
                if (has) { nxt = tr_decode(F, nx); tr_load(nxt, vb, F.lane); }
                tr_store(cur, va, scr, F.lane);
                if (!has) break;
                it = nx + NGW; const bool has2 = it < TR_NITEMS; TrItem nn = nxt;
                if (has2) { nn = tr_decode(F, it); tr_load(nn, va, F.lane); }
                tr_store(nxt, vb, scr, F.lane);
                if (!has2) break;
                cur = nn;
            }
        }
    }
    const float* x = F.in[IN_X]; bf16* XB = (bf16*)(ws + WS_XB);
    for (int m = gw; m < M; m += NGW) {
        const GAS f32x4* xr = (const GAS f32x4*)(x + (size_t)m * D) + F.lane; f32x4 v[4]; float s = 0.f;
#pragma unroll
        for (int j = 0; j < 4; ++j) { v[j] = xr[64 * j]; s += (v[j].x * v[j].x + v[j].y * v[j].y) + (v[j].z * v[j].z + v[j].w * v[j].w); }
        s = wave_sum(s); const float rs = 1.0f / sqrtf(s * (1.0f / 1024.0f) + 1e-6f);
        GAS unsigned long long* o8 = (GAS unsigned long long*)(XB + (size_t)m * D) + F.lane;
#pragma unroll
        for (int j = 0; j < 4; ++j) o8[64 * j] = (unsigned long long)pk2(v[j].x * rs, v[j].y * rs) | ((unsigned long long)pk2(v[j].z * rs, v[j].w * rs) << 32);
    }
}

#define WAVE_SYNC() asm volatile("s_waitcnt lgkmcnt(0)" ::: "memory")
__device__ __forceinline__ void rope8(float (&y)[8], bool isx1, bool isx2, int i0, int pshift, LAS const float* tab) {
#pragma unroll
    for (int e = 0; e < 8; ++e) {
        const float other = __shfl_xor(y[e], pshift); const float c = tab[2 * (i0 + e)], s = tab[2 * (i0 + e) + 1];
        y[e] = isx1 ? (y[e] * c - other * s) : (isx2 ? (y[e] * c + other * s) : y[e]);
    }
}
__device__ __forceinline__ size_t kif_off(int grow, int d) { return ((((size_t)(grow >> 5) * 4 + ((d >> 3) & 3)) * 2 + (d >> 5)) * 32 + (grow & 31)) * 8 + (d & 7); }
__device__ __forceinline__ void unpack8(const v4u w, float (&y)[8]) { y[0] = bflo(w.x); y[1] = bfhi(w.x); y[2] = bflo(w.y); y[3] = bfhi(w.y); y[4] = bflo(w.z); y[5] = bfhi(w.z); y[6] = bflo(w.w); y[7] = bfhi(w.w); }
__device__ __forceinline__ v4u pack8(const float (&y)[8]) { v4u o; o.x = pk2(y[0], y[1]); o.y = pk2(y[2], y[3]); o.z = pk2(y[4], y[5]); o.w = pk2(y[6], y[7]); return o; }
__device__ __forceinline__ void p2_post(Frame& F) {
    unsigned char* ws = F.ws; const int lane = F.lane;
    const bf16* PROJ = (const bf16*)(ws + WS_PROJ); const bf16* XB = (const bf16*)(ws + WS_XB); const bf16* WT = (const bf16*)(ws + WS_WTAIL);
    bf16* QF = (bf16*)(ws + WS_QF); bf16* KVF = (bf16*)(ws + WS_KVF); bf16* QIF = (bf16*)(ws + WS_QIF); bf16* KIF = (bf16*)(ws + WS_KIF); float* WIF = (float*)(ws + WS_WIF);
    const float* qnw = F.in[IN_AQN]; const float* knw = F.in[IN_AKN];
    LAS float* tab = (LAS float*)(F.lds + F.wave * 256);
    const int gw = F.wave * F.G + F.bid, NGW = F.G * NWAVES;
    for (int task = gw; task < M / 8; task += NGW) {
        const int row0 = task * 8;
        f32x4 acc[5];
#pragma unroll
        for (int c = 0; c < 5; ++c) acc[c] = (f32x4){0.f, 0.f, 0.f, 0.f};
        const bf16* ap = XB + (size_t)(row0 + (lane & 7)) * D + 8 * (lane >> 4);
        const bf16* bp = WT + (size_t)(lane & 15) * D + 8 * (lane >> 4);
#pragma unroll 4
        for (int j = 0; j < 32; ++j) {
            const bf16x8 a = *(const bf16x8*)(ap + 32 * j);
#pragma unroll
            for (int c = 0; c < 5; ++c) { const bf16x8 b = *(const bf16x8*)(bp + (size_t)(16 * c) * D + 32 * j); acc[c] = __builtin_amdgcn_mfma_f32_16x16x32_bf16(a, b, acc[c], 0, 0, 0); }
        }
        if (lane < 32) {
#pragma unroll
            for (int reg = 0; reg < 4; ++reg) {
                const int row = row0 + 4 * (lane >> 4) + reg; const float rs = 1.0f; const float pos = (float)(row & (SEQ - 1));
                const int d = lane & 15;
                float v0 = acc[0][reg] * rs; const float other = __shfl_xor(v0, 8);
                { float c, s; sincos_acc(pos * INV_I[d & 7], c, s); v0 = (d < 8) ? (v0 * c - other * s) : (v0 * c + other * s); }
                KIF[kif_off(row, d)] = (bf16)f2bf(v0);
#pragma unroll
                for (int c = 1; c < 4; ++c) KIF[kif_off(row, 16 * c + d)] = (bf16)f2bf(acc[c][reg] * rs);
                if (d < 8) WIF[(size_t)row * 8 + d] = acc[4][reg] * rs * WISCALE;
            }
        }
        for (int r = 0; r < 8; ++r) {
            const int row = row0 + r, b = row >> 13, t = row & (SEQ - 1); const float pos = (float)t;
            const bf16* pr = PROJ + (size_t)row * 2048 + 8 * lane;
            v4u w[4];
#pragma unroll
            for (int j = 0; j < 4; ++j) w[j] = __builtin_nontemporal_load((const v4u*)(pr + 512 * j));
            if (lane < 24) { float c, s; sincos_acc(pos * ((lane < 16) ? INV_Q[lane & 15] : INV_I[lane & 7]), c, s); tab[2 * lane] = c; tab[2 * lane + 1] = s; }
            WAVE_SYNC();
#pragma unroll
            for (int j = 0; j < 2; ++j) {
                float y[8]; unpack8(w[j], y); float ss = 0.f;
#pragma unroll
                for (int e = 0; e < 8; ++e) ss += y[e] * y[e];
                ss += __shfl_xor(ss, 1); ss += __shfl_xor(ss, 2); ss += __shfl_xor(ss, 4); ss += __shfl_xor(ss, 8);
                const float rs = 1.0f / sqrtf(ss * (1.0f / 128.0f) + 1e-6f); const int c8 = (lane & 15) * 8;
#pragma unroll
                for (int e = 0; e < 8; ++e) y[e] = y[e] * rs * qnw[c8 + e];
                rope8(y, c8 < 16, c8 >= 16 && c8 < 32, c8 & 15, 2, tab);
#pragma unroll
                for (int e = 0; e < 8; ++e) y[e] *= QSCALE;
                *(v4u*)(QF + (size_t)row * D + 512 * j + 8 * lane) = pack8(y);
            }
            {
                float y[8]; unpack8(w[2], y); float ss = 0.f;
#pragma unroll
                for (int e = 0; e < 8; ++e) ss += y[e] * y[e];
                ss += __shfl_xor(ss, 1); ss += __shfl_xor(ss, 2); ss += __shfl_xor(ss, 4); ss += __shfl_xor(ss, 8);
                const bool isk = lane < 32; const float rs = 1.0f / sqrtf(ss * (1.0f / 128.0f) + 1e-6f); const int c8 = (lane & 15) * 8;
                if (isk) {
#pragma unroll
                    for (int e = 0; e < 8; ++e) y[e] = y[e] * rs * knw[c8 + e];
                }
                rope8(y, isk && c8 < 16, isk && c8 >= 16 && c8 < 32, c8 & 15, 2, tab);
                const int kvh = (lane >> 4) & 1;
                int w0 = __builtin_amdgcn_cvt_pk_fp8_f32(y[0], y[1], 0, false); w0 = __builtin_amdgcn_cvt_pk_fp8_f32(y[2], y[3], w0, true);
                int w1 = __builtin_amdgcn_cvt_pk_fp8_f32(y[4], y[5], 0, false); w1 = __builtin_amdgcn_cvt_pk_fp8_f32(y[6], y[7], w1, true);
                *(v2u*)((unsigned char*)KVF + ((size_t)(b * NKV + kvh) * SEQ + t) * 256 + (isk ? 0 : 128) + c8) = (v2u){(unsigned)w0, (unsigned)w1};
            }
            {
                float y[8]; unpack8(w[3], y); const int c8 = (lane & 7) * 8;
                rope8(y, c8 == 0, c8 == 8, 16, 1, tab);
                *(v4u*)(QIF + (size_t)row * 512 + 8 * lane) = pack8(y);
            }
            WAVE_SYNC();
        }
    }
}

__device__ __forceinline__ unsigned f2key(float f) { const unsigned u = __float_as_uint(f); return (u & 0x80000000u) ? ~u : (u | 0x80000000u); }
__device__ __forceinline__ void p3_query_naive(unsigned char* ws, LAS unsigned char* lds, int row, int* SEL) {
    const int tid = threadIdx.x, lane = tid & 63, wave = tid >> 6;
    const bf16* QIF = (const bf16*)(ws + WS_QIF); const bf16* KIF = (const bf16*)(ws + WS_KIF); const float* WIF = (const float*)(ws + WS_WIF);
    LAS unsigned* keys = (LAS unsigned*)lds;
    LAS float* qis = (LAS float*)(lds + 32768);
    LAS float* wl = (LAS float*)(lds + 32768 + 2048);
    LAS unsigned* hist = (LAS unsigned*)(lds + 36864);
    LAS unsigned* ctl = (LAS unsigned*)(lds + 36864 + 1024);
    LAS unsigned* wcnt = (LAS unsigned*)(lds + 36864 + 1024 + 64);
    {
        const int b = row >> 13, t = row & (SEQ - 1), n = t + 1;
        int* sel = SEL + (size_t)row * TOPK;
        if (n <= TOPK) { if (tid < TOPK) sel[tid] = tid < n ? tid : 0; return; }
        __syncthreads();
        qis[tid] = __uint_as_float((unsigned)QIF[(size_t)row * 512 + tid] << 16);
        if (tid < 8) wl[tid] = WIF[(size_t)row * 8 + tid];
        __syncthreads();
        for (int s = tid; s < n; s += 512) {
            const int grow = (b << 13) + s;
            float kf[64];
#pragma unroll
            for (int j = 0; j < 8; ++j) { const v4u w = *(const v4u*)(KIF + kif_off(grow, 8 * j)); kf[8 * j] = bflo(w.x); kf[8 * j + 1] = bfhi(w.x); kf[8 * j + 2] = bflo(w.y); kf[8 * j + 3] = bfhi(w.y); kf[8 * j + 4] = bflo(w.z); kf[8 * j + 5] = bfhi(w.z); kf[8 * j + 6] = bflo(w.w); kf[8 * j + 7] = bfhi(w.w); }
            float sc = 0.f;
#pragma unroll
            for (int h = 0; h < 8; ++h) { float d = 0.f; asm volatile("" ::: "memory");
#pragma unroll
                for (int dd = 0; dd < 64; ++dd) d += qis[h * 64 + dd] * kf[dd];
                sc += wl[h] * fmaxf(d, 0.f); }
            keys[s] = f2key(sc + 0.0f);
        }
        __syncthreads();
        unsigned prefix = 0u, mask = 0u, need = TOPK;
        for (int pass = 0; pass < 4; ++pass) {
            const int shift = 24 - 8 * pass;
            if (tid < 256) hist[tid] = 0u;
            __syncthreads();
            for (int s = tid; s < n; s += 512) { const unsigned k = keys[s]; if ((k & mask) == prefix) __hip_atomic_fetch_add(&hist[(k >> shift) & 255u], 1u, __ATOMIC_RELAXED, __HIP_MEMORY_SCOPE_WORKGROUP); }
            __syncthreads();
            if (tid < 64) {
                const unsigned h0 = hist[4 * lane], h1 = hist[4 * lane + 1], h2 = hist[4 * lane + 2], h3 = hist[4 * lane + 3]; const unsigned tot = h0 + h1 + h2 + h3;
                unsigned incl = tot;
#pragma unroll
                for (int o = 1; o < 64; o <<= 1) { const unsigned v = __shfl_down(incl, o); if (lane + o < 64) incl += v; }
                const unsigned above = incl - tot;
                if (above < need && need <= above + tot) {
                    unsigned a = above; unsigned bin;
                    if (a + h3 >= need) bin = 3; else { a += h3; if (a + h2 >= need) bin = 2; else { a += h2; if (a + h1 >= need) bin = 1; else { a += h1; bin = 0; } } }
                    ctl[0] = 4 * lane + bin; ctl[1] = need - a;
                }
            }
            __syncthreads();
            prefix |= ctl[0] << shift; mask |= 255u << shift; need = ctl[1];
            __syncthreads();
        }
        const unsigned thr = prefix, n_gt = TOPK - need;
        unsigned base_gt = 0u, base_eq = 0u;
        for (int s0 = 0; s0 < n; s0 += 512) {
            const int s = s0 + tid; const unsigned k = s < n ? keys[s] : 0u; const bool gt = (s < n) && (k > thr); const bool eq = (s < n) && (k == thr);
            const unsigned long long bg = __ballot(gt), be = __ballot(eq); const unsigned long long lt = (1ull << lane) - 1ull;
            const unsigned rg = __popcll(bg & lt), re = __popcll(be & lt);
            if (lane == 0) { wcnt[wave] = __popcll(bg); wcnt[8 + wave] = __popcll(be); }
            __syncthreads();
            unsigned og = base_gt, oe = base_eq, tg = 0u, te = 0u;
#pragma unroll
            for (int w = 0; w < 8; ++w) { const unsigned cg = wcnt[w], ce = wcnt[8 + w]; if (w < wave) { og += cg; oe += ce; } tg += cg; te += ce; }
            if (gt) sel[og + rg] = s;
            if (eq && oe + re < need) sel[n_gt + oe + re] = s;
            base_gt += tg; base_eq += te;
            __syncthreads();
        }
    }
}

constexpr int P3_HIST = 0, P3_H2 = 65536, P3_BM = 98304, P3_QS = 114688, P3_FLAG = P3_QS + 512, P3_CAP = 512;
__device__ __forceinline__ void find_bin_2048(LAS const unsigned* hist, unsigned need, int lane, unsigned& bin_out, unsigned& need_out, unsigned& cnt_out, bool& ok) {
    unsigned w[16]; unsigned tot = 0u;
#pragma unroll
    for (int i = 0; i < 16; ++i) { w[i] = hist[16 * lane + i]; tot += (w[i] & 0xffffu) + (w[i] >> 16); }
    unsigned incl = tot;
#pragma unroll
    for (int o = 1; o < 64; o <<= 1) { const unsigned v = __shfl_down(incl, o); if (lane + o < 64) incl += v; }
    const unsigned above = incl - tot;
    const bool mine = (above < need) && (need <= above + tot);
    unsigned a = above, fb = 0u, fn = 0u, fc = 0u; bool found = false;
#pragma unroll
    for (int i = 15; i >= 0; --i) {
        const unsigned h1 = w[i] >> 16, h0 = w[i] & 0xffffu;
        if (!found) { if (a + h1 >= need) { found = true; fb = 32u * lane + 2u * i + 1u; fn = need - a; fc = h1; } else a += h1; }
        if (!found) { if (a + h0 >= need) { found = true; fb = 32u * lane + 2u * i; fn = need - a; fc = h0; } else a += h0; }
    }
    const unsigned long long bm = __ballot(mine);
    ok = (bm != 0ull);
    const int src = ok ? (__ffsll((long long)bm) - 1) : 0;
    bin_out = (unsigned)__builtin_amdgcn_readlane((int)fb, src); need_out = (unsigned)__builtin_amdgcn_readlane((int)fn, src); cnt_out = (unsigned)__builtin_amdgcn_readlane((int)fc, src);
}
__device__ __forceinline__ unsigned bin11(float sc) { const unsigned u = __float_as_uint(sc); const int m = (int)((u & 0x7fffffffu) >> 17) - 7360; const unsigned mc = (unsigned)(m < 0 ? 0 : (m > 1023 ? 1023 : m)); return (u >> 31) ? (1023u - mc) : (1024u + mc); }
__device__ __forceinline__ float relu_i(float x) { const int xi = __builtin_bit_cast(int, x); const int ri = (xi < 0) ? 0 : xi; return __builtin_bit_cast(float, ri); }
#define RELU(x) relu_i(x)
typedef _Float16 f16x8 __attribute__((ext_vector_type(8)));
typedef short s16x2 __attribute__((ext_vector_type(2)));
__device__ __forceinline__ unsigned pk_relu_f16(float a, float b) { const s16x2 h = __builtin_bit_cast(s16x2, __builtin_amdgcn_cvt_pkrtz(a, b)); return __builtin_bit_cast(unsigned, __builtin_elementwise_max(h, (s16x2){0, 0})); }
template <int PASS> __device__ __forceinline__ void p3_score_pass(const bf16x8 (&af)[2][4], const f16x8 (&wa)[2][2], const bf16* kib, int t0, int nt, int wave, int n, int hi,
                                                                  LAS unsigned char* lds, const unsigned (&thr)[2][2], int rot) {
    LAS unsigned* HIST = (LAS unsigned*)(lds + P3_HIST); LAS unsigned* BM = (LAS unsigned*)(lds + P3_BM); LAS unsigned* QS = (LAS unsigned*)(lds + P3_QS);
    const int kmax = t0 + 15;
    bf16x8 bc[4], bn[4];
    const int qh = 8 * (wave >> 2), w4 = wave & 3;
    const int cnt4 = (nt - w4 + 3) >> 2; const int r0 = rot % cnt4;
    bf16x8 bq[4][4];
#define P3_LOADB(u, j) do { int jj_ = r0 + (j); jj_ = (jj_ >= cnt4) ? jj_ - cnt4 : jj_; const int t_ = w4 + 4 * jj_; \
        const bf16* kp_ = kib + ((size_t)t_ * 8 + hi) * 256 + n * 8; _Pragma("unroll") for (int s = 0; s < 4; ++s) bq[u][s] = *(const bf16x8*)(kp_ + s * 512); } while (0)
#pragma unroll
    for (int u = 0; u < 4; ++u) P3_LOADB(u, (u < cnt4) ? u : 0);
    for (int i0 = 0; i0 < cnt4; i0 += 4) {
#pragma unroll
        for (int u = 0; u < 4; ++u) {
            if (i0 + u < cnt4) {
                int jj = r0 + i0 + u; jj = (jj >= cnt4) ? jj - cnt4 : jj; const int tile = w4 + 4 * jj;
                const int key = 32 * tile + n; const bool full = (32 * tile + 31 <= t0);
                f32x16 acc0, acc1;
#pragma unroll
                for (int r = 0; r < 16; ++r) { acc0[r] = 0.f; acc1[r] = 0.f; }
#pragma unroll
                for (int s = 0; s < 4; ++s) acc0 = __builtin_amdgcn_mfma_f32_32x32x16_bf16(af[0][s], bq[u][s], acc0, 0, 0, 0);
#pragma unroll
                for (int s = 0; s < 4; ++s) acc1 = __builtin_amdgcn_mfma_f32_32x32x16_bf16(af[1][s], bq[u][s], acc1, 0, 0, 0);
                float sc4[4];
                {
                    f32x16 y0, y1;
#pragma unroll
                    for (int r = 0; r < 16; ++r) { y0[r] = 0.f; y1[r] = 0.f; }
                    const f16x8 x00 = __builtin_bit_cast(f16x8, (v4u){pk_relu_f16(acc0[0], acc0[1]), pk_relu_f16(acc0[2], acc0[3]), pk_relu_f16(acc0[4], acc0[5]), pk_relu_f16(acc0[6], acc0[7])});
                    const f16x8 x01 = __builtin_bit_cast(f16x8, (v4u){pk_relu_f16(acc0[8], acc0[9]), pk_relu_f16(acc0[10], acc0[11]), pk_relu_f16(acc0[12], acc0[13]), pk_relu_f16(acc0[14], acc0[15])});
                    const f16x8 x10 = __builtin_bit_cast(f16x8, (v4u){pk_relu_f16(acc1[0], acc1[1]), pk_relu_f16(acc1[2], acc1[3]), pk_relu_f16(acc1[4], acc1[5]), pk_relu_f16(acc1[6], acc1[7])});
                    const f16x8 x11 = __builtin_bit_cast(f16x8, (v4u){pk_relu_f16(acc1[8], acc1[9]), pk_relu_f16(acc1[10], acc1[11]), pk_relu_f16(acc1[12], acc1[13]), pk_relu_f16(acc1[14], acc1[15])});
                    y0 = __builtin_amdgcn_mfma_f32_32x32x16_f16(wa[0][0], x00, y0, 0, 0, 0); y1 = __builtin_amdgcn_mfma_f32_32x32x16_f16(wa[1][0], x10, y1, 0, 0, 0);
                    y0 = __builtin_amdgcn_mfma_f32_32x32x16_f16(wa[0][1], x01, y0, 0, 0, 0); y1 = __builtin_amdgcn_mfma_f32_32x32x16_f16(wa[1][1], x11, y1, 0, 0, 0);
                    sc4[0] = y0[0]; sc4[1] = y0[1]; sc4[2] = y1[0]; sc4[3] = y1[1];
                }
                unsigned bin4[4]; float scz4[4]; bool val4[4];
#pragma unroll
                for (int e = 0; e < 4; ++e) { scz4[e] = sc4[e] + 0.0f; bin4[e] = bin11(scz4[e]); val4[e] = full || (key <= t0 + qh + 4 * (e >> 1) + hi + 2 * (e & 1)); }
                if (PASS == 1) {
                    if (full) {
#pragma unroll
                        for (int e = 0; e < 4; ++e) { const int q = qh + 4 * (e >> 1) + hi + 2 * (e & 1); __hip_atomic_fetch_add(&HIST[q * 1024 + (bin4[e] >> 1)], 1u << (16 * (bin4[e] & 1u)), __ATOMIC_RELAXED, __HIP_MEMORY_SCOPE_WORKGROUP); }
                    } else {
#pragma unroll
                        for (int e = 0; e < 4; ++e) { const int q = qh + 4 * (e >> 1) + hi + 2 * (e & 1); if (val4[e]) __hip_atomic_fetch_add(&HIST[q * 1024 + (bin4[e] >> 1)], 1u << (16 * (bin4[e] & 1u)), __ATOMIC_RELAXED, __HIP_MEMORY_SCOPE_WORKGROUP); }
                    }
                } else if (PASS == 2) {
                    unsigned long long ab4[4]; bool cand4[4]; bool anyc = false;
#pragma unroll
                    for (int e = 0; e < 4; ++e) { ab4[e] = __ballot(val4[e] && bin4[e] > thr[e >> 1][e & 1]); cand4[e] = val4[e] && bin4[e] == thr[e >> 1][e & 1]; anyc = anyc || cand4[e]; }
                    if (n == 0) {
#pragma unroll
                        for (int e = 0; e < 4; ++e) { const int q = qh + 4 * (e >> 1) + hi + 2 * (e & 1); BM[q * 256 + tile] = hi ? (unsigned)(ab4[e] >> 32) : (unsigned)ab4[e]; }
                    }
                    if (__ballot(anyc) != 0ull) {
#pragma unroll
                        for (int e = 0; e < 4; ++e) if (cand4[e]) { const int q = qh + 4 * (e >> 1) + hi + 2 * (e & 1); const unsigned pos = __hip_atomic_fetch_add(&QS[q * 8 + 3], 1u, __ATOMIC_RELAXED, __HIP_MEMORY_SCOPE_WORKGROUP);
                            if (pos < (unsigned)P3_CAP) { HIST[q * 1024 + 2 * pos] = f2key(scz4[e]); HIST[q * 1024 + 2 * pos + 1] = (unsigned)key; } }
                    }
                }
            }
            { const int jn = (i0 + u + 4 < cnt4) ? (i0 + u + 4) : (cnt4 - 1); P3_LOADB(u, jn); }
        }
    }
#undef P3_LOADB
}
__device__ __forceinline__ void p3_index(Frame& F) {
    unsigned char* ws = F.ws; const int tid = F.tid, lane = F.lane, wave = F.wave, n = lane & 31, hi = lane >> 5;
    const bf16* QIF = (const bf16*)(ws + WS_QIF); const bf16* KIF = (const bf16*)(ws + WS_KIF); const float* WIF = (const float*)(ws + WS_WIF); int* SEL = (int*)(ws + WS_SEL);
    LAS unsigned char* lds = F.lds;
    LAS unsigned* HIST = (LAS unsigned*)(lds + P3_HIST); LAS unsigned* H2 = (LAS unsigned*)(lds + P3_H2 + wave * 4096); LAS unsigned* BM = (LAS unsigned*)(lds + P3_BM); LAS unsigned* QS = (LAS unsigned*)(lds + P3_QS);
    LAS unsigned* FLAG = (LAS unsigned*)(lds + P3_FLAG); LAS unsigned* FBL = (LAS unsigned*)(lds + P3_QS + 1024);
    if (tid == 0) FBL[0] = 0u;
    __syncthreads();
    for (int ps = F.bid; ps < 512; ps += F.G) {
        const int b = ps >> 8, wq = ps & 255;
#pragma unroll 1
        for (int half = 0; half < 2; ++half) {
            const int idx = half ? (511 - wq) : wq; const int t0 = 16 * idx, row0 = (b << 13) + t0;
            if (idx < 16) {
                for (int e = tid; e < 16 * TOPK; e += 512) { const int q = e >> 8, i = e & 255; SEL[(size_t)(row0 + q) * TOPK + i] = (i <= t0 + q) ? i : 0; }
                continue;
            }
            for (int e = tid; e < 16384; e += 512) HIST[e] = 0u;
            for (int e = tid; e < 4096; e += 512) BM[e] = 0u;
            if (tid < 132) QS[tid] = 0u;
            bf16x8 af[2][4]; f16x8 wa[2][2]; const int qh = 8 * (wave >> 2);
            { const int head = (n & 3) + 4 * ((n >> 3) & 1), q4 = ((n >> 2) & 1) + 2 * (n >> 4);
#pragma unroll
              for (int mt = 0; mt < 2; ++mt) { const bf16* ap = QIF + (size_t)(row0 + qh + 4 * mt + q4) * 512 + head * IDX + 32 * hi;
#pragma unroll
                  for (int s = 0; s < 4; ++s) af[mt][s] = *(const bf16x8*)(ap + 8 * s);
#pragma unroll
                  for (int sp = 0; sp < 2; ++sp) {
                      const bool on = (sp == 0) ? ((n == 0 && hi == 0) || (n == 4 && hi == 1)) : ((n == 1 && hi == 0) || (n == 5 && hi == 1));
                      const float* wp = WIF + (size_t)(row0 + qh + 4 * mt + hi + 2 * sp) * 8; const f32x4 w0 = *(const f32x4*)wp, w1 = *(const f32x4*)(wp + 4);
                      f16x8 t; t[0] = (_Float16)w0[0]; t[1] = (_Float16)w0[1]; t[2] = (_Float16)w0[2]; t[3] = (_Float16)w0[3]; t[4] = (_Float16)w1[0]; t[5] = (_Float16)w1[1]; t[6] = (_Float16)w1[2]; t[7] = (_Float16)w1[3];
                      if (!on) t = (f16x8){0, 0, 0, 0, 0, 0, 0, 0};
                      wa[mt][sp] = t; } } }
            const int nt = (t0 + 16 + 31) >> 5; const bf16* kib = KIF + (size_t)(b << 13) * IDX;
            unsigned thr[2][2] = {{0u, 0u}, {0u, 0u}};
            __syncthreads();
            p3_score_pass<1>(af, wa, kib, t0, nt, wave, n, hi, lds, thr, F.bid * 5);
            __syncthreads();
#pragma unroll 1
            for (int qq = 0; qq < 2; ++qq) { const int q = 2 * wave + qq; unsigned bin, need, cnt; bool ok;
                find_bin_2048(HIST + q * 1024, (unsigned)TOPK, lane, bin, need, cnt, ok);
                if (lane == 0) { const bool defer = !ok || cnt > (unsigned)P3_CAP; QS[q * 8 + 0] = defer ? 4096u : bin; QS[q * 8 + 1] = need; QS[q * 8 + 2] = cnt; QS[q * 8 + 4] = defer ? 1u : 0u;
                    if (defer) { const unsigned k = __hip_atomic_fetch_add(&FBL[0], 1u, __ATOMIC_RELAXED, __HIP_MEMORY_SCOPE_WORKGROUP); if (k < 63u) FBL[1 + k] = (unsigned)(row0 + q); } } }
            __syncthreads();
#pragma unroll
            for (int mt = 0; mt < 2; ++mt)
#pragma unroll
                for (int j = 0; j < 2; ++j) thr[mt][j] = QS[(qh + 4 * mt + hi + 2 * j) * 8];
            __syncthreads();
            p3_score_pass<2>(af, wa, kib, t0, nt, wave, n, hi, lds, thr, F.bid * 5 + 3);
            __syncthreads();
#pragma unroll 1
            for (int qq = 0; qq < 2; ++qq) {
                const int q = 2 * wave + qq; LAS unsigned* cand = HIST + q * 1024; LAS unsigned* bmq = BM + q * 256;
                const unsigned needA = QS[q * 8 + 1], c = QS[q * 8 + 2];
                if (QS[q * 8 + 4] != 0u) continue;
                for (unsigned i0 = 0; i0 < c; i0 += 64) { const unsigned i = i0 + lane; const bool in = i < c; const unsigned k32 = in ? cand[2 * i] : 0u, ki = in ? (cand[2 * i + 1] & 8191u) : 0u; unsigned rank = 0u;
                    for (unsigned j = 0; j < c; ++j) { const unsigned kj = cand[2 * j], ij = cand[2 * j + 1]; rank += (kj > k32 || (kj == k32 && ij < ki)) ? 1u : 0u; }
                    if (in && rank < needA) __hip_atomic_fetch_or(&bmq[ki >> 5], 1u << (ki & 31), __ATOMIC_RELAXED, __HIP_MEMORY_SCOPE_WORKGROUP); }
                WAVE_SYNC();
                unsigned w0 = bmq[4 * lane], w1 = bmq[4 * lane + 1], w2 = bmq[4 * lane + 2], w3 = bmq[4 * lane + 3];
                const unsigned mycnt = __popc(w0) + __popc(w1) + __popc(w2) + __popc(w3);
                unsigned incl = mycnt;
#pragma unroll
                for (int o = 1; o < 64; o <<= 1) { const unsigned v = __shfl_up(incl, o); if (lane >= o) incl += v; }
                unsigned pos = incl - mycnt; int* sel = SEL + (size_t)(row0 + q) * TOPK;
#pragma unroll
                for (int wi = 0; wi < 4; ++wi) { unsigned w = (wi == 0) ? w0 : (wi == 1) ? w1 : (wi == 2) ? w2 : w3;
                    while (w) { const int bit = __ffs((int)w) - 1; if (pos < (unsigned)TOPK) sel[pos] = 128 * lane + 32 * wi + bit; ++pos; w &= w - 1u; } }
            }
            __syncthreads();
        }
    }
    __syncthreads();
    const unsigned nfb = FBL[0];
    for (unsigned k = 0; k < nfb && k < 63u; ++k) { const int r0 = (int)FBL[1 + k]; __syncthreads(); p3_query_naive(ws, lds, r0, SEL); }
}

typedef short v4i16_t __attribute__((ext_vector_type(4)));
typedef int v4i __attribute__((ext_vector_type(4)));
__device__ __forceinline__ v4i16_t tr16(LAS unsigned char* p) { return __builtin_amdgcn_ds_read_tr16_b64_v4i16((LAS v4i16_t*)p); }
typedef __bf16 bf16x2_t __attribute__((ext_vector_type(2)));
__device__ __forceinline__ unsigned dq2(unsigned w, bool hi) { return __builtin_bit_cast(unsigned, hi ? __builtin_amdgcn_cvt_scalef32_pk_bf16_fp8(w, 1.0f, true) : __builtin_amdgcn_cvt_scalef32_pk_bf16_fp8(w, 1.0f, false)); }
__device__ __forceinline__ bf16x8 dq8(unsigned w0, unsigned w1) { return __builtin_bit_cast(bf16x8, (v4u){dq2(w0, false), dq2(w0, true), dq2(w1, false), dq2(w1, true)}); }
__device__ __forceinline__ void p4_dsa(Frame& F) {
    unsigned char* ws = F.ws; const int lane = F.lane, nh = lane & 15, kg = lane >> 4;
    const bf16* QF = (const bf16*)(ws + WS_QF); const unsigned char* KV8 = (const unsigned char*)(ws + WS_KVF); const int* SEL = (const int*)(ws + WS_SEL); bf16* AO = (bf16*)(ws + WS_AO);
    LAS unsigned char* wl = F.lds + F.wave * 10240; LAS int* selw = (LAS int*)wl; LAS unsigned char* vb = wl + 1024;
    const int gw = F.wave * F.G + F.bid, NGW = F.G * NWAVES;
    LAS unsigned char* trp = vb + (4 * kg + ((lane >> 2) & 3)) * 288 + 8 * (lane & 3);
#pragma unroll 1
    for (int combo = 0; combo < BATCH * NKV; ++combo) {
        const int b = combo >> 1, kvh = combo & 1;
        const unsigned char* kvb = KV8 + (size_t)(b * NKV + kvh) * SEQ * 256;
#pragma unroll 1
        for (int t = gw; t < SEQ; t += NGW) {
            const int row = (b << 13) + t; const int cnt = (t + 1 < TOPK) ? (t + 1) : TOPK;
            *(LAS v4i*)(selw + 4 * lane) = *(const v4i*)(SEL + (size_t)row * TOPK + 4 * lane);
            WAVE_SYNC();
            const bf16* qp = QF + (size_t)row * D + (kvh * 4 + (nh & 3)) * HD + 32 * kg;
            bf16x8 qf[4];
#pragma unroll
            for (int s = 0; s < 4; ++s) { qf[s] = *(const bf16x8*)(qp + 8 * s); if (nh >= 4) qf[s] = (bf16x8){0, 0, 0, 0, 0, 0, 0, 0}; }
            f32x4 S[16];
            v4u kq[2][4][2];
#define P4_LOADK(buf, batch) do { _Pragma("unroll") for (int tt = 0; tt < 4; ++tt) { const unsigned char* kp_ = kvb + (size_t)(selw[16 * (4 * (batch) + tt) + nh] & (SEQ - 1)) * 256 + 32 * kg; \
                kq[buf][tt][0] = *(const v4u*)(kp_); kq[buf][tt][1] = *(const v4u*)(kp_ + 16); } } while (0)
            P4_LOADK(0, 0);
#pragma unroll
            for (int bt = 0; bt < 4; ++bt) {
                if (bt < 3) P4_LOADK((bt + 1) & 1, bt + 1);
                asm volatile("" ::: "memory");
#pragma unroll
                for (int tt = 0; tt < 4; ++tt) {
                    const v4u k0 = kq[bt & 1][tt][0], k1 = kq[bt & 1][tt][1];
                    f32x4 a = (f32x4){0.f, 0.f, 0.f, 0.f};
                    a = __builtin_amdgcn_mfma_f32_16x16x32_bf16(dq8(k0.x, k0.y), qf[0], a, 0, 0, 0); a = __builtin_amdgcn_mfma_f32_16x16x32_bf16(dq8(k0.z, k0.w), qf[1], a, 0, 0, 0);
                    a = __builtin_amdgcn_mfma_f32_16x16x32_bf16(dq8(k1.x, k1.y), qf[2], a, 0, 0, 0); a = __builtin_amdgcn_mfma_f32_16x16x32_bf16(dq8(k1.z, k1.w), qf[3], a, 0, 0, 0);
                    S[4 * bt + tt] = a;
                }
            }
#undef P4_LOADK
            float mx = -INFINITY;
#pragma unroll
            for (int T = 0; T < 16; ++T)
#pragma unroll
                for (int r = 0; r < 4; ++r) { const float v = (16 * T + 4 * kg + r < cnt) ? S[T][r] : -INFINITY; S[T][r] = v; mx = fmaxf(mx, v); }
            mx = fmaxf(mx, __shfl_xor(mx, 16)); mx = fmaxf(mx, __shfl_xor(mx, 32));
            float sum = 0.f;
#pragma unroll
            for (int T = 0; T < 16; ++T)
#pragma unroll
                for (int r = 0; r < 4; ++r) { const float e = __builtin_amdgcn_exp2f(S[T][r] - mx); S[T][r] = e; sum += e; }
            sum += __shfl_xor(sum, 16); sum += __shfl_xor(sum, 32);
            bf16x8 pa[8];
#pragma unroll
            for (int c = 0; c < 8; ++c) { v4u pw; pw.x = pg8::cvt_pk_bf16(S[2 * c][0], S[2 * c][1]); pw.y = pg8::cvt_pk_bf16(S[2 * c][2], S[2 * c][3]); pw.z = pg8::cvt_pk_bf16(S[2 * c + 1][0], S[2 * c + 1][1]); pw.w = pg8::cvt_pk_bf16(S[2 * c + 1][2], S[2 * c + 1][3]); pa[c] = __builtin_bit_cast(bf16x8, pw); }
            f32x4 O[8];
#pragma unroll
            for (int d = 0; d < 8; ++d) O[d] = (f32x4){0.f, 0.f, 0.f, 0.f};
            v4u g[3][4];
#define P4_LOADV(buf, c_) do { _Pragma("unroll") for (int i = 0; i < 4; ++i) { const int key_ = selw[32 * (c_) + (lane >> 3) + 8 * i] & (SEQ - 1); g[buf][i] = *(const v4u*)(kvb + (size_t)key_ * 256 + 128 + 16 * (lane & 7)); } } while (0)
            P4_LOADV(0, 0); P4_LOADV(1, 1); P4_LOADV(2, 2);
#pragma unroll
            for (int c = 0; c < 8; ++c) {
#pragma unroll
                for (int i = 0; i < 4; ++i) { const v4u gg = g[c % 3][i]; LAS unsigned char* dst = vb + ((lane >> 3) + 8 * i) * 288 + 32 * (lane & 7);
                    *(LAS v4u*)dst = __builtin_bit_cast(v4u, dq8(gg.x, gg.y)); *(LAS v4u*)(dst + 16) = __builtin_bit_cast(v4u, dq8(gg.z, gg.w)); }
                asm volatile("" ::: "memory");
                if (c < 5) P4_LOADV(c % 3, c + 3);
#pragma unroll
                for (int d = 0; d < 8; ++d) {
                    const v4i16_t lo = tr16(trp + 32 * d), hi4 = tr16(trp + 16 * 288 + 32 * d);
                    const bf16x8 vfr = (bf16x8){lo[0], lo[1], lo[2], lo[3], hi4[0], hi4[1], hi4[2], hi4[3]};
                    O[d] = __builtin_amdgcn_mfma_f32_16x16x32_bf16(pa[c], vfr, O[d], 0, 0, 0);
                }
            }
#undef P4_LOADV
            const float i0 = 1.0f / __builtin_bit_cast(float, __builtin_amdgcn_readlane(__builtin_bit_cast(int, sum), 0)), i1 = 1.0f / __builtin_bit_cast(float, __builtin_amdgcn_readlane(__builtin_bit_cast(int, sum), 1));
            const float i2 = 1.0f / __builtin_bit_cast(float, __builtin_amdgcn_readlane(__builtin_bit_cast(int, sum), 2)), i3 = 1.0f / __builtin_bit_cast(float, __builtin_amdgcn_readlane(__builtin_bit_cast(int, sum), 3));
            LAS bf16* ost = (LAS bf16*)vb;
            if (kg == 0) {
#pragma unroll
                for (int d = 0; d < 8; ++d) { ost[0 * 128 + 16 * d + nh] = (bf16)f2bf(O[d][0] * i0); ost[1 * 128 + 16 * d + nh] = (bf16)f2bf(O[d][1] * i1); ost[2 * 128 + 16 * d + nh] = (bf16)f2bf(O[d][2] * i2); ost[3 * 128 + 16 * d + nh] = (bf16)f2bf(O[d][3] * i3); }
            }
            WAVE_SYNC();
            const v4u ov = *(LAS v4u*)(vb + 16 * lane);
            *(v4u*)(AO + (size_t)row * D + (kvh * 4 + kg) * HD + 8 * nh) = ov;
            WAVE_SYNC();
        }
    }
}

__device__ __forceinline__ void p9_sb(Frame& F) {
    unsigned char* ws = F.ws; const int lane = F.lane, n = lane & 31, hi = lane >> 5;
    const bf16* KQ = (const bf16*)(ws + WS_KQ); const bf16* VT = (const bf16*)(ws + WS_VT); bf16* AO = (bf16*)(ws + WS_AO);
    const int gw = F.wave * F.G + F.bid, NGW = F.G * NWAVES;
    const int koff = 16 * (n >> 4) + 8 * ((n >> 2) & 1) + 4 * ((n >> 3) & 1) + (n & 3);
    constexpr float LOG2E = 1.4426950408889634f, LN2 = 0.6931471805599453f;
    for (int u = gw; u < (M / 32) * NH; u += NGW) {
        const int h = u & 7, blk = u >> 3, b = blk >> 8, qb = blk & 255, q0 = 32 * qb, t = q0 + n;
        const bf16* qp = KQ + (size_t)(b * SEQ + q0 + n) * 2048 + 1024 + h * HD + 64 * hi;
        bf16x8 qf[8];
#pragma unroll
        for (int s = 0; s < 8; ++s) qf[s] = *(const bf16x8*)(qp + 8 * s);
        f32x16 o[4];
#pragma unroll
        for (int mt = 0; mt < 4; ++mt)
#pragma unroll
            for (int r = 0; r < 16; ++r) o[mt][r] = 0.f;
        float C = 0.f;
        bf16x8 kf[8];
        { const bf16* kp = KQ + (size_t)(b * SEQ + 32 * qb + koff) * 2048 + h * HD + 64 * hi;
#pragma unroll
          for (int s = 0; s < 8; ++s) kf[s] = *(const bf16x8*)(kp + 8 * s); }
        for (int kb = qb; kb >= 0; --kb) {
            const int k0 = 32 * kb;
            bf16x8 vf[4][2];
#pragma unroll
            for (int mt = 0; mt < 4; ++mt)
#pragma unroll
                for (int sp = 0; sp < 2; ++sp) vf[mt][sp] = *(const bf16x8*)(VT + (size_t)(h * HD + 32 * mt + n) * M + b * SEQ + k0 + 16 * sp + 8 * hi);
            f32x16 z;
#pragma unroll
            for (int r = 0; r < 16; ++r) z[r] = 0.f;
#pragma unroll
            for (int s = 0; s < 8; ++s) z = __builtin_amdgcn_mfma_f32_32x32x16_bf16(kf[s], qf[s], z, 0, 0, 0);
            { const int kn = (kb > 0) ? kb - 1 : 0; const bf16* kp = KQ + (size_t)(b * SEQ + 32 * kn + koff) * 2048 + h * HD + 64 * hi;
#pragma unroll
              for (int s = 0; s < 8; ++s) kf[s] = *(const bf16x8*)(kp + 8 * s); }
            float lk[16], lb[16];
#pragma unroll
            for (int r = 0; r < 16; ++r) {
                const int key = k0 + ((r < 8) ? (8 * hi + r) : (16 + 8 * hi + (r - 8)));
                const float zz = z[r]; const float L = __builtin_amdgcn_logf(1.0f + __builtin_amdgcn_exp2f(-fabsf(zz) * LOG2E)) * LN2;
                const bool valid = key < t;
                lk[r] = valid ? (-fmaxf(zz, 0.f) - L) : 0.f;
                lb[r] = valid ? (fminf(zz, 0.f) - L) : -INFINITY;
            }
            float suf[16];
            suf[7] = 0.f; suf[15] = 0.f;
#pragma unroll
            for (int i = 6; i >= 0; --i) { suf[i] = suf[i + 1] + lk[i + 1]; suf[8 + i] = suf[9 + i] + lk[9 + i]; }
            const float T0 = suf[0] + lk[0], T1 = suf[8] + lk[8];
            const float P0 = __shfl_xor(T0, 32), P1 = __shfl_xor(T1, 32);
            const float base1 = C + (hi ? 0.f : P1), base0 = C + (hi ? (T1 + P1) : (P0 + T1 + P1));
            unsigned pw[8];
#pragma unroll
            for (int r = 0; r < 16; r += 2) {
                const float a0 = __builtin_amdgcn_exp2f((lb[r] + ((r < 8) ? base0 : base1) + suf[r]) * LOG2E), a1 = __builtin_amdgcn_exp2f((lb[r + 1] + ((r < 8) ? base0 : base1) + suf[r + 1]) * LOG2E);
                pw[r >> 1] = pg8::cvt_pk_bf16(a0, a1);
            }
            C += (T0 + T1) + (P0 + P1);
            const bf16x8 pa0 = __builtin_bit_cast(bf16x8, (v4u){pw[0], pw[1], pw[2], pw[3]}), pa1 = __builtin_bit_cast(bf16x8, (v4u){pw[4], pw[5], pw[6], pw[7]});
#pragma unroll
            for (int mt = 0; mt < 4; ++mt) { o[mt] = __builtin_amdgcn_mfma_f32_32x32x16_bf16(vf[mt][0], pa0, o[mt], 0, 0, 0); o[mt] = __builtin_amdgcn_mfma_f32_32x32x16_bf16(vf[mt][1], pa1, o[mt], 0, 0, 0); }
            if (__all(C < -44.0f)) break;
        }
        bf16* op = AO + (size_t)(b * SEQ + q0 + n) * D + h * HD + 4 * hi;
#pragma unroll
        for (int mt = 0; mt < 4; ++mt)
#pragma unroll
            for (int g = 0; g < 4; ++g) { v2u w; w.x = pg8::cvt_pk_bf16(o[mt][4 * g], o[mt][4 * g + 1]); w.y = pg8::cvt_pk_bf16(o[mt][4 * g + 2], o[mt][4 * g + 3]); *(v2u*)(op + 32 * mt + 8 * g) = w; }
    }
}

__device__ __forceinline__ void p11_router(Frame& F) {
    unsigned char* ws = F.ws; const int tid = F.tid, lane = F.lane, wave = F.wave;
    const float* H = (const float*)(ws + WS_H); const float* gn = F.in[IN_FFNNORM] + D; const float* Wr = F.in[IN_ROUTER];
    int* TOPE = (int*)(ws + WS_RT); int* POS = (int*)(ws + WS_RT + 128 * 1024); float* GATE = (float*)(ws + WS_RT + 256 * 1024); float* RSTD3 = (float*)(ws + WS_RT + 384 * 1024);
    LAS unsigned* lcnt = (LAS unsigned*)F.lds;
    LAS unsigned* gb = (LAS unsigned*)(F.lds + 64);
    LAS int* ltok = (LAS int*)(F.lds + 128);
    LAS float* lgt = (LAS float*)(F.lds + 128 + 1024);
    for (int chunk = F.bid; chunk < M / 64; chunk += F.G) {
        if (tid < 8) lcnt[tid] = 0u;
        __syncthreads();
        for (int r = 0; r < 8; ++r) {
            const int row = chunk * 64 + wave * 8 + r;
            const GAS f32x4* xr = (const GAS f32x4*)(H + (size_t)row * D) + lane; f32x4 v[4]; float ss = 0.f;
#pragma unroll
            for (int j = 0; j < 4; ++j) { v[j] = xr[64 * j]; ss += (v[j].x * v[j].x + v[j].y * v[j].y) + (v[j].z * v[j].z + v[j].w * v[j].w); }
            ss = wave_sum(ss); const float rs = 1.0f / sqrtf(ss * (1.0f / 1024.0f) + 1e-6f);
            float lg[8] = {0.f, 0.f, 0.f, 0.f, 0.f, 0.f, 0.f, 0.f};
#pragma unroll
            for (int j = 0; j < 4; ++j)
#pragma unroll
                for (int i = 0; i < 4; ++i) { const int k = 256 * j + 4 * lane + i; const float xv = v[j][i] * gn[k]; const f32x4 w0 = *(const f32x4*)(Wr + (size_t)k * 8), w1 = *(const f32x4*)(Wr + (size_t)k * 8 + 4);
                    lg[0] += xv * w0[0]; lg[1] += xv * w0[1]; lg[2] += xv * w0[2]; lg[3] += xv * w0[3]; lg[4] += xv * w1[0]; lg[5] += xv * w1[1]; lg[6] += xv * w1[2]; lg[7] += xv * w1[3]; }
#pragma unroll
            for (int e = 0; e < 8; ++e) lg[e] = wave_sum(lg[e]) * rs;
            int i1 = 0; float l1 = lg[0];
#pragma unroll
            for (int e = 1; e < 8; ++e) if (lg[e] > l1) { l1 = lg[e]; i1 = e; }
            int i2 = -1; float l2 = -INFINITY;
#pragma unroll
            for (int e = 0; e < 8; ++e) if (e != i1 && lg[e] > l2) { l2 = lg[e]; i2 = e; }
            const float g1 = 1.0f / (1.0f + __expf(l2 - l1)), g2 = 1.0f - g1;
            if (lane == 0) {
                const unsigned p1 = __hip_atomic_fetch_add(&lcnt[i1], 1u, __ATOMIC_RELAXED, __HIP_MEMORY_SCOPE_WORKGROUP), p2 = __hip_atomic_fetch_add(&lcnt[i2], 1u, __ATOMIC_RELAXED, __HIP_MEMORY_SCOPE_WORKGROUP);
                const int ti = wave * 8 + r; ltok[ti * 4 + 0] = i1; ltok[ti * 4 + 1] = i2; ltok[ti * 4 + 2] = (int)p1; ltok[ti * 4 + 3] = (int)p2;
                lgt[ti * 4 + 0] = g1; lgt[ti * 4 + 1] = g2; lgt[ti * 4 + 2] = rs;
            }
        }
        __syncthreads();
        if (tid < 8) gb[tid] = __hip_atomic_fetch_add(F.ctl + CW_CNT + tid, lcnt[tid], RLX_AGENT);
        __syncthreads();
        if (tid < 64) { const int row = chunk * 64 + tid; const int e1 = ltok[tid * 4], e2 = ltok[tid * 4 + 1];
            TOPE[row * 2] = e1; TOPE[row * 2 + 1] = e2; POS[row * 2] = (int)gb[e1] + ltok[tid * 4 + 2]; POS[row * 2 + 1] = (int)gb[e2] + ltok[tid * 4 + 3];
            GATE[row * 2] = lgt[tid * 4]; GATE[row * 2 + 1] = lgt[tid * 4 + 1]; RSTD3[row] = lgt[tid * 4 + 2]; }
        __syncthreads();
    }
}
__device__ __forceinline__ void moe_bases(Frame& F, int (&tb)[9]) {
    int acc = 0;
#pragma unroll
    for (int e = 0; e < 8; ++e) { tb[e] = acc; const unsigned c = __hip_atomic_load(F.ctl + CW_CNT + e, RLX_AGENT); acc += (int)((c + 255u) >> 8); }
    tb[8] = acc;
}
__device__ __forceinline__ void p12_permute(Frame& F) {
    unsigned char* ws = F.ws; const int lane = F.lane;
    const int* TOPE = (const int*)(ws + WS_RT); const int* POS = (const int*)(ws + WS_RT + 128 * 1024); const float* RSTD3 = (const float*)(ws + WS_RT + 384 * 1024);
    int* SLOT = (int*)(ws + WS_RT + 512 * 1024);
    const float* H = (const float*)(ws + WS_H); bf16* XP = (bf16*)(ws + WS_XPERM);
    int tb[9]; moe_bases(F, tb);
    const int gw = F.wave * F.G + F.bid, NGW = F.G * NWAVES;
    for (int i = gw; i < 2 * M; i += NGW) {
        const int row = i >> 1; const int e = TOPE[i]; int base = 0;
#pragma unroll
        for (int k = 0; k < 8; ++k) base = (e == k) ? tb[k] : base;
        const int slot = base * 256 + POS[i];
        const float rs = RSTD3[row];
        const GAS f32x4* src = (const GAS f32x4*)(H + (size_t)row * D) + lane; GAS unsigned* dst = (GAS unsigned*)((unsigned char*)XP + (size_t)slot * D) + lane;
        const float r16 = rs * pg8::F8_SX;
#pragma unroll
        for (int j = 0; j < 4; ++j) { const f32x4 v = src[64 * j]; dst[64 * j] = pg8::pk4_fp8(v.x * r16, v.y * r16, v.z * r16, v.w * r16); }
        if (lane == 0) SLOT[i] = slot;
    }
}
__device__ __forceinline__ void p15_combine(Frame& F) {
    unsigned char* ws = F.ws; const int lane = F.lane;
    const float* H = (const float*)(ws + WS_H); const bf16* Y = (const bf16*)(ws + WS_Y); const int* SLOT = (const int*)(ws + WS_RT + 512 * 1024); const float* GATE = (const float*)(ws + WS_RT + 256 * 1024);
    const int gw = F.wave * F.G + F.bid, NGW = F.G * NWAVES;
    for (int row = gw; row < M; row += NGW) {
        const int s1 = SLOT[row * 2], s2 = SLOT[row * 2 + 1]; const float g1 = GATE[row * 2], g2 = GATE[row * 2 + 1];
        const GAS f32x4* hr = (const GAS f32x4*)(H + (size_t)row * D) + lane; GAS f32x4* orow = (GAS f32x4*)(F.out + (size_t)row * D) + lane;
        const GAS v2u* y1 = (const GAS v2u*)(Y + (size_t)s1 * D) + lane; const GAS v2u* y2 = (const GAS v2u*)(Y + (size_t)s2 * D) + lane;
#pragma unroll
        for (int j = 0; j < 4; ++j) { const f32x4 h = __builtin_nontemporal_load(hr + 64 * j); const v2u a = __builtin_nontemporal_load(y1 + 64 * j), c = __builtin_nontemporal_load(y2 + 64 * j); f32x4 o;
            o.x = h.x + (g1 * bflo(a.x) + g2 * bflo(c.x)); o.y = h.y + (g1 * bfhi(a.x) + g2 * bfhi(c.x)); o.z = h.z + (g1 * bflo(a.y) + g2 * bflo(c.y)); o.w = h.w + (g1 * bfhi(a.y) + g2 * bfhi(c.y)); orow[64 * j] = o; }
    }
}

constexpr int N_PHASES = 16;
#ifndef MK_ONE_LAUNCH
#define MK_ONE_LAUNCH 1
#endif
struct Args { const float* in[17]; float* out; unsigned char* ws; int ph_lo, ph_hi; };
__global__ void __launch_bounds__(NWAVES * 64, 2) yoco_fwd(Args args) {
    extern __shared__ __attribute__((aligned(16))) unsigned char lds[];
    Frame F;
    F.lds = (LAS unsigned char*)lds; F.MISC = (volatile LAS unsigned*)(F.lds + MISC_OFF);
    F.tid = threadIdx.x; F.lane = F.tid & 63; F.wave = __builtin_amdgcn_readfirstlane(F.tid >> 6); F.G = gridDim.x; F.bid = blockIdx.x;
    F.ws = args.ws; F.ctl = (gu32*)(args.ws + WS_CTL); F.out = args.out;
#pragma unroll
    for (int i = 0; i < 17; ++i) F.in[i] = args.in[i];
    for (int u = F.tid; u < (LDS_BYTES - LDSCTL_OFF) / 4; u += NWAVES * 64) ((LAS unsigned*)(F.lds + LDSCTL_OFF))[u] = 0u;
    __syncthreads();
    unsigned char* ws = args.ws;
    XcdBarrier bar; bar.bar = (unsigned*)(F.ctl + CW_BAR); bar.x = 0; bar.st = nullptr;
    if (MK_ONE_LAUNCH) bar = xcd_barrier_post((unsigned*)(F.ctl + CW_BAR), F.MISC + 8);
    const int lo = args.ph_lo, hi = args.ph_hi;
#define IN(k) (lo <= (k) && (k) < hi)
#define SEAM(k) do { if (MK_ONE_LAUNCH && IN((k) + 1)) xcd_barrier(bar); } while (0)
    bf16* XB = (bf16*)(ws + WS_XB); float* H = (float*)(ws + WS_H); bf16* AO = (bf16*)(ws + WS_AO);

    if (IN(0)) { p0_prologue(F); SEAM(0); }
    if (IN(1)) {
        pg8::Gemm g{XB, (const bf16*)(ws + WS_WIN), M, 2048, D}; pg8::StaticOrder S; S.init(M, 2048, F.G, F.bid);
        pg8::EpiPlainBf16 E{(bf16*)(ws + WS_PROJ), 2048, 0xffff};
        pg8::gemm_phase<pg8::EpiPlainBf16, pg8::StaticOrder, true, true>(F.lds, g, S, E); SEAM(1); }
    if (IN(2)) { p2_post(F); SEAM(2); }
    if (IN(3)) { p3_index(F); SEAM(3); }
    if (IN(4)) { p4_dsa(F); SEAM(4); }
    if (IN(5)) {
        pg8::Gemm g{AO, (const bf16*)(ws + WS_WOA), M, D, D}; pg8::StaticOrder S; S.init(M, D, F.G, F.bid);
        pg8::EpiResid E{F.in[IN_X], H, XB, (float*)(ws + WS_SS1)};
        pg8::gemm_phase<pg8::EpiResid, pg8::StaticOrder, true, true>(F.lds, g, S, E); SEAM(5); }
    if (IN(6)) {
        pg8::Gemm g{XB, (const bf16*)(ws + WS_WGU), M, 2 * FF, D}; pg8::StaticOrder S; S.init(M, 2 * FF, F.G, F.bid);
        pg8::EpiSwiGLU<false> E{(bf16*)(ws + WS_HF), FF, (const float*)(ws + WS_SS1)};
        pg8::gemm_phase<pg8::EpiSwiGLU<false>, pg8::StaticOrder, true, true>(F.lds, g, S, E); SEAM(6); }
    if (IN(7)) {
        pg8::Gemm g{(const bf16*)(ws + WS_HF), (const bf16*)(ws + WS_WD), M, D, FF}; pg8::StaticOrder S; S.init(M, D, F.G, F.bid);
        pg8::EpiResid E{H, H, XB, (float*)(ws + WS_SS2)};
        pg8::gemm_phase<pg8::EpiResid, pg8::StaticOrder, true, true>(F.lds, g, S, E); SEAM(7); }
    if (IN(8)) {
        { pg8::Gemm g{XB, (const bf16*)(ws + WS_WKVQ), M, 2048, D}; pg8::StaticOrder S; S.init(M, 2048, F.G, F.bid);
          pg8::EpiScaleBf16 E{(bf16*)(ws + WS_KQ), 2048, (const float*)(ws + WS_SS2)};
          pg8::gemm_phase<pg8::EpiScaleBf16, pg8::StaticOrder, true, true>(F.lds, g, S, E); }
        { pg8::Gemm g{(const bf16*)(ws + WS_WKVQ) + (size_t)2048 * D, XB, D, M, D}; pg8::StaticOrder S; S.init(D, M, F.G, F.bid);
          pg8::EpiScaleColBf16 E{(bf16*)(ws + WS_VT), M, (const float*)(ws + WS_SS2)};
          pg8::gemm_phase<pg8::EpiScaleColBf16, pg8::StaticOrder, true, true>(F.lds, g, S, E); }
        SEAM(8); }
    if (IN(9)) { p9_sb(F); SEAM(9); }
    if (IN(10)) {
        pg8::Gemm g{AO, (const bf16*)(ws + WS_WOB), M, D, D}; pg8::StaticOrder S; S.init(M, D, F.G, F.bid);
        pg8::EpiResid E{H, H, XB, (float*)(ws + WS_SS3)};
        pg8::gemm_phase<pg8::EpiResid, pg8::StaticOrder, true, true>(F.lds, g, S, E); SEAM(10); }
    if (IN(11)) { p11_router(F); SEAM(11); }
    if (IN(12)) { p12_permute(F); SEAM(12); }
    if (IN(13)) {
        pg8::MoeOrder S; moe_bases(F, S.tb); S.npn = 22; S.G = F.G; S.c = F.bid;
        pg8::Gemm g{(const bf16*)(ws + WS_XPERM), (const bf16*)(ws + WS_WGUM), MAXSLOT, NE * 2 * FF, D / 2};
        pg8::EpiSwiGLUMoe8 E{ws + WS_HM, FF};
        pg8::gemm_phase<pg8::EpiSwiGLUMoe8, pg8::MoeOrder, true, true, true>(F.lds, g, S, E); SEAM(13); }
    if (IN(14)) {
        pg8::MoeOrder S; moe_bases(F, S.tb); S.npn = 4; S.G = F.G; S.c = F.bid;
        pg8::Gemm g{(const bf16*)(ws + WS_HM), (const bf16*)(ws + WS_WDM), MAXSLOT, NE * D, FF / 2};
        pg8::EpiScaledBf16 E{(bf16*)(ws + WS_Y), D, 3, 1.0f / (pg8::F8_SH * pg8::F8_SWD)};
        pg8::gemm_phase<pg8::EpiScaledBf16, pg8::MoeOrder, true, true, true>(F.lds, g, S, E); SEAM(14); }
    if (IN(15)) { p15_combine(F); }
#undef IN
#undef SEAM
}

extern "C" void kernel_launch(void* const* d_in, const int* in_sizes, int n_in, void* d_out, int out_size, void* d_ws, size_t ws_size, hipStream_t stream) {
    static int grid = 0;
    if (grid == 0) {
        if (n_in != 17 || out_size != M * D || ws_size < WS_END) { fprintf(stderr, "kernel_launch: unexpected problem (n_in %d, out %d, ws %zu < %zu)\n", n_in, out_size, ws_size, (size_t)WS_END); grid = -1; return; }
        int dev = 0, cus = 0, per_cu = 0;
        if (hipGetDevice(&dev) != hipSuccess || hipDeviceGetAttribute(&cus, hipDeviceAttributeMultiprocessorCount, dev) != hipSuccess) { grid = -1; return; }
        if (hipFuncSetAttribute((const void*)yoco_fwd, hipFuncAttributeMaxDynamicSharedMemorySize, LDS_BYTES) != hipSuccess) { fprintf(stderr, "kernel_launch: hipFuncSetAttribute failed\n"); grid = -1; return; }
        if (hipOccupancyMaxActiveBlocksPerMultiprocessor(&per_cu, (const void*)yoco_fwd, NWAVES * 64, LDS_BYTES) != hipSuccess || per_cu < 1) fprintf(stderr, "kernel_launch: occupancy query says %d\n", per_cu);
        (void)hipGetLastError();
        grid = cus;
    }
    if (grid < 0) return;
    if (hipMemsetAsync((char*)d_ws + WS_CTL, 0, CTL_ZERO_BYTES, stream) != hipSuccess) return;
    Args a{};
    for (int i = 0; i < 17; ++i) a.in[i] = (const float*)d_in[i];
    a.out = (float*)d_out; a.ws = (unsigned char*)d_ws;
#if MK_ONE_LAUNCH
    a.ph_lo = 0; a.ph_hi = N_PHASES;
    hipLaunchKernelGGL(yoco_fwd, dim3(grid), dim3(NWAVES * 64), LDS_BYTES, stream, a);
#else
    for (int p = 0; p < N_PHASES; ++p) { a.ph_lo = p; a.ph_hi = p + 1; hipLaunchKernelGGL(yoco_fwd, dim3(grid), dim3(NWAVES * 64), LDS_BYTES, stream, a); }
#endif
}
```

```cpp
#include <hip/hip_runtime.h>
#include <cstdio>
#include <cstdint>
namespace pg8 {
#define PG8_LAS __attribute__((address_space(3)))
typedef unsigned short bf16_t;
typedef short bf16x8 __attribute__((ext_vector_type(8)));
typedef float f32x4 __attribute__((ext_vector_type(4)));
typedef unsigned u32x4 __attribute__((ext_vector_type(4)));
typedef int i32x4 __attribute__((ext_vector_type(4)));
typedef int i32x8 __attribute__((ext_vector_type(8)));
constexpr int BM = 256, BK = 64, HALF = 128, HTB = HALF * BK * 2  , STAGE_BYTES = 8 * HTB, NXCD = 8, WGM = 8;

__host__ __device__ __forceinline__ int lds_byte(int r, int c) { const int st = (r >> 4) * 2 + (c >> 5), rr = r & 15, cc = c & 31, ob = rr * 64 + cc * 2; return st * 1024 + (ob ^ (((ob >> 9) & 1) << 5)); }
__host__ __device__ __forceinline__ void stage_rc(int b, int& R, int& C) { const int st = b / 1024, sb = b % 1024, swz = sb ^ (((sb >> 9) & 1) << 5); R = (st >> 1) * 16 + swz / 64; C = (st & 1) * 32 + (swz % 64) / 2; }
__host__ __device__ __forceinline__ int perm32(int rho) { const int n = rho >> 4, i = rho & 15; return 8 * (i >> 2) + 4 * n + (i & 3); }

struct Unit { int pm, pn; int koff = 0; };
struct Gemm { const bf16_t* A; const bf16_t* Bt; int M, N, K; int ld = 0; };

struct StaticOrder {
    int nM, nN, nwg, G, c;
    __host__ __device__ void init(int M, int N, int G_, int c_) { nM = M / BM; nN = N / BM; nwg = nM * nN; G = G_; c = c_; }
    __host__ __device__ bool next(int i, Unit& u) const {
        const long L = (long)i * G + c; if (L >= nwg) return false;
        int wgid = (int)L; { const int q = nwg / NXCD, r = nwg % NXCD, xcd = wgid % NXCD, off = wgid / NXCD; wgid = (xcd < r ? xcd * (q + 1) : r * (q + 1) + (xcd - r) * q) + off; }
        const int nig = WGM * nN, gid = wgid / nig, fm = gid * WGM, gsz = (nM - fm) < WGM ? (nM - fm) : WGM;
        u.pm = fm + ((wgid % nig) % gsz); u.pn = (wgid % nig) / gsz; return true;
    }
    __device__ __forceinline__ void a_ready(const Unit&) const {}
    __device__ __forceinline__ void done(const Unit&) const {}
};

__device__ __forceinline__ unsigned cvt_pk_bf16(float lo, float hi) { unsigned r; asm volatile("v_cvt_pk_bf16_f32 %0, %1, %2" : "=v"(r) : "v"(lo), "v"(hi)); return r; }
typedef unsigned u32x2 __attribute__((ext_vector_type(2)));
constexpr float RMS_EPS = 1e-6f;
__device__ __forceinline__ float rstd16(const float* p) {
    const f32x4 a = *(const f32x4*)p, b = *(const f32x4*)(p + 4), c = *(const f32x4*)(p + 8), d = *(const f32x4*)(p + 12);
    const float s = (((a[0] + a[1]) + (a[2] + a[3])) + ((b[0] + b[1]) + (b[2] + b[3]))) + (((c[0] + c[1]) + (c[2] + c[3])) + ((d[0] + d[1]) + (d[2] + d[3])));
    return 1.0f / sqrtf(s * (1.0f / 1024.0f) + RMS_EPS);
}
struct EpiScaleBf16 {
    static constexpr bool PERM = true, AFTER_DRAIN = false;
    bf16_t* O; int ldc; const float* ss;
    __device__ __forceinline__ void operator()(const f32x4 (&acc)[2][2][4][2], const Unit& u, int wr, int wc, int fr, int fq) const {
        const int row0 = u.pm * BM + wr * 64 + fr, col0 = u.pn * BM + wc * 32 + 8 * fq;
        float rsv[2][4];
#pragma unroll
        for (int ai = 0; ai < 2; ++ai)
#pragma unroll
            for (int m = 0; m < 4; ++m) rsv[ai][m] = rstd16(ss + (size_t)(row0 + ai * HALF + m * 16) * 16);
#pragma unroll
        for (int ai = 0; ai < 2; ++ai)
#pragma unroll
            for (int m = 0; m < 4; ++m) { const int row = row0 + ai * HALF + m * 16; const float rs = rsv[ai][m]; bf16_t* rowp = O + (size_t)row * ldc + col0;
#pragma unroll
                for (int bj = 0; bj < 2; ++bj) { const f32x4 v0 = acc[ai][bj][m][0] * rs, v1 = acc[ai][bj][m][1] * rs;
                    u32x4 w; w.x = cvt_pk_bf16(v0[0], v0[1]); w.y = cvt_pk_bf16(v0[2], v0[3]); w.z = cvt_pk_bf16(v1[0], v1[1]); w.w = cvt_pk_bf16(v1[2], v1[3]);
                    *(u32x4*)(rowp + bj * HALF) = w; } }
    }
};
struct EpiPlainBf16 {
    static constexpr bool PERM = true, AFTER_DRAIN = false;
    bf16_t* O; int ldc; int pnmask;
    __device__ __forceinline__ void operator()(const f32x4 (&acc)[2][2][4][2], const Unit& u, int wr, int wc, int fr, int fq) const {
        const int row0 = u.pm * BM + wr * 64 + fr, col0 = (u.pn & pnmask) * BM + wc * 32 + 8 * fq;
#pragma unroll
        for (int ai = 0; ai < 2; ++ai)
#pragma unroll
            for (int m = 0; m < 4; ++m) { bf16_t* rowp = O + (size_t)(row0 + ai * HALF + m * 16) * ldc + col0;
#pragma unroll
                for (int bj = 0; bj < 2; ++bj) { const f32x4 v0 = acc[ai][bj][m][0], v1 = acc[ai][bj][m][1];
                    u32x4 w; w.x = cvt_pk_bf16(v0[0], v0[1]); w.y = cvt_pk_bf16(v0[2], v0[3]); w.z = cvt_pk_bf16(v1[0], v1[1]); w.w = cvt_pk_bf16(v1[2], v1[3]);
                    *(u32x4*)(rowp + bj * HALF) = w; } }
    }
};
struct EpiScaleColBf16 {
    static constexpr bool PERM = true, AFTER_DRAIN = false;
    bf16_t* O; int ldc; const float* ss;
    __device__ __forceinline__ void operator()(const f32x4 (&acc)[2][2][4][2], const Unit& u, int wr, int wc, int fr, int fq) const {
        const int row0 = u.pm * BM + wr * 64 + fr, col0 = u.pn * BM + wc * 32 + 8 * fq;
        f32x4 rs[2][2];
#pragma unroll
        for (int bj = 0; bj < 2; ++bj)
#pragma unroll
            for (int n = 0; n < 2; ++n)
#pragma unroll
                for (int e = 0; e < 4; ++e) rs[bj][n][e] = rstd16(ss + (size_t)(col0 + bj * HALF + 4 * n + e) * 16);
#pragma unroll
        for (int ai = 0; ai < 2; ++ai)
#pragma unroll
            for (int m = 0; m < 4; ++m) { const int row = row0 + ai * HALF + m * 16; bf16_t* rowp = O + (size_t)row * ldc + col0;
#pragma unroll
                for (int bj = 0; bj < 2; ++bj) { const f32x4 v0 = acc[ai][bj][m][0] * rs[bj][0], v1 = acc[ai][bj][m][1] * rs[bj][1];
                    u32x4 w; w.x = cvt_pk_bf16(v0[0], v0[1]); w.y = cvt_pk_bf16(v0[2], v0[3]); w.z = cvt_pk_bf16(v1[0], v1[1]); w.w = cvt_pk_bf16(v1[2], v1[3]);
                    *(u32x4*)(rowp + bj * HALF) = w; } }
    }
};
constexpr float F8_SX = 16.f, F8_SWGU = 512.f, F8_SH = 16.f, F8_SWD = 1024.f;
__device__ __forceinline__ unsigned pk4_fp8(float a, float b, float c, float d) {
    a = __builtin_amdgcn_fmed3f(a, -448.f, 448.f); b = __builtin_amdgcn_fmed3f(b, -448.f, 448.f); c = __builtin_amdgcn_fmed3f(c, -448.f, 448.f); d = __builtin_amdgcn_fmed3f(d, -448.f, 448.f);
    int w = __builtin_amdgcn_cvt_pk_fp8_f32(a, b, 0, false); w = __builtin_amdgcn_cvt_pk_fp8_f32(c, d, w, true); return (unsigned)w;
}
template <bool X8> struct EpiResid {
    static constexpr bool PERM = false, AFTER_DRAIN = false;
    const float* base; float* H; bf16_t* XB; float* ssp; float sc;
    __device__ __forceinline__ void operator()(const f32x4 (&acc)[2][2][4][2], const Unit& u, int wr, int wc, int fr, int fq) const {
        const int row0 = u.pm * BM + wr * 64 + fr, col0 = u.pn * BM + wc * 32 + 4 * fq;
#pragma unroll
        for (int ai = 0; ai < 2; ++ai) {
            f32x4 bv[4][2][2];
#pragma unroll
            for (int m = 0; m < 4; ++m)
#pragma unroll
                for (int bj = 0; bj < 2; ++bj)
#pragma unroll
                    for (int n = 0; n < 2; ++n) bv[m][bj][n] = *(const f32x4*)(base + (size_t)(row0 + ai * HALF + m * 16) * 1024 + col0 + bj * HALF + n * 16);
#pragma unroll
            for (int m = 0; m < 4; ++m) { const int row = row0 + ai * HALF + m * 16; float q = 0.f;
#pragma unroll
                for (int bj = 0; bj < 2; ++bj)
#pragma unroll
                    for (int n = 0; n < 2; ++n) { const size_t off = (size_t)row * 1024 + col0 + bj * HALF + n * 16;
                        const f32x4 v = bv[m][bj][n] + acc[ai][bj][m][n] * sc; *(f32x4*)(H + off) = v;
                        q += (v[0] * v[0] + v[1] * v[1]) + (v[2] * v[2] + v[3] * v[3]);
                        if constexpr (X8) { *(unsigned*)((unsigned char*)XB + off) = pk4_fp8(v[0] * F8_SX, v[1] * F8_SX, v[2] * F8_SX, v[3] * F8_SX); }
                        else { u32x2 w; w.x = cvt_pk_bf16(v[0], v[1]); w.y = cvt_pk_bf16(v[2], v[3]); *(u32x2*)(XB + off) = w; } }
                q += __shfl_xor(q, 16); q += __shfl_xor(q, 32);
                if (fq == 0) ssp[(size_t)row * 16 + u.pn * 4 + wc] = q; }
        }
    }
};
__device__ __forceinline__ float silu_mul(float g, float u) { return g * __builtin_amdgcn_rcpf(1.0f + __builtin_amdgcn_exp2f(g * -1.4426950408889634f)) * u; }
template <bool MOE> struct EpiSwiGLU {
    static constexpr bool PERM = true, AFTER_DRAIN = false;
    bf16_t* O; int ldc; const float* ss;
    __device__ __forceinline__ void operator()(const f32x4 (&acc)[2][2][4][2], const Unit& u, int wr, int wc, int fr, int fq) const {
        const int row0 = u.pm * BM + wr * 64 + fr; const int pnl = MOE ? (u.pn % 22) : u.pn; const int col0 = pnl * HALF + wc * 32 + 8 * fq;
        float rsv[2][4];
#pragma unroll
        for (int ai = 0; ai < 2; ++ai)
#pragma unroll
            for (int m = 0; m < 4; ++m) { const int row = row0 + ai * HALF + m * 16; rsv[ai][m] = MOE ? 1.0f : rstd16(ss + (size_t)row * 16); }
#pragma unroll
        for (int ai = 0; ai < 2; ++ai)
#pragma unroll
            for (int m = 0; m < 4; ++m) { const int row = row0 + ai * HALF + m * 16; const float rs = rsv[ai][m];
                const f32x4 g0 = acc[ai][0][m][0] * rs, g1 = acc[ai][0][m][1] * rs, u0 = acc[ai][1][m][0] * rs, u1 = acc[ai][1][m][1] * rs;
                u32x4 w; w.x = cvt_pk_bf16(silu_mul(g0[0], u0[0]), silu_mul(g0[1], u0[1])); w.y = cvt_pk_bf16(silu_mul(g0[2], u0[2]), silu_mul(g0[3], u0[3]));
                w.z = cvt_pk_bf16(silu_mul(g1[0], u1[0]), silu_mul(g1[1], u1[1])); w.w = cvt_pk_bf16(silu_mul(g1[2], u1[2]), silu_mul(g1[3], u1[3]));
                *(u32x4*)(O + (size_t)row * ldc + col0) = w; }
    }
};
template <bool MOE> struct EpiSwiGLU8 {
    static constexpr bool PERM = true, AFTER_DRAIN = false;
    unsigned char* O; int ldc; const float* ss;
    __device__ __forceinline__ void operator()(const f32x4 (&acc)[2][2][4][2], const Unit& u, int wr, int wc, int fr, int fq) const {
        const int row0 = u.pm * BM + wr * 64 + fr; const int col0 = (MOE ? (u.pn % 22) : u.pn) * HALF + wc * 32 + 8 * fq; const float r0 = 1.0f / (F8_SX * F8_SWGU);
        float rsv[2][4];
#pragma unroll
        for (int ai = 0; ai < 2; ++ai)
#pragma unroll
            for (int m = 0; m < 4; ++m) rsv[ai][m] = MOE ? r0 : r0 * rstd16(ss + (size_t)(row0 + ai * HALF + m * 16) * 16);
#pragma unroll
        for (int ai = 0; ai < 2; ++ai)
#pragma unroll
            for (int m = 0; m < 4; ++m) { const int row = row0 + ai * HALF + m * 16; const float rs = rsv[ai][m], rh = rs * F8_SH;
                const f32x4 g0 = acc[ai][0][m][0] * rs, g1 = acc[ai][0][m][1] * rs, u0 = acc[ai][1][m][0] * rh, u1 = acc[ai][1][m][1] * rh;
                u32x2 w; w.x = pk4_fp8(silu_mul(g0[0], u0[0]), silu_mul(g0[1], u0[1]), silu_mul(g0[2], u0[2]), silu_mul(g0[3], u0[3]));
                w.y = pk4_fp8(silu_mul(g1[0], u1[0]), silu_mul(g1[1], u1[1]), silu_mul(g1[2], u1[2]), silu_mul(g1[3], u1[3]));
                *(u32x2*)(O + (size_t)row * ldc + col0) = w; }
    }
};
struct EpiScaledBf16 {
    static constexpr bool PERM = true, AFTER_DRAIN = false;
    bf16_t* O; int ldc; int pnmask; float sc;
    __device__ __forceinline__ void operator()(const f32x4 (&acc)[2][2][4][2], const Unit& u, int wr, int wc, int fr, int fq) const {
        const int row0 = u.pm * BM + wr * 64 + fr, col0 = (u.pn & pnmask) * BM + wc * 32 + 8 * fq;
#pragma unroll
        for (int ai = 0; ai < 2; ++ai)
#pragma unroll
            for (int m = 0; m < 4; ++m) { bf16_t* rowp = O + (size_t)(row0 + ai * HALF + m * 16) * ldc + col0;
#pragma unroll
                for (int bj = 0; bj < 2; ++bj) { const f32x4 v0 = acc[ai][bj][m][0] * sc, v1 = acc[ai][bj][m][1] * sc;
                    u32x4 w; w.x = cvt_pk_bf16(v0[0], v0[1]); w.y = cvt_pk_bf16(v0[2], v0[3]); w.z = cvt_pk_bf16(v1[0], v1[1]); w.w = cvt_pk_bf16(v1[2], v1[3]);
                    *(u32x4*)(rowp + bj * HALF) = w; } }
    }
};
struct MoeOrder {
    int tb[9]; int npn, G, c;
    __device__ __forceinline__ bool next(int i, Unit& u) const {
        const int L = i * G + c; if (L >= tb[8] * npn) return false;
        const int t = L / npn, j = L - t * npn; int e = 0;
#pragma unroll
        for (int k = 1; k < 8; ++k) e += (t >= tb[k]) ? 1 : 0;
        u.pm = t; u.pn = e * npn + j; return true;
    }
    __device__ __forceinline__ void a_ready(const Unit&) const {}
    __device__ __forceinline__ void done(const Unit&) const {}
};

template <class Epi, class Sched, bool ALIGN_EPI = false, bool SP2 = false, bool F8 = false>
__device__ __forceinline__ void gemm_phase(PG8_LAS unsigned char* lds, const Gemm g, const Sched& S, const Epi& E) {
    const int tid = threadIdx.x, wid = __builtin_amdgcn_readfirstlane(tid >> 6), lane = tid & 63, wr = wid >> 2, wc = wid & 3, fr = lane & 15, fq = lane >> 4;
    const int K = g.K, nt = K / BK, LD = g.ld ? g.ld : g.K;
    unsigned voffA[2], voffB[2];
#pragma unroll
    for (int i = 0; i < 2; ++i) { int R, C; stage_rc(tid * 16 + i * 8192, R, C); const int Rb = Epi::PERM ? ((R & ~31) + perm32(R & 31)) : R;
        voffA[i] = (unsigned)(R * LD + C) * 2u; voffB[i] = (unsigned)(Rb * LD + C) * 2u; }
    const size_t kstep = (size_t)(BK * 2);
    const size_t hstep = (size_t)HALF * LD * 2;
    const size_t tstep = 2 * hstep;
    const unsigned ldsw = (unsigned)wid * 1024u;
    const int aoff = lds_byte(wr * 64 + fr, fq * 8), boff = lds_byte(wc * 32 + fr, fq * 8);
#define PG8_SA(b, h) (((b) * 2 + (h)) * HTB)
#define PG8_SB(b, h) ((4 + (b) * 2 + (h)) * HTB)
#define PG8_STAGE(bufoff, gbase, voff) do { _Pragma("unroll") for (int _i = 0; _i < 2; ++_i) \
        __builtin_amdgcn_global_load_lds((const unsigned*)((const char*)(gbase) + (voff)[_i]), (PG8_LAS unsigned*)(lds + (bufoff) + ldsw + _i * 8192), 16, 0, 0); } while (0)
#define PG8_LD32(p) __builtin_shufflevector(*(const PG8_LAS i32x4*)(p), *(const PG8_LAS i32x4*)((p) + 1024), 0, 1, 2, 3, 4, 5, 6, 7)
#define PG8_LDA(dst, b, h) do { if constexpr (F8) { _Pragma("unroll") for (int m = 0; m < 4; ++m) dst##8[m] = PG8_LD32(lds + PG8_SA(b, h) + aoff + m * 2048); } else { \
        _Pragma("unroll") for (int m = 0; m < 4; ++m) _Pragma("unroll") for (int k = 0; k < 2; ++k) dst[m][k] = *(const PG8_LAS bf16x8*)(lds + PG8_SA(b, h) + aoff + m * 2048 + k * 1024); } } while (0)
#define PG8_LDB(dst, b, h) do { if constexpr (F8) { _Pragma("unroll") for (int n = 0; n < 2; ++n) dst##8[n] = PG8_LD32(lds + PG8_SB(b, h) + boff + n * 2048); } else { \
        _Pragma("unroll") for (int n = 0; n < 2; ++n) _Pragma("unroll") for (int k = 0; k < 2; ++k) dst[n][k] = *(const PG8_LAS bf16x8*)(lds + PG8_SB(b, h) + boff + n * 2048 + k * 1024); } } while (0)
#define PG8_MMA(ai, bj, At, Bt) do { __builtin_amdgcn_s_setprio(1); if constexpr (F8) { _Pragma("unroll") for (int m = 0; m < 4; ++m) _Pragma("unroll") for (int n = 0; n < 2; ++n) \
        asm("v_mfma_f32_16x16x128_f8f6f4 %0, %1, %2, %0" : "+v"(acc[ai][bj][m][n]) : "v"(Bt##8[n]), "v"(At##8[m])); } else { \
        _Pragma("unroll") for (int m = 0; m < 4; ++m) _Pragma("unroll") for (int n = 0; n < 2; ++n) _Pragma("unroll") for (int k = 0; k < 2; ++k) \
        acc[ai][bj][m][n] = __builtin_amdgcn_mfma_f32_16x16x32_bf16(Bt[n][k], At[m][k], acc[ai][bj][m][n], 0, 0, 0); } __builtin_amdgcn_s_setprio(0); } while (0)
#define PG8_WAIT_V(n) asm volatile("s_waitcnt vmcnt(" #n ")" ::: "memory")
#define PG8_WAIT_L(n) asm volatile("s_waitcnt lgkmcnt(" #n ")" ::: "memory")
#define PG8_BAR __builtin_amdgcn_s_barrier()
#define PG8_SCHED __builtin_amdgcn_sched_barrier(0)
    Unit cur, nxt; int ui = 0;
    if (!S.next(0, cur)) return;
    f32x4 acc[2][2][4][2];
#pragma unroll
    for (int a = 0; a < 2; ++a)
#pragma unroll
        for (int b = 0; b < 2; ++b)
#pragma unroll
            for (int m = 0; m < 4; ++m)
#pragma unroll
                for (int n = 0; n < 2; ++n) acc[a][b][m][n] = (f32x4){0.f, 0.f, 0.f, 0.f};
    bf16x8 At[4][2], B0[2][2], B1[2][2]; i32x8 At8[4], B08[2], B18[2];
    const char* cA = (const char*)g.A + (size_t)cur.pm * tstep + cur.koff; const char* cB = (const char*)g.Bt + (size_t)cur.pn * tstep + cur.koff;
    S.a_ready(cur);
    if constexpr (SP2) {
        PG8_STAGE(PG8_SB(0, 0), cB, voffB); PG8_STAGE(PG8_SB(0, 1), cB + hstep, voffB); PG8_STAGE(PG8_SA(0, 0), cA, voffA); PG8_STAGE(PG8_SA(0, 1), cA + hstep, voffA);
        if (wr == 1) PG8_BAR;
        PG8_WAIT_V(2); PG8_BAR;
        PG8_STAGE(PG8_SB(1, 0), cB + kstep, voffB); PG8_STAGE(PG8_SA(1, 0), cA + kstep, voffA); PG8_STAGE(PG8_SB(1, 1), cB + hstep + kstep, voffB);
        PG8_WAIT_V(6); PG8_BAR;
    } else {
        PG8_STAGE(PG8_SB(0, 0), cB, voffB); PG8_STAGE(PG8_SA(0, 0), cA, voffA); PG8_STAGE(PG8_SB(0, 1), cB + hstep, voffB); PG8_STAGE(PG8_SA(0, 1), cA + hstep, voffA);
        if (wr == 1) PG8_BAR;
        PG8_WAIT_V(4); PG8_BAR;
        PG8_STAGE(PG8_SB(1, 0), cB + kstep, voffB); PG8_STAGE(PG8_SA(1, 0), cA + kstep, voffA); PG8_STAGE(PG8_SB(1, 1), cB + hstep + kstep, voffB);
        PG8_WAIT_V(6); PG8_BAR;
    }
    for (;;) {
        const bool has_next = S.next(ui + 1, nxt);
        const char* nA = has_next ? (const char*)g.A + (size_t)nxt.pm * tstep + nxt.koff : cA; const char* nB = has_next ? (const char*)g.Bt + (size_t)nxt.pn * tstep + nxt.koff : cB;
#pragma clang loop unroll(disable)
        for (int t = 0; t < nt; t += 2) {
            const bool last = (t == nt - 2);
            const char* a1 = cA + (size_t)(t + 1) * kstep;
            const char* a2 = last ? nA : cA + (size_t)(t + 2) * kstep; const char* b2 = last ? nB : cB + (size_t)(t + 2) * kstep;
            const char* a3 = a2 + kstep; const char* b3 = b2 + kstep;
            if (last && has_next) S.a_ready(nxt);
            if constexpr (SP2) {
            PG8_LDB(B0, 0, 0); PG8_LDB(B1, 0, 1); PG8_SCHED; PG8_LDA(At, 0, 0); PG8_STAGE(PG8_SA(1, 1), a1 + hstep, voffA);
            PG8_WAIT_V(8); PG8_WAIT_L(0); PG8_BAR; PG8_MMA(0, 0, At, B0); PG8_MMA(0, 1, At, B1); PG8_BAR; PG8_SCHED;
            PG8_LDA(At, 0, 1); PG8_STAGE(PG8_SB(0, 0), b2, voffB); PG8_STAGE(PG8_SB(0, 1), b2 + hstep, voffB); PG8_STAGE(PG8_SA(0, 0), a2, voffA);
            PG8_WAIT_V(8); PG8_WAIT_L(0); PG8_BAR; PG8_MMA(1, 0, At, B0); PG8_MMA(1, 1, At, B1); PG8_BAR; PG8_SCHED;
            PG8_LDB(B0, 1, 0); PG8_LDB(B1, 1, 1); PG8_SCHED; PG8_LDA(At, 1, 0); PG8_STAGE(PG8_SA(0, 1), a2 + hstep, voffA);
            PG8_WAIT_V(8); PG8_WAIT_L(0); PG8_BAR; PG8_MMA(0, 0, At, B0); PG8_MMA(0, 1, At, B1); PG8_BAR; PG8_SCHED;
            PG8_LDA(At, 1, 1); PG8_STAGE(PG8_SB(1, 0), b3, voffB); PG8_STAGE(PG8_SB(1, 1), b3 + hstep, voffB); PG8_STAGE(PG8_SA(1, 0), a3, voffA);
            PG8_WAIT_V(8); PG8_WAIT_L(0); PG8_BAR; PG8_MMA(1, 0, At, B0); PG8_MMA(1, 1, At, B1); PG8_BAR; PG8_SCHED;
            } else {
            PG8_LDB(B0, 0, 0); PG8_SCHED; PG8_LDA(At, 0, 0); PG8_STAGE(PG8_SA(1, 1), a1 + hstep, voffA);
            PG8_WAIT_L(8); PG8_BAR; PG8_WAIT_L(0); PG8_MMA(0, 0, At, B0); PG8_BAR; PG8_SCHED;
            PG8_LDB(B1, 0, 1); PG8_STAGE(PG8_SB(0, 0), b2, voffB);
            PG8_BAR; PG8_WAIT_L(0); PG8_MMA(0, 1, At, B1); PG8_BAR;
            PG8_LDA(At, 0, 1); PG8_STAGE(PG8_SA(0, 0), a2, voffA);
            PG8_BAR; PG8_WAIT_L(0); PG8_MMA(1, 0, At, B0); PG8_BAR; PG8_SCHED;
            PG8_STAGE(PG8_SB(0, 1), b2 + hstep, voffB);
            PG8_WAIT_V(6); PG8_BAR; PG8_MMA(1, 1, At, B1); PG8_BAR;
            PG8_LDB(B0, 1, 0); PG8_SCHED; PG8_LDA(At, 1, 0); PG8_STAGE(PG8_SA(0, 1), a2 + hstep, voffA);
            PG8_WAIT_L(8); PG8_BAR; PG8_WAIT_L(0); PG8_MMA(0, 0, At, B0); PG8_BAR; PG8_SCHED;
            PG8_LDB(B1, 1, 1); PG8_STAGE(PG8_SB(1, 0), b3, voffB);
            PG8_BAR; PG8_WAIT_L(0); PG8_MMA(0, 1, At, B1); PG8_BAR;
            PG8_LDA(At, 1, 1); PG8_STAGE(PG8_SA(1, 0), a3, voffA);
            PG8_BAR; PG8_WAIT_L(0); PG8_MMA(1, 0, At, B0); PG8_BAR; PG8_SCHED;
            PG8_STAGE(PG8_SB(1, 1), b3 + hstep, voffB);
            PG8_WAIT_V(6); PG8_BAR; PG8_MMA(1, 1, At, B1); PG8_BAR;
            }
        }
        if constexpr (F8) asm volatile("s_nop 15\n\ts_nop 15" ::: "memory");
        if constexpr (ALIGN_EPI) { if (wr == 0) PG8_BAR; }
        if constexpr (!Epi::AFTER_DRAIN) { E(acc, cur, wr, wc, fr, fq); S.done(cur); }
        if (!has_next) break;
#pragma unroll
        for (int a = 0; a < 2; ++a)
#pragma unroll
            for (int b = 0; b < 2; ++b)
#pragma unroll
                for (int m = 0; m < 4; ++m)
#pragma unroll
                    for (int n = 0; n < 2; ++n) acc[a][b][m][n] = (f32x4){0.f, 0.f, 0.f, 0.f};
        cur = nxt; cA = nA; cB = nB; ++ui;
        if constexpr (ALIGN_EPI) { if (wr == 1) PG8_BAR; }
    }
    PG8_WAIT_V(0);
    if constexpr (!ALIGN_EPI) { if (wr == 0) PG8_BAR; }
    PG8_BAR;
    if constexpr (Epi::AFTER_DRAIN) { E.fused(acc, cur, wr, wc, fr, fq, lds, wid, lane); S.done(cur); }
#undef PG8_SA
#undef PG8_SB
#undef PG8_STAGE
#undef PG8_LDA
#undef PG8_LDB
#undef PG8_MMA
#undef PG8_LD32
#undef PG8_WAIT_V
#undef PG8_WAIT_L
#undef PG8_BAR
#undef PG8_SCHED
}
}

constexpr int NWAVES = 8;
constexpr int BATCH = 2, SEQ = 8192, D = 1024, M = BATCH * SEQ;
constexpr int HD = 128, NH = 8, NKV = 2, NIH = 8, IDX = 64, TOPK = 256;
constexpr int A_IN = 2120, FF = 2816, NE = 8;
constexpr int MAXSLOT = 34816;
constexpr float QSCALE = 0.12751743082459868f;
constexpr float SBSCALE = 0.08838834764831845f;
constexpr float WISCALE = 0.04419417382415922f;
constexpr size_t MiB = 1u << 20;
constexpr size_t WS_CTL = 0, CTL_ZERO_BYTES = 1 * MiB;
constexpr size_t WS_WIN = 2 * MiB, WS_WTAIL = 6 * MiB, WS_WOA = 7 * MiB, WS_WGU = 9 * MiB, WS_WD = 20 * MiB, WS_WKVQ = 26 * MiB, WS_WOB = 32 * MiB, WS_WGUM = 34 * MiB, WS_WDM = 122 * MiB;
constexpr size_t WS_H = 166 * MiB, WS_XB = 230 * MiB, WS_SS0 = 262 * MiB, WS_SS1 = 263 * MiB, WS_SS2 = 264 * MiB, WS_SS3 = 265 * MiB;
constexpr size_t WS_T = 266 * MiB;
constexpr size_t WS_PROJ = WS_T, WS_QF = 330 * MiB, WS_KVF = 362 * MiB, WS_QIF = 378 * MiB, WS_KIF = 394 * MiB, WS_WIF = 396 * MiB, WS_SEL = 397 * MiB, WS_AO = 413 * MiB;
constexpr size_t WS_HF = WS_T, WS_KQ = WS_T, WS_VT = 330 * MiB;
constexpr size_t WS_XPERM = WS_T, WS_HM = 334 * MiB, WS_Y = 521 * MiB;
constexpr size_t WS_RT = 590 * MiB;
constexpr size_t WS_END = 591 * MiB;
constexpr int CW_CNT = 64;
constexpr int CW_P3Q = 192;
constexpr int CW_BAR = 4096;
constexpr int RING_BYTES = 131072, LDSCTL_OFF = RING_BYTES, MISC_OFF = LDSCTL_OFF + 320, LDS_BYTES = 147456;

#define GAS __attribute__((address_space(1)))
#define LAS __attribute__((address_space(3)))
typedef unsigned short bf16;
typedef unsigned v4u __attribute__((ext_vector_type(4)));
typedef unsigned v2u __attribute__((ext_vector_type(2)));
typedef float f32x4 __attribute__((ext_vector_type(4)));
typedef short bf16x8 __attribute__((ext_vector_type(8)));
typedef float f32x16 __attribute__((ext_vector_type(16)));
typedef GAS unsigned gu32;
#define RLX_AGENT __ATOMIC_RELAXED, __HIP_MEMORY_SCOPE_AGENT
#define LDS_WAIT() asm volatile("s_waitcnt lgkmcnt(0)" ::: "memory")
#define VM_WAIT() asm volatile("s_waitcnt vmcnt(0)" ::: "memory")
__device__ __forceinline__ unsigned f2bf(float f) { unsigned u = __builtin_bit_cast(unsigned, f); return (u + 0x7fffu + ((u >> 16) & 1u)) >> 16; }
__device__ __forceinline__ unsigned pk2(float lo, float hi) { return f2bf(lo) | (f2bf(hi) << 16); }
__device__ __forceinline__ float bflo(unsigned w) { return __uint_as_float(w << 16); }
__device__ __forceinline__ float bfhi(unsigned w) { return __uint_as_float(w & 0xffff0000u); }
__device__ __forceinline__ float wave_sum(float v) {
#pragma unroll
    for (int o = 1; o < 64; o <<= 1) v += __shfl_xor(v, o);
    return v;
}
__device__ __forceinline__ float wave_max(float v) {
#pragma unroll
    for (int o = 1; o < 64; o <<= 1) v = fmaxf(v, __shfl_xor(v, o));
    return v;
}
__device__ __forceinline__ void sincos_acc(float a, float& c, float& s) {
    const double x = (double)a; const double n = __builtin_rint(x * 0.63661977236758134308);
    const double r = __builtin_fma(-n, 6.123233995736766035869e-17, __builtin_fma(-n, 1.57079632679489655800, x)); const double r2 = r * r;
    double sn = 1.0 - r2 * (1.0 / 156.0); sn = 1.0 - r2 * (1.0 / 110.0) * sn; sn = 1.0 - r2 * (1.0 / 72.0) * sn; sn = 1.0 - r2 * (1.0 / 42.0) * sn; sn = 1.0 - r2 * (1.0 / 20.0) * sn; sn = 1.0 - r2 * (1.0 / 6.0) * sn; sn *= r;
    double cs = 1.0 - r2 * (1.0 / 182.0); cs = 1.0 - r2 * (1.0 / 132.0) * cs; cs = 1.0 - r2 * (1.0 / 90.0) * cs; cs = 1.0 - r2 * (1.0 / 56.0) * cs; cs = 1.0 - r2 * (1.0 / 30.0) * cs; cs = 1.0 - r2 * (1.0 / 12.0) * cs; cs = 1.0 - r2 * 0.5 * cs;
    const int q = ((int)n) & 3;
    const double cq = (q == 0) ? cs : (q == 1) ? -sn : (q == 2) ? -cs : sn;
    const double sq = (q == 0) ? sn : (q == 1) ? cs : (q == 2) ? -sn : -cs;
    c = (float)cq; s = (float)sq;
}
__device__ const float INV_Q[16] = {1.000000000e+00f, 4.403665960e-01f, 1.939227432e-01f, 8.539710194e-02f, 3.760603070e-02f, 1.656043902e-02f, 7.292664610e-03f, 3.211445874e-03f,
                                    1.414213562e-03f, 6.227723788e-04f, 2.742481884e-04f, 1.207697351e-04f, 5.318296098e-05f, 2.341999971e-05f, 1.031338616e-05f, 4.541670478e-06f};
__device__ const float INV_I[8] = {1.000000000e+00f, 1.939227432e-01f, 3.760603070e-02f, 7.292664610e-03f, 1.414213562e-03f, 2.742481884e-04f, 5.318296098e-05f, 1.031338616e-05f};

#define XB_TMO      128
#define XB_XCNT(j)  (256  + 64 * (j))
#define XB_XSUB(j)  (1280 + 64 * (j))
#define XB_XGEN(j)  (2304 + 64 * (j))
#define XB_TOP      3328
#define XB_TOPGEN   3392
#define XCD_BAR_WORDS 3456
#define XB_SPIN_CAP (1u << 18)

__device__ __forceinline__ unsigned xb_ld(unsigned* p)              { return __hip_atomic_load(p, __ATOMIC_RELAXED, __HIP_MEMORY_SCOPE_AGENT); }
__device__ __forceinline__ unsigned xb_add(unsigned* p, unsigned v) { return __hip_atomic_fetch_add(p, v, __ATOMIC_RELAXED, __HIP_MEMORY_SCOPE_AGENT); }
__device__ __forceinline__ unsigned xb_xcc_id() { return (unsigned)__builtin_amdgcn_s_getreg((3 << 11) | 20) & 0xFu; }
#define XB_SPIN(cond, bar) do { unsigned _sp = 0; while (cond) { __builtin_amdgcn_s_sleep(1); \
    if ((++_sp & 255u) == 0u) { if (xb_ld(&(bar)[XB_TMO])) break; if (_sp > XB_SPIN_CAP) { atomicAdd(&(bar)[XB_TMO], 1u); break; } } } } while (0)

struct XcdBarrier {
    unsigned* bar; unsigned x;
    volatile LAS unsigned* st;
};

__device__ __forceinline__ XcdBarrier xcd_barrier_post(unsigned* bar, volatile LAS unsigned* st) {
    XcdBarrier b; b.bar = bar; b.x = xb_xcc_id(); b.st = st;
    if (threadIdx.x == 0) (void)xb_add(&bar[XB_XCNT(b.x)], 1u);
    return b;
}
__device__ __forceinline__ void xcd_barrier_complete(unsigned* bar, unsigned x, unsigned& nloc, unsigned& nx) {
    const unsigned G = gridDim.x * gridDim.y * gridDim.z;
    unsigned sum, cnt, mine, sp = 0u;
    for (;;) {
        sum = 0u; cnt = 0u; mine = 0u;
#pragma unroll
        for (unsigned j = 0; j < 16; ++j) { const unsigned c = xb_ld(&bar[XB_XCNT(j)]); sum += c; cnt += (c > 0u) ? 1u : 0u; mine = (j == x) ? c : mine; }
        if (sum == G) break;
        __builtin_amdgcn_s_sleep(1);
        if ((++sp & 255u) == 0u) { if (xb_ld(&bar[XB_TMO])) break; if (sp > XB_SPIN_CAP) { atomicAdd(&bar[XB_TMO], 1u); break; } }
    }
    nloc = mine > 0u ? mine : 1u; nx = cnt > 0u ? cnt : 1u;
}

__device__ __forceinline__ void xcd_barrier(const XcdBarrier& b) {
    asm volatile("s_waitcnt vmcnt(0)" ::: "memory");
    __syncthreads();
    if (threadIdx.x == 0) {
        unsigned* bar = b.bar;
        __builtin_amdgcn_s_waitcnt(0);
        unsigned nloc = b.st[0], nx = b.st[1];
        if (nloc == 0u) { xcd_barrier_complete(bar, b.x, nloc, nx); b.st[0] = nloc; b.st[1] = nx; }
        const unsigned old = xb_add(&bar[XB_XSUB(b.x)], 1u);
        const unsigned gen = old / nloc;
        if (old + 1u == (gen + 1u) * nloc) {
            __builtin_amdgcn_fence(__ATOMIC_RELEASE, "agent");
            asm volatile("s_waitcnt vmcnt(0)" ::: "memory");
            const unsigned og = xb_add(&bar[XB_TOP], 1u);
            const unsigned tg = og / nx;
            if (og + 1u == (tg + 1u) * nx) xb_add(&bar[XB_TOPGEN], 1u);
            else XB_SPIN(xb_ld(&bar[XB_TOPGEN]) == tg, bar);
            __builtin_amdgcn_fence(__ATOMIC_ACQUIRE, "agent");
            xb_add(&bar[XB_XGEN(b.x)], 1u);
            asm volatile("s_waitcnt vmcnt(0)" ::: "memory");
        } else {
            XB_SPIN(xb_ld(&bar[XB_XGEN(b.x)]) == gen, bar);
            __builtin_amdgcn_fence(__ATOMIC_ACQUIRE, "agent");
            asm volatile("s_waitcnt vmcnt(0)" ::: "memory");
        }
    }
    __syncthreads();
}

struct Frame {
    LAS unsigned char* lds;
    volatile LAS unsigned* MISC;
    gu32* ctl;
    int tid, lane, wave, G, bid;
    const float* in[17];
    float* out; unsigned char* ws;
};
enum { IN_X = 0, IN_ANORM, IN_AWIN, IN_AQN, IN_AKN, IN_AWOUT, IN_KVNORM, IN_KVW, IN_BNORM, IN_BWQ, IN_BWOUT, IN_FFNNORM, IN_DGU, IN_DDN, IN_ROUTER, IN_MGU, IN_MDN };

struct TrItem { const float* W; size_t ldw; int K, k0, csrc0, cend; bf16* WT; int drow0; const float* gain; float scale; int f8; };
__device__ __forceinline__ int gu_row(int c0) { return (c0 < FF) ? ((c0 >> 7) * 256 + (c0 & 127)) : (((c0 - FF) >> 7) * 256 + 128 + ((c0 - FF) & 127)); }
constexpr int I_WIN = 16 * 32, I_TAIL = 16 * 2, I_SQ = 16 * 16, I_GU = 16 * 88, I_DN = 44 * 16, I_KV = 16 * 32;
constexpr int TR_NITEMS = I_WIN + I_TAIL + I_SQ + I_GU + I_DN + I_KV + I_SQ + I_SQ + NE * I_GU + NE * I_DN;
__device__ __forceinline__ TrItem tr_decode(const Frame& F, int it) {
    unsigned char* ws = F.ws; int r = it; TrItem t;
    if (r < I_WIN) { const int kb = r / 32, nb = r % 32; t = TrItem{F.in[IN_AWIN], (size_t)A_IN, D, 64 * kb, 64 * nb, A_IN, (bf16*)(ws + WS_WIN), 64 * nb, F.in[IN_ANORM], 1.f}; return t; } r -= I_WIN;
    if (r < I_TAIL) { const int kb = r / 2, nb = r % 2; t = TrItem{F.in[IN_AWIN], (size_t)A_IN, D, 64 * kb, 2048 + 64 * nb, A_IN, (bf16*)(ws + WS_WTAIL), 64 * nb, F.in[IN_ANORM], 1.f}; return t; } r -= I_TAIL;
    if (r < I_SQ) { const int kb = r / 16, nb = r % 16; t = TrItem{F.in[IN_AWOUT], (size_t)D, D, 64 * kb, 64 * nb, D, (bf16*)(ws + WS_WOA), 64 * nb, nullptr, 1.f}; return t; } r -= I_SQ;
    if (r < I_GU) { const int kb = r / 88, nb = r % 88; t = TrItem{F.in[IN_DGU], (size_t)(2 * FF), D, 64 * kb, 64 * nb, 2 * FF, (bf16*)(ws + WS_WGU), gu_row(64 * nb), F.in[IN_FFNNORM], pg8::F8_SWGU, 1}; return t; } r -= I_GU;
    if (r < I_DN) { const int kb = r / 16, nb = r % 16; t = TrItem{F.in[IN_DDN], (size_t)D, FF, 64 * kb, 64 * nb, D, (bf16*)(ws + WS_WD), 64 * nb, nullptr, pg8::F8_SWD, 1}; return t; } r -= I_DN;
    if (r < I_KV) { const int kb = r / 32, nb = r % 32; t = TrItem{F.in[IN_KVW], (size_t)(2 * D), D, 64 * kb, 64 * nb, 2 * D, (bf16*)(ws + WS_WKVQ), (nb < 16) ? 64 * nb : 1024 + 64 * nb, F.in[IN_KVNORM], 1.f}; return t; } r -= I_KV;
    if (r < I_SQ) { const int kb = r / 16, nb = r % 16; t = TrItem{F.in[IN_BWQ], (size_t)D, D, 64 * kb, 64 * nb, D, (bf16*)(ws + WS_WKVQ), 1024 + 64 * nb, F.in[IN_BNORM], SBSCALE}; return t; } r -= I_SQ;
    if (r < I_SQ) { const int kb = r / 16, nb = r % 16; t = TrItem{F.in[IN_BWOUT], (size_t)D, D, 64 * kb, 64 * nb, D, (bf16*)(ws + WS_WOB), 64 * nb, nullptr, 1.f}; return t; } r -= I_SQ;
    if (r < NE * I_GU) { const int e = r / I_GU, rr = r % I_GU, kb = rr / 88, nb = rr % 88;
        t = TrItem{F.in[IN_MGU] + (size_t)e * D * 2 * FF, (size_t)(2 * FF), D, 64 * kb, 64 * nb, 2 * FF, (bf16*)(ws + WS_WGUM), e * 2 * FF + gu_row(64 * nb), F.in[IN_FFNNORM] + D, pg8::F8_SWGU, 1}; return t; } r -= NE * I_GU;
    { const int e = r / I_DN, rr = r % I_DN, kb = rr / 16, nb = rr % 16;
      t = TrItem{F.in[IN_MDN] + (size_t)e * FF * D, (size_t)D, FF, 64 * kb, 64 * nb, D, (bf16*)(ws + WS_WDM), e * D + 64 * nb, nullptr, pg8::F8_SWD, 1}; return t; }
}
__device__ __forceinline__ void tr_load(const TrItem& t, f32x4 (&v)[16], int lane) {
    const int r = lane >> 4, c = t.csrc0 + 4 * (lane & 15); const bool ok = c < t.cend; const float* src = t.W + (size_t)(t.k0 + r) * t.ldw + (ok ? c : 0);
#pragma unroll
    for (int i = 0; i < 16; ++i) { const f32x4 x = __builtin_nontemporal_load((const f32x4*)(src + (size_t)(4 * i) * t.ldw)); v[i] = ok ? x : (f32x4){0.f, 0.f, 0.f, 0.f}; }
}
__device__ __forceinline__ void tr_store(const TrItem& t, const f32x4 (&v)[16], LAS float* scr, int lane) {
    const int r = lane >> 4, c4 = lane & 15;
#pragma unroll
    for (int i = 0; i < 16; ++i) { const int k = 4 * i + r; const float g = t.gain ? t.gain[t.k0 + k] * t.scale : t.scale;
        *(LAS f32x4*)(scr + k * 64 + 4 * (c4 ^ ((k >> 3) & 7))) = v[i] * g; }
    LDS_WAIT(); asm volatile("" ::: "memory");
    if (t.f8) {
        const int c4b = lane & 3;
#pragma unroll
        for (int j = 0; j < 4; ++j) { const int n = (lane >> 2) + 16 * j;
            const LAS float* s0 = scr + (16 * c4b) * 64 + (n ^ ((2 * c4b) << 2)); const LAS float* s1 = scr + (16 * c4b + 8) * 64 + (n ^ ((2 * c4b + 1) << 2));
            v4u o; o.x = pg8::pk4_fp8(s0[0 * 64], s0[1 * 64], s0[2 * 64], s0[3 * 64]); o.y = pg8::pk4_fp8(s0[4 * 64], s0[5 * 64], s0[6 * 64], s0[7 * 64]);
            o.z = pg8::pk4_fp8(s1[0 * 64], s1[1 * 64], s1[2 * 64], s1[3 * 64]); o.w = pg8::pk4_fp8(s1[4 * 64], s1[5 * 64], s1[6 * 64], s1[7 * 64]);
            *(GAS v4u*)((unsigned char*)t.WT + (size_t)(t.drow0 + n) * t.K + t.k0 + 16 * c4b) = o; }
    } else {
    const int c8 = lane & 7;
#pragma unroll
    for (int j = 0; j < 8; ++j) { const int n = (lane >> 3) + 8 * j; const LAS float* s = scr + (8 * c8) * 64 + (n ^ (c8 << 2));
        v4u o; o.x = pk2(s[0 * 64], s[1 * 64]); o.y = pk2(s[2 * 64], s[3 * 64]); o.z = pk2(s[4 * 64], s[5 * 64]); o.w = pk2(s[6 * 64], s[7 * 64]);
        *(GAS v4u*)(t.WT + (size_t)(t.drow0 + n) * t.K + t.k0 + 8 * c8) = o; }
    }
    LDS_WAIT(); asm volatile("" ::: "memory");
}
__device__ __forceinline__ void p0_prologue(Frame& F) {
    LAS float* scr = (LAS float*)(F.lds + F.wave * 16384);
    const int gw = F.wave * F.G + F.bid, NGW = F.G * NWAVES;
    unsigned char* ws = F.ws;
    {
        f32x4 va[16], vb[16];
        int it = gw;
        if (it < TR_NITEMS) { TrItem cur = tr_decode(F, it); tr_load(cur, va, F.lane);
            for (;;) {
                const int nx = it + NGW; const bool has = nx < TR_NITEMS; TrItem nxt = cur;
                if (has) { nxt = tr_decode(F, nx); tr_load(nxt, vb, F.lane); }
                tr_store(cur, va, scr, F.lane);
                if (!has) break;
                it = nx + NGW; const bool has2 = it < TR_NITEMS; TrItem nn = nxt;
                if (has2) { nn = tr_decode(F, it); tr_load(nn, va, F.lane); }
                tr_store(nxt, vb, scr, F.lane);
                if (!has2) break;
                cur = nn;
            }
        }
    }
    const float* x = F.in[IN_X]; bf16* XB = (bf16*)(ws + WS_XB);
    for (int m = gw; m < M; m += NGW) {
        const GAS f32x4* xr = (const GAS f32x4*)(x + (size_t)m * D) + F.lane; f32x4 v[4]; float s = 0.f;
#pragma unroll
        for (int j = 0; j < 4; ++j) { v[j] = xr[64 * j]; s += (v[j].x * v[j].x + v[j].y * v[j].y) + (v[j].z * v[j].z + v[j].w * v[j].w); }
        s = wave_sum(s); const float rs = 1.0f / sqrtf(s * (1.0f / 1024.0f) + 1e-6f);
        GAS unsigned long long* o8 = (GAS unsigned long long*)(XB + (size_t)m * D) + F.lane;
#pragma unroll
        for (int j = 0; j < 4; ++j) o8[64 * j] = (unsigned long long)pk2(v[j].x * rs, v[j].y * rs) | ((unsigned long long)pk2(v[j].z * rs, v[j].w * rs) << 32);
    }
}

#define WAVE_SYNC() asm volatile("s_waitcnt lgkmcnt(0)" ::: "memory")
__device__ __forceinline__ void rope8(float (&y)[8], bool isx1, bool isx2, int i0, int pshift, LAS const float* tab) {
#pragma unroll
    for (int e = 0; e < 8; ++e) {
        const float other = __shfl_xor(y[e], pshift); const float c = tab[2 * (i0 + e)], s = tab[2 * (i0 + e) + 1];
        y[e] = isx1 ? (y[e] * c - other * s) : (isx2 ? (y[e] * c + other * s) : y[e]);
    }
}
__device__ __forceinline__ size_t kif_off(int grow, int d) { return ((((size_t)(grow >> 5) * 4 + ((d >> 3) & 3)) * 2 + (d >> 5)) * 32 + (grow & 31)) * 8 + (d & 7); }
__device__ __forceinline__ void unpack8(const v4u w, float (&y)[8]) { y[0] = bflo(w.x); y[1] = bfhi(w.x); y[2] = bflo(w.y); y[3] = bfhi(w.y); y[4] = bflo(w.z); y[5] = bfhi(w.z); y[6] = bflo(w.w); y[7] = bfhi(w.w); }
__device__ __forceinline__ v4u pack8(const float (&y)[8]) { v4u o; o.x = pk2(y[0], y[1]); o.y = pk2(y[2], y[3]); o.z = pk2(y[4], y[5]); o.w = pk2(y[6], y[7]); return o; }
__device__ __forceinline__ void p2_post(Frame& F) {
    unsigned char* ws = F.ws; const int lane = F.lane;
    const bf16* PROJ = (const bf16*)(ws + WS_PROJ); const bf16* XB = (const bf16*)(ws + WS_XB); const bf16* WT = (const bf16*)(ws + WS_WTAIL);
    bf16* QF = (bf16*)(ws + WS_QF); bf16* KVF = (bf16*)(ws + WS_KVF); bf16* QIF = (bf16*)(ws + WS_QIF); bf16* KIF = (bf16*)(ws + WS_KIF); float* WIF = (float*)(ws + WS_WIF);
    const float* qnw = F.in[IN_AQN]; const float* knw = F.in[IN_AKN];
    LAS float* tab = (LAS float*)(F.lds + F.wave * 256);
    const int gw = F.wave * F.G + F.bid, NGW = F.G * NWAVES;
    for (int task = gw; task < M / 8; task += NGW) {
        const int row0 = task * 8;
        f32x4 acc[5];
#pragma unroll
        for (int c = 0; c < 5; ++c) acc[c] = (f32x4){0.f, 0.f, 0.f, 0.f};
        const bf16* ap = XB + (size_t)(row0 + (lane & 7)) * D + 8 * (lane >> 4);
        const bf16* bp = WT + (size_t)(lane & 15) * D + 8 * (lane >> 4);
#pragma unroll 4
        for (int j = 0; j < 32; ++j) {
            const bf16x8 a = *(const bf16x8*)(ap + 32 * j);
#pragma unroll
            for (int c = 0; c < 5; ++c) { const bf16x8 b = *(const bf16x8*)(bp + (size_t)(16 * c) * D + 32 * j); acc[c] = __builtin_amdgcn_mfma_f32_16x16x32_bf16(a, b, acc[c], 0, 0, 0); }
        }
        if (lane < 32) {
#pragma unroll
            for (int reg = 0; reg < 4; ++reg) {
                const int row = row0 + 4 * (lane >> 4) + reg; const float rs = 1.0f; const float pos = (float)(row & (SEQ - 1));
                const int d = lane & 15;
                float v0 = acc[0][reg] * rs; const float other = __shfl_xor(v0, 8);
                { float c, s; sincos_acc(pos * INV_I[d & 7], c, s); v0 = (d < 8) ? (v0 * c - other * s) : (v0 * c + other * s); }
                KIF[kif_off(row, d)] = (bf16)f2bf(v0);
#pragma unroll
                for (int c = 1; c < 4; ++c) KIF[kif_off(row, 16 * c + d)] = (bf16)f2bf(acc[c][reg] * rs);
                if (d < 8) WIF[(size_t)row * 8 + d] = acc[4][reg] * rs * WISCALE;
            }
        }
        for (int r = 0; r < 8; ++r) {
            const int row = row0 + r, b = row >> 13, t = row & (SEQ - 1); const float pos = (float)t;
            const bf16* pr = PROJ + (size_t)row * 2048 + 8 * lane;
            v4u w[4];
#pragma unroll
            for (int j = 0; j < 4; ++j) w[j] = __builtin_nontemporal_load((const v4u*)(pr + 512 * j));
            if (lane < 24) { float c, s; sincos_acc(pos * ((lane < 16) ? INV_Q[lane & 15] : INV_I[lane & 7]), c, s); tab[2 * lane] = c; tab[2 * lane + 1] = s; }
            WAVE_SYNC();
#pragma unroll
            for (int j = 0; j < 2; ++j) {
                float y[8]; unpack8(w[j], y); float ss = 0.f;
#pragma unroll
                for (int e = 0; e < 8; ++e) ss += y[e] * y[e];
                ss += __shfl_xor(ss, 1); ss += __shfl_xor(ss, 2); ss += __shfl_xor(ss, 4); ss += __shfl_xor(ss, 8);
                const float rs = 1.0f / sqrtf(ss * (1.0f / 128.0f) + 1e-6f); const int c8 = (lane & 15) * 8;
#pragma unroll
                for (int e = 0; e < 8; ++e) y[e] = y[e] * rs * qnw[c8 + e];
                rope8(y, c8 < 16, c8 >= 16 && c8 < 32, c8 & 15, 2, tab);
#pragma unroll
                for (int e = 0; e < 8; ++e) y[e] *= QSCALE;
                *(v4u*)(QF + (size_t)row * D + 512 * j + 8 * lane) = pack8(y);
            }
            {
                float y[8]; unpack8(w[2], y); float ss = 0.f;
#pragma unroll
                for (int e = 0; e < 8; ++e) ss += y[e] * y[e];
                ss += __shfl_xor(ss, 1); ss += __shfl_xor(ss, 2); ss += __shfl_xor(ss, 4); ss += __shfl_xor(ss, 8);
                const bool isk = lane < 32; const float rs = 1.0f / sqrtf(ss * (1.0f / 128.0f) + 1e-6f); const int c8 = (lane & 15) * 8;
                if (isk) {
#pragma unroll
                    for (int e = 0; e < 8; ++e) y[e] = y[e] * rs * knw[c8 + e];
                }
                rope8(y, isk && c8 < 16, isk && c8 >= 16 && c8 < 32, c8 & 15, 2, tab);
                const int kvh = (lane >> 4) & 1;
                int w0 = __builtin_amdgcn_cvt_pk_fp8_f32(y[0], y[1], 0, false); w0 = __builtin_amdgcn_cvt_pk_fp8_f32(y[2], y[3], w0, true);
                int w1 = __builtin_amdgcn_cvt_pk_fp8_f32(y[4], y[5], 0, false); w1 = __builtin_amdgcn_cvt_pk_fp8_f32(y[6], y[7], w1, true);
                *(v2u*)((unsigned char*)KVF + ((size_t)(b * NKV + kvh) * SEQ + t) * 256 + (isk ? 0 : 128) + c8) = (v2u){(unsigned)w0, (unsigned)w1};
            }
            {
                float y[8]; unpack8(w[3], y); const int c8 = (lane & 7) * 8;
                rope8(y, c8 == 0, c8 == 8, 16, 1, tab);
                *(v4u*)(QIF + (size_t)row * 512 + 8 * lane) = pack8(y);
            }
            WAVE_SYNC();
        }
    }
}

__device__ __forceinline__ unsigned f2key(float f) { const unsigned u = __float_as_uint(f); return (u & 0x80000000u) ? ~u : (u | 0x80000000u); }
__device__ __forceinline__ void p3_query_naive(unsigned char* ws, LAS unsigned char* lds, int row, int* SEL) {
    const int tid = threadIdx.x, lane = tid & 63, wave = tid >> 6;
    const bf16* QIF = (const bf16*)(ws + WS_QIF); const bf16* KIF = (const bf16*)(ws + WS_KIF); const float* WIF = (const float*)(ws + WS_WIF);
    LAS unsigned* keys = (LAS unsigned*)lds;
    LAS float* qis = (LAS float*)(lds + 32768);
    LAS float* wl = (LAS float*)(lds + 32768 + 2048);
    LAS unsigned* hist = (LAS unsigned*)(lds + 36864);
    LAS unsigned* ctl = (LAS unsigned*)(lds + 36864 + 1024);
    LAS unsigned* wcnt = (LAS unsigned*)(lds + 36864 + 1024 + 64);
    {
        const int b = row >> 13, t = row & (SEQ - 1), n = t + 1;
        int* sel = SEL + (size_t)row * TOPK;
        if (n <= TOPK) { if (tid < TOPK) sel[tid] = tid < n ? tid : 0; return; }
        __syncthreads();
        qis[tid] = __uint_as_float((unsigned)QIF[(size_t)row * 512 + tid] << 16);
        if (tid < 8) wl[tid] = WIF[(size_t)row * 8 + tid];
        __syncthreads();
        for (int s = tid; s < n; s += 512) {
            const int grow = (b << 13) + s;
            float kf[64];
#pragma unroll
            for (int j = 0; j < 8; ++j) { const v4u w = *(const v4u*)(KIF + kif_off(grow, 8 * j)); kf[8 * j] = bflo(w.x); kf[8 * j + 1] = bfhi(w.x); kf[8 * j + 2] = bflo(w.y); kf[8 * j + 3] = bfhi(w.y); kf[8 * j + 4] = bflo(w.z); kf[8 * j + 5] = bfhi(w.z); kf[8 * j + 6] = bflo(w.w); kf[8 * j + 7] = bfhi(w.w); }
            float sc = 0.f;
#pragma unroll
            for (int h = 0; h < 8; ++h) { float d = 0.f; asm volatile("" ::: "memory");
#pragma unroll
                for (int dd = 0; dd < 64; ++dd) d += qis[h * 64 + dd] * kf[dd];
                sc += wl[h] * fmaxf(d, 0.f); }
            keys[s] = f2key(sc + 0.0f);
        }
        __syncthreads();
        unsigned prefix = 0u, mask = 0u, need = TOPK;
        for (int pass = 0; pass < 4; ++pass) {
            const int shift = 24 - 8 * pass;
            if (tid < 256) hist[tid] = 0u;
            __syncthreads();
            for (int s = tid; s < n; s += 512) { const unsigned k = keys[s]; if ((k & mask) == prefix) __hip_atomic_fetch_add(&hist[(k >> shift) & 255u], 1u, __ATOMIC_RELAXED, __HIP_MEMORY_SCOPE_WORKGROUP); }
            __syncthreads();
            if (tid < 64) {
                const unsigned h0 = hist[4 * lane], h1 = hist[4 * lane + 1], h2 = hist[4 * lane + 2], h3 = hist[4 * lane + 3]; const unsigned tot = h0 + h1 + h2 + h3;
                unsigned incl = tot;
#pragma unroll
                for (int o = 1; o < 64; o <<= 1) { const unsigned v = __shfl_down(incl, o); if (lane + o < 64) incl += v; }
                const unsigned above = incl - tot;
                if (above < need && need <= above + tot) {
                    unsigned a = above; unsigned bin;
                    if (a + h3 >= need) bin = 3; else { a += h3; if (a + h2 >= need) bin = 2; else { a += h2; if (a + h1 >= need) bin = 1; else { a += h1; bin = 0; } } }
                    ctl[0] = 4 * lane + bin; ctl[1] = need - a;
                }
            }
            __syncthreads();
            prefix |= ctl[0] << shift; mask |= 255u << shift; need = ctl[1];
            __syncthreads();
        }
        const unsigned thr = prefix, n_gt = TOPK - need;
        unsigned base_gt = 0u, base_eq = 0u;
        for (int s0 = 0; s0 < n; s0 += 512) {
            const int s = s0 + tid; const unsigned k = s < n ? keys[s] : 0u; const bool gt = (s < n) && (k > thr); const bool eq = (s < n) && (k == thr);
            const unsigned long long bg = __ballot(gt), be = __ballot(eq); const unsigned long long lt = (1ull << lane) - 1ull;
            const unsigned rg = __popcll(bg & lt), re = __popcll(be & lt);
            if (lane == 0) { wcnt[wave] = __popcll(bg); wcnt[8 + wave] = __popcll(be); }
            __syncthreads();
            unsigned og = base_gt, oe = base_eq, tg = 0u, te = 0u;
#pragma unroll
            for (int w = 0; w < 8; ++w) { const unsigned cg = wcnt[w], ce = wcnt[8 + w]; if (w < wave) { og += cg; oe += ce; } tg += cg; te += ce; }
            if (gt) sel[og + rg] = s;
            if (eq && oe + re < need) sel[n_gt + oe + re] = s;
            base_gt += tg; base_eq += te;
            __syncthreads();
        }
    }
}

constexpr int P3_HIST = 0, P3_H2 = 65536, P3_BM = 98304, P3_QS = 114688, P3_FLAG = P3_QS + 512, P3_CAP = 512;
__device__ __forceinline__ void find_bin_2048(LAS const unsigned* hist, unsigned need, int lane, unsigned& bin_out, unsigned& need_out, unsigned& cnt_out, bool& ok) {
    unsigned w[16]; unsigned tot = 0u;
#pragma unroll
    for (int i = 0; i < 16; ++i) { w[i] = hist[16 * lane + i]; tot += (w[i] & 0xffffu) + (w[i] >> 16); }
    unsigned incl = tot;
#pragma unroll
    for (int o = 1; o < 64; o <<= 1) { const unsigned v = __shfl_down(incl, o); if (lane + o < 64) incl += v; }
    const unsigned above = incl - tot;
    const bool mine = (above < need) && (need <= above + tot);
    unsigned a = above, fb = 0u, fn = 0u, fc = 0u; bool found = false;
#pragma unroll
    for (int i = 15; i >= 0; --i) {
        const unsigned h1 = w[i] >> 16, h0 = w[i] & 0xffffu;
        if (!found) { if (a + h1 >= need) { found = true; fb = 32u * lane + 2u * i + 1u; fn = need - a; fc = h1; } else a += h1; }
        if (!found) { if (a + h0 >= need) { found = true; fb = 32u * lane + 2u * i; fn = need - a; fc = h0; } else a += h0; }
    }
    const unsigned long long bm = __ballot(mine);
    ok = (bm != 0ull);
    const int src = ok ? (__ffsll((long long)bm) - 1) : 0;
    bin_out = (unsigned)__builtin_amdgcn_readlane((int)fb, src); need_out = (unsigned)__builtin_amdgcn_readlane((int)fn, src); cnt_out = (unsigned)__builtin_amdgcn_readlane((int)fc, src);
}
__device__ __forceinline__ unsigned bin11(float sc) { const unsigned u = __float_as_uint(sc); const int m = (int)((u & 0x7fffffffu) >> 17) - 7360; const unsigned mc = (unsigned)(m < 0 ? 0 : (m > 1023 ? 1023 : m)); return (u >> 31) ? (1023u - mc) : (1024u + mc); }
__device__ __forceinline__ float relu_i(float x) { const int xi = __builtin_bit_cast(int, x); const int ri = (xi < 0) ? 0 : xi; return __builtin_bit_cast(float, ri); }
#define RELU(x) relu_i(x)
typedef _Float16 f16x8 __attribute__((ext_vector_type(8)));
typedef short s16x2 __attribute__((ext_vector_type(2)));
__device__ __forceinline__ unsigned pk_relu_f16(float a, float b) { const s16x2 h = __builtin_bit_cast(s16x2, __builtin_amdgcn_cvt_pkrtz(a, b)); return __builtin_bit_cast(unsigned, __builtin_elementwise_max(h, (s16x2){0, 0})); }
template <int PASS> __device__ __forceinline__ void p3_score_pass(const bf16x8 (&af)[2][4], const f16x8 (&wa)[2][2], const bf16* kib, int t0, int nt, int wave, int n, int hi,
                                                                  LAS unsigned char* lds, const unsigned (&thr)[2][2], int rot) {
    LAS unsigned* HIST = (LAS unsigned*)(lds + P3_HIST); LAS unsigned* BM = (LAS unsigned*)(lds + P3_BM); LAS unsigned* QS = (LAS unsigned*)(lds + P3_QS);
    const int kmax = t0 + 15;
    bf16x8 bc[4], bn[4];
    const int qh = 8 * (wave >> 2), w4 = wave & 3;
    const int cnt4 = (nt - w4 + 3) >> 2; const int r0 = rot % cnt4;
    bf16x8 bq[4][4];
#define P3_LOADB(u, j) do { int jj_ = r0 + (j); jj_ = (jj_ >= cnt4) ? jj_ - cnt4 : jj_; const int t_ = w4 + 4 * jj_; \
        const bf16* kp_ = kib + ((size_t)t_ * 8 + hi) * 256 + n * 8; _Pragma("unroll") for (int s = 0; s < 4; ++s) bq[u][s] = *(const bf16x8*)(kp_ + s * 512); } while (0)
#pragma unroll
    for (int u = 0; u < 4; ++u) P3_LOADB(u, (u < cnt4) ? u : 0);
    for (int i0 = 0; i0 < cnt4; i0 += 4) {
#pragma unroll
        for (int u = 0; u < 4; ++u) {
            if (i0 + u < cnt4) {
                int jj = r0 + i0 + u; jj = (jj >= cnt4) ? jj - cnt4 : jj; const int tile = w4 + 4 * jj;
                const int key = 32 * tile + n; const bool full = (32 * tile + 31 <= t0);
                f32x16 acc0, acc1;
#pragma unroll
                for (int r = 0; r < 16; ++r) { acc0[r] = 0.f; acc1[r] = 0.f; }
#pragma unroll
                for (int s = 0; s < 4; ++s) acc0 = __builtin_amdgcn_mfma_f32_32x32x16_bf16(af[0][s], bq[u][s], acc0, 0, 0, 0);
#pragma unroll
                for (int s = 0; s < 4; ++s) acc1 = __builtin_amdgcn_mfma_f32_32x32x16_bf16(af[1][s], bq[u][s], acc1, 0, 0, 0);
                float sc4[4];
                {
                    f32x16 y0, y1;
#pragma unroll
                    for (int r = 0; r < 16; ++r) { y0[r] = 0.f; y1[r] = 0.f; }
                    const f16x8 x00 = __builtin_bit_cast(f16x8, (v4u){pk_relu_f16(acc0[0], acc0[1]), pk_relu_f16(acc0[2], acc0[3]), pk_relu_f16(acc0[4], acc0[5]), pk_relu_f16(acc0[6], acc0[7])});
                    const f16x8 x01 = __builtin_bit_cast(f16x8, (v4u){pk_relu_f16(acc0[8], acc0[9]), pk_relu_f16(acc0[10], acc0[11]), pk_relu_f16(acc0[12], acc0[13]), pk_relu_f16(acc0[14], acc0[15])});
                    const f16x8 x10 = __builtin_bit_cast(f16x8, (v4u){pk_relu_f16(acc1[0], acc1[1]), pk_relu_f16(acc1[2], acc1[3]), pk_relu_f16(acc1[4], acc1[5]), pk_relu_f16(acc1[6], acc1[7])});
                    const f16x8 x11 = __builtin_bit_cast(f16x8, (v4u){pk_relu_f16(acc1[8], acc1[9]), pk_relu_f16(acc1[10], acc1[11]), pk_relu_f16(acc1[12], acc1[13]), pk_relu_f16(acc1[14], acc1[15])});
                    y0 = __builtin_amdgcn_mfma_f32_32x32x16_f16(wa[0][0], x00, y0, 0, 0, 0); y1 = __builtin_amdgcn_mfma_f32_32x32x16_f16(wa[1][0], x10, y1, 0, 0, 0);
                    y0 = __builtin_amdgcn_mfma_f32_32x32x16_f16(wa[0][1], x01, y0, 0, 0, 0); y1 = __builtin_amdgcn_mfma_f32_32x32x16_f16(wa[1][1], x11, y1, 0, 0, 0);
                    sc4[0] = y0[0]; sc4[1] = y0[1]; sc4[2] = y1[0]; sc4[3] = y1[1];
                }
                unsigned bin4[4]; float scz4[4]; bool val4[4];
#pragma unroll
                for (int e = 0; e < 4; ++e) { scz4[e] = sc4[e] + 0.0f; bin4[e] = bin11(scz4[e]); val4[e] = full || (key <= t0 + qh + 4 * (e >> 1) + hi + 2 * (e & 1)); }
                if (PASS == 1) {
                    if (full) {
#pragma unroll
                        for (int e = 0; e < 4; ++e) { const int q = qh + 4 * (e >> 1) + hi + 2 * (e & 1); __hip_atomic_fetch_add(&HIST[q * 1024 + (bin4[e] >> 1)], 1u << (16 * (bin4[e] & 1u)), __ATOMIC_RELAXED, __HIP_MEMORY_SCOPE_WORKGROUP); }
                    } else {
#pragma unroll
                        for (int e = 0; e < 4; ++e) { const int q = qh + 4 * (e >> 1) + hi + 2 * (e & 1); if (val4[e]) __hip_atomic_fetch_add(&HIST[q * 1024 + (bin4[e] >> 1)], 1u << (16 * (bin4[e] & 1u)), __ATOMIC_RELAXED, __HIP_MEMORY_SCOPE_WORKGROUP); }
                    }
                } else if (PASS == 2) {
                    unsigned long long ab4[4]; bool cand4[4]; bool anyc = false;
#pragma unroll
                    for (int e = 0; e < 4; ++e) { ab4[e] = __ballot(val4[e] && bin4[e] > thr[e >> 1][e & 1]); cand4[e] = val4[e] && bin4[e] == thr[e >> 1][e & 1]; anyc = anyc || cand4[e]; }
                    if (n == 0) {
#pragma unroll
                        for (int e = 0; e < 4; ++e) { const int q = qh + 4 * (e >> 1) + hi + 2 * (e & 1); BM[q * 256 + tile] = hi ? (unsigned)(ab4[e] >> 32) : (unsigned)ab4[e]; }
                    }
                    if (__ballot(anyc) != 0ull) {
#pragma unroll
                        for (int e = 0; e < 4; ++e) if (cand4[e]) { const int q = qh + 4 * (e >> 1) + hi + 2 * (e & 1); const unsigned pos = __hip_atomic_fetch_add(&QS[q * 8 + 3], 1u, __ATOMIC_RELAXED, __HIP_MEMORY_SCOPE_WORKGROUP);
                            if (pos < (unsigned)P3_CAP) { HIST[q * 1024 + 2 * pos] = f2key(scz4[e]); HIST[q * 1024 + 2 * pos + 1] = (unsigned)key; } }
                    }
                }
            }
            { const int jn = (i0 + u + 4 < cnt4) ? (i0 + u + 4) : (cnt4 - 1); P3_LOADB(u, jn); }
        }
    }
#undef P3_LOADB
}
__device__ __forceinline__ void p3_index(Frame& F) {
    unsigned char* ws = F.ws; const int tid = F.tid, lane = F.lane, wave = F.wave, n = lane & 31, hi = lane >> 5;
    const bf16* QIF = (const bf16*)(ws + WS_QIF); const bf16* KIF = (const bf16*)(ws + WS_KIF); const float* WIF = (const float*)(ws + WS_WIF); int* SEL = (int*)(ws + WS_SEL);
    LAS unsigned char* lds = F.lds;
    LAS unsigned* HIST = (LAS unsigned*)(lds + P3_HIST); LAS unsigned* H2 = (LAS unsigned*)(lds + P3_H2 + wave * 4096); LAS unsigned* BM = (LAS unsigned*)(lds + P3_BM); LAS unsigned* QS = (LAS unsigned*)(lds + P3_QS);
    LAS unsigned* FLAG = (LAS unsigned*)(lds + P3_FLAG); LAS unsigned* FBL = (LAS unsigned*)(lds + P3_QS + 1024);
    if (tid == 0) FBL[0] = 0u;
    __syncthreads();
    for (int ps = F.bid; ps < 512; ps += F.G) {
        const int b = ps >> 8, wq = ps & 255;
#pragma unroll 1
        for (int half = 0; half < 2; ++half) {
            const int idx = half ? (511 - wq) : wq; const int t0 = 16 * idx, row0 = (b << 13) + t0;
            if (idx < 16) {
                for (int e = tid; e < 16 * TOPK; e += 512) { const int q = e >> 8, i = e & 255; SEL[(size_t)(row0 + q) * TOPK + i] = (i <= t0 + q) ? i : 0; }
                continue;
            }
            for (int e = tid; e < 16384; e += 512) HIST[e] = 0u;
            for (int e = tid; e < 4096; e += 512) BM[e] = 0u;
            if (tid < 132) QS[tid] = 0u;
            bf16x8 af[2][4]; f16x8 wa[2][2]; const int qh = 8 * (wave >> 2);
            { const int head = (n & 3) + 4 * ((n >> 3) & 1), q4 = ((n >> 2) & 1) + 2 * (n >> 4);
#pragma unroll
              for (int mt = 0; mt < 2; ++mt) { const bf16* ap = QIF + (size_t)(row0 + qh + 4 * mt + q4) * 512 + head * IDX + 32 * hi;
#pragma unroll
                  for (int s = 0; s < 4; ++s) af[mt][s] = *(const bf16x8*)(ap + 8 * s);
#pragma unroll
                  for (int sp = 0; sp < 2; ++sp) {
                      const bool on = (sp == 0) ? ((n == 0 && hi == 0) || (n == 4 && hi == 1)) : ((n == 1 && hi == 0) || (n == 5 && hi == 1));
                      const float* wp = WIF + (size_t)(row0 + qh + 4 * mt + hi + 2 * sp) * 8; const f32x4 w0 = *(const f32x4*)wp, w1 = *(const f32x4*)(wp + 4);
                      f16x8 t; t[0] = (_Float16)w0[0]; t[1] = (_Float16)w0[1]; t[2] = (_Float16)w0[2]; t[3] = (_Float16)w0[3]; t[4] = (_Float16)w1[0]; t[5] = (_Float16)w1[1]; t[6] = (_Float16)w1[2]; t[7] = (_Float16)w1[3];
                      if (!on) t = (f16x8){0, 0, 0, 0, 0, 0, 0, 0};
                      wa[mt][sp] = t; } } }
            const int nt = (t0 + 16 + 31) >> 5; const bf16* kib = KIF + (size_t)(b << 13) * IDX;
            unsigned thr[2][2] = {{0u, 0u}, {0u, 0u}};
            __syncthreads();
            p3_score_pass<1>(af, wa, kib, t0, nt, wave, n, hi, lds, thr, F.bid * 5);
            __syncthreads();
#pragma unroll 1
            for (int qq = 0; qq < 2; ++qq) { const int q = 2 * wave + qq; unsigned bin, need, cnt; bool ok;
                find_bin_2048(HIST + q * 1024, (unsigned)TOPK, lane, bin, need, cnt, ok);
                if (lane == 0) { const bool defer = !ok || cnt > (unsigned)P3_CAP; QS[q * 8 + 0] = defer ? 4096u : bin; QS[q * 8 + 1] = need; QS[q * 8 + 2] = cnt; QS[q * 8 + 4] = defer ? 1u : 0u;
                    if (defer) { const unsigned k = __hip_atomic_fetch_add(&FBL[0], 1u, __ATOMIC_RELAXED, __HIP_MEMORY_SCOPE_WORKGROUP); if (k < 63u) FBL[1 + k] = (unsigned)(row0 + q); } } }
            __syncthreads();
#pragma unroll
            for (int mt = 0; mt < 2; ++mt)
#pragma unroll
                for (int j = 0; j < 2; ++j) thr[mt][j] = QS[(qh + 4 * mt + hi + 2 * j) * 8];
            __syncthreads();
            p3_score_pass<2>(af, wa, kib, t0, nt, wave, n, hi, lds, thr, F.bid * 5 + 3);
            __syncthreads();
#pragma unroll 1
            for (int qq = 0; qq < 2; ++qq) {
                const int q = 2 * wave + qq; LAS unsigned* cand = HIST + q * 1024; LAS unsigned* bmq = BM + q * 256;
                const unsigned needA = QS[q * 8 + 1], c = QS[q * 8 + 2];
                if (QS[q * 8 + 4] != 0u) continue;
                for (unsigned i0 = 0; i0 < c; i0 += 64) { const unsigned i = i0 + lane; const bool in = i < c; const unsigned k32 = in ? cand[2 * i] : 0u, ki = in ? (cand[2 * i + 1] & 8191u) : 0u; unsigned rank = 0u;
                    for (unsigned j = 0; j < c; ++j) { const unsigned kj = cand[2 * j], ij = cand[2 * j + 1]; rank += (kj > k32 || (kj == k32 && ij < ki)) ? 1u : 0u; }
                    if (in && rank < needA) __hip_atomic_fetch_or(&bmq[ki >> 5], 1u << (ki & 31), __ATOMIC_RELAXED, __HIP_MEMORY_SCOPE_WORKGROUP); }
                WAVE_SYNC();
                unsigned w0 = bmq[4 * lane], w1 = bmq[4 * lane + 1], w2 = bmq[4 * lane + 2], w3 = bmq[4 * lane + 3];
                const unsigned mycnt = __popc(w0) + __popc(w1) + __popc(w2) + __popc(w3);
                unsigned incl = mycnt;
#pragma unroll
                for (int o = 1; o < 64; o <<= 1) { const unsigned v = __shfl_up(incl, o); if (lane >= o) incl += v; }
                unsigned pos = incl - mycnt; int* sel = SEL + (size_t)(row0 + q) * TOPK;
#pragma unroll
                for (int wi = 0; wi < 4; ++wi) { unsigned w = (wi == 0) ? w0 : (wi == 1) ? w1 : (wi == 2) ? w2 : w3;
                    while (w) { const int bit = __ffs((int)w) - 1; if (pos < (unsigned)TOPK) sel[pos] = 128 * lane + 32 * wi + bit; ++pos; w &= w - 1u; } }
            }
            __syncthreads();
        }
    }
    __syncthreads();
    const unsigned nfb = FBL[0];
    for (unsigned k = 0; k < nfb && k < 63u; ++k) { const int r0 = (int)FBL[1 + k]; __syncthreads(); p3_query_naive(ws, lds, r0, SEL); }
}

typedef short v4i16_t __attribute__((ext_vector_type(4)));
typedef int v4i __attribute__((ext_vector_type(4)));
__device__ __forceinline__ v4i16_t tr16(LAS unsigned char* p) { return __builtin_amdgcn_ds_read_tr16_b64_v4i16((LAS v4i16_t*)p); }
typedef __bf16 bf16x2_t __attribute__((ext_vector_type(2)));
__device__ __forceinline__ unsigned dq2(unsigned w, bool hi) { return __builtin_bit_cast(unsigned, hi ? __builtin_amdgcn_cvt_scalef32_pk_bf16_fp8(w, 1.0f, true) : __builtin_amdgcn_cvt_scalef32_pk_bf16_fp8(w, 1.0f, false)); }
__device__ __forceinline__ bf16x8 dq8(unsigned w0, unsigned w1) { return __builtin_bit_cast(bf16x8, (v4u){dq2(w0, false), dq2(w0, true), dq2(w1, false), dq2(w1, true)}); }
__device__ __forceinline__ void p4_dsa(Frame& F) {
    unsigned char* ws = F.ws; const int lane = F.lane, nh = lane & 15, kg = lane >> 4;
    const bf16* QF = (const bf16*)(ws + WS_QF); const unsigned char* KV8 = (const unsigned char*)(ws + WS_KVF); const int* SEL = (const int*)(ws + WS_SEL); bf16* AO = (bf16*)(ws + WS_AO);
    LAS unsigned char* wl = F.lds + F.wave * 10240; LAS int* selw = (LAS int*)wl; LAS unsigned char* vb = wl + 1024;
    const int gw = F.wave * F.G + F.bid, NGW = F.G * NWAVES;
    LAS unsigned char* trp = vb + (4 * kg + ((lane >> 2) & 3)) * 288 + 8 * (lane & 3);
#pragma unroll 1
    for (int combo = 0; combo < BATCH * NKV; ++combo) {
        const int b = combo >> 1, kvh = combo & 1;
        const unsigned char* kvb = KV8 + (size_t)(b * NKV + kvh) * SEQ * 256;
#pragma unroll 1
        for (int t = gw; t < SEQ; t += NGW) {
            const int row = (b << 13) + t; const int cnt = (t + 1 < TOPK) ? (t + 1) : TOPK;
            *(LAS v4i*)(selw + 4 * lane) = *(const v4i*)(SEL + (size_t)row * TOPK + 4 * lane);
            WAVE_SYNC();
            const bf16* qp = QF + (size_t)row * D + (kvh * 4 + (nh & 3)) * HD + 32 * kg;
            bf16x8 qf[4];
#pragma unroll
            for (int s = 0; s < 4; ++s) { qf[s] = *(const bf16x8*)(qp + 8 * s); if (nh >= 4) qf[s] = (bf16x8){0, 0, 0, 0, 0, 0, 0, 0}; }
            f32x4 S[16];
            v4u kq[2][4][2];
#define P4_LOADK(buf, batch) do { _Pragma("unroll") for (int tt = 0; tt < 4; ++tt) { const unsigned char* kp_ = kvb + (size_t)(selw[16 * (4 * (batch) + tt) + nh] & (SEQ - 1)) * 256 + 32 * kg; \
                kq[buf][tt][0] = *(const v4u*)(kp_); kq[buf][tt][1] = *(const v4u*)(kp_ + 16); } } while (0)
            P4_LOADK(0, 0);
#pragma unroll
            for (int bt = 0; bt < 4; ++bt) {
                if (bt < 3) P4_LOADK((bt + 1) & 1, bt + 1);
                asm volatile("" ::: "memory");
#pragma unroll
                for (int tt = 0; tt < 4; ++tt) {
                    const v4u k0 = kq[bt & 1][tt][0], k1 = kq[bt & 1][tt][1];
                    f32x4 a = (f32x4){0.f, 0.f, 0.f, 0.f};
                    a = __builtin_amdgcn_mfma_f32_16x16x32_bf16(dq8(k0.x, k0.y), qf[0], a, 0, 0, 0); a = __builtin_amdgcn_mfma_f32_16x16x32_bf16(dq8(k0.z, k0.w), qf[1], a, 0, 0, 0);
                    a = __builtin_amdgcn_mfma_f32_16x16x32_bf16(dq8(k1.x, k1.y), qf[2], a, 0, 0, 0); a = __builtin_amdgcn_mfma_f32_16x16x32_bf16(dq8(k1.z, k1.w), qf[3], a, 0, 0, 0);
                    S[4 * bt + tt] = a;
                }
            }
#undef P4_LOADK
            float mx = -INFINITY;
#pragma unroll
            for (int T = 0; T < 16; ++T)
#pragma unroll
                for (int r = 0; r < 4; ++r) { const float v = (16 * T + 4 * kg + r < cnt) ? S[T][r] : -INFINITY; S[T][r] = v; mx = fmaxf(mx, v); }
            mx = fmaxf(mx, __shfl_xor(mx, 16)); mx = fmaxf(mx, __shfl_xor(mx, 32));
            float sum = 0.f;
#pragma unroll
            for (int T = 0; T < 16; ++T)
#pragma unroll
                for (int r = 0; r < 4; ++r) { const float e = __builtin_amdgcn_exp2f(S[T][r] - mx); S[T][r] = e; sum += e; }
            sum += __shfl_xor(sum, 16); sum += __shfl_xor(sum, 32);
            bf16x8 pa[8];
#pragma unroll
            for (int c = 0; c < 8; ++c) { v4u pw; pw.x = pg8::cvt_pk_bf16(S[2 * c][0], S[2 * c][1]); pw.y = pg8::cvt_pk_bf16(S[2 * c][2], S[2 * c][3]); pw.z = pg8::cvt_pk_bf16(S[2 * c + 1][0], S[2 * c + 1][1]); pw.w = pg8::cvt_pk_bf16(S[2 * c + 1][2], S[2 * c + 1][3]); pa[c] = __builtin_bit_cast(bf16x8, pw); }
            f32x4 O[8];
#pragma unroll
            for (int d = 0; d < 8; ++d) O[d] = (f32x4){0.f, 0.f, 0.f, 0.f};
            v4u g[3][4];
#define P4_LOADV(buf, c_) do { _Pragma("unroll") for (int i = 0; i < 4; ++i) { const int key_ = selw[32 * (c_) + (lane >> 3) + 8 * i] & (SEQ - 1); g[buf][i] = *(const v4u*)(kvb + (size_t)key_ * 256 + 128 + 16 * (lane & 7)); } } while (0)
            P4_LOADV(0, 0); P4_LOADV(1, 1); P4_LOADV(2, 2);
#pragma unroll
            for (int c = 0; c < 8; ++c) {
#pragma unroll
                for (int i = 0; i < 4; ++i) { const v4u gg = g[c % 3][i]; LAS unsigned char* dst = vb + ((lane >> 3) + 8 * i) * 288 + 32 * (lane & 7);
                    *(LAS v4u*)dst = __builtin_bit_cast(v4u, dq8(gg.x, gg.y)); *(LAS v4u*)(dst + 16) = __builtin_bit_cast(v4u, dq8(gg.z, gg.w)); }
                asm volatile("" ::: "memory");
                if (c < 5) P4_LOADV(c % 3, c + 3);
#pragma unroll
                for (int d = 0; d < 8; ++d) {
                    const v4i16_t lo = tr16(trp + 32 * d), hi4 = tr16(trp + 16 * 288 + 32 * d);
                    const bf16x8 vfr = (bf16x8){lo[0], lo[1], lo[2], lo[3], hi4[0], hi4[1], hi4[2], hi4[3]};
                    O[d] = __builtin_amdgcn_mfma_f32_16x16x32_bf16(pa[c], vfr, O[d], 0, 0, 0);
                }
            }
#undef P4_LOADV
            const float i0 = 1.0f / __builtin_bit_cast(float, __builtin_amdgcn_readlane(__builtin_bit_cast(int, sum), 0)), i1 = 1.0f / __builtin_bit_cast(float, __builtin_amdgcn_readlane(__builtin_bit_cast(int, sum), 1));
            const float i2 = 1.0f / __builtin_bit_cast(float, __builtin_amdgcn_readlane(__builtin_bit_cast(int, sum), 2)), i3 = 1.0f / __builtin_bit_cast(float, __builtin_amdgcn_readlane(__builtin_bit_cast(int, sum), 3));
            LAS bf16* ost = (LAS bf16*)vb;
            if (kg == 0) {
#pragma unroll
                for (int d = 0; d < 8; ++d) { ost[0 * 128 + 16 * d + nh] = (bf16)f2bf(O[d][0] * i0); ost[1 * 128 + 16 * d + nh] = (bf16)f2bf(O[d][1] * i1); ost[2 * 128 + 16 * d + nh] = (bf16)f2bf(O[d][2] * i2); ost[3 * 128 + 16 * d + nh] = (bf16)f2bf(O[d][3] * i3); }
            }
            WAVE_SYNC();
            const v4u ov = *(LAS v4u*)(vb + 16 * lane);
            *(v4u*)(AO + (size_t)row * D + (kvh * 4 + kg) * HD + 8 * nh) = ov;
            WAVE_SYNC();
        }
    }
}

__device__ __forceinline__ void p9_sb(Frame& F) {
    unsigned char* ws = F.ws; const int lane = F.lane, n = lane & 31, hi = lane >> 5;
    const bf16* KQ = (const bf16*)(ws + WS_KQ); const bf16* VT = (const bf16*)(ws + WS_VT); bf16* AO = (bf16*)(ws + WS_AO);
    const int gw = F.wave * F.G + F.bid, NGW = F.G * NWAVES;
    const int koff = 16 * (n >> 4) + 8 * ((n >> 2) & 1) + 4 * ((n >> 3) & 1) + (n & 3);
    constexpr float LOG2E = 1.4426950408889634f, LN2 = 0.6931471805599453f;
    for (int u = gw; u < (M / 32) * NH; u += NGW) {
        const int h = u & 7, blk = u >> 3, b = blk >> 8, qb = blk & 255, q0 = 32 * qb, t = q0 + n;
        const bf16* qp = KQ + (size_t)(b * SEQ + q0 + n) * 2048 + 1024 + h * HD + 64 * hi;
        bf16x8 qf[8];
#pragma unroll
        for (int s = 0; s < 8; ++s) qf[s] = *(const bf16x8*)(qp + 8 * s);
        f32x16 o[4];
#pragma unroll
        for (int mt = 0; mt < 4; ++mt)
#pragma unroll
            for (int r = 0; r < 16; ++r) o[mt][r] = 0.f;
        float C = 0.f;
        bf16x8 kf[8];
        { const bf16* kp = KQ + (size_t)(b * SEQ + 32 * qb + koff) * 2048 + h * HD + 64 * hi;
#pragma unroll
          for (int s = 0; s < 8; ++s) kf[s] = *(const bf16x8*)(kp + 8 * s); }
        for (int kb = qb; kb >= 0; --kb) {
            const int k0 = 32 * kb;
            bf16x8 vf[4][2];
#pragma unroll
            for (int mt = 0; mt < 4; ++mt)
#pragma unroll
                for (int sp = 0; sp < 2; ++sp) vf[mt][sp] = *(const bf16x8*)(VT + (size_t)(h * HD + 32 * mt + n) * M + b * SEQ + k0 + 16 * sp + 8 * hi);
            f32x16 z;
#pragma unroll
            for (int r = 0; r < 16; ++r) z[r] = 0.f;
#pragma unroll
            for (int s = 0; s < 8; ++s) z = __builtin_amdgcn_mfma_f32_32x32x16_bf16(kf[s], qf[s], z, 0, 0, 0);
            { const int kn = (kb > 0) ? kb - 1 : 0; const bf16* kp = KQ + (size_t)(b * SEQ + 32 * kn + koff) * 2048 + h * HD + 64 * hi;
#pragma unroll
              for (int s = 0; s < 8; ++s) kf[s] = *(const bf16x8*)(kp + 8 * s); }
            float lk[16], lb[16];
#pragma unroll
            for (int r = 0; r < 16; ++r) {
                const int key = k0 + ((r < 8) ? (8 * hi + r) : (16 + 8 * hi + (r - 8)));
                const float zz = z[r]; const float L = __builtin_amdgcn_logf(1.0f + __builtin_amdgcn_exp2f(-fabsf(zz) * LOG2E)) * LN2;
                const bool valid = key < t;
                lk[r] = valid ? (-fmaxf(zz, 0.f) - L) : 0.f;
                lb[r] = valid ? (fminf(zz, 0.f) - L) : -INFINITY;
            }
            float suf[16];
            suf[7] = 0.f; suf[15] = 0.f;
#pragma unroll
            for (int i = 6; i >= 0; --i) { suf[i] = suf[i + 1] + lk[i + 1]; suf[8 + i] = suf[9 + i] + lk[9 + i]; }
            const float T0 = suf[0] + lk[0], T1 = suf[8] + lk[8];
            const float P0 = __shfl_xor(T0, 32), P1 = __shfl_xor(T1, 32);
            const float base1 = C + (hi ? 0.f : P1), base0 = C + (hi ? (T1 + P1) : (P0 + T1 + P1));
            unsigned pw[8];
#pragma unroll
            for (int r = 0; r < 16; r += 2) {
                const float a0 = __builtin_amdgcn_exp2f((lb[r] + ((r < 8) ? base0 : base1) + suf[r]) * LOG2E), a1 = __builtin_amdgcn_exp2f((lb[r + 1] + ((r < 8) ? base0 : base1) + suf[r + 1]) * LOG2E);
                pw[r >> 1] = pg8::cvt_pk_bf16(a0, a1);
            }
            C += (T0 + T1) + (P0 + P1);
            const bf16x8 pa0 = __builtin_bit_cast(bf16x8, (v4u){pw[0], pw[1], pw[2], pw[3]}), pa1 = __builtin_bit_cast(bf16x8, (v4u){pw[4], pw[5], pw[6], pw[7]});
#pragma unroll
            for (int mt = 0; mt < 4; ++mt) { o[mt] = __builtin_amdgcn_mfma_f32_32x32x16_bf16(vf[mt][0], pa0, o[mt], 0, 0, 0); o[mt] = __builtin_amdgcn_mfma_f32_32x32x16_bf16(vf[mt][1], pa1, o[mt], 0, 0, 0); }
            if (__all(C < -44.0f)) break;
        }
        bf16* op = AO + (size_t)(b * SEQ + q0 + n) * D + h * HD + 4 * hi;
#pragma unroll
        for (int mt = 0; mt < 4; ++mt)
#pragma unroll
            for (int g = 0; g < 4; ++g) { v2u w; w.x = pg8::cvt_pk_bf16(o[mt][4 * g], o[mt][4 * g + 1]); w.y = pg8::cvt_pk_bf16(o[mt][4 * g + 2], o[mt][4 * g + 3]); *(v2u*)(op + 32 * mt + 8 * g) = w; }
    }
}

__device__ __forceinline__ void p11_router(Frame& F) {
    unsigned char* ws = F.ws; const int tid = F.tid, lane = F.lane, wave = F.wave;
    const float* H = (const float*)(ws + WS_H); const float* gn = F.in[IN_FFNNORM] + D; const float* Wr = F.in[IN_ROUTER];
    int* TOPE = (int*)(ws + WS_RT); int* POS = (int*)(ws + WS_RT + 128 * 1024); float* GATE = (float*)(ws + WS_RT + 256 * 1024); float* RSTD3 = (float*)(ws + WS_RT + 384 * 1024);
    LAS unsigned* lcnt = (LAS unsigned*)F.lds;
    LAS unsigned* gb = (LAS unsigned*)(F.lds + 64);
    LAS int* ltok = (LAS int*)(F.lds + 128);
    LAS float* lgt = (LAS float*)(F.lds + 128 + 1024);
    for (int chunk = F.bid; chunk < M / 64; chunk += F.G) {
        if (tid < 8) lcnt[tid] = 0u;
        __syncthreads();
        for (int r = 0; r < 8; ++r) {
            const int row = chunk * 64 + wave * 8 + r;
            const GAS f32x4* xr = (const GAS f32x4*)(H + (size_t)row * D) + lane; f32x4 v[4]; float ss = 0.f;
#pragma unroll
            for (int j = 0; j < 4; ++j) { v[j] = xr[64 * j]; ss += (v[j].x * v[j].x + v[j].y * v[j].y) + (v[j].z * v[j].z + v[j].w * v[j].w); }
            ss = wave_sum(ss); const float rs = 1.0f / sqrtf(ss * (1.0f / 1024.0f) + 1e-6f);
            float lg[8] = {0.f, 0.f, 0.f, 0.f, 0.f, 0.f, 0.f, 0.f};
#pragma unroll
            for (int j = 0; j < 4; ++j)
#pragma unroll
                for (int i = 0; i < 4; ++i) { const int k = 256 * j + 4 * lane + i; const float xv = v[j][i] * gn[k]; const f32x4 w0 = *(const f32x4*)(Wr + (size_t)k * 8), w1 = *(const f32x4*)(Wr + (size_t)k * 8 + 4);
                    lg[0] += xv * w0[0]; lg[1] += xv * w0[1]; lg[2] += xv * w0[2]; lg[3] += xv * w0[3]; lg[4] += xv * w1[0]; lg[5] += xv * w1[1]; lg[6] += xv * w1[2]; lg[7] += xv * w1[3]; }
#pragma unroll
            for (int e = 0; e < 8; ++e) lg[e] = wave_sum(lg[e]) * rs;
            int i1 = 0; float l1 = lg[0];
#pragma unroll
            for (int e = 1; e < 8; ++e) if (lg[e] > l1) { l1 = lg[e]; i1 = e; }
            int i2 = -1; float l2 = -INFINITY;
#pragma unroll
            for (int e = 0; e < 8; ++e) if (e != i1 && lg[e] > l2) { l2 = lg[e]; i2 = e; }
            const float g1 = 1.0f / (1.0f + __expf(l2 - l1)), g2 = 1.0f - g1;
            if (lane == 0) {
                const unsigned p1 = __hip_atomic_fetch_add(&lcnt[i1], 1u, __ATOMIC_RELAXED, __HIP_MEMORY_SCOPE_WORKGROUP), p2 = __hip_atomic_fetch_add(&lcnt[i2], 1u, __ATOMIC_RELAXED, __HIP_MEMORY_SCOPE_WORKGROUP);
                const int ti = wave * 8 + r; ltok[ti * 4 + 0] = i1; ltok[ti * 4 + 1] = i2; ltok[ti * 4 + 2] = (int)p1; ltok[ti * 4 + 3] = (int)p2;
                lgt[ti * 4 + 0] = g1; lgt[ti * 4 + 1] = g2; lgt[ti * 4 + 2] = rs;
            }
        }
        __syncthreads();
        if (tid < 8) gb[tid] = __hip_atomic_fetch_add(F.ctl + CW_CNT + tid, lcnt[tid], RLX_AGENT);
        __syncthreads();
        if (tid < 64) { const int row = chunk * 64 + tid; const int e1 = ltok[tid * 4], e2 = ltok[tid * 4 + 1];
            TOPE[row * 2] = e1; TOPE[row * 2 + 1] = e2; POS[row * 2] = (int)gb[e1] + ltok[tid * 4 + 2]; POS[row * 2 + 1] = (int)gb[e2] + ltok[tid * 4 + 3];
            GATE[row * 2] = lgt[tid * 4]; GATE[row * 2 + 1] = lgt[tid * 4 + 1]; RSTD3[row] = lgt[tid * 4 + 2]; }
        __syncthreads();
    }
}
__device__ __forceinline__ void moe_bases(Frame& F, int (&tb)[9]) {
    int acc = 0;
#pragma unroll
    for (int e = 0; e < 8; ++e) { tb[e] = acc; const unsigned c = __hip_atomic_load(F.ctl + CW_CNT + e, RLX_AGENT); acc += (int)((c + 255u) >> 8); }
    tb[8] = acc;
}
__device__ __forceinline__ void p12_permute(Frame& F) {
    unsigned char* ws = F.ws; const int lane = F.lane;
    const int* TOPE = (const int*)(ws + WS_RT); const int* POS = (const int*)(ws + WS_RT + 128 * 1024); const float* RSTD3 = (const float*)(ws + WS_RT + 384 * 1024);
    int* SLOT = (int*)(ws + WS_RT + 512 * 1024);
    const float* H = (const float*)(ws + WS_H); bf16* XP = (bf16*)(ws + WS_XPERM);
    int tb[9]; moe_bases(F, tb);
    const int gw = F.wave * F.G + F.bid, NGW = F.G * NWAVES;
    for (int i = gw; i < 2 * M; i += NGW) {
        const int row = i >> 1; const int e = TOPE[i]; int base = 0;
#pragma unroll
        for (int k = 0; k < 8; ++k) base = (e == k) ? tb[k] : base;
        const int slot = base * 256 + POS[i];
        const float rs = RSTD3[row];
        const GAS f32x4* src = (const GAS f32x4*)(H + (size_t)row * D) + lane; GAS unsigned* dst = (GAS unsigned*)((unsigned char*)XP + (size_t)slot * D) + lane;
        const float r16 = rs * pg8::F8_SX;
#pragma unroll
        for (int j = 0; j < 4; ++j) { const f32x4 v = src[64 * j]; dst[64 * j] = pg8::pk4_fp8(v.x * r16, v.y * r16, v.z * r16, v.w * r16); }
        if (lane == 0) SLOT[i] = slot;
    }
}
__device__ __forceinline__ void p15_combine(Frame& F) {
    unsigned char* ws = F.ws; const int lane = F.lane;
    const float* H = (const float*)(ws + WS_H); const bf16* Y = (const bf16*)(ws + WS_Y); const int* SLOT = (const int*)(ws + WS_RT + 512 * 1024); const float* GATE = (const float*)(ws + WS_RT + 256 * 1024);
    const int gw = F.wave * F.G + F.bid, NGW = F.G * NWAVES;
    for (int row = gw; row < M; row += NGW) {
        const int s1 = SLOT[row * 2], s2 = SLOT[row * 2 + 1]; const float g1 = GATE[row * 2], g2 = GATE[row * 2 + 1];
        const GAS f32x4* hr = (const GAS f32x4*)(H + (size_t)row * D) + lane; GAS f32x4* orow = (GAS f32x4*)(F.out + (size_t)row * D) + lane;
        const GAS v2u* y1 = (const GAS v2u*)(Y + (size_t)s1 * D) + lane; const GAS v2u* y2 = (const GAS v2u*)(Y + (size_t)s2 * D) + lane;
#pragma unroll
        for (int j = 0; j < 4; ++j) { const f32x4 h = __builtin_nontemporal_load(hr + 64 * j); const v2u a = __builtin_nontemporal_load(y1 + 64 * j), c = __builtin_nontemporal_load(y2 + 64 * j); f32x4 o;
            o.x = h.x + (g1 * bflo(a.x) + g2 * bflo(c.x)); o.y = h.y + (g1 * bfhi(a.x) + g2 * bfhi(c.x)); o.z = h.z + (g1 * bflo(a.y) + g2 * bflo(c.y)); o.w = h.w + (g1 * bfhi(a.y) + g2 * bfhi(c.y)); orow[64 * j] = o; }
    }
}

constexpr int N_PHASES = 16;
#ifndef MK_ONE_LAUNCH
#define MK_ONE_LAUNCH 1
#endif
struct Args { const float* in[17]; float* out; unsigned char* ws; int ph_lo, ph_hi; };
__global__ void __launch_bounds__(NWAVES * 64, 2) yoco_fwd(Args args) {
    extern __shared__ __attribute__((aligned(16))) unsigned char lds[];
    Frame F;
    F.lds = (LAS unsigned char*)lds; F.MISC = (volatile LAS unsigned*)(F.lds + MISC_OFF);
    F.tid = threadIdx.x; F.lane = F.tid & 63; F.wave = __builtin_amdgcn_readfirstlane(F.tid >> 6); F.G = gridDim.x; F.bid = blockIdx.x;
    F.ws = args.ws; F.ctl = (gu32*)(args.ws + WS_CTL); F.out = args.out;
#pragma unroll
    for (int i = 0; i < 17; ++i) F.in[i] = args.in[i];
    for (int u = F.tid; u < (LDS_BYTES - LDSCTL_OFF) / 4; u += NWAVES * 64) ((LAS unsigned*)(F.lds + LDSCTL_OFF))[u] = 0u;
    __syncthreads();
    unsigned char* ws = args.ws;
    XcdBarrier bar; bar.bar = (unsigned*)(F.ctl + CW_BAR); bar.x = 0; bar.st = nullptr;
    if (MK_ONE_LAUNCH) bar = xcd_barrier_post((unsigned*)(F.ctl + CW_BAR), F.MISC + 8);
    const int lo = args.ph_lo, hi = args.ph_hi;
#define IN(k) (lo <= (k) && (k) < hi)
#define SEAM(k) do { if (MK_ONE_LAUNCH && IN((k) + 1)) xcd_barrier(bar); } while (0)
    bf16* XB = (bf16*)(ws + WS_XB); float* H = (float*)(ws + WS_H); bf16* AO = (bf16*)(ws + WS_AO);

    if (IN(0)) { p0_prologue(F); SEAM(0); }
    if (IN(1)) {
        pg8::Gemm g{XB, (const bf16*)(ws + WS_WIN), M, 2048, D}; pg8::StaticOrder S; S.init(M, 2048, F.G, F.bid);
        pg8::EpiPlainBf16 E{(bf16*)(ws + WS_PROJ), 2048, 0xffff};
        pg8::gemm_phase<pg8::EpiPlainBf16, pg8::StaticOrder, true, true>(F.lds, g, S, E); SEAM(1); }
    if (IN(2)) { p2_post(F); SEAM(2); }
    if (IN(3)) { p3_index(F); SEAM(3); }
    if (IN(4)) { p4_dsa(F); SEAM(4); }
    if (IN(5)) {
        pg8::Gemm g{AO, (const bf16*)(ws + WS_WOA), M, D, D}; pg8::StaticOrder S; S.init(M, D, F.G, F.bid);
        pg8::EpiResid<true> E{F.in[IN_X], H, XB, (float*)(ws + WS_SS1), 1.0f};
        pg8::gemm_phase<pg8::EpiResid<true>, pg8::StaticOrder, true, true>(F.lds, g, S, E); SEAM(5); }
    if (IN(6)) {
        pg8::Gemm g{XB, (const bf16*)(ws + WS_WGU), M, 2 * FF, D / 2}; pg8::StaticOrder S; S.init(M, 2 * FF, F.G, F.bid);
        pg8::EpiSwiGLU8<false> E{ws + WS_HF, FF, (const float*)(ws + WS_SS1)};
        pg8::gemm_phase<pg8::EpiSwiGLU8<false>, pg8::StaticOrder, true, true, true>(F.lds, g, S, E); SEAM(6); }
    if (IN(7)) {
        pg8::Gemm g{(const bf16*)(ws + WS_HF), (const bf16*)(ws + WS_WD), M, D, FF / 2}; pg8::StaticOrder S; S.init(M, D, F.G, F.bid);
        pg8::EpiResid<false> E{H, H, XB, (float*)(ws + WS_SS2), 1.0f / (pg8::F8_SH * pg8::F8_SWD)};
        pg8::gemm_phase<pg8::EpiResid<false>, pg8::StaticOrder, true, true, true>(F.lds, g, S, E); SEAM(7); }
    if (IN(8)) {
        { pg8::Gemm g{XB, (const bf16*)(ws + WS_WKVQ), M, 2048, D}; pg8::StaticOrder S; S.init(M, 2048, F.G, F.bid);
          pg8::EpiScaleBf16 E{(bf16*)(ws + WS_KQ), 2048, (const float*)(ws + WS_SS2)};
          pg8::gemm_phase<pg8::EpiScaleBf16, pg8::StaticOrder, true, true>(F.lds, g, S, E); }
        { pg8::Gemm g{(const bf16*)(ws + WS_WKVQ) + (size_t)2048 * D, XB, D, M, D}; pg8::StaticOrder S; S.init(D, M, F.G, F.bid);
          pg8::EpiScaleColBf16 E{(bf16*)(ws + WS_VT), M, (const float*)(ws + WS_SS2)};
          pg8::gemm_phase<pg8::EpiScaleColBf16, pg8::StaticOrder, true, true>(F.lds, g, S, E); }
        SEAM(8); }
    if (IN(9)) { p9_sb(F); SEAM(9); }
    if (IN(10)) {
        pg8::Gemm g{AO, (const bf16*)(ws + WS_WOB), M, D, D}; pg8::StaticOrder S; S.init(M, D, F.G, F.bid);
        pg8::EpiResid<false> E{H, H, XB, (float*)(ws + WS_SS3), 1.0f};
        pg8::gemm_phase<pg8::EpiResid<false>, pg8::StaticOrder, true, true>(F.lds, g, S, E); SEAM(10); }
    if (IN(11)) { p11_router(F); SEAM(11); }
    if (IN(12)) { p12_permute(F); SEAM(12); }
    if (IN(13)) {
        pg8::MoeOrder S; moe_bases(F, S.tb); S.npn = 22; S.G = F.G; S.c = F.bid;
        pg8::Gemm g{(const bf16*)(ws + WS_XPERM), (const bf16*)(ws + WS_WGUM), MAXSLOT, NE * 2 * FF, D / 2};
        pg8::EpiSwiGLU8<true> E{ws + WS_HM, FF, nullptr};
        pg8::gemm_phase<pg8::EpiSwiGLU8<true>, pg8::MoeOrder, true, true, true>(F.lds, g, S, E); SEAM(13); }
    if (IN(14)) {
        pg8::MoeOrder S; moe_bases(F, S.tb); S.npn = 4; S.G = F.G; S.c = F.bid;
        pg8::Gemm g{(const bf16*)(ws + WS_HM), (const bf16*)(ws + WS_WDM), MAXSLOT, NE * D, FF / 2};
        pg8::EpiScaledBf16 E{(bf16*)(ws + WS_Y), D, 3, 1.0f / (pg8::F8_SH * pg8::F8_SWD)};
        pg8::gemm_phase<pg8::EpiScaledBf16, pg8::MoeOrder, true, true, true>(F.lds, g, S, E); SEAM(14); }
    if (IN(15)) { p15_combine(F); }
#undef IN
#undef SEAM
}

extern "C" void kernel_launch(void* const* d_in, const int* in_sizes, int n_in, void* d_out, int out_size, void* d_ws, size_t ws_size, hipStream_t stream) {
    static int grid = 0;
    if (grid == 0) {
        if (n_in != 17 || out_size != M * D || ws_size < WS_END) { fprintf(stderr, "kernel_launch: unexpected problem (n_in %d, out %d, ws %zu < %zu)\n", n_in, out_size, ws_size, (size_t)WS_END); grid = -1; return; }
        int dev = 0, cus = 0, per_cu = 0;
        if (hipGetDevice(&dev) != hipSuccess || hipDeviceGetAttribute(&cus, hipDeviceAttributeMultiprocessorCount, dev) != hipSuccess) { grid = -1; return; }
        if (hipFuncSetAttribute((const void*)yoco_fwd, hipFuncAttributeMaxDynamicSharedMemorySize, LDS_BYTES) != hipSuccess) { fprintf(stderr, "kernel_launch: hipFuncSetAttribute failed\n"); grid = -1; return; }
        if (hipOccupancyMaxActiveBlocksPerMultiprocessor(&per_cu, (const void*)yoco_fwd, NWAVES * 64, LDS_BYTES) != hipSuccess || per_cu < 1) fprintf(stderr, "kernel_launch: occupancy query says %d\n", per_cu);
        (void)hipGetLastError();
        grid = cus;
    }
    if (grid < 0) return;
    if (hipMemsetAsync((char*)d_ws + WS_CTL, 0, CTL_ZERO_BYTES, stream) != hipSuccess) return;
    Args a{};
    for (int i = 0; i < 17; ++i) a.in[i] = (const float*)d_in[i];
    a.out = (float*)d_out; a.ws = (unsigned char*)d_ws;
#if MK_ONE_LAUNCH
    a.ph_lo = 0; a.ph_hi = N_PHASES;
    hipLaunchKernelGGL(yoco_fwd, dim3(grid), dim3(NWAVES * 64), LDS_BYTES, stream, a);
#else
    for (int p = 0; p < N_PHASES; ++p) { a.ph_lo = p; a.ph_hi = p + 1; hipLaunchKernelGGL(yoco_fwd, dim3(grid), dim3(NWAVES * 64), LDS_BYTES, stream, a); }
#endif
}
```

```cpp
#include <hip/hip_runtime.h>
#include <cstdio>
#include <cstdint>
namespace pg8 {
#define PG8_LAS __attribute__((address_space(3)))
typedef unsigned short bf16_t;
typedef short bf16x8 __attribute__((ext_vector_type(8)));
typedef float f32x4 __attribute__((ext_vector_type(4)));
typedef unsigned u32x4 __attribute__((ext_vector_type(4)));
typedef int i32x4 __attribute__((ext_vector_type(4)));
typedef int i32x8 __attribute__((ext_vector_type(8)));
constexpr int BM = 256, BK = 64, HALF = 128, HTB = HALF * BK * 2  , STAGE_BYTES = 8 * HTB, NXCD = 8, WGM = 8;

__host__ __device__ __forceinline__ int lds_byte(int r, int c) { const int st = (r >> 4) * 2 + (c >> 5), rr = r & 15, cc = c & 31, ob = rr * 64 + cc * 2; return st * 1024 + (ob ^ (((ob >> 9) & 1) << 5)); }
__host__ __device__ __forceinline__ void stage_rc(int b, int& R, int& C) { const int st = b / 1024, sb = b % 1024, swz = sb ^ (((sb >> 9) & 1) << 5); R = (st >> 1) * 16 + swz / 64; C = (st & 1) * 32 + (swz % 64) / 2; }
__host__ __device__ __forceinline__ int perm32(int rho) { const int n = rho >> 4, i = rho & 15; return 8 * (i >> 2) + 4 * n + (i & 3); }

struct Unit { int pm, pn; int koff = 0; };
struct Gemm { const bf16_t* A; const bf16_t* Bt; int M, N, K; int ld = 0; };

struct StaticOrder {
    int nM, nN, nwg, G, c;
    __host__ __device__ void init(int M, int N, int G_, int c_) { nM = M / BM; nN = N / BM; nwg = nM * nN; G = G_; c = c_; }
    __host__ __device__ bool next(int i, Unit& u) const {
        const long L = (long)i * G + c; if (L >= nwg) return false;
        int wgid = (int)L; { const int q = nwg / NXCD, r = nwg % NXCD, xcd = wgid % NXCD, off = wgid / NXCD; wgid = (xcd < r ? xcd * (q + 1) : r * (q + 1) + (xcd - r) * q) + off; }
        const int nig = WGM * nN, gid = wgid / nig, fm = gid * WGM, gsz = (nM - fm) < WGM ? (nM - fm) : WGM;
        u.pm = fm + ((wgid % nig) % gsz); u.pn = (wgid % nig) / gsz; return true;
    }
    __device__ __forceinline__ void a_ready(const Unit&) const {}
    __device__ __forceinline__ void done(const Unit&) const {}
};

__device__ __forceinline__ unsigned cvt_pk_bf16(float lo, float hi) { unsigned r; asm volatile("v_cvt_pk_bf16_f32 %0, %1, %2" : "=v"(r) : "v"(lo), "v"(hi)); return r; }
typedef unsigned u32x2 __attribute__((ext_vector_type(2)));
constexpr float RMS_EPS = 1e-6f;
__device__ __forceinline__ float rstd16(const float* p) {
    const f32x4 a = *(const f32x4*)p, b = *(const f32x4*)(p + 4), c = *(const f32x4*)(p + 8), d = *(const f32x4*)(p + 12);
    const float s = (((a[0] + a[1]) + (a[2] + a[3])) + ((b[0] + b[1]) + (b[2] + b[3]))) + (((c[0] + c[1]) + (c[2] + c[3])) + ((d[0] + d[1]) + (d[2] + d[3])));
    return 1.0f / sqrtf(s * (1.0f / 1024.0f) + RMS_EPS);
}
struct EpiScaleBf16 {
    static constexpr bool PERM = true, AFTER_DRAIN = false;
    bf16_t* O; int ldc; const float* ss;
    __device__ __forceinline__ void operator()(const f32x4 (&acc)[2][2][4][2], const Unit& u, int wr, int wc, int fr, int fq) const {
        const int row0 = u.pm * BM + wr * 64 + fr, col0 = u.pn * BM + wc * 32 + 8 * fq;
        float rsv[2][4];
#pragma unroll
        for (int ai = 0; ai < 2; ++ai)
#pragma unroll
            for (int m = 0; m < 4; ++m) rsv[ai][m] = rstd16(ss + (size_t)(row0 + ai * HALF + m * 16) * 16);
#pragma unroll
        for (int ai = 0; ai < 2; ++ai)
#pragma unroll
            for (int m = 0; m < 4; ++m) { const int row = row0 + ai * HALF + m * 16; const float rs = rsv[ai][m]; bf16_t* rowp = O + (size_t)row * ldc + col0;
#pragma unroll
                for (int bj = 0; bj < 2; ++bj) { const f32x4 v0 = acc[ai][bj][m][0] * rs, v1 = acc[ai][bj][m][1] * rs;
                    u32x4 w; w.x = cvt_pk_bf16(v0[0], v0[1]); w.y = cvt_pk_bf16(v0[2], v0[3]); w.z = cvt_pk_bf16(v1[0], v1[1]); w.w = cvt_pk_bf16(v1[2], v1[3]);
                    *(u32x4*)(rowp + bj * HALF) = w; } }
    }
};
struct EpiPlainBf16 {
    static constexpr bool PERM = true, AFTER_DRAIN = false;
    bf16_t* O; int ldc; int pnmask;
    __device__ __forceinline__ void operator()(const f32x4 (&acc)[2][2][4][2], const Unit& u, int wr, int wc, int fr, int fq) const {
        const int row0 = u.pm * BM + wr * 64 + fr, col0 = (u.pn & pnmask) * BM + wc * 32 + 8 * fq;
#pragma unroll
        for (int ai = 0; ai < 2; ++ai)
#pragma unroll
            for (int m = 0; m < 4; ++m) { bf16_t* rowp = O + (size_t)(row0 + ai * HALF + m * 16) * ldc + col0;
#pragma unroll
                for (int bj = 0; bj < 2; ++bj) { const f32x4 v0 = acc[ai][bj][m][0], v1 = acc[ai][bj][m][1];
                    u32x4 w; w.x = cvt_pk_bf16(v0[0], v0[1]); w.y = cvt_pk_bf16(v0[2], v0[3]); w.z = cvt_pk_bf16(v1[0], v1[1]); w.w = cvt_pk_bf16(v1[2], v1[3]);
                    *(u32x4*)(rowp + bj * HALF) = w; } }
    }
};
struct EpiScaleColBf16 {
    static constexpr bool PERM = true, AFTER_DRAIN = false;
    bf16_t* O; int ldc; const float* ss;
    __device__ __forceinline__ void operator()(const f32x4 (&acc)[2][2][4][2], const Unit& u, int wr, int wc, int fr, int fq) const {
        const int row0 = u.pm * BM + wr * 64 + fr, col0 = u.pn * BM + wc * 32 + 8 * fq;
        f32x4 rs[2][2];
#pragma unroll
        for (int bj = 0; bj < 2; ++bj)
#pragma unroll
            for (int n = 0; n < 2; ++n)
#pragma unroll
                for (int e = 0; e < 4; ++e) rs[bj][n][e] = rstd16(ss + (size_t)(col0 + bj * HALF + 4 * n + e) * 16);
#pragma unroll
        for (int ai = 0; ai < 2; ++ai)
#pragma unroll
            for (int m = 0; m < 4; ++m) { const int row = row0 + ai * HALF + m * 16; bf16_t* rowp = O + (size_t)row * ldc + col0;
#pragma unroll
                for (int bj = 0; bj < 2; ++bj) { const f32x4 v0 = acc[ai][bj][m][0] * rs[bj][0], v1 = acc[ai][bj][m][1] * rs[bj][1];
                    u32x4 w; w.x = cvt_pk_bf16(v0[0], v0[1]); w.y = cvt_pk_bf16(v0[2], v0[3]); w.z = cvt_pk_bf16(v1[0], v1[1]); w.w = cvt_pk_bf16(v1[2], v1[3]);
                    *(u32x4*)(rowp + bj * HALF) = w; } }
    }
};
constexpr float F8_SX = 16.f, F8_SWGU = 512.f, F8_SH = 16.f, F8_SWD = 1024.f;
__device__ __forceinline__ unsigned pk4_fp8(float a, float b, float c, float d) {
    a = __builtin_amdgcn_fmed3f(a, -448.f, 448.f); b = __builtin_amdgcn_fmed3f(b, -448.f, 448.f); c = __builtin_amdgcn_fmed3f(c, -448.f, 448.f); d = __builtin_amdgcn_fmed3f(d, -448.f, 448.f);
    int w = __builtin_amdgcn_cvt_pk_fp8_f32(a, b, 0, false); w = __builtin_amdgcn_cvt_pk_fp8_f32(c, d, w, true); return (unsigned)w;
}
template <bool X8> struct EpiResid {
    static constexpr bool PERM = false, AFTER_DRAIN = false;
    const float* base; float* H; bf16_t* XB; float* ssp; float sc;
    __device__ __forceinline__ void operator()(const f32x4 (&acc)[2][2][4][2], const Unit& u, int wr, int wc, int fr, int fq) const {
        const int row0 = u.pm * BM + wr * 64 + fr, col0 = u.pn * BM + wc * 32 + 4 * fq;
#pragma unroll
        for (int ai = 0; ai < 2; ++ai) {
            f32x4 bv[4][2][2];
#pragma unroll
            for (int m = 0; m < 4; ++m)
#pragma unroll
                for (int bj = 0; bj < 2; ++bj)
#pragma unroll
                    for (int n = 0; n < 2; ++n) bv[m][bj][n] = *(const f32x4*)(base + (size_t)(row0 + ai * HALF + m * 16) * 1024 + col0 + bj * HALF + n * 16);
#pragma unroll
            for (int m = 0; m < 4; ++m) { const int row = row0 + ai * HALF + m * 16; float q = 0.f;
#pragma unroll
                for (int bj = 0; bj < 2; ++bj)
#pragma unroll
                    for (int n = 0; n < 2; ++n) { const size_t off = (size_t)row * 1024 + col0 + bj * HALF + n * 16;
                        const f32x4 v = bv[m][bj][n] + acc[ai][bj][m][n] * sc; *(f32x4*)(H + off) = v;
                        q += (v[0] * v[0] + v[1] * v[1]) + (v[2] * v[2] + v[3] * v[3]);
                        if constexpr (X8) { *(unsigned*)((unsigned char*)XB + off) = pk4_fp8(v[0] * F8_SX, v[1] * F8_SX, v[2] * F8_SX, v[3] * F8_SX); }
                        else { u32x2 w; w.x = cvt_pk_bf16(v[0], v[1]); w.y = cvt_pk_bf16(v[2], v[3]); *(u32x2*)(XB + off) = w; } }
                q += __shfl_xor(q, 16); q += __shfl_xor(q, 32);
                if (fq == 0) ssp[(size_t)row * 16 + u.pn * 4 + wc] = q; }
        }
    }
};
__device__ __forceinline__ float silu_mul(float g, float u) { return g * __builtin_amdgcn_rcpf(1.0f + __builtin_amdgcn_exp2f(g * -1.4426950408889634f)) * u; }
template <bool MOE> struct EpiSwiGLU {
    static constexpr bool PERM = true, AFTER_DRAIN = false;
    bf16_t* O; int ldc; const float* ss;
    __device__ __forceinline__ void operator()(const f32x4 (&acc)[2][2][4][2], const Unit& u, int wr, int wc, int fr, int fq) const {
        const int row0 = u.pm * BM + wr * 64 + fr; const int pnl = MOE ? (u.pn % 22) : u.pn; const int col0 = pnl * HALF + wc * 32 + 8 * fq;
        float rsv[2][4];
#pragma unroll
        for (int ai = 0; ai < 2; ++ai)
#pragma unroll
            for (int m = 0; m < 4; ++m) { const int row = row0 + ai * HALF + m * 16; rsv[ai][m] = MOE ? 1.0f : rstd16(ss + (size_t)row * 16); }
#pragma unroll
        for (int ai = 0; ai < 2; ++ai)
#pragma unroll
            for (int m = 0; m < 4; ++m) { const int row = row0 + ai * HALF + m * 16; const float rs = rsv[ai][m];
                const f32x4 g0 = acc[ai][0][m][0] * rs, g1 = acc[ai][0][m][1] * rs, u0 = acc[ai][1][m][0] * rs, u1 = acc[ai][1][m][1] * rs;
                u32x4 w; w.x = cvt_pk_bf16(silu_mul(g0[0], u0[0]), silu_mul(g0[1], u0[1])); w.y = cvt_pk_bf16(silu_mul(g0[2], u0[2]), silu_mul(g0[3], u0[3]));
                w.z = cvt_pk_bf16(silu_mul(g1[0], u1[0]), silu_mul(g1[1], u1[1])); w.w = cvt_pk_bf16(silu_mul(g1[2], u1[2]), silu_mul(g1[3], u1[3]));
                *(u32x4*)(O + (size_t)row * ldc + col0) = w; }
    }
};
template <bool MOE> struct EpiSwiGLU8 {
    static constexpr bool PERM = true, AFTER_DRAIN = false;
    unsigned char* O; int ldc; const float* ss;
    __device__ __forceinline__ void operator()(const f32x4 (&acc)[2][2][4][2], const Unit& u, int wr, int wc, int fr, int fq) const {
        const int row0 = u.pm * BM + wr * 64 + fr; const int col0 = (MOE ? (u.pn % 22) : u.pn) * HALF + wc * 32 + 8 * fq; const float r0 = 1.0f / (F8_SX * F8_SWGU);
        float rsv[2][4];
#pragma unroll
        for (int ai = 0; ai < 2; ++ai)
#pragma unroll
            for (int m = 0; m < 4; ++m) rsv[ai][m] = MOE ? r0 : r0 * rstd16(ss + (size_t)(row0 + ai * HALF + m * 16) * 16);
#pragma unroll
        for (int ai = 0; ai < 2; ++ai)
#pragma unroll
            for (int m = 0; m < 4; ++m) { const int row = row0 + ai * HALF + m * 16; const float rs = rsv[ai][m], rh = rs * F8_SH;
                const f32x4 g0 = acc[ai][0][m][0] * rs, g1 = acc[ai][0][m][1] * rs, u0 = acc[ai][1][m][0] * rh, u1 = acc[ai][1][m][1] * rh;
                u32x2 w; w.x = pk4_fp8(silu_mul(g0[0], u0[0]), silu_mul(g0[1], u0[1]), silu_mul(g0[2], u0[2]), silu_mul(g0[3], u0[3]));
                w.y = pk4_fp8(silu_mul(g1[0], u1[0]), silu_mul(g1[1], u1[1]), silu_mul(g1[2], u1[2]), silu_mul(g1[3], u1[3]));
                *(u32x2*)(O + (size_t)row * ldc + col0) = w; }
    }
};
struct EpiScaledBf16 {
    static constexpr bool PERM = true, AFTER_DRAIN = false;
    bf16_t* O; int ldc; int pnmask; float sc;
    __device__ __forceinline__ void operator()(const f32x4 (&acc)[2][2][4][2], const Unit& u, int wr, int wc, int fr, int fq) const {
        const int row0 = u.pm * BM + wr * 64 + fr, col0 = (u.pn & pnmask) * BM + wc * 32 + 8 * fq;
#pragma unroll
        for (int ai = 0; ai < 2; ++ai)
#pragma unroll
            for (int m = 0; m < 4; ++m) { bf16_t* rowp = O + (size_t)(row0 + ai * HALF + m * 16) * ldc + col0;
#pragma unroll
                for (int bj = 0; bj < 2; ++bj) { const f32x4 v0 = acc[ai][bj][m][0] * sc, v1 = acc[ai][bj][m][1] * sc;
                    u32x4 w; w.x = cvt_pk_bf16(v0[0], v0[1]); w.y = cvt_pk_bf16(v0[2], v0[3]); w.z = cvt_pk_bf16(v1[0], v1[1]); w.w = cvt_pk_bf16(v1[2], v1[3]);
                    *(u32x4*)(rowp + bj * HALF) = w; } }
    }
};
struct MoeOrder {
    int tb[9]; int npn, G, c;
    __device__ __forceinline__ bool next(int i, Unit& u) const {
        const int L = i * G + c; if (L >= tb[8] * npn) return false;
        const int t = L / npn, j = L - t * npn; int e = 0;
#pragma unroll
        for (int k = 1; k < 8; ++k) e += (t >= tb[k]) ? 1 : 0;
        u.pm = t; u.pn = e * npn + j; return true;
    }
    __device__ __forceinline__ void a_ready(const Unit&) const {}
    __device__ __forceinline__ void done(const Unit&) const {}
};

template <class Epi, class Sched, bool ALIGN_EPI = false, bool SP2 = false, bool F8 = false>
__device__ __forceinline__ void gemm_phase(PG8_LAS unsigned char* lds, const Gemm g, const Sched& S, const Epi& E) {
    const int tid = threadIdx.x, wid = __builtin_amdgcn_readfirstlane(tid >> 6), lane = tid & 63, wr = wid >> 2, wc = wid & 3, fr = lane & 15, fq = lane >> 4;
    const int K = g.K, nt = K / BK, LD = g.ld ? g.ld : g.K;
    unsigned voffA[2], voffB[2];
#pragma unroll
    for (int i = 0; i < 2; ++i) { int R, C; stage_rc(tid * 16 + i * 8192, R, C); const int Rb = Epi::PERM ? ((R & ~31) + perm32(R & 31)) : R;
        voffA[i] = (unsigned)(R * LD + C) * 2u; voffB[i] = (unsigned)(Rb * LD + C) * 2u; }
    const size_t kstep = (size_t)(BK * 2);
    const size_t hstep = (size_t)HALF * LD * 2;
    const size_t tstep = 2 * hstep;
    const unsigned ldsw = (unsigned)wid * 1024u;
    const int aoff = lds_byte(wr * 64 + fr, fq * 8), boff = lds_byte(wc * 32 + fr, fq * 8);
#define PG8_SA(b, h) (((b) * 2 + (h)) * HTB)
#define PG8_SB(b, h) ((4 + (b) * 2 + (h)) * HTB)
#define PG8_STAGE(bufoff, gbase, voff) do { _Pragma("unroll") for (int _i = 0; _i < 2; ++_i) \
        __builtin_amdgcn_global_load_lds((const unsigned*)((const char*)(gbase) + (voff)[_i]), (PG8_LAS unsigned*)(lds + (bufoff) + ldsw + _i * 8192), 16, 0, 0); } while (0)
#define PG8_LD32(p) __builtin_shufflevector(*(const PG8_LAS i32x4*)(p), *(const PG8_LAS i32x4*)((p) + 1024), 0, 1, 2, 3, 4, 5, 6, 7)
#define PG8_LDA(dst, b, h) do { if constexpr (F8) { _Pragma("unroll") for (int m = 0; m < 4; ++m) dst##8[m] = PG8_LD32(lds + PG8_SA(b, h) + aoff + m * 2048); } else { \
        _Pragma("unroll") for (int m = 0; m < 4; ++m) _Pragma("unroll") for (int k = 0; k < 2; ++k) dst[m][k] = *(const PG8_LAS bf16x8*)(lds + PG8_SA(b, h) + aoff + m * 2048 + k * 1024); } } while (0)
#define PG8_LDB(dst, b, h) do { if constexpr (F8) { _Pragma("unroll") for (int n = 0; n < 2; ++n) dst##8[n] = PG8_LD32(lds + PG8_SB(b, h) + boff + n * 2048); } else { \
        _Pragma("unroll") for (int n = 0; n < 2; ++n) _Pragma("unroll") for (int k = 0; k < 2; ++k) dst[n][k] = *(const PG8_LAS bf16x8*)(lds + PG8_SB(b, h) + boff + n * 2048 + k * 1024); } } while (0)
#define PG8_MMA(ai, bj, At, Bt) do { __builtin_amdgcn_s_setprio(1); if constexpr (F8) { _Pragma("unroll") for (int m = 0; m < 4; ++m) _Pragma("unroll") for (int n = 0; n < 2; ++n) \
        asm("v_mfma_f32_16x16x128_f8f6f4 %0, %1, %2, %0" : "+v"(acc[ai][bj][m][n]) : "v"(Bt##8[n]), "v"(At##8[m])); } else { \
        _Pragma("unroll") for (int m = 0; m < 4; ++m) _Pragma("unroll") for (int n = 0; n < 2; ++n) _Pragma("unroll") for (int k = 0; k < 2; ++k) \
        acc[ai][bj][m][n] = __builtin_amdgcn_mfma_f32_16x16x32_bf16(Bt[n][k], At[m][k], acc[ai][bj][m][n], 0, 0, 0); } __builtin_amdgcn_s_setprio(0); } while (0)
#define PG8_WAIT_V(n) asm volatile("s_waitcnt vmcnt(" #n ")" ::: "memory")
#define PG8_WAIT_L(n) asm volatile("s_waitcnt lgkmcnt(" #n ")" ::: "memory")
#define PG8_BAR __builtin_amdgcn_s_barrier()
#define PG8_SCHED __builtin_amdgcn_sched_barrier(0)
    Unit cur, nxt; int ui = 0;
    if (!S.next(0, cur)) return;
    f32x4 acc[2][2][4][2];
#pragma unroll
    for (int a = 0; a < 2; ++a)
#pragma unroll
        for (int b = 0; b < 2; ++b)
#pragma unroll
            for (int m = 0; m < 4; ++m)
#pragma unroll
                for (int n = 0; n < 2; ++n) acc[a][b][m][n] = (f32x4){0.f, 0.f, 0.f, 0.f};
    bf16x8 At[4][2], B0[2][2], B1[2][2]; i32x8 At8[4], B08[2], B18[2];
    const char* cA = (const char*)g.A + (size_t)cur.pm * tstep + cur.koff; const char* cB = (const char*)g.Bt + (size_t)cur.pn * tstep + cur.koff;
    S.a_ready(cur);
    if constexpr (SP2) {
        PG8_STAGE(PG8_SB(0, 0), cB, voffB); PG8_STAGE(PG8_SB(0, 1), cB + hstep, voffB); PG8_STAGE(PG8_SA(0, 0), cA, voffA); PG8_STAGE(PG8_SA(0, 1), cA + hstep, voffA);
        if (wr == 1) PG8_BAR;
        PG8_WAIT_V(2); PG8_BAR;
        PG8_STAGE(PG8_SB(1, 0), cB + kstep, voffB); PG8_STAGE(PG8_SA(1, 0), cA + kstep, voffA); PG8_STAGE(PG8_SB(1, 1), cB + hstep + kstep, voffB);
        PG8_WAIT_V(6); PG8_BAR;
    } else {
        PG8_STAGE(PG8_SB(0, 0), cB, voffB); PG8_STAGE(PG8_SA(0, 0), cA, voffA); PG8_STAGE(PG8_SB(0, 1), cB + hstep, voffB); PG8_STAGE(PG8_SA(0, 1), cA + hstep, voffA);
        if (wr == 1) PG8_BAR;
        PG8_WAIT_V(4); PG8_BAR;
        PG8_STAGE(PG8_SB(1, 0), cB + kstep, voffB); PG8_STAGE(PG8_SA(1, 0), cA + kstep, voffA); PG8_STAGE(PG8_SB(1, 1), cB + hstep + kstep, voffB);
        PG8_WAIT_V(6); PG8_BAR;
    }
    for (;;) {
        const bool has_next = S.next(ui + 1, nxt);
        const char* nA = has_next ? (const char*)g.A + (size_t)nxt.pm * tstep + nxt.koff : cA; const char* nB = has_next ? (const char*)g.Bt + (size_t)nxt.pn * tstep + nxt.koff : cB;
#pragma clang loop unroll(disable)
        for (int t = 0; t < nt; t += 2) {
            const bool last = (t == nt - 2);
            const char* a1 = cA + (size_t)(t + 1) * kstep;
            const char* a2 = last ? nA : cA + (size_t)(t + 2) * kstep; const char* b2 = last ? nB : cB + (size_t)(t + 2) * kstep;
            const char* a3 = a2 + kstep; const char* b3 = b2 + kstep;
            if (last && has_next) S.a_ready(nxt);
            if constexpr (SP2) {
            PG8_LDB(B0, 0, 0); PG8_LDB(B1, 0, 1); PG8_SCHED; PG8_LDA(At, 0, 0); PG8_STAGE(PG8_SA(1, 1), a1 + hstep, voffA);
            PG8_WAIT_V(8); PG8_WAIT_L(0); PG8_BAR; PG8_MMA(0, 0, At, B0); PG8_MMA(0, 1, At, B1); PG8_BAR; PG8_SCHED;
            PG8_LDA(At, 0, 1); PG8_STAGE(PG8_SB(0, 0), b2, voffB); PG8_STAGE(PG8_SB(0, 1), b2 + hstep, voffB); PG8_STAGE(PG8_SA(0, 0), a2, voffA);
            PG8_WAIT_V(8); PG8_WAIT_L(0); PG8_BAR; PG8_MMA(1, 0, At, B0); PG8_MMA(1, 1, At, B1); PG8_BAR; PG8_SCHED;
            PG8_LDB(B0, 1, 0); PG8_LDB(B1, 1, 1); PG8_SCHED; PG8_LDA(At, 1, 0); PG8_STAGE(PG8_SA(0, 1), a2 + hstep, voffA);
            PG8_WAIT_V(8); PG8_WAIT_L(0); PG8_BAR; PG8_MMA(0, 0, At, B0); PG8_MMA(0, 1, At, B1); PG8_BAR; PG8_SCHED;
            PG8_LDA(At, 1, 1); PG8_STAGE(PG8_SB(1, 0), b3, voffB); PG8_STAGE(PG8_SB(1, 1), b3 + hstep, voffB); PG8_STAGE(PG8_SA(1, 0), a3, voffA);
            PG8_WAIT_V(8); PG8_WAIT_L(0); PG8_BAR; PG8_MMA(1, 0, At, B0); PG8_MMA(1, 1, At, B1); PG8_BAR; PG8_SCHED;
            } else {
            PG8_LDB(B0, 0, 0); PG8_SCHED; PG8_LDA(At, 0, 0); PG8_STAGE(PG8_SA(1, 1), a1 + hstep, voffA);
            PG8_WAIT_L(8); PG8_BAR; PG8_WAIT_L(0); PG8_MMA(0, 0, At, B0); PG8_BAR; PG8_SCHED;
            PG8_LDB(B1, 0, 1); PG8_STAGE(PG8_SB(0, 0), b2, voffB);
            PG8_BAR; PG8_WAIT_L(0); PG8_MMA(0, 1, At, B1); PG8_BAR;
            PG8_LDA(At, 0, 1); PG8_STAGE(PG8_SA(0, 0), a2, voffA);
            PG8_BAR; PG8_WAIT_L(0); PG8_MMA(1, 0, At, B0); PG8_BAR; PG8_SCHED;
            PG8_STAGE(PG8_SB(0, 1), b2 + hstep, voffB);
            PG8_WAIT_V(6); PG8_BAR; PG8_MMA(1, 1, At, B1); PG8_BAR;
            PG8_LDB(B0, 1, 0); PG8_SCHED; PG8_LDA(At, 1, 0); PG8_STAGE(PG8_SA(0, 1), a2 + hstep, voffA);
            PG8_WAIT_L(8); PG8_BAR; PG8_WAIT_L(0); PG8_MMA(0, 0, At, B0); PG8_BAR; PG8_SCHED;
            PG8_LDB(B1, 1, 1); PG8_STAGE(PG8_SB(1, 0), b3, voffB);
            PG8_BAR; PG8_WAIT_L(0); PG8_MMA(0, 1, At, B1); PG8_BAR;
            PG8_LDA(At, 1, 1); PG8_STAGE(PG8_SA(1, 0), a3, voffA);
            PG8_BAR; PG8_WAIT_L(0); PG8_MMA(1, 0, At, B0); PG8_BAR; PG8_SCHED;
            PG8_STAGE(PG8_SB(1, 1), b3 + hstep, voffB);
            PG8_WAIT_V(6); PG8_BAR; PG8_MMA(1, 1, At, B1); PG8_BAR;
            }
        }
        if constexpr (F8) asm volatile("s_nop 15\n\ts_nop 15" ::: "memory");
        if constexpr (ALIGN_EPI) { if (wr == 0) PG8_BAR; }
        if constexpr (!Epi::AFTER_DRAIN) { E(acc, cur, wr, wc, fr, fq); S.done(cur); }
        if (!has_next) break;
#pragma unroll
        for (int a = 0; a < 2; ++a)
#pragma unroll
            for (int b = 0; b < 2; ++b)
#pragma unroll
                for (int m = 0; m < 4; ++m)
#pragma unroll
                    for (int n = 0; n < 2; ++n) acc[a][b][m][n] = (f32x4){0.f, 0.f, 0.f, 0.f};
        cur = nxt; cA = nA; cB = nB; ++ui;
        if constexpr (ALIGN_EPI) { if (wr == 1) PG8_BAR; }
    }
    PG8_WAIT_V(0);
    if constexpr (!ALIGN_EPI) { if (wr == 0) PG8_BAR; }
    PG8_BAR;
    if constexpr (Epi::AFTER_DRAIN) { E.fused(acc, cur, wr, wc, fr, fq, lds, wid, lane); S.done(cur); }
#undef PG8_SA
#undef PG8_SB
#undef PG8_STAGE
#undef PG8_LDA
#undef PG8_LDB
#undef PG8_MMA
#undef PG8_LD32
#undef PG8_WAIT_V
#undef PG8_WAIT_L
#undef PG8_BAR
#undef PG8_SCHED
}
}

constexpr int NWAVES = 8;
constexpr int BATCH = 2, SEQ = 8192, D = 1024, M = BATCH * SEQ;
constexpr int HD = 128, NH = 8, NKV = 2, NIH = 8, IDX = 64, TOPK = 256;
constexpr int A_IN = 2120, FF = 2816, NE = 8;
constexpr int MAXSLOT = 34816;
constexpr float QSCALE = 0.12751743082459868f;
constexpr float SBSCALE = 0.08838834764831845f;
constexpr float WISCALE = 0.04419417382415922f;
constexpr size_t MiB = 1u << 20;
constexpr size_t WS_CTL = 0, CTL_ZERO_BYTES = 1 * MiB;
constexpr size_t WS_WIN = 2 * MiB, WS_WTAIL = 6 * MiB, WS_WOA = 7 * MiB, WS_WGU = 9 * MiB, WS_WD = 20 * MiB, WS_WKVQ = 26 * MiB, WS_WOB = 32 * MiB, WS_WGUM = 34 * MiB, WS_WDM = 122 * MiB;
constexpr size_t WS_H = 166 * MiB, WS_XB = 230 * MiB, WS_SS0 = 262 * MiB, WS_SS1 = 263 * MiB, WS_SS2 = 264 * MiB, WS_SS3 = 265 * MiB;
constexpr size_t WS_T = 266 * MiB;
constexpr size_t WS_PROJ = WS_T, WS_QF = 330 * MiB, WS_KVF = 362 * MiB, WS_QIF = 378 * MiB, WS_KIF = 394 * MiB, WS_WIF = 396 * MiB, WS_SEL = 397 * MiB, WS_AO = 413 * MiB;
constexpr size_t WS_HF = WS_T, WS_KQ = WS_T, WS_VT = 330 * MiB;
constexpr size_t WS_XPERM = WS_T, WS_HM = 334 * MiB, WS_Y = 521 * MiB;
constexpr size_t WS_RT = 590 * MiB;
constexpr size_t WS_END = 591 * MiB;
constexpr int CW_CNT = 64;
constexpr int CW_P3Q = 192;
constexpr int CW_BAR = 4096;
constexpr int RING_BYTES = 131072, LDSCTL_OFF = RING_BYTES, MISC_OFF = LDSCTL_OFF + 320, LDS_BYTES = 147456;

#define GAS __attribute__((address_space(1)))
#define LAS __attribute__((address_space(3)))
typedef unsigned short bf16;
typedef unsigned v4u __attribute__((ext_vector_type(4)));
typedef unsigned v2u __attribute__((ext_vector_type(2)));
typedef float f32x4 __attribute__((ext_vector_type(4)));
typedef short bf16x8 __attribute__((ext_vector_type(8)));
typedef float f32x16 __attribute__((ext_vector_type(16)));
typedef GAS unsigned gu32;
#define RLX_AGENT __ATOMIC_RELAXED, __HIP_MEMORY_SCOPE_AGENT
#define LDS_WAIT() asm volatile("s_waitcnt lgkmcnt(0)" ::: "memory")
#define VM_WAIT() asm volatile("s_waitcnt vmcnt(0)" ::: "memory")
__device__ __forceinline__ unsigned f2bf(float f) { unsigned u = __builtin_bit_cast(unsigned, f); return (u + 0x7fffu + ((u >> 16) & 1u)) >> 16; }
__device__ __forceinline__ unsigned pk2(float lo, float hi) { return f2bf(lo) | (f2bf(hi) << 16); }
__device__ __forceinline__ float bflo(unsigned w) { return __uint_as_float(w << 16); }
__device__ __forceinline__ float bfhi(unsigned w) { return __uint_as_float(w & 0xffff0000u); }
__device__ __forceinline__ float wave_sum(float v) {
#pragma unroll
    for (int o = 1; o < 64; o <<= 1) v += __shfl_xor(v, o);
    return v;
}
__device__ __forceinline__ float wave_max(float v) {
#pragma unroll
    for (int o = 1; o < 64; o <<= 1) v = fmaxf(v, __shfl_xor(v, o));
    return v;
}
__device__ __forceinline__ void sincos_acc(float a, float& c, float& s) {
    const double x = (double)a; const double n = __builtin_rint(x * 0.63661977236758134308);
    const double r = __builtin_fma(-n, 6.123233995736766035869e-17, __builtin_fma(-n, 1.57079632679489655800, x)); const double r2 = r * r;
    double sn = 1.0 - r2 * (1.0 / 156.0); sn = 1.0 - r2 * (1.0 / 110.0) * sn; sn = 1.0 - r2 * (1.0 / 72.0) * sn; sn = 1.0 - r2 * (1.0 / 42.0) * sn; sn = 1.0 - r2 * (1.0 / 20.0) * sn; sn = 1.0 - r2 * (1.0 / 6.0) * sn; sn *= r;
    double cs = 1.0 - r2 * (1.0 / 182.0); cs = 1.0 - r2 * (1.0 / 132.0) * cs; cs = 1.0 - r2 * (1.0 / 90.0) * cs; cs = 1.0 - r2 * (1.0 / 56.0) * cs; cs = 1.0 - r2 * (1.0 / 30.0) * cs; cs = 1.0 - r2 * (1.0 / 12.0) * cs; cs = 1.0 - r2 * 0.5 * cs;
    const int q = ((int)n) & 3;
    const double cq = (q == 0) ? cs : (q == 1) ? -sn : (q == 2) ? -cs : sn;
    const double sq = (q == 0) ? sn : (q == 1) ? cs : (q == 2) ? -sn : -cs;
    c = (float)cq; s = (float)sq;
}
__device__ const float INV_Q[16] = {1.000000000e+00f, 4.403665960e-01f, 1.939227432e-01f, 8.539710194e-02f, 3.760603070e-02f, 1.656043902e-02f, 7.292664610e-03f, 3.211445874e-03f,
                                    1.414213562e-03f, 6.227723788e-04f, 2.742481884e-04f, 1.207697351e-04f, 5.318296098e-05f, 2.341999971e-05f, 1.031338616e-05f, 4.541670478e-06f};
__device__ const float INV_I[8] = {1.000000000e+00f, 1.939227432e-01f, 3.760603070e-02f, 7.292664610e-03f, 1.414213562e-03f, 2.742481884e-04f, 5.318296098e-05f, 1.031338616e-05f};

#define XB_TMO      128
#define XB_XCNT(j)  (256  + 64 * (j))
#define XB_XSUB(j)  (1280 + 64 * (j))
#define XB_XGEN(j)  (2304 + 64 * (j))
#define XB_TOP      3328
#define XB_TOPGEN   3392
#define XCD_BAR_WORDS 3456
#define XB_SPIN_CAP (1u << 18)

__device__ __forceinline__ unsigned xb_ld(unsigned* p)              { return __hip_atomic_load(p, __ATOMIC_RELAXED, __HIP_MEMORY_SCOPE_AGENT); }
__device__ __forceinline__ unsigned xb_add(unsigned* p, unsigned v) { return __hip_atomic_fetch_add(p, v, __ATOMIC_RELAXED, __HIP_MEMORY_SCOPE_AGENT); }
__device__ __forceinline__ unsigned xb_xcc_id() { return (unsigned)__builtin_amdgcn_s_getreg((3 << 11) | 20) & 0xFu; }
#define XB_SPIN(cond, bar) do { unsigned _sp = 0; while (cond) { __builtin_amdgcn_s_sleep(1); \
    if ((++_sp & 255u) == 0u) { if (xb_ld(&(bar)[XB_TMO])) break; if (_sp > XB_SPIN_CAP) { atomicAdd(&(bar)[XB_TMO], 1u); break; } } } } while (0)

struct XcdBarrier {
    unsigned* bar; unsigned x;
    volatile LAS unsigned* st;
};

__device__ __forceinline__ XcdBarrier xcd_barrier_post(unsigned* bar, volatile LAS unsigned* st) {
    XcdBarrier b; b.bar = bar; b.x = xb_xcc_id(); b.st = st;
    if (threadIdx.x == 0) (void)xb_add(&bar[XB_XCNT(b.x)], 1u);
    return b;
}
__device__ __forceinline__ void xcd_barrier_complete(unsigned* bar, unsigned x, unsigned& nloc, unsigned& nx) {
    const unsigned G = gridDim.x * gridDim.y * gridDim.z;
    unsigned sum, cnt, mine, sp = 0u;
    for (;;) {
        sum = 0u; cnt = 0u; mine = 0u;
#pragma unroll
        for (unsigned j = 0; j < 16; ++j) { const unsigned c = xb_ld(&bar[XB_XCNT(j)]); sum += c; cnt += (c > 0u) ? 1u : 0u; mine = (j == x) ? c : mine; }
        if (sum == G) break;
        __builtin_amdgcn_s_sleep(1);
        if ((++sp & 255u) == 0u) { if (xb_ld(&bar[XB_TMO])) break; if (sp > XB_SPIN_CAP) { atomicAdd(&bar[XB_TMO], 1u); break; } }
    }
    nloc = mine > 0u ? mine : 1u; nx = cnt > 0u ? cnt : 1u;
}

__device__ __forceinline__ void xcd_barrier(const XcdBarrier& b) {
    asm volatile("s_waitcnt vmcnt(0)" ::: "memory");
    __syncthreads();
    if (threadIdx.x == 0) {
        unsigned* bar = b.bar;
        __builtin_amdgcn_s_waitcnt(0);
        unsigned nloc = b.st[0], nx = b.st[1];
        if (nloc == 0u) { xcd_barrier_complete(bar, b.x, nloc, nx); b.st[0] = nloc; b.st[1] = nx; }
        const unsigned old = xb_add(&bar[XB_XSUB(b.x)], 1u);
        const unsigned gen = old / nloc;
        if (old + 1u == (gen + 1u) * nloc) {
            __builtin_amdgcn_fence(__ATOMIC_RELEASE, "agent");
            asm volatile("s_waitcnt vmcnt(0)" ::: "memory");
            const unsigned og = xb_add(&bar[XB_TOP], 1u);
            const unsigned tg = og / nx;
            if (og + 1u == (tg + 1u) * nx) xb_add(&bar[XB_TOPGEN], 1u);
            else XB_SPIN(xb_ld(&bar[XB_TOPGEN]) == tg, bar);
            __builtin_amdgcn_fence(__ATOMIC_ACQUIRE, "agent");
            xb_add(&bar[XB_XGEN(b.x)], 1u);
            asm volatile("s_waitcnt vmcnt(0)" ::: "memory");
        } else {
            XB_SPIN(xb_ld(&bar[XB_XGEN(b.x)]) == gen, bar);
            __builtin_amdgcn_fence(__ATOMIC_ACQUIRE, "agent");
            asm volatile("s_waitcnt vmcnt(0)" ::: "memory");
        }
    }
    __syncthreads();
}

struct Frame {
    LAS unsigned char* lds;
    volatile LAS unsigned* MISC;
    gu32* ctl;
    int tid, lane, wave, G, bid;
    const float* in[17];
    float* out; unsigned char* ws;
};
enum { IN_X = 0, IN_ANORM, IN_AWIN, IN_AQN, IN_AKN, IN_AWOUT, IN_KVNORM, IN_KVW, IN_BNORM, IN_BWQ, IN_BWOUT, IN_FFNNORM, IN_DGU, IN_DDN, IN_ROUTER, IN_MGU, IN_MDN };

struct TrItem { const float* W; size_t ldw; int K, k0, csrc0, cend; bf16* WT; int drow0; const float* gain; float scale; int f8; };
__device__ __forceinline__ int gu_row(int c0) { return (c0 < FF) ? ((c0 >> 7) * 256 + (c0 & 127)) : (((c0 - FF) >> 7) * 256 + 128 + ((c0 - FF) & 127)); }
constexpr int I_WIN = 16 * 32, I_TAIL = 16 * 2, I_SQ = 16 * 16, I_GU = 16 * 88, I_DN = 44 * 16, I_KV = 16 * 32;
constexpr int TR_NITEMS = I_WIN + I_TAIL + I_SQ + I_GU + I_DN + I_KV + I_SQ + I_SQ + NE * I_GU + NE * I_DN;
__device__ __forceinline__ TrItem tr_decode(const Frame& F, int it) {
    unsigned char* ws = F.ws; int r = it; TrItem t;
    if (r < I_WIN) { const int kb = r / 32, nb = r % 32; t = TrItem{F.in[IN_AWIN], (size_t)A_IN, D, 64 * kb, 64 * nb, A_IN, (bf16*)(ws + WS_WIN), 64 * nb, F.in[IN_ANORM], 1.f}; return t; } r -= I_WIN;
    if (r < I_TAIL) { const int kb = r / 2, nb = r % 2; t = TrItem{F.in[IN_AWIN], (size_t)A_IN, D, 64 * kb, 2048 + 64 * nb, A_IN, (bf16*)(ws + WS_WTAIL), 64 * nb, F.in[IN_ANORM], 1.f}; return t; } r -= I_TAIL;
    if (r < I_SQ) { const int kb = r / 16, nb = r % 16; t = TrItem{F.in[IN_AWOUT], (size_t)D, D, 64 * kb, 64 * nb, D, (bf16*)(ws + WS_WOA), 64 * nb, nullptr, 1.f}; return t; } r -= I_SQ;
    if (r < I_GU) { const int kb = r / 88, nb = r % 88; t = TrItem{F.in[IN_DGU], (size_t)(2 * FF), D, 64 * kb, 64 * nb, 2 * FF, (bf16*)(ws + WS_WGU), gu_row(64 * nb), F.in[IN_FFNNORM], pg8::F8_SWGU, 1}; return t; } r -= I_GU;
    if (r < I_DN) { const int kb = r / 16, nb = r % 16; t = TrItem{F.in[IN_DDN], (size_t)D, FF, 64 * kb, 64 * nb, D, (bf16*)(ws + WS_WD), 64 * nb, nullptr, pg8::F8_SWD, 1}; return t; } r -= I_DN;
    if (r < I_KV) { const int kb = r / 32, nb = r % 32; t = TrItem{F.in[IN_KVW], (size_t)(2 * D), D, 64 * kb, 64 * nb, 2 * D, (bf16*)(ws + WS_WKVQ), (nb < 16) ? 64 * nb : 1024 + 64 * nb, F.in[IN_KVNORM], 1.f}; return t; } r -= I_KV;
    if (r < I_SQ) { const int kb = r / 16, nb = r % 16; t = TrItem{F.in[IN_BWQ], (size_t)D, D, 64 * kb, 64 * nb, D, (bf16*)(ws + WS_WKVQ), 1024 + 64 * nb, F.in[IN_BNORM], SBSCALE}; return t; } r -= I_SQ;
    if (r < I_SQ) { const int kb = r / 16, nb = r % 16; t = TrItem{F.in[IN_BWOUT], (size_t)D, D, 64 * kb, 64 * nb, D, (bf16*)(ws + WS_WOB), 64 * nb, nullptr, 1.f}; return t; } r -= I_SQ;
    if (r < NE * I_GU) { const int e = r / I_GU, rr = r % I_GU, kb = rr / 88, nb = rr % 88;
        t = TrItem{F.in[IN_MGU] + (size_t)e * D * 2 * FF, (size_t)(2 * FF), D, 64 * kb, 64 * nb, 2 * FF, (bf16*)(ws + WS_WGUM), e * 2 * FF + gu_row(64 * nb), F.in[IN_FFNNORM] + D, pg8::F8_SWGU, 1}; return t; } r -= NE * I_GU;
    { const int e = r / I_DN, rr = r % I_DN, kb = rr / 16, nb = rr % 16;
      t = TrItem{F.in[IN_MDN] + (size_t)e * FF * D, (size_t)D, FF, 64 * kb, 64 * nb, D, (bf16*)(ws + WS_WDM), e * D + 64 * nb, nullptr, pg8::F8_SWD, 1}; return t; }
}
__device__ __forceinline__ void tr_load(const TrItem& t, f32x4 (&v)[16], int lane) {
    const int r = lane >> 4, c = t.csrc0 + 4 * (lane & 15); const bool ok = c < t.cend; const float* src = t.W + (size_t)(t.k0 + r) * t.ldw + (ok ? c : 0);
#pragma unroll
    for (int i = 0; i < 16; ++i) { const f32x4 x = __builtin_nontemporal_load((const f32x4*)(src + (size_t)(4 * i) * t.ldw)); v[i] = ok ? x : (f32x4){0.f, 0.f, 0.f, 0.f}; }
}
__device__ __forceinline__ void tr_store(const TrItem& t, const f32x4 (&v)[16], LAS float* scr, int lane) {
    const int r = lane >> 4, c4 = lane & 15;
#pragma unroll
    for (int i = 0; i < 16; ++i) { const int k = 4 * i + r; const float g = t.gain ? t.gain[t.k0 + k] * t.scale : t.scale;
        *(LAS f32x4*)(scr + k * 64 + 4 * (c4 ^ ((k >> 3) & 7))) = v[i] * g; }
    LDS_WAIT(); asm volatile("" ::: "memory");
    if (t.f8) {
        const int c4b = lane & 3;
#pragma unroll
        for (int j = 0; j < 4; ++j) { const int n = (lane >> 2) + 16 * j;
            const LAS float* s0 = scr + (16 * c4b) * 64 + (n ^ ((2 * c4b) << 2)); const LAS float* s1 = scr + (16 * c4b + 8) * 64 + (n ^ ((2 * c4b + 1) << 2));
            v4u o; o.x = pg8::pk4_fp8(s0[0 * 64], s0[1 * 64], s0[2 * 64], s0[3 * 64]); o.y = pg8::pk4_fp8(s0[4 * 64], s0[5 * 64], s0[6 * 64], s0[7 * 64]);
            o.z = pg8::pk4_fp8(s1[0 * 64], s1[1 * 64], s1[2 * 64], s1[3 * 64]); o.w = pg8::pk4_fp8(s1[4 * 64], s1[5 * 64], s1[6 * 64], s1[7 * 64]);
            *(GAS v4u*)((unsigned char*)t.WT + (size_t)(t.drow0 + n) * t.K + t.k0 + 16 * c4b) = o; }
    } else {
    const int c8 = lane & 7;
#pragma unroll
    for (int j = 0; j < 8; ++j) { const int n = (lane >> 3) + 8 * j; const LAS float* s = scr + (8 * c8) * 64 + (n ^ (c8 << 2));
        v4u o; o.x = pk2(s[0 * 64], s[1 * 64]); o.y = pk2(s[2 * 64], s[3 * 64]); o.z = pk2(s[4 * 64], s[5 * 64]); o.w = pk2(s[6 * 64], s[7 * 64]);
        *(GAS v4u*)(t.WT + (size_t)(t.drow0 + n) * t.K + t.k0 + 8 * c8) = o; }
    }
    LDS_WAIT(); asm volatile("" ::: "memory");
}
__device__ __forceinline__ void p0_prologue(Frame& F) {
    LAS float* scr = (LAS float*)(F.lds + F.wave * 16384);
    const int gw = F.wave * F.G + F.bid, NGW = F.G * NWAVES;
    unsigned char* ws = F.ws;
    {
        f32x4 va[16], vb[16];
        int it = gw;
        if (it < TR_NITEMS) { TrItem cur = tr_decode(F, it); tr_load(cur, va, F.lane);
            for (;;) {
                const int nx = it + NGW; const bool has = nx < TR_NITEMS; TrItem nxt = cur;
                if (has) { nxt = tr_decode(F, nx); tr_load(nxt, vb, F.lane); }
                tr_store(cur, va, scr, F.lane);
                if (!has) break;
                it = nx + NGW; const bool has2 = it < TR_NITEMS; TrItem nn = nxt;
                if (has2) { nn = tr_decode(F, it); tr_load(nn, va, F.lane); }
                tr_store(nxt, vb, scr, F.lane);
                if (!has2) break;
                cur = nn;
            }
        }
    }
    const float* x = F.in[IN_X]; bf16* XB = (bf16*)(ws + WS_XB);
    for (int m = gw; m < M; m += NGW) {
        const GAS f32x4* xr = (const GAS f32x4*)(x + (size_t)m * D) + F.lane; f32x4 v[4]; float s = 0.f;
#pragma unroll
        for (int j = 0; j < 4; ++j) { v[j] = xr[64 * j]; s += (v[j].x * v[j].x + v[j].y * v[j].y) + (v[j].z * v[j].z + v[j].w * v[j].w); }
        s = wave_sum(s); const float rs = 1.0f / sqrtf(s * (1.0f / 1024.0f) + 1e-6f);
        GAS unsigned long long* o8 = (GAS unsigned long long*)(XB + (size_t)m * D) + F.lane;
#pragma unroll
        for (int j = 0; j < 4; ++j) o8[64 * j] = (unsigned long long)pk2(v[j].x * rs, v[j].y * rs) | ((unsigned long long)pk2(v[j].z * rs, v[j].w * rs) << 32);
    }
}

#define WAVE_SYNC() asm volatile("s_waitcnt lgkmcnt(0)" ::: "memory")
__device__ __forceinline__ void rope8(float (&y)[8], bool isx1, bool isx2, int i0, int pshift, LAS const float* tab) {
#pragma unroll
    for (int e = 0; e < 8; ++e) {
        const float other = __shfl_xor(y[e], pshift); const float c = tab[2 * (i0 + e)], s = tab[2 * (i0 + e) + 1];
        y[e] = isx1 ? (y[e] * c - other * s) : (isx2 ? (y[e] * c + other * s) : y[e]);
    }
}
__device__ __forceinline__ size_t kif_off(int grow, int d) { return ((((size_t)(grow >> 5) * 4 + ((d >> 3) & 3)) * 2 + (d >> 5)) * 32 + (grow & 31)) * 8 + (d & 7); }
__device__ __forceinline__ void unpack8(const v4u w, float (&y)[8]) { y[0] = bflo(w.x); y[1] = bfhi(w.x); y[2] = bflo(w.y); y[3] = bfhi(w.y); y[4] = bflo(w.z); y[5] = bfhi(w.z); y[6] = bflo(w.w); y[7] = bfhi(w.w); }
__device__ __forceinline__ v4u pack8(const float (&y)[8]) { v4u o; o.x = pk2(y[0], y[1]); o.y = pk2(y[2], y[3]); o.z = pk2(y[4], y[5]); o.w = pk2(y[6], y[7]); return o; }
__device__ __forceinline__ void p2_post(Frame& F) {
    unsigned char* ws = F.ws; const int lane = F.lane;
    const bf16* PROJ = (const bf16*)(ws + WS_PROJ); const bf16* XB = (const bf16*)(ws + WS_XB); const bf16* WT = (const bf16*)(ws + WS_WTAIL);
    bf16* QF = (bf16*)(ws + WS_QF); bf16* KVF = (bf16*)(ws + WS_KVF); bf16* QIF = (bf16*)(ws + WS_QIF); bf16* KIF = (bf16*)(ws + WS_KIF); float* WIF = (float*)(ws + WS_WIF);
    const float* qnw = F.in[IN_AQN]; const float* knw = F.in[IN_AKN];
    LAS float* tab = (LAS float*)(F.lds + F.wave * 256);
    const int gw = F.wave * F.G + F.bid, NGW = F.G * NWAVES;
    for (int task = gw; task < M / 8; task += NGW) {
        const int row0 = task * 8;
        f32x4 acc[5];
#pragma unroll
        for (int c = 0; c < 5; ++c) acc[c] = (f32x4){0.f, 0.f, 0.f, 0.f};
        const bf16* ap = XB + (size_t)(row0 + (lane & 7)) * D + 8 * (lane >> 4);
        const bf16* bp = WT + (size_t)(lane & 15) * D + 8 * (lane >> 4);
#pragma unroll 4
        for (int j = 0; j < 32; ++j) {
            const bf16x8 a = *(const bf16x8*)(ap + 32 * j);
#pragma unroll
            for (int c = 0; c < 5; ++c) { const bf16x8 b = *(const bf16x8*)(bp + (size_t)(16 * c) * D + 32 * j); acc[c] = __builtin_amdgcn_mfma_f32_16x16x32_bf16(a, b, acc[c], 0, 0, 0); }
        }
        if (lane < 32) {
#pragma unroll
            for (int reg = 0; reg < 4; ++reg) {
                const int row = row0 + 4 * (lane >> 4) + reg; const float rs = 1.0f; const float pos = (float)(row & (SEQ - 1));
                const int d = lane & 15;
                float v0 = acc[0][reg] * rs; const float other = __shfl_xor(v0, 8);
                { float c, s; sincos_acc(pos * INV_I[d & 7], c, s); v0 = (d < 8) ? (v0 * c - other * s) : (v0 * c + other * s); }
                KIF[kif_off(row, d)] = (bf16)f2bf(v0);
#pragma unroll
                for (int c = 1; c < 4; ++c) KIF[kif_off(row, 16 * c + d)] = (bf16)f2bf(acc[c][reg] * rs);
                if (d < 8) WIF[(size_t)row * 8 + d] = acc[4][reg] * rs * WISCALE;
            }
        }
        for (int r = 0; r < 8; ++r) {
            const int row = row0 + r, b = row >> 13, t = row & (SEQ - 1); const float pos = (float)t;
            const bf16* pr = PROJ + (size_t)row * 2048 + 8 * lane;
            v4u w[4];
#pragma unroll
            for (int j = 0; j < 4; ++j) w[j] = __builtin_nontemporal_load((const v4u*)(pr + 512 * j));
            if (lane < 24) { float c, s; sincos_acc(pos * ((lane < 16) ? INV_Q[lane & 15] : INV_I[lane & 7]), c, s); tab[2 * lane] = c; tab[2 * lane + 1] = s; }
            WAVE_SYNC();
#pragma unroll
            for (int j = 0; j < 2; ++j) {
                float y[8]; unpack8(w[j], y); float ss = 0.f;
#pragma unroll
                for (int e = 0; e < 8; ++e) ss += y[e] * y[e];
                ss += __shfl_xor(ss, 1); ss += __shfl_xor(ss, 2); ss += __shfl_xor(ss, 4); ss += __shfl_xor(ss, 8);
                const float rs = 1.0f / sqrtf(ss * (1.0f / 128.0f) + 1e-6f); const int c8 = (lane & 15) * 8;
#pragma unroll
                for (int e = 0; e < 8; ++e) y[e] = y[e] * rs * qnw[c8 + e];
                rope8(y, c8 < 16, c8 >= 16 && c8 < 32, c8 & 15, 2, tab);
#pragma unroll
                for (int e = 0; e < 8; ++e) y[e] *= QSCALE;
                *(v4u*)(QF + (size_t)row * D + 512 * j + 8 * lane) = pack8(y);
            }
            {
                float y[8]; unpack8(w[2], y); float ss = 0.f;
#pragma unroll
                for (int e = 0; e < 8; ++e) ss += y[e] * y[e];
                ss += __shfl_xor(ss, 1); ss += __shfl_xor(ss, 2); ss += __shfl_xor(ss, 4); ss += __shfl_xor(ss, 8);
                const bool isk = lane < 32; const float rs = 1.0f / sqrtf(ss * (1.0f / 128.0f) + 1e-6f); const int c8 = (lane & 15) * 8;
                if (isk) {
#pragma unroll
                    for (int e = 0; e < 8; ++e) y[e] = y[e] * rs * knw[c8 + e];
                }
                rope8(y, isk && c8 < 16, isk && c8 >= 16 && c8 < 32, c8 & 15, 2, tab);
                const int kvh = (lane >> 4) & 1;
                int w0 = __builtin_amdgcn_cvt_pk_fp8_f32(y[0], y[1], 0, false); w0 = __builtin_amdgcn_cvt_pk_fp8_f32(y[2], y[3], w0, true);
                int w1 = __builtin_amdgcn_cvt_pk_fp8_f32(y[4], y[5], 0, false); w1 = __builtin_amdgcn_cvt_pk_fp8_f32(y[6], y[7], w1, true);
                *(v2u*)((unsigned char*)KVF + ((size_t)(b * NKV + kvh) * SEQ + t) * 256 + (isk ? 0 : 128) + c8) = (v2u){(unsigned)w0, (unsigned)w1};
            }
            {
                float y[8]; unpack8(w[3], y); const int c8 = (lane & 7) * 8;
                rope8(y, c8 == 0, c8 == 8, 16, 1, tab);
                *(v4u*)(QIF + (size_t)row * 512 + 8 * lane) = pack8(y);
            }
            WAVE_SYNC();
        }
    }
}

__device__ __forceinline__ unsigned f2key(float f) { const unsigned u = __float_as_uint(f); return (u & 0x80000000u) ? ~u : (u | 0x80000000u); }
__device__ __forceinline__ void p3_query_naive(unsigned char* ws, LAS unsigned char* lds, int row, int* SEL) {
    const int tid = threadIdx.x, lane = tid & 63, wave = tid >> 6;
    const bf16* QIF = (const bf16*)(ws + WS_QIF); const bf16* KIF = (const bf16*)(ws + WS_KIF); const float* WIF = (const float*)(ws + WS_WIF);
    LAS unsigned* keys = (LAS unsigned*)lds;
    LAS float* qis = (LAS float*)(lds + 32768);
    LAS float* wl = (LAS float*)(lds + 32768 + 2048);
    LAS unsigned* hist = (LAS unsigned*)(lds + 36864);
    LAS unsigned* ctl = (LAS unsigned*)(lds + 36864 + 1024);
    LAS unsigned* wcnt = (LAS unsigned*)(lds + 36864 + 1024 + 64);
    {
        const int b = row >> 13, t = row & (SEQ - 1), n = t + 1;
        int* sel = SEL + (size_t)row * TOPK;
        if (n <= TOPK) { if (tid < TOPK) sel[tid] = tid < n ? tid : 0; return; }
        __syncthreads();
        qis[tid] = __uint_as_float((unsigned)QIF[(size_t)row * 512 + tid] << 16);
        if (tid < 8) wl[tid] = WIF[(size_t)row * 8 + tid];
        __syncthreads();
        for (int s = tid; s < n; s += 512) {
            const int grow = (b << 13) + s;
            float kf[64];
#pragma unroll
            for (int j = 0; j < 8; ++j) { const v4u w = *(const v4u*)(KIF + kif_off(grow, 8 * j)); kf[8 * j] = bflo(w.x); kf[8 * j + 1] = bfhi(w.x); kf[8 * j + 2] = bflo(w.y); kf[8 * j + 3] = bfhi(w.y); kf[8 * j + 4] = bflo(w.z); kf[8 * j + 5] = bfhi(w.z); kf[8 * j + 6] = bflo(w.w); kf[8 * j + 7] = bfhi(w.w); }
            float sc = 0.f;
#pragma unroll
            for (int h = 0; h < 8; ++h) { float d = 0.f; asm volatile("" ::: "memory");
#pragma unroll
                for (int dd = 0; dd < 64; ++dd) d += qis[h * 64 + dd] * kf[dd];
                sc += wl[h] * fmaxf(d, 0.f); }
            keys[s] = f2key(sc + 0.0f);
        }
        __syncthreads();
        unsigned prefix = 0u, mask = 0u, need = TOPK;
        for (int pass = 0; pass < 4; ++pass) {
            const int shift = 24 - 8 * pass;
            if (tid < 256) hist[tid] = 0u;
            __syncthreads();
            for (int s = tid; s < n; s += 512) { const unsigned k = keys[s]; if ((k & mask) == prefix) __hip_atomic_fetch_add(&hist[(k >> shift) & 255u], 1u, __ATOMIC_RELAXED, __HIP_MEMORY_SCOPE_WORKGROUP); }
            __syncthreads();
            if (tid < 64) {
                const unsigned h0 = hist[4 * lane], h1 = hist[4 * lane + 1], h2 = hist[4 * lane + 2], h3 = hist[4 * lane + 3]; const unsigned tot = h0 + h1 + h2 + h3;
                unsigned incl = tot;
#pragma unroll
                for (int o = 1; o < 64; o <<= 1) { const unsigned v = __shfl_down(incl, o); if (lane + o < 64) incl += v; }
                const unsigned above = incl - tot;
                if (above < need && need <= above + tot) {
                    unsigned a = above; unsigned bin;
                    if (a + h3 >= need) bin = 3; else { a += h3; if (a + h2 >= need) bin = 2; else { a += h2; if (a + h1 >= need) bin = 1; else { a += h1; bin = 0; } } }
                    ctl[0] = 4 * lane + bin; ctl[1] = need - a;
                }
            }
            __syncthreads();
            prefix |= ctl[0] << shift; mask |= 255u << shift; need = ctl[1];
            __syncthreads();
        }
        const unsigned thr = prefix, n_gt = TOPK - need;
        unsigned base_gt = 0u, base_eq = 0u;
        for (int s0 = 0; s0 < n; s0 += 512) {
            const int s = s0 + tid; const unsigned k = s < n ? keys[s] : 0u; const bool gt = (s < n) && (k > thr); const bool eq = (s < n) && (k == thr);
            const unsigned long long bg = __ballot(gt), be = __ballot(eq); const unsigned long long lt = (1ull << lane) - 1ull;
            const unsigned rg = __popcll(bg & lt), re = __popcll(be & lt);
            if (lane == 0) { wcnt[wave] = __popcll(bg); wcnt[8 + wave] = __popcll(be); }
            __syncthreads();
            unsigned og = base_gt, oe = base_eq, tg = 0u, te = 0u;
#pragma unroll
            for (int w = 0; w < 8; ++w) { const unsigned cg = wcnt[w], ce = wcnt[8 + w]; if (w < wave) { og += cg; oe += ce; } tg += cg; te += ce; }
            if (gt) sel[og + rg] = s;
            if (eq && oe + re < need) sel[n_gt + oe + re] = s;
            base_gt += tg; base_eq += te;
            __syncthreads();
        }
    }
}

constexpr int P3_HIST = 0, P3_H2 = 65536, P3_BM = 98304, P3_QS = 114688, P3_FLAG = P3_QS + 512, P3_CAP = 512;
__device__ __forceinline__ void find_bin_2048(LAS const unsigned* hist, unsigned need, int lane, unsigned& bin_out, unsigned& need_out, unsigned& cnt_out, bool& ok) {
    unsigned w[16]; unsigned tot = 0u;
#pragma unroll
    for (int i = 0; i < 16; ++i) { w[i] = hist[16 * lane + i]; tot += (w[i] & 0xffffu) + (w[i] >> 16); }
    unsigned incl = tot;
#pragma unroll
    for (int o = 1; o < 64; o <<= 1) { const unsigned v = __shfl_down(incl, o); if (lane + o < 64) incl += v; }
    const unsigned above = incl - tot;
    const bool mine = (above < need) && (need <= above + tot);
    unsigned a = above, fb = 0u, fn = 0u, fc = 0u; bool found = false;
#pragma unroll
    for (int i = 15; i >= 0; --i) {
        const unsigned h1 = w[i] >> 16, h0 = w[i] & 0xffffu;
        if (!found) { if (a + h1 >= need) { found = true; fb = 32u * lane + 2u * i + 1u; fn = need - a; fc = h1; } else a += h1; }
        if (!found) { if (a + h0 >= need) { found = true; fb = 32u * lane + 2u * i; fn = need - a; fc = h0; } else a += h0; }
    }
    const unsigned long long bm = __ballot(mine);
    ok = (bm != 0ull);
    const int src = ok ? (__ffsll((long long)bm) - 1) : 0;
    bin_out = (unsigned)__builtin_amdgcn_readlane((int)fb, src); need_out = (unsigned)__builtin_amdgcn_readlane((int)fn, src); cnt_out = (unsigned)__builtin_amdgcn_readlane((int)fc, src);
}
__device__ __forceinline__ unsigned bin11(float sc) { const unsigned u = __float_as_uint(sc); const int m = (int)((u & 0x7fffffffu) >> 17) - 7360; const unsigned mc = (unsigned)(m < 0 ? 0 : (m > 1023 ? 1023 : m)); return (u >> 31) ? (1023u - mc) : (1024u + mc); }
__device__ __forceinline__ float relu_i(float x) { const int xi = __builtin_bit_cast(int, x); const int ri = (xi < 0) ? 0 : xi; return __builtin_bit_cast(float, ri); }
#define RELU(x) relu_i(x)
typedef _Float16 f16x8 __attribute__((ext_vector_type(8)));
typedef short s16x2 __attribute__((ext_vector_type(2)));
__device__ __forceinline__ unsigned pk_relu_f16(float a, float b) { const s16x2 h = __builtin_bit_cast(s16x2, __builtin_amdgcn_cvt_pkrtz(a, b)); return __builtin_bit_cast(unsigned, __builtin_elementwise_max(h, (s16x2){0, 0})); }
__device__ __forceinline__ unsigned bin16(unsigned h) { const int m = (int)((h & 0x7fffu) >> 4) - 192; const unsigned mc = (unsigned)(m < 0 ? 0 : (m > 1023 ? 1023 : m)); return (h & 0x8000u) ? (1023u - mc) : (1024u + mc); }
__device__ __forceinline__ unsigned key16(unsigned h) { return (h & 0x8000u) ? (~h & 0xffffu) : (h | 0x8000u); }
__device__ __forceinline__ void p3_score_pass(const bf16x8 (&af)[2][4], const f16x8 (&wa)[2][2], const bf16* kib, int t0, int nt, int wave, int n, int hi,
                                              LAS unsigned char* lds, unsigned short* SC, int rot) {
    LAS unsigned* HIST = (LAS unsigned*)(lds + P3_HIST);
    const int qh = 8 * (wave >> 2), w4 = wave & 3;
    const int cnt4 = (nt - w4 + 3) >> 2; const int r0 = rot % cnt4;
    bf16x8 bq[4][4];
#define P3_LOADB(u, j) do { int jj_ = r0 + (j); jj_ = (jj_ >= cnt4) ? jj_ - cnt4 : jj_; const int t_ = w4 + 4 * jj_; \
        const bf16* kp_ = kib + ((size_t)t_ * 8 + hi) * 256 + n * 8; _Pragma("unroll") for (int s = 0; s < 4; ++s) bq[u][s] = *(const bf16x8*)(kp_ + s * 512); } while (0)
#pragma unroll
    for (int u = 0; u < 4; ++u) P3_LOADB(u, (u < cnt4) ? u : 0);
    for (int i0 = 0; i0 < cnt4; i0 += 4) {
#pragma unroll
        for (int u = 0; u < 4; ++u) {
            if (i0 + u < cnt4) {
                int jj = r0 + i0 + u; jj = (jj >= cnt4) ? jj - cnt4 : jj; const int tile = w4 + 4 * jj;
                const int key = 32 * tile + n; const bool full = (32 * tile + 31 <= t0);
                f32x16 acc0, acc1;
#pragma unroll
                for (int r = 0; r < 16; ++r) { acc0[r] = 0.f; acc1[r] = 0.f; }
#pragma unroll
                for (int s = 0; s < 4; ++s) acc0 = __builtin_amdgcn_mfma_f32_32x32x16_bf16(af[0][s], bq[u][s], acc0, 0, 0, 0);
#pragma unroll
                for (int s = 0; s < 4; ++s) acc1 = __builtin_amdgcn_mfma_f32_32x32x16_bf16(af[1][s], bq[u][s], acc1, 0, 0, 0);
                unsigned p01, p23;
                {
                    f32x16 y0, y1;
#pragma unroll
                    for (int r = 0; r < 16; ++r) { y0[r] = 0.f; y1[r] = 0.f; }
                    const f16x8 x00 = __builtin_bit_cast(f16x8, (v4u){pk_relu_f16(acc0[0], acc0[1]), pk_relu_f16(acc0[2], acc0[3]), pk_relu_f16(acc0[4], acc0[5]), pk_relu_f16(acc0[6], acc0[7])});
                    const f16x8 x01 = __builtin_bit_cast(f16x8, (v4u){pk_relu_f16(acc0[8], acc0[9]), pk_relu_f16(acc0[10], acc0[11]), pk_relu_f16(acc0[12], acc0[13]), pk_relu_f16(acc0[14], acc0[15])});
                    const f16x8 x10 = __builtin_bit_cast(f16x8, (v4u){pk_relu_f16(acc1[0], acc1[1]), pk_relu_f16(acc1[2], acc1[3]), pk_relu_f16(acc1[4], acc1[5]), pk_relu_f16(acc1[6], acc1[7])});
                    const f16x8 x11 = __builtin_bit_cast(f16x8, (v4u){pk_relu_f16(acc1[8], acc1[9]), pk_relu_f16(acc1[10], acc1[11]), pk_relu_f16(acc1[12], acc1[13]), pk_relu_f16(acc1[14], acc1[15])});
                    y0 = __builtin_amdgcn_mfma_f32_32x32x16_f16(wa[0][0], x00, y0, 0, 0, 0); y1 = __builtin_amdgcn_mfma_f32_32x32x16_f16(wa[1][0], x10, y1, 0, 0, 0);
                    y0 = __builtin_amdgcn_mfma_f32_32x32x16_f16(wa[0][1], x01, y0, 0, 0, 0); y1 = __builtin_amdgcn_mfma_f32_32x32x16_f16(wa[1][1], x11, y1, 0, 0, 0);
                    p01 = __builtin_bit_cast(unsigned, __builtin_amdgcn_cvt_pkrtz(y0[0], y0[1])); p23 = __builtin_bit_cast(unsigned, __builtin_amdgcn_cvt_pkrtz(y1[0], y1[1]));
                }
                unsigned h4[4]; h4[0] = p01 & 0xffffu; h4[1] = p01 >> 16; h4[2] = p23 & 0xffffu; h4[3] = p23 >> 16;
                unsigned short* scp = SC + (size_t)(qh + hi) * SEQ + key;
                scp[0] = (unsigned short)h4[0]; scp[2 * SEQ] = (unsigned short)h4[1]; scp[4 * SEQ] = (unsigned short)h4[2]; scp[6 * SEQ] = (unsigned short)h4[3];
                unsigned bin4[4];
#pragma unroll
                for (int e = 0; e < 4; ++e) bin4[e] = bin16(h4[e]);
                if (full) {
#pragma unroll
                    for (int e = 0; e < 4; ++e) { const int q = qh + 4 * (e >> 1) + hi + 2 * (e & 1); __hip_atomic_fetch_add(&HIST[q * 1024 + (bin4[e] >> 1)], 1u << (16 * (bin4[e] & 1u)), __ATOMIC_RELAXED, __HIP_MEMORY_SCOPE_WORKGROUP); }
                } else {
#pragma unroll
                    for (int e = 0; e < 4; ++e) { const int q = qh + 4 * (e >> 1) + hi + 2 * (e & 1); if (key <= t0 + q) __hip_atomic_fetch_add(&HIST[q * 1024 + (bin4[e] >> 1)], 1u << (16 * (bin4[e] & 1u)), __ATOMIC_RELAXED, __HIP_MEMORY_SCOPE_WORKGROUP); }
                }
            }
            { const int jn = (i0 + u + 4 < cnt4) ? (i0 + u + 4) : (cnt4 - 1); P3_LOADB(u, jn); }
        }
    }
#undef P3_LOADB
}
__device__ __forceinline__ void p3_index(Frame& F) {
    unsigned char* ws = F.ws; const int tid = F.tid, lane = F.lane, wave = F.wave, n = lane & 31, hi = lane >> 5;
    const bf16* QIF = (const bf16*)(ws + WS_QIF); const bf16* KIF = (const bf16*)(ws + WS_KIF); const float* WIF = (const float*)(ws + WS_WIF); int* SEL = (int*)(ws + WS_SEL);
    unsigned short* SC = (unsigned short*)(ws + WS_PROJ) + (size_t)F.bid * 16 * SEQ;
    LAS unsigned char* lds = F.lds;
    LAS unsigned* HIST = (LAS unsigned*)(lds + P3_HIST); LAS unsigned* H2 = (LAS unsigned*)(lds + P3_H2 + wave * 4096); LAS unsigned* BM = (LAS unsigned*)(lds + P3_BM); LAS unsigned* QS = (LAS unsigned*)(lds + P3_QS);
    LAS unsigned* FBL = (LAS unsigned*)(lds + P3_QS + 1024);
    if (tid == 0) FBL[0] = 0u;
    __syncthreads();
    for (int ps = F.bid; ps < 512; ps += F.G) {
        const int b = ps >> 8, wq = ps & 255;
#pragma unroll 1
        for (int half = 0; half < 2; ++half) {
            const int idx = half ? (511 - wq) : wq; const int t0 = 16 * idx, row0 = (b << 13) + t0;
            if (idx < 16) {
                for (int e = tid; e < 16 * TOPK; e += 512) { const int q = e >> 8, i = e & 255; SEL[(size_t)(row0 + q) * TOPK + i] = (i <= t0 + q) ? i : 0; }
                continue;
            }
            for (int e = tid; e < 16384; e += 512) HIST[e] = 0u;
            if (tid < 128) QS[tid] = 0u;
            bf16x8 af[2][4]; f16x8 wa[2][2]; const int qh = 8 * (wave >> 2);
            { const int head = (n & 3) + 4 * ((n >> 3) & 1), q4 = ((n >> 2) & 1) + 2 * (n >> 4);
#pragma unroll
              for (int mt = 0; mt < 2; ++mt) { const bf16* ap = QIF + (size_t)(row0 + qh + 4 * mt + q4) * 512 + head * IDX + 32 * hi;
#pragma unroll
                  for (int s = 0; s < 4; ++s) af[mt][s] = *(const bf16x8*)(ap + 8 * s);
#pragma unroll
                  for (int sp = 0; sp < 2; ++sp) {
                      const bool on = (sp == 0) ? ((n == 0 && hi == 0) || (n == 4 && hi == 1)) : ((n == 1 && hi == 0) || (n == 5 && hi == 1));
                      const float* wp = WIF + (size_t)(row0 + qh + 4 * mt + hi + 2 * sp) * 8; const f32x4 w0 = *(const f32x4*)wp, w1 = *(const f32x4*)(wp + 4);
                      f16x8 t; t[0] = (_Float16)w0[0]; t[1] = (_Float16)w0[1]; t[2] = (_Float16)w0[2]; t[3] = (_Float16)w0[3]; t[4] = (_Float16)w1[0]; t[5] = (_Float16)w1[1]; t[6] = (_Float16)w1[2]; t[7] = (_Float16)w1[3];
                      if (!on) t = (f16x8){0, 0, 0, 0, 0, 0, 0, 0};
                      wa[mt][sp] = t; } } }
            const int nt = (t0 + 16 + 31) >> 5; const bf16* kib = KIF + (size_t)(b << 13) * IDX;
            __syncthreads();
            p3_score_pass(af, wa, kib, t0, nt, wave, n, hi, lds, SC, F.bid * 5);
            __syncthreads();
            v4u hv[16];
#define P3_LOADSC(qx) do { unsigned long long qo_ = (unsigned long long)(qx) * (SEQ * 2); asm volatile("" : "+s"(qo_)); const char* s_ = (const char*)SC + qo_; const int n_ = ((t0 + (qx)) >> 9) + 1; const unsigned lo_ = 16u * (unsigned)lane; \
                _Pragma("unroll") for (int ch = 0; ch < 16; ++ch) { hv[ch] = (v4u){0u, 0u, 0u, 0u}; if (ch < n_) hv[ch] = *(const v4u*)(s_ + 1024 * ch + lo_); } } while (0)
            P3_LOADSC(2 * wave);
#pragma unroll 1
            for (int qq = 0; qq < 2; ++qq) {
                const int q = 2 * wave + qq; unsigned T, needA, c; bool ok;
                find_bin_2048(HIST + q * 1024, (unsigned)TOPK, lane, T, needA, c, ok);
                const bool defer = !ok || c > (unsigned)P3_CAP;
                if (defer && lane == 0) { const unsigned k = __hip_atomic_fetch_add(&FBL[0], 1u, __ATOMIC_RELAXED, __HIP_MEMORY_SCOPE_WORKGROUP); if (k < 63u) FBL[1 + k] = (unsigned)(row0 + q); }
                const int tq = t0 + q, nch = (tq >> 9) + 1;
                LAS unsigned char* bmb = (LAS unsigned char*)(BM + q * 256); LAS unsigned* cand = H2; LAS unsigned* bmq = BM + q * 256;
                const bool fastp = T >= 1024u; const unsigned mcT = T - 1024u;
                const unsigned klo = (mcT == 0u) ? 0u : ((mcT + 192u) << 4), khi = (mcT == 1023u) ? 0x7fffu : (((mcT + 192u) << 4) + 15u);
                const int hiT = (int)((khi << 16) | 0xffffu), loT = (int)(klo << 16);
                if (!defer) {
#pragma unroll
                for (int ch = 0; ch < 16; ++ch) {
                    if (ch < nch) {
                        const v4u hw = hv[ch]; int k0 = 512 * ch + 8 * lane; asm volatile("" : "+v"(k0));
                        unsigned am = 0u, cm = 0u;
                        int nv = tq - k0 + 1; nv = nv < 0 ? 0 : (nv > 8 ? 8 : nv); const unsigned vm = (1u << nv) - 1u;
                        if (fastp) {
                            unsigned nb = 0u;
#pragma unroll
                            for (int d = 3; d >= 0; --d) { const unsigned w = (d == 0) ? hw.x : (d == 1) ? hw.y : (d == 2) ? hw.z : hw.w; const int wh = (int)w, wl = (int)(w << 16);
                                am = am + am + ((wh > hiT) ? 1u : 0u); nb = nb + nb + ((wh >= loT) ? 1u : 0u);
                                am = am + am + ((wl > hiT) ? 1u : 0u); nb = nb + nb + ((wl >= loT) ? 1u : 0u); }
                            am &= vm; cm = nb & vm & ~am;
                        } else {
#pragma unroll
                            for (int j = 0; j < 8; ++j) { const unsigned w = (j < 2) ? hw.x : (j < 4) ? hw.y : (j < 6) ? hw.z : hw.w; const unsigned h = (j & 1) ? (w >> 16) : (w & 0xffffu);
                                const unsigned bn = bin16(h); am |= (bn > T) ? (1u << j) : 0u; cm |= (bn == T) ? (1u << j) : 0u; }
                            am &= vm; cm &= vm;
                        }
                        bmb[64 * ch + lane] = (unsigned char)am;
                        if (__ballot(cm != 0u) != 0ull) {
#pragma unroll
                            for (int j = 0; j < 8; ++j) if ((cm >> j) & 1u) { const unsigned w = (j < 2) ? hw.x : (j < 4) ? hw.y : (j < 6) ? hw.z : hw.w; const unsigned h = (j & 1) ? (w >> 16) : (w & 0xffffu);
                                const unsigned pos = __hip_atomic_fetch_add(&QS[q * 8 + 3], 1u, __ATOMIC_RELAXED, __HIP_MEMORY_SCOPE_WORKGROUP);
                                if (pos < (unsigned)P3_CAP) { cand[2 * pos] = key16(h); cand[2 * pos + 1] = (unsigned)(k0 + j); } }
                        }
                    } else { ((LAS unsigned*)bmb)[16 * ch + (lane & 15)] = 0u; }
                }
                }
                if (qq == 0) P3_LOADSC(2 * wave + 1);
                if (defer) continue;
                WAVE_SYNC();
                if (c <= 64u) {
                    const bool in = (unsigned)lane < c; const unsigned k32 = in ? cand[2 * lane] : 0u, ki = in ? (cand[2 * lane + 1] & 8191u) : 0u; unsigned rank = 0u;
                    for (unsigned j = 0; j < c; ++j) { const unsigned kj = (unsigned)__builtin_amdgcn_readlane((int)k32, (int)j), ij = (unsigned)__builtin_amdgcn_readlane((int)ki, (int)j); rank += (kj > k32 || (kj == k32 && ij < ki)) ? 1u : 0u; }
                    if (in && rank < needA) __hip_atomic_fetch_or(&bmq[ki >> 5], 1u << (ki & 31), __ATOMIC_RELAXED, __HIP_MEMORY_SCOPE_WORKGROUP);
                } else {
                for (unsigned i0 = 0; i0 < c; i0 += 64) { const unsigned i = i0 + lane; const bool in = i < c; const unsigned k32 = in ? cand[2 * i] : 0u, ki = in ? (cand[2 * i + 1] & 8191u) : 0u; unsigned rank = 0u;
                    for (unsigned j = 0; j < c; ++j) { const unsigned kj = cand[2 * j], ij = cand[2 * j + 1]; rank += (kj > k32 || (kj == k32 && ij < ki)) ? 1u : 0u; }
                    if (in && rank < needA) __hip_atomic_fetch_or(&bmq[ki >> 5], 1u << (ki & 31), __ATOMIC_RELAXED, __HIP_MEMORY_SCOPE_WORKGROUP); }
                }
                WAVE_SYNC();
                unsigned w0 = bmq[4 * lane], w1 = bmq[4 * lane + 1], w2 = bmq[4 * lane + 2], w3 = bmq[4 * lane + 3];
                const unsigned mycnt = __popc(w0) + __popc(w1) + __popc(w2) + __popc(w3);
                unsigned incl = mycnt;
#pragma unroll
                for (int o = 1; o < 64; o <<= 1) { const unsigned v = __shfl_up(incl, o); if (lane >= o) incl += v; }
                unsigned pos = incl - mycnt; int* sel = SEL + (size_t)(row0 + q) * TOPK;
#pragma unroll
                for (int wi = 0; wi < 4; ++wi) { unsigned w = (wi == 0) ? w0 : (wi == 1) ? w1 : (wi == 2) ? w2 : w3;
                    while (w) { const int bit = __ffs((int)w) - 1; if (pos < (unsigned)TOPK) sel[pos] = 128 * lane + 32 * wi + bit; ++pos; w &= w - 1u; } }
                WAVE_SYNC();
            }
#undef P3_LOADSC
            __syncthreads();
        }
    }
    __syncthreads();
    const unsigned nfb = FBL[0];
    for (unsigned k = 0; k < nfb && k < 63u; ++k) { const int r0 = (int)FBL[1 + k]; __syncthreads(); p3_query_naive(ws, lds, r0, SEL); }
}

typedef short v4i16_t __attribute__((ext_vector_type(4)));
typedef int v4i __attribute__((ext_vector_type(4)));
__device__ __forceinline__ v4i16_t tr16(LAS unsigned char* p) { return __builtin_amdgcn_ds_read_tr16_b64_v4i16((LAS v4i16_t*)p); }
typedef __bf16 bf16x2_t __attribute__((ext_vector_type(2)));
__device__ __forceinline__ unsigned dq2(unsigned w, bool hi) { return __builtin_bit_cast(unsigned, hi ? __builtin_amdgcn_cvt_scalef32_pk_bf16_fp8(w, 1.0f, true) : __builtin_amdgcn_cvt_scalef32_pk_bf16_fp8(w, 1.0f, false)); }
__device__ __forceinline__ bf16x8 dq8(unsigned w0, unsigned w1) { return __builtin_bit_cast(bf16x8, (v4u){dq2(w0, false), dq2(w0, true), dq2(w1, false), dq2(w1, true)}); }
__device__ __forceinline__ void p4_dsa(Frame& F) {
    unsigned char* ws = F.ws; const int lane = F.lane, nh = lane & 15, kg = lane >> 4;
    const bf16* QF = (const bf16*)(ws + WS_QF); const unsigned char* KV8 = (const unsigned char*)(ws + WS_KVF); const int* SEL = (const int*)(ws + WS_SEL); bf16* AO = (bf16*)(ws + WS_AO);
    LAS unsigned char* wl = F.lds + F.wave * 10240; LAS int* selw = (LAS int*)wl; LAS unsigned char* vb = wl + 1024;
    const int gw = F.wave * F.G + F.bid, NGW = F.G * NWAVES;
    LAS unsigned char* trp = vb + (4 * kg + ((lane >> 2) & 3)) * 288 + 8 * (lane & 3);
#pragma unroll 1
    for (int combo = 0; combo < BATCH * NKV; ++combo) {
        const int b = combo >> 1, kvh = combo & 1;
        const unsigned char* kvb = KV8 + (size_t)(b * NKV + kvh) * SEQ * 256;
#pragma unroll 1
        for (int t = gw; t < SEQ; t += NGW) {
            const int row = (b << 13) + t; const int cnt = (t + 1 < TOPK) ? (t + 1) : TOPK;
            *(LAS v4i*)(selw + 4 * lane) = *(const v4i*)(SEL + (size_t)row * TOPK + 4 * lane);
            WAVE_SYNC();
            const bf16* qp = QF + (size_t)row * D + (kvh * 4 + (nh & 3)) * HD + 32 * kg;
            bf16x8 qf[4];
#pragma unroll
            for (int s = 0; s < 4; ++s) { qf[s] = *(const bf16x8*)(qp + 8 * s); if (nh >= 4) qf[s] = (bf16x8){0, 0, 0, 0, 0, 0, 0, 0}; }
            f32x4 S[16];
            v4u kq[2][4][2];
#define P4_LOADK(buf, batch) do { _Pragma("unroll") for (int tt = 0; tt < 4; ++tt) { const unsigned char* kp_ = kvb + (size_t)(selw[16 * (4 * (batch) + tt) + nh] & (SEQ - 1)) * 256 + 32 * kg; \
                kq[buf][tt][0] = *(const v4u*)(kp_); kq[buf][tt][1] = *(const v4u*)(kp_ + 16); } } while (0)
            P4_LOADK(0, 0);
#pragma unroll
            for (int bt = 0; bt < 4; ++bt) {
                if (bt < 3) P4_LOADK((bt + 1) & 1, bt + 1);
                asm volatile("" ::: "memory");
#pragma unroll
                for (int tt = 0; tt < 4; ++tt) {
                    const v4u k0 = kq[bt & 1][tt][0], k1 = kq[bt & 1][tt][1];
                    f32x4 a = (f32x4){0.f, 0.f, 0.f, 0.f};
                    a = __builtin_amdgcn_mfma_f32_16x16x32_bf16(dq8(k0.x, k0.y), qf[0], a, 0, 0, 0); a = __builtin_amdgcn_mfma_f32_16x16x32_bf16(dq8(k0.z, k0.w), qf[1], a, 0, 0, 0);
                    a = __builtin_amdgcn_mfma_f32_16x16x32_bf16(dq8(k1.x, k1.y), qf[2], a, 0, 0, 0); a = __builtin_amdgcn_mfma_f32_16x16x32_bf16(dq8(k1.z, k1.w), qf[3], a, 0, 0, 0);
                    S[4 * bt + tt] = a;
                }
            }
#undef P4_LOADK
            float mx = -INFINITY;
#pragma unroll
            for (int T = 0; T < 16; ++T)
#pragma unroll
                for (int r = 0; r < 4; ++r) { const float v = (16 * T + 4 * kg + r < cnt) ? S[T][r] : -INFINITY; S[T][r] = v; mx = fmaxf(mx, v); }
            mx = fmaxf(mx, __shfl_xor(mx, 16)); mx = fmaxf(mx, __shfl_xor(mx, 32));
            float sum = 0.f;
#pragma unroll
            for (int T = 0; T < 16; ++T)
#pragma unroll
                for (int r = 0; r < 4; ++r) { const float e = __builtin_amdgcn_exp2f(S[T][r] - mx); S[T][r] = e; sum += e; }
            sum += __shfl_xor(sum, 16); sum += __shfl_xor(sum, 32);
            bf16x8 pa[8];
#pragma unroll
            for (int c = 0; c < 8; ++c) { v4u pw; pw.x = pg8::cvt_pk_bf16(S[2 * c][0], S[2 * c][1]); pw.y = pg8::cvt_pk_bf16(S[2 * c][2], S[2 * c][3]); pw.z = pg8::cvt_pk_bf16(S[2 * c + 1][0], S[2 * c + 1][1]); pw.w = pg8::cvt_pk_bf16(S[2 * c + 1][2], S[2 * c + 1][3]); pa[c] = __builtin_bit_cast(bf16x8, pw); }
            f32x4 O[8];
#pragma unroll
            for (int d = 0; d < 8; ++d) O[d] = (f32x4){0.f, 0.f, 0.f, 0.f};
            v4u g[3][4];
#define P4_LOADV(buf, c_) do { _Pragma("unroll") for (int i = 0; i < 4; ++i) { const int key_ = selw[32 * (c_) + (lane >> 3) + 8 * i] & (SEQ - 1); g[buf][i] = *(const v4u*)(kvb + (size_t)key_ * 256 + 128 + 16 * (lane & 7)); } } while (0)
            P4_LOADV(0, 0); P4_LOADV(1, 1); P4_LOADV(2, 2);
#pragma unroll
            for (int c = 0; c < 8; ++c) {
#pragma unroll
                for (int i = 0; i < 4; ++i) { const v4u gg = g[c % 3][i]; LAS unsigned char* dst = vb + ((lane >> 3) + 8 * i) * 288 + 32 * (lane & 7);
                    *(LAS v4u*)dst = __builtin_bit_cast(v4u, dq8(gg.x, gg.y)); *(LAS v4u*)(dst + 16) = __builtin_bit_cast(v4u, dq8(gg.z, gg.w)); }
                asm volatile("" ::: "memory");
                if (c < 5) P4_LOADV(c % 3, c + 3);
#pragma unroll
                for (int d = 0; d < 8; ++d) {
                    const v4i16_t lo = tr16(trp + 32 * d), hi4 = tr16(trp + 16 * 288 + 32 * d);
                    const bf16x8 vfr = (bf16x8){lo[0], lo[1], lo[2], lo[3], hi4[0], hi4[1], hi4[2], hi4[3]};
                    O[d] = __builtin_amdgcn_mfma_f32_16x16x32_bf16(pa[c], vfr, O[d], 0, 0, 0);
                }
            }
#undef P4_LOADV
            const float i0 = 1.0f / __builtin_bit_cast(float, __builtin_amdgcn_readlane(__builtin_bit_cast(int, sum), 0)), i1 = 1.0f / __builtin_bit_cast(float, __builtin_amdgcn_readlane(__builtin_bit_cast(int, sum), 1));
            const float i2 = 1.0f / __builtin_bit_cast(float, __builtin_amdgcn_readlane(__builtin_bit_cast(int, sum), 2)), i3 = 1.0f / __builtin_bit_cast(float, __builtin_amdgcn_readlane(__builtin_bit_cast(int, sum), 3));
            LAS bf16* ost = (LAS bf16*)vb;
            if (kg == 0) {
#pragma unroll
                for (int d = 0; d < 8; ++d) { ost[0 * 128 + 16 * d + nh] = (bf16)f2bf(O[d][0] * i0); ost[1 * 128 + 16 * d + nh] = (bf16)f2bf(O[d][1] * i1); ost[2 * 128 + 16 * d + nh] = (bf16)f2bf(O[d][2] * i2); ost[3 * 128 + 16 * d + nh] = (bf16)f2bf(O[d][3] * i3); }
            }
            WAVE_SYNC();
            const v4u ov = *(LAS v4u*)(vb + 16 * lane);
            *(v4u*)(AO + (size_t)row * D + (kvh * 4 + kg) * HD + 8 * nh) = ov;
            WAVE_SYNC();
        }
    }
}

__device__ __forceinline__ void p9_sb(Frame& F) {
    unsigned char* ws = F.ws; const int lane = F.lane, n = lane & 31, hi = lane >> 5;
    const bf16* KQ = (const bf16*)(ws + WS_KQ); const bf16* VT = (const bf16*)(ws + WS_VT); bf16* AO = (bf16*)(ws + WS_AO);
    const int gw = F.wave * F.G + F.bid, NGW = F.G * NWAVES;
    const int koff = 16 * (n >> 4) + 8 * ((n >> 2) & 1) + 4 * ((n >> 3) & 1) + (n & 3);
    constexpr float LOG2E = 1.4426950408889634f, LN2 = 0.6931471805599453f;
    for (int u = gw; u < (M / 32) * NH; u += NGW) {
        const int h = u & 7, blk = u >> 3, b = blk >> 8, qb = blk & 255, q0 = 32 * qb, t = q0 + n;
        const bf16* qp = KQ + (size_t)(b * SEQ + q0 + n) * 2048 + 1024 + h * HD + 64 * hi;
        bf16x8 qf[8];
#pragma unroll
        for (int s = 0; s < 8; ++s) qf[s] = *(const bf16x8*)(qp + 8 * s);
        f32x16 o[4];
#pragma unroll
        for (int mt = 0; mt < 4; ++mt)
#pragma unroll
            for (int r = 0; r < 16; ++r) o[mt][r] = 0.f;
        float C = 0.f;
        bf16x8 kf[8];
        { const bf16* kp = KQ + (size_t)(b * SEQ + 32 * qb + koff) * 2048 + h * HD + 64 * hi;
#pragma unroll
          for (int s = 0; s < 8; ++s) kf[s] = *(const bf16x8*)(kp + 8 * s); }
        for (int kb = qb; kb >= 0; --kb) {
            const int k0 = 32 * kb;
            bf16x8 vf[4][2];
#pragma unroll
            for (int mt = 0; mt < 4; ++mt)
#pragma unroll
                for (int sp = 0; sp < 2; ++sp) vf[mt][sp] = *(const bf16x8*)(VT + (size_t)(h * HD + 32 * mt + n) * M + b * SEQ + k0 + 16 * sp + 8 * hi);
            f32x16 z;
#pragma unroll
            for (int r = 0; r < 16; ++r) z[r] = 0.f;
#pragma unroll
            for (int s = 0; s < 8; ++s) z = __builtin_amdgcn_mfma_f32_32x32x16_bf16(kf[s], qf[s], z, 0, 0, 0);
            { const int kn = (kb > 0) ? kb - 1 : 0; const bf16* kp = KQ + (size_t)(b * SEQ + 32 * kn + koff) * 2048 + h * HD + 64 * hi;
#pragma unroll
              for (int s = 0; s < 8; ++s) kf[s] = *(const bf16x8*)(kp + 8 * s); }
            float lk[16], lb[16];
#pragma unroll
            for (int r = 0; r < 16; ++r) {
                const int key = k0 + ((r < 8) ? (8 * hi + r) : (16 + 8 * hi + (r - 8)));
                const float zz = z[r]; const float L = __builtin_amdgcn_logf(1.0f + __builtin_amdgcn_exp2f(-fabsf(zz) * LOG2E)) * LN2;
                const bool valid = key < t;
                lk[r] = valid ? (-fmaxf(zz, 0.f) - L) : 0.f;
                lb[r] = valid ? (fminf(zz, 0.f) - L) : -INFINITY;
            }
            float suf[16];
            suf[7] = 0.f; suf[15] = 0.f;
#pragma unroll
            for (int i = 6; i >= 0; --i) { suf[i] = suf[i + 1] + lk[i + 1]; suf[8 + i] = suf[9 + i] + lk[9 + i]; }
            const float T0 = suf[0] + lk[0], T1 = suf[8] + lk[8];
            const float P0 = __shfl_xor(T0, 32), P1 = __shfl_xor(T1, 32);
            const float base1 = C + (hi ? 0.f : P1), base0 = C + (hi ? (T1 + P1) : (P0 + T1 + P1));
            unsigned pw[8];
#pragma unroll
            for (int r = 0; r < 16; r += 2) {
                const float a0 = __builtin_amdgcn_exp2f((lb[r] + ((r < 8) ? base0 : base1) + suf[r]) * LOG2E), a1 = __builtin_amdgcn_exp2f((lb[r + 1] + ((r < 8) ? base0 : base1) + suf[r + 1]) * LOG2E);
                pw[r >> 1] = pg8::cvt_pk_bf16(a0, a1);
            }
            C += (T0 + T1) + (P0 + P1);
            const bf16x8 pa0 = __builtin_bit_cast(bf16x8, (v4u){pw[0], pw[1], pw[2], pw[3]}), pa1 = __builtin_bit_cast(bf16x8, (v4u){pw[4], pw[5], pw[6], pw[7]});
#pragma unroll
            for (int mt = 0; mt < 4; ++mt) { o[mt] = __builtin_amdgcn_mfma_f32_32x32x16_bf16(vf[mt][0], pa0, o[mt], 0, 0, 0); o[mt] = __builtin_amdgcn_mfma_f32_32x32x16_bf16(vf[mt][1], pa1, o[mt], 0, 0, 0); }
            if (__all(C < -44.0f)) break;
        }
        bf16* op = AO + (size_t)(b * SEQ + q0 + n) * D + h * HD + 4 * hi;
#pragma unroll
        for (int mt = 0; mt < 4; ++mt)
#pragma unroll
            for (int g = 0; g < 4; ++g) { v2u w; w.x = pg8::cvt_pk_bf16(o[mt][4 * g], o[mt][4 * g + 1]); w.y = pg8::cvt_pk_bf16(o[mt][4 * g + 2], o[mt][4 * g + 3]); *(v2u*)(op + 32 * mt + 8 * g) = w; }
    }
}

__device__ __forceinline__ void p11_router(Frame& F) {
    unsigned char* ws = F.ws; const int tid = F.tid, lane = F.lane, wave = F.wave;
    const float* H = (const float*)(ws + WS_H); const float* gn = F.in[IN_FFNNORM] + D; const float* Wr = F.in[IN_ROUTER];
    int* TOPE = (int*)(ws + WS_RT); int* POS = (int*)(ws + WS_RT + 128 * 1024); float* GATE = (float*)(ws + WS_RT + 256 * 1024); float* RSTD3 = (float*)(ws + WS_RT + 384 * 1024);
    LAS unsigned* lcnt = (LAS unsigned*)F.lds;
    LAS unsigned* gb = (LAS unsigned*)(F.lds + 64);
    LAS int* ltok = (LAS int*)(F.lds + 128);
    LAS float* lgt = (LAS float*)(F.lds + 128 + 1024);
    for (int chunk = F.bid; chunk < M / 64; chunk += F.G) {
        if (tid < 8) lcnt[tid] = 0u;
        __syncthreads();
        for (int r = 0; r < 8; ++r) {
            const int row = chunk * 64 + wave * 8 + r;
            const GAS f32x4* xr = (const GAS f32x4*)(H + (size_t)row * D) + lane; f32x4 v[4]; float ss = 0.f;
#pragma unroll
            for (int j = 0; j < 4; ++j) { v[j] = xr[64 * j]; ss += (v[j].x * v[j].x + v[j].y * v[j].y) + (v[j].z * v[j].z + v[j].w * v[j].w); }
            ss = wave_sum(ss); const float rs = 1.0f / sqrtf(ss * (1.0f / 1024.0f) + 1e-6f);
            float lg[8] = {0.f, 0.f, 0.f, 0.f, 0.f, 0.f, 0.f, 0.f};
#pragma unroll
            for (int j = 0; j < 4; ++j)
#pragma unroll
                for (int i = 0; i < 4; ++i) { const int k = 256 * j + 4 * lane + i; const float xv = v[j][i] * gn[k]; const f32x4 w0 = *(const f32x4*)(Wr + (size_t)k * 8), w1 = *(const f32x4*)(Wr + (size_t)k * 8 + 4);
                    lg[0] += xv * w0[0]; lg[1] += xv * w0[1]; lg[2] += xv * w0[2]; lg[3] += xv * w0[3]; lg[4] += xv * w1[0]; lg[5] += xv * w1[1]; lg[6] += xv * w1[2]; lg[7] += xv * w1[3]; }
#pragma unroll
            for (int e = 0; e < 8; ++e) lg[e] = wave_sum(lg[e]) * rs;
            int i1 = 0; float l1 = lg[0];
#pragma unroll
            for (int e = 1; e < 8; ++e) if (lg[e] > l1) { l1 = lg[e]; i1 = e; }
            int i2 = -1; float l2 = -INFINITY;
#pragma unroll
            for (int e = 0; e < 8; ++e) if (e != i1 && lg[e] > l2) { l2 = lg[e]; i2 = e; }
            const float g1 = 1.0f / (1.0f + __expf(l2 - l1)), g2 = 1.0f - g1;
            if (lane == 0) {
                const unsigned p1 = __hip_atomic_fetch_add(&lcnt[i1], 1u, __ATOMIC_RELAXED, __HIP_MEMORY_SCOPE_WORKGROUP), p2 = __hip_atomic_fetch_add(&lcnt[i2], 1u, __ATOMIC_RELAXED, __HIP_MEMORY_SCOPE_WORKGROUP);
                const int ti = wave * 8 + r; ltok[ti * 4 + 0] = i1; ltok[ti * 4 + 1] = i2; ltok[ti * 4 + 2] = (int)p1; ltok[ti * 4 + 3] = (int)p2;
                lgt[ti * 4 + 0] = g1; lgt[ti * 4 + 1] = g2; lgt[ti * 4 + 2] = rs;
            }
        }
        __syncthreads();
        if (tid < 8) gb[tid] = __hip_atomic_fetch_add(F.ctl + CW_CNT + tid, lcnt[tid], RLX_AGENT);
        __syncthreads();
        if (tid < 64) { const int row = chunk * 64 + tid; const int e1 = ltok[tid * 4], e2 = ltok[tid * 4 + 1];
            TOPE[row * 2] = e1; TOPE[row * 2 + 1] = e2; POS[row * 2] = (int)gb[e1] + ltok[tid * 4 + 2]; POS[row * 2 + 1] = (int)gb[e2] + ltok[tid * 4 + 3];
            GATE[row * 2] = lgt[tid * 4]; GATE[row * 2 + 1] = lgt[tid * 4 + 1]; RSTD3[row] = lgt[tid * 4 + 2]; }
        __syncthreads();
    }
}
__device__ __forceinline__ void moe_bases(Frame& F, int (&tb)[9]) {
    int acc = 0;
#pragma unroll
    for (int e = 0; e < 8; ++e) { tb[e] = acc; const unsigned c = __hip_atomic_load(F.ctl + CW_CNT + e, RLX_AGENT); acc += (int)((c + 255u) >> 8); }
    tb[8] = acc;
}
__device__ __forceinline__ void p12_permute(Frame& F) {
    unsigned char* ws = F.ws; const int lane = F.lane;
    const int* TOPE = (const int*)(ws + WS_RT); const int* POS = (const int*)(ws + WS_RT + 128 * 1024); const float* RSTD3 = (const float*)(ws + WS_RT + 384 * 1024);
    int* SLOT = (int*)(ws + WS_RT + 512 * 1024);
    const float* H = (const float*)(ws + WS_H); bf16* XP = (bf16*)(ws + WS_XPERM);
    int tb[9]; moe_bases(F, tb);
    const int gw = F.wave * F.G + F.bid, NGW = F.G * NWAVES;
    for (int i = gw; i < 2 * M; i += NGW) {
        const int row = i >> 1; const int e = TOPE[i]; int base = 0;
#pragma unroll
        for (int k = 0; k < 8; ++k) base = (e == k) ? tb[k] : base;
        const int slot = base * 256 + POS[i];
        const float rs = RSTD3[row];
        const GAS f32x4* src = (const GAS f32x4*)(H + (size_t)row * D) + lane; GAS unsigned* dst = (GAS unsigned*)((unsigned char*)XP + (size_t)slot * D) + lane;
        const float r16 = rs * pg8::F8_SX;
#pragma unroll
        for (int j = 0; j < 4; ++j) { const f32x4 v = src[64 * j]; dst[64 * j] = pg8::pk4_fp8(v.x * r16, v.y * r16, v.z * r16, v.w * r16); }
        if (lane == 0) SLOT[i] = slot;
    }
}
__device__ __forceinline__ void p15_combine(Frame& F) {
    unsigned char* ws = F.ws; const int lane = F.lane;
    const float* H = (const float*)(ws + WS_H); const bf16* Y = (const bf16*)(ws + WS_Y); const int* SLOT = (const int*)(ws + WS_RT + 512 * 1024); const float* GATE = (const float*)(ws + WS_RT + 256 * 1024);
    const int gw = F.wave * F.G + F.bid, NGW = F.G * NWAVES;
    for (int row = gw; row < M; row += NGW) {
        const int s1 = SLOT[row * 2], s2 = SLOT[row * 2 + 1]; const float g1 = GATE[row * 2], g2 = GATE[row * 2 + 1];
        const GAS f32x4* hr = (const GAS f32x4*)(H + (size_t)row * D) + lane; GAS f32x4* orow = (GAS f32x4*)(F.out + (size_t)row * D) + lane;
        const GAS v2u* y1 = (const GAS v2u*)(Y + (size_t)s1 * D) + lane; const GAS v2u* y2 = (const GAS v2u*)(Y + (size_t)s2 * D) + lane;
#pragma unroll
        for (int j = 0; j < 4; ++j) { const f32x4 h = __builtin_nontemporal_load(hr + 64 * j); const v2u a = __builtin_nontemporal_load(y1 + 64 * j), c = __builtin_nontemporal_load(y2 + 64 * j); f32x4 o;
            o.x = h.x + (g1 * bflo(a.x) + g2 * bflo(c.x)); o.y = h.y + (g1 * bfhi(a.x) + g2 * bfhi(c.x)); o.z = h.z + (g1 * bflo(a.y) + g2 * bflo(c.y)); o.w = h.w + (g1 * bfhi(a.y) + g2 * bfhi(c.y)); orow[64 * j] = o; }
    }
}

constexpr int N_PHASES = 16;
#ifndef MK_ONE_LAUNCH
#define MK_ONE_LAUNCH 1
#endif
struct Args { const float* in[17]; float* out; unsigned char* ws; int ph_lo, ph_hi; };
__global__ void __launch_bounds__(NWAVES * 64, 2) yoco_fwd(Args args) {
    extern __shared__ __attribute__((aligned(16))) unsigned char lds[];
    Frame F;
    F.lds = (LAS unsigned char*)lds; F.MISC = (volatile LAS unsigned*)(F.lds + MISC_OFF);
    F.tid = threadIdx.x; F.lane = F.tid & 63; F.wave = __builtin_amdgcn_readfirstlane(F.tid >> 6); F.G = gridDim.x; F.bid = blockIdx.x;
    F.ws = args.ws; F.ctl = (gu32*)(args.ws + WS_CTL); F.out = args.out;
#pragma unroll
    for (int i = 0; i < 17; ++i) F.in[i] = args.in[i];
    for (int u = F.tid; u < (LDS_BYTES - LDSCTL_OFF) / 4; u += NWAVES * 64) ((LAS unsigned*)(F.lds + LDSCTL_OFF))[u] = 0u;
    __syncthreads();
    unsigned char* ws = args.ws;
    XcdBarrier bar; bar.bar = (unsigned*)(F.ctl + CW_BAR); bar.x = 0; bar.st = nullptr;
    if (MK_ONE_LAUNCH) bar = xcd_barrier_post((unsigned*)(F.ctl + CW_BAR), F.MISC + 8);
    const int lo = args.ph_lo, hi = args.ph_hi;
#define IN(k) (lo <= (k) && (k) < hi)
#define SEAM(k) do { if (MK_ONE_LAUNCH && IN((k) + 1)) xcd_barrier(bar); } while (0)
    bf16* XB = (bf16*)(ws + WS_XB); float* H = (float*)(ws + WS_H); bf16* AO = (bf16*)(ws + WS_AO);

    if (IN(0)) { p0_prologue(F); SEAM(0); }
    if (IN(1)) {
        pg8::Gemm g{XB, (const bf16*)(ws + WS_WIN), M, 2048, D}; pg8::StaticOrder S; S.init(M, 2048, F.G, F.bid);
        pg8::EpiPlainBf16 E{(bf16*)(ws + WS_PROJ), 2048, 0xffff};
        pg8::gemm_phase<pg8::EpiPlainBf16, pg8::StaticOrder, true, true>(F.lds, g, S, E); SEAM(1); }
    if (IN(2)) { p2_post(F); SEAM(2); }
    if (IN(3)) { p3_index(F); SEAM(3); }
    if (IN(4)) { p4_dsa(F); SEAM(4); }
    if (IN(5)) {
        pg8::Gemm g{AO, (const bf16*)(ws + WS_WOA), M, D, D}; pg8::StaticOrder S; S.init(M, D, F.G, F.bid);
        pg8::EpiResid<true> E{F.in[IN_X], H, XB, (float*)(ws + WS_SS1), 1.0f};
        pg8::gemm_phase<pg8::EpiResid<true>, pg8::StaticOrder, true, true>(F.lds, g, S, E); SEAM(5); }
    if (IN(6)) {
        pg8::Gemm g{XB, (const bf16*)(ws + WS_WGU), M, 2 * FF, D / 2}; pg8::StaticOrder S; S.init(M, 2 * FF, F.G, F.bid);
        pg8::EpiSwiGLU8<false> E{ws + WS_HF, FF, (const float*)(ws + WS_SS1)};
        pg8::gemm_phase<pg8::EpiSwiGLU8<false>, pg8::StaticOrder, true, true, true>(F.lds, g, S, E); SEAM(6); }
    if (IN(7)) {
        pg8::Gemm g{(const bf16*)(ws + WS_HF), (const bf16*)(ws + WS_WD), M, D, FF / 2}; pg8::StaticOrder S; S.init(M, D, F.G, F.bid);
        pg8::EpiResid<false> E{H, H, XB, (float*)(ws + WS_SS2), 1.0f / (pg8::F8_SH * pg8::F8_SWD)};
        pg8::gemm_phase<pg8::EpiResid<false>, pg8::StaticOrder, true, true, true>(F.lds, g, S, E); SEAM(7); }
    if (IN(8)) {
        { pg8::Gemm g{XB, (const bf16*)(ws + WS_WKVQ), M, 2048, D}; pg8::StaticOrder S; S.init(M, 2048, F.G, F.bid);
          pg8::EpiScaleBf16 E{(bf16*)(ws + WS_KQ), 2048, (const float*)(ws + WS_SS2)};
          pg8::gemm_phase<pg8::EpiScaleBf16, pg8::StaticOrder, true, true>(F.lds, g, S, E); }
        { pg8::Gemm g{(const bf16*)(ws + WS_WKVQ) + (size_t)2048 * D, XB, D, M, D}; pg8::StaticOrder S; S.init(D, M, F.G, F.bid);
          pg8::EpiScaleColBf16 E{(bf16*)(ws + WS_VT), M, (const float*)(ws + WS_SS2)};
          pg8::gemm_phase<pg8::EpiScaleColBf16, pg8::StaticOrder, true, true>(F.lds, g, S, E); }
        SEAM(8); }
    if (IN(9)) { p9_sb(F); SEAM(9); }
    if (IN(10)) {
        pg8::Gemm g{AO, (const bf16*)(ws + WS_WOB), M, D, D}; pg8::StaticOrder S; S.init(M, D, F.G, F.bid);
        pg8::EpiResid<false> E{H, H, XB, (float*)(ws + WS_SS3), 1.0f};
        pg8::gemm_phase<pg8::EpiResid<false>, pg8::StaticOrder, true, true>(F.lds, g, S, E); SEAM(10); }
    if (IN(11)) { p11_router(F); SEAM(11); }
    if (IN(12)) { p12_permute(F); SEAM(12); }
    if (IN(13)) {
        pg8::MoeOrder S; moe_bases(F, S.tb); S.npn = 22; S.G = F.G; S.c = F.bid;
        pg8::Gemm g{(const bf16*)(ws + WS_XPERM), (const bf16*)(ws + WS_WGUM), MAXSLOT, NE * 2 * FF, D / 2};
        pg8::EpiSwiGLU8<true> E{ws + WS_HM, FF, nullptr};
        pg8::gemm_phase<pg8::EpiSwiGLU8<true>, pg8::MoeOrder, true, true, true>(F.lds, g, S, E); SEAM(13); }
    if (IN(14)) {
        pg8::MoeOrder S; moe_bases(F, S.tb); S.npn = 4; S.G = F.G; S.c = F.bid;
        pg8::Gemm g{(const bf16*)(ws + WS_HM), (const bf16*)(ws + WS_WDM), MAXSLOT, NE * D, FF / 2};
        pg8::EpiScaledBf16 E{(bf16*)(ws + WS_Y), D, 3, 1.0f / (pg8::F8_SH * pg8::F8_SWD)};
        pg8::gemm_phase<pg8::EpiScaledBf16, pg8::MoeOrder, true, true, true>(F.lds, g, S, E); SEAM(14); }
    if (IN(15)) { p15_combine(F); }
#undef IN
#undef SEAM
}

extern "C" void kernel_launch(void* const* d_in, const int* in_sizes, int n_in, void* d_out, int out_size, void* d_ws, size_t ws_size, hipStream_t stream) {
    static int grid = 0;
    if (grid == 0) {
        if (n_in != 17 || out_size != M * D || ws_size < WS_END) { fprintf(stderr, "kernel_launch: unexpected problem (n_in %d, out %d, ws %zu < %zu)\n", n_in, out_size, ws_size, (size_t)WS_END); grid = -1; return; }
        int dev = 0, cus = 0, per_cu = 0;
        if (hipGetDevice(&dev) != hipSuccess || hipDeviceGetAttribute(&cus, hipDeviceAttributeMultiprocessorCount, dev) != hipSuccess) { grid = -1; return; }
        if (hipFuncSetAttribute((const void*)yoco_fwd, hipFuncAttributeMaxDynamicSharedMemorySize, LDS_BYTES) != hipSuccess) { fprintf(stderr, "kernel_launch: hipFuncSetAttribute failed\n"); grid = -1; return; }
        if (hipOccupancyMaxActiveBlocksPerMultiprocessor(&per_cu, (const void*)yoco_fwd, NWAVES * 64, LDS_BYTES) != hipSuccess || per_cu < 1) fprintf(stderr, "kernel_launch: occupancy query says %d\n", per_cu);
        (void)hipGetLastError();
        grid = cus < 256 ? cus : 256;
    }
    if (grid < 0) return;
    if (hipMemsetAsync((char*)d_ws + WS_CTL, 0, CTL_ZERO_BYTES, stream) != hipSuccess) return;
    Args a{};
    for (int i = 0; i < 17; ++i) a.in[i] = (const float*)d_in[i];
    a.out = (float*)d_out; a.ws = (unsigned char*)d_ws;
#if MK_ONE_LAUNCH
    a.ph_lo = 0; a.ph_hi = N_PHASES;
    hipLaunchKernelGGL(yoco_fwd, dim3(grid), dim3(NWAVES * 64), LDS_BYTES, stream, a);
#else
    for (int p = 0; p < N_PHASES; ++p) { a.ph_lo = p; a.ph_hi = p + 1; hipLaunchKernelGGL(yoco_fwd, dim3(grid), dim3(NWAVES * 64), LDS_BYTES, stream, a); }
#endif
}
```

```cpp
#include <hip/hip_runtime.h>
#include <cstdio>
#include <cstdint>
namespace pg8 {
#define PG8_LAS __attribute__((address_space(3)))
typedef unsigned short bf16_t;
typedef short bf16x8 __attribute__((ext_vector_type(8)));
typedef float f32x4 __attribute__((ext_vector_type(4)));
typedef unsigned u32x4 __attribute__((ext_vector_type(4)));
typedef int i32x4 __attribute__((ext_vector_type(4)));
typedef int i32x8 __attribute__((ext_vector_type(8)));
constexpr int BM = 256, BK = 64, HALF = 128, HTB = HALF * BK * 2  , STAGE_BYTES = 8 * HTB, NXCD = 8, WGM = 8;

__host__ __device__ __forceinline__ int lds_byte(int r, int c) { const int st = (r >> 4) * 2 + (c >> 5), rr = r & 15, cc = c & 31, ob = rr * 64 + cc * 2; return st * 1024 + (ob ^ (((ob >> 9) & 1) << 5)); }
__host__ __device__ __forceinline__ void stage_rc(int b, int& R, int& C) { const int st = b / 1024, sb = b % 1024, swz = sb ^ (((sb >> 9) & 1) << 5); R = (st >> 1) * 16 + swz / 64; C = (st & 1) * 32 + (swz % 64) / 2; }
__host__ __device__ __forceinline__ int perm32(int rho) { const int n = rho >> 4, i = rho & 15; return 8 * (i >> 2) + 4 * n + (i & 3); }

struct Unit { int pm, pn; int koff = 0; };
struct Gemm { const bf16_t* A; const bf16_t* Bt; int M, N, K; int ld = 0; };

struct StaticOrder {
    int nM, nN, nwg, G, c;
    __host__ __device__ void init(int M, int N, int G_, int c_) { nM = M / BM; nN = N / BM; nwg = nM * nN; G = G_; c = c_; }
    __host__ __device__ bool next(int i, Unit& u) const {
        const long L = (long)i * G + c; if (L >= nwg) return false;
        int wgid = (int)L; { const int q = nwg / NXCD, r = nwg % NXCD, xcd = wgid % NXCD, off = wgid / NXCD; wgid = (xcd < r ? xcd * (q + 1) : r * (q + 1) + (xcd - r) * q) + off; }
        const int nig = WGM * nN, gid = wgid / nig, fm = gid * WGM, gsz = (nM - fm) < WGM ? (nM - fm) : WGM;
        u.pm = fm + ((wgid % nig) % gsz); u.pn = (wgid % nig) / gsz; return true;
    }
    __device__ __forceinline__ void a_ready(const Unit&) const {}
    __device__ __forceinline__ void done(const Unit&) const {}
};

__device__ __forceinline__ unsigned cvt_pk_bf16(float lo, float hi) { unsigned r; asm volatile("v_cvt_pk_bf16_f32 %0, %1, %2" : "=v"(r) : "v"(lo), "v"(hi)); return r; }
typedef unsigned u32x2 __attribute__((ext_vector_type(2)));
constexpr float RMS_EPS = 1e-6f;
__device__ __forceinline__ float rstd16(const float* p) {
    const f32x4 a = *(const f32x4*)p, b = *(const f32x4*)(p + 4), c = *(const f32x4*)(p + 8), d = *(const f32x4*)(p + 12);
    const float s = (((a[0] + a[1]) + (a[2] + a[3])) + ((b[0] + b[1]) + (b[2] + b[3]))) + (((c[0] + c[1]) + (c[2] + c[3])) + ((d[0] + d[1]) + (d[2] + d[3])));
    return 1.0f / sqrtf(s * (1.0f / 1024.0f) + RMS_EPS);
}
struct EpiScaleBf16 {
    static constexpr bool PERM = true, AFTER_DRAIN = false;
    bf16_t* O; int ldc; const float* ss;
    __device__ __forceinline__ void operator()(const f32x4 (&acc)[2][2][4][2], const Unit& u, int wr, int wc, int fr, int fq) const {
        const int row0 = u.pm * BM + wr * 64 + fr, col0 = u.pn * BM + wc * 32 + 8 * fq;
        float rsv[2][4];
#pragma unroll
        for (int ai = 0; ai < 2; ++ai)
#pragma unroll
            for (int m = 0; m < 4; ++m) rsv[ai][m] = rstd16(ss + (size_t)(row0 + ai * HALF + m * 16) * 16);
#pragma unroll
        for (int ai = 0; ai < 2; ++ai)
#pragma unroll
            for (int m = 0; m < 4; ++m) { const int row = row0 + ai * HALF + m * 16; const float rs = rsv[ai][m]; bf16_t* rowp = O + (size_t)row * ldc + col0;
#pragma unroll
                for (int bj = 0; bj < 2; ++bj) { const f32x4 v0 = acc[ai][bj][m][0] * rs, v1 = acc[ai][bj][m][1] * rs;
                    u32x4 w; w.x = cvt_pk_bf16(v0[0], v0[1]); w.y = cvt_pk_bf16(v0[2], v0[3]); w.z = cvt_pk_bf16(v1[0], v1[1]); w.w = cvt_pk_bf16(v1[2], v1[3]);
                    *(u32x4*)(rowp + bj * HALF) = w; } }
    }
};
struct EpiPlainBf16 {
    static constexpr bool PERM = true, AFTER_DRAIN = false;
    bf16_t* O; int ldc; int pnmask;
    __device__ __forceinline__ void operator()(const f32x4 (&acc)[2][2][4][2], const Unit& u, int wr, int wc, int fr, int fq) const {
        const int row0 = u.pm * BM + wr * 64 + fr, col0 = (u.pn & pnmask) * BM + wc * 32 + 8 * fq;
#pragma unroll
        for (int ai = 0; ai < 2; ++ai)
#pragma unroll
            for (int m = 0; m < 4; ++m) { bf16_t* rowp = O + (size_t)(row0 + ai * HALF + m * 16) * ldc + col0;
#pragma unroll
                for (int bj = 0; bj < 2; ++bj) { const f32x4 v0 = acc[ai][bj][m][0], v1 = acc[ai][bj][m][1];
                    u32x4 w; w.x = cvt_pk_bf16(v0[0], v0[1]); w.y = cvt_pk_bf16(v0[2], v0[3]); w.z = cvt_pk_bf16(v1[0], v1[1]); w.w = cvt_pk_bf16(v1[2], v1[3]);
                    *(u32x4*)(rowp + bj * HALF) = w; } }
    }
};
struct EpiScaleColBf16 {
    static constexpr bool PERM = true, AFTER_DRAIN = false;
    bf16_t* O; int ldc; const float* ss;
    __device__ __forceinline__ void operator()(const f32x4 (&acc)[2][2][4][2], const Unit& u, int wr, int wc, int fr, int fq) const {
        const int row0 = u.pm * BM + wr * 64 + fr, col0 = u.pn * BM + wc * 32 + 8 * fq;
        f32x4 rs[2][2];
#pragma unroll
        for (int bj = 0; bj < 2; ++bj)
#pragma unroll
            for (int n = 0; n < 2; ++n)
#pragma unroll
                for (int e = 0; e < 4; ++e) rs[bj][n][e] = rstd16(ss + (size_t)(col0 + bj * HALF + 4 * n + e) * 16);
#pragma unroll
        for (int ai = 0; ai < 2; ++ai)
#pragma unroll
            for (int m = 0; m < 4; ++m) { const int row = row0 + ai * HALF + m * 16; bf16_t* rowp = O + (size_t)row * ldc + col0;
#pragma unroll
                for (int bj = 0; bj < 2; ++bj) { const f32x4 v0 = acc[ai][bj][m][0] * rs[bj][0], v1 = acc[ai][bj][m][1] * rs[bj][1];
                    u32x4 w; w.x = cvt_pk_bf16(v0[0], v0[1]); w.y = cvt_pk_bf16(v0[2], v0[3]); w.z = cvt_pk_bf16(v1[0], v1[1]); w.w = cvt_pk_bf16(v1[2], v1[3]);
                    *(u32x4*)(rowp + bj * HALF) = w; } }
    }
};
constexpr float F8_SX = 16.f, F8_SWGU = 512.f, F8_SH = 16.f, F8_SWD = 1024.f;
__device__ __forceinline__ unsigned pk4_fp8(float a, float b, float c, float d) {
    a = __builtin_amdgcn_fmed3f(a, -448.f, 448.f); b = __builtin_amdgcn_fmed3f(b, -448.f, 448.f); c = __builtin_amdgcn_fmed3f(c, -448.f, 448.f); d = __builtin_amdgcn_fmed3f(d, -448.f, 448.f);
    int w = __builtin_amdgcn_cvt_pk_fp8_f32(a, b, 0, false); w = __builtin_amdgcn_cvt_pk_fp8_f32(c, d, w, true); return (unsigned)w;
}
template <bool X8> struct EpiResid {
    static constexpr bool PERM = false, AFTER_DRAIN = false;
    const float* base; float* H; bf16_t* XB; float* ssp; float sc;
    __device__ __forceinline__ void operator()(const f32x4 (&acc)[2][2][4][2], const Unit& u, int wr, int wc, int fr, int fq) const {
        const int row0 = u.pm * BM + wr * 64 + fr, col0 = u.pn * BM + wc * 32 + 4 * fq;
#pragma unroll
        for (int ai = 0; ai < 2; ++ai) {
            f32x4 bv[4][2][2];
#pragma unroll
            for (int m = 0; m < 4; ++m)
#pragma unroll
                for (int bj = 0; bj < 2; ++bj)
#pragma unroll
                    for (int n = 0; n < 2; ++n) bv[m][bj][n] = *(const f32x4*)(base + (size_t)(row0 + ai * HALF + m * 16) * 1024 + col0 + bj * HALF + n * 16);
#pragma unroll
            for (int m = 0; m < 4; ++m) { const int row = row0 + ai * HALF + m * 16; float q = 0.f;
#pragma unroll
                for (int bj = 0; bj < 2; ++bj)
#pragma unroll
                    for (int n = 0; n < 2; ++n) { const size_t off = (size_t)row * 1024 + col0 + bj * HALF + n * 16;
                        const f32x4 v = bv[m][bj][n] + acc[ai][bj][m][n] * sc; *(f32x4*)(H + off) = v;
                        q += (v[0] * v[0] + v[1] * v[1]) + (v[2] * v[2] + v[3] * v[3]);
                        if constexpr (X8) { *(unsigned*)((unsigned char*)XB + off) = pk4_fp8(v[0] * F8_SX, v[1] * F8_SX, v[2] * F8_SX, v[3] * F8_SX); }
                        else { u32x2 w; w.x = cvt_pk_bf16(v[0], v[1]); w.y = cvt_pk_bf16(v[2], v[3]); *(u32x2*)(XB + off) = w; } }
                q += __shfl_xor(q, 16); q += __shfl_xor(q, 32);
                if (fq == 0) ssp[(size_t)row * 16 + u.pn * 4 + wc] = q; }
        }
    }
};
__device__ __forceinline__ float silu_mul(float g, float u) { return g * __builtin_amdgcn_rcpf(1.0f + __builtin_amdgcn_exp2f(g * -1.4426950408889634f)) * u; }
template <bool MOE> struct EpiSwiGLU {
    static constexpr bool PERM = true, AFTER_DRAIN = false;
    bf16_t* O; int ldc; const float* ss;
    __device__ __forceinline__ void operator()(const f32x4 (&acc)[2][2][4][2], const Unit& u, int wr, int wc, int fr, int fq) const {
        const int row0 = u.pm * BM + wr * 64 + fr; const int pnl = MOE ? (u.pn % 22) : u.pn; const int col0 = pnl * HALF + wc * 32 + 8 * fq;
        float rsv[2][4];
#pragma unroll
        for (int ai = 0; ai < 2; ++ai)
#pragma unroll
            for (int m = 0; m < 4; ++m) { const int row = row0 + ai * HALF + m * 16; rsv[ai][m] = MOE ? 1.0f : rstd16(ss + (size_t)row * 16); }
#pragma unroll
        for (int ai = 0; ai < 2; ++ai)
#pragma unroll
            for (int m = 0; m < 4; ++m) { const int row = row0 + ai * HALF + m * 16; const float rs = rsv[ai][m];
                const f32x4 g0 = acc[ai][0][m][0] * rs, g1 = acc[ai][0][m][1] * rs, u0 = acc[ai][1][m][0] * rs, u1 = acc[ai][1][m][1] * rs;
                u32x4 w; w.x = cvt_pk_bf16(silu_mul(g0[0], u0[0]), silu_mul(g0[1], u0[1])); w.y = cvt_pk_bf16(silu_mul(g0[2], u0[2]), silu_mul(g0[3], u0[3]));
                w.z = cvt_pk_bf16(silu_mul(g1[0], u1[0]), silu_mul(g1[1], u1[1])); w.w = cvt_pk_bf16(silu_mul(g1[2], u1[2]), silu_mul(g1[3], u1[3]));
                *(u32x4*)(O + (size_t)row * ldc + col0) = w; }
    }
};
template <bool MOE> struct EpiSwiGLU8 {
    static constexpr bool PERM = true, AFTER_DRAIN = false;
    unsigned char* O; int ldc; const float* ss;
    __device__ __forceinline__ void operator()(const f32x4 (&acc)[2][2][4][2], const Unit& u, int wr, int wc, int fr, int fq) const {
        const int row0 = u.pm * BM + wr * 64 + fr; const int col0 = (MOE ? (u.pn % 22) : u.pn) * HALF + wc * 32 + 8 * fq; const float r0 = 1.0f / (F8_SX * F8_SWGU);
        float rsv[2][4];
#pragma unroll
        for (int ai = 0; ai < 2; ++ai)
#pragma unroll
            for (int m = 0; m < 4; ++m) rsv[ai][m] = MOE ? r0 : r0 * rstd16(ss + (size_t)(row0 + ai * HALF + m * 16) * 16);
#pragma unroll
        for (int ai = 0; ai < 2; ++ai)
#pragma unroll
            for (int m = 0; m < 4; ++m) { const int row = row0 + ai * HALF + m * 16; const float rs = rsv[ai][m], rh = rs * F8_SH;
                const f32x4 g0 = acc[ai][0][m][0] * rs, g1 = acc[ai][0][m][1] * rs, u0 = acc[ai][1][m][0] * rh, u1 = acc[ai][1][m][1] * rh;
                u32x2 w; w.x = pk4_fp8(silu_mul(g0[0], u0[0]), silu_mul(g0[1], u0[1]), silu_mul(g0[2], u0[2]), silu_mul(g0[3], u0[3]));
                w.y = pk4_fp8(silu_mul(g1[0], u1[0]), silu_mul(g1[1], u1[1]), silu_mul(g1[2], u1[2]), silu_mul(g1[3], u1[3]));
                *(u32x2*)(O + (size_t)row * ldc + col0) = w; }
    }
};
struct EpiScaledBf16 {
    static constexpr bool PERM = true, AFTER_DRAIN = false;
    bf16_t* O; int ldc; int pnmask; float sc;
    __device__ __forceinline__ void operator()(const f32x4 (&acc)[2][2][4][2], const Unit& u, int wr, int wc, int fr, int fq) const {
        const int row0 = u.pm * BM + wr * 64 + fr, col0 = (u.pn & pnmask) * BM + wc * 32 + 8 * fq;
#pragma unroll
        for (int ai = 0; ai < 2; ++ai)
#pragma unroll
            for (int m = 0; m < 4; ++m) { bf16_t* rowp = O + (size_t)(row0 + ai * HALF + m * 16) * ldc + col0;
#pragma unroll
                for (int bj = 0; bj < 2; ++bj) { const f32x4 v0 = acc[ai][bj][m][0] * sc, v1 = acc[ai][bj][m][1] * sc;
                    u32x4 w; w.x = cvt_pk_bf16(v0[0], v0[1]); w.y = cvt_pk_bf16(v0[2], v0[3]); w.z = cvt_pk_bf16(v1[0], v1[1]); w.w = cvt_pk_bf16(v1[2], v1[3]);
                    *(u32x4*)(rowp + bj * HALF) = w; } }
    }
};
struct MoeOrder {
    int tb[9]; int npn, G, c;
    __device__ __forceinline__ bool next(int i, Unit& u) const {
        const int L = i * G + c; if (L >= tb[8] * npn) return false;
        const int t = L / npn, j = L - t * npn; int e = 0;
#pragma unroll
        for (int k = 1; k < 8; ++k) e += (t >= tb[k]) ? 1 : 0;
        u.pm = t; u.pn = e * npn + j; return true;
    }
    __device__ __forceinline__ void a_ready(const Unit&) const {}
    __device__ __forceinline__ void done(const Unit&) const {}
};

template <class Epi, class Sched, bool ALIGN_EPI = false, bool SP2 = false, bool F8 = false>
__device__ __forceinline__ void gemm_phase(PG8_LAS unsigned char* lds, const Gemm g, const Sched& S, const Epi& E) {
    const int tid = threadIdx.x, wid = __builtin_amdgcn_readfirstlane(tid >> 6), lane = tid & 63, wr = wid >> 2, wc = wid & 3, fr = lane & 15, fq = lane >> 4;
    const int K = g.K, nt = K / BK, LD = g.ld ? g.ld : g.K;
    unsigned voffA[2], voffB[2];
#pragma unroll
    for (int i = 0; i < 2; ++i) { int R, C; stage_rc(tid * 16 + i * 8192, R, C); const int Rb = Epi::PERM ? ((R & ~31) + perm32(R & 31)) : R;
        voffA[i] = (unsigned)(R * LD + C) * 2u; voffB[i] = (unsigned)(Rb * LD + C) * 2u; }
    const size_t kstep = (size_t)(BK * 2);
    const size_t hstep = (size_t)HALF * LD * 2;
    const size_t tstep = 2 * hstep;
    const unsigned ldsw = (unsigned)wid * 1024u;
    const int aoff = lds_byte(wr * 64 + fr, fq * 8), boff = lds_byte(wc * 32 + fr, fq * 8);
#define PG8_SA(b, h) (((b) * 2 + (h)) * HTB)
#define PG8_SB(b, h) ((4 + (b) * 2 + (h)) * HTB)
#define PG8_STAGE(bufoff, gbase, voff) do { _Pragma("unroll") for (int _i = 0; _i < 2; ++_i) \
        __builtin_amdgcn_global_load_lds((const unsigned*)((const char*)(gbase) + (voff)[_i]), (PG8_LAS unsigned*)(lds + (bufoff) + ldsw + _i * 8192), 16, 0, 0); } while (0)
#define PG8_LD32(p) __builtin_shufflevector(*(const PG8_LAS i32x4*)(p), *(const PG8_LAS i32x4*)((p) + 1024), 0, 1, 2, 3, 4, 5, 6, 7)
#define PG8_LDA(dst, b, h) do { if constexpr (F8) { _Pragma("unroll") for (int m = 0; m < 4; ++m) dst##8[m] = PG8_LD32(lds + PG8_SA(b, h) + aoff + m * 2048); } else { \
        _Pragma("unroll") for (int m = 0; m < 4; ++m) _Pragma("unroll") for (int k = 0; k < 2; ++k) dst[m][k] = *(const PG8_LAS bf16x8*)(lds + PG8_SA(b, h) + aoff + m * 2048 + k * 1024); } } while (0)
#define PG8_LDB(dst, b, h) do { if constexpr (F8) { _Pragma("unroll") for (int n = 0; n < 2; ++n) dst##8[n] = PG8_LD32(lds + PG8_SB(b, h) + boff + n * 2048); } else { \
        _Pragma("unroll") for (int n = 0; n < 2; ++n) _Pragma("unroll") for (int k = 0; k < 2; ++k) dst[n][k] = *(const PG8_LAS bf16x8*)(lds + PG8_SB(b, h) + boff + n * 2048 + k * 1024); } } while (0)
#define PG8_MMA(ai, bj, At, Bt) do { __builtin_amdgcn_s_setprio(1); if constexpr (F8) { _Pragma("unroll") for (int m = 0; m < 4; ++m) _Pragma("unroll") for (int n = 0; n < 2; ++n) \
        asm("v_mfma_f32_16x16x128_f8f6f4 %0, %1, %2, %0" : "+v"(acc[ai][bj][m][n]) : "v"(Bt##8[n]), "v"(At##8[m])); } else { \
        _Pragma("unroll") for (int m = 0; m < 4; ++m) _Pragma("unroll") for (int n = 0; n < 2; ++n) _Pragma("unroll") for (int k = 0; k < 2; ++k) \
        acc[ai][bj][m][n] = __builtin_amdgcn_mfma_f32_16x16x32_bf16(Bt[n][k], At[m][k], acc[ai][bj][m][n], 0, 0, 0); } __builtin_amdgcn_s_setprio(0); } while (0)
#define PG8_WAIT_V(n) asm volatile("s_waitcnt vmcnt(" #n ")" ::: "memory")
#define PG8_WAIT_L(n) asm volatile("s_waitcnt lgkmcnt(" #n ")" ::: "memory")
#define PG8_BAR __builtin_amdgcn_s_barrier()
#define PG8_SCHED __builtin_amdgcn_sched_barrier(0)
    Unit cur, nxt; int ui = 0;
    if (!S.next(0, cur)) return;
    f32x4 acc[2][2][4][2];
#pragma unroll
    for (int a = 0; a < 2; ++a)
#pragma unroll
        for (int b = 0; b < 2; ++b)
#pragma unroll
            for (int m = 0; m < 4; ++m)
#pragma unroll
                for (int n = 0; n < 2; ++n) acc[a][b][m][n] = (f32x4){0.f, 0.f, 0.f, 0.f};
    bf16x8 At[4][2], B0[2][2], B1[2][2]; i32x8 At8[4], B08[2], B18[2];
    const char* cA = (const char*)g.A + (size_t)cur.pm * tstep + cur.koff; const char* cB = (const char*)g.Bt + (size_t)cur.pn * tstep + cur.koff;
    S.a_ready(cur);
    if constexpr (SP2) {
        PG8_STAGE(PG8_SB(0, 0), cB, voffB); PG8_STAGE(PG8_SB(0, 1), cB + hstep, voffB); PG8_STAGE(PG8_SA(0, 0), cA, voffA); PG8_STAGE(PG8_SA(0, 1), cA + hstep, voffA);
        if (wr == 1) PG8_BAR;
        PG8_WAIT_V(2); PG8_BAR;
        PG8_STAGE(PG8_SB(1, 0), cB + kstep, voffB); PG8_STAGE(PG8_SA(1, 0), cA + kstep, voffA); PG8_STAGE(PG8_SB(1, 1), cB + hstep + kstep, voffB);
        PG8_WAIT_V(6); PG8_BAR;
    } else {
        PG8_STAGE(PG8_SB(0, 0), cB, voffB); PG8_STAGE(PG8_SA(0, 0), cA, voffA); PG8_STAGE(PG8_SB(0, 1), cB + hstep, voffB); PG8_STAGE(PG8_SA(0, 1), cA + hstep, voffA);
        if (wr == 1) PG8_BAR;
        PG8_WAIT_V(4); PG8_BAR;
        PG8_STAGE(PG8_SB(1, 0), cB + kstep, voffB); PG8_STAGE(PG8_SA(1, 0), cA + kstep, voffA); PG8_STAGE(PG8_SB(1, 1), cB + hstep + kstep, voffB);
        PG8_WAIT_V(6); PG8_BAR;
    }
    for (;;) {
        const bool has_next = S.next(ui + 1, nxt);
        const char* nA = has_next ? (const char*)g.A + (size_t)nxt.pm * tstep + nxt.koff : cA; const char* nB = has_next ? (const char*)g.Bt + (size_t)nxt.pn * tstep + nxt.koff : cB;
#pragma clang loop unroll(disable)
        for (int t = 0; t < nt; t += 2) {
            const bool last = (t == nt - 2);
            const char* a1 = cA + (size_t)(t + 1) * kstep;
            const char* a2 = last ? nA : cA + (size_t)(t + 2) * kstep; const char* b2 = last ? nB : cB + (size_t)(t + 2) * kstep;
            const char* a3 = a2 + kstep; const char* b3 = b2 + kstep;
            if (last && has_next) S.a_ready(nxt);
            if constexpr (SP2) {
            PG8_LDB(B0, 0, 0); PG8_LDB(B1, 0, 1); PG8_SCHED; PG8_LDA(At, 0, 0); PG8_STAGE(PG8_SA(1, 1), a1 + hstep, voffA);
            PG8_WAIT_V(8); PG8_WAIT_L(0); PG8_BAR; PG8_MMA(0, 0, At, B0); PG8_MMA(0, 1, At, B1); PG8_BAR; PG8_SCHED;
            PG8_LDA(At, 0, 1); PG8_STAGE(PG8_SB(0, 0), b2, voffB); PG8_STAGE(PG8_SB(0, 1), b2 + hstep, voffB); PG8_STAGE(PG8_SA(0, 0), a2, voffA);
            PG8_WAIT_V(8); PG8_WAIT_L(0); PG8_BAR; PG8_MMA(1, 0, At, B0); PG8_MMA(1, 1, At, B1); PG8_BAR; PG8_SCHED;
            PG8_LDB(B0, 1, 0); PG8_LDB(B1, 1, 1); PG8_SCHED; PG8_LDA(At, 1, 0); PG8_STAGE(PG8_SA(0, 1), a2 + hstep, voffA);
            PG8_WAIT_V(8); PG8_WAIT_L(0); PG8_BAR; PG8_MMA(0, 0, At, B0); PG8_MMA(0, 1, At, B1); PG8_BAR; PG8_SCHED;
            PG8_LDA(At, 1, 1); PG8_STAGE(PG8_SB(1, 0), b3, voffB); PG8_STAGE(PG8_SB(1, 1), b3 + hstep, voffB); PG8_STAGE(PG8_SA(1, 0), a3, voffA);
            PG8_WAIT_V(8); PG8_WAIT_L(0); PG8_BAR; PG8_MMA(1, 0, At, B0); PG8_MMA(1, 1, At, B1); PG8_BAR; PG8_SCHED;
            } else {
            PG8_LDB(B0, 0, 0); PG8_SCHED; PG8_LDA(At, 0, 0); PG8_STAGE(PG8_SA(1, 1), a1 + hstep, voffA);
            PG8_WAIT_L(8); PG8_BAR; PG8_WAIT_L(0); PG8_MMA(0, 0, At, B0); PG8_BAR; PG8_SCHED;
            PG8_LDB(B1, 0, 1); PG8_STAGE(PG8_SB(0, 0), b2, voffB);
            PG8_BAR; PG8_WAIT_L(0); PG8_MMA(0, 1, At, B1); PG8_BAR;
            PG8_LDA(At, 0, 1); PG8_STAGE(PG8_SA(0, 0), a2, voffA);
            PG8_BAR; PG8_WAIT_L(0); PG8_MMA(1, 0, At, B0); PG8_BAR; PG8_SCHED;
            PG8_STAGE(PG8_SB(0, 1), b2 + hstep, voffB);
            PG8_WAIT_V(6); PG8_BAR; PG8_MMA(1, 1, At, B1); PG8_BAR;
            PG8_LDB(B0, 1, 0); PG8_SCHED; PG8_LDA(At, 1, 0); PG8_STAGE(PG8_SA(0, 1), a2 + hstep, voffA);
            PG8_WAIT_L(8); PG8_BAR; PG8_WAIT_L(0); PG8_MMA(0, 0, At, B0); PG8_BAR; PG8_SCHED;
            PG8_LDB(B1, 1, 1); PG8_STAGE(PG8_SB(1, 0), b3, voffB);
            PG8_BAR; PG8_WAIT_L(0); PG8_MMA(0, 1, At, B1); PG8_BAR;
            PG8_LDA(At, 1, 1); PG8_STAGE(PG8_SA(1, 0), a3, voffA);
            PG8_BAR; PG8_WAIT_L(0); PG8_MMA(1, 0, At, B0); PG8_BAR; PG8_SCHED;
            PG8_STAGE(PG8_SB(1, 1), b3 + hstep, voffB);
            PG8_WAIT_V(6); PG8_BAR; PG8_MMA(1, 1, At, B1); PG8_BAR;
            }
        }
        if constexpr (F8) asm volatile("s_nop 15\n\ts_nop 15" ::: "memory");
        if constexpr (ALIGN_EPI) { if (wr == 0) PG8_BAR; }
        if constexpr (!Epi::AFTER_DRAIN) { E(acc, cur, wr, wc, fr, fq); S.done(cur); }
        if (!has_next) break;
#pragma unroll
        for (int a = 0; a < 2; ++a)
#pragma unroll
            for (int b = 0; b < 2; ++b)
#pragma unroll
                for (int m = 0; m < 4; ++m)
#pragma unroll
                    for (int n = 0; n < 2; ++n) acc[a][b][m][n] = (f32x4){0.f, 0.f, 0.f, 0.f};
        cur = nxt; cA = nA; cB = nB; ++ui;
        if constexpr (ALIGN_EPI) { if (wr == 1) PG8_BAR; }
    }
    PG8_WAIT_V(0);
    if constexpr (!ALIGN_EPI) { if (wr == 0) PG8_BAR; }
    PG8_BAR;
    if constexpr (Epi::AFTER_DRAIN) { E.fused(acc, cur, wr, wc, fr, fq, lds, wid, lane); S.done(cur); }
#undef PG8_SA
#undef PG8_SB
#undef PG8_STAGE
#undef PG8_LDA
#undef PG8_LDB
#undef PG8_MMA
#undef PG8_LD32
#undef PG8_WAIT_V
#undef PG8_WAIT_L
#undef PG8_BAR
#undef PG8_SCHED
}
}

constexpr int NWAVES = 8;
constexpr int BATCH = 2, SEQ = 8192, D = 1024, M = BATCH * SEQ;
constexpr int HD = 128, NH = 8, NKV = 2, NIH = 8, IDX = 64, TOPK = 256;
constexpr int A_IN = 2120, FF = 2816, NE = 8;
constexpr int MAXSLOT = 34816;
constexpr float QSCALE = 0.12751743082459868f;
constexpr float SBSCALE = 0.08838834764831845f;
constexpr float WISCALE = 0.04419417382415922f;
constexpr size_t MiB = 1u << 20;
constexpr size_t WS_CTL = 0, CTL_ZERO_BYTES = 1 * MiB;
constexpr size_t WS_WIN = 2 * MiB, WS_WTAIL = 6 * MiB, WS_WOA = 7 * MiB, WS_WGU = 9 * MiB, WS_WD = 20 * MiB, WS_WKVQ = 26 * MiB, WS_WOB = 32 * MiB, WS_WGUM = 34 * MiB, WS_WDM = 122 * MiB;
constexpr size_t WS_H = 166 * MiB, WS_XB = 230 * MiB, WS_SS0 = 262 * MiB, WS_SS1 = 263 * MiB, WS_SS2 = 264 * MiB, WS_SS3 = 265 * MiB;
constexpr size_t WS_T = 266 * MiB;
constexpr size_t WS_PROJ = WS_T, WS_QF = 330 * MiB, WS_KVF = 362 * MiB, WS_QIF = 378 * MiB, WS_KIF = 394 * MiB, WS_WIF = 396 * MiB, WS_SEL = 397 * MiB, WS_AO = 413 * MiB;
constexpr size_t WS_HF = WS_T, WS_KQ = WS_T, WS_VT = 330 * MiB;
constexpr size_t WS_XPERM = WS_T, WS_HM = 334 * MiB, WS_Y = 521 * MiB;
constexpr size_t WS_RT = 590 * MiB;
constexpr size_t WS_END = 591 * MiB;
constexpr int CW_CNT = 64;
constexpr int CW_P3Q = 192;
constexpr int CW_BAR = 4096;
constexpr int RING_BYTES = 131072, LDSCTL_OFF = RING_BYTES, MISC_OFF = LDSCTL_OFF + 320, LDS_BYTES = 147456;

#define GAS __attribute__((address_space(1)))
#define LAS __attribute__((address_space(3)))
typedef unsigned short bf16;
typedef unsigned v4u __attribute__((ext_vector_type(4)));
typedef unsigned v2u __attribute__((ext_vector_type(2)));
typedef float f32x4 __attribute__((ext_vector_type(4)));
typedef short bf16x8 __attribute__((ext_vector_type(8)));
typedef float f32x16 __attribute__((ext_vector_type(16)));
typedef GAS unsigned gu32;
#define RLX_AGENT __ATOMIC_RELAXED, __HIP_MEMORY_SCOPE_AGENT
#define LDS_WAIT() asm volatile("s_waitcnt lgkmcnt(0)" ::: "memory")
#define VM_WAIT() asm volatile("s_waitcnt vmcnt(0)" ::: "memory")
__device__ __forceinline__ unsigned f2bf(float f) { unsigned u = __builtin_bit_cast(unsigned, f); return (u + 0x7fffu + ((u >> 16) & 1u)) >> 16; }
__device__ __forceinline__ unsigned pk2(float lo, float hi) { return f2bf(lo) | (f2bf(hi) << 16); }
__device__ __forceinline__ float bflo(unsigned w) { return __uint_as_float(w << 16); }
__device__ __forceinline__ float bfhi(unsigned w) { return __uint_as_float(w & 0xffff0000u); }
__device__ __forceinline__ float wave_sum(float v) {
#pragma unroll
    for (int o = 1; o < 64; o <<= 1) v += __shfl_xor(v, o);
    return v;
}
__device__ __forceinline__ float wave_max(float v) {
#pragma unroll
    for (int o = 1; o < 64; o <<= 1) v = fmaxf(v, __shfl_xor(v, o));
    return v;
}
__device__ __forceinline__ void sincos_acc(float a, float& c, float& s) {
    const double x = (double)a; const double n = __builtin_rint(x * 0.63661977236758134308);
    const double r = __builtin_fma(-n, 6.123233995736766035869e-17, __builtin_fma(-n, 1.57079632679489655800, x)); const double r2 = r * r;
    double sn = 1.0 - r2 * (1.0 / 156.0); sn = 1.0 - r2 * (1.0 / 110.0) * sn; sn = 1.0 - r2 * (1.0 / 72.0) * sn; sn = 1.0 - r2 * (1.0 / 42.0) * sn; sn = 1.0 - r2 * (1.0 / 20.0) * sn; sn = 1.0 - r2 * (1.0 / 6.0) * sn; sn *= r;
    double cs = 1.0 - r2 * (1.0 / 182.0); cs = 1.0 - r2 * (1.0 / 132.0) * cs; cs = 1.0 - r2 * (1.0 / 90.0) * cs; cs = 1.0 - r2 * (1.0 / 56.0) * cs; cs = 1.0 - r2 * (1.0 / 30.0) * cs; cs = 1.0 - r2 * (1.0 / 12.0) * cs; cs = 1.0 - r2 * 0.5 * cs;
    const int q = ((int)n) & 3;
    const double cq = (q == 0) ? cs : (q == 1) ? -sn : (q == 2) ? -cs : sn;
    const double sq = (q == 0) ? sn : (q == 1) ? cs : (q == 2) ? -sn : -cs;
    c = (float)cq; s = (float)sq;
}
__device__ const float INV_Q[16] = {1.000000000e+00f, 4.403665960e-01f, 1.939227432e-01f, 8.539710194e-02f, 3.760603070e-02f, 1.656043902e-02f, 7.292664610e-03f, 3.211445874e-03f,
                                    1.414213562e-03f, 6.227723788e-04f, 2.742481884e-04f, 1.207697351e-04f, 5.318296098e-05f, 2.341999971e-05f, 1.031338616e-05f, 4.541670478e-06f};
__device__ const float INV_I[8] = {1.000000000e+00f, 1.939227432e-01f, 3.760603070e-02f, 7.292664610e-03f, 1.414213562e-03f, 2.742481884e-04f, 5.318296098e-05f, 1.031338616e-05f};

#define XB_TMO      128
#define XB_XCNT(j)  (256  + 64 * (j))
#define XB_XSUB(j)  (1280 + 64 * (j))
#define XB_XGEN(j)  (2304 + 64 * (j))
#define XB_TOP      3328
#define XB_TOPGEN   3392
#define XCD_BAR_WORDS 3456
#define XB_SPIN_CAP (1u << 18)

__device__ __forceinline__ unsigned xb_ld(unsigned* p)              { return __hip_atomic_load(p, __ATOMIC_RELAXED, __HIP_MEMORY_SCOPE_AGENT); }
__device__ __forceinline__ unsigned xb_add(unsigned* p, unsigned v) { return __hip_atomic_fetch_add(p, v, __ATOMIC_RELAXED, __HIP_MEMORY_SCOPE_AGENT); }
__device__ __forceinline__ unsigned xb_xcc_id() { return (unsigned)__builtin_amdgcn_s_getreg((3 << 11) | 20) & 0xFu; }
#define XB_SPIN(cond, bar) do { unsigned _sp = 0; while (cond) { __builtin_amdgcn_s_sleep(1); \
    if ((++_sp & 255u) == 0u) { if (xb_ld(&(bar)[XB_TMO])) break; if (_sp > XB_SPIN_CAP) { atomicAdd(&(bar)[XB_TMO], 1u); break; } } } } while (0)

struct XcdBarrier {
    unsigned* bar; unsigned x;
    volatile LAS unsigned* st;
};

__device__ __forceinline__ XcdBarrier xcd_barrier_post(unsigned* bar, volatile LAS unsigned* st) {
    XcdBarrier b; b.bar = bar; b.x = xb_xcc_id(); b.st = st;
    if (threadIdx.x == 0) (void)xb_add(&bar[XB_XCNT(b.x)], 1u);
    return b;
}
__device__ __forceinline__ void xcd_barrier_complete(unsigned* bar, unsigned x, unsigned& nloc, unsigned& nx) {
    const unsigned G = gridDim.x * gridDim.y * gridDim.z;
    unsigned sum, cnt, mine, sp = 0u;
    for (;;) {
        sum = 0u; cnt = 0u; mine = 0u;
#pragma unroll
        for (unsigned j = 0; j < 16; ++j) { const unsigned c = xb_ld(&bar[XB_XCNT(j)]); sum += c; cnt += (c > 0u) ? 1u : 0u; mine = (j == x) ? c : mine; }
        if (sum == G) break;
        __builtin_amdgcn_s_sleep(1);
        if ((++sp & 255u) == 0u) { if (xb_ld(&bar[XB_TMO])) break; if (sp > XB_SPIN_CAP) { atomicAdd(&bar[XB_TMO], 1u); break; } }
    }
    nloc = mine > 0u ? mine : 1u; nx = cnt > 0u ? cnt : 1u;
}

__device__ __forceinline__ void xcd_barrier(const XcdBarrier& b) {
    asm volatile("s_waitcnt vmcnt(0)" ::: "memory");
    __syncthreads();
    if (threadIdx.x == 0) {
        unsigned* bar = b.bar;
        __builtin_amdgcn_s_waitcnt(0);
        unsigned nloc = b.st[0], nx = b.st[1];
        if (nloc == 0u) { xcd_barrier_complete(bar, b.x, nloc, nx); b.st[0] = nloc; b.st[1] = nx; }
        const unsigned old = xb_add(&bar[XB_XSUB(b.x)], 1u);
        const unsigned gen = old / nloc;
        if (old + 1u == (gen + 1u) * nloc) {
            __builtin_amdgcn_fence(__ATOMIC_RELEASE, "agent");
            asm volatile("s_waitcnt vmcnt(0)" ::: "memory");
            const unsigned og = xb_add(&bar[XB_TOP], 1u);
            const unsigned tg = og / nx;
            if (og + 1u == (tg + 1u) * nx) xb_add(&bar[XB_TOPGEN], 1u);
            else XB_SPIN(xb_ld(&bar[XB_TOPGEN]) == tg, bar);
            __builtin_amdgcn_fence(__ATOMIC_ACQUIRE, "agent");
            xb_add(&bar[XB_XGEN(b.x)], 1u);
            asm volatile("s_waitcnt vmcnt(0)" ::: "memory");
        } else {
            XB_SPIN(xb_ld(&bar[XB_XGEN(b.x)]) == gen, bar);
            __builtin_amdgcn_fence(__ATOMIC_ACQUIRE, "agent");
            asm volatile("s_waitcnt vmcnt(0)" ::: "memory");
        }
    }
    __syncthreads();
}

struct Frame {
    LAS unsigned char* lds;
    volatile LAS unsigned* MISC;
    gu32* ctl;
    int tid, lane, wave, G, bid;
    const float* in[17];
    float* out; unsigned char* ws;
};
enum { IN_X = 0, IN_ANORM, IN_AWIN, IN_AQN, IN_AKN, IN_AWOUT, IN_KVNORM, IN_KVW, IN_BNORM, IN_BWQ, IN_BWOUT, IN_FFNNORM, IN_DGU, IN_DDN, IN_ROUTER, IN_MGU, IN_MDN };

struct TrItem { const float* W; size_t ldw; int K, k0, csrc0, cend; bf16* WT; int drow0; const float* gain; float scale; int f8; };
__device__ __forceinline__ int gu_row(int c0) { return (c0 < FF) ? ((c0 >> 7) * 256 + (c0 & 127)) : (((c0 - FF) >> 7) * 256 + 128 + ((c0 - FF) & 127)); }
constexpr int I_WIN = 16 * 32, I_TAIL = 16 * 2, I_SQ = 16 * 16, I_GU = 16 * 88, I_DN = 44 * 16, I_KV = 16 * 32;
constexpr int TR_NITEMS = I_WIN + I_TAIL + I_SQ + I_GU + I_DN + I_KV + I_SQ + I_SQ + NE * I_GU + NE * I_DN;
__device__ __forceinline__ TrItem tr_decode(const Frame& F, int it) {
    unsigned char* ws = F.ws; int r = it; TrItem t;
    if (r < I_WIN) { const int kb = r / 32, nb = r % 32; t = TrItem{F.in[IN_AWIN], (size_t)A_IN, D, 64 * kb, 64 * nb, A_IN, (bf16*)(ws + WS_WIN), 64 * nb, F.in[IN_ANORM], 1.f}; return t; } r -= I_WIN;
    if (r < I_TAIL) { const int kb = r / 2, nb = r % 2; t = TrItem{F.in[IN_AWIN], (size_t)A_IN, D, 64 * kb, 2048 + 64 * nb, A_IN, (bf16*)(ws + WS_WTAIL), 64 * nb, F.in[IN_ANORM], 1.f}; return t; } r -= I_TAIL;
    if (r < I_SQ) { const int kb = r / 16, nb = r % 16; t = TrItem{F.in[IN_AWOUT], (size_t)D, D, 64 * kb, 64 * nb, D, (bf16*)(ws + WS_WOA), 64 * nb, nullptr, 1.f}; return t; } r -= I_SQ;
    if (r < I_GU) { const int kb = r / 88, nb = r % 88; t = TrItem{F.in[IN_DGU], (size_t)(2 * FF), D, 64 * kb, 64 * nb, 2 * FF, (bf16*)(ws + WS_WGU), gu_row(64 * nb), F.in[IN_FFNNORM], pg8::F8_SWGU, 1}; return t; } r -= I_GU;
    if (r < I_DN) { const int kb = r / 16, nb = r % 16; t = TrItem{F.in[IN_DDN], (size_t)D, FF, 64 * kb, 64 * nb, D, (bf16*)(ws + WS_WD), 64 * nb, nullptr, pg8::F8_SWD, 1}; return t; } r -= I_DN;
    if (r < I_KV) { const int kb = r / 32, nb = r % 32; t = TrItem{F.in[IN_KVW], (size_t)(2 * D), D, 64 * kb, 64 * nb, 2 * D, (bf16*)(ws + WS_WKVQ), (nb < 16) ? 64 * nb : 1024 + 64 * nb, F.in[IN_KVNORM], 1.f}; return t; } r -= I_KV;
    if (r < I_SQ) { const int kb = r / 16, nb = r % 16; t = TrItem{F.in[IN_BWQ], (size_t)D, D, 64 * kb, 64 * nb, D, (bf16*)(ws + WS_WKVQ), 1024 + 64 * nb, F.in[IN_BNORM], SBSCALE}; return t; } r -= I_SQ;
    if (r < I_SQ) { const int kb = r / 16, nb = r % 16; t = TrItem{F.in[IN_BWOUT], (size_t)D, D, 64 * kb, 64 * nb, D, (bf16*)(ws + WS_WOB), 64 * nb, nullptr, 1.f}; return t; } r -= I_SQ;
    if (r < NE * I_GU) { const int e = r / I_GU, rr = r % I_GU, kb = rr / 88, nb = rr % 88;
        t = TrItem{F.in[IN_MGU] + (size_t)e * D * 2 * FF, (size_t)(2 * FF), D, 64 * kb, 64 * nb, 2 * FF, (bf16*)(ws + WS_WGUM), e * 2 * FF + gu_row(64 * nb), F.in[IN_FFNNORM] + D, pg8::F8_SWGU, 1}; return t; } r -= NE * I_GU;
    { const int e = r / I_DN, rr = r % I_DN, kb = rr / 16, nb = rr % 16;
      t = TrItem{F.in[IN_MDN] + (size_t)e * FF * D, (size_t)D, FF, 64 * kb, 64 * nb, D, (bf16*)(ws + WS_WDM), e * D + 64 * nb, nullptr, pg8::F8_SWD, 1}; return t; }
}
__device__ __forceinline__ void tr_load(const TrItem& t, f32x4 (&v)[16], int lane) {
    const int r = lane >> 4, c = t.csrc0 + 4 * (lane & 15); const bool ok = c < t.cend; const float* src = t.W + (size_t)(t.k0 + r) * t.ldw + (ok ? c : 0);
#pragma unroll
    for (int i = 0; i < 16; ++i) { const f32x4 x = __builtin_nontemporal_load((const f32x4*)(src + (size_t)(4 * i) * t.ldw)); v[i] = ok ? x : (f32x4){0.f, 0.f, 0.f, 0.f}; }
}
__device__ __forceinline__ void tr_store(const TrItem& t, const f32x4 (&v)[16], LAS float* scr, int lane) {
    const int r = lane >> 4, c4 = lane & 15;
#pragma unroll
    for (int i = 0; i < 16; ++i) { const int k = 4 * i + r; const float g = t.gain ? t.gain[t.k0 + k] * t.scale : t.scale;
        *(LAS f32x4*)(scr + k * 64 + 4 * (c4 ^ ((k >> 3) & 7))) = v[i] * g; }
    LDS_WAIT(); asm volatile("" ::: "memory");
    if (t.f8) {
        const int c4b = lane & 3;
#pragma unroll
        for (int j = 0; j < 4; ++j) { const int n = (lane >> 2) + 16 * j;
            const LAS float* s0 = scr + (16 * c4b) * 64 + (n ^ ((2 * c4b) << 2)); const LAS float* s1 = scr + (16 * c4b + 8) * 64 + (n ^ ((2 * c4b + 1) << 2));
            v4u o; o.x = pg8::pk4_fp8(s0[0 * 64], s0[1 * 64], s0[2 * 64], s0[3 * 64]); o.y = pg8::pk4_fp8(s0[4 * 64], s0[5 * 64], s0[6 * 64], s0[7 * 64]);
            o.z = pg8::pk4_fp8(s1[0 * 64], s1[1 * 64], s1[2 * 64], s1[3 * 64]); o.w = pg8::pk4_fp8(s1[4 * 64], s1[5 * 64], s1[6 * 64], s1[7 * 64]);
            *(GAS v4u*)((unsigned char*)t.WT + (size_t)(t.drow0 + n) * t.K + t.k0 + 16 * c4b) = o; }
    } else {
    const int c8 = lane & 7;
#pragma unroll
    for (int j = 0; j < 8; ++j) { const int n = (lane >> 3) + 8 * j; const LAS float* s = scr + (8 * c8) * 64 + (n ^ (c8 << 2));
        v4u o; o.x = pk2(s[0 * 64], s[1 * 64]); o.y = pk2(s[2 * 64], s[3 * 64]); o.z = pk2(s[4 * 64], s[5 * 64]); o.w = pk2(s[6 * 64], s[7 * 64]);
        *(GAS v4u*)(t.WT + (size_t)(t.drow0 + n) * t.K + t.k0 + 8 * c8) = o; }
    }
    LDS_WAIT(); asm volatile("" ::: "memory");
}
__device__ __forceinline__ void p0_prologue(Frame& F) {
    LAS float* scr = (LAS float*)(F.lds + F.wave * 16384);
    const int gw = F.wave * F.G + F.bid, NGW = F.G * NWAVES;
    unsigned char* ws = F.ws;
    {
        f32x4 va[16], vb[16];
        int it = gw;
        if (it < TR_NITEMS) { TrItem cur = tr_decode(F, it); tr_load(cur, va, F.lane);
            for (;;) {
                const int nx = it + NGW; const bool has = nx < TR_NITEMS; TrItem nxt = cur;
                if (has) { nxt = tr_decode(F, nx); tr_load(nxt, vb, F.lane); }
                tr_store(cur, va, scr, F.lane);
                if (!has) break;
                it = nx + NGW; const bool has2 = it < TR_NITEMS; TrItem nn = nxt;
                if (has2) { nn = tr_decode(F, it); tr_load(nn, va, F.lane); }
                tr_store(nxt, vb, scr, F.lane);
                if (!has2) break;
                cur = nn;
            }
        }
    }
    const float* x = F.in[IN_X]; bf16* XB = (bf16*)(ws + WS_XB);
    for (int m = gw; m < M; m += NGW) {
        const GAS f32x4* xr = (const GAS f32x4*)(x + (size_t)m * D) + F.lane; f32x4 v[4]; float s = 0.f;
#pragma unroll
        for (int j = 0; j < 4; ++j) { v[j] = xr[64 * j]; s += (v[j].x * v[j].x + v[j].y * v[j].y) + (v[j].z * v[j].z + v[j].w * v[j].w); }
        s = wave_sum(s); const float rs = 1.0f / sqrtf(s * (1.0f / 1024.0f) + 1e-6f);
        GAS unsigned long long* o8 = (GAS unsigned long long*)(XB + (size_t)m * D) + F.lane;
#pragma unroll
        for (int j = 0; j < 4; ++j) o8[64 * j] = (unsigned long long)pk2(v[j].x * rs, v[j].y * rs) | ((unsigned long long)pk2(v[j].z * rs, v[j].w * rs) << 32);
    }
}

#define WAVE_SYNC() asm volatile("s_waitcnt lgkmcnt(0)" ::: "memory")
__device__ __forceinline__ void rope8(float (&y)[8], bool isx1, bool isx2, int i0, int pshift, LAS const float* tab) {
#pragma unroll
    for (int e = 0; e < 8; ++e) {
        const float other = __shfl_xor(y[e], pshift); const float c = tab[2 * (i0 + e)], s = tab[2 * (i0 + e) + 1];
        y[e] = isx1 ? (y[e] * c - other * s) : (isx2 ? (y[e] * c + other * s) : y[e]);
    }
}
__device__ __forceinline__ size_t kif_off(int grow, int d) { return ((((size_t)(grow >> 5) * 4 + ((d >> 3) & 3)) * 2 + (d >> 5)) * 32 + (grow & 31)) * 8 + (d & 7); }
__device__ __forceinline__ void unpack8(const v4u w, float (&y)[8]) { y[0] = bflo(w.x); y[1] = bfhi(w.x); y[2] = bflo(w.y); y[3] = bfhi(w.y); y[4] = bflo(w.z); y[5] = bfhi(w.z); y[6] = bflo(w.w); y[7] = bfhi(w.w); }
__device__ __forceinline__ v4u pack8(const float (&y)[8]) { v4u o; o.x = pk2(y[0], y[1]); o.y = pk2(y[2], y[3]); o.z = pk2(y[4], y[5]); o.w = pk2(y[6], y[7]); return o; }
__device__ __forceinline__ void p2_post(Frame& F) {
    unsigned char* ws = F.ws; const int lane = F.lane;
    const bf16* PROJ = (const bf16*)(ws + WS_PROJ); const bf16* XB = (const bf16*)(ws + WS_XB); const bf16* WT = (const bf16*)(ws + WS_WTAIL);
    bf16* QF = (bf16*)(ws + WS_QF); bf16* KVF = (bf16*)(ws + WS_KVF); bf16* QIF = (bf16*)(ws + WS_QIF); bf16* KIF = (bf16*)(ws + WS_KIF); float* WIF = (float*)(ws + WS_WIF);
    const float* qnw = F.in[IN_AQN]; const float* knw = F.in[IN_AKN];
    LAS float* tab = (LAS float*)(F.lds + F.wave * 256);
    const int gw = F.wave * F.G + F.bid, NGW = F.G * NWAVES;
    for (int task = gw; task < M / 8; task += NGW) {
        const int row0 = task * 8;
        f32x4 acc[5];
#pragma unroll
        for (int c = 0; c < 5; ++c) acc[c] = (f32x4){0.f, 0.f, 0.f, 0.f};
        const bf16* ap = XB + (size_t)(row0 + (lane & 7)) * D + 8 * (lane >> 4);
        const bf16* bp = WT + (size_t)(lane & 15) * D + 8 * (lane >> 4);
#pragma unroll 4
        for (int j = 0; j < 32; ++j) {
            const bf16x8 a = *(const bf16x8*)(ap + 32 * j);
#pragma unroll
            for (int c = 0; c < 5; ++c) { const bf16x8 b = *(const bf16x8*)(bp + (size_t)(16 * c) * D + 32 * j); acc[c] = __builtin_amdgcn_mfma_f32_16x16x32_bf16(a, b, acc[c], 0, 0, 0); }
        }
        if (lane < 32) {
#pragma unroll
            for (int reg = 0; reg < 4; ++reg) {
                const int row = row0 + 4 * (lane >> 4) + reg; const float rs = 1.0f; const float pos = (float)(row & (SEQ - 1));
                const int d = lane & 15;
                float v0 = acc[0][reg] * rs; const float other = __shfl_xor(v0, 8);
                { float c, s; sincos_acc(pos * INV_I[d & 7], c, s); v0 = (d < 8) ? (v0 * c - other * s) : (v0 * c + other * s); }
                KIF[kif_off(row, d)] = (bf16)f2bf(v0);
#pragma unroll
                for (int c = 1; c < 4; ++c) KIF[kif_off(row, 16 * c + d)] = (bf16)f2bf(acc[c][reg] * rs);
                if (d < 8) WIF[(size_t)row * 8 + d] = acc[4][reg] * rs * WISCALE;
            }
        }
        for (int r = 0; r < 8; ++r) {
            const int row = row0 + r, b = row >> 13, t = row & (SEQ - 1); const float pos = (float)t;
            const bf16* pr = PROJ + (size_t)row * 2048 + 8 * lane;
            v4u w[4];
#pragma unroll
            for (int j = 0; j < 4; ++j) w[j] = __builtin_nontemporal_load((const v4u*)(pr + 512 * j));
            if (lane < 24) { float c, s; sincos_acc(pos * ((lane < 16) ? INV_Q[lane & 15] : INV_I[lane & 7]), c, s); tab[2 * lane] = c; tab[2 * lane + 1] = s; }
            WAVE_SYNC();
#pragma unroll
            for (int j = 0; j < 2; ++j) {
                float y[8]; unpack8(w[j], y); float ss = 0.f;
#pragma unroll
                for (int e = 0; e < 8; ++e) ss += y[e] * y[e];
                ss += __shfl_xor(ss, 1); ss += __shfl_xor(ss, 2); ss += __shfl_xor(ss, 4); ss += __shfl_xor(ss, 8);
                const float rs = 1.0f / sqrtf(ss * (1.0f / 128.0f) + 1e-6f); const int c8 = (lane & 15) * 8;
#pragma unroll
                for (int e = 0; e < 8; ++e) y[e] = y[e] * rs * qnw[c8 + e];
                rope8(y, c8 < 16, c8 >= 16 && c8 < 32, c8 & 15, 2, tab);
#pragma unroll
                for (int e = 0; e < 8; ++e) y[e] *= QSCALE;
                *(v4u*)(QF + (size_t)row * D + 512 * j + 8 * lane) = pack8(y);
            }
            {
                float y[8]; unpack8(w[2], y); float ss = 0.f;
#pragma unroll
                for (int e = 0; e < 8; ++e) ss += y[e] * y[e];
                ss += __shfl_xor(ss, 1); ss += __shfl_xor(ss, 2); ss += __shfl_xor(ss, 4); ss += __shfl_xor(ss, 8);
                const bool isk = lane < 32; const float rs = 1.0f / sqrtf(ss * (1.0f / 128.0f) + 1e-6f); const int c8 = (lane & 15) * 8;
                if (isk) {
#pragma unroll
                    for (int e = 0; e < 8; ++e) y[e] = y[e] * rs * knw[c8 + e];
                }
                rope8(y, isk && c8 < 16, isk && c8 >= 16 && c8 < 32, c8 & 15, 2, tab);
                const int kvh = (lane >> 4) & 1;
                int w0 = __builtin_amdgcn_cvt_pk_fp8_f32(y[0], y[1], 0, false); w0 = __builtin_amdgcn_cvt_pk_fp8_f32(y[2], y[3], w0, true);
                int w1 = __builtin_amdgcn_cvt_pk_fp8_f32(y[4], y[5], 0, false); w1 = __builtin_amdgcn_cvt_pk_fp8_f32(y[6], y[7], w1, true);
                *(v2u*)((unsigned char*)KVF + ((size_t)(b * NKV + kvh) * SEQ + t) * 256 + (isk ? 0 : 128) + c8) = (v2u){(unsigned)w0, (unsigned)w1};
            }
            {
                float y[8]; unpack8(w[3], y); const int c8 = (lane & 7) * 8;
                rope8(y, c8 == 0, c8 == 8, 16, 1, tab);
                *(v4u*)(QIF + (size_t)row * 512 + 8 * lane) = pack8(y);
            }
            WAVE_SYNC();
        }
    }
}

__device__ __forceinline__ unsigned f2key(float f) { const unsigned u = __float_as_uint(f); return (u & 0x80000000u) ? ~u : (u | 0x80000000u); }
__device__ __forceinline__ void p3_query_naive(unsigned char* ws, LAS unsigned char* lds, int row, int* SEL) {
    const int tid = threadIdx.x, lane = tid & 63, wave = tid >> 6;
    const bf16* QIF = (const bf16*)(ws + WS_QIF); const bf16* KIF = (const bf16*)(ws + WS_KIF); const float* WIF = (const float*)(ws + WS_WIF);
    LAS unsigned* keys = (LAS unsigned*)lds;
    LAS float* qis = (LAS float*)(lds + 32768);
    LAS float* wl = (LAS float*)(lds + 32768 + 2048);
    LAS unsigned* hist = (LAS unsigned*)(lds + 36864);
    LAS unsigned* ctl = (LAS unsigned*)(lds + 36864 + 1024);
    LAS unsigned* wcnt = (LAS unsigned*)(lds + 36864 + 1024 + 64);
    {
        const int b = row >> 13, t = row & (SEQ - 1), n = t + 1;
        int* sel = SEL + (size_t)row * TOPK;
        if (n <= TOPK) { if (tid < TOPK) sel[tid] = tid < n ? tid : 0; return; }
        __syncthreads();
        qis[tid] = __uint_as_float((unsigned)QIF[(size_t)row * 512 + tid] << 16);
        if (tid < 8) wl[tid] = WIF[(size_t)row * 8 + tid];
        __syncthreads();
        for (int s = tid; s < n; s += 512) {
            const int grow = (b << 13) + s;
            float kf[64];
#pragma unroll
            for (int j = 0; j < 8; ++j) { const v4u w = *(const v4u*)(KIF + kif_off(grow, 8 * j)); kf[8 * j] = bflo(w.x); kf[8 * j + 1] = bfhi(w.x); kf[8 * j + 2] = bflo(w.y); kf[8 * j + 3] = bfhi(w.y); kf[8 * j + 4] = bflo(w.z); kf[8 * j + 5] = bfhi(w.z); kf[8 * j + 6] = bflo(w.w); kf[8 * j + 7] = bfhi(w.w); }
            float sc = 0.f;
#pragma unroll
            for (int h = 0; h < 8; ++h) { float d = 0.f; asm volatile("" ::: "memory");
#pragma unroll
                for (int dd = 0; dd < 64; ++dd) d += qis[h * 64 + dd] * kf[dd];
                sc += wl[h] * fmaxf(d, 0.f); }
            keys[s] = f2key(sc + 0.0f);
        }
        __syncthreads();
        unsigned prefix = 0u, mask = 0u, need = TOPK;
        for (int pass = 0; pass < 4; ++pass) {
            const int shift = 24 - 8 * pass;
            if (tid < 256) hist[tid] = 0u;
            __syncthreads();
            for (int s = tid; s < n; s += 512) { const unsigned k = keys[s]; if ((k & mask) == prefix) __hip_atomic_fetch_add(&hist[(k >> shift) & 255u], 1u, __ATOMIC_RELAXED, __HIP_MEMORY_SCOPE_WORKGROUP); }
            __syncthreads();
            if (tid < 64) {
                const unsigned h0 = hist[4 * lane], h1 = hist[4 * lane + 1], h2 = hist[4 * lane + 2], h3 = hist[4 * lane + 3]; const unsigned tot = h0 + h1 + h2 + h3;
                unsigned incl = tot;
#pragma unroll
                for (int o = 1; o < 64; o <<= 1) { const unsigned v = __shfl_down(incl, o); if (lane + o < 64) incl += v; }
                const unsigned above = incl - tot;
                if (above < need && need <= above + tot) {
                    unsigned a = above; unsigned bin;
                    if (a + h3 >= need) bin = 3; else { a += h3; if (a + h2 >= need) bin = 2; else { a += h2; if (a + h1 >= need) bin = 1; else { a += h1; bin = 0; } } }
                    ctl[0] = 4 * lane + bin; ctl[1] = need - a;
                }
            }
            __syncthreads();
            prefix |= ctl[0] << shift; mask |= 255u << shift; need = ctl[1];
            __syncthreads();
        }
        const unsigned thr = prefix, n_gt = TOPK - need;
        unsigned base_gt = 0u, base_eq = 0u;
        for (int s0 = 0; s0 < n; s0 += 512) {
            const int s = s0 + tid; const unsigned k = s < n ? keys[s] : 0u; const bool gt = (s < n) && (k > thr); const bool eq = (s < n) && (k == thr);
            const unsigned long long bg = __ballot(gt), be = __ballot(eq); const unsigned long long lt = (1ull << lane) - 1ull;
            const unsigned rg = __popcll(bg & lt), re = __popcll(be & lt);
            if (lane == 0) { wcnt[wave] = __popcll(bg); wcnt[8 + wave] = __popcll(be); }
            __syncthreads();
            unsigned og = base_gt, oe = base_eq, tg = 0u, te = 0u;
#pragma unroll
            for (int w = 0; w < 8; ++w) { const unsigned cg = wcnt[w], ce = wcnt[8 + w]; if (w < wave) { og += cg; oe += ce; } tg += cg; te += ce; }
            if (gt) sel[og + rg] = s;
            if (eq && oe + re < need) sel[n_gt + oe + re] = s;
            base_gt += tg; base_eq += te;
            __syncthreads();
        }
    }
}

constexpr int P3_HIST = 0, P3_H2 = 65536, P3_BM = 98304, P3_QS = 114688, P3_FLAG = P3_QS + 512, P3_CAP = 512;
__device__ __forceinline__ void find_bin_2048(LAS const unsigned* hist, unsigned need, int lane, unsigned& bin_out, unsigned& need_out, unsigned& cnt_out, bool& ok) {
    unsigned w[16]; unsigned tot = 0u;
#pragma unroll
    for (int i = 0; i < 16; ++i) { w[i] = hist[16 * lane + i]; tot += (w[i] & 0xffffu) + (w[i] >> 16); }
    unsigned incl = tot;
#pragma unroll
    for (int o = 1; o < 64; o <<= 1) { const unsigned v = __shfl_down(incl, o); if (lane + o < 64) incl += v; }
    const unsigned above = incl - tot;
    const bool mine = (above < need) && (need <= above + tot);
    unsigned a = above, fb = 0u, fn = 0u, fc = 0u; bool found = false;
#pragma unroll
    for (int i = 15; i >= 0; --i) {
        const unsigned h1 = w[i] >> 16, h0 = w[i] & 0xffffu;
        if (!found) { if (a + h1 >= need) { found = true; fb = 32u * lane + 2u * i + 1u; fn = need - a; fc = h1; } else a += h1; }
        if (!found) { if (a + h0 >= need) { found = true; fb = 32u * lane + 2u * i; fn = need - a; fc = h0; } else a += h0; }
    }
    const unsigned long long bm = __ballot(mine);
    ok = (bm != 0ull);
    const int src = ok ? (__ffsll((long long)bm) - 1) : 0;
    bin_out = (unsigned)__builtin_amdgcn_readlane((int)fb, src); need_out = (unsigned)__builtin_amdgcn_readlane((int)fn, src); cnt_out = (unsigned)__builtin_amdgcn_readlane((int)fc, src);
}
__device__ __forceinline__ unsigned bin11(float sc) { const unsigned u = __float_as_uint(sc); const int m = (int)((u & 0x7fffffffu) >> 17) - 7360; const unsigned mc = (unsigned)(m < 0 ? 0 : (m > 1023 ? 1023 : m)); return (u >> 31) ? (1023u - mc) : (1024u + mc); }
__device__ __forceinline__ float relu_i(float x) { const int xi = __builtin_bit_cast(int, x); const int ri = (xi < 0) ? 0 : xi; return __builtin_bit_cast(float, ri); }
#define RELU(x) relu_i(x)
typedef _Float16 f16x8 __attribute__((ext_vector_type(8)));
typedef short s16x2 __attribute__((ext_vector_type(2)));
__device__ __forceinline__ unsigned pk_relu_f16(float a, float b) { const s16x2 h = __builtin_bit_cast(s16x2, __builtin_amdgcn_cvt_pkrtz(a, b)); return __builtin_bit_cast(unsigned, __builtin_elementwise_max(h, (s16x2){0, 0})); }
__device__ __forceinline__ unsigned bin16(unsigned h) { const int m = (int)((h & 0x7fffu) >> 4) - 192; const unsigned mc = (unsigned)(m < 0 ? 0 : (m > 1023 ? 1023 : m)); return (h & 0x8000u) ? (1023u - mc) : (1024u + mc); }
__device__ __forceinline__ unsigned key16(unsigned h) { return (h & 0x8000u) ? (~h & 0xffffu) : (h | 0x8000u); }
__device__ __forceinline__ void p3_score_pass(const bf16x8 (&af)[2][4], const f16x8 (&wa)[2][2], const bf16* kib, int t0, int nt, int wave, int n, int hi,
                                              LAS unsigned char* lds, unsigned short* SC, int rot) {
    LAS unsigned* HIST = (LAS unsigned*)(lds + P3_HIST);
    const int qh = 8 * (wave >> 2), w4 = wave & 3;
    const int cnt4 = (nt - w4 + 3) >> 2; const int r0 = rot % cnt4;
    bf16x8 bq[4][4];
#define P3_LOADB(u, j) do { int jj_ = r0 + (j); jj_ = (jj_ >= cnt4) ? jj_ - cnt4 : jj_; const int t_ = w4 + 4 * jj_; \
        const bf16* kp_ = kib + ((size_t)t_ * 8 + hi) * 256 + n * 8; _Pragma("unroll") for (int s = 0; s < 4; ++s) bq[u][s] = *(const bf16x8*)(kp_ + s * 512); } while (0)
#pragma unroll
    for (int u = 0; u < 4; ++u) P3_LOADB(u, (u < cnt4) ? u : 0);
    for (int i0 = 0; i0 < cnt4; i0 += 4) {
#pragma unroll
        for (int u = 0; u < 4; ++u) {
            if (i0 + u < cnt4) {
                int jj = r0 + i0 + u; jj = (jj >= cnt4) ? jj - cnt4 : jj; const int tile = w4 + 4 * jj;
                const int key = 32 * tile + n; const bool full = (32 * tile + 31 <= t0);
                f32x16 acc0, acc1;
#pragma unroll
                for (int r = 0; r < 16; ++r) { acc0[r] = 0.f; acc1[r] = 0.f; }
#pragma unroll
                for (int s = 0; s < 4; ++s) acc0 = __builtin_amdgcn_mfma_f32_32x32x16_bf16(af[0][s], bq[u][s], acc0, 0, 0, 0);
#pragma unroll
                for (int s = 0; s < 4; ++s) acc1 = __builtin_amdgcn_mfma_f32_32x32x16_bf16(af[1][s], bq[u][s], acc1, 0, 0, 0);
                unsigned p01, p23;
                {
                    f32x16 y0, y1;
#pragma unroll
                    for (int r = 0; r < 16; ++r) { y0[r] = 0.f; y1[r] = 0.f; }
                    const f16x8 x00 = __builtin_bit_cast(f16x8, (v4u){pk_relu_f16(acc0[0], acc0[1]), pk_relu_f16(acc0[2], acc0[3]), pk_relu_f16(acc0[4], acc0[5]), pk_relu_f16(acc0[6], acc0[7])});
                    const f16x8 x01 = __builtin_bit_cast(f16x8, (v4u){pk_relu_f16(acc0[8], acc0[9]), pk_relu_f16(acc0[10], acc0[11]), pk_relu_f16(acc0[12], acc0[13]), pk_relu_f16(acc0[14], acc0[15])});
                    const f16x8 x10 = __builtin_bit_cast(f16x8, (v4u){pk_relu_f16(acc1[0], acc1[1]), pk_relu_f16(acc1[2], acc1[3]), pk_relu_f16(acc1[4], acc1[5]), pk_relu_f16(acc1[6], acc1[7])});
                    const f16x8 x11 = __builtin_bit_cast(f16x8, (v4u){pk_relu_f16(acc1[8], acc1[9]), pk_relu_f16(acc1[10], acc1[11]), pk_relu_f16(acc1[12], acc1[13]), pk_relu_f16(acc1[14], acc1[15])});
                    y0 = __builtin_amdgcn_mfma_f32_32x32x16_f16(wa[0][0], x00, y0, 0, 0, 0); y1 = __builtin_amdgcn_mfma_f32_32x32x16_f16(wa[1][0], x10, y1, 0, 0, 0);
                    y0 = __builtin_amdgcn_mfma_f32_32x32x16_f16(wa[0][1], x01, y0, 0, 0, 0); y1 = __builtin_amdgcn_mfma_f32_32x32x16_f16(wa[1][1], x11, y1, 0, 0, 0);
                    p01 = __builtin_bit_cast(unsigned, __builtin_amdgcn_cvt_pkrtz(y0[0], y0[1])); p23 = __builtin_bit_cast(unsigned, __builtin_amdgcn_cvt_pkrtz(y1[0], y1[1]));
                }
                unsigned h4[4]; h4[0] = p01 & 0xffffu; h4[1] = p01 >> 16; h4[2] = p23 & 0xffffu; h4[3] = p23 >> 16;
                unsigned short* scp = SC + (size_t)(qh + hi) * SEQ + key;
                scp[0] = (unsigned short)h4[0]; scp[2 * SEQ] = (unsigned short)h4[1]; scp[4 * SEQ] = (unsigned short)h4[2]; scp[6 * SEQ] = (unsigned short)h4[3];
                unsigned bin4[4];
#pragma unroll
                for (int e = 0; e < 4; ++e) bin4[e] = bin16(h4[e]);
                if (full) {
#pragma unroll
                    for (int e = 0; e < 4; ++e) { const int q = qh + 4 * (e >> 1) + hi + 2 * (e & 1); __hip_atomic_fetch_add(&HIST[q * 1024 + (bin4[e] >> 1)], 1u << (16 * (bin4[e] & 1u)), __ATOMIC_RELAXED, __HIP_MEMORY_SCOPE_WORKGROUP); }
                } else {
#pragma unroll
                    for (int e = 0; e < 4; ++e) { const int q = qh + 4 * (e >> 1) + hi + 2 * (e & 1); if (key <= t0 + q) __hip_atomic_fetch_add(&HIST[q * 1024 + (bin4[e] >> 1)], 1u << (16 * (bin4[e] & 1u)), __ATOMIC_RELAXED, __HIP_MEMORY_SCOPE_WORKGROUP); }
                }
            }
            { const int jn = (i0 + u + 4 < cnt4) ? (i0 + u + 4) : (cnt4 - 1); P3_LOADB(u, jn); }
        }
    }
#undef P3_LOADB
}
__device__ __forceinline__ void p3_append(unsigned cm, const v4u& hw, int k0, LAS unsigned* cnt, LAS unsigned* cand) {
    while (cm) { const int j = __ffs((int)cm) - 1; cm &= cm - 1u; const unsigned w = (j < 2) ? hw.x : (j < 4) ? hw.y : (j < 6) ? hw.z : hw.w; const unsigned h = (j & 1) ? (w >> 16) : (w & 0xffffu);
        const unsigned pos = __hip_atomic_fetch_add(cnt, 1u, __ATOMIC_RELAXED, __HIP_MEMORY_SCOPE_WORKGROUP);
        if (pos < (unsigned)P3_CAP) { cand[2 * pos] = key16(h); cand[2 * pos + 1] = (unsigned)(k0 + j); } }
}
__device__ __forceinline__ void p3_index(Frame& F) {
    unsigned char* ws = F.ws; const int tid = F.tid, lane = F.lane, wave = F.wave, n = lane & 31, hi = lane >> 5;
    const bf16* QIF = (const bf16*)(ws + WS_QIF); const bf16* KIF = (const bf16*)(ws + WS_KIF); const float* WIF = (const float*)(ws + WS_WIF); int* SEL = (int*)(ws + WS_SEL);
    unsigned short* SC = (unsigned short*)(ws + WS_PROJ) + (size_t)F.bid * 16 * SEQ;
    LAS unsigned char* lds = F.lds;
    LAS unsigned* HIST = (LAS unsigned*)(lds + P3_HIST); LAS unsigned* H2 = (LAS unsigned*)(lds + P3_H2 + wave * 4096); LAS unsigned* BM = (LAS unsigned*)(lds + P3_BM); LAS unsigned* QS = (LAS unsigned*)(lds + P3_QS);
    LAS unsigned* FBL = (LAS unsigned*)(lds + P3_QS + 1024);
    if (tid == 0) FBL[0] = 0u;
    __syncthreads();
    for (int ps = F.bid; ps < 512; ps += F.G) {
        const int b = ps >> 8, wq = ps & 255;
#pragma unroll 1
        for (int half = 0; half < 2; ++half) {
            const int idx = half ? (511 - wq) : wq; const int t0 = 16 * idx, row0 = (b << 13) + t0;
            if (idx < 16) {
                for (int e = tid; e < 16 * TOPK; e += 512) { const int q = e >> 8, i = e & 255; SEL[(size_t)(row0 + q) * TOPK + i] = (i <= t0 + q) ? i : 0; }
                continue;
            }
            for (int e = tid; e < 16384; e += 512) HIST[e] = 0u;
            if (tid < 128) QS[tid] = 0u;
            bf16x8 af[2][4]; f16x8 wa[2][2]; const int qh = 8 * (wave >> 2);
            { const int head = (n & 3) + 4 * ((n >> 3) & 1), q4 = ((n >> 2) & 1) + 2 * (n >> 4);
#pragma unroll
              for (int mt = 0; mt < 2; ++mt) { const bf16* ap = QIF + (size_t)(row0 + qh + 4 * mt + q4) * 512 + head * IDX + 32 * hi;
#pragma unroll
                  for (int s = 0; s < 4; ++s) af[mt][s] = *(const bf16x8*)(ap + 8 * s);
#pragma unroll
                  for (int sp = 0; sp < 2; ++sp) {
                      const bool on = (sp == 0) ? ((n == 0 && hi == 0) || (n == 4 && hi == 1)) : ((n == 1 && hi == 0) || (n == 5 && hi == 1));
                      const float* wp = WIF + (size_t)(row0 + qh + 4 * mt + hi + 2 * sp) * 8; const f32x4 w0 = *(const f32x4*)wp, w1 = *(const f32x4*)(wp + 4);
                      f16x8 t; t[0] = (_Float16)w0[0]; t[1] = (_Float16)w0[1]; t[2] = (_Float16)w0[2]; t[3] = (_Float16)w0[3]; t[4] = (_Float16)w1[0]; t[5] = (_Float16)w1[1]; t[6] = (_Float16)w1[2]; t[7] = (_Float16)w1[3];
                      if (!on) t = (f16x8){0, 0, 0, 0, 0, 0, 0, 0};
                      wa[mt][sp] = t; } } }
            const int nt = (t0 + 16 + 31) >> 5; const bf16* kib = KIF + (size_t)(b << 13) * IDX;
            __syncthreads();
            p3_score_pass(af, wa, kib, t0, nt, wave, n, hi, lds, SC, F.bid * 5);
            __syncthreads();
            v4u hv[16];
#define P3_LOADSC(qx) do { unsigned long long qo_ = (unsigned long long)(qx) * (SEQ * 2); asm volatile("" : "+s"(qo_)); const char* s_ = (const char*)SC + qo_; const int n_ = ((t0 + (qx)) >> 9) + 1; const unsigned lo_ = 16u * (unsigned)lane; \
                _Pragma("unroll") for (int ch = 0; ch < 16; ++ch) { hv[ch] = (v4u){0u, 0u, 0u, 0u}; if (ch < n_) hv[ch] = *(const v4u*)(s_ + 1024 * ch + lo_); } } while (0)
            P3_LOADSC(2 * wave);
#pragma unroll 1
            for (int qq = 0; qq < 2; ++qq) {
                const int q = 2 * wave + qq; unsigned T, needA, c; bool ok;
                find_bin_2048(HIST + q * 1024, (unsigned)TOPK, lane, T, needA, c, ok);
                const bool defer = !ok || c > (unsigned)P3_CAP;
                if (defer && lane == 0) { const unsigned k = __hip_atomic_fetch_add(&FBL[0], 1u, __ATOMIC_RELAXED, __HIP_MEMORY_SCOPE_WORKGROUP); if (k < 63u) FBL[1 + k] = (unsigned)(row0 + q); }
                const int tq = t0 + q, nch = (tq >> 9) + 1;
                LAS unsigned char* bmb = (LAS unsigned char*)(BM + q * 256); LAS unsigned* cand = H2; LAS unsigned* bmq = BM + q * 256;
                const bool fastp = T >= 1024u; const unsigned mcT = T - 1024u;
                const unsigned klo = (mcT == 0u) ? 0u : ((mcT + 192u) << 4), khi = (mcT == 1023u) ? 0x7fffu : (((mcT + 192u) << 4) + 15u);
                const int hiT = (int)((khi << 16) | 0xffffu), loT = (int)(klo << 16);
                if (!defer) {
                    if (fastp) {
#pragma unroll
                        for (int ch = 0; ch < 16; ++ch) {
                            if (ch < nch) {
                                const v4u hw = hv[ch]; int k0 = 512 * ch + 8 * lane; asm volatile("" : "+v"(k0));
                                int nv = tq - k0 + 1; nv = nv < 0 ? 0 : (nv > 8 ? 8 : nv); const unsigned vm = (1u << nv) - 1u;
                                unsigned am = 0u, nb = 0u;
#pragma unroll
                                for (int d = 3; d >= 0; --d) { const unsigned w = (d == 0) ? hw.x : (d == 1) ? hw.y : (d == 2) ? hw.z : hw.w; const int wh = (int)w, wl = (int)(w << 16);
                                    am = am + am + ((wh > hiT) ? 1u : 0u); nb = nb + nb + ((wh >= loT) ? 1u : 0u);
                                    am = am + am + ((wl > hiT) ? 1u : 0u); nb = nb + nb + ((wl >= loT) ? 1u : 0u); }
                                am &= vm; const unsigned cm = nb & vm & ~am;
                                bmb[64 * ch + lane] = (unsigned char)am;
                                if (__ballot(cm != 0u) != 0ull) p3_append(cm, hw, k0, &QS[q * 8 + 3], cand);
                            } else { ((LAS unsigned*)bmb)[16 * ch + (lane & 15)] = 0u; }
                        }
                    } else {
#pragma unroll 1
                        for (int ch = 0; ch < 16; ++ch) {
                            if (ch < nch) {
                                int k0 = 512 * ch + 8 * lane; asm volatile("" : "+v"(k0)); const v4u hw = *(const v4u*)(SC + (size_t)q * SEQ + k0);
                                int nv = tq - k0 + 1; nv = nv < 0 ? 0 : (nv > 8 ? 8 : nv); const unsigned vm = (1u << nv) - 1u; unsigned am = 0u, cm = 0u;
#pragma unroll
                                for (int j = 0; j < 8; ++j) { const unsigned w = (j < 2) ? hw.x : (j < 4) ? hw.y : (j < 6) ? hw.z : hw.w; const unsigned h = (j & 1) ? (w >> 16) : (w & 0xffffu);
                                    const unsigned bn = bin16(h); am |= (bn > T) ? (1u << j) : 0u; cm |= (bn == T) ? (1u << j) : 0u; }
                                am &= vm; cm &= vm;
                                bmb[64 * ch + lane] = (unsigned char)am;
                                if (__ballot(cm != 0u) != 0ull) p3_append(cm, hw, k0, &QS[q * 8 + 3], cand);
                            } else { ((LAS unsigned*)bmb)[16 * ch + (lane & 15)] = 0u; }
                        }
                    }
                }
                if (qq == 0) P3_LOADSC(2 * wave + 1);
                if (defer) continue;
                WAVE_SYNC();
                if (c <= 64u) {
                    const bool in = (unsigned)lane < c; const unsigned k32 = in ? cand[2 * lane] : 0u, ki = in ? (cand[2 * lane + 1] & 8191u) : 0u; unsigned rank = 0u;
                    for (unsigned j = 0; j < c; ++j) { const unsigned kj = (unsigned)__builtin_amdgcn_readlane((int)k32, (int)j), ij = (unsigned)__builtin_amdgcn_readlane((int)ki, (int)j); rank += (kj > k32 || (kj == k32 && ij < ki)) ? 1u : 0u; }
                    if (in && rank < needA) __hip_atomic_fetch_or(&bmq[ki >> 5], 1u << (ki & 31), __ATOMIC_RELAXED, __HIP_MEMORY_SCOPE_WORKGROUP);
                } else {
                for (unsigned i0 = 0; i0 < c; i0 += 64) { const unsigned i = i0 + lane; const bool in = i < c; const unsigned k32 = in ? cand[2 * i] : 0u, ki = in ? (cand[2 * i + 1] & 8191u) : 0u; unsigned rank = 0u;
                    for (unsigned j = 0; j < c; ++j) { const unsigned kj = cand[2 * j], ij = cand[2 * j + 1]; rank += (kj > k32 || (kj == k32 && ij < ki)) ? 1u : 0u; }
                    if (in && rank < needA) __hip_atomic_fetch_or(&bmq[ki >> 5], 1u << (ki & 31), __ATOMIC_RELAXED, __HIP_MEMORY_SCOPE_WORKGROUP); }
                }
                WAVE_SYNC();
                unsigned w0 = bmq[4 * lane], w1 = bmq[4 * lane + 1], w2 = bmq[4 * lane + 2], w3 = bmq[4 * lane + 3];
                const unsigned mycnt = __popc(w0) + __popc(w1) + __popc(w2) + __popc(w3);
                unsigned incl = mycnt;
#pragma unroll
                for (int o = 1; o < 64; o <<= 1) { const unsigned v = __shfl_up(incl, o); if (lane >= o) incl += v; }
                unsigned pos = incl - mycnt; int* sel = SEL + (size_t)(row0 + q) * TOPK;
#pragma unroll
                for (int wi = 0; wi < 4; ++wi) { unsigned w = (wi == 0) ? w0 : (wi == 1) ? w1 : (wi == 2) ? w2 : w3;
                    while (w) { const int bit = __ffs((int)w) - 1; if (pos < (unsigned)TOPK) sel[pos] = 128 * lane + 32 * wi + bit; ++pos; w &= w - 1u; } }
                WAVE_SYNC();
            }
#undef P3_LOADSC
            __syncthreads();
        }
    }
    __syncthreads();
    const unsigned nfb = FBL[0];
    for (unsigned k = 0; k < nfb && k < 63u; ++k) { const int r0 = (int)FBL[1 + k]; __syncthreads(); p3_query_naive(ws, lds, r0, SEL); }
}

typedef short v4i16_t __attribute__((ext_vector_type(4)));
typedef int v4i __attribute__((ext_vector_type(4)));
__device__ __forceinline__ v4i16_t tr16(LAS unsigned char* p) { return __builtin_amdgcn_ds_read_tr16_b64_v4i16((LAS v4i16_t*)p); }
typedef __bf16 bf16x2_t __attribute__((ext_vector_type(2)));
__device__ __forceinline__ unsigned dq2(unsigned w, bool hi) { return __builtin_bit_cast(unsigned, hi ? __builtin_amdgcn_cvt_scalef32_pk_bf16_fp8(w, 1.0f, true) : __builtin_amdgcn_cvt_scalef32_pk_bf16_fp8(w, 1.0f, false)); }
__device__ __forceinline__ bf16x8 dq8(unsigned w0, unsigned w1) { return __builtin_bit_cast(bf16x8, (v4u){dq2(w0, false), dq2(w0, true), dq2(w1, false), dq2(w1, true)}); }
__device__ __forceinline__ void p4_dsa(Frame& F) {
    unsigned char* ws = F.ws; const int lane = F.lane, nh = lane & 15, kg = lane >> 4;
    const bf16* QF = (const bf16*)(ws + WS_QF); const unsigned char* KV8 = (const unsigned char*)(ws + WS_KVF); const int* SEL = (const int*)(ws + WS_SEL); bf16* AO = (bf16*)(ws + WS_AO);
    LAS unsigned char* wl = F.lds + F.wave * 10240; LAS int* selw = (LAS int*)wl; LAS unsigned char* vb = wl + 1024;
    const int gw = F.wave * F.G + F.bid, NGW = F.G * NWAVES;
    LAS unsigned char* trp = vb + (4 * kg + ((lane >> 2) & 3)) * 288 + 8 * (lane & 3);
#pragma unroll 1
    for (int combo = 0; combo < BATCH * NKV; ++combo) {
        const int b = combo >> 1, kvh = combo & 1;
        const unsigned char* kvb = KV8 + (size_t)(b * NKV + kvh) * SEQ * 256;
#pragma unroll 1
        for (int t = gw; t < SEQ; t += NGW) {
            const int row = (b << 13) + t; const int cnt = (t + 1 < TOPK) ? (t + 1) : TOPK;
            *(LAS v4i*)(selw + 4 * lane) = *(const v4i*)(SEL + (size_t)row * TOPK + 4 * lane);
            WAVE_SYNC();
            const bf16* qp = QF + (size_t)row * D + (kvh * 4 + (nh & 3)) * HD + 32 * kg;
            bf16x8 qf[4];
#pragma unroll
            for (int s = 0; s < 4; ++s) { qf[s] = *(const bf16x8*)(qp + 8 * s); if (nh >= 4) qf[s] = (bf16x8){0, 0, 0, 0, 0, 0, 0, 0}; }
            f32x4 S[16];
            v4u kq[2][4][2];
#define P4_LOADK(buf, batch) do { _Pragma("unroll") for (int tt = 0; tt < 4; ++tt) { const unsigned char* kp_ = kvb + (size_t)(selw[16 * (4 * (batch) + tt) + nh] & (SEQ - 1)) * 256 + 32 * kg; \
                kq[buf][tt][0] = *(const v4u*)(kp_); kq[buf][tt][1] = *(const v4u*)(kp_ + 16); } } while (0)
            P4_LOADK(0, 0);
#pragma unroll
            for (int bt = 0; bt < 4; ++bt) {
                if (bt < 3) P4_LOADK((bt + 1) & 1, bt + 1);
                asm volatile("" ::: "memory");
#pragma unroll
                for (int tt = 0; tt < 4; ++tt) {
                    const v4u k0 = kq[bt & 1][tt][0], k1 = kq[bt & 1][tt][1];
                    f32x4 a = (f32x4){0.f, 0.f, 0.f, 0.f};
                    a = __builtin_amdgcn_mfma_f32_16x16x32_bf16(dq8(k0.x, k0.y), qf[0], a, 0, 0, 0); a = __builtin_amdgcn_mfma_f32_16x16x32_bf16(dq8(k0.z, k0.w), qf[1], a, 0, 0, 0);
                    a = __builtin_amdgcn_mfma_f32_16x16x32_bf16(dq8(k1.x, k1.y), qf[2], a, 0, 0, 0); a = __builtin_amdgcn_mfma_f32_16x16x32_bf16(dq8(k1.z, k1.w), qf[3], a, 0, 0, 0);
                    S[4 * bt + tt] = a;
                }
            }
#undef P4_LOADK
            float mx = -INFINITY;
#pragma unroll
            for (int T = 0; T < 16; ++T)
#pragma unroll
                for (int r = 0; r < 4; ++r) { const float v = (16 * T + 4 * kg + r < cnt) ? S[T][r] : -INFINITY; S[T][r] = v; mx = fmaxf(mx, v); }
            mx = fmaxf(mx, __shfl_xor(mx, 16)); mx = fmaxf(mx, __shfl_xor(mx, 32));
            float sum = 0.f;
#pragma unroll
            for (int T = 0; T < 16; ++T)
#pragma unroll
                for (int r = 0; r < 4; ++r) { const float e = __builtin_amdgcn_exp2f(S[T][r] - mx); S[T][r] = e; sum += e; }
            sum += __shfl_xor(sum, 16); sum += __shfl_xor(sum, 32);
            bf16x8 pa[8];
#pragma unroll
            for (int c = 0; c < 8; ++c) { v4u pw; pw.x = pg8::cvt_pk_bf16(S[2 * c][0], S[2 * c][1]); pw.y = pg8::cvt_pk_bf16(S[2 * c][2], S[2 * c][3]); pw.z = pg8::cvt_pk_bf16(S[2 * c + 1][0], S[2 * c + 1][1]); pw.w = pg8::cvt_pk_bf16(S[2 * c + 1][2], S[2 * c + 1][3]); pa[c] = __builtin_bit_cast(bf16x8, pw); }
            f32x4 O[8];
#pragma unroll
            for (int d = 0; d < 8; ++d) O[d] = (f32x4){0.f, 0.f, 0.f, 0.f};
            v4u g[3][4];
#define P4_LOADV(buf, c_) do { _Pragma("unroll") for (int i = 0; i < 4; ++i) { const int key_ = selw[32 * (c_) + (lane >> 3) + 8 * i] & (SEQ - 1); g[buf][i] = *(const v4u*)(kvb + (size_t)key_ * 256 + 128 + 16 * (lane & 7)); } } while (0)
            P4_LOADV(0, 0); P4_LOADV(1, 1); P4_LOADV(2, 2);
#pragma unroll
            for (int c = 0; c < 8; ++c) {
#pragma unroll
                for (int i = 0; i < 4; ++i) { const v4u gg = g[c % 3][i]; LAS unsigned char* dst = vb + ((lane >> 3) + 8 * i) * 288 + 32 * (lane & 7);
                    *(LAS v4u*)dst = __builtin_bit_cast(v4u, dq8(gg.x, gg.y)); *(LAS v4u*)(dst + 16) = __builtin_bit_cast(v4u, dq8(gg.z, gg.w)); }
                asm volatile("" ::: "memory");
                if (c < 5) P4_LOADV(c % 3, c + 3);
#pragma unroll
                for (int d = 0; d < 8; ++d) {
                    const v4i16_t lo = tr16(trp + 32 * d), hi4 = tr16(trp + 16 * 288 + 32 * d);
                    const bf16x8 vfr = (bf16x8){lo[0], lo[1], lo[2], lo[3], hi4[0], hi4[1], hi4[2], hi4[3]};
                    O[d] = __builtin_amdgcn_mfma_f32_16x16x32_bf16(pa[c], vfr, O[d], 0, 0, 0);
                }
            }
#undef P4_LOADV
            const float i0 = 1.0f / __builtin_bit_cast(float, __builtin_amdgcn_readlane(__builtin_bit_cast(int, sum), 0)), i1 = 1.0f / __builtin_bit_cast(float, __builtin_amdgcn_readlane(__builtin_bit_cast(int, sum), 1));
            const float i2 = 1.0f / __builtin_bit_cast(float, __builtin_amdgcn_readlane(__builtin_bit_cast(int, sum), 2)), i3 = 1.0f / __builtin_bit_cast(float, __builtin_amdgcn_readlane(__builtin_bit_cast(int, sum), 3));
            LAS bf16* ost = (LAS bf16*)vb;
            if (kg == 0) {
#pragma unroll
                for (int d = 0; d < 8; ++d) { ost[0 * 128 + 16 * d + nh] = (bf16)f2bf(O[d][0] * i0); ost[1 * 128 + 16 * d + nh] = (bf16)f2bf(O[d][1] * i1); ost[2 * 128 + 16 * d + nh] = (bf16)f2bf(O[d][2] * i2); ost[3 * 128 + 16 * d + nh] = (bf16)f2bf(O[d][3] * i3); }
            }
            WAVE_SYNC();
            const v4u ov = *(LAS v4u*)(vb + 16 * lane);
            *(v4u*)(AO + (size_t)row * D + (kvh * 4 + kg) * HD + 8 * nh) = ov;
            WAVE_SYNC();
        }
    }
}

__device__ __forceinline__ void p9_sb(Frame& F) {
    unsigned char* ws = F.ws; const int lane = F.lane, n = lane & 31, hi = lane >> 5;
    const bf16* KQ = (const bf16*)(ws + WS_KQ); const bf16* VT = (const bf16*)(ws + WS_VT); bf16* AO = (bf16*)(ws + WS_AO);
    const int gw = F.wave * F.G + F.bid, NGW = F.G * NWAVES;
    const int koff = 16 * (n >> 4) + 8 * ((n >> 2) & 1) + 4 * ((n >> 3) & 1) + (n & 3);
    constexpr float LOG2E = 1.4426950408889634f, LN2 = 0.6931471805599453f;
    for (int u = gw; u < (M / 32) * NH; u += NGW) {
        const int h = u & 7, blk = u >> 3, b = blk >> 8, qb = blk & 255, q0 = 32 * qb, t = q0 + n;
        const bf16* qp = KQ + (size_t)(b * SEQ + q0 + n) * 2048 + 1024 + h * HD + 64 * hi;
        bf16x8 qf[8];
#pragma unroll
        for (int s = 0; s < 8; ++s) qf[s] = *(const bf16x8*)(qp + 8 * s);
        f32x16 o[4];
#pragma unroll
        for (int mt = 0; mt < 4; ++mt)
#pragma unroll
            for (int r = 0; r < 16; ++r) o[mt][r] = 0.f;
        float C = 0.f;
        bf16x8 kf[8];
        { const bf16* kp = KQ + (size_t)(b * SEQ + 32 * qb + koff) * 2048 + h * HD + 64 * hi;
#pragma unroll
          for (int s = 0; s < 8; ++s) kf[s] = *(const bf16x8*)(kp + 8 * s); }
        for (int kb = qb; kb >= 0; --kb) {
            const int k0 = 32 * kb;
            bf16x8 vf[4][2];
#pragma unroll
            for (int mt = 0; mt < 4; ++mt)
#pragma unroll
                for (int sp = 0; sp < 2; ++sp) vf[mt][sp] = *(const bf16x8*)(VT + (size_t)(h * HD + 32 * mt + n) * M + b * SEQ + k0 + 16 * sp + 8 * hi);
            f32x16 z;
#pragma unroll
            for (int r = 0; r < 16; ++r) z[r] = 0.f;
#pragma unroll
            for (int s = 0; s < 8; ++s) z = __builtin_amdgcn_mfma_f32_32x32x16_bf16(kf[s], qf[s], z, 0, 0, 0);
            { const int kn = (kb > 0) ? kb - 1 : 0; const bf16* kp = KQ + (size_t)(b * SEQ + 32 * kn + koff) * 2048 + h * HD + 64 * hi;
#pragma unroll
              for (int s = 0; s < 8; ++s) kf[s] = *(const bf16x8*)(kp + 8 * s); }
            float lk[16], lb[16];
#pragma unroll
            for (int r = 0; r < 16; ++r) {
                const int key = k0 + ((r < 8) ? (8 * hi + r) : (16 + 8 * hi + (r - 8)));
                const float zz = z[r]; const float L = __builtin_amdgcn_logf(1.0f + __builtin_amdgcn_exp2f(-fabsf(zz) * LOG2E)) * LN2;
                const bool valid = key < t;
                lk[r] = valid ? (-fmaxf(zz, 0.f) - L) : 0.f;
                lb[r] = valid ? (fminf(zz, 0.f) - L) : -INFINITY;
            }
            float suf[16];
            suf[7] = 0.f; suf[15] = 0.f;
#pragma unroll
            for (int i = 6; i >= 0; --i) { suf[i] = suf[i + 1] + lk[i + 1]; suf[8 + i] = suf[9 + i] + lk[9 + i]; }
            const float T0 = suf[0] + lk[0], T1 = suf[8] + lk[8];
            const float P0 = __shfl_xor(T0, 32), P1 = __shfl_xor(T1, 32);
            const float base1 = C + (hi ? 0.f : P1), base0 = C + (hi ? (T1 + P1) : (P0 + T1 + P1));
            unsigned pw[8];
#pragma unroll
            for (int r = 0; r < 16; r += 2) {
                const float a0 = __builtin_amdgcn_exp2f((lb[r] + ((r < 8) ? base0 : base1) + suf[r]) * LOG2E), a1 = __builtin_amdgcn_exp2f((lb[r + 1] + ((r < 8) ? base0 : base1) + suf[r + 1]) * LOG2E);
                pw[r >> 1] = pg8::cvt_pk_bf16(a0, a1);
            }
            C += (T0 + T1) + (P0 + P1);
            const bf16x8 pa0 = __builtin_bit_cast(bf16x8, (v4u){pw[0], pw[1], pw[2], pw[3]}), pa1 = __builtin_bit_cast(bf16x8, (v4u){pw[4], pw[5], pw[6], pw[7]});
#pragma unroll
            for (int mt = 0; mt < 4; ++mt) { o[mt] = __builtin_amdgcn_mfma_f32_32x32x16_bf16(vf[mt][0], pa0, o[mt], 0, 0, 0); o[mt] = __builtin_amdgcn_mfma_f32_32x32x16_bf16(vf[mt][1], pa1, o[mt], 0, 0, 0); }
            if (__all(C < -44.0f)) break;
        }
        bf16* op = AO + (size_t)(b * SEQ + q0 + n) * D + h * HD + 4 * hi;
#pragma unroll
        for (int mt = 0; mt < 4; ++mt)
#pragma unroll
            for (int g = 0; g < 4; ++g) { v2u w; w.x = pg8::cvt_pk_bf16(o[mt][4 * g], o[mt][4 * g + 1]); w.y = pg8::cvt_pk_bf16(o[mt][4 * g + 2], o[mt][4 * g + 3]); *(v2u*)(op + 32 * mt + 8 * g) = w; }
    }
}

__device__ __forceinline__ void p11_router(Frame& F) {
    unsigned char* ws = F.ws; const int tid = F.tid, lane = F.lane, wave = F.wave;
    const float* H = (const float*)(ws + WS_H); const float* gn = F.in[IN_FFNNORM] + D; const float* Wr = F.in[IN_ROUTER];
    int* TOPE = (int*)(ws + WS_RT); int* POS = (int*)(ws + WS_RT + 128 * 1024); float* GATE = (float*)(ws + WS_RT + 256 * 1024); float* RSTD3 = (float*)(ws + WS_RT + 384 * 1024);
    LAS unsigned* lcnt = (LAS unsigned*)F.lds;
    LAS unsigned* gb = (LAS unsigned*)(F.lds + 64);
    LAS int* ltok = (LAS int*)(F.lds + 128);
    LAS float* lgt = (LAS float*)(F.lds + 128 + 1024);
    for (int chunk = F.bid; chunk < M / 64; chunk += F.G) {
        if (tid < 8) lcnt[tid] = 0u;
        __syncthreads();
        for (int r = 0; r < 8; ++r) {
            const int row = chunk * 64 + wave * 8 + r;
            const GAS f32x4* xr = (const GAS f32x4*)(H + (size_t)row * D) + lane; f32x4 v[4]; float ss = 0.f;
#pragma unroll
            for (int j = 0; j < 4; ++j) { v[j] = xr[64 * j]; ss += (v[j].x * v[j].x + v[j].y * v[j].y) + (v[j].z * v[j].z + v[j].w * v[j].w); }
            ss = wave_sum(ss); const float rs = 1.0f / sqrtf(ss * (1.0f / 1024.0f) + 1e-6f);
            float lg[8] = {0.f, 0.f, 0.f, 0.f, 0.f, 0.f, 0.f, 0.f};
#pragma unroll
            for (int j = 0; j < 4; ++j)
#pragma unroll
                for (int i = 0; i < 4; ++i) { const int k = 256 * j + 4 * lane + i; const float xv = v[j][i] * gn[k]; const f32x4 w0 = *(const f32x4*)(Wr + (size_t)k * 8), w1 = *(const f32x4*)(Wr + (size_t)k * 8 + 4);
                    lg[0] += xv * w0[0]; lg[1] += xv * w0[1]; lg[2] += xv * w0[2]; lg[3] += xv * w0[3]; lg[4] += xv * w1[0]; lg[5] += xv * w1[1]; lg[6] += xv * w1[2]; lg[7] += xv * w1[3]; }
#pragma unroll
            for (int e = 0; e < 8; ++e) lg[e] = wave_sum(lg[e]) * rs;
            int i1 = 0; float l1 = lg[0];
#pragma unroll
            for (int e = 1; e < 8; ++e) if (lg[e] > l1) { l1 = lg[e]; i1 = e; }
            int i2 = -1; float l2 = -INFINITY;
#pragma unroll
            for (int e = 0; e < 8; ++e) if (e != i1 && lg[e] > l2) { l2 = lg[e]; i2 = e; }
            const float g1 = 1.0f / (1.0f + __expf(l2 - l1)), g2 = 1.0f - g1;
            if (lane == 0) {
                const unsigned p1 = __hip_atomic_fetch_add(&lcnt[i1], 1u, __ATOMIC_RELAXED, __HIP_MEMORY_SCOPE_WORKGROUP), p2 = __hip_atomic_fetch_add(&lcnt[i2], 1u, __ATOMIC_RELAXED, __HIP_MEMORY_SCOPE_WORKGROUP);
                const int ti = wave * 8 + r; ltok[ti * 4 + 0] = i1; ltok[ti * 4 + 1] = i2; ltok[ti * 4 + 2] = (int)p1; ltok[ti * 4 + 3] = (int)p2;
                lgt[ti * 4 + 0] = g1; lgt[ti * 4 + 1] = g2; lgt[ti * 4 + 2] = rs;
            }
        }
        __syncthreads();
        if (tid < 8) gb[tid] = __hip_atomic_fetch_add(F.ctl + CW_CNT + tid, lcnt[tid], RLX_AGENT);
        __syncthreads();
        if (tid < 64) { const int row = chunk * 64 + tid; const int e1 = ltok[tid * 4], e2 = ltok[tid * 4 + 1];
            TOPE[row * 2] = e1; TOPE[row * 2 + 1] = e2; POS[row * 2] = (int)gb[e1] + ltok[tid * 4 + 2]; POS[row * 2 + 1] = (int)gb[e2] + ltok[tid * 4 + 3];
            GATE[row * 2] = lgt[tid * 4]; GATE[row * 2 + 1] = lgt[tid * 4 + 1]; RSTD3[row] = lgt[tid * 4 + 2]; }
        __syncthreads();
    }
}
__device__ __forceinline__ void moe_bases(Frame& F, int (&tb)[9]) {
    int acc = 0;
#pragma unroll
    for (int e = 0; e < 8; ++e) { tb[e] = acc; const unsigned c = __hip_atomic_load(F.ctl + CW_CNT + e, RLX_AGENT); acc += (int)((c + 255u) >> 8); }
    tb[8] = acc;
}
__device__ __forceinline__ void p12_permute(Frame& F) {
    unsigned char* ws = F.ws; const int lane = F.lane;
    const int* TOPE = (const int*)(ws + WS_RT); const int* POS = (const int*)(ws + WS_RT + 128 * 1024); const float* RSTD3 = (const float*)(ws + WS_RT + 384 * 1024);
    int* SLOT = (int*)(ws + WS_RT + 512 * 1024);
    const float* H = (const float*)(ws + WS_H); bf16* XP = (bf16*)(ws + WS_XPERM);
    int tb[9]; moe_bases(F, tb);
    const int gw = F.wave * F.G + F.bid, NGW = F.G * NWAVES;
    for (int i = gw; i < 2 * M; i += NGW) {
        const int row = i >> 1; const int e = TOPE[i]; int base = 0;
#pragma unroll
        for (int k = 0; k < 8; ++k) base = (e == k) ? tb[k] : base;
        const int slot = base * 256 + POS[i];
        const float rs = RSTD3[row];
        const GAS f32x4* src = (const GAS f32x4*)(H + (size_t)row * D) + lane; GAS unsigned* dst = (GAS unsigned*)((unsigned char*)XP + (size_t)slot * D) + lane;
        const float r16 = rs * pg8::F8_SX;
#pragma unroll
        for (int j = 0; j < 4; ++j) { const f32x4 v = src[64 * j]; dst[64 * j] = pg8::pk4_fp8(v.x * r16, v.y * r16, v.z * r16, v.w * r16); }
        if (lane == 0) SLOT[i] = slot;
    }
}
__device__ __forceinline__ void p15_combine(Frame& F) {
    unsigned char* ws = F.ws; const int lane = F.lane;
    const float* H = (const float*)(ws + WS_H); const bf16* Y = (const bf16*)(ws + WS_Y); const int* SLOT = (const int*)(ws + WS_RT + 512 * 1024); const float* GATE = (const float*)(ws + WS_RT + 256 * 1024);
    const int gw = F.wave * F.G + F.bid, NGW = F.G * NWAVES;
    for (int row = gw; row < M; row += NGW) {
        const int s1 = SLOT[row * 2], s2 = SLOT[row * 2 + 1]; const float g1 = GATE[row * 2], g2 = GATE[row * 2 + 1];
        const GAS f32x4* hr = (const GAS f32x4*)(H + (size_t)row * D) + lane; GAS f32x4* orow = (GAS f32x4*)(F.out + (size_t)row * D) + lane;
        const GAS v2u* y1 = (const GAS v2u*)(Y + (size_t)s1 * D) + lane; const GAS v2u* y2 = (const GAS v2u*)(Y + (size_t)s2 * D) + lane;
#pragma unroll
        for (int j = 0; j < 4; ++j) { const f32x4 h = __builtin_nontemporal_load(hr + 64 * j); const v2u a = __builtin_nontemporal_load(y1 + 64 * j), c = __builtin_nontemporal_load(y2 + 64 * j); f32x4 o;
            o.x = h.x + (g1 * bflo(a.x) + g2 * bflo(c.x)); o.y = h.y + (g1 * bfhi(a.x) + g2 * bfhi(c.x)); o.z = h.z + (g1 * bflo(a.y) + g2 * bflo(c.y)); o.w = h.w + (g1 * bfhi(a.y) + g2 * bfhi(c.y)); orow[64 * j] = o; }
    }
}

constexpr int N_PHASES = 16;
#ifndef MK_ONE_LAUNCH
#define MK_ONE_LAUNCH 1
#endif
struct Args { const float* in[17]; float* out; unsigned char* ws; int ph_lo, ph_hi; };
__global__ void __launch_bounds__(NWAVES * 64, 2) yoco_fwd(Args args) {
    extern __shared__ __attribute__((aligned(16))) unsigned char lds[];
    Frame F;
    F.lds = (LAS unsigned char*)lds; F.MISC = (volatile LAS unsigned*)(F.lds + MISC_OFF);
    F.tid = threadIdx.x; F.lane = F.tid & 63; F.wave = __builtin_amdgcn_readfirstlane(F.tid >> 6); F.G = gridDim.x; F.bid = blockIdx.x;
    F.ws = args.ws; F.ctl = (gu32*)(args.ws + WS_CTL); F.out = args.out;
#pragma unroll
    for (int i = 0; i < 17; ++i) F.in[i] = args.in[i];
    for (int u = F.tid; u < (LDS_BYTES - LDSCTL_OFF) / 4; u += NWAVES * 64) ((LAS unsigned*)(F.lds + LDSCTL_OFF))[u] = 0u;
    __syncthreads();
    unsigned char* ws = args.ws;
    XcdBarrier bar; bar.bar = (unsigned*)(F.ctl + CW_BAR); bar.x = 0; bar.st = nullptr;
    if (MK_ONE_LAUNCH) bar = xcd_barrier_post((unsigned*)(F.ctl + CW_BAR), F.MISC + 8);
    const int lo = args.ph_lo, hi = args.ph_hi;
#define IN(k) (lo <= (k) && (k) < hi)
#define SEAM(k) do { if (MK_ONE_LAUNCH && IN((k) + 1)) xcd_barrier(bar); } while (0)
    bf16* XB = (bf16*)(ws + WS_XB); float* H = (float*)(ws + WS_H); bf16* AO = (bf16*)(ws + WS_AO);

    if (IN(0)) { p0_prologue(F); SEAM(0); }
    if (IN(1)) {
        pg8::Gemm g{XB, (const bf16*)(ws + WS_WIN), M, 2048, D}; pg8::StaticOrder S; S.init(M, 2048, F.G, F.bid);
        pg8::EpiPlainBf16 E{(bf16*)(ws + WS_PROJ), 2048, 0xffff};
        pg8::gemm_phase<pg8::EpiPlainBf16, pg8::StaticOrder, true, true>(F.lds, g, S, E); SEAM(1); }
    if (IN(2)) { p2_post(F); SEAM(2); }
    if (IN(3)) { p3_index(F); SEAM(3); }
    if (IN(4)) { p4_dsa(F); SEAM(4); }
    if (IN(5)) {
        pg8::Gemm g{AO, (const bf16*)(ws + WS_WOA), M, D, D}; pg8::StaticOrder S; S.init(M, D, F.G, F.bid);
        pg8::EpiResid<true> E{F.in[IN_X], H, XB, (float*)(ws + WS_SS1), 1.0f};
        pg8::gemm_phase<pg8::EpiResid<true>, pg8::StaticOrder, true, true>(F.lds, g, S, E); SEAM(5); }
    if (IN(6)) {
        pg8::Gemm g{XB, (const bf16*)(ws + WS_WGU), M, 2 * FF, D / 2}; pg8::StaticOrder S; S.init(M, 2 * FF, F.G, F.bid);
        pg8::EpiSwiGLU8<false> E{ws + WS_HF, FF, (const float*)(ws + WS_SS1)};
        pg8::gemm_phase<pg8::EpiSwiGLU8<false>, pg8::StaticOrder, true, true, true>(F.lds, g, S, E); SEAM(6); }
    if (IN(7)) {
        pg8::Gemm g{(const bf16*)(ws + WS_HF), (const bf16*)(ws + WS_WD), M, D, FF / 2}; pg8::StaticOrder S; S.init(M, D, F.G, F.bid);
        pg8::EpiResid<false> E{H, H, XB, (float*)(ws + WS_SS2), 1.0f / (pg8::F8_SH * pg8::F8_SWD)};
        pg8::gemm_phase<pg8::EpiResid<false>, pg8::StaticOrder, true, true, true>(F.lds, g, S, E); SEAM(7); }
    if (IN(8)) {
        { pg8::Gemm g{XB, (const bf16*)(ws + WS_WKVQ), M, 2048, D}; pg8::StaticOrder S; S.init(M, 2048, F.G, F.bid);
          pg8::EpiScaleBf16 E{(bf16*)(ws + WS_KQ), 2048, (const float*)(ws + WS_SS2)};
          pg8::gemm_phase<pg8::EpiScaleBf16, pg8::StaticOrder, true, true>(F.lds, g, S, E); }
        { pg8::Gemm g{(const bf16*)(ws + WS_WKVQ) + (size_t)2048 * D, XB, D, M, D}; pg8::StaticOrder S; S.init(D, M, F.G, F.bid);
          pg8::EpiScaleColBf16 E{(bf16*)(ws + WS_VT), M, (const float*)(ws + WS_SS2)};
          pg8::gemm_phase<pg8::EpiScaleColBf16, pg8::StaticOrder, true, true>(F.lds, g, S, E); }
        SEAM(8); }
    if (IN(9)) { p9_sb(F); SEAM(9); }
    if (IN(10)) {
        pg8::Gemm g{AO, (const bf16*)(ws + WS_WOB), M, D, D}; pg8::StaticOrder S; S.init(M, D, F.G, F.bid);
        pg8::EpiResid<false> E{H, H, XB, (float*)(ws + WS_SS3), 1.0f};
        pg8::gemm_phase<pg8::EpiResid<false>, pg8::StaticOrder, true, true>(F.lds, g, S, E); SEAM(10); }
    if (IN(11)) { p11_router(F); SEAM(11); }
    if (IN(12)) { p12_permute(F); SEAM(12); }
    if (IN(13)) {
        pg8::MoeOrder S; moe_bases(F, S.tb); S.npn = 22; S.G = F.G; S.c = F.bid;
        pg8::Gemm g{(const bf16*)(ws + WS_XPERM), (const bf16*)(ws + WS_WGUM), MAXSLOT, NE * 2 * FF, D / 2};
        pg8::EpiSwiGLU8<true> E{ws + WS_HM, FF, nullptr};
        pg8::gemm_phase<pg8::EpiSwiGLU8<true>, pg8::MoeOrder, true, true, true>(F.lds, g, S, E); SEAM(13); }
    if (IN(14)) {
        pg8::MoeOrder S; moe_bases(F, S.tb); S.npn = 4; S.G = F.G; S.c = F.bid;
        pg8::Gemm g{(const bf16*)(ws + WS_HM), (const bf16*)(ws + WS_WDM), MAXSLOT, NE * D, FF / 2};
        pg8::EpiScaledBf16 E{(bf16*)(ws + WS_Y), D, 3, 1.0f / (pg8::F8_SH * pg8::F8_SWD)};
        pg8::gemm_phase<pg8::EpiScaledBf16, pg8::MoeOrder, true, true, true>(F.lds, g, S, E); SEAM(14); }
    if (IN(15)) { p15_combine(F); }
#undef IN
#undef SEAM
}

extern "C" void kernel_launch(void* const* d_in, const int* in_sizes, int n_in, void* d_out, int out_size, void* d_ws, size_t ws_size, hipStream_t stream) {
    static int grid = 0;
    if (grid == 0) {
        if (n_in != 17 || out_size != M * D || ws_size < WS_END) { fprintf(stderr, "kernel_launch: unexpected problem (n_in %d, out %d, ws %zu < %zu)\n", n_in, out_size, ws_size, (size_t)WS_END); grid = -1; return; }
        int dev = 0, cus = 0, per_cu = 0;
        if (hipGetDevice(&dev) != hipSuccess || hipDeviceGetAttribute(&cus, hipDeviceAttributeMultiprocessorCount, dev) != hipSuccess) { grid = -1; return; }
        if (hipFuncSetAttribute((const void*)yoco_fwd, hipFuncAttributeMaxDynamicSharedMemorySize, LDS_BYTES) != hipSuccess) { fprintf(stderr, "kernel_launch: hipFuncSetAttribute failed\n"); grid = -1; return; }
        if (hipOccupancyMaxActiveBlocksPerMultiprocessor(&per_cu, (const void*)yoco_fwd, NWAVES * 64, LDS_BYTES) != hipSuccess || per_cu < 1) fprintf(stderr, "kernel_launch: occupancy query says %d\n", per_cu);
        (void)hipGetLastError();
        grid = cus < 256 ? cus : 256;
    }
    if (grid < 0) return;
    if (hipMemsetAsync((char*)d_ws + WS_CTL, 0, CTL_ZERO_BYTES, stream) != hipSuccess) return;
    Args a{};
    for (int i = 0; i < 17; ++i) a.in[i] = (const float*)d_in[i];
    a.out = (float*)d_out; a.ws = (unsigned char*)d_ws;
#if MK_ONE_LAUNCH
    a.ph_lo = 0; a.ph_hi = N_PHASES;
    hipLaunchKernelGGL(yoco_fwd, dim3(grid), dim3(NWAVES * 64), LDS_BYTES, stream, a);
#else
    for (int p = 0; p < N_PHASES; ++p) { a.ph_lo = p; a.ph_hi = p + 1; hipLaunchKernelGGL(yoco_fwd, dim3(grid), dim3(NWAVES * 64), LDS_BYTES, stream, a); }
#endif
}
```

```cpp
#include <hip/hip_runtime.h>
#include <cstdio>
#include <cstdint>
namespace pg8 {
#define PG8_LAS __attribute__((address_space(3)))
typedef unsigned short bf16_t;
typedef short bf16x8 __attribute__((ext_vector_type(8)));
typedef float f32x4 __attribute__((ext_vector_type(4)));
typedef unsigned u32x4 __attribute__((ext_vector_type(4)));
typedef int i32x4 __attribute__((ext_vector_type(4)));
typedef int i32x8 __attribute__((ext_vector_type(8)));
constexpr int BM = 256, BK = 64, HALF = 128, HTB = HALF * BK * 2  , STAGE_BYTES = 8 * HTB, NXCD = 8, WGM = 8;

__host__ __device__ __forceinline__ int lds_byte(int r, int c) { const int st = (r >> 4) * 2 + (c >> 5), rr = r & 15, cc = c & 31, ob = rr * 64 + cc * 2; return st * 1024 + (ob ^ (((ob >> 9) & 1) << 5)); }
__host__ __device__ __forceinline__ void stage_rc(int b, int& R, int& C) { const int st = b / 1024, sb = b % 1024, swz = sb ^ (((sb >> 9) & 1) << 5); R = (st >> 1) * 16 + swz / 64; C = (st & 1) * 32 + (swz % 64) / 2; }
__host__ __device__ __forceinline__ int perm32(int rho) { const int n = rho >> 4, i = rho & 15; return 8 * (i >> 2) + 4 * n + (i & 3); }

struct Unit { int pm, pn; int koff = 0; };
struct Gemm { const bf16_t* A; const bf16_t* Bt; int M, N, K; int ld = 0; };

struct StaticOrder {
    int nM, nN, nwg, G, c;
    __host__ __device__ void init(int M, int N, int G_, int c_) { nM = M / BM; nN = N / BM; nwg = nM * nN; G = G_; c = c_; }
    __host__ __device__ bool next(int i, Unit& u) const {
        const long L = (long)i * G + c; if (L >= nwg) return false;
        int wgid = (int)L; { const int q = nwg / NXCD, r = nwg % NXCD, xcd = wgid % NXCD, off = wgid / NXCD; wgid = (xcd < r ? xcd * (q + 1) : r * (q + 1) + (xcd - r) * q) + off; }
        const int nig = WGM * nN, gid = wgid / nig, fm = gid * WGM, gsz = (nM - fm) < WGM ? (nM - fm) : WGM;
        u.pm = fm + ((wgid % nig) % gsz); u.pn = (wgid % nig) / gsz; return true;
    }
    __device__ __forceinline__ void a_ready(const Unit&) const {}
    __device__ __forceinline__ void done(const Unit&) const {}
};

__device__ __forceinline__ unsigned cvt_pk_bf16(float lo, float hi) { unsigned r; asm volatile("v_cvt_pk_bf16_f32 %0, %1, %2" : "=v"(r) : "v"(lo), "v"(hi)); return r; }
typedef unsigned u32x2 __attribute__((ext_vector_type(2)));
constexpr float RMS_EPS = 1e-6f;
__device__ __forceinline__ float rstd16(const float* p) {
    const f32x4 a = *(const f32x4*)p, b = *(const f32x4*)(p + 4), c = *(const f32x4*)(p + 8), d = *(const f32x4*)(p + 12);
    const float s = (((a[0] + a[1]) + (a[2] + a[3])) + ((b[0] + b[1]) + (b[2] + b[3]))) + (((c[0] + c[1]) + (c[2] + c[3])) + ((d[0] + d[1]) + (d[2] + d[3])));
    return 1.0f / sqrtf(s * (1.0f / 1024.0f) + RMS_EPS);
}
struct EpiScaleBf16 {
    static constexpr bool PERM = true, AFTER_DRAIN = false;
    bf16_t* O; int ldc; const float* ss;
    __device__ __forceinline__ void operator()(const f32x4 (&acc)[2][2][4][2], const Unit& u, int wr, int wc, int fr, int fq) const {
        const int row0 = u.pm * BM + wr * 64 + fr, col0 = u.pn * BM + wc * 32 + 8 * fq;
        float rsv[2][4];
#pragma unroll
        for (int ai = 0; ai < 2; ++ai)
#pragma unroll
            for (int m = 0; m < 4; ++m) rsv[ai][m] = rstd16(ss + (size_t)(row0 + ai * HALF + m * 16) * 16);
#pragma unroll
        for (int ai = 0; ai < 2; ++ai)
#pragma unroll
            for (int m = 0; m < 4; ++m) { const int row = row0 + ai * HALF + m * 16; const float rs = rsv[ai][m]; bf16_t* rowp = O + (size_t)row * ldc + col0;
#pragma unroll
                for (int bj = 0; bj < 2; ++bj) { const f32x4 v0 = acc[ai][bj][m][0] * rs, v1 = acc[ai][bj][m][1] * rs;
                    u32x4 w; w.x = cvt_pk_bf16(v0[0], v0[1]); w.y = cvt_pk_bf16(v0[2], v0[3]); w.z = cvt_pk_bf16(v1[0], v1[1]); w.w = cvt_pk_bf16(v1[2], v1[3]);
                    *(u32x4*)(rowp + bj * HALF) = w; } }
    }
};
struct EpiPlainBf16 {
    static constexpr bool PERM = true, AFTER_DRAIN = false;
    bf16_t* O; int ldc; int pnmask;
    __device__ __forceinline__ void operator()(const f32x4 (&acc)[2][2][4][2], const Unit& u, int wr, int wc, int fr, int fq) const {
        const int row0 = u.pm * BM + wr * 64 + fr, col0 = (u.pn & pnmask) * BM + wc * 32 + 8 * fq;
#pragma unroll
        for (int ai = 0; ai < 2; ++ai)
#pragma unroll
            for (int m = 0; m < 4; ++m) { bf16_t* rowp = O + (size_t)(row0 + ai * HALF + m * 16) * ldc + col0;
#pragma unroll
                for (int bj = 0; bj < 2; ++bj) { const f32x4 v0 = acc[ai][bj][m][0], v1 = acc[ai][bj][m][1];
                    u32x4 w; w.x = cvt_pk_bf16(v0[0], v0[1]); w.y = cvt_pk_bf16(v0[2], v0[3]); w.z = cvt_pk_bf16(v1[0], v1[1]); w.w = cvt_pk_bf16(v1[2], v1[3]);
                    *(u32x4*)(rowp + bj * HALF) = w; } }
    }
};
struct EpiScaleColBf16 {
    static constexpr bool PERM = true, AFTER_DRAIN = false;
    bf16_t* O; int ldc; const float* ss;
    __device__ __forceinline__ void operator()(const f32x4 (&acc)[2][2][4][2], const Unit& u, int wr, int wc, int fr, int fq) const {
        const int row0 = u.pm * BM + wr * 64 + fr, col0 = u.pn * BM + wc * 32 + 8 * fq;
        f32x4 rs[2][2];
#pragma unroll
        for (int bj = 0; bj < 2; ++bj)
#pragma unroll
            for (int n = 0; n < 2; ++n)
#pragma unroll
                for (int e = 0; e < 4; ++e) rs[bj][n][e] = rstd16(ss + (size_t)(col0 + bj * HALF + 4 * n + e) * 16);
#pragma unroll
        for (int ai = 0; ai < 2; ++ai)
#pragma unroll
            for (int m = 0; m < 4; ++m) { const int row = row0 + ai * HALF + m * 16; bf16_t* rowp = O + (size_t)row * ldc + col0;
#pragma unroll
                for (int bj = 0; bj < 2; ++bj) { const f32x4 v0 = acc[ai][bj][m][0] * rs[bj][0], v1 = acc[ai][bj][m][1] * rs[bj][1];
                    u32x4 w; w.x = cvt_pk_bf16(v0[0], v0[1]); w.y = cvt_pk_bf16(v0[2], v0[3]); w.z = cvt_pk_bf16(v1[0], v1[1]); w.w = cvt_pk_bf16(v1[2], v1[3]);
                    *(u32x4*)(rowp + bj * HALF) = w; } }
    }
};
constexpr float F8_SX = 16.f, F8_SWGU = 512.f, F8_SH = 16.f, F8_SWD = 1024.f;
__device__ __forceinline__ unsigned pk4_fp8(float a, float b, float c, float d) {
    a = __builtin_amdgcn_fmed3f(a, -448.f, 448.f); b = __builtin_amdgcn_fmed3f(b, -448.f, 448.f); c = __builtin_amdgcn_fmed3f(c, -448.f, 448.f); d = __builtin_amdgcn_fmed3f(d, -448.f, 448.f);
    int w = __builtin_amdgcn_cvt_pk_fp8_f32(a, b, 0, false); w = __builtin_amdgcn_cvt_pk_fp8_f32(c, d, w, true); return (unsigned)w;
}
template <bool X8> struct EpiResid {
    static constexpr bool PERM = false, AFTER_DRAIN = false;
    const float* base; float* H; bf16_t* XB; float* ssp; float sc;
    __device__ __forceinline__ void operator()(const f32x4 (&acc)[2][2][4][2], const Unit& u, int wr, int wc, int fr, int fq) const {
        const int row0 = u.pm * BM + wr * 64 + fr, col0 = u.pn * BM + wc * 32 + 4 * fq;
#pragma unroll
        for (int ai = 0; ai < 2; ++ai) {
            f32x4 bv[4][2][2];
#pragma unroll
            for (int m = 0; m < 4; ++m)
#pragma unroll
                for (int bj = 0; bj < 2; ++bj)
#pragma unroll
                    for (int n = 0; n < 2; ++n) bv[m][bj][n] = *(const f32x4*)(base + (size_t)(row0 + ai * HALF + m * 16) * 1024 + col0 + bj * HALF + n * 16);
#pragma unroll
            for (int m = 0; m < 4; ++m) { const int row = row0 + ai * HALF + m * 16; float q = 0.f;
#pragma unroll
                for (int bj = 0; bj < 2; ++bj)
#pragma unroll
                    for (int n = 0; n < 2; ++n) { const size_t off = (size_t)row * 1024 + col0 + bj * HALF + n * 16;
                        const f32x4 v = bv[m][bj][n] + acc[ai][bj][m][n] * sc; *(f32x4*)(H + off) = v;
                        q += (v[0] * v[0] + v[1] * v[1]) + (v[2] * v[2] + v[3] * v[3]);
                        if constexpr (X8) { *(unsigned*)((unsigned char*)XB + off) = pk4_fp8(v[0] * F8_SX, v[1] * F8_SX, v[2] * F8_SX, v[3] * F8_SX); }
                        else { u32x2 w; w.x = cvt_pk_bf16(v[0], v[1]); w.y = cvt_pk_bf16(v[2], v[3]); *(u32x2*)(XB + off) = w; } }
                q += __shfl_xor(q, 16); q += __shfl_xor(q, 32);
                if (fq == 0) ssp[(size_t)row * 16 + u.pn * 4 + wc] = q; }
        }
    }
};
__device__ __forceinline__ float silu_mul(float g, float u) { return g * __builtin_amdgcn_rcpf(1.0f + __builtin_amdgcn_exp2f(g * -1.4426950408889634f)) * u; }
template <bool MOE> struct EpiSwiGLU {
    static constexpr bool PERM = true, AFTER_DRAIN = false;
    bf16_t* O; int ldc; const float* ss;
    __device__ __forceinline__ void operator()(const f32x4 (&acc)[2][2][4][2], const Unit& u, int wr, int wc, int fr, int fq) const {
        const int row0 = u.pm * BM + wr * 64 + fr; const int pnl = MOE ? (u.pn % 22) : u.pn; const int col0 = pnl * HALF + wc * 32 + 8 * fq;
        float rsv[2][4];
#pragma unroll
        for (int ai = 0; ai < 2; ++ai)
#pragma unroll
            for (int m = 0; m < 4; ++m) { const int row = row0 + ai * HALF + m * 16; rsv[ai][m] = MOE ? 1.0f : rstd16(ss + (size_t)row * 16); }
#pragma unroll
        for (int ai = 0; ai < 2; ++ai)
#pragma unroll
            for (int m = 0; m < 4; ++m) { const int row = row0 + ai * HALF + m * 16; const float rs = rsv[ai][m];
                const f32x4 g0 = acc[ai][0][m][0] * rs, g1 = acc[ai][0][m][1] * rs, u0 = acc[ai][1][m][0] * rs, u1 = acc[ai][1][m][1] * rs;
                u32x4 w; w.x = cvt_pk_bf16(silu_mul(g0[0], u0[0]), silu_mul(g0[1], u0[1])); w.y = cvt_pk_bf16(silu_mul(g0[2], u0[2]), silu_mul(g0[3], u0[3]));
                w.z = cvt_pk_bf16(silu_mul(g1[0], u1[0]), silu_mul(g1[1], u1[1])); w.w = cvt_pk_bf16(silu_mul(g1[2], u1[2]), silu_mul(g1[3], u1[3]));
                *(u32x4*)(O + (size_t)row * ldc + col0) = w; }
    }
};
template <bool MOE> struct EpiSwiGLU8 {
    static constexpr bool PERM = true, AFTER_DRAIN = false;
    unsigned char* O; int ldc; const float* ss;
    __device__ __forceinline__ void operator()(const f32x4 (&acc)[2][2][4][2], const Unit& u, int wr, int wc, int fr, int fq) const {
        const int row0 = u.pm * BM + wr * 64 + fr; const int col0 = (MOE ? (u.pn % 22) : u.pn) * HALF + wc * 32 + 8 * fq; const float r0 = 1.0f / (F8_SX * F8_SWGU);
        float rsv[2][4];
#pragma unroll
        for (int ai = 0; ai < 2; ++ai)
#pragma unroll
            for (int m = 0; m < 4; ++m) rsv[ai][m] = MOE ? r0 : r0 * rstd16(ss + (size_t)(row0 + ai * HALF + m * 16) * 16);
#pragma unroll
        for (int ai = 0; ai < 2; ++ai)
#pragma unroll
            for (int m = 0; m < 4; ++m) { const int row = row0 + ai * HALF + m * 16; const float rs = rsv[ai][m], rh = rs * F8_SH;
                const f32x4 g0 = acc[ai][0][m][0] * rs, g1 = acc[ai][0][m][1] * rs, u0 = acc[ai][1][m][0] * rh, u1 = acc[ai][1][m][1] * rh;
                u32x2 w; w.x = pk4_fp8(silu_mul(g0[0], u0[0]), silu_mul(g0[1], u0[1]), silu_mul(g0[2], u0[2]), silu_mul(g0[3], u0[3]));
                w.y = pk4_fp8(silu_mul(g1[0], u1[0]), silu_mul(g1[1], u1[1]), silu_mul(g1[2], u1[2]), silu_mul(g1[3], u1[3]));
                *(u32x2*)(O + (size_t)row * ldc + col0) = w; }
    }
};
struct EpiScaledBf16 {
    static constexpr bool PERM = true, AFTER_DRAIN = false;
    bf16_t* O; int ldc; int pnmask; float sc;
    __device__ __forceinline__ void operator()(const f32x4 (&acc)[2][2][4][2], const Unit& u, int wr, int wc, int fr, int fq) const {
        const int row0 = u.pm * BM + wr * 64 + fr, col0 = (u.pn & pnmask) * BM + wc * 32 + 8 * fq;
#pragma unroll
        for (int ai = 0; ai < 2; ++ai)
#pragma unroll
            for (int m = 0; m < 4; ++m) { bf16_t* rowp = O + (size_t)(row0 + ai * HALF + m * 16) * ldc + col0;
#pragma unroll
                for (int bj = 0; bj < 2; ++bj) { const f32x4 v0 = acc[ai][bj][m][0] * sc, v1 = acc[ai][bj][m][1] * sc;
                    u32x4 w; w.x = cvt_pk_bf16(v0[0], v0[1]); w.y = cvt_pk_bf16(v0[2], v0[3]); w.z = cvt_pk_bf16(v1[0], v1[1]); w.w = cvt_pk_bf16(v1[2], v1[3]);
                    *(u32x4*)(rowp + bj * HALF) = w; } }
    }
};
struct EpiProj {
    static constexpr bool PERM = true, AFTER_DRAIN = false;
    unsigned char* QF8; unsigned char* KV8; bf16_t* QIF; const float* qnw; const float* knw; const unsigned* rope; PG8_LAS float* PS; float qsc;
    static __device__ __forceinline__ float hlo(unsigned w) { return (float)__builtin_bit_cast(_Float16, (unsigned short)(w & 0xffffu)); }
    static __device__ __forceinline__ float hhi(unsigned w) { return (float)__builtin_bit_cast(_Float16, (unsigned short)(w >> 16)); }
    static __device__ __forceinline__ void rot8(f32x4& y0, f32x4& y1, const f32x4& o0, const f32x4& o1, const u32x4& ca, const u32x4& cb, float sg) {
#pragma unroll
        for (int e = 0; e < 4; ++e) { y0[e] = y0[e] * hlo(ca[e]) + sg * o0[e] * hhi(ca[e]); y1[e] = y1[e] * hlo(cb[e]) + sg * o1[e] * hhi(cb[e]); }
    }
    __device__ __forceinline__ void operator()(const f32x4 (&acc)[2][2][4][2], const Unit& u, int wr, int wc, int fr, int fq) const {
        const int rl0 = wr * 64 + fr, row0 = u.pm * BM + rl0, c = wc * 32 + 8 * fq;
        u32x4 ct[3][2];
        const bool rq = (u.pn <= 4) && (wc == 0), ri = (u.pn >= 6) && ((wc & 1) == 0); const int aoff = (u.pn <= 4) ? 8 * (fq & 1) : 16;
#define EPJ_LOADCT(r) do { const unsigned* rp = rope + (size_t)((row0 + ((r) >> 2) * HALF + ((r) & 3) * 16) & 8191) * 24 + aoff; ct[(r) % 3][0] = *(const u32x4*)rp; ct[(r) % 3][1] = *(const u32x4*)(rp + 4); } while (0)
        if (rq || ri) { EPJ_LOADCT(0); EPJ_LOADCT(1); EPJ_LOADCT(2); }
        if (u.pn <= 4) {
#pragma unroll
            for (int ai = 0; ai < 2; ++ai)
#pragma unroll
                for (int m = 0; m < 4; ++m)
#pragma unroll
                    for (int bj = 0; bj < 2; ++bj) { const f32x4 a0 = acc[ai][bj][m][0], a1 = acc[ai][bj][m][1];
                        float s = ((a0[0] * a0[0] + a0[1] * a0[1]) + (a0[2] * a0[2] + a0[3] * a0[3])) + ((a1[0] * a1[0] + a1[1] * a1[1]) + (a1[2] * a1[2] + a1[3] * a1[3]));
                        s += __shfl_xor(s, 16); s += __shfl_xor(s, 32);
                        if (fq == 0) PS[(rl0 + ai * HALF + m * 16) * 8 + bj * 4 + wc] = s; }
            asm volatile("s_waitcnt lgkmcnt(0)" ::: "memory"); __builtin_amdgcn_s_barrier();
            const bool isk = (u.pn == 4); const float* nw = isk ? knw : qnw; const f32x4 g0 = *(const f32x4*)(nw + c), g1 = *(const f32x4*)(nw + c + 4); const float osc = isk ? 1.0f : qsc;
#pragma unroll
            for (int ai = 0; ai < 2; ++ai) {
#pragma unroll
                for (int m = 0; m < 4; ++m) { const int rl = rl0 + ai * HALF + m * 16, row = row0 + ai * HALF + m * 16, t = row & 8191, b = row >> 13;
#pragma unroll
                    for (int bj = 0; bj < 2; ++bj) { const f32x4 p = *(const PG8_LAS f32x4*)(PS + rl * 8 + bj * 4);
                        const float rs = 1.0f / sqrtf(((p[0] + p[1]) + (p[2] + p[3])) * (1.0f / 128.0f) + RMS_EPS);
                        f32x4 y0 = acc[ai][bj][m][0] * rs * g0, y1 = acc[ai][bj][m][1] * rs * g1;
                        if (wc == 0) {
                            f32x4 o0, o1;
#pragma unroll
                            for (int e = 0; e < 4; ++e) { o0[e] = __shfl_xor(y0[e], 32); o1[e] = __shfl_xor(y1[e], 32); }
                            rot8(y0, y1, o0, o1, ct[(4 * ai + m) % 3][0], ct[(4 * ai + m) % 3][1], (fq < 2) ? -1.0f : 1.0f); }
                        y0 = y0 * osc; y1 = y1 * osc;
                        u32x2 w; w.x = pk4_fp8(y0[0], y0[1], y0[2], y0[3]); w.y = pk4_fp8(y1[0], y1[1], y1[2], y1[3]);
                        unsigned char* dst = isk ? (KV8 + ((size_t)(b * 2 + bj) * 8192 + t) * 256 + c) : (QF8 + (size_t)row * 1024 + (2 * u.pn + bj) * HALF + c);
                        *(u32x2*)dst = w; }
                    if (4 * ai + m + 3 < 8 && rq) EPJ_LOADCT(4 * ai + m + 3); }
            }
        } else if (u.pn == 5) {
#pragma unroll
            for (int ai = 0; ai < 2; ++ai)
#pragma unroll
                for (int m = 0; m < 4; ++m) { const int row = row0 + ai * HALF + m * 16, t = row & 8191, b = row >> 13;
#pragma unroll
                    for (int bj = 0; bj < 2; ++bj) { const f32x4 y0 = acc[ai][bj][m][0], y1 = acc[ai][bj][m][1];
                        u32x2 w; w.x = pk4_fp8(y0[0], y0[1], y0[2], y0[3]); w.y = pk4_fp8(y1[0], y1[1], y1[2], y1[3]);
                        *(u32x2*)(KV8 + ((size_t)(b * 2 + bj) * 8192 + t) * 256 + 128 + c) = w; } }
        } else {
#pragma unroll
            for (int ai = 0; ai < 2; ++ai) {
#pragma unroll
                for (int m = 0; m < 4; ++m) { const int row = row0 + ai * HALF + m * 16;
#pragma unroll
                    for (int bj = 0; bj < 2; ++bj) { f32x4 y0 = acc[ai][bj][m][0], y1 = acc[ai][bj][m][1];
                        if (ri) {
                            f32x4 o0, o1;
#pragma unroll
                            for (int e = 0; e < 4; ++e) { o0[e] = __shfl_xor(y0[e], 16); o1[e] = __shfl_xor(y1[e], 16); }
                            if (fq < 2) rot8(y0, y1, o0, o1, ct[(4 * ai + m) % 3][0], ct[(4 * ai + m) % 3][1], (fq == 0) ? -1.0f : 1.0f); }
                        u32x4 w; w.x = cvt_pk_bf16(y0[0], y0[1]); w.y = cvt_pk_bf16(y0[2], y0[3]); w.z = cvt_pk_bf16(y1[0], y1[1]); w.w = cvt_pk_bf16(y1[2], y1[3]);
                        *(u32x4*)(QIF + (size_t)row * 512 + (u.pn - 6) * BM + bj * HALF + c) = w; }
                    if (4 * ai + m + 3 < 8 && ri) EPJ_LOADCT(4 * ai + m + 3); }
            }
        }
#undef EPJ_LOADCT
    }
};
struct MoeOrder {
    int tb[9]; int npn, G, c;
    __device__ __forceinline__ bool next(int i, Unit& u) const {
        const int L = i * G + c; if (L >= tb[8] * npn) return false;
        const int t = L / npn, j = L - t * npn; int e = 0;
#pragma unroll
        for (int k = 1; k < 8; ++k) e += (t >= tb[k]) ? 1 : 0;
        u.pm = t; u.pn = e * npn + j; return true;
    }
    __device__ __forceinline__ void a_ready(const Unit&) const {}
    __device__ __forceinline__ void done(const Unit&) const {}
};

template <class Epi, class Sched, bool ALIGN_EPI = false, bool SP2 = false, bool F8 = false>
__device__ __forceinline__ void gemm_phase(PG8_LAS unsigned char* lds, const Gemm g, const Sched& S, const Epi& E) {
    const int tid = threadIdx.x, wid = __builtin_amdgcn_readfirstlane(tid >> 6), lane = tid & 63, wr = wid >> 2, wc = wid & 3, fr = lane & 15, fq = lane >> 4;
    const int K = g.K, nt = K / BK, LD = g.ld ? g.ld : g.K;
    unsigned voffA[2], voffB[2];
#pragma unroll
    for (int i = 0; i < 2; ++i) { int R, C; stage_rc(tid * 16 + i * 8192, R, C); const int Rb = Epi::PERM ? ((R & ~31) + perm32(R & 31)) : R;
        voffA[i] = (unsigned)(R * LD + C) * 2u; voffB[i] = (unsigned)(Rb * LD + C) * 2u; }
    const size_t kstep = (size_t)(BK * 2);
    const size_t hstep = (size_t)HALF * LD * 2;
    const size_t tstep = 2 * hstep;
    const unsigned ldsw = (unsigned)wid * 1024u;
    const int aoff = lds_byte(wr * 64 + fr, fq * 8), boff = lds_byte(wc * 32 + fr, fq * 8);
#define PG8_SA(b, h) (((b) * 2 + (h)) * HTB)
#define PG8_SB(b, h) ((4 + (b) * 2 + (h)) * HTB)
#define PG8_STAGE(bufoff, gbase, voff) do { _Pragma("unroll") for (int _i = 0; _i < 2; ++_i) \
        __builtin_amdgcn_global_load_lds((const unsigned*)((const char*)(gbase) + (voff)[_i]), (PG8_LAS unsigned*)(lds + (bufoff) + ldsw + _i * 8192), 16, 0, 0); } while (0)
#define PG8_LD32(p) __builtin_shufflevector(*(const PG8_LAS i32x4*)(p), *(const PG8_LAS i32x4*)((p) + 1024), 0, 1, 2, 3, 4, 5, 6, 7)
#define PG8_LDA(dst, b, h) do { if constexpr (F8) { _Pragma("unroll") for (int m = 0; m < 4; ++m) dst##8[m] = PG8_LD32(lds + PG8_SA(b, h) + aoff + m * 2048); } else { \
        _Pragma("unroll") for (int m = 0; m < 4; ++m) _Pragma("unroll") for (int k = 0; k < 2; ++k) dst[m][k] = *(const PG8_LAS bf16x8*)(lds + PG8_SA(b, h) + aoff + m * 2048 + k * 1024); } } while (0)
#define PG8_LDB(dst, b, h) do { if constexpr (F8) { _Pragma("unroll") for (int n = 0; n < 2; ++n) dst##8[n] = PG8_LD32(lds + PG8_SB(b, h) + boff + n * 2048); } else { \
        _Pragma("unroll") for (int n = 0; n < 2; ++n) _Pragma("unroll") for (int k = 0; k < 2; ++k) dst[n][k] = *(const PG8_LAS bf16x8*)(lds + PG8_SB(b, h) + boff + n * 2048 + k * 1024); } } while (0)
#define PG8_MMA(ai, bj, At, Bt) do { __builtin_amdgcn_s_setprio(1); if constexpr (F8) { _Pragma("unroll") for (int m = 0; m < 4; ++m) _Pragma("unroll") for (int n = 0; n < 2; ++n) \
        asm("v_mfma_f32_16x16x128_f8f6f4 %0, %1, %2, %0" : "+v"(acc[ai][bj][m][n]) : "v"(Bt##8[n]), "v"(At##8[m])); } else { \
        _Pragma("unroll") for (int m = 0; m < 4; ++m) _Pragma("unroll") for (int n = 0; n < 2; ++n) _Pragma("unroll") for (int k = 0; k < 2; ++k) \
        acc[ai][bj][m][n] = __builtin_amdgcn_mfma_f32_16x16x32_bf16(Bt[n][k], At[m][k], acc[ai][bj][m][n], 0, 0, 0); } __builtin_amdgcn_s_setprio(0); } while (0)
#define PG8_WAIT_V(n) asm volatile("s_waitcnt vmcnt(" #n ")" ::: "memory")
#define PG8_WAIT_L(n) asm volatile("s_waitcnt lgkmcnt(" #n ")" ::: "memory")
#define PG8_BAR __builtin_amdgcn_s_barrier()
#define PG8_SCHED __builtin_amdgcn_sched_barrier(0)
    Unit cur, nxt; int ui = 0;
    if (!S.next(0, cur)) return;
    f32x4 acc[2][2][4][2];
#pragma unroll
    for (int a = 0; a < 2; ++a)
#pragma unroll
        for (int b = 0; b < 2; ++b)
#pragma unroll
            for (int m = 0; m < 4; ++m)
#pragma unroll
                for (int n = 0; n < 2; ++n) acc[a][b][m][n] = (f32x4){0.f, 0.f, 0.f, 0.f};
    bf16x8 At[4][2], B0[2][2], B1[2][2]; i32x8 At8[4], B08[2], B18[2];
    const char* cA = (const char*)g.A + (size_t)cur.pm * tstep + cur.koff; const char* cB = (const char*)g.Bt + (size_t)cur.pn * tstep + cur.koff;
    S.a_ready(cur);
    if constexpr (SP2) {
        PG8_STAGE(PG8_SB(0, 0), cB, voffB); PG8_STAGE(PG8_SB(0, 1), cB + hstep, voffB); PG8_STAGE(PG8_SA(0, 0), cA, voffA); PG8_STAGE(PG8_SA(0, 1), cA + hstep, voffA);
        if (wr == 1) PG8_BAR;
        PG8_WAIT_V(2); PG8_BAR;
        PG8_STAGE(PG8_SB(1, 0), cB + kstep, voffB); PG8_STAGE(PG8_SA(1, 0), cA + kstep, voffA); PG8_STAGE(PG8_SB(1, 1), cB + hstep + kstep, voffB);
        PG8_WAIT_V(6); PG8_BAR;
    } else {
        PG8_STAGE(PG8_SB(0, 0), cB, voffB); PG8_STAGE(PG8_SA(0, 0), cA, voffA); PG8_STAGE(PG8_SB(0, 1), cB + hstep, voffB); PG8_STAGE(PG8_SA(0, 1), cA + hstep, voffA);
        if (wr == 1) PG8_BAR;
        PG8_WAIT_V(4); PG8_BAR;
        PG8_STAGE(PG8_SB(1, 0), cB + kstep, voffB); PG8_STAGE(PG8_SA(1, 0), cA + kstep, voffA); PG8_STAGE(PG8_SB(1, 1), cB + hstep + kstep, voffB);
        PG8_WAIT_V(6); PG8_BAR;
    }
    for (;;) {
        const bool has_next = S.next(ui + 1, nxt);
        const char* nA = has_next ? (const char*)g.A + (size_t)nxt.pm * tstep + nxt.koff : cA; const char* nB = has_next ? (const char*)g.Bt + (size_t)nxt.pn * tstep + nxt.koff : cB;
#pragma clang loop unroll(disable)
        for (int t = 0; t < nt; t += 2) {
            const bool last = (t == nt - 2);
            const char* a1 = cA + (size_t)(t + 1) * kstep;
            const char* a2 = last ? nA : cA + (size_t)(t + 2) * kstep; const char* b2 = last ? nB : cB + (size_t)(t + 2) * kstep;
            const char* a3 = a2 + kstep; const char* b3 = b2 + kstep;
            if (last && has_next) S.a_ready(nxt);
            if constexpr (SP2) {
            PG8_LDB(B0, 0, 0); PG8_LDB(B1, 0, 1); PG8_SCHED; PG8_LDA(At, 0, 0); PG8_STAGE(PG8_SA(1, 1), a1 + hstep, voffA);
            PG8_WAIT_V(8); PG8_WAIT_L(0); PG8_BAR; PG8_MMA(0, 0, At, B0); PG8_MMA(0, 1, At, B1); PG8_BAR; PG8_SCHED;
            PG8_LDA(At, 0, 1); PG8_STAGE(PG8_SB(0, 0), b2, voffB); PG8_STAGE(PG8_SB(0, 1), b2 + hstep, voffB); PG8_STAGE(PG8_SA(0, 0), a2, voffA);
            PG8_WAIT_V(8); PG8_WAIT_L(0); PG8_BAR; PG8_MMA(1, 0, At, B0); PG8_MMA(1, 1, At, B1); PG8_BAR; PG8_SCHED;
            PG8_LDB(B0, 1, 0); PG8_LDB(B1, 1, 1); PG8_SCHED; PG8_LDA(At, 1, 0); PG8_STAGE(PG8_SA(0, 1), a2 + hstep, voffA);
            PG8_WAIT_V(8); PG8_WAIT_L(0); PG8_BAR; PG8_MMA(0, 0, At, B0); PG8_MMA(0, 1, At, B1); PG8_BAR; PG8_SCHED;
            PG8_LDA(At, 1, 1); PG8_STAGE(PG8_SB(1, 0), b3, voffB); PG8_STAGE(PG8_SB(1, 1), b3 + hstep, voffB); PG8_STAGE(PG8_SA(1, 0), a3, voffA);
            PG8_WAIT_V(8); PG8_WAIT_L(0); PG8_BAR; PG8_MMA(1, 0, At, B0); PG8_MMA(1, 1, At, B1); PG8_BAR; PG8_SCHED;
            } else {
            PG8_LDB(B0, 0, 0); PG8_SCHED; PG8_LDA(At, 0, 0); PG8_STAGE(PG8_SA(1, 1), a1 + hstep, voffA);
            PG8_WAIT_L(8); PG8_BAR; PG8_WAIT_L(0); PG8_MMA(0, 0, At, B0); PG8_BAR; PG8_SCHED;
            PG8_LDB(B1, 0, 1); PG8_STAGE(PG8_SB(0, 0), b2, voffB);
            PG8_BAR; PG8_WAIT_L(0); PG8_MMA(0, 1, At, B1); PG8_BAR;
            PG8_LDA(At, 0, 1); PG8_STAGE(PG8_SA(0, 0), a2, voffA);
            PG8_BAR; PG8_WAIT_L(0); PG8_MMA(1, 0, At, B0); PG8_BAR; PG8_SCHED;
            PG8_STAGE(PG8_SB(0, 1), b2 + hstep, voffB);
            PG8_WAIT_V(6); PG8_BAR; PG8_MMA(1, 1, At, B1); PG8_BAR;
            PG8_LDB(B0, 1, 0); PG8_SCHED; PG8_LDA(At, 1, 0); PG8_STAGE(PG8_SA(0, 1), a2 + hstep, voffA);
            PG8_WAIT_L(8); PG8_BAR; PG8_WAIT_L(0); PG8_MMA(0, 0, At, B0); PG8_BAR; PG8_SCHED;
            PG8_LDB(B1, 1, 1); PG8_STAGE(PG8_SB(1, 0), b3, voffB);
            PG8_BAR; PG8_WAIT_L(0); PG8_MMA(0, 1, At, B1); PG8_BAR;
            PG8_LDA(At, 1, 1); PG8_STAGE(PG8_SA(1, 0), a3, voffA);
            PG8_BAR; PG8_WAIT_L(0); PG8_MMA(1, 0, At, B0); PG8_BAR; PG8_SCHED;
            PG8_STAGE(PG8_SB(1, 1), b3 + hstep, voffB);
            PG8_WAIT_V(6); PG8_BAR; PG8_MMA(1, 1, At, B1); PG8_BAR;
            }
        }
        if constexpr (F8) asm volatile("s_nop 15\n\ts_nop 15" ::: "memory");
        if constexpr (ALIGN_EPI) { if (wr == 0) PG8_BAR; }
        if constexpr (!Epi::AFTER_DRAIN) { E(acc, cur, wr, wc, fr, fq); S.done(cur); }
        if (!has_next) break;
#pragma unroll
        for (int a = 0; a < 2; ++a)
#pragma unroll
            for (int b = 0; b < 2; ++b)
#pragma unroll
                for (int m = 0; m < 4; ++m)
#pragma unroll
                    for (int n = 0; n < 2; ++n) acc[a][b][m][n] = (f32x4){0.f, 0.f, 0.f, 0.f};
        cur = nxt; cA = nA; cB = nB; ++ui;
        if constexpr (ALIGN_EPI) { if (wr == 1) PG8_BAR; }
    }
    PG8_WAIT_V(0);
    if constexpr (!ALIGN_EPI) { if (wr == 0) PG8_BAR; }
    PG8_BAR;
    if constexpr (Epi::AFTER_DRAIN) { E.fused(acc, cur, wr, wc, fr, fq, lds, wid, lane); S.done(cur); }
#undef PG8_SA
#undef PG8_SB
#undef PG8_STAGE
#undef PG8_LDA
#undef PG8_LDB
#undef PG8_MMA
#undef PG8_LD32
#undef PG8_WAIT_V
#undef PG8_WAIT_L
#undef PG8_BAR
#undef PG8_SCHED
}
}

constexpr int NWAVES = 8;
constexpr int BATCH = 2, SEQ = 8192, D = 1024, M = BATCH * SEQ;
constexpr int HD = 128, NH = 8, NKV = 2, NIH = 8, IDX = 64, TOPK = 256;
constexpr int A_IN = 2120, FF = 2816, NE = 8;
constexpr int MAXSLOT = 34816;
constexpr float QSCALE = 0.12751743082459868f;
constexpr float SBSCALE = 0.08838834764831845f;
constexpr float WISCALE = 0.04419417382415922f;
constexpr size_t MiB = 1u << 20;
constexpr size_t WS_CTL = 0, CTL_ZERO_BYTES = 1 * MiB;
constexpr size_t WS_WIN = 2 * MiB, WS_WTAIL = 6 * MiB, WS_WOA = 7 * MiB, WS_WGU = 9 * MiB, WS_WD = 20 * MiB, WS_WKVQ = 26 * MiB, WS_WOB = 32 * MiB, WS_WGUM = 34 * MiB, WS_WDM = 122 * MiB;
constexpr size_t WS_H = 166 * MiB, WS_XB = 230 * MiB, WS_SS0 = 262 * MiB, WS_SS1 = 263 * MiB, WS_SS2 = 264 * MiB, WS_SS3 = 265 * MiB;
constexpr size_t WS_T = 266 * MiB;
constexpr size_t WS_PROJ = WS_T, WS_QF = 330 * MiB, WS_KVF = 362 * MiB, WS_QIF = 378 * MiB, WS_KIF = 394 * MiB, WS_WIF = 396 * MiB, WS_SEL = 397 * MiB, WS_AO = 413 * MiB;
constexpr size_t WS_HF = WS_T, WS_KQ = WS_T, WS_VT = 330 * MiB;
constexpr size_t WS_XPERM = WS_T, WS_HM = 334 * MiB, WS_Y = 521 * MiB;
constexpr size_t WS_RT = 590 * MiB;
constexpr size_t WS_ROPE = 15 * MiB;
constexpr size_t WS_END = 591 * MiB;
constexpr int CW_CNT = 64;
constexpr int CW_P3Q = 192;
constexpr int CW_BAR = 4096;
constexpr int RING_BYTES = 131072, LDSCTL_OFF = RING_BYTES, MISC_OFF = LDSCTL_OFF + 320, PS_OFF = LDSCTL_OFF + 1024  , LDS_BYTES = 147456;

#define GAS __attribute__((address_space(1)))
#define LAS __attribute__((address_space(3)))
typedef unsigned short bf16;
typedef unsigned v4u __attribute__((ext_vector_type(4)));
typedef unsigned v2u __attribute__((ext_vector_type(2)));
typedef float f32x4 __attribute__((ext_vector_type(4)));
typedef short bf16x8 __attribute__((ext_vector_type(8)));
typedef float f32x16 __attribute__((ext_vector_type(16)));
typedef GAS unsigned gu32;
#define RLX_AGENT __ATOMIC_RELAXED, __HIP_MEMORY_SCOPE_AGENT
#define LDS_WAIT() asm volatile("s_waitcnt lgkmcnt(0)" ::: "memory")
#define VM_WAIT() asm volatile("s_waitcnt vmcnt(0)" ::: "memory")
__device__ __forceinline__ unsigned f2bf(float f) { unsigned u = __builtin_bit_cast(unsigned, f); return (u + 0x7fffu + ((u >> 16) & 1u)) >> 16; }
__device__ __forceinline__ unsigned pk2(float lo, float hi) { return f2bf(lo) | (f2bf(hi) << 16); }
__device__ __forceinline__ float bflo(unsigned w) { return __uint_as_float(w << 16); }
__device__ __forceinline__ float bfhi(unsigned w) { return __uint_as_float(w & 0xffff0000u); }
__device__ __forceinline__ float wave_sum(float v) {
#pragma unroll
    for (int o = 1; o < 64; o <<= 1) v += __shfl_xor(v, o);
    return v;
}
__device__ __forceinline__ float wave_max(float v) {
#pragma unroll
    for (int o = 1; o < 64; o <<= 1) v = fmaxf(v, __shfl_xor(v, o));
    return v;
}
__device__ __forceinline__ void sincos_acc(float a, float& c, float& s) {
    const double x = (double)a; const double n = __builtin_rint(x * 0.63661977236758134308);
    const double r = __builtin_fma(-n, 6.123233995736766035869e-17, __builtin_fma(-n, 1.57079632679489655800, x)); const double r2 = r * r;
    double sn = 1.0 - r2 * (1.0 / 156.0); sn = 1.0 - r2 * (1.0 / 110.0) * sn; sn = 1.0 - r2 * (1.0 / 72.0) * sn; sn = 1.0 - r2 * (1.0 / 42.0) * sn; sn = 1.0 - r2 * (1.0 / 20.0) * sn; sn = 1.0 - r2 * (1.0 / 6.0) * sn; sn *= r;
    double cs = 1.0 - r2 * (1.0 / 182.0); cs = 1.0 - r2 * (1.0 / 132.0) * cs; cs = 1.0 - r2 * (1.0 / 90.0) * cs; cs = 1.0 - r2 * (1.0 / 56.0) * cs; cs = 1.0 - r2 * (1.0 / 30.0) * cs; cs = 1.0 - r2 * (1.0 / 12.0) * cs; cs = 1.0 - r2 * 0.5 * cs;
    const int q = ((int)n) & 3;
    const double cq = (q == 0) ? cs : (q == 1) ? -sn : (q == 2) ? -cs : sn;
    const double sq = (q == 0) ? sn : (q == 1) ? cs : (q == 2) ? -sn : -cs;
    c = (float)cq; s = (float)sq;
}
__device__ const float INV_Q[16] = {1.000000000e+00f, 4.403665960e-01f, 1.939227432e-01f, 8.539710194e-02f, 3.760603070e-02f, 1.656043902e-02f, 7.292664610e-03f, 3.211445874e-03f,
                                    1.414213562e-03f, 6.227723788e-04f, 2.742481884e-04f, 1.207697351e-04f, 5.318296098e-05f, 2.341999971e-05f, 1.031338616e-05f, 4.541670478e-06f};
__device__ const float INV_I[8] = {1.000000000e+00f, 1.939227432e-01f, 3.760603070e-02f, 7.292664610e-03f, 1.414213562e-03f, 2.742481884e-04f, 5.318296098e-05f, 1.031338616e-05f};

#define XB_TMO      128
#define XB_XCNT(j)  (256  + 64 * (j))
#define XB_XSUB(j)  (1280 + 64 * (j))
#define XB_XGEN(j)  (2304 + 64 * (j))
#define XB_TOP      3328
#define XB_TOPGEN   3392
#define XCD_BAR_WORDS 3456
#define XB_SPIN_CAP (1u << 18)

__device__ __forceinline__ unsigned xb_ld(unsigned* p)              { return __hip_atomic_load(p, __ATOMIC_RELAXED, __HIP_MEMORY_SCOPE_AGENT); }
__device__ __forceinline__ unsigned xb_add(unsigned* p, unsigned v) { return __hip_atomic_fetch_add(p, v, __ATOMIC_RELAXED, __HIP_MEMORY_SCOPE_AGENT); }
__device__ __forceinline__ unsigned xb_xcc_id() { return (unsigned)__builtin_amdgcn_s_getreg((3 << 11) | 20) & 0xFu; }
#define XB_SPIN(cond, bar) do { unsigned _sp = 0; while (cond) { __builtin_amdgcn_s_sleep(1); \
    if ((++_sp & 255u) == 0u) { if (xb_ld(&(bar)[XB_TMO])) break; if (_sp > XB_SPIN_CAP) { atomicAdd(&(bar)[XB_TMO], 1u); break; } } } } while (0)

struct XcdBarrier {
    unsigned* bar; unsigned x;
    volatile LAS unsigned* st;
};

__device__ __forceinline__ XcdBarrier xcd_barrier_post(unsigned* bar, volatile LAS unsigned* st) {
    XcdBarrier b; b.bar = bar; b.x = xb_xcc_id(); b.st = st;
    if (threadIdx.x == 0) (void)xb_add(&bar[XB_XCNT(b.x)], 1u);
    return b;
}
__device__ __forceinline__ void xcd_barrier_complete(unsigned* bar, unsigned x, unsigned& nloc, unsigned& nx) {
    const unsigned G = gridDim.x * gridDim.y * gridDim.z;
    unsigned sum, cnt, mine, sp = 0u;
    for (;;) {
        sum = 0u; cnt = 0u; mine = 0u;
#pragma unroll
        for (unsigned j = 0; j < 16; ++j) { const unsigned c = xb_ld(&bar[XB_XCNT(j)]); sum += c; cnt += (c > 0u) ? 1u : 0u; mine = (j == x) ? c : mine; }
        if (sum == G) break;
        __builtin_amdgcn_s_sleep(1);
        if ((++sp & 255u) == 0u) { if (xb_ld(&bar[XB_TMO])) break; if (sp > XB_SPIN_CAP) { atomicAdd(&bar[XB_TMO], 1u); break; } }
    }
    nloc = mine > 0u ? mine : 1u; nx = cnt > 0u ? cnt : 1u;
}

__device__ __forceinline__ void xcd_barrier(const XcdBarrier& b) {
    asm volatile("s_waitcnt vmcnt(0)" ::: "memory");
    __syncthreads();
    if (threadIdx.x == 0) {
        unsigned* bar = b.bar;
        __builtin_amdgcn_s_waitcnt(0);
        unsigned nloc = b.st[0], nx = b.st[1];
        if (nloc == 0u) { xcd_barrier_complete(bar, b.x, nloc, nx); b.st[0] = nloc; b.st[1] = nx; }
        const unsigned old = xb_add(&bar[XB_XSUB(b.x)], 1u);
        const unsigned gen = old / nloc;
        if (old + 1u == (gen + 1u) * nloc) {
            __builtin_amdgcn_fence(__ATOMIC_RELEASE, "agent");
            asm volatile("s_waitcnt vmcnt(0)" ::: "memory");
            const unsigned og = xb_add(&bar[XB_TOP], 1u);
            const unsigned tg = og / nx;
            if (og + 1u == (tg + 1u) * nx) xb_add(&bar[XB_TOPGEN], 1u);
            else XB_SPIN(xb_ld(&bar[XB_TOPGEN]) == tg, bar);
            __builtin_amdgcn_fence(__ATOMIC_ACQUIRE, "agent");
            xb_add(&bar[XB_XGEN(b.x)], 1u);
            asm volatile("s_waitcnt vmcnt(0)" ::: "memory");
        } else {
            XB_SPIN(xb_ld(&bar[XB_XGEN(b.x)]) == gen, bar);
            __builtin_amdgcn_fence(__ATOMIC_ACQUIRE, "agent");
            asm volatile("s_waitcnt vmcnt(0)" ::: "memory");
        }
    }
    __syncthreads();
}

struct Frame {
    LAS unsigned char* lds;
    volatile LAS unsigned* MISC;
    gu32* ctl;
    int tid, lane, wave, G, bid;
    const float* in[17];
    float* out; unsigned char* ws;
};
enum { IN_X = 0, IN_ANORM, IN_AWIN, IN_AQN, IN_AKN, IN_AWOUT, IN_KVNORM, IN_KVW, IN_BNORM, IN_BWQ, IN_BWOUT, IN_FFNNORM, IN_DGU, IN_DDN, IN_ROUTER, IN_MGU, IN_MDN };

constexpr float P4_QS = 16.f;
struct TrItem { const float* W; size_t ldw; int K, k0, csrc0, cend; bf16* WT; int drow0; const float* gain; float scale; int f8; };
__device__ __forceinline__ int gu_row(int c0) { return (c0 < FF) ? ((c0 >> 7) * 256 + (c0 & 127)) : (((c0 - FF) >> 7) * 256 + 128 + ((c0 - FF) & 127)); }
constexpr int I_WIN = 16 * 32, I_TAIL = 16 * 2, I_SQ = 16 * 16, I_GU = 16 * 88, I_DN = 44 * 16, I_KV = 16 * 32;
constexpr int TR_NITEMS = I_WIN + I_TAIL + I_SQ + I_GU + I_DN + I_KV + I_SQ + I_SQ + NE * I_GU + NE * I_DN;
__device__ __forceinline__ TrItem tr_decode(const Frame& F, int it) {
    unsigned char* ws = F.ws; int r = it; TrItem t;
    if (r < I_WIN) { const int kb = r / 32, nb = r % 32; t = TrItem{F.in[IN_AWIN], (size_t)A_IN, D, 64 * kb, 64 * nb, A_IN, (bf16*)(ws + WS_WIN), 64 * nb, F.in[IN_ANORM], 1.f}; return t; } r -= I_WIN;
    if (r < I_TAIL) { const int kb = r / 2, nb = r % 2; t = TrItem{F.in[IN_AWIN], (size_t)A_IN, D, 64 * kb, 2048 + 64 * nb, A_IN, (bf16*)(ws + WS_WTAIL), 64 * nb, F.in[IN_ANORM], 1.f}; return t; } r -= I_TAIL;
    if (r < I_SQ) { const int kb = r / 16, nb = r % 16; t = TrItem{F.in[IN_AWOUT], (size_t)D, D, 64 * kb, 64 * nb, D, (bf16*)(ws + WS_WOA), 64 * nb, nullptr, 1.f}; return t; } r -= I_SQ;
    if (r < I_GU) { const int kb = r / 88, nb = r % 88; t = TrItem{F.in[IN_DGU], (size_t)(2 * FF), D, 64 * kb, 64 * nb, 2 * FF, (bf16*)(ws + WS_WGU), gu_row(64 * nb), F.in[IN_FFNNORM], pg8::F8_SWGU, 1}; return t; } r -= I_GU;
    if (r < I_DN) { const int kb = r / 16, nb = r % 16; t = TrItem{F.in[IN_DDN], (size_t)D, FF, 64 * kb, 64 * nb, D, (bf16*)(ws + WS_WD), 64 * nb, nullptr, pg8::F8_SWD, 1}; return t; } r -= I_DN;
    if (r < I_KV) { const int kb = r / 32, nb = r % 32; t = TrItem{F.in[IN_KVW], (size_t)(2 * D), D, 64 * kb, 64 * nb, 2 * D, (bf16*)(ws + WS_WKVQ), (nb < 16) ? 64 * nb : 1024 + 64 * nb, F.in[IN_KVNORM], 1.f}; return t; } r -= I_KV;
    if (r < I_SQ) { const int kb = r / 16, nb = r % 16; t = TrItem{F.in[IN_BWQ], (size_t)D, D, 64 * kb, 64 * nb, D, (bf16*)(ws + WS_WKVQ), 1024 + 64 * nb, F.in[IN_BNORM], SBSCALE}; return t; } r -= I_SQ;
    if (r < I_SQ) { const int kb = r / 16, nb = r % 16; t = TrItem{F.in[IN_BWOUT], (size_t)D, D, 64 * kb, 64 * nb, D, (bf16*)(ws + WS_WOB), 64 * nb, nullptr, 1.f}; return t; } r -= I_SQ;
    if (r < NE * I_GU) { const int e = r / I_GU, rr = r % I_GU, kb = rr / 88, nb = rr % 88;
        t = TrItem{F.in[IN_MGU] + (size_t)e * D * 2 * FF, (size_t)(2 * FF), D, 64 * kb, 64 * nb, 2 * FF, (bf16*)(ws + WS_WGUM), e * 2 * FF + gu_row(64 * nb), F.in[IN_FFNNORM] + D, pg8::F8_SWGU, 1}; return t; } r -= NE * I_GU;
    { const int e = r / I_DN, rr = r % I_DN, kb = rr / 16, nb = rr % 16;
      t = TrItem{F.in[IN_MDN] + (size_t)e * FF * D, (size_t)D, FF, 64 * kb, 64 * nb, D, (bf16*)(ws + WS_WDM), e * D + 64 * nb, nullptr, pg8::F8_SWD, 1}; return t; }
}
__device__ __forceinline__ void tr_load(const TrItem& t, f32x4 (&v)[16], int lane) {
    const int r = lane >> 4, c = t.csrc0 + 4 * (lane & 15); const bool ok = c < t.cend; const float* src = t.W + (size_t)(t.k0 + r) * t.ldw + (ok ? c : 0);
#pragma unroll
    for (int i = 0; i < 16; ++i) { const f32x4 x = __builtin_nontemporal_load((const f32x4*)(src + (size_t)(4 * i) * t.ldw)); v[i] = ok ? x : (f32x4){0.f, 0.f, 0.f, 0.f}; }
}
__device__ __forceinline__ void tr_store(const TrItem& t, const f32x4 (&v)[16], LAS float* scr, int lane) {
    const int r = lane >> 4, c4 = lane & 15;
#pragma unroll
    for (int i = 0; i < 16; ++i) { const int k = 4 * i + r; const float g = t.gain ? t.gain[t.k0 + k] * t.scale : t.scale;
        *(LAS f32x4*)(scr + k * 64 + 4 * (c4 ^ ((k >> 3) & 7))) = v[i] * g; }
    LDS_WAIT(); asm volatile("" ::: "memory");
    if (t.f8) {
        const int c4b = lane & 3;
#pragma unroll
        for (int j = 0; j < 4; ++j) { const int n = (lane >> 2) + 16 * j;
            const LAS float* s0 = scr + (16 * c4b) * 64 + (n ^ ((2 * c4b) << 2)); const LAS float* s1 = scr + (16 * c4b + 8) * 64 + (n ^ ((2 * c4b + 1) << 2));
            v4u o; o.x = pg8::pk4_fp8(s0[0 * 64], s0[1 * 64], s0[2 * 64], s0[3 * 64]); o.y = pg8::pk4_fp8(s0[4 * 64], s0[5 * 64], s0[6 * 64], s0[7 * 64]);
            o.z = pg8::pk4_fp8(s1[0 * 64], s1[1 * 64], s1[2 * 64], s1[3 * 64]); o.w = pg8::pk4_fp8(s1[4 * 64], s1[5 * 64], s1[6 * 64], s1[7 * 64]);
            *(GAS v4u*)((unsigned char*)t.WT + (size_t)(t.drow0 + n) * t.K + t.k0 + 16 * c4b) = o; }
    } else {
    const int c8 = lane & 7;
#pragma unroll
    for (int j = 0; j < 8; ++j) { const int n = (lane >> 3) + 8 * j; const LAS float* s = scr + (8 * c8) * 64 + (n ^ (c8 << 2));
        v4u o; o.x = pk2(s[0 * 64], s[1 * 64]); o.y = pk2(s[2 * 64], s[3 * 64]); o.z = pk2(s[4 * 64], s[5 * 64]); o.w = pk2(s[6 * 64], s[7 * 64]);
        *(GAS v4u*)(t.WT + (size_t)(t.drow0 + n) * t.K + t.k0 + 8 * c8) = o; }
    }
    LDS_WAIT(); asm volatile("" ::: "memory");
}
__device__ __forceinline__ void p0_prologue(Frame& F) {
    LAS float* scr = (LAS float*)(F.lds + F.wave * 16384);
    const int gw = F.wave * F.G + F.bid, NGW = F.G * NWAVES;
    unsigned char* ws = F.ws;
    {
        f32x4 va[16], vb[16];
        int it = gw;
        if (it < TR_NITEMS) { TrItem cur = tr_decode(F, it); tr_load(cur, va, F.lane);
            for (;;) {
                const int nx = it + NGW; const bool has = nx < TR_NITEMS; TrItem nxt = cur;
                if (has) { nxt = tr_decode(F, nx); tr_load(nxt, vb, F.lane); }
                tr_store(cur, va, scr, F.lane);
                if (!has) break;
                it = nx + NGW; const bool has2 = it < TR_NITEMS; TrItem nn = nxt;
                if (has2) { nn = tr_decode(F, it); tr_load(nn, va, F.lane); }
                tr_store(nxt, vb, scr, F.lane);
                if (!has2) break;
                cur = nn;
            }
        }
    }
    { unsigned* RT = (unsigned*)(ws + WS_ROPE);
      for (int t = gw; t < SEQ; t += NGW) if (F.lane < 24) { float c, s; sincos_acc((float)t * ((F.lane < 16) ? INV_Q[F.lane & 15] : INV_I[F.lane & 7]), c, s);
          RT[t * 24 + F.lane] = (unsigned)__builtin_bit_cast(unsigned short, (_Float16)c) | ((unsigned)__builtin_bit_cast(unsigned short, (_Float16)s) << 16); } }
    const float* x = F.in[IN_X]; bf16* XB = (bf16*)(ws + WS_XB);
    for (int m = gw; m < M; m += NGW) {
        const GAS f32x4* xr = (const GAS f32x4*)(x + (size_t)m * D) + F.lane; f32x4 v[4]; float s = 0.f;
#pragma unroll
        for (int j = 0; j < 4; ++j) { v[j] = xr[64 * j]; s += (v[j].x * v[j].x + v[j].y * v[j].y) + (v[j].z * v[j].z + v[j].w * v[j].w); }
        s = wave_sum(s); const float rs = 1.0f / sqrtf(s * (1.0f / 1024.0f) + 1e-6f);
        GAS unsigned long long* o8 = (GAS unsigned long long*)(XB + (size_t)m * D) + F.lane;
#pragma unroll
        for (int j = 0; j < 4; ++j) o8[64 * j] = (unsigned long long)pk2(v[j].x * rs, v[j].y * rs) | ((unsigned long long)pk2(v[j].z * rs, v[j].w * rs) << 32);
    }
}

#define WAVE_SYNC() asm volatile("s_waitcnt lgkmcnt(0)" ::: "memory")
__device__ __forceinline__ void rope8(float (&y)[8], bool isx1, bool isx2, int i0, int pshift, LAS const float* tab) {
#pragma unroll
    for (int e = 0; e < 8; ++e) {
        const float other = __shfl_xor(y[e], pshift); const float c = tab[2 * (i0 + e)], s = tab[2 * (i0 + e) + 1];
        y[e] = isx1 ? (y[e] * c - other * s) : (isx2 ? (y[e] * c + other * s) : y[e]);
    }
}
__device__ __forceinline__ size_t kif_off(int grow, int d) { return ((((size_t)(grow >> 5) * 4 + ((d >> 3) & 3)) * 2 + (d >> 5)) * 32 + (grow & 31)) * 8 + (d & 7); }
__device__ __forceinline__ void unpack8(const v4u w, float (&y)[8]) { y[0] = bflo(w.x); y[1] = bfhi(w.x); y[2] = bflo(w.y); y[3] = bfhi(w.y); y[4] = bflo(w.z); y[5] = bfhi(w.z); y[6] = bflo(w.w); y[7] = bfhi(w.w); }
__device__ __forceinline__ v4u pack8(const float (&y)[8]) { v4u o; o.x = pk2(y[0], y[1]); o.y = pk2(y[2], y[3]); o.z = pk2(y[4], y[5]); o.w = pk2(y[6], y[7]); return o; }
__device__ __forceinline__ void p2_post(Frame& F) {
    unsigned char* ws = F.ws; const int lane = F.lane;
    const bf16* PROJ = (const bf16*)(ws + WS_PROJ); const bf16* XB = (const bf16*)(ws + WS_XB); const bf16* WT = (const bf16*)(ws + WS_WTAIL);
    bf16* QF = (bf16*)(ws + WS_QF); bf16* KVF = (bf16*)(ws + WS_KVF); bf16* QIF = (bf16*)(ws + WS_QIF); bf16* KIF = (bf16*)(ws + WS_KIF); float* WIF = (float*)(ws + WS_WIF);
    const float* qnw = F.in[IN_AQN]; const float* knw = F.in[IN_AKN];
    LAS float* tab = (LAS float*)(F.lds + F.wave * 256);
    const int gw = F.wave * F.G + F.bid, NGW = F.G * NWAVES;
    const unsigned* RT = (const unsigned*)(ws + WS_ROPE);
    for (int task = gw; task < M / 16; task += NGW) {
        const int row0 = task * 16;
        f32x4 acc[5];
#pragma unroll
        for (int c = 0; c < 5; ++c) acc[c] = (f32x4){0.f, 0.f, 0.f, 0.f};
        const bf16* ap = XB + (size_t)(row0 + (lane & 15)) * D + 8 * (lane >> 4);
        const bf16* bp = WT + (size_t)(lane & 15) * D + 8 * (lane >> 4);
#pragma unroll 4
        for (int j = 0; j < 32; ++j) {
            const bf16x8 a = *(const bf16x8*)(ap + 32 * j);
#pragma unroll
            for (int c = 0; c < 5; ++c) { const bf16x8 b = *(const bf16x8*)(bp + (size_t)(16 * c) * D + 32 * j); acc[c] = __builtin_amdgcn_mfma_f32_16x16x32_bf16(a, b, acc[c], 0, 0, 0); }
        }
#pragma unroll
        for (int reg = 0; reg < 4; ++reg) {
            const int row = row0 + 4 * (lane >> 4) + reg;
            const int d = lane & 15;
            float v0 = acc[0][reg]; const float other = __shfl_xor(v0, 8);
            { const unsigned cs = RT[(row & (SEQ - 1)) * 24 + 16 + (d & 7)]; const float c = pg8::EpiProj::hlo(cs), s = pg8::EpiProj::hhi(cs); v0 = (d < 8) ? (v0 * c - other * s) : (v0 * c + other * s); }
            KIF[kif_off(row, d)] = (bf16)f2bf(v0);
#pragma unroll
            for (int c = 1; c < 4; ++c) KIF[kif_off(row, 16 * c + d)] = (bf16)f2bf(acc[c][reg]);
            if (d < 8) WIF[(size_t)row * 8 + d] = acc[4][reg] * WISCALE;
        }
    }
}

__device__ __forceinline__ unsigned f2key(float f) { const unsigned u = __float_as_uint(f); return (u & 0x80000000u) ? ~u : (u | 0x80000000u); }
__device__ __forceinline__ void p3_query_naive(unsigned char* ws, LAS unsigned char* lds, int row, int* SEL) {
    const int tid = threadIdx.x, lane = tid & 63, wave = tid >> 6;
    const bf16* QIF = (const bf16*)(ws + WS_QIF); const bf16* KIF = (const bf16*)(ws + WS_KIF); const float* WIF = (const float*)(ws + WS_WIF);
    LAS unsigned* keys = (LAS unsigned*)lds;
    LAS float* qis = (LAS float*)(lds + 32768);
    LAS float* wl = (LAS float*)(lds + 32768 + 2048);
    LAS unsigned* hist = (LAS unsigned*)(lds + 36864);
    LAS unsigned* ctl = (LAS unsigned*)(lds + 36864 + 1024);
    LAS unsigned* wcnt = (LAS unsigned*)(lds + 36864 + 1024 + 64);
    {
        const int b = row >> 13, t = row & (SEQ - 1), n = t + 1;
        int* sel = SEL + (size_t)row * TOPK;
        if (n <= TOPK) { if (tid < TOPK) sel[tid] = tid < n ? tid : 0; return; }
        __syncthreads();
        qis[tid] = __uint_as_float((unsigned)QIF[(size_t)row * 512 + tid] << 16);
        if (tid < 8) wl[tid] = WIF[(size_t)row * 8 + tid];
        __syncthreads();
        for (int s = tid; s < n; s += 512) {
            const int grow = (b << 13) + s;
            float kf[64];
#pragma unroll
            for (int j = 0; j < 8; ++j) { const v4u w = *(const v4u*)(KIF + kif_off(grow, 8 * j)); kf[8 * j] = bflo(w.x); kf[8 * j + 1] = bfhi(w.x); kf[8 * j + 2] = bflo(w.y); kf[8 * j + 3] = bfhi(w.y); kf[8 * j + 4] = bflo(w.z); kf[8 * j + 5] = bfhi(w.z); kf[8 * j + 6] = bflo(w.w); kf[8 * j + 7] = bfhi(w.w); }
            float sc = 0.f;
#pragma unroll
            for (int h = 0; h < 8; ++h) { float d = 0.f; asm volatile("" ::: "memory");
#pragma unroll
                for (int dd = 0; dd < 64; ++dd) d += qis[h * 64 + dd] * kf[dd];
                sc += wl[h] * fmaxf(d, 0.f); }
            keys[s] = f2key(sc + 0.0f);
        }
        __syncthreads();
        unsigned prefix = 0u, mask = 0u, need = TOPK;
        for (int pass = 0; pass < 4; ++pass) {
            const int shift = 24 - 8 * pass;
            if (tid < 256) hist[tid] = 0u;
            __syncthreads();
            for (int s = tid; s < n; s += 512) { const unsigned k = keys[s]; if ((k & mask) == prefix) __hip_atomic_fetch_add(&hist[(k >> shift) & 255u], 1u, __ATOMIC_RELAXED, __HIP_MEMORY_SCOPE_WORKGROUP); }
            __syncthreads();
            if (tid < 64) {
                const unsigned h0 = hist[4 * lane], h1 = hist[4 * lane + 1], h2 = hist[4 * lane + 2], h3 = hist[4 * lane + 3]; const unsigned tot = h0 + h1 + h2 + h3;
                unsigned incl = tot;
#pragma unroll
                for (int o = 1; o < 64; o <<= 1) { const unsigned v = __shfl_down(incl, o); if (lane + o < 64) incl += v; }
                const unsigned above = incl - tot;
                if (above < need && need <= above + tot) {
                    unsigned a = above; unsigned bin;
                    if (a + h3 >= need) bin = 3; else { a += h3; if (a + h2 >= need) bin = 2; else { a += h2; if (a + h1 >= need) bin = 1; else { a += h1; bin = 0; } } }
                    ctl[0] = 4 * lane + bin; ctl[1] = need - a;
                }
            }
            __syncthreads();
            prefix |= ctl[0] << shift; mask |= 255u << shift; need = ctl[1];
            __syncthreads();
        }
        const unsigned thr = prefix, n_gt = TOPK - need;
        unsigned base_gt = 0u, base_eq = 0u;
        for (int s0 = 0; s0 < n; s0 += 512) {
            const int s = s0 + tid; const unsigned k = s < n ? keys[s] : 0u; const bool gt = (s < n) && (k > thr); const bool eq = (s < n) && (k == thr);
            const unsigned long long bg = __ballot(gt), be = __ballot(eq); const unsigned long long lt = (1ull << lane) - 1ull;
            const unsigned rg = __popcll(bg & lt), re = __popcll(be & lt);
            if (lane == 0) { wcnt[wave] = __popcll(bg); wcnt[8 + wave] = __popcll(be); }
            __syncthreads();
            unsigned og = base_gt, oe = base_eq, tg = 0u, te = 0u;
#pragma unroll
            for (int w = 0; w < 8; ++w) { const unsigned cg = wcnt[w], ce = wcnt[8 + w]; if (w < wave) { og += cg; oe += ce; } tg += cg; te += ce; }
            if (gt) sel[og + rg] = s;
            if (eq && oe + re < need) sel[n_gt + oe + re] = s;
            base_gt += tg; base_eq += te;
            __syncthreads();
        }
    }
}

constexpr int P3_HIST = 0, P3_H2 = 65536, P3_BM = 98304, P3_QS = 114688, P3_FLAG = P3_QS + 512, P3_CAP = 512;
__device__ __forceinline__ void find_bin_2048(LAS const unsigned* hist, unsigned need, int lane, unsigned& bin_out, unsigned& need_out, unsigned& cnt_out, bool& ok) {
    unsigned w[16]; unsigned tot = 0u;
#pragma unroll
    for (int i = 0; i < 16; ++i) { w[i] = hist[16 * lane + i]; tot += (w[i] & 0xffffu) + (w[i] >> 16); }
    unsigned incl = tot;
#pragma unroll
    for (int o = 1; o < 64; o <<= 1) { const unsigned v = __shfl_down(incl, o); if (lane + o < 64) incl += v; }
    const unsigned above = incl - tot;
    const bool mine = (above < need) && (need <= above + tot);
    unsigned a = above, fb = 0u, fn = 0u, fc = 0u; bool found = false;
#pragma unroll
    for (int i = 15; i >= 0; --i) {
        const unsigned h1 = w[i] >> 16, h0 = w[i] & 0xffffu;
        if (!found) { if (a + h1 >= need) { found = true; fb = 32u * lane + 2u * i + 1u; fn = need - a; fc = h1; } else a += h1; }
        if (!found) { if (a + h0 >= need) { found = true; fb = 32u * lane + 2u * i; fn = need - a; fc = h0; } else a += h0; }
    }
    const unsigned long long bm = __ballot(mine);
    ok = (bm != 0ull);
    const int src = ok ? (__ffsll((long long)bm) - 1) : 0;
    bin_out = (unsigned)__builtin_amdgcn_readlane((int)fb, src); need_out = (unsigned)__builtin_amdgcn_readlane((int)fn, src); cnt_out = (unsigned)__builtin_amdgcn_readlane((int)fc, src);
}
__device__ __forceinline__ unsigned bin11(float sc) { const unsigned u = __float_as_uint(sc); const int m = (int)((u & 0x7fffffffu) >> 17) - 7360; const unsigned mc = (unsigned)(m < 0 ? 0 : (m > 1023 ? 1023 : m)); return (u >> 31) ? (1023u - mc) : (1024u + mc); }
__device__ __forceinline__ float relu_i(float x) { const int xi = __builtin_bit_cast(int, x); const int ri = (xi < 0) ? 0 : xi; return __builtin_bit_cast(float, ri); }
#define RELU(x) relu_i(x)
typedef _Float16 f16x8 __attribute__((ext_vector_type(8)));
typedef short s16x2 __attribute__((ext_vector_type(2)));
__device__ __forceinline__ unsigned pk_relu_f16(float a, float b) { const s16x2 h = __builtin_bit_cast(s16x2, __builtin_amdgcn_cvt_pkrtz(a, b)); return __builtin_bit_cast(unsigned, __builtin_elementwise_max(h, (s16x2){0, 0})); }
__device__ __forceinline__ unsigned bin16(unsigned h) { const int m = (int)((h & 0x7fffu) >> 4) - 192; const unsigned mc = (unsigned)(m < 0 ? 0 : (m > 1023 ? 1023 : m)); return (h & 0x8000u) ? (1023u - mc) : (1024u + mc); }
__device__ __forceinline__ unsigned key16(unsigned h) { return (h & 0x8000u) ? (~h & 0xffffu) : (h | 0x8000u); }
__device__ __forceinline__ void p3_score_pass(const bf16x8 (&af)[2][4], const f16x8 (&wa)[2][2], const bf16* kib, int t0, int nt, int wave, int n, int hi,
                                              LAS unsigned char* lds, unsigned short* SC, int rot) {
    LAS unsigned* HIST = (LAS unsigned*)(lds + P3_HIST);
    const int qh = 8 * (wave >> 2), w4 = wave & 3;
    const int cnt4 = (nt - w4 + 3) >> 2; const int r0 = rot % cnt4;
    bf16x8 bq[4][4];
#define P3_LOADB(u, j) do { int jj_ = r0 + (j); jj_ = (jj_ >= cnt4) ? jj_ - cnt4 : jj_; const int t_ = w4 + 4 * jj_; \
        const bf16* kp_ = kib + ((size_t)t_ * 8 + hi) * 256 + n * 8; _Pragma("unroll") for (int s = 0; s < 4; ++s) bq[u][s] = *(const bf16x8*)(kp_ + s * 512); } while (0)
#pragma unroll
    for (int u = 0; u < 4; ++u) P3_LOADB(u, (u < cnt4) ? u : 0);
    for (int i0 = 0; i0 < cnt4; i0 += 4) {
#pragma unroll
        for (int u = 0; u < 4; ++u) {
            if (i0 + u < cnt4) {
                int jj = r0 + i0 + u; jj = (jj >= cnt4) ? jj - cnt4 : jj; const int tile = w4 + 4 * jj;
                const int key = 32 * tile + n; const bool full = (32 * tile + 31 <= t0);
                f32x16 acc0, acc1;
#pragma unroll
                for (int r = 0; r < 16; ++r) { acc0[r] = 0.f; acc1[r] = 0.f; }
#pragma unroll
                for (int s = 0; s < 4; ++s) acc0 = __builtin_amdgcn_mfma_f32_32x32x16_bf16(af[0][s], bq[u][s], acc0, 0, 0, 0);
#pragma unroll
                for (int s = 0; s < 4; ++s) acc1 = __builtin_amdgcn_mfma_f32_32x32x16_bf16(af[1][s], bq[u][s], acc1, 0, 0, 0);
                unsigned p01, p23;
                {
                    f32x16 y0, y1;
#pragma unroll
                    for (int r = 0; r < 16; ++r) { y0[r] = 0.f; y1[r] = 0.f; }
                    const f16x8 x00 = __builtin_bit_cast(f16x8, (v4u){pk_relu_f16(acc0[0], acc0[1]), pk_relu_f16(acc0[2], acc0[3]), pk_relu_f16(acc0[4], acc0[5]), pk_relu_f16(acc0[6], acc0[7])});
                    const f16x8 x01 = __builtin_bit_cast(f16x8, (v4u){pk_relu_f16(acc0[8], acc0[9]), pk_relu_f16(acc0[10], acc0[11]), pk_relu_f16(acc0[12], acc0[13]), pk_relu_f16(acc0[14], acc0[15])});
                    const f16x8 x10 = __builtin_bit_cast(f16x8, (v4u){pk_relu_f16(acc1[0], acc1[1]), pk_relu_f16(acc1[2], acc1[3]), pk_relu_f16(acc1[4], acc1[5]), pk_relu_f16(acc1[6], acc1[7])});
                    const f16x8 x11 = __builtin_bit_cast(f16x8, (v4u){pk_relu_f16(acc1[8], acc1[9]), pk_relu_f16(acc1[10], acc1[11]), pk_relu_f16(acc1[12], acc1[13]), pk_relu_f16(acc1[14], acc1[15])});
                    y0 = __builtin_amdgcn_mfma_f32_32x32x16_f16(wa[0][0], x00, y0, 0, 0, 0); y1 = __builtin_amdgcn_mfma_f32_32x32x16_f16(wa[1][0], x10, y1, 0, 0, 0);
                    y0 = __builtin_amdgcn_mfma_f32_32x32x16_f16(wa[0][1], x01, y0, 0, 0, 0); y1 = __builtin_amdgcn_mfma_f32_32x32x16_f16(wa[1][1], x11, y1, 0, 0, 0);
                    p01 = __builtin_bit_cast(unsigned, __builtin_amdgcn_cvt_pkrtz(y0[0], y0[1])); p23 = __builtin_bit_cast(unsigned, __builtin_amdgcn_cvt_pkrtz(y1[0], y1[1]));
                }
                unsigned h4[4]; h4[0] = p01 & 0xffffu; h4[1] = p01 >> 16; h4[2] = p23 & 0xffffu; h4[3] = p23 >> 16;
                unsigned short* scp = SC + (size_t)(qh + hi) * SEQ + key;
                scp[0] = (unsigned short)h4[0]; scp[2 * SEQ] = (unsigned short)h4[1]; scp[4 * SEQ] = (unsigned short)h4[2]; scp[6 * SEQ] = (unsigned short)h4[3];
                unsigned bin4[4];
#pragma unroll
                for (int e = 0; e < 4; ++e) bin4[e] = bin16(h4[e]);
                if (full) {
#pragma unroll
                    for (int e = 0; e < 4; ++e) { const int q = qh + 4 * (e >> 1) + hi + 2 * (e & 1); __hip_atomic_fetch_add(&HIST[q * 1024 + (bin4[e] >> 1)], 1u << (16 * (bin4[e] & 1u)), __ATOMIC_RELAXED, __HIP_MEMORY_SCOPE_WORKGROUP); }
                } else {
#pragma unroll
                    for (int e = 0; e < 4; ++e) { const int q = qh + 4 * (e >> 1) + hi + 2 * (e & 1); if (key <= t0 + q) __hip_atomic_fetch_add(&HIST[q * 1024 + (bin4[e] >> 1)], 1u << (16 * (bin4[e] & 1u)), __ATOMIC_RELAXED, __HIP_MEMORY_SCOPE_WORKGROUP); }
                }
            }
            { const int jn = (i0 + u + 4 < cnt4) ? (i0 + u + 4) : (cnt4 - 1); P3_LOADB(u, jn); }
        }
    }
#undef P3_LOADB
}
__device__ __forceinline__ void p3_append(unsigned cm, const v4u& hw, int k0, LAS unsigned* cnt, LAS unsigned* cand) {
    while (cm) { const int j = __ffs((int)cm) - 1; cm &= cm - 1u; const unsigned w = (j < 2) ? hw.x : (j < 4) ? hw.y : (j < 6) ? hw.z : hw.w; const unsigned h = (j & 1) ? (w >> 16) : (w & 0xffffu);
        const unsigned pos = __hip_atomic_fetch_add(cnt, 1u, __ATOMIC_RELAXED, __HIP_MEMORY_SCOPE_WORKGROUP);
        if (pos < (unsigned)P3_CAP) { cand[2 * pos] = key16(h); cand[2 * pos + 1] = (unsigned)(k0 + j); } }
}
__device__ __forceinline__ void p3_index(Frame& F) {
    unsigned char* ws = F.ws; const int tid = F.tid, lane = F.lane, wave = F.wave, n = lane & 31, hi = lane >> 5;
    const bf16* QIF = (const bf16*)(ws + WS_QIF); const bf16* KIF = (const bf16*)(ws + WS_KIF); const float* WIF = (const float*)(ws + WS_WIF); int* SEL = (int*)(ws + WS_SEL);
    unsigned short* SC = (unsigned short*)(ws + WS_PROJ) + (size_t)F.bid * 16 * SEQ;
    LAS unsigned char* lds = F.lds;
    LAS unsigned* HIST = (LAS unsigned*)(lds + P3_HIST); LAS unsigned* H2 = (LAS unsigned*)(lds + P3_H2 + wave * 4096); LAS unsigned* BM = (LAS unsigned*)(lds + P3_BM); LAS unsigned* QS = (LAS unsigned*)(lds + P3_QS);
    LAS unsigned* FBL = (LAS unsigned*)(lds + P3_QS + 1024);
    if (tid == 0) FBL[0] = 0u;
    __syncthreads();
    for (int ps = F.bid; ps < 512; ps += F.G) {
        const int b = ps >> 8, wq = ps & 255;
#pragma unroll 1
        for (int half = 0; half < 2; ++half) {
            const int idx = half ? (511 - wq) : wq; const int t0 = 16 * idx, row0 = (b << 13) + t0;
            if (idx < 16) {
                for (int e = tid; e < 16 * TOPK; e += 512) { const int q = e >> 8, i = e & 255; SEL[(size_t)(row0 + q) * TOPK + i] = (i <= t0 + q) ? i : 0; }
                continue;
            }
            for (int e = tid; e < 16384; e += 512) HIST[e] = 0u;
            if (tid < 128) QS[tid] = 0u;
            bf16x8 af[2][4]; f16x8 wa[2][2]; const int qh = 8 * (wave >> 2);
            { const int head = (n & 3) + 4 * ((n >> 3) & 1), q4 = ((n >> 2) & 1) + 2 * (n >> 4);
#pragma unroll
              for (int mt = 0; mt < 2; ++mt) { const bf16* ap = QIF + (size_t)(row0 + qh + 4 * mt + q4) * 512 + head * IDX + 32 * hi;
#pragma unroll
                  for (int s = 0; s < 4; ++s) af[mt][s] = *(const bf16x8*)(ap + 8 * s);
#pragma unroll
                  for (int sp = 0; sp < 2; ++sp) {
                      const bool on = (sp == 0) ? ((n == 0 && hi == 0) || (n == 4 && hi == 1)) : ((n == 1 && hi == 0) || (n == 5 && hi == 1));
                      const float* wp = WIF + (size_t)(row0 + qh + 4 * mt + hi + 2 * sp) * 8; const f32x4 w0 = *(const f32x4*)wp, w1 = *(const f32x4*)(wp + 4);
                      f16x8 t; t[0] = (_Float16)w0[0]; t[1] = (_Float16)w0[1]; t[2] = (_Float16)w0[2]; t[3] = (_Float16)w0[3]; t[4] = (_Float16)w1[0]; t[5] = (_Float16)w1[1]; t[6] = (_Float16)w1[2]; t[7] = (_Float16)w1[3];
                      if (!on) t = (f16x8){0, 0, 0, 0, 0, 0, 0, 0};
                      wa[mt][sp] = t; } } }
            const int nt = (t0 + 16 + 31) >> 5; const bf16* kib = KIF + (size_t)(b << 13) * IDX;
            __syncthreads();
            p3_score_pass(af, wa, kib, t0, nt, wave, n, hi, lds, SC, F.bid * 5);
            __syncthreads();
            v4u hv[16];
#define P3_LOADSC(qx) do { unsigned long long qo_ = (unsigned long long)(qx) * (SEQ * 2); asm volatile("" : "+s"(qo_)); const char* s_ = (const char*)SC + qo_; const int n_ = ((t0 + (qx)) >> 9) + 1; const unsigned lo_ = 16u * (unsigned)lane; \
                _Pragma("unroll") for (int ch = 0; ch < 16; ++ch) { hv[ch] = (v4u){0u, 0u, 0u, 0u}; if (ch < n_) hv[ch] = *(const v4u*)(s_ + 1024 * ch + lo_); } } while (0)
            P3_LOADSC(2 * wave);
#pragma unroll 1
            for (int qq = 0; qq < 2; ++qq) {
                const int q = 2 * wave + qq; unsigned T, needA, c; bool ok;
                find_bin_2048(HIST + q * 1024, (unsigned)TOPK, lane, T, needA, c, ok);
                const bool defer = !ok || c > (unsigned)P3_CAP;
                if (defer && lane == 0) { const unsigned k = __hip_atomic_fetch_add(&FBL[0], 1u, __ATOMIC_RELAXED, __HIP_MEMORY_SCOPE_WORKGROUP); if (k < 63u) FBL[1 + k] = (unsigned)(row0 + q); }
                const int tq = t0 + q, nch = (tq >> 9) + 1;
                LAS unsigned char* bmb = (LAS unsigned char*)(BM + q * 256); LAS unsigned* cand = H2; LAS unsigned* bmq = BM + q * 256;
                const bool fastp = T >= 1024u; const unsigned mcT = T - 1024u;
                const unsigned klo = (mcT == 0u) ? 0u : ((mcT + 192u) << 4), khi = (mcT == 1023u) ? 0x7fffu : (((mcT + 192u) << 4) + 15u);
                const int hiT = (int)((khi << 16) | 0xffffu), loT = (int)(klo << 16);
                if (!defer) {
                    if (fastp) {
#pragma unroll
                        for (int ch = 0; ch < 16; ++ch) {
                            if (ch < nch) {
                                const v4u hw = hv[ch]; int k0 = 512 * ch + 8 * lane; asm volatile("" : "+v"(k0));
                                int nv = tq - k0 + 1; nv = nv < 0 ? 0 : (nv > 8 ? 8 : nv); const unsigned vm = (1u << nv) - 1u;
                                unsigned am = 0u, nb = 0u;
#pragma unroll
                                for (int d = 3; d >= 0; --d) { const unsigned w = (d == 0) ? hw.x : (d == 1) ? hw.y : (d == 2) ? hw.z : hw.w; const int wh = (int)w, wl = (int)(w << 16);
                                    am = am + am + ((wh > hiT) ? 1u : 0u); nb = nb + nb + ((wh >= loT) ? 1u : 0u);
                                    am = am + am + ((wl > hiT) ? 1u : 0u); nb = nb + nb + ((wl >= loT) ? 1u : 0u); }
                                am &= vm; const unsigned cm = nb & vm & ~am;
                                bmb[64 * ch + lane] = (unsigned char)am;
                                if (__ballot(cm != 0u) != 0ull) p3_append(cm, hw, k0, &QS[q * 8 + 3], cand);
                            } else { ((LAS unsigned*)bmb)[16 * ch + (lane & 15)] = 0u; }
                        }
                    } else {
#pragma unroll 1
                        for (int ch = 0; ch < 16; ++ch) {
                            if (ch < nch) {
                                int k0 = 512 * ch + 8 * lane; asm volatile("" : "+v"(k0)); const v4u hw = *(const v4u*)(SC + (size_t)q * SEQ + k0);
                                int nv = tq - k0 + 1; nv = nv < 0 ? 0 : (nv > 8 ? 8 : nv); const unsigned vm = (1u << nv) - 1u; unsigned am = 0u, cm = 0u;
#pragma unroll
                                for (int j = 0; j < 8; ++j) { const unsigned w = (j < 2) ? hw.x : (j < 4) ? hw.y : (j < 6) ? hw.z : hw.w; const unsigned h = (j & 1) ? (w >> 16) : (w & 0xffffu);
                                    const unsigned bn = bin16(h); am |= (bn > T) ? (1u << j) : 0u; cm |= (bn == T) ? (1u << j) : 0u; }
                                am &= vm; cm &= vm;
                                bmb[64 * ch + lane] = (unsigned char)am;
                                if (__ballot(cm != 0u) != 0ull) p3_append(cm, hw, k0, &QS[q * 8 + 3], cand);
                            } else { ((LAS unsigned*)bmb)[16 * ch + (lane & 15)] = 0u; }
                        }
                    }
                }
                if (qq == 0) P3_LOADSC(2 * wave + 1);
                if (defer) continue;
                WAVE_SYNC();
                if (c <= 64u) {
                    const bool in = (unsigned)lane < c; const unsigned k32 = in ? cand[2 * lane] : 0u, ki = in ? (cand[2 * lane + 1] & 8191u) : 0u; unsigned rank = 0u;
                    for (unsigned j = 0; j < c; ++j) { const unsigned kj = (unsigned)__builtin_amdgcn_readlane((int)k32, (int)j), ij = (unsigned)__builtin_amdgcn_readlane((int)ki, (int)j); rank += (kj > k32 || (kj == k32 && ij < ki)) ? 1u : 0u; }
                    if (in && rank < needA) __hip_atomic_fetch_or(&bmq[ki >> 5], 1u << (ki & 31), __ATOMIC_RELAXED, __HIP_MEMORY_SCOPE_WORKGROUP);
                } else {
                for (unsigned i0 = 0; i0 < c; i0 += 64) { const unsigned i = i0 + lane; const bool in = i < c; const unsigned k32 = in ? cand[2 * i] : 0u, ki = in ? (cand[2 * i + 1] & 8191u) : 0u; unsigned rank = 0u;
                    for (unsigned j = 0; j < c; ++j) { const unsigned kj = cand[2 * j], ij = cand[2 * j + 1]; rank += (kj > k32 || (kj == k32 && ij < ki)) ? 1u : 0u; }
                    if (in && rank < needA) __hip_atomic_fetch_or(&bmq[ki >> 5], 1u << (ki & 31), __ATOMIC_RELAXED, __HIP_MEMORY_SCOPE_WORKGROUP); }
                }
                WAVE_SYNC();
                unsigned w0 = bmq[4 * lane], w1 = bmq[4 * lane + 1], w2 = bmq[4 * lane + 2], w3 = bmq[4 * lane + 3];
                const unsigned mycnt = __popc(w0) + __popc(w1) + __popc(w2) + __popc(w3);
                unsigned incl = mycnt;
#pragma unroll
                for (int o = 1; o < 64; o <<= 1) { const unsigned v = __shfl_up(incl, o); if (lane >= o) incl += v; }
                unsigned pos = incl - mycnt; int* sel = SEL + (size_t)(row0 + q) * TOPK;
#pragma unroll
                for (int wi = 0; wi < 4; ++wi) { unsigned w = (wi == 0) ? w0 : (wi == 1) ? w1 : (wi == 2) ? w2 : w3;
                    while (w) { const int bit = __ffs((int)w) - 1; if (pos < (unsigned)TOPK) sel[pos] = 128 * lane + 32 * wi + bit; ++pos; w &= w - 1u; } }
                WAVE_SYNC();
            }
#undef P3_LOADSC
            __syncthreads();
        }
    }
    __syncthreads();
    const unsigned nfb = FBL[0];
    for (unsigned k = 0; k < nfb && k < 63u; ++k) { const int r0 = (int)FBL[1 + k]; __syncthreads(); p3_query_naive(ws, lds, r0, SEL); }
}

typedef short v4i16_t __attribute__((ext_vector_type(4)));
typedef int v4i __attribute__((ext_vector_type(4)));
__device__ __forceinline__ v4i16_t tr16(LAS unsigned char* p) { return __builtin_amdgcn_ds_read_tr16_b64_v4i16((LAS v4i16_t*)p); }
typedef __bf16 bf16x2_t __attribute__((ext_vector_type(2)));
__device__ __forceinline__ unsigned dq2(unsigned w, bool hi) { return __builtin_bit_cast(unsigned, hi ? __builtin_amdgcn_cvt_scalef32_pk_bf16_fp8(w, 1.0f, true) : __builtin_amdgcn_cvt_scalef32_pk_bf16_fp8(w, 1.0f, false)); }
__device__ __forceinline__ bf16x8 dq8(unsigned w0, unsigned w1) { return __builtin_bit_cast(bf16x8, (v4u){dq2(w0, false), dq2(w0, true), dq2(w1, false), dq2(w1, true)}); }
__device__ __forceinline__ void p4_dsa(Frame& F) {
    unsigned char* ws = F.ws; const int lane = F.lane, nh = lane & 15, kg = lane >> 4;
    const bf16* QF = (const bf16*)(ws + WS_QF); const unsigned char* KV8 = (const unsigned char*)(ws + WS_KVF); const int* SEL = (const int*)(ws + WS_SEL); bf16* AO = (bf16*)(ws + WS_AO);
    LAS unsigned char* wl = F.lds + F.wave * 10240; LAS int* selw = (LAS int*)wl; LAS unsigned char* vb = wl + 1024;
    const int gw = F.wave * F.G + F.bid, NGW = F.G * NWAVES;
    LAS unsigned char* trp = vb + (4 * kg + ((lane >> 2) & 3)) * 288 + 8 * (lane & 3);
#pragma unroll 1
    for (int combo = 0; combo < BATCH * NKV; ++combo) {
        const int b = combo >> 1, kvh = combo & 1;
        const unsigned char* kvb = KV8 + (size_t)(b * NKV + kvh) * SEQ * 256;
#pragma unroll 1
        for (int t = gw; t < SEQ; t += NGW) {
            const int row = (b << 13) + t; const int cnt = (t + 1 < TOPK) ? (t + 1) : TOPK;
            *(LAS v4i*)(selw + 4 * lane) = *(const v4i*)(SEL + (size_t)row * TOPK + 4 * lane);
            WAVE_SYNC();
            const unsigned char* qp = (const unsigned char*)QF + (size_t)row * D + (kvh * 4 + (nh & 3)) * HD + 32 * kg;
            pg8::i32x8 q8;
            { const v4i qa = *(const v4i*)qp, qb = *(const v4i*)(qp + 16); q8 = __builtin_shufflevector(qa, qb, 0, 1, 2, 3, 4, 5, 6, 7); if (nh >= 4) q8 = (pg8::i32x8){0, 0, 0, 0, 0, 0, 0, 0}; }
            f32x4 S[16];
            v4u kq[2][4][2];
#define P4_LOADK(buf, batch) do { _Pragma("unroll") for (int tt = 0; tt < 4; ++tt) { const unsigned char* kp_ = kvb + (size_t)(selw[16 * (4 * (batch) + tt) + nh] & (SEQ - 1)) * 256 + 32 * kg; \
                kq[buf][tt][0] = *(const v4u*)(kp_); kq[buf][tt][1] = *(const v4u*)(kp_ + 16); } } while (0)
            P4_LOADK(0, 0);
#pragma unroll
            for (int bt = 0; bt < 4; ++bt) {
                if (bt < 3) P4_LOADK((bt + 1) & 1, bt + 1);
                asm volatile("" ::: "memory");
#pragma unroll
                for (int tt = 0; tt < 4; ++tt) {
                    const pg8::i32x8 k8 = __builtin_shufflevector(__builtin_bit_cast(v4i, kq[bt & 1][tt][0]), __builtin_bit_cast(v4i, kq[bt & 1][tt][1]), 0, 1, 2, 3, 4, 5, 6, 7);
                    S[4 * bt + tt] = __builtin_amdgcn_mfma_scale_f32_16x16x128_f8f6f4(k8, q8, (f32x4){0.f, 0.f, 0.f, 0.f}, 0, 0, 0, 0, 0, 0);
                }
            }
#undef P4_LOADK
            v4u g[3][4];
#define P4_LOADV(buf, c_) do { _Pragma("unroll") for (int i = 0; i < 4; ++i) { const int key_ = selw[32 * (c_) + (lane >> 3) + 8 * i] & (SEQ - 1); g[buf][i] = *(const v4u*)(kvb + (size_t)key_ * 256 + 128 + 16 * (lane & 7)); } } while (0)
            P4_LOADV(0, 0); P4_LOADV(1, 1); P4_LOADV(2, 2);
            float mx = -INFINITY;
#pragma unroll
            for (int T = 0; T < 16; ++T)
#pragma unroll
                for (int r = 0; r < 4; ++r) { const float v = (16 * T + 4 * kg + r < cnt) ? S[T][r] : -INFINITY; S[T][r] = v; mx = fmaxf(mx, v); }
            mx = fmaxf(mx, __shfl_xor(mx, 16)); mx = fmaxf(mx, __shfl_xor(mx, 32));
            float sum = 0.f;
#pragma unroll
            for (int T = 0; T < 16; ++T)
#pragma unroll
                for (int r = 0; r < 4; ++r) { const float e = __builtin_amdgcn_exp2f((S[T][r] - mx) * (1.0f / P4_QS)); S[T][r] = e; sum += e; }
            sum += __shfl_xor(sum, 16); sum += __shfl_xor(sum, 32);
            bf16x8 pa[8];
#pragma unroll
            for (int c = 0; c < 8; ++c) { v4u pw; pw.x = pg8::cvt_pk_bf16(S[2 * c][0], S[2 * c][1]); pw.y = pg8::cvt_pk_bf16(S[2 * c][2], S[2 * c][3]); pw.z = pg8::cvt_pk_bf16(S[2 * c + 1][0], S[2 * c + 1][1]); pw.w = pg8::cvt_pk_bf16(S[2 * c + 1][2], S[2 * c + 1][3]); pa[c] = __builtin_bit_cast(bf16x8, pw); }
            f32x4 O[8];
#pragma unroll
            for (int d = 0; d < 8; ++d) O[d] = (f32x4){0.f, 0.f, 0.f, 0.f};
#pragma unroll
            for (int c = 0; c < 8; ++c) {
#pragma unroll
                for (int i = 0; i < 4; ++i) { const v4u gg = g[c % 3][i]; LAS unsigned char* dst = vb + ((lane >> 3) + 8 * i) * 288 + 32 * (lane & 7);
                    *(LAS v4u*)dst = __builtin_bit_cast(v4u, dq8(gg.x, gg.y)); *(LAS v4u*)(dst + 16) = __builtin_bit_cast(v4u, dq8(gg.z, gg.w)); }
                asm volatile("" ::: "memory");
                if (c < 5) P4_LOADV(c % 3, c + 3);
#pragma unroll
                for (int d = 0; d < 8; ++d) {
                    const v4i16_t lo = tr16(trp + 32 * d), hi4 = tr16(trp + 16 * 288 + 32 * d);
                    const bf16x8 vfr = (bf16x8){lo[0], lo[1], lo[2], lo[3], hi4[0], hi4[1], hi4[2], hi4[3]};
                    O[d] = __builtin_amdgcn_mfma_f32_16x16x32_bf16(pa[c], vfr, O[d], 0, 0, 0);
                }
            }
#undef P4_LOADV
            const float i0 = 1.0f / __builtin_bit_cast(float, __builtin_amdgcn_readlane(__builtin_bit_cast(int, sum), 0)), i1 = 1.0f / __builtin_bit_cast(float, __builtin_amdgcn_readlane(__builtin_bit_cast(int, sum), 1));
            const float i2 = 1.0f / __builtin_bit_cast(float, __builtin_amdgcn_readlane(__builtin_bit_cast(int, sum), 2)), i3 = 1.0f / __builtin_bit_cast(float, __builtin_amdgcn_readlane(__builtin_bit_cast(int, sum), 3));
            LAS bf16* ost = (LAS bf16*)vb;
            if (kg == 0) {
#pragma unroll
                for (int d = 0; d < 8; ++d) { ost[0 * 128 + 16 * d + nh] = (bf16)f2bf(O[d][0] * i0); ost[1 * 128 + 16 * d + nh] = (bf16)f2bf(O[d][1] * i1); ost[2 * 128 + 16 * d + nh] = (bf16)f2bf(O[d][2] * i2); ost[3 * 128 + 16 * d + nh] = (bf16)f2bf(O[d][3] * i3); }
            }
            WAVE_SYNC();
            const v4u ov = *(LAS v4u*)(vb + 16 * lane);
            *(v4u*)(AO + (size_t)row * D + (kvh * 4 + kg) * HD + 8 * nh) = ov;
            WAVE_SYNC();
        }
    }
}

__device__ __forceinline__ void p9_sb(Frame& F) {
    unsigned char* ws = F.ws; const int lane = F.lane, n = lane & 31, hi = lane >> 5;
    const bf16* KQ = (const bf16*)(ws + WS_KQ); const bf16* VT = (const bf16*)(ws + WS_VT); bf16* AO = (bf16*)(ws + WS_AO);
    const int gw = F.wave * F.G + F.bid, NGW = F.G * NWAVES;
    const int koff = 16 * (n >> 4) + 8 * ((n >> 2) & 1) + 4 * ((n >> 3) & 1) + (n & 3);
    constexpr float LOG2E = 1.4426950408889634f, LN2 = 0.6931471805599453f;
    for (int u = gw; u < (M / 32) * NH; u += NGW) {
        const int h = u & 7, blk = u >> 3, b = blk >> 8, qb = blk & 255, q0 = 32 * qb, t = q0 + n;
        const bf16* qp = KQ + (size_t)(b * SEQ + q0 + n) * 2048 + 1024 + h * HD + 64 * hi;
        bf16x8 qf[8];
#pragma unroll
        for (int s = 0; s < 8; ++s) qf[s] = *(const bf16x8*)(qp + 8 * s);
        f32x16 o[4];
#pragma unroll
        for (int mt = 0; mt < 4; ++mt)
#pragma unroll
            for (int r = 0; r < 16; ++r) o[mt][r] = 0.f;
        float C = 0.f;
        bf16x8 kf[8];
        { const bf16* kp = KQ + (size_t)(b * SEQ + 32 * qb + koff) * 2048 + h * HD + 64 * hi;
#pragma unroll
          for (int s = 0; s < 8; ++s) kf[s] = *(const bf16x8*)(kp + 8 * s); }
        for (int kb = qb; kb >= 0; --kb) {
            const int k0 = 32 * kb;
            bf16x8 vf[4][2];
#pragma unroll
            for (int mt = 0; mt < 4; ++mt)
#pragma unroll
                for (int sp = 0; sp < 2; ++sp) vf[mt][sp] = *(const bf16x8*)(VT + (size_t)(h * HD + 32 * mt + n) * M + b * SEQ + k0 + 16 * sp + 8 * hi);
            f32x16 z;
#pragma unroll
            for (int r = 0; r < 16; ++r) z[r] = 0.f;
#pragma unroll
            for (int s = 0; s < 8; ++s) z = __builtin_amdgcn_mfma_f32_32x32x16_bf16(kf[s], qf[s], z, 0, 0, 0);
            { const int kn = (kb > 0) ? kb - 1 : 0; const bf16* kp = KQ + (size_t)(b * SEQ + 32 * kn + koff) * 2048 + h * HD + 64 * hi;
#pragma unroll
              for (int s = 0; s < 8; ++s) kf[s] = *(const bf16x8*)(kp + 8 * s); }
            float lk[16], lb[16];
#pragma unroll
            for (int r = 0; r < 16; ++r) {
                const int key = k0 + ((r < 8) ? (8 * hi + r) : (16 + 8 * hi + (r - 8)));
                const float zz = z[r]; const float L = __builtin_amdgcn_logf(1.0f + __builtin_amdgcn_exp2f(-fabsf(zz) * LOG2E)) * LN2;
                const bool valid = key < t;
                lk[r] = valid ? (-fmaxf(zz, 0.f) - L) : 0.f;
                lb[r] = valid ? (fminf(zz, 0.f) - L) : -INFINITY;
            }
            float suf[16];
            suf[7] = 0.f; suf[15] = 0.f;
#pragma unroll
            for (int i = 6; i >= 0; --i) { suf[i] = suf[i + 1] + lk[i + 1]; suf[8 + i] = suf[9 + i] + lk[9 + i]; }
            const float T0 = suf[0] + lk[0], T1 = suf[8] + lk[8];
            const float P0 = __shfl_xor(T0, 32), P1 = __shfl_xor(T1, 32);
            const float base1 = C + (hi ? 0.f : P1), base0 = C + (hi ? (T1 + P1) : (P0 + T1 + P1));
            unsigned pw[8];
#pragma unroll
            for (int r = 0; r < 16; r += 2) {
                const float a0 = __builtin_amdgcn_exp2f((lb[r] + ((r < 8) ? base0 : base1) + suf[r]) * LOG2E), a1 = __builtin_amdgcn_exp2f((lb[r + 1] + ((r < 8) ? base0 : base1) + suf[r + 1]) * LOG2E);
                pw[r >> 1] = pg8::cvt_pk_bf16(a0, a1);
            }
            C += (T0 + T1) + (P0 + P1);
            const bf16x8 pa0 = __builtin_bit_cast(bf16x8, (v4u){pw[0], pw[1], pw[2], pw[3]}), pa1 = __builtin_bit_cast(bf16x8, (v4u){pw[4], pw[5], pw[6], pw[7]});
#pragma unroll
            for (int mt = 0; mt < 4; ++mt) { o[mt] = __builtin_amdgcn_mfma_f32_32x32x16_bf16(vf[mt][0], pa0, o[mt], 0, 0, 0); o[mt] = __builtin_amdgcn_mfma_f32_32x32x16_bf16(vf[mt][1], pa1, o[mt], 0, 0, 0); }
            if (__all(C < -44.0f)) break;
        }
        bf16* op = AO + (size_t)(b * SEQ + q0 + n) * D + h * HD + 4 * hi;
#pragma unroll
        for (int mt = 0; mt < 4; ++mt)
#pragma unroll
            for (int g = 0; g < 4; ++g) { v2u w; w.x = pg8::cvt_pk_bf16(o[mt][4 * g], o[mt][4 * g + 1]); w.y = pg8::cvt_pk_bf16(o[mt][4 * g + 2], o[mt][4 * g + 3]); *(v2u*)(op + 32 * mt + 8 * g) = w; }
    }
}

__device__ __forceinline__ void p11_router(Frame& F) {
    unsigned char* ws = F.ws; const int tid = F.tid, lane = F.lane, wave = F.wave;
    const float* H = (const float*)(ws + WS_H); const float* gn = F.in[IN_FFNNORM] + D; const float* Wr = F.in[IN_ROUTER];
    int* TOPE = (int*)(ws + WS_RT); int* POS = (int*)(ws + WS_RT + 128 * 1024); float* GATE = (float*)(ws + WS_RT + 256 * 1024); float* RSTD3 = (float*)(ws + WS_RT + 384 * 1024);
    LAS unsigned* lcnt = (LAS unsigned*)F.lds;
    LAS unsigned* gb = (LAS unsigned*)(F.lds + 64);
    LAS int* ltok = (LAS int*)(F.lds + 128);
    LAS float* lgt = (LAS float*)(F.lds + 128 + 1024);
    for (int chunk = F.bid; chunk < M / 64; chunk += F.G) {
        if (tid < 8) lcnt[tid] = 0u;
        __syncthreads();
        for (int r = 0; r < 8; ++r) {
            const int row = chunk * 64 + wave * 8 + r;
            const GAS f32x4* xr = (const GAS f32x4*)(H + (size_t)row * D) + lane; f32x4 v[4]; float ss = 0.f;
#pragma unroll
            for (int j = 0; j < 4; ++j) { v[j] = xr[64 * j]; ss += (v[j].x * v[j].x + v[j].y * v[j].y) + (v[j].z * v[j].z + v[j].w * v[j].w); }
            ss = wave_sum(ss); const float rs = 1.0f / sqrtf(ss * (1.0f / 1024.0f) + 1e-6f);
            float lg[8] = {0.f, 0.f, 0.f, 0.f, 0.f, 0.f, 0.f, 0.f};
#pragma unroll
            for (int j = 0; j < 4; ++j)
#pragma unroll
                for (int i = 0; i < 4; ++i) { const int k = 256 * j + 4 * lane + i; const float xv = v[j][i] * gn[k]; const f32x4 w0 = *(const f32x4*)(Wr + (size_t)k * 8), w1 = *(const f32x4*)(Wr + (size_t)k * 8 + 4);
                    lg[0] += xv * w0[0]; lg[1] += xv * w0[1]; lg[2] += xv * w0[2]; lg[3] += xv * w0[3]; lg[4] += xv * w1[0]; lg[5] += xv * w1[1]; lg[6] += xv * w1[2]; lg[7] += xv * w1[3]; }
#pragma unroll
            for (int e = 0; e < 8; ++e) lg[e] = wave_sum(lg[e]) * rs;
            int i1 = 0; float l1 = lg[0];
#pragma unroll
            for (int e = 1; e < 8; ++e) if (lg[e] > l1) { l1 = lg[e]; i1 = e; }
            int i2 = -1; float l2 = -INFINITY;
#pragma unroll
            for (int e = 0; e < 8; ++e) if (e != i1 && lg[e] > l2) { l2 = lg[e]; i2 = e; }
            const float g1 = 1.0f / (1.0f + __expf(l2 - l1)), g2 = 1.0f - g1;
            if (lane == 0) {
                const unsigned p1 = __hip_atomic_fetch_add(&lcnt[i1], 1u, __ATOMIC_RELAXED, __HIP_MEMORY_SCOPE_WORKGROUP), p2 = __hip_atomic_fetch_add(&lcnt[i2], 1u, __ATOMIC_RELAXED, __HIP_MEMORY_SCOPE_WORKGROUP);
                const int ti = wave * 8 + r; ltok[ti * 4 + 0] = i1; ltok[ti * 4 + 1] = i2; ltok[ti * 4 + 2] = (int)p1; ltok[ti * 4 + 3] = (int)p2;
                lgt[ti * 4 + 0] = g1; lgt[ti * 4 + 1] = g2; lgt[ti * 4 + 2] = rs;
            }
        }
        __syncthreads();
        if (tid < 8) gb[tid] = __hip_atomic_fetch_add(F.ctl + CW_CNT + tid, lcnt[tid], RLX_AGENT);
        __syncthreads();
        if (tid < 64) { const int row = chunk * 64 + tid; const int e1 = ltok[tid * 4], e2 = ltok[tid * 4 + 1];
            TOPE[row * 2] = e1; TOPE[row * 2 + 1] = e2; POS[row * 2] = (int)gb[e1] + ltok[tid * 4 + 2]; POS[row * 2 + 1] = (int)gb[e2] + ltok[tid * 4 + 3];
            GATE[row * 2] = lgt[tid * 4]; GATE[row * 2 + 1] = lgt[tid * 4 + 1]; RSTD3[row] = lgt[tid * 4 + 2]; }
        __syncthreads();
    }
}
__device__ __forceinline__ void moe_bases(Frame& F, int (&tb)[9]) {
    int acc = 0;
#pragma unroll
    for (int e = 0; e < 8; ++e) { tb[e] = acc; const unsigned c = __hip_atomic_load(F.ctl + CW_CNT + e, RLX_AGENT); acc += (int)((c + 255u) >> 8); }
    tb[8] = acc;
}
__device__ __forceinline__ void p12_permute(Frame& F) {
    unsigned char* ws = F.ws; const int lane = F.lane;
    const int* TOPE = (const int*)(ws + WS_RT); const int* POS = (const int*)(ws + WS_RT + 128 * 1024); const float* RSTD3 = (const float*)(ws + WS_RT + 384 * 1024);
    int* SLOT = (int*)(ws + WS_RT + 512 * 1024);
    const float* H = (const float*)(ws + WS_H); bf16* XP = (bf16*)(ws + WS_XPERM);
    int tb[9]; moe_bases(F, tb);
    const int gw = F.wave * F.G + F.bid, NGW = F.G * NWAVES;
    for (int i = gw; i < 2 * M; i += NGW) {
        const int row = i >> 1; const int e = TOPE[i]; int base = 0;
#pragma unroll
        for (int k = 0; k < 8; ++k) base = (e == k) ? tb[k] : base;
        const int slot = base * 256 + POS[i];
        const float rs = RSTD3[row];
        const GAS f32x4* src = (const GAS f32x4*)(H + (size_t)row * D) + lane; GAS unsigned* dst = (GAS unsigned*)((unsigned char*)XP + (size_t)slot * D) + lane;
        const float r16 = rs * pg8::F8_SX;
#pragma unroll
        for (int j = 0; j < 4; ++j) { const f32x4 v = src[64 * j]; dst[64 * j] = pg8::pk4_fp8(v.x * r16, v.y * r16, v.z * r16, v.w * r16); }
        if (lane == 0) SLOT[i] = slot;
    }
}
__device__ __forceinline__ void p15_combine(Frame& F) {
    unsigned char* ws = F.ws; const int lane = F.lane;
    const float* H = (const float*)(ws + WS_H); const bf16* Y = (const bf16*)(ws + WS_Y); const int* SLOT = (const int*)(ws + WS_RT + 512 * 1024); const float* GATE = (const float*)(ws + WS_RT + 256 * 1024);
    const int gw = F.wave * F.G + F.bid, NGW = F.G * NWAVES;
    for (int row = gw; row < M; row += NGW) {
        const int s1 = SLOT[row * 2], s2 = SLOT[row * 2 + 1]; const float g1 = GATE[row * 2], g2 = GATE[row * 2 + 1];
        const GAS f32x4* hr = (const GAS f32x4*)(H + (size_t)row * D) + lane; GAS f32x4* orow = (GAS f32x4*)(F.out + (size_t)row * D) + lane;
        const GAS v2u* y1 = (const GAS v2u*)(Y + (size_t)s1 * D) + lane; const GAS v2u* y2 = (const GAS v2u*)(Y + (size_t)s2 * D) + lane;
#pragma unroll
        for (int j = 0; j < 4; ++j) { const f32x4 h = __builtin_nontemporal_load(hr + 64 * j); const v2u a = __builtin_nontemporal_load(y1 + 64 * j), c = __builtin_nontemporal_load(y2 + 64 * j); f32x4 o;
            o.x = h.x + (g1 * bflo(a.x) + g2 * bflo(c.x)); o.y = h.y + (g1 * bfhi(a.x) + g2 * bfhi(c.x)); o.z = h.z + (g1 * bflo(a.y) + g2 * bflo(c.y)); o.w = h.w + (g1 * bfhi(a.y) + g2 * bfhi(c.y)); orow[64 * j] = o; }
    }
}

constexpr int N_PHASES = 16;
#ifndef MK_ONE_LAUNCH
#define MK_ONE_LAUNCH 1
#endif
struct Args { const float* in[17]; float* out; unsigned char* ws; int ph_lo, ph_hi; };
__global__ void __launch_bounds__(NWAVES * 64, 2) yoco_fwd(Args args) {
    extern __shared__ __attribute__((aligned(16))) unsigned char lds[];
    Frame F;
    F.lds = (LAS unsigned char*)lds; F.MISC = (volatile LAS unsigned*)(F.lds + MISC_OFF);
    F.tid = threadIdx.x; F.lane = F.tid & 63; F.wave = __builtin_amdgcn_readfirstlane(F.tid >> 6); F.G = gridDim.x; F.bid = blockIdx.x;
    F.ws = args.ws; F.ctl = (gu32*)(args.ws + WS_CTL); F.out = args.out;
#pragma unroll
    for (int i = 0; i < 17; ++i) F.in[i] = args.in[i];
    for (int u = F.tid; u < (LDS_BYTES - LDSCTL_OFF) / 4; u += NWAVES * 64) ((LAS unsigned*)(F.lds + LDSCTL_OFF))[u] = 0u;
    __syncthreads();
    unsigned char* ws = args.ws;
    XcdBarrier bar; bar.bar = (unsigned*)(F.ctl + CW_BAR); bar.x = 0; bar.st = nullptr;
    if (MK_ONE_LAUNCH) bar = xcd_barrier_post((unsigned*)(F.ctl + CW_BAR), F.MISC + 8);
    const int lo = args.ph_lo, hi = args.ph_hi;
#define IN(k) (lo <= (k) && (k) < hi)
#define SEAM(k) do { if (MK_ONE_LAUNCH && IN((k) + 1)) xcd_barrier(bar); } while (0)
    bf16* XB = (bf16*)(ws + WS_XB); float* H = (float*)(ws + WS_H); bf16* AO = (bf16*)(ws + WS_AO);

    if (IN(0)) { p0_prologue(F); SEAM(0); }
    if (IN(1)) {
        pg8::Gemm g{XB, (const bf16*)(ws + WS_WIN), M, 2048, D}; pg8::StaticOrder S; S.init(M, 2048, F.G, F.bid);
        pg8::EpiProj E{ws + WS_QF, ws + WS_KVF, (bf16*)(ws + WS_QIF), F.in[IN_AQN], F.in[IN_AKN], (const unsigned*)(ws + WS_ROPE), (LAS float*)(F.lds + PS_OFF), QSCALE * P4_QS};
        pg8::gemm_phase<pg8::EpiProj, pg8::StaticOrder, true, true>(F.lds, g, S, E); SEAM(1); }
    if (IN(2)) { p2_post(F); SEAM(2); }
    if (IN(3)) { p3_index(F); SEAM(3); }
    if (IN(4)) { p4_dsa(F); SEAM(4); }
    if (IN(5)) {
        pg8::Gemm g{AO, (const bf16*)(ws + WS_WOA), M, D, D}; pg8::StaticOrder S; S.init(M, D, F.G, F.bid);
        pg8::EpiResid<true> E{F.in[IN_X], H, XB, (float*)(ws + WS_SS1), 1.0f};
        pg8::gemm_phase<pg8::EpiResid<true>, pg8::StaticOrder, true, true>(F.lds, g, S, E); SEAM(5); }
    if (IN(6)) {
        pg8::Gemm g{XB, (const bf16*)(ws + WS_WGU), M, 2 * FF, D / 2}; pg8::StaticOrder S; S.init(M, 2 * FF, F.G, F.bid);
        pg8::EpiSwiGLU8<false> E{ws + WS_HF, FF, (const float*)(ws + WS_SS1)};
        pg8::gemm_phase<pg8::EpiSwiGLU8<false>, pg8::StaticOrder, true, true, true>(F.lds, g, S, E); SEAM(6); }
    if (IN(7)) {
        pg8::Gemm g{(const bf16*)(ws + WS_HF), (const bf16*)(ws + WS_WD), M, D, FF / 2}; pg8::StaticOrder S; S.init(M, D, F.G, F.bid);
        pg8::EpiResid<false> E{H, H, XB, (float*)(ws + WS_SS2), 1.0f / (pg8::F8_SH * pg8::F8_SWD)};
        pg8::gemm_phase<pg8::EpiResid<false>, pg8::StaticOrder, true, true, true>(F.lds, g, S, E); SEAM(7); }
    if (IN(8)) {
        { pg8::Gemm g{XB, (const bf16*)(ws + WS_WKVQ), M, 2048, D}; pg8::StaticOrder S; S.init(M, 2048, F.G, F.bid);
          pg8::EpiScaleBf16 E{(bf16*)(ws + WS_KQ), 2048, (const float*)(ws + WS_SS2)};
          pg8::gemm_phase<pg8::EpiScaleBf16, pg8::StaticOrder, true, true>(F.lds, g, S, E); }
        { pg8::Gemm g{(const bf16*)(ws + WS_WKVQ) + (size_t)2048 * D, XB, D, M, D}; pg8::StaticOrder S; S.init(D, M, F.G, F.bid);
          pg8::EpiScaleColBf16 E{(bf16*)(ws + WS_VT), M, (const float*)(ws + WS_SS2)};
          pg8::gemm_phase<pg8::EpiScaleColBf16, pg8::StaticOrder, true, true>(F.lds, g, S, E); }
        SEAM(8); }
    if (IN(9)) { p9_sb(F); SEAM(9); }
    if (IN(10)) {
        pg8::Gemm g{AO, (const bf16*)(ws + WS_WOB), M, D, D}; pg8::StaticOrder S; S.init(M, D, F.G, F.bid);
        pg8::EpiResid<false> E{H, H, XB, (float*)(ws + WS_SS3), 1.0f};
        pg8::gemm_phase<pg8::EpiResid<false>, pg8::StaticOrder, true, true>(F.lds, g, S, E); SEAM(10); }
    if (IN(11)) { p11_router(F); SEAM(11); }
    if (IN(12)) { p12_permute(F); SEAM(12); }
    if (IN(13)) {
        pg8::MoeOrder S; moe_bases(F, S.tb); S.npn = 22; S.G = F.G; S.c = F.bid;
        pg8::Gemm g{(const bf16*)(ws + WS_XPERM), (const bf16*)(ws + WS_WGUM), MAXSLOT, NE * 2 * FF, D / 2};
        pg8::EpiSwiGLU8<true> E{ws + WS_HM, FF, nullptr};
        pg8::gemm_phase<pg8::EpiSwiGLU8<true>, pg8::MoeOrder, true, true, true>(F.lds, g, S, E); SEAM(13); }
    if (IN(14)) {
        pg8::MoeOrder S; moe_bases(F, S.tb); S.npn = 4; S.G = F.G; S.c = F.bid;
        pg8::Gemm g{(const bf16*)(ws + WS_HM), (const bf16*)(ws + WS_WDM), MAXSLOT, NE * D, FF / 2};
        pg8::EpiScaledBf16 E{(bf16*)(ws + WS_Y), D, 3, 1.0f / (pg8::F8_SH * pg8::F8_SWD)};
        pg8::gemm_phase<pg8::EpiScaledBf16, pg8::MoeOrder, true, true, true>(F.lds, g, S, E); SEAM(14); }
    if (IN(15)) { p15_combine(F); }
#undef IN
#undef SEAM
}

extern "C" void kernel_launch(void* const* d_in, const int* in_sizes, int n_in, void* d_out, int out_size, void* d_ws, size_t ws_size, hipStream_t stream) {
    static int grid = 0;
    if (grid == 0) {
        if (n_in != 17 || out_size != M * D || ws_size < WS_END) { fprintf(stderr, "kernel_launch: unexpected problem (n_in %d, out %d, ws %zu < %zu)\n", n_in, out_size, ws_size, (size_t)WS_END); grid = -1; return; }
        int dev = 0, cus = 0, per_cu = 0;
        if (hipGetDevice(&dev) != hipSuccess || hipDeviceGetAttribute(&cus, hipDeviceAttributeMultiprocessorCount, dev) != hipSuccess) { grid = -1; return; }
        if (hipFuncSetAttribute((const void*)yoco_fwd, hipFuncAttributeMaxDynamicSharedMemorySize, LDS_BYTES) != hipSuccess) { fprintf(stderr, "kernel_launch: hipFuncSetAttribute failed\n"); grid = -1; return; }
        if (hipOccupancyMaxActiveBlocksPerMultiprocessor(&per_cu, (const void*)yoco_fwd, NWAVES * 64, LDS_BYTES) != hipSuccess || per_cu < 1) fprintf(stderr, "kernel_launch: occupancy query says %d\n", per_cu);
        (void)hipGetLastError();
        grid = cus < 256 ? cus : 256;
    }
    if (grid < 0) return;
    if (hipMemsetAsync((char*)d_ws + WS_CTL, 0, CTL_ZERO_BYTES, stream) != hipSuccess) return;
    Args a{};
    for (int i = 0; i < 17; ++i) a.in[i] = (const float*)d_in[i];
    a.out = (float*)d_out; a.ws = (unsigned char*)d_ws;
#if MK_ONE_LAUNCH
    a.ph_lo = 0; a.ph_hi = N_PHASES;
    hipLaunchKernelGGL(yoco_fwd, dim3(grid), dim3(NWAVES * 64), LDS_BYTES, stream, a);
#else
    for (int p = 0; p < N_PHASES; ++p) { a.ph_lo = p; a.ph_hi = p + 1; hipLaunchKernelGGL(yoco_fwd, dim3(grid), dim3(NWAVES * 64), LDS_BYTES, stream, a); }
#endif
}
```

```cpp
#include <hip/hip_runtime.h>
#include <cstdio>
#include <cstdint>
namespace pg8 {
#define PG8_LAS __attribute__((address_space(3)))
typedef unsigned short bf16_t;
typedef short bf16x8 __attribute__((ext_vector_type(8)));
typedef float f32x4 __attribute__((ext_vector_type(4)));
typedef unsigned u32x4 __attribute__((ext_vector_type(4)));
typedef int i32x4 __attribute__((ext_vector_type(4)));
typedef int i32x8 __attribute__((ext_vector_type(8)));
constexpr int BM = 256, BK = 64, HALF = 128, HTB = HALF * BK * 2  , STAGE_BYTES = 8 * HTB, NXCD = 8, WGM = 8;

__host__ __device__ __forceinline__ int lds_byte(int r, int c) { const int st = (r >> 4) * 2 + (c >> 5), rr = r & 15, cc = c & 31, ob = rr * 64 + cc * 2; return st * 1024 + (ob ^ (((ob >> 9) & 1) << 5)); }
__host__ __device__ __forceinline__ void stage_rc(int b, int& R, int& C) { const int st = b / 1024, sb = b % 1024, swz = sb ^ (((sb >> 9) & 1) << 5); R = (st >> 1) * 16 + swz / 64; C = (st & 1) * 32 + (swz % 64) / 2; }
__host__ __device__ __forceinline__ int perm32(int rho) { const int n = rho >> 4, i = rho & 15; return 8 * (i >> 2) + 4 * n + (i & 3); }

struct Unit { int pm, pn; int koff = 0; };
struct Gemm { const bf16_t* A; const bf16_t* Bt; int M, N, K; int ld = 0; };

struct StaticOrder {
    int nM, nN, nwg, G, c;
    __host__ __device__ void init(int M, int N, int G_, int c_) { nM = M / BM; nN = N / BM; nwg = nM * nN; G = G_; c = c_; }
    __host__ __device__ bool next(int i, Unit& u) const {
        const long L = (long)i * G + c; if (L >= nwg) return false;
        int wgid = (int)L; { const int q = nwg / NXCD, r = nwg % NXCD, xcd = wgid % NXCD, off = wgid / NXCD; wgid = (xcd < r ? xcd * (q + 1) : r * (q + 1) + (xcd - r) * q) + off; }
        const int nig = WGM * nN, gid = wgid / nig, fm = gid * WGM, gsz = (nM - fm) < WGM ? (nM - fm) : WGM;
        u.pm = fm + ((wgid % nig) % gsz); u.pn = (wgid % nig) / gsz; return true;
    }
    __device__ __forceinline__ void a_ready(const Unit&) const {}
    __device__ __forceinline__ void done(const Unit&) const {}
};

__device__ __forceinline__ unsigned cvt_pk_bf16(float lo, float hi) { unsigned r; asm volatile("v_cvt_pk_bf16_f32 %0, %1, %2" : "=v"(r) : "v"(lo), "v"(hi)); return r; }
typedef unsigned u32x2 __attribute__((ext_vector_type(2)));
constexpr float RMS_EPS = 1e-6f;
__device__ __forceinline__ float rstd16(const float* p) {
    const f32x4 a = *(const f32x4*)p, b = *(const f32x4*)(p + 4), c = *(const f32x4*)(p + 8), d = *(const f32x4*)(p + 12);
    const float s = (((a[0] + a[1]) + (a[2] + a[3])) + ((b[0] + b[1]) + (b[2] + b[3]))) + (((c[0] + c[1]) + (c[2] + c[3])) + ((d[0] + d[1]) + (d[2] + d[3])));
    return 1.0f / sqrtf(s * (1.0f / 1024.0f) + RMS_EPS);
}
struct EpiScaleBf16 {
    static constexpr bool PERM = true, AFTER_DRAIN = false;
    bf16_t* O; int ldc; const float* ss;
    __device__ __forceinline__ void operator()(const f32x4 (&acc)[2][2][4][2], const Unit& u, int wr, int wc, int fr, int fq) const {
        const int row0 = u.pm * BM + wr * 64 + fr, col0 = u.pn * BM + wc * 32 + 8 * fq;
        float rsv[2][4];
#pragma unroll
        for (int ai = 0; ai < 2; ++ai)
#pragma unroll
            for (int m = 0; m < 4; ++m) rsv[ai][m] = rstd16(ss + (size_t)(row0 + ai * HALF + m * 16) * 16);
#pragma unroll
        for (int ai = 0; ai < 2; ++ai)
#pragma unroll
            for (int m = 0; m < 4; ++m) { const int row = row0 + ai * HALF + m * 16; const float rs = rsv[ai][m]; bf16_t* rowp = O + (size_t)row * ldc + col0;
#pragma unroll
                for (int bj = 0; bj < 2; ++bj) { const f32x4 v0 = acc[ai][bj][m][0] * rs, v1 = acc[ai][bj][m][1] * rs;
                    u32x4 w; w.x = cvt_pk_bf16(v0[0], v0[1]); w.y = cvt_pk_bf16(v0[2], v0[3]); w.z = cvt_pk_bf16(v1[0], v1[1]); w.w = cvt_pk_bf16(v1[2], v1[3]);
                    *(u32x4*)(rowp + bj * HALF) = w; } }
    }
};
struct EpiPlainBf16 {
    static constexpr bool PERM = true, AFTER_DRAIN = false;
    bf16_t* O; int ldc; int pnmask;
    __device__ __forceinline__ void operator()(const f32x4 (&acc)[2][2][4][2], const Unit& u, int wr, int wc, int fr, int fq) const {
        const int row0 = u.pm * BM + wr * 64 + fr, col0 = (u.pn & pnmask) * BM + wc * 32 + 8 * fq;
#pragma unroll
        for (int ai = 0; ai < 2; ++ai)
#pragma unroll
            for (int m = 0; m < 4; ++m) { bf16_t* rowp = O + (size_t)(row0 + ai * HALF + m * 16) * ldc + col0;
#pragma unroll
                for (int bj = 0; bj < 2; ++bj) { const f32x4 v0 = acc[ai][bj][m][0], v1 = acc[ai][bj][m][1];
                    u32x4 w; w.x = cvt_pk_bf16(v0[0], v0[1]); w.y = cvt_pk_bf16(v0[2], v0[3]); w.z = cvt_pk_bf16(v1[0], v1[1]); w.w = cvt_pk_bf16(v1[2], v1[3]);
                    *(u32x4*)(rowp + bj * HALF) = w; } }
    }
};
struct EpiScaleColBf16 {
    static constexpr bool PERM = true, AFTER_DRAIN = false;
    bf16_t* O; int ldc; const float* ss;
    __device__ __forceinline__ void operator()(const f32x4 (&acc)[2][2][4][2], const Unit& u, int wr, int wc, int fr, int fq) const {
        const int row0 = u.pm * BM + wr * 64 + fr, col0 = u.pn * BM + wc * 32 + 8 * fq;
        f32x4 rs[2][2];
#pragma unroll
        for (int bj = 0; bj < 2; ++bj)
#pragma unroll
            for (int n = 0; n < 2; ++n)
#pragma unroll
                for (int e = 0; e < 4; ++e) rs[bj][n][e] = rstd16(ss + (size_t)(col0 + bj * HALF + 4 * n + e) * 16);
#pragma unroll
        for (int ai = 0; ai < 2; ++ai)
#pragma unroll
            for (int m = 0; m < 4; ++m) { const int row = row0 + ai * HALF + m * 16; bf16_t* rowp = O + (size_t)row * ldc + col0;
#pragma unroll
                for (int bj = 0; bj < 2; ++bj) { const f32x4 v0 = acc[ai][bj][m][0] * rs[bj][0], v1 = acc[ai][bj][m][1] * rs[bj][1];
                    u32x4 w; w.x = cvt_pk_bf16(v0[0], v0[1]); w.y = cvt_pk_bf16(v0[2], v0[3]); w.z = cvt_pk_bf16(v1[0], v1[1]); w.w = cvt_pk_bf16(v1[2], v1[3]);
                    *(u32x4*)(rowp + bj * HALF) = w; } }
    }
};
constexpr float F8_SX = 16.f, F8_SWGU = 512.f, F8_SH = 16.f, F8_SWD = 1024.f;
__device__ __forceinline__ unsigned pk4_fp8(float a, float b, float c, float d) {
    a = __builtin_amdgcn_fmed3f(a, -448.f, 448.f); b = __builtin_amdgcn_fmed3f(b, -448.f, 448.f); c = __builtin_amdgcn_fmed3f(c, -448.f, 448.f); d = __builtin_amdgcn_fmed3f(d, -448.f, 448.f);
    int w = __builtin_amdgcn_cvt_pk_fp8_f32(a, b, 0, false); w = __builtin_amdgcn_cvt_pk_fp8_f32(c, d, w, true); return (unsigned)w;
}
template <bool X8, bool BB> struct EpiResid {
    static constexpr bool PERM = false, AFTER_DRAIN = false;
    const void* base; bf16_t* H; unsigned char* XB8; float* ssp; float sc;
    __device__ __forceinline__ void operator()(const f32x4 (&acc)[2][2][4][2], const Unit& u, int wr, int wc, int fr, int fq) const {
        const int row0 = u.pm * BM + wr * 64 + fr, col0 = u.pn * BM + wc * 32 + 4 * fq;
#pragma unroll
        for (int ai = 0; ai < 2; ++ai) {
            f32x4 bv[4][2][2];
#pragma unroll
            for (int m = 0; m < 4; ++m)
#pragma unroll
                for (int bj = 0; bj < 2; ++bj)
#pragma unroll
                    for (int n = 0; n < 2; ++n) { const size_t off = (size_t)(row0 + ai * HALF + m * 16) * 1024 + col0 + bj * HALF + n * 16;
                        if constexpr (BB) { const u32x2 w = *(const u32x2*)((const bf16_t*)base + off);
                            bv[m][bj][n] = (f32x4){__builtin_bit_cast(float, w.x << 16), __builtin_bit_cast(float, w.x & 0xffff0000u), __builtin_bit_cast(float, w.y << 16), __builtin_bit_cast(float, w.y & 0xffff0000u)}; }
                        else bv[m][bj][n] = *(const f32x4*)((const float*)base + off); }
#pragma unroll
            for (int m = 0; m < 4; ++m) { const int row = row0 + ai * HALF + m * 16; float q = 0.f;
#pragma unroll
                for (int bj = 0; bj < 2; ++bj)
#pragma unroll
                    for (int n = 0; n < 2; ++n) { const size_t off = (size_t)row * 1024 + col0 + bj * HALF + n * 16;
                        const f32x4 v = bv[m][bj][n] + acc[ai][bj][m][n] * sc;
                        q += (v[0] * v[0] + v[1] * v[1]) + (v[2] * v[2] + v[3] * v[3]);
                        u32x2 w; w.x = cvt_pk_bf16(v[0], v[1]); w.y = cvt_pk_bf16(v[2], v[3]); *(u32x2*)(H + off) = w;
                        if constexpr (X8) *(unsigned*)(XB8 + off) = pk4_fp8(v[0] * F8_SX, v[1] * F8_SX, v[2] * F8_SX, v[3] * F8_SX); }
                q += __shfl_xor(q, 16); q += __shfl_xor(q, 32);
                if (fq == 0) ssp[(size_t)row * 16 + u.pn * 4 + wc] = q; }
        }
    }
};
__device__ __forceinline__ float silu_mul(float g, float u) { return g * __builtin_amdgcn_rcpf(1.0f + __builtin_amdgcn_exp2f(g * -1.4426950408889634f)) * u; }
template <bool MOE> struct EpiSwiGLU {
    static constexpr bool PERM = true, AFTER_DRAIN = false;
    bf16_t* O; int ldc; const float* ss;
    __device__ __forceinline__ void operator()(const f32x4 (&acc)[2][2][4][2], const Unit& u, int wr, int wc, int fr, int fq) const {
        const int row0 = u.pm * BM + wr * 64 + fr; const int pnl = MOE ? (u.pn % 22) : u.pn; const int col0 = pnl * HALF + wc * 32 + 8 * fq;
        float rsv[2][4];
#pragma unroll
        for (int ai = 0; ai < 2; ++ai)
#pragma unroll
            for (int m = 0; m < 4; ++m) { const int row = row0 + ai * HALF + m * 16; rsv[ai][m] = MOE ? 1.0f : rstd16(ss + (size_t)row * 16); }
#pragma unroll
        for (int ai = 0; ai < 2; ++ai)
#pragma unroll
            for (int m = 0; m < 4; ++m) { const int row = row0 + ai * HALF + m * 16; const float rs = rsv[ai][m];
                const f32x4 g0 = acc[ai][0][m][0] * rs, g1 = acc[ai][0][m][1] * rs, u0 = acc[ai][1][m][0] * rs, u1 = acc[ai][1][m][1] * rs;
                u32x4 w; w.x = cvt_pk_bf16(silu_mul(g0[0], u0[0]), silu_mul(g0[1], u0[1])); w.y = cvt_pk_bf16(silu_mul(g0[2], u0[2]), silu_mul(g0[3], u0[3]));
                w.z = cvt_pk_bf16(silu_mul(g1[0], u1[0]), silu_mul(g1[1], u1[1])); w.w = cvt_pk_bf16(silu_mul(g1[2], u1[2]), silu_mul(g1[3], u1[3]));
                *(u32x4*)(O + (size_t)row * ldc + col0) = w; }
    }
};
template <bool MOE> struct EpiSwiGLU8 {
    static constexpr bool PERM = true, AFTER_DRAIN = false;
    unsigned char* O; int ldc; const float* ss;
    __device__ __forceinline__ void operator()(const f32x4 (&acc)[2][2][4][2], const Unit& u, int wr, int wc, int fr, int fq) const {
        const int row0 = u.pm * BM + wr * 64 + fr; const int col0 = (MOE ? (u.pn % 22) : u.pn) * HALF + wc * 32 + 8 * fq; const float r0 = 1.0f / (F8_SX * F8_SWGU);
        float rsv[2][4];
#pragma unroll
        for (int ai = 0; ai < 2; ++ai)
#pragma unroll
            for (int m = 0; m < 4; ++m) rsv[ai][m] = MOE ? r0 : r0 * rstd16(ss + (size_t)(row0 + ai * HALF + m * 16) * 16);
#pragma unroll
        for (int ai = 0; ai < 2; ++ai)
#pragma unroll
            for (int m = 0; m < 4; ++m) { const int row = row0 + ai * HALF + m * 16; const float rs = rsv[ai][m], rh = rs * F8_SH;
                const f32x4 g0 = acc[ai][0][m][0] * rs, g1 = acc[ai][0][m][1] * rs, u0 = acc[ai][1][m][0] * rh, u1 = acc[ai][1][m][1] * rh;
                u32x2 w; w.x = pk4_fp8(silu_mul(g0[0], u0[0]), silu_mul(g0[1], u0[1]), silu_mul(g0[2], u0[2]), silu_mul(g0[3], u0[3]));
                w.y = pk4_fp8(silu_mul(g1[0], u1[0]), silu_mul(g1[1], u1[1]), silu_mul(g1[2], u1[2]), silu_mul(g1[3], u1[3]));
                *(u32x2*)(O + (size_t)row * ldc + col0) = w; }
    }
};
struct EpiScaledBf16 {
    static constexpr bool PERM = true, AFTER_DRAIN = false;
    bf16_t* O; int ldc; int pnmask; float sc;
    __device__ __forceinline__ void operator()(const f32x4 (&acc)[2][2][4][2], const Unit& u, int wr, int wc, int fr, int fq) const {
        const int row0 = u.pm * BM + wr * 64 + fr, col0 = (u.pn & pnmask) * BM + wc * 32 + 8 * fq;
#pragma unroll
        for (int ai = 0; ai < 2; ++ai)
#pragma unroll
            for (int m = 0; m < 4; ++m) { bf16_t* rowp = O + (size_t)(row0 + ai * HALF + m * 16) * ldc + col0;
#pragma unroll
                for (int bj = 0; bj < 2; ++bj) { const f32x4 v0 = acc[ai][bj][m][0] * sc, v1 = acc[ai][bj][m][1] * sc;
                    u32x4 w; w.x = cvt_pk_bf16(v0[0], v0[1]); w.y = cvt_pk_bf16(v0[2], v0[3]); w.z = cvt_pk_bf16(v1[0], v1[1]); w.w = cvt_pk_bf16(v1[2], v1[3]);
                    *(u32x4*)(rowp + bj * HALF) = w; } }
    }
};
struct EpiProj {
    static constexpr bool PERM = true, AFTER_DRAIN = false;
    unsigned char* QF8; unsigned char* KV8; bf16_t* QIF; const float* qnw; const float* knw; const unsigned* rope; PG8_LAS float* PS; float qsc;
    static __device__ __forceinline__ float hlo(unsigned w) { return (float)__builtin_bit_cast(_Float16, (unsigned short)(w & 0xffffu)); }
    static __device__ __forceinline__ float hhi(unsigned w) { return (float)__builtin_bit_cast(_Float16, (unsigned short)(w >> 16)); }
    static __device__ __forceinline__ void rot8(f32x4& y0, f32x4& y1, const f32x4& o0, const f32x4& o1, const u32x4& ca, const u32x4& cb, float sg) {
#pragma unroll
        for (int e = 0; e < 4; ++e) { y0[e] = y0[e] * hlo(ca[e]) + sg * o0[e] * hhi(ca[e]); y1[e] = y1[e] * hlo(cb[e]) + sg * o1[e] * hhi(cb[e]); }
    }
    __device__ __forceinline__ void operator()(const f32x4 (&acc)[2][2][4][2], const Unit& u, int wr, int wc, int fr, int fq) const {
        const int rl0 = wr * 64 + fr, row0 = u.pm * BM + rl0, c = wc * 32 + 8 * fq;
        u32x4 ct[3][2];
        const bool rq = (u.pn <= 4) && (wc == 0), ri = (u.pn >= 6) && ((wc & 1) == 0); const int aoff = (u.pn <= 4) ? 8 * (fq & 1) : 16;
#define EPJ_LOADCT(r) do { const unsigned* rp = rope + (size_t)((row0 + ((r) >> 2) * HALF + ((r) & 3) * 16) & 8191) * 24 + aoff; ct[(r) % 3][0] = *(const u32x4*)rp; ct[(r) % 3][1] = *(const u32x4*)(rp + 4); } while (0)
        if (rq || ri) { EPJ_LOADCT(0); EPJ_LOADCT(1); EPJ_LOADCT(2); }
        if (u.pn <= 4) {
#pragma unroll
            for (int ai = 0; ai < 2; ++ai)
#pragma unroll
                for (int m = 0; m < 4; ++m)
#pragma unroll
                    for (int bj = 0; bj < 2; ++bj) { const f32x4 a0 = acc[ai][bj][m][0], a1 = acc[ai][bj][m][1];
                        float s = ((a0[0] * a0[0] + a0[1] * a0[1]) + (a0[2] * a0[2] + a0[3] * a0[3])) + ((a1[0] * a1[0] + a1[1] * a1[1]) + (a1[2] * a1[2] + a1[3] * a1[3]));
                        s += __shfl_xor(s, 16); s += __shfl_xor(s, 32);
                        if (fq == 0) PS[(rl0 + ai * HALF + m * 16) * 8 + bj * 4 + wc] = s; }
            asm volatile("s_waitcnt lgkmcnt(0)" ::: "memory"); __builtin_amdgcn_s_barrier();
            const bool isk = (u.pn == 4); const float* nw = isk ? knw : qnw; const f32x4 g0 = *(const f32x4*)(nw + c), g1 = *(const f32x4*)(nw + c + 4); const float osc = isk ? 1.0f : qsc;
#pragma unroll
            for (int ai = 0; ai < 2; ++ai) {
#pragma unroll
                for (int m = 0; m < 4; ++m) { const int rl = rl0 + ai * HALF + m * 16, row = row0 + ai * HALF + m * 16, t = row & 8191, b = row >> 13;
#pragma unroll
                    for (int bj = 0; bj < 2; ++bj) { const f32x4 p = *(const PG8_LAS f32x4*)(PS + rl * 8 + bj * 4);
                        const float rs = 1.0f / sqrtf(((p[0] + p[1]) + (p[2] + p[3])) * (1.0f / 128.0f) + RMS_EPS);
                        f32x4 y0 = acc[ai][bj][m][0] * rs * g0, y1 = acc[ai][bj][m][1] * rs * g1;
                        if (wc == 0) {
                            f32x4 o0, o1;
#pragma unroll
                            for (int e = 0; e < 4; ++e) { o0[e] = __shfl_xor(y0[e], 32); o1[e] = __shfl_xor(y1[e], 32); }
                            rot8(y0, y1, o0, o1, ct[(4 * ai + m) % 3][0], ct[(4 * ai + m) % 3][1], (fq < 2) ? -1.0f : 1.0f); }
                        y0 = y0 * osc; y1 = y1 * osc;
                        u32x2 w; w.x = pk4_fp8(y0[0], y0[1], y0[2], y0[3]); w.y = pk4_fp8(y1[0], y1[1], y1[2], y1[3]);
                        unsigned char* dst = isk ? (KV8 + ((size_t)(b * 2 + bj) * 8192 + t) * 256 + c) : (QF8 + (size_t)row * 1024 + (2 * u.pn + bj) * HALF + c);
                        *(u32x2*)dst = w; }
                    if (4 * ai + m + 3 < 8 && rq) EPJ_LOADCT(4 * ai + m + 3); }
            }
        } else if (u.pn == 5) {
#pragma unroll
            for (int ai = 0; ai < 2; ++ai)
#pragma unroll
                for (int m = 0; m < 4; ++m) { const int row = row0 + ai * HALF + m * 16, t = row & 8191, b = row >> 13;
#pragma unroll
                    for (int bj = 0; bj < 2; ++bj) { const f32x4 y0 = acc[ai][bj][m][0], y1 = acc[ai][bj][m][1];
                        u32x2 w; w.x = pk4_fp8(y0[0], y0[1], y0[2], y0[3]); w.y = pk4_fp8(y1[0], y1[1], y1[2], y1[3]);
                        *(u32x2*)(KV8 + ((size_t)(b * 2 + bj) * 8192 + t) * 256 + 128 + c) = w; } }
        } else {
#pragma unroll
            for (int ai = 0; ai < 2; ++ai) {
#pragma unroll
                for (int m = 0; m < 4; ++m) { const int row = row0 + ai * HALF + m * 16;
#pragma unroll
                    for (int bj = 0; bj < 2; ++bj) { f32x4 y0 = acc[ai][bj][m][0], y1 = acc[ai][bj][m][1];
                        if (ri) {
                            f32x4 o0, o1;
#pragma unroll
                            for (int e = 0; e < 4; ++e) { o0[e] = __shfl_xor(y0[e], 16); o1[e] = __shfl_xor(y1[e], 16); }
                            if (fq < 2) rot8(y0, y1, o0, o1, ct[(4 * ai + m) % 3][0], ct[(4 * ai + m) % 3][1], (fq == 0) ? -1.0f : 1.0f); }
                        u32x4 w; w.x = cvt_pk_bf16(y0[0], y0[1]); w.y = cvt_pk_bf16(y0[2], y0[3]); w.z = cvt_pk_bf16(y1[0], y1[1]); w.w = cvt_pk_bf16(y1[2], y1[3]);
                        *(u32x4*)(QIF + (size_t)row * 512 + (u.pn - 6) * BM + bj * HALF + c) = w; }
                    if (4 * ai + m + 3 < 8 && ri) EPJ_LOADCT(4 * ai + m + 3); }
            }
        }
#undef EPJ_LOADCT
    }
};
struct MoeOrder {
    int tb[9]; int npn, G, c;
    __device__ __forceinline__ bool next(int i, Unit& u) const {
        const int L = i * G + c; if (L >= tb[8] * npn) return false;
        const int t = L / npn, j = L - t * npn; int e = 0;
#pragma unroll
        for (int k = 1; k < 8; ++k) e += (t >= tb[k]) ? 1 : 0;
        u.pm = t; u.pn = e * npn + j; return true;
    }
    __device__ __forceinline__ void a_ready(const Unit&) const {}
    __device__ __forceinline__ void done(const Unit&) const {}
};

template <class Epi, class Sched, bool ALIGN_EPI = false, bool SP2 = false, bool F8 = false>
__device__ __forceinline__ void gemm_phase(PG8_LAS unsigned char* lds, const Gemm g, const Sched& S, const Epi& E) {
    const int tid = threadIdx.x, wid = __builtin_amdgcn_readfirstlane(tid >> 6), lane = tid & 63, wr = wid >> 2, wc = wid & 3, fr = lane & 15, fq = lane >> 4;
    const int K = g.K, nt = K / BK, LD = g.ld ? g.ld : g.K;
    unsigned voffA[2], voffB[2];
#pragma unroll
    for (int i = 0; i < 2; ++i) { int R, C; stage_rc(tid * 16 + i * 8192, R, C); const int Rb = Epi::PERM ? ((R & ~31) + perm32(R & 31)) : R;
        voffA[i] = (unsigned)(R * LD + C) * 2u; voffB[i] = (unsigned)(Rb * LD + C) * 2u; }
    const size_t kstep = (size_t)(BK * 2);
    const size_t hstep = (size_t)HALF * LD * 2;
    const size_t tstep = 2 * hstep;
    const unsigned ldsw = (unsigned)wid * 1024u;
    const int aoff = lds_byte(wr * 64 + fr, fq * 8), boff = lds_byte(wc * 32 + fr, fq * 8);
#define PG8_SA(b, h) (((b) * 2 + (h)) * HTB)
#define PG8_SB(b, h) ((4 + (b) * 2 + (h)) * HTB)
#define PG8_STAGE(bufoff, gbase, voff) do { _Pragma("unroll") for (int _i = 0; _i < 2; ++_i) \
        __builtin_amdgcn_global_load_lds((const unsigned*)((const char*)(gbase) + (voff)[_i]), (PG8_LAS unsigned*)(lds + (bufoff) + ldsw + _i * 8192), 16, 0, 0); } while (0)
#define PG8_LD32(p) __builtin_shufflevector(*(const PG8_LAS i32x4*)(p), *(const PG8_LAS i32x4*)((p) + 1024), 0, 1, 2, 3, 4, 5, 6, 7)
#define PG8_LDA(dst, b, h) do { if constexpr (F8) { _Pragma("unroll") for (int m = 0; m < 4; ++m) dst##8[m] = PG8_LD32(lds + PG8_SA(b, h) + aoff + m * 2048); } else { \
        _Pragma("unroll") for (int m = 0; m < 4; ++m) _Pragma("unroll") for (int k = 0; k < 2; ++k) dst[m][k] = *(const PG8_LAS bf16x8*)(lds + PG8_SA(b, h) + aoff + m * 2048 + k * 1024); } } while (0)
#define PG8_LDB(dst, b, h) do { if constexpr (F8) { _Pragma("unroll") for (int n = 0; n < 2; ++n) dst##8[n] = PG8_LD32(lds + PG8_SB(b, h) + boff + n * 2048); } else { \
        _Pragma("unroll") for (int n = 0; n < 2; ++n) _Pragma("unroll") for (int k = 0; k < 2; ++k) dst[n][k] = *(const PG8_LAS bf16x8*)(lds + PG8_SB(b, h) + boff + n * 2048 + k * 1024); } } while (0)
#define PG8_MMA(ai, bj, At, Bt) do { __builtin_amdgcn_s_setprio(1); if constexpr (F8) { _Pragma("unroll") for (int m = 0; m < 4; ++m) _Pragma("unroll") for (int n = 0; n < 2; ++n) \
        asm("v_mfma_f32_16x16x128_f8f6f4 %0, %1, %2, %0" : "+v"(acc[ai][bj][m][n]) : "v"(Bt##8[n]), "v"(At##8[m])); } else { \
        _Pragma("unroll") for (int m = 0; m < 4; ++m) _Pragma("unroll") for (int n = 0; n < 2; ++n) _Pragma("unroll") for (int k = 0; k < 2; ++k) \
        acc[ai][bj][m][n] = __builtin_amdgcn_mfma_f32_16x16x32_bf16(Bt[n][k], At[m][k], acc[ai][bj][m][n], 0, 0, 0); } __builtin_amdgcn_s_setprio(0); } while (0)
#define PG8_WAIT_V(n) asm volatile("s_waitcnt vmcnt(" #n ")" ::: "memory")
#define PG8_WAIT_L(n) asm volatile("s_waitcnt lgkmcnt(" #n ")" ::: "memory")
#define PG8_BAR __builtin_amdgcn_s_barrier()
#define PG8_SCHED __builtin_amdgcn_sched_barrier(0)
    Unit cur, nxt; int ui = 0;
    if (!S.next(0, cur)) return;
    f32x4 acc[2][2][4][2];
#pragma unroll
    for (int a = 0; a < 2; ++a)
#pragma unroll
        for (int b = 0; b < 2; ++b)
#pragma unroll
            for (int m = 0; m < 4; ++m)
#pragma unroll
                for (int n = 0; n < 2; ++n) acc[a][b][m][n] = (f32x4){0.f, 0.f, 0.f, 0.f};
    bf16x8 At[4][2], B0[2][2], B1[2][2]; i32x8 At8[4], B08[2], B18[2];
    const char* cA = (const char*)g.A + (size_t)cur.pm * tstep + cur.koff; const char* cB = (const char*)g.Bt + (size_t)cur.pn * tstep + cur.koff;
    S.a_ready(cur);
    if constexpr (SP2) {
        PG8_STAGE(PG8_SB(0, 0), cB, voffB); PG8_STAGE(PG8_SB(0, 1), cB + hstep, voffB); PG8_STAGE(PG8_SA(0, 0), cA, voffA); PG8_STAGE(PG8_SA(0, 1), cA + hstep, voffA);
        if (wr == 1) PG8_BAR;
        PG8_WAIT_V(2); PG8_BAR;
        PG8_STAGE(PG8_SB(1, 0), cB + kstep, voffB); PG8_STAGE(PG8_SA(1, 0), cA + kstep, voffA); PG8_STAGE(PG8_SB(1, 1), cB + hstep + kstep, voffB);
        PG8_WAIT_V(6); PG8_BAR;
    } else {
        PG8_STAGE(PG8_SB(0, 0), cB, voffB); PG8_STAGE(PG8_SA(0, 0), cA, voffA); PG8_STAGE(PG8_SB(0, 1), cB + hstep, voffB); PG8_STAGE(PG8_SA(0, 1), cA + hstep, voffA);
        if (wr == 1) PG8_BAR;
        PG8_WAIT_V(4); PG8_BAR;
        PG8_STAGE(PG8_SB(1, 0), cB + kstep, voffB); PG8_STAGE(PG8_SA(1, 0), cA + kstep, voffA); PG8_STAGE(PG8_SB(1, 1), cB + hstep + kstep, voffB);
        PG8_WAIT_V(6); PG8_BAR;
    }
    for (;;) {
        const bool has_next = S.next(ui + 1, nxt);
        const char* nA = has_next ? (const char*)g.A + (size_t)nxt.pm * tstep + nxt.koff : cA; const char* nB = has_next ? (const char*)g.Bt + (size_t)nxt.pn * tstep + nxt.koff : cB;
#pragma clang loop unroll(disable)
        for (int t = 0; t < nt; t += 2) {
            const bool last = (t == nt - 2);
            const char* a1 = cA + (size_t)(t + 1) * kstep;
            const char* a2 = last ? nA : cA + (size_t)(t + 2) * kstep; const char* b2 = last ? nB : cB + (size_t)(t + 2) * kstep;
            const char* a3 = a2 + kstep; const char* b3 = b2 + kstep;
            if (last && has_next) S.a_ready(nxt);
            if constexpr (SP2) {
            PG8_LDB(B0, 0, 0); PG8_LDB(B1, 0, 1); PG8_SCHED; PG8_LDA(At, 0, 0); PG8_STAGE(PG8_SA(1, 1), a1 + hstep, voffA);
            PG8_WAIT_V(8); PG8_WAIT_L(0); PG8_BAR; PG8_MMA(0, 0, At, B0); PG8_MMA(0, 1, At, B1); PG8_BAR; PG8_SCHED;
            PG8_LDA(At, 0, 1); PG8_STAGE(PG8_SB(0, 0), b2, voffB); PG8_STAGE(PG8_SB(0, 1), b2 + hstep, voffB); PG8_STAGE(PG8_SA(0, 0), a2, voffA);
            PG8_WAIT_V(8); PG8_WAIT_L(0); PG8_BAR; PG8_MMA(1, 0, At, B0); PG8_MMA(1, 1, At, B1); PG8_BAR; PG8_SCHED;
            PG8_LDB(B0, 1, 0); PG8_LDB(B1, 1, 1); PG8_SCHED; PG8_LDA(At, 1, 0); PG8_STAGE(PG8_SA(0, 1), a2 + hstep, voffA);
            PG8_WAIT_V(8); PG8_WAIT_L(0); PG8_BAR; PG8_MMA(0, 0, At, B0); PG8_MMA(0, 1, At, B1); PG8_BAR; PG8_SCHED;
            PG8_LDA(At, 1, 1); PG8_STAGE(PG8_SB(1, 0), b3, voffB); PG8_STAGE(PG8_SB(1, 1), b3 + hstep, voffB); PG8_STAGE(PG8_SA(1, 0), a3, voffA);
            PG8_WAIT_V(8); PG8_WAIT_L(0); PG8_BAR; PG8_MMA(1, 0, At, B0); PG8_MMA(1, 1, At, B1); PG8_BAR; PG8_SCHED;
            } else {
            PG8_LDB(B0, 0, 0); PG8_SCHED; PG8_LDA(At, 0, 0); PG8_STAGE(PG8_SA(1, 1), a1 + hstep, voffA);
            PG8_WAIT_L(8); PG8_BAR; PG8_WAIT_L(0); PG8_MMA(0, 0, At, B0); PG8_BAR; PG8_SCHED;
            PG8_LDB(B1, 0, 1); PG8_STAGE(PG8_SB(0, 0), b2, voffB);
            PG8_BAR; PG8_WAIT_L(0); PG8_MMA(0, 1, At, B1); PG8_BAR;
            PG8_LDA(At, 0, 1); PG8_STAGE(PG8_SA(0, 0), a2, voffA);
            PG8_BAR; PG8_WAIT_L(0); PG8_MMA(1, 0, At, B0); PG8_BAR; PG8_SCHED;
            PG8_STAGE(PG8_SB(0, 1), b2 + hstep, voffB);
            PG8_WAIT_V(6); PG8_BAR; PG8_MMA(1, 1, At, B1); PG8_BAR;
            PG8_LDB(B0, 1, 0); PG8_SCHED; PG8_LDA(At, 1, 0); PG8_STAGE(PG8_SA(0, 1), a2 + hstep, voffA);
            PG8_WAIT_L(8); PG8_BAR; PG8_WAIT_L(0); PG8_MMA(0, 0, At, B0); PG8_BAR; PG8_SCHED;
            PG8_LDB(B1, 1, 1); PG8_STAGE(PG8_SB(1, 0), b3, voffB);
            PG8_BAR; PG8_WAIT_L(0); PG8_MMA(0, 1, At, B1); PG8_BAR;
            PG8_LDA(At, 1, 1); PG8_STAGE(PG8_SA(1, 0), a3, voffA);
            PG8_BAR; PG8_WAIT_L(0); PG8_MMA(1, 0, At, B0); PG8_BAR; PG8_SCHED;
            PG8_STAGE(PG8_SB(1, 1), b3 + hstep, voffB);
            PG8_WAIT_V(6); PG8_BAR; PG8_MMA(1, 1, At, B1); PG8_BAR;
            }
        }
        if constexpr (F8) asm volatile("s_nop 15\n\ts_nop 15" ::: "memory");
        if constexpr (ALIGN_EPI) { if (wr == 0) PG8_BAR; }
        if constexpr (!Epi::AFTER_DRAIN) { E(acc, cur, wr, wc, fr, fq); S.done(cur); }
        if (!has_next) break;
#pragma unroll
        for (int a = 0; a < 2; ++a)
#pragma unroll
            for (int b = 0; b < 2; ++b)
#pragma unroll
                for (int m = 0; m < 4; ++m)
#pragma unroll
                    for (int n = 0; n < 2; ++n) acc[a][b][m][n] = (f32x4){0.f, 0.f, 0.f, 0.f};
        cur = nxt; cA = nA; cB = nB; ++ui;
        if constexpr (ALIGN_EPI) { if (wr == 1) PG8_BAR; }
    }
    PG8_WAIT_V(0);
    if constexpr (!ALIGN_EPI) { if (wr == 0) PG8_BAR; }
    PG8_BAR;
    if constexpr (Epi::AFTER_DRAIN) { E.fused(acc, cur, wr, wc, fr, fq, lds, wid, lane); S.done(cur); }
#undef PG8_SA
#undef PG8_SB
#undef PG8_STAGE
#undef PG8_LDA
#undef PG8_LDB
#undef PG8_MMA
#undef PG8_LD32
#undef PG8_WAIT_V
#undef PG8_WAIT_L
#undef PG8_BAR
#undef PG8_SCHED
}
}

constexpr int NWAVES = 8;
constexpr int BATCH = 2, SEQ = 8192, D = 1024, M = BATCH * SEQ;
constexpr int HD = 128, NH = 8, NKV = 2, NIH = 8, IDX = 64, TOPK = 256;
constexpr int A_IN = 2120, FF = 2816, NE = 8;
constexpr int MAXSLOT = 34816;
constexpr float QSCALE = 0.12751743082459868f;
constexpr float SBSCALE = 0.08838834764831845f;
constexpr float WISCALE = 0.04419417382415922f;
constexpr size_t MiB = 1u << 20;
constexpr size_t WS_CTL = 0, CTL_ZERO_BYTES = 1 * MiB;
constexpr size_t WS_WIN = 2 * MiB, WS_WTAIL = 6 * MiB, WS_WOA = 7 * MiB, WS_WGU = 9 * MiB, WS_WD = 20 * MiB, WS_WKVQ = 26 * MiB, WS_WOB = 32 * MiB, WS_WGUM = 34 * MiB, WS_WDM = 122 * MiB;
constexpr size_t WS_H = 166 * MiB, WS_XB = 230 * MiB, WS_SS0 = 262 * MiB, WS_SS1 = 263 * MiB, WS_SS2 = 264 * MiB, WS_SS3 = 265 * MiB;
constexpr size_t WS_T = 266 * MiB;
constexpr size_t WS_PROJ = WS_T, WS_QF = 330 * MiB, WS_KVF = 362 * MiB, WS_QIF = 378 * MiB, WS_KIF = 394 * MiB, WS_WIF = 396 * MiB, WS_SEL = 397 * MiB, WS_AO = 413 * MiB;
constexpr size_t WS_HF = WS_T, WS_KQ = WS_T, WS_VT = 330 * MiB;
constexpr size_t WS_XPERM = WS_T, WS_HM = 334 * MiB, WS_Y = 521 * MiB;
constexpr size_t WS_RT = 590 * MiB;
constexpr size_t WS_ROPE = 15 * MiB;
constexpr size_t WS_END = 591 * MiB;
constexpr int CW_CNT = 64;
constexpr int CW_P3Q = 192;
constexpr int CW_BAR = 4096;
constexpr int RING_BYTES = 131072, LDSCTL_OFF = RING_BYTES, MISC_OFF = LDSCTL_OFF + 320, PS_OFF = LDSCTL_OFF + 1024  , LDS_BYTES = 147456;

#define GAS __attribute__((address_space(1)))
#define LAS __attribute__((address_space(3)))
typedef unsigned short bf16;
typedef unsigned v4u __attribute__((ext_vector_type(4)));
typedef unsigned v2u __attribute__((ext_vector_type(2)));
typedef float f32x4 __attribute__((ext_vector_type(4)));
typedef short bf16x8 __attribute__((ext_vector_type(8)));
typedef float f32x16 __attribute__((ext_vector_type(16)));
typedef GAS unsigned gu32;
#define RLX_AGENT __ATOMIC_RELAXED, __HIP_MEMORY_SCOPE_AGENT
#define LDS_WAIT() asm volatile("s_waitcnt lgkmcnt(0)" ::: "memory")
#define VM_WAIT() asm volatile("s_waitcnt vmcnt(0)" ::: "memory")
__device__ __forceinline__ unsigned f2bf(float f) { unsigned u = __builtin_bit_cast(unsigned, f); return (u + 0x7fffu + ((u >> 16) & 1u)) >> 16; }
__device__ __forceinline__ unsigned pk2(float lo, float hi) { return f2bf(lo) | (f2bf(hi) << 16); }
__device__ __forceinline__ float bflo(unsigned w) { return __uint_as_float(w << 16); }
__device__ __forceinline__ float bfhi(unsigned w) { return __uint_as_float(w & 0xffff0000u); }
__device__ __forceinline__ float wave_sum(float v) {
#pragma unroll
    for (int o = 1; o < 64; o <<= 1) v += __shfl_xor(v, o);
    return v;
}
__device__ __forceinline__ float wave_max(float v) {
#pragma unroll
    for (int o = 1; o < 64; o <<= 1) v = fmaxf(v, __shfl_xor(v, o));
    return v;
}
__device__ __forceinline__ void sincos_acc(float a, float& c, float& s) {
    const double x = (double)a; const double n = __builtin_rint(x * 0.63661977236758134308);
    const double r = __builtin_fma(-n, 6.123233995736766035869e-17, __builtin_fma(-n, 1.57079632679489655800, x)); const double r2 = r * r;
    double sn = 1.0 - r2 * (1.0 / 156.0); sn = 1.0 - r2 * (1.0 / 110.0) * sn; sn = 1.0 - r2 * (1.0 / 72.0) * sn; sn = 1.0 - r2 * (1.0 / 42.0) * sn; sn = 1.0 - r2 * (1.0 / 20.0) * sn; sn = 1.0 - r2 * (1.0 / 6.0) * sn; sn *= r;
    double cs = 1.0 - r2 * (1.0 / 182.0); cs = 1.0 - r2 * (1.0 / 132.0) * cs; cs = 1.0 - r2 * (1.0 / 90.0) * cs; cs = 1.0 - r2 * (1.0 / 56.0) * cs; cs = 1.0 - r2 * (1.0 / 30.0) * cs; cs = 1.0 - r2 * (1.0 / 12.0) * cs; cs = 1.0 - r2 * 0.5 * cs;
    const int q = ((int)n) & 3;
    const double cq = (q == 0) ? cs : (q == 1) ? -sn : (q == 2) ? -cs : sn;
    const double sq = (q == 0) ? sn : (q == 1) ? cs : (q == 2) ? -sn : -cs;
    c = (float)cq; s = (float)sq;
}
__device__ const float INV_Q[16] = {1.000000000e+00f, 4.403665960e-01f, 1.939227432e-01f, 8.539710194e-02f, 3.760603070e-02f, 1.656043902e-02f, 7.292664610e-03f, 3.211445874e-03f,
                                    1.414213562e-03f, 6.227723788e-04f, 2.742481884e-04f, 1.207697351e-04f, 5.318296098e-05f, 2.341999971e-05f, 1.031338616e-05f, 4.541670478e-06f};
__device__ const float INV_I[8] = {1.000000000e+00f, 1.939227432e-01f, 3.760603070e-02f, 7.292664610e-03f, 1.414213562e-03f, 2.742481884e-04f, 5.318296098e-05f, 1.031338616e-05f};

#define XB_TMO      128
#define XB_XCNT(j)  (256  + 64 * (j))
#define XB_XSUB(j)  (1280 + 64 * (j))
#define XB_XGEN(j)  (2304 + 64 * (j))
#define XB_TOP      3328
#define XB_TOPGEN   3392
#define XCD_BAR_WORDS 3456
#define XB_SPIN_CAP (1u << 18)

__device__ __forceinline__ unsigned xb_ld(unsigned* p)              { return __hip_atomic_load(p, __ATOMIC_RELAXED, __HIP_MEMORY_SCOPE_AGENT); }
__device__ __forceinline__ unsigned xb_add(unsigned* p, unsigned v) { return __hip_atomic_fetch_add(p, v, __ATOMIC_RELAXED, __HIP_MEMORY_SCOPE_AGENT); }
__device__ __forceinline__ unsigned xb_xcc_id() { return (unsigned)__builtin_amdgcn_s_getreg((3 << 11) | 20) & 0xFu; }
#define XB_SPIN(cond, bar) do { unsigned _sp = 0; while (cond) { __builtin_amdgcn_s_sleep(1); \
    if ((++_sp & 255u) == 0u) { if (xb_ld(&(bar)[XB_TMO])) break; if (_sp > XB_SPIN_CAP) { atomicAdd(&(bar)[XB_TMO], 1u); break; } } } } while (0)

struct XcdBarrier {
    unsigned* bar; unsigned x;
    volatile LAS unsigned* st;
};

__device__ __forceinline__ XcdBarrier xcd_barrier_post(unsigned* bar, volatile LAS unsigned* st) {
    XcdBarrier b; b.bar = bar; b.x = xb_xcc_id(); b.st = st;
    if (threadIdx.x == 0) (void)xb_add(&bar[XB_XCNT(b.x)], 1u);
    return b;
}
__device__ __forceinline__ void xcd_barrier_complete(unsigned* bar, unsigned x, unsigned& nloc, unsigned& nx) {
    const unsigned G = gridDim.x * gridDim.y * gridDim.z;
    unsigned sum, cnt, mine, sp = 0u;
    for (;;) {
        sum = 0u; cnt = 0u; mine = 0u;
#pragma unroll
        for (unsigned j = 0; j < 16; ++j) { const unsigned c = xb_ld(&bar[XB_XCNT(j)]); sum += c; cnt += (c > 0u) ? 1u : 0u; mine = (j == x) ? c : mine; }
        if (sum == G) break;
        __builtin_amdgcn_s_sleep(1);
        if ((++sp & 255u) == 0u) { if (xb_ld(&bar[XB_TMO])) break; if (sp > XB_SPIN_CAP) { atomicAdd(&bar[XB_TMO], 1u); break; } }
    }
    nloc = mine > 0u ? mine : 1u; nx = cnt > 0u ? cnt : 1u;
}

__device__ __forceinline__ void xcd_barrier(const XcdBarrier& b) {
    asm volatile("s_waitcnt vmcnt(0)" ::: "memory");
    __syncthreads();
    if (threadIdx.x == 0) {
        unsigned* bar = b.bar;
        __builtin_amdgcn_s_waitcnt(0);
        unsigned nloc = b.st[0], nx = b.st[1];
        if (nloc == 0u) { xcd_barrier_complete(bar, b.x, nloc, nx); b.st[0] = nloc; b.st[1] = nx; }
        const unsigned old = xb_add(&bar[XB_XSUB(b.x)], 1u);
        const unsigned gen = old / nloc;
        if (old + 1u == (gen + 1u) * nloc) {
            __builtin_amdgcn_fence(__ATOMIC_RELEASE, "agent");
            asm volatile("s_waitcnt vmcnt(0)" ::: "memory");
            const unsigned og = xb_add(&bar[XB_TOP], 1u);
            const unsigned tg = og / nx;
            if (og + 1u == (tg + 1u) * nx) xb_add(&bar[XB_TOPGEN], 1u);
            else XB_SPIN(xb_ld(&bar[XB_TOPGEN]) == tg, bar);
            __builtin_amdgcn_fence(__ATOMIC_ACQUIRE, "agent");
            xb_add(&bar[XB_XGEN(b.x)], 1u);
            asm volatile("s_waitcnt vmcnt(0)" ::: "memory");
        } else {
            XB_SPIN(xb_ld(&bar[XB_XGEN(b.x)]) == gen, bar);
            __builtin_amdgcn_fence(__ATOMIC_ACQUIRE, "agent");
            asm volatile("s_waitcnt vmcnt(0)" ::: "memory");
        }
    }
    __syncthreads();
}

struct Frame {
    LAS unsigned char* lds;
    volatile LAS unsigned* MISC;
    gu32* ctl;
    int tid, lane, wave, G, bid;
    const float* in[17];
    float* out; unsigned char* ws;
};
enum { IN_X = 0, IN_ANORM, IN_AWIN, IN_AQN, IN_AKN, IN_AWOUT, IN_KVNORM, IN_KVW, IN_BNORM, IN_BWQ, IN_BWOUT, IN_FFNNORM, IN_DGU, IN_DDN, IN_ROUTER, IN_MGU, IN_MDN };

constexpr float P4_QS = 16.f;
struct TrItem { const float* W; size_t ldw; int K, k0, csrc0, cend; bf16* WT; int drow0; const float* gain; float scale; int f8; };
__device__ __forceinline__ int gu_row(int c0) { return (c0 < FF) ? ((c0 >> 7) * 256 + (c0 & 127)) : (((c0 - FF) >> 7) * 256 + 128 + ((c0 - FF) & 127)); }
constexpr int I_WIN = 16 * 32, I_TAIL = 16 * 2, I_SQ = 16 * 16, I_GU = 16 * 88, I_DN = 44 * 16, I_KV = 16 * 32;
constexpr int TR_NITEMS = I_WIN + I_TAIL + I_SQ + I_GU + I_DN + I_KV + I_SQ + I_SQ + NE * I_GU + NE * I_DN;
__device__ __forceinline__ TrItem tr_decode(const Frame& F, int it) {
    unsigned char* ws = F.ws; int r = it; TrItem t;
    if (r < I_WIN) { const int kb = r / 32, nb = r % 32; t = TrItem{F.in[IN_AWIN], (size_t)A_IN, D, 64 * kb, 64 * nb, A_IN, (bf16*)(ws + WS_WIN), 64 * nb, F.in[IN_ANORM], 1.f}; return t; } r -= I_WIN;
    if (r < I_TAIL) { const int kb = r / 2, nb = r % 2; t = TrItem{F.in[IN_AWIN], (size_t)A_IN, D, 64 * kb, 2048 + 64 * nb, A_IN, (bf16*)(ws + WS_WTAIL), 64 * nb, F.in[IN_ANORM], 1.f}; return t; } r -= I_TAIL;
    if (r < I_SQ) { const int kb = r / 16, nb = r % 16; t = TrItem{F.in[IN_AWOUT], (size_t)D, D, 64 * kb, 64 * nb, D, (bf16*)(ws + WS_WOA), 64 * nb, nullptr, 1.f}; return t; } r -= I_SQ;
    if (r < I_GU) { const int kb = r / 88, nb = r % 88; t = TrItem{F.in[IN_DGU], (size_t)(2 * FF), D, 64 * kb, 64 * nb, 2 * FF, (bf16*)(ws + WS_WGU), gu_row(64 * nb), F.in[IN_FFNNORM], pg8::F8_SWGU, 1}; return t; } r -= I_GU;
    if (r < I_DN) { const int kb = r / 16, nb = r % 16; t = TrItem{F.in[IN_DDN], (size_t)D, FF, 64 * kb, 64 * nb, D, (bf16*)(ws + WS_WD), 64 * nb, nullptr, pg8::F8_SWD, 1}; return t; } r -= I_DN;
    if (r < I_KV) { const int kb = r / 32, nb = r % 32; t = TrItem{F.in[IN_KVW], (size_t)(2 * D), D, 64 * kb, 64 * nb, 2 * D, (bf16*)(ws + WS_WKVQ), (nb < 16) ? 64 * nb : 1024 + 64 * nb, F.in[IN_KVNORM], 1.f}; return t; } r -= I_KV;
    if (r < I_SQ) { const int kb = r / 16, nb = r % 16; t = TrItem{F.in[IN_BWQ], (size_t)D, D, 64 * kb, 64 * nb, D, (bf16*)(ws + WS_WKVQ), 1024 + 64 * nb, F.in[IN_BNORM], SBSCALE}; return t; } r -= I_SQ;
    if (r < I_SQ) { const int kb = r / 16, nb = r % 16; t = TrItem{F.in[IN_BWOUT], (size_t)D, D, 64 * kb, 64 * nb, D, (bf16*)(ws + WS_WOB), 64 * nb, nullptr, 1.f}; return t; } r -= I_SQ;
    if (r < NE * I_GU) { const int e = r / I_GU, rr = r % I_GU, kb = rr / 88, nb = rr % 88;
        t = TrItem{F.in[IN_MGU] + (size_t)e * D * 2 * FF, (size_t)(2 * FF), D, 64 * kb, 64 * nb, 2 * FF, (bf16*)(ws + WS_WGUM), e * 2 * FF + gu_row(64 * nb), F.in[IN_FFNNORM] + D, pg8::F8_SWGU, 1}; return t; } r -= NE * I_GU;
    { const int e = r / I_DN, rr = r % I_DN, kb = rr / 16, nb = rr % 16;
      t = TrItem{F.in[IN_MDN] + (size_t)e * FF * D, (size_t)D, FF, 64 * kb, 64 * nb, D, (bf16*)(ws + WS_WDM), e * D + 64 * nb, nullptr, pg8::F8_SWD, 1}; return t; }
}
__device__ __forceinline__ void tr_load(const TrItem& t, f32x4 (&v)[16], int lane) {
    const int r = lane >> 4, c = t.csrc0 + 4 * (lane & 15); const bool ok = c < t.cend; const float* src = t.W + (size_t)(t.k0 + r) * t.ldw + (ok ? c : 0);
#pragma unroll
    for (int i = 0; i < 16; ++i) { const f32x4 x = __builtin_nontemporal_load((const f32x4*)(src + (size_t)(4 * i) * t.ldw)); v[i] = ok ? x : (f32x4){0.f, 0.f, 0.f, 0.f}; }
}
__device__ __forceinline__ void tr_store(const TrItem& t, const f32x4 (&v)[16], LAS float* scr, int lane) {
    const int r = lane >> 4, c4 = lane & 15;
#pragma unroll
    for (int i = 0; i < 16; ++i) { const int k = 4 * i + r; const float g = t.gain ? t.gain[t.k0 + k] * t.scale : t.scale;
        *(LAS f32x4*)(scr + k * 64 + 4 * (c4 ^ ((k >> 3) & 7))) = v[i] * g; }
    LDS_WAIT(); asm volatile("" ::: "memory");
    if (t.f8) {
        const int c4b = lane & 3;
#pragma unroll
        for (int j = 0; j < 4; ++j) { const int n = (lane >> 2) + 16 * j;
            const LAS float* s0 = scr + (16 * c4b) * 64 + (n ^ ((2 * c4b) << 2)); const LAS float* s1 = scr + (16 * c4b + 8) * 64 + (n ^ ((2 * c4b + 1) << 2));
            v4u o; o.x = pg8::pk4_fp8(s0[0 * 64], s0[1 * 64], s0[2 * 64], s0[3 * 64]); o.y = pg8::pk4_fp8(s0[4 * 64], s0[5 * 64], s0[6 * 64], s0[7 * 64]);
            o.z = pg8::pk4_fp8(s1[0 * 64], s1[1 * 64], s1[2 * 64], s1[3 * 64]); o.w = pg8::pk4_fp8(s1[4 * 64], s1[5 * 64], s1[6 * 64], s1[7 * 64]);
            *(GAS v4u*)((unsigned char*)t.WT + (size_t)(t.drow0 + n) * t.K + t.k0 + 16 * c4b) = o; }
    } else {
    const int c8 = lane & 7;
#pragma unroll
    for (int j = 0; j < 8; ++j) { const int n = (lane >> 3) + 8 * j; const LAS float* s = scr + (8 * c8) * 64 + (n ^ (c8 << 2));
        v4u o; o.x = pk2(s[0 * 64], s[1 * 64]); o.y = pk2(s[2 * 64], s[3 * 64]); o.z = pk2(s[4 * 64], s[5 * 64]); o.w = pk2(s[6 * 64], s[7 * 64]);
        *(GAS v4u*)(t.WT + (size_t)(t.drow0 + n) * t.K + t.k0 + 8 * c8) = o; }
    }
    LDS_WAIT(); asm volatile("" ::: "memory");
}
__device__ __forceinline__ void p0_prologue(Frame& F) {
    LAS float* scr = (LAS float*)(F.lds + F.wave * 16384);
    const int gw = F.wave * F.G + F.bid, NGW = F.G * NWAVES;
    unsigned char* ws = F.ws;
    {
        f32x4 va[16], vb[16];
        int it = gw;
        if (it < TR_NITEMS) { TrItem cur = tr_decode(F, it); tr_load(cur, va, F.lane);
            for (;;) {
                const int nx = it + NGW; const bool has = nx < TR_NITEMS; TrItem nxt = cur;
                if (has) { nxt = tr_decode(F, nx); tr_load(nxt, vb, F.lane); }
                tr_store(cur, va, scr, F.lane);
                if (!has) break;
                it = nx + NGW; const bool has2 = it < TR_NITEMS; TrItem nn = nxt;
                if (has2) { nn = tr_decode(F, it); tr_load(nn, va, F.lane); }
                tr_store(nxt, vb, scr, F.lane);
                if (!has2) break;
                cur = nn;
            }
        }
    }
    { unsigned* RT = (unsigned*)(ws + WS_ROPE);
      for (int t = gw; t < SEQ; t += NGW) if (F.lane < 24) { float c, s; sincos_acc((float)t * ((F.lane < 16) ? INV_Q[F.lane & 15] : INV_I[F.lane & 7]), c, s);
          RT[t * 24 + F.lane] = (unsigned)__builtin_bit_cast(unsigned short, (_Float16)c) | ((unsigned)__builtin_bit_cast(unsigned short, (_Float16)s) << 16); } }
    const float* x = F.in[IN_X]; bf16* XB = (bf16*)(ws + WS_XB);
    for (int m = gw; m < M; m += NGW) {
        const GAS f32x4* xr = (const GAS f32x4*)(x + (size_t)m * D) + F.lane; f32x4 v[4]; float s = 0.f;
#pragma unroll
        for (int j = 0; j < 4; ++j) { v[j] = xr[64 * j]; s += (v[j].x * v[j].x + v[j].y * v[j].y) + (v[j].z * v[j].z + v[j].w * v[j].w); }
        s = wave_sum(s); const float rs = 1.0f / sqrtf(s * (1.0f / 1024.0f) + 1e-6f);
        GAS unsigned long long* o8 = (GAS unsigned long long*)(XB + (size_t)m * D) + F.lane;
#pragma unroll
        for (int j = 0; j < 4; ++j) o8[64 * j] = (unsigned long long)pk2(v[j].x * rs, v[j].y * rs) | ((unsigned long long)pk2(v[j].z * rs, v[j].w * rs) << 32);
    }
}

#define WAVE_SYNC() asm volatile("s_waitcnt lgkmcnt(0)" ::: "memory")
__device__ __forceinline__ void rope8(float (&y)[8], bool isx1, bool isx2, int i0, int pshift, LAS const float* tab) {
#pragma unroll
    for (int e = 0; e < 8; ++e) {
        const float other = __shfl_xor(y[e], pshift); const float c = tab[2 * (i0 + e)], s = tab[2 * (i0 + e) + 1];
        y[e] = isx1 ? (y[e] * c - other * s) : (isx2 ? (y[e] * c + other * s) : y[e]);
    }
}
__device__ __forceinline__ size_t kif_off(int grow, int d) { return ((((size_t)(grow >> 5) * 4 + ((d >> 3) & 3)) * 2 + (d >> 5)) * 32 + (grow & 31)) * 8 + (d & 7); }
__device__ __forceinline__ void unpack8(const v4u w, float (&y)[8]) { y[0] = bflo(w.x); y[1] = bfhi(w.x); y[2] = bflo(w.y); y[3] = bfhi(w.y); y[4] = bflo(w.z); y[5] = bfhi(w.z); y[6] = bflo(w.w); y[7] = bfhi(w.w); }
__device__ __forceinline__ v4u pack8(const float (&y)[8]) { v4u o; o.x = pk2(y[0], y[1]); o.y = pk2(y[2], y[3]); o.z = pk2(y[4], y[5]); o.w = pk2(y[6], y[7]); return o; }
__device__ __forceinline__ void p2_post(Frame& F) {
    unsigned char* ws = F.ws; const int lane = F.lane;
    const bf16* PROJ = (const bf16*)(ws + WS_PROJ); const bf16* XB = (const bf16*)(ws + WS_XB); const bf16* WT = (const bf16*)(ws + WS_WTAIL);
    bf16* QF = (bf16*)(ws + WS_QF); bf16* KVF = (bf16*)(ws + WS_KVF); bf16* QIF = (bf16*)(ws + WS_QIF); bf16* KIF = (bf16*)(ws + WS_KIF); float* WIF = (float*)(ws + WS_WIF);
    const float* qnw = F.in[IN_AQN]; const float* knw = F.in[IN_AKN];
    LAS float* tab = (LAS float*)(F.lds + F.wave * 256);
    const int gw = F.wave * F.G + F.bid, NGW = F.G * NWAVES;
    const unsigned* RT = (const unsigned*)(ws + WS_ROPE);
    for (int task = gw; task < M / 16; task += NGW) {
        const int row0 = task * 16;
        f32x4 acc[5];
#pragma unroll
        for (int c = 0; c < 5; ++c) acc[c] = (f32x4){0.f, 0.f, 0.f, 0.f};
        const bf16* ap = XB + (size_t)(row0 + (lane & 15)) * D + 8 * (lane >> 4);
        const bf16* bp = WT + (size_t)(lane & 15) * D + 8 * (lane >> 4);
#pragma unroll 4
        for (int j = 0; j < 32; ++j) {
            const bf16x8 a = *(const bf16x8*)(ap + 32 * j);
#pragma unroll
            for (int c = 0; c < 5; ++c) { const bf16x8 b = *(const bf16x8*)(bp + (size_t)(16 * c) * D + 32 * j); acc[c] = __builtin_amdgcn_mfma_f32_16x16x32_bf16(a, b, acc[c], 0, 0, 0); }
        }
#pragma unroll
        for (int reg = 0; reg < 4; ++reg) {
            const int row = row0 + 4 * (lane >> 4) + reg;
            const int d = lane & 15;
            float v0 = acc[0][reg]; const float other = __shfl_xor(v0, 8);
            { const unsigned cs = RT[(row & (SEQ - 1)) * 24 + 16 + (d & 7)]; const float c = pg8::EpiProj::hlo(cs), s = pg8::EpiProj::hhi(cs); v0 = (d < 8) ? (v0 * c - other * s) : (v0 * c + other * s); }
            KIF[kif_off(row, d)] = (bf16)f2bf(v0);
#pragma unroll
            for (int c = 1; c < 4; ++c) KIF[kif_off(row, 16 * c + d)] = (bf16)f2bf(acc[c][reg]);
            if (d < 8) WIF[(size_t)row * 8 + d] = acc[4][reg] * WISCALE;
        }
    }
}

__device__ __forceinline__ unsigned f2key(float f) { const unsigned u = __float_as_uint(f); return (u & 0x80000000u) ? ~u : (u | 0x80000000u); }
__device__ __forceinline__ void p3_query_naive(unsigned char* ws, LAS unsigned char* lds, int row, int* SEL) {
    const int tid = threadIdx.x, lane = tid & 63, wave = tid >> 6;
    const bf16* QIF = (const bf16*)(ws + WS_QIF); const bf16* KIF = (const bf16*)(ws + WS_KIF); const float* WIF = (const float*)(ws + WS_WIF);
    LAS unsigned* keys = (LAS unsigned*)lds;
    LAS float* qis = (LAS float*)(lds + 32768);
    LAS float* wl = (LAS float*)(lds + 32768 + 2048);
    LAS unsigned* hist = (LAS unsigned*)(lds + 36864);
    LAS unsigned* ctl = (LAS unsigned*)(lds + 36864 + 1024);
    LAS unsigned* wcnt = (LAS unsigned*)(lds + 36864 + 1024 + 64);
    {
        const int b = row >> 13, t = row & (SEQ - 1), n = t + 1;
        int* sel = SEL + (size_t)row * TOPK;
        if (n <= TOPK) { if (tid < TOPK) sel[tid] = tid < n ? tid : 0; return; }
        __syncthreads();
        qis[tid] = __uint_as_float((unsigned)QIF[(size_t)row * 512 + tid] << 16);
        if (tid < 8) wl[tid] = WIF[(size_t)row * 8 + tid];
        __syncthreads();
        for (int s = tid; s < n; s += 512) {
            const int grow = (b << 13) + s;
            float kf[64];
#pragma unroll
            for (int j = 0; j < 8; ++j) { const v4u w = *(const v4u*)(KIF + kif_off(grow, 8 * j)); kf[8 * j] = bflo(w.x); kf[8 * j + 1] = bfhi(w.x); kf[8 * j + 2] = bflo(w.y); kf[8 * j + 3] = bfhi(w.y); kf[8 * j + 4] = bflo(w.z); kf[8 * j + 5] = bfhi(w.z); kf[8 * j + 6] = bflo(w.w); kf[8 * j + 7] = bfhi(w.w); }
            float sc = 0.f;
#pragma unroll
            for (int h = 0; h < 8; ++h) { float d = 0.f; asm volatile("" ::: "memory");
#pragma unroll
                for (int dd = 0; dd < 64; ++dd) d += qis[h * 64 + dd] * kf[dd];
                sc += wl[h] * fmaxf(d, 0.f); }
            keys[s] = f2key(sc + 0.0f);
        }
        __syncthreads();
        unsigned prefix = 0u, mask = 0u, need = TOPK;
        for (int pass = 0; pass < 4; ++pass) {
            const int shift = 24 - 8 * pass;
            if (tid < 256) hist[tid] = 0u;
            __syncthreads();
            for (int s = tid; s < n; s += 512) { const unsigned k = keys[s]; if ((k & mask) == prefix) __hip_atomic_fetch_add(&hist[(k >> shift) & 255u], 1u, __ATOMIC_RELAXED, __HIP_MEMORY_SCOPE_WORKGROUP); }
            __syncthreads();
            if (tid < 64) {
                const unsigned h0 = hist[4 * lane], h1 = hist[4 * lane + 1], h2 = hist[4 * lane + 2], h3 = hist[4 * lane + 3]; const unsigned tot = h0 + h1 + h2 + h3;
                unsigned incl = tot;
#pragma unroll
                for (int o = 1; o < 64; o <<= 1) { const unsigned v = __shfl_down(incl, o); if (lane + o < 64) incl += v; }
                const unsigned above = incl - tot;
                if (above < need && need <= above + tot) {
                    unsigned a = above; unsigned bin;
                    if (a + h3 >= need) bin = 3; else { a += h3; if (a + h2 >= need) bin = 2; else { a += h2; if (a + h1 >= need) bin = 1; else { a += h1; bin = 0; } } }
                    ctl[0] = 4 * lane + bin; ctl[1] = need - a;
                }
            }
            __syncthreads();
            prefix |= ctl[0] << shift; mask |= 255u << shift; need = ctl[1];
            __syncthreads();
        }
        const unsigned thr = prefix, n_gt = TOPK - need;
        unsigned base_gt = 0u, base_eq = 0u;
        for (int s0 = 0; s0 < n; s0 += 512) {
            const int s = s0 + tid; const unsigned k = s < n ? keys[s] : 0u; const bool gt = (s < n) && (k > thr); const bool eq = (s < n) && (k == thr);
            const unsigned long long bg = __ballot(gt), be = __ballot(eq); const unsigned long long lt = (1ull << lane) - 1ull;
            const unsigned rg = __popcll(bg & lt), re = __popcll(be & lt);
            if (lane == 0) { wcnt[wave] = __popcll(bg); wcnt[8 + wave] = __popcll(be); }
            __syncthreads();
            unsigned og = base_gt, oe = base_eq, tg = 0u, te = 0u;
#pragma unroll
            for (int w = 0; w < 8; ++w) { const unsigned cg = wcnt[w], ce = wcnt[8 + w]; if (w < wave) { og += cg; oe += ce; } tg += cg; te += ce; }
            if (gt) sel[og + rg] = s;
            if (eq && oe + re < need) sel[n_gt + oe + re] = s;
            base_gt += tg; base_eq += te;
            __syncthreads();
        }
    }
}

constexpr int P3_HIST = 0, P3_H2 = 65536, P3_BM = 98304, P3_QS = 114688, P3_FLAG = P3_QS + 512, P3_CAP = 512;
__device__ __forceinline__ void find_bin_2048(LAS const unsigned* hist, unsigned need, int lane, unsigned& bin_out, unsigned& need_out, unsigned& cnt_out, bool& ok) {
    unsigned w[16]; unsigned tot = 0u;
#pragma unroll
    for (int i = 0; i < 16; ++i) { w[i] = hist[16 * lane + i]; tot += (w[i] & 0xffffu) + (w[i] >> 16); }
    unsigned incl = tot;
#pragma unroll
    for (int o = 1; o < 64; o <<= 1) { const unsigned v = __shfl_down(incl, o); if (lane + o < 64) incl += v; }
    const unsigned above = incl - tot;
    const bool mine = (above < need) && (need <= above + tot);
    unsigned a = above, fb = 0u, fn = 0u, fc = 0u; bool found = false;
#pragma unroll
    for (int i = 15; i >= 0; --i) {
        const unsigned h1 = w[i] >> 16, h0 = w[i] & 0xffffu;
        if (!found) { if (a + h1 >= need) { found = true; fb = 32u * lane + 2u * i + 1u; fn = need - a; fc = h1; } else a += h1; }
        if (!found) { if (a + h0 >= need) { found = true; fb = 32u * lane + 2u * i; fn = need - a; fc = h0; } else a += h0; }
    }
    const unsigned long long bm = __ballot(mine);
    ok = (bm != 0ull);
    const int src = ok ? (__ffsll((long long)bm) - 1) : 0;
    bin_out = (unsigned)__builtin_amdgcn_readlane((int)fb, src); need_out = (unsigned)__builtin_amdgcn_readlane((int)fn, src); cnt_out = (unsigned)__builtin_amdgcn_readlane((int)fc, src);
}
__device__ __forceinline__ unsigned bin11(float sc) { const unsigned u = __float_as_uint(sc); const int m = (int)((u & 0x7fffffffu) >> 17) - 7360; const unsigned mc = (unsigned)(m < 0 ? 0 : (m > 1023 ? 1023 : m)); return (u >> 31) ? (1023u - mc) : (1024u + mc); }
__device__ __forceinline__ float relu_i(float x) { const int xi = __builtin_bit_cast(int, x); const int ri = (xi < 0) ? 0 : xi; return __builtin_bit_cast(float, ri); }
#define RELU(x) relu_i(x)
typedef _Float16 f16x8 __attribute__((ext_vector_type(8)));
typedef short s16x2 __attribute__((ext_vector_type(2)));
__device__ __forceinline__ unsigned pk_relu_f16(float a, float b) { const s16x2 h = __builtin_bit_cast(s16x2, __builtin_amdgcn_cvt_pkrtz(a, b)); return __builtin_bit_cast(unsigned, __builtin_elementwise_max(h, (s16x2){0, 0})); }
__device__ __forceinline__ unsigned bin16(unsigned h) { const int m = (int)((h & 0x7fffu) >> 4) - 192; const unsigned mc = (unsigned)(m < 0 ? 0 : (m > 1023 ? 1023 : m)); return (h & 0x8000u) ? (1023u - mc) : (1024u + mc); }
__device__ __forceinline__ unsigned key16(unsigned h) { return (h & 0x8000u) ? (~h & 0xffffu) : (h | 0x8000u); }
__device__ __forceinline__ void p3_score_pass(const bf16x8 (&af)[2][4], const f16x8 (&wa)[2][2], const bf16* kib, int t0, int nt, int wave, int n, int hi,
                                              LAS unsigned char* lds, unsigned short* SC, int rot) {
    LAS unsigned* HIST = (LAS unsigned*)(lds + P3_HIST);
    const int qh = 8 * (wave >> 2), w4 = wave & 3;
    const int cnt4 = (nt - w4 + 3) >> 2; const int r0 = rot % cnt4;
    bf16x8 bq[4][4];
#define P3_LOADB(u, j) do { int jj_ = r0 + (j); jj_ = (jj_ >= cnt4) ? jj_ - cnt4 : jj_; const int t_ = w4 + 4 * jj_; \
        const bf16* kp_ = kib + ((size_t)t_ * 8 + hi) * 256 + n * 8; _Pragma("unroll") for (int s = 0; s < 4; ++s) bq[u][s] = *(const bf16x8*)(kp_ + s * 512); } while (0)
#pragma unroll
    for (int u = 0; u < 4; ++u) P3_LOADB(u, (u < cnt4) ? u : 0);
    for (int i0 = 0; i0 < cnt4; i0 += 4) {
#pragma unroll
        for (int u = 0; u < 4; ++u) {
            if (i0 + u < cnt4) {
                int jj = r0 + i0 + u; jj = (jj >= cnt4) ? jj - cnt4 : jj; const int tile = w4 + 4 * jj;
                const int key = 32 * tile + n; const bool full = (32 * tile + 31 <= t0);
                f32x16 acc0, acc1;
#pragma unroll
                for (int r = 0; r < 16; ++r) { acc0[r] = 0.f; acc1[r] = 0.f; }
#pragma unroll
                for (int s = 0; s < 4; ++s) acc0 = __builtin_amdgcn_mfma_f32_32x32x16_bf16(af[0][s], bq[u][s], acc0, 0, 0, 0);
#pragma unroll
                for (int s = 0; s < 4; ++s) acc1 = __builtin_amdgcn_mfma_f32_32x32x16_bf16(af[1][s], bq[u][s], acc1, 0, 0, 0);
                unsigned p01, p23;
                {
                    f32x16 y0, y1;
#pragma unroll
                    for (int r = 0; r < 16; ++r) { y0[r] = 0.f; y1[r] = 0.f; }
                    const f16x8 x00 = __builtin_bit_cast(f16x8, (v4u){pk_relu_f16(acc0[0], acc0[1]), pk_relu_f16(acc0[2], acc0[3]), pk_relu_f16(acc0[4], acc0[5]), pk_relu_f16(acc0[6], acc0[7])});
                    const f16x8 x01 = __builtin_bit_cast(f16x8, (v4u){pk_relu_f16(acc0[8], acc0[9]), pk_relu_f16(acc0[10], acc0[11]), pk_relu_f16(acc0[12], acc0[13]), pk_relu_f16(acc0[14], acc0[15])});
                    const f16x8 x10 = __builtin_bit_cast(f16x8, (v4u){pk_relu_f16(acc1[0], acc1[1]), pk_relu_f16(acc1[2], acc1[3]), pk_relu_f16(acc1[4], acc1[5]), pk_relu_f16(acc1[6], acc1[7])});
                    const f16x8 x11 = __builtin_bit_cast(f16x8, (v4u){pk_relu_f16(acc1[8], acc1[9]), pk_relu_f16(acc1[10], acc1[11]), pk_relu_f16(acc1[12], acc1[13]), pk_relu_f16(acc1[14], acc1[15])});
                    y0 = __builtin_amdgcn_mfma_f32_32x32x16_f16(wa[0][0], x00, y0, 0, 0, 0); y1 = __builtin_amdgcn_mfma_f32_32x32x16_f16(wa[1][0], x10, y1, 0, 0, 0);
                    y0 = __builtin_amdgcn_mfma_f32_32x32x16_f16(wa[0][1], x01, y0, 0, 0, 0); y1 = __builtin_amdgcn_mfma_f32_32x32x16_f16(wa[1][1], x11, y1, 0, 0, 0);
                    p01 = __builtin_bit_cast(unsigned, __builtin_amdgcn_cvt_pkrtz(y0[0], y0[1])); p23 = __builtin_bit_cast(unsigned, __builtin_amdgcn_cvt_pkrtz(y1[0], y1[1]));
                }
                unsigned h4[4]; h4[0] = p01 & 0xffffu; h4[1] = p01 >> 16; h4[2] = p23 & 0xffffu; h4[3] = p23 >> 16;
                unsigned short* scp = SC + (size_t)(qh + hi) * SEQ + key;
                scp[0] = (unsigned short)h4[0]; scp[2 * SEQ] = (unsigned short)h4[1]; scp[4 * SEQ] = (unsigned short)h4[2]; scp[6 * SEQ] = (unsigned short)h4[3];
                unsigned bin4[4];
#pragma unroll
                for (int e = 0; e < 4; ++e) bin4[e] = bin16(h4[e]);
                if (full) {
#pragma unroll
                    for (int e = 0; e < 4; ++e) { const int q = qh + 4 * (e >> 1) + hi + 2 * (e & 1); __hip_atomic_fetch_add(&HIST[q * 1024 + (bin4[e] >> 1)], 1u << (16 * (bin4[e] & 1u)), __ATOMIC_RELAXED, __HIP_MEMORY_SCOPE_WORKGROUP); }
                } else {
#pragma unroll
                    for (int e = 0; e < 4; ++e) { const int q = qh + 4 * (e >> 1) + hi + 2 * (e & 1); if (key <= t0 + q) __hip_atomic_fetch_add(&HIST[q * 1024 + (bin4[e] >> 1)], 1u << (16 * (bin4[e] & 1u)), __ATOMIC_RELAXED, __HIP_MEMORY_SCOPE_WORKGROUP); }
                }
            }
            { const int jn = (i0 + u + 4 < cnt4) ? (i0 + u + 4) : (cnt4 - 1); P3_LOADB(u, jn); }
        }
    }
#undef P3_LOADB
}
__device__ __forceinline__ void p3_append(unsigned cm, const v4u& hw, int k0, LAS unsigned* cnt, LAS unsigned* cand) {
    while (cm) { const int j = __ffs((int)cm) - 1; cm &= cm - 1u; const unsigned w = (j < 2) ? hw.x : (j < 4) ? hw.y : (j < 6) ? hw.z : hw.w; const unsigned h = (j & 1) ? (w >> 16) : (w & 0xffffu);
        const unsigned pos = __hip_atomic_fetch_add(cnt, 1u, __ATOMIC_RELAXED, __HIP_MEMORY_SCOPE_WORKGROUP);
        if (pos < (unsigned)P3_CAP) { cand[2 * pos] = key16(h); cand[2 * pos + 1] = (unsigned)(k0 + j); } }
}
__device__ __forceinline__ void p3_index(Frame& F) {
    unsigned char* ws = F.ws; const int tid = F.tid, lane = F.lane, wave = F.wave, n = lane & 31, hi = lane >> 5;
    const bf16* QIF = (const bf16*)(ws + WS_QIF); const bf16* KIF = (const bf16*)(ws + WS_KIF); const float* WIF = (const float*)(ws + WS_WIF); int* SEL = (int*)(ws + WS_SEL);
    unsigned short* SC = (unsigned short*)(ws + WS_PROJ) + (size_t)F.bid * 16 * SEQ;
    LAS unsigned char* lds = F.lds;
    LAS unsigned* HIST = (LAS unsigned*)(lds + P3_HIST); LAS unsigned* H2 = (LAS unsigned*)(lds + P3_H2 + wave * 4096); LAS unsigned* BM = (LAS unsigned*)(lds + P3_BM); LAS unsigned* QS = (LAS unsigned*)(lds + P3_QS);
    LAS unsigned* FBL = (LAS unsigned*)(lds + P3_QS + 1024);
    if (tid == 0) FBL[0] = 0u;
    __syncthreads();
    for (int ps = F.bid; ps < 512; ps += F.G) {
        const int b = ps >> 8, wq = ps & 255;
#pragma unroll 1
        for (int half = 0; half < 2; ++half) {
            const int idx = half ? (511 - wq) : wq; const int t0 = 16 * idx, row0 = (b << 13) + t0;
            if (idx < 16) {
                for (int e = tid; e < 16 * TOPK; e += 512) { const int q = e >> 8, i = e & 255; SEL[(size_t)(row0 + q) * TOPK + i] = (i <= t0 + q) ? i : 0; }
                continue;
            }
            for (int e = tid; e < 16384; e += 512) HIST[e] = 0u;
            if (tid < 128) QS[tid] = 0u;
            bf16x8 af[2][4]; f16x8 wa[2][2]; const int qh = 8 * (wave >> 2);
            { const int head = (n & 3) + 4 * ((n >> 3) & 1), q4 = ((n >> 2) & 1) + 2 * (n >> 4);
#pragma unroll
              for (int mt = 0; mt < 2; ++mt) { const bf16* ap = QIF + (size_t)(row0 + qh + 4 * mt + q4) * 512 + head * IDX + 32 * hi;
#pragma unroll
                  for (int s = 0; s < 4; ++s) af[mt][s] = *(const bf16x8*)(ap + 8 * s);
#pragma unroll
                  for (int sp = 0; sp < 2; ++sp) {
                      const bool on = (sp == 0) ? ((n == 0 && hi == 0) || (n == 4 && hi == 1)) : ((n == 1 && hi == 0) || (n == 5 && hi == 1));
                      const float* wp = WIF + (size_t)(row0 + qh + 4 * mt + hi + 2 * sp) * 8; const f32x4 w0 = *(const f32x4*)wp, w1 = *(const f32x4*)(wp + 4);
                      f16x8 t; t[0] = (_Float16)w0[0]; t[1] = (_Float16)w0[1]; t[2] = (_Float16)w0[2]; t[3] = (_Float16)w0[3]; t[4] = (_Float16)w1[0]; t[5] = (_Float16)w1[1]; t[6] = (_Float16)w1[2]; t[7] = (_Float16)w1[3];
                      if (!on) t = (f16x8){0, 0, 0, 0, 0, 0, 0, 0};
                      wa[mt][sp] = t; } } }
            const int nt = (t0 + 16 + 31) >> 5; const bf16* kib = KIF + (size_t)(b << 13) * IDX;
            __syncthreads();
            p3_score_pass(af, wa, kib, t0, nt, wave, n, hi, lds, SC, F.bid * 5);
            __syncthreads();
            v4u hv[16];
#define P3_LOADSC(qx) do { unsigned long long qo_ = (unsigned long long)(qx) * (SEQ * 2); asm volatile("" : "+s"(qo_)); const char* s_ = (const char*)SC + qo_; const int n_ = ((t0 + (qx)) >> 9) + 1; const unsigned lo_ = 16u * (unsigned)lane; \
                _Pragma("unroll") for (int ch = 0; ch < 16; ++ch) { hv[ch] = (v4u){0u, 0u, 0u, 0u}; if (ch < n_) hv[ch] = *(const v4u*)(s_ + 1024 * ch + lo_); } } while (0)
            P3_LOADSC(2 * wave);
#pragma unroll 1
            for (int qq = 0; qq < 2; ++qq) {
                const int q = 2 * wave + qq; unsigned T, needA, c; bool ok;
                find_bin_2048(HIST + q * 1024, (unsigned)TOPK, lane, T, needA, c, ok);
                const bool defer = !ok || c > (unsigned)P3_CAP;
                if (defer && lane == 0) { const unsigned k = __hip_atomic_fetch_add(&FBL[0], 1u, __ATOMIC_RELAXED, __HIP_MEMORY_SCOPE_WORKGROUP); if (k < 63u) FBL[1 + k] = (unsigned)(row0 + q); }
                const int tq = t0 + q, nch = (tq >> 9) + 1;
                LAS unsigned char* bmb = (LAS unsigned char*)(BM + q * 256); LAS unsigned* cand = H2; LAS unsigned* bmq = BM + q * 256;
                const bool fastp = T >= 1024u; const unsigned mcT = T - 1024u;
                const unsigned klo = (mcT == 0u) ? 0u : ((mcT + 192u) << 4), khi = (mcT == 1023u) ? 0x7fffu : (((mcT + 192u) << 4) + 15u);
                const int hiT = (int)((khi << 16) | 0xffffu), loT = (int)(klo << 16);
                if (!defer) {
                    if (fastp) {
#pragma unroll
                        for (int ch = 0; ch < 16; ++ch) {
                            if (ch < nch) {
                                const v4u hw = hv[ch]; int k0 = 512 * ch + 8 * lane; asm volatile("" : "+v"(k0));
                                int nv = tq - k0 + 1; nv = nv < 0 ? 0 : (nv > 8 ? 8 : nv); const unsigned vm = (1u << nv) - 1u;
                                unsigned am = 0u, nb = 0u;
#pragma unroll
                                for (int d = 3; d >= 0; --d) { const unsigned w = (d == 0) ? hw.x : (d == 1) ? hw.y : (d == 2) ? hw.z : hw.w; const int wh = (int)w, wl = (int)(w << 16);
                                    am = am + am + ((wh > hiT) ? 1u : 0u); nb = nb + nb + ((wh >= loT) ? 1u : 0u);
                                    am = am + am + ((wl > hiT) ? 1u : 0u); nb = nb + nb + ((wl >= loT) ? 1u : 0u); }
                                am &= vm; const unsigned cm = nb & vm & ~am;
                                bmb[64 * ch + lane] = (unsigned char)am;
                                if (__ballot(cm != 0u) != 0ull) p3_append(cm, hw, k0, &QS[q * 8 + 3], cand);
                            } else { ((LAS unsigned*)bmb)[16 * ch + (lane & 15)] = 0u; }
                        }
                    } else {
#pragma unroll 1
                        for (int ch = 0; ch < 16; ++ch) {
                            if (ch < nch) {
                                int k0 = 512 * ch + 8 * lane; asm volatile("" : "+v"(k0)); const v4u hw = *(const v4u*)(SC + (size_t)q * SEQ + k0);
                                int nv = tq - k0 + 1; nv = nv < 0 ? 0 : (nv > 8 ? 8 : nv); const unsigned vm = (1u << nv) - 1u; unsigned am = 0u, cm = 0u;
#pragma unroll
                                for (int j = 0; j < 8; ++j) { const unsigned w = (j < 2) ? hw.x : (j < 4) ? hw.y : (j < 6) ? hw.z : hw.w; const unsigned h = (j & 1) ? (w >> 16) : (w & 0xffffu);
                                    const unsigned bn = bin16(h); am |= (bn > T) ? (1u << j) : 0u; cm |= (bn == T) ? (1u << j) : 0u; }
                                am &= vm; cm &= vm;
                                bmb[64 * ch + lane] = (unsigned char)am;
                                if (__ballot(cm != 0u) != 0ull) p3_append(cm, hw, k0, &QS[q * 8 + 3], cand);
                            } else { ((LAS unsigned*)bmb)[16 * ch + (lane & 15)] = 0u; }
                        }
                    }
                }
                if (qq == 0) P3_LOADSC(2 * wave + 1);
                if (defer) continue;
                WAVE_SYNC();
                if (c <= 64u) {
                    const bool in = (unsigned)lane < c; const unsigned k32 = in ? cand[2 * lane] : 0u, ki = in ? (cand[2 * lane + 1] & 8191u) : 0u; unsigned rank = 0u;
                    for (unsigned j = 0; j < c; ++j) { const unsigned kj = (unsigned)__builtin_amdgcn_readlane((int)k32, (int)j), ij = (unsigned)__builtin_amdgcn_readlane((int)ki, (int)j); rank += (kj > k32 || (kj == k32 && ij < ki)) ? 1u : 0u; }
                    if (in && rank < needA) __hip_atomic_fetch_or(&bmq[ki >> 5], 1u << (ki & 31), __ATOMIC_RELAXED, __HIP_MEMORY_SCOPE_WORKGROUP);
                } else {
                for (unsigned i0 = 0; i0 < c; i0 += 64) { const unsigned i = i0 + lane; const bool in = i < c; const unsigned k32 = in ? cand[2 * i] : 0u, ki = in ? (cand[2 * i + 1] & 8191u) : 0u; unsigned rank = 0u;
                    for (unsigned j = 0; j < c; ++j) { const unsigned kj = cand[2 * j], ij = cand[2 * j + 1]; rank += (kj > k32 || (kj == k32 && ij < ki)) ? 1u : 0u; }
                    if (in && rank < needA) __hip_atomic_fetch_or(&bmq[ki >> 5], 1u << (ki & 31), __ATOMIC_RELAXED, __HIP_MEMORY_SCOPE_WORKGROUP); }
                }
                WAVE_SYNC();
                unsigned w0 = bmq[4 * lane], w1 = bmq[4 * lane + 1], w2 = bmq[4 * lane + 2], w3 = bmq[4 * lane + 3];
                const unsigned mycnt = __popc(w0) + __popc(w1) + __popc(w2) + __popc(w3);
                unsigned incl = mycnt;
#pragma unroll
                for (int o = 1; o < 64; o <<= 1) { const unsigned v = __shfl_up(incl, o); if (lane >= o) incl += v; }
                unsigned pos = incl - mycnt; int* sel = SEL + (size_t)(row0 + q) * TOPK;
#pragma unroll
                for (int wi = 0; wi < 4; ++wi) { unsigned w = (wi == 0) ? w0 : (wi == 1) ? w1 : (wi == 2) ? w2 : w3;
                    while (w) { const int bit = __ffs((int)w) - 1; if (pos < (unsigned)TOPK) sel[pos] = 128 * lane + 32 * wi + bit; ++pos; w &= w - 1u; } }
                WAVE_SYNC();
            }
#undef P3_LOADSC
            __syncthreads();
        }
    }
    __syncthreads();
    const unsigned nfb = FBL[0];
    for (unsigned k = 0; k < nfb && k < 63u; ++k) { const int r0 = (int)FBL[1 + k]; __syncthreads(); p3_query_naive(ws, lds, r0, SEL); }
}

typedef short v4i16_t __attribute__((ext_vector_type(4)));
typedef int v4i __attribute__((ext_vector_type(4)));
__device__ __forceinline__ v4i16_t tr16(LAS unsigned char* p) { return __builtin_amdgcn_ds_read_tr16_b64_v4i16((LAS v4i16_t*)p); }
typedef __bf16 bf16x2_t __attribute__((ext_vector_type(2)));
__device__ __forceinline__ unsigned dq2(unsigned w, bool hi) { return __builtin_bit_cast(unsigned, hi ? __builtin_amdgcn_cvt_scalef32_pk_bf16_fp8(w, 1.0f, true) : __builtin_amdgcn_cvt_scalef32_pk_bf16_fp8(w, 1.0f, false)); }
__device__ __forceinline__ bf16x8 dq8(unsigned w0, unsigned w1) { return __builtin_bit_cast(bf16x8, (v4u){dq2(w0, false), dq2(w0, true), dq2(w1, false), dq2(w1, true)}); }
__device__ __forceinline__ void p4_dsa(Frame& F) {
    unsigned char* ws = F.ws; const int lane = F.lane, nh = lane & 15, kg = lane >> 4;
    const bf16* QF = (const bf16*)(ws + WS_QF); const unsigned char* KV8 = (const unsigned char*)(ws + WS_KVF); const int* SEL = (const int*)(ws + WS_SEL); bf16* AO = (bf16*)(ws + WS_AO);
    LAS unsigned char* wl = F.lds + F.wave * 10240; LAS int* selw = (LAS int*)wl; LAS unsigned char* vb = wl + 1024;
    const int gw = F.wave * F.G + F.bid, NGW = F.G * NWAVES;
    LAS unsigned char* trp = vb + (4 * kg + ((lane >> 2) & 3)) * 288 + 8 * (lane & 3);
#pragma unroll 1
    for (int combo = 0; combo < BATCH * NKV; ++combo) {
        const int b = combo >> 1, kvh = combo & 1;
        const unsigned char* kvb = KV8 + (size_t)(b * NKV + kvh) * SEQ * 256;
#pragma unroll 1
        for (int t = gw; t < SEQ; t += NGW) {
            const int row = (b << 13) + t; const int cnt = (t + 1 < TOPK) ? (t + 1) : TOPK;
            *(LAS v4i*)(selw + 4 * lane) = *(const v4i*)(SEL + (size_t)row * TOPK + 4 * lane);
            WAVE_SYNC();
            const unsigned char* qp = (const unsigned char*)QF + (size_t)row * D + (kvh * 4 + (nh & 3)) * HD + 32 * kg;
            pg8::i32x8 q8;
            { const v4i qa = *(const v4i*)qp, qb = *(const v4i*)(qp + 16); q8 = __builtin_shufflevector(qa, qb, 0, 1, 2, 3, 4, 5, 6, 7); if (nh >= 4) q8 = (pg8::i32x8){0, 0, 0, 0, 0, 0, 0, 0}; }
            f32x4 S[16];
            v4u kq[2][4][2];
#define P4_LOADK(buf, batch) do { _Pragma("unroll") for (int tt = 0; tt < 4; ++tt) { const unsigned char* kp_ = kvb + (size_t)(selw[16 * (4 * (batch) + tt) + nh] & (SEQ - 1)) * 256 + 32 * kg; \
                kq[buf][tt][0] = *(const v4u*)(kp_); kq[buf][tt][1] = *(const v4u*)(kp_ + 16); } } while (0)
            P4_LOADK(0, 0);
#pragma unroll
            for (int bt = 0; bt < 4; ++bt) {
                if (bt < 3) P4_LOADK((bt + 1) & 1, bt + 1);
                asm volatile("" ::: "memory");
#pragma unroll
                for (int tt = 0; tt < 4; ++tt) {
                    const pg8::i32x8 k8 = __builtin_shufflevector(__builtin_bit_cast(v4i, kq[bt & 1][tt][0]), __builtin_bit_cast(v4i, kq[bt & 1][tt][1]), 0, 1, 2, 3, 4, 5, 6, 7);
                    S[4 * bt + tt] = __builtin_amdgcn_mfma_scale_f32_16x16x128_f8f6f4(k8, q8, (f32x4){0.f, 0.f, 0.f, 0.f}, 0, 0, 0, 0, 0, 0);
                }
            }
#undef P4_LOADK
            v4u g[3][4];
#define P4_LOADV(buf, c_) do { _Pragma("unroll") for (int i = 0; i < 4; ++i) { const int key_ = selw[32 * (c_) + (lane >> 3) + 8 * i] & (SEQ - 1); g[buf][i] = *(const v4u*)(kvb + (size_t)key_ * 256 + 128 + 16 * (lane & 7)); } } while (0)
            P4_LOADV(0, 0); P4_LOADV(1, 1); P4_LOADV(2, 2);
            float mx = -INFINITY;
#pragma unroll
            for (int T = 0; T < 16; ++T)
#pragma unroll
                for (int r = 0; r < 4; ++r) { const float v = (16 * T + 4 * kg + r < cnt) ? S[T][r] : -INFINITY; S[T][r] = v; mx = fmaxf(mx, v); }
            mx = fmaxf(mx, __shfl_xor(mx, 16)); mx = fmaxf(mx, __shfl_xor(mx, 32));
            float sum = 0.f;
#pragma unroll
            for (int T = 0; T < 16; ++T)
#pragma unroll
                for (int r = 0; r < 4; ++r) { const float e = __builtin_amdgcn_exp2f((S[T][r] - mx) * (1.0f / P4_QS)); S[T][r] = e; sum += e; }
            sum += __shfl_xor(sum, 16); sum += __shfl_xor(sum, 32);
            bf16x8 pa[8];
#pragma unroll
            for (int c = 0; c < 8; ++c) { v4u pw; pw.x = pg8::cvt_pk_bf16(S[2 * c][0], S[2 * c][1]); pw.y = pg8::cvt_pk_bf16(S[2 * c][2], S[2 * c][3]); pw.z = pg8::cvt_pk_bf16(S[2 * c + 1][0], S[2 * c + 1][1]); pw.w = pg8::cvt_pk_bf16(S[2 * c + 1][2], S[2 * c + 1][3]); pa[c] = __builtin_bit_cast(bf16x8, pw); }
            f32x4 O[8];
#pragma unroll
            for (int d = 0; d < 8; ++d) O[d] = (f32x4){0.f, 0.f, 0.f, 0.f};
#pragma unroll
            for (int c = 0; c < 8; ++c) {
#pragma unroll
                for (int i = 0; i < 4; ++i) { const v4u gg = g[c % 3][i]; LAS unsigned char* dst = vb + ((lane >> 3) + 8 * i) * 288 + 32 * (lane & 7);
                    *(LAS v4u*)dst = __builtin_bit_cast(v4u, dq8(gg.x, gg.y)); *(LAS v4u*)(dst + 16) = __builtin_bit_cast(v4u, dq8(gg.z, gg.w)); }
                asm volatile("" ::: "memory");
                if (c < 5) P4_LOADV(c % 3, c + 3);
#pragma unroll
                for (int d = 0; d < 8; ++d) {
                    const v4i16_t lo = tr16(trp + 32 * d), hi4 = tr16(trp + 16 * 288 + 32 * d);
                    const bf16x8 vfr = (bf16x8){lo[0], lo[1], lo[2], lo[3], hi4[0], hi4[1], hi4[2], hi4[3]};
                    O[d] = __builtin_amdgcn_mfma_f32_16x16x32_bf16(pa[c], vfr, O[d], 0, 0, 0);
                }
            }
#undef P4_LOADV
            const float i0 = 1.0f / __builtin_bit_cast(float, __builtin_amdgcn_readlane(__builtin_bit_cast(int, sum), 0)), i1 = 1.0f / __builtin_bit_cast(float, __builtin_amdgcn_readlane(__builtin_bit_cast(int, sum), 1));
            const float i2 = 1.0f / __builtin_bit_cast(float, __builtin_amdgcn_readlane(__builtin_bit_cast(int, sum), 2)), i3 = 1.0f / __builtin_bit_cast(float, __builtin_amdgcn_readlane(__builtin_bit_cast(int, sum), 3));
            LAS bf16* ost = (LAS bf16*)vb;
            if (kg == 0) {
#pragma unroll
                for (int d = 0; d < 8; ++d) { ost[0 * 128 + 16 * d + nh] = (bf16)f2bf(O[d][0] * i0); ost[1 * 128 + 16 * d + nh] = (bf16)f2bf(O[d][1] * i1); ost[2 * 128 + 16 * d + nh] = (bf16)f2bf(O[d][2] * i2); ost[3 * 128 + 16 * d + nh] = (bf16)f2bf(O[d][3] * i3); }
            }
            WAVE_SYNC();
            const v4u ov = *(LAS v4u*)(vb + 16 * lane);
            *(v4u*)(AO + (size_t)row * D + (kvh * 4 + kg) * HD + 8 * nh) = ov;
            WAVE_SYNC();
        }
    }
}

__device__ __forceinline__ void p9_sb(Frame& F) {
    unsigned char* ws = F.ws; const int lane = F.lane, n = lane & 31, hi = lane >> 5;
    const bf16* KQ = (const bf16*)(ws + WS_KQ); const bf16* VT = (const bf16*)(ws + WS_VT); bf16* AO = (bf16*)(ws + WS_AO);
    const int gw = F.wave * F.G + F.bid, NGW = F.G * NWAVES;
    const int koff = 16 * (n >> 4) + 8 * ((n >> 2) & 1) + 4 * ((n >> 3) & 1) + (n & 3);
    constexpr float LOG2E = 1.4426950408889634f, LN2 = 0.6931471805599453f;
    for (int u = gw; u < (M / 32) * NH; u += NGW) {
        const int h = u & 7, blk = u >> 3, b = blk >> 8, qb = blk & 255, q0 = 32 * qb, t = q0 + n;
        const bf16* qp = KQ + (size_t)(b * SEQ + q0 + n) * 2048 + 1024 + h * HD + 64 * hi;
        bf16x8 qf[8];
#pragma unroll
        for (int s = 0; s < 8; ++s) qf[s] = *(const bf16x8*)(qp + 8 * s);
        f32x16 o[4];
#pragma unroll
        for (int mt = 0; mt < 4; ++mt)
#pragma unroll
            for (int r = 0; r < 16; ++r) o[mt][r] = 0.f;
        float C = 0.f;
        bf16x8 kf[8];
        { const bf16* kp = KQ + (size_t)(b * SEQ + 32 * qb + koff) * 2048 + h * HD + 64 * hi;
#pragma unroll
          for (int s = 0; s < 8; ++s) kf[s] = *(const bf16x8*)(kp + 8 * s); }
        for (int kb = qb; kb >= 0; --kb) {
            const int k0 = 32 * kb;
            bf16x8 vf[4][2];
#pragma unroll
            for (int mt = 0; mt < 4; ++mt)
#pragma unroll
                for (int sp = 0; sp < 2; ++sp) vf[mt][sp] = *(const bf16x8*)(VT + (size_t)(h * HD + 32 * mt + n) * M + b * SEQ + k0 + 16 * sp + 8 * hi);
            f32x16 z;
#pragma unroll
            for (int r = 0; r < 16; ++r) z[r] = 0.f;
#pragma unroll
            for (int s = 0; s < 8; ++s) z = __builtin_amdgcn_mfma_f32_32x32x16_bf16(kf[s], qf[s], z, 0, 0, 0);
            { const int kn = (kb > 0) ? kb - 1 : 0; const bf16* kp = KQ + (size_t)(b * SEQ + 32 * kn + koff) * 2048 + h * HD + 64 * hi;
#pragma unroll
              for (int s = 0; s < 8; ++s) kf[s] = *(const bf16x8*)(kp + 8 * s); }
            float lk[16], lb[16];
#pragma unroll
            for (int r = 0; r < 16; ++r) {
                const int key = k0 + ((r < 8) ? (8 * hi + r) : (16 + 8 * hi + (r - 8)));
                const float zz = z[r]; const float L = __builtin_amdgcn_logf(1.0f + __builtin_amdgcn_exp2f(-fabsf(zz) * LOG2E)) * LN2;
                const bool valid = key < t;
                lk[r] = valid ? (-fmaxf(zz, 0.f) - L) : 0.f;
                lb[r] = valid ? (fminf(zz, 0.f) - L) : -INFINITY;
            }
            float suf[16];
            suf[7] = 0.f; suf[15] = 0.f;
#pragma unroll
            for (int i = 6; i >= 0; --i) { suf[i] = suf[i + 1] + lk[i + 1]; suf[8 + i] = suf[9 + i] + lk[9 + i]; }
            const float T0 = suf[0] + lk[0], T1 = suf[8] + lk[8];
            const float P0 = __shfl_xor(T0, 32), P1 = __shfl_xor(T1, 32);
            const float base1 = C + (hi ? 0.f : P1), base0 = C + (hi ? (T1 + P1) : (P0 + T1 + P1));
            unsigned pw[8];
#pragma unroll
            for (int r = 0; r < 16; r += 2) {
                const float a0 = __builtin_amdgcn_exp2f((lb[r] + ((r < 8) ? base0 : base1) + suf[r]) * LOG2E), a1 = __builtin_amdgcn_exp2f((lb[r + 1] + ((r < 8) ? base0 : base1) + suf[r + 1]) * LOG2E);
                pw[r >> 1] = pg8::cvt_pk_bf16(a0, a1);
            }
            C += (T0 + T1) + (P0 + P1);
            const bf16x8 pa0 = __builtin_bit_cast(bf16x8, (v4u){pw[0], pw[1], pw[2], pw[3]}), pa1 = __builtin_bit_cast(bf16x8, (v4u){pw[4], pw[5], pw[6], pw[7]});
#pragma unroll
            for (int mt = 0; mt < 4; ++mt) { o[mt] = __builtin_amdgcn_mfma_f32_32x32x16_bf16(vf[mt][0], pa0, o[mt], 0, 0, 0); o[mt] = __builtin_amdgcn_mfma_f32_32x32x16_bf16(vf[mt][1], pa1, o[mt], 0, 0, 0); }
            if (__all(C < -44.0f)) break;
        }
        bf16* op = AO + (size_t)(b * SEQ + q0 + n) * D + h * HD + 4 * hi;
#pragma unroll
        for (int mt = 0; mt < 4; ++mt)
#pragma unroll
            for (int g = 0; g < 4; ++g) { v2u w; w.x = pg8::cvt_pk_bf16(o[mt][4 * g], o[mt][4 * g + 1]); w.y = pg8::cvt_pk_bf16(o[mt][4 * g + 2], o[mt][4 * g + 3]); *(v2u*)(op + 32 * mt + 8 * g) = w; }
    }
}

__device__ __forceinline__ void p11_router(Frame& F) {
    unsigned char* ws = F.ws; const int tid = F.tid, lane = F.lane, wave = F.wave;
    const bf16* H = (const bf16*)(ws + WS_H); const float* gn = F.in[IN_FFNNORM] + D; const float* Wr = F.in[IN_ROUTER];
    int* TOPE = (int*)(ws + WS_RT); int* POS = (int*)(ws + WS_RT + 128 * 1024); float* GATE = (float*)(ws + WS_RT + 256 * 1024); float* RSTD3 = (float*)(ws + WS_RT + 384 * 1024);
    LAS unsigned* lcnt = (LAS unsigned*)F.lds;
    LAS unsigned* gb = (LAS unsigned*)(F.lds + 64);
    LAS int* ltok = (LAS int*)(F.lds + 128);
    LAS float* lgt = (LAS float*)(F.lds + 128 + 1024);
    for (int chunk = F.bid; chunk < M / 64; chunk += F.G) {
        if (tid < 8) lcnt[tid] = 0u;
        __syncthreads();
        for (int r = 0; r < 8; ++r) {
            const int row = chunk * 64 + wave * 8 + r;
            const GAS v2u* xr = (const GAS v2u*)(H + (size_t)row * D) + lane; f32x4 v[4]; float ss = 0.f;
#pragma unroll
            for (int j = 0; j < 4; ++j) { const v2u w = xr[64 * j]; v[j] = (f32x4){bflo(w.x), bfhi(w.x), bflo(w.y), bfhi(w.y)}; ss += (v[j].x * v[j].x + v[j].y * v[j].y) + (v[j].z * v[j].z + v[j].w * v[j].w); }
            ss = wave_sum(ss); const float rs = 1.0f / sqrtf(ss * (1.0f / 1024.0f) + 1e-6f);
            float lg[8] = {0.f, 0.f, 0.f, 0.f, 0.f, 0.f, 0.f, 0.f};
#pragma unroll
            for (int j = 0; j < 4; ++j)
#pragma unroll
                for (int i = 0; i < 4; ++i) { const int k = 256 * j + 4 * lane + i; const float xv = v[j][i] * gn[k]; const f32x4 w0 = *(const f32x4*)(Wr + (size_t)k * 8), w1 = *(const f32x4*)(Wr + (size_t)k * 8 + 4);
                    lg[0] += xv * w0[0]; lg[1] += xv * w0[1]; lg[2] += xv * w0[2]; lg[3] += xv * w0[3]; lg[4] += xv * w1[0]; lg[5] += xv * w1[1]; lg[6] += xv * w1[2]; lg[7] += xv * w1[3]; }
#pragma unroll
            for (int e = 0; e < 8; ++e) lg[e] = wave_sum(lg[e]) * rs;
            int i1 = 0; float l1 = lg[0];
#pragma unroll
            for (int e = 1; e < 8; ++e) if (lg[e] > l1) { l1 = lg[e]; i1 = e; }
            int i2 = -1; float l2 = -INFINITY;
#pragma unroll
            for (int e = 0; e < 8; ++e) if (e != i1 && lg[e] > l2) { l2 = lg[e]; i2 = e; }
            const float g1 = 1.0f / (1.0f + __expf(l2 - l1)), g2 = 1.0f - g1;
            if (lane == 0) {
                const unsigned p1 = __hip_atomic_fetch_add(&lcnt[i1], 1u, __ATOMIC_RELAXED, __HIP_MEMORY_SCOPE_WORKGROUP), p2 = __hip_atomic_fetch_add(&lcnt[i2], 1u, __ATOMIC_RELAXED, __HIP_MEMORY_SCOPE_WORKGROUP);
                const int ti = wave * 8 + r; ltok[ti * 4 + 0] = i1; ltok[ti * 4 + 1] = i2; ltok[ti * 4 + 2] = (int)p1; ltok[ti * 4 + 3] = (int)p2;
                lgt[ti * 4 + 0] = g1; lgt[ti * 4 + 1] = g2; lgt[ti * 4 + 2] = rs;
            }
        }
        __syncthreads();
        if (tid < 8) gb[tid] = __hip_atomic_fetch_add(F.ctl + CW_CNT + tid, lcnt[tid], RLX_AGENT);
        __syncthreads();
        if (tid < 64) { const int row = chunk * 64 + tid; const int e1 = ltok[tid * 4], e2 = ltok[tid * 4 + 1];
            TOPE[row * 2] = e1; TOPE[row * 2 + 1] = e2; POS[row * 2] = (int)gb[e1] + ltok[tid * 4 + 2]; POS[row * 2 + 1] = (int)gb[e2] + ltok[tid * 4 + 3];
            GATE[row * 2] = lgt[tid * 4]; GATE[row * 2 + 1] = lgt[tid * 4 + 1]; RSTD3[row] = lgt[tid * 4 + 2]; }
        __syncthreads();
    }
}
__device__ __forceinline__ void moe_bases(Frame& F, int (&tb)[9]) {
    int acc = 0;
#pragma unroll
    for (int e = 0; e < 8; ++e) { tb[e] = acc; const unsigned c = __hip_atomic_load(F.ctl + CW_CNT + e, RLX_AGENT); acc += (int)((c + 255u) >> 8); }
    tb[8] = acc;
}
__device__ __forceinline__ void p12_permute(Frame& F) {
    unsigned char* ws = F.ws; const int lane = F.lane;
    const int* TOPE = (const int*)(ws + WS_RT); const int* POS = (const int*)(ws + WS_RT + 128 * 1024); const float* RSTD3 = (const float*)(ws + WS_RT + 384 * 1024);
    int* SLOT = (int*)(ws + WS_RT + 512 * 1024);
    const bf16* H = (const bf16*)(ws + WS_H); bf16* XP = (bf16*)(ws + WS_XPERM);
    int tb[9]; moe_bases(F, tb);
    const int gw = F.wave * F.G + F.bid, NGW = F.G * NWAVES;
    for (int i = gw; i < 2 * M; i += NGW) {
        const int row = i >> 1; const int e = TOPE[i]; int base = 0;
#pragma unroll
        for (int k = 0; k < 8; ++k) base = (e == k) ? tb[k] : base;
        const int slot = base * 256 + POS[i];
        const float rs = RSTD3[row];
        const GAS v2u* src = (const GAS v2u*)(H + (size_t)row * D) + lane; GAS unsigned* dst = (GAS unsigned*)((unsigned char*)XP + (size_t)slot * D) + lane;
        const float r16 = rs * pg8::F8_SX;
#pragma unroll
        for (int j = 0; j < 4; ++j) { const v2u w = src[64 * j]; dst[64 * j] = pg8::pk4_fp8(bflo(w.x) * r16, bfhi(w.x) * r16, bflo(w.y) * r16, bfhi(w.y) * r16); }
        if (lane == 0) SLOT[i] = slot;
    }
}
__device__ __forceinline__ void p15_combine(Frame& F) {
    unsigned char* ws = F.ws; const int lane = F.lane;
    const bf16* H = (const bf16*)(ws + WS_H); const bf16* Y = (const bf16*)(ws + WS_Y); const int* SLOT = (const int*)(ws + WS_RT + 512 * 1024); const float* GATE = (const float*)(ws + WS_RT + 256 * 1024);
    const int gw = F.wave * F.G + F.bid, NGW = F.G * NWAVES;
    for (int row = gw; row < M; row += NGW) {
        const int s1 = SLOT[row * 2], s2 = SLOT[row * 2 + 1]; const float g1 = GATE[row * 2], g2 = GATE[row * 2 + 1];
        const GAS v2u* hr = (const GAS v2u*)(H + (size_t)row * D) + lane; GAS f32x4* orow = (GAS f32x4*)(F.out + (size_t)row * D) + lane;
        const GAS v2u* y1 = (const GAS v2u*)(Y + (size_t)s1 * D) + lane; const GAS v2u* y2 = (const GAS v2u*)(Y + (size_t)s2 * D) + lane;
#pragma unroll
        for (int j = 0; j < 4; ++j) { const v2u hw = __builtin_nontemporal_load(hr + 64 * j); const f32x4 h = (f32x4){bflo(hw.x), bfhi(hw.x), bflo(hw.y), bfhi(hw.y)}; const v2u a = __builtin_nontemporal_load(y1 + 64 * j), c = __builtin_nontemporal_load(y2 + 64 * j); f32x4 o;
            o.x = h.x + (g1 * bflo(a.x) + g2 * bflo(c.x)); o.y = h.y + (g1 * bfhi(a.x) + g2 * bfhi(c.x)); o.z = h.z + (g1 * bflo(a.y) + g2 * bflo(c.y)); o.w = h.w + (g1 * bfhi(a.y) + g2 * bfhi(c.y)); orow[64 * j] = o; }
    }
}

constexpr int N_PHASES = 16;
#ifndef MK_ONE_LAUNCH
#define MK_ONE_LAUNCH 1
#endif
struct Args { const float* in[17]; float* out; unsigned char* ws; int ph_lo, ph_hi; };
__global__ void __launch_bounds__(NWAVES * 64, 2) yoco_fwd(Args args) {
    extern __shared__ __attribute__((aligned(16))) unsigned char lds[];
    Frame F;
    F.lds = (LAS unsigned char*)lds; F.MISC = (volatile LAS unsigned*)(F.lds + MISC_OFF);
    F.tid = threadIdx.x; F.lane = F.tid & 63; F.wave = __builtin_amdgcn_readfirstlane(F.tid >> 6); F.G = gridDim.x; F.bid = blockIdx.x;
    F.ws = args.ws; F.ctl = (gu32*)(args.ws + WS_CTL); F.out = args.out;
#pragma unroll
    for (int i = 0; i < 17; ++i) F.in[i] = args.in[i];
    for (int u = F.tid; u < (LDS_BYTES - LDSCTL_OFF) / 4; u += NWAVES * 64) ((LAS unsigned*)(F.lds + LDSCTL_OFF))[u] = 0u;
    __syncthreads();
    unsigned char* ws = args.ws;
    XcdBarrier bar; bar.bar = (unsigned*)(F.ctl + CW_BAR); bar.x = 0; bar.st = nullptr;
    if (MK_ONE_LAUNCH) bar = xcd_barrier_post((unsigned*)(F.ctl + CW_BAR), F.MISC + 8);
    const int lo = args.ph_lo, hi = args.ph_hi;
#define IN(k) (lo <= (k) && (k) < hi)
#define SEAM(k) do { if (MK_ONE_LAUNCH && IN((k) + 1)) xcd_barrier(bar); } while (0)
    bf16* XB = (bf16*)(ws + WS_XB); bf16* H = (bf16*)(ws + WS_H); bf16* AO = (bf16*)(ws + WS_AO);

    if (IN(0)) { p0_prologue(F); SEAM(0); }
    if (IN(1)) {
        pg8::Gemm g{XB, (const bf16*)(ws + WS_WIN), M, 2048, D}; pg8::StaticOrder S; S.init(M, 2048, F.G, F.bid);
        pg8::EpiProj E{ws + WS_QF, ws + WS_KVF, (bf16*)(ws + WS_QIF), F.in[IN_AQN], F.in[IN_AKN], (const unsigned*)(ws + WS_ROPE), (LAS float*)(F.lds + PS_OFF), QSCALE * P4_QS};
        pg8::gemm_phase<pg8::EpiProj, pg8::StaticOrder, true, true>(F.lds, g, S, E); }
    if (IN(2)) { p2_post(F); SEAM(2); }
    if (IN(3)) { p3_index(F); SEAM(3); }
    if (IN(4)) { p4_dsa(F); SEAM(4); }
    if (IN(5)) {
        pg8::Gemm g{AO, (const bf16*)(ws + WS_WOA), M, D, D}; pg8::StaticOrder S; S.init(M, D, F.G, F.bid);
        pg8::EpiResid<true, false> E{F.in[IN_X], H, (unsigned char*)XB, (float*)(ws + WS_SS1), 1.0f};
        pg8::gemm_phase<pg8::EpiResid<true, false>, pg8::StaticOrder, true, true>(F.lds, g, S, E); SEAM(5); }
    if (IN(6)) {
        pg8::Gemm g{XB, (const bf16*)(ws + WS_WGU), M, 2 * FF, D / 2}; pg8::StaticOrder S; S.init(M, 2 * FF, F.G, F.bid);
        pg8::EpiSwiGLU8<false> E{ws + WS_HF, FF, (const float*)(ws + WS_SS1)};
        pg8::gemm_phase<pg8::EpiSwiGLU8<false>, pg8::StaticOrder, true, true, true>(F.lds, g, S, E); SEAM(6); }
    if (IN(7)) {
        pg8::Gemm g{(const bf16*)(ws + WS_HF), (const bf16*)(ws + WS_WD), M, D, FF / 2}; pg8::StaticOrder S; S.init(M, D, F.G, F.bid);
        pg8::EpiResid<false, true> E{H, H, nullptr, (float*)(ws + WS_SS2), 1.0f / (pg8::F8_SH * pg8::F8_SWD)};
        pg8::gemm_phase<pg8::EpiResid<false, true>, pg8::StaticOrder, true, true, true>(F.lds, g, S, E); SEAM(7); }
    if (IN(8)) {
        { pg8::Gemm g{H, (const bf16*)(ws + WS_WKVQ), M, 2048, D}; pg8::StaticOrder S; S.init(M, 2048, F.G, F.bid);
          pg8::EpiScaleBf16 E{(bf16*)(ws + WS_KQ), 2048, (const float*)(ws + WS_SS2)};
          pg8::gemm_phase<pg8::EpiScaleBf16, pg8::StaticOrder, true, true>(F.lds, g, S, E); }
        { pg8::Gemm g{(const bf16*)(ws + WS_WKVQ) + (size_t)2048 * D, H, D, M, D}; pg8::StaticOrder S; S.init(D, M, F.G, F.bid);
          pg8::EpiScaleColBf16 E{(bf16*)(ws + WS_VT), M, (const float*)(ws + WS_SS2)};
          pg8::gemm_phase<pg8::EpiScaleColBf16, pg8::StaticOrder, true, true>(F.lds, g, S, E); }
        SEAM(8); }
    if (IN(9)) { p9_sb(F); SEAM(9); }
    if (IN(10)) {
        pg8::Gemm g{AO, (const bf16*)(ws + WS_WOB), M, D, D}; pg8::StaticOrder S; S.init(M, D, F.G, F.bid);
        pg8::EpiResid<false, true> E{H, H, nullptr, (float*)(ws + WS_SS3), 1.0f};
        pg8::gemm_phase<pg8::EpiResid<false, true>, pg8::StaticOrder, true, true>(F.lds, g, S, E); SEAM(10); }
    if (IN(11)) { p11_router(F); SEAM(11); }
    if (IN(12)) { p12_permute(F); SEAM(12); }
    if (IN(13)) {
        pg8::MoeOrder S; moe_bases(F, S.tb); S.npn = 22; S.G = F.G; S.c = F.bid;
        pg8::Gemm g{(const bf16*)(ws + WS_XPERM), (const bf16*)(ws + WS_WGUM), MAXSLOT, NE * 2 * FF, D / 2};
        pg8::EpiSwiGLU8<true> E{ws + WS_HM, FF, nullptr};
        pg8::gemm_phase<pg8::EpiSwiGLU8<true>, pg8::MoeOrder, true, true, true>(F.lds, g, S, E); SEAM(13); }
    if (IN(14)) {
        pg8::MoeOrder S; moe_bases(F, S.tb); S.npn = 4; S.G = F.G; S.c = F.bid;
        pg8::Gemm g{(const bf16*)(ws + WS_HM), (const bf16*)(ws + WS_WDM), MAXSLOT, NE * D, FF / 2};
        pg8::EpiScaledBf16 E{(bf16*)(ws + WS_Y), D, 3, 1.0f / (pg8::F8_SH * pg8::F8_SWD)};
        pg8::gemm_phase<pg8::EpiScaledBf16, pg8::MoeOrder, true, true, true>(F.lds, g, S, E); SEAM(14); }
    if (IN(15)) { p15_combine(F); }
#undef IN
#undef SEAM
}

extern "C" void kernel_launch(void* const* d_in, const int* in_sizes, int n_in, void* d_out, int out_size, void* d_ws, size_t ws_size, hipStream_t stream) {
    static int grid = 0;
    if (grid == 0) {
        if (n_in != 17 || out_size != M * D || ws_size < WS_END) { fprintf(stderr, "kernel_launch: unexpected problem (n_in %d, out %d, ws %zu < %zu)\n", n_in, out_size, ws_size, (size_t)WS_END); grid = -1; return; }
        int dev = 0, cus = 0, per_cu = 0;
        if (hipGetDevice(&dev) != hipSuccess || hipDeviceGetAttribute(&cus, hipDeviceAttributeMultiprocessorCount, dev) != hipSuccess) { grid = -1; return; }
        if (hipFuncSetAttribute((const void*)yoco_fwd, hipFuncAttributeMaxDynamicSharedMemorySize, LDS_BYTES) != hipSuccess) { fprintf(stderr, "kernel_launch: hipFuncSetAttribute failed\n"); grid = -1; return; }
        if (hipOccupancyMaxActiveBlocksPerMultiprocessor(&per_cu, (const void*)yoco_fwd, NWAVES * 64, LDS_BYTES) != hipSuccess || per_cu < 1) fprintf(stderr, "kernel_launch: occupancy query says %d\n", per_cu);
        (void)hipGetLastError();
        grid = cus < 256 ? cus : 256;
    }
    if (grid < 0) return;
    if (hipMemsetAsync((char*)d_ws + WS_CTL, 0, CTL_ZERO_BYTES, stream) != hipSuccess) return;
    Args a{};
    for (int i = 0; i < 17; ++i) a.in[i] = (const float*)d_in[i];
    a.out = (float*)d_out; a.ws = (unsigned char*)d_ws;
#if MK_ONE_LAUNCH
    a.ph_lo = 0; a.ph_hi = N_PHASES;
    hipLaunchKernelGGL(yoco_fwd, dim3(grid), dim3(NWAVES * 64), LDS_BYTES, stream, a);
#else
    for (int p = 0; p < N_PHASES; ++p) { a.ph_lo = p; a.ph_hi = p + 1; hipLaunchKernelGGL(yoco_fwd, dim3(grid), dim3(NWAVES * 64), LDS_BYTES, stream, a); }
#endif
}
```

```cpp
#include <hip/hip_runtime.h>
#include <cstdio>
#include <cstdint>

namespace pg8 {
#define PG8_LAS __attribute__((address_space(3)))
typedef unsigned short bf16_t;
typedef short bf16x8 __attribute__((ext_vector_type(8)));
typedef float f32x4 __attribute__((ext_vector_type(4)));
typedef unsigned u32x4 __attribute__((ext_vector_type(4)));
typedef int i32x4 __attribute__((ext_vector_type(4)));
typedef int i32x8 __attribute__((ext_vector_type(8)));
constexpr int BM = 256, BK = 64, HALF = 128, HTB = HALF * BK * 2  , STAGE_BYTES = 8 * HTB, NXCD = 8, WGM = 8;

__host__ __device__ __forceinline__ int lds_byte(int r, int c) { const int st = (r >> 4) * 2 + (c >> 5), rr = r & 15, cc = c & 31, ob = rr * 64 + cc * 2; return st * 1024 + (ob ^ (((ob >> 9) & 1) << 5)); }
__host__ __device__ __forceinline__ void stage_rc(int b, int& R, int& C) { const int st = b / 1024, sb = b % 1024, swz = sb ^ (((sb >> 9) & 1) << 5); R = (st >> 1) * 16 + swz / 64; C = (st & 1) * 32 + (swz % 64) / 2; }
__host__ __device__ __forceinline__ int perm32(int rho) { const int n = rho >> 4, i = rho & 15; return 8 * (i >> 2) + 4 * n + (i & 3); }

struct Unit { int pm, pn; int koff = 0; int hn = 0; int rnd = 0; };
struct Gemm { const bf16_t* A; const bf16_t* Bt; int M, N, K; int ld = 0; };

struct StaticOrder {
    int nM, nN, nwg, G, c;
    __host__ __device__ void init(int M, int N, int G_, int c_) { nM = M / BM; nN = N / BM; nwg = nM * nN; G = G_; c = c_; }
    __host__ __device__ __forceinline__ bool next(int i, Unit& u) const {
        long L = (long)i * G + c; u.hn = 0; u.rnd = i;
        { const int F = nwg / G, R = nwg - F * G; if (i == F && R > 0 && 2 * R <= G) { if (c >= 2 * R) return false; L = (long)F * G + (c >> 1); u.hn = 1 + (c & 1); } }
        if (L >= nwg) return false;
        int wgid = (int)L; { const int q = nwg / NXCD, r = nwg % NXCD, xcd = wgid % NXCD, off = wgid / NXCD; wgid = (xcd < r ? xcd * (q + 1) : r * (q + 1) + (xcd - r) * q) + off; }
        const int nig = WGM * nN, gid = wgid / nig, fm = gid * WGM, gsz = (nM - fm) < WGM ? (nM - fm) : WGM;
        u.pm = fm + ((wgid % nig) % gsz); u.pn = (wgid % nig) / gsz; return true;
    }
    __device__ __forceinline__ void a_ready(const Unit&) const {}
    __device__ __forceinline__ void done(const Unit&) const {}
};

__device__ __forceinline__ unsigned cvt_pk_bf16(float lo, float hi) { unsigned r; asm volatile("v_cvt_pk_bf16_f32 %0, %1, %2" : "=v"(r) : "v"(lo), "v"(hi)); return r; }
typedef unsigned u32x2 __attribute__((ext_vector_type(2)));
constexpr float RMS_EPS = 1e-6f;
__device__ __forceinline__ float rstd16(const float* p) {
    const f32x4 a = *(const f32x4*)p, b = *(const f32x4*)(p + 4), c = *(const f32x4*)(p + 8), d = *(const f32x4*)(p + 12);
    const float s = (((a[0] + a[1]) + (a[2] + a[3])) + ((b[0] + b[1]) + (b[2] + b[3]))) + (((c[0] + c[1]) + (c[2] + c[3])) + ((d[0] + d[1]) + (d[2] + d[3])));
    return 1.0f / sqrtf(s * (1.0f / 1024.0f) + RMS_EPS);
}
struct EpiScaleBf16 {
    static constexpr bool PERM = true, AFTER_DRAIN = false;
    bf16_t* O; int ldc; PG8_LAS const float* rsl; float sc0, sc1;
    __device__ __forceinline__ void operator()(const f32x4 (&acc)[2][2][4][2], const Unit& u, int wr, int wc, int fr, int fq) const {
        const int row0 = u.pm * BM + wr * 64 + fr, col0 = u.pn * BM + wc * 32 + 8 * fq;
        float rsv[2][4];
#pragma unroll
        for (int ai = 0; ai < 2; ++ai)
#pragma unroll
            for (int m = 0; m < 4; ++m) rsv[ai][m] = rsl[u.rnd * BM + wr * 64 + fr + ai * HALF + m * 16] * ((u.pn < 4) ? sc0 : sc1);
#pragma unroll
        for (int ai = 0; ai < 2; ++ai)
#pragma unroll
            for (int m = 0; m < 4; ++m) { const int row = row0 + ai * HALF + m * 16; const float rs = rsv[ai][m]; bf16_t* rowp = O + (size_t)row * ldc + col0;
#pragma unroll
                for (int bj = 0; bj < 2; ++bj) { const f32x4 v0 = acc[ai][bj][m][0] * rs, v1 = acc[ai][bj][m][1] * rs;
                    u32x4 w; w.x = cvt_pk_bf16(v0[0], v0[1]); w.y = cvt_pk_bf16(v0[2], v0[3]); w.z = cvt_pk_bf16(v1[0], v1[1]); w.w = cvt_pk_bf16(v1[2], v1[3]);
                    *(u32x4*)(rowp + bj * HALF) = w; } }
    }
};
struct EpiPlainBf16 {
    static constexpr bool PERM = true, AFTER_DRAIN = false;
    bf16_t* O; int ldc; int pnmask;
    __device__ __forceinline__ void operator()(const f32x4 (&acc)[2][2][4][2], const Unit& u, int wr, int wc, int fr, int fq) const {
        const int row0 = u.pm * BM + wr * 64 + fr, col0 = (u.pn & pnmask) * BM + wc * 32 + 8 * fq;
#pragma unroll
        for (int ai = 0; ai < 2; ++ai)
#pragma unroll
            for (int m = 0; m < 4; ++m) { bf16_t* rowp = O + (size_t)(row0 + ai * HALF + m * 16) * ldc + col0;
#pragma unroll
                for (int bj = 0; bj < 2; ++bj) { const f32x4 v0 = acc[ai][bj][m][0], v1 = acc[ai][bj][m][1];
                    u32x4 w; w.x = cvt_pk_bf16(v0[0], v0[1]); w.y = cvt_pk_bf16(v0[2], v0[3]); w.z = cvt_pk_bf16(v1[0], v1[1]); w.w = cvt_pk_bf16(v1[2], v1[3]);
                    *(u32x4*)(rowp + bj * HALF) = w; } }
    }
};
struct EpiScaleColBf16 {
    static constexpr bool PERM = true, AFTER_DRAIN = false;
    bf16_t* O; int ldc; PG8_LAS const float* rsl; float sc;
    __device__ __forceinline__ void operator()(const f32x4 (&acc)[2][2][4][2], const Unit& u, int wr, int wc, int fr, int fq) const {
        const int row0 = u.pm * BM + wr * 64 + fr, col0 = u.pn * BM + wc * 32 + 8 * fq;
        f32x4 rs[2][2];
#pragma unroll
        for (int bj = 0; bj < 2; ++bj)
#pragma unroll
            for (int n = 0; n < 2; ++n) rs[bj][n] = *(const PG8_LAS f32x4*)(rsl + u.rnd * BM + wc * 32 + 8 * fq + bj * HALF + 4 * n) * sc;
#pragma unroll
        for (int ai = 0; ai < 2; ++ai)
#pragma unroll
            for (int m = 0; m < 4; ++m) { const int row = row0 + ai * HALF + m * 16; bf16_t* rowp = O + (size_t)row * ldc + col0;
#pragma unroll
                for (int bj = 0; bj < 2; ++bj) { const f32x4 v0 = acc[ai][bj][m][0] * rs[bj][0], v1 = acc[ai][bj][m][1] * rs[bj][1];
                    u32x4 w; w.x = cvt_pk_bf16(v0[0], v0[1]); w.y = cvt_pk_bf16(v0[2], v0[3]); w.z = cvt_pk_bf16(v1[0], v1[1]); w.w = cvt_pk_bf16(v1[2], v1[3]);
                    *(u32x4*)(rowp + bj * HALF) = w; } }
    }
};
constexpr float F8_SX = 16.f, F8_SWGU = 512.f, F8_SH = 16.f, F8_SWD = 1024.f;
__device__ __forceinline__ unsigned pk4_fp8(float a, float b, float c, float d) {
    a = __builtin_amdgcn_fmed3f(a, -448.f, 448.f); b = __builtin_amdgcn_fmed3f(b, -448.f, 448.f); c = __builtin_amdgcn_fmed3f(c, -448.f, 448.f); d = __builtin_amdgcn_fmed3f(d, -448.f, 448.f);
    int w = __builtin_amdgcn_cvt_pk_fp8_f32(a, b, 0, false); w = __builtin_amdgcn_cvt_pk_fp8_f32(c, d, w, true); return (unsigned)w;
}
template <bool X8, bool BB> struct EpiResid {
    static constexpr bool PERM = true, AFTER_DRAIN = false;
    const void* base; bf16_t* H; unsigned char* XB8; float* ssp; float sc; PG8_LAS unsigned char* stg;
    __device__ __forceinline__ void operator()(const f32x4 (&acc)[2][2][4][2], const Unit& u, int wr, int wc, int fr, int fq) const {
        int l_ = fq * 16 + fr; asm volatile("" : "+v"(l_));
        const int r = l_ >> 2, q4 = l_ & 3;
        PG8_LAS unsigned char* st = stg + (wr * 4 + wc) * 2048;
        PG8_LAS unsigned char* wp0 = st + fr * 128 + 16 * ((2 * fq) ^ (fr & 7)); PG8_LAS unsigned char* wp1 = st + fr * 128 + 16 * ((2 * fq + 1) ^ (fr & 7));
        const PG8_LAS unsigned char* rp0 = st + r * 128 + 16 * ((2 * q4) ^ (r & 7)); const PG8_LAS unsigned char* rp1 = st + r * 128 + 16 * ((2 * q4 + 1) ^ (r & 7));
        const int rowb = u.pm * BM + wr * 64 + r, colb = u.pn * BM + wc * 32 + 8 * q4;
#pragma unroll
        for (int ai = 0; ai < 2; ++ai) {
            f32x4 bv[4][2][2];
#pragma unroll
            for (int m = 0; m < 4; ++m)
#pragma unroll
                for (int bj = 0; bj < 2; ++bj) { const size_t off = (size_t)(rowb + ai * HALF + m * 16) * 1024 + colb + bj * HALF;
                    if constexpr (BB) { const u32x4 w = *(const u32x4*)((const bf16_t*)base + off);
                        bv[m][bj][0] = (f32x4){__builtin_bit_cast(float, w.x << 16), __builtin_bit_cast(float, w.x & 0xffff0000u), __builtin_bit_cast(float, w.y << 16), __builtin_bit_cast(float, w.y & 0xffff0000u)};
                        bv[m][bj][1] = (f32x4){__builtin_bit_cast(float, w.z << 16), __builtin_bit_cast(float, w.z & 0xffff0000u), __builtin_bit_cast(float, w.w << 16), __builtin_bit_cast(float, w.w & 0xffff0000u)}; }
                    else { bv[m][bj][0] = *(const f32x4*)((const float*)base + off); bv[m][bj][1] = *(const f32x4*)((const float*)base + off + 4); } }
#pragma unroll
            for (int m = 0; m < 4; ++m) { const int row = rowb + ai * HALF + m * 16; float q = 0.f;
#pragma unroll
                for (int bj = 0; bj < 2; ++bj) { const size_t off = (size_t)row * 1024 + colb + bj * HALF;
                    *(PG8_LAS f32x4*)wp0 = acc[ai][bj][m][0] * sc; *(PG8_LAS f32x4*)wp1 = acc[ai][bj][m][1] * sc;
                    asm volatile("" ::: "memory");
                    const f32x4 t0 = *(const PG8_LAS f32x4*)rp0, t1 = *(const PG8_LAS f32x4*)rp1;
                    asm volatile("" ::: "memory");
                    const f32x4 v0 = bv[m][bj][0] + t0, v1 = bv[m][bj][1] + t1;
                    q += ((v0[0] * v0[0] + v0[1] * v0[1]) + (v0[2] * v0[2] + v0[3] * v0[3])) + ((v1[0] * v1[0] + v1[1] * v1[1]) + (v1[2] * v1[2] + v1[3] * v1[3]));
                    u32x4 w; w.x = cvt_pk_bf16(v0[0], v0[1]); w.y = cvt_pk_bf16(v0[2], v0[3]); w.z = cvt_pk_bf16(v1[0], v1[1]); w.w = cvt_pk_bf16(v1[2], v1[3]); *(u32x4*)(H + off) = w;
                    if constexpr (X8) { u32x2 x; x.x = pk4_fp8(v0[0] * F8_SX, v0[1] * F8_SX, v0[2] * F8_SX, v0[3] * F8_SX); x.y = pk4_fp8(v1[0] * F8_SX, v1[1] * F8_SX, v1[2] * F8_SX, v1[3] * F8_SX); *(u32x2*)(XB8 + off) = x; } }
                q += __shfl_xor(q, 1); q += __shfl_xor(q, 2);
                if (q4 == 0) ssp[(size_t)row * 16 + u.pn * 4 + wc] = q; }
        }
    }
};
__device__ __forceinline__ f32x4 silu_mul4s(const f32x4 ag, const f32x4 au, float ka, float kgu) {
    const f32x4 a = ag * ka; const f32x4 gu = (ag * au) * kgu;
    f32x4 e; e[0] = __builtin_amdgcn_exp2f(a[0]); e[1] = __builtin_amdgcn_exp2f(a[1]); e[2] = __builtin_amdgcn_exp2f(a[2]); e[3] = __builtin_amdgcn_exp2f(a[3]);
    const f32x4 d = e + 1.0f;
    f32x4 r; r[0] = __builtin_amdgcn_rcpf(d[0]); r[1] = __builtin_amdgcn_rcpf(d[1]); r[2] = __builtin_amdgcn_rcpf(d[2]); r[3] = __builtin_amdgcn_rcpf(d[3]);
    return gu * r;
}
__device__ __forceinline__ f32x4 silu_mul4(const f32x4 g, const f32x4 u) {
    const f32x4 a = g * -1.4426950408889634f; const f32x4 gu = g * u;
    f32x4 e; e[0] = __builtin_amdgcn_exp2f(a[0]); e[1] = __builtin_amdgcn_exp2f(a[1]); e[2] = __builtin_amdgcn_exp2f(a[2]); e[3] = __builtin_amdgcn_exp2f(a[3]);
    const f32x4 d = e + 1.0f;
    f32x4 r; r[0] = __builtin_amdgcn_rcpf(d[0]); r[1] = __builtin_amdgcn_rcpf(d[1]); r[2] = __builtin_amdgcn_rcpf(d[2]); r[3] = __builtin_amdgcn_rcpf(d[3]);
    return gu * r;
}
__device__ __forceinline__ float silu_mul(float g, float u) { return g * __builtin_amdgcn_rcpf(1.0f + __builtin_amdgcn_exp2f(g * -1.4426950408889634f)) * u; }
template <bool MOE> struct EpiSwiGLU {
    static constexpr bool PERM = true, AFTER_DRAIN = false;
    bf16_t* O; int ldc; const float* ss;
    __device__ __forceinline__ void operator()(const f32x4 (&acc)[2][2][4][2], const Unit& u, int wr, int wc, int fr, int fq) const {
        const int row0 = u.pm * BM + wr * 64 + fr; const int pnl = MOE ? (u.pn % 22) : u.pn; const int col0 = pnl * HALF + wc * 32 + 8 * fq;
        float rsv[2][4];
#pragma unroll
        for (int ai = 0; ai < 2; ++ai)
#pragma unroll
            for (int m = 0; m < 4; ++m) { const int row = row0 + ai * HALF + m * 16; rsv[ai][m] = MOE ? 1.0f : rstd16(ss + (size_t)row * 16); }
#pragma unroll
        for (int ai = 0; ai < 2; ++ai)
#pragma unroll
            for (int m = 0; m < 4; ++m) { const int row = row0 + ai * HALF + m * 16; const float rs = rsv[ai][m];
                const f32x4 g0 = acc[ai][0][m][0] * rs, g1 = acc[ai][0][m][1] * rs, u0 = acc[ai][1][m][0] * rs, u1 = acc[ai][1][m][1] * rs;
                u32x4 w; w.x = cvt_pk_bf16(silu_mul(g0[0], u0[0]), silu_mul(g0[1], u0[1])); w.y = cvt_pk_bf16(silu_mul(g0[2], u0[2]), silu_mul(g0[3], u0[3]));
                w.z = cvt_pk_bf16(silu_mul(g1[0], u1[0]), silu_mul(g1[1], u1[1])); w.w = cvt_pk_bf16(silu_mul(g1[2], u1[2]), silu_mul(g1[3], u1[3]));
                *(u32x4*)(O + (size_t)row * ldc + col0) = w; }
    }
};
template <bool MOE> struct EpiSwiGLU8 {
    static constexpr bool PERM = true, AFTER_DRAIN = false;
    unsigned char* O; int ldc; PG8_LAS const float* rsl;
    __device__ __forceinline__ void operator()(const f32x4 (&acc)[2][2][4][2], const Unit& u, int wr, int wc, int fr, int fq) const {
        const int row0 = u.pm * BM + wr * 64 + fr; const int col0 = (MOE ? (u.pn % 22) : u.pn) * HALF + wc * 32 + 8 * fq; const float r0 = 1.0f / (F8_SX * F8_SWGU);
#pragma unroll
        for (int ai = 0; ai < 2; ++ai) {
            if (u.hn == 2 - ai) continue;
            float rsv[4];
#pragma unroll
            for (int m = 0; m < 4; ++m) rsv[m] = MOE ? r0 : r0 * rsl[u.rnd * BM + wr * 64 + fr + ai * HALF + m * 16];
#pragma unroll
            for (int m = 0; m < 4; ++m) { const int row = row0 + ai * HALF + m * 16; const float rs = rsv[m], rh = rs * F8_SH;
                const float ka = rs * -1.4426950408889634f, kgu = rs * rh;
                const f32x4 h0 = silu_mul4s(acc[ai][0][m][0], acc[ai][1][m][0], ka, kgu), h1 = silu_mul4s(acc[ai][0][m][1], acc[ai][1][m][1], ka, kgu);
                u32x2 w; w.x = pk4_fp8(h0[0], h0[1], h0[2], h0[3]); w.y = pk4_fp8(h1[0], h1[1], h1[2], h1[3]);
                *(u32x2*)(O + (size_t)row * ldc + col0) = w; }
        }
    }
};
struct EpiScaledBf16 {
    static constexpr bool PERM = true, AFTER_DRAIN = false;
    bf16_t* O; int ldc; int pnmask; float sc;
    __device__ __forceinline__ void operator()(const f32x4 (&acc)[2][2][4][2], const Unit& u, int wr, int wc, int fr, int fq) const {
        const int row0 = u.pm * BM + wr * 64 + fr, col0 = (u.pn & pnmask) * BM + wc * 32 + 8 * fq;
#pragma unroll
        for (int ai = 0; ai < 2; ++ai) {
            if (u.hn == 2 - ai) continue;
#pragma unroll
            for (int m = 0; m < 4; ++m) { bf16_t* rowp = O + (size_t)(row0 + ai * HALF + m * 16) * ldc + col0;
#pragma unroll
                for (int bj = 0; bj < 2; ++bj) { const f32x4 v0 = acc[ai][bj][m][0] * sc, v1 = acc[ai][bj][m][1] * sc;
                    u32x4 w; w.x = cvt_pk_bf16(v0[0], v0[1]); w.y = cvt_pk_bf16(v0[2], v0[3]); w.z = cvt_pk_bf16(v1[0], v1[1]); w.w = cvt_pk_bf16(v1[2], v1[3]);
                    *(u32x4*)(rowp + bj * HALF) = w; } }
        }
    }
};
struct EpiProj {
    static constexpr bool PERM = true, AFTER_DRAIN = false;
    unsigned char* QF8; unsigned char* KV8; bf16_t* QIF; const float* qnw; const float* knw; const unsigned* rope; PG8_LAS float* PS; float qsc;
    static __device__ __forceinline__ float hlo(unsigned w) { return (float)__builtin_bit_cast(_Float16, (unsigned short)(w & 0xffffu)); }
    static __device__ __forceinline__ float hhi(unsigned w) { return (float)__builtin_bit_cast(_Float16, (unsigned short)(w >> 16)); }
    static __device__ __forceinline__ void rot8(f32x4& y0, f32x4& y1, const f32x4& o0, const f32x4& o1, const u32x4& ca, const u32x4& cb, float sg) {
#pragma unroll
        for (int e = 0; e < 4; ++e) { y0[e] = y0[e] * hlo(ca[e]) + sg * o0[e] * hhi(ca[e]); y1[e] = y1[e] * hlo(cb[e]) + sg * o1[e] * hhi(cb[e]); }
    }
    __device__ __forceinline__ void operator()(const f32x4 (&acc)[2][2][4][2], const Unit& u, int wr, int wc, int fr, int fq) const {
        const int rl0 = wr * 64 + fr, row0 = u.pm * BM + rl0, c = wc * 32 + 8 * fq;
        u32x4 ct[3][2];
        const bool rq = (u.pn <= 4) && (wc == 0), ri = (u.pn >= 6) && ((wc & 1) == 0); const int aoff = (u.pn <= 4) ? 8 * (fq & 1) : 16;
#define EPJ_LOADCT(r) do { const unsigned* rp = rope + (size_t)((row0 + ((r) >> 2) * HALF + ((r) & 3) * 16) & 8191) * 24 + aoff; ct[(r) % 3][0] = *(const u32x4*)rp; ct[(r) % 3][1] = *(const u32x4*)(rp + 4); } while (0)
        if (rq || ri) { EPJ_LOADCT(0); EPJ_LOADCT(1); EPJ_LOADCT(2); }
        if (u.pn <= 4) {
            const bool isk = (u.pn == 4); const float* nw = isk ? knw : qnw; const f32x4 g0 = *(const f32x4*)(nw + c), g1 = *(const f32x4*)(nw + c + 4);
#pragma unroll
            for (int ai = 0; ai < 2; ++ai)
#pragma unroll
                for (int m = 0; m < 4; ++m)
#pragma unroll
                    for (int bj = 0; bj < 2; ++bj) { const f32x4 a0 = acc[ai][bj][m][0], a1 = acc[ai][bj][m][1];
                        float s = ((a0[0] * a0[0] + a0[1] * a0[1]) + (a0[2] * a0[2] + a0[3] * a0[3])) + ((a1[0] * a1[0] + a1[1] * a1[1]) + (a1[2] * a1[2] + a1[3] * a1[3]));
                        s += __shfl_xor(s, 16); s += __shfl_xor(s, 32);
                        if (fq == 0) PS[(rl0 + ai * HALF + m * 16) * 8 + bj * 4 + wc] = s; }
            asm volatile("s_waitcnt lgkmcnt(0)" ::: "memory"); __builtin_amdgcn_s_barrier();
            const float osc = isk ? 1.0f : qsc;
#pragma unroll
            for (int ai = 0; ai < 2; ++ai) {
#pragma unroll
                for (int m = 0; m < 4; ++m) { const int rl = rl0 + ai * HALF + m * 16, row = row0 + ai * HALF + m * 16, t = row & 8191, b = row >> 13;
#pragma unroll
                    for (int bj = 0; bj < 2; ++bj) { const f32x4 p = *(const PG8_LAS f32x4*)(PS + rl * 8 + bj * 4);
                        const float rs = 1.0f / sqrtf(((p[0] + p[1]) + (p[2] + p[3])) * (1.0f / 128.0f) + RMS_EPS);
                        f32x4 y0 = acc[ai][bj][m][0] * rs * g0, y1 = acc[ai][bj][m][1] * rs * g1;
                        if (wc == 0) {
                            f32x4 o0, o1;
#pragma unroll
                            for (int e = 0; e < 4; ++e) { o0[e] = __shfl_xor(y0[e], 32); o1[e] = __shfl_xor(y1[e], 32); }
                            rot8(y0, y1, o0, o1, ct[(4 * ai + m) % 3][0], ct[(4 * ai + m) % 3][1], (fq < 2) ? -1.0f : 1.0f); }
                        y0 = y0 * osc; y1 = y1 * osc;
                        u32x2 w; w.x = pk4_fp8(y0[0], y0[1], y0[2], y0[3]); w.y = pk4_fp8(y1[0], y1[1], y1[2], y1[3]);
                        unsigned char* dst = isk ? (KV8 + ((size_t)(b * 2 + bj) * 8192 + t) * 256 + c) : (QF8 + (size_t)row * 1024 + (2 * u.pn + bj) * HALF + c);
                        *(u32x2*)dst = w; }
                    if (4 * ai + m + 3 < 8 && rq) EPJ_LOADCT(4 * ai + m + 3); }
            }
        } else if (u.pn == 5) {
#pragma unroll
            for (int ai = 0; ai < 2; ++ai)
#pragma unroll
                for (int m = 0; m < 4; ++m) { const int row = row0 + ai * HALF + m * 16, t = row & 8191, b = row >> 13;
#pragma unroll
                    for (int bj = 0; bj < 2; ++bj) { const f32x4 y0 = acc[ai][bj][m][0], y1 = acc[ai][bj][m][1];
                        u32x2 w; w.x = pk4_fp8(y0[0], y0[1], y0[2], y0[3]); w.y = pk4_fp8(y1[0], y1[1], y1[2], y1[3]);
                        *(u32x2*)(KV8 + ((size_t)(b * 2 + bj) * 8192 + t) * 256 + 128 + c) = w; } }
        } else {
#pragma unroll
            for (int ai = 0; ai < 2; ++ai) {
#pragma unroll
                for (int m = 0; m < 4; ++m) { const int row = row0 + ai * HALF + m * 16;
#pragma unroll
                    for (int bj = 0; bj < 2; ++bj) { f32x4 y0 = acc[ai][bj][m][0], y1 = acc[ai][bj][m][1];
                        if (ri) {
                            f32x4 o0, o1;
#pragma unroll
                            for (int e = 0; e < 4; ++e) { o0[e] = __shfl_xor(y0[e], 16); o1[e] = __shfl_xor(y1[e], 16); }
                            if (fq < 2) rot8(y0, y1, o0, o1, ct[(4 * ai + m) % 3][0], ct[(4 * ai + m) % 3][1], (fq == 0) ? -1.0f : 1.0f); }
                        u32x4 w; w.x = cvt_pk_bf16(y0[0], y0[1]); w.y = cvt_pk_bf16(y0[2], y0[3]); w.z = cvt_pk_bf16(y1[0], y1[1]); w.w = cvt_pk_bf16(y1[2], y1[3]);
                        *(u32x4*)(QIF + (size_t)row * 512 + (u.pn - 6) * BM + bj * HALF + c) = w; }
                    if (4 * ai + m + 3 < 8 && ri) EPJ_LOADCT(4 * ai + m + 3); }
            }
        }
#undef EPJ_LOADCT
    }
};
struct EpiScaledF8 {
    static constexpr bool PERM = true, AFTER_DRAIN = false;
    unsigned char* O; int ldc; int pnmask; float sc;
    __device__ __forceinline__ void operator()(const f32x4 (&acc)[2][2][4][2], const Unit& u, int wr, int wc, int fr, int fq) const {
        const int row0 = u.pm * BM + wr * 64 + fr, col0 = (u.pn & pnmask) * BM + wc * 32 + 8 * fq;
#pragma unroll
        for (int ai = 0; ai < 2; ++ai) {
            if (u.hn == 2 - ai) continue;
#pragma unroll
            for (int m = 0; m < 4; ++m) { unsigned char* rowp = O + (size_t)(row0 + ai * HALF + m * 16) * ldc + col0;
#pragma unroll
                for (int bj = 0; bj < 2; ++bj) { const f32x4 v0 = acc[ai][bj][m][0] * sc, v1 = acc[ai][bj][m][1] * sc;
                    u32x2 w; w.x = pk4_fp8(v0[0], v0[1], v0[2], v0[3]); w.y = pk4_fp8(v1[0], v1[1], v1[2], v1[3]); *(u32x2*)(rowp + bj * HALF) = w; } }
        }
    }
};
struct MoeOrder {
    int tb[9]; int npn, G, c;
    __device__ __forceinline__ bool next(int i, Unit& u) const {
        int L = i * G + c; u.hn = 0; const int nu = tb[8] * npn;
        { const int F = nu / G, R = nu - F * G; if (i == F && R > 0 && 2 * R <= G) { if (c >= 2 * R) return false; L = F * G + (c >> 1); u.hn = 1 + (c & 1); } }
        if (L >= nu) return false;
        const int t = L / npn, j = L - t * npn; int e = 0;
#pragma unroll
        for (int k = 1; k < 8; ++k) e += (t >= tb[k]) ? 1 : 0;
        u.pm = t; u.pn = e * npn + j; return true;
    }
    __device__ __forceinline__ void a_ready(const Unit&) const {}
    __device__ __forceinline__ void done(const Unit&) const {}
};

template <class Epi, class Sched, bool ALIGN_EPI = false, bool SP2 = false, bool F8 = false, bool HU = false>
__device__ __forceinline__ void gemm_phase(PG8_LAS unsigned char* lds, const Gemm g, const Sched& S, const Epi& E) {
    const int tid = threadIdx.x, wid = __builtin_amdgcn_readfirstlane(tid >> 6), lane = tid & 63, wr = wid >> 2, wc = wid & 3, fr = lane & 15, fq = lane >> 4;
    const int K = g.K, nt = K / BK, LD = g.ld ? g.ld : g.K;
    unsigned voffA[2], voffB[2];
#pragma unroll
    for (int i = 0; i < 2; ++i) { int R, C; stage_rc(tid * 16 + i * 8192, R, C); const int Rb = Epi::PERM ? ((R & ~31) + perm32(R & 31)) : R;
        voffA[i] = (unsigned)(R * LD + C) * 2u; voffB[i] = (unsigned)(Rb * LD + C) * 2u; }
    const size_t kstep = (size_t)(BK * 2);
    const size_t hstep = (size_t)HALF * LD * 2;
    const size_t tstep = 2 * hstep;
    const unsigned ldsw = (unsigned)wid * 1024u;
    const int aoff = lds_byte(wr * 64 + fr, fq * 8), boff = lds_byte(wc * 32 + fr, fq * 8);
#define PG8_SA(b, h) (((b) * 2 + (h)) * HTB)
#define PG8_SB(b, h) ((4 + (b) * 2 + (h)) * HTB)
#define PG8_STAGE(bufoff, gbase, voff) do { _Pragma("unroll") for (int _i = 0; _i < 2; ++_i) \
        __builtin_amdgcn_global_load_lds((const unsigned*)((const char*)(gbase) + (voff)[_i]), (PG8_LAS unsigned*)(lds + (bufoff) + ldsw + _i * 8192), 16, 0, 0); } while (0)
#define PG8_LD32(p) __builtin_shufflevector(*(const PG8_LAS i32x4*)(p), *(const PG8_LAS i32x4*)((p) + 1024), 0, 1, 2, 3, 4, 5, 6, 7)
#define PG8_LDA(dst, b, h) do { if constexpr (F8) { _Pragma("unroll") for (int m = 0; m < 4; ++m) dst##8[m] = PG8_LD32(lds + PG8_SA(b, h) + aoff + m * 2048); } else { \
        _Pragma("unroll") for (int m = 0; m < 4; ++m) _Pragma("unroll") for (int k = 0; k < 2; ++k) dst[m][k] = *(const PG8_LAS bf16x8*)(lds + PG8_SA(b, h) + aoff + m * 2048 + k * 1024); } } while (0)
#define PG8_LDB(dst, b, h) do { if constexpr (F8) { _Pragma("unroll") for (int n = 0; n < 2; ++n) dst##8[n] = PG8_LD32(lds + PG8_SB(b, h) + boff + n * 2048); } else { \
        _Pragma("unroll") for (int n = 0; n < 2; ++n) _Pragma("unroll") for (int k = 0; k < 2; ++k) dst[n][k] = *(const PG8_LAS bf16x8*)(lds + PG8_SB(b, h) + boff + n * 2048 + k * 1024); } } while (0)
#define PG8_MMA(ai, bj, At, Bt) do { __builtin_amdgcn_s_setprio(1); if constexpr (F8) { _Pragma("unroll") for (int m = 0; m < 4; ++m) _Pragma("unroll") for (int n = 0; n < 2; ++n) \
        asm("v_mfma_f32_16x16x128_f8f6f4 %0, %1, %2, %0" : "+v"(acc[ai][bj][m][n]) : "v"(Bt##8[n]), "v"(At##8[m])); } else { \
        _Pragma("unroll") for (int m = 0; m < 4; ++m) _Pragma("unroll") for (int n = 0; n < 2; ++n) _Pragma("unroll") for (int k = 0; k < 2; ++k) \
        acc[ai][bj][m][n] = __builtin_amdgcn_mfma_f32_16x16x32_bf16(Bt[n][k], At[m][k], acc[ai][bj][m][n], 0, 0, 0); } __builtin_amdgcn_s_setprio(0); } while (0)
#define PG8_WAIT_V(n) asm volatile("s_waitcnt vmcnt(" #n ")" ::: "memory")
#define PG8_WAIT_L(n) asm volatile("s_waitcnt lgkmcnt(" #n ")" ::: "memory")
#define PG8_BAR __builtin_amdgcn_s_barrier()
#define PG8_SCHED __builtin_amdgcn_sched_barrier(0)
    Unit cur, nxt; int ui = 0;
    if (!S.next(0, cur)) return;
    f32x4 acc[2][2][4][2];
#pragma unroll
    for (int a = 0; a < 2; ++a)
#pragma unroll
        for (int b = 0; b < 2; ++b)
#pragma unroll
            for (int m = 0; m < 4; ++m)
#pragma unroll
                for (int n = 0; n < 2; ++n) acc[a][b][m][n] = (f32x4){0.f, 0.f, 0.f, 0.f};
    bf16x8 At[4][2], B0[2][2], B1[2][2]; i32x8 At8[4], B08[2], B18[2];
    const char* cA = (const char*)g.A + (size_t)cur.pm * tstep + cur.koff; const char* cB = (const char*)g.Bt + (size_t)cur.pn * tstep + cur.koff;
    S.a_ready(cur);
    if constexpr (SP2) {
        PG8_STAGE(PG8_SB(0, 0), cB, voffB); PG8_STAGE(PG8_SB(0, 1), cB + hstep, voffB); PG8_STAGE(PG8_SA(0, 0), cA, voffA); PG8_STAGE(PG8_SA(0, 1), cA + hstep, voffA);
        if (wr == 1) PG8_BAR;
        PG8_WAIT_V(2); PG8_BAR;
        PG8_STAGE(PG8_SB(1, 0), cB + kstep, voffB); PG8_STAGE(PG8_SA(1, 0), cA + kstep, voffA); PG8_STAGE(PG8_SB(1, 1), cB + hstep + kstep, voffB);
        PG8_WAIT_V(6); PG8_BAR;
    } else {
        PG8_STAGE(PG8_SB(0, 0), cB, voffB); PG8_STAGE(PG8_SA(0, 0), cA, voffA); PG8_STAGE(PG8_SB(0, 1), cB + hstep, voffB); PG8_STAGE(PG8_SA(0, 1), cA + hstep, voffA);
        if (wr == 1) PG8_BAR;
        PG8_WAIT_V(4); PG8_BAR;
        PG8_STAGE(PG8_SB(1, 0), cB + kstep, voffB); PG8_STAGE(PG8_SA(1, 0), cA + kstep, voffA); PG8_STAGE(PG8_SB(1, 1), cB + hstep + kstep, voffB);
        PG8_WAIT_V(6); PG8_BAR;
    }
    for (;;) {
        const bool has_next = S.next(ui + 1, nxt);
        const char* nA = has_next ? (const char*)g.A + (size_t)nxt.pm * tstep + nxt.koff : cA; const char* nB = has_next ? (const char*)g.Bt + (size_t)nxt.pn * tstep + nxt.koff : cB;
#pragma clang loop unroll(disable)
        for (int t = 0; t < nt; t += 2) {
            const bool last = (t == nt - 2);
            const char* a1 = cA + (size_t)(t + 1) * kstep;
            const char* a2 = last ? nA : cA + (size_t)(t + 2) * kstep; const char* b2 = last ? nB : cB + (size_t)(t + 2) * kstep;
            const char* a3 = a2 + kstep; const char* b3 = b2 + kstep;
            if (last && has_next) S.a_ready(nxt);
            if constexpr (SP2) {
            PG8_LDB(B0, 0, 0); PG8_LDB(B1, 0, 1); PG8_SCHED; PG8_LDA(At, 0, 0); PG8_STAGE(PG8_SA(1, 1), a1 + hstep, voffA);
            PG8_WAIT_V(8); PG8_WAIT_L(0); PG8_BAR; if (!HU || cur.hn != 2) { PG8_MMA(0, 0, At, B0); PG8_MMA(0, 1, At, B1); } PG8_BAR; PG8_SCHED;
            PG8_LDA(At, 0, 1); PG8_STAGE(PG8_SB(0, 0), b2, voffB); PG8_STAGE(PG8_SB(0, 1), b2 + hstep, voffB); PG8_STAGE(PG8_SA(0, 0), a2, voffA);
            PG8_WAIT_V(8); PG8_WAIT_L(0); PG8_BAR; if (!HU || cur.hn != 1) { PG8_MMA(1, 0, At, B0); PG8_MMA(1, 1, At, B1); } PG8_BAR; PG8_SCHED;
            PG8_LDB(B0, 1, 0); PG8_LDB(B1, 1, 1); PG8_SCHED; PG8_LDA(At, 1, 0); PG8_STAGE(PG8_SA(0, 1), a2 + hstep, voffA);
            PG8_WAIT_V(8); PG8_WAIT_L(0); PG8_BAR; if (!HU || cur.hn != 2) { PG8_MMA(0, 0, At, B0); PG8_MMA(0, 1, At, B1); } PG8_BAR; PG8_SCHED;
            PG8_LDA(At, 1, 1); PG8_STAGE(PG8_SB(1, 0), b3, voffB); PG8_STAGE(PG8_SB(1, 1), b3 + hstep, voffB); PG8_STAGE(PG8_SA(1, 0), a3, voffA);
            PG8_WAIT_V(8); PG8_WAIT_L(0); PG8_BAR; if (!HU || cur.hn != 1) { PG8_MMA(1, 0, At, B0); PG8_MMA(1, 1, At, B1); } PG8_BAR; PG8_SCHED;
            } else {
            PG8_LDB(B0, 0, 0); PG8_SCHED; PG8_LDA(At, 0, 0); PG8_STAGE(PG8_SA(1, 1), a1 + hstep, voffA);
            PG8_WAIT_L(8); PG8_BAR; PG8_WAIT_L(0); PG8_MMA(0, 0, At, B0); PG8_BAR; PG8_SCHED;
            PG8_LDB(B1, 0, 1); PG8_STAGE(PG8_SB(0, 0), b2, voffB);
            PG8_BAR; PG8_WAIT_L(0); PG8_MMA(0, 1, At, B1); PG8_BAR;
            PG8_LDA(At, 0, 1); PG8_STAGE(PG8_SA(0, 0), a2, voffA);
            PG8_BAR; PG8_WAIT_L(0); PG8_MMA(1, 0, At, B0); PG8_BAR; PG8_SCHED;
            PG8_STAGE(PG8_SB(0, 1), b2 + hstep, voffB);
            PG8_WAIT_V(6); PG8_BAR; PG8_MMA(1, 1, At, B1); PG8_BAR;
            PG8_LDB(B0, 1, 0); PG8_SCHED; PG8_LDA(At, 1, 0); PG8_STAGE(PG8_SA(0, 1), a2 + hstep, voffA);
            PG8_WAIT_L(8); PG8_BAR; PG8_WAIT_L(0); PG8_MMA(0, 0, At, B0); PG8_BAR; PG8_SCHED;
            PG8_LDB(B1, 1, 1); PG8_STAGE(PG8_SB(1, 0), b3, voffB);
            PG8_BAR; PG8_WAIT_L(0); PG8_MMA(0, 1, At, B1); PG8_BAR;
            PG8_LDA(At, 1, 1); PG8_STAGE(PG8_SA(1, 0), a3, voffA);
            PG8_BAR; PG8_WAIT_L(0); PG8_MMA(1, 0, At, B0); PG8_BAR; PG8_SCHED;
            PG8_STAGE(PG8_SB(1, 1), b3 + hstep, voffB);
            PG8_WAIT_V(6); PG8_BAR; PG8_MMA(1, 1, At, B1); PG8_BAR;
            }
        }
        if constexpr (F8) asm volatile("s_nop 15\n\ts_nop 15" ::: "memory");
        if constexpr (ALIGN_EPI) { if (wr == 0) PG8_BAR; }
        if constexpr (!Epi::AFTER_DRAIN) { E(acc, cur, wr, wc, fr, fq); S.done(cur); }
        if (!has_next) break;
#pragma unroll
        for (int a = 0; a < 2; ++a)
#pragma unroll
            for (int b = 0; b < 2; ++b)
#pragma unroll
                for (int m = 0; m < 4; ++m)
#pragma unroll
                    for (int n = 0; n < 2; ++n) acc[a][b][m][n] = (f32x4){0.f, 0.f, 0.f, 0.f};
        cur = nxt; cA = nA; cB = nB; ++ui;
        if constexpr (ALIGN_EPI) { if (wr == 1) PG8_BAR; }
    }
    PG8_WAIT_V(0);
    if constexpr (!ALIGN_EPI) { if (wr == 0) PG8_BAR; }
    PG8_BAR;
    if constexpr (Epi::AFTER_DRAIN) { E.fused(acc, cur, wr, wc, fr, fq, lds, wid, lane); S.done(cur); }
#undef PG8_SA
#undef PG8_SB
#undef PG8_STAGE
#undef PG8_LDA
#undef PG8_LDB
#undef PG8_MMA
#undef PG8_LD32
#undef PG8_WAIT_V
#undef PG8_WAIT_L
#undef PG8_BAR
#undef PG8_SCHED
}
}

constexpr int NWAVES = 8;
constexpr int BATCH = 2, SEQ = 8192, D = 1024, M = BATCH * SEQ;
constexpr int HD = 128, NH = 8, NKV = 2, NIH = 8, IDX = 64, TOPK = 256;
constexpr int A_IN = 2120, FF = 2816, NE = 8;
constexpr int MAXSLOT = 34816;
constexpr float QSCALE = 0.12751743082459868f;
constexpr float SBSCALE = 0.08838834764831845f;
constexpr float WISCALE = 0.04419417382415922f;
constexpr size_t MiB = 1u << 20;
constexpr size_t WS_CTL = 0, CTL_ZERO_BYTES = 1 * MiB;
constexpr size_t WS_WIN = 2 * MiB, WS_WTAIL = 6 * MiB, WS_WOA = 7 * MiB, WS_WGU = 9 * MiB, WS_WD = 20 * MiB, WS_WKVQ = 26 * MiB, WS_WOB = 32 * MiB, WS_WGUM = 34 * MiB, WS_WDM = 122 * MiB;
constexpr size_t WS_H = 166 * MiB, WS_XB = 230 * MiB, WS_SS0 = 262 * MiB, WS_SS1 = 263 * MiB, WS_SS2 = 264 * MiB, WS_SS3 = 265 * MiB;
constexpr size_t WS_T = 266 * MiB;
constexpr size_t WS_PROJ = WS_T, WS_QF = 330 * MiB, WS_KVF = 362 * MiB, WS_QIF = 378 * MiB, WS_KIF = 394 * MiB, WS_WIF = 396 * MiB, WS_SEL = 397 * MiB, WS_AO = 413 * MiB;
constexpr size_t WS_HF = WS_T, WS_KQ = WS_T, WS_VT = 330 * MiB;
constexpr size_t WS_XPERM = WS_T, WS_HM = 334 * MiB, WS_Y = 521 * MiB;
constexpr size_t WS_RT = 590 * MiB;
constexpr size_t WS_WKQ8 = 16 * MiB;
constexpr size_t WS_ROPE = 15 * MiB;
constexpr size_t WS_END = 591 * MiB;
constexpr int CW_CNT = 64;
constexpr int CW_P3Q = 192;
constexpr int CW_BAR = 4096;
constexpr int RING_BYTES = 131072, LDSCTL_OFF = RING_BYTES, MISC_OFF = LDSCTL_OFF + 320, PS_OFF = LDSCTL_OFF + 1024  , LDS_BYTES = 149504;

#define GAS __attribute__((address_space(1)))
#define LAS __attribute__((address_space(3)))
typedef unsigned short bf16;
typedef unsigned v4u __attribute__((ext_vector_type(4)));
typedef unsigned v2u __attribute__((ext_vector_type(2)));
typedef int v4i __attribute__((ext_vector_type(4)));
typedef float f32x4 __attribute__((ext_vector_type(4)));
typedef short bf16x8 __attribute__((ext_vector_type(8)));
typedef float f32x16 __attribute__((ext_vector_type(16)));
typedef GAS unsigned gu32;
#define RLX_AGENT __ATOMIC_RELAXED, __HIP_MEMORY_SCOPE_AGENT
#define LDS_WAIT() asm volatile("s_waitcnt lgkmcnt(0)" ::: "memory")
#define VM_WAIT() asm volatile("s_waitcnt vmcnt(0)" ::: "memory")
__device__ __forceinline__ unsigned f2bf(float f) { unsigned u = __builtin_bit_cast(unsigned, f); return (u + 0x7fffu + ((u >> 16) & 1u)) >> 16; }
__device__ __forceinline__ unsigned pk2(float lo, float hi) { return f2bf(lo) | (f2bf(hi) << 16); }
__device__ __forceinline__ float bflo(unsigned w) { return __uint_as_float(w << 16); }
__device__ __forceinline__ float bfhi(unsigned w) { return __uint_as_float(w & 0xffff0000u); }
#define FDPP(x, ctrl, rmask, bctl) __builtin_bit_cast(float, __builtin_amdgcn_update_dpp(0, __builtin_bit_cast(int, x), ctrl, rmask, 0xf, bctl))
__device__ __forceinline__ float wave_sum(float v) {
    v += FDPP(v, 0x111, 0xf, true); v += FDPP(v, 0x112, 0xf, true); v += FDPP(v, 0x114, 0xf, true); v += FDPP(v, 0x118, 0xf, true);
    v += FDPP(v, 0x142, 0xa, false); v += FDPP(v, 0x143, 0xc, false);
    return __builtin_bit_cast(float, __builtin_amdgcn_readlane(__builtin_bit_cast(int, v), 63));
}
__device__ __forceinline__ float wave_max(float v) {
#pragma unroll
    for (int o = 1; o < 64; o <<= 1) v = fmaxf(v, __shfl_xor(v, o));
    return v;
}
__device__ __forceinline__ void sincos_acc(float a, float& c, float& s) {
    const double x = (double)a; const double n = __builtin_rint(x * 0.63661977236758134308);
    const double r = __builtin_fma(-n, 6.123233995736766035869e-17, __builtin_fma(-n, 1.57079632679489655800, x)); const double r2 = r * r;
    double sn = 1.0 - r2 * (1.0 / 156.0); sn = 1.0 - r2 * (1.0 / 110.0) * sn; sn = 1.0 - r2 * (1.0 / 72.0) * sn; sn = 1.0 - r2 * (1.0 / 42.0) * sn; sn = 1.0 - r2 * (1.0 / 20.0) * sn; sn = 1.0 - r2 * (1.0 / 6.0) * sn; sn *= r;
    double cs = 1.0 - r2 * (1.0 / 182.0); cs = 1.0 - r2 * (1.0 / 132.0) * cs; cs = 1.0 - r2 * (1.0 / 90.0) * cs; cs = 1.0 - r2 * (1.0 / 56.0) * cs; cs = 1.0 - r2 * (1.0 / 30.0) * cs; cs = 1.0 - r2 * (1.0 / 12.0) * cs; cs = 1.0 - r2 * 0.5 * cs;
    const int q = ((int)n) & 3;
    const double cq = (q == 0) ? cs : (q == 1) ? -sn : (q == 2) ? -cs : sn;
    const double sq = (q == 0) ? sn : (q == 1) ? cs : (q == 2) ? -sn : -cs;
    c = (float)cq; s = (float)sq;
}
__device__ const float INV_Q[16] = {1.000000000e+00f, 4.403665960e-01f, 1.939227432e-01f, 8.539710194e-02f, 3.760603070e-02f, 1.656043902e-02f, 7.292664610e-03f, 3.211445874e-03f,
                                    1.414213562e-03f, 6.227723788e-04f, 2.742481884e-04f, 1.207697351e-04f, 5.318296098e-05f, 2.341999971e-05f, 1.031338616e-05f, 4.541670478e-06f};
__device__ const float INV_I[8] = {1.000000000e+00f, 1.939227432e-01f, 3.760603070e-02f, 7.292664610e-03f, 1.414213562e-03f, 2.742481884e-04f, 5.318296098e-05f, 1.031338616e-05f};

#define XB_TMO      128
#define XB_XCNT(j)  (256  + 64 * (j))
#define XB_XSUB(j)  (1280 + 64 * (j))
#define XB_XGEN(j)  (2304 + 64 * (j))
#define XB_TOP      3328
#define XB_TOPGEN   3392
#define XCD_BAR_WORDS 3456
#define XB_SPIN_CAP (1u << 18)

__device__ __forceinline__ unsigned xb_ld(unsigned* p)              { return __hip_atomic_load(p, __ATOMIC_RELAXED, __HIP_MEMORY_SCOPE_AGENT); }
__device__ __forceinline__ unsigned xb_add(unsigned* p, unsigned v) { return __hip_atomic_fetch_add(p, v, __ATOMIC_RELAXED, __HIP_MEMORY_SCOPE_AGENT); }
__device__ __forceinline__ unsigned xb_xcc_id() { return (unsigned)__builtin_amdgcn_s_getreg((3 << 11) | 20) & 0xFu; }
#define XB_SPIN(cond, bar) do { unsigned _sp = 0; while (cond) { __builtin_amdgcn_s_sleep(1); \
    if ((++_sp & 255u) == 0u) { if (xb_ld(&(bar)[XB_TMO])) break; if (_sp > XB_SPIN_CAP) { atomicAdd(&(bar)[XB_TMO], 1u); break; } } } } while (0)

struct XcdBarrier {
    unsigned* bar; unsigned x;
    volatile LAS unsigned* st;
};

__device__ __forceinline__ XcdBarrier xcd_barrier_post(unsigned* bar, volatile LAS unsigned* st) {
    XcdBarrier b; b.bar = bar; b.x = xb_xcc_id(); b.st = st;
    if (threadIdx.x == 0) (void)xb_add(&bar[XB_XCNT(b.x)], 1u);
    return b;
}
__device__ __forceinline__ void xcd_barrier_complete(unsigned* bar, unsigned x, unsigned& nloc, unsigned& nx) {
    const unsigned G = gridDim.x * gridDim.y * gridDim.z;
    unsigned sum, cnt, mine, sp = 0u;
    for (;;) {
        sum = 0u; cnt = 0u; mine = 0u;
#pragma unroll
        for (unsigned j = 0; j < 16; ++j) { const unsigned c = xb_ld(&bar[XB_XCNT(j)]); sum += c; cnt += (c > 0u) ? 1u : 0u; mine = (j == x) ? c : mine; }
        if (sum == G) break;
        __builtin_amdgcn_s_sleep(1);
        if ((++sp & 255u) == 0u) { if (xb_ld(&bar[XB_TMO])) break; if (sp > XB_SPIN_CAP) { atomicAdd(&bar[XB_TMO], 1u); break; } }
    }
    nloc = mine > 0u ? mine : 1u; nx = cnt > 0u ? cnt : 1u;
}

__device__ __forceinline__ void xcd_barrier(const XcdBarrier& b) {
    asm volatile("s_waitcnt vmcnt(0)" ::: "memory");
    __syncthreads();
    if (threadIdx.x == 0) {
        unsigned* bar = b.bar;
        __builtin_amdgcn_s_waitcnt(0);
        unsigned nloc = b.st[0], nx = b.st[1];
        if (nloc == 0u) { xcd_barrier_complete(bar, b.x, nloc, nx); b.st[0] = nloc; b.st[1] = nx; }
        const unsigned old = xb_add(&bar[XB_XSUB(b.x)], 1u);
        const unsigned gen = old / nloc;
        if (old + 1u == (gen + 1u) * nloc) {
            __builtin_amdgcn_fence(__ATOMIC_RELEASE, "agent");
            asm volatile("s_waitcnt vmcnt(0)" ::: "memory");
            const unsigned og = xb_add(&bar[XB_TOP], 1u);
            const unsigned tg = og / nx;
            if (og + 1u == (tg + 1u) * nx) xb_add(&bar[XB_TOPGEN], 1u);
            else XB_SPIN(xb_ld(&bar[XB_TOPGEN]) == tg, bar);
            __builtin_amdgcn_fence(__ATOMIC_ACQUIRE, "agent");
            xb_add(&bar[XB_XGEN(b.x)], 1u);
            asm volatile("s_waitcnt vmcnt(0)" ::: "memory");
        } else {
            XB_SPIN(xb_ld(&bar[XB_XGEN(b.x)]) == gen, bar);
            __builtin_amdgcn_fence(__ATOMIC_ACQUIRE, "agent");
            asm volatile("s_waitcnt vmcnt(0)" ::: "memory");
        }
    }
    __syncthreads();
}

struct Frame {
    LAS unsigned char* lds;
    volatile LAS unsigned* MISC;
    gu32* ctl;
    int tid, lane, wave, G, bid;
    const float* in[17];
    float* out; unsigned char* ws;
};
enum { IN_X = 0, IN_ANORM, IN_AWIN, IN_AQN, IN_AKN, IN_AWOUT, IN_KVNORM, IN_KVW, IN_BNORM, IN_BWQ, IN_BWOUT, IN_FFNNORM, IN_DGU, IN_DDN, IN_ROUTER, IN_MGU, IN_MDN };

constexpr float P4_QS = 16.f;
constexpr float F8_SWQ = 4096.f;
struct TrItem { const float* W; size_t ldw; int K, k0, csrc0, cend; bf16* WT; int drow0; const float* gain; float scale; int f8; };
__device__ __forceinline__ int gu_row(int c0) { return (c0 < FF) ? ((c0 >> 7) * 256 + (c0 & 127)) : (((c0 - FF) >> 7) * 256 + 128 + ((c0 - FF) & 127)); }
constexpr int I_WIN = 16 * 32, I_TAIL = 16 * 2, I_SQ = 16 * 16, I_GU = 16 * 88, I_DN = 44 * 16, I_KV = 16 * 32;
constexpr int TR_NITEMS = I_WIN + I_TAIL + I_SQ + I_GU + I_DN + I_KV + I_SQ + I_SQ + NE * I_GU + NE * I_DN;
__device__ __forceinline__ TrItem tr_decode(const Frame& F, int it) {
    unsigned char* ws = F.ws; int r = it; TrItem t;
    if (r < I_WIN) { const int kb = r / 32, nb = r % 32; t = TrItem{F.in[IN_AWIN], (size_t)A_IN, D, 64 * kb, 64 * nb, A_IN, (bf16*)(ws + WS_WIN), 64 * nb, F.in[IN_ANORM], 1.f}; return t; } r -= I_WIN;
    if (r < I_TAIL) { const int kb = r / 2, nb = r % 2; t = TrItem{F.in[IN_AWIN], (size_t)A_IN, D, 64 * kb, 2048 + 64 * nb, A_IN, (bf16*)(ws + WS_WTAIL), 64 * nb, F.in[IN_ANORM], 1.f, 2}; return t; } r -= I_TAIL;
    if (r < I_SQ) { const int kb = r / 16, nb = r % 16; t = TrItem{F.in[IN_AWOUT], (size_t)D, D, 64 * kb, 64 * nb, D, (bf16*)(ws + WS_WOA), 64 * nb, nullptr, pg8::F8_SWGU, 1}; return t; } r -= I_SQ;
    if (r < I_GU) { const int kb = r / 88, nb = r % 88; t = TrItem{F.in[IN_DGU], (size_t)(2 * FF), D, 64 * kb, 64 * nb, 2 * FF, (bf16*)(ws + WS_WGU), gu_row(64 * nb), F.in[IN_FFNNORM], pg8::F8_SWGU, 1}; return t; } r -= I_GU;
    if (r < I_DN) { const int kb = r / 16, nb = r % 16; t = TrItem{F.in[IN_DDN], (size_t)D, FF, 64 * kb, 64 * nb, D, (bf16*)(ws + WS_WD), 64 * nb, nullptr, pg8::F8_SWD, 1}; return t; } r -= I_DN;
    if (r < I_KV) { const int kb = r / 32, nb = r % 32; t = (nb < 16) ? TrItem{F.in[IN_KVW], (size_t)(2 * D), D, 64 * kb, 64 * nb, 2 * D, (bf16*)(ws + WS_WKQ8), 64 * nb, F.in[IN_KVNORM], pg8::F8_SWGU, 1}
                      : TrItem{F.in[IN_KVW], (size_t)(2 * D), D, 64 * kb, 64 * nb, 2 * D, (bf16*)(ws + WS_WKQ8), 1024 + 64 * nb, F.in[IN_KVNORM], pg8::F8_SWGU, 1}; return t; } r -= I_KV;
    if (r < I_SQ) { const int kb = r / 16, nb = r % 16; t = TrItem{F.in[IN_BWQ], (size_t)D, D, 64 * kb, 64 * nb, D, (bf16*)(ws + WS_WKQ8), 1024 + 64 * nb, F.in[IN_BNORM], SBSCALE * F8_SWQ, 1}; return t; } r -= I_SQ;
    if (r < I_SQ) { const int kb = r / 16, nb = r % 16; t = TrItem{F.in[IN_BWOUT], (size_t)D, D, 64 * kb, 64 * nb, D, (bf16*)(ws + WS_WOB), 64 * nb, nullptr, 1.f}; return t; } r -= I_SQ;
    if (r < NE * I_GU) { const int e = r / I_GU, rr = r % I_GU, kb = rr / 88, nb = rr % 88;
        t = TrItem{F.in[IN_MGU] + (size_t)e * D * 2 * FF, (size_t)(2 * FF), D, 64 * kb, 64 * nb, 2 * FF, (bf16*)(ws + WS_WGUM), e * 2 * FF + gu_row(64 * nb), F.in[IN_FFNNORM] + D, pg8::F8_SWGU, 1}; return t; } r -= NE * I_GU;
    { const int e = r / I_DN, rr = r % I_DN, kb = rr / 16, nb = rr % 16;
      t = TrItem{F.in[IN_MDN] + (size_t)e * FF * D, (size_t)D, FF, 64 * kb, 64 * nb, D, (bf16*)(ws + WS_WDM), e * D + 64 * nb, nullptr, pg8::F8_SWD, 1}; return t; }
}
__device__ __forceinline__ void tr_load(const TrItem& t, f32x4 (&v)[16], int lane) {
    const int r = lane >> 4, c = t.csrc0 + 4 * (lane & 15); const bool ok = c < t.cend; const float* src = t.W + (size_t)(t.k0 + r) * t.ldw + (ok ? c : 0);
#pragma unroll
    for (int i = 0; i < 16; ++i) { const f32x4 x = __builtin_nontemporal_load((const f32x4*)(src + (size_t)(4 * i) * t.ldw)); v[i] = ok ? x : (f32x4){0.f, 0.f, 0.f, 0.f}; }
}
__device__ __forceinline__ void tr_store(const TrItem& t, const f32x4 (&v)[16], LAS float* scr, int lane) {
    const int r = lane >> 4, c4 = lane & 15;
#pragma unroll
    for (int i = 0; i < 16; ++i) { const int k = 4 * i + r; const float g = t.gain ? t.gain[t.k0 + k] * t.scale : t.scale;
        *(LAS f32x4*)(scr + k * 64 + 4 * (c4 ^ ((k >> 3) & 7))) = v[i] * g; }
    LDS_WAIT(); asm volatile("" ::: "memory");
    if (t.f8 == 1) {
        const int c4b = lane & 3;
#pragma unroll
        for (int j = 0; j < 4; ++j) { const int n = (lane >> 2) + 16 * j;
            const LAS float* s0 = scr + (16 * c4b) * 64 + (n ^ ((2 * c4b) << 2)); const LAS float* s1 = scr + (16 * c4b + 8) * 64 + (n ^ ((2 * c4b + 1) << 2));
            v4u o; o.x = pg8::pk4_fp8(s0[0 * 64], s0[1 * 64], s0[2 * 64], s0[3 * 64]); o.y = pg8::pk4_fp8(s0[4 * 64], s0[5 * 64], s0[6 * 64], s0[7 * 64]);
            o.z = pg8::pk4_fp8(s1[0 * 64], s1[1 * 64], s1[2 * 64], s1[3 * 64]); o.w = pg8::pk4_fp8(s1[4 * 64], s1[5 * 64], s1[6 * 64], s1[7 * 64]);
            *(GAS v4u*)((unsigned char*)t.WT + (size_t)(t.drow0 + n) * t.K + t.k0 + 16 * c4b) = o; }
    } else {
    const int c8 = lane & 7;
#pragma unroll
    for (int j = 0; j < 8; ++j) { const int n = (lane >> 3) + 8 * j; const LAS float* s = scr + (8 * c8) * 64 + (n ^ (c8 << 2));
        v4u o; o.x = pk2(s[0 * 64], s[1 * 64]); o.y = pk2(s[2 * 64], s[3 * 64]); o.z = pk2(s[4 * 64], s[5 * 64]); o.w = pk2(s[6 * 64], s[7 * 64]);
        const int rw = t.drow0 + n, kk = t.k0 + 8 * c8;
        const size_t off = (t.f8 == 2) ? ((size_t)(((((rw >> 4) * 4 + (kk >> 8)) * 8 + ((kk >> 5) & 7)) * 64) + ((kk >> 3) & 3) * 16 + (rw & 15)) * 8) : ((size_t)rw * t.K + kk);
        *(GAS v4u*)(t.WT + off) = o; }
    }
    LDS_WAIT(); asm volatile("" ::: "memory");
}
__device__ __forceinline__ void p0_prologue(Frame& F) {
    LAS float* scr = (LAS float*)(F.lds + F.wave * 16384);
    const int gw = F.wave * F.G + F.bid, NGW = F.G * NWAVES;
    unsigned char* ws = F.ws;
    {
        f32x4 va[16], vb[16];
        int it = gw;
        if (it < TR_NITEMS) { TrItem cur = tr_decode(F, it); tr_load(cur, va, F.lane);
            for (;;) {
                const int nx = it + NGW; const bool has = nx < TR_NITEMS; TrItem nxt = cur;
                if (has) { nxt = tr_decode(F, nx); tr_load(nxt, vb, F.lane); }
                tr_store(cur, va, scr, F.lane);
                if (!has) break;
                it = nx + NGW; const bool has2 = it < TR_NITEMS; TrItem nn = nxt;
                if (has2) { nn = tr_decode(F, it); tr_load(nn, va, F.lane); }
                tr_store(nxt, vb, scr, F.lane);
                if (!has2) break;
                cur = nn;
            }
        }
    }
    { unsigned* RT = (unsigned*)(ws + WS_ROPE);
      for (int t = gw; t < SEQ; t += NGW) if (F.lane < 24) { float c, s; sincos_acc((float)t * ((F.lane < 16) ? INV_Q[F.lane & 15] : INV_I[F.lane & 7]), c, s);
          RT[t * 24 + F.lane] = (unsigned)__builtin_bit_cast(unsigned short, (_Float16)c) | ((unsigned)__builtin_bit_cast(unsigned short, (_Float16)s) << 16); } }
    const float* x = F.in[IN_X]; bf16* XB = (bf16*)(ws + WS_XB);
    for (int m = gw; m < M; m += NGW) {
        const GAS f32x4* xr = (const GAS f32x4*)(x + (size_t)m * D) + F.lane; f32x4 v[4]; float s = 0.f;
#pragma unroll
        for (int j = 0; j < 4; ++j) { v[j] = xr[64 * j]; s += (v[j].x * v[j].x + v[j].y * v[j].y) + (v[j].z * v[j].z + v[j].w * v[j].w); }
        s = wave_sum(s); const float rs = 1.0f / sqrtf(s * (1.0f / 1024.0f) + 1e-6f);
        GAS unsigned long long* o8 = (GAS unsigned long long*)(XB + (size_t)m * D) + F.lane;
#pragma unroll
        for (int j = 0; j < 4; ++j) o8[64 * j] = (unsigned long long)pk2(v[j].x * rs, v[j].y * rs) | ((unsigned long long)pk2(v[j].z * rs, v[j].w * rs) << 32);
    }
}

#define WAVE_SYNC() asm volatile("s_waitcnt lgkmcnt(0)" ::: "memory")
__device__ __forceinline__ void rope8(float (&y)[8], bool isx1, bool isx2, int i0, int pshift, LAS const float* tab) {
#pragma unroll
    for (int e = 0; e < 8; ++e) {
        const float other = __shfl_xor(y[e], pshift); const float c = tab[2 * (i0 + e)], s = tab[2 * (i0 + e) + 1];
        y[e] = isx1 ? (y[e] * c - other * s) : (isx2 ? (y[e] * c + other * s) : y[e]);
    }
}
__device__ __forceinline__ size_t kif_off(int grow, int d) { return ((((size_t)(grow >> 5) * 4 + ((d >> 3) & 3)) * 2 + (d >> 5)) * 32 + (grow & 31)) * 8 + (d & 7); }
__device__ __forceinline__ void unpack8(const v4u w, float (&y)[8]) { y[0] = bflo(w.x); y[1] = bfhi(w.x); y[2] = bflo(w.y); y[3] = bfhi(w.y); y[4] = bflo(w.z); y[5] = bfhi(w.z); y[6] = bflo(w.w); y[7] = bfhi(w.w); }
__device__ __forceinline__ v4u pack8(const float (&y)[8]) { v4u o; o.x = pk2(y[0], y[1]); o.y = pk2(y[2], y[3]); o.z = pk2(y[4], y[5]); o.w = pk2(y[6], y[7]); return o; }
__device__ __forceinline__ void p2_post(Frame& F) {
    unsigned char* ws = F.ws; const int lane = F.lane;
    const bf16* PROJ = (const bf16*)(ws + WS_PROJ); const bf16* XB = (const bf16*)(ws + WS_XB); const bf16* WT = (const bf16*)(ws + WS_WTAIL);
    bf16* QF = (bf16*)(ws + WS_QF); bf16* KVF = (bf16*)(ws + WS_KVF); bf16* QIF = (bf16*)(ws + WS_QIF); bf16* KIF = (bf16*)(ws + WS_KIF); float* WIF = (float*)(ws + WS_WIF);
    const float* qnw = F.in[IN_AQN]; const float* knw = F.in[IN_AKN];
    LAS float* tab = (LAS float*)(F.lds + F.wave * 256);
    const int gw = F.wave * F.G + F.bid, NGW = F.G * NWAVES;
    const unsigned* RT = (const unsigned*)(ws + WS_ROPE);
    const int quad = F.wave >> 2, kq = F.wave & 3; LAS float* xch = (LAS float*)(F.lds + quad * 32768);
    for (int t0 = 0; t0 < M / 32; t0 += 2 * F.G) {
        const int task = t0 + quad * F.G + F.bid; const bool on = task < M / 32; const int row0 = (on ? task : 0) * 32;
        f32x4 acc[2][5];
#pragma unroll
        for (int rt = 0; rt < 2; ++rt)
#pragma unroll
            for (int c = 0; c < 5; ++c) acc[rt][c] = (f32x4){0.f, 0.f, 0.f, 0.f};
        LAS unsigned char* aimg = F.lds + 65536 + F.wave * 8192;
        v4u araw[2][8];
        { const int asw = (lane & 15) ^ (lane >> 4);
#pragma unroll
          for (int hh = 0; hh < 2; ++hh)
#pragma unroll
              for (int i = 0; i < 8; ++i) araw[hh][i] = *(const v4u*)(XB + (size_t)(row0 + 4 * i + (lane >> 4)) * D + 256 * kq + 128 * hh + 8 * (asw ^ ((4 * i) & 15))); }
        const bf16* bp = WT + (size_t)(kq * 8 * 64 + lane) * 8;
#pragma unroll
        for (int j = 0; j < 8; ++j) {
            if ((j & 3) == 0) {
#pragma unroll
                for (int i = 0; i < 8; ++i) *(LAS v4u*)(aimg + 1024 * i + 16 * lane) = araw[j >> 2][i];
                asm volatile("" ::: "memory");
            }
            const LAS unsigned char* ar = aimg + (lane & 15) * 256 + 16 * ((4 * (j & 3) + (lane >> 4)) ^ (lane & 15));
            const bf16x8 a0 = *(const LAS bf16x8*)ar, a1 = *(const LAS bf16x8*)(ar + 16 * 256);
#pragma unroll
            for (int c = 0; c < 5; ++c) { const bf16x8 b = *(const bf16x8*)(bp + (size_t)((c * 4 * 8 + j) * 512));
                acc[0][c] = __builtin_amdgcn_mfma_f32_16x16x32_bf16(a0, b, acc[0][c], 0, 0, 0); acc[1][c] = __builtin_amdgcn_mfma_f32_16x16x32_bf16(a1, b, acc[1][c], 0, 0, 0); }
        }
        if (kq) {
#pragma unroll
            for (int rt = 0; rt < 2; ++rt)
#pragma unroll
                for (int c = 0; c < 5; ++c) *(LAS f32x4*)(xch + (((kq - 1) * 10 + rt * 5 + c) * 64 + lane) * 4) = acc[rt][c];
        }
        __syncthreads();
        if (!kq && on) {
#pragma unroll
            for (int rt = 0; rt < 2; ++rt) {
#pragma unroll
                for (int c = 0; c < 5; ++c)
#pragma unroll
                    for (int pp = 0; pp < 3; ++pp) acc[rt][c] += *(LAS f32x4*)(xch + ((pp * 10 + rt * 5 + c) * 64 + lane) * 4);
#pragma unroll
                for (int reg = 0; reg < 4; ++reg) {
                    const int row = row0 + 16 * rt + 4 * (lane >> 4) + reg;
                    const int d = lane & 15;
                    float v0 = acc[rt][0][reg]; const float other = __shfl_xor(v0, 8);
                    { const unsigned cs = RT[(row & (SEQ - 1)) * 24 + 16 + (d & 7)]; const float c = pg8::EpiProj::hlo(cs), s = pg8::EpiProj::hhi(cs); v0 = (d < 8) ? (v0 * c - other * s) : (v0 * c + other * s); }
                    KIF[kif_off(row, d)] = (bf16)f2bf(v0);
#pragma unroll
                    for (int c = 1; c < 4; ++c) KIF[kif_off(row, 16 * c + d)] = (bf16)f2bf(acc[rt][c][reg]);
                    if (d < 8) WIF[(size_t)row * 8 + d] = acc[rt][4][reg] * WISCALE;
                }
            }
        }
        __syncthreads();
    }
}

__device__ __forceinline__ unsigned f2key(float f) { const unsigned u = __float_as_uint(f); return (u & 0x80000000u) ? ~u : (u | 0x80000000u); }
__device__ __forceinline__ void p3_query_naive(unsigned char* ws, LAS unsigned char* lds, int row, int* SEL) {
    const int tid = threadIdx.x, lane = tid & 63, wave = tid >> 6;
    const bf16* QIF = (const bf16*)(ws + WS_QIF); const bf16* KIF = (const bf16*)(ws + WS_KIF); const float* WIF = (const float*)(ws + WS_WIF);
    LAS unsigned* keys = (LAS unsigned*)lds;
    LAS float* qis = (LAS float*)(lds + 32768);
    LAS float* wl = (LAS float*)(lds + 32768 + 2048);
    LAS unsigned* hist = (LAS unsigned*)(lds + 36864);
    LAS unsigned* ctl = (LAS unsigned*)(lds + 36864 + 1024);
    LAS unsigned* wcnt = (LAS unsigned*)(lds + 36864 + 1024 + 64);
    {
        const int b = row >> 13, t = row & (SEQ - 1), n = t + 1;
        int* sel = SEL + (size_t)row * TOPK;
        if (n <= TOPK) { if (tid < TOPK) sel[tid] = tid < n ? tid : 0; return; }
        __syncthreads();
        qis[tid] = __uint_as_float((unsigned)QIF[(size_t)row * 512 + tid] << 16);
        if (tid < 8) wl[tid] = WIF[(size_t)row * 8 + tid];
        __syncthreads();
        for (int s = tid; s < n; s += 512) {
            const int grow = (b << 13) + s;
            float kf[64];
#pragma unroll
            for (int j = 0; j < 8; ++j) { const v4u w = *(const v4u*)(KIF + kif_off(grow, 8 * j)); kf[8 * j] = bflo(w.x); kf[8 * j + 1] = bfhi(w.x); kf[8 * j + 2] = bflo(w.y); kf[8 * j + 3] = bfhi(w.y); kf[8 * j + 4] = bflo(w.z); kf[8 * j + 5] = bfhi(w.z); kf[8 * j + 6] = bflo(w.w); kf[8 * j + 7] = bfhi(w.w); }
            float sc = 0.f;
#pragma unroll
            for (int h = 0; h < 8; ++h) { float d = 0.f; asm volatile("" ::: "memory");
#pragma unroll
                for (int dd = 0; dd < 64; ++dd) d += qis[h * 64 + dd] * kf[dd];
                sc += wl[h] * fmaxf(d, 0.f); }
            keys[s] = f2key(sc + 0.0f);
        }
        __syncthreads();
        unsigned prefix = 0u, mask = 0u, need = TOPK;
        for (int pass = 0; pass < 4; ++pass) {
            const int shift = 24 - 8 * pass;
            if (tid < 256) hist[tid] = 0u;
            __syncthreads();
            for (int s = tid; s < n; s += 512) { const unsigned k = keys[s]; if ((k & mask) == prefix) __hip_atomic_fetch_add(&hist[(k >> shift) & 255u], 1u, __ATOMIC_RELAXED, __HIP_MEMORY_SCOPE_WORKGROUP); }
            __syncthreads();
            if (tid < 64) {
                const unsigned h0 = hist[4 * lane], h1 = hist[4 * lane + 1], h2 = hist[4 * lane + 2], h3 = hist[4 * lane + 3]; const unsigned tot = h0 + h1 + h2 + h3;
                unsigned incl = tot;
#pragma unroll
                for (int o = 1; o < 64; o <<= 1) { const unsigned v = __shfl_down(incl, o); if (lane + o < 64) incl += v; }
                const unsigned above = incl - tot;
                if (above < need && need <= above + tot) {
                    unsigned a = above; unsigned bin;
                    if (a + h3 >= need) bin = 3; else { a += h3; if (a + h2 >= need) bin = 2; else { a += h2; if (a + h1 >= need) bin = 1; else { a += h1; bin = 0; } } }
                    ctl[0] = 4 * lane + bin; ctl[1] = need - a;
                }
            }
            __syncthreads();
            prefix |= ctl[0] << shift; mask |= 255u << shift; need = ctl[1];
            __syncthreads();
        }
        const unsigned thr = prefix, n_gt = TOPK - need;
        unsigned base_gt = 0u, base_eq = 0u;
        for (int s0 = 0; s0 < n; s0 += 512) {
            const int s = s0 + tid; const unsigned k = s < n ? keys[s] : 0u; const bool gt = (s < n) && (k > thr); const bool eq = (s < n) && (k == thr);
            const unsigned long long bg = __ballot(gt), be = __ballot(eq); const unsigned long long lt = (1ull << lane) - 1ull;
            const unsigned rg = __popcll(bg & lt), re = __popcll(be & lt);
            if (lane == 0) { wcnt[wave] = __popcll(bg); wcnt[8 + wave] = __popcll(be); }
            __syncthreads();
            unsigned og = base_gt, oe = base_eq, tg = 0u, te = 0u;
#pragma unroll
            for (int w = 0; w < 8; ++w) { const unsigned cg = wcnt[w], ce = wcnt[8 + w]; if (w < wave) { og += cg; oe += ce; } tg += cg; te += ce; }
            if (gt) sel[og + rg] = s;
            if (eq && oe + re < need) sel[n_gt + oe + re] = s;
            base_gt += tg; base_eq += te;
            __syncthreads();
        }
    }
}

constexpr int P3_HIST = 0, P3_H2 = 65536, P3_BM = 98304, P3_QS = 114688, P3_FLAG = P3_QS + 512, P3_CAP = 512;
__device__ __forceinline__ void find_bin_2048(LAS const unsigned* hist, unsigned need, int lane, unsigned& bin_out, unsigned& need_out, unsigned& cnt_out, bool& ok) {
    unsigned w[16]; unsigned tot = 0u;
#pragma unroll
    for (int i = 0; i < 16; ++i) { w[i] = hist[16 * lane + i]; tot += (w[i] & 0xffffu) + (w[i] >> 16); }
    unsigned incl = tot;
#pragma unroll
    for (int o = 1; o < 64; o <<= 1) { const unsigned v = __shfl_down(incl, o); if (lane + o < 64) incl += v; }
    const unsigned above = incl - tot;
    const bool mine = (above < need) && (need <= above + tot);
    unsigned a = above, fb = 0u, fn = 0u, fc = 0u; bool found = false;
#pragma unroll
    for (int i = 15; i >= 0; --i) {
        const unsigned h1 = w[i] >> 16, h0 = w[i] & 0xffffu;
        if (!found) { if (a + h1 >= need) { found = true; fb = 32u * lane + 2u * i + 1u; fn = need - a; fc = h1; } else a += h1; }
        if (!found) { if (a + h0 >= need) { found = true; fb = 32u * lane + 2u * i; fn = need - a; fc = h0; } else a += h0; }
    }
    const unsigned long long bm = __ballot(mine);
    ok = (bm != 0ull);
    const int src = ok ? (__ffsll((long long)bm) - 1) : 0;
    bin_out = (unsigned)__builtin_amdgcn_readlane((int)fb, src); need_out = (unsigned)__builtin_amdgcn_readlane((int)fn, src); cnt_out = (unsigned)__builtin_amdgcn_readlane((int)fc, src);
}
__device__ __forceinline__ unsigned bin11(float sc) { const unsigned u = __float_as_uint(sc); const int m = (int)((u & 0x7fffffffu) >> 17) - 7360; const unsigned mc = (unsigned)(m < 0 ? 0 : (m > 1023 ? 1023 : m)); return (u >> 31) ? (1023u - mc) : (1024u + mc); }
__device__ __forceinline__ float relu_i(float x) { const int xi = __builtin_bit_cast(int, x); const int ri = (xi < 0) ? 0 : xi; return __builtin_bit_cast(float, ri); }
#define RELU(x) relu_i(x)
typedef _Float16 f16x8 __attribute__((ext_vector_type(8)));
typedef short s16x2 __attribute__((ext_vector_type(2)));
__device__ __forceinline__ unsigned pk_relu_f16(float a, float b) { const s16x2 h = __builtin_bit_cast(s16x2, __builtin_amdgcn_cvt_pkrtz(a, b)); return __builtin_bit_cast(unsigned, __builtin_elementwise_max(h, (s16x2){0, 0})); }
__device__ __forceinline__ unsigned bin16(unsigned h) { const int m = (int)((h & 0x7fffu) >> 4) - 192; const unsigned mc = (unsigned)(m < 0 ? 0 : (m > 1023 ? 1023 : m)); return (h & 0x8000u) ? (1023u - mc) : (1024u + mc); }
__device__ __forceinline__ unsigned pk_bin16(unsigned p) {
    typedef unsigned short u16p __attribute__((ext_vector_type(2)));
    const u16p um = __builtin_bit_cast(u16p, p & 0x7fff7fffu) >> (u16p){4, 4};
    s16x2 m = __builtin_bit_cast(s16x2, um) - (s16x2){192, 192};
    m = __builtin_elementwise_min(__builtin_elementwise_max(m, (s16x2){0, 0}), (s16x2){1023, 1023}) + (s16x2){1024, 1024};
    const s16x2 sg = __builtin_bit_cast(s16x2, p) >> (s16x2){15, 15};
    return (__builtin_bit_cast(unsigned, m) ^ __builtin_bit_cast(unsigned, sg)) & 0x07ff07ffu;
}
__device__ __forceinline__ unsigned key16(unsigned h) { return (h & 0x8000u) ? (~h & 0xffffu) : (h | 0x8000u); }
__device__ __forceinline__ void p3_score_pass(const bf16x8 (&af)[2][4], const f16x8 (&wa)[2][2], const bf16* kib, int t0, int nt, int wave, int n, int hi,
                                              LAS unsigned char* lds, unsigned short* SC, int rot) {
    LAS unsigned* HIST = (LAS unsigned*)(lds + P3_HIST);
    const int qh = 8 * (wave >> 2), w4 = wave & 3;
    const __amdgpu_buffer_rsrc_t scr = __builtin_amdgcn_make_buffer_rsrc((void*)SC, 0, 16 * SEQ * 2, 0x00020000);
    const int cnt4 = (nt - w4 + 3) >> 2; const int r0 = rot % cnt4;
    bf16x8 bq[4][4];
    const __amdgpu_buffer_rsrc_t kbr = __builtin_amdgcn_make_buffer_rsrc((void*)kib, 0, SEQ * IDX * 2, 0x00020000);
#define P3_LOADB(u, j) do { int jj_ = r0 + (j); jj_ = (jj_ >= cnt4) ? jj_ - cnt4 : jj_; const int t_ = __builtin_amdgcn_readfirstlane(w4 + 4 * jj_); int lo_ = (hi * 256 + n * 8) * 2; asm volatile("" : "+v"(lo_)); \
        _Pragma("unroll") for (int s = 0; s < 4; ++s) bq[u][s] = __builtin_bit_cast(bf16x8, __builtin_amdgcn_raw_buffer_load_b128(kbr, lo_, t_ * 4096 + s * 1024, 0)); } while (0)
#pragma unroll
    for (int u = 0; u < 4; ++u) P3_LOADB(u, (u < cnt4) ? u : 0);
    for (int i0 = 0; i0 < cnt4; i0 += 4) {
#pragma unroll
        for (int u = 0; u < 4; ++u) {
            if (i0 + u < cnt4) {
                int jj = r0 + i0 + u; jj = (jj >= cnt4) ? jj - cnt4 : jj; const int tile = w4 + 4 * jj;
                const int key = 32 * tile + n; const bool full = (32 * tile + 31 <= t0);
                f32x16 acc0, acc1;
#pragma unroll
                for (int r = 0; r < 16; ++r) { acc0[r] = 0.f; acc1[r] = 0.f; }
#pragma unroll
                for (int s = 0; s < 4; ++s) acc0 = __builtin_amdgcn_mfma_f32_32x32x16_bf16(af[0][s], bq[u][s], acc0, 0, 0, 0);
#pragma unroll
                for (int s = 0; s < 4; ++s) acc1 = __builtin_amdgcn_mfma_f32_32x32x16_bf16(af[1][s], bq[u][s], acc1, 0, 0, 0);
                unsigned p01, p23;
                {
                    f32x16 y0, y1;
#pragma unroll
                    for (int r = 0; r < 16; ++r) { y0[r] = 0.f; y1[r] = 0.f; }
                    const f16x8 x00 = __builtin_bit_cast(f16x8, (v4u){pk_relu_f16(acc0[0], acc0[1]), pk_relu_f16(acc0[2], acc0[3]), pk_relu_f16(acc0[4], acc0[5]), pk_relu_f16(acc0[6], acc0[7])});
                    const f16x8 x01 = __builtin_bit_cast(f16x8, (v4u){pk_relu_f16(acc0[8], acc0[9]), pk_relu_f16(acc0[10], acc0[11]), pk_relu_f16(acc0[12], acc0[13]), pk_relu_f16(acc0[14], acc0[15])});
                    y0 = __builtin_amdgcn_mfma_f32_32x32x16_f16(wa[0][0], x00, y0, 0, 0, 0); y0 = __builtin_amdgcn_mfma_f32_32x32x16_f16(wa[0][1], x01, y0, 0, 0, 0);
                    const f16x8 x10 = __builtin_bit_cast(f16x8, (v4u){pk_relu_f16(acc1[0], acc1[1]), pk_relu_f16(acc1[2], acc1[3]), pk_relu_f16(acc1[4], acc1[5]), pk_relu_f16(acc1[6], acc1[7])});
                    const f16x8 x11 = __builtin_bit_cast(f16x8, (v4u){pk_relu_f16(acc1[8], acc1[9]), pk_relu_f16(acc1[10], acc1[11]), pk_relu_f16(acc1[12], acc1[13]), pk_relu_f16(acc1[14], acc1[15])});
                    y1 = __builtin_amdgcn_mfma_f32_32x32x16_f16(wa[1][0], x10, y1, 0, 0, 0); y1 = __builtin_amdgcn_mfma_f32_32x32x16_f16(wa[1][1], x11, y1, 0, 0, 0);
                    p01 = __builtin_bit_cast(unsigned, __builtin_amdgcn_cvt_pkrtz(y0[0], y0[1])); p23 = __builtin_bit_cast(unsigned, __builtin_amdgcn_cvt_pkrtz(y1[0], y1[1]));
                    __builtin_amdgcn_sched_group_barrier(0x8, 4, 0);
#pragma unroll
                    for (int g = 0; g < 4; ++g) { __builtin_amdgcn_sched_group_barrier(0x8, 1, 0); __builtin_amdgcn_sched_group_barrier(0x2, 4, 0); }
#pragma unroll
                    for (int g = 0; g < 2; ++g) { __builtin_amdgcn_sched_group_barrier(0x8, 1, 0); __builtin_amdgcn_sched_group_barrier(0x2, 8, 0); }
                    __builtin_amdgcn_sched_group_barrier(0x8, 2, 0);
                }
                unsigned h4[4]; h4[0] = p01 & 0xffffu; h4[1] = p01 >> 16; h4[2] = p23 & 0xffffu; h4[3] = p23 >> 16;
                { const int so_ = __builtin_amdgcn_readfirstlane(tile) * 64; int lo_ = ((qh + hi) * SEQ + n) * 2; asm volatile("" : "+v"(lo_));
                  __builtin_amdgcn_raw_buffer_store_b16((short)h4[0], scr, lo_, so_, 0); __builtin_amdgcn_raw_buffer_store_b16((short)h4[1], scr, lo_, so_ + 4 * SEQ, 0);
                  __builtin_amdgcn_raw_buffer_store_b16((short)h4[2], scr, lo_, so_ + 8 * SEQ, 0); __builtin_amdgcn_raw_buffer_store_b16((short)h4[3], scr, lo_, so_ + 12 * SEQ, 0); }
                unsigned bin4[4];
                { typedef unsigned short u16x2_t __attribute__((ext_vector_type(2)));
                  const unsigned b01 = pk_bin16(p01), b23 = pk_bin16(p23);
                  bin4[0] = b01 & 0xffffu; bin4[1] = b01 >> 16; bin4[2] = b23 & 0xffffu; bin4[3] = b23 >> 16; }
                if (full) {
#pragma unroll
                    for (int e = 0; e < 4; ++e) { const int q = qh + 4 * (e >> 1) + hi + 2 * (e & 1); __hip_atomic_fetch_add(&HIST[q * 1024 + (bin4[e] >> 1)], 1u << (16 * (bin4[e] & 1u)), __ATOMIC_RELAXED, __HIP_MEMORY_SCOPE_WORKGROUP); }
                } else {
#pragma unroll
                    for (int e = 0; e < 4; ++e) { const int q = qh + 4 * (e >> 1) + hi + 2 * (e & 1); if (key <= t0 + q) __hip_atomic_fetch_add(&HIST[q * 1024 + (bin4[e] >> 1)], 1u << (16 * (bin4[e] & 1u)), __ATOMIC_RELAXED, __HIP_MEMORY_SCOPE_WORKGROUP); }
                }
            }
            { const int jn = (i0 + u + 4 < cnt4) ? (i0 + u + 4) : (cnt4 - 1); P3_LOADB(u, jn); }
        }
    }
#undef P3_LOADB
}
#define P3_DPP(v, ctrl, rmask, bctl) ((unsigned)__builtin_amdgcn_update_dpp(0, (int)(v), ctrl, rmask, 0xf, bctl))
__device__ __forceinline__ unsigned wave_scan_add(unsigned v) {
    v += P3_DPP(v, 0x111, 0xf, true); v += P3_DPP(v, 0x112, 0xf, true); v += P3_DPP(v, 0x114, 0xf, true); v += P3_DPP(v, 0x118, 0xf, true);
    v += P3_DPP(v, 0x142, 0xa, false); v += P3_DPP(v, 0x143, 0xc, false); return v;
}
__device__ __forceinline__ unsigned wave_scan_max(unsigned v) {
    unsigned t;
    t = P3_DPP(v, 0x111, 0xf, true); v = v > t ? v : t; t = P3_DPP(v, 0x112, 0xf, true); v = v > t ? v : t; t = P3_DPP(v, 0x114, 0xf, true); v = v > t ? v : t; t = P3_DPP(v, 0x118, 0xf, true); v = v > t ? v : t;
    t = P3_DPP(v, 0x142, 0xa, false); v = v > t ? v : t; t = P3_DPP(v, 0x143, 0xc, false); v = v > t ? v : t; return v;
}
__device__ __forceinline__ unsigned wave_shr1(unsigned v) { return P3_DPP(v, 0x138, 0xf, true); }
__device__ __forceinline__ void p3_append(unsigned cm, const v4u& hw, int k0, LAS unsigned* cnt, LAS unsigned* cand) {
    while (cm) { const int j = __ffs((int)cm) - 1; cm &= cm - 1u; const unsigned w = (j < 2) ? hw.x : (j < 4) ? hw.y : (j < 6) ? hw.z : hw.w; const unsigned h = (j & 1) ? (w >> 16) : (w & 0xffffu);
        const unsigned pos = __hip_atomic_fetch_add(cnt, 1u, __ATOMIC_RELAXED, __HIP_MEMORY_SCOPE_WORKGROUP);
        if (pos < (unsigned)P3_CAP) { cand[2 * pos] = key16(h); cand[2 * pos + 1] = (unsigned)(k0 + j); } }
}
__device__ __forceinline__ void p3_index(Frame& F) {
    unsigned char* ws = F.ws; const int tid = F.tid, lane = F.lane, wave = F.wave, n = lane & 31, hi = lane >> 5;
    const bf16* QIF = (const bf16*)(ws + WS_QIF); const bf16* KIF = (const bf16*)(ws + WS_KIF); const float* WIF = (const float*)(ws + WS_WIF); int* SEL = (int*)(ws + WS_SEL);
    unsigned short* SC = (unsigned short*)(ws + WS_PROJ) + (size_t)F.bid * 16 * SEQ;
    LAS unsigned char* lds = F.lds;
    LAS unsigned* HIST = (LAS unsigned*)(lds + P3_HIST); LAS unsigned* H2 = (LAS unsigned*)(lds + P3_H2 + wave * 4096); LAS unsigned* BM = (LAS unsigned*)(lds + P3_BM); LAS unsigned* QS = (LAS unsigned*)(lds + P3_QS);
    LAS unsigned* FBL = (LAS unsigned*)(lds + P3_QS + 1024);
    LAS unsigned* WPX = (LAS unsigned*)(lds + 118784 + wave * 1024);
    if (tid == 0) FBL[0] = 0u;
    __syncthreads();
    for (int ps = F.bid; ps < 512; ps += F.G) {
        const int b = ps >> 8, wq = ps & 255;
#pragma unroll 1
        for (int half = 0; half < 2; ++half) {
            const int idx = half ? (511 - wq) : wq; const int t0 = 16 * idx, row0 = (b << 13) + t0;
            if (idx < 16) {
                for (int e = tid; e < 16 * TOPK; e += 512) { const int q = e >> 8, i = e & 255; SEL[(size_t)(row0 + q) * TOPK + i] = (i <= t0 + q) ? i : 0; }
                continue;
            }
            for (int e = tid; e < 16384; e += 512) HIST[e] = 0u;
            if (tid < 128) QS[tid] = 0u;
            bf16x8 af[2][4]; f16x8 wa[2][2]; const int qh = 8 * (wave >> 2);
            { const int head = (n & 3) + 4 * ((n >> 3) & 1), q4 = ((n >> 2) & 1) + 2 * (n >> 4);
#pragma unroll
              for (int mt = 0; mt < 2; ++mt) { const bf16* ap = QIF + (size_t)(row0 + qh + 4 * mt + q4) * 512 + head * IDX + 32 * hi;
#pragma unroll
                  for (int s = 0; s < 4; ++s) af[mt][s] = *(const bf16x8*)(ap + 8 * s);
#pragma unroll
                  for (int sp = 0; sp < 2; ++sp) {
                      const bool on = (sp == 0) ? ((n == 0 && hi == 0) || (n == 4 && hi == 1)) : ((n == 1 && hi == 0) || (n == 5 && hi == 1));
                      const float* wp = WIF + (size_t)(row0 + qh + 4 * mt + hi + 2 * sp) * 8; const f32x4 w0 = *(const f32x4*)wp, w1 = *(const f32x4*)(wp + 4);
                      f16x8 t; t[0] = (_Float16)w0[0]; t[1] = (_Float16)w0[1]; t[2] = (_Float16)w0[2]; t[3] = (_Float16)w0[3]; t[4] = (_Float16)w1[0]; t[5] = (_Float16)w1[1]; t[6] = (_Float16)w1[2]; t[7] = (_Float16)w1[3];
                      if (!on) t = (f16x8){0, 0, 0, 0, 0, 0, 0, 0};
                      wa[mt][sp] = t; } } }
            const int nt = (t0 + 16 + 31) >> 5; const bf16* kib = KIF + (size_t)(b << 13) * IDX;
            __syncthreads();
            p3_score_pass(af, wa, kib, t0, nt, wave, n, hi, lds, SC, F.bid * 5);
            __syncthreads();
            v4u hv[16];
#define P3_LOADSC(qx) do { unsigned long long qo_ = (unsigned long long)(qx) * (SEQ * 2); asm volatile("" : "+s"(qo_)); const char* s_ = (const char*)SC + qo_; const int n_ = ((t0 + (qx)) >> 9) + 1; const unsigned lo_ = 16u * (unsigned)lane; \
                _Pragma("unroll") for (int ch = 0; ch < 16; ++ch) { hv[ch] = (v4u){0u, 0u, 0u, 0u}; if (ch < n_) hv[ch] = *(const v4u*)(s_ + 1024 * ch + lo_); } } while (0)
            P3_LOADSC(2 * wave);
#pragma unroll 1
            for (int qq = 0; qq < 2; ++qq) {
                const int q = 2 * wave + qq; unsigned T, needA, c; bool ok;
                find_bin_2048(HIST + q * 1024, (unsigned)TOPK, lane, T, needA, c, ok);
                const bool defer = !ok || c > (unsigned)P3_CAP;
                if (defer && lane == 0) { const unsigned k = __hip_atomic_fetch_add(&FBL[0], 1u, __ATOMIC_RELAXED, __HIP_MEMORY_SCOPE_WORKGROUP); if (k < 63u) FBL[1 + k] = (unsigned)(row0 + q); }
                const int tq = t0 + q, nch = (tq >> 9) + 1;
                LAS unsigned char* bmb = (LAS unsigned char*)(BM + q * 256); LAS unsigned* cand = H2; LAS unsigned* bmq = BM + q * 256;
                const bool fastp = T >= 1024u; const unsigned mcT = T - 1024u;
                const unsigned klo = (mcT == 0u) ? 0u : ((mcT + 192u) << 4), khi = (mcT == 1023u) ? 0x7fffu : (((mcT + 192u) << 4) + 15u);
                const int hiT = (int)((khi << 16) | 0xffffu), loT = (int)(klo << 16);
                if (!defer) {
                    if (fastp) {
#pragma unroll
                        for (int ch = 0; ch < 16; ++ch) {
                            if (ch < nch) {
                                const v4u hw = hv[ch]; int k0 = 512 * ch + 8 * lane; asm volatile("" : "+v"(k0));
                                int nv = tq - k0 + 1; nv = nv < 0 ? 0 : (nv > 8 ? 8 : nv); const unsigned vm = (1u << nv) - 1u;
                                unsigned am = 0u, nb = 0u;
#pragma unroll
                                for (int d = 3; d >= 0; --d) { const unsigned w = (d == 0) ? hw.x : (d == 1) ? hw.y : (d == 2) ? hw.z : hw.w; const int wh = (int)w, wl = (int)(w << 16);
                                    am = am + am + ((wh > hiT) ? 1u : 0u); nb = nb + nb + ((wh >= loT) ? 1u : 0u);
                                    am = am + am + ((wl > hiT) ? 1u : 0u); nb = nb + nb + ((wl >= loT) ? 1u : 0u); }
                                am &= vm; const unsigned cm = nb & vm & ~am;
                                bmb[64 * ch + lane] = (unsigned char)am;
                                if (__ballot(cm != 0u) != 0ull) p3_append(cm, hw, k0, &QS[q * 8 + 3], cand);
                            } else { ((LAS unsigned*)bmb)[16 * ch + (lane & 15)] = 0u; }
                        }
                    } else {
#pragma unroll 1
                        for (int ch = 0; ch < 16; ++ch) {
                            if (ch < nch) {
                                int k0 = 512 * ch + 8 * lane; asm volatile("" : "+v"(k0)); const v4u hw = *(const v4u*)(SC + (size_t)q * SEQ + k0);
                                int nv = tq - k0 + 1; nv = nv < 0 ? 0 : (nv > 8 ? 8 : nv); const unsigned vm = (1u << nv) - 1u; unsigned am = 0u, cm = 0u;
#pragma unroll
                                for (int j = 0; j < 8; ++j) { const unsigned w = (j < 2) ? hw.x : (j < 4) ? hw.y : (j < 6) ? hw.z : hw.w; const unsigned h = (j & 1) ? (w >> 16) : (w & 0xffffu);
                                    const unsigned bn = bin16(h); am |= (bn > T) ? (1u << j) : 0u; cm |= (bn == T) ? (1u << j) : 0u; }
                                am &= vm; cm &= vm;
                                bmb[64 * ch + lane] = (unsigned char)am;
                                if (__ballot(cm != 0u) != 0ull) p3_append(cm, hw, k0, &QS[q * 8 + 3], cand);
                            } else { ((LAS unsigned*)bmb)[16 * ch + (lane & 15)] = 0u; }
                        }
                    }
                }
                if (qq == 0) P3_LOADSC(2 * wave + 1);
                if (defer) continue;
                WAVE_SYNC();
                if (c <= 64u) {
                    const bool in = (unsigned)lane < c; const unsigned k32 = in ? cand[2 * lane] : 0u, ki = in ? (cand[2 * lane + 1] & 8191u) : 0u; unsigned rank = 0u;
                    for (unsigned j = 0; j < c; ++j) { const unsigned kj = (unsigned)__builtin_amdgcn_readlane((int)k32, (int)j), ij = (unsigned)__builtin_amdgcn_readlane((int)ki, (int)j); rank += (kj > k32 || (kj == k32 && ij < ki)) ? 1u : 0u; }
                    if (in && rank < needA) __hip_atomic_fetch_or(&bmq[ki >> 5], 1u << (ki & 31), __ATOMIC_RELAXED, __HIP_MEMORY_SCOPE_WORKGROUP);
                } else {
                for (unsigned i0 = 0; i0 < c; i0 += 64) { const unsigned i = i0 + lane; const bool in = i < c; const unsigned k32 = in ? cand[2 * i] : 0u, ki = in ? (cand[2 * i + 1] & 8191u) : 0u; unsigned rank = 0u;
                    for (unsigned j = 0; j < c; ++j) { const unsigned kj = cand[2 * j], ij = cand[2 * j + 1]; rank += (kj > k32 || (kj == k32 && ij < ki)) ? 1u : 0u; }
                    if (in && rank < needA) __hip_atomic_fetch_or(&bmq[ki >> 5], 1u << (ki & 31), __ATOMIC_RELAXED, __HIP_MEMORY_SCOPE_WORKGROUP); }
                }
                WAVE_SYNC();
                { LAS unsigned* mk = WPX;
                  const v4u wv = *(LAS v4u*)(bmq + 4 * lane);
                  const unsigned c0 = __popc(wv.x), c1 = __popc(wv.y), c2 = __popc(wv.z), c3 = __popc(wv.w), mycnt = (c0 + c1) + (c2 + c3);
                  const unsigned ex = wave_scan_add(mycnt) - mycnt;
                  *(LAS v4u*)(mk + 4 * lane) = (v4u){0u, 0u, 0u, 0u};
                  WAVE_SYNC();
                  { const unsigned s0 = ex, s1 = ex + c0, s2 = s1 + c1, s3 = s2 + c2; const unsigned wb = 4u * (unsigned)lane;
                    if (c0) mk[s0 & 255u] = ((wb + 0u) << 16) | s0; if (c1) mk[s1 & 255u] = ((wb + 1u) << 16) | s1; if (c2) mk[s2 & 255u] = ((wb + 2u) << 16) | s2; if (c3) mk[s3 & 255u] = ((wb + 3u) << 16) | s3; }
                  WAVE_SYNC();
                  const v4u mv = *(LAS v4u*)(mk + 4 * lane);
                  unsigned m0 = mv.x, m1 = m0 > mv.y ? m0 : mv.y, m2 = m1 > mv.z ? m1 : mv.z, m3 = m2 > mv.w ? m2 : mv.w;
                  const unsigned pre = wave_shr1(wave_scan_max(m3));
                  m0 = m0 > pre ? m0 : pre; m1 = m1 > pre ? m1 : pre; m2 = m2 > pre ? m2 : pre; m3 = m3 > pre ? m3 : pre;
                  v4i outk;
#pragma unroll
                  for (int k = 0; k < 4; ++k) { const unsigned mm = (k == 0) ? m0 : (k == 1) ? m1 : (k == 2) ? m2 : m3; const unsigned lo = mm >> 16;
                      unsigned w = bmq[lo & 255u], r = (4u * (unsigned)lane + (unsigned)k) - (mm & 0xffffu), bit = 0u, tcnt;
                      tcnt = __popc(w & 0xffffu); if (r >= tcnt) { r -= tcnt; w >>= 16; bit += 16u; }
                      tcnt = __popc(w & 0xffu); if (r >= tcnt) { r -= tcnt; w >>= 8; bit += 8u; }
                      tcnt = __popc(w & 0xfu); if (r >= tcnt) { r -= tcnt; w >>= 4; bit += 4u; }
                      tcnt = __popc(w & 0x3u); if (r >= tcnt) { r -= tcnt; w >>= 2; bit += 2u; }
                      tcnt = w & 1u; if (r >= tcnt) { bit += 1u; }
                      outk[k] = (int)((32u * lo + bit) & 8191u); }
                  *(v4i*)(SEL + (size_t)(row0 + q) * TOPK + 4 * lane) = outk; }
                WAVE_SYNC();
            }
#undef P3_LOADSC
            __syncthreads();
        }
    }
    __syncthreads();
    const unsigned nfb = FBL[0];
    for (unsigned k = 0; k < nfb && k < 63u; ++k) { const int r0 = (int)FBL[1 + k]; __syncthreads(); p3_query_naive(ws, lds, r0, SEL); }
}

typedef short v4i16_t __attribute__((ext_vector_type(4)));
__device__ __forceinline__ v4i16_t tr16(LAS unsigned char* p) { return __builtin_amdgcn_ds_read_tr16_b64_v4i16((LAS v4i16_t*)p); }
typedef __bf16 bf16x2_t __attribute__((ext_vector_type(2)));
__device__ __forceinline__ unsigned dq2(unsigned w, bool hi) { return __builtin_bit_cast(unsigned, hi ? __builtin_amdgcn_cvt_scalef32_pk_bf16_fp8(w, 1.0f, true) : __builtin_amdgcn_cvt_scalef32_pk_bf16_fp8(w, 1.0f, false)); }
__device__ __forceinline__ bf16x8 dq8(unsigned w0, unsigned w1) { return __builtin_bit_cast(bf16x8, (v4u){dq2(w0, false), dq2(w0, true), dq2(w1, false), dq2(w1, true)}); }
__device__ __forceinline__ void p4_dsa(Frame& F) {
    unsigned char* ws = F.ws; const int lane = F.lane, nh = lane & 15, kg = lane >> 4;
    const unsigned char* QF = (const unsigned char*)(ws + WS_QF); const unsigned char* KV8 = (const unsigned char*)(ws + WS_KVF); const int* SEL = (const int*)(ws + WS_SEL); bf16* AO = (bf16*)(ws + WS_AO);
    LAS unsigned char* wl = F.lds + F.wave * 15360; LAS int* selw = (LAS int*)wl; LAS unsigned char* vb = wl + 2048; LAS unsigned char* kb = wl + 7168;
    const int gw = F.wave * F.G + F.bid, NGW = F.G * NWAVES;
    const int tr_r = ((lane >> 1) & 3) + 4 * kg + 16 * ((lane >> 3) & 1);
    LAS unsigned char* trp = vb + tr_r * 144 + 16 * (tr_r >> 4) + 8 * (lane & 1);
    if (gw >= SEQ) return;
    const int per = (SEQ - gw + NGW - 1) / NGW, nU = BATCH * NKV * per;
    const int kswz = 16 * ((lane & 7) ^ ((lane >> 3) & 7));
#define P4_LOADK(buf, batch, selp, kvp) do { _Pragma("unroll") for (int i_ = 0; i_ < 8; ++i_) { const unsigned ko_ = ((((unsigned)(selp)[64 * (batch) + 8 * i_ + (lane >> 3)]) & (unsigned)(SEQ - 1)) << 8) | (unsigned)kswz;     \
        kq[buf][i_ >> 1][i_ & 1] = *(const v4u*)((kvp) + ko_); } } while (0)
#define P4_LOADQ(dst, row_, kvh_) do { const unsigned char* qp_ = QF + (size_t)(row_) * D + ((kvh_) * 4 + (nh & 3)) * HD + 32 * kg; const v4i qa_ = *(const v4i*)qp_, qb_ = *(const v4i*)(qp_ + 16); \
        dst = __builtin_shufflevector(qa_, qb_, 0, 1, 2, 3, 4, 5, 6, 7); if (nh >= 4) dst = (pg8::i32x8){0, 0, 0, 0, 0, 0, 0, 0}; } while (0)
    v4u kq[2][4][2];
    pg8::i32x8 q8;
    {
        const int row = gw;
        *(LAS v4i*)(selw + 4 * lane) = *(const v4i*)(SEL + (size_t)row * TOPK + 4 * lane);
        WAVE_SYNC();
        P4_LOADQ(q8, row, 0);
        P4_LOADK(0, 0, selw, KV8); P4_LOADK(1, 1, selw, KV8);
    }
#pragma unroll 1
    for (int iu = 0; iu < nU; ++iu) {
        const int combo = iu / per, b = combo >> 1, kvh = combo & 1, t = gw + (iu - combo * per) * NGW;
        const unsigned char* kvb = KV8 + (size_t)(b * NKV + kvh) * SEQ * 256;
        const int row = (b << 13) + t; const int cnt = (t + 1 < TOPK) ? (t + 1) : TOPK;
        LAS int* selc = selw + 256 * (iu & 1); LAS int* seln = selw + 256 * ((iu + 1) & 1);
        const bool hasn = iu + 1 < nU; const int iun = hasn ? iu + 1 : iu;
        const int combon = iun / per, bn = combon >> 1, kvhn = combon & 1, tn = gw + (iun - combon * per) * NGW, rown = (bn << 13) + tn;
        const unsigned char* kvbn = KV8 + (size_t)(bn * NKV + kvhn) * SEQ * 256;
        f32x4 S[16];
#pragma unroll
        for (int bt = 0; bt < 4; ++bt) {
            asm volatile("" ::: "memory");
#pragma unroll
            for (int i = 0; i < 8; ++i) *(LAS v4u*)(kb + (8 * i + (lane >> 3)) * 128 + 16 * (lane & 7)) = kq[bt & 1][i >> 1][i & 1];
            asm volatile("" ::: "memory");
#pragma unroll
            for (int tt = 0; tt < 4; ++tt) {
                const LAS unsigned char* kr = kb + (16 * tt + nh) * 128;
                const v4i ka = *(const LAS v4i*)(kr + 16 * ((2 * kg) ^ (nh & 7))), kc = *(const LAS v4i*)(kr + 16 * ((2 * kg + 1) ^ (nh & 7)));
                const pg8::i32x8 k8 = __builtin_shufflevector(ka, kc, 0, 1, 2, 3, 4, 5, 6, 7);
                S[4 * bt + tt] = __builtin_amdgcn_mfma_scale_f32_16x16x128_f8f6f4(k8, q8, (f32x4){0.f, 0.f, 0.f, 0.f}, 0, 0, 0, 0, 0, 0);
            }
            if (bt < 2) P4_LOADK(bt & 1, bt + 2, selc, kvb);
        }
        const unsigned vlo = 128u + 16u * (unsigned)(lane & 7);
        v4u g[3][4];
#define P4_LOADV(buf, c_) do { _Pragma("unroll") for (int i = 0; i < 4; ++i) { const unsigned vo_ = ((((unsigned)selc[32 * (c_) + (lane >> 3) + 8 * i]) & (unsigned)(SEQ - 1)) << 8) | vlo; g[buf][i] = *(const v4u*)(kvb + vo_); } } while (0)
        P4_LOADV(0, 0); P4_LOADV(1, 1); P4_LOADV(2, 2);
        float mx = -INFINITY;
        if (cnt < TOPK) {
            asm volatile("" ::: "memory");
#pragma unroll
            for (int T = 0; T < 16; ++T)
#pragma unroll
                for (int r = 0; r < 4; ++r) S[T][r] = (4 * kg + r < cnt - 16 * T) ? S[T][r] : -INFINITY;
        }
#define P4_DPP(old_, src_, ctrl_, bank_) __builtin_bit_cast(float, __builtin_amdgcn_update_dpp(__builtin_bit_cast(int, (float)(old_)), __builtin_bit_cast(int, (float)(src_)), (ctrl_), 0xf, (bank_), false))
#pragma unroll
        for (int i = 0; i < 4; ++i)
#pragma unroll
            for (int r = 0; r < 4; ++r) { float v = S[i][r];
                v = P4_DPP(v, S[4 + i][r], 0x114, 0x2); v = P4_DPP(v, S[8 + i][r], 0x118, 0x4); v = P4_DPP(v, S[12 + i][r], 0x11C, 0x8); S[i][r] = v; }
#pragma unroll
        for (int i = 0; i < 4; ++i)
#pragma unroll
            for (int r = 0; r < 4; ++r) mx = fmaxf(mx, S[i][r]);
        mx = fmaxf(mx, P4_DPP(mx, mx, 0x128, 0xf)); mx = fmaxf(mx, P4_DPP(mx, mx, 0x124, 0xf));
        mx = fmaxf(mx, __shfl_xor(mx, 16)); mx = fmaxf(mx, __shfl_xor(mx, 32));
        float sum = 0.f;
#pragma unroll
        for (int i = 0; i < 4; ++i)
#pragma unroll
            for (int r = 0; r < 4; ++r) { const float e = __builtin_amdgcn_exp2f((S[i][r] - mx) * (1.0f / P4_QS) + 8.0f); S[i][r] = e; sum += e; }
        sum += P4_DPP(sum, sum, 0x128, 0xf); sum += P4_DPP(sum, sum, 0x124, 0xf);
        sum += __shfl_xor(sum, 16); sum += __shfl_xor(sum, 32);
        int pl[4];
#pragma unroll
        for (int i = 0; i < 4; ++i) { int w = __builtin_amdgcn_cvt_pk_fp8_f32(S[i][0], S[i][1], 0, false); pl[i] = __builtin_amdgcn_cvt_pk_fp8_f32(S[i][2], S[i][3], w, true); }
        long pa[8];
#pragma unroll
        for (int i2 = 0; i2 < 2; ++i2) { const int a0 = pl[2 * i2], a1 = pl[2 * i2 + 1];
            pa[i2] = __builtin_bit_cast(long, (v2u){(unsigned)a0, (unsigned)a1});
            pa[2 + i2] = __builtin_bit_cast(long, (v2u){(unsigned)__builtin_amdgcn_update_dpp(a0, a0, 0x104, 0xf, 0x1, false), (unsigned)__builtin_amdgcn_update_dpp(a1, a1, 0x104, 0xf, 0x1, false)});
            pa[4 + i2] = __builtin_bit_cast(long, (v2u){(unsigned)__builtin_amdgcn_update_dpp(a0, a0, 0x108, 0xf, 0x1, false), (unsigned)__builtin_amdgcn_update_dpp(a1, a1, 0x108, 0xf, 0x1, false)});
            pa[6 + i2] = __builtin_bit_cast(long, (v2u){(unsigned)__builtin_amdgcn_update_dpp(a0, a0, 0x10C, 0xf, 0x1, false), (unsigned)__builtin_amdgcn_update_dpp(a1, a1, 0x10C, 0xf, 0x1, false)}); }
#undef P4_DPP
        f32x4 O[8];
#pragma unroll
        for (int d = 0; d < 8; ++d) O[d] = (f32x4){0.f, 0.f, 0.f, 0.f};
        v4i nsel; pg8::i32x8 q8n;
#pragma unroll
        for (int c = 0; c < 8; ++c) {
#pragma unroll
            for (int i = 0; i < 4; ++i) *(LAS v4u*)(vb + ((lane >> 3) + 8 * i) * 144 + 16 * (i >> 1) + 16 * (lane & 7)) = g[c % 3][i];
            asm volatile("" ::: "memory");
            if (c < 5) P4_LOADV(c % 3, c + 3);
            if (c == 0) nsel = *(const v4i*)(SEL + (size_t)rown * TOPK + 4 * lane);
            if (c == 2) { *(LAS v4i*)(seln + 4 * lane) = nsel; WAVE_SYNC(); }
            if (c == 3) P4_LOADK(0, 0, seln, kvbn);
            if (c == 4) P4_LOADK(1, 1, seln, kvbn);
            if (c == 5) P4_LOADQ(q8n, rown, kvhn);
#pragma unroll
            for (int d = 0; d < 8; ++d) {
                typedef int v2i_t __attribute__((ext_vector_type(2))); const v2i_t vfr = __builtin_amdgcn_ds_read_tr8_b64_v2i32((LAS v2i_t*)(trp + 16 * d));
                O[d] = __builtin_amdgcn_mfma_f32_16x16x32_fp8_fp8(pa[c], __builtin_bit_cast(long, vfr), O[d], 0, 0, 0);
            }
        }
#undef P4_LOADV
        const float i0 = 1.0f / __builtin_bit_cast(float, __builtin_amdgcn_readlane(__builtin_bit_cast(int, sum), 0)), i1 = 1.0f / __builtin_bit_cast(float, __builtin_amdgcn_readlane(__builtin_bit_cast(int, sum), 1));
        const float i2 = 1.0f / __builtin_bit_cast(float, __builtin_amdgcn_readlane(__builtin_bit_cast(int, sum), 2)), i3 = 1.0f / __builtin_bit_cast(float, __builtin_amdgcn_readlane(__builtin_bit_cast(int, sum), 3));
        LAS unsigned char* ost = (LAS unsigned char*)vb;
        if (kg == 0) {
#pragma unroll
            for (int d = 0; d < 8; ++d) { const unsigned w = pg8::pk4_fp8(O[d][0] * (i0 * pg8::F8_SX), O[d][1] * (i1 * pg8::F8_SX), O[d][2] * (i2 * pg8::F8_SX), O[d][3] * (i3 * pg8::F8_SX));
                ost[0 * 128 + 16 * d + nh] = (unsigned char)w; ost[1 * 128 + 16 * d + nh] = (unsigned char)(w >> 8); ost[2 * 128 + 16 * d + nh] = (unsigned char)(w >> 16); ost[3 * 128 + 16 * d + nh] = (unsigned char)(w >> 24); }
        }
        WAVE_SYNC();
        const v2u ov = *(LAS v2u*)(vb + 8 * lane);
        *(v2u*)((unsigned char*)AO + (size_t)row * D + kvh * 4 * HD + 8 * lane) = ov;
        WAVE_SYNC();
        q8 = q8n;
    }
#undef P4_LOADK
#undef P4_LOADQ
}

__device__ __forceinline__ void p9_sb(Frame& F) {
    unsigned char* ws = F.ws; const int lane = F.lane, n = lane & 31, hi = lane >> 5;
    const bf16* KQ = (const bf16*)(ws + WS_KQ); const bf16* VT = (const bf16*)(ws + WS_VT); bf16* AO = (bf16*)(ws + WS_AO);
    const int gw = F.wave * F.G + F.bid, NGW = F.G * NWAVES;
    const int koff = 16 * (n >> 4) + 8 * ((n >> 2) & 1) + 4 * ((n >> 3) & 1) + (n & 3);
    constexpr float LOG2E = 1.4426950408889634f, LN2 = 0.6931471805599453f;
    LAS unsigned char* kimg = F.lds + F.wave * 16384; LAS unsigned char* vimg = kimg + 8192;
    const LAS unsigned char* krow = kimg + koff * 256; const int kx = koff & 15;
#define P9_LOADK(kbk) do { int l_ = lane; asm volatile("" : "+v"(l_)); const int ksw = (l_ & 15) ^ (l_ >> 4);     \
        _Pragma("unroll") for (int i_ = 0; i_ < 8; ++i_) kraw[i_] = *(const v4u*)(KQ + (size_t)(b * SEQ + 32 * (kbk) + 4 * i_ + (l_ >> 4)) * 2048 + h * HD + 8 * (ksw ^ ((4 * i_) & 15))); } while (0)
    for (int u = gw; u < (M / 32) * NH; u += NGW) {
        const int h = u & 7, blk = u >> 3, b = blk >> 8, qb = blk & 255, q0 = 32 * qb, t = q0 + n;
        bf16x8 qf[8];
        { v4u qraw[8]; int l_ = lane; asm volatile("" : "+v"(l_)); const int ksw = (l_ & 15) ^ (l_ >> 4);
#pragma unroll
          for (int i = 0; i < 8; ++i) qraw[i] = *(const v4u*)(KQ + (size_t)(b * SEQ + q0 + 4 * i + (l_ >> 4)) * 2048 + 1024 + h * HD + 8 * (ksw ^ ((4 * i) & 15)));
#pragma unroll
          for (int i = 0; i < 8; ++i) *(LAS v4u*)(kimg + 1024 * i + 16 * lane) = qraw[i];
          asm volatile("" ::: "memory");
#pragma unroll
          for (int s = 0; s < 8; ++s) qf[s] = *(const LAS bf16x8*)(kimg + (l_ & 31) * 256 + 16 * ((2 * s + (l_ >> 5)) ^ (l_ & 15)));
          asm volatile("" ::: "memory"); }
        f32x16 o[4];
#pragma unroll
        for (int mt = 0; mt < 4; ++mt)
#pragma unroll
            for (int r = 0; r < 16; ++r) o[mt][r] = 0.f;
        float C = 1.f;
        v4u kraw[8];
        P9_LOADK(qb);
        for (int kb = qb; kb >= 0; --kb) {
            const int k0 = 32 * kb;
            v4u vraw[8];
            { int l_ = lane; asm volatile("" : "+v"(l_)); const int vsw = (l_ & 3) ^ ((l_ >> 4) & 3);
#pragma unroll
              for (int i = 0; i < 8; ++i) vraw[i] = *(const v4u*)(VT + (size_t)(h * HD + 16 * i + (l_ >> 2)) * M + b * SEQ + k0 + 8 * vsw); }
#pragma unroll
            for (int i = 0; i < 8; ++i) *(LAS v4u*)(kimg + 1024 * i + 16 * lane) = kraw[i];
            asm volatile("" ::: "memory");
            f32x16 z;
#pragma unroll
            for (int r = 0; r < 16; ++r) z[r] = 0.f;
#pragma unroll
            for (int s = 0; s < 8; ++s) { const bf16x8 kf = *(const LAS bf16x8*)(krow + 16 * ((2 * s + hi) ^ kx)); z = __builtin_amdgcn_mfma_f32_32x32x16_bf16(kf, qf[s], z, 0, 0, 0); }
            { const int kn = (kb > 0) ? kb - 1 : 0; P9_LOADK(kn); }
            float rk[16], bk[16];
#pragma unroll
            for (int r = 0; r < 16; ++r) {
                const int key = k0 + ((r < 8) ? (8 * hi + r) : (16 + 8 * hi + (r - 8)));
                const float e = __builtin_amdgcn_exp2f(fminf(z[r], 60.0f) * LOG2E), rr = __builtin_amdgcn_rcpf(1.0f + e);
                const bool valid = key < t;
                rk[r] = valid ? rr : 1.0f;
                bk[r] = valid ? e * rr : 0.0f;
            }
            float suf[16];
            suf[7] = 1.f; suf[15] = 1.f;
#pragma unroll
            for (int i = 6; i >= 0; --i) { suf[i] = suf[i + 1] * rk[i + 1]; suf[8 + i] = suf[9 + i] * rk[9 + i]; }
            const float T0 = suf[0] * rk[0], T1 = suf[8] * rk[8];
            const float P0 = __shfl_xor(T0, 32), P1 = __shfl_xor(T1, 32);
            const float base1 = C * (hi ? 1.f : P1), base0 = C * (hi ? (T1 * P1) : (P0 * T1 * P1));
            unsigned pw[8];
#pragma unroll
            for (int r = 0; r < 16; r += 2) {
                const float a0 = bk[r] * ((r < 8) ? base0 : base1) * suf[r], a1 = bk[r + 1] * ((r < 8) ? base0 : base1) * suf[r + 1];
                pw[r >> 1] = pg8::cvt_pk_bf16(a0, a1);
            }
            C *= (T0 * T1) * (P0 * P1);
            const bf16x8 pa0 = __builtin_bit_cast(bf16x8, (v4u){pw[0], pw[1], pw[2], pw[3]}), pa1 = __builtin_bit_cast(bf16x8, (v4u){pw[4], pw[5], pw[6], pw[7]});
#pragma unroll
            for (int i = 0; i < 8; ++i) *(LAS v4u*)(vimg + 1024 * i + 16 * lane) = vraw[i];
            asm volatile("" ::: "memory");
#pragma unroll
            for (int mt = 0; mt < 4; ++mt) { const LAS unsigned char* vr = vimg + (32 * mt + n) * 64; const int vx = (n >> 2) & 3;
                const bf16x8 vf0 = *(const LAS bf16x8*)(vr + 16 * (hi ^ vx)), vf1 = *(const LAS bf16x8*)(vr + 16 * ((2 + hi) ^ vx));
                o[mt] = __builtin_amdgcn_mfma_f32_32x32x16_bf16(vf0, pa0, o[mt], 0, 0, 0); o[mt] = __builtin_amdgcn_mfma_f32_32x32x16_bf16(vf1, pa1, o[mt], 0, 0, 0); }
            if (__all(C < 7.7811323e-20f)) break;
        }
        { int l_ = lane; asm volatile("" : "+v"(l_)); LAS unsigned char* orow = kimg + (l_ & 31) * 256 + 8 * (l_ >> 5); const int ox = l_ & 15;
#pragma unroll
        for (int mt = 0; mt < 4; ++mt)
#pragma unroll
            for (int g = 0; g < 4; ++g) { v2u w; w.x = pg8::cvt_pk_bf16(o[mt][4 * g], o[mt][4 * g + 1]); w.y = pg8::cvt_pk_bf16(o[mt][4 * g + 2], o[mt][4 * g + 3]);
                *(LAS v2u*)(orow + 16 * ((4 * mt + g) ^ ox)) = w; } }
        asm volatile("" ::: "memory");
        { int l_ = lane; asm volatile("" : "+v"(l_)); const int ksw = (l_ & 15) ^ (l_ >> 4);
#pragma unroll
          for (int i = 0; i < 8; ++i) { const v4u w = *(const LAS v4u*)(kimg + 1024 * i + 16 * l_);
              *(v4u*)(AO + (size_t)(b * SEQ + q0 + 4 * i + (l_ >> 4)) * D + h * HD + 8 * (ksw ^ ((4 * i) & 15))) = w; } }
        asm volatile("" ::: "memory");
    }
#undef P9_LOADK
}

__device__ __forceinline__ void p11_router(Frame& F) {
    unsigned char* ws = F.ws; const int tid = F.tid, lane = F.lane, wave = F.wave;
    const bf16* H = (const bf16*)(ws + WS_H); const float* gn = F.in[IN_FFNNORM] + D; const float* Wr = F.in[IN_ROUTER];
    int* TOPE = (int*)(ws + WS_RT); int* POS = (int*)(ws + WS_RT + 128 * 1024); float* GATE = (float*)(ws + WS_RT + 256 * 1024); float* RSTD3 = (float*)(ws + WS_RT + 384 * 1024);
    LAS unsigned* lcnt = (LAS unsigned*)F.lds;
    LAS unsigned* gb = (LAS unsigned*)(F.lds + 64);
    LAS int* ltok = (LAS int*)(F.lds + 128);
    LAS float* lgt = (LAS float*)(F.lds + 128 + 1024);
    float wg[16][8];
#pragma unroll
    for (int j = 0; j < 4; ++j)
#pragma unroll
        for (int i = 0; i < 4; ++i) { const int k = 256 * j + 4 * lane + i; const float g = gn[k]; const f32x4 w0 = *(const f32x4*)(Wr + (size_t)k * 8), w1 = *(const f32x4*)(Wr + (size_t)k * 8 + 4);
#pragma unroll
            for (int e = 0; e < 4; ++e) { wg[4 * j + i][e] = w0[e] * g; wg[4 * j + i][4 + e] = w1[e] * g; } }
    for (int chunk = F.bid; chunk < M / 64; chunk += F.G) {
        if (tid < 8) lcnt[tid] = 0u;
        __syncthreads();
        v2u xc[4];
        { const GAS v2u* xr = (const GAS v2u*)(H + (size_t)(chunk * 64 + wave * 8) * D) + lane;
#pragma unroll
          for (int j = 0; j < 4; ++j) xc[j] = xr[64 * j]; }
#pragma unroll 1
        for (int r = 0; r < 8; ++r) {
            const int row = chunk * 64 + wave * 8 + r;
            v2u xn[4];
            { const GAS v2u* xr = (const GAS v2u*)(H + (size_t)(row + ((r < 7) ? 1 : 0)) * D) + lane;
#pragma unroll
              for (int j = 0; j < 4; ++j) xn[j] = xr[64 * j]; }
            f32x4 v[4]; float ss = 0.f;
#pragma unroll
            for (int j = 0; j < 4; ++j) { const v2u w = xc[j]; xc[j] = xn[j]; v[j] = (f32x4){bflo(w.x), bfhi(w.x), bflo(w.y), bfhi(w.y)}; ss += (v[j].x * v[j].x + v[j].y * v[j].y) + (v[j].z * v[j].z + v[j].w * v[j].w); }
            ss = wave_sum(ss); const float rs = 1.0f / sqrtf(ss * (1.0f / 1024.0f) + 1e-6f);
            float lg[8] = {0.f, 0.f, 0.f, 0.f, 0.f, 0.f, 0.f, 0.f};
#pragma unroll
            for (int j = 0; j < 4; ++j)
#pragma unroll
                for (int i = 0; i < 4; ++i) { const float xv = v[j][i];
#pragma unroll
                    for (int e = 0; e < 8; ++e) lg[e] += xv * wg[4 * j + i][e]; }
#pragma unroll
            for (int e = 0; e < 8; ++e) lg[e] = wave_sum(lg[e]) * rs;
            int i1 = 0; float l1 = lg[0];
#pragma unroll
            for (int e = 1; e < 8; ++e) if (lg[e] > l1) { l1 = lg[e]; i1 = e; }
            int i2 = -1; float l2 = -INFINITY;
#pragma unroll
            for (int e = 0; e < 8; ++e) if (e != i1 && lg[e] > l2) { l2 = lg[e]; i2 = e; }
            const float g1 = 1.0f / (1.0f + __expf(l2 - l1)), g2 = 1.0f - g1;
            if (lane == 0) {
                const unsigned p1 = __hip_atomic_fetch_add(&lcnt[i1], 1u, __ATOMIC_RELAXED, __HIP_MEMORY_SCOPE_WORKGROUP), p2 = __hip_atomic_fetch_add(&lcnt[i2], 1u, __ATOMIC_RELAXED, __HIP_MEMORY_SCOPE_WORKGROUP);
                const int ti = wave * 8 + r; ltok[ti * 4 + 0] = i1; ltok[ti * 4 + 1] = i2; ltok[ti * 4 + 2] = (int)p1; ltok[ti * 4 + 3] = (int)p2;
                lgt[ti * 4 + 0] = g1; lgt[ti * 4 + 1] = g2; lgt[ti * 4 + 2] = rs;
            }
        }
        __syncthreads();
        if (tid < 8) gb[tid] = __hip_atomic_fetch_add(F.ctl + CW_CNT + tid, lcnt[tid], RLX_AGENT);
        __syncthreads();
        if (tid < 64) { const int row = chunk * 64 + tid; const int e1 = ltok[tid * 4], e2 = ltok[tid * 4 + 1];
            TOPE[row * 2] = e1; TOPE[row * 2 + 1] = e2; POS[row * 2] = (int)gb[e1] + ltok[tid * 4 + 2]; POS[row * 2 + 1] = (int)gb[e2] + ltok[tid * 4 + 3];
            GATE[row * 2] = lgt[tid * 4]; GATE[row * 2 + 1] = lgt[tid * 4 + 1]; RSTD3[row] = lgt[tid * 4 + 2]; }
        __syncthreads();
    }
}
__device__ __forceinline__ void moe_bases(Frame& F, int (&tb)[9]) {
    int acc = 0;
#pragma unroll
    for (int e = 0; e < 8; ++e) { tb[e] = acc; const unsigned c = __hip_atomic_load(F.ctl + CW_CNT + e, RLX_AGENT); acc += (int)((c + 255u) >> 8); }
    tb[8] = acc;
}
__device__ __forceinline__ void p12_permute(Frame& F) {
    unsigned char* ws = F.ws; const int lane = F.lane;
    const int* TOPE = (const int*)(ws + WS_RT); const int* POS = (const int*)(ws + WS_RT + 128 * 1024); const float* RSTD3 = (const float*)(ws + WS_RT + 384 * 1024);
    int* SLOT = (int*)(ws + WS_RT + 512 * 1024);
    const bf16* H = (const bf16*)(ws + WS_H); bf16* XP = (bf16*)(ws + WS_XPERM);
    int tb[9]; moe_bases(F, tb);
    const int gw = F.wave * F.G + F.bid, NGW = F.G * NWAVES;
    for (int row0 = gw; row0 < M; row0 += 4 * NGW) {
        int sl[4][2]; float r16[4]; v2u w[4][4];
#pragma unroll
        for (int r = 0; r < 4; ++r) { const int row = (row0 + r * NGW < M) ? (row0 + r * NGW) : row0;
#pragma unroll
            for (int q = 0; q < 2; ++q) { const int e = TOPE[2 * row + q]; int base = 0;
#pragma unroll
                for (int k = 0; k < 8; ++k) base = (e == k) ? tb[k] : base;
                sl[r][q] = base * 256 + POS[2 * row + q]; }
            r16[r] = RSTD3[row] * pg8::F8_SX;
            const GAS v2u* src = (const GAS v2u*)(H + (size_t)row * D) + lane;
#pragma unroll
            for (int j = 0; j < 4; ++j) w[r][j] = src[64 * j]; }
#pragma unroll
        for (int r = 0; r < 4; ++r) { if (row0 + r * NGW >= M) break; const int row = row0 + r * NGW;
            GAS unsigned* d0 = (GAS unsigned*)((unsigned char*)XP + (size_t)sl[r][0] * D) + lane; GAS unsigned* d1 = (GAS unsigned*)((unsigned char*)XP + (size_t)sl[r][1] * D) + lane;
#pragma unroll
            for (int j = 0; j < 4; ++j) { const unsigned o = pg8::pk4_fp8(bflo(w[r][j].x) * r16[r], bfhi(w[r][j].x) * r16[r], bflo(w[r][j].y) * r16[r], bfhi(w[r][j].y) * r16[r]); d0[64 * j] = o; d1[64 * j] = o; }
            if (lane == 0) { SLOT[2 * row] = sl[r][0]; SLOT[2 * row + 1] = sl[r][1]; } }
    }
}
constexpr float Y8_S = 16.f;
typedef float f32x2_t __attribute__((ext_vector_type(2)));
__device__ __forceinline__ void p15_combine(Frame& F) {
    unsigned char* ws = F.ws; const int lane = F.lane;
    const bf16* H = (const bf16*)(ws + WS_H); const unsigned char* Y = ws + WS_Y; const int* SLOT = (const int*)(ws + WS_RT + 512 * 1024); const float* GATE = (const float*)(ws + WS_RT + 256 * 1024);
    const int gw = F.wave * F.G + F.bid, NGW = F.G * NWAVES;
    for (int row0 = gw; row0 < M; row0 += 4 * NGW) {
        int s1[4], s2[4]; float g1[4], g2[4];
#pragma unroll
        for (int r = 0; r < 4; ++r) { const int row = (row0 + r * NGW < M) ? (row0 + r * NGW) : row0; s1[r] = SLOT[row * 2]; s2[r] = SLOT[row * 2 + 1]; g1[r] = GATE[row * 2] * (1.0f / Y8_S); g2[r] = GATE[row * 2 + 1] * (1.0f / Y8_S); }
        v2u hw[4][4]; unsigned a[4][4], c[4][4];
#pragma unroll
        for (int r = 0; r < 4; ++r) { const int row = (row0 + r * NGW < M) ? (row0 + r * NGW) : row0;
            const GAS v2u* hr = (const GAS v2u*)(H + (size_t)row * D) + lane; const GAS unsigned* y1 = (const GAS unsigned*)(Y + (size_t)s1[r] * D) + lane; const GAS unsigned* y2 = (const GAS unsigned*)(Y + (size_t)s2[r] * D) + lane;
#pragma unroll
            for (int j = 0; j < 4; ++j) { hw[r][j] = __builtin_nontemporal_load(hr + 64 * j); a[r][j] = __builtin_nontemporal_load(y1 + 64 * j); c[r][j] = __builtin_nontemporal_load(y2 + 64 * j); } }
#pragma unroll
        for (int r = 0; r < 4; ++r) { if (row0 + r * NGW >= M) break; GAS f32x4* orow = (GAS f32x4*)(F.out + (size_t)(row0 + r * NGW) * D) + lane;
#pragma unroll
            for (int j = 0; j < 4; ++j) {
                const f32x2_t a0 = __builtin_amdgcn_cvt_pk_f32_fp8((int)a[r][j], false), a1 = __builtin_amdgcn_cvt_pk_f32_fp8((int)a[r][j], true), c0 = __builtin_amdgcn_cvt_pk_f32_fp8((int)c[r][j], false), c1 = __builtin_amdgcn_cvt_pk_f32_fp8((int)c[r][j], true);
                f32x4 o; o.x = bflo(hw[r][j].x) + (g1[r] * a0[0] + g2[r] * c0[0]); o.y = bfhi(hw[r][j].x) + (g1[r] * a0[1] + g2[r] * c0[1]); o.z = bflo(hw[r][j].y) + (g1[r] * a1[0] + g2[r] * c1[0]); o.w = bfhi(hw[r][j].y) + (g1[r] * a1[1] + g2[r] * c1[1]); orow[64 * j] = o; } }
    }
}

constexpr int N_PHASES = 16;
#ifndef MK_ONE_LAUNCH
#define MK_ONE_LAUNCH 1
#endif
struct Args { const float* in[17]; float* out; unsigned char* ws; int ph_lo, ph_hi; };
__global__ void __launch_bounds__(NWAVES * 64, 2) yoco_fwd(Args args) {
    extern __shared__ __attribute__((aligned(16))) unsigned char lds[];
    Frame F;
    F.lds = (LAS unsigned char*)lds; F.MISC = (volatile LAS unsigned*)(F.lds + MISC_OFF);
    F.tid = threadIdx.x; F.lane = F.tid & 63; F.wave = __builtin_amdgcn_readfirstlane(F.tid >> 6); F.G = gridDim.x; F.bid = blockIdx.x;
    F.ws = args.ws; F.ctl = (gu32*)(args.ws + WS_CTL); F.out = args.out;
#pragma unroll
    for (int i = 0; i < 17; ++i) F.in[i] = args.in[i];
    for (int u = F.tid; u < (LDS_BYTES - LDSCTL_OFF) / 4; u += NWAVES * 64) ((LAS unsigned*)(F.lds + LDSCTL_OFF))[u] = 0u;
    __syncthreads();
    unsigned char* ws = args.ws;
    XcdBarrier bar; bar.bar = (unsigned*)(F.ctl + CW_BAR); bar.x = 0; bar.st = nullptr;
    if (MK_ONE_LAUNCH) bar = xcd_barrier_post((unsigned*)(F.ctl + CW_BAR), F.MISC + 8);
    const int lo = args.ph_lo, hi = args.ph_hi;
#define IN(k) (lo <= (k) && (k) < hi)
#define SEAM(k) do { if (MK_ONE_LAUNCH && IN((k) + 1)) xcd_barrier(bar); } while (0)
    bf16* XB = (bf16*)(ws + WS_XB); bf16* H = (bf16*)(ws + WS_H); bf16* AO = (bf16*)(ws + WS_AO);

    if (IN(0)) { p0_prologue(F); SEAM(0); }
    if (IN(1)) {
        pg8::Gemm g{XB, (const bf16*)(ws + WS_WIN), M, 2048, D}; pg8::StaticOrder S; S.init(M, 2048, F.G, F.bid);
        pg8::EpiProj E{ws + WS_QF, ws + WS_KVF, (bf16*)(ws + WS_QIF), F.in[IN_AQN], F.in[IN_AKN], (const unsigned*)(ws + WS_ROPE), (LAS float*)(F.lds + PS_OFF), QSCALE * P4_QS};
        pg8::gemm_phase<pg8::EpiProj, pg8::StaticOrder, true, true>(F.lds, g, S, E); }
    if (IN(2)) { p2_post(F); SEAM(2); }
    if (IN(3)) { p3_index(F); SEAM(3); }
    if (IN(4)) { p4_dsa(F); SEAM(4); }
    if (IN(5)) {
        pg8::Gemm g{AO, (const bf16*)(ws + WS_WOA), M, D, D / 2}; pg8::StaticOrder S; S.init(M, D, F.G, F.bid);
        pg8::EpiResid<true, false> E{F.in[IN_X], H, (unsigned char*)XB, (float*)(ws + WS_SS1), 1.0f / (pg8::F8_SX * pg8::F8_SWGU), F.lds + PS_OFF};
        pg8::gemm_phase<pg8::EpiResid<true, false>, pg8::StaticOrder, true, true, true>(F.lds, g, S, E); SEAM(5); }
    if (IN(6)) {
        pg8::Gemm g{XB, (const bf16*)(ws + WS_WGU), M, 2 * FF, D / 2}; pg8::StaticOrder S; S.init(M, 2 * FF, F.G, F.bid);
        LAS float* RSL = (LAS float*)(F.lds + PS_OFF);
        {
#pragma unroll
          for (int i = 0; i < 6; ++i) { pg8::Unit uu; if (S.next(i, uu) && F.tid < 256) RSL[i * 256 + F.tid] = pg8::rstd16((const float*)(ws + WS_SS1) + (size_t)(uu.pm * 256 + F.tid) * 16); } }
        __syncthreads();
        pg8::EpiSwiGLU8<false> E{ws + WS_HF, FF, RSL};
        pg8::gemm_phase<pg8::EpiSwiGLU8<false>, pg8::StaticOrder, true, true, true, true>(F.lds, g, S, E); SEAM(6); }
    if (IN(7)) {
        pg8::Gemm g{(const bf16*)(ws + WS_HF), (const bf16*)(ws + WS_WD), M, D, FF / 2}; pg8::StaticOrder S; S.init(M, D, F.G, F.bid);
        pg8::EpiResid<true, true> E{H, H, (unsigned char*)XB, (float*)(ws + WS_SS2), 1.0f / (pg8::F8_SH * pg8::F8_SWD), F.lds + PS_OFF};
        pg8::gemm_phase<pg8::EpiResid<true, true>, pg8::StaticOrder, true, true, true>(F.lds, g, S, E); SEAM(7); }
    if (IN(8)) {
        LAS float* RSL = (LAS float*)(F.lds + PS_OFF);
        { pg8::Gemm g{XB, (const bf16*)(ws + WS_WKQ8), M, 2048, D / 2}; pg8::StaticOrder S; S.init(M, 2048, F.G, F.bid);
#pragma unroll
          for (int i = 0; i < 2; ++i) { pg8::Unit uu; if (S.next(i, uu) && F.tid < 256) RSL[i * 256 + F.tid] = pg8::rstd16((const float*)(ws + WS_SS2) + (size_t)(uu.pm * 256 + F.tid) * 16); }
          __syncthreads();
          pg8::EpiScaleBf16 E{(bf16*)(ws + WS_KQ), 2048, RSL, 1.0f / (pg8::F8_SX * pg8::F8_SWGU), 1.0f / (pg8::F8_SX * F8_SWQ)};
          pg8::gemm_phase<pg8::EpiScaleBf16, pg8::StaticOrder, true, true, true>(F.lds, g, S, E); }
        { pg8::Gemm g{(const bf16*)(ws + WS_WKQ8 + (size_t)2048 * D), XB, D, M, D / 2}; pg8::StaticOrder S; S.init(D, M, F.G, F.bid);
          { pg8::Unit uu; if (S.next(0, uu) && F.tid < 256) RSL[F.tid] = pg8::rstd16((const float*)(ws + WS_SS2) + (size_t)(uu.pn * 256 + F.tid) * 16); }
          __syncthreads();
          pg8::EpiScaleColBf16 E{(bf16*)(ws + WS_VT), M, RSL, 1.0f / (pg8::F8_SX * pg8::F8_SWGU)};
          pg8::gemm_phase<pg8::EpiScaleColBf16, pg8::StaticOrder, true, true, true>(F.lds, g, S, E); }
        SEAM(8); }
    if (IN(9)) { p9_sb(F); SEAM(9); }
    if (IN(10)) {
        pg8::Gemm g{AO, (const bf16*)(ws + WS_WOB), M, D, D}; pg8::StaticOrder S; S.init(M, D, F.G, F.bid);
        pg8::EpiResid<false, true> E{H, H, nullptr, (float*)(ws + WS_SS3), 1.0f, F.lds + PS_OFF};
        pg8::gemm_phase<pg8::EpiResid<false, true>, pg8::StaticOrder, true, true>(F.lds, g, S, E); SEAM(10); }
    if (IN(11)) { p11_router(F); SEAM(11); }
    if (IN(12)) { p12_permute(F); SEAM(12); }
    if (IN(13)) {
        pg8::MoeOrder S; moe_bases(F, S.tb); S.npn = 22; S.G = F.G; S.c = F.bid;
        pg8::Gemm g{(const bf16*)(ws + WS_XPERM), (const bf16*)(ws + WS_WGUM), MAXSLOT, NE * 2 * FF, D / 2};
        pg8::EpiSwiGLU8<true> E{ws + WS_HM, FF, (LAS const float*)nullptr};
        pg8::gemm_phase<pg8::EpiSwiGLU8<true>, pg8::MoeOrder, true, true, true, true>(F.lds, g, S, E); SEAM(13); }
    if (IN(14)) {
        pg8::MoeOrder S; moe_bases(F, S.tb); S.npn = 4; S.G = F.G; S.c = F.bid;
        pg8::Gemm g{(const bf16*)(ws + WS_HM), (const bf16*)(ws + WS_WDM), MAXSLOT, NE * D, FF / 2};
        pg8::EpiScaledF8 E{ws + WS_Y, D, 3, Y8_S / (pg8::F8_SH * pg8::F8_SWD)};
        pg8::gemm_phase<pg8::EpiScaledF8, pg8::MoeOrder, true, true, true, true>(F.lds, g, S, E); SEAM(14); }
    if (IN(15)) { p15_combine(F); }
#undef IN
#undef SEAM
}

extern "C" void kernel_launch(void* const* d_in, const int* in_sizes, int n_in, void* d_out, int out_size, void* d_ws, size_t ws_size, hipStream_t stream) {
    static int grid = 0;
    if (grid == 0) {
        if (n_in != 17 || out_size != M * D || ws_size < WS_END) { fprintf(stderr, "kernel_launch: unexpected problem (n_in %d, out %d, ws %zu < %zu)\n", n_in, out_size, ws_size, (size_t)WS_END); grid = -1; return; }
        int dev = 0, cus = 0, per_cu = 0;
        if (hipGetDevice(&dev) != hipSuccess || hipDeviceGetAttribute(&cus, hipDeviceAttributeMultiprocessorCount, dev) != hipSuccess) { grid = -1; return; }
        if (hipFuncSetAttribute((const void*)yoco_fwd, hipFuncAttributeMaxDynamicSharedMemorySize, LDS_BYTES) != hipSuccess) { fprintf(stderr, "kernel_launch: hipFuncSetAttribute failed\n"); grid = -1; return; }
        if (hipOccupancyMaxActiveBlocksPerMultiprocessor(&per_cu, (const void*)yoco_fwd, NWAVES * 64, LDS_BYTES) != hipSuccess || per_cu < 1) fprintf(stderr, "kernel_launch: occupancy query says %d\n", per_cu);
        (void)hipGetLastError();
        grid = cus < 256 ? cus : 256;
    }
    if (grid < 0) return;
    if (hipMemsetAsync((char*)d_ws + WS_CTL, 0, CTL_ZERO_BYTES, stream) != hipSuccess) return;
    Args a{};
    for (int i = 0; i < 17; ++i) a.in[i] = (const float*)d_in[i];
    a.out = (float*)d_out; a.ws = (unsigned char*)d_ws;
#if MK_ONE_LAUNCH
    a.ph_lo = 0; a.ph_hi = N_PHASES;
    hipLaunchKernelGGL(yoco_fwd, dim3(grid), dim3(NWAVES * 64), LDS_BYTES, stream, a);
#else
    for (int p = 0; p < N_PHASES; ++p) { a.ph_lo = p; a.ph_hi = p + 1; hipLaunchKernelGGL(yoco_fwd, dim3(grid), dim3(NWAVES * 64), LDS_BYTES, stream, a); }
#endif
}
```
